# Optimizing an MI355X kernel written in HIP

```python
import jax
import jax.numpy as jnp
from jax import lax
import numpy as np

D_MODEL = 1024
BATCH = 8
SEQ = 4096
DEPTH = 2

CTX_LEN = 256
GRID_W = 64
BRANCH_WIDTH = D_MODEL // 2
N_BRANCHES = 3
RET_HEADS = 4
RET_V_DIM = BRANCH_WIDTH // RET_HEADS
RET_QK_DIM = RET_V_DIM // 2
RET_CHUNK = 128
SGU_WIDTH = BRANCH_WIDTH
SGU_GROUPS = 4
SGU_CHUNK = 128
ATT_HEAD_DIM = 64
ATT_HEADS = BRANCH_WIDTH // ATT_HEAD_DIM
ATT_KV_HEADS = 2
ATT_GROUP = ATT_HEADS // ATT_KV_HEADS
WINDOW = 128
ATT_BLOCK = 128
ROPE_BASE = 10000.0
N_EXPERTS = 16
EXPERT_FF = D_MODEL
CAPACITY_FACTOR = 2
EPS = 1e-6
NEG_INF = -1e30
IN_LAYOUT = (
    ('ret_q', RET_HEADS * RET_QK_DIM),
    ('ret_k', RET_HEADS * RET_QK_DIM),
    ('ret_v', RET_HEADS * RET_V_DIM),
    ('ret_g', RET_HEADS * RET_V_DIM),
    ('sgu_u', SGU_WIDTH),
    ('sgu_v', SGU_WIDTH),
    ('att_q', ATT_HEADS * ATT_HEAD_DIM),
    ('att_k', ATT_KV_HEADS * ATT_HEAD_DIM),
    ('att_v', ATT_KV_HEADS * ATT_HEAD_DIM),
    ('gates', N_BRANCHES * D_MODEL),
)
IN_WIDTH = 2 * RET_HEADS * RET_QK_DIM + 2 * RET_HEADS * RET_V_DIM + 2 * SGU_WIDTH + (ATT_HEADS + 2 * ATT_KV_HEADS) * ATT_HEAD_DIM + N_BRANCHES * D_MODEL
CTX_KV_NAMES = ('ret_k', 'ret_v', 'att_k', 'att_v')

kernel_name = 'hybrid_retention_sgu_swa_ecmoe_dit'


def _rms_norm(x, gain):
    xf = x.astype(jnp.float32)
    y = xf * lax.rsqrt(jnp.mean(xf * xf, axis=-1, keepdims=True) + EPS)
    return y.astype(x.dtype) * gain


def _layer_norm(x):
    xf = x.astype(jnp.float32)
    xc = xf - jnp.mean(xf, axis=-1, keepdims=True)
    return (xc * lax.rsqrt(jnp.mean(xc * xc, axis=-1, keepdims=True) + EPS)).astype(x.dtype)


def _layout_ranges():
    ranges, start = {}, 0
    for name, width in IN_LAYOUT:
        ranges[name] = (start, start + width)
        start += width
    return ranges


def _project(h, w_in, names):
    ranges = _layout_ranges()
    w = jnp.concatenate([w_in[:, ranges[n][0]:ranges[n][1]] for n in names], axis=1)
    z = h @ w
    widths = [ranges[n][1] - ranges[n][0] for n in names]
    offs = np.cumsum(widths)[:-1].tolist()
    return dict(zip(names, jnp.split(z, offs, axis=-1)))


def _heads(t, n, d):
    return t.reshape(t.shape[:-1] + (n, d))


def _axial_rope(rows, head_dim, dtype):
    f32 = jnp.float32
    row = jnp.repeat(jnp.arange(rows), GRID_W).astype(f32)
    col = jnp.tile(jnp.arange(GRID_W), rows).astype(f32)
    n_freq = head_dim // 4
    inv = jnp.power(ROPE_BASE, -jnp.arange(n_freq, dtype=f32) / n_freq)
    ang = jnp.concatenate([row[:, None] * inv, col[:, None] * inv], axis=-1)
    return jnp.cos(ang).astype(dtype), jnp.sin(ang).astype(dtype)


def _apply_rope(x, cos, sin):
    half = x.shape[-1] // 2
    shape = (x.shape[1],) + (1,) * (x.ndim - 3) + (half,)
    cos = cos.reshape(shape)
    sin = sin.reshape(shape)
    x1, x2 = x[..., :half], x[..., half:]
    return jnp.concatenate([x1 * cos - x2 * sin, x1 * sin + x2 * cos], axis=-1)


def _retention_dir(q, k, v, log_gamma, state0, include_diag):
    f32 = jnp.float32
    Bn, T, H, dk = q.shape
    dv = v.shape[-1]
    C = RET_CHUNK
    N = T // C
    qc = q.astype(f32).reshape(Bn, N, C, H, dk)
    kc = k.astype(f32).reshape(Bn, N, C, H, dk)
    vc = v.astype(f32).reshape(Bn, N, C, H, dv)
    idx = jnp.arange(C, dtype=f32)
    diff = idx[:, None] - idx[None, :]
    mask = (diff >= 0) if include_diag else (diff > 0)
    dec = jnp.where(mask[None], jnp.exp(jnp.where(mask, diff, 0.0)[None] * log_gamma[:, None, None]), 0.0)
    scores = jnp.einsum('bnihd,bnjhd->bnhij', qc, kc) * dec[None, None]
    inner = jnp.einsum('bnhij,bnjhe->bnihe', scores, vc)
    w_k = jnp.exp((C - 1 - idx)[:, None] * log_gamma[None, :])
    upd = jnp.einsum('bnjhd,bnjhe->nbhde', kc * w_k[None, None, :, :, None], vc)
    chunk_decay = jnp.exp(C * log_gamma)[None, :, None, None]

    def step(s, u):
        return chunk_decay * s + u, s

    final, s_prev = lax.scan(step, state0, upd)
    q_dec = jnp.exp((idx + 1.0)[:, None] * log_gamma[None, :])
    cross = jnp.einsum('bnihd,nbhde->bnihe', qc * q_dec[None, None, :, :, None], s_prev)
    return (inner + cross).reshape(Bn, T, H, dv), final


def _context_state(k, v, log_gamma):
    T = k.shape[1]
    w = jnp.exp((T - 1 - jnp.arange(T, dtype=jnp.float32))[:, None] * log_gamma[None, :])
    return jnp.einsum('bthd,bthe->bhde', k.astype(jnp.float32) * w[None, :, :, None], v.astype(jnp.float32))


def _retention_out(o, g):
    Bn, T = o.shape[:2]
    y = _layer_norm(o).reshape(Bn, T, -1).astype(g.dtype)
    return y * jax.nn.silu(g)


def _sgu(zu, zv, w_s, b_s):
    Bn, T, _ = zu.shape
    u = jax.nn.gelu(zu)
    v = _layer_norm(jax.nn.gelu(zv))
    n = T // SGU_CHUNK
    vg = v.reshape(Bn, n, SGU_CHUNK, SGU_GROUPS, SGU_WIDTH // SGU_GROUPS)
    mixed = jnp.einsum('gij,bnjgc->bnigc', w_s, vg) + b_s.T[:, :, None]
    return u * mixed.reshape(Bn, T, SGU_WIDTH)


def _window_attention(q, k, v, kc, vc, sink):
    f32 = jnp.float32
    Bn, S = q.shape[:2]
    nb = S // ATT_BLOCK
    L = kc.shape[1]
    scale = ATT_HEAD_DIM ** -0.5
    qb = q.reshape(Bn, nb, ATT_BLOCK, ATT_KV_HEADS, ATT_GROUP, ATT_HEAD_DIM)

    def band(t):
        tp = jnp.pad(t, ((0, 0), (ATT_BLOCK, ATT_BLOCK), (0, 0), (0, 0)))
        tp = tp.reshape(Bn, nb + 2, ATT_BLOCK, ATT_KV_HEADS, ATT_HEAD_DIM)
        return jnp.concatenate([tp[:, :-2], tp[:, 1:-1], tp[:, 2:]], axis=2)

    kb, vb = band(k), band(v)
    s_loc = jnp.einsum('bnihgd,bnjhd->bhgnij', qb, kb).astype(f32) * scale
    blk = jnp.arange(nb)[:, None, None] * ATT_BLOCK
    q_pos = blk + jnp.arange(ATT_BLOCK)[None, :, None]
    k_pos = blk - ATT_BLOCK + jnp.arange(3 * ATT_BLOCK)[None, None, :]
    valid = (jnp.abs(q_pos - k_pos) <= WINDOW) & (k_pos >= 0) & (k_pos < S)
    s_loc = jnp.where(valid, s_loc, NEG_INF)
    s_ctx = jnp.einsum('bnihgd,bjhd->bhgnij', qb, kc).astype(f32) * scale
    s_sink = jnp.broadcast_to(sink.astype(f32).reshape(1, ATT_KV_HEADS, ATT_GROUP, 1, 1, 1), s_loc.shape[:-1] + (1,))
    probs = jax.nn.softmax(jnp.concatenate([s_loc, s_ctx, s_sink], axis=-1), axis=-1).astype(v.dtype)
    n_loc = 3 * ATT_BLOCK
    o = (jnp.einsum('bhgnij,bnjhd->bnihgd', probs[..., :n_loc], vb)
         + jnp.einsum('bhgnij,bjhd->bnihgd', probs[..., n_loc:n_loc + L], vc))
    return o.reshape(Bn, S, ATT_HEADS * ATT_HEAD_DIM)


def _context_attention(q, kc, vc, sink):
    f32 = jnp.float32
    Bn, L = q.shape[:2]
    s = jnp.einsum('bihgd,bjhd->bhgij', q, kc).astype(f32) * (ATT_HEAD_DIM ** -0.5)
    s_sink = jnp.broadcast_to(sink.astype(f32).reshape(1, ATT_KV_HEADS, ATT_GROUP, 1, 1), s.shape[:-1] + (1,))
    probs = jax.nn.softmax(jnp.concatenate([s, s_sink], axis=-1), axis=-1).astype(vc.dtype)
    o = jnp.einsum('bhgij,bjhd->bihgd', probs[..., :L], vc)
    return o.reshape(Bn, L, ATT_HEADS * ATT_HEAD_DIM)


def _merge(branches, gate_logits, w_branch, w_out):
    Bn, T, _ = gate_logits.shape
    gates = jax.nn.sigmoid(gate_logits.reshape(Bn, T, N_BRANCHES, D_MODEL))
    merged = gates[:, :, 0] * (branches[0] @ w_branch[0])
    for i in range(1, N_BRANCHES):
        merged = merged + gates[:, :, i] * (branches[i] @ w_branch[i])
    return merged @ w_out


def _expert_choice_ffn(h, w_router, w_gate, w_up, w_down):
    Bn, T, D = h.shape
    cap = CAPACITY_FACTOR * T // N_EXPERTS
    aff = jax.nn.softmax((h @ w_router).astype(jnp.float32), axis=-1)
    top_w, top_idx = lax.top_k(jnp.swapaxes(aff, 1, 2), cap)
    xs = jax.vmap(lambda hb, ib: hb[ib])(h, top_idx)
    a = jnp.einsum('becd,edf->becf', xs, w_gate)
    u = jnp.einsum('becd,edf->becf', xs, w_up)
    y = jnp.einsum('becf,efd->becd', jax.nn.silu(a) * u, w_down) * top_w[..., None].astype(h.dtype)
    return jax.vmap(lambda ib, yb: jnp.zeros((T, D), h.dtype).at[ib.reshape(-1)].add(yb.reshape(-1, D)))(top_idx, y)


def _layer(x, xc, mod_lat, mod_ctx, rope_ret, rope_att, p, last):
    f32 = jnp.float32
    Bn = x.shape[0]
    sh1, sc1, g1, sh2, sc2, g2 = jnp.split(mod_lat, 6, axis=-1)
    csh1, csc1, cg1, csh2, csc2, cg2 = jnp.split(mod_ctx, 6, axis=-1)
    h = _rms_norm(x, p['norm1_g']) * (1 + sc1) + sh1
    hc = _rms_norm(xc, p['norm1_g']) * (1 + csc1) + csh1
    all_names = tuple(name for name, _ in IN_LAYOUT)
    z = _project(h, p['w_in'], all_names)
    zc = _project(hc, p['w_in'], CTX_KV_NAMES if last else all_names)

    cos_r, sin_r = rope_ret
    lg_f = jax.nn.log_sigmoid(p['ret_decay_fwd'].astype(f32))
    lg_b = jax.nn.log_sigmoid(p['ret_decay_bwd'].astype(f32))
    k_scale = RET_QK_DIM ** -0.5
    rq = _apply_rope(_heads(z['ret_q'], RET_HEADS, RET_QK_DIM), cos_r, sin_r)
    rk = _apply_rope(_heads(z['ret_k'], RET_HEADS, RET_QK_DIM), cos_r, sin_r) * k_scale
    rv = _heads(z['ret_v'], RET_HEADS, RET_V_DIM)
    rkc = _heads(zc['ret_k'], RET_HEADS, RET_QK_DIM) * k_scale
    rvc = _heads(zc['ret_v'], RET_HEADS, RET_V_DIM)
    if last:
        s_f = _context_state(rkc, rvc, lg_f)
        s_b = _context_state(rkc[:, ::-1], rvc[:, ::-1], lg_b)
    else:
        rqc = _heads(zc['ret_q'], RET_HEADS, RET_QK_DIM)
        zero = jnp.zeros((Bn, RET_HEADS, RET_QK_DIM, RET_V_DIM), f32)
        oc_f, s_f = _retention_dir(rqc, rkc, rvc, lg_f, zero, True)
        oc_b, s_b = _retention_dir(rqc[:, ::-1], rkc[:, ::-1], rvc[:, ::-1], lg_b, zero, False)
        ret_c = _retention_out(oc_f + oc_b[:, ::-1], zc['ret_g'])
    o_f, _ = _retention_dir(rq, rk, rv, lg_f, s_f, True)
    o_b, _ = _retention_dir(rq[:, ::-1], rk[:, ::-1], rv[:, ::-1], lg_b, s_b, False)
    ret = _retention_out(o_f + o_b[:, ::-1], z['ret_g'])

    sgu = _sgu(z['sgu_u'], z['sgu_v'], p['sgu_w'], p['sgu_b'])

    cos_a, sin_a = rope_att
    aq = _rms_norm(_heads(z['att_q'], ATT_KV_HEADS, ATT_GROUP * ATT_HEAD_DIM).reshape(z['att_q'].shape[:2] + (ATT_KV_HEADS, ATT_GROUP, ATT_HEAD_DIM)), p['q_norm_g'])
    aq = _apply_rope(aq, cos_a, sin_a)
    ak = _apply_rope(_rms_norm(_heads(z['att_k'], ATT_KV_HEADS, ATT_HEAD_DIM), p['k_norm_g']), cos_a, sin_a)
    av = _heads(z['att_v'], ATT_KV_HEADS, ATT_HEAD_DIM)
    akc = _rms_norm(_heads(zc['att_k'], ATT_KV_HEADS, ATT_HEAD_DIM), p['k_norm_g'])
    avc = _heads(zc['att_v'], ATT_KV_HEADS, ATT_HEAD_DIM)
    att = _window_attention(aq, ak, av, akc, avc, p['attn_sink'])

    x = x + g1 * _merge((ret, sgu, att), z['gates'], p['w_branch'], p['w_out'])
    h2 = _rms_norm(x, p['norm2_g']) * (1 + sc2) + sh2
    x = x + g2 * _expert_choice_ffn(h2, p['w_router'], p['w_exp_gate'], p['w_exp_up'], p['w_exp_down'])
    if last:
        return x, None

    sgu_c = _sgu(zc['sgu_u'], zc['sgu_v'], p['sgu_w'], p['sgu_b'])
    aqc = _rms_norm(zc['att_q'].reshape(zc['att_q'].shape[:2] + (ATT_KV_HEADS, ATT_GROUP, ATT_HEAD_DIM)), p['q_norm_g'])
    att_c = _context_attention(aqc, akc, avc, p['attn_sink'])
    xc = xc + cg1 * _merge((ret_c, sgu_c, att_c), zc['gates'], p['w_branch'], p['w_out'])
    h2c = _rms_norm(xc, p['norm2_g']) * (1 + csc2) + csh2
    xc = xc + cg2 * _expert_choice_ffn(h2c, p['w_router'], p['w_exp_gate'], p['w_exp_up'], p['w_exp_down'])
    return x, xc


def setup_inputs(seed: int = 0) -> dict:
    key = jax.random.key(seed)
    ks = jax.random.split(key, 24)
    f32 = jnp.float32
    D = D_MODEL

    def nrm(k, shape, s):
        return jax.random.normal(k, shape, f32) * s

    hidx = jnp.arange(RET_HEADS, dtype=f32)
    base_logit = jnp.log(jnp.power(2.0, 5.0 + hidx) - 1.0)
    return {
        'x': nrm(ks[0], (BATCH, SEQ, D), 1.0),
        'c': nrm(ks[1], (BATCH, D), 1.0),
        'ctx': nrm(ks[2], (BATCH, CTX_LEN, D), 1.0),
        'c_ctx': nrm(ks[3], (D,), 1.0),
        'w_mod': nrm(ks[4], (DEPTH, D, 6 * D), 0.5 * D ** -0.5),
        'b_mod': nrm(ks[5], (DEPTH, 6 * D), 0.02),
        'norm1_g': 1.0 + nrm(ks[6], (DEPTH, D), 0.02),
        'norm2_g': 1.0 + nrm(ks[7], (DEPTH, D), 0.02),
        'w_in': nrm(ks[8], (DEPTH, D, IN_WIDTH), D ** -0.5),
        'ret_decay_fwd': base_logit + nrm(ks[9], (DEPTH, RET_HEADS), 0.05),
        'ret_decay_bwd': base_logit + nrm(ks[10], (DEPTH, RET_HEADS), 0.05),
        'sgu_w': nrm(ks[11], (DEPTH, SGU_GROUPS, SGU_CHUNK, SGU_CHUNK), SGU_CHUNK ** -0.5),
        'sgu_b': 1.0 + nrm(ks[12], (DEPTH, SGU_GROUPS, SGU_CHUNK), 0.02),
        'q_norm_g': 1.0 + nrm(ks[13], (DEPTH, ATT_HEAD_DIM), 0.02),
        'k_norm_g': 1.0 + nrm(ks[14], (DEPTH, ATT_HEAD_DIM), 0.02),
        'attn_sink': nrm(ks[15], (DEPTH, ATT_HEADS), 0.5),
        'w_branch': nrm(ks[16], (DEPTH, N_BRANCHES, BRANCH_WIDTH, D), BRANCH_WIDTH ** -0.5),
        'w_out': nrm(ks[17], (DEPTH, D, D), D ** -0.5),
        'w_router': nrm(ks[18], (DEPTH, D, N_EXPERTS), D ** -0.5),
        'w_exp_gate': nrm(ks[19], (DEPTH, N_EXPERTS, D, EXPERT_FF), D ** -0.5),
        'w_exp_up': nrm(ks[20], (DEPTH, N_EXPERTS, D, EXPERT_FF), D ** -0.5),
        'w_exp_down': nrm(ks[21], (DEPTH, N_EXPERTS, EXPERT_FF, D), EXPERT_FF ** -0.5),
    }


def reference(x, c, ctx, c_ctx, w_mod, b_mod, norm1_g, norm2_g, w_in, ret_decay_fwd, ret_decay_bwd, sgu_w, sgu_b, q_norm_g, k_norm_g, attn_sink, w_branch, w_out, w_router, w_exp_gate, w_exp_up, w_exp_down):
    rows = x.shape[1] // GRID_W
    rope_ret = _axial_rope(rows, RET_QK_DIM, x.dtype)
    rope_att = _axial_rope(rows, ATT_HEAD_DIM, x.dtype)
    c_act = jax.nn.silu(c)
    c_ctx_act = jax.nn.silu(c_ctx)
    xc = ctx
    for l in range(DEPTH):
        p = {
            'norm1_g': norm1_g[l], 'norm2_g': norm2_g[l], 'w_in': w_in[l],
            'ret_decay_fwd': ret_decay_fwd[l], 'ret_decay_bwd': ret_decay_bwd[l],
            'sgu_w': sgu_w[l], 'sgu_b': sgu_b[l],
            'q_norm_g': q_norm_g[l], 'k_norm_g': k_norm_g[l], 'attn_sink': attn_sink[l],
            'w_branch': w_branch[l], 'w_out': w_out[l], 'w_router': w_router[l],
            'w_exp_gate': w_exp_gate[l], 'w_exp_up': w_exp_up[l], 'w_exp_down': w_exp_down[l],
        }
        mod_lat = (c_act @ w_mod[l] + b_mod[l])[:, None, :]
        mod_ctx = (c_ctx_act @ w_mod[l] + b_mod[l])[None, None, :]
        x, xc = _layer(x, xc, mod_lat, mod_ctx, rope_ret, rope_att, p, l == DEPTH - 1)
    return x
```

```cpp
#include <hip/hip_runtime.h>
#include <hip/hip_cooperative_groups.h>
#include <cstdio>
#include <cstdint>
namespace cg = cooperative_groups;
namespace pg8 {
#define PG8_LAS __attribute__((address_space(3)))
typedef unsigned short bf16_t;
typedef short bf16x8 __attribute__((ext_vector_type(8)));
typedef float f32x4 __attribute__((ext_vector_type(4)));
typedef unsigned u32x4 __attribute__((ext_vector_type(4)));
constexpr int BM = 256, BK = 64, HALF = 128, HTB = HALF * BK * 2  , STAGE_BYTES = 8 * HTB, NXCD = 8, WGM = 8;

__host__ __device__ __forceinline__ int lds_byte(int r, int c) { const int st = (r >> 4) * 2 + (c >> 5), rr = r & 15, cc = c & 31, ob = rr * 64 + cc * 2; return st * 1024 + (ob ^ (((ob >> 9) & 1) << 5)); }
__host__ __device__ __forceinline__ void stage_rc(int b, int& R, int& C) { const int st = b / 1024, sb = b % 1024, swz = sb ^ (((sb >> 9) & 1) << 5); R = (st >> 1) * 16 + swz / 64; C = (st & 1) * 32 + (swz % 64) / 2; }
__host__ __device__ __forceinline__ int perm32(int rho) { const int n = rho >> 4, i = rho & 15; return 8 * (i >> 2) + 4 * n + (i & 3); }

struct Unit { int pm, pn; };
struct Gemm { const bf16_t* A; const bf16_t* Bt; int M, N, K; };

struct StaticOrder {
    int nM, nN, nwg, G, c;
    __host__ __device__ void init(int M, int N, int G_, int c_) { nM = M / BM; nN = N / BM; nwg = nM * nN; G = G_; c = c_; }
    __host__ __device__ bool next(int i, Unit& u) const {
        const long L = (long)i * G + c; if (L >= nwg) return false;
        int wgid = (int)L; { const int q = nwg / NXCD, r = nwg % NXCD, xcd = wgid % NXCD, off = wgid / NXCD; wgid = (xcd < r ? xcd * (q + 1) : r * (q + 1) + (xcd - r) * q) + off; }
        const int nig = WGM * nN, gid = wgid / nig, fm = gid * WGM, gsz = (nM - fm) < WGM ? (nM - fm) : WGM;
        u.pm = fm + ((wgid % nig) % gsz); u.pn = (wgid % nig) / gsz; return true;
    }
    __device__ __forceinline__ void a_ready(const Unit&) const {}
    __device__ __forceinline__ void done(const Unit&) const {}
};

__device__ __forceinline__ unsigned cvt_pk_bf16(float lo, float hi) { unsigned r; asm volatile("v_cvt_pk_bf16_f32 %0, %1, %2" : "=v"(r) : "v"(lo), "v"(hi)); return r; }
typedef float f32x2 __attribute__((ext_vector_type(2)));
__device__ __forceinline__ f32x2 gelu_pk(f32x2 v) {
    const f32x2 av = __builtin_elementwise_abs(v), d = av * 0.2316418882f + 1.0f;
    f32x2 t; t.x = __builtin_amdgcn_rcpf(d.x); t.y = __builtin_amdgcn_rcpf(d.y);
    f32x2 q = t * 0.5307027145f + (-0.7265760135f); q = q * t + 0.7107068705f; q = q * t + (-0.142248368f); q = q * t + 0.127414796f; q = q * t;
    const f32x2 s = (v * v) * (-0.72134752044f);
    f32x2 e; e.x = __builtin_amdgcn_exp2f(s.x); e.y = __builtin_amdgcn_exp2f(s.y);
    const f32x2 m = v * (q * e), r = v - m;
    f32x2 o; o.x = v.x < 0.f ? m.x : r.x; o.y = v.y < 0.f ? m.y : r.y; return o;
}

template <int ACT  > struct EpiBf16 {
    static constexpr bool PERM = true, AFTER_DRAIN = false; static_assert(ACT == 0 || ACT == 1, "EpiBf16: ACT is 0 (none) or 1 (gelu_pk)");
    bf16_t* O; int ldc; const float* bias; int split_cols; size_t split_stride; float scale0;
    __device__ __forceinline__ void operator()(const f32x4 (&acc)[2][2][4][2], const Unit& u, int wr, int wc, int fr, int fq) const {
        const int row0 = u.pm * BM + wr * 64 + fr; int colt = u.pn * BM; bf16_t* base = O;
        float sc = 1.f; if (split_cols) { const int t = colt / split_cols; base += (size_t)t * split_stride; colt -= t * split_cols; if (t == 0) sc = scale0; }
        const int col0 = colt + wc * 32 + 8 * fq, bcol0 = u.pn * BM + wc * 32 + 8 * fq;
        f32x4 bv[2][2];
#pragma unroll
        for (int bj = 0; bj < 2; ++bj)
#pragma unroll
            for (int n = 0; n < 2; ++n) bv[bj][n] = bias ? *(const f32x4*)(bias + bcol0 + bj * HALF + 4 * n) : (f32x4){0.f, 0.f, 0.f, 0.f};
#pragma unroll
        for (int ai = 0; ai < 2; ++ai)
#pragma unroll
            for (int m = 0; m < 4; ++m) { bf16_t* rowp = base + (size_t)(row0 + ai * HALF + m * 16) * ldc + col0;
#pragma unroll
                for (int bj = 0; bj < 2; ++bj) { f32x4 v0 = acc[ai][bj][m][0] + bv[bj][0], v1 = acc[ai][bj][m][1] + bv[bj][1];
                    if (ACT == 1) { f32x2 a = gelu_pk((f32x2){v0[0], v0[1]}), b = gelu_pk((f32x2){v0[2], v0[3]}), c = gelu_pk((f32x2){v1[0], v1[1]}), d = gelu_pk((f32x2){v1[2], v1[3]});
                        v0 = (f32x4){a.x, a.y, b.x, b.y}; v1 = (f32x4){c.x, c.y, d.x, d.y}; }
                    v0 = v0 * sc; v1 = v1 * sc; u32x4 w; w.x = cvt_pk_bf16(v0[0], v0[1]); w.y = cvt_pk_bf16(v0[2], v0[3]); w.z = cvt_pk_bf16(v1[0], v1[1]); w.w = cvt_pk_bf16(v1[2], v1[3]);
                    *(u32x4*)(rowp + bj * HALF) = w; } }
    }
};
template <class Epi, class Sched, bool ALIGN_EPI = false, bool SP2 = false>
__device__ __forceinline__ void gemm_phase(PG8_LAS unsigned char* lds, const Gemm g, const Sched& S, const Epi& E) {
    const int tid = threadIdx.x, wid = __builtin_amdgcn_readfirstlane(tid >> 6), lane = tid & 63, wr = wid >> 2, wc = wid & 3, fr = lane & 15, fq = lane >> 4;
    const int K = g.K, nt = K / BK;
    unsigned voffA[2], voffB[2];
#pragma unroll
    for (int i = 0; i < 2; ++i) { int R, C; stage_rc(tid * 16 + i * 8192, R, C); const int Rb = Epi::PERM ? ((R & ~31) + perm32(R & 31)) : R;
        voffA[i] = (unsigned)(R * K + C) * 2u; voffB[i] = (unsigned)(Rb * K + C) * 2u; }
    const size_t kstep = (size_t)(BK * 2);
    const size_t hstep = (size_t)HALF * K * 2;
    const size_t tstep = 2 * hstep;
    const unsigned ldsw = (unsigned)wid * 1024u;
    const int aoff = lds_byte(wr * 64 + fr, fq * 8), boff = lds_byte(wc * 32 + fr, fq * 8);
#define PG8_SA(b, h) (((b) * 2 + (h)) * HTB)
#define PG8_SB(b, h) ((4 + (b) * 2 + (h)) * HTB)
#define PG8_STAGE(bufoff, gbase, voff) do { _Pragma("unroll") for (int _i = 0; _i < 2; ++_i) \
        __builtin_amdgcn_global_load_lds((const unsigned*)((const char*)(gbase) + (voff)[_i]), (PG8_LAS unsigned*)(lds + (bufoff) + ldsw + _i * 8192), 16, 0, 0); } while (0)
#define PG8_LDA(dst, b, h) do { _Pragma("unroll") for (int m = 0; m < 4; ++m) _Pragma("unroll") for (int k = 0; k < 2; ++k) dst[m][k] = *(const PG8_LAS bf16x8*)(lds + PG8_SA(b, h) + aoff + m * 2048 + k * 1024); } while (0)
#define PG8_LDB(dst, b, h) do { _Pragma("unroll") for (int n = 0; n < 2; ++n) _Pragma("unroll") for (int k = 0; k < 2; ++k) dst[n][k] = *(const PG8_LAS bf16x8*)(lds + PG8_SB(b, h) + boff + n * 2048 + k * 1024); } while (0)
#define PG8_MMA(ai, bj, At, Bt) do { __builtin_amdgcn_s_setprio(1); _Pragma("unroll") for (int m = 0; m < 4; ++m) _Pragma("unroll") for (int n = 0; n < 2; ++n) _Pragma("unroll") for (int k = 0; k < 2; ++k) \
        acc[ai][bj][m][n] = __builtin_amdgcn_mfma_f32_16x16x32_bf16(Bt[n][k], At[m][k], acc[ai][bj][m][n], 0, 0, 0); __builtin_amdgcn_s_setprio(0); } while (0)
#define PG8_WAIT_V(n) asm volatile("s_waitcnt vmcnt(" #n ")" ::: "memory")
#define PG8_WAIT_L(n) asm volatile("s_waitcnt lgkmcnt(" #n ")" ::: "memory")
#define PG8_BAR __builtin_amdgcn_s_barrier()
#define PG8_SCHED __builtin_amdgcn_sched_barrier(0)
    Unit cur, nxt; int ui = 0;
    if (!S.next(0, cur)) return;
    f32x4 acc[2][2][4][2];
#pragma unroll
    for (int a = 0; a < 2; ++a)
#pragma unroll
        for (int b = 0; b < 2; ++b)
#pragma unroll
            for (int m = 0; m < 4; ++m)
#pragma unroll
                for (int n = 0; n < 2; ++n) acc[a][b][m][n] = (f32x4){0.f, 0.f, 0.f, 0.f};
    bf16x8 At[4][2], B0[2][2], B1[2][2];
    const char* cA = (const char*)g.A + (size_t)cur.pm * tstep; const char* cB = (const char*)g.Bt + (size_t)cur.pn * tstep;
    S.a_ready(cur);
    if constexpr (SP2) {
        PG8_STAGE(PG8_SB(0, 0), cB, voffB); PG8_STAGE(PG8_SB(0, 1), cB + hstep, voffB); PG8_STAGE(PG8_SA(0, 0), cA, voffA); PG8_STAGE(PG8_SA(0, 1), cA + hstep, voffA);
        if (wr == 1) PG8_BAR;
        PG8_WAIT_V(2); PG8_BAR;
        PG8_STAGE(PG8_SB(1, 0), cB + kstep, voffB); PG8_STAGE(PG8_SA(1, 0), cA + kstep, voffA); PG8_STAGE(PG8_SB(1, 1), cB + hstep + kstep, voffB);
        PG8_WAIT_V(6); PG8_BAR;
    } else {
        PG8_STAGE(PG8_SB(0, 0), cB, voffB); PG8_STAGE(PG8_SA(0, 0), cA, voffA); PG8_STAGE(PG8_SB(0, 1), cB + hstep, voffB); PG8_STAGE(PG8_SA(0, 1), cA + hstep, voffA);
        if (wr == 1) PG8_BAR;
        PG8_WAIT_V(4); PG8_BAR;
        PG8_STAGE(PG8_SB(1, 0), cB + kstep, voffB); PG8_STAGE(PG8_SA(1, 0), cA + kstep, voffA); PG8_STAGE(PG8_SB(1, 1), cB + hstep + kstep, voffB);
        PG8_WAIT_V(6); PG8_BAR;
    }
    for (;;) {
        const bool has_next = S.next(ui + 1, nxt);
        const char* nA = has_next ? (const char*)g.A + (size_t)nxt.pm * tstep : cA; const char* nB = has_next ? (const char*)g.Bt + (size_t)nxt.pn * tstep : cB;
        for (int t = 0; t < nt; t += 2) {
            const bool last = (t == nt - 2);
            const char* a1 = cA + (size_t)(t + 1) * kstep;
            const char* a2 = last ? nA : cA + (size_t)(t + 2) * kstep; const char* b2 = last ? nB : cB + (size_t)(t + 2) * kstep;
            const char* a3 = a2 + kstep; const char* b3 = b2 + kstep;
            if (last && has_next) S.a_ready(nxt);
            if constexpr (SP2) {
            PG8_LDB(B0, 0, 0); PG8_LDB(B1, 0, 1); PG8_SCHED; PG8_LDA(At, 0, 0); PG8_STAGE(PG8_SA(1, 1), a1 + hstep, voffA);
            PG8_WAIT_V(8); PG8_WAIT_L(0); PG8_BAR; PG8_MMA(0, 0, At, B0); PG8_MMA(0, 1, At, B1); PG8_BAR; PG8_SCHED;
            PG8_LDA(At, 0, 1); PG8_STAGE(PG8_SB(0, 0), b2, voffB); PG8_STAGE(PG8_SB(0, 1), b2 + hstep, voffB); PG8_STAGE(PG8_SA(0, 0), a2, voffA);
            PG8_WAIT_V(8); PG8_WAIT_L(0); PG8_BAR; PG8_MMA(1, 0, At, B0); PG8_MMA(1, 1, At, B1); PG8_BAR; PG8_SCHED;
            PG8_LDB(B0, 1, 0); PG8_LDB(B1, 1, 1); PG8_SCHED; PG8_LDA(At, 1, 0); PG8_STAGE(PG8_SA(0, 1), a2 + hstep, voffA);
            PG8_WAIT_V(8); PG8_WAIT_L(0); PG8_BAR; PG8_MMA(0, 0, At, B0); PG8_MMA(0, 1, At, B1); PG8_BAR; PG8_SCHED;
            PG8_LDA(At, 1, 1); PG8_STAGE(PG8_SB(1, 0), b3, voffB); PG8_STAGE(PG8_SB(1, 1), b3 + hstep, voffB); PG8_STAGE(PG8_SA(1, 0), a3, voffA);
            PG8_WAIT_V(8); PG8_WAIT_L(0); PG8_BAR; PG8_MMA(1, 0, At, B0); PG8_MMA(1, 1, At, B1); PG8_BAR; PG8_SCHED;
            } else {
            PG8_LDB(B0, 0, 0); PG8_SCHED; PG8_LDA(At, 0, 0); PG8_STAGE(PG8_SA(1, 1), a1 + hstep, voffA);
            PG8_WAIT_L(8); PG8_BAR; PG8_WAIT_L(0); PG8_MMA(0, 0, At, B0); PG8_BAR; PG8_SCHED;
            PG8_LDB(B1, 0, 1); PG8_STAGE(PG8_SB(0, 0), b2, voffB);
            PG8_BAR; PG8_WAIT_L(0); PG8_MMA(0, 1, At, B1); PG8_BAR;
            PG8_LDA(At, 0, 1); PG8_STAGE(PG8_SA(0, 0), a2, voffA);
            PG8_BAR; PG8_WAIT_L(0); PG8_MMA(1, 0, At, B0); PG8_BAR; PG8_SCHED;
            PG8_STAGE(PG8_SB(0, 1), b2 + hstep, voffB);
            PG8_WAIT_V(6); PG8_BAR; PG8_MMA(1, 1, At, B1); PG8_BAR;
            PG8_LDB(B0, 1, 0); PG8_SCHED; PG8_LDA(At, 1, 0); PG8_STAGE(PG8_SA(0, 1), a2 + hstep, voffA);
            PG8_WAIT_L(8); PG8_BAR; PG8_WAIT_L(0); PG8_MMA(0, 0, At, B0); PG8_BAR; PG8_SCHED;
            PG8_LDB(B1, 1, 1); PG8_STAGE(PG8_SB(1, 0), b3, voffB);
            PG8_BAR; PG8_WAIT_L(0); PG8_MMA(0, 1, At, B1); PG8_BAR;
            PG8_LDA(At, 1, 1); PG8_STAGE(PG8_SA(1, 0), a3, voffA);
            PG8_BAR; PG8_WAIT_L(0); PG8_MMA(1, 0, At, B0); PG8_BAR; PG8_SCHED;
            PG8_STAGE(PG8_SB(1, 1), b3 + hstep, voffB);
            PG8_WAIT_V(6); PG8_BAR; PG8_MMA(1, 1, At, B1); PG8_BAR;
            }
        }
        if constexpr (ALIGN_EPI) { if (wr == 0) PG8_BAR; }
        if constexpr (!Epi::AFTER_DRAIN) { E(acc, cur, wr, wc, fr, fq); S.done(cur); }
        if (!has_next) break;
#pragma unroll
        for (int a = 0; a < 2; ++a)
#pragma unroll
            for (int b = 0; b < 2; ++b)
#pragma unroll
                for (int m = 0; m < 4; ++m)
#pragma unroll
                    for (int n = 0; n < 2; ++n) acc[a][b][m][n] = (f32x4){0.f, 0.f, 0.f, 0.f};
        cur = nxt; cA = nA; cB = nB; ++ui;
        if constexpr (ALIGN_EPI) { if (wr == 1) PG8_BAR; }
    }
    PG8_WAIT_V(0);
    if constexpr (!ALIGN_EPI) { if (wr == 0) PG8_BAR; }
    PG8_BAR;
    if constexpr (Epi::AFTER_DRAIN) { E.fused(acc, cur, wr, wc, fr, fq, lds, wid, lane); S.done(cur); }
#undef PG8_SA
#undef PG8_SB
#undef PG8_STAGE
#undef PG8_LDA
#undef PG8_LDB
#undef PG8_MMA
#undef PG8_WAIT_V
#undef PG8_WAIT_L
#undef PG8_BAR
#undef PG8_SCHED
}
}

#define LAS __attribute__((address_space(3)))
typedef unsigned short bf16;
typedef short bf16x8 __attribute__((ext_vector_type(8)));
typedef float f32x4 __attribute__((ext_vector_type(4)));
typedef unsigned u32x4 __attribute__((ext_vector_type(4)));
typedef unsigned u32x2 __attribute__((ext_vector_type(2)));

constexpr int D = 1024, NB = 8, T = 4096, CL = 256;
constexpr int ML = NB * T, MC = NB * CL, M = ML + MC;
constexpr int NZA = 3328, NZG = 3072;
constexpr int C_RQ = 0, C_RK = 256, C_RV = 512, C_RG = 1024, C_SU = 1536, C_SV = 2048, C_AQ = 2560, C_AK = 3072, C_AV = 3200;
constexpr int NE = 16, CAPL = 512, CAPC = 32, ME = NB * (CAPL + CAPC);
constexpr int NCH = 34;
constexpr float EPS = 1e-6f, LOG2E = 1.4426950408889634f;
constexpr int LDS_BYTES = 147456;

constexpr size_t MiB = 1u << 20;
constexpr size_t WS_ROPEC = 1 * MiB, WS_ROPES = 1 * MiB + 512 * 1024, WS_MODV = 2 * MiB, WS_AFF = 3 * MiB, WS_AFFC = 5 * MiB, WS_INV = 6 * MiB, WS_TOPW = 9 * MiB;
constexpr size_t WS_WTIN = 16 * MiB, WS_WTBR = WS_WTIN + (size_t)6400 * 1024 * 2, WS_WTOUT = WS_WTBR + (size_t)3072 * 512 * 2;
constexpr size_t WS_X = 34 * MiB, WS_H = 170 * MiB, WS_R = 238 * MiB;
constexpr size_t WS_ZA = WS_R, WS_G = WS_R, WS_RS = 459 * MiB, WS_ST = 527 * MiB;
constexpr size_t WS_XS = WS_R, WS_ACT = 374 * MiB, WS_WT1 = 510 * MiB, WS_WT2 = 574 * MiB, WS_END = 606 * MiB;
static_assert(WS_WTOUT + 2 * MiB <= WS_X && WS_ZA + (size_t)M * NZA * 2 <= WS_RS && WS_ST + (size_t)NB * 4 * NCH * 128 * 128 * 2 <= WS_END, "ws map");

struct KP {
    const float *x, *c, *ctx, *c_ctx, *w_mod, *b_mod, *norm1_g, *norm2_g, *w_in, *dec_f, *dec_b, *sgu_w, *sgu_b, *qn_g, *kn_g, *sink, *w_branch, *w_out, *w_router, *w_eg, *w_eu, *w_ed;
    float* out; unsigned char* ws;
};
typedef const __attribute__((address_space(4))) KP* KPC;

#define LDS_WAIT() asm volatile("s_waitcnt lgkmcnt(0)" ::: "memory")
__device__ __forceinline__ unsigned pk2(float lo, float hi) { return pg8::cvt_pk_bf16(lo, hi); }
__device__ __forceinline__ float bflo(unsigned w) { return __uint_as_float(w << 16); }
__device__ __forceinline__ float bfhi(unsigned w) { return __uint_as_float(w & 0xffff0000u); }
__device__ __forceinline__ void unpack8(const u32x4 w, float (&f)[8]) { f[0] = bflo(w.x); f[1] = bfhi(w.x); f[2] = bflo(w.y); f[3] = bfhi(w.y); f[4] = bflo(w.z); f[5] = bfhi(w.z); f[6] = bflo(w.w); f[7] = bfhi(w.w); }
__device__ __forceinline__ u32x4 pack8(const float (&f)[8]) { u32x4 o; o.x = pk2(f[0], f[1]); o.y = pk2(f[2], f[3]); o.z = pk2(f[4], f[5]); o.w = pk2(f[6], f[7]); return o; }
template <int MASK> __device__ __forceinline__ float swz_xor(float v) { static_assert(MASK > 0 && MASK < 32, "swz_xor: 1..31"); return __builtin_bit_cast(float, __builtin_amdgcn_ds_swizzle(__builtin_bit_cast(int, v), 0x1f | (MASK << 10))); }
template <int MASK> __device__ __forceinline__ int swz_xor_i(int v) { return __builtin_amdgcn_ds_swizzle(v, 0x1f | (MASK << 10)); }
__device__ __forceinline__ float sum_x32(float v) { const unsigned u = __builtin_bit_cast(unsigned, v); auto r = __builtin_amdgcn_permlane32_swap(u, u, false, false); return __builtin_bit_cast(float, (unsigned)r[0]) + __builtin_bit_cast(float, (unsigned)r[1]); }
__device__ __forceinline__ float max_x32(float v) { const unsigned u = __builtin_bit_cast(unsigned, v); auto r = __builtin_amdgcn_permlane32_swap(u, u, false, false); return fmaxf(__builtin_bit_cast(float, (unsigned)r[0]), __builtin_bit_cast(float, (unsigned)r[1])); }
__device__ __forceinline__ int sum_x32_i(int v) { auto r = __builtin_amdgcn_permlane32_swap((unsigned)v, (unsigned)v, false, false); return (int)r[0] + (int)r[1]; }
__device__ __forceinline__ float wave_sum(float v) { v += swz_xor<1>(v); v += swz_xor<2>(v); v += swz_xor<4>(v); v += swz_xor<8>(v); v += swz_xor<16>(v); return sum_x32(v); }
__device__ __forceinline__ float wave_max(float v) { v = fmaxf(v, swz_xor<1>(v)); v = fmaxf(v, swz_xor<2>(v)); v = fmaxf(v, swz_xor<4>(v)); v = fmaxf(v, swz_xor<8>(v)); v = fmaxf(v, swz_xor<16>(v)); return max_x32(v); }
__device__ __forceinline__ int wave_sum_i(int v) { v += swz_xor_i<1>(v); v += swz_xor_i<2>(v); v += swz_xor_i<4>(v); v += swz_xor_i<8>(v); v += swz_xor_i<16>(v); return sum_x32_i(v); }
__device__ __forceinline__ float sum_x16_x32(float v) { v += swz_xor<16>(v); return sum_x32(v); }
__device__ __forceinline__ float sum_x1_x2(float v) { v += swz_xor<1>(v); v += swz_xor<2>(v); return v; }
__device__ __forceinline__ float ex2(float x) { return __builtin_amdgcn_exp2f(x); }
__device__ __forceinline__ float sigmoidf_(float x) { return 1.f / (1.f + ex2(-x * LOG2E)); }
__device__ __forceinline__ float gelu_tanh(float x) { const float u = 0.7978845608028654f * (x + 0.044715f * x * x * x); return x / (1.f + ex2(-2.f * LOG2E * u)); }
__device__ __forceinline__ f32x4 mfma16(bf16x8 a, bf16x8 b, f32x4 c) { return __builtin_amdgcn_mfma_f32_16x16x32_bf16(a, b, c, 0, 0, 0); }
__device__ __forceinline__ bf16x8 as_bf16x8(u32x4 w) { return __builtin_bit_cast(bf16x8, w); }
__device__ __forceinline__ float log2_sigmoid(float a) { return -log1pf(__expf(-a)) * LOG2E; }

struct GroupOrder {
    int nG, nM, nN, pmS, pnS, G, c;
    __device__ __forceinline__ bool next(int i, pg8::Unit& u) const {
        const long L = (long)i * G + c; const int tot = nG * nM * nN; if (L >= tot) return false;
        int wgid = (int)L; { const int q = tot / 8, r = tot % 8, xcd = wgid % 8, off = wgid / 8; wgid = (xcd < r ? xcd * (q + 1) : r * (q + 1) + (xcd - r) * q) + off; }
        const int per = nM * nN, g = wgid / per, rem = wgid - g * per;
        const int nig = 8 * nN, gid = rem / nig, fm = gid * 8, gsz = (nM - fm) < 8 ? (nM - fm) : 8;
        u.pm = g * pmS + fm + ((rem % nig) % gsz); u.pn = g * pnS + (rem % nig) / gsz; return true;
    }
    __device__ __forceinline__ void a_ready(const pg8::Unit&) const {}
    __device__ __forceinline__ void done(const pg8::Unit&) const {}
};
struct MergeOrder {
    int nM, G, c;
    __device__ __forceinline__ bool next(int i, pg8::Unit& u) const {
        const int ii = i / 3, g = i - 3 * ii; const long L = (long)ii * G + c; const int tot = nM * 4; if (L >= tot) return false;
        int wgid = (int)L; { const int q = tot / 8, r = tot % 8, xcd = wgid % 8, off = wgid / 8; wgid = (xcd < r ? xcd * (q + 1) : r * (q + 1) + (xcd - r) * q) + off; }
        const int nig = 32, gid = wgid / nig, fm = gid * 8, gsz = (nM - fm) < 8 ? (nM - fm) : 8;
        u.pm = g * (M / 256) + fm + ((wgid % nig) % gsz); u.pn = g * 4 + (wgid % nig) / gsz; return true;
    }
    __device__ __forceinline__ void a_ready(const pg8::Unit&) const {}
    __device__ __forceinline__ void done(const pg8::Unit&) const {}
};

struct EpiMerge {
    static constexpr bool PERM = true, AFTER_DRAIN = false;
    const bf16* Gt; bf16* Hm;
    __device__ __forceinline__ void operator()(const f32x4 (&acc)[2][2][4][2], const pg8::Unit& u, int wr, int wc, int fr, int fq) const {
        const int g = u.pm / (M / 256), m = u.pm - g * (M / 256), n = u.pn - g * 4;
        const int row0 = m * 256 + wr * 64 + fr, col0 = n * 256 + wc * 32 + 8 * fq;
#pragma unroll
        for (int ai = 0; ai < 2; ++ai)
#pragma unroll
            for (int mm = 0; mm < 4; ++mm) { const size_t r = (size_t)(row0 + ai * 128 + mm * 16);
#pragma unroll
                for (int bj = 0; bj < 2; ++bj) { const int cc = col0 + bj * 128;
                    const u32x4 gw = *(const u32x4*)(Gt + r * NZG + g * 1024 + cc); float gt[8]; unpack8(gw, gt);
                    const f32x4 v0 = acc[ai][bj][mm][0], v1 = acc[ai][bj][mm][1];
                    float o[8] = {v0[0], v0[1], v0[2], v0[3], v1[0], v1[1], v1[2], v1[3]};
#pragma unroll
                    for (int k = 0; k < 8; ++k) o[k] *= sigmoidf_(gt[k]);
                    if (g > 0) { const u32x4 ow = *(const u32x4*)(Hm + r * 1024 + cc); float od[8]; unpack8(ow, od);
#pragma unroll
                        for (int k = 0; k < 8; ++k) o[k] += od[k]; }
                    *(u32x4*)(Hm + r * 1024 + cc) = pack8(o); } }
    }
};
struct EpiOut {
    static constexpr bool PERM = false, AFTER_DRAIN = false;
    const float* xl; const float* xc; float* X; const float* modv;
    __device__ __forceinline__ void operator()(const f32x4 (&acc)[2][2][4][2], const pg8::Unit& u, int wr, int wc, int fr, int fq) const {
        const int row0 = u.pm * 256 + wr * 64 + fr, col0 = u.pn * 256 + wc * 32 + 4 * fq;
        const int bi = (u.pm * 256 < ML) ? ((u.pm * 256) >> 12) : 8;
        const float* g1 = modv + bi * 6144 + 2 * 1024;
        f32x4 gv[2][2];
#pragma unroll
        for (int bj = 0; bj < 2; ++bj)
#pragma unroll
            for (int n = 0; n < 2; ++n) gv[bj][n] = *(const f32x4*)(g1 + col0 + bj * 128 + n * 16);
#pragma unroll
        for (int ai = 0; ai < 2; ++ai)
#pragma unroll
            for (int m = 0; m < 4; ++m) { const int r = row0 + ai * 128 + m * 16; const float* src = (r < ML) ? xl + (size_t)r * 1024 : xc + (size_t)(r - ML) * 1024;
#pragma unroll
                for (int bj = 0; bj < 2; ++bj)
#pragma unroll
                    for (int n = 0; n < 2; ++n) { const int cc = col0 + bj * 128 + n * 16; const f32x4 xv = *(const f32x4*)(src + cc);
                        *(f32x4*)(X + (size_t)r * 1024 + cc) = xv + gv[bj][n] * acc[ai][bj][m][n]; } }
    }
};
struct EpiMoe1 {
    static constexpr bool PERM = true, AFTER_DRAIN = false;
    bf16* ACT;
    __device__ __forceinline__ void operator()(const f32x4 (&acc)[2][2][4][2], const pg8::Unit& u, int wr, int wc, int fr, int fq) const {
        const int row0 = u.pm * 256 + wr * 64 + fr, col0 = (u.pn & 7) * 128 + wc * 32 + 8 * fq;
#pragma unroll
        for (int ai = 0; ai < 2; ++ai)
#pragma unroll
            for (int m = 0; m < 4; ++m) { const size_t r = (size_t)(row0 + ai * 128 + m * 16);
                const f32x4 a0 = acc[ai][0][m][0], a1 = acc[ai][0][m][1], u0 = acc[ai][1][m][0], u1 = acc[ai][1][m][1];
                float o[8];
#pragma unroll
                for (int k = 0; k < 4; ++k) { o[k] = a0[k] * sigmoidf_(a0[k]) * u0[k]; o[4 + k] = a1[k] * sigmoidf_(a1[k]) * u1[k]; }
                *(u32x4*)(ACT + r * 1024 + col0) = pack8(o); }
    }
};
struct EpiMoe2 {
    static constexpr bool PERM = true, AFTER_DRAIN = false;
    bf16* Y; const float* topw;
    __device__ __forceinline__ void operator()(const f32x4 (&acc)[2][2][4][2], const pg8::Unit& u, int wr, int wc, int fr, int fq) const {
        const int row0 = u.pm * 256 + wr * 64 + fr, col0 = (u.pn & 3) * 256 + wc * 32 + 8 * fq;
#pragma unroll
        for (int ai = 0; ai < 2; ++ai)
#pragma unroll
            for (int m = 0; m < 4; ++m) { const size_t r = (size_t)(row0 + ai * 128 + m * 16); const float tw = topw[r];
#pragma unroll
                for (int bj = 0; bj < 2; ++bj) { const f32x4 v0 = acc[ai][bj][m][0] * tw, v1 = acc[ai][bj][m][1] * tw;
                    u32x4 w; w.x = pk2(v0[0], v0[1]); w.y = pk2(v0[2], v0[3]); w.z = pk2(v1[0], v1[1]); w.w = pk2(v1[2], v1[3]);
                    *(u32x4*)(Y + r * 1024 + col0 + bj * 128) = w; } }
    }
};

__device__ __forceinline__ void tr_item(const float* W, int N, int k0, int n0, bf16* dst, int K, LAS float* scr, int lane) {
#pragma unroll 8
    for (int i = 0; i < 32; ++i) { const int kk = 2 * i + (lane >> 5); scr[kk * 33 + (lane & 31)] = W[(size_t)(k0 + kk) * N + n0 + (lane & 31)]; }
    LDS_WAIT();
    const int cc = lane & 7;
#pragma unroll
    for (int j = 0; j < 4; ++j) { const int n = (lane >> 3) + 8 * j; const LAS float* s = scr + (8 * cc) * 33 + n;
        u32x4 o; o.x = pk2(s[0 * 33], s[1 * 33]); o.y = pk2(s[2 * 33], s[3 * 33]); o.z = pk2(s[4 * 33], s[5 * 33]); o.w = pk2(s[6 * 33], s[7 * 33]);
        *(u32x4*)(dst + (size_t)n * K + 8 * cc) = o; }
    LDS_WAIT();
}
__device__ __forceinline__ void convert_small(KPC p, int l, LAS unsigned char* lds, int lane, int wave, int bid, int G) {
    LAS float* scr = (LAS float*)(lds + wave * 8448);
    const int gw = bid * 8 + wave, NGW = G * 8;
    constexpr int I_IN = 16 * 200, I_BR = 8 * 32, I_OUT = 16 * 32;
    bf16* wtin = (bf16*)(p->ws + WS_WTIN); bf16* wtbr = (bf16*)(p->ws + WS_WTBR); bf16* wtout = (bf16*)(p->ws + WS_WTOUT);
    for (int it = gw; it < I_IN + 3 * I_BR + I_OUT; it += NGW) {
        int r = it;
        if (r < I_IN) { const int kb = r / 200, nb = r % 200; tr_item(p->w_in + (size_t)l * 1024 * 6400, 6400, 64 * kb, 32 * nb, wtin + (size_t)(32 * nb) * 1024 + 64 * kb, 1024, scr, lane); continue; }
        r -= I_IN;
        if (r < 3 * I_BR) { const int br = r / I_BR, q = r % I_BR, kb = q / 32, nb = q % 32;
            tr_item(p->w_branch + ((size_t)l * 3 + br) * 512 * 1024, 1024, 64 * kb, 32 * nb, wtbr + (size_t)(br * 1024 + 32 * nb) * 512 + 64 * kb, 512, scr, lane); continue; }
        r -= 3 * I_BR;
        { const int kb = r / 32, nb = r % 32; tr_item(p->w_out + (size_t)l * 1024 * 1024, 1024, 64 * kb, 32 * nb, wtout + (size_t)(32 * nb) * 1024 + 64 * kb, 1024, scr, lane); }
    }
}
__device__ __forceinline__ void convert_experts(KPC p, int l, LAS unsigned char* lds, int lane, int wave, int bid, int G) {
    LAS float* scr = (LAS float*)(lds + wave * 8448);
    const int gw = bid * 8 + wave, NGW = G * 8;
    bf16* wt1 = (bf16*)(p->ws + WS_WT1); bf16* wt2 = (bf16*)(p->ws + WS_WT2);
    for (int it = gw; it < NE * 3 * 512; it += NGW) {
        const int e = it / 1536, q = it % 1536, which = q / 512, qq = q % 512, kb = qq / 32, nb = qq % 32, n0 = 32 * nb, k0 = 64 * kb;
        const size_t woff = ((size_t)l * NE + e) * 1024 * 1024;
        if (which == 0) tr_item(p->w_eg + woff, 1024, k0, n0, wt1 + ((size_t)e * 2048 + (n0 >> 7) * 256 + (n0 & 127)) * 1024 + k0, 1024, scr, lane);
        else if (which == 1) tr_item(p->w_eu + woff, 1024, k0, n0, wt1 + ((size_t)e * 2048 + (n0 >> 7) * 256 + 128 + (n0 & 127)) * 1024 + k0, 1024, scr, lane);
        else tr_item(p->w_ed + woff, 1024, k0, n0, wt2 + ((size_t)e * 1024 + n0) * 1024 + k0, 1024, scr, lane);
    }
}

__device__ __forceinline__ void phase_prep(KPC p, LAS unsigned char* lds, int tid, int lane, int wave, int bid, int G) {
    unsigned char* ws = p->ws;
    {   float* rc = (float*)(ws + WS_ROPEC); float* rsn = (float*)(ws + WS_ROPES);
        for (int i = bid * 512 + tid; i < T * 32; i += G * 512) { const int t = i >> 5, f = i & 31; const int pos = (f < 16) ? (t >> 6) : (t & 63); const int fi = f & 15;
            const float inv = ex2(-(float)fi * (13.287712379549449f / 16.f));
            float ang = (float)pos * inv; ang -= 6.283185307179586f * rintf(ang * 0.15915494309189535f);
            rc[i] = __cosf(ang); rsn[i] = __sinf(ang); } }
    {   LAS float* sv = (LAS float*)lds;
        LAS float* red = (LAS float*)(lds + 36864);
        for (int i = tid; i < 9 * 1024; i += 512) { const int r = i >> 10, k = i & 1023; const float v = (r < 8) ? p->c[r * 1024 + k] : p->c_ctx[k]; sv[i] = v * sigmoidf_(v); }
        __syncthreads();
        for (int it = bid; it < 192; it += G) {
            const int l = it / 96, n0 = (it % 96) * 64;
            const float* W = p->w_mod + (size_t)l * 1024 * 6144 + n0 + lane;
            float acc[9];
#pragma unroll
            for (int r = 0; r < 9; ++r) acc[r] = 0.f;
#pragma unroll 4
            for (int k = wave * 128; k < wave * 128 + 128; ++k) { const float wv = W[(size_t)k * 6144];
#pragma unroll
                for (int r = 0; r < 9; ++r) acc[r] += sv[r * 1024 + k] * wv; }
#pragma unroll
            for (int r = 0; r < 9; ++r) red[(wave * 9 + r) * 64 + lane] = acc[r];
            __syncthreads();
            for (int i = tid; i < 576; i += 512) { const int r = i >> 6, ln = i & 63; float s = 0.f;
#pragma unroll
                for (int w = 0; w < 8; ++w) s += red[(w * 9 + r) * 64 + ln];
                s += p->b_mod[l * 6144 + n0 + ln]; ((float*)(ws + WS_MODV))[(l * 9 + r) * 6144 + n0 + ln] = s; }
            __syncthreads();
        }
    }
    __syncthreads();
    convert_small(p, 0, lds, lane, wave, bid, G);
}

__device__ __forceinline__ float row_rs(const f32x4 (&v)[4]) {
    float ss = 0.f;
#pragma unroll
    for (int j = 0; j < 4; ++j) ss += (v[j].x * v[j].x + v[j].y * v[j].y) + (v[j].z * v[j].z + v[j].w * v[j].w);
    return 1.0f / sqrtf(wave_sum(ss) * (1.f / 1024.f) + EPS);
}
__device__ __forceinline__ void norm_mod(const f32x4 (&v)[4], float rs, const float* gain, const float* sh, const float* sc, f32x4 (&h)[4], int lane) {
#pragma unroll
    for (int j = 0; j < 4; ++j) { const int col = 4 * lane + 256 * j; const f32x4 g = *(const f32x4*)(gain + col), a = *(const f32x4*)(sc + col), b = *(const f32x4*)(sh + col);
        h[j] = (v[j] * rs) * g * (a + 1.0f) + b; }
}
__device__ __forceinline__ void store_h(const f32x4 (&h)[4], bf16* hrow, int lane) {
#pragma unroll
    for (int j = 0; j < 4; ++j) { u32x2 w; w.x = pk2(h[j].x, h[j].y); w.y = pk2(h[j].z, h[j].w); *(u32x2*)(hrow + 4 * lane + 256 * j) = w; }
}
__device__ __forceinline__ void phase_norm_in(KPC p, int lane, int wave, int bid, int G) {
    const float* modv = (const float*)(p->ws + WS_MODV); bf16* H = (bf16*)(p->ws + WS_H);
    for (int r = bid * 8 + wave; r < M; r += G * 8) {
        const float* src = (r < ML) ? p->x + (size_t)r * 1024 : p->ctx + (size_t)(r - ML) * 1024; const int bi = (r < ML) ? (r >> 12) : 8;
        f32x4 v[4], h[4];
#pragma unroll
        for (int j = 0; j < 4; ++j) v[j] = *(const f32x4*)(src + 4 * lane + 256 * j);
        const float rs = row_rs(v);
        norm_mod(v, rs, p->norm1_g, modv + bi * 6144, modv + bi * 6144 + 1024, h, lane);
        store_h(h, H + (size_t)r * 1024, lane);
    }
}

__device__ __forceinline__ void att_item(KPC p, int l, LAS unsigned char* lds, int item, float Mb2, int tid, int lane, int wave) {
    const bf16* ZA = (const bf16*)(p->ws + WS_ZA); bf16* BR = (bf16*)p->out + (size_t)2 * M * 512;
    const float* rc = (const float*)(p->ws + WS_ROPEC); const float* rsn = (const float*)(p->ws + WS_ROPES);
    const bool isctx = item >= 512;
    int b, kvh, qb;
    if (!isctx) { b = item >> 6; kvh = (item >> 5) & 1; qb = item & 31; } else { const int ci = item - 512; b = ci >> 2; kvh = (ci >> 1) & 1; qb = ci & 1; }
    const int rowbase = isctx ? ML + b * CL : b * T;
    const int g = wave >> 1, qs = wave & 1, hh = kvh * 4 + g, c = lane & 15, g4 = lane >> 4, q0 = qb * 128 + qs * 64;
    const float* qg = p->qn_g + l * 64; const float* kg = p->kn_g + l * 64;
    LAS unsigned char* Kl = lds; LAS unsigned char* Vt = lds + 18432;
    bf16x8 qf[4][2];
#pragma unroll
    for (int ti = 0; ti < 4; ++ti) {
        const int pos = q0 + 16 * ti + c; const bf16* src = ZA + (size_t)(rowbase + pos) * NZA + C_AQ + hh * 64 + 8 * g4;
        float a[8], bb[8]; unpack8(*(const u32x4*)src, a); unpack8(*(const u32x4*)(src + 32), bb);
        float ss = 0.f;
#pragma unroll
        for (int j = 0; j < 8; ++j) ss += a[j] * a[j] + bb[j] * bb[j];
        ss = sum_x16_x32(ss);
        const float rs = 1.0f / sqrtf(ss * (1.f / 64.f) + EPS);
#pragma unroll
        for (int j = 0; j < 8; ++j) { a[j] *= rs * qg[8 * g4 + j]; bb[j] *= rs * qg[32 + 8 * g4 + j]; }
        if (!isctx) {
#pragma unroll
            for (int j = 0; j < 8; ++j) { const float cs = rc[pos * 32 + 8 * g4 + j], sn = rsn[pos * 32 + 8 * g4 + j]; const float x1 = a[j], x2 = bb[j]; a[j] = x1 * cs - x2 * sn; bb[j] = x1 * sn + x2 * cs; } }
#pragma unroll
        for (int j = 0; j < 8; ++j) { a[j] *= 0.125f * LOG2E; bb[j] *= 0.125f * LOG2E; }
        qf[ti][0] = as_bf16x8(pack8(a)); qf[ti][1] = as_bf16x8(pack8(bb));
        __builtin_amdgcn_sched_barrier(0);
    }
    f32x4 O[4][4]; float lsum[4];
#pragma unroll
    for (int i = 0; i < 4; ++i) { lsum[i] = 0.f;
#pragma unroll
        for (int j = 0; j < 4; ++j) O[i][j] = (f32x4){0.f, 0.f, 0.f, 0.f}; }
    const int ntile = isctx ? 2 : 5;
    for (int kt = 0; kt < ntile; ++kt) {
        int krow0, kpos0 = 0, mode = 0; bool local = false;
        if (isctx) krow0 = ML + b * CL + 128 * kt;
        else if (kt < 3) { const int kb = qb - 1 + kt; if (kb < 0 || kb > 31) continue; krow0 = b * T + kb * 128; kpos0 = kb * 128; local = true; mode = (kt == 0) ? 1 : ((kt == 2) ? 2 : 0); }
        else krow0 = ML + b * CL + 128 * (kt - 3);
        __syncthreads();
        {
            const int key = tid >> 2, q4 = tid & 3; const bf16* src = ZA + (size_t)(krow0 + key) * NZA + C_AK + kvh * 64 + 8 * q4;
            float a[8], bb[8]; unpack8(*(const u32x4*)src, a); unpack8(*(const u32x4*)(src + 32), bb);
            float ss = 0.f;
#pragma unroll
            for (int j = 0; j < 8; ++j) ss += a[j] * a[j] + bb[j] * bb[j];
            ss = sum_x1_x2(ss);
            const float rs = 1.0f / sqrtf(ss * (1.f / 64.f) + EPS);
#pragma unroll
            for (int j = 0; j < 8; ++j) { a[j] *= rs * kg[8 * q4 + j]; bb[j] *= rs * kg[32 + 8 * q4 + j]; }
            if (local) { const int pos = kpos0 + key;
#pragma unroll
                for (int j = 0; j < 8; ++j) { const float cs = rc[pos * 32 + 8 * q4 + j], sn = rsn[pos * 32 + 8 * q4 + j]; const float x1 = a[j], x2 = bb[j]; a[j] = x1 * cs - x2 * sn; bb[j] = x1 * sn + x2 * cs; } }
            *(LAS u32x4*)(Kl + key * 144 + 16 * q4) = pack8(a); *(LAS u32x4*)(Kl + key * 144 + 64 + 16 * q4) = pack8(bb);
            const bf16* vs = ZA + (size_t)(krow0 + key) * NZA + C_AV + kvh * 64 + 16 * q4;
            const u32x4 v0 = *(const u32x4*)vs, v1 = *(const u32x4*)(vs + 8);
            const unsigned vw[8] = {v0.x, v0.y, v0.z, v0.w, v1.x, v1.y, v1.z, v1.w};
#pragma unroll
            for (int j = 0; j < 8; ++j) { *(LAS unsigned short*)(Vt + (16 * q4 + 2 * j) * 272 + key * 2) = (unsigned short)(vw[j] & 0xffffu); *(LAS unsigned short*)(Vt + (16 * q4 + 2 * j + 1) * 272 + key * 2) = (unsigned short)(vw[j] >> 16); }
        }
        __syncthreads();
#pragma unroll 1
        for (int kk = 0; kk < 4; ++kk) {
            bf16x8 ka[2][2];
#pragma unroll
            for (int hf = 0; hf < 2; ++hf)
#pragma unroll
                for (int ks = 0; ks < 2; ++ks) ka[hf][ks] = *(const LAS bf16x8*)(Kl + (32 * kk + 16 * hf + c) * 144 + ks * 64 + g4 * 16);
            bf16x8 pf[4];
#pragma unroll
            for (int ti = 0; ti < 4; ++ti) {
                f32x4 sa = (f32x4){0.f, 0.f, 0.f, 0.f}, sb = (f32x4){0.f, 0.f, 0.f, 0.f};
                sa = mfma16(ka[0][0], qf[ti][0], sa); sa = mfma16(ka[0][1], qf[ti][1], sa);
                sb = mfma16(ka[1][0], qf[ti][0], sb); sb = mfma16(ka[1][1], qf[ti][1], sb);
                const int ii = qs * 64 + 16 * ti + c; float pa[4], pb[4]; const int mlo = (mode == 1) ? ii : -1000, mhi = (mode == 2) ? ii : 1000;
#pragma unroll
                for (int rr = 0; rr < 4; ++rr) { const int ja = 32 * kk + 4 * g4 + rr, jb = ja + 16;
                    pa[rr] = ex2(sa[rr] - Mb2); pb[rr] = ex2(sb[rr] - Mb2);
                    pa[rr] = (ja >= mlo && ja <= mhi) ? pa[rr] : 0.f; pb[rr] = (jb >= mlo && jb <= mhi) ? pb[rr] : 0.f;
                    lsum[ti] += pa[rr] + pb[rr]; }
                u32x4 w; w.x = pk2(pa[0], pa[1]); w.y = pk2(pa[2], pa[3]); w.z = pk2(pb[0], pb[1]); w.w = pk2(pb[2], pb[3]); pf[ti] = as_bf16x8(w);
            }
#pragma unroll
            for (int dt = 0; dt < 4; ++dt) {
                const u32x2 v0 = *(const LAS u32x2*)(Vt + (16 * dt + c) * 272 + (32 * kk + 4 * g4) * 2), v1 = *(const LAS u32x2*)(Vt + (16 * dt + c) * 272 + (32 * kk + 16 + 4 * g4) * 2);
                u32x4 vv; vv.x = v0.x; vv.y = v0.y; vv.z = v1.x; vv.w = v1.y; const bf16x8 va = as_bf16x8(vv);
#pragma unroll
                for (int ti = 0; ti < 4; ++ti) O[dt][ti] = mfma16(va, pf[ti], O[dt][ti]);
            }
        }
    }
    const float sk = ex2(p->sink[l * 8 + hh] * LOG2E - Mb2);
#pragma unroll
    for (int ti = 0; ti < 4; ++ti) { float lt = sum_x16_x32(lsum[ti]); const float inv = 1.0f / (lt + sk);
        bf16* dst = BR + (size_t)(rowbase + q0 + 16 * ti + c) * 512 + hh * 64 + 4 * g4;
#pragma unroll
        for (int dt = 0; dt < 4; ++dt) { const f32x4 o = O[dt][ti] * inv; u32x2 w; w.x = pk2(o[0], o[1]); w.y = pk2(o[2], o[3]); *(u32x2*)(dst + 16 * dt) = w; } }
    __syncthreads();
}

__device__ __forceinline__ void sgu_item(KPC p, int l, LAS unsigned char* lds, int item, int tid, int lane, int wave) {
    const bf16* ZA = (const bf16*)(p->ws + WS_ZA); bf16* BR = (bf16*)p->out + (size_t)1 * M * 512;
    const int ch = item >> 2, g = item & 3, r0 = ch * 128, c = lane & 15, g4 = lane >> 4;
    LAS unsigned char* vT = lds;
    LAS unsigned char* WL = lds + 34816;
    {
        const int j = tid >> 2, q4 = tid & 3; const bf16* src = ZA + (size_t)(r0 + j) * NZA + C_SV + 32 * q4;
        float s = 0.f, ss = 0.f;
#pragma unroll
        for (int k = 0; k < 4; ++k)
#pragma unroll
            for (int q = 0; q < 4; ++q) { float f[8]; unpack8(*(const u32x4*)(src + 128 * k + 8 * q), f);
#pragma unroll
                for (int e = 0; e < 8; ++e) { const float y = gelu_tanh(f[e]); s += y; ss += y * y; } }
        s = sum_x1_x2(s); ss = sum_x1_x2(ss);
        const float mean = s * (1.f / 512.f), var = fmaxf(ss * (1.f / 512.f) - mean * mean, 0.f), rstd = 1.0f / sqrtf(var + EPS);
#pragma unroll
        for (int q = 0; q < 4; ++q) { float f[8]; unpack8(*(const u32x4*)(src + 128 * g + 8 * q), f);
#pragma unroll
            for (int e = 0; e < 8; e += 2) { const float y0 = (gelu_tanh(f[e]) - mean) * rstd, y1 = (gelu_tanh(f[e + 1]) - mean) * rstd; const unsigned w = pk2(y0, y1);
                *(LAS unsigned short*)(vT + (32 * q4 + 8 * q + e) * 272 + j * 2) = (unsigned short)(w & 0xffffu); *(LAS unsigned short*)(vT + (32 * q4 + 8 * q + e + 1) * 272 + j * 2) = (unsigned short)(w >> 16); } }
        const float* wsrc = p->sgu_w + ((size_t)(l * 4 + g) * 128 + (tid >> 2)) * 128 + 32 * (tid & 3);
#pragma unroll
        for (int q = 0; q < 4; ++q) { const f32x4 a = *(const f32x4*)(wsrc + 8 * q), bq = *(const f32x4*)(wsrc + 8 * q + 4);
            u32x4 w; w.x = pk2(a.x, a.y); w.y = pk2(a.z, a.w); w.z = pk2(bq.x, bq.y); w.w = pk2(bq.z, bq.w);
            *(LAS u32x4*)(WL + (tid >> 2) * 272 + (32 * (tid & 3) + 8 * q) * 2) = w; }
    }
    __syncthreads();
    bf16x8 af[4];
#pragma unroll
    for (int ks = 0; ks < 4; ++ks) af[ks] = *(const LAS bf16x8*)(vT + (16 * wave + c) * 272 + (32 * ks + 8 * g4) * 2);
#pragma unroll 2
    for (int ti = 0; ti < 8; ++ti) {
        f32x4 acc = (f32x4){0.f, 0.f, 0.f, 0.f};
#pragma unroll
        for (int ks = 0; ks < 4; ++ks) acc = mfma16(af[ks], *(const LAS bf16x8*)(WL + (16 * ti + c) * 272 + (32 * ks + 8 * g4) * 2), acc);
        const int i = 16 * ti + c; const float bias = p->sgu_b[(l * 4 + g) * 128 + i];
        const int col = 128 * g + 16 * wave + 4 * g4;
        const u32x2 uw = *(const u32x2*)(ZA + (size_t)(r0 + i) * NZA + C_SU + col);
        const float o0 = gelu_tanh(bflo(uw.x)) * (acc[0] + bias), o1 = gelu_tanh(bfhi(uw.x)) * (acc[1] + bias), o2 = gelu_tanh(bflo(uw.y)) * (acc[2] + bias), o3 = gelu_tanh(bfhi(uw.y)) * (acc[3] + bias);
        u32x2 w; w.x = pk2(o0, o1); w.y = pk2(o2, o3); *(u32x2*)(BR + (size_t)(r0 + i) * 512 + col) = w;
    }
    __syncthreads();
}

__device__ __forceinline__ void ret_load_k(KPC p, const bf16* ZA, int r0, int h, bool latent, int pos0, int tid, float (&a)[8], float (&bb)[8]) {
    const int j = tid >> 2, q4 = tid & 3; const bf16* src = ZA + (size_t)(r0 + j) * NZA + C_RK + 64 * h + 8 * q4;
    unpack8(*(const u32x4*)src, a); unpack8(*(const u32x4*)(src + 32), bb);
    if (latent) { const float* rc = (const float*)(p->ws + WS_ROPEC); const float* rsn = (const float*)(p->ws + WS_ROPES); const int pos = pos0 + j;
#pragma unroll
        for (int e = 0; e < 8; ++e) { const float cs = rc[pos * 32 + 8 * q4 + e], sn = rsn[pos * 32 + 8 * q4 + e]; const float x1 = a[e], x2 = bb[e]; a[e] = x1 * cs - x2 * sn; bb[e] = x1 * sn + x2 * cs; } }
#pragma unroll
    for (int e = 0; e < 8; ++e) { a[e] *= 0.125f; bb[e] *= 0.125f; }
}
__device__ __forceinline__ void ret_stage_vT(const bf16* ZA, int r0, int h, LAS unsigned char* vT, int tid) {
    const int j = tid >> 2, q4 = tid & 3; const bf16* src = ZA + (size_t)(r0 + j) * NZA + C_RV + 128 * h + 32 * q4;
#pragma unroll
    for (int q = 0; q < 4; ++q) { const u32x4 v = *(const u32x4*)(src + 8 * q); const unsigned vw[4] = {v.x, v.y, v.z, v.w};
#pragma unroll
        for (int e = 0; e < 4; ++e) { *(LAS unsigned short*)(vT + (32 * q4 + 8 * q + 2 * e) * 272 + j * 2) = (unsigned short)(vw[e] & 0xffffu); *(LAS unsigned short*)(vT + (32 * q4 + 8 * q + 2 * e + 1) * 272 + j * 2) = (unsigned short)(vw[e] >> 16); } }
}
__device__ __forceinline__ void ret_upd_item(KPC p, int l, LAS unsigned char* lds, int item, int tid, int lane, int wave) {
    const bf16* ZA = (const bf16*)(p->ws + WS_ZA); float* RS = (float*)(p->ws + WS_RS);
    const int b = item / (NCH * 4), rem = item % (NCH * 4), n = rem >> 2, h = rem & 3, c = lane & 15, g4 = lane >> 4;
    const bool latent = n < 32; const int r0 = latent ? b * T + 128 * n : ML + b * CL + 128 * (n - 32);
    const float lgf = log2_sigmoid(p->dec_f[l * 4 + h]), lgb = log2_sigmoid(p->dec_b[l * 4 + h]);
    LAS unsigned char* vT = lds; LAS unsigned char* kTf = lds + 34816; LAS unsigned char* kTb = lds + 34816 + 17408;
    {   float a[8], bb[8]; ret_load_k(p, ZA, r0, h, latent, 128 * n, tid, a, bb);
        const int j = tid >> 2, q4 = tid & 3; const float wf = ex2((float)(127 - j) * lgf), wb = ex2((float)j * lgb);
#pragma unroll
        for (int e = 0; e < 8; e += 2) {
            unsigned w = pk2(a[e] * wf, a[e + 1] * wf); *(LAS unsigned short*)(kTf + (8 * q4 + e) * 272 + j * 2) = (unsigned short)(w & 0xffffu); *(LAS unsigned short*)(kTf + (8 * q4 + e + 1) * 272 + j * 2) = (unsigned short)(w >> 16);
            w = pk2(bb[e] * wf, bb[e + 1] * wf); *(LAS unsigned short*)(kTf + (32 + 8 * q4 + e) * 272 + j * 2) = (unsigned short)(w & 0xffffu); *(LAS unsigned short*)(kTf + (32 + 8 * q4 + e + 1) * 272 + j * 2) = (unsigned short)(w >> 16);
            w = pk2(a[e] * wb, a[e + 1] * wb); *(LAS unsigned short*)(kTb + (8 * q4 + e) * 272 + j * 2) = (unsigned short)(w & 0xffffu); *(LAS unsigned short*)(kTb + (8 * q4 + e + 1) * 272 + j * 2) = (unsigned short)(w >> 16);
            w = pk2(bb[e] * wb, bb[e + 1] * wb); *(LAS unsigned short*)(kTb + (32 + 8 * q4 + e) * 272 + j * 2) = (unsigned short)(w & 0xffffu); *(LAS unsigned short*)(kTb + (32 + 8 * q4 + e + 1) * 272 + j * 2) = (unsigned short)(w >> 16);
        }
        ret_stage_vT(ZA, r0, h, vT, tid);
    }
    __syncthreads();
    bf16x8 af[4];
#pragma unroll
    for (int ks = 0; ks < 4; ++ks) af[ks] = *(const LAS bf16x8*)(vT + (16 * wave + c) * 272 + (32 * ks + 8 * g4) * 2);
#pragma unroll
    for (int dir = 0; dir < 2; ++dir) { const LAS unsigned char* kT = dir ? kTb : kTf;
        float* dst = RS + ((size_t)(((b * 4 + h) * 2 + dir) * NCH + n) * 128 + 16 * wave + 4 * g4) * 64;
#pragma unroll
        for (int dt = 0; dt < 4; ++dt) { f32x4 acc = (f32x4){0.f, 0.f, 0.f, 0.f};
#pragma unroll
            for (int ks = 0; ks < 4; ++ks) acc = mfma16(af[ks], *(const LAS bf16x8*)(kT + (16 * dt + c) * 272 + (32 * ks + 8 * g4) * 2), acc);
#pragma unroll
            for (int rr = 0; rr < 4; ++rr) dst[rr * 64 + 16 * dt + c] = acc[rr]; } }
    __syncthreads();
}
__device__ __forceinline__ void phase_scan(KPC p, int l, int tid, int bid, int G) {
    const float* RS = (const float*)(p->ws + WS_RS); bf16* ST = (bf16*)(p->ws + WS_ST);
    for (int idx = bid * 512 + tid; idx < NB * 4 * 2 * 8192; idx += G * 512) {
        const int ed = idx & 8191, dir = (idx >> 13) & 1, bh = idx >> 14, e = ed >> 6, d = ed & 63, h = bh & 3;
        const float* P = RS + (size_t)((bh * 2 + dir) * NCH) * 8192 + ed;
        bf16* S = ST + ((size_t)bh * NCH * 128 + e) * 128 + dir * 64 + d;
        const float lg = log2_sigmoid(dir ? p->dec_b[l * 4 + h] : p->dec_f[l * 4 + h]); const float dec = ex2(128.f * lg);
        const float u32 = P[32 * 8192], u33 = P[33 * 8192];
        if (dir == 0) {
            S[32 * 16384] = 0; S[33 * 16384] = (bf16)(pk2(u32, 0.f) & 0xffffu);
            float s = dec * u32 + u33;
            for (int n = 0; n < 32; ++n) { const float u = P[(size_t)n * 8192]; S[(size_t)n * 16384] = (bf16)(pk2(s, 0.f) & 0xffffu); s = dec * s + u; }
        } else {
            S[33 * 16384] = 0; S[32 * 16384] = (bf16)(pk2(u33, 0.f) & 0xffffu);
            float s = dec * u33 + u32;
            for (int n = 31; n >= 0; --n) { const float u = P[(size_t)n * 8192]; S[(size_t)n * 16384] = (bf16)(pk2(s, 0.f) & 0xffffu); s = dec * s + u; }
        }
    }
}
__device__ __forceinline__ void ret_out_item(KPC p, int l, LAS unsigned char* lds, int item, int tid, int lane, int wave) {
    const bf16* ZA = (const bf16*)(p->ws + WS_ZA); bf16* BR = (bf16*)p->out; const bf16* ST = (const bf16*)(p->ws + WS_ST);
    const int b = item / (NCH * 4), rem = item % (NCH * 4), n = rem >> 2, h = rem & 3, c = lane & 15, g4 = lane >> 4;
    const bool latent = n < 32; const int r0 = latent ? b * T + 128 * n : ML + b * CL + 128 * (n - 32);
    const float lgf = log2_sigmoid(p->dec_f[l * 4 + h]), lgb = log2_sigmoid(p->dec_b[l * 4 + h]);
    LAS unsigned char* vT = lds; LAS unsigned char* Kl = lds + 34816; LAS unsigned char* Sl = lds + 34816 + 18432;
    {   float a[8], bb[8]; ret_load_k(p, ZA, r0, h, latent, 128 * n, tid, a, bb);
        const int j = tid >> 2, q4 = tid & 3;
        *(LAS u32x4*)(Kl + j * 144 + 16 * q4) = pack8(a); *(LAS u32x4*)(Kl + j * 144 + 64 + 16 * q4) = pack8(bb);
        ret_stage_vT(ZA, r0, h, vT, tid);
        const u32x4* ssrc = (const u32x4*)(ST + (size_t)((b * 4 + h) * NCH + n) * 16384);
#pragma unroll
        for (int k = 0; k < 4; ++k) { const int q = tid + 512 * k; *(LAS u32x4*)(Sl + (q >> 4) * 272 + (q & 15) * 16) = ssrc[q]; }
    }
    __syncthreads();
    const int ii = 16 * wave + c;
    bf16x8 qf[2];
    {   const bf16* src = ZA + (size_t)(r0 + ii) * NZA + C_RQ + 64 * h + 8 * g4; float a[8], bb[8]; unpack8(*(const u32x4*)src, a); unpack8(*(const u32x4*)(src + 32), bb);
        if (latent) { const float* rc = (const float*)(p->ws + WS_ROPEC); const float* rsn = (const float*)(p->ws + WS_ROPES); const int pos = 128 * n + ii;
#pragma unroll
            for (int e = 0; e < 8; ++e) { const float cs = rc[pos * 32 + 8 * g4 + e], sn = rsn[pos * 32 + 8 * g4 + e]; const float x1 = a[e], x2 = bb[e]; a[e] = x1 * cs - x2 * sn; bb[e] = x1 * sn + x2 * cs; } }
        qf[0] = as_bf16x8(pack8(a)); qf[1] = as_bf16x8(pack8(bb)); }
    bf16x8 pf[4];
#pragma unroll
    for (int kk = 0; kk < 4; ++kk) {
        f32x4 sa = (f32x4){0.f, 0.f, 0.f, 0.f}, sb = (f32x4){0.f, 0.f, 0.f, 0.f};
        sa = mfma16(*(const LAS bf16x8*)(Kl + (32 * kk + c) * 144 + g4 * 16), qf[0], sa); sa = mfma16(*(const LAS bf16x8*)(Kl + (32 * kk + c) * 144 + 64 + g4 * 16), qf[1], sa);
        sb = mfma16(*(const LAS bf16x8*)(Kl + (32 * kk + 16 + c) * 144 + g4 * 16), qf[0], sb); sb = mfma16(*(const LAS bf16x8*)(Kl + (32 * kk + 16 + c) * 144 + 64 + g4 * 16), qf[1], sb);
        float pa[4], pb[4];
#pragma unroll
        for (int rr = 0; rr < 4; ++rr) { const int ja = 32 * kk + 4 * g4 + rr, jb = ja + 16; const int da = ii - ja, db = ii - jb;
            pa[rr] = sa[rr] * ((da >= 0) ? ex2((float)da * lgf) : ex2((float)(-da) * lgb)); pb[rr] = sb[rr] * ((db >= 0) ? ex2((float)db * lgf) : ex2((float)(-db) * lgb)); }
        u32x4 w; w.x = pk2(pa[0], pa[1]); w.y = pk2(pa[2], pa[3]); w.z = pk2(pb[0], pb[1]); w.w = pk2(pb[2], pb[3]); pf[kk] = as_bf16x8(w);
    }
    const float cf = ex2((float)(ii + 1) * lgf), cb = ex2((float)(128 - ii) * lgb);
    f32x4 O[8]; float s = 0.f, ss = 0.f;
#pragma unroll
    for (int et = 0; et < 8; ++et) {
        f32x4 acc = (f32x4){0.f, 0.f, 0.f, 0.f}, xf = (f32x4){0.f, 0.f, 0.f, 0.f}, xb = (f32x4){0.f, 0.f, 0.f, 0.f};
#pragma unroll
        for (int kk = 0; kk < 4; ++kk) { const u32x2 v0 = *(const LAS u32x2*)(vT + (16 * et + c) * 272 + (32 * kk + 4 * g4) * 2), v1 = *(const LAS u32x2*)(vT + (16 * et + c) * 272 + (32 * kk + 16 + 4 * g4) * 2);
            u32x4 vv; vv.x = v0.x; vv.y = v0.y; vv.z = v1.x; vv.w = v1.y; acc = mfma16(as_bf16x8(vv), pf[kk], acc); }
#pragma unroll
        for (int ks = 0; ks < 2; ++ks) { xf = mfma16(*(const LAS bf16x8*)(Sl + (16 * et + c) * 272 + (32 * ks + 8 * g4) * 2), qf[ks], xf);
            xb = mfma16(*(const LAS bf16x8*)(Sl + (16 * et + c) * 272 + (64 + 32 * ks + 8 * g4) * 2), qf[ks], xb); }
        acc = acc + xf * cf + xb * cb; O[et] = acc;
        s += (acc[0] + acc[1]) + (acc[2] + acc[3]); ss += (acc[0] * acc[0] + acc[1] * acc[1]) + (acc[2] * acc[2] + acc[3] * acc[3]);
    }
    s = sum_x16_x32(s); ss = sum_x16_x32(ss);
    const float mean = s * (1.f / 128.f), var = fmaxf(ss * (1.f / 128.f) - mean * mean, 0.f), rstd = 1.0f / sqrtf(var + EPS);
    const bf16* gsrc = ZA + (size_t)(r0 + ii) * NZA + C_RG + 128 * h + 4 * g4; bf16* dst = BR + (size_t)(r0 + ii) * 512 + 128 * h + 4 * g4;
#pragma unroll
    for (int et = 0; et < 8; ++et) { const u32x2 gw = *(const u32x2*)(gsrc + 16 * et); const float g0 = bflo(gw.x), g1 = bfhi(gw.x), g2 = bflo(gw.y), g3 = bfhi(gw.y);
        const float o0 = (O[et][0] - mean) * rstd * g0 * sigmoidf_(g0), o1 = (O[et][1] - mean) * rstd * g1 * sigmoidf_(g1), o2 = (O[et][2] - mean) * rstd * g2 * sigmoidf_(g2), o3 = (O[et][3] - mean) * rstd * g3 * sigmoidf_(g3);
        u32x2 w; w.x = pk2(o0, o1); w.y = pk2(o2, o3); *(u32x2*)(dst + 16 * et) = w; }
    __syncthreads();
}

__device__ __forceinline__ int wr_off(int k) { return k * 64 + (k >> 2) * 16; }
__device__ __forceinline__ void phase_norm2(KPC p, int l, LAS unsigned char* lds, int tid, int lane, int wave, int bid, int G) {
    convert_experts(p, l, lds, lane, wave, bid, G);
    LAS unsigned char* wrl = lds + 69632;
    for (int i = tid; i < 1024 * 4; i += 512) { const int k = i >> 2, q = i & 3; *(LAS f32x4*)(wrl + wr_off(k) + 16 * q) = *(const f32x4*)(p->w_router + (size_t)l * 16384 + k * 16 + 4 * q); }
    __syncthreads();
    const float* modv = (const float*)(p->ws + WS_MODV) + l * 9 * 6144; const float* X = (const float*)(p->ws + WS_X); bf16* H = (bf16*)(p->ws + WS_H);
    float* AFF = (float*)(p->ws + WS_AFF); float* AFFC = (float*)(p->ws + WS_AFFC); int* INV = (int*)(p->ws + WS_INV);
    const int rows = (l == 0) ? M : ML;
    for (int r = bid * 8 + wave; r < rows; r += G * 8) {
        const int bi = (r < ML) ? (r >> 12) : 8;
        f32x4 v[4], h[4];
#pragma unroll
        for (int j = 0; j < 4; ++j) v[j] = *(const f32x4*)(X + (size_t)r * 1024 + 4 * lane + 256 * j);
        const float rs = row_rs(v);
        norm_mod(v, rs, p->norm2_g + l * 1024, modv + bi * 6144 + 3 * 1024, modv + bi * 6144 + 4 * 1024, h, lane);
        store_h(h, H + (size_t)r * 1024, lane);
        float lg[16];
#pragma unroll
        for (int e = 0; e < 16; ++e) lg[e] = 0.f;
#pragma unroll
        for (int j = 0; j < 4; ++j)
#pragma unroll
            for (int i = 0; i < 4; ++i) { const int k = 4 * lane + 256 * j + i; const float hv = h[j][i]; const LAS f32x4* wp = (const LAS f32x4*)(wrl + wr_off(k));
#pragma unroll
                for (int q = 0; q < 4; ++q) { const f32x4 w = wp[q]; lg[4 * q] += hv * w.x; lg[4 * q + 1] += hv * w.y; lg[4 * q + 2] += hv * w.z; lg[4 * q + 3] += hv * w.w; } }
        float mx = -1e30f;
#pragma unroll
        for (int e = 0; e < 16; ++e) { lg[e] = wave_sum(lg[e]); mx = fmaxf(mx, lg[e]); }
        float sum = 0.f;
#pragma unroll
        for (int e = 0; e < 16; ++e) { lg[e] = ex2((lg[e] - mx) * LOG2E); sum += lg[e]; }
        const float isum = 1.0f / sum; float mine = 0.f;
#pragma unroll
        for (int e = 0; e < 16; ++e) mine = (lane == e) ? lg[e] * isum : mine;
        if (lane < 16) { if (r < ML) AFF[((size_t)(bi * 16 + lane) << 12) + (r & 4095)] = mine; else AFFC[((r - ML) >> 8) * 4096 + lane * 256 + ((r - ML) & 255)] = mine;
            INV[(size_t)r * 16 + lane] = -1; }
    }
}

__device__ __forceinline__ int block_sum_i(int v, LAS int* red, int lane, int wave) {
    v = wave_sum_i(v);
    __syncthreads();
    if (lane == 0) red[wave] = v;
    __syncthreads();
    int s = 0;
#pragma unroll
    for (int w = 0; w < 8; ++w) s += red[w];
    return s;
}
__device__ __forceinline__ int block_excl_scan(int v, LAS int* red, int lane, int wave) {
    int inc = v;
#pragma unroll
    for (int o = 1; o < 64; o <<= 1) { const int t = __builtin_amdgcn_ds_bpermute((lane - o) << 2, inc); if (lane >= o) inc += t; }
    __syncthreads();
    if (lane == 63) red[wave] = inc;
    __syncthreads();
    int base = 0;
#pragma unroll
    for (int w = 0; w < 8; ++w) { const int x = red[w]; if (w < wave) base += x; }
    return base + inc - v;
}
template <int KPT>
__device__ __forceinline__ void topk_item(KPC p, const float* aff, int n, int cap, int rowbase, int e, int slotbase, LAS unsigned char* lds, int tid, int lane, int wave) {
    const bf16* H = (const bf16*)(p->ws + WS_H); bf16* XS = (bf16*)(p->ws + WS_XS); float* topw = (float*)(p->ws + WS_TOPW); int* INV = (int*)(p->ws + WS_INV);
    LAS int* red = (LAS int*)lds; LAS int* rl = (LAS int*)(lds + 64);
    unsigned key[KPT]; const bool valid = tid * KPT < n;
#pragma unroll
    for (int j = 0; j < KPT; ++j) key[j] = valid ? __float_as_uint(aff[tid * KPT + j]) : 0u;
    unsigned Tsel = 0u;
    for (int bit = 30; bit >= 0; --bit) { const unsigned cand = Tsel | (1u << bit); int cnt = 0;
#pragma unroll
        for (int j = 0; j < KPT; ++j) cnt += (valid && key[j] >= cand) ? 1 : 0;
        if (block_sum_i(cnt, red, lane, wave) >= cap) Tsel = cand; }
    int cgt = 0, ceq = 0;
#pragma unroll
    for (int j = 0; j < KPT; ++j) { cgt += (valid && key[j] > Tsel) ? 1 : 0; ceq += (valid && key[j] == Tsel) ? 1 : 0; }
    const int need = cap - block_sum_i(cgt, red, lane, wave);
    int er = block_excl_scan(ceq, red, lane, wave);
    bool sel[KPT]; int nsel = 0;
#pragma unroll
    for (int j = 0; j < KPT; ++j) { const bool iseq = valid && key[j] == Tsel; sel[j] = valid && (key[j] > Tsel || (iseq && er < need)); er += iseq ? 1 : 0; nsel += sel[j] ? 1 : 0; }
    int slot = block_excl_scan(nsel, red, lane, wave);
#pragma unroll
    for (int j = 0; j < KPT; ++j) if (sel[j]) { const int t = tid * KPT + j; if (slot < cap) { rl[slot] = t; topw[e * ME + slotbase + slot] = __uint_as_float(key[j]); INV[(size_t)(rowbase + t) * 16 + e] = slotbase + slot; } ++slot; }
    __syncthreads();
    for (int s = wave; s < cap; s += 8) { const int t = rl[s]; const u32x4* src = (const u32x4*)(H + (size_t)(rowbase + t) * 1024); u32x4* dst = (u32x4*)(XS + ((size_t)e * ME + slotbase + s) * 1024);
        dst[lane] = src[lane]; dst[lane + 64] = src[lane + 64]; }
    __syncthreads();
}
__device__ __forceinline__ void phase_topk(KPC p, int l, LAS unsigned char* lds, int tid, int lane, int wave, int bid, int G) {
    const float* AFF = (const float*)(p->ws + WS_AFF); const float* AFFC = (const float*)(p->ws + WS_AFFC);
    const int nitem = (l == 0) ? 256 : 128;
    for (int it = bid; it < nitem; it += G) {
        if (it < 128) { const int b = it >> 4, e = it & 15; topk_item<8>(p, AFF + ((size_t)(b * 16 + e) << 12), 4096, CAPL, b * T, e, b * CAPL, lds, tid, lane, wave); }
        else { const int q = it - 128, b = q >> 4, e = q & 15; topk_item<1>(p, AFFC + (b * 16 + e) * 256, 256, CAPC, ML + b * CL, e, NB * CAPL + b * CAPC, lds, tid, lane, wave); }
    }
}

__device__ __forceinline__ void phase_combine(KPC p, int l, LAS unsigned char* lds, int tid, int lane, int wave, int bid, int G) {
    const float* modv = (const float*)(p->ws + WS_MODV); float* X = (float*)(p->ws + WS_X); bf16* H = (bf16*)(p->ws + WS_H);
    const bf16* Y = (const bf16*)(p->ws + WS_XS); const int* INV = (const int*)(p->ws + WS_INV);
    const int rows = (l == 0) ? M : ML;
    for (int r = bid * 8 + wave; r < rows; r += G * 8) {
        const int bi = (r < ML) ? (r >> 12) : 8;
        f32x4 v[4], acc[4];
#pragma unroll
        for (int j = 0; j < 4; ++j) { v[j] = *(const f32x4*)(X + (size_t)r * 1024 + 4 * lane + 256 * j); acc[j] = (f32x4){0.f, 0.f, 0.f, 0.f}; }
        const int myslot = (lane < 16) ? INV[(size_t)r * 16 + lane] : -1;
#pragma unroll 1
        for (int e = 0; e < 16; ++e) { const int s = __builtin_amdgcn_readlane(myslot, e);
            if (s >= 0) { const bf16* y = Y + ((size_t)e * ME + s) * 1024;
#pragma unroll
                for (int j = 0; j < 4; ++j) { const u32x2 w = *(const u32x2*)(y + 4 * lane + 256 * j); acc[j] += (f32x4){bflo(w.x), bfhi(w.x), bflo(w.y), bfhi(w.y)}; } } }
        const float* g2 = modv + (l * 9 + bi) * 6144 + 5 * 1024;
#pragma unroll
        for (int j = 0; j < 4; ++j) v[j] = v[j] + *(const f32x4*)(g2 + 4 * lane + 256 * j) * acc[j];
        if (l == 0) {
#pragma unroll
            for (int j = 0; j < 4; ++j) *(f32x4*)(X + (size_t)r * 1024 + 4 * lane + 256 * j) = v[j];
            const float rs = row_rs(v); f32x4 h[4];
            norm_mod(v, rs, p->norm1_g + 1024, modv + (9 + bi) * 6144, modv + (9 + bi) * 6144 + 1024, h, lane);
            store_h(h, H + (size_t)r * 1024, lane);
        } else {
#pragma unroll
            for (int j = 0; j < 4; ++j) *(f32x4*)(p->out + (size_t)r * 1024 + 4 * lane + 256 * j) = v[j];
        }
    }
    if (l == 0) convert_small(p, 1, lds, lane, wave, bid, G);
}

#ifndef EN_GEMM
#define EN_GEMM 0x3f
#endif
#ifndef EN_ATT
#define EN_ATT 1
#endif
#ifndef EN_UPD
#define EN_UPD 1
#endif
#ifndef EN_SGU
#define EN_SGU 1
#endif
#ifndef EN_RO
#define EN_RO 1
#endif
#ifndef EN_MISC
#define EN_MISC 1
#endif
#define KPP() ({ KPC q_ = kp_; asm volatile("" : "+s"(q_)); q_; })
__global__ void __launch_bounds__(512, 2) mk_fwd(KP p_unused) {
    extern __shared__ __attribute__((aligned(16))) unsigned char lds_raw[];
    LAS unsigned char* lds = (LAS unsigned char*)lds_raw;
    cg::grid_group grid = cg::this_grid();
    const int bid = blockIdx.x, G = gridDim.x;
#define IDS() int tid = threadIdx.x; asm volatile("" : "+v"(tid)); const int lane = tid & 63, wave = __builtin_amdgcn_readfirstlane(tid >> 6); (void)lane; (void)wave
    const KPC kp_ = (KPC)__builtin_amdgcn_kernarg_segment_ptr();

    { IDS(); if (EN_MISC) phase_prep(KPP(), lds, tid, lane, wave, bid, G); }
    grid.sync();
    { IDS(); if (EN_MISC) phase_norm_in(KPP(), lane, wave, bid, G); }
    grid.sync();
#pragma unroll 1
    for (int l = 0; l < 2; ++l) {
        {
            unsigned char* ws = KPP()->ws;
            pg8::Gemm g{(const pg8::bf16_t*)(ws + WS_H), (const pg8::bf16_t*)(ws + WS_WTIN), M, NZA, 1024}; GroupOrder S{1, M / 256, NZA / 256, 0, 0, G, bid};
            pg8::EpiBf16<0> E{(pg8::bf16_t*)(ws + WS_ZA), NZA, nullptr, 0, 0, 1.f};
            if (EN_GEMM & 1) pg8::gemm_phase<pg8::EpiBf16<0>, GroupOrder, true, false>(lds, g, S, E);
        }
        grid.sync();
        {
            KPC p = KPP(); IDS();
            float mq = fabsf(p->qn_g[l * 64 + lane]), mk = fabsf(p->kn_g[l * 64 + lane]);
            mq = wave_max(mq); mk = wave_max(mk);
            const float Mb2 = 8.0f * mq * mk * LOG2E;
            const int natt = (l == 0) ? 544 : 512, nupd = NB * NCH * 4, nsgu = ((l == 0) ? (M / 128) : (ML / 128)) * 4;
            for (int it = bid; it < natt + nupd + nsgu; it += G) {
                if (it < natt) { if (EN_ATT) att_item(p, l, lds, it, Mb2, tid, lane, wave); }
                else if (it < natt + nupd) { if (EN_UPD) ret_upd_item(p, l, lds, it - natt, tid, lane, wave); }
                else { if (EN_SGU) sgu_item(p, l, lds, it - natt - nupd, tid, lane, wave); }
            }
        }
        grid.sync();
        { IDS(); if (EN_MISC) phase_scan(KPP(), l, tid, bid, G); }
        grid.sync();
        {   KPC p = KPP(); IDS(); const int nch = (l == 0) ? NCH : 32;
            for (int it = bid; it < NB * nch * 4; it += G) { const int b = it / (nch * 4), rem = it % (nch * 4); if (EN_RO) ret_out_item(p, l, lds, b * (NCH * 4) + rem, tid, lane, wave); }
        }
        grid.sync();
        const int Mrows = (l == 0) ? M : ML;
        {
            unsigned char* ws = KPP()->ws;
            pg8::Gemm g{(const pg8::bf16_t*)(ws + WS_H), (const pg8::bf16_t*)(ws + WS_WTIN) + (size_t)NZA * 1024, Mrows, NZG, 1024}; GroupOrder S{1, Mrows / 256, NZG / 256, 0, 0, G, bid};
            pg8::EpiBf16<0> E{(pg8::bf16_t*)(ws + WS_G), NZG, nullptr, 0, 0, 1.f};
            if (EN_GEMM & 2) pg8::gemm_phase<pg8::EpiBf16<0>, GroupOrder, true, false>(lds, g, S, E);
        }
        grid.sync();
        {
            KPC p = KPP(); unsigned char* ws = p->ws;
            pg8::Gemm g{(const pg8::bf16_t*)p->out, (const pg8::bf16_t*)(ws + WS_WTBR), 3 * M, 3072, 512}; MergeOrder S{Mrows / 256, G, bid};
            EpiMerge E{(const bf16*)(ws + WS_G), (bf16*)(ws + WS_H)};
            if (EN_GEMM & 4) pg8::gemm_phase<EpiMerge, MergeOrder, true, true>(lds, g, S, E);
        }
        grid.sync();
        {
            KPC p = KPP(); unsigned char* ws = p->ws;
            pg8::Gemm g{(const pg8::bf16_t*)(ws + WS_H), (const pg8::bf16_t*)(ws + WS_WTOUT), Mrows, 1024, 1024}; GroupOrder S{1, Mrows / 256, 4, 0, 0, G, bid};
            EpiOut E{(l == 0) ? p->x : (const float*)(ws + WS_X), (l == 0) ? p->ctx : (const float*)(ws + WS_X) + (size_t)ML * 1024, (float*)(ws + WS_X), (const float*)(ws + WS_MODV) + l * 9 * 6144};
            if (EN_GEMM & 8) pg8::gemm_phase<EpiOut, GroupOrder, true, true>(lds, g, S, E);
        }
        grid.sync();
        { IDS(); if (EN_MISC) phase_norm2(KPP(), l, lds, tid, lane, wave, bid, G); }
        grid.sync();
        { IDS(); if (EN_MISC) phase_topk(KPP(), l, lds, tid, lane, wave, bid, G); }
        grid.sync();
        {
            unsigned char* ws = KPP()->ws;
            pg8::Gemm g{(const pg8::bf16_t*)(ws + WS_XS), (const pg8::bf16_t*)(ws + WS_WT1), NE * ME, NE * 2048, 1024}; GroupOrder S{NE, (l == 0) ? 17 : 16, 8, 17, 8, G, bid};
            EpiMoe1 E{(bf16*)(ws + WS_ACT)};
            if (EN_GEMM & 16) pg8::gemm_phase<EpiMoe1, GroupOrder, true, true>(lds, g, S, E);
        }
        grid.sync();
        {
            unsigned char* ws = KPP()->ws;
            pg8::Gemm g{(const pg8::bf16_t*)(ws + WS_ACT), (const pg8::bf16_t*)(ws + WS_WT2), NE * ME, NE * 1024, 1024}; GroupOrder S{NE, (l == 0) ? 17 : 16, 4, 17, 4, G, bid};
            EpiMoe2 E{(bf16*)(ws + WS_XS), (const float*)(ws + WS_TOPW)};
            if (EN_GEMM & 32) pg8::gemm_phase<EpiMoe2, GroupOrder, true, true>(lds, g, S, E);
        }
        grid.sync();
        { IDS(); if (EN_MISC) phase_combine(KPP(), l, lds, tid, lane, wave, bid, G); }
        if (l == 0) grid.sync();
    }
}

extern "C" void kernel_launch(void* const* d_in, const int* in_sizes, int n_in, void* d_out, int out_size, void* d_ws, size_t ws_size, hipStream_t stream) {
    static int grid = 0;
    if (grid == 0) {
        if (n_in != 22 || out_size != ML * D || ws_size < WS_END) { fprintf(stderr, "kernel_launch: unexpected shapes (n_in %d out %d ws %zu, need %zu)\n", n_in, out_size, ws_size, (size_t)WS_END); grid = -1; return; }
        int dev = 0, cus = 0, per_cu = 0;
        if (hipGetDevice(&dev) != hipSuccess || hipDeviceGetAttribute(&cus, hipDeviceAttributeMultiprocessorCount, dev) != hipSuccess) { grid = -1; return; }
        if (hipFuncSetAttribute((const void*)mk_fwd, hipFuncAttributeMaxDynamicSharedMemorySize, LDS_BYTES) != hipSuccess) { fprintf(stderr, "kernel_launch: hipFuncSetAttribute failed\n"); grid = -1; return; }
        if (hipOccupancyMaxActiveBlocksPerMultiprocessor(&per_cu, (const void*)mk_fwd, 512, LDS_BYTES) != hipSuccess || per_cu < 1) { fprintf(stderr, "kernel_launch: occupancy query says %d\n", per_cu); (void)hipGetLastError(); }
        grid = cus;
        fprintf(stderr, "kernel_launch: grid %d, occupancy %d/CU, ws %zu\n", grid, per_cu, ws_size);
    }
    if (grid < 0) return;
    KP hp{};
    const float** f = (const float**)&hp;
    for (int i = 0; i < 22; ++i) f[i] = (const float*)d_in[i];
    hp.out = (float*)d_out; hp.ws = (unsigned char*)d_ws;
    void* args[] = {&hp};
    hipError_t e = hipLaunchCooperativeKernel((const void*)mk_fwd, dim3(grid), dim3(512), args, LDS_BYTES, stream);
    if (e != hipSuccess) fprintf(stderr, "kernel_launch: cooperative launch failed: %s\n", hipGetErrorString(e));
}
```

```cpp
#include <hip/hip_runtime.h>
#include <hip/hip_cooperative_groups.h>
#include <cstdio>
#include <cstdint>
namespace cg = cooperative_groups;

namespace pg8 {
#define PG8_LAS __attribute__((address_space(3)))
typedef unsigned short bf16_t;
typedef short bf16x8 __attribute__((ext_vector_type(8)));
typedef float f32x4 __attribute__((ext_vector_type(4)));
typedef unsigned u32x4 __attribute__((ext_vector_type(4)));
constexpr int BM = 256, BK = 64, HALF = 128, HTB = HALF * BK * 2  , STAGE_BYTES = 8 * HTB, NXCD = 8, WGM = 8;

__host__ __device__ __forceinline__ int lds_byte(int r, int c) { const int st = (r >> 4) * 2 + (c >> 5), rr = r & 15, cc = c & 31, ob = rr * 64 + cc * 2; return st * 1024 + (ob ^ (((ob >> 9) & 1) << 5)); }
__host__ __device__ __forceinline__ void stage_rc(int b, int& R, int& C) { const int st = b / 1024, sb = b % 1024, swz = sb ^ (((sb >> 9) & 1) << 5); R = (st >> 1) * 16 + swz / 64; C = (st & 1) * 32 + (swz % 64) / 2; }
__host__ __device__ __forceinline__ int perm32(int rho) { const int n = rho >> 4, i = rho & 15; return 8 * (i >> 2) + 4 * n + (i & 3); }

struct Unit { int pm, pn; };
struct Gemm { const bf16_t* A; const bf16_t* Bt; int M, N, K; };

struct StaticOrder {
    int nM, nN, nwg, G, c;
    __host__ __device__ void init(int M, int N, int G_, int c_) { nM = M / BM; nN = N / BM; nwg = nM * nN; G = G_; c = c_; }
    __host__ __device__ bool next(int i, Unit& u) const {
        const long L = (long)i * G + c; if (L >= nwg) return false;
        int wgid = (int)L; { const int q = nwg / NXCD, r = nwg % NXCD, xcd = wgid % NXCD, off = wgid / NXCD; wgid = (xcd < r ? xcd * (q + 1) : r * (q + 1) + (xcd - r) * q) + off; }
        const int nig = WGM * nN, gid = wgid / nig, fm = gid * WGM, gsz = (nM - fm) < WGM ? (nM - fm) : WGM;
        u.pm = fm + ((wgid % nig) % gsz); u.pn = (wgid % nig) / gsz; return true;
    }
    __device__ __forceinline__ void a_ready(const Unit&) const {}
    __device__ __forceinline__ void done(const Unit&) const {}
};

__device__ __forceinline__ unsigned cvt_pk_bf16(float lo, float hi) { unsigned r; asm volatile("v_cvt_pk_bf16_f32 %0, %1, %2" : "=v"(r) : "v"(lo), "v"(hi)); return r; }
typedef float f32x2 __attribute__((ext_vector_type(2)));
__device__ __forceinline__ f32x2 gelu_pk(f32x2 v) {
    const f32x2 av = __builtin_elementwise_abs(v), d = av * 0.2316418882f + 1.0f;
    f32x2 t; t.x = __builtin_amdgcn_rcpf(d.x); t.y = __builtin_amdgcn_rcpf(d.y);
    f32x2 q = t * 0.5307027145f + (-0.7265760135f); q = q * t + 0.7107068705f; q = q * t + (-0.142248368f); q = q * t + 0.127414796f; q = q * t;
    const f32x2 s = (v * v) * (-0.72134752044f);
    f32x2 e; e.x = __builtin_amdgcn_exp2f(s.x); e.y = __builtin_amdgcn_exp2f(s.y);
    const f32x2 m = v * (q * e), r = v - m;
    f32x2 o; o.x = v.x < 0.f ? m.x : r.x; o.y = v.y < 0.f ? m.y : r.y; return o;
}

template <int ACT  > struct EpiBf16 {
    static constexpr bool PERM = true, AFTER_DRAIN = false; static_assert(ACT == 0 || ACT == 1, "EpiBf16: ACT is 0 (none) or 1 (gelu_pk)");
    bf16_t* O; int ldc; const float* bias; int split_cols; size_t split_stride; float scale0;
    __device__ __forceinline__ void operator()(const f32x4 (&acc)[2][2][4][2], const Unit& u, int wr, int wc, int fr, int fq) const {
        const int row0 = u.pm * BM + wr * 64 + fr; int colt = u.pn * BM; bf16_t* base = O;
        float sc = 1.f; if (split_cols) { const int t = colt / split_cols; base += (size_t)t * split_stride; colt -= t * split_cols; if (t == 0) sc = scale0; }
        const int col0 = colt + wc * 32 + 8 * fq, bcol0 = u.pn * BM + wc * 32 + 8 * fq;
        f32x4 bv[2][2];
#pragma unroll
        for (int bj = 0; bj < 2; ++bj)
#pragma unroll
            for (int n = 0; n < 2; ++n) bv[bj][n] = bias ? *(const f32x4*)(bias + bcol0 + bj * HALF + 4 * n) : (f32x4){0.f, 0.f, 0.f, 0.f};
#pragma unroll
        for (int ai = 0; ai < 2; ++ai)
#pragma unroll
            for (int m = 0; m < 4; ++m) { bf16_t* rowp = base + (size_t)(row0 + ai * HALF + m * 16) * ldc + col0;
#pragma unroll
                for (int bj = 0; bj < 2; ++bj) { f32x4 v0 = acc[ai][bj][m][0] + bv[bj][0], v1 = acc[ai][bj][m][1] + bv[bj][1];
                    if (ACT == 1) { f32x2 a = gelu_pk((f32x2){v0[0], v0[1]}), b = gelu_pk((f32x2){v0[2], v0[3]}), c = gelu_pk((f32x2){v1[0], v1[1]}), d = gelu_pk((f32x2){v1[2], v1[3]});
                        v0 = (f32x4){a.x, a.y, b.x, b.y}; v1 = (f32x4){c.x, c.y, d.x, d.y}; }
                    v0 = v0 * sc; v1 = v1 * sc; u32x4 w; w.x = cvt_pk_bf16(v0[0], v0[1]); w.y = cvt_pk_bf16(v0[2], v0[3]); w.z = cvt_pk_bf16(v1[0], v1[1]); w.w = cvt_pk_bf16(v1[2], v1[3]);
                    *(u32x4*)(rowp + bj * HALF) = w; } }
    }
};
template <class Epi, class Sched, bool ALIGN_EPI = false, bool SP2 = false>
__device__ __forceinline__ void gemm_phase(PG8_LAS unsigned char* lds, const Gemm g, const Sched& S, const Epi& E) {
    int tid_ = threadIdx.x; asm volatile("" : "+v"(tid_));
    const int tid = tid_, wid = __builtin_amdgcn_readfirstlane(tid >> 6), lane = tid & 63, wr = wid >> 2, wc = wid & 3, fr = lane & 15, fq = lane >> 4;
    const int K = g.K, nt = K / BK;
    unsigned voffA[2], voffB[2];
#pragma unroll
    for (int i = 0; i < 2; ++i) { int R, C; stage_rc(tid * 16 + i * 8192, R, C); const int Rb = Epi::PERM ? ((R & ~31) + perm32(R & 31)) : R;
        voffA[i] = (unsigned)(R * K + C) * 2u; voffB[i] = (unsigned)(Rb * K + C) * 2u; }
    const size_t kstep = (size_t)(BK * 2);
    const size_t hstep = (size_t)HALF * K * 2;
    const size_t tstep = 2 * hstep;
    const unsigned ldsw = (unsigned)wid * 1024u;
    const int aoff = lds_byte(wr * 64 + fr, fq * 8), boff = lds_byte(wc * 32 + fr, fq * 8);
#define PG8_SA(b, h) (((b) * 2 + (h)) * HTB)
#define PG8_SB(b, h) ((4 + (b) * 2 + (h)) * HTB)
#define PG8_STAGE(bufoff, gbase, voff) do { _Pragma("unroll") for (int _i = 0; _i < 2; ++_i) \
        __builtin_amdgcn_global_load_lds((const unsigned*)((const char*)(gbase) + (voff)[_i]), (PG8_LAS unsigned*)(lds + (bufoff) + ldsw + _i * 8192), 16, 0, 0); } while (0)
#define PG8_LDA(dst, b, h) do { _Pragma("unroll") for (int m = 0; m < 4; ++m) _Pragma("unroll") for (int k = 0; k < 2; ++k) dst[m][k] = *(const PG8_LAS bf16x8*)(lds + PG8_SA(b, h) + aoff + m * 2048 + k * 1024); } while (0)
#define PG8_LDB(dst, b, h) do { _Pragma("unroll") for (int n = 0; n < 2; ++n) _Pragma("unroll") for (int k = 0; k < 2; ++k) dst[n][k] = *(const PG8_LAS bf16x8*)(lds + PG8_SB(b, h) + boff + n * 2048 + k * 1024); } while (0)
#define PG8_MMA(ai, bj, At, Bt) do { __builtin_amdgcn_s_setprio(1); _Pragma("unroll") for (int m = 0; m < 4; ++m) _Pragma("unroll") for (int n = 0; n < 2; ++n) _Pragma("unroll") for (int k = 0; k < 2; ++k) \
        acc[ai][bj][m][n] = __builtin_amdgcn_mfma_f32_16x16x32_bf16(Bt[n][k], At[m][k], acc[ai][bj][m][n], 0, 0, 0); __builtin_amdgcn_s_setprio(0); } while (0)
#define PG8_WAIT_V(n) asm volatile("s_waitcnt vmcnt(" #n ")" ::: "memory")
#define PG8_WAIT_L(n) asm volatile("s_waitcnt lgkmcnt(" #n ")" ::: "memory")
#define PG8_BAR __builtin_amdgcn_s_barrier()
#define PG8_SCHED __builtin_amdgcn_sched_barrier(0)
    Unit cur, nxt; int ui = 0;
    if (!S.next(0, cur)) return;
    f32x4 acc[2][2][4][2];
#pragma unroll
    for (int a = 0; a < 2; ++a)
#pragma unroll
        for (int b = 0; b < 2; ++b)
#pragma unroll
            for (int m = 0; m < 4; ++m)
#pragma unroll
                for (int n = 0; n < 2; ++n) acc[a][b][m][n] = (f32x4){0.f, 0.f, 0.f, 0.f};
    bf16x8 At[4][2], B0[2][2], B1[2][2];
    const char* cA = (const char*)g.A + (size_t)cur.pm * tstep; const char* cB = (const char*)g.Bt + (size_t)cur.pn * tstep;
    S.a_ready(cur);
    if constexpr (SP2) {
        PG8_STAGE(PG8_SB(0, 0), cB, voffB); PG8_STAGE(PG8_SB(0, 1), cB + hstep, voffB); PG8_STAGE(PG8_SA(0, 0), cA, voffA); PG8_STAGE(PG8_SA(0, 1), cA + hstep, voffA);
        if (wr == 1) PG8_BAR;
        PG8_WAIT_V(2); PG8_BAR;
        PG8_STAGE(PG8_SB(1, 0), cB + kstep, voffB); PG8_STAGE(PG8_SA(1, 0), cA + kstep, voffA); PG8_STAGE(PG8_SB(1, 1), cB + hstep + kstep, voffB);
        PG8_WAIT_V(6); PG8_BAR;
    } else {
        PG8_STAGE(PG8_SB(0, 0), cB, voffB); PG8_STAGE(PG8_SA(0, 0), cA, voffA); PG8_STAGE(PG8_SB(0, 1), cB + hstep, voffB); PG8_STAGE(PG8_SA(0, 1), cA + hstep, voffA);
        if (wr == 1) PG8_BAR;
        PG8_WAIT_V(4); PG8_BAR;
        PG8_STAGE(PG8_SB(1, 0), cB + kstep, voffB); PG8_STAGE(PG8_SA(1, 0), cA + kstep, voffA); PG8_STAGE(PG8_SB(1, 1), cB + hstep + kstep, voffB);
        PG8_WAIT_V(6); PG8_BAR;
    }
    for (;;) {
        const bool has_next = S.next(ui + 1, nxt);
        const char* nA = has_next ? (const char*)g.A + (size_t)nxt.pm * tstep : cA; const char* nB = has_next ? (const char*)g.Bt + (size_t)nxt.pn * tstep : cB;
        for (int t = 0; t < nt; t += 2) {
            const bool last = (t == nt - 2);
            const char* a1 = cA + (size_t)(t + 1) * kstep;
            const char* a2 = last ? nA : cA + (size_t)(t + 2) * kstep; const char* b2 = last ? nB : cB + (size_t)(t + 2) * kstep;
            const char* a3 = a2 + kstep; const char* b3 = b2 + kstep;
            if (last && has_next) S.a_ready(nxt);
            if constexpr (SP2) {
            PG8_LDB(B0, 0, 0); PG8_LDB(B1, 0, 1); PG8_SCHED; PG8_LDA(At, 0, 0); PG8_STAGE(PG8_SA(1, 1), a1 + hstep, voffA);
            PG8_WAIT_V(8); PG8_WAIT_L(0); PG8_BAR; PG8_MMA(0, 0, At, B0); PG8_MMA(0, 1, At, B1); PG8_BAR; PG8_SCHED;
            PG8_LDA(At, 0, 1); PG8_STAGE(PG8_SB(0, 0), b2, voffB); PG8_STAGE(PG8_SB(0, 1), b2 + hstep, voffB); PG8_STAGE(PG8_SA(0, 0), a2, voffA);
            PG8_WAIT_V(8); PG8_WAIT_L(0); PG8_BAR; PG8_MMA(1, 0, At, B0); PG8_MMA(1, 1, At, B1); PG8_BAR; PG8_SCHED;
            PG8_LDB(B0, 1, 0); PG8_LDB(B1, 1, 1); PG8_SCHED; PG8_LDA(At, 1, 0); PG8_STAGE(PG8_SA(0, 1), a2 + hstep, voffA);
            PG8_WAIT_V(8); PG8_WAIT_L(0); PG8_BAR; PG8_MMA(0, 0, At, B0); PG8_MMA(0, 1, At, B1); PG8_BAR; PG8_SCHED;
            PG8_LDA(At, 1, 1); PG8_STAGE(PG8_SB(1, 0), b3, voffB); PG8_STAGE(PG8_SB(1, 1), b3 + hstep, voffB); PG8_STAGE(PG8_SA(1, 0), a3, voffA);
            PG8_WAIT_V(8); PG8_WAIT_L(0); PG8_BAR; PG8_MMA(1, 0, At, B0); PG8_MMA(1, 1, At, B1); PG8_BAR; PG8_SCHED;
            } else {
            PG8_LDB(B0, 0, 0); PG8_SCHED; PG8_LDA(At, 0, 0); PG8_STAGE(PG8_SA(1, 1), a1 + hstep, voffA);
            PG8_WAIT_L(8); PG8_BAR; PG8_WAIT_L(0); PG8_MMA(0, 0, At, B0); PG8_BAR; PG8_SCHED;
            PG8_LDB(B1, 0, 1); PG8_STAGE(PG8_SB(0, 0), b2, voffB);
            PG8_BAR; PG8_WAIT_L(0); PG8_MMA(0, 1, At, B1); PG8_BAR;
            PG8_LDA(At, 0, 1); PG8_STAGE(PG8_SA(0, 0), a2, voffA);
            PG8_BAR; PG8_WAIT_L(0); PG8_MMA(1, 0, At, B0); PG8_BAR; PG8_SCHED;
            PG8_STAGE(PG8_SB(0, 1), b2 + hstep, voffB);
            PG8_WAIT_V(6); PG8_BAR; PG8_MMA(1, 1, At, B1); PG8_BAR;
            PG8_LDB(B0, 1, 0); PG8_SCHED; PG8_LDA(At, 1, 0); PG8_STAGE(PG8_SA(0, 1), a2 + hstep, voffA);
            PG8_WAIT_L(8); PG8_BAR; PG8_WAIT_L(0); PG8_MMA(0, 0, At, B0); PG8_BAR; PG8_SCHED;
            PG8_LDB(B1, 1, 1); PG8_STAGE(PG8_SB(1, 0), b3, voffB);
            PG8_BAR; PG8_WAIT_L(0); PG8_MMA(0, 1, At, B1); PG8_BAR;
            PG8_LDA(At, 1, 1); PG8_STAGE(PG8_SA(1, 0), a3, voffA);
            PG8_BAR; PG8_WAIT_L(0); PG8_MMA(1, 0, At, B0); PG8_BAR; PG8_SCHED;
            PG8_STAGE(PG8_SB(1, 1), b3 + hstep, voffB);
            PG8_WAIT_V(6); PG8_BAR; PG8_MMA(1, 1, At, B1); PG8_BAR;
            }
        }
        if constexpr (ALIGN_EPI) { if (wr == 0) PG8_BAR; }
        if constexpr (!Epi::AFTER_DRAIN) { E(acc, cur, wr, wc, fr, fq); S.done(cur); }
        if (!has_next) break;
#pragma unroll
        for (int a = 0; a < 2; ++a)
#pragma unroll
            for (int b = 0; b < 2; ++b)
#pragma unroll
                for (int m = 0; m < 4; ++m)
#pragma unroll
                    for (int n = 0; n < 2; ++n) acc[a][b][m][n] = (f32x4){0.f, 0.f, 0.f, 0.f};
        cur = nxt; cA = nA; cB = nB; ++ui;
        if constexpr (ALIGN_EPI) { if (wr == 1) PG8_BAR; }
    }
    PG8_WAIT_V(0);
    if constexpr (!ALIGN_EPI) { if (wr == 0) PG8_BAR; }
    PG8_BAR;
    if constexpr (Epi::AFTER_DRAIN) { E.fused(acc, cur, wr, wc, fr, fq, lds, wid, lane); S.done(cur); }
#undef PG8_SA
#undef PG8_SB
#undef PG8_STAGE
#undef PG8_LDA
#undef PG8_LDB
#undef PG8_MMA
#undef PG8_WAIT_V
#undef PG8_WAIT_L
#undef PG8_BAR
#undef PG8_SCHED
}
}

#define LAS __attribute__((address_space(3)))
typedef unsigned short bf16;
typedef short bf16x8 __attribute__((ext_vector_type(8)));
typedef float f32x4 __attribute__((ext_vector_type(4)));
typedef unsigned u32x4 __attribute__((ext_vector_type(4)));
typedef unsigned u32x2 __attribute__((ext_vector_type(2)));

constexpr int D = 1024, NB = 8, T = 4096, CL = 256;
constexpr int ML = NB * T, MC = NB * CL, M = ML + MC;
constexpr int NZA = 3328, NZG = 3072;
constexpr int C_RQ = 0, C_RK = 256, C_RV = 512, C_RG = 1024, C_SU = 1536, C_SV = 2048, C_AQ = 2560, C_AK = 3072, C_AV = 3200;
constexpr int NE = 16, CAPL = 512, CAPC = 32, ME = NB * (CAPL + CAPC);
constexpr int NCH = 34;
constexpr float EPS = 1e-6f, LOG2E = 1.4426950408889634f;
constexpr int LDS_BYTES = 147456;

constexpr size_t MiB = 1u << 20;
constexpr size_t WS_ROPEC = 1 * MiB, WS_ROPES = 1 * MiB + 512 * 1024, WS_MODV = 2 * MiB, WS_AFF = 3 * MiB, WS_AFFC = 5 * MiB, WS_INV = 6 * MiB, WS_TOPW = 9 * MiB;
constexpr size_t WS_WTIN = 16 * MiB, WS_WTBR = WS_WTIN + (size_t)6400 * 1024 * 2, WS_WTOUT = WS_WTBR + (size_t)3072 * 512 * 2;
constexpr size_t WS_X = 34 * MiB, WS_H = 170 * MiB, WS_R = 238 * MiB;
constexpr size_t WS_ZA = WS_R, WS_G = WS_R, WS_RS = 459 * MiB, WS_ST = 527 * MiB;
constexpr size_t WS_XS = WS_R, WS_ACT = 374 * MiB, WS_WT1 = 510 * MiB, WS_WT2 = 574 * MiB, WS_END = 606 * MiB;
static_assert(WS_WTOUT + 2 * MiB <= WS_X && WS_ZA + (size_t)M * NZA * 2 <= WS_RS && WS_ST + (size_t)NB * 4 * NCH * 128 * 128 * 2 <= WS_END, "ws map");

struct KP {
    const float *x, *c, *ctx, *c_ctx, *w_mod, *b_mod, *norm1_g, *norm2_g, *w_in, *dec_f, *dec_b, *sgu_w, *sgu_b, *qn_g, *kn_g, *sink, *w_branch, *w_out, *w_router, *w_eg, *w_eu, *w_ed;
    float* out; unsigned char* ws;
};
typedef const __attribute__((address_space(4))) KP* KPC;

#define LDS_WAIT() asm volatile("s_waitcnt lgkmcnt(0)" ::: "memory")
__device__ __forceinline__ unsigned pk2(float lo, float hi) { return pg8::cvt_pk_bf16(lo, hi); }
__device__ __forceinline__ float bflo(unsigned w) { return __uint_as_float(w << 16); }
__device__ __forceinline__ float bfhi(unsigned w) { return __uint_as_float(w & 0xffff0000u); }
__device__ __forceinline__ void unpack8(const u32x4 w, float (&f)[8]) { f[0] = bflo(w.x); f[1] = bfhi(w.x); f[2] = bflo(w.y); f[3] = bfhi(w.y); f[4] = bflo(w.z); f[5] = bfhi(w.z); f[6] = bflo(w.w); f[7] = bfhi(w.w); }
__device__ __forceinline__ u32x4 pack8(const float (&f)[8]) { u32x4 o; o.x = pk2(f[0], f[1]); o.y = pk2(f[2], f[3]); o.z = pk2(f[4], f[5]); o.w = pk2(f[6], f[7]); return o; }
template <int MASK> __device__ __forceinline__ float swz_xor(float v) { static_assert(MASK > 0 && MASK < 32, "swz_xor: 1..31"); return __builtin_bit_cast(float, __builtin_amdgcn_ds_swizzle(__builtin_bit_cast(int, v), 0x1f | (MASK << 10))); }
template <int MASK> __device__ __forceinline__ int swz_xor_i(int v) { return __builtin_amdgcn_ds_swizzle(v, 0x1f | (MASK << 10)); }
__device__ __forceinline__ float sum_x32(float v) { const unsigned u = __builtin_bit_cast(unsigned, v); auto r = __builtin_amdgcn_permlane32_swap(u, u, false, false); return __builtin_bit_cast(float, (unsigned)r[0]) + __builtin_bit_cast(float, (unsigned)r[1]); }
__device__ __forceinline__ float max_x32(float v) { const unsigned u = __builtin_bit_cast(unsigned, v); auto r = __builtin_amdgcn_permlane32_swap(u, u, false, false); return fmaxf(__builtin_bit_cast(float, (unsigned)r[0]), __builtin_bit_cast(float, (unsigned)r[1])); }
__device__ __forceinline__ int sum_x32_i(int v) { auto r = __builtin_amdgcn_permlane32_swap((unsigned)v, (unsigned)v, false, false); return (int)r[0] + (int)r[1]; }
__device__ __forceinline__ float wave_sum(float v) { v += swz_xor<1>(v); v += swz_xor<2>(v); v += swz_xor<4>(v); v += swz_xor<8>(v); v += swz_xor<16>(v); return sum_x32(v); }
__device__ __forceinline__ float wave_max(float v) { v = fmaxf(v, swz_xor<1>(v)); v = fmaxf(v, swz_xor<2>(v)); v = fmaxf(v, swz_xor<4>(v)); v = fmaxf(v, swz_xor<8>(v)); v = fmaxf(v, swz_xor<16>(v)); return max_x32(v); }
__device__ __forceinline__ int wave_sum_i(int v) { v += swz_xor_i<1>(v); v += swz_xor_i<2>(v); v += swz_xor_i<4>(v); v += swz_xor_i<8>(v); v += swz_xor_i<16>(v); return sum_x32_i(v); }
__device__ __forceinline__ float sum_x16_x32(float v) { v += swz_xor<16>(v); return sum_x32(v); }
__device__ __forceinline__ float sum_x1_x2(float v) { v += swz_xor<1>(v); v += swz_xor<2>(v); return v; }
__device__ __forceinline__ float ex2(float x) { return __builtin_amdgcn_exp2f(x); }
__device__ __forceinline__ float sigmoidf_(float x) { return 1.f / (1.f + ex2(-x * LOG2E)); }
__device__ __forceinline__ float gelu_tanh(float x) { const float u = 0.7978845608028654f * (x + 0.044715f * x * x * x); return x / (1.f + ex2(-2.f * LOG2E * u)); }
__device__ __forceinline__ f32x4 mfma16(bf16x8 a, bf16x8 b, f32x4 c) { return __builtin_amdgcn_mfma_f32_16x16x32_bf16(a, b, c, 0, 0, 0); }
__device__ __forceinline__ bf16x8 as_bf16x8(u32x4 w) { return __builtin_bit_cast(bf16x8, w); }
__device__ __forceinline__ float log2_sigmoid(float a) { return -log1pf(__expf(-a)) * LOG2E; }

struct GroupOrder {
    int nG, nM, nN, pmS, pnS, G, c;
    __device__ __forceinline__ bool next(int i, pg8::Unit& u) const {
        const long L = (long)i * G + c; const int tot = nG * nM * nN; if (L >= tot) return false;
        int wgid = (int)L; { const int q = tot / 8, r = tot % 8, xcd = wgid % 8, off = wgid / 8; wgid = (xcd < r ? xcd * (q + 1) : r * (q + 1) + (xcd - r) * q) + off; }
        const int per = nM * nN, g = wgid / per, rem = wgid - g * per;
        const int nig = 8 * nN, gid = rem / nig, fm = gid * 8, gsz = (nM - fm) < 8 ? (nM - fm) : 8;
        u.pm = g * pmS + fm + ((rem % nig) % gsz); u.pn = g * pnS + (rem % nig) / gsz; return true;
    }
    __device__ __forceinline__ void a_ready(const pg8::Unit&) const {}
    __device__ __forceinline__ void done(const pg8::Unit&) const {}
};
struct MergeOrder {
    int nM, G, c;
    __device__ __forceinline__ bool next(int i, pg8::Unit& u) const {
        const int ii = i / 3, g = i - 3 * ii; const long L = (long)ii * G + c; const int tot = nM * 4; if (L >= tot) return false;
        int wgid = (int)L; { const int q = tot / 8, r = tot % 8, xcd = wgid % 8, off = wgid / 8; wgid = (xcd < r ? xcd * (q + 1) : r * (q + 1) + (xcd - r) * q) + off; }
        const int nig = 32, gid = wgid / nig, fm = gid * 8, gsz = (nM - fm) < 8 ? (nM - fm) : 8;
        u.pm = g * (M / 256) + fm + ((wgid % nig) % gsz); u.pn = g * 4 + (wgid % nig) / gsz; return true;
    }
    __device__ __forceinline__ void a_ready(const pg8::Unit&) const {}
    __device__ __forceinline__ void done(const pg8::Unit&) const {}
};

struct EpiMerge {
    static constexpr bool PERM = true, AFTER_DRAIN = false;
    const bf16* Gt; bf16* Hm;
    __device__ __forceinline__ void operator()(const f32x4 (&acc)[2][2][4][2], const pg8::Unit& u, int wr, int wc, int fr, int fq) const {
        const int g = u.pm / (M / 256), m = u.pm - g * (M / 256), n = u.pn - g * 4;
        const int row0 = m * 256 + wr * 64 + fr, col0 = n * 256 + wc * 32 + 8 * fq;
#pragma unroll
        for (int ai = 0; ai < 2; ++ai)
#pragma unroll
            for (int mm = 0; mm < 4; ++mm) { const size_t r = (size_t)(row0 + ai * 128 + mm * 16);
#pragma unroll
                for (int bj = 0; bj < 2; ++bj) { const int cc = col0 + bj * 128;
                    const u32x4 gw = *(const u32x4*)(Gt + r * NZG + g * 1024 + cc); float gt[8]; unpack8(gw, gt);
                    const f32x4 v0 = acc[ai][bj][mm][0], v1 = acc[ai][bj][mm][1];
                    float o[8] = {v0[0], v0[1], v0[2], v0[3], v1[0], v1[1], v1[2], v1[3]};
#pragma unroll
                    for (int k = 0; k < 8; ++k) o[k] *= sigmoidf_(gt[k]);
                    if (g > 0) { const u32x4 ow = *(const u32x4*)(Hm + r * 1024 + cc); float od[8]; unpack8(ow, od);
#pragma unroll
                        for (int k = 0; k < 8; ++k) o[k] += od[k]; }
                    *(u32x4*)(Hm + r * 1024 + cc) = pack8(o); } }
    }
};
struct EpiOut {
    static constexpr bool PERM = false, AFTER_DRAIN = false;
    const float* xl; const float* xc; float* X; const float* modv;
    __device__ __forceinline__ void operator()(const f32x4 (&acc)[2][2][4][2], const pg8::Unit& u, int wr, int wc, int fr, int fq) const {
        const int row0 = u.pm * 256 + wr * 64 + fr, col0 = u.pn * 256 + wc * 32 + 4 * fq;
        const int bi = (u.pm * 256 < ML) ? ((u.pm * 256) >> 12) : 8;
        const float* g1 = modv + bi * 6144 + 2 * 1024;
        f32x4 gv[2][2];
#pragma unroll
        for (int bj = 0; bj < 2; ++bj)
#pragma unroll
            for (int n = 0; n < 2; ++n) gv[bj][n] = *(const f32x4*)(g1 + col0 + bj * 128 + n * 16);
#pragma unroll
        for (int ai = 0; ai < 2; ++ai)
#pragma unroll
            for (int m = 0; m < 4; ++m) { const int r = row0 + ai * 128 + m * 16; const float* src = (r < ML) ? xl + (size_t)r * 1024 : xc + (size_t)(r - ML) * 1024;
#pragma unroll
                for (int bj = 0; bj < 2; ++bj)
#pragma unroll
                    for (int n = 0; n < 2; ++n) { const int cc = col0 + bj * 128 + n * 16; const f32x4 xv = *(const f32x4*)(src + cc);
                        *(f32x4*)(X + (size_t)r * 1024 + cc) = xv + gv[bj][n] * acc[ai][bj][m][n]; } }
    }
};
struct EpiMoe1 {
    static constexpr bool PERM = true, AFTER_DRAIN = false;
    bf16* ACT;
    __device__ __forceinline__ void operator()(const f32x4 (&acc)[2][2][4][2], const pg8::Unit& u, int wr, int wc, int fr, int fq) const {
        const int row0 = u.pm * 256 + wr * 64 + fr, col0 = (u.pn & 7) * 128 + wc * 32 + 8 * fq;
#pragma unroll
        for (int ai = 0; ai < 2; ++ai)
#pragma unroll
            for (int m = 0; m < 4; ++m) { const size_t r = (size_t)(row0 + ai * 128 + m * 16);
                const f32x4 a0 = acc[ai][0][m][0], a1 = acc[ai][0][m][1], u0 = acc[ai][1][m][0], u1 = acc[ai][1][m][1];
                float o[8];
#pragma unroll
                for (int k = 0; k < 4; ++k) { o[k] = a0[k] * sigmoidf_(a0[k]) * u0[k]; o[4 + k] = a1[k] * sigmoidf_(a1[k]) * u1[k]; }
                *(u32x4*)(ACT + r * 1024 + col0) = pack8(o); }
    }
};
struct EpiMoe2 {
    static constexpr bool PERM = true, AFTER_DRAIN = false;
    bf16* Y; const float* topw;
    __device__ __forceinline__ void operator()(const f32x4 (&acc)[2][2][4][2], const pg8::Unit& u, int wr, int wc, int fr, int fq) const {
        const int row0 = u.pm * 256 + wr * 64 + fr, col0 = (u.pn & 3) * 256 + wc * 32 + 8 * fq;
#pragma unroll
        for (int ai = 0; ai < 2; ++ai)
#pragma unroll
            for (int m = 0; m < 4; ++m) { const size_t r = (size_t)(row0 + ai * 128 + m * 16); const float tw = topw[r];
#pragma unroll
                for (int bj = 0; bj < 2; ++bj) { const f32x4 v0 = acc[ai][bj][m][0] * tw, v1 = acc[ai][bj][m][1] * tw;
                    u32x4 w; w.x = pk2(v0[0], v0[1]); w.y = pk2(v0[2], v0[3]); w.z = pk2(v1[0], v1[1]); w.w = pk2(v1[2], v1[3]);
                    *(u32x4*)(Y + r * 1024 + col0 + bj * 128) = w; } }
    }
};

__device__ __forceinline__ void tr_item(const float* W, int N, int k0, int n0, bf16* dst, int K, LAS float* scr, int lane) {
#pragma unroll 8
    for (int i = 0; i < 32; ++i) { const int kk = 2 * i + (lane >> 5); scr[kk * 33 + (lane & 31)] = W[(size_t)(k0 + kk) * N + n0 + (lane & 31)]; }
    LDS_WAIT();
    const int cc = lane & 7;
#pragma unroll
    for (int j = 0; j < 4; ++j) { const int n = (lane >> 3) + 8 * j; const LAS float* s = scr + (8 * cc) * 33 + n;
        u32x4 o; o.x = pk2(s[0 * 33], s[1 * 33]); o.y = pk2(s[2 * 33], s[3 * 33]); o.z = pk2(s[4 * 33], s[5 * 33]); o.w = pk2(s[6 * 33], s[7 * 33]);
        *(u32x4*)(dst + (size_t)n * K + 8 * cc) = o; }
    LDS_WAIT();
}
__device__ __forceinline__ void convert_small(KPC p, int l, LAS unsigned char* lds, int lane, int wave, int bid, int G) {
    LAS float* scr = (LAS float*)(lds + wave * 8448);
    const int gw = bid * 8 + wave, NGW = G * 8;
    constexpr int I_IN = 16 * 200, I_BR = 8 * 32, I_OUT = 16 * 32;
    bf16* wtin = (bf16*)(p->ws + WS_WTIN); bf16* wtbr = (bf16*)(p->ws + WS_WTBR); bf16* wtout = (bf16*)(p->ws + WS_WTOUT);
    for (int it = gw; it < I_IN + 3 * I_BR + I_OUT; it += NGW) {
        int r = it;
        if (r < I_IN) { const int kb = r / 200, nb = r % 200; tr_item(p->w_in + (size_t)l * 1024 * 6400, 6400, 64 * kb, 32 * nb, wtin + (size_t)(32 * nb) * 1024 + 64 * kb, 1024, scr, lane); continue; }
        r -= I_IN;
        if (r < 3 * I_BR) { const int br = r / I_BR, q = r % I_BR, kb = q / 32, nb = q % 32;
            tr_item(p->w_branch + ((size_t)l * 3 + br) * 512 * 1024, 1024, 64 * kb, 32 * nb, wtbr + (size_t)(br * 1024 + 32 * nb) * 512 + 64 * kb, 512, scr, lane); continue; }
        r -= 3 * I_BR;
        { const int kb = r / 32, nb = r % 32; tr_item(p->w_out + (size_t)l * 1024 * 1024, 1024, 64 * kb, 32 * nb, wtout + (size_t)(32 * nb) * 1024 + 64 * kb, 1024, scr, lane); }
    }
}
__device__ __forceinline__ void convert_experts(KPC p, int l, LAS unsigned char* lds, int lane, int wave, int bid, int G) {
    LAS float* scr = (LAS float*)(lds + wave * 8448);
    const int gw = bid * 8 + wave, NGW = G * 8;
    bf16* wt1 = (bf16*)(p->ws + WS_WT1); bf16* wt2 = (bf16*)(p->ws + WS_WT2);
    for (int it = gw; it < NE * 3 * 512; it += NGW) {
        const int e = it / 1536, q = it % 1536, which = q / 512, qq = q % 512, kb = qq / 32, nb = qq % 32, n0 = 32 * nb, k0 = 64 * kb;
        const size_t woff = ((size_t)l * NE + e) * 1024 * 1024;
        if (which == 0) tr_item(p->w_eg + woff, 1024, k0, n0, wt1 + ((size_t)e * 2048 + (n0 >> 7) * 256 + (n0 & 127)) * 1024 + k0, 1024, scr, lane);
        else if (which == 1) tr_item(p->w_eu + woff, 1024, k0, n0, wt1 + ((size_t)e * 2048 + (n0 >> 7) * 256 + 128 + (n0 & 127)) * 1024 + k0, 1024, scr, lane);
        else tr_item(p->w_ed + woff, 1024, k0, n0, wt2 + ((size_t)e * 1024 + n0) * 1024 + k0, 1024, scr, lane);
    }
}

__device__ __forceinline__ void phase_prep(KPC p, LAS unsigned char* lds, int tid, int lane, int wave, int bid, int G) {
    unsigned char* ws = p->ws;
    {   float* rc = (float*)(ws + WS_ROPEC); float* rsn = (float*)(ws + WS_ROPES);
        for (int i = bid * 512 + tid; i < T * 32; i += G * 512) { const int t = i >> 5, f = i & 31; const int pos = (f < 16) ? (t >> 6) : (t & 63); const int fi = f & 15;
            const float inv = ex2(-(float)fi * (13.287712379549449f / 16.f));
            float ang = (float)pos * inv; ang -= 6.283185307179586f * rintf(ang * 0.15915494309189535f);
            rc[i] = __cosf(ang); rsn[i] = __sinf(ang); } }
    {   LAS float* sv = (LAS float*)lds;
        LAS float* red = (LAS float*)(lds + 36864);
        for (int i = tid; i < 9 * 1024; i += 512) { const int r = i >> 10, k = i & 1023; const float v = (r < 8) ? p->c[r * 1024 + k] : p->c_ctx[k]; sv[i] = v * sigmoidf_(v); }
        __syncthreads();
        for (int it = bid; it < 192; it += G) {
            const int l = it / 96, n0 = (it % 96) * 64;
            const float* W = p->w_mod + (size_t)l * 1024 * 6144 + n0 + lane;
            float acc[9];
#pragma unroll
            for (int r = 0; r < 9; ++r) acc[r] = 0.f;
#pragma unroll 4
            for (int k = wave * 128; k < wave * 128 + 128; ++k) { const float wv = W[(size_t)k * 6144];
#pragma unroll
                for (int r = 0; r < 9; ++r) acc[r] += sv[r * 1024 + k] * wv; }
#pragma unroll
            for (int r = 0; r < 9; ++r) red[(wave * 9 + r) * 64 + lane] = acc[r];
            __syncthreads();
            for (int i = tid; i < 576; i += 512) { const int r = i >> 6, ln = i & 63; float s = 0.f;
#pragma unroll
                for (int w = 0; w < 8; ++w) s += red[(w * 9 + r) * 64 + ln];
                s += p->b_mod[l * 6144 + n0 + ln]; ((float*)(ws + WS_MODV))[(l * 9 + r) * 6144 + n0 + ln] = s; }
            __syncthreads();
        }
    }
    __syncthreads();
    convert_small(p, 0, lds, lane, wave, bid, G);
}

__device__ __forceinline__ float row_rs(const f32x4 (&v)[4]) {
    float ss = 0.f;
#pragma unroll
    for (int j = 0; j < 4; ++j) ss += (v[j].x * v[j].x + v[j].y * v[j].y) + (v[j].z * v[j].z + v[j].w * v[j].w);
    return 1.0f / sqrtf(wave_sum(ss) * (1.f / 1024.f) + EPS);
}
__device__ __forceinline__ void norm_mod(const f32x4 (&v)[4], float rs, const float* gain, const float* sh, const float* sc, f32x4 (&h)[4], int lane) {
#pragma unroll
    for (int j = 0; j < 4; ++j) { const int col = 4 * lane + 256 * j; const f32x4 g = *(const f32x4*)(gain + col), a = *(const f32x4*)(sc + col), b = *(const f32x4*)(sh + col);
        h[j] = (v[j] * rs) * g * (a + 1.0f) + b; }
}
__device__ __forceinline__ void store_h(const f32x4 (&h)[4], bf16* hrow, int lane) {
#pragma unroll
    for (int j = 0; j < 4; ++j) { u32x2 w; w.x = pk2(h[j].x, h[j].y); w.y = pk2(h[j].z, h[j].w); *(u32x2*)(hrow + 4 * lane + 256 * j) = w; }
}
__device__ __forceinline__ void phase_norm_in(KPC p, int lane, int wave, int bid, int G) {
    const float* modv = (const float*)(p->ws + WS_MODV); bf16* H = (bf16*)(p->ws + WS_H);
    for (int r = bid * 8 + wave; r < M; r += G * 8) {
        const float* src = (r < ML) ? p->x + (size_t)r * 1024 : p->ctx + (size_t)(r - ML) * 1024; const int bi = (r < ML) ? (r >> 12) : 8;
        f32x4 v[4], h[4];
#pragma unroll
        for (int j = 0; j < 4; ++j) v[j] = *(const f32x4*)(src + 4 * lane + 256 * j);
        const float rs = row_rs(v);
        norm_mod(v, rs, p->norm1_g, modv + bi * 6144, modv + bi * 6144 + 1024, h, lane);
        store_h(h, H + (size_t)r * 1024, lane);
    }
}

__device__ __forceinline__ void att_item(KPC p, int l, LAS unsigned char* lds, int item, float Mb2, int tid, int lane, int wave) {
    const bf16* ZA = (const bf16*)(p->ws + WS_ZA); bf16* BR = (bf16*)p->out + (size_t)2 * M * 512;
    const float* rc = (const float*)(p->ws + WS_ROPEC); const float* rsn = (const float*)(p->ws + WS_ROPES);
    const bool isctx = item >= 512;
    int b, kvh, qb;
    if (!isctx) { b = item >> 6; kvh = (item >> 5) & 1; qb = item & 31; } else { const int ci = item - 512; b = ci >> 2; kvh = (ci >> 1) & 1; qb = ci & 1; }
    const int rowbase = isctx ? ML + b * CL : b * T;
    const int g = wave >> 1, qs = wave & 1, hh = kvh * 4 + g, c = lane & 15, g4 = lane >> 4, q0 = qb * 128 + qs * 64;
    const float* qg = p->qn_g + l * 64; const float* kg = p->kn_g + l * 64;
    LAS unsigned char* Kl = lds; LAS unsigned char* Vt = lds + 18432;
    bf16x8 qf[4][2];
#pragma unroll
    for (int ti = 0; ti < 4; ++ti) {
        const int pos = q0 + 16 * ti + c; const bf16* src = ZA + (size_t)(rowbase + pos) * NZA + C_AQ + hh * 64 + 8 * g4;
        float a[8], bb[8]; unpack8(*(const u32x4*)src, a); unpack8(*(const u32x4*)(src + 32), bb);
        float ss = 0.f;
#pragma unroll
        for (int j = 0; j < 8; ++j) ss += a[j] * a[j] + bb[j] * bb[j];
        ss = sum_x16_x32(ss);
        const float rs = 1.0f / sqrtf(ss * (1.f / 64.f) + EPS);
#pragma unroll
        for (int j = 0; j < 8; ++j) { a[j] *= rs * qg[8 * g4 + j]; bb[j] *= rs * qg[32 + 8 * g4 + j]; }
        if (!isctx) {
#pragma unroll
            for (int j = 0; j < 8; ++j) { const float cs = rc[pos * 32 + 8 * g4 + j], sn = rsn[pos * 32 + 8 * g4 + j]; const float x1 = a[j], x2 = bb[j]; a[j] = x1 * cs - x2 * sn; bb[j] = x1 * sn + x2 * cs; } }
#pragma unroll
        for (int j = 0; j < 8; ++j) { a[j] *= 0.125f * LOG2E; bb[j] *= 0.125f * LOG2E; }
        qf[ti][0] = as_bf16x8(pack8(a)); qf[ti][1] = as_bf16x8(pack8(bb));
        __builtin_amdgcn_sched_barrier(0);
    }
    f32x4 O[4][4]; float lsum[4];
#pragma unroll
    for (int i = 0; i < 4; ++i) { lsum[i] = 0.f;
#pragma unroll
        for (int j = 0; j < 4; ++j) O[i][j] = (f32x4){0.f, 0.f, 0.f, 0.f}; }
    const int ntile = isctx ? 2 : 5;
    for (int kt = 0; kt < ntile; ++kt) {
        int krow0, kpos0 = 0, mode = 0; bool local = false;
        if (isctx) krow0 = ML + b * CL + 128 * kt;
        else if (kt < 3) { const int kb = qb - 1 + kt; if (kb < 0 || kb > 31) continue; krow0 = b * T + kb * 128; kpos0 = kb * 128; local = true; mode = (kt == 0) ? 1 : ((kt == 2) ? 2 : 0); }
        else krow0 = ML + b * CL + 128 * (kt - 3);
        __syncthreads();
        {
            const int key = tid >> 2, q4 = tid & 3; const bf16* src = ZA + (size_t)(krow0 + key) * NZA + C_AK + kvh * 64 + 8 * q4;
            float a[8], bb[8]; unpack8(*(const u32x4*)src, a); unpack8(*(const u32x4*)(src + 32), bb);
            float ss = 0.f;
#pragma unroll
            for (int j = 0; j < 8; ++j) ss += a[j] * a[j] + bb[j] * bb[j];
            ss = sum_x1_x2(ss);
            const float rs = 1.0f / sqrtf(ss * (1.f / 64.f) + EPS);
#pragma unroll
            for (int j = 0; j < 8; ++j) { a[j] *= rs * kg[8 * q4 + j]; bb[j] *= rs * kg[32 + 8 * q4 + j]; }
            if (local) { const int pos = kpos0 + key;
#pragma unroll
                for (int j = 0; j < 8; ++j) { const float cs = rc[pos * 32 + 8 * q4 + j], sn = rsn[pos * 32 + 8 * q4 + j]; const float x1 = a[j], x2 = bb[j]; a[j] = x1 * cs - x2 * sn; bb[j] = x1 * sn + x2 * cs; } }
            *(LAS u32x4*)(Kl + key * 144 + 16 * q4) = pack8(a); *(LAS u32x4*)(Kl + key * 144 + 64 + 16 * q4) = pack8(bb);
            const bf16* vs = ZA + (size_t)(krow0 + key) * NZA + C_AV + kvh * 64 + 16 * q4;
            const u32x4 v0 = *(const u32x4*)vs, v1 = *(const u32x4*)(vs + 8);
            const unsigned vw[8] = {v0.x, v0.y, v0.z, v0.w, v1.x, v1.y, v1.z, v1.w};
#pragma unroll
            for (int j = 0; j < 8; ++j) { *(LAS unsigned short*)(Vt + (16 * q4 + 2 * j) * 272 + key * 2) = (unsigned short)(vw[j] & 0xffffu); *(LAS unsigned short*)(Vt + (16 * q4 + 2 * j + 1) * 272 + key * 2) = (unsigned short)(vw[j] >> 16); }
        }
        __syncthreads();
#pragma unroll 1
        for (int kk = 0; kk < 4; ++kk) {
            bf16x8 ka[2][2];
#pragma unroll
            for (int hf = 0; hf < 2; ++hf)
#pragma unroll
                for (int ks = 0; ks < 2; ++ks) ka[hf][ks] = *(const LAS bf16x8*)(Kl + (32 * kk + 16 * hf + c) * 144 + ks * 64 + g4 * 16);
            bf16x8 pf[4];
#pragma unroll
            for (int ti = 0; ti < 4; ++ti) {
                f32x4 sa = (f32x4){0.f, 0.f, 0.f, 0.f}, sb = (f32x4){0.f, 0.f, 0.f, 0.f};
                sa = mfma16(ka[0][0], qf[ti][0], sa); sa = mfma16(ka[0][1], qf[ti][1], sa);
                sb = mfma16(ka[1][0], qf[ti][0], sb); sb = mfma16(ka[1][1], qf[ti][1], sb);
                const int ii = qs * 64 + 16 * ti + c; float pa[4], pb[4]; const int mlo = (mode == 1) ? ii : -1000, mhi = (mode == 2) ? ii : 1000;
#pragma unroll
                for (int rr = 0; rr < 4; ++rr) { const int ja = 32 * kk + 4 * g4 + rr, jb = ja + 16;
                    pa[rr] = ex2(sa[rr] - Mb2); pb[rr] = ex2(sb[rr] - Mb2);
                    pa[rr] = (ja >= mlo && ja <= mhi) ? pa[rr] : 0.f; pb[rr] = (jb >= mlo && jb <= mhi) ? pb[rr] : 0.f;
                    lsum[ti] += pa[rr] + pb[rr]; }
                u32x4 w; w.x = pk2(pa[0], pa[1]); w.y = pk2(pa[2], pa[3]); w.z = pk2(pb[0], pb[1]); w.w = pk2(pb[2], pb[3]); pf[ti] = as_bf16x8(w);
            }
#pragma unroll
            for (int dt = 0; dt < 4; ++dt) {
                const u32x2 v0 = *(const LAS u32x2*)(Vt + (16 * dt + c) * 272 + (32 * kk + 4 * g4) * 2), v1 = *(const LAS u32x2*)(Vt + (16 * dt + c) * 272 + (32 * kk + 16 + 4 * g4) * 2);
                u32x4 vv; vv.x = v0.x; vv.y = v0.y; vv.z = v1.x; vv.w = v1.y; const bf16x8 va = as_bf16x8(vv);
#pragma unroll
                for (int ti = 0; ti < 4; ++ti) O[dt][ti] = mfma16(va, pf[ti], O[dt][ti]);
            }
        }
    }
    const float sk = ex2(p->sink[l * 8 + hh] * LOG2E - Mb2);
#pragma unroll
    for (int ti = 0; ti < 4; ++ti) { float lt = sum_x16_x32(lsum[ti]); const float inv = 1.0f / (lt + sk);
        bf16* dst = BR + (size_t)(rowbase + q0 + 16 * ti + c) * 512 + hh * 64 + 4 * g4;
#pragma unroll
        for (int dt = 0; dt < 4; ++dt) { const f32x4 o = O[dt][ti] * inv; u32x2 w; w.x = pk2(o[0], o[1]); w.y = pk2(o[2], o[3]); *(u32x2*)(dst + 16 * dt) = w; } }
    __syncthreads();
}

__device__ __forceinline__ void sgu_item(KPC p, int l, LAS unsigned char* lds, int item, int tid, int lane, int wave) {
    const bf16* ZA = (const bf16*)(p->ws + WS_ZA); bf16* BR = (bf16*)p->out + (size_t)1 * M * 512;
    const int ch = item >> 2, g = item & 3, r0 = ch * 128, c = lane & 15, g4 = lane >> 4;
    LAS unsigned char* vT = lds;
    LAS unsigned char* WL = lds + 34816;
    {
        const int j = tid >> 2, q4 = tid & 3; const bf16* src = ZA + (size_t)(r0 + j) * NZA + C_SV + 32 * q4;
        float s = 0.f, ss = 0.f;
#pragma unroll
        for (int k = 0; k < 4; ++k)
#pragma unroll
            for (int q = 0; q < 4; ++q) { float f[8]; unpack8(*(const u32x4*)(src + 128 * k + 8 * q), f);
#pragma unroll
                for (int e = 0; e < 8; ++e) { const float y = gelu_tanh(f[e]); s += y; ss += y * y; } }
        s = sum_x1_x2(s); ss = sum_x1_x2(ss);
        const float mean = s * (1.f / 512.f), var = fmaxf(ss * (1.f / 512.f) - mean * mean, 0.f), rstd = 1.0f / sqrtf(var + EPS);
#pragma unroll
        for (int q = 0; q < 4; ++q) { float f[8]; unpack8(*(const u32x4*)(src + 128 * g + 8 * q), f);
#pragma unroll
            for (int e = 0; e < 8; e += 2) { const float y0 = (gelu_tanh(f[e]) - mean) * rstd, y1 = (gelu_tanh(f[e + 1]) - mean) * rstd; const unsigned w = pk2(y0, y1);
                *(LAS unsigned short*)(vT + (32 * q4 + 8 * q + e) * 272 + j * 2) = (unsigned short)(w & 0xffffu); *(LAS unsigned short*)(vT + (32 * q4 + 8 * q + e + 1) * 272 + j * 2) = (unsigned short)(w >> 16); } }
        const float* wsrc = p->sgu_w + ((size_t)(l * 4 + g) * 128 + (tid >> 2)) * 128 + 32 * (tid & 3);
#pragma unroll
        for (int q = 0; q < 4; ++q) { const f32x4 a = *(const f32x4*)(wsrc + 8 * q), bq = *(const f32x4*)(wsrc + 8 * q + 4);
            u32x4 w; w.x = pk2(a.x, a.y); w.y = pk2(a.z, a.w); w.z = pk2(bq.x, bq.y); w.w = pk2(bq.z, bq.w);
            *(LAS u32x4*)(WL + (tid >> 2) * 272 + (32 * (tid & 3) + 8 * q) * 2) = w; }
    }
    __syncthreads();
    bf16x8 af[4];
#pragma unroll
    for (int ks = 0; ks < 4; ++ks) af[ks] = *(const LAS bf16x8*)(vT + (16 * wave + c) * 272 + (32 * ks + 8 * g4) * 2);
#pragma unroll 2
    for (int ti = 0; ti < 8; ++ti) {
        f32x4 acc = (f32x4){0.f, 0.f, 0.f, 0.f};
#pragma unroll
        for (int ks = 0; ks < 4; ++ks) acc = mfma16(af[ks], *(const LAS bf16x8*)(WL + (16 * ti + c) * 272 + (32 * ks + 8 * g4) * 2), acc);
        const int i = 16 * ti + c; const float bias = p->sgu_b[(l * 4 + g) * 128 + i];
        const int col = 128 * g + 16 * wave + 4 * g4;
        const u32x2 uw = *(const u32x2*)(ZA + (size_t)(r0 + i) * NZA + C_SU + col);
        const float o0 = gelu_tanh(bflo(uw.x)) * (acc[0] + bias), o1 = gelu_tanh(bfhi(uw.x)) * (acc[1] + bias), o2 = gelu_tanh(bflo(uw.y)) * (acc[2] + bias), o3 = gelu_tanh(bfhi(uw.y)) * (acc[3] + bias);
        u32x2 w; w.x = pk2(o0, o1); w.y = pk2(o2, o3); *(u32x2*)(BR + (size_t)(r0 + i) * 512 + col) = w;
    }
    __syncthreads();
}

__device__ __forceinline__ void ret_load_k(KPC p, const bf16* ZA, int r0, int h, bool latent, int pos0, int tid, float (&a)[8], float (&bb)[8]) {
    const int j = tid >> 2, q4 = tid & 3; const bf16* src = ZA + (size_t)(r0 + j) * NZA + C_RK + 64 * h + 8 * q4;
    unpack8(*(const u32x4*)src, a); unpack8(*(const u32x4*)(src + 32), bb);
    if (latent) { const float* rc = (const float*)(p->ws + WS_ROPEC); const float* rsn = (const float*)(p->ws + WS_ROPES); const int pos = pos0 + j;
#pragma unroll
        for (int e = 0; e < 8; ++e) { const float cs = rc[pos * 32 + 8 * q4 + e], sn = rsn[pos * 32 + 8 * q4 + e]; const float x1 = a[e], x2 = bb[e]; a[e] = x1 * cs - x2 * sn; bb[e] = x1 * sn + x2 * cs; } }
#pragma unroll
    for (int e = 0; e < 8; ++e) { a[e] *= 0.125f; bb[e] *= 0.125f; }
}
__device__ __forceinline__ void ret_stage_vT(const bf16* ZA, int r0, int h, LAS unsigned char* vT, int tid) {
    const int j = tid >> 2, q4 = tid & 3; const bf16* src = ZA + (size_t)(r0 + j) * NZA + C_RV + 128 * h + 32 * q4;
#pragma unroll
    for (int q = 0; q < 4; ++q) { const u32x4 v = *(const u32x4*)(src + 8 * q); const unsigned vw[4] = {v.x, v.y, v.z, v.w};
#pragma unroll
        for (int e = 0; e < 4; ++e) { *(LAS unsigned short*)(vT + (32 * q4 + 8 * q + 2 * e) * 272 + j * 2) = (unsigned short)(vw[e] & 0xffffu); *(LAS unsigned short*)(vT + (32 * q4 + 8 * q + 2 * e + 1) * 272 + j * 2) = (unsigned short)(vw[e] >> 16); } }
}
__device__ __forceinline__ void ret_upd_item(KPC p, int l, LAS unsigned char* lds, int item, int tid, int lane, int wave) {
    const bf16* ZA = (const bf16*)(p->ws + WS_ZA); float* RS = (float*)(p->ws + WS_RS);
    const int b = item / (NCH * 4), rem = item % (NCH * 4), n = rem >> 2, h = rem & 3, c = lane & 15, g4 = lane >> 4;
    const bool latent = n < 32; const int r0 = latent ? b * T + 128 * n : ML + b * CL + 128 * (n - 32);
    const float lgf = log2_sigmoid(p->dec_f[l * 4 + h]), lgb = log2_sigmoid(p->dec_b[l * 4 + h]);
    LAS unsigned char* vT = lds; LAS unsigned char* kTf = lds + 34816; LAS unsigned char* kTb = lds + 34816 + 17408;
    {   float a[8], bb[8]; ret_load_k(p, ZA, r0, h, latent, 128 * n, tid, a, bb);
        const int j = tid >> 2, q4 = tid & 3; const float wf = ex2((float)(127 - j) * lgf), wb = ex2((float)j * lgb);
#pragma unroll
        for (int e = 0; e < 8; e += 2) {
            unsigned w = pk2(a[e] * wf, a[e + 1] * wf); *(LAS unsigned short*)(kTf + (8 * q4 + e) * 272 + j * 2) = (unsigned short)(w & 0xffffu); *(LAS unsigned short*)(kTf + (8 * q4 + e + 1) * 272 + j * 2) = (unsigned short)(w >> 16);
            w = pk2(bb[e] * wf, bb[e + 1] * wf); *(LAS unsigned short*)(kTf + (32 + 8 * q4 + e) * 272 + j * 2) = (unsigned short)(w & 0xffffu); *(LAS unsigned short*)(kTf + (32 + 8 * q4 + e + 1) * 272 + j * 2) = (unsigned short)(w >> 16);
            w = pk2(a[e] * wb, a[e + 1] * wb); *(LAS unsigned short*)(kTb + (8 * q4 + e) * 272 + j * 2) = (unsigned short)(w & 0xffffu); *(LAS unsigned short*)(kTb + (8 * q4 + e + 1) * 272 + j * 2) = (unsigned short)(w >> 16);
            w = pk2(bb[e] * wb, bb[e + 1] * wb); *(LAS unsigned short*)(kTb + (32 + 8 * q4 + e) * 272 + j * 2) = (unsigned short)(w & 0xffffu); *(LAS unsigned short*)(kTb + (32 + 8 * q4 + e + 1) * 272 + j * 2) = (unsigned short)(w >> 16);
        }
        ret_stage_vT(ZA, r0, h, vT, tid);
    }
    __syncthreads();
    bf16x8 af[4];
#pragma unroll
    for (int ks = 0; ks < 4; ++ks) af[ks] = *(const LAS bf16x8*)(vT + (16 * wave + c) * 272 + (32 * ks + 8 * g4) * 2);
#pragma unroll
    for (int dir = 0; dir < 2; ++dir) { const LAS unsigned char* kT = dir ? kTb : kTf;
        float* dst = RS + ((size_t)(((b * 4 + h) * 2 + dir) * NCH + n) * 128 + 16 * wave + 4 * g4) * 64;
#pragma unroll
        for (int dt = 0; dt < 4; ++dt) { f32x4 acc = (f32x4){0.f, 0.f, 0.f, 0.f};
#pragma unroll
            for (int ks = 0; ks < 4; ++ks) acc = mfma16(af[ks], *(const LAS bf16x8*)(kT + (16 * dt + c) * 272 + (32 * ks + 8 * g4) * 2), acc);
#pragma unroll
            for (int rr = 0; rr < 4; ++rr) dst[rr * 64 + 16 * dt + c] = acc[rr]; } }
    __syncthreads();
}
__device__ __forceinline__ void phase_scan(KPC p, int l, int tid, int bid, int G) {
    const float* RS = (const float*)(p->ws + WS_RS); bf16* ST = (bf16*)(p->ws + WS_ST);
    for (int idx = bid * 512 + tid; idx < NB * 4 * 2 * 8192; idx += G * 512) {
        const int ed = idx & 8191, dir = (idx >> 13) & 1, bh = idx >> 14, e = ed >> 6, d = ed & 63, h = bh & 3;
        const float* P = RS + (size_t)((bh * 2 + dir) * NCH) * 8192 + ed;
        bf16* S = ST + ((size_t)bh * NCH * 128 + e) * 128 + dir * 64 + d;
        const float lg = log2_sigmoid(dir ? p->dec_b[l * 4 + h] : p->dec_f[l * 4 + h]); const float dec = ex2(128.f * lg);
        const float u32 = P[32 * 8192], u33 = P[33 * 8192];
        if (dir == 0) {
            S[32 * 16384] = 0; S[33 * 16384] = (bf16)(pk2(u32, 0.f) & 0xffffu);
            float s = dec * u32 + u33;
            for (int n = 0; n < 32; ++n) { const float u = P[(size_t)n * 8192]; S[(size_t)n * 16384] = (bf16)(pk2(s, 0.f) & 0xffffu); s = dec * s + u; }
        } else {
            S[33 * 16384] = 0; S[32 * 16384] = (bf16)(pk2(u33, 0.f) & 0xffffu);
            float s = dec * u33 + u32;
            for (int n = 31; n >= 0; --n) { const float u = P[(size_t)n * 8192]; S[(size_t)n * 16384] = (bf16)(pk2(s, 0.f) & 0xffffu); s = dec * s + u; }
        }
    }
}
__device__ __forceinline__ void ret_out_item(KPC p, int l, LAS unsigned char* lds, int item, int tid, int lane, int wave) {
    const bf16* ZA = (const bf16*)(p->ws + WS_ZA); bf16* BR = (bf16*)p->out; const bf16* ST = (const bf16*)(p->ws + WS_ST);
    const int b = item / (NCH * 4), rem = item % (NCH * 4), n = rem >> 2, h = rem & 3, c = lane & 15, g4 = lane >> 4;
    const bool latent = n < 32; const int r0 = latent ? b * T + 128 * n : ML + b * CL + 128 * (n - 32);
    const float lgf = log2_sigmoid(p->dec_f[l * 4 + h]), lgb = log2_sigmoid(p->dec_b[l * 4 + h]);
    LAS unsigned char* vT = lds; LAS unsigned char* Kl = lds + 34816; LAS unsigned char* Sl = lds + 34816 + 18432;
    {   float a[8], bb[8]; ret_load_k(p, ZA, r0, h, latent, 128 * n, tid, a, bb);
        const int j = tid >> 2, q4 = tid & 3;
        *(LAS u32x4*)(Kl + j * 144 + 16 * q4) = pack8(a); *(LAS u32x4*)(Kl + j * 144 + 64 + 16 * q4) = pack8(bb);
        ret_stage_vT(ZA, r0, h, vT, tid);
        const u32x4* ssrc = (const u32x4*)(ST + (size_t)((b * 4 + h) * NCH + n) * 16384);
#pragma unroll
        for (int k = 0; k < 4; ++k) { const int q = tid + 512 * k; *(LAS u32x4*)(Sl + (q >> 4) * 272 + (q & 15) * 16) = ssrc[q]; }
    }
    __syncthreads();
    const int ii = 16 * wave + c;
    bf16x8 qf[2];
    {   const bf16* src = ZA + (size_t)(r0 + ii) * NZA + C_RQ + 64 * h + 8 * g4; float a[8], bb[8]; unpack8(*(const u32x4*)src, a); unpack8(*(const u32x4*)(src + 32), bb);
        if (latent) { const float* rc = (const float*)(p->ws + WS_ROPEC); const float* rsn = (const float*)(p->ws + WS_ROPES); const int pos = 128 * n + ii;
#pragma unroll
            for (int e = 0; e < 8; ++e) { const float cs = rc[pos * 32 + 8 * g4 + e], sn = rsn[pos * 32 + 8 * g4 + e]; const float x1 = a[e], x2 = bb[e]; a[e] = x1 * cs - x2 * sn; bb[e] = x1 * sn + x2 * cs; } }
        qf[0] = as_bf16x8(pack8(a)); qf[1] = as_bf16x8(pack8(bb)); }
    bf16x8 pf[4];
#pragma unroll
    for (int kk = 0; kk < 4; ++kk) {
        f32x4 sa = (f32x4){0.f, 0.f, 0.f, 0.f}, sb = (f32x4){0.f, 0.f, 0.f, 0.f};
        sa = mfma16(*(const LAS bf16x8*)(Kl + (32 * kk + c) * 144 + g4 * 16), qf[0], sa); sa = mfma16(*(const LAS bf16x8*)(Kl + (32 * kk + c) * 144 + 64 + g4 * 16), qf[1], sa);
        sb = mfma16(*(const LAS bf16x8*)(Kl + (32 * kk + 16 + c) * 144 + g4 * 16), qf[0], sb); sb = mfma16(*(const LAS bf16x8*)(Kl + (32 * kk + 16 + c) * 144 + 64 + g4 * 16), qf[1], sb);
        float pa[4], pb[4];
#pragma unroll
        for (int rr = 0; rr < 4; ++rr) { const int ja = 32 * kk + 4 * g4 + rr, jb = ja + 16; const int da = ii - ja, db = ii - jb;
            pa[rr] = sa[rr] * ((da >= 0) ? ex2((float)da * lgf) : ex2((float)(-da) * lgb)); pb[rr] = sb[rr] * ((db >= 0) ? ex2((float)db * lgf) : ex2((float)(-db) * lgb)); }
        u32x4 w; w.x = pk2(pa[0], pa[1]); w.y = pk2(pa[2], pa[3]); w.z = pk2(pb[0], pb[1]); w.w = pk2(pb[2], pb[3]); pf[kk] = as_bf16x8(w);
    }
    const float cf = ex2((float)(ii + 1) * lgf), cb = ex2((float)(128 - ii) * lgb);
    f32x4 O[8]; float s = 0.f, ss = 0.f;
#pragma unroll
    for (int et = 0; et < 8; ++et) {
        f32x4 acc = (f32x4){0.f, 0.f, 0.f, 0.f}, xf = (f32x4){0.f, 0.f, 0.f, 0.f}, xb = (f32x4){0.f, 0.f, 0.f, 0.f};
#pragma unroll
        for (int kk = 0; kk < 4; ++kk) { const u32x2 v0 = *(const LAS u32x2*)(vT + (16 * et + c) * 272 + (32 * kk + 4 * g4) * 2), v1 = *(const LAS u32x2*)(vT + (16 * et + c) * 272 + (32 * kk + 16 + 4 * g4) * 2);
            u32x4 vv; vv.x = v0.x; vv.y = v0.y; vv.z = v1.x; vv.w = v1.y; acc = mfma16(as_bf16x8(vv), pf[kk], acc); }
#pragma unroll
        for (int ks = 0; ks < 2; ++ks) { xf = mfma16(*(const LAS bf16x8*)(Sl + (16 * et + c) * 272 + (32 * ks + 8 * g4) * 2), qf[ks], xf);
            xb = mfma16(*(const LAS bf16x8*)(Sl + (16 * et + c) * 272 + (64 + 32 * ks + 8 * g4) * 2), qf[ks], xb); }
        acc = acc + xf * cf + xb * cb; O[et] = acc;
        s += (acc[0] + acc[1]) + (acc[2] + acc[3]); ss += (acc[0] * acc[0] + acc[1] * acc[1]) + (acc[2] * acc[2] + acc[3] * acc[3]);
    }
    s = sum_x16_x32(s); ss = sum_x16_x32(ss);
    const float mean = s * (1.f / 128.f), var = fmaxf(ss * (1.f / 128.f) - mean * mean, 0.f), rstd = 1.0f / sqrtf(var + EPS);
    const bf16* gsrc = ZA + (size_t)(r0 + ii) * NZA + C_RG + 128 * h + 4 * g4; bf16* dst = BR + (size_t)(r0 + ii) * 512 + 128 * h + 4 * g4;
#pragma unroll
    for (int et = 0; et < 8; ++et) { const u32x2 gw = *(const u32x2*)(gsrc + 16 * et); const float g0 = bflo(gw.x), g1 = bfhi(gw.x), g2 = bflo(gw.y), g3 = bfhi(gw.y);
        const float o0 = (O[et][0] - mean) * rstd * g0 * sigmoidf_(g0), o1 = (O[et][1] - mean) * rstd * g1 * sigmoidf_(g1), o2 = (O[et][2] - mean) * rstd * g2 * sigmoidf_(g2), o3 = (O[et][3] - mean) * rstd * g3 * sigmoidf_(g3);
        u32x2 w; w.x = pk2(o0, o1); w.y = pk2(o2, o3); *(u32x2*)(dst + 16 * et) = w; }
    __syncthreads();
}

__device__ __forceinline__ int wr_off(int k) { return k * 64 + (k >> 2) * 16; }
__device__ __forceinline__ void phase_norm2(KPC p, int l, LAS unsigned char* lds, int tid, int lane, int wave, int bid, int G) {
    convert_experts(p, l, lds, lane, wave, bid, G);
    LAS unsigned char* wrl = lds + 69632;
    for (int i = tid; i < 1024 * 4; i += 512) { const int k = i >> 2, q = i & 3; *(LAS f32x4*)(wrl + wr_off(k) + 16 * q) = *(const f32x4*)(p->w_router + (size_t)l * 16384 + k * 16 + 4 * q); }
    __syncthreads();
    const float* modv = (const float*)(p->ws + WS_MODV) + l * 9 * 6144; const float* X = (const float*)(p->ws + WS_X); bf16* H = (bf16*)(p->ws + WS_H);
    float* AFF = (float*)(p->ws + WS_AFF); float* AFFC = (float*)(p->ws + WS_AFFC); int* INV = (int*)(p->ws + WS_INV);
    const int rows = (l == 0) ? M : ML;
    for (int r = bid * 8 + wave; r < rows; r += G * 8) {
        const int bi = (r < ML) ? (r >> 12) : 8;
        f32x4 v[4], h[4];
#pragma unroll
        for (int j = 0; j < 4; ++j) v[j] = *(const f32x4*)(X + (size_t)r * 1024 + 4 * lane + 256 * j);
        const float rs = row_rs(v);
        norm_mod(v, rs, p->norm2_g + l * 1024, modv + bi * 6144 + 3 * 1024, modv + bi * 6144 + 4 * 1024, h, lane);
        store_h(h, H + (size_t)r * 1024, lane);
        float lg[16];
#pragma unroll
        for (int e = 0; e < 16; ++e) lg[e] = 0.f;
#pragma unroll
        for (int j = 0; j < 4; ++j)
#pragma unroll
            for (int i = 0; i < 4; ++i) { const int k = 4 * lane + 256 * j + i; const float hv = h[j][i]; const LAS f32x4* wp = (const LAS f32x4*)(wrl + wr_off(k));
#pragma unroll
                for (int q = 0; q < 4; ++q) { const f32x4 w = wp[q]; lg[4 * q] += hv * w.x; lg[4 * q + 1] += hv * w.y; lg[4 * q + 2] += hv * w.z; lg[4 * q + 3] += hv * w.w; } }
        float mx = -1e30f;
#pragma unroll
        for (int e = 0; e < 16; ++e) { lg[e] = wave_sum(lg[e]); mx = fmaxf(mx, lg[e]); }
        float sum = 0.f;
#pragma unroll
        for (int e = 0; e < 16; ++e) { lg[e] = ex2((lg[e] - mx) * LOG2E); sum += lg[e]; }
        const float isum = 1.0f / sum; float mine = 0.f;
#pragma unroll
        for (int e = 0; e < 16; ++e) mine = (lane == e) ? lg[e] * isum : mine;
        if (lane < 16) { if (r < ML) AFF[((size_t)(bi * 16 + lane) << 12) + (r & 4095)] = mine; else AFFC[((r - ML) >> 8) * 4096 + lane * 256 + ((r - ML) & 255)] = mine;
            INV[(size_t)r * 16 + lane] = -1; }
    }
}

__device__ __forceinline__ int block_sum_i(int v, LAS int* red, int lane, int wave) {
    v = wave_sum_i(v);
    __syncthreads();
    if (lane == 0) red[wave] = v;
    __syncthreads();
    int s = 0;
#pragma unroll
    for (int w = 0; w < 8; ++w) s += red[w];
    return s;
}
__device__ __forceinline__ int block_excl_scan(int v, LAS int* red, int lane, int wave) {
    int inc = v;
#pragma unroll
    for (int o = 1; o < 64; o <<= 1) { const int t = __builtin_amdgcn_ds_bpermute((lane - o) << 2, inc); if (lane >= o) inc += t; }
    __syncthreads();
    if (lane == 63) red[wave] = inc;
    __syncthreads();
    int base = 0;
#pragma unroll
    for (int w = 0; w < 8; ++w) { const int x = red[w]; if (w < wave) base += x; }
    return base + inc - v;
}
template <int KPT>
__device__ __forceinline__ void topk_item(KPC p, const float* aff, int n, int cap, int rowbase, int e, int slotbase, LAS unsigned char* lds, int tid, int lane, int wave) {
    const bf16* H = (const bf16*)(p->ws + WS_H); bf16* XS = (bf16*)(p->ws + WS_XS); float* topw = (float*)(p->ws + WS_TOPW); int* INV = (int*)(p->ws + WS_INV);
    LAS int* red = (LAS int*)lds; LAS int* rl = (LAS int*)(lds + 64);
    unsigned key[KPT]; const bool valid = tid * KPT < n;
#pragma unroll
    for (int j = 0; j < KPT; ++j) key[j] = valid ? __float_as_uint(aff[tid * KPT + j]) : 0u;
    unsigned Tsel = 0u;
    for (int bit = 30; bit >= 0; --bit) { const unsigned cand = Tsel | (1u << bit); int cnt = 0;
#pragma unroll
        for (int j = 0; j < KPT; ++j) cnt += (valid && key[j] >= cand) ? 1 : 0;
        if (block_sum_i(cnt, red, lane, wave) >= cap) Tsel = cand; }
    int cgt = 0, ceq = 0;
#pragma unroll
    for (int j = 0; j < KPT; ++j) { cgt += (valid && key[j] > Tsel) ? 1 : 0; ceq += (valid && key[j] == Tsel) ? 1 : 0; }
    const int need = cap - block_sum_i(cgt, red, lane, wave);
    int er = block_excl_scan(ceq, red, lane, wave);
    bool sel[KPT]; int nsel = 0;
#pragma unroll
    for (int j = 0; j < KPT; ++j) { const bool iseq = valid && key[j] == Tsel; sel[j] = valid && (key[j] > Tsel || (iseq && er < need)); er += iseq ? 1 : 0; nsel += sel[j] ? 1 : 0; }
    int slot = block_excl_scan(nsel, red, lane, wave);
#pragma unroll
    for (int j = 0; j < KPT; ++j) if (sel[j]) { const int t = tid * KPT + j; if (slot < cap) { rl[slot] = t; topw[e * ME + slotbase + slot] = __uint_as_float(key[j]); INV[(size_t)(rowbase + t) * 16 + e] = slotbase + slot; } ++slot; }
    __syncthreads();
    for (int s = wave; s < cap; s += 8) { const int t = rl[s]; const u32x4* src = (const u32x4*)(H + (size_t)(rowbase + t) * 1024); u32x4* dst = (u32x4*)(XS + ((size_t)e * ME + slotbase + s) * 1024);
        dst[lane] = src[lane]; dst[lane + 64] = src[lane + 64]; }
    __syncthreads();
}
__device__ __forceinline__ void phase_topk(KPC p, int l, LAS unsigned char* lds, int tid, int lane, int wave, int bid, int G) {
    const float* AFF = (const float*)(p->ws + WS_AFF); const float* AFFC = (const float*)(p->ws + WS_AFFC);
    const int nitem = (l == 0) ? 256 : 128;
    for (int it = bid; it < nitem; it += G) {
        if (it < 128) { const int b = it >> 4, e = it & 15; topk_item<8>(p, AFF + ((size_t)(b * 16 + e) << 12), 4096, CAPL, b * T, e, b * CAPL, lds, tid, lane, wave); }
        else { const int q = it - 128, b = q >> 4, e = q & 15; topk_item<1>(p, AFFC + (b * 16 + e) * 256, 256, CAPC, ML + b * CL, e, NB * CAPL + b * CAPC, lds, tid, lane, wave); }
    }
}

__device__ __forceinline__ void phase_combine(KPC p, int l, LAS unsigned char* lds, int tid, int lane, int wave, int bid, int G) {
    const float* modv = (const float*)(p->ws + WS_MODV); float* X = (float*)(p->ws + WS_X); bf16* H = (bf16*)(p->ws + WS_H);
    const bf16* Y = (const bf16*)(p->ws + WS_XS); const int* INV = (const int*)(p->ws + WS_INV);
    const int rows = (l == 0) ? M : ML;
    for (int r = bid * 8 + wave; r < rows; r += G * 8) {
        const int bi = (r < ML) ? (r >> 12) : 8;
        f32x4 v[4], acc[4];
#pragma unroll
        for (int j = 0; j < 4; ++j) { v[j] = *(const f32x4*)(X + (size_t)r * 1024 + 4 * lane + 256 * j); acc[j] = (f32x4){0.f, 0.f, 0.f, 0.f}; }
        const int myslot = (lane < 16) ? INV[(size_t)r * 16 + lane] : -1;
#pragma unroll 1
        for (int e = 0; e < 16; ++e) { const int s = __builtin_amdgcn_readlane(myslot, e);
            if (s >= 0) { const bf16* y = Y + ((size_t)e * ME + s) * 1024;
#pragma unroll
                for (int j = 0; j < 4; ++j) { const u32x2 w = *(const u32x2*)(y + 4 * lane + 256 * j); acc[j] += (f32x4){bflo(w.x), bfhi(w.x), bflo(w.y), bfhi(w.y)}; } } }
        const float* g2 = modv + (l * 9 + bi) * 6144 + 5 * 1024;
#pragma unroll
        for (int j = 0; j < 4; ++j) v[j] = v[j] + *(const f32x4*)(g2 + 4 * lane + 256 * j) * acc[j];
        if (l == 0) {
#pragma unroll
            for (int j = 0; j < 4; ++j) *(f32x4*)(X + (size_t)r * 1024 + 4 * lane + 256 * j) = v[j];
            const float rs = row_rs(v); f32x4 h[4];
            norm_mod(v, rs, p->norm1_g + 1024, modv + (9 + bi) * 6144, modv + (9 + bi) * 6144 + 1024, h, lane);
            store_h(h, H + (size_t)r * 1024, lane);
        } else {
#pragma unroll
            for (int j = 0; j < 4; ++j) *(f32x4*)(p->out + (size_t)r * 1024 + 4 * lane + 256 * j) = v[j];
        }
    }
    if (l == 0) convert_small(p, 1, lds, lane, wave, bid, G);
}

#define XB_TMO      128
#define XB_XCNT(j)  (256  + 64 * (j))
#define XB_XSUB(j)  (1280 + 64 * (j))
#define XB_XGEN(j)  (2304 + 64 * (j))
#define XB_TOP      3328
#define XB_TOPGEN   3392
#define XCD_BAR_WORDS 3456
#define XB_SPIN_CAP (1u << 18)

__device__ __forceinline__ unsigned xb_ld(unsigned* p)              { return __hip_atomic_load(p, __ATOMIC_RELAXED, __HIP_MEMORY_SCOPE_AGENT); }
__device__ __forceinline__ unsigned xb_add(unsigned* p, unsigned v) { return __hip_atomic_fetch_add(p, v, __ATOMIC_RELAXED, __HIP_MEMORY_SCOPE_AGENT); }
__device__ __forceinline__ unsigned xb_xcc_id() { return (unsigned)__builtin_amdgcn_s_getreg((3 << 11) | 20) & 0xFu; }
#define XB_SPIN(cond, bar) do { unsigned _sp = 0; while (cond) { __builtin_amdgcn_s_sleep(1); \
    if ((++_sp & 255u) == 0u) { if (xb_ld(&(bar)[XB_TMO])) break; if (_sp > XB_SPIN_CAP) { atomicAdd(&(bar)[XB_TMO], 1u); break; } } } } while (0)

struct XcdBarrier {
    unsigned* bar; unsigned x;
    volatile LAS unsigned* st;
};

__device__ __forceinline__ XcdBarrier xcd_barrier_post(unsigned* bar, volatile LAS unsigned* st) {
    XcdBarrier b; b.bar = bar; b.x = xb_xcc_id(); b.st = st;
    if (threadIdx.x == 0) (void)xb_add(&bar[XB_XCNT(b.x)], 1u);
    return b;
}
__device__ __forceinline__ void xcd_barrier_complete(unsigned* bar, unsigned x, unsigned& nloc, unsigned& nx) {
    const unsigned G = gridDim.x * gridDim.y * gridDim.z;
    unsigned sum, cnt, mine, sp = 0u;
    for (;;) {
        sum = 0u; cnt = 0u; mine = 0u;
#pragma unroll
        for (unsigned j = 0; j < 16; ++j) { const unsigned c = xb_ld(&bar[XB_XCNT(j)]); sum += c; cnt += (c > 0u) ? 1u : 0u; mine = (j == x) ? c : mine; }
        if (sum == G) break;
        __builtin_amdgcn_s_sleep(1);
        if ((++sp & 255u) == 0u) { if (xb_ld(&bar[XB_TMO])) break; if (sp > XB_SPIN_CAP) { atomicAdd(&bar[XB_TMO], 1u); break; } }
    }
    nloc = mine > 0u ? mine : 1u; nx = cnt > 0u ? cnt : 1u;
}

__device__ __forceinline__ void xcd_barrier(const XcdBarrier& b) {
    asm volatile("s_waitcnt vmcnt(0)" ::: "memory");
    __syncthreads();
    if (threadIdx.x == 0) {
        unsigned* bar = b.bar;
        __builtin_amdgcn_s_waitcnt(0);
        unsigned nloc = b.st[0], nx = b.st[1];
        if (nloc == 0u) { xcd_barrier_complete(bar, b.x, nloc, nx); b.st[0] = nloc; b.st[1] = nx; }
        const unsigned old = xb_add(&bar[XB_XSUB(b.x)], 1u);
        const unsigned gen = old / nloc;
        if (old + 1u == (gen + 1u) * nloc) {
            __builtin_amdgcn_fence(__ATOMIC_RELEASE, "agent");
            asm volatile("s_waitcnt vmcnt(0)" ::: "memory");
            const unsigned og = xb_add(&bar[XB_TOP], 1u);
            const unsigned tg = og / nx;
            if (og + 1u == (tg + 1u) * nx) xb_add(&bar[XB_TOPGEN], 1u);
            else XB_SPIN(xb_ld(&bar[XB_TOPGEN]) == tg, bar);
            __builtin_amdgcn_fence(__ATOMIC_ACQUIRE, "agent");
            xb_add(&bar[XB_XGEN(b.x)], 1u);
            asm volatile("s_waitcnt vmcnt(0)" ::: "memory");
        } else {
            XB_SPIN(xb_ld(&bar[XB_XGEN(b.x)]) == gen, bar);
            __builtin_amdgcn_fence(__ATOMIC_ACQUIRE, "agent");
            asm volatile("s_waitcnt vmcnt(0)" ::: "memory");
        }
    }
    __syncthreads();
}

#ifndef REP_MIX
#define REP_MIX 1
#endif
#ifndef REP_RO
#define REP_RO 1
#endif
#ifndef REP_N2
#define REP_N2 1
#endif
#ifndef REP_GEMM
#define REP_GEMM 1
#endif
#ifndef REP_SYNC
#define REP_SYNC 1
#endif
#ifndef EN_GEMM
#define EN_GEMM 0x3f
#endif
#ifndef EN_ATT
#define EN_ATT 1
#endif
#ifndef EN_UPD
#define EN_UPD 1
#endif
#ifndef EN_SGU
#define EN_SGU 1
#endif
#ifndef EN_RO
#define EN_RO 1
#endif
#ifndef EN_MISC
#define EN_MISC 1
#endif
#define KPP() ({ KPC q_ = kp_; asm volatile("" : "+s"(q_)); q_; })
__global__ void __launch_bounds__(512, 2) mk_fwd(KP p_unused) {
    extern __shared__ __attribute__((aligned(16))) unsigned char lds_raw[];
    LAS unsigned char* lds = (LAS unsigned char*)lds_raw;
    cg::grid_group grid = cg::this_grid();
    const int bid = blockIdx.x, G = gridDim.x;
#define IDS() int tid = threadIdx.x; asm volatile("" : "+v"(tid)); const int lane = tid & 63, wave = __builtin_amdgcn_readfirstlane(tid >> 6); (void)lane; (void)wave
    const KPC kp_ = (KPC)__builtin_amdgcn_kernarg_segment_ptr();
    volatile LAS unsigned* bst = (volatile LAS unsigned*)(lds + 147392);
    if (threadIdx.x < 16) bst[threadIdx.x] = 0u;
    __syncthreads();
    (void)xcd_barrier_post((unsigned*)KPP()->ws, bst);
#define GSYNC() do { XcdBarrier b_; b_.bar = (unsigned*)KPP()->ws; b_.x = xb_xcc_id(); b_.st = bst; xcd_barrier(b_); } while (0)

    { IDS(); if (EN_MISC) phase_prep(KPP(), lds, tid, lane, wave, bid, G); }
    grid.sync();
    { IDS(); if (EN_MISC) phase_norm_in(KPP(), lane, wave, bid, G); }
    GSYNC();
#pragma unroll 1
    for (int l = 0; l < 2; ++l) {
        {
            unsigned char* ws = KPP()->ws;
            pg8::Gemm g{(const pg8::bf16_t*)(ws + WS_H), (const pg8::bf16_t*)(ws + WS_WTIN), M, NZA, 1024}; GroupOrder S{1, M / 256, NZA / 256, 0, 0, G, bid};
            pg8::EpiBf16<0> E{(pg8::bf16_t*)(ws + WS_ZA), NZA, nullptr, 0, 0, 1.f};
            for (int rep = 0; rep < REP_GEMM; ++rep) pg8::gemm_phase<pg8::EpiBf16<0>, GroupOrder, true, true>(lds, g, S, E);
        }
        GSYNC();
        {
            KPC p = KPP(); IDS();
            float mq = fabsf(p->qn_g[l * 64 + lane]), mk = fabsf(p->kn_g[l * 64 + lane]);
            mq = wave_max(mq); mk = wave_max(mk);
            const float Mb2 = 8.0f * mq * mk * LOG2E;
            const int natt = (l == 0) ? 544 : 512, nupd = NB * NCH * 4, nsgu = ((l == 0) ? (M / 128) : (ML / 128)) * 4;
            for (int rep = 0; rep < REP_MIX; ++rep)
            for (int it = bid; it < natt + nupd + nsgu; it += G) {
                if (it < natt) { if (EN_ATT) att_item(p, l, lds, it, Mb2, tid, lane, wave); }
                else if (it < natt + nupd) { if (EN_UPD) ret_upd_item(p, l, lds, it - natt, tid, lane, wave); }
                else { if (EN_SGU) sgu_item(p, l, lds, it - natt - nupd, tid, lane, wave); }
            }
        }
        GSYNC();
        { IDS(); for (int rep = 0; rep < REP_RO; ++rep) phase_scan(KPP(), l, tid, bid, G); }
        GSYNC();
        {   KPC p = KPP(); IDS(); const int nch = (l == 0) ? NCH : 32;
            for (int rep = 0; rep < REP_RO; ++rep)
            for (int it = bid; it < NB * nch * 4; it += G) { const int b = it / (nch * 4), rem = it % (nch * 4); if (EN_RO) ret_out_item(p, l, lds, b * (NCH * 4) + rem, tid, lane, wave); }
        }
        GSYNC();
        const int Mrows = (l == 0) ? M : ML;
        {
            unsigned char* ws = KPP()->ws;
            pg8::Gemm g{(const pg8::bf16_t*)(ws + WS_H), (const pg8::bf16_t*)(ws + WS_WTIN) + (size_t)NZA * 1024, Mrows, NZG, 1024}; GroupOrder S{1, Mrows / 256, NZG / 256, 0, 0, G, bid};
            pg8::EpiBf16<0> E{(pg8::bf16_t*)(ws + WS_G), NZG, nullptr, 0, 0, 1.f};
            for (int rep = 0; rep < REP_GEMM; ++rep) pg8::gemm_phase<pg8::EpiBf16<0>, GroupOrder, true, true>(lds, g, S, E);
        }
        GSYNC();
        {
            KPC p = KPP(); unsigned char* ws = p->ws;
            pg8::Gemm g{(const pg8::bf16_t*)p->out, (const pg8::bf16_t*)(ws + WS_WTBR), 3 * M, 3072, 512}; MergeOrder S{Mrows / 256, G, bid};
            EpiMerge E{(const bf16*)(ws + WS_G), (bf16*)(ws + WS_H)};
            for (int rep = 0; rep < REP_GEMM; ++rep) pg8::gemm_phase<EpiMerge, MergeOrder, true, true>(lds, g, S, E);
        }
        GSYNC();
        {
            KPC p = KPP(); unsigned char* ws = p->ws;
            pg8::Gemm g{(const pg8::bf16_t*)(ws + WS_H), (const pg8::bf16_t*)(ws + WS_WTOUT), Mrows, 1024, 1024}; GroupOrder S{1, Mrows / 256, 4, 0, 0, G, bid};
            EpiOut E{(l == 0) ? p->x : (const float*)(ws + WS_X), (l == 0) ? p->ctx : (const float*)(ws + WS_X) + (size_t)ML * 1024, (float*)(ws + WS_X), (const float*)(ws + WS_MODV) + l * 9 * 6144};
            pg8::gemm_phase<EpiOut, GroupOrder, true, true>(lds, g, S, E);
        }
        GSYNC();
        { IDS(); for (int rep = 0; rep < REP_N2; ++rep) { phase_norm2(KPP(), l, lds, tid, lane, wave, bid, G); __syncthreads(); } }
        GSYNC();
        { IDS(); for (int rep = 0; rep < REP_N2; ++rep) phase_topk(KPP(), l, lds, tid, lane, wave, bid, G); }
        GSYNC();
        {
            unsigned char* ws = KPP()->ws;
            pg8::Gemm g{(const pg8::bf16_t*)(ws + WS_XS), (const pg8::bf16_t*)(ws + WS_WT1), NE * ME, NE * 2048, 1024}; GroupOrder S{NE, (l == 0) ? 17 : 16, 8, 17, 8, G, bid};
            EpiMoe1 E{(bf16*)(ws + WS_ACT)};
            for (int rep = 0; rep < REP_GEMM; ++rep) pg8::gemm_phase<EpiMoe1, GroupOrder, true, true>(lds, g, S, E);
        }
        GSYNC();
        {
            unsigned char* ws = KPP()->ws;
            pg8::Gemm g{(const pg8::bf16_t*)(ws + WS_ACT), (const pg8::bf16_t*)(ws + WS_WT2), NE * ME, NE * 1024, 1024}; GroupOrder S{NE, (l == 0) ? 17 : 16, 4, 17, 4, G, bid};
            EpiMoe2 E{(bf16*)(ws + WS_XS), (const float*)(ws + WS_TOPW)};
            for (int rep = 0; rep < REP_GEMM; ++rep) pg8::gemm_phase<EpiMoe2, GroupOrder, true, true>(lds, g, S, E);
        }
        GSYNC();
        { IDS(); if (EN_MISC) phase_combine(KPP(), l, lds, tid, lane, wave, bid, G); }
        if (l == 0) GSYNC();
        for (int rep = 1; rep < REP_SYNC; ++rep) { for (int k = 0; k < 12; ++k) GSYNC(); }
    }
}

extern "C" void kernel_launch(void* const* d_in, const int* in_sizes, int n_in, void* d_out, int out_size, void* d_ws, size_t ws_size, hipStream_t stream) {
    static int grid = 0;
    if (grid == 0) {
        if (n_in != 22 || out_size != ML * D || ws_size < WS_END) { fprintf(stderr, "kernel_launch: unexpected shapes (n_in %d out %d ws %zu, need %zu)\n", n_in, out_size, ws_size, (size_t)WS_END); grid = -1; return; }
        int dev = 0, cus = 0, per_cu = 0;
        if (hipGetDevice(&dev) != hipSuccess || hipDeviceGetAttribute(&cus, hipDeviceAttributeMultiprocessorCount, dev) != hipSuccess) { grid = -1; return; }
        if (hipFuncSetAttribute((const void*)mk_fwd, hipFuncAttributeMaxDynamicSharedMemorySize, LDS_BYTES) != hipSuccess) { fprintf(stderr, "kernel_launch: hipFuncSetAttribute failed\n"); grid = -1; return; }
        if (hipOccupancyMaxActiveBlocksPerMultiprocessor(&per_cu, (const void*)mk_fwd, 512, LDS_BYTES) != hipSuccess || per_cu < 1) { fprintf(stderr, "kernel_launch: occupancy query says %d\n", per_cu); (void)hipGetLastError(); }
        grid = cus;
        fprintf(stderr, "kernel_launch: grid %d, occupancy %d/CU, ws %zu\n", grid, per_cu, ws_size);
    }
    if (grid < 0) return;
    if (hipMemsetAsync(d_ws, 0, 16384, stream) != hipSuccess) { fprintf(stderr, "kernel_launch: memset failed\n"); return; }
    KP hp{};
    const float** f = (const float**)&hp;
    for (int i = 0; i < 22; ++i) f[i] = (const float*)d_in[i];
    hp.out = (float*)d_out; hp.ws = (unsigned char*)d_ws;
    void* args[] = {&hp};
    hipError_t e = hipLaunchCooperativeKernel((const void*)mk_fwd, dim3(grid), dim3(512), args, LDS_BYTES, stream);
    if (e != hipSuccess) fprintf(stderr, "kernel_launch: cooperative launch failed: %s\n", hipGetErrorString(e));
}
```

```cpp
#include <hip/hip_runtime.h>
#include <hip/hip_cooperative_groups.h>
#include <cstdio>
#include <cstdint>
namespace cg = cooperative_groups;

namespace pg8 {
#define PG8_LAS __attribute__((address_space(3)))
typedef unsigned short bf16_t;
typedef short bf16x8 __attribute__((ext_vector_type(8)));
typedef float f32x4 __attribute__((ext_vector_type(4)));
typedef unsigned u32x4 __attribute__((ext_vector_type(4)));
constexpr int BM = 256, BK = 64, HALF = 128, HTB = HALF * BK * 2  , STAGE_BYTES = 8 * HTB, NXCD = 8, WGM = 8;

__host__ __device__ __forceinline__ int lds_byte(int r, int c) { const int st = (r >> 4) * 2 + (c >> 5), rr = r & 15, cc = c & 31, ob = rr * 64 + cc * 2; return st * 1024 + (ob ^ (((ob >> 9) & 1) << 5)); }
__host__ __device__ __forceinline__ void stage_rc(int b, int& R, int& C) { const int st = b / 1024, sb = b % 1024, swz = sb ^ (((sb >> 9) & 1) << 5); R = (st >> 1) * 16 + swz / 64; C = (st & 1) * 32 + (swz % 64) / 2; }
__host__ __device__ __forceinline__ int perm32(int rho) { const int n = rho >> 4, i = rho & 15; return 8 * (i >> 2) + 4 * n + (i & 3); }

struct Unit { int pm, pn; };
struct Gemm { const bf16_t* A; const bf16_t* Bt; int M, N, K; };

struct StaticOrder {
    int nM, nN, nwg, G, c;
    __host__ __device__ void init(int M, int N, int G_, int c_) { nM = M / BM; nN = N / BM; nwg = nM * nN; G = G_; c = c_; }
    __host__ __device__ bool next(int i, Unit& u) const {
        const long L = (long)i * G + c; if (L >= nwg) return false;
        int wgid = (int)L; { const int q = nwg / NXCD, r = nwg % NXCD, xcd = wgid % NXCD, off = wgid / NXCD; wgid = (xcd < r ? xcd * (q + 1) : r * (q + 1) + (xcd - r) * q) + off; }
        const int nig = WGM * nN, gid = wgid / nig, fm = gid * WGM, gsz = (nM - fm) < WGM ? (nM - fm) : WGM;
        u.pm = fm + ((wgid % nig) % gsz); u.pn = (wgid % nig) / gsz; return true;
    }
    __device__ __forceinline__ void a_ready(const Unit&) const {}
    __device__ __forceinline__ void done(const Unit&) const {}
};

__device__ __forceinline__ unsigned cvt_pk_bf16(float lo, float hi) { unsigned r; asm volatile("v_cvt_pk_bf16_f32 %0, %1, %2" : "=v"(r) : "v"(lo), "v"(hi)); return r; }
typedef float f32x2 __attribute__((ext_vector_type(2)));
__device__ __forceinline__ f32x2 gelu_pk(f32x2 v) {
    const f32x2 av = __builtin_elementwise_abs(v), d = av * 0.2316418882f + 1.0f;
    f32x2 t; t.x = __builtin_amdgcn_rcpf(d.x); t.y = __builtin_amdgcn_rcpf(d.y);
    f32x2 q = t * 0.5307027145f + (-0.7265760135f); q = q * t + 0.7107068705f; q = q * t + (-0.142248368f); q = q * t + 0.127414796f; q = q * t;
    const f32x2 s = (v * v) * (-0.72134752044f);
    f32x2 e; e.x = __builtin_amdgcn_exp2f(s.x); e.y = __builtin_amdgcn_exp2f(s.y);
    const f32x2 m = v * (q * e), r = v - m;
    f32x2 o; o.x = v.x < 0.f ? m.x : r.x; o.y = v.y < 0.f ? m.y : r.y; return o;
}

template <int ACT  > struct EpiBf16 {
    static constexpr bool PERM = true, AFTER_DRAIN = false; static_assert(ACT == 0 || ACT == 1, "EpiBf16: ACT is 0 (none) or 1 (gelu_pk)");
    bf16_t* O; int ldc; const float* bias; int split_cols; size_t split_stride; float scale0;
    __device__ __forceinline__ void operator()(const f32x4 (&acc)[2][2][4][2], const Unit& u, int wr, int wc, int fr, int fq) const {
        const int row0 = u.pm * BM + wr * 64 + fr; int colt = u.pn * BM; bf16_t* base = O;
        float sc = 1.f; if (split_cols) { const int t = colt / split_cols; base += (size_t)t * split_stride; colt -= t * split_cols; if (t == 0) sc = scale0; }
        const int col0 = colt + wc * 32 + 8 * fq, bcol0 = u.pn * BM + wc * 32 + 8 * fq;
        f32x4 bv[2][2];
#pragma unroll
        for (int bj = 0; bj < 2; ++bj)
#pragma unroll
            for (int n = 0; n < 2; ++n) bv[bj][n] = bias ? *(const f32x4*)(bias + bcol0 + bj * HALF + 4 * n) : (f32x4){0.f, 0.f, 0.f, 0.f};
#pragma unroll
        for (int ai = 0; ai < 2; ++ai)
#pragma unroll
            for (int m = 0; m < 4; ++m) { bf16_t* rowp = base + (size_t)(row0 + ai * HALF + m * 16) * ldc + col0;
#pragma unroll
                for (int bj = 0; bj < 2; ++bj) { f32x4 v0 = acc[ai][bj][m][0] + bv[bj][0], v1 = acc[ai][bj][m][1] + bv[bj][1];
                    if (ACT == 1) { f32x2 a = gelu_pk((f32x2){v0[0], v0[1]}), b = gelu_pk((f32x2){v0[2], v0[3]}), c = gelu_pk((f32x2){v1[0], v1[1]}), d = gelu_pk((f32x2){v1[2], v1[3]});
                        v0 = (f32x4){a.x, a.y, b.x, b.y}; v1 = (f32x4){c.x, c.y, d.x, d.y}; }
                    v0 = v0 * sc; v1 = v1 * sc; u32x4 w; w.x = cvt_pk_bf16(v0[0], v0[1]); w.y = cvt_pk_bf16(v0[2], v0[3]); w.z = cvt_pk_bf16(v1[0], v1[1]); w.w = cvt_pk_bf16(v1[2], v1[3]);
                    *(u32x4*)(rowp + bj * HALF) = w; } }
    }
};
template <class Epi, class Sched, bool ALIGN_EPI = false, bool SP2 = false>
__device__ __forceinline__ void gemm_phase(PG8_LAS unsigned char* lds, const Gemm g, const Sched& S, const Epi& E) {
    int tid_ = threadIdx.x; asm volatile("" : "+v"(tid_));
    const int tid = tid_, wid = __builtin_amdgcn_readfirstlane(tid >> 6), lane = tid & 63, wr = wid >> 2, wc = wid & 3, fr = lane & 15, fq = lane >> 4;
    const int K = g.K, nt = K / BK;
    unsigned voffA[2], voffB[2];
#pragma unroll
    for (int i = 0; i < 2; ++i) { int R, C; stage_rc(tid * 16 + i * 8192, R, C); const int Rb = Epi::PERM ? ((R & ~31) + perm32(R & 31)) : R;
        voffA[i] = (unsigned)(R * K + C) * 2u; voffB[i] = (unsigned)(Rb * K + C) * 2u; }
    const size_t kstep = (size_t)(BK * 2);
    const size_t hstep = (size_t)HALF * K * 2;
    const size_t tstep = 2 * hstep;
    const unsigned ldsw = (unsigned)wid * 1024u;
    const int aoff = lds_byte(wr * 64 + fr, fq * 8), boff = lds_byte(wc * 32 + fr, fq * 8);
#define PG8_SA(b, h) (((b) * 2 + (h)) * HTB)
#define PG8_SB(b, h) ((4 + (b) * 2 + (h)) * HTB)
#define PG8_STAGE(bufoff, gbase, voff) do { _Pragma("unroll") for (int _i = 0; _i < 2; ++_i) \
        __builtin_amdgcn_global_load_lds((const unsigned*)((const char*)(gbase) + (voff)[_i]), (PG8_LAS unsigned*)(lds + (bufoff) + ldsw + _i * 8192), 16, 0, 0); } while (0)
#define PG8_LDA(dst, b, h) do { _Pragma("unroll") for (int m = 0; m < 4; ++m) _Pragma("unroll") for (int k = 0; k < 2; ++k) dst[m][k] = *(const PG8_LAS bf16x8*)(lds + PG8_SA(b, h) + aoff + m * 2048 + k * 1024); } while (0)
#define PG8_LDB(dst, b, h) do { _Pragma("unroll") for (int n = 0; n < 2; ++n) _Pragma("unroll") for (int k = 0; k < 2; ++k) dst[n][k] = *(const PG8_LAS bf16x8*)(lds + PG8_SB(b, h) + boff + n * 2048 + k * 1024); } while (0)
#define PG8_MMA(ai, bj, At, Bt) do { __builtin_amdgcn_s_setprio(1); _Pragma("unroll") for (int m = 0; m < 4; ++m) _Pragma("unroll") for (int n = 0; n < 2; ++n) _Pragma("unroll") for (int k = 0; k < 2; ++k) \
        acc[ai][bj][m][n] = __builtin_amdgcn_mfma_f32_16x16x32_bf16(Bt[n][k], At[m][k], acc[ai][bj][m][n], 0, 0, 0); __builtin_amdgcn_s_setprio(0); } while (0)
#define PG8_WAIT_V(n) asm volatile("s_waitcnt vmcnt(" #n ")" ::: "memory")
#define PG8_WAIT_L(n) asm volatile("s_waitcnt lgkmcnt(" #n ")" ::: "memory")
#define PG8_BAR __builtin_amdgcn_s_barrier()
#define PG8_SCHED __builtin_amdgcn_sched_barrier(0)
    Unit cur, nxt; int ui = 0;
    if (!S.next(0, cur)) return;
    f32x4 acc[2][2][4][2];
#pragma unroll
    for (int a = 0; a < 2; ++a)
#pragma unroll
        for (int b = 0; b < 2; ++b)
#pragma unroll
            for (int m = 0; m < 4; ++m)
#pragma unroll
                for (int n = 0; n < 2; ++n) acc[a][b][m][n] = (f32x4){0.f, 0.f, 0.f, 0.f};
    bf16x8 At[4][2], B0[2][2], B1[2][2];
    const char* cA = (const char*)g.A + (size_t)cur.pm * tstep; const char* cB = (const char*)g.Bt + (size_t)cur.pn * tstep;
    S.a_ready(cur);
    if constexpr (SP2) {
        PG8_STAGE(PG8_SB(0, 0), cB, voffB); PG8_STAGE(PG8_SB(0, 1), cB + hstep, voffB); PG8_STAGE(PG8_SA(0, 0), cA, voffA); PG8_STAGE(PG8_SA(0, 1), cA + hstep, voffA);
        if (wr == 1) PG8_BAR;
        PG8_WAIT_V(2); PG8_BAR;
        PG8_STAGE(PG8_SB(1, 0), cB + kstep, voffB); PG8_STAGE(PG8_SA(1, 0), cA + kstep, voffA); PG8_STAGE(PG8_SB(1, 1), cB + hstep + kstep, voffB);
        PG8_WAIT_V(6); PG8_BAR;
    } else {
        PG8_STAGE(PG8_SB(0, 0), cB, voffB); PG8_STAGE(PG8_SA(0, 0), cA, voffA); PG8_STAGE(PG8_SB(0, 1), cB + hstep, voffB); PG8_STAGE(PG8_SA(0, 1), cA + hstep, voffA);
        if (wr == 1) PG8_BAR;
        PG8_WAIT_V(4); PG8_BAR;
        PG8_STAGE(PG8_SB(1, 0), cB + kstep, voffB); PG8_STAGE(PG8_SA(1, 0), cA + kstep, voffA); PG8_STAGE(PG8_SB(1, 1), cB + hstep + kstep, voffB);
        PG8_WAIT_V(6); PG8_BAR;
    }
    for (;;) {
        const bool has_next = S.next(ui + 1, nxt);
        const char* nA = has_next ? (const char*)g.A + (size_t)nxt.pm * tstep : cA; const char* nB = has_next ? (const char*)g.Bt + (size_t)nxt.pn * tstep : cB;
        for (int t = 0; t < nt; t += 2) {
            const bool last = (t == nt - 2);
            const char* a1 = cA + (size_t)(t + 1) * kstep;
            const char* a2 = last ? nA : cA + (size_t)(t + 2) * kstep; const char* b2 = last ? nB : cB + (size_t)(t + 2) * kstep;
            const char* a3 = a2 + kstep; const char* b3 = b2 + kstep;
            if (last && has_next) S.a_ready(nxt);
            if constexpr (SP2) {
            PG8_LDB(B0, 0, 0); PG8_LDB(B1, 0, 1); PG8_SCHED; PG8_LDA(At, 0, 0); PG8_STAGE(PG8_SA(1, 1), a1 + hstep, voffA);
            PG8_WAIT_V(8); PG8_WAIT_L(0); PG8_BAR; PG8_MMA(0, 0, At, B0); PG8_MMA(0, 1, At, B1); PG8_BAR; PG8_SCHED;
            PG8_LDA(At, 0, 1); PG8_STAGE(PG8_SB(0, 0), b2, voffB); PG8_STAGE(PG8_SB(0, 1), b2 + hstep, voffB); PG8_STAGE(PG8_SA(0, 0), a2, voffA);
            PG8_WAIT_V(8); PG8_WAIT_L(0); PG8_BAR; PG8_MMA(1, 0, At, B0); PG8_MMA(1, 1, At, B1); PG8_BAR; PG8_SCHED;
            PG8_LDB(B0, 1, 0); PG8_LDB(B1, 1, 1); PG8_SCHED; PG8_LDA(At, 1, 0); PG8_STAGE(PG8_SA(0, 1), a2 + hstep, voffA);
            PG8_WAIT_V(8); PG8_WAIT_L(0); PG8_BAR; PG8_MMA(0, 0, At, B0); PG8_MMA(0, 1, At, B1); PG8_BAR; PG8_SCHED;
            PG8_LDA(At, 1, 1); PG8_STAGE(PG8_SB(1, 0), b3, voffB); PG8_STAGE(PG8_SB(1, 1), b3 + hstep, voffB); PG8_STAGE(PG8_SA(1, 0), a3, voffA);
            PG8_WAIT_V(8); PG8_WAIT_L(0); PG8_BAR; PG8_MMA(1, 0, At, B0); PG8_MMA(1, 1, At, B1); PG8_BAR; PG8_SCHED;
            } else {
            PG8_LDB(B0, 0, 0); PG8_SCHED; PG8_LDA(At, 0, 0); PG8_STAGE(PG8_SA(1, 1), a1 + hstep, voffA);
            PG8_WAIT_L(8); PG8_BAR; PG8_WAIT_L(0); PG8_MMA(0, 0, At, B0); PG8_BAR; PG8_SCHED;
            PG8_LDB(B1, 0, 1); PG8_STAGE(PG8_SB(0, 0), b2, voffB);
            PG8_BAR; PG8_WAIT_L(0); PG8_MMA(0, 1, At, B1); PG8_BAR;
            PG8_LDA(At, 0, 1); PG8_STAGE(PG8_SA(0, 0), a2, voffA);
            PG8_BAR; PG8_WAIT_L(0); PG8_MMA(1, 0, At, B0); PG8_BAR; PG8_SCHED;
            PG8_STAGE(PG8_SB(0, 1), b2 + hstep, voffB);
            PG8_WAIT_V(6); PG8_BAR; PG8_MMA(1, 1, At, B1); PG8_BAR;
            PG8_LDB(B0, 1, 0); PG8_SCHED; PG8_LDA(At, 1, 0); PG8_STAGE(PG8_SA(0, 1), a2 + hstep, voffA);
            PG8_WAIT_L(8); PG8_BAR; PG8_WAIT_L(0); PG8_MMA(0, 0, At, B0); PG8_BAR; PG8_SCHED;
            PG8_LDB(B1, 1, 1); PG8_STAGE(PG8_SB(1, 0), b3, voffB);
            PG8_BAR; PG8_WAIT_L(0); PG8_MMA(0, 1, At, B1); PG8_BAR;
            PG8_LDA(At, 1, 1); PG8_STAGE(PG8_SA(1, 0), a3, voffA);
            PG8_BAR; PG8_WAIT_L(0); PG8_MMA(1, 0, At, B0); PG8_BAR; PG8_SCHED;
            PG8_STAGE(PG8_SB(1, 1), b3 + hstep, voffB);
            PG8_WAIT_V(6); PG8_BAR; PG8_MMA(1, 1, At, B1); PG8_BAR;
            }
        }
        if constexpr (ALIGN_EPI) { if (wr == 0) PG8_BAR; }
        if constexpr (!Epi::AFTER_DRAIN) { E(acc, cur, wr, wc, fr, fq); S.done(cur); }
        if (!has_next) break;
#pragma unroll
        for (int a = 0; a < 2; ++a)
#pragma unroll
            for (int b = 0; b < 2; ++b)
#pragma unroll
                for (int m = 0; m < 4; ++m)
#pragma unroll
                    for (int n = 0; n < 2; ++n) acc[a][b][m][n] = (f32x4){0.f, 0.f, 0.f, 0.f};
        cur = nxt; cA = nA; cB = nB; ++ui;
        if constexpr (ALIGN_EPI) { if (wr == 1) PG8_BAR; }
    }
    PG8_WAIT_V(0);
    if constexpr (!ALIGN_EPI) { if (wr == 0) PG8_BAR; }
    PG8_BAR;
    if constexpr (Epi::AFTER_DRAIN) { E.fused(acc, cur, wr, wc, fr, fq, lds, wid, lane); S.done(cur); }
#undef PG8_SA
#undef PG8_SB
#undef PG8_STAGE
#undef PG8_LDA
#undef PG8_LDB
#undef PG8_MMA
#undef PG8_WAIT_V
#undef PG8_WAIT_L
#undef PG8_BAR
#undef PG8_SCHED
}
}

#define LAS __attribute__((address_space(3)))
typedef unsigned short bf16;
typedef short bf16x8 __attribute__((ext_vector_type(8)));
typedef float f32x4 __attribute__((ext_vector_type(4)));
typedef unsigned u32x4 __attribute__((ext_vector_type(4)));
typedef unsigned u32x2 __attribute__((ext_vector_type(2)));

constexpr int D = 1024, NB = 8, T = 4096, CL = 256;
constexpr int ML = NB * T, MC = NB * CL, M = ML + MC;
constexpr int NZA = 3328, NZG = 3072;
constexpr int C_RQ = 0, C_RK = 256, C_RV = 512, C_RG = 1024, C_SU = 1536, C_SV = 2048, C_AQ = 2560, C_AK = 3072, C_AV = 3200;
constexpr int NE = 16, CAPL = 512, CAPC = 32, ME = NB * (CAPL + CAPC);
constexpr int NCH = 34;
constexpr float EPS = 1e-6f, LOG2E = 1.4426950408889634f;
constexpr int LDS_BYTES = 147456;

constexpr size_t MiB = 1u << 20;
constexpr size_t WS_ROPEC = 1 * MiB, WS_ROPES = 1 * MiB + 512 * 1024, WS_MODV = 2 * MiB, WS_AFF = 3 * MiB, WS_AFFC = 5 * MiB, WS_INV = 6 * MiB, WS_TOPW = 9 * MiB;
constexpr size_t WS_WTIN = 16 * MiB, WS_WTBR = WS_WTIN + (size_t)6400 * 1024 * 2, WS_WTOUT = WS_WTBR + (size_t)3072 * 512 * 2;
constexpr size_t WS_X = 34 * MiB, WS_H = 170 * MiB, WS_R = 238 * MiB;
constexpr size_t WS_ZA = WS_R, WS_G = WS_R, WS_RS = 459 * MiB, WS_ST = 527 * MiB;
constexpr size_t WS_XS = WS_R, WS_ACT = 374 * MiB, WS_WT1 = 510 * MiB, WS_WT2 = 574 * MiB, WS_END = 606 * MiB;
static_assert(WS_WTOUT + 2 * MiB <= WS_X && WS_ZA + (size_t)M * NZA * 2 <= WS_RS && WS_ST + (size_t)NB * 4 * NCH * 128 * 128 * 2 <= WS_END, "ws map");

struct KP {
    const float *x, *c, *ctx, *c_ctx, *w_mod, *b_mod, *norm1_g, *norm2_g, *w_in, *dec_f, *dec_b, *sgu_w, *sgu_b, *qn_g, *kn_g, *sink, *w_branch, *w_out, *w_router, *w_eg, *w_eu, *w_ed;
    float* out; unsigned char* ws;
};
typedef const __attribute__((address_space(4))) KP* KPC;

#define LDS_WAIT() asm volatile("s_waitcnt lgkmcnt(0)" ::: "memory")
__device__ __forceinline__ unsigned pk2(float lo, float hi) { return pg8::cvt_pk_bf16(lo, hi); }
__device__ __forceinline__ float bflo(unsigned w) { return __uint_as_float(w << 16); }
__device__ __forceinline__ float bfhi(unsigned w) { return __uint_as_float(w & 0xffff0000u); }
__device__ __forceinline__ void unpack8(const u32x4 w, float (&f)[8]) { f[0] = bflo(w.x); f[1] = bfhi(w.x); f[2] = bflo(w.y); f[3] = bfhi(w.y); f[4] = bflo(w.z); f[5] = bfhi(w.z); f[6] = bflo(w.w); f[7] = bfhi(w.w); }
__device__ __forceinline__ u32x4 pack8(const float (&f)[8]) { u32x4 o; o.x = pk2(f[0], f[1]); o.y = pk2(f[2], f[3]); o.z = pk2(f[4], f[5]); o.w = pk2(f[6], f[7]); return o; }
template <int MASK> __device__ __forceinline__ float swz_xor(float v) { static_assert(MASK > 0 && MASK < 32, "swz_xor: 1..31"); return __builtin_bit_cast(float, __builtin_amdgcn_ds_swizzle(__builtin_bit_cast(int, v), 0x1f | (MASK << 10))); }
template <int MASK> __device__ __forceinline__ int swz_xor_i(int v) { return __builtin_amdgcn_ds_swizzle(v, 0x1f | (MASK << 10)); }
__device__ __forceinline__ float sum_x32(float v) { const unsigned u = __builtin_bit_cast(unsigned, v); auto r = __builtin_amdgcn_permlane32_swap(u, u, false, false); return __builtin_bit_cast(float, (unsigned)r[0]) + __builtin_bit_cast(float, (unsigned)r[1]); }
__device__ __forceinline__ float max_x32(float v) { const unsigned u = __builtin_bit_cast(unsigned, v); auto r = __builtin_amdgcn_permlane32_swap(u, u, false, false); return fmaxf(__builtin_bit_cast(float, (unsigned)r[0]), __builtin_bit_cast(float, (unsigned)r[1])); }
__device__ __forceinline__ int sum_x32_i(int v) { auto r = __builtin_amdgcn_permlane32_swap((unsigned)v, (unsigned)v, false, false); return (int)r[0] + (int)r[1]; }
__device__ __forceinline__ float wave_sum(float v) { v += swz_xor<1>(v); v += swz_xor<2>(v); v += swz_xor<4>(v); v += swz_xor<8>(v); v += swz_xor<16>(v); return sum_x32(v); }
__device__ __forceinline__ float wave_max(float v) { v = fmaxf(v, swz_xor<1>(v)); v = fmaxf(v, swz_xor<2>(v)); v = fmaxf(v, swz_xor<4>(v)); v = fmaxf(v, swz_xor<8>(v)); v = fmaxf(v, swz_xor<16>(v)); return max_x32(v); }
__device__ __forceinline__ int wave_sum_i(int v) { v += swz_xor_i<1>(v); v += swz_xor_i<2>(v); v += swz_xor_i<4>(v); v += swz_xor_i<8>(v); v += swz_xor_i<16>(v); return sum_x32_i(v); }
__device__ __forceinline__ float sum_x16_x32(float v) { v += swz_xor<16>(v); return sum_x32(v); }
__device__ __forceinline__ float sum_x1_x2(float v) { v += swz_xor<1>(v); v += swz_xor<2>(v); return v; }
__device__ __forceinline__ float ex2(float x) { return __builtin_amdgcn_exp2f(x); }
__device__ __forceinline__ float sigmoidf_(float x) { return 1.f / (1.f + ex2(-x * LOG2E)); }
__device__ __forceinline__ float gelu_tanh(float x) { const float u = 0.7978845608028654f * (x + 0.044715f * x * x * x); return x / (1.f + ex2(-2.f * LOG2E * u)); }
__device__ __forceinline__ f32x4 mfma16(bf16x8 a, bf16x8 b, f32x4 c) { return __builtin_amdgcn_mfma_f32_16x16x32_bf16(a, b, c, 0, 0, 0); }
__device__ __forceinline__ bf16x8 as_bf16x8(u32x4 w) { return __builtin_bit_cast(bf16x8, w); }
__device__ __forceinline__ float log2_sigmoid(float a) { return -log1pf(__expf(-a)) * LOG2E; }

struct GroupOrder {
    int nG, nM, nN, pmS, pnS, G, c;
    __device__ __forceinline__ bool next(int i, pg8::Unit& u) const {
        const long L = (long)i * G + c; const int tot = nG * nM * nN; if (L >= tot) return false;
        int wgid = (int)L; { const int q = tot / 8, r = tot % 8, xcd = wgid % 8, off = wgid / 8; wgid = (xcd < r ? xcd * (q + 1) : r * (q + 1) + (xcd - r) * q) + off; }
        const int per = nM * nN, g = wgid / per, rem = wgid - g * per;
        const int nig = 8 * nN, gid = rem / nig, fm = gid * 8, gsz = (nM - fm) < 8 ? (nM - fm) : 8;
        u.pm = g * pmS + fm + ((rem % nig) % gsz); u.pn = g * pnS + (rem % nig) / gsz; return true;
    }
    __device__ __forceinline__ void a_ready(const pg8::Unit&) const {}
    __device__ __forceinline__ void done(const pg8::Unit&) const {}
};
struct MergeOrder {
    int nM, G, c;
    __device__ __forceinline__ bool next(int i, pg8::Unit& u) const {
        const int ii = i / 3, g = i - 3 * ii; const long L = (long)ii * G + c; const int tot = nM * 4; if (L >= tot) return false;
        int wgid = (int)L; { const int q = tot / 8, r = tot % 8, xcd = wgid % 8, off = wgid / 8; wgid = (xcd < r ? xcd * (q + 1) : r * (q + 1) + (xcd - r) * q) + off; }
        const int nig = 32, gid = wgid / nig, fm = gid * 8, gsz = (nM - fm) < 8 ? (nM - fm) : 8;
        u.pm = g * (M / 256) + fm + ((wgid % nig) % gsz); u.pn = g * 4 + (wgid % nig) / gsz; return true;
    }
    __device__ __forceinline__ void a_ready(const pg8::Unit&) const {}
    __device__ __forceinline__ void done(const pg8::Unit&) const {}
};

struct EpiZA {
    static constexpr bool PERM = true, AFTER_DRAIN = false;
    bf16* O;
    __device__ __forceinline__ void operator()(const f32x4 (&acc)[2][2][4][2], const pg8::Unit& u, int wr, int wc, int fr, int fq) const {
        const int row0 = u.pm * 256 + wr * 64 + fr, col0 = u.pn * 256 + wc * 32 + 8 * fq; const bool act = (u.pn >= 6 && u.pn <= 9);
#pragma unroll
        for (int ai = 0; ai < 2; ++ai)
#pragma unroll
            for (int m = 0; m < 4; ++m) { bf16* rowp = O + (size_t)(row0 + ai * 128 + m * 16) * NZA + col0;
#pragma unroll
                for (int bj = 0; bj < 2; ++bj) { const f32x4 v0 = acc[ai][bj][m][0], v1 = acc[ai][bj][m][1];
                    float o[8] = {v0[0], v0[1], v0[2], v0[3], v1[0], v1[1], v1[2], v1[3]};
                    if (act) {
#pragma unroll
                        for (int k = 0; k < 8; ++k) o[k] = gelu_tanh(o[k]); }
                    *(u32x4*)(rowp + bj * 128) = pack8(o); } }
    }
};
struct EpiMerge {
    static constexpr bool PERM = true, AFTER_DRAIN = false;
    const bf16* Gt; bf16* Hm;
    __device__ __forceinline__ void operator()(const f32x4 (&acc)[2][2][4][2], const pg8::Unit& u, int wr, int wc, int fr, int fq) const {
        const int g = u.pm / (M / 256), m = u.pm - g * (M / 256), n = u.pn - g * 4;
        const int row0 = m * 256 + wr * 64 + fr, col0 = n * 256 + wc * 32 + 8 * fq;
#pragma unroll
        for (int ai = 0; ai < 2; ++ai) {
            u32x4 gw[4][2], ow[4][2];
#pragma unroll
            for (int mm = 0; mm < 4; ++mm)
#pragma unroll
                for (int bj = 0; bj < 2; ++bj) gw[mm][bj] = *(const u32x4*)(Gt + (size_t)(row0 + ai * 128 + mm * 16) * NZG + g * 1024 + col0 + bj * 128);
            if (g > 0) {
#pragma unroll
                for (int mm = 0; mm < 4; ++mm)
#pragma unroll
                    for (int bj = 0; bj < 2; ++bj) ow[mm][bj] = *(const u32x4*)(Hm + (size_t)(row0 + ai * 128 + mm * 16) * 1024 + col0 + bj * 128);
            }
#pragma unroll
            for (int mm = 0; mm < 4; ++mm)
#pragma unroll
                for (int bj = 0; bj < 2; ++bj) {
                    float gt[8]; unpack8(gw[mm][bj], gt);
                    const f32x4 v0 = acc[ai][bj][mm][0], v1 = acc[ai][bj][mm][1];
                    float o[8] = {v0[0], v0[1], v0[2], v0[3], v1[0], v1[1], v1[2], v1[3]};
#pragma unroll
                    for (int k = 0; k < 8; ++k) o[k] *= sigmoidf_(gt[k]);
                    if (g > 0) { float od[8]; unpack8(ow[mm][bj], od);
#pragma unroll
                        for (int k = 0; k < 8; ++k) o[k] += od[k]; }
                    *(u32x4*)(Hm + (size_t)(row0 + ai * 128 + mm * 16) * 1024 + col0 + bj * 128) = pack8(o);
                }
        }
    }
};
struct EpiOut {
    static constexpr bool PERM = false, AFTER_DRAIN = false;
    const float* xl; const float* xc; float* X; const float* modv;
    __device__ __forceinline__ void operator()(const f32x4 (&acc)[2][2][4][2], const pg8::Unit& u, int wr, int wc, int fr, int fq) const {
        const int row0 = u.pm * 256 + wr * 64 + fr, col0 = u.pn * 256 + wc * 32 + 4 * fq;
        const int bi = (u.pm * 256 < ML) ? ((u.pm * 256) >> 12) : 8;
        const float* g1 = modv + bi * 6144 + 2 * 1024;
        const float* src0 = (u.pm * 256 < ML) ? xl + (size_t)row0 * 1024 : xc + (size_t)(row0 - ML) * 1024;
        f32x4 gv[2][2];
#pragma unroll
        for (int bj = 0; bj < 2; ++bj)
#pragma unroll
            for (int n = 0; n < 2; ++n) gv[bj][n] = *(const f32x4*)(g1 + col0 + bj * 128 + n * 16);
#pragma unroll
        for (int ai = 0; ai < 2; ++ai) {
            f32x4 xv[4][2][2];
#pragma unroll
            for (int m = 0; m < 4; ++m)
#pragma unroll
                for (int bj = 0; bj < 2; ++bj)
#pragma unroll
                    for (int n = 0; n < 2; ++n) xv[m][bj][n] = *(const f32x4*)(src0 + (size_t)(ai * 128 + m * 16) * 1024 + col0 + bj * 128 + n * 16);
#pragma unroll
            for (int m = 0; m < 4; ++m)
#pragma unroll
                for (int bj = 0; bj < 2; ++bj)
#pragma unroll
                    for (int n = 0; n < 2; ++n) *(f32x4*)(X + (size_t)(row0 + ai * 128 + m * 16) * 1024 + col0 + bj * 128 + n * 16) = xv[m][bj][n] + gv[bj][n] * acc[ai][bj][m][n];
        }
    }
};
struct EpiMoe1 {
    static constexpr bool PERM = true, AFTER_DRAIN = false;
    bf16* ACT;
    __device__ __forceinline__ void operator()(const f32x4 (&acc)[2][2][4][2], const pg8::Unit& u, int wr, int wc, int fr, int fq) const {
        const int row0 = u.pm * 256 + wr * 64 + fr, col0 = (u.pn & 7) * 128 + wc * 32 + 8 * fq;
#pragma unroll
        for (int ai = 0; ai < 2; ++ai)
#pragma unroll
            for (int m = 0; m < 4; ++m) { const size_t r = (size_t)(row0 + ai * 128 + m * 16);
                const f32x4 a0 = acc[ai][0][m][0], a1 = acc[ai][0][m][1], u0 = acc[ai][1][m][0], u1 = acc[ai][1][m][1];
                float o[8];
#pragma unroll
                for (int k = 0; k < 4; ++k) { o[k] = a0[k] * sigmoidf_(a0[k]) * u0[k]; o[4 + k] = a1[k] * sigmoidf_(a1[k]) * u1[k]; }
                *(u32x4*)(ACT + r * 1024 + col0) = pack8(o); }
    }
};
struct EpiMoe2 {
    static constexpr bool PERM = true, AFTER_DRAIN = false;
    bf16* Y; const float* topw;
    __device__ __forceinline__ void operator()(const f32x4 (&acc)[2][2][4][2], const pg8::Unit& u, int wr, int wc, int fr, int fq) const {
        const int row0 = u.pm * 256 + wr * 64 + fr, col0 = (u.pn & 3) * 256 + wc * 32 + 8 * fq;
        float twv[2][4];
#pragma unroll
        for (int ai = 0; ai < 2; ++ai)
#pragma unroll
            for (int m = 0; m < 4; ++m) twv[ai][m] = topw[row0 + ai * 128 + m * 16];
#pragma unroll
        for (int ai = 0; ai < 2; ++ai)
#pragma unroll
            for (int m = 0; m < 4; ++m) { const size_t r = (size_t)(row0 + ai * 128 + m * 16); const float tw = twv[ai][m];
#pragma unroll
                for (int bj = 0; bj < 2; ++bj) { const f32x4 v0 = acc[ai][bj][m][0] * tw, v1 = acc[ai][bj][m][1] * tw;
                    u32x4 w; w.x = pk2(v0[0], v0[1]); w.y = pk2(v0[2], v0[3]); w.z = pk2(v1[0], v1[1]); w.w = pk2(v1[2], v1[3]);
                    *(u32x4*)(Y + r * 1024 + col0 + bj * 128) = w; } }
    }
};

__device__ __forceinline__ void tr_item(const float* W, int N, int k0, int n0, bf16* dst, int K, LAS float* scr, int lane) {
#pragma unroll 8
    for (int i = 0; i < 32; ++i) { const int kk = 2 * i + (lane >> 5); scr[kk * 33 + (lane & 31)] = W[(size_t)(k0 + kk) * N + n0 + (lane & 31)]; }
    LDS_WAIT();
    const int cc = lane & 7;
#pragma unroll
    for (int j = 0; j < 4; ++j) { const int n = (lane >> 3) + 8 * j; const LAS float* s = scr + (8 * cc) * 33 + n;
        u32x4 o; o.x = pk2(s[0 * 33], s[1 * 33]); o.y = pk2(s[2 * 33], s[3 * 33]); o.z = pk2(s[4 * 33], s[5 * 33]); o.w = pk2(s[6 * 33], s[7 * 33]);
        *(u32x4*)(dst + (size_t)n * K + 8 * cc) = o; }
    LDS_WAIT();
}
__device__ __forceinline__ void convert_small(KPC p, int l, LAS unsigned char* lds, int lane, int wave, int bid, int G) {
    LAS float* scr = (LAS float*)(lds + wave * 8448);
    const int gw = bid * 8 + wave, NGW = G * 8;
    constexpr int I_IN = 16 * 200, I_BR = 8 * 32, I_OUT = 16 * 32;
    bf16* wtin = (bf16*)(p->ws + WS_WTIN); bf16* wtbr = (bf16*)(p->ws + WS_WTBR); bf16* wtout = (bf16*)(p->ws + WS_WTOUT);
    for (int it = gw; it < I_IN + 3 * I_BR + I_OUT; it += NGW) {
        int r = it;
        if (r < I_IN) { const int kb = r / 200, nb = r % 200; tr_item(p->w_in + (size_t)l * 1024 * 6400, 6400, 64 * kb, 32 * nb, wtin + (size_t)(32 * nb) * 1024 + 64 * kb, 1024, scr, lane); continue; }
        r -= I_IN;
        if (r < 3 * I_BR) { const int br = r / I_BR, q = r % I_BR, kb = q / 32, nb = q % 32;
            tr_item(p->w_branch + ((size_t)l * 3 + br) * 512 * 1024, 1024, 64 * kb, 32 * nb, wtbr + (size_t)(br * 1024 + 32 * nb) * 512 + 64 * kb, 512, scr, lane); continue; }
        r -= 3 * I_BR;
        { const int kb = r / 32, nb = r % 32; tr_item(p->w_out + (size_t)l * 1024 * 1024, 1024, 64 * kb, 32 * nb, wtout + (size_t)(32 * nb) * 1024 + 64 * kb, 1024, scr, lane); }
    }
}
__device__ __forceinline__ void convert_experts(KPC p, int l, LAS unsigned char* lds, int lane, int wave, int bid, int G) {
    LAS float* scr = (LAS float*)(lds + wave * 8448);
    const int gw = bid * 8 + wave, NGW = G * 8;
    bf16* wt1 = (bf16*)(p->ws + WS_WT1); bf16* wt2 = (bf16*)(p->ws + WS_WT2);
    for (int it = gw; it < NE * 3 * 512; it += NGW) {
        const int e = it / 1536, q = it % 1536, which = q / 512, qq = q % 512, kb = qq / 32, nb = qq % 32, n0 = 32 * nb, k0 = 64 * kb;
        const size_t woff = ((size_t)l * NE + e) * 1024 * 1024;
        if (which == 0) tr_item(p->w_eg + woff, 1024, k0, n0, wt1 + ((size_t)e * 2048 + (n0 >> 7) * 256 + (n0 & 127)) * 1024 + k0, 1024, scr, lane);
        else if (which == 1) tr_item(p->w_eu + woff, 1024, k0, n0, wt1 + ((size_t)e * 2048 + (n0 >> 7) * 256 + 128 + (n0 & 127)) * 1024 + k0, 1024, scr, lane);
        else tr_item(p->w_ed + woff, 1024, k0, n0, wt2 + ((size_t)e * 1024 + n0) * 1024 + k0, 1024, scr, lane);
    }
}

__device__ __forceinline__ void phase_prep(KPC p, LAS unsigned char* lds, int tid, int lane, int wave, int bid, int G) {
    unsigned char* ws = p->ws;
    {   float* rc = (float*)(ws + WS_ROPEC); float* rsn = (float*)(ws + WS_ROPES);
        for (int i = bid * 512 + tid; i < T * 32; i += G * 512) { const int t = i >> 5, f = i & 31; const int pos = (f < 16) ? (t >> 6) : (t & 63); const int fi = f & 15;
            const float inv = ex2(-(float)fi * (13.287712379549449f / 16.f));
            float ang = (float)pos * inv; ang -= 6.283185307179586f * rintf(ang * 0.15915494309189535f);
            rc[i] = __cosf(ang); rsn[i] = __sinf(ang); } }
    {   LAS float* sv = (LAS float*)lds;
        LAS float* red = (LAS float*)(lds + 36864);
        for (int i = tid; i < 9 * 1024; i += 512) { const int r = i >> 10, k = i & 1023; const float v = (r < 8) ? p->c[r * 1024 + k] : p->c_ctx[k]; sv[i] = v * sigmoidf_(v); }
        __syncthreads();
        for (int it = bid; it < 192; it += G) {
            const int l = it / 96, n0 = (it % 96) * 64;
            const float* W = p->w_mod + (size_t)l * 1024 * 6144 + n0 + lane;
            float acc[9];
#pragma unroll
            for (int r = 0; r < 9; ++r) acc[r] = 0.f;
#pragma unroll 4
            for (int k = wave * 128; k < wave * 128 + 128; ++k) { const float wv = W[(size_t)k * 6144];
#pragma unroll
                for (int r = 0; r < 9; ++r) acc[r] += sv[r * 1024 + k] * wv; }
#pragma unroll
            for (int r = 0; r < 9; ++r) red[(wave * 9 + r) * 64 + lane] = acc[r];
            __syncthreads();
            for (int i = tid; i < 576; i += 512) { const int r = i >> 6, ln = i & 63; float s = 0.f;
#pragma unroll
                for (int w = 0; w < 8; ++w) s += red[(w * 9 + r) * 64 + ln];
                s += p->b_mod[l * 6144 + n0 + ln]; ((float*)(ws + WS_MODV))[(l * 9 + r) * 6144 + n0 + ln] = s; }
            __syncthreads();
        }
    }
    __syncthreads();
    convert_small(p, 0, lds, lane, wave, bid, G);
}

__device__ __forceinline__ float row_rs(const f32x4 (&v)[4]) {
    float ss = 0.f;
#pragma unroll
    for (int j = 0; j < 4; ++j) ss += (v[j].x * v[j].x + v[j].y * v[j].y) + (v[j].z * v[j].z + v[j].w * v[j].w);
    return 1.0f / sqrtf(wave_sum(ss) * (1.f / 1024.f) + EPS);
}
__device__ __forceinline__ void norm_mod(const f32x4 (&v)[4], float rs, const float* gain, const float* sh, const float* sc, f32x4 (&h)[4], int lane) {
#pragma unroll
    for (int j = 0; j < 4; ++j) { const int col = 4 * lane + 256 * j; const f32x4 g = *(const f32x4*)(gain + col), a = *(const f32x4*)(sc + col), b = *(const f32x4*)(sh + col);
        h[j] = (v[j] * rs) * g * (a + 1.0f) + b; }
}
__device__ __forceinline__ void store_h(const f32x4 (&h)[4], bf16* hrow, int lane) {
#pragma unroll
    for (int j = 0; j < 4; ++j) { u32x2 w; w.x = pk2(h[j].x, h[j].y); w.y = pk2(h[j].z, h[j].w); *(u32x2*)(hrow + 4 * lane + 256 * j) = w; }
}
__device__ __forceinline__ void phase_norm_in(KPC p, int lane, int wave, int bid, int G) {
    const float* modv = (const float*)(p->ws + WS_MODV); bf16* H = (bf16*)(p->ws + WS_H);
    for (int r = bid * 8 + wave; r < M; r += G * 8) {
        const float* src = (r < ML) ? p->x + (size_t)r * 1024 : p->ctx + (size_t)(r - ML) * 1024; const int bi = (r < ML) ? (r >> 12) : 8;
        f32x4 v[4], h[4];
#pragma unroll
        for (int j = 0; j < 4; ++j) v[j] = *(const f32x4*)(src + 4 * lane + 256 * j);
        const float rs = row_rs(v);
        norm_mod(v, rs, p->norm1_g, modv + bi * 6144, modv + bi * 6144 + 1024, h, lane);
        store_h(h, H + (size_t)r * 1024, lane);
    }
}

__device__ __forceinline__ void att_item(KPC p, int l, LAS unsigned char* lds, int item, float Mb2, int tid, int lane, int wave) {
    const bf16* ZA = (const bf16*)(p->ws + WS_ZA); bf16* BR = (bf16*)p->out + (size_t)2 * M * 512;
    const float* rc = (const float*)(p->ws + WS_ROPEC); const float* rsn = (const float*)(p->ws + WS_ROPES);
    const bool isctx = item >= 512;
    int b, kvh, qb;
    if (!isctx) { b = item >> 6; kvh = (item >> 5) & 1; qb = item & 31; } else { const int ci = item - 512; b = ci >> 2; kvh = (ci >> 1) & 1; qb = ci & 1; }
    const int rowbase = isctx ? ML + b * CL : b * T;
    const int g = wave >> 1, qs = wave & 1, hh = kvh * 4 + g, c = lane & 15, g4 = lane >> 4, q0 = qb * 128 + qs * 64;
    const float* qg = p->qn_g + l * 64; const float* kg = p->kn_g + l * 64;
    LAS unsigned char* Kl = lds; LAS unsigned char* Vt = lds + 18432;
    bf16x8 qf[4][2];
#pragma unroll
    for (int ti = 0; ti < 4; ++ti) {
        const int pos = q0 + 16 * ti + c; const bf16* src = ZA + (size_t)(rowbase + pos) * NZA + C_AQ + hh * 64 + 8 * g4;
        float a[8], bb[8]; unpack8(*(const u32x4*)src, a); unpack8(*(const u32x4*)(src + 32), bb);
        float ss = 0.f;
#pragma unroll
        for (int j = 0; j < 8; ++j) ss += a[j] * a[j] + bb[j] * bb[j];
        ss = sum_x16_x32(ss);
        const float rs = 1.0f / sqrtf(ss * (1.f / 64.f) + EPS);
#pragma unroll
        for (int j = 0; j < 8; ++j) { a[j] *= rs * qg[8 * g4 + j]; bb[j] *= rs * qg[32 + 8 * g4 + j]; }
        if (!isctx) {
#pragma unroll
            for (int j = 0; j < 8; ++j) { const float cs = rc[pos * 32 + 8 * g4 + j], sn = rsn[pos * 32 + 8 * g4 + j]; const float x1 = a[j], x2 = bb[j]; a[j] = x1 * cs - x2 * sn; bb[j] = x1 * sn + x2 * cs; } }
#pragma unroll
        for (int j = 0; j < 8; ++j) { a[j] *= 0.125f * LOG2E; bb[j] *= 0.125f * LOG2E; }
        qf[ti][0] = as_bf16x8(pack8(a)); qf[ti][1] = as_bf16x8(pack8(bb));
        __builtin_amdgcn_sched_barrier(0);
    }
    f32x4 O[4][4]; float lsum[4];
#pragma unroll
    for (int i = 0; i < 4; ++i) { lsum[i] = 0.f;
#pragma unroll
        for (int j = 0; j < 4; ++j) O[i][j] = (f32x4){0.f, 0.f, 0.f, 0.f}; }
    const int ntile = isctx ? 2 : 5;
    for (int kt = 0; kt < ntile; ++kt) {
        int krow0, kpos0 = 0, mode = 0; bool local = false;
        if (isctx) krow0 = ML + b * CL + 128 * kt;
        else if (kt < 3) { const int kb = qb - 1 + kt; if (kb < 0 || kb > 31) continue; krow0 = b * T + kb * 128; kpos0 = kb * 128; local = true; mode = (kt == 0) ? 1 : ((kt == 2) ? 2 : 0); }
        else krow0 = ML + b * CL + 128 * (kt - 3);
        __syncthreads();
        {
            const int key = tid >> 2, q4 = tid & 3; const bf16* src = ZA + (size_t)(krow0 + key) * NZA + C_AK + kvh * 64 + 8 * q4;
            float a[8], bb[8]; unpack8(*(const u32x4*)src, a); unpack8(*(const u32x4*)(src + 32), bb);
            float ss = 0.f;
#pragma unroll
            for (int j = 0; j < 8; ++j) ss += a[j] * a[j] + bb[j] * bb[j];
            ss = sum_x1_x2(ss);
            const float rs = 1.0f / sqrtf(ss * (1.f / 64.f) + EPS);
#pragma unroll
            for (int j = 0; j < 8; ++j) { a[j] *= rs * kg[8 * q4 + j]; bb[j] *= rs * kg[32 + 8 * q4 + j]; }
            if (local) { const int pos = kpos0 + key;
#pragma unroll
                for (int j = 0; j < 8; ++j) { const float cs = rc[pos * 32 + 8 * q4 + j], sn = rsn[pos * 32 + 8 * q4 + j]; const float x1 = a[j], x2 = bb[j]; a[j] = x1 * cs - x2 * sn; bb[j] = x1 * sn + x2 * cs; } }
            *(LAS u32x4*)(Kl + key * 144 + 16 * q4) = pack8(a); *(LAS u32x4*)(Kl + key * 144 + 64 + 16 * q4) = pack8(bb);
            const bf16* vs = ZA + (size_t)(krow0 + key) * NZA + C_AV + kvh * 64 + 16 * q4;
            const u32x4 v0 = *(const u32x4*)vs, v1 = *(const u32x4*)(vs + 8);
            const unsigned vw[8] = {v0.x, v0.y, v0.z, v0.w, v1.x, v1.y, v1.z, v1.w};
#pragma unroll
            for (int j = 0; j < 8; ++j) { *(LAS unsigned short*)(Vt + (16 * q4 + 2 * j) * 272 + key * 2) = (unsigned short)(vw[j] & 0xffffu); *(LAS unsigned short*)(Vt + (16 * q4 + 2 * j + 1) * 272 + key * 2) = (unsigned short)(vw[j] >> 16); }
        }
        __syncthreads();
#pragma unroll 1
        for (int kk = 0; kk < 4; ++kk) {
            bf16x8 ka[2][2];
#pragma unroll
            for (int hf = 0; hf < 2; ++hf)
#pragma unroll
                for (int ks = 0; ks < 2; ++ks) ka[hf][ks] = *(const LAS bf16x8*)(Kl + (32 * kk + 16 * hf + c) * 144 + ks * 64 + g4 * 16);
            bf16x8 pf[4];
#pragma unroll
            for (int ti = 0; ti < 4; ++ti) {
                f32x4 sa = (f32x4){0.f, 0.f, 0.f, 0.f}, sb = (f32x4){0.f, 0.f, 0.f, 0.f};
                sa = mfma16(ka[0][0], qf[ti][0], sa); sa = mfma16(ka[0][1], qf[ti][1], sa);
                sb = mfma16(ka[1][0], qf[ti][0], sb); sb = mfma16(ka[1][1], qf[ti][1], sb);
                const int ii = qs * 64 + 16 * ti + c; float pa[4], pb[4]; const int mlo = (mode == 1) ? ii : -1000, mhi = (mode == 2) ? ii : 1000;
#pragma unroll
                for (int rr = 0; rr < 4; ++rr) { const int ja = 32 * kk + 4 * g4 + rr, jb = ja + 16;
                    pa[rr] = ex2(sa[rr] - Mb2); pb[rr] = ex2(sb[rr] - Mb2);
                    pa[rr] = (ja >= mlo && ja <= mhi) ? pa[rr] : 0.f; pb[rr] = (jb >= mlo && jb <= mhi) ? pb[rr] : 0.f;
                    lsum[ti] += pa[rr] + pb[rr]; }
                u32x4 w; w.x = pk2(pa[0], pa[1]); w.y = pk2(pa[2], pa[3]); w.z = pk2(pb[0], pb[1]); w.w = pk2(pb[2], pb[3]); pf[ti] = as_bf16x8(w);
            }
#pragma unroll
            for (int dt = 0; dt < 4; ++dt) {
                const u32x2 v0 = *(const LAS u32x2*)(Vt + (16 * dt + c) * 272 + (32 * kk + 4 * g4) * 2), v1 = *(const LAS u32x2*)(Vt + (16 * dt + c) * 272 + (32 * kk + 16 + 4 * g4) * 2);
                u32x4 vv; vv.x = v0.x; vv.y = v0.y; vv.z = v1.x; vv.w = v1.y; const bf16x8 va = as_bf16x8(vv);
#pragma unroll
                for (int ti = 0; ti < 4; ++ti) O[dt][ti] = mfma16(va, pf[ti], O[dt][ti]);
            }
        }
    }
    const float sk = ex2(p->sink[l * 8 + hh] * LOG2E - Mb2);
#pragma unroll
    for (int ti = 0; ti < 4; ++ti) { float lt = sum_x16_x32(lsum[ti]); const float inv = 1.0f / (lt + sk);
        bf16* dst = BR + (size_t)(rowbase + q0 + 16 * ti + c) * 512 + hh * 64 + 4 * g4;
#pragma unroll
        for (int dt = 0; dt < 4; ++dt) { const f32x4 o = O[dt][ti] * inv; u32x2 w; w.x = pk2(o[0], o[1]); w.y = pk2(o[2], o[3]); *(u32x2*)(dst + 16 * dt) = w; } }
    __syncthreads();
}

__device__ __forceinline__ void sgu_item(KPC p, int l, LAS unsigned char* lds, int item, int tid, int lane, int wave) {
    const bf16* ZA = (const bf16*)(p->ws + WS_ZA); bf16* BR = (bf16*)p->out + (size_t)1 * M * 512;
    const int ch = item >> 2, g = item & 3, r0 = ch * 128, c = lane & 15, g4 = lane >> 4;
    LAS unsigned char* vT = lds;
    LAS unsigned char* WL = lds + 34816;
    {
        const int j = tid >> 2, q4 = tid & 3; const bf16* src = ZA + (size_t)(r0 + j) * NZA + C_SV + 32 * q4;
        float s = 0.f, ss = 0.f;
#pragma unroll
        for (int k = 0; k < 4; ++k)
#pragma unroll
            for (int q = 0; q < 4; ++q) { float f[8]; unpack8(*(const u32x4*)(src + 128 * k + 8 * q), f);
#pragma unroll
                for (int e = 0; e < 8; ++e) { const float y = f[e]; s += y; ss += y * y; } }
        s = sum_x1_x2(s); ss = sum_x1_x2(ss);
        const float mean = s * (1.f / 512.f), var = fmaxf(ss * (1.f / 512.f) - mean * mean, 0.f), rstd = 1.0f / sqrtf(var + EPS);
#pragma unroll
        for (int q = 0; q < 4; ++q) { float f[8]; unpack8(*(const u32x4*)(src + 128 * g + 8 * q), f);
#pragma unroll
            for (int e = 0; e < 8; e += 2) { const float y0 = (f[e] - mean) * rstd, y1 = (f[e + 1] - mean) * rstd; const unsigned w = pk2(y0, y1);
                *(LAS unsigned short*)(vT + (32 * q4 + 8 * q + e) * 272 + j * 2) = (unsigned short)(w & 0xffffu); *(LAS unsigned short*)(vT + (32 * q4 + 8 * q + e + 1) * 272 + j * 2) = (unsigned short)(w >> 16); } }
        const float* wsrc = p->sgu_w + ((size_t)(l * 4 + g) * 128 + (tid >> 2)) * 128 + 32 * (tid & 3);
#pragma unroll
        for (int q = 0; q < 4; ++q) { const f32x4 a = *(const f32x4*)(wsrc + 8 * q), bq = *(const f32x4*)(wsrc + 8 * q + 4);
            u32x4 w; w.x = pk2(a.x, a.y); w.y = pk2(a.z, a.w); w.z = pk2(bq.x, bq.y); w.w = pk2(bq.z, bq.w);
            *(LAS u32x4*)(WL + (tid >> 2) * 272 + (32 * (tid & 3) + 8 * q) * 2) = w; }
    }
    __syncthreads();
    bf16x8 af[4];
#pragma unroll
    for (int ks = 0; ks < 4; ++ks) af[ks] = *(const LAS bf16x8*)(vT + (16 * wave + c) * 272 + (32 * ks + 8 * g4) * 2);
#pragma unroll 2
    for (int ti = 0; ti < 8; ++ti) {
        f32x4 acc = (f32x4){0.f, 0.f, 0.f, 0.f};
#pragma unroll
        for (int ks = 0; ks < 4; ++ks) acc = mfma16(af[ks], *(const LAS bf16x8*)(WL + (16 * ti + c) * 272 + (32 * ks + 8 * g4) * 2), acc);
        const int i = 16 * ti + c; const float bias = p->sgu_b[(l * 4 + g) * 128 + i];
        const int col = 128 * g + 16 * wave + 4 * g4;
        const u32x2 uw = *(const u32x2*)(ZA + (size_t)(r0 + i) * NZA + C_SU + col);
        const float o0 = bflo(uw.x) * (acc[0] + bias), o1 = bfhi(uw.x) * (acc[1] + bias), o2 = bflo(uw.y) * (acc[2] + bias), o3 = bfhi(uw.y) * (acc[3] + bias);
        u32x2 w; w.x = pk2(o0, o1); w.y = pk2(o2, o3); *(u32x2*)(BR + (size_t)(r0 + i) * 512 + col) = w;
    }
    __syncthreads();
}

__device__ __forceinline__ void ret_load_k(KPC p, const bf16* ZA, int r0, int h, bool latent, int pos0, int tid, float (&a)[8], float (&bb)[8]) {
    const int j = tid >> 2, q4 = tid & 3; const bf16* src = ZA + (size_t)(r0 + j) * NZA + C_RK + 64 * h + 8 * q4;
    unpack8(*(const u32x4*)src, a); unpack8(*(const u32x4*)(src + 32), bb);
    if (latent) { const float* rc = (const float*)(p->ws + WS_ROPEC); const float* rsn = (const float*)(p->ws + WS_ROPES); const int pos = pos0 + j;
#pragma unroll
        for (int e = 0; e < 8; ++e) { const float cs = rc[pos * 32 + 8 * q4 + e], sn = rsn[pos * 32 + 8 * q4 + e]; const float x1 = a[e], x2 = bb[e]; a[e] = x1 * cs - x2 * sn; bb[e] = x1 * sn + x2 * cs; } }
#pragma unroll
    for (int e = 0; e < 8; ++e) { a[e] *= 0.125f; bb[e] *= 0.125f; }
}
__device__ __forceinline__ void ret_stage_vT(const bf16* ZA, int r0, int h, LAS unsigned char* vT, int tid) {
    const int j = tid >> 2, q4 = tid & 3; const bf16* src = ZA + (size_t)(r0 + j) * NZA + C_RV + 128 * h + 32 * q4;
#pragma unroll
    for (int q = 0; q < 4; ++q) { const u32x4 v = *(const u32x4*)(src + 8 * q); const unsigned vw[4] = {v.x, v.y, v.z, v.w};
#pragma unroll
        for (int e = 0; e < 4; ++e) { *(LAS unsigned short*)(vT + (32 * q4 + 8 * q + 2 * e) * 272 + j * 2) = (unsigned short)(vw[e] & 0xffffu); *(LAS unsigned short*)(vT + (32 * q4 + 8 * q + 2 * e + 1) * 272 + j * 2) = (unsigned short)(vw[e] >> 16); } }
}
__device__ __forceinline__ void ret_upd_item(KPC p, int l, LAS unsigned char* lds, int item, int tid, int lane, int wave) {
    const bf16* ZA = (const bf16*)(p->ws + WS_ZA); float* RS = (float*)(p->ws + WS_RS);
    const int b = item / (NCH * 4), rem = item % (NCH * 4), n = rem >> 2, h = rem & 3, c = lane & 15, g4 = lane >> 4;
    const bool latent = n < 32; const int r0 = latent ? b * T + 128 * n : ML + b * CL + 128 * (n - 32);
    const float lgf = log2_sigmoid(p->dec_f[l * 4 + h]), lgb = log2_sigmoid(p->dec_b[l * 4 + h]);
    LAS unsigned char* vT = lds; LAS unsigned char* kTf = lds + 34816; LAS unsigned char* kTb = lds + 34816 + 17408;
    {   float a[8], bb[8]; ret_load_k(p, ZA, r0, h, latent, 128 * n, tid, a, bb);
        const int j = tid >> 2, q4 = tid & 3; const float wf = ex2((float)(127 - j) * lgf), wb = ex2((float)j * lgb);
#pragma unroll
        for (int e = 0; e < 8; e += 2) {
            unsigned w = pk2(a[e] * wf, a[e + 1] * wf); *(LAS unsigned short*)(kTf + (8 * q4 + e) * 272 + j * 2) = (unsigned short)(w & 0xffffu); *(LAS unsigned short*)(kTf + (8 * q4 + e + 1) * 272 + j * 2) = (unsigned short)(w >> 16);
            w = pk2(bb[e] * wf, bb[e + 1] * wf); *(LAS unsigned short*)(kTf + (32 + 8 * q4 + e) * 272 + j * 2) = (unsigned short)(w & 0xffffu); *(LAS unsigned short*)(kTf + (32 + 8 * q4 + e + 1) * 272 + j * 2) = (unsigned short)(w >> 16);
            w = pk2(a[e] * wb, a[e + 1] * wb); *(LAS unsigned short*)(kTb + (8 * q4 + e) * 272 + j * 2) = (unsigned short)(w & 0xffffu); *(LAS unsigned short*)(kTb + (8 * q4 + e + 1) * 272 + j * 2) = (unsigned short)(w >> 16);
            w = pk2(bb[e] * wb, bb[e + 1] * wb); *(LAS unsigned short*)(kTb + (32 + 8 * q4 + e) * 272 + j * 2) = (unsigned short)(w & 0xffffu); *(LAS unsigned short*)(kTb + (32 + 8 * q4 + e + 1) * 272 + j * 2) = (unsigned short)(w >> 16);
        }
        ret_stage_vT(ZA, r0, h, vT, tid);
    }
    __syncthreads();
    bf16x8 af[4];
#pragma unroll
    for (int ks = 0; ks < 4; ++ks) af[ks] = *(const LAS bf16x8*)(vT + (16 * wave + c) * 272 + (32 * ks + 8 * g4) * 2);
#pragma unroll
    for (int dir = 0; dir < 2; ++dir) { const LAS unsigned char* kT = dir ? kTb : kTf;
        float* dst = RS + ((size_t)(((b * 4 + h) * 2 + dir) * NCH + n) * 128 + 16 * wave + 4 * g4) * 64;
#pragma unroll
        for (int dt = 0; dt < 4; ++dt) { f32x4 acc = (f32x4){0.f, 0.f, 0.f, 0.f};
#pragma unroll
            for (int ks = 0; ks < 4; ++ks) acc = mfma16(af[ks], *(const LAS bf16x8*)(kT + (16 * dt + c) * 272 + (32 * ks + 8 * g4) * 2), acc);
#pragma unroll
            for (int rr = 0; rr < 4; ++rr) dst[rr * 64 + 16 * dt + c] = acc[rr]; } }
    __syncthreads();
}
__device__ __forceinline__ void phase_scan(KPC p, int l, int tid, int bid, int G) {
    const float* RS = (const float*)(p->ws + WS_RS); bf16* ST = (bf16*)(p->ws + WS_ST);
    for (int idx = bid * 512 + tid; idx < NB * 4 * 2 * 8192; idx += G * 512) {
        const int ed = idx & 8191, dir = (idx >> 13) & 1, bh = idx >> 14, e = ed >> 6, d = ed & 63, h = bh & 3;
        const float* P = RS + (size_t)((bh * 2 + dir) * NCH) * 8192 + ed;
        bf16* S = ST + ((size_t)bh * NCH * 128 + e) * 128 + dir * 64 + d;
        const float lg = log2_sigmoid(dir ? p->dec_b[l * 4 + h] : p->dec_f[l * 4 + h]); const float dec = ex2(128.f * lg);
        const float u32 = P[32 * 8192], u33 = P[33 * 8192];
        if (dir == 0) {
            S[32 * 16384] = 0; S[33 * 16384] = (bf16)(pk2(u32, 0.f) & 0xffffu);
            float s = dec * u32 + u33;
            for (int n = 0; n < 32; ++n) { const float u = P[(size_t)n * 8192]; S[(size_t)n * 16384] = (bf16)(pk2(s, 0.f) & 0xffffu); s = dec * s + u; }
        } else {
            S[33 * 16384] = 0; S[32 * 16384] = (bf16)(pk2(u33, 0.f) & 0xffffu);
            float s = dec * u33 + u32;
            for (int n = 31; n >= 0; --n) { const float u = P[(size_t)n * 8192]; S[(size_t)n * 16384] = (bf16)(pk2(s, 0.f) & 0xffffu); s = dec * s + u; }
        }
    }
}
__device__ __forceinline__ void ret_out_item(KPC p, int l, LAS unsigned char* lds, int item, int tid, int lane, int wave) {
    const bf16* ZA = (const bf16*)(p->ws + WS_ZA); bf16* BR = (bf16*)p->out; const bf16* ST = (const bf16*)(p->ws + WS_ST);
    const int b = item / (NCH * 4), rem = item % (NCH * 4), n = rem >> 2, h = rem & 3, c = lane & 15, g4 = lane >> 4;
    const bool latent = n < 32; const int r0 = latent ? b * T + 128 * n : ML + b * CL + 128 * (n - 32);
    const float lgf = log2_sigmoid(p->dec_f[l * 4 + h]), lgb = log2_sigmoid(p->dec_b[l * 4 + h]);
    LAS unsigned char* vT = lds; LAS unsigned char* Kl = lds + 34816; LAS unsigned char* Sl = lds + 34816 + 18432;
    {   float a[8], bb[8]; ret_load_k(p, ZA, r0, h, latent, 128 * n, tid, a, bb);
        const int j = tid >> 2, q4 = tid & 3;
        *(LAS u32x4*)(Kl + j * 144 + 16 * q4) = pack8(a); *(LAS u32x4*)(Kl + j * 144 + 64 + 16 * q4) = pack8(bb);
        ret_stage_vT(ZA, r0, h, vT, tid);
        const u32x4* ssrc = (const u32x4*)(ST + (size_t)((b * 4 + h) * NCH + n) * 16384);
#pragma unroll
        for (int k = 0; k < 4; ++k) { const int q = tid + 512 * k; *(LAS u32x4*)(Sl + (q >> 4) * 272 + (q & 15) * 16) = ssrc[q]; }
    }
    __syncthreads();
    const int ii = 16 * wave + c;
    bf16x8 qf[2];
    {   const bf16* src = ZA + (size_t)(r0 + ii) * NZA + C_RQ + 64 * h + 8 * g4; float a[8], bb[8]; unpack8(*(const u32x4*)src, a); unpack8(*(const u32x4*)(src + 32), bb);
        if (latent) { const float* rc = (const float*)(p->ws + WS_ROPEC); const float* rsn = (const float*)(p->ws + WS_ROPES); const int pos = 128 * n + ii;
#pragma unroll
            for (int e = 0; e < 8; ++e) { const float cs = rc[pos * 32 + 8 * g4 + e], sn = rsn[pos * 32 + 8 * g4 + e]; const float x1 = a[e], x2 = bb[e]; a[e] = x1 * cs - x2 * sn; bb[e] = x1 * sn + x2 * cs; } }
        qf[0] = as_bf16x8(pack8(a)); qf[1] = as_bf16x8(pack8(bb)); }
    bf16x8 pf[4];
#pragma unroll
    for (int kk = 0; kk < 4; ++kk) {
        f32x4 sa = (f32x4){0.f, 0.f, 0.f, 0.f}, sb = (f32x4){0.f, 0.f, 0.f, 0.f};
        sa = mfma16(*(const LAS bf16x8*)(Kl + (32 * kk + c) * 144 + g4 * 16), qf[0], sa); sa = mfma16(*(const LAS bf16x8*)(Kl + (32 * kk + c) * 144 + 64 + g4 * 16), qf[1], sa);
        sb = mfma16(*(const LAS bf16x8*)(Kl + (32 * kk + 16 + c) * 144 + g4 * 16), qf[0], sb); sb = mfma16(*(const LAS bf16x8*)(Kl + (32 * kk + 16 + c) * 144 + 64 + g4 * 16), qf[1], sb);
        float pa[4], pb[4];
#pragma unroll
        for (int rr = 0; rr < 4; ++rr) { const int ja = 32 * kk + 4 * g4 + rr, jb = ja + 16; const int da = ii - ja, db = ii - jb;
            pa[rr] = sa[rr] * ((da >= 0) ? ex2((float)da * lgf) : ex2((float)(-da) * lgb)); pb[rr] = sb[rr] * ((db >= 0) ? ex2((float)db * lgf) : ex2((float)(-db) * lgb)); }
        u32x4 w; w.x = pk2(pa[0], pa[1]); w.y = pk2(pa[2], pa[3]); w.z = pk2(pb[0], pb[1]); w.w = pk2(pb[2], pb[3]); pf[kk] = as_bf16x8(w);
    }
    const float cf = ex2((float)(ii + 1) * lgf), cb = ex2((float)(128 - ii) * lgb);
    f32x4 O[8]; float s = 0.f, ss = 0.f;
#pragma unroll
    for (int et = 0; et < 8; ++et) {
        f32x4 acc = (f32x4){0.f, 0.f, 0.f, 0.f}, xf = (f32x4){0.f, 0.f, 0.f, 0.f}, xb = (f32x4){0.f, 0.f, 0.f, 0.f};
#pragma unroll
        for (int kk = 0; kk < 4; ++kk) { const u32x2 v0 = *(const LAS u32x2*)(vT + (16 * et + c) * 272 + (32 * kk + 4 * g4) * 2), v1 = *(const LAS u32x2*)(vT + (16 * et + c) * 272 + (32 * kk + 16 + 4 * g4) * 2);
            u32x4 vv; vv.x = v0.x; vv.y = v0.y; vv.z = v1.x; vv.w = v1.y; acc = mfma16(as_bf16x8(vv), pf[kk], acc); }
#pragma unroll
        for (int ks = 0; ks < 2; ++ks) { xf = mfma16(*(const LAS bf16x8*)(Sl + (16 * et + c) * 272 + (32 * ks + 8 * g4) * 2), qf[ks], xf);
            xb = mfma16(*(const LAS bf16x8*)(Sl + (16 * et + c) * 272 + (64 + 32 * ks + 8 * g4) * 2), qf[ks], xb); }
        acc = acc + xf * cf + xb * cb; O[et] = acc;
        s += (acc[0] + acc[1]) + (acc[2] + acc[3]); ss += (acc[0] * acc[0] + acc[1] * acc[1]) + (acc[2] * acc[2] + acc[3] * acc[3]);
    }
    s = sum_x16_x32(s); ss = sum_x16_x32(ss);
    const float mean = s * (1.f / 128.f), var = fmaxf(ss * (1.f / 128.f) - mean * mean, 0.f), rstd = 1.0f / sqrtf(var + EPS);
    const bf16* gsrc = ZA + (size_t)(r0 + ii) * NZA + C_RG + 128 * h + 4 * g4; bf16* dst = BR + (size_t)(r0 + ii) * 512 + 128 * h + 4 * g4;
#pragma unroll
    for (int et = 0; et < 8; ++et) { const u32x2 gw = *(const u32x2*)(gsrc + 16 * et); const float g0 = bflo(gw.x), g1 = bfhi(gw.x), g2 = bflo(gw.y), g3 = bfhi(gw.y);
        const float o0 = (O[et][0] - mean) * rstd * g0 * sigmoidf_(g0), o1 = (O[et][1] - mean) * rstd * g1 * sigmoidf_(g1), o2 = (O[et][2] - mean) * rstd * g2 * sigmoidf_(g2), o3 = (O[et][3] - mean) * rstd * g3 * sigmoidf_(g3);
        u32x2 w; w.x = pk2(o0, o1); w.y = pk2(o2, o3); *(u32x2*)(dst + 16 * et) = w; }
    __syncthreads();
}

#ifndef REP_CVT
#define REP_CVT 1
#endif
#ifndef REP_N2R
#define REP_N2R 1
#endif
#ifndef REP_TK
#define REP_TK 1
#endif
__device__ __forceinline__ int wr_off(int k) { return k * 64 + (k >> 2) * 16; }
__device__ __forceinline__ void phase_norm2(KPC p, int l, LAS unsigned char* lds, int tid, int lane, int wave, int bid, int G) {
    for (int rep = 0; rep < REP_CVT; ++rep) convert_experts(p, l, lds, lane, wave, bid, G);
    LAS unsigned char* wrl = lds + 69632;
    for (int i = tid; i < 1024 * 4; i += 512) { const int k = i >> 2, q = i & 3; *(LAS f32x4*)(wrl + wr_off(k) + 16 * q) = *(const f32x4*)(p->w_router + (size_t)l * 16384 + k * 16 + 4 * q); }
    __syncthreads();
    const float* modv = (const float*)(p->ws + WS_MODV) + l * 9 * 6144; const float* X = (const float*)(p->ws + WS_X); bf16* H = (bf16*)(p->ws + WS_H);
    float* AFF = (float*)(p->ws + WS_AFF); float* AFFC = (float*)(p->ws + WS_AFFC); int* INV = (int*)(p->ws + WS_INV);
    const int rows = (l == 0) ? M : ML;
    for (int rep = 0; rep < REP_N2R; ++rep)
    for (int r = bid * 8 + wave; r < rows; r += G * 8) {
        const int bi = (r < ML) ? (r >> 12) : 8;
        f32x4 v[4], h[4];
#pragma unroll
        for (int j = 0; j < 4; ++j) v[j] = *(const f32x4*)(X + (size_t)r * 1024 + 4 * lane + 256 * j);
        const float rs = row_rs(v);
        norm_mod(v, rs, p->norm2_g + l * 1024, modv + bi * 6144 + 3 * 1024, modv + bi * 6144 + 4 * 1024, h, lane);
        store_h(h, H + (size_t)r * 1024, lane);
        float lg[16];
#pragma unroll
        for (int e = 0; e < 16; ++e) lg[e] = 0.f;
#pragma unroll
        for (int j = 0; j < 4; ++j)
#pragma unroll
            for (int i = 0; i < 4; ++i) { const int k = 4 * lane + 256 * j + i; const float hv = h[j][i]; const LAS f32x4* wp = (const LAS f32x4*)(wrl + wr_off(k));
#pragma unroll
                for (int q = 0; q < 4; ++q) { const f32x4 w = wp[q]; lg[4 * q] += hv * w.x; lg[4 * q + 1] += hv * w.y; lg[4 * q + 2] += hv * w.z; lg[4 * q + 3] += hv * w.w; } }
        float mx = -1e30f;
#pragma unroll
        for (int e = 0; e < 16; ++e) { lg[e] = wave_sum(lg[e]); mx = fmaxf(mx, lg[e]); }
        float sum = 0.f;
#pragma unroll
        for (int e = 0; e < 16; ++e) { lg[e] = ex2((lg[e] - mx) * LOG2E); sum += lg[e]; }
        const float isum = 1.0f / sum; float mine = 0.f;
#pragma unroll
        for (int e = 0; e < 16; ++e) mine = (lane == e) ? lg[e] * isum : mine;
        if (lane < 16) { if (r < ML) AFF[((size_t)(bi * 16 + lane) << 12) + (r & 4095)] = mine; else AFFC[((r - ML) >> 8) * 4096 + lane * 256 + ((r - ML) & 255)] = mine;
            INV[(size_t)r * 16 + lane] = -1; }
    }
}

__device__ __forceinline__ int block_sum_i(int v, LAS int* red, int lane, int wave) {
    v = wave_sum_i(v);
    __syncthreads();
    if (lane == 0) red[wave] = v;
    __syncthreads();
    int s = 0;
#pragma unroll
    for (int w = 0; w < 8; ++w) s += red[w];
    return s;
}
__device__ __forceinline__ int block_excl_scan(int v, LAS int* red, int lane, int wave) {
    int inc = v;
#pragma unroll
    for (int o = 1; o < 64; o <<= 1) { const int t = __builtin_amdgcn_ds_bpermute((lane - o) << 2, inc); if (lane >= o) inc += t; }
    __syncthreads();
    if (lane == 63) red[wave] = inc;
    __syncthreads();
    int base = 0;
#pragma unroll
    for (int w = 0; w < 8; ++w) { const int x = red[w]; if (w < wave) base += x; }
    return base + inc - v;
}
template <int KPT>
__device__ __forceinline__ void topk_item(KPC p, const float* aff, int n, int cap, int rowbase, int e, int slotbase, LAS unsigned char* lds, int tid, int lane, int wave) {
    const bf16* H = (const bf16*)(p->ws + WS_H); bf16* XS = (bf16*)(p->ws + WS_XS); float* topw = (float*)(p->ws + WS_TOPW); int* INV = (int*)(p->ws + WS_INV);
    LAS int* red = (LAS int*)lds; LAS int* rl = (LAS int*)(lds + 64);
    unsigned key[KPT]; const bool valid = tid * KPT < n;
#pragma unroll
    for (int j = 0; j < KPT; ++j) key[j] = valid ? __float_as_uint(aff[tid * KPT + j]) : 0u;
    unsigned Tsel = 0u;
    for (int bit = 30; bit >= 0; --bit) { const unsigned cand = Tsel | (1u << bit); int cnt = 0;
#pragma unroll
        for (int j = 0; j < KPT; ++j) cnt += (valid && key[j] >= cand) ? 1 : 0;
        if (block_sum_i(cnt, red, lane, wave) >= cap) Tsel = cand; }
    int cgt = 0, ceq = 0;
#pragma unroll
    for (int j = 0; j < KPT; ++j) { cgt += (valid && key[j] > Tsel) ? 1 : 0; ceq += (valid && key[j] == Tsel) ? 1 : 0; }
    const int need = cap - block_sum_i(cgt, red, lane, wave);
    int er = block_excl_scan(ceq, red, lane, wave);
    bool sel[KPT]; int nsel = 0;
#pragma unroll
    for (int j = 0; j < KPT; ++j) { const bool iseq = valid && key[j] == Tsel; sel[j] = valid && (key[j] > Tsel || (iseq && er < need)); er += iseq ? 1 : 0; nsel += sel[j] ? 1 : 0; }
    int slot = block_excl_scan(nsel, red, lane, wave);
#pragma unroll
    for (int j = 0; j < KPT; ++j) if (sel[j]) { const int t = tid * KPT + j; if (slot < cap) { rl[slot] = t; topw[e * ME + slotbase + slot] = __uint_as_float(key[j]); INV[(size_t)(rowbase + t) * 16 + e] = slotbase + slot; } ++slot; }
    __syncthreads();
    for (int s = wave; s < cap; s += 8) { const int t = rl[s]; const u32x4* src = (const u32x4*)(H + (size_t)(rowbase + t) * 1024); u32x4* dst = (u32x4*)(XS + ((size_t)e * ME + slotbase + s) * 1024);
        dst[lane] = src[lane]; dst[lane + 64] = src[lane + 64]; }
    __syncthreads();
}
__device__ __forceinline__ void phase_topk(KPC p, int l, LAS unsigned char* lds, int tid, int lane, int wave, int bid, int G) {
    const float* AFF = (const float*)(p->ws + WS_AFF); const float* AFFC = (const float*)(p->ws + WS_AFFC);
    const int nitem = (l == 0) ? 256 : 128;
    for (int it = bid; it < nitem; it += G) {
        if (it < 128) { const int b = it >> 4, e = it & 15; topk_item<8>(p, AFF + ((size_t)(b * 16 + e) << 12), 4096, CAPL, b * T, e, b * CAPL, lds, tid, lane, wave); }
        else { const int q = it - 128, b = q >> 4, e = q & 15; topk_item<1>(p, AFFC + (b * 16 + e) * 256, 256, CAPC, ML + b * CL, e, NB * CAPL + b * CAPC, lds, tid, lane, wave); }
    }
}

__device__ __forceinline__ void phase_combine(KPC p, int l, LAS unsigned char* lds, int tid, int lane, int wave, int bid, int G) {
    const float* modv = (const float*)(p->ws + WS_MODV); float* X = (float*)(p->ws + WS_X); bf16* H = (bf16*)(p->ws + WS_H);
    const bf16* Y = (const bf16*)(p->ws + WS_XS); const int* INV = (const int*)(p->ws + WS_INV);
    const int rows = (l == 0) ? M : ML, stride = G * 8;
    int r = bid * 8 + wave;
    int slot_next = (lane < 16 && r < rows) ? INV[(size_t)r * 16 + lane] : -1;
    for (; r < rows; r += stride) {
        const int bi = (r < ML) ? (r >> 12) : 8;
        const int myslot = slot_next; const int rn = r + stride;
        slot_next = (lane < 16 && rn < rows) ? INV[(size_t)rn * 16 + lane] : -1;
        f32x4 v[4], acc[4];
#pragma unroll
        for (int j = 0; j < 4; ++j) { v[j] = *(const f32x4*)(X + (size_t)r * 1024 + 4 * lane + 256 * j); acc[j] = (f32x4){0.f, 0.f, 0.f, 0.f}; }
        unsigned mask = (unsigned)(__builtin_amdgcn_ballot_w64(myslot >= 0) & 0xffffull);
        while (mask) {
            const int e0 = __builtin_ctz(mask); mask &= mask - 1u; const int s0 = __builtin_amdgcn_readlane(myslot, e0);
            const bool has1 = mask != 0u; const int e1 = has1 ? __builtin_ctz(mask) : e0; if (has1) mask &= mask - 1u; const int s1 = __builtin_amdgcn_readlane(myslot, e1);
            const bf16* ya = Y + ((size_t)e0 * ME + s0) * 1024; const bf16* yb = Y + ((size_t)e1 * ME + s1) * 1024;
            u32x2 wa[4], wb[4];
#pragma unroll
            for (int j = 0; j < 4; ++j) wa[j] = *(const u32x2*)(ya + 4 * lane + 256 * j);
#pragma unroll
            for (int j = 0; j < 4; ++j) wb[j] = *(const u32x2*)(yb + 4 * lane + 256 * j);
            const float kb = has1 ? 1.0f : 0.0f;
#pragma unroll
            for (int j = 0; j < 4; ++j) { acc[j] += (f32x4){bflo(wa[j].x), bfhi(wa[j].x), bflo(wa[j].y), bfhi(wa[j].y)}; acc[j] += (f32x4){bflo(wb[j].x), bfhi(wb[j].x), bflo(wb[j].y), bfhi(wb[j].y)} * kb; }
        }
        const float* g2 = modv + (l * 9 + bi) * 6144 + 5 * 1024;
#pragma unroll
        for (int j = 0; j < 4; ++j) v[j] = v[j] + *(const f32x4*)(g2 + 4 * lane + 256 * j) * acc[j];
        if (l == 0) {
#pragma unroll
            for (int j = 0; j < 4; ++j) *(f32x4*)(X + (size_t)r * 1024 + 4 * lane + 256 * j) = v[j];
            const float rs = row_rs(v); f32x4 h[4];
            norm_mod(v, rs, p->norm1_g + 1024, modv + (9 + bi) * 6144, modv + (9 + bi) * 6144 + 1024, h, lane);
            store_h(h, H + (size_t)r * 1024, lane);
        } else {
#pragma unroll
            for (int j = 0; j < 4; ++j) *(f32x4*)(p->out + (size_t)r * 1024 + 4 * lane + 256 * j) = v[j];
        }
    }
    if (l == 0) convert_small(p, 1, lds, lane, wave, bid, G);
}

#define XB_TMO      128
#define XB_XCNT(j)  (256  + 64 * (j))
#define XB_XSUB(j)  (1280 + 64 * (j))
#define XB_XGEN(j)  (2304 + 64 * (j))
#define XB_TOP      3328
#define XB_TOPGEN   3392
#define XCD_BAR_WORDS 3456
#define XB_SPIN_CAP (1u << 18)

__device__ __forceinline__ unsigned xb_ld(unsigned* p)              { return __hip_atomic_load(p, __ATOMIC_RELAXED, __HIP_MEMORY_SCOPE_AGENT); }
__device__ __forceinline__ unsigned xb_add(unsigned* p, unsigned v) { return __hip_atomic_fetch_add(p, v, __ATOMIC_RELAXED, __HIP_MEMORY_SCOPE_AGENT); }
__device__ __forceinline__ unsigned xb_xcc_id() { return (unsigned)__builtin_amdgcn_s_getreg((3 << 11) | 20) & 0xFu; }
#define XB_SPIN(cond, bar) do { unsigned _sp = 0; while (cond) { __builtin_amdgcn_s_sleep(1); \
    if ((++_sp & 255u) == 0u) { if (xb_ld(&(bar)[XB_TMO])) break; if (_sp > XB_SPIN_CAP) { atomicAdd(&(bar)[XB_TMO], 1u); break; } } } } while (0)

struct XcdBarrier {
    unsigned* bar; unsigned x;
    volatile LAS unsigned* st;
};

__device__ __forceinline__ XcdBarrier xcd_barrier_post(unsigned* bar, volatile LAS unsigned* st) {
    XcdBarrier b; b.bar = bar; b.x = xb_xcc_id(); b.st = st;
    if (threadIdx.x == 0) (void)xb_add(&bar[XB_XCNT(b.x)], 1u);
    return b;
}
__device__ __forceinline__ void xcd_barrier_complete(unsigned* bar, unsigned x, unsigned& nloc, unsigned& nx) {
    const unsigned G = gridDim.x * gridDim.y * gridDim.z;
    unsigned sum, cnt, mine, sp = 0u;
    for (;;) {
        sum = 0u; cnt = 0u; mine = 0u;
#pragma unroll
        for (unsigned j = 0; j < 16; ++j) { const unsigned c = xb_ld(&bar[XB_XCNT(j)]); sum += c; cnt += (c > 0u) ? 1u : 0u; mine = (j == x) ? c : mine; }
        if (sum == G) break;
        __builtin_amdgcn_s_sleep(1);
        if ((++sp & 255u) == 0u) { if (xb_ld(&bar[XB_TMO])) break; if (sp > XB_SPIN_CAP) { atomicAdd(&bar[XB_TMO], 1u); break; } }
    }
    nloc = mine > 0u ? mine : 1u; nx = cnt > 0u ? cnt : 1u;
}

__device__ __forceinline__ void xcd_barrier(const XcdBarrier& b) {
    asm volatile("s_waitcnt vmcnt(0)" ::: "memory");
    __syncthreads();
    if (threadIdx.x == 0) {
        unsigned* bar = b.bar;
        __builtin_amdgcn_s_waitcnt(0);
        unsigned nloc = b.st[0], nx = b.st[1];
        if (nloc == 0u) { xcd_barrier_complete(bar, b.x, nloc, nx); b.st[0] = nloc; b.st[1] = nx; }
        const unsigned old = xb_add(&bar[XB_XSUB(b.x)], 1u);
        const unsigned gen = old / nloc;
        if (old + 1u == (gen + 1u) * nloc) {
            __builtin_amdgcn_fence(__ATOMIC_RELEASE, "agent");
            asm volatile("s_waitcnt vmcnt(0)" ::: "memory");
            const unsigned og = xb_add(&bar[XB_TOP], 1u);
            const unsigned tg = og / nx;
            if (og + 1u == (tg + 1u) * nx) xb_add(&bar[XB_TOPGEN], 1u);
            else XB_SPIN(xb_ld(&bar[XB_TOPGEN]) == tg, bar);
            __builtin_amdgcn_fence(__ATOMIC_ACQUIRE, "agent");
            xb_add(&bar[XB_XGEN(b.x)], 1u);
            asm volatile("s_waitcnt vmcnt(0)" ::: "memory");
        } else {
            XB_SPIN(xb_ld(&bar[XB_XGEN(b.x)]) == gen, bar);
            __builtin_amdgcn_fence(__ATOMIC_ACQUIRE, "agent");
            asm volatile("s_waitcnt vmcnt(0)" ::: "memory");
        }
    }
    __syncthreads();
}

#ifndef REP_GZA
#define REP_GZA 1
#endif
#ifndef REP_GG
#define REP_GG 1
#endif
#ifndef REP_GMRG
#define REP_GMRG 1
#endif
#ifndef REP_GM1
#define REP_GM1 1
#endif
#ifndef REP_GM2
#define REP_GM2 1
#endif
#ifndef REP_ATT
#define REP_ATT 1
#endif
#ifndef REP_UPD
#define REP_UPD 1
#endif
#ifndef REP_SGU
#define REP_SGU 1
#endif
#ifndef REP_PRE
#define REP_PRE 1
#endif
#ifndef REP_CMB
#define REP_CMB 1
#endif
#ifndef REP_MIX
#define REP_MIX 1
#endif
#ifndef REP_RO
#define REP_RO 1
#endif
#ifndef REP_N2
#define REP_N2 1
#endif
#ifndef REP_GEMM
#define REP_GEMM 1
#endif
#ifndef REP_SYNC
#define REP_SYNC 1
#endif
#ifndef EN_GEMM
#define EN_GEMM 0x3f
#endif
#ifndef EN_ATT
#define EN_ATT 1
#endif
#ifndef EN_UPD
#define EN_UPD 1
#endif
#ifndef EN_SGU
#define EN_SGU 1
#endif
#ifndef EN_RO
#define EN_RO 1
#endif
#ifndef EN_MISC
#define EN_MISC 1
#endif
#define KPP() ({ KPC q_ = kp_; asm volatile("" : "+s"(q_)); q_; })
__global__ void __launch_bounds__(512, 2) mk_fwd(KP p_unused) {
    extern __shared__ __attribute__((aligned(16))) unsigned char lds_raw[];
    LAS unsigned char* lds = (LAS unsigned char*)lds_raw;
    cg::grid_group grid = cg::this_grid();
    const int bid = blockIdx.x, G = gridDim.x;
#define IDS() int tid = threadIdx.x; asm volatile("" : "+v"(tid)); const int lane = tid & 63, wave = __builtin_amdgcn_readfirstlane(tid >> 6); (void)lane; (void)wave
    const KPC kp_ = (KPC)__builtin_amdgcn_kernarg_segment_ptr();
    volatile LAS unsigned* bst = (volatile LAS unsigned*)(lds + 147392);
    if (threadIdx.x < 16) bst[threadIdx.x] = 0u;
    __syncthreads();
    (void)xcd_barrier_post((unsigned*)KPP()->ws, bst);
#define GSYNC() do { XcdBarrier b_; b_.bar = (unsigned*)KPP()->ws; b_.x = xb_xcc_id(); b_.st = bst; xcd_barrier(b_); } while (0)

    { IDS(); for (int rep = 0; rep < REP_PRE; ++rep) { phase_prep(KPP(), lds, tid, lane, wave, bid, G); __syncthreads(); } }
    grid.sync();
    { IDS(); for (int rep = 0; rep < REP_PRE; ++rep) phase_norm_in(KPP(), lane, wave, bid, G); }
    GSYNC();
#pragma unroll 1
    for (int l = 0; l < 2; ++l) {
        {
            unsigned char* ws = KPP()->ws;
            pg8::Gemm g{(const pg8::bf16_t*)(ws + WS_H), (const pg8::bf16_t*)(ws + WS_WTIN), M, NZA, 1024}; GroupOrder S{1, M / 256, NZA / 256, 0, 0, G, bid};
            EpiZA E{(bf16*)(ws + WS_ZA)};
            for (int rep = 0; rep < REP_GEMM * REP_GZA; ++rep) pg8::gemm_phase<EpiZA, GroupOrder, true, true>(lds, g, S, E);
        }
        GSYNC();
        {
            KPC p = KPP(); IDS();
            float mq = fabsf(p->qn_g[l * 64 + lane]), mk = fabsf(p->kn_g[l * 64 + lane]);
            mq = wave_max(mq); mk = wave_max(mk);
            const float Mb2 = 8.0f * mq * mk * LOG2E;
            const int natt = (l == 0) ? 544 : 512, nupd = NB * NCH * 4, nsgu = ((l == 0) ? (M / 128) : (ML / 128)) * 4;
            for (int rep = 0; rep < REP_MIX; ++rep)
            for (int it = bid; it < natt + nupd + nsgu; it += G) {
                if (it < natt) { for (int q = 0; q < REP_ATT; ++q) att_item(p, l, lds, it, Mb2, tid, lane, wave); }
                else if (it < natt + nupd) { for (int q = 0; q < REP_UPD; ++q) ret_upd_item(p, l, lds, it - natt, tid, lane, wave); }
                else { for (int q = 0; q < REP_SGU; ++q) sgu_item(p, l, lds, it - natt - nupd, tid, lane, wave); }
            }
        }
        GSYNC();
        { IDS(); for (int rep = 0; rep < REP_RO; ++rep) phase_scan(KPP(), l, tid, bid, G); }
        GSYNC();
        {   KPC p = KPP(); IDS(); const int nch = (l == 0) ? NCH : 32;
            for (int rep = 0; rep < REP_RO; ++rep)
            for (int it = bid; it < NB * nch * 4; it += G) { const int b = it / (nch * 4), rem = it % (nch * 4); if (EN_RO) ret_out_item(p, l, lds, b * (NCH * 4) + rem, tid, lane, wave); }
        }
        GSYNC();
        const int Mrows = (l == 0) ? M : ML;
        {
            unsigned char* ws = KPP()->ws;
            pg8::Gemm g{(const pg8::bf16_t*)(ws + WS_H), (const pg8::bf16_t*)(ws + WS_WTIN) + (size_t)NZA * 1024, Mrows, NZG, 1024}; GroupOrder S{1, Mrows / 256, NZG / 256, 0, 0, G, bid};
            pg8::EpiBf16<0> E{(pg8::bf16_t*)(ws + WS_G), NZG, nullptr, 0, 0, 1.f};
            for (int rep = 0; rep < REP_GEMM * REP_GG; ++rep) pg8::gemm_phase<pg8::EpiBf16<0>, GroupOrder, true, true>(lds, g, S, E);
        }
        GSYNC();
        {
            KPC p = KPP(); unsigned char* ws = p->ws;
            pg8::Gemm g{(const pg8::bf16_t*)p->out, (const pg8::bf16_t*)(ws + WS_WTBR), 3 * M, 3072, 512}; MergeOrder S{Mrows / 256, G, bid};
            EpiMerge E{(const bf16*)(ws + WS_G), (bf16*)(ws + WS_H)};
            for (int rep = 0; rep < REP_GEMM * REP_GMRG; ++rep) pg8::gemm_phase<EpiMerge, MergeOrder, true, true>(lds, g, S, E);
        }
        GSYNC();
        {
            KPC p = KPP(); unsigned char* ws = p->ws;
            pg8::Gemm g{(const pg8::bf16_t*)(ws + WS_H), (const pg8::bf16_t*)(ws + WS_WTOUT), Mrows, 1024, 1024}; GroupOrder S{1, Mrows / 256, 4, 0, 0, G, bid};
            EpiOut E{(l == 0) ? p->x : (const float*)(ws + WS_X), (l == 0) ? p->ctx : (const float*)(ws + WS_X) + (size_t)ML * 1024, (float*)(ws + WS_X), (const float*)(ws + WS_MODV) + l * 9 * 6144};
            pg8::gemm_phase<EpiOut, GroupOrder, true, true>(lds, g, S, E);
        }
        GSYNC();
        { IDS(); for (int rep = 0; rep < REP_N2; ++rep) { phase_norm2(KPP(), l, lds, tid, lane, wave, bid, G); __syncthreads(); } }
        GSYNC();
        { IDS(); for (int rep = 0; rep < REP_N2 * REP_TK; ++rep) phase_topk(KPP(), l, lds, tid, lane, wave, bid, G); }
        GSYNC();
        {
            unsigned char* ws = KPP()->ws;
            pg8::Gemm g{(const pg8::bf16_t*)(ws + WS_XS), (const pg8::bf16_t*)(ws + WS_WT1), NE * ME, NE * 2048, 1024}; GroupOrder S{NE, (l == 0) ? 17 : 16, 8, 17, 8, G, bid};
            EpiMoe1 E{(bf16*)(ws + WS_ACT)};
            for (int rep = 0; rep < REP_GEMM * REP_GM1; ++rep) pg8::gemm_phase<EpiMoe1, GroupOrder, true, true>(lds, g, S, E);
        }
        GSYNC();
        {
            unsigned char* ws = KPP()->ws;
            pg8::Gemm g{(const pg8::bf16_t*)(ws + WS_ACT), (const pg8::bf16_t*)(ws + WS_WT2), NE * ME, NE * 1024, 1024}; GroupOrder S{NE, (l == 0) ? 17 : 16, 4, 17, 4, G, bid};
            EpiMoe2 E{(bf16*)(ws + WS_XS), (const float*)(ws + WS_TOPW)};
            for (int rep = 0; rep < REP_GEMM * REP_GM2; ++rep) pg8::gemm_phase<EpiMoe2, GroupOrder, true, true>(lds, g, S, E);
        }
        GSYNC();
        { IDS(); for (int rep = 0; rep < ((l == 1) ? REP_CMB : 1); ++rep) phase_combine(KPP(), l, lds, tid, lane, wave, bid, G); }
        if (l == 0) GSYNC();
        for (int rep = 1; rep < REP_SYNC; ++rep) { for (int k = 0; k < 12; ++k) GSYNC(); }
    }
}

extern "C" void kernel_launch(void* const* d_in, const int* in_sizes, int n_in, void* d_out, int out_size, void* d_ws, size_t ws_size, hipStream_t stream) {
    static int grid = 0;
    if (grid == 0) {
        if (n_in != 22 || out_size != ML * D || ws_size < WS_END) { fprintf(stderr, "kernel_launch: unexpected shapes (n_in %d out %d ws %zu, need %zu)\n", n_in, out_size, ws_size, (size_t)WS_END); grid = -1; return; }
        int dev = 0, cus = 0, per_cu = 0;
        if (hipGetDevice(&dev) != hipSuccess || hipDeviceGetAttribute(&cus, hipDeviceAttributeMultiprocessorCount, dev) != hipSuccess) { grid = -1; return; }
        if (hipFuncSetAttribute((const void*)mk_fwd, hipFuncAttributeMaxDynamicSharedMemorySize, LDS_BYTES) != hipSuccess) { fprintf(stderr, "kernel_launch: hipFuncSetAttribute failed\n"); grid = -1; return; }
        if (hipOccupancyMaxActiveBlocksPerMultiprocessor(&per_cu, (const void*)mk_fwd, 512, LDS_BYTES) != hipSuccess || per_cu < 1) { fprintf(stderr, "kernel_launch: occupancy query says %d\n", per_cu); (void)hipGetLastError(); }
        grid = cus;
        fprintf(stderr, "kernel_launch: grid %d, occupancy %d/CU, ws %zu\n", grid, per_cu, ws_size);
    }
    if (grid < 0) return;
    if (hipMemsetAsync(d_ws, 0, 16384, stream) != hipSuccess) { fprintf(stderr, "kernel_launch: memset failed\n"); return; }
    KP hp{};
    const float** f = (const float**)&hp;
    for (int i = 0; i < 22; ++i) f[i] = (const float*)d_in[i];
    hp.out = (float*)d_out; hp.ws = (unsigned char*)d_ws;
    void* args[] = {&hp};
    hipError_t e = hipLaunchCooperativeKernel((const void*)mk_fwd, dim3(grid), dim3(512), args, LDS_BYTES, stream);
    if (e != hipSuccess) fprintf(stderr, "kernel_launch: cooperative launch failed: %s\n", hipGetErrorString(e));
}
```

```cpp
#include <hip/hip_runtime.h>
#include <hip/hip_cooperative_groups.h>
#include <cstdio>
#include <cstdint>
namespace cg = cooperative_groups;

namespace pg8 {
#define PG8_LAS __attribute__((address_space(3)))
typedef unsigned short bf16_t;
typedef short bf16x8 __attribute__((ext_vector_type(8)));
typedef float f32x4 __attribute__((ext_vector_type(4)));
typedef unsigned u32x4 __attribute__((ext_vector_type(4)));
constexpr int BM = 256, BK = 64, HALF = 128, HTB = HALF * BK * 2  , STAGE_BYTES = 8 * HTB, NXCD = 8, WGM = 8;

__host__ __device__ __forceinline__ int lds_byte(int r, int c) { const int st = (r >> 4) * 2 + (c >> 5), rr = r & 15, cc = c & 31, ob = rr * 64 + cc * 2; return st * 1024 + (ob ^ (((ob >> 9) & 1) << 5)); }
__host__ __device__ __forceinline__ void stage_rc(int b, int& R, int& C) { const int st = b / 1024, sb = b % 1024, swz = sb ^ (((sb >> 9) & 1) << 5); R = (st >> 1) * 16 + swz / 64; C = (st & 1) * 32 + (swz % 64) / 2; }
__host__ __device__ __forceinline__ int perm32(int rho) { const int n = rho >> 4, i = rho & 15; return 8 * (i >> 2) + 4 * n + (i & 3); }

struct Unit { int pm, pn; };
struct Gemm { const bf16_t* A; const bf16_t* Bt; int M, N, K; };

struct StaticOrder {
    int nM, nN, nwg, G, c;
    __host__ __device__ void init(int M, int N, int G_, int c_) { nM = M / BM; nN = N / BM; nwg = nM * nN; G = G_; c = c_; }
    __host__ __device__ bool next(int i, Unit& u) const {
        const long L = (long)i * G + c; if (L >= nwg) return false;
        int wgid = (int)L; { const int q = nwg / NXCD, r = nwg % NXCD, xcd = wgid % NXCD, off = wgid / NXCD; wgid = (xcd < r ? xcd * (q + 1) : r * (q + 1) + (xcd - r) * q) + off; }
        const int nig = WGM * nN, gid = wgid / nig, fm = gid * WGM, gsz = (nM - fm) < WGM ? (nM - fm) : WGM;
        u.pm = fm + ((wgid % nig) % gsz); u.pn = (wgid % nig) / gsz; return true;
    }
    __device__ __forceinline__ void a_ready(const Unit&) const {}
    __device__ __forceinline__ void done(const Unit&) const {}
};

__device__ __forceinline__ unsigned cvt_pk_bf16(float lo, float hi) { unsigned r; asm volatile("v_cvt_pk_bf16_f32 %0, %1, %2" : "=v"(r) : "v"(lo), "v"(hi)); return r; }
typedef float f32x2 __attribute__((ext_vector_type(2)));
__device__ __forceinline__ f32x2 gelu_pk(f32x2 v) {
    const f32x2 av = __builtin_elementwise_abs(v), d = av * 0.2316418882f + 1.0f;
    f32x2 t; t.x = __builtin_amdgcn_rcpf(d.x); t.y = __builtin_amdgcn_rcpf(d.y);
    f32x2 q = t * 0.5307027145f + (-0.7265760135f); q = q * t + 0.7107068705f; q = q * t + (-0.142248368f); q = q * t + 0.127414796f; q = q * t;
    const f32x2 s = (v * v) * (-0.72134752044f);
    f32x2 e; e.x = __builtin_amdgcn_exp2f(s.x); e.y = __builtin_amdgcn_exp2f(s.y);
    const f32x2 m = v * (q * e), r = v - m;
    f32x2 o; o.x = v.x < 0.f ? m.x : r.x; o.y = v.y < 0.f ? m.y : r.y; return o;
}

template <int ACT  > struct EpiBf16 {
    static constexpr bool PERM = true, AFTER_DRAIN = false, CHAIN = false; static_assert(ACT == 0 || ACT == 1, "EpiBf16: ACT is 0 (none) or 1 (gelu_pk)");
    bf16_t* O; int ldc; const float* bias; int split_cols; size_t split_stride; float scale0;
    __device__ __forceinline__ void operator()(const f32x4 (&acc)[2][2][4][2], const Unit& u, int wr, int wc, int fr, int fq) const {
        const int row0 = u.pm * BM + wr * 64 + fr; int colt = u.pn * BM; bf16_t* base = O;
        float sc = 1.f; if (split_cols) { const int t = colt / split_cols; base += (size_t)t * split_stride; colt -= t * split_cols; if (t == 0) sc = scale0; }
        const int col0 = colt + wc * 32 + 8 * fq, bcol0 = u.pn * BM + wc * 32 + 8 * fq;
        f32x4 bv[2][2];
#pragma unroll
        for (int bj = 0; bj < 2; ++bj)
#pragma unroll
            for (int n = 0; n < 2; ++n) bv[bj][n] = bias ? *(const f32x4*)(bias + bcol0 + bj * HALF + 4 * n) : (f32x4){0.f, 0.f, 0.f, 0.f};
#pragma unroll
        for (int ai = 0; ai < 2; ++ai)
#pragma unroll
            for (int m = 0; m < 4; ++m) { bf16_t* rowp = base + (size_t)(row0 + ai * HALF + m * 16) * ldc + col0;
#pragma unroll
                for (int bj = 0; bj < 2; ++bj) { f32x4 v0 = acc[ai][bj][m][0] + bv[bj][0], v1 = acc[ai][bj][m][1] + bv[bj][1];
                    if (ACT == 1) { f32x2 a = gelu_pk((f32x2){v0[0], v0[1]}), b = gelu_pk((f32x2){v0[2], v0[3]}), c = gelu_pk((f32x2){v1[0], v1[1]}), d = gelu_pk((f32x2){v1[2], v1[3]});
                        v0 = (f32x4){a.x, a.y, b.x, b.y}; v1 = (f32x4){c.x, c.y, d.x, d.y}; }
                    v0 = v0 * sc; v1 = v1 * sc; u32x4 w; w.x = cvt_pk_bf16(v0[0], v0[1]); w.y = cvt_pk_bf16(v0[2], v0[3]); w.z = cvt_pk_bf16(v1[0], v1[1]); w.w = cvt_pk_bf16(v1[2], v1[3]);
                    *(u32x4*)(rowp + bj * HALF) = w; } }
    }
};
template <class Epi, class Sched, bool ALIGN_EPI = false, bool SP2 = false>
__device__ __forceinline__ void gemm_phase(PG8_LAS unsigned char* lds, const Gemm g, const Sched& S, const Epi& E) {
    int tid_ = threadIdx.x; asm volatile("" : "+v"(tid_));
    const int tid = tid_, wid = __builtin_amdgcn_readfirstlane(tid >> 6), lane = tid & 63, wr = wid >> 2, wc = wid & 3, fr = lane & 15, fq = lane >> 4;
    const int K = g.K, nt = K / BK;
    unsigned voffA[2], voffB[2];
#pragma unroll
    for (int i = 0; i < 2; ++i) { int R, C; stage_rc(tid * 16 + i * 8192, R, C); const int Rb = Epi::PERM ? ((R & ~31) + perm32(R & 31)) : R;
        voffA[i] = (unsigned)(R * K + C) * 2u; voffB[i] = (unsigned)(Rb * K + C) * 2u; }
    const size_t kstep = (size_t)(BK * 2);
    const size_t hstep = (size_t)HALF * K * 2;
    const size_t tstep = 2 * hstep;
    const unsigned ldsw = (unsigned)wid * 1024u;
    const int aoff = lds_byte(wr * 64 + fr, fq * 8), boff = lds_byte(wc * 32 + fr, fq * 8);
#define PG8_SA(b, h) (((b) * 2 + (h)) * HTB)
#define PG8_SB(b, h) ((4 + (b) * 2 + (h)) * HTB)
#define PG8_STAGE(bufoff, gbase, voff) do { _Pragma("unroll") for (int _i = 0; _i < 2; ++_i) \
        __builtin_amdgcn_global_load_lds((const unsigned*)((const char*)(gbase) + (voff)[_i]), (PG8_LAS unsigned*)(lds + (bufoff) + ldsw + _i * 8192), 16, 0, 0); } while (0)
#define PG8_LDA(dst, b, h) do { _Pragma("unroll") for (int m = 0; m < 4; ++m) _Pragma("unroll") for (int k = 0; k < 2; ++k) dst[m][k] = *(const PG8_LAS bf16x8*)(lds + PG8_SA(b, h) + aoff + m * 2048 + k * 1024); } while (0)
#define PG8_LDB(dst, b, h) do { _Pragma("unroll") for (int n = 0; n < 2; ++n) _Pragma("unroll") for (int k = 0; k < 2; ++k) dst[n][k] = *(const PG8_LAS bf16x8*)(lds + PG8_SB(b, h) + boff + n * 2048 + k * 1024); } while (0)
#define PG8_MMA(ai, bj, At, Bt) do { __builtin_amdgcn_s_setprio(1); _Pragma("unroll") for (int m = 0; m < 4; ++m) _Pragma("unroll") for (int n = 0; n < 2; ++n) _Pragma("unroll") for (int k = 0; k < 2; ++k) \
        acc[ai][bj][m][n] = __builtin_amdgcn_mfma_f32_16x16x32_bf16(Bt[n][k], At[m][k], acc[ai][bj][m][n], 0, 0, 0); __builtin_amdgcn_s_setprio(0); } while (0)
#define PG8_WAIT_V(n) asm volatile("s_waitcnt vmcnt(" #n ")" ::: "memory")
#define PG8_WAIT_L(n) asm volatile("s_waitcnt lgkmcnt(" #n ")" ::: "memory")
#define PG8_BAR __builtin_amdgcn_s_barrier()
#define PG8_SCHED __builtin_amdgcn_sched_barrier(0)
    Unit cur, nxt; int ui = 0;
    if (!S.next(0, cur)) return;
    f32x4 acc[2][2][4][2];
#pragma unroll
    for (int a = 0; a < 2; ++a)
#pragma unroll
        for (int b = 0; b < 2; ++b)
#pragma unroll
            for (int m = 0; m < 4; ++m)
#pragma unroll
                for (int n = 0; n < 2; ++n) acc[a][b][m][n] = (f32x4){0.f, 0.f, 0.f, 0.f};
    bf16x8 At[4][2], B0[2][2], B1[2][2];
    const char* cA = (const char*)g.A + (size_t)cur.pm * tstep; const char* cB = (const char*)g.Bt + (size_t)cur.pn * tstep;
    S.a_ready(cur);
    if constexpr (SP2) {
        PG8_STAGE(PG8_SB(0, 0), cB, voffB); PG8_STAGE(PG8_SB(0, 1), cB + hstep, voffB); PG8_STAGE(PG8_SA(0, 0), cA, voffA); PG8_STAGE(PG8_SA(0, 1), cA + hstep, voffA);
        if (wr == 1) PG8_BAR;
        PG8_WAIT_V(2); PG8_BAR;
        PG8_STAGE(PG8_SB(1, 0), cB + kstep, voffB); PG8_STAGE(PG8_SA(1, 0), cA + kstep, voffA); PG8_STAGE(PG8_SB(1, 1), cB + hstep + kstep, voffB);
        PG8_WAIT_V(6); PG8_BAR;
    } else {
        PG8_STAGE(PG8_SB(0, 0), cB, voffB); PG8_STAGE(PG8_SA(0, 0), cA, voffA); PG8_STAGE(PG8_SB(0, 1), cB + hstep, voffB); PG8_STAGE(PG8_SA(0, 1), cA + hstep, voffA);
        if (wr == 1) PG8_BAR;
        PG8_WAIT_V(4); PG8_BAR;
        PG8_STAGE(PG8_SB(1, 0), cB + kstep, voffB); PG8_STAGE(PG8_SA(1, 0), cA + kstep, voffA); PG8_STAGE(PG8_SB(1, 1), cB + hstep + kstep, voffB);
        PG8_WAIT_V(6); PG8_BAR;
    }
    for (;;) {
        const bool has_next = S.next(ui + 1, nxt);
        const char* nA = has_next ? (const char*)g.A + (size_t)nxt.pm * tstep : cA; const char* nB = has_next ? (const char*)g.Bt + (size_t)nxt.pn * tstep : cB;
        for (int t = 0; t < nt; t += 2) {
            const bool last = (t == nt - 2);
            const char* a1 = cA + (size_t)(t + 1) * kstep;
            const char* a2 = last ? nA : cA + (size_t)(t + 2) * kstep; const char* b2 = last ? nB : cB + (size_t)(t + 2) * kstep;
            const char* a3 = a2 + kstep; const char* b3 = b2 + kstep;
            if (last && has_next) S.a_ready(nxt);
            if constexpr (SP2) {
            PG8_LDB(B0, 0, 0); PG8_LDB(B1, 0, 1); PG8_SCHED; PG8_LDA(At, 0, 0); PG8_STAGE(PG8_SA(1, 1), a1 + hstep, voffA);
            PG8_WAIT_V(8); PG8_WAIT_L(0); PG8_BAR; PG8_MMA(0, 0, At, B0); PG8_MMA(0, 1, At, B1); PG8_BAR; PG8_SCHED;
            PG8_LDA(At, 0, 1); PG8_STAGE(PG8_SB(0, 0), b2, voffB); PG8_STAGE(PG8_SB(0, 1), b2 + hstep, voffB); PG8_STAGE(PG8_SA(0, 0), a2, voffA);
            PG8_WAIT_V(8); PG8_WAIT_L(0); PG8_BAR; PG8_MMA(1, 0, At, B0); PG8_MMA(1, 1, At, B1); PG8_BAR; PG8_SCHED;
            PG8_LDB(B0, 1, 0); PG8_LDB(B1, 1, 1); PG8_SCHED; PG8_LDA(At, 1, 0); PG8_STAGE(PG8_SA(0, 1), a2 + hstep, voffA);
            PG8_WAIT_V(8); PG8_WAIT_L(0); PG8_BAR; PG8_MMA(0, 0, At, B0); PG8_MMA(0, 1, At, B1); PG8_BAR; PG8_SCHED;
            PG8_LDA(At, 1, 1); PG8_STAGE(PG8_SB(1, 0), b3, voffB); PG8_STAGE(PG8_SB(1, 1), b3 + hstep, voffB); PG8_STAGE(PG8_SA(1, 0), a3, voffA);
            PG8_WAIT_V(8); PG8_WAIT_L(0); PG8_BAR; PG8_MMA(1, 0, At, B0); PG8_MMA(1, 1, At, B1); PG8_BAR; PG8_SCHED;
            } else {
            PG8_LDB(B0, 0, 0); PG8_SCHED; PG8_LDA(At, 0, 0); PG8_STAGE(PG8_SA(1, 1), a1 + hstep, voffA);
            PG8_WAIT_L(8); PG8_BAR; PG8_WAIT_L(0); PG8_MMA(0, 0, At, B0); PG8_BAR; PG8_SCHED;
            PG8_LDB(B1, 0, 1); PG8_STAGE(PG8_SB(0, 0), b2, voffB);
            PG8_BAR; PG8_WAIT_L(0); PG8_MMA(0, 1, At, B1); PG8_BAR;
            PG8_LDA(At, 0, 1); PG8_STAGE(PG8_SA(0, 0), a2, voffA);
            PG8_BAR; PG8_WAIT_L(0); PG8_MMA(1, 0, At, B0); PG8_BAR; PG8_SCHED;
            PG8_STAGE(PG8_SB(0, 1), b2 + hstep, voffB);
            PG8_WAIT_V(6); PG8_BAR; PG8_MMA(1, 1, At, B1); PG8_BAR;
            PG8_LDB(B0, 1, 0); PG8_SCHED; PG8_LDA(At, 1, 0); PG8_STAGE(PG8_SA(0, 1), a2 + hstep, voffA);
            PG8_WAIT_L(8); PG8_BAR; PG8_WAIT_L(0); PG8_MMA(0, 0, At, B0); PG8_BAR; PG8_SCHED;
            PG8_LDB(B1, 1, 1); PG8_STAGE(PG8_SB(1, 0), b3, voffB);
            PG8_BAR; PG8_WAIT_L(0); PG8_MMA(0, 1, At, B1); PG8_BAR;
            PG8_LDA(At, 1, 1); PG8_STAGE(PG8_SA(1, 0), a3, voffA);
            PG8_BAR; PG8_WAIT_L(0); PG8_MMA(1, 0, At, B0); PG8_BAR; PG8_SCHED;
            PG8_STAGE(PG8_SB(1, 1), b3 + hstep, voffB);
            PG8_WAIT_V(6); PG8_BAR; PG8_MMA(1, 1, At, B1); PG8_BAR;
            }
        }
        if constexpr (ALIGN_EPI) { if (wr == 0) PG8_BAR; }
        bool keep_acc = false;
        if constexpr (Epi::CHAIN) { keep_acc = E.chain(acc, cur, wr, wc, fr, fq); S.done(cur); }
        else if constexpr (!Epi::AFTER_DRAIN) { E(acc, cur, wr, wc, fr, fq); S.done(cur); }
        if (!has_next) break;
        if (!keep_acc) {
#pragma unroll
        for (int a = 0; a < 2; ++a)
#pragma unroll
            for (int b = 0; b < 2; ++b)
#pragma unroll
                for (int m = 0; m < 4; ++m)
#pragma unroll
                    for (int n = 0; n < 2; ++n) acc[a][b][m][n] = (f32x4){0.f, 0.f, 0.f, 0.f};
        }
        cur = nxt; cA = nA; cB = nB; ++ui;
        if constexpr (ALIGN_EPI) { if (wr == 1) PG8_BAR; }
    }
    PG8_WAIT_V(0);
    if constexpr (!ALIGN_EPI) { if (wr == 0) PG8_BAR; }
    PG8_BAR;
    if constexpr (Epi::AFTER_DRAIN) { E.fused(acc, cur, wr, wc, fr, fq, lds, wid, lane); S.done(cur); }
#undef PG8_SA
#undef PG8_SB
#undef PG8_STAGE
#undef PG8_LDA
#undef PG8_LDB
#undef PG8_MMA
#undef PG8_WAIT_V
#undef PG8_WAIT_L
#undef PG8_BAR
#undef PG8_SCHED
}
}

#define LAS __attribute__((address_space(3)))
typedef unsigned short bf16;
typedef short bf16x8 __attribute__((ext_vector_type(8)));
typedef float f32x4 __attribute__((ext_vector_type(4)));
typedef unsigned u32x4 __attribute__((ext_vector_type(4)));
typedef unsigned u32x2 __attribute__((ext_vector_type(2)));

constexpr int D = 1024, NB = 8, T = 4096, CL = 256;
constexpr int ML = NB * T, MC = NB * CL, M = ML + MC;
constexpr int NZA = 3328, NZG = 3072;
constexpr int C_RQ = 0, C_RK = 256, C_RV = 512, C_RG = 1024, C_SU = 1536, C_SV = 2048, C_AQ = 2560, C_AK = 3072, C_AV = 3200;
constexpr int NE = 16, CAPL = 512, CAPC = 32, ME = NB * (CAPL + CAPC);
constexpr int NCH = 34;
constexpr float EPS = 1e-6f, LOG2E = 1.4426950408889634f;
constexpr int LDS_BYTES = 147456;

constexpr size_t MiB = 1u << 20;
constexpr size_t WS_ROPEC = 1 * MiB, WS_ROPES = 1 * MiB + 512 * 1024, WS_MODV = 2 * MiB, WS_AFF = 3 * MiB, WS_AFFC = 5 * MiB, WS_INV = 6 * MiB, WS_TOPW = 9 * MiB;
constexpr size_t WS_WTIN = 16 * MiB, WS_WTBR = WS_WTIN + (size_t)6400 * 1024 * 2, WS_WTOUT = WS_WTBR + (size_t)3072 * 512 * 2;
constexpr size_t WS_X = 34 * MiB, WS_H = 170 * MiB, WS_R = 238 * MiB;
constexpr size_t WS_ZA = WS_R, WS_G = WS_R, WS_RS = 459 * MiB, WS_ST = 527 * MiB;
constexpr size_t WS_XS = WS_R, WS_ACT = 374 * MiB, WS_WT1 = 510 * MiB, WS_WT2 = 574 * MiB, WS_END = 606 * MiB;
static_assert(WS_WTOUT + 2 * MiB <= WS_X && WS_ZA + (size_t)M * NZA * 2 <= WS_RS && WS_ST + (size_t)NB * 4 * NCH * 128 * 128 * 2 <= WS_END, "ws map");

struct KP {
    const float *x, *c, *ctx, *c_ctx, *w_mod, *b_mod, *norm1_g, *norm2_g, *w_in, *dec_f, *dec_b, *sgu_w, *sgu_b, *qn_g, *kn_g, *sink, *w_branch, *w_out, *w_router, *w_eg, *w_eu, *w_ed;
    float* out; unsigned char* ws;
};
typedef const __attribute__((address_space(4))) KP* KPC;

#define LDS_WAIT() asm volatile("s_waitcnt lgkmcnt(0)" ::: "memory")
__device__ __forceinline__ unsigned pk2(float lo, float hi) { return pg8::cvt_pk_bf16(lo, hi); }
__device__ __forceinline__ float bflo(unsigned w) { return __uint_as_float(w << 16); }
__device__ __forceinline__ float bfhi(unsigned w) { return __uint_as_float(w & 0xffff0000u); }
__device__ __forceinline__ void unpack8(const u32x4 w, float (&f)[8]) { f[0] = bflo(w.x); f[1] = bfhi(w.x); f[2] = bflo(w.y); f[3] = bfhi(w.y); f[4] = bflo(w.z); f[5] = bfhi(w.z); f[6] = bflo(w.w); f[7] = bfhi(w.w); }
__device__ __forceinline__ u32x4 pack8(const float (&f)[8]) { u32x4 o; o.x = pk2(f[0], f[1]); o.y = pk2(f[2], f[3]); o.z = pk2(f[4], f[5]); o.w = pk2(f[6], f[7]); return o; }
template <int MASK> __device__ __forceinline__ float swz_xor(float v) { static_assert(MASK > 0 && MASK < 32, "swz_xor: 1..31"); return __builtin_bit_cast(float, __builtin_amdgcn_ds_swizzle(__builtin_bit_cast(int, v), 0x1f | (MASK << 10))); }
template <int MASK> __device__ __forceinline__ int swz_xor_i(int v) { return __builtin_amdgcn_ds_swizzle(v, 0x1f | (MASK << 10)); }
__device__ __forceinline__ float sum_x32(float v) { const unsigned u = __builtin_bit_cast(unsigned, v); auto r = __builtin_amdgcn_permlane32_swap(u, u, false, false); return __builtin_bit_cast(float, (unsigned)r[0]) + __builtin_bit_cast(float, (unsigned)r[1]); }
__device__ __forceinline__ float max_x32(float v) { const unsigned u = __builtin_bit_cast(unsigned, v); auto r = __builtin_amdgcn_permlane32_swap(u, u, false, false); return fmaxf(__builtin_bit_cast(float, (unsigned)r[0]), __builtin_bit_cast(float, (unsigned)r[1])); }
__device__ __forceinline__ int sum_x32_i(int v) { auto r = __builtin_amdgcn_permlane32_swap((unsigned)v, (unsigned)v, false, false); return (int)r[0] + (int)r[1]; }
__device__ __forceinline__ float wave_sum(float v) { v += swz_xor<1>(v); v += swz_xor<2>(v); v += swz_xor<4>(v); v += swz_xor<8>(v); v += swz_xor<16>(v); return sum_x32(v); }
__device__ __forceinline__ float wave_max(float v) { v = fmaxf(v, swz_xor<1>(v)); v = fmaxf(v, swz_xor<2>(v)); v = fmaxf(v, swz_xor<4>(v)); v = fmaxf(v, swz_xor<8>(v)); v = fmaxf(v, swz_xor<16>(v)); return max_x32(v); }
__device__ __forceinline__ int wave_sum_i(int v) { v += swz_xor_i<1>(v); v += swz_xor_i<2>(v); v += swz_xor_i<4>(v); v += swz_xor_i<8>(v); v += swz_xor_i<16>(v); return sum_x32_i(v); }
__device__ __forceinline__ float sum_x16_x32(float v) { v += swz_xor<16>(v); return sum_x32(v); }
__device__ __forceinline__ float sum_x1_x2(float v) { v += swz_xor<1>(v); v += swz_xor<2>(v); return v; }
__device__ __forceinline__ float ex2(float x) { return __builtin_amdgcn_exp2f(x); }
__device__ __forceinline__ float sigmoidf_(float x) { return 1.f / (1.f + ex2(-x * LOG2E)); }
__device__ __forceinline__ float gelu_tanh(float x) { const float u = 0.7978845608028654f * (x + 0.044715f * x * x * x); return x / (1.f + ex2(-2.f * LOG2E * u)); }
__device__ __forceinline__ f32x4 mfma16(bf16x8 a, bf16x8 b, f32x4 c) { return __builtin_amdgcn_mfma_f32_16x16x32_bf16(a, b, c, 0, 0, 0); }
__device__ __forceinline__ bf16x8 as_bf16x8(u32x4 w) { return __builtin_bit_cast(bf16x8, w); }
__device__ __forceinline__ float log2_sigmoid(float a) { return -log1pf(__expf(-a)) * LOG2E; }

struct GroupOrder {
    int nG, nM, nN, pmS, pnS, G, c;
    __device__ __forceinline__ bool next(int i, pg8::Unit& u) const {
        const long L = (long)i * G + c; const int tot = nG * nM * nN; if (L >= tot) return false;
        int wgid = (int)L; { const int q = tot / 8, r = tot % 8, xcd = wgid % 8, off = wgid / 8; wgid = (xcd < r ? xcd * (q + 1) : r * (q + 1) + (xcd - r) * q) + off; }
        const int per = nM * nN, g = wgid / per, rem = wgid - g * per;
        const int nig = 8 * nN, gid = rem / nig, fm = gid * 8, gsz = (nM - fm) < 8 ? (nM - fm) : 8;
        u.pm = g * pmS + fm + ((rem % nig) % gsz); u.pn = g * pnS + (rem % nig) / gsz; return true;
    }
    __device__ __forceinline__ void a_ready(const pg8::Unit&) const {}
    __device__ __forceinline__ void done(const pg8::Unit&) const {}
};
struct MergeOrder {
    int nM, G, c;
    __device__ __forceinline__ bool next(int i, pg8::Unit& u) const {
        const int ii = i / 3, g = i - 3 * ii; const long L = (long)ii * G + c; const int tot = nM * 4; if (L >= tot) return false;
        int wgid = (int)L; { const int q = tot / 8, r = tot % 8, xcd = wgid % 8, off = wgid / 8; wgid = (xcd < r ? xcd * (q + 1) : r * (q + 1) + (xcd - r) * q) + off; }
        const int nig = 32, gid = wgid / nig, fm = gid * 8, gsz = (nM - fm) < 8 ? (nM - fm) : 8;
        u.pm = g * (M / 256) + fm + ((wgid % nig) % gsz); u.pn = g * 4 + (wgid % nig) / gsz; return true;
    }
    __device__ __forceinline__ void a_ready(const pg8::Unit&) const {}
    __device__ __forceinline__ void done(const pg8::Unit&) const {}
};

struct EpiZA {
    static constexpr bool PERM = true, AFTER_DRAIN = false, CHAIN = false;
    bf16* O;
    __device__ __forceinline__ void operator()(const f32x4 (&acc)[2][2][4][2], const pg8::Unit& u, int wr, int wc, int fr, int fq) const {
        const int row0 = u.pm * 256 + wr * 64 + fr, col0 = u.pn * 256 + wc * 32 + 8 * fq; const bool act = (u.pn >= 6 && u.pn <= 9);
#pragma unroll
        for (int ai = 0; ai < 2; ++ai)
#pragma unroll
            for (int m = 0; m < 4; ++m) { bf16* rowp = O + (size_t)(row0 + ai * 128 + m * 16) * NZA + col0;
#pragma unroll
                for (int bj = 0; bj < 2; ++bj) { const f32x4 v0 = acc[ai][bj][m][0], v1 = acc[ai][bj][m][1];
                    float o[8] = {v0[0], v0[1], v0[2], v0[3], v1[0], v1[1], v1[2], v1[3]};
                    if (act) {
#pragma unroll
                        for (int k = 0; k < 8; ++k) o[k] = gelu_tanh(o[k]); }
                    *(u32x4*)(rowp + bj * 128) = pack8(o); } }
    }
};
struct EpiSig {
    static constexpr bool PERM = true, AFTER_DRAIN = false, CHAIN = false;
    bf16* O;
    __device__ __forceinline__ void operator()(const f32x4 (&acc)[2][2][4][2], const pg8::Unit& u, int wr, int wc, int fr, int fq) const {
        const int row0 = u.pm * 256 + wr * 64 + fr, col0 = u.pn * 256 + wc * 32 + 8 * fq;
#pragma unroll
        for (int ai = 0; ai < 2; ++ai)
#pragma unroll
            for (int m = 0; m < 4; ++m) { bf16* rowp = O + (size_t)(row0 + ai * 128 + m * 16) * NZG + col0;
#pragma unroll
                for (int bj = 0; bj < 2; ++bj) { const f32x4 v0 = acc[ai][bj][m][0], v1 = acc[ai][bj][m][1];
                    float o[8] = {v0[0], v0[1], v0[2], v0[3], v1[0], v1[1], v1[2], v1[3]};
#pragma unroll
                    for (int k = 0; k < 8; ++k) o[k] = fmaxf(sigmoidf_(o[k]), 1e-20f);
                    *(u32x4*)(rowp + bj * 128) = pack8(o); } }
    }
};
struct EpiMergeChain {
    static constexpr bool PERM = true, AFTER_DRAIN = false, CHAIN = true;
    const bf16* Gt; bf16* Hm;
    __device__ __forceinline__ bool chain(f32x4 (&acc)[2][2][4][2], const pg8::Unit& u, int wr, int wc, int fr, int fq) const {
        const int g = u.pm / (M / 256), m = u.pm - g * (M / 256), n = u.pn - g * 4;
        const int row0 = m * 256 + wr * 64 + fr, col0 = n * 256 + wc * 32 + 8 * fq;
#pragma unroll
        for (int ai = 0; ai < 2; ++ai) {
            u32x4 gw[4][2], hw[4][2];
#pragma unroll
            for (int mm = 0; mm < 4; ++mm)
#pragma unroll
                for (int bj = 0; bj < 2; ++bj) gw[mm][bj] = *(const u32x4*)(Gt + (size_t)(row0 + ai * 128 + mm * 16) * NZG + g * 1024 + col0 + bj * 128);
            if (g < 2) {
#pragma unroll
                for (int mm = 0; mm < 4; ++mm)
#pragma unroll
                    for (int bj = 0; bj < 2; ++bj) hw[mm][bj] = *(const u32x4*)(Gt + (size_t)(row0 + ai * 128 + mm * 16) * NZG + (g + 1) * 1024 + col0 + bj * 128);
            }
#pragma unroll
            for (int mm = 0; mm < 4; ++mm)
#pragma unroll
                for (int bj = 0; bj < 2; ++bj) {
                    float sc[8]; unpack8(gw[mm][bj], sc);
                    if (g < 2) { float sn[8]; unpack8(hw[mm][bj], sn);
#pragma unroll
                        for (int k = 0; k < 8; ++k) sc[k] *= __builtin_amdgcn_rcpf(sn[k]); }
                    f32x4& v0 = acc[ai][bj][mm][0]; f32x4& v1 = acc[ai][bj][mm][1];
                    v0[0] *= sc[0]; v0[1] *= sc[1]; v0[2] *= sc[2]; v0[3] *= sc[3]; v1[0] *= sc[4]; v1[1] *= sc[5]; v1[2] *= sc[6]; v1[3] *= sc[7];
                    if (g == 2) { u32x4 w; w.x = pk2(v0[0], v0[1]); w.y = pk2(v0[2], v0[3]); w.z = pk2(v1[0], v1[1]); w.w = pk2(v1[2], v1[3]);
                        *(u32x4*)(Hm + (size_t)(row0 + ai * 128 + mm * 16) * 1024 + col0 + bj * 128) = w; }
                }
        }
        return g < 2;
    }
};
struct EpiMerge {
    static constexpr bool PERM = true, AFTER_DRAIN = false, CHAIN = false;
    const bf16* Gt; bf16* Hm;
    __device__ __forceinline__ void operator()(const f32x4 (&acc)[2][2][4][2], const pg8::Unit& u, int wr, int wc, int fr, int fq) const {
        const int g = u.pm / (M / 256), m = u.pm - g * (M / 256), n = u.pn - g * 4;
        const int row0 = m * 256 + wr * 64 + fr, col0 = n * 256 + wc * 32 + 8 * fq;
#pragma unroll
        for (int ai = 0; ai < 2; ++ai) {
            u32x4 gw[4][2], ow[4][2];
#pragma unroll
            for (int mm = 0; mm < 4; ++mm)
#pragma unroll
                for (int bj = 0; bj < 2; ++bj) gw[mm][bj] = *(const u32x4*)(Gt + (size_t)(row0 + ai * 128 + mm * 16) * NZG + g * 1024 + col0 + bj * 128);
            if (g > 0) {
#pragma unroll
                for (int mm = 0; mm < 4; ++mm)
#pragma unroll
                    for (int bj = 0; bj < 2; ++bj) ow[mm][bj] = *(const u32x4*)(Hm + (size_t)(row0 + ai * 128 + mm * 16) * 1024 + col0 + bj * 128);
            }
#pragma unroll
            for (int mm = 0; mm < 4; ++mm)
#pragma unroll
                for (int bj = 0; bj < 2; ++bj) {
                    float gt[8]; unpack8(gw[mm][bj], gt);
                    const f32x4 v0 = acc[ai][bj][mm][0], v1 = acc[ai][bj][mm][1];
                    float o[8] = {v0[0], v0[1], v0[2], v0[3], v1[0], v1[1], v1[2], v1[3]};
#pragma unroll
                    for (int k = 0; k < 8; ++k) o[k] *= sigmoidf_(gt[k]);
                    if (g > 0) { float od[8]; unpack8(ow[mm][bj], od);
#pragma unroll
                        for (int k = 0; k < 8; ++k) o[k] += od[k]; }
                    *(u32x4*)(Hm + (size_t)(row0 + ai * 128 + mm * 16) * 1024 + col0 + bj * 128) = pack8(o);
                }
        }
    }
};
struct EpiOut {
    static constexpr bool PERM = false, AFTER_DRAIN = false, CHAIN = false;
    const float* xl; const float* xc; float* X; const float* modv;
    __device__ __forceinline__ void operator()(const f32x4 (&acc)[2][2][4][2], const pg8::Unit& u, int wr, int wc, int fr, int fq) const {
        const int row0 = u.pm * 256 + wr * 64 + fr, col0 = u.pn * 256 + wc * 32 + 4 * fq;
        const int bi = (u.pm * 256 < ML) ? ((u.pm * 256) >> 12) : 8;
        const float* g1 = modv + bi * 6144 + 2 * 1024;
        const float* src0 = (u.pm * 256 < ML) ? xl + (size_t)row0 * 1024 : xc + (size_t)(row0 - ML) * 1024;
        f32x4 gv[2][2];
#pragma unroll
        for (int bj = 0; bj < 2; ++bj)
#pragma unroll
            for (int n = 0; n < 2; ++n) gv[bj][n] = *(const f32x4*)(g1 + col0 + bj * 128 + n * 16);
#pragma unroll
        for (int ai = 0; ai < 2; ++ai) {
            f32x4 xv[4][2][2];
#pragma unroll
            for (int m = 0; m < 4; ++m)
#pragma unroll
                for (int bj = 0; bj < 2; ++bj)
#pragma unroll
                    for (int n = 0; n < 2; ++n) xv[m][bj][n] = *(const f32x4*)(src0 + (size_t)(ai * 128 + m * 16) * 1024 + col0 + bj * 128 + n * 16);
#pragma unroll
            for (int m = 0; m < 4; ++m)
#pragma unroll
                for (int bj = 0; bj < 2; ++bj)
#pragma unroll
                    for (int n = 0; n < 2; ++n) *(f32x4*)(X + (size_t)(row0 + ai * 128 + m * 16) * 1024 + col0 + bj * 128 + n * 16) = xv[m][bj][n] + gv[bj][n] * acc[ai][bj][m][n];
        }
    }
};
struct EpiMoe1 {
    static constexpr bool PERM = true, AFTER_DRAIN = false, CHAIN = false;
    bf16* ACT;
    __device__ __forceinline__ void operator()(const f32x4 (&acc)[2][2][4][2], const pg8::Unit& u, int wr, int wc, int fr, int fq) const {
        const int row0 = u.pm * 256 + wr * 64 + fr, col0 = (u.pn & 7) * 128 + wc * 32 + 8 * fq;
#pragma unroll
        for (int ai = 0; ai < 2; ++ai)
#pragma unroll
            for (int m = 0; m < 4; ++m) { const size_t r = (size_t)(row0 + ai * 128 + m * 16);
                const f32x4 a0 = acc[ai][0][m][0], a1 = acc[ai][0][m][1], u0 = acc[ai][1][m][0], u1 = acc[ai][1][m][1];
                float o[8];
#pragma unroll
                for (int k = 0; k < 4; ++k) { o[k] = a0[k] * sigmoidf_(a0[k]) * u0[k]; o[4 + k] = a1[k] * sigmoidf_(a1[k]) * u1[k]; }
                *(u32x4*)(ACT + r * 1024 + col0) = pack8(o); }
    }
};
struct EpiMoe2 {
    static constexpr bool PERM = true, AFTER_DRAIN = false, CHAIN = false;
    bf16* Y; const float* topw;
    __device__ __forceinline__ void operator()(const f32x4 (&acc)[2][2][4][2], const pg8::Unit& u, int wr, int wc, int fr, int fq) const {
        const int row0 = u.pm * 256 + wr * 64 + fr, col0 = (u.pn & 3) * 256 + wc * 32 + 8 * fq;
        float twv[2][4];
#pragma unroll
        for (int ai = 0; ai < 2; ++ai)
#pragma unroll
            for (int m = 0; m < 4; ++m) twv[ai][m] = topw[row0 + ai * 128 + m * 16];
#pragma unroll
        for (int ai = 0; ai < 2; ++ai)
#pragma unroll
            for (int m = 0; m < 4; ++m) { const size_t r = (size_t)(row0 + ai * 128 + m * 16); const float tw = twv[ai][m];
#pragma unroll
                for (int bj = 0; bj < 2; ++bj) { const f32x4 v0 = acc[ai][bj][m][0] * tw, v1 = acc[ai][bj][m][1] * tw;
                    u32x4 w; w.x = pk2(v0[0], v0[1]); w.y = pk2(v0[2], v0[3]); w.z = pk2(v1[0], v1[1]); w.w = pk2(v1[2], v1[3]);
                    *(u32x4*)(Y + r * 1024 + col0 + bj * 128) = w; } }
    }
};

__device__ __forceinline__ void tr_item(const float* W, int N, int k0, int n0, bf16* dst, int K, LAS float* scr, int lane) {
#pragma unroll 8
    for (int i = 0; i < 32; ++i) { const int kk = 2 * i + (lane >> 5); scr[kk * 33 + (lane & 31)] = W[(size_t)(k0 + kk) * N + n0 + (lane & 31)]; }
    LDS_WAIT();
    const int cc = lane & 7;
#pragma unroll
    for (int j = 0; j < 4; ++j) { const int n = (lane >> 3) + 8 * j; const LAS float* s = scr + (8 * cc) * 33 + n;
        u32x4 o; o.x = pk2(s[0 * 33], s[1 * 33]); o.y = pk2(s[2 * 33], s[3 * 33]); o.z = pk2(s[4 * 33], s[5 * 33]); o.w = pk2(s[6 * 33], s[7 * 33]);
        *(u32x4*)(dst + (size_t)n * K + 8 * cc) = o; }
    LDS_WAIT();
}
__device__ __forceinline__ void convert_small(KPC p, int l, LAS unsigned char* lds, int lane, int wave, int bid, int G) {
    LAS float* scr = (LAS float*)(lds + wave * 8448);
    const int gw = bid * 8 + wave, NGW = G * 8;
    constexpr int I_IN = 16 * 200, I_BR = 8 * 32, I_OUT = 16 * 32;
    bf16* wtin = (bf16*)(p->ws + WS_WTIN); bf16* wtbr = (bf16*)(p->ws + WS_WTBR); bf16* wtout = (bf16*)(p->ws + WS_WTOUT);
    for (int it = gw; it < I_IN + 3 * I_BR + I_OUT; it += NGW) {
        int r = it;
        if (r < I_IN) { const int kb = r / 200, nb = r % 200; tr_item(p->w_in + (size_t)l * 1024 * 6400, 6400, 64 * kb, 32 * nb, wtin + (size_t)(32 * nb) * 1024 + 64 * kb, 1024, scr, lane); continue; }
        r -= I_IN;
        if (r < 3 * I_BR) { const int br = r / I_BR, q = r % I_BR, kb = q / 32, nb = q % 32;
            tr_item(p->w_branch + ((size_t)l * 3 + br) * 512 * 1024, 1024, 64 * kb, 32 * nb, wtbr + (size_t)(br * 1024 + 32 * nb) * 512 + 64 * kb, 512, scr, lane); continue; }
        r -= 3 * I_BR;
        { const int kb = r / 32, nb = r % 32; tr_item(p->w_out + (size_t)l * 1024 * 1024, 1024, 64 * kb, 32 * nb, wtout + (size_t)(32 * nb) * 1024 + 64 * kb, 1024, scr, lane); }
    }
}
__device__ __forceinline__ void convert_experts(KPC p, int l, int lo, int hi, int widx, int nw, LAS unsigned char* lds, int lane, int wave) {
    LAS float* scr = (LAS float*)(lds + wave * 8448);
    bf16* wt1 = (bf16*)(p->ws + WS_WT1); bf16* wt2 = (bf16*)(p->ws + WS_WT2);
    for (int it = lo + widx; it < hi; it += nw) {
        const int e = it / 1536, q = it % 1536, which = q / 512, qq = q % 512, kb = qq / 32, nb = qq % 32, n0 = 32 * nb, k0 = 64 * kb;
        const size_t woff = ((size_t)l * NE + e) * 1024 * 1024;
        if (which == 0) tr_item(p->w_eg + woff, 1024, k0, n0, wt1 + ((size_t)e * 2048 + (n0 >> 7) * 256 + (n0 & 127)) * 1024 + k0, 1024, scr, lane);
        else if (which == 1) tr_item(p->w_eu + woff, 1024, k0, n0, wt1 + ((size_t)e * 2048 + (n0 >> 7) * 256 + 128 + (n0 & 127)) * 1024 + k0, 1024, scr, lane);
        else tr_item(p->w_ed + woff, 1024, k0, n0, wt2 + ((size_t)e * 1024 + n0) * 1024 + k0, 1024, scr, lane);
    }
}
constexpr int CVT_ITEMS = NE * 3 * 512;
constexpr int CVT_G_IDLE0 = 96, CVT_M_IDLE0 = 32, CVT_O_IDLE0 = 32;
constexpr int CVT_G_HI = 7680, CVT_M_HI = 7680 + 14336;

__device__ __forceinline__ void phase_prep(KPC p, LAS unsigned char* lds, int tid, int lane, int wave, int bid, int G) {
    unsigned char* ws = p->ws;
    {   float* rc = (float*)(ws + WS_ROPEC); float* rsn = (float*)(ws + WS_ROPES);
        for (int i = bid * 512 + tid; i < T * 32; i += G * 512) { const int t = i >> 5, f = i & 31; const int pos = (f < 16) ? (t >> 6) : (t & 63); const int fi = f & 15;
            const float inv = ex2(-(float)fi * (13.287712379549449f / 16.f));
            float ang = (float)pos * inv; ang -= 6.283185307179586f * rintf(ang * 0.15915494309189535f);
            rc[i] = __cosf(ang); rsn[i] = __sinf(ang); } }
    {   LAS float* sv = (LAS float*)lds;
        LAS float* red = (LAS float*)(lds + 36864);
        for (int i = tid; i < 9 * 1024; i += 512) { const int r = i >> 10, k = i & 1023; const float v = (r < 8) ? p->c[r * 1024 + k] : p->c_ctx[k]; sv[i] = v * sigmoidf_(v); }
        __syncthreads();
        for (int it = bid; it < 192; it += G) {
            const int l = it / 96, n0 = (it % 96) * 64;
            const float* W = p->w_mod + (size_t)l * 1024 * 6144 + n0 + lane;
            float acc[9];
#pragma unroll
            for (int r = 0; r < 9; ++r) acc[r] = 0.f;
#pragma unroll 4
            for (int k = wave * 128; k < wave * 128 + 128; ++k) { const float wv = W[(size_t)k * 6144];
#pragma unroll
                for (int r = 0; r < 9; ++r) acc[r] += sv[r * 1024 + k] * wv; }
#pragma unroll
            for (int r = 0; r < 9; ++r) red[(wave * 9 + r) * 64 + lane] = acc[r];
            __syncthreads();
            for (int i = tid; i < 576; i += 512) { const int r = i >> 6, ln = i & 63; float s = 0.f;
#pragma unroll
                for (int w = 0; w < 8; ++w) s += red[(w * 9 + r) * 64 + ln];
                s += p->b_mod[l * 6144 + n0 + ln]; ((float*)(ws + WS_MODV))[(l * 9 + r) * 6144 + n0 + ln] = s; }
            __syncthreads();
        }
    }
    __syncthreads();
    convert_small(p, 0, lds, lane, wave, bid, G);
}

__device__ __forceinline__ float row_rs(const f32x4 (&v)[4]) {
    float ss = 0.f;
#pragma unroll
    for (int j = 0; j < 4; ++j) ss += (v[j].x * v[j].x + v[j].y * v[j].y) + (v[j].z * v[j].z + v[j].w * v[j].w);
    return 1.0f / sqrtf(wave_sum(ss) * (1.f / 1024.f) + EPS);
}
__device__ __forceinline__ void norm_mod(const f32x4 (&v)[4], float rs, const float* gain, const float* sh, const float* sc, f32x4 (&h)[4], int lane) {
#pragma unroll
    for (int j = 0; j < 4; ++j) { const int col = 4 * lane + 256 * j; const f32x4 g = *(const f32x4*)(gain + col), a = *(const f32x4*)(sc + col), b = *(const f32x4*)(sh + col);
        h[j] = (v[j] * rs) * g * (a + 1.0f) + b; }
}
__device__ __forceinline__ void store_h(const f32x4 (&h)[4], bf16* hrow, int lane) {
#pragma unroll
    for (int j = 0; j < 4; ++j) { u32x2 w; w.x = pk2(h[j].x, h[j].y); w.y = pk2(h[j].z, h[j].w); *(u32x2*)(hrow + 4 * lane + 256 * j) = w; }
}
__device__ __forceinline__ void phase_norm_in(KPC p, int lane, int wave, int bid, int G) {
    const float* modv = (const float*)(p->ws + WS_MODV); bf16* H = (bf16*)(p->ws + WS_H);
    for (int r = bid * 8 + wave; r < M; r += G * 8) {
        const float* src = (r < ML) ? p->x + (size_t)r * 1024 : p->ctx + (size_t)(r - ML) * 1024; const int bi = (r < ML) ? (r >> 12) : 8;
        f32x4 v[4], h[4];
#pragma unroll
        for (int j = 0; j < 4; ++j) v[j] = *(const f32x4*)(src + 4 * lane + 256 * j);
        const float rs = row_rs(v);
        norm_mod(v, rs, p->norm1_g, modv + bi * 6144, modv + bi * 6144 + 1024, h, lane);
        store_h(h, H + (size_t)r * 1024, lane);
    }
}

__device__ __forceinline__ void att_item(KPC p, int l, LAS unsigned char* lds, int item, float Mb2, int tid, int lane, int wave) {
    const bf16* ZA = (const bf16*)(p->ws + WS_ZA); bf16* BR = (bf16*)p->out + (size_t)2 * M * 512;
    const float* rc = (const float*)(p->ws + WS_ROPEC); const float* rsn = (const float*)(p->ws + WS_ROPES);
    const bool isctx = item >= 512;
    int b, kvh, qb;
    if (!isctx) { b = item >> 6; kvh = (item >> 5) & 1; qb = item & 31; } else { const int ci = item - 512; b = ci >> 2; kvh = (ci >> 1) & 1; qb = ci & 1; }
    const int rowbase = isctx ? ML + b * CL : b * T;
    const int g = wave >> 1, qs = wave & 1, hh = kvh * 4 + g, c = lane & 15, g4 = lane >> 4, q0 = qb * 128 + qs * 64;
    const float* qg = p->qn_g + l * 64; const float* kg = p->kn_g + l * 64;
    LAS unsigned char* Kl = lds; LAS unsigned char* Vt = lds + 18432;
    bf16x8 qf[4][2];
#pragma unroll
    for (int ti = 0; ti < 4; ++ti) {
        const int pos = q0 + 16 * ti + c; const bf16* src = ZA + (size_t)(rowbase + pos) * NZA + C_AQ + hh * 64 + 8 * g4;
        float a[8], bb[8]; unpack8(*(const u32x4*)src, a); unpack8(*(const u32x4*)(src + 32), bb);
        float ss = 0.f;
#pragma unroll
        for (int j = 0; j < 8; ++j) ss += a[j] * a[j] + bb[j] * bb[j];
        ss = sum_x16_x32(ss);
        const float rs = 1.0f / sqrtf(ss * (1.f / 64.f) + EPS);
#pragma unroll
        for (int j = 0; j < 8; ++j) { a[j] *= rs * qg[8 * g4 + j]; bb[j] *= rs * qg[32 + 8 * g4 + j]; }
        if (!isctx) {
#pragma unroll
            for (int j = 0; j < 8; ++j) { const float cs = rc[pos * 32 + 8 * g4 + j], sn = rsn[pos * 32 + 8 * g4 + j]; const float x1 = a[j], x2 = bb[j]; a[j] = x1 * cs - x2 * sn; bb[j] = x1 * sn + x2 * cs; } }
#pragma unroll
        for (int j = 0; j < 8; ++j) { a[j] *= 0.125f * LOG2E; bb[j] *= 0.125f * LOG2E; }
        qf[ti][0] = as_bf16x8(pack8(a)); qf[ti][1] = as_bf16x8(pack8(bb));
        __builtin_amdgcn_sched_barrier(0);
    }
    f32x4 O[4][4]; float lsum[4];
#pragma unroll
    for (int i = 0; i < 4; ++i) { lsum[i] = 0.f;
#pragma unroll
        for (int j = 0; j < 4; ++j) O[i][j] = (f32x4){0.f, 0.f, 0.f, 0.f}; }
    const int ntile = isctx ? 2 : 5;
    for (int kt = 0; kt < ntile; ++kt) {
        int krow0, kpos0 = 0, mode = 0; bool local = false;
        if (isctx) krow0 = ML + b * CL + 128 * kt;
        else if (kt < 3) { const int kb = qb - 1 + kt; if (kb < 0 || kb > 31) continue; krow0 = b * T + kb * 128; kpos0 = kb * 128; local = true; mode = (kt == 0) ? 1 : ((kt == 2) ? 2 : 0); }
        else krow0 = ML + b * CL + 128 * (kt - 3);
        __syncthreads();
        {
            const int key = tid >> 2, q4 = tid & 3; const bf16* src = ZA + (size_t)(krow0 + key) * NZA + C_AK + kvh * 64 + 8 * q4;
            float a[8], bb[8]; unpack8(*(const u32x4*)src, a); unpack8(*(const u32x4*)(src + 32), bb);
            float ss = 0.f;
#pragma unroll
            for (int j = 0; j < 8; ++j) ss += a[j] * a[j] + bb[j] * bb[j];
            ss = sum_x1_x2(ss);
            const float rs = 1.0f / sqrtf(ss * (1.f / 64.f) + EPS);
#pragma unroll
            for (int j = 0; j < 8; ++j) { a[j] *= rs * kg[8 * q4 + j]; bb[j] *= rs * kg[32 + 8 * q4 + j]; }
            if (local) { const int pos = kpos0 + key;
#pragma unroll
                for (int j = 0; j < 8; ++j) { const float cs = rc[pos * 32 + 8 * q4 + j], sn = rsn[pos * 32 + 8 * q4 + j]; const float x1 = a[j], x2 = bb[j]; a[j] = x1 * cs - x2 * sn; bb[j] = x1 * sn + x2 * cs; } }
            *(LAS u32x4*)(Kl + key * 144 + 16 * q4) = pack8(a); *(LAS u32x4*)(Kl + key * 144 + 64 + 16 * q4) = pack8(bb);
            const bf16* vs = ZA + (size_t)(krow0 + key) * NZA + C_AV + kvh * 64 + 16 * q4;
            const u32x4 v0 = *(const u32x4*)vs, v1 = *(const u32x4*)(vs + 8);
            const unsigned vw[8] = {v0.x, v0.y, v0.z, v0.w, v1.x, v1.y, v1.z, v1.w};
#pragma unroll
            for (int j = 0; j < 8; ++j) { *(LAS unsigned short*)(Vt + (16 * q4 + 2 * j) * 272 + key * 2) = (unsigned short)(vw[j] & 0xffffu); *(LAS unsigned short*)(Vt + (16 * q4 + 2 * j + 1) * 272 + key * 2) = (unsigned short)(vw[j] >> 16); }
        }
        __syncthreads();
#pragma unroll 1
        for (int kk = 0; kk < 4; ++kk) {
            if ((mode == 1 && 32 * kk + 31 < qs * 64) || (mode == 2 && 32 * kk > qs * 64 + 63)) continue;
            bf16x8 ka[2][2];
#pragma unroll
            for (int hf = 0; hf < 2; ++hf)
#pragma unroll
                for (int ks = 0; ks < 2; ++ks) ka[hf][ks] = *(const LAS bf16x8*)(Kl + (32 * kk + 16 * hf + c) * 144 + ks * 64 + g4 * 16);
            bf16x8 pf[4];
#pragma unroll
            for (int ti = 0; ti < 4; ++ti) {
                f32x4 sa = (f32x4){0.f, 0.f, 0.f, 0.f}, sb = (f32x4){0.f, 0.f, 0.f, 0.f};
                sa = mfma16(ka[0][0], qf[ti][0], sa); sa = mfma16(ka[0][1], qf[ti][1], sa);
                sb = mfma16(ka[1][0], qf[ti][0], sb); sb = mfma16(ka[1][1], qf[ti][1], sb);
                const int ii = qs * 64 + 16 * ti + c; float pa[4], pb[4]; const int mlo = (mode == 1) ? ii : -1000, mhi = (mode == 2) ? ii : 1000;
#pragma unroll
                for (int rr = 0; rr < 4; ++rr) { const int ja = 32 * kk + 4 * g4 + rr, jb = ja + 16;
                    pa[rr] = ex2(sa[rr] - Mb2); pb[rr] = ex2(sb[rr] - Mb2);
                    pa[rr] = (ja >= mlo && ja <= mhi) ? pa[rr] : 0.f; pb[rr] = (jb >= mlo && jb <= mhi) ? pb[rr] : 0.f;
                    lsum[ti] += pa[rr] + pb[rr]; }
                u32x4 w; w.x = pk2(pa[0], pa[1]); w.y = pk2(pa[2], pa[3]); w.z = pk2(pb[0], pb[1]); w.w = pk2(pb[2], pb[3]); pf[ti] = as_bf16x8(w);
            }
#pragma unroll
            for (int dt = 0; dt < 4; ++dt) {
                const u32x2 v0 = *(const LAS u32x2*)(Vt + (16 * dt + c) * 272 + (32 * kk + 4 * g4) * 2), v1 = *(const LAS u32x2*)(Vt + (16 * dt + c) * 272 + (32 * kk + 16 + 4 * g4) * 2);
                u32x4 vv; vv.x = v0.x; vv.y = v0.y; vv.z = v1.x; vv.w = v1.y; const bf16x8 va = as_bf16x8(vv);
#pragma unroll
                for (int ti = 0; ti < 4; ++ti) O[dt][ti] = mfma16(va, pf[ti], O[dt][ti]);
            }
        }
    }
    const float sk = ex2(p->sink[l * 8 + hh] * LOG2E - Mb2);
#pragma unroll
    for (int ti = 0; ti < 4; ++ti) { float lt = sum_x16_x32(lsum[ti]); const float inv = 1.0f / (lt + sk);
        bf16* dst = BR + (size_t)(rowbase + q0 + 16 * ti + c) * 512 + hh * 64 + 4 * g4;
#pragma unroll
        for (int dt = 0; dt < 4; ++dt) { const f32x4 o = O[dt][ti] * inv; u32x2 w; w.x = pk2(o[0], o[1]); w.y = pk2(o[2], o[3]); *(u32x2*)(dst + 16 * dt) = w; } }
    __syncthreads();
}

__device__ __forceinline__ void sgu_item(KPC p, int l, LAS unsigned char* lds, int item, int tid, int lane, int wave) {
    const bf16* ZA = (const bf16*)(p->ws + WS_ZA); bf16* BR = (bf16*)p->out + (size_t)1 * M * 512;
    const int ch = item >> 2, g = item & 3, r0 = ch * 128, c = lane & 15, g4 = lane >> 4;
    LAS unsigned char* vT = lds;
    LAS unsigned char* WL = lds + 34816;
    {
        const int j = tid >> 2, q4 = tid & 3; const bf16* src = ZA + (size_t)(r0 + j) * NZA + C_SV + 32 * q4;
        float s = 0.f, ss = 0.f;
#pragma unroll
        for (int k = 0; k < 4; ++k)
#pragma unroll
            for (int q = 0; q < 4; ++q) { float f[8]; unpack8(*(const u32x4*)(src + 128 * k + 8 * q), f);
#pragma unroll
                for (int e = 0; e < 8; ++e) { const float y = f[e]; s += y; ss += y * y; } }
        s = sum_x1_x2(s); ss = sum_x1_x2(ss);
        const float mean = s * (1.f / 512.f), var = fmaxf(ss * (1.f / 512.f) - mean * mean, 0.f), rstd = 1.0f / sqrtf(var + EPS);
#pragma unroll
        for (int q = 0; q < 4; ++q) { float f[8]; unpack8(*(const u32x4*)(src + 128 * g + 8 * q), f);
#pragma unroll
            for (int e = 0; e < 8; e += 2) { const float y0 = (f[e] - mean) * rstd, y1 = (f[e + 1] - mean) * rstd; const unsigned w = pk2(y0, y1);
                *(LAS unsigned short*)(vT + (32 * q4 + 8 * q + e) * 272 + j * 2) = (unsigned short)(w & 0xffffu); *(LAS unsigned short*)(vT + (32 * q4 + 8 * q + e + 1) * 272 + j * 2) = (unsigned short)(w >> 16); } }
        const float* wsrc = p->sgu_w + ((size_t)(l * 4 + g) * 128 + (tid >> 2)) * 128 + 32 * (tid & 3);
#pragma unroll
        for (int q = 0; q < 4; ++q) { const f32x4 a = *(const f32x4*)(wsrc + 8 * q), bq = *(const f32x4*)(wsrc + 8 * q + 4);
            u32x4 w; w.x = pk2(a.x, a.y); w.y = pk2(a.z, a.w); w.z = pk2(bq.x, bq.y); w.w = pk2(bq.z, bq.w);
            *(LAS u32x4*)(WL + (tid >> 2) * 272 + (32 * (tid & 3) + 8 * q) * 2) = w; }
    }
    __syncthreads();
    bf16x8 af[4];
#pragma unroll
    for (int ks = 0; ks < 4; ++ks) af[ks] = *(const LAS bf16x8*)(vT + (16 * wave + c) * 272 + (32 * ks + 8 * g4) * 2);
#pragma unroll 2
    for (int ti = 0; ti < 8; ++ti) {
        f32x4 acc = (f32x4){0.f, 0.f, 0.f, 0.f};
#pragma unroll
        for (int ks = 0; ks < 4; ++ks) acc = mfma16(af[ks], *(const LAS bf16x8*)(WL + (16 * ti + c) * 272 + (32 * ks + 8 * g4) * 2), acc);
        const int i = 16 * ti + c; const float bias = p->sgu_b[(l * 4 + g) * 128 + i];
        const int col = 128 * g + 16 * wave + 4 * g4;
        const u32x2 uw = *(const u32x2*)(ZA + (size_t)(r0 + i) * NZA + C_SU + col);
        const float o0 = bflo(uw.x) * (acc[0] + bias), o1 = bfhi(uw.x) * (acc[1] + bias), o2 = bflo(uw.y) * (acc[2] + bias), o3 = bfhi(uw.y) * (acc[3] + bias);
        u32x2 w; w.x = pk2(o0, o1); w.y = pk2(o2, o3); *(u32x2*)(BR + (size_t)(r0 + i) * 512 + col) = w;
    }
    __syncthreads();
}

__device__ __forceinline__ void ret_load_k(KPC p, const bf16* ZA, int r0, int h, bool latent, int pos0, int tid, float (&a)[8], float (&bb)[8]) {
    const int j = tid >> 2, q4 = tid & 3; const bf16* src = ZA + (size_t)(r0 + j) * NZA + C_RK + 64 * h + 8 * q4;
    unpack8(*(const u32x4*)src, a); unpack8(*(const u32x4*)(src + 32), bb);
    if (latent) { const float* rc = (const float*)(p->ws + WS_ROPEC); const float* rsn = (const float*)(p->ws + WS_ROPES); const int pos = pos0 + j;
#pragma unroll
        for (int e = 0; e < 8; ++e) { const float cs = rc[pos * 32 + 8 * q4 + e], sn = rsn[pos * 32 + 8 * q4 + e]; const float x1 = a[e], x2 = bb[e]; a[e] = x1 * cs - x2 * sn; bb[e] = x1 * sn + x2 * cs; } }
#pragma unroll
    for (int e = 0; e < 8; ++e) { a[e] *= 0.125f; bb[e] *= 0.125f; }
}
__device__ __forceinline__ void ret_stage_vT(const bf16* ZA, int r0, int h, LAS unsigned char* vT, int tid) {
    const int j = tid >> 2, q4 = tid & 3; const bf16* src = ZA + (size_t)(r0 + j) * NZA + C_RV + 128 * h + 32 * q4;
#pragma unroll
    for (int q = 0; q < 4; ++q) { const u32x4 v = *(const u32x4*)(src + 8 * q); const unsigned vw[4] = {v.x, v.y, v.z, v.w};
#pragma unroll
        for (int e = 0; e < 4; ++e) { *(LAS unsigned short*)(vT + (32 * q4 + 8 * q + 2 * e) * 272 + j * 2) = (unsigned short)(vw[e] & 0xffffu); *(LAS unsigned short*)(vT + (32 * q4 + 8 * q + 2 * e + 1) * 272 + j * 2) = (unsigned short)(vw[e] >> 16); } }
}
__device__ __forceinline__ void ret_upd_item(KPC p, int l, LAS unsigned char* lds, int item, int tid, int lane, int wave) {
    const bf16* ZA = (const bf16*)(p->ws + WS_ZA); float* RS = (float*)(p->ws + WS_RS);
    const int b = item / (NCH * 4), rem = item % (NCH * 4), n = rem >> 2, h = rem & 3, c = lane & 15, g4 = lane >> 4;
    const bool latent = n < 32; const int r0 = latent ? b * T + 128 * n : ML + b * CL + 128 * (n - 32);
    const float lgf = log2_sigmoid(p->dec_f[l * 4 + h]), lgb = log2_sigmoid(p->dec_b[l * 4 + h]);
    LAS unsigned char* vT = lds; LAS unsigned char* kTf = lds + 34816; LAS unsigned char* kTb = lds + 34816 + 17408;
    {   float a[8], bb[8]; ret_load_k(p, ZA, r0, h, latent, 128 * n, tid, a, bb);
        const int j = tid >> 2, q4 = tid & 3; const float wf = ex2((float)(127 - j) * lgf), wb = ex2((float)j * lgb);
#pragma unroll
        for (int e = 0; e < 8; e += 2) {
            unsigned w = pk2(a[e] * wf, a[e + 1] * wf); *(LAS unsigned short*)(kTf + (8 * q4 + e) * 272 + j * 2) = (unsigned short)(w & 0xffffu); *(LAS unsigned short*)(kTf + (8 * q4 + e + 1) * 272 + j * 2) = (unsigned short)(w >> 16);
            w = pk2(bb[e] * wf, bb[e + 1] * wf); *(LAS unsigned short*)(kTf + (32 + 8 * q4 + e) * 272 + j * 2) = (unsigned short)(w & 0xffffu); *(LAS unsigned short*)(kTf + (32 + 8 * q4 + e + 1) * 272 + j * 2) = (unsigned short)(w >> 16);
            w = pk2(a[e] * wb, a[e + 1] * wb); *(LAS unsigned short*)(kTb + (8 * q4 + e) * 272 + j * 2) = (unsigned short)(w & 0xffffu); *(LAS unsigned short*)(kTb + (8 * q4 + e + 1) * 272 + j * 2) = (unsigned short)(w >> 16);
            w = pk2(bb[e] * wb, bb[e + 1] * wb); *(LAS unsigned short*)(kTb + (32 + 8 * q4 + e) * 272 + j * 2) = (unsigned short)(w & 0xffffu); *(LAS unsigned short*)(kTb + (32 + 8 * q4 + e + 1) * 272 + j * 2) = (unsigned short)(w >> 16);
        }
        ret_stage_vT(ZA, r0, h, vT, tid);
    }
    __syncthreads();
    bf16x8 af[4];
#pragma unroll
    for (int ks = 0; ks < 4; ++ks) af[ks] = *(const LAS bf16x8*)(vT + (16 * wave + c) * 272 + (32 * ks + 8 * g4) * 2);
#pragma unroll
    for (int dir = 0; dir < 2; ++dir) { const LAS unsigned char* kT = dir ? kTb : kTf;
        float* dst = RS + ((size_t)(((b * 4 + h) * 2 + dir) * NCH + n) * 128 + 16 * wave + 4 * g4) * 64;
#pragma unroll
        for (int dt = 0; dt < 4; ++dt) { f32x4 acc = (f32x4){0.f, 0.f, 0.f, 0.f};
#pragma unroll
            for (int ks = 0; ks < 4; ++ks) acc = mfma16(af[ks], *(const LAS bf16x8*)(kT + (16 * dt + c) * 272 + (32 * ks + 8 * g4) * 2), acc);
#pragma unroll
            for (int rr = 0; rr < 4; ++rr) dst[rr * 64 + 16 * dt + c] = acc[rr]; } }
    __syncthreads();
}
__device__ __forceinline__ void phase_scan(KPC p, int l, int tid, int bid, int G) {
    const float* RS = (const float*)(p->ws + WS_RS); bf16* ST = (bf16*)(p->ws + WS_ST);
    for (int idx = bid * 512 + tid; idx < NB * 4 * 2 * 8192; idx += G * 512) {
        const int ed = idx & 8191, dir = (idx >> 13) & 1, bh = idx >> 14, e = ed >> 6, d = ed & 63, h = bh & 3;
        const float* P = RS + (size_t)((bh * 2 + dir) * NCH) * 8192 + ed;
        bf16* S = ST + ((size_t)bh * NCH * 128 + e) * 128 + dir * 64 + d;
        const float lg = log2_sigmoid(dir ? p->dec_b[l * 4 + h] : p->dec_f[l * 4 + h]); const float dec = ex2(128.f * lg);
        const float u32 = P[32 * 8192], u33 = P[33 * 8192];
        if (dir == 0) {
            S[32 * 16384] = 0; S[33 * 16384] = (bf16)(pk2(u32, 0.f) & 0xffffu);
            float s = dec * u32 + u33;
            for (int n = 0; n < 32; ++n) { const float u = P[(size_t)n * 8192]; S[(size_t)n * 16384] = (bf16)(pk2(s, 0.f) & 0xffffu); s = dec * s + u; }
        } else {
            S[33 * 16384] = 0; S[32 * 16384] = (bf16)(pk2(u33, 0.f) & 0xffffu);
            float s = dec * u33 + u32;
            for (int n = 31; n >= 0; --n) { const float u = P[(size_t)n * 8192]; S[(size_t)n * 16384] = (bf16)(pk2(s, 0.f) & 0xffffu); s = dec * s + u; }
        }
    }
}
__device__ __forceinline__ void ret_out_item(KPC p, int l, LAS unsigned char* lds, int item, int tid, int lane, int wave) {
    const bf16* ZA = (const bf16*)(p->ws + WS_ZA); bf16* BR = (bf16*)p->out; const bf16* ST = (const bf16*)(p->ws + WS_ST);
    const int b = item / (NCH * 4), rem = item % (NCH * 4), n = rem >> 2, h = rem & 3, c = lane & 15, g4 = lane >> 4;
    const bool latent = n < 32; const int r0 = latent ? b * T + 128 * n : ML + b * CL + 128 * (n - 32);
    const float lgf = log2_sigmoid(p->dec_f[l * 4 + h]), lgb = log2_sigmoid(p->dec_b[l * 4 + h]);
    LAS unsigned char* vT = lds; LAS unsigned char* Kl = lds + 34816; LAS unsigned char* Sl = lds + 34816 + 18432;
    {   float a[8], bb[8]; ret_load_k(p, ZA, r0, h, latent, 128 * n, tid, a, bb);
        const int j = tid >> 2, q4 = tid & 3;
        *(LAS u32x4*)(Kl + j * 144 + 16 * q4) = pack8(a); *(LAS u32x4*)(Kl + j * 144 + 64 + 16 * q4) = pack8(bb);
        ret_stage_vT(ZA, r0, h, vT, tid);
        const u32x4* ssrc = (const u32x4*)(ST + (size_t)((b * 4 + h) * NCH + n) * 16384);
#pragma unroll
        for (int k = 0; k < 4; ++k) { const int q = tid + 512 * k; *(LAS u32x4*)(Sl + (q >> 4) * 272 + (q & 15) * 16) = ssrc[q]; }
    }
    __syncthreads();
    const int ii = 16 * wave + c;
    bf16x8 qf[2];
    {   const bf16* src = ZA + (size_t)(r0 + ii) * NZA + C_RQ + 64 * h + 8 * g4; float a[8], bb[8]; unpack8(*(const u32x4*)src, a); unpack8(*(const u32x4*)(src + 32), bb);
        if (latent) { const float* rc = (const float*)(p->ws + WS_ROPEC); const float* rsn = (const float*)(p->ws + WS_ROPES); const int pos = 128 * n + ii;
#pragma unroll
            for (int e = 0; e < 8; ++e) { const float cs = rc[pos * 32 + 8 * g4 + e], sn = rsn[pos * 32 + 8 * g4 + e]; const float x1 = a[e], x2 = bb[e]; a[e] = x1 * cs - x2 * sn; bb[e] = x1 * sn + x2 * cs; } }
        qf[0] = as_bf16x8(pack8(a)); qf[1] = as_bf16x8(pack8(bb)); }
    bf16x8 pf[4];
#pragma unroll
    for (int kk = 0; kk < 4; ++kk) {
        f32x4 sa = (f32x4){0.f, 0.f, 0.f, 0.f}, sb = (f32x4){0.f, 0.f, 0.f, 0.f};
        sa = mfma16(*(const LAS bf16x8*)(Kl + (32 * kk + c) * 144 + g4 * 16), qf[0], sa); sa = mfma16(*(const LAS bf16x8*)(Kl + (32 * kk + c) * 144 + 64 + g4 * 16), qf[1], sa);
        sb = mfma16(*(const LAS bf16x8*)(Kl + (32 * kk + 16 + c) * 144 + g4 * 16), qf[0], sb); sb = mfma16(*(const LAS bf16x8*)(Kl + (32 * kk + 16 + c) * 144 + 64 + g4 * 16), qf[1], sb);
        float pa[4], pb[4];
#pragma unroll
        for (int rr = 0; rr < 4; ++rr) { const int ja = 32 * kk + 4 * g4 + rr, jb = ja + 16; const int da = ii - ja, db = ii - jb;
            pa[rr] = sa[rr] * ((da >= 0) ? ex2((float)da * lgf) : ex2((float)(-da) * lgb)); pb[rr] = sb[rr] * ((db >= 0) ? ex2((float)db * lgf) : ex2((float)(-db) * lgb)); }
        u32x4 w; w.x = pk2(pa[0], pa[1]); w.y = pk2(pa[2], pa[3]); w.z = pk2(pb[0], pb[1]); w.w = pk2(pb[2], pb[3]); pf[kk] = as_bf16x8(w);
    }
    const float cf = ex2((float)(ii + 1) * lgf), cb = ex2((float)(128 - ii) * lgb);
    f32x4 O[8]; float s = 0.f, ss = 0.f;
#pragma unroll
    for (int et = 0; et < 8; ++et) {
        f32x4 acc = (f32x4){0.f, 0.f, 0.f, 0.f}, xf = (f32x4){0.f, 0.f, 0.f, 0.f}, xb = (f32x4){0.f, 0.f, 0.f, 0.f};
#pragma unroll
        for (int kk = 0; kk < 4; ++kk) { const u32x2 v0 = *(const LAS u32x2*)(vT + (16 * et + c) * 272 + (32 * kk + 4 * g4) * 2), v1 = *(const LAS u32x2*)(vT + (16 * et + c) * 272 + (32 * kk + 16 + 4 * g4) * 2);
            u32x4 vv; vv.x = v0.x; vv.y = v0.y; vv.z = v1.x; vv.w = v1.y; acc = mfma16(as_bf16x8(vv), pf[kk], acc); }
#pragma unroll
        for (int ks = 0; ks < 2; ++ks) { xf = mfma16(*(const LAS bf16x8*)(Sl + (16 * et + c) * 272 + (32 * ks + 8 * g4) * 2), qf[ks], xf);
            xb = mfma16(*(const LAS bf16x8*)(Sl + (16 * et + c) * 272 + (64 + 32 * ks + 8 * g4) * 2), qf[ks], xb); }
        acc = acc + xf * cf + xb * cb; O[et] = acc;
        s += (acc[0] + acc[1]) + (acc[2] + acc[3]); ss += (acc[0] * acc[0] + acc[1] * acc[1]) + (acc[2] * acc[2] + acc[3] * acc[3]);
    }
    s = sum_x16_x32(s); ss = sum_x16_x32(ss);
    const float mean = s * (1.f / 128.f), var = fmaxf(ss * (1.f / 128.f) - mean * mean, 0.f), rstd = 1.0f / sqrtf(var + EPS);
    const bf16* gsrc = ZA + (size_t)(r0 + ii) * NZA + C_RG + 128 * h + 4 * g4; bf16* dst = BR + (size_t)(r0 + ii) * 512 + 128 * h + 4 * g4;
#pragma unroll
    for (int et = 0; et < 8; ++et) { const u32x2 gw = *(const u32x2*)(gsrc + 16 * et); const float g0 = bflo(gw.x), g1 = bfhi(gw.x), g2 = bflo(gw.y), g3 = bfhi(gw.y);
        const float o0 = (O[et][0] - mean) * rstd * g0 * sigmoidf_(g0), o1 = (O[et][1] - mean) * rstd * g1 * sigmoidf_(g1), o2 = (O[et][2] - mean) * rstd * g2 * sigmoidf_(g2), o3 = (O[et][3] - mean) * rstd * g3 * sigmoidf_(g3);
        u32x2 w; w.x = pk2(o0, o1); w.y = pk2(o2, o3); *(u32x2*)(dst + 16 * et) = w; }
    __syncthreads();
}

#ifndef REP_CVT
#define REP_CVT 1
#endif
#ifndef REP_N2R
#define REP_N2R 1
#endif
#ifndef REP_TK
#define REP_TK 1
#endif
__device__ __forceinline__ int wr_off(int k) { return k * 64 + (k >> 2) * 16; }
__device__ __forceinline__ void phase_norm2(KPC p, int l, LAS unsigned char* lds, int tid, int lane, int wave, int bid, int G) {
    if (l == 1 || G != 256) { for (int rep = 0; rep < REP_CVT; ++rep) convert_experts(p, l, 0, CVT_ITEMS, bid * 8 + wave, G * 8, lds, lane, wave); __syncthreads(); }
    LAS unsigned char* wrl = lds + 69632;
    for (int i = tid; i < 1024 * 4; i += 512) { const int k = i >> 2, q = i & 3; *(LAS f32x4*)(wrl + wr_off(k) + 16 * q) = *(const f32x4*)(p->w_router + (size_t)l * 16384 + k * 16 + 4 * q); }
    __syncthreads();
    const float* modv = (const float*)(p->ws + WS_MODV) + l * 9 * 6144; const float* X = (const float*)(p->ws + WS_X); bf16* H = (bf16*)(p->ws + WS_H);
    float* AFF = (float*)(p->ws + WS_AFF); float* AFFC = (float*)(p->ws + WS_AFFC); int* INV = (int*)(p->ws + WS_INV);
    const int rows = (l == 0) ? M : ML;
    for (int rep = 0; rep < REP_N2R; ++rep)
    for (int r = bid * 8 + wave; r < rows; r += G * 8) {
        const int bi = (r < ML) ? (r >> 12) : 8;
        f32x4 v[4], h[4];
#pragma unroll
        for (int j = 0; j < 4; ++j) v[j] = *(const f32x4*)(X + (size_t)r * 1024 + 4 * lane + 256 * j);
        const float rs = row_rs(v);
        norm_mod(v, rs, p->norm2_g + l * 1024, modv + bi * 6144 + 3 * 1024, modv + bi * 6144 + 4 * 1024, h, lane);
        store_h(h, H + (size_t)r * 1024, lane);
        float lg[16];
#pragma unroll
        for (int e = 0; e < 16; ++e) lg[e] = 0.f;
#pragma unroll
        for (int j = 0; j < 4; ++j)
#pragma unroll
            for (int i = 0; i < 4; ++i) { const int k = 4 * lane + 256 * j + i; const float hv = h[j][i]; const LAS f32x4* wp = (const LAS f32x4*)(wrl + wr_off(k));
#pragma unroll
                for (int q = 0; q < 4; ++q) { const f32x4 w = wp[q]; lg[4 * q] += hv * w.x; lg[4 * q + 1] += hv * w.y; lg[4 * q + 2] += hv * w.z; lg[4 * q + 3] += hv * w.w; } }
        float mx = -1e30f;
#pragma unroll
        for (int e = 0; e < 16; ++e) { lg[e] = wave_sum(lg[e]); mx = fmaxf(mx, lg[e]); }
        float sum = 0.f;
#pragma unroll
        for (int e = 0; e < 16; ++e) { lg[e] = ex2((lg[e] - mx) * LOG2E); sum += lg[e]; }
        const float isum = 1.0f / sum; float mine = 0.f;
#pragma unroll
        for (int e = 0; e < 16; ++e) mine = (lane == e) ? lg[e] * isum : mine;
        if (lane < 16) { if (r < ML) AFF[((size_t)(bi * 16 + lane) << 12) + (r & 4095)] = mine; else AFFC[((r - ML) >> 8) * 4096 + lane * 256 + ((r - ML) & 255)] = mine;
            INV[(size_t)r * 16 + lane] = -1; }
    }
}

__device__ __forceinline__ int block_sum_i(int v, LAS int* red, int lane, int wave) {
    v = wave_sum_i(v);
    __syncthreads();
    if (lane == 0) red[wave] = v;
    __syncthreads();
    int s = 0;
#pragma unroll
    for (int w = 0; w < 8; ++w) s += red[w];
    return s;
}
__device__ __forceinline__ int block_excl_scan(int v, LAS int* red, int lane, int wave) {
    int inc = v;
#pragma unroll
    for (int o = 1; o < 64; o <<= 1) { const int t = __builtin_amdgcn_ds_bpermute((lane - o) << 2, inc); if (lane >= o) inc += t; }
    __syncthreads();
    if (lane == 63) red[wave] = inc;
    __syncthreads();
    int base = 0;
#pragma unroll
    for (int w = 0; w < 8; ++w) { const int x = red[w]; if (w < wave) base += x; }
    return base + inc - v;
}
template <int KPT>
__device__ __forceinline__ void topk_item(KPC p, const float* aff, int n, int cap, int rowbase, int e, int slotbase, int s_lo, int s_hi, bool writer, LAS unsigned char* lds, int tid, int lane, int wave) {
    const bf16* H = (const bf16*)(p->ws + WS_H); bf16* XS = (bf16*)(p->ws + WS_XS); float* topw = (float*)(p->ws + WS_TOPW); int* INV = (int*)(p->ws + WS_INV);
    LAS int* red = (LAS int*)lds; LAS int* rl = (LAS int*)(lds + 64);
    unsigned key[KPT]; const bool valid = tid * KPT < n;
#pragma unroll
    for (int j = 0; j < KPT; ++j) key[j] = valid ? __float_as_uint(aff[tid * KPT + j]) : 0u;
    unsigned Tsel = 0u;
    for (int bit = 30; bit >= 0; --bit) { const unsigned cand = Tsel | (1u << bit); int cnt = 0;
#pragma unroll
        for (int j = 0; j < KPT; ++j) cnt += (valid && key[j] >= cand) ? 1 : 0;
        if (block_sum_i(cnt, red, lane, wave) >= cap) Tsel = cand; }
    int cgt = 0, ceq = 0;
#pragma unroll
    for (int j = 0; j < KPT; ++j) { cgt += (valid && key[j] > Tsel) ? 1 : 0; ceq += (valid && key[j] == Tsel) ? 1 : 0; }
    const int need = cap - block_sum_i(cgt, red, lane, wave);
    int er = block_excl_scan(ceq, red, lane, wave);
    bool sel[KPT]; int nsel = 0;
#pragma unroll
    for (int j = 0; j < KPT; ++j) { const bool iseq = valid && key[j] == Tsel; sel[j] = valid && (key[j] > Tsel || (iseq && er < need)); er += iseq ? 1 : 0; nsel += sel[j] ? 1 : 0; }
    int slot = block_excl_scan(nsel, red, lane, wave);
#pragma unroll
    for (int j = 0; j < KPT; ++j) if (sel[j]) { const int t = tid * KPT + j; if (slot < cap) { rl[slot] = t; if (writer) { topw[e * ME + slotbase + slot] = __uint_as_float(key[j]); INV[(size_t)(rowbase + t) * 16 + e] = slotbase + slot; } } ++slot; }
    __syncthreads();
    for (int s = s_lo + wave * 4; s < s_hi; s += 32) {
        u32x4 a[4][2];
#pragma unroll
        for (int q = 0; q < 4; ++q) { const int t = rl[s + q]; const u32x4* src = (const u32x4*)(H + (size_t)(rowbase + t) * 1024); a[q][0] = src[lane]; a[q][1] = src[lane + 64]; }
#pragma unroll
        for (int q = 0; q < 4; ++q) { u32x4* dst = (u32x4*)(XS + ((size_t)e * ME + slotbase + s + q) * 1024); dst[lane] = a[q][0]; dst[lane + 64] = a[q][1]; }
    }
    __syncthreads();
}
__device__ __forceinline__ void phase_topk(KPC p, int l, LAS unsigned char* lds, int tid, int lane, int wave, int bid, int G) {
    const float* AFF = (const float*)(p->ws + WS_AFF); const float* AFFC = (const float*)(p->ws + WS_AFFC);
    const int nitem = (l == 0) ? 384 : 256;
    for (int it = bid; it < nitem; it += G) {
        if (it < 256) { const int q = it >> 1, hf = it & 1, b = q >> 4, e = q & 15; topk_item<8>(p, AFF + ((size_t)(b * 16 + e) << 12), 4096, CAPL, b * T, e, b * CAPL, hf * 256, hf * 256 + 256, hf == 0, lds, tid, lane, wave); }
        else { const int q = it - 256, b = q >> 4, e = q & 15; topk_item<1>(p, AFFC + (b * 16 + e) * 256, 256, CAPC, ML + b * CL, e, NB * CAPL + b * CAPC, 0, CAPC, true, lds, tid, lane, wave); }
    }
}

__device__ __forceinline__ void phase_combine(KPC p, int l, LAS unsigned char* lds, int tid, int lane, int wave, int bid, int G) {
    const float* modv = (const float*)(p->ws + WS_MODV); float* X = (float*)(p->ws + WS_X); bf16* H = (bf16*)(p->ws + WS_H);
    const bf16* Y = (const bf16*)(p->ws + WS_XS); const int* INV = (const int*)(p->ws + WS_INV);
    const int rows = (l == 0) ? M : ML, stride = G * 8;
    int r = bid * 8 + wave;
    int slot_next = (lane < 16 && r < rows) ? INV[(size_t)r * 16 + lane] : -1;
    for (; r < rows; r += stride) {
        const int bi = (r < ML) ? (r >> 12) : 8;
        const int myslot = slot_next; const int rn = r + stride;
        slot_next = (lane < 16 && rn < rows) ? INV[(size_t)rn * 16 + lane] : -1;
        f32x4 v[4], acc[4];
#pragma unroll
        for (int j = 0; j < 4; ++j) { v[j] = *(const f32x4*)(X + (size_t)r * 1024 + 4 * lane + 256 * j); acc[j] = (f32x4){0.f, 0.f, 0.f, 0.f}; }
        unsigned mask = (unsigned)(__builtin_amdgcn_ballot_w64(myslot >= 0) & 0xffffull);
        while (mask) {
            const int e0 = __builtin_ctz(mask); mask &= mask - 1u; const int s0 = __builtin_amdgcn_readlane(myslot, e0);
            const bool has1 = mask != 0u; const int e1 = has1 ? __builtin_ctz(mask) : e0; if (has1) mask &= mask - 1u; const int s1 = __builtin_amdgcn_readlane(myslot, e1);
            const bf16* ya = Y + ((size_t)e0 * ME + s0) * 1024; const bf16* yb = Y + ((size_t)e1 * ME + s1) * 1024;
            u32x2 wa[4], wb[4];
#pragma unroll
            for (int j = 0; j < 4; ++j) wa[j] = *(const u32x2*)(ya + 4 * lane + 256 * j);
#pragma unroll
            for (int j = 0; j < 4; ++j) wb[j] = *(const u32x2*)(yb + 4 * lane + 256 * j);
            const float kb = has1 ? 1.0f : 0.0f;
#pragma unroll
            for (int j = 0; j < 4; ++j) { acc[j] += (f32x4){bflo(wa[j].x), bfhi(wa[j].x), bflo(wa[j].y), bfhi(wa[j].y)}; acc[j] += (f32x4){bflo(wb[j].x), bfhi(wb[j].x), bflo(wb[j].y), bfhi(wb[j].y)} * kb; }
        }
        const float* g2 = modv + (l * 9 + bi) * 6144 + 5 * 1024;
#pragma unroll
        for (int j = 0; j < 4; ++j) v[j] = v[j] + *(const f32x4*)(g2 + 4 * lane + 256 * j) * acc[j];
        if (l == 0) {
#pragma unroll
            for (int j = 0; j < 4; ++j) *(f32x4*)(X + (size_t)r * 1024 + 4 * lane + 256 * j) = v[j];
            const float rs = row_rs(v); f32x4 h[4];
            norm_mod(v, rs, p->norm1_g + 1024, modv + (9 + bi) * 6144, modv + (9 + bi) * 6144 + 1024, h, lane);
            store_h(h, H + (size_t)r * 1024, lane);
        } else {
#pragma unroll
            for (int j = 0; j < 4; ++j) *(f32x4*)(p->out + (size_t)r * 1024 + 4 * lane + 256 * j) = v[j];
        }
    }
    if (l == 0) convert_small(p, 1, lds, lane, wave, bid, G);
}

#define XB_TMO      128
#define XB_XCNT(j)  (256  + 64 * (j))
#define XB_XSUB(j)  (1280 + 64 * (j))
#define XB_XGEN(j)  (2304 + 64 * (j))
#define XB_TOP      3328
#define XB_TOPGEN   3392
#define XCD_BAR_WORDS 3456
#define XB_SPIN_CAP (1u << 18)

__device__ __forceinline__ unsigned xb_ld(unsigned* p)              { return __hip_atomic_load(p, __ATOMIC_RELAXED, __HIP_MEMORY_SCOPE_AGENT); }
__device__ __forceinline__ unsigned xb_add(unsigned* p, unsigned v) { return __hip_atomic_fetch_add(p, v, __ATOMIC_RELAXED, __HIP_MEMORY_SCOPE_AGENT); }
__device__ __forceinline__ unsigned xb_xcc_id() { return (unsigned)__builtin_amdgcn_s_getreg((3 << 11) | 20) & 0xFu; }
#define XB_SPIN(cond, bar) do { unsigned _sp = 0; while (cond) { __builtin_amdgcn_s_sleep(1); \
    if ((++_sp & 255u) == 0u) { if (xb_ld(&(bar)[XB_TMO])) break; if (_sp > XB_SPIN_CAP) { atomicAdd(&(bar)[XB_TMO], 1u); break; } } } } while (0)

struct XcdBarrier {
    unsigned* bar; unsigned x;
    volatile LAS unsigned* st;
};

__device__ __forceinline__ XcdBarrier xcd_barrier_post(unsigned* bar, volatile LAS unsigned* st) {
    XcdBarrier b; b.bar = bar; b.x = xb_xcc_id(); b.st = st;
    if (threadIdx.x == 0) (void)xb_add(&bar[XB_XCNT(b.x)], 1u);
    return b;
}
__device__ __forceinline__ void xcd_barrier_complete(unsigned* bar, unsigned x, unsigned& nloc, unsigned& nx) {
    const unsigned G = gridDim.x * gridDim.y * gridDim.z;
    unsigned sum, cnt, mine, sp = 0u;
    for (;;) {
        sum = 0u; cnt = 0u; mine = 0u;
#pragma unroll
        for (unsigned j = 0; j < 16; ++j) { const unsigned c = xb_ld(&bar[XB_XCNT(j)]); sum += c; cnt += (c > 0u) ? 1u : 0u; mine = (j == x) ? c : mine; }
        if (sum == G) break;
        __builtin_amdgcn_s_sleep(1);
        if ((++sp & 255u) == 0u) { if (xb_ld(&bar[XB_TMO])) break; if (sp > XB_SPIN_CAP) { atomicAdd(&bar[XB_TMO], 1u); break; } }
    }
    nloc = mine > 0u ? mine : 1u; nx = cnt > 0u ? cnt : 1u;
}

__device__ __forceinline__ void xcd_barrier(const XcdBarrier& b) {
    asm volatile("s_waitcnt vmcnt(0)" ::: "memory");
    __syncthreads();
    if (threadIdx.x == 0) {
        unsigned* bar = b.bar;
        __builtin_amdgcn_s_waitcnt(0);
        unsigned nloc = b.st[0], nx = b.st[1];
        if (nloc == 0u) { xcd_barrier_complete(bar, b.x, nloc, nx); b.st[0] = nloc; b.st[1] = nx; }
        const unsigned old = xb_add(&bar[XB_XSUB(b.x)], 1u);
        const unsigned gen = old / nloc;
        if (old + 1u == (gen + 1u) * nloc) {
            __builtin_amdgcn_fence(__ATOMIC_RELEASE, "agent");
            asm volatile("s_waitcnt vmcnt(0)" ::: "memory");
            const unsigned og = xb_add(&bar[XB_TOP], 1u);
            const unsigned tg = og / nx;
            if (og + 1u == (tg + 1u) * nx) xb_add(&bar[XB_TOPGEN], 1u);
            else XB_SPIN(xb_ld(&bar[XB_TOPGEN]) == tg, bar);
            __builtin_amdgcn_fence(__ATOMIC_ACQUIRE, "agent");
            xb_add(&bar[XB_XGEN(b.x)], 1u);
            asm volatile("s_waitcnt vmcnt(0)" ::: "memory");
        } else {
            XB_SPIN(xb_ld(&bar[XB_XGEN(b.x)]) == gen, bar);
            __builtin_amdgcn_fence(__ATOMIC_ACQUIRE, "agent");
            asm volatile("s_waitcnt vmcnt(0)" ::: "memory");
        }
    }
    __syncthreads();
}

#ifndef REP_GZA
#define REP_GZA 1
#endif
#ifndef REP_GG
#define REP_GG 1
#endif
#ifndef REP_GMRG
#define REP_GMRG 1
#endif
#ifndef REP_GM1
#define REP_GM1 1
#endif
#ifndef REP_GM2
#define REP_GM2 1
#endif
#ifndef REP_ATT
#define REP_ATT 1
#endif
#ifndef REP_UPD
#define REP_UPD 1
#endif
#ifndef REP_SGU
#define REP_SGU 1
#endif
#ifndef REP_PRE
#define REP_PRE 1
#endif
#ifndef REP_CMB
#define REP_CMB 1
#endif
#ifndef REP_MIX
#define REP_MIX 1
#endif
#ifndef REP_RO
#define REP_RO 1
#endif
#ifndef REP_N2
#define REP_N2 1
#endif
#ifndef REP_GEMM
#define REP_GEMM 1
#endif
#ifndef REP_SYNC
#define REP_SYNC 1
#endif
#ifndef EN_GEMM
#define EN_GEMM 0x3f
#endif
#ifndef EN_ATT
#define EN_ATT 1
#endif
#ifndef EN_UPD
#define EN_UPD 1
#endif
#ifndef EN_SGU
#define EN_SGU 1
#endif
#ifndef EN_RO
#define EN_RO 1
#endif
#ifndef EN_MISC
#define EN_MISC 1
#endif
#define KPP() ({ KPC q_ = kp_; asm volatile("" : "+s"(q_)); q_; })
__global__ void __launch_bounds__(512, 2) mk_fwd(KP p_unused) {
    extern __shared__ __attribute__((aligned(16))) unsigned char lds_raw[];
    LAS unsigned char* lds = (LAS unsigned char*)lds_raw;
    cg::grid_group grid = cg::this_grid();
    const int bid = blockIdx.x, G = gridDim.x;
#define IDS() int tid = threadIdx.x; asm volatile("" : "+v"(tid)); const int lane = tid & 63, wave = __builtin_amdgcn_readfirstlane(tid >> 6); (void)lane; (void)wave
    const KPC kp_ = (KPC)__builtin_amdgcn_kernarg_segment_ptr();
    volatile LAS unsigned* bst = (volatile LAS unsigned*)(lds + 147392);
    if (threadIdx.x < 16) bst[threadIdx.x] = 0u;
    __syncthreads();
    (void)xcd_barrier_post((unsigned*)KPP()->ws, bst);
#define GSYNC() do { XcdBarrier b_; b_.bar = (unsigned*)KPP()->ws; b_.x = xb_xcc_id(); b_.st = bst; xcd_barrier(b_); } while (0)

    { IDS(); for (int rep = 0; rep < REP_PRE; ++rep) { phase_prep(KPP(), lds, tid, lane, wave, bid, G); __syncthreads(); } }
    grid.sync();
    { IDS(); for (int rep = 0; rep < REP_PRE; ++rep) phase_norm_in(KPP(), lane, wave, bid, G); }
    GSYNC();
#pragma unroll 1
    for (int l = 0; l < 2; ++l) {
        {
            unsigned char* ws = KPP()->ws;
            pg8::Gemm g{(const pg8::bf16_t*)(ws + WS_H), (const pg8::bf16_t*)(ws + WS_WTIN), M, NZA, 1024}; GroupOrder S{1, M / 256, NZA / 256, 0, 0, G, bid};
            EpiZA E{(bf16*)(ws + WS_ZA)};
            for (int rep = 0; rep < REP_GEMM * REP_GZA; ++rep) pg8::gemm_phase<EpiZA, GroupOrder, true, true>(lds, g, S, E);
        }
        GSYNC();
        {
            KPC p = KPP(); IDS();
            float mq = fabsf(p->qn_g[l * 64 + lane]), mk = fabsf(p->kn_g[l * 64 + lane]);
            mq = wave_max(mq); mk = wave_max(mk);
            const float Mb2 = 8.0f * mq * mk * LOG2E;
            const int natt = (l == 0) ? 544 : 512, nupd = NB * NCH * 4, nsgu = ((l == 0) ? (M / 128) : (ML / 128)) * 4;
            for (int rep = 0; rep < REP_MIX; ++rep)
            for (int it = bid; it < natt + nupd + nsgu; it += G) {
                if (it < natt) { for (int q = 0; q < REP_ATT; ++q) att_item(p, l, lds, it, Mb2, tid, lane, wave); }
                else if (it < natt + nupd) { for (int q = 0; q < REP_UPD; ++q) ret_upd_item(p, l, lds, it - natt, tid, lane, wave); }
                else { for (int q = 0; q < REP_SGU; ++q) sgu_item(p, l, lds, it - natt - nupd, tid, lane, wave); }
            }
        }
        GSYNC();
        { IDS(); for (int rep = 0; rep < REP_RO; ++rep) phase_scan(KPP(), l, tid, bid, G); }
        GSYNC();
        {   KPC p = KPP(); IDS(); const int nch = (l == 0) ? NCH : 32;
            for (int rep = 0; rep < REP_RO; ++rep)
            for (int it = bid; it < NB * nch * 4; it += G) { const int b = it / (nch * 4), rem = it % (nch * 4); if (EN_RO) ret_out_item(p, l, lds, b * (NCH * 4) + rem, tid, lane, wave); }
        }
        GSYNC();
        const int Mrows = (l == 0) ? M : ML;
        {
            unsigned char* ws = KPP()->ws;
            pg8::Gemm g{(const pg8::bf16_t*)(ws + WS_H), (const pg8::bf16_t*)(ws + WS_WTIN) + (size_t)NZA * 1024, Mrows, NZG, 1024}; GroupOrder S{1, Mrows / 256, NZG / 256, 0, 0, G, bid};
            EpiSig E{(bf16*)(ws + WS_G)};
            for (int rep = 0; rep < REP_GEMM * REP_GG; ++rep) pg8::gemm_phase<EpiSig, GroupOrder, true, true>(lds, g, S, E);
            if (l == 0 && G == 256 && bid >= CVT_G_IDLE0) { IDS(); convert_experts(KPP(), 0, 0, CVT_G_HI, (bid - CVT_G_IDLE0) * 8 + wave, (256 - CVT_G_IDLE0) * 8, lds, lane, wave); }
        }
        GSYNC();
        {
            KPC p = KPP(); unsigned char* ws = p->ws;
            pg8::Gemm g{(const pg8::bf16_t*)p->out, (const pg8::bf16_t*)(ws + WS_WTBR), 3 * M, 3072, 512}; MergeOrder S{Mrows / 256, G, bid};
            EpiMergeChain E{(const bf16*)(ws + WS_G), (bf16*)(ws + WS_H)};
            for (int rep = 0; rep < REP_GEMM * REP_GMRG; ++rep) pg8::gemm_phase<EpiMergeChain, MergeOrder, true, true>(lds, g, S, E);
            if (l == 0 && G == 256 && bid >= CVT_M_IDLE0) { IDS(); convert_experts(KPP(), 0, CVT_G_HI, CVT_M_HI, (bid - CVT_M_IDLE0) * 8 + wave, (256 - CVT_M_IDLE0) * 8, lds, lane, wave); }
        }
        GSYNC();
        {
            KPC p = KPP(); unsigned char* ws = p->ws;
            pg8::Gemm g{(const pg8::bf16_t*)(ws + WS_H), (const pg8::bf16_t*)(ws + WS_WTOUT), Mrows, 1024, 1024}; GroupOrder S{1, Mrows / 256, 4, 0, 0, G, bid};
            EpiOut E{(l == 0) ? p->x : (const float*)(ws + WS_X), (l == 0) ? p->ctx : (const float*)(ws + WS_X) + (size_t)ML * 1024, (float*)(ws + WS_X), (const float*)(ws + WS_MODV) + l * 9 * 6144};
            pg8::gemm_phase<EpiOut, GroupOrder, true, true>(lds, g, S, E);
            if (l == 0 && G == 256 && bid >= CVT_O_IDLE0) { IDS(); convert_experts(KPP(), 0, CVT_M_HI, CVT_ITEMS, (bid - CVT_O_IDLE0) * 8 + wave, (256 - CVT_O_IDLE0) * 8, lds, lane, wave); }
        }
        GSYNC();
        { IDS(); for (int rep = 0; rep < REP_N2; ++rep) { phase_norm2(KPP(), l, lds, tid, lane, wave, bid, G); __syncthreads(); } }
        GSYNC();
        { IDS(); for (int rep = 0; rep < REP_N2 * REP_TK; ++rep) phase_topk(KPP(), l, lds, tid, lane, wave, bid, G); }
        GSYNC();
        {
            unsigned char* ws = KPP()->ws;
            pg8::Gemm g{(const pg8::bf16_t*)(ws + WS_XS), (const pg8::bf16_t*)(ws + WS_WT1), NE * ME, NE * 2048, 1024}; GroupOrder S{NE, (l == 0) ? 17 : 16, 8, 17, 8, G, bid};
            EpiMoe1 E{(bf16*)(ws + WS_ACT)};
            for (int rep = 0; rep < REP_GEMM * REP_GM1; ++rep) pg8::gemm_phase<EpiMoe1, GroupOrder, true, true>(lds, g, S, E);
        }
        GSYNC();
        {
            unsigned char* ws = KPP()->ws;
            pg8::Gemm g{(const pg8::bf16_t*)(ws + WS_ACT), (const pg8::bf16_t*)(ws + WS_WT2), NE * ME, NE * 1024, 1024}; GroupOrder S{NE, (l == 0) ? 17 : 16, 4, 17, 4, G, bid};
            EpiMoe2 E{(bf16*)(ws + WS_XS), (const float*)(ws + WS_TOPW)};
            for (int rep = 0; rep < REP_GEMM * REP_GM2; ++rep) pg8::gemm_phase<EpiMoe2, GroupOrder, true, true>(lds, g, S, E);
        }
        GSYNC();
        { IDS(); for (int rep = 0; rep < ((l == 1) ? REP_CMB : 1); ++rep) phase_combine(KPP(), l, lds, tid, lane, wave, bid, G); }
        if (l == 0) GSYNC();
        for (int rep = 1; rep < REP_SYNC; ++rep) { for (int k = 0; k < 12; ++k) GSYNC(); }
    }
}

extern "C" void kernel_launch(void* const* d_in, const int* in_sizes, int n_in, void* d_out, int out_size, void* d_ws, size_t ws_size, hipStream_t stream) {
    static int grid = 0;
    if (grid == 0) {
        if (n_in != 22 || out_size != ML * D || ws_size < WS_END) { fprintf(stderr, "kernel_launch: unexpected shapes (n_in %d out %d ws %zu, need %zu)\n", n_in, out_size, ws_size, (size_t)WS_END); grid = -1; return; }
        int dev = 0, cus = 0, per_cu = 0;
        if (hipGetDevice(&dev) != hipSuccess || hipDeviceGetAttribute(&cus, hipDeviceAttributeMultiprocessorCount, dev) != hipSuccess) { grid = -1; return; }
        if (hipFuncSetAttribute((const void*)mk_fwd, hipFuncAttributeMaxDynamicSharedMemorySize, LDS_BYTES) != hipSuccess) { fprintf(stderr, "kernel_launch: hipFuncSetAttribute failed\n"); grid = -1; return; }
        if (hipOccupancyMaxActiveBlocksPerMultiprocessor(&per_cu, (const void*)mk_fwd, 512, LDS_BYTES) != hipSuccess || per_cu < 1) { fprintf(stderr, "kernel_launch: occupancy query says %d\n", per_cu); (void)hipGetLastError(); }
        grid = cus;
        fprintf(stderr, "kernel_launch: grid %d, occupancy %d/CU, ws %zu\n", grid, per_cu, ws_size);
    }
    if (grid < 0) return;
    if (hipMemsetAsync(d_ws, 0, 16384, stream) != hipSuccess) { fprintf(stderr, "kernel_launch: memset failed\n"); return; }
    KP hp{};
    const float** f = (const float**)&hp;
    for (int i = 0; i < 22; ++i) f[i] = (const float*)d_in[i];
    hp.out = (float*)d_out; hp.ws = (unsigned char*)d_ws;
    void* args[] = {&hp};
    hipError_t e = hipLaunchCooperativeKernel((const void*)mk_fwd, dim3(grid), dim3(512), args, LDS_BYTES, stream);
    if (e != hipSuccess) fprintf(stderr, "kernel_launch: cooperative launch failed: %s\n", hipGetErrorString(e));
}
```

```cpp
#include <hip/hip_runtime.h>
#include <hip/hip_cooperative_groups.h>
#include <cstdio>
#include <cstdint>
namespace cg = cooperative_groups;

namespace pg8 {
#define PG8_LAS __attribute__((address_space(3)))
typedef unsigned short bf16_t;
typedef short bf16x8 __attribute__((ext_vector_type(8)));
typedef float f32x4 __attribute__((ext_vector_type(4)));
typedef unsigned u32x4 __attribute__((ext_vector_type(4)));
constexpr int BM = 256, BK = 64, HALF = 128, HTB = HALF * BK * 2  , STAGE_BYTES = 8 * HTB, NXCD = 8, WGM = 8;

__host__ __device__ __forceinline__ int lds_byte(int r, int c) { const int st = (r >> 4) * 2 + (c >> 5), rr = r & 15, cc = c & 31, ob = rr * 64 + cc * 2; return st * 1024 + (ob ^ (((ob >> 9) & 1) << 5)); }
__host__ __device__ __forceinline__ void stage_rc(int b, int& R, int& C) { const int st = b / 1024, sb = b % 1024, swz = sb ^ (((sb >> 9) & 1) << 5); R = (st >> 1) * 16 + swz / 64; C = (st & 1) * 32 + (swz % 64) / 2; }
__host__ __device__ __forceinline__ int perm32(int rho) { const int n = rho >> 4, i = rho & 15; return 8 * (i >> 2) + 4 * n + (i & 3); }

struct Unit { int pm, pn; };
struct Gemm { const bf16_t* A; const bf16_t* Bt; int M, N, K; };

struct StaticOrder {
    int nM, nN, nwg, G, c;
    __host__ __device__ void init(int M, int N, int G_, int c_) { nM = M / BM; nN = N / BM; nwg = nM * nN; G = G_; c = c_; }
    __host__ __device__ bool next(int i, Unit& u) const {
        const long L = (long)i * G + c; if (L >= nwg) return false;
        int wgid = (int)L; { const int q = nwg / NXCD, r = nwg % NXCD, xcd = wgid % NXCD, off = wgid / NXCD; wgid = (xcd < r ? xcd * (q + 1) : r * (q + 1) + (xcd - r) * q) + off; }
        const int nig = WGM * nN, gid = wgid / nig, fm = gid * WGM, gsz = (nM - fm) < WGM ? (nM - fm) : WGM;
        u.pm = fm + ((wgid % nig) % gsz); u.pn = (wgid % nig) / gsz; return true;
    }
    __device__ __forceinline__ void a_ready(const Unit&) const {}
    __device__ __forceinline__ void done(const Unit&) const {}
};

__device__ __forceinline__ unsigned cvt_pk_bf16(float lo, float hi) { unsigned r; asm volatile("v_cvt_pk_bf16_f32 %0, %1, %2" : "=v"(r) : "v"(lo), "v"(hi)); return r; }
typedef float f32x2 __attribute__((ext_vector_type(2)));
__device__ __forceinline__ f32x2 gelu_pk(f32x2 v) {
    const f32x2 av = __builtin_elementwise_abs(v), d = av * 0.2316418882f + 1.0f;
    f32x2 t; t.x = __builtin_amdgcn_rcpf(d.x); t.y = __builtin_amdgcn_rcpf(d.y);
    f32x2 q = t * 0.5307027145f + (-0.7265760135f); q = q * t + 0.7107068705f; q = q * t + (-0.142248368f); q = q * t + 0.127414796f; q = q * t;
    const f32x2 s = (v * v) * (-0.72134752044f);
    f32x2 e; e.x = __builtin_amdgcn_exp2f(s.x); e.y = __builtin_amdgcn_exp2f(s.y);
    const f32x2 m = v * (q * e), r = v - m;
    f32x2 o; o.x = v.x < 0.f ? m.x : r.x; o.y = v.y < 0.f ? m.y : r.y; return o;
}

template <int ACT  > struct EpiBf16 {
    static constexpr bool PERM = true, AFTER_DRAIN = false, CHAIN = false; static_assert(ACT == 0 || ACT == 1, "EpiBf16: ACT is 0 (none) or 1 (gelu_pk)");
    bf16_t* O; int ldc; const float* bias; int split_cols; size_t split_stride; float scale0;
    __device__ __forceinline__ void operator()(const f32x4 (&acc)[2][2][4][2], const Unit& u, int wr, int wc, int fr, int fq) const {
        const int row0 = u.pm * BM + wr * 64 + fr; int colt = u.pn * BM; bf16_t* base = O;
        float sc = 1.f; if (split_cols) { const int t = colt / split_cols; base += (size_t)t * split_stride; colt -= t * split_cols; if (t == 0) sc = scale0; }
        const int col0 = colt + wc * 32 + 8 * fq, bcol0 = u.pn * BM + wc * 32 + 8 * fq;
        f32x4 bv[2][2];
#pragma unroll
        for (int bj = 0; bj < 2; ++bj)
#pragma unroll
            for (int n = 0; n < 2; ++n) bv[bj][n] = bias ? *(const f32x4*)(bias + bcol0 + bj * HALF + 4 * n) : (f32x4){0.f, 0.f, 0.f, 0.f};
#pragma unroll
        for (int ai = 0; ai < 2; ++ai)
#pragma unroll
            for (int m = 0; m < 4; ++m) { bf16_t* rowp = base + (size_t)(row0 + ai * HALF + m * 16) * ldc + col0;
#pragma unroll
                for (int bj = 0; bj < 2; ++bj) { f32x4 v0 = acc[ai][bj][m][0] + bv[bj][0], v1 = acc[ai][bj][m][1] + bv[bj][1];
                    if (ACT == 1) { f32x2 a = gelu_pk((f32x2){v0[0], v0[1]}), b = gelu_pk((f32x2){v0[2], v0[3]}), c = gelu_pk((f32x2){v1[0], v1[1]}), d = gelu_pk((f32x2){v1[2], v1[3]});
                        v0 = (f32x4){a.x, a.y, b.x, b.y}; v1 = (f32x4){c.x, c.y, d.x, d.y}; }
                    v0 = v0 * sc; v1 = v1 * sc; u32x4 w; w.x = cvt_pk_bf16(v0[0], v0[1]); w.y = cvt_pk_bf16(v0[2], v0[3]); w.z = cvt_pk_bf16(v1[0], v1[1]); w.w = cvt_pk_bf16(v1[2], v1[3]);
                    *(u32x4*)(rowp + bj * HALF) = w; } }
    }
};
template <class Epi, class Sched, bool ALIGN_EPI = false, bool SP2 = false>
__device__ __forceinline__ void gemm_phase(PG8_LAS unsigned char* lds, const Gemm g, const Sched& S, const Epi& E) {
    int tid_ = threadIdx.x; asm volatile("" : "+v"(tid_));
    const int tid = tid_, wid = __builtin_amdgcn_readfirstlane(tid >> 6), lane = tid & 63, wr = wid >> 2, wc = wid & 3, fr = lane & 15, fq = lane >> 4;
    const int K = g.K, nt = K / BK;
    unsigned voffA[2], voffB[2];
#pragma unroll
    for (int i = 0; i < 2; ++i) { int R, C; stage_rc(tid * 16 + i * 8192, R, C); const int Rb = Epi::PERM ? ((R & ~31) + perm32(R & 31)) : R;
        voffA[i] = (unsigned)(R * K + C) * 2u; voffB[i] = (unsigned)(Rb * K + C) * 2u; }
    const size_t kstep = (size_t)(BK * 2);
    const size_t hstep = (size_t)HALF * K * 2;
    const size_t tstep = 2 * hstep;
    const unsigned ldsw = (unsigned)wid * 1024u;
    const int aoff = lds_byte(wr * 64 + fr, fq * 8), boff = lds_byte(wc * 32 + fr, fq * 8);
#define PG8_SA(b, h) (((b) * 2 + (h)) * HTB)
#define PG8_SB(b, h) ((4 + (b) * 2 + (h)) * HTB)
#define PG8_STAGE(bufoff, gbase, voff) do { _Pragma("unroll") for (int _i = 0; _i < 2; ++_i) \
        __builtin_amdgcn_global_load_lds((const unsigned*)((const char*)(gbase) + (voff)[_i]), (PG8_LAS unsigned*)(lds + (bufoff) + ldsw + _i * 8192), 16, 0, 0); } while (0)
#define PG8_LDA(dst, b, h) do { _Pragma("unroll") for (int m = 0; m < 4; ++m) _Pragma("unroll") for (int k = 0; k < 2; ++k) dst[m][k] = *(const PG8_LAS bf16x8*)(lds + PG8_SA(b, h) + aoff + m * 2048 + k * 1024); } while (0)
#define PG8_LDB(dst, b, h) do { _Pragma("unroll") for (int n = 0; n < 2; ++n) _Pragma("unroll") for (int k = 0; k < 2; ++k) dst[n][k] = *(const PG8_LAS bf16x8*)(lds + PG8_SB(b, h) + boff + n * 2048 + k * 1024); } while (0)
#define PG8_MMA(ai, bj, At, Bt) do { __builtin_amdgcn_s_setprio(1); _Pragma("unroll") for (int m = 0; m < 4; ++m) _Pragma("unroll") for (int n = 0; n < 2; ++n) _Pragma("unroll") for (int k = 0; k < 2; ++k) \
        acc[ai][bj][m][n] = __builtin_amdgcn_mfma_f32_16x16x32_bf16(Bt[n][k], At[m][k], acc[ai][bj][m][n], 0, 0, 0); __builtin_amdgcn_s_setprio(0); } while (0)
#define PG8_WAIT_V(n) asm volatile("s_waitcnt vmcnt(" #n ")" ::: "memory")
#define PG8_WAIT_L(n) asm volatile("s_waitcnt lgkmcnt(" #n ")" ::: "memory")
#define PG8_BAR __builtin_amdgcn_s_barrier()
#define PG8_SCHED __builtin_amdgcn_sched_barrier(0)
    Unit cur, nxt; int ui = 0;
    if (!S.next(0, cur)) return;
    f32x4 acc[2][2][4][2];
#pragma unroll
    for (int a = 0; a < 2; ++a)
#pragma unroll
        for (int b = 0; b < 2; ++b)
#pragma unroll
            for (int m = 0; m < 4; ++m)
#pragma unroll
                for (int n = 0; n < 2; ++n) acc[a][b][m][n] = (f32x4){0.f, 0.f, 0.f, 0.f};
    bf16x8 At[4][2], B0[2][2], B1[2][2];
    const char* cA = (const char*)g.A + (size_t)cur.pm * tstep; const char* cB = (const char*)g.Bt + (size_t)cur.pn * tstep;
    S.a_ready(cur);
    if constexpr (SP2) {
        PG8_STAGE(PG8_SB(0, 0), cB, voffB); PG8_STAGE(PG8_SB(0, 1), cB + hstep, voffB); PG8_STAGE(PG8_SA(0, 0), cA, voffA); PG8_STAGE(PG8_SA(0, 1), cA + hstep, voffA);
        if (wr == 1) PG8_BAR;
        PG8_WAIT_V(2); PG8_BAR;
        PG8_STAGE(PG8_SB(1, 0), cB + kstep, voffB); PG8_STAGE(PG8_SA(1, 0), cA + kstep, voffA); PG8_STAGE(PG8_SB(1, 1), cB + hstep + kstep, voffB);
        PG8_WAIT_V(6); PG8_BAR;
    } else {
        PG8_STAGE(PG8_SB(0, 0), cB, voffB); PG8_STAGE(PG8_SA(0, 0), cA, voffA); PG8_STAGE(PG8_SB(0, 1), cB + hstep, voffB); PG8_STAGE(PG8_SA(0, 1), cA + hstep, voffA);
        if (wr == 1) PG8_BAR;
        PG8_WAIT_V(4); PG8_BAR;
        PG8_STAGE(PG8_SB(1, 0), cB + kstep, voffB); PG8_STAGE(PG8_SA(1, 0), cA + kstep, voffA); PG8_STAGE(PG8_SB(1, 1), cB + hstep + kstep, voffB);
        PG8_WAIT_V(6); PG8_BAR;
    }
    for (;;) {
        const bool has_next = S.next(ui + 1, nxt);
        const char* nA = has_next ? (const char*)g.A + (size_t)nxt.pm * tstep : cA; const char* nB = has_next ? (const char*)g.Bt + (size_t)nxt.pn * tstep : cB;
        for (int t = 0; t < nt; t += 2) {
            const bool last = (t == nt - 2);
            const char* a1 = cA + (size_t)(t + 1) * kstep;
            const char* a2 = last ? nA : cA + (size_t)(t + 2) * kstep; const char* b2 = last ? nB : cB + (size_t)(t + 2) * kstep;
            const char* a3 = a2 + kstep; const char* b3 = b2 + kstep;
            if (last && has_next) S.a_ready(nxt);
            if constexpr (SP2) {
            PG8_LDB(B0, 0, 0); PG8_LDB(B1, 0, 1); PG8_SCHED; PG8_LDA(At, 0, 0); PG8_STAGE(PG8_SA(1, 1), a1 + hstep, voffA);
            PG8_WAIT_V(8); PG8_WAIT_L(0); PG8_BAR; PG8_MMA(0, 0, At, B0); PG8_MMA(0, 1, At, B1); PG8_BAR; PG8_SCHED;
            PG8_LDA(At, 0, 1); PG8_STAGE(PG8_SB(0, 0), b2, voffB); PG8_STAGE(PG8_SB(0, 1), b2 + hstep, voffB); PG8_STAGE(PG8_SA(0, 0), a2, voffA);
            PG8_WAIT_V(8); PG8_WAIT_L(0); PG8_BAR; PG8_MMA(1, 0, At, B0); PG8_MMA(1, 1, At, B1); PG8_BAR; PG8_SCHED;
            PG8_LDB(B0, 1, 0); PG8_LDB(B1, 1, 1); PG8_SCHED; PG8_LDA(At, 1, 0); PG8_STAGE(PG8_SA(0, 1), a2 + hstep, voffA);
            PG8_WAIT_V(8); PG8_WAIT_L(0); PG8_BAR; PG8_MMA(0, 0, At, B0); PG8_MMA(0, 1, At, B1); PG8_BAR; PG8_SCHED;
            PG8_LDA(At, 1, 1); PG8_STAGE(PG8_SB(1, 0), b3, voffB); PG8_STAGE(PG8_SB(1, 1), b3 + hstep, voffB); PG8_STAGE(PG8_SA(1, 0), a3, voffA);
            PG8_WAIT_V(8); PG8_WAIT_L(0); PG8_BAR; PG8_MMA(1, 0, At, B0); PG8_MMA(1, 1, At, B1); PG8_BAR; PG8_SCHED;
            } else {
            PG8_LDB(B0, 0, 0); PG8_SCHED; PG8_LDA(At, 0, 0); PG8_STAGE(PG8_SA(1, 1), a1 + hstep, voffA);
            PG8_WAIT_L(8); PG8_BAR; PG8_WAIT_L(0); PG8_MMA(0, 0, At, B0); PG8_BAR; PG8_SCHED;
            PG8_LDB(B1, 0, 1); PG8_STAGE(PG8_SB(0, 0), b2, voffB);
            PG8_BAR; PG8_WAIT_L(0); PG8_MMA(0, 1, At, B1); PG8_BAR;
            PG8_LDA(At, 0, 1); PG8_STAGE(PG8_SA(0, 0), a2, voffA);
            PG8_BAR; PG8_WAIT_L(0); PG8_MMA(1, 0, At, B0); PG8_BAR; PG8_SCHED;
            PG8_STAGE(PG8_SB(0, 1), b2 + hstep, voffB);
            PG8_WAIT_V(6); PG8_BAR; PG8_MMA(1, 1, At, B1); PG8_BAR;
            PG8_LDB(B0, 1, 0); PG8_SCHED; PG8_LDA(At, 1, 0); PG8_STAGE(PG8_SA(0, 1), a2 + hstep, voffA);
            PG8_WAIT_L(8); PG8_BAR; PG8_WAIT_L(0); PG8_MMA(0, 0, At, B0); PG8_BAR; PG8_SCHED;
            PG8_LDB(B1, 1, 1); PG8_STAGE(PG8_SB(1, 0), b3, voffB);
            PG8_BAR; PG8_WAIT_L(0); PG8_MMA(0, 1, At, B1); PG8_BAR;
            PG8_LDA(At, 1, 1); PG8_STAGE(PG8_SA(1, 0), a3, voffA);
            PG8_BAR; PG8_WAIT_L(0); PG8_MMA(1, 0, At, B0); PG8_BAR; PG8_SCHED;
            PG8_STAGE(PG8_SB(1, 1), b3 + hstep, voffB);
            PG8_WAIT_V(6); PG8_BAR; PG8_MMA(1, 1, At, B1); PG8_BAR;
            }
        }
        if constexpr (ALIGN_EPI) { if (wr == 0) PG8_BAR; }
        bool keep_acc = false;
        if constexpr (Epi::CHAIN) { keep_acc = E.chain(acc, cur, wr, wc, fr, fq); S.done(cur); }
        else if constexpr (!Epi::AFTER_DRAIN) { E(acc, cur, wr, wc, fr, fq); S.done(cur); }
        if (!has_next) break;
        if (!keep_acc) {
#pragma unroll
        for (int a = 0; a < 2; ++a)
#pragma unroll
            for (int b = 0; b < 2; ++b)
#pragma unroll
                for (int m = 0; m < 4; ++m)
#pragma unroll
                    for (int n = 0; n < 2; ++n) acc[a][b][m][n] = (f32x4){0.f, 0.f, 0.f, 0.f};
        }
        cur = nxt; cA = nA; cB = nB; ++ui;
        if constexpr (ALIGN_EPI) { if (wr == 1) PG8_BAR; }
    }
    PG8_WAIT_V(0);
    if constexpr (!ALIGN_EPI) { if (wr == 0) PG8_BAR; }
    PG8_BAR;
    if constexpr (Epi::AFTER_DRAIN) { E.fused(acc, cur, wr, wc, fr, fq, lds, wid, lane); S.done(cur); }
#undef PG8_SA
#undef PG8_SB
#undef PG8_STAGE
#undef PG8_LDA
#undef PG8_LDB
#undef PG8_MMA
#undef PG8_WAIT_V
#undef PG8_WAIT_L
#undef PG8_BAR
#undef PG8_SCHED
}
}

#define LAS __attribute__((address_space(3)))
typedef unsigned short bf16;
typedef short bf16x8 __attribute__((ext_vector_type(8)));
typedef float f32x4 __attribute__((ext_vector_type(4)));
typedef unsigned u32x4 __attribute__((ext_vector_type(4)));
typedef unsigned u32x2 __attribute__((ext_vector_type(2)));

constexpr int D = 1024, NB = 8, T = 4096, CL = 256;
constexpr int ML = NB * T, MC = NB * CL, M = ML + MC;
constexpr int NZA = 3328, NZG = 3072;
constexpr int C_RQ = 0, C_RK = 256, C_RV = 512, C_RG = 1024, C_SU = 1536, C_SV = 2048, C_AQ = 2560, C_AK = 3072, C_AV = 3200;
constexpr int NE = 16, CAPL = 512, CAPC = 32, ME = NB * (CAPL + CAPC);
constexpr int NCH = 34;
constexpr float EPS = 1e-6f, LOG2E = 1.4426950408889634f;
constexpr int LDS_BYTES = 147456;

constexpr size_t MiB = 1u << 20;
constexpr size_t WS_ROPEC = 1 * MiB, WS_ROPES = 1 * MiB + 512 * 1024, WS_MODV = 2 * MiB, WS_AFF = 3 * MiB, WS_AFFC = 5 * MiB, WS_INV = 6 * MiB, WS_TOPW = 9 * MiB;
constexpr size_t WS_WTIN = 16 * MiB, WS_WTBR = WS_WTIN + (size_t)6400 * 1024 * 2, WS_WTOUT = WS_WTBR + (size_t)3072 * 512 * 2;
constexpr size_t WS_X = 34 * MiB, WS_H = 170 * MiB, WS_R = 238 * MiB;
constexpr size_t WS_ZA = WS_R, WS_G = WS_R, WS_RS = 459 * MiB, WS_ST = 527 * MiB;
constexpr size_t WS_XS = WS_R, WS_ACT = 374 * MiB, WS_WT1 = 510 * MiB, WS_WT2 = 574 * MiB, WS_END = 606 * MiB;
static_assert(WS_WTOUT + 2 * MiB <= WS_X && WS_ZA + (size_t)M * NZA * 2 <= WS_RS && WS_ST + (size_t)NB * 4 * NCH * 128 * 128 * 2 <= WS_END, "ws map");

struct KP {
    const float *x, *c, *ctx, *c_ctx, *w_mod, *b_mod, *norm1_g, *norm2_g, *w_in, *dec_f, *dec_b, *sgu_w, *sgu_b, *qn_g, *kn_g, *sink, *w_branch, *w_out, *w_router, *w_eg, *w_eu, *w_ed;
    float* out; unsigned char* ws;
};
typedef const __attribute__((address_space(4))) KP* KPC;

#define LDS_WAIT() asm volatile("s_waitcnt lgkmcnt(0)" ::: "memory")
__device__ __forceinline__ unsigned pk2(float lo, float hi) { return pg8::cvt_pk_bf16(lo, hi); }
__device__ __forceinline__ float bflo(unsigned w) { return __uint_as_float(w << 16); }
__device__ __forceinline__ float bfhi(unsigned w) { return __uint_as_float(w & 0xffff0000u); }
__device__ __forceinline__ void unpack8(const u32x4 w, float (&f)[8]) { f[0] = bflo(w.x); f[1] = bfhi(w.x); f[2] = bflo(w.y); f[3] = bfhi(w.y); f[4] = bflo(w.z); f[5] = bfhi(w.z); f[6] = bflo(w.w); f[7] = bfhi(w.w); }
__device__ __forceinline__ u32x4 pack8(const float (&f)[8]) { u32x4 o; o.x = pk2(f[0], f[1]); o.y = pk2(f[2], f[3]); o.z = pk2(f[4], f[5]); o.w = pk2(f[6], f[7]); return o; }
template <int MASK> __device__ __forceinline__ float swz_xor(float v) { static_assert(MASK > 0 && MASK < 32, "swz_xor: 1..31"); return __builtin_bit_cast(float, __builtin_amdgcn_ds_swizzle(__builtin_bit_cast(int, v), 0x1f | (MASK << 10))); }
template <int MASK> __device__ __forceinline__ int swz_xor_i(int v) { return __builtin_amdgcn_ds_swizzle(v, 0x1f | (MASK << 10)); }
__device__ __forceinline__ float sum_x32(float v) { const unsigned u = __builtin_bit_cast(unsigned, v); auto r = __builtin_amdgcn_permlane32_swap(u, u, false, false); return __builtin_bit_cast(float, (unsigned)r[0]) + __builtin_bit_cast(float, (unsigned)r[1]); }
__device__ __forceinline__ float max_x32(float v) { const unsigned u = __builtin_bit_cast(unsigned, v); auto r = __builtin_amdgcn_permlane32_swap(u, u, false, false); return fmaxf(__builtin_bit_cast(float, (unsigned)r[0]), __builtin_bit_cast(float, (unsigned)r[1])); }
__device__ __forceinline__ int sum_x32_i(int v) { auto r = __builtin_amdgcn_permlane32_swap((unsigned)v, (unsigned)v, false, false); return (int)r[0] + (int)r[1]; }
__device__ __forceinline__ float wave_sum(float v) { v += swz_xor<1>(v); v += swz_xor<2>(v); v += swz_xor<4>(v); v += swz_xor<8>(v); v += swz_xor<16>(v); return sum_x32(v); }
__device__ __forceinline__ float wave_max(float v) { v = fmaxf(v, swz_xor<1>(v)); v = fmaxf(v, swz_xor<2>(v)); v = fmaxf(v, swz_xor<4>(v)); v = fmaxf(v, swz_xor<8>(v)); v = fmaxf(v, swz_xor<16>(v)); return max_x32(v); }
__device__ __forceinline__ int wave_sum_i(int v) { v += swz_xor_i<1>(v); v += swz_xor_i<2>(v); v += swz_xor_i<4>(v); v += swz_xor_i<8>(v); v += swz_xor_i<16>(v); return sum_x32_i(v); }
__device__ __forceinline__ float sum_x16_x32(float v) { v += swz_xor<16>(v); return sum_x32(v); }
__device__ __forceinline__ float sum_x1_x2(float v) { v += swz_xor<1>(v); v += swz_xor<2>(v); return v; }
__device__ __forceinline__ float ex2(float x) { return __builtin_amdgcn_exp2f(x); }
__device__ __forceinline__ float sigmoidf_(float x) { return 1.f / (1.f + ex2(-x * LOG2E)); }
__device__ __forceinline__ float gelu_tanh(float x) { const float u = 0.7978845608028654f * (x + 0.044715f * x * x * x); return x / (1.f + ex2(-2.f * LOG2E * u)); }
__device__ __forceinline__ f32x4 mfma16(bf16x8 a, bf16x8 b, f32x4 c) { return __builtin_amdgcn_mfma_f32_16x16x32_bf16(a, b, c, 0, 0, 0); }
__device__ __forceinline__ bf16x8 as_bf16x8(u32x4 w) { return __builtin_bit_cast(bf16x8, w); }
__device__ __forceinline__ float log2_sigmoid(float a) { return -log1pf(__expf(-a)) * LOG2E; }

struct GroupOrder {
    int nG, nM, nN, pmS, pnS, G, c;
    __device__ __forceinline__ bool next(int i, pg8::Unit& u) const {
        const long L = (long)i * G + c; const int tot = nG * nM * nN; if (L >= tot) return false;
        int wgid = (int)L; { const int q = tot / 8, r = tot % 8, xcd = wgid % 8, off = wgid / 8; wgid = (xcd < r ? xcd * (q + 1) : r * (q + 1) + (xcd - r) * q) + off; }
        const int per = nM * nN, g = wgid / per, rem = wgid - g * per;
        const int nig = 8 * nN, gid = rem / nig, fm = gid * 8, gsz = (nM - fm) < 8 ? (nM - fm) : 8;
        u.pm = g * pmS + fm + ((rem % nig) % gsz); u.pn = g * pnS + (rem % nig) / gsz; return true;
    }
    __device__ __forceinline__ void a_ready(const pg8::Unit&) const {}
    __device__ __forceinline__ void done(const pg8::Unit&) const {}
};
struct MergeOrder {
    int nM, G, c;
    __device__ __forceinline__ bool next(int i, pg8::Unit& u) const {
        const int ii = i / 3, g = i - 3 * ii; const long L = (long)ii * G + c; const int tot = nM * 4; if (L >= tot) return false;
        int wgid = (int)L; { const int q = tot / 8, r = tot % 8, xcd = wgid % 8, off = wgid / 8; wgid = (xcd < r ? xcd * (q + 1) : r * (q + 1) + (xcd - r) * q) + off; }
        const int nig = 32, gid = wgid / nig, fm = gid * 8, gsz = (nM - fm) < 8 ? (nM - fm) : 8;
        u.pm = g * (M / 256) + fm + ((wgid % nig) % gsz); u.pn = g * 4 + (wgid % nig) / gsz; return true;
    }
    __device__ __forceinline__ void a_ready(const pg8::Unit&) const {}
    __device__ __forceinline__ void done(const pg8::Unit&) const {}
};

struct EpiZA {
    static constexpr bool PERM = true, AFTER_DRAIN = false, CHAIN = false;
    bf16* O;
    __device__ __forceinline__ void operator()(const f32x4 (&acc)[2][2][4][2], const pg8::Unit& u, int wr, int wc, int fr, int fq) const {
        const int row0 = u.pm * 256 + wr * 64 + fr, col0 = u.pn * 256 + wc * 32 + 8 * fq; const bool act = false;
#pragma unroll
        for (int ai = 0; ai < 2; ++ai)
#pragma unroll
            for (int m = 0; m < 4; ++m) { bf16* rowp = O + (size_t)(row0 + ai * 128 + m * 16) * NZA + col0;
#pragma unroll
                for (int bj = 0; bj < 2; ++bj) { const f32x4 v0 = acc[ai][bj][m][0], v1 = acc[ai][bj][m][1];
                    float o[8] = {v0[0], v0[1], v0[2], v0[3], v1[0], v1[1], v1[2], v1[3]};
                    if (act) {
#pragma unroll
                        for (int k = 0; k < 8; ++k) o[k] = gelu_tanh(o[k]); }
                    *(u32x4*)(rowp + bj * 128) = pack8(o); } }
    }
};
struct EpiNull {
    static constexpr bool PERM = true, AFTER_DRAIN = false, CHAIN = false;
    __device__ __forceinline__ void operator()(const f32x4 (&acc)[2][2][4][2], const pg8::Unit& u, int wr, int wc, int fr, int fq) const {
#pragma unroll
        for (int ai = 0; ai < 2; ++ai)
#pragma unroll
            for (int m = 0; m < 4; ++m)
#pragma unroll
                for (int bj = 0; bj < 2; ++bj) { asm volatile("" :: "v"(acc[ai][bj][m][0]), "v"(acc[ai][bj][m][1])); }
    }
};
struct EpiSig {
    static constexpr bool PERM = true, AFTER_DRAIN = false, CHAIN = false;
    bf16* O;
    __device__ __forceinline__ void operator()(const f32x4 (&acc)[2][2][4][2], const pg8::Unit& u, int wr, int wc, int fr, int fq) const {
        const int row0 = u.pm * 256 + wr * 64 + fr, col0 = u.pn * 256 + wc * 32 + 8 * fq;
#pragma unroll
        for (int ai = 0; ai < 2; ++ai)
#pragma unroll
            for (int m = 0; m < 4; ++m) { bf16* rowp = O + (size_t)(row0 + ai * 128 + m * 16) * NZG + col0;
#pragma unroll
                for (int bj = 0; bj < 2; ++bj) { const f32x4 v0 = acc[ai][bj][m][0], v1 = acc[ai][bj][m][1];
                    float o[8] = {v0[0], v0[1], v0[2], v0[3], v1[0], v1[1], v1[2], v1[3]};
#pragma unroll
                    for (int k = 0; k < 8; ++k) o[k] = fmaxf(sigmoidf_(o[k]), 1e-20f);
                    *(u32x4*)(rowp + bj * 128) = pack8(o); } }
    }
};
struct EpiMergeChain {
    static constexpr bool PERM = true, AFTER_DRAIN = false, CHAIN = true;
    const bf16* Gt; bf16* Hm;
    __device__ __forceinline__ bool chain(f32x4 (&acc)[2][2][4][2], const pg8::Unit& u, int wr, int wc, int fr, int fq) const {
        const int g = u.pm / (M / 256), m = u.pm - g * (M / 256), n = u.pn - g * 4;
        const int row0 = m * 256 + wr * 64 + fr, col0 = n * 256 + wc * 32 + 8 * fq;
#pragma unroll
        for (int ai = 0; ai < 2; ++ai) {
            u32x4 gw[4][2], hw[4][2];
#pragma unroll
            for (int mm = 0; mm < 4; ++mm)
#pragma unroll
                for (int bj = 0; bj < 2; ++bj) gw[mm][bj] = *(const u32x4*)(Gt + (size_t)(row0 + ai * 128 + mm * 16) * NZG + g * 1024 + col0 + bj * 128);
            if (g < 2) {
#pragma unroll
                for (int mm = 0; mm < 4; ++mm)
#pragma unroll
                    for (int bj = 0; bj < 2; ++bj) hw[mm][bj] = *(const u32x4*)(Gt + (size_t)(row0 + ai * 128 + mm * 16) * NZG + (g + 1) * 1024 + col0 + bj * 128);
            }
#pragma unroll
            for (int mm = 0; mm < 4; ++mm)
#pragma unroll
                for (int bj = 0; bj < 2; ++bj) {
                    float sc[8]; unpack8(gw[mm][bj], sc);
                    if (g < 2) { float sn[8]; unpack8(hw[mm][bj], sn);
#pragma unroll
                        for (int k = 0; k < 8; ++k) sc[k] *= __builtin_amdgcn_rcpf(sn[k]); }
                    f32x4& v0 = acc[ai][bj][mm][0]; f32x4& v1 = acc[ai][bj][mm][1];
                    v0[0] *= sc[0]; v0[1] *= sc[1]; v0[2] *= sc[2]; v0[3] *= sc[3]; v1[0] *= sc[4]; v1[1] *= sc[5]; v1[2] *= sc[6]; v1[3] *= sc[7];
                    if (g == 2) { u32x4 w; w.x = pk2(v0[0], v0[1]); w.y = pk2(v0[2], v0[3]); w.z = pk2(v1[0], v1[1]); w.w = pk2(v1[2], v1[3]);
                        *(u32x4*)(Hm + (size_t)(row0 + ai * 128 + mm * 16) * 1024 + col0 + bj * 128) = w; }
                }
        }
        return g < 2;
    }
};
struct EpiMerge {
    static constexpr bool PERM = true, AFTER_DRAIN = false, CHAIN = false;
    const bf16* Gt; bf16* Hm;
    __device__ __forceinline__ void operator()(const f32x4 (&acc)[2][2][4][2], const pg8::Unit& u, int wr, int wc, int fr, int fq) const {
        const int g = u.pm / (M / 256), m = u.pm - g * (M / 256), n = u.pn - g * 4;
        const int row0 = m * 256 + wr * 64 + fr, col0 = n * 256 + wc * 32 + 8 * fq;
#pragma unroll
        for (int ai = 0; ai < 2; ++ai) {
            u32x4 gw[4][2], ow[4][2];
#pragma unroll
            for (int mm = 0; mm < 4; ++mm)
#pragma unroll
                for (int bj = 0; bj < 2; ++bj) gw[mm][bj] = *(const u32x4*)(Gt + (size_t)(row0 + ai * 128 + mm * 16) * NZG + g * 1024 + col0 + bj * 128);
            if (g > 0) {
#pragma unroll
                for (int mm = 0; mm < 4; ++mm)
#pragma unroll
                    for (int bj = 0; bj < 2; ++bj) ow[mm][bj] = *(const u32x4*)(Hm + (size_t)(row0 + ai * 128 + mm * 16) * 1024 + col0 + bj * 128);
            }
#pragma unroll
            for (int mm = 0; mm < 4; ++mm)
#pragma unroll
                for (int bj = 0; bj < 2; ++bj) {
                    float gt[8]; unpack8(gw[mm][bj], gt);
                    const f32x4 v0 = acc[ai][bj][mm][0], v1 = acc[ai][bj][mm][1];
                    float o[8] = {v0[0], v0[1], v0[2], v0[3], v1[0], v1[1], v1[2], v1[3]};
#pragma unroll
                    for (int k = 0; k < 8; ++k) o[k] *= sigmoidf_(gt[k]);
                    if (g > 0) { float od[8]; unpack8(ow[mm][bj], od);
#pragma unroll
                        for (int k = 0; k < 8; ++k) o[k] += od[k]; }
                    *(u32x4*)(Hm + (size_t)(row0 + ai * 128 + mm * 16) * 1024 + col0 + bj * 128) = pack8(o);
                }
        }
    }
};
struct EpiOut {
    static constexpr bool PERM = false, AFTER_DRAIN = false, CHAIN = false;
    const float* xl; const float* xc; float* X; const float* modv;
    __device__ __forceinline__ void operator()(const f32x4 (&acc)[2][2][4][2], const pg8::Unit& u, int wr, int wc, int fr, int fq) const {
        const int row0 = u.pm * 256 + wr * 64 + fr, col0 = u.pn * 256 + wc * 32 + 4 * fq;
        const int bi = (u.pm * 256 < ML) ? ((u.pm * 256) >> 12) : 8;
        const float* g1 = modv + bi * 6144 + 2 * 1024;
        const float* src0 = (u.pm * 256 < ML) ? xl + (size_t)row0 * 1024 : xc + (size_t)(row0 - ML) * 1024;
        f32x4 gv[2][2];
#pragma unroll
        for (int bj = 0; bj < 2; ++bj)
#pragma unroll
            for (int n = 0; n < 2; ++n) gv[bj][n] = *(const f32x4*)(g1 + col0 + bj * 128 + n * 16);
#pragma unroll
        for (int ai = 0; ai < 2; ++ai) {
            f32x4 xv[4][2][2];
#pragma unroll
            for (int m = 0; m < 4; ++m)
#pragma unroll
                for (int bj = 0; bj < 2; ++bj)
#pragma unroll
                    for (int n = 0; n < 2; ++n) xv[m][bj][n] = *(const f32x4*)(src0 + (size_t)(ai * 128 + m * 16) * 1024 + col0 + bj * 128 + n * 16);
#pragma unroll
            for (int m = 0; m < 4; ++m)
#pragma unroll
                for (int bj = 0; bj < 2; ++bj)
#pragma unroll
                    for (int n = 0; n < 2; ++n) *(f32x4*)(X + (size_t)(row0 + ai * 128 + m * 16) * 1024 + col0 + bj * 128 + n * 16) = xv[m][bj][n] + gv[bj][n] * acc[ai][bj][m][n];
        }
    }
};
struct EpiMoe1 {
    static constexpr bool PERM = true, AFTER_DRAIN = false, CHAIN = false;
    bf16* ACT;
    __device__ __forceinline__ void operator()(const f32x4 (&acc)[2][2][4][2], const pg8::Unit& u, int wr, int wc, int fr, int fq) const {
        const int row0 = u.pm * 256 + wr * 64 + fr, col0 = (u.pn & 7) * 128 + wc * 32 + 8 * fq;
#pragma unroll
        for (int ai = 0; ai < 2; ++ai)
#pragma unroll
            for (int m = 0; m < 4; ++m) { const size_t r = (size_t)(row0 + ai * 128 + m * 16);
                const f32x4 a0 = acc[ai][0][m][0], a1 = acc[ai][0][m][1], u0 = acc[ai][1][m][0], u1 = acc[ai][1][m][1];
                float o[8];
#pragma unroll
                for (int k = 0; k < 4; ++k) { o[k] = a0[k] * sigmoidf_(a0[k]) * u0[k]; o[4 + k] = a1[k] * sigmoidf_(a1[k]) * u1[k]; }
                *(u32x4*)(ACT + r * 1024 + col0) = pack8(o); }
    }
};
struct EpiMoe2 {
    static constexpr bool PERM = true, AFTER_DRAIN = false, CHAIN = false;
    bf16* Y; const float* topw;
    __device__ __forceinline__ void operator()(const f32x4 (&acc)[2][2][4][2], const pg8::Unit& u, int wr, int wc, int fr, int fq) const {
        const int row0 = u.pm * 256 + wr * 64 + fr, col0 = (u.pn & 3) * 256 + wc * 32 + 8 * fq;
        float twv[2][4];
#pragma unroll
        for (int ai = 0; ai < 2; ++ai)
#pragma unroll
            for (int m = 0; m < 4; ++m) twv[ai][m] = topw[row0 + ai * 128 + m * 16];
#pragma unroll
        for (int ai = 0; ai < 2; ++ai)
#pragma unroll
            for (int m = 0; m < 4; ++m) { const size_t r = (size_t)(row0 + ai * 128 + m * 16); const float tw = twv[ai][m];
#pragma unroll
                for (int bj = 0; bj < 2; ++bj) { const f32x4 v0 = acc[ai][bj][m][0] * tw, v1 = acc[ai][bj][m][1] * tw;
                    u32x4 w; w.x = pk2(v0[0], v0[1]); w.y = pk2(v0[2], v0[3]); w.z = pk2(v1[0], v1[1]); w.w = pk2(v1[2], v1[3]);
                    *(u32x4*)(Y + r * 1024 + col0 + bj * 128) = w; } }
    }
};

__device__ __forceinline__ void tr_item(const float* W, int N, int k0, int n0, bf16* dst, int K, LAS float* scr, int lane) {
#pragma unroll 8
    for (int i = 0; i < 32; ++i) { const int kk = 2 * i + (lane >> 5); scr[kk * 33 + (lane & 31)] = W[(size_t)(k0 + kk) * N + n0 + (lane & 31)]; }
    LDS_WAIT();
    const int cc = lane & 7;
#pragma unroll
    for (int j = 0; j < 4; ++j) { const int n = (lane >> 3) + 8 * j; const LAS float* s = scr + (8 * cc) * 33 + n;
        u32x4 o; o.x = pk2(s[0 * 33], s[1 * 33]); o.y = pk2(s[2 * 33], s[3 * 33]); o.z = pk2(s[4 * 33], s[5 * 33]); o.w = pk2(s[6 * 33], s[7 * 33]);
        *(u32x4*)(dst + (size_t)n * K + 8 * cc) = o; }
    LDS_WAIT();
}
__device__ __forceinline__ void convert_small(KPC p, int l, LAS unsigned char* lds, int lane, int wave, int bid, int G) {
    LAS float* scr = (LAS float*)(lds + wave * 8448);
    const int gw = bid * 8 + wave, NGW = G * 8;
    constexpr int I_IN = 16 * 200, I_BR = 8 * 32, I_OUT = 16 * 32;
    bf16* wtin = (bf16*)(p->ws + WS_WTIN); bf16* wtbr = (bf16*)(p->ws + WS_WTBR); bf16* wtout = (bf16*)(p->ws + WS_WTOUT);
    for (int it = gw; it < I_IN + 3 * I_BR + I_OUT; it += NGW) {
        int r = it;
        if (r < I_IN) { const int kb = r / 200, nb = r % 200; tr_item(p->w_in + (size_t)l * 1024 * 6400, 6400, 64 * kb, 32 * nb, wtin + (size_t)(32 * nb) * 1024 + 64 * kb, 1024, scr, lane); continue; }
        r -= I_IN;
        if (r < 3 * I_BR) { const int br = r / I_BR, q = r % I_BR, kb = q / 32, nb = q % 32;
            tr_item(p->w_branch + ((size_t)l * 3 + br) * 512 * 1024, 1024, 64 * kb, 32 * nb, wtbr + (size_t)(br * 1024 + 32 * nb) * 512 + 64 * kb, 512, scr, lane); continue; }
        r -= 3 * I_BR;
        { const int kb = r / 32, nb = r % 32; tr_item(p->w_out + (size_t)l * 1024 * 1024, 1024, 64 * kb, 32 * nb, wtout + (size_t)(32 * nb) * 1024 + 64 * kb, 1024, scr, lane); }
    }
}
__device__ __forceinline__ void convert_experts(KPC p, int l, int lo, int hi, int widx, int nw, LAS unsigned char* lds, int lane, int wave) {
    LAS float* scr = (LAS float*)(lds + wave * 8448);
    bf16* wt1 = (bf16*)(p->ws + WS_WT1); bf16* wt2 = (bf16*)(p->ws + WS_WT2);
    for (int it = lo + widx; it < hi; it += nw) {
        const int e = it / 1536, q = it % 1536, which = q / 512, qq = q % 512, kb = qq / 32, nb = qq % 32, n0 = 32 * nb, k0 = 64 * kb;
        const size_t woff = ((size_t)l * NE + e) * 1024 * 1024;
        if (which == 0) tr_item(p->w_eg + woff, 1024, k0, n0, wt1 + ((size_t)e * 2048 + (n0 >> 7) * 256 + (n0 & 127)) * 1024 + k0, 1024, scr, lane);
        else if (which == 1) tr_item(p->w_eu + woff, 1024, k0, n0, wt1 + ((size_t)e * 2048 + (n0 >> 7) * 256 + 128 + (n0 & 127)) * 1024 + k0, 1024, scr, lane);
        else tr_item(p->w_ed + woff, 1024, k0, n0, wt2 + ((size_t)e * 1024 + n0) * 1024 + k0, 1024, scr, lane);
    }
}
constexpr int CVT_ITEMS = NE * 3 * 512;
constexpr int CVT_G_IDLE0 = 96, CVT_M_IDLE0 = 32, CVT_O_IDLE0 = 32;
constexpr int CVT_G_HI = 7680, CVT_M_HI = 7680 + 14336;

__device__ __forceinline__ void phase_prep(KPC p, LAS unsigned char* lds, int tid, int lane, int wave, int bid, int G) {
    unsigned char* ws = p->ws;
    {   float* rc = (float*)(ws + WS_ROPEC); float* rsn = (float*)(ws + WS_ROPES);
        for (int i = bid * 512 + tid; i < T * 32; i += G * 512) { const int t = i >> 5, f = i & 31; const int pos = (f < 16) ? (t >> 6) : (t & 63); const int fi = f & 15;
            const float inv = ex2(-(float)fi * (13.287712379549449f / 16.f));
            float ang = (float)pos * inv; ang -= 6.283185307179586f * rintf(ang * 0.15915494309189535f);
            rc[i] = __cosf(ang); rsn[i] = __sinf(ang); } }
    {   LAS float* sv = (LAS float*)lds;
        LAS float* red = (LAS float*)(lds + 36864);
        for (int i = tid; i < 9 * 1024; i += 512) { const int r = i >> 10, k = i & 1023; const float v = (r < 8) ? p->c[r * 1024 + k] : p->c_ctx[k]; sv[i] = v * sigmoidf_(v); }
        __syncthreads();
        for (int it = bid; it < 192; it += G) {
            const int l = it / 96, n0 = (it % 96) * 64;
            const float* W = p->w_mod + (size_t)l * 1024 * 6144 + n0 + lane;
            float acc[9];
#pragma unroll
            for (int r = 0; r < 9; ++r) acc[r] = 0.f;
#pragma unroll 4
            for (int k = wave * 128; k < wave * 128 + 128; ++k) { const float wv = W[(size_t)k * 6144];
#pragma unroll
                for (int r = 0; r < 9; ++r) acc[r] += sv[r * 1024 + k] * wv; }
#pragma unroll
            for (int r = 0; r < 9; ++r) red[(wave * 9 + r) * 64 + lane] = acc[r];
            __syncthreads();
            for (int i = tid; i < 576; i += 512) { const int r = i >> 6, ln = i & 63; float s = 0.f;
#pragma unroll
                for (int w = 0; w < 8; ++w) s += red[(w * 9 + r) * 64 + ln];
                s += p->b_mod[l * 6144 + n0 + ln]; ((float*)(ws + WS_MODV))[(l * 9 + r) * 6144 + n0 + ln] = s; }
            __syncthreads();
        }
    }
    __syncthreads();
    convert_small(p, 0, lds, lane, wave, bid, G);
}

__device__ __forceinline__ float row_rs(const f32x4 (&v)[4]) {
    float ss = 0.f;
#pragma unroll
    for (int j = 0; j < 4; ++j) ss += (v[j].x * v[j].x + v[j].y * v[j].y) + (v[j].z * v[j].z + v[j].w * v[j].w);
    return 1.0f / sqrtf(wave_sum(ss) * (1.f / 1024.f) + EPS);
}
__device__ __forceinline__ void norm_mod(const f32x4 (&v)[4], float rs, const float* gain, const float* sh, const float* sc, f32x4 (&h)[4], int lane) {
#pragma unroll
    for (int j = 0; j < 4; ++j) { const int col = 4 * lane + 256 * j; const f32x4 g = *(const f32x4*)(gain + col), a = *(const f32x4*)(sc + col), b = *(const f32x4*)(sh + col);
        h[j] = (v[j] * rs) * g * (a + 1.0f) + b; }
}
__device__ __forceinline__ void store_h(const f32x4 (&h)[4], bf16* hrow, int lane) {
#pragma unroll
    for (int j = 0; j < 4; ++j) { u32x2 w; w.x = pk2(h[j].x, h[j].y); w.y = pk2(h[j].z, h[j].w); *(u32x2*)(hrow + 4 * lane + 256 * j) = w; }
}
__device__ __forceinline__ void phase_norm_in(KPC p, int lane, int wave, int bid, int G) {
    const float* modv = (const float*)(p->ws + WS_MODV); bf16* H = (bf16*)(p->ws + WS_H);
    const int stride = G * 8; int r = bid * 8 + wave;
    f32x4 vn[4];
    {   const float* src = (r < ML) ? p->x + (size_t)r * 1024 : p->ctx + (size_t)(r - ML) * 1024;
#pragma unroll
        for (int j = 0; j < 4; ++j) vn[j] = (r < M) ? *(const f32x4*)(src + 4 * lane + 256 * j) : (f32x4){0.f, 0.f, 0.f, 0.f}; }
    for (; r < M; r += stride) {
        const int bi = (r < ML) ? (r >> 12) : 8; const float* mv = modv + bi * 6144;
        f32x4 v[4], h[4], g[4], sc[4], sh[4];
#pragma unroll
        for (int j = 0; j < 4; ++j) { v[j] = vn[j]; const int col = 4 * lane + 256 * j; g[j] = *(const f32x4*)(p->norm1_g + col); sh[j] = *(const f32x4*)(mv + col); sc[j] = *(const f32x4*)(mv + 1024 + col); }
        const int rn = r + stride;
        if (rn < M) { const float* src = (rn < ML) ? p->x + (size_t)rn * 1024 : p->ctx + (size_t)(rn - ML) * 1024;
#pragma unroll
            for (int j = 0; j < 4; ++j) vn[j] = *(const f32x4*)(src + 4 * lane + 256 * j); }
        const float rs = row_rs(v);
#pragma unroll
        for (int j = 0; j < 4; ++j) h[j] = (v[j] * rs) * g[j] * (sc[j] + 1.0f) + sh[j];
        store_h(h, H + (size_t)r * 1024, lane);
    }
}

__device__ __forceinline__ void att_item(KPC p, int l, LAS unsigned char* lds, int item, float Mb2, int tid, int lane, int wave) {
    const bf16* ZA = (const bf16*)(p->ws + WS_ZA); bf16* BR = (bf16*)p->out + (size_t)2 * M * 512;
    const float* rc = (const float*)(p->ws + WS_ROPEC); const float* rsn = (const float*)(p->ws + WS_ROPES);
    const bool isctx = item >= 512;
    int b, kvh, qb;
    if (!isctx) { b = item >> 6; kvh = (item >> 5) & 1; qb = item & 31; } else { const int ci = item - 512; b = ci >> 2; kvh = (ci >> 1) & 1; qb = ci & 1; }
    const int rowbase = isctx ? ML + b * CL : b * T;
    const int g = wave >> 1, qs = wave & 1, hh = kvh * 4 + g, c = lane & 15, g4 = lane >> 4, q0 = qb * 128 + qs * 64;
    const float* qg = p->qn_g + l * 64; const float* kg = p->kn_g + l * 64;
    LAS unsigned char* Kl = lds; LAS unsigned char* Vt = lds + 18432;
    bf16x8 qf[4][2];
#pragma unroll
    for (int ti = 0; ti < 4; ++ti) {
        const int pos = q0 + 16 * ti + c; const bf16* src = ZA + (size_t)(rowbase + pos) * NZA + C_AQ + hh * 64 + 8 * g4;
        float a[8], bb[8]; unpack8(*(const u32x4*)src, a); unpack8(*(const u32x4*)(src + 32), bb);
        float ss = 0.f;
#pragma unroll
        for (int j = 0; j < 8; ++j) ss += a[j] * a[j] + bb[j] * bb[j];
        ss = sum_x16_x32(ss);
        const float rs = 1.0f / sqrtf(ss * (1.f / 64.f) + EPS);
#pragma unroll
        for (int j = 0; j < 8; ++j) { a[j] *= rs * qg[8 * g4 + j]; bb[j] *= rs * qg[32 + 8 * g4 + j]; }
        if (!isctx) {
#pragma unroll
            for (int j = 0; j < 8; ++j) { const float cs = rc[pos * 32 + 8 * g4 + j], sn = rsn[pos * 32 + 8 * g4 + j]; const float x1 = a[j], x2 = bb[j]; a[j] = x1 * cs - x2 * sn; bb[j] = x1 * sn + x2 * cs; } }
#pragma unroll
        for (int j = 0; j < 8; ++j) { a[j] *= 0.125f * LOG2E; bb[j] *= 0.125f * LOG2E; }
        qf[ti][0] = as_bf16x8(pack8(a)); qf[ti][1] = as_bf16x8(pack8(bb));
        __builtin_amdgcn_sched_barrier(0);
    }
    f32x4 O[4][4]; float lsum[4];
#pragma unroll
    for (int i = 0; i < 4; ++i) { lsum[i] = 0.f;
#pragma unroll
        for (int j = 0; j < 4; ++j) O[i][j] = (f32x4){0.f, 0.f, 0.f, 0.f}; }
    const int ntile = isctx ? 2 : 5;
    for (int kt = 0; kt < ntile; ++kt) {
        int krow0, kpos0 = 0, mode = 0; bool local = false;
        if (isctx) krow0 = ML + b * CL + 128 * kt;
        else if (kt < 3) { const int kb = qb - 1 + kt; if (kb < 0 || kb > 31) continue; krow0 = b * T + kb * 128; kpos0 = kb * 128; local = true; mode = (kt == 0) ? 1 : ((kt == 2) ? 2 : 0); }
        else krow0 = ML + b * CL + 128 * (kt - 3);
        __syncthreads();
        {
            const int key = tid >> 2, q4 = tid & 3; const bf16* src = ZA + (size_t)(krow0 + key) * NZA + C_AK + kvh * 64 + 8 * q4;
            float a[8], bb[8]; unpack8(*(const u32x4*)src, a); unpack8(*(const u32x4*)(src + 32), bb);
            float ss = 0.f;
#pragma unroll
            for (int j = 0; j < 8; ++j) ss += a[j] * a[j] + bb[j] * bb[j];
            ss = sum_x1_x2(ss);
            const float rs = 1.0f / sqrtf(ss * (1.f / 64.f) + EPS);
#pragma unroll
            for (int j = 0; j < 8; ++j) { a[j] *= rs * kg[8 * q4 + j]; bb[j] *= rs * kg[32 + 8 * q4 + j]; }
            if (local) { const int pos = kpos0 + key;
#pragma unroll
                for (int j = 0; j < 8; ++j) { const float cs = rc[pos * 32 + 8 * q4 + j], sn = rsn[pos * 32 + 8 * q4 + j]; const float x1 = a[j], x2 = bb[j]; a[j] = x1 * cs - x2 * sn; bb[j] = x1 * sn + x2 * cs; } }
            *(LAS u32x4*)(Kl + key * 144 + 16 * q4) = pack8(a); *(LAS u32x4*)(Kl + key * 144 + 64 + 16 * q4) = pack8(bb);
            const bf16* vs = ZA + (size_t)(krow0 + key) * NZA + C_AV + kvh * 64 + 16 * q4;
            const u32x4 v0 = *(const u32x4*)vs, v1 = *(const u32x4*)(vs + 8);
            const unsigned vw[8] = {v0.x, v0.y, v0.z, v0.w, v1.x, v1.y, v1.z, v1.w};
#pragma unroll
            for (int j = 0; j < 8; ++j) { *(LAS unsigned short*)(Vt + (16 * q4 + 2 * j) * 272 + key * 2) = (unsigned short)(vw[j] & 0xffffu); *(LAS unsigned short*)(Vt + (16 * q4 + 2 * j + 1) * 272 + key * 2) = (unsigned short)(vw[j] >> 16); }
        }
        __syncthreads();
#pragma unroll 1
        for (int kk = 0; kk < 4; ++kk) {
            if ((mode == 1 && 32 * kk + 31 < qs * 64) || (mode == 2 && 32 * kk > qs * 64 + 63)) continue;
            bf16x8 ka[2][2];
#pragma unroll
            for (int hf = 0; hf < 2; ++hf)
#pragma unroll
                for (int ks = 0; ks < 2; ++ks) ka[hf][ks] = *(const LAS bf16x8*)(Kl + (32 * kk + 16 * hf + c) * 144 + ks * 64 + g4 * 16);
            bf16x8 pf[4];
#pragma unroll
            for (int ti = 0; ti < 4; ++ti) {
                f32x4 sa = (f32x4){0.f, 0.f, 0.f, 0.f}, sb = (f32x4){0.f, 0.f, 0.f, 0.f};
                sa = mfma16(ka[0][0], qf[ti][0], sa); sa = mfma16(ka[0][1], qf[ti][1], sa);
                sb = mfma16(ka[1][0], qf[ti][0], sb); sb = mfma16(ka[1][1], qf[ti][1], sb);
                const int ii = qs * 64 + 16 * ti + c; float pa[4], pb[4]; const int mlo = (mode == 1) ? ii : -1000, mhi = (mode == 2) ? ii : 1000;
#pragma unroll
                for (int rr = 0; rr < 4; ++rr) { const int ja = 32 * kk + 4 * g4 + rr, jb = ja + 16;
                    pa[rr] = ex2(sa[rr] - Mb2); pb[rr] = ex2(sb[rr] - Mb2);
                    pa[rr] = (ja >= mlo && ja <= mhi) ? pa[rr] : 0.f; pb[rr] = (jb >= mlo && jb <= mhi) ? pb[rr] : 0.f;
                    lsum[ti] += pa[rr] + pb[rr]; }
                u32x4 w; w.x = pk2(pa[0], pa[1]); w.y = pk2(pa[2], pa[3]); w.z = pk2(pb[0], pb[1]); w.w = pk2(pb[2], pb[3]); pf[ti] = as_bf16x8(w);
            }
#pragma unroll
            for (int dt = 0; dt < 4; ++dt) {
                const u32x2 v0 = *(const LAS u32x2*)(Vt + (16 * dt + c) * 272 + (32 * kk + 4 * g4) * 2), v1 = *(const LAS u32x2*)(Vt + (16 * dt + c) * 272 + (32 * kk + 16 + 4 * g4) * 2);
                u32x4 vv; vv.x = v0.x; vv.y = v0.y; vv.z = v1.x; vv.w = v1.y; const bf16x8 va = as_bf16x8(vv);
#pragma unroll
                for (int ti = 0; ti < 4; ++ti) O[dt][ti] = mfma16(va, pf[ti], O[dt][ti]);
            }
        }
    }
    const float sk = ex2(p->sink[l * 8 + hh] * LOG2E - Mb2);
#pragma unroll
    for (int ti = 0; ti < 4; ++ti) { float lt = sum_x16_x32(lsum[ti]); const float inv = 1.0f / (lt + sk);
        bf16* dst = BR + (size_t)(rowbase + q0 + 16 * ti + c) * 512 + hh * 64 + 4 * g4;
#pragma unroll
        for (int dt = 0; dt < 4; ++dt) { const f32x4 o = O[dt][ti] * inv; u32x2 w; w.x = pk2(o[0], o[1]); w.y = pk2(o[2], o[3]); *(u32x2*)(dst + 16 * dt) = w; } }
    __syncthreads();
}

__device__ __forceinline__ void sgu_vprep_item(KPC p, int ch, int tid) {
    bf16* ZA = (bf16*)(p->ws + WS_ZA);
    const int seg = tid & 15;
#pragma unroll 1
    for (int ps = 0; ps < 4; ++ps) {
        bf16* rowp = ZA + (size_t)(ch * 128 + ps * 32 + (tid >> 4)) * NZA + C_SV + 32 * seg;
        float f[4][8]; float s = 0.f, ss = 0.f;
#pragma unroll
        for (int q = 0; q < 4; ++q) unpack8(*(const u32x4*)(rowp + 8 * q), f[q]);
#pragma unroll
        for (int q = 0; q < 4; ++q)
#pragma unroll
            for (int e = 0; e < 8; ++e) { const float y = gelu_tanh(f[q][e]); f[q][e] = y; s += y; ss += y * y; }
        s += swz_xor<1>(s); s += swz_xor<2>(s); s += swz_xor<4>(s); s += swz_xor<8>(s);
        ss += swz_xor<1>(ss); ss += swz_xor<2>(ss); ss += swz_xor<4>(ss); ss += swz_xor<8>(ss);
        const float mean = s * (1.f / 512.f), var = fmaxf(ss * (1.f / 512.f) - mean * mean, 0.f), rstd = 1.0f / sqrtf(var + EPS);
#pragma unroll
        for (int q = 0; q < 4; ++q) {
#pragma unroll
            for (int e = 0; e < 8; ++e) f[q][e] = (f[q][e] - mean) * rstd;
            *(u32x4*)(rowp + 8 * q) = pack8(f[q]); }
    }
}
__device__ __forceinline__ void sgu_item(KPC p, int l, LAS unsigned char* lds, int item, int tid, int lane, int wave) {
    const bf16* ZA = (const bf16*)(p->ws + WS_ZA); bf16* BR = (bf16*)p->out + (size_t)1 * M * 512;
    const int ch = item >> 2, g = item & 3, r0 = ch * 128, c = lane & 15, g4 = lane >> 4;
    LAS unsigned char* vT = lds;
    LAS unsigned char* WL = lds + 34816;
    {   const int j = tid >> 2, q4 = tid & 3; const bf16* src = ZA + (size_t)(r0 + j) * NZA + C_SV + 128 * g + 32 * q4;
#pragma unroll
        for (int q = 0; q < 4; ++q) { const u32x4 v = *(const u32x4*)(src + 8 * q); const unsigned vw[4] = {v.x, v.y, v.z, v.w};
#pragma unroll
            for (int e = 0; e < 4; ++e) { *(LAS unsigned short*)(vT + (32 * q4 + 8 * q + 2 * e) * 272 + j * 2) = (unsigned short)(vw[e] & 0xffffu); *(LAS unsigned short*)(vT + (32 * q4 + 8 * q + 2 * e + 1) * 272 + j * 2) = (unsigned short)(vw[e] >> 16); } }
        const float* wsrc = p->sgu_w + ((size_t)(l * 4 + g) * 128 + (tid >> 2)) * 128 + 32 * (tid & 3);
#pragma unroll
        for (int q = 0; q < 4; ++q) { const f32x4 a = *(const f32x4*)(wsrc + 8 * q), bq = *(const f32x4*)(wsrc + 8 * q + 4);
            u32x4 w; w.x = pk2(a.x, a.y); w.y = pk2(a.z, a.w); w.z = pk2(bq.x, bq.y); w.w = pk2(bq.z, bq.w);
            *(LAS u32x4*)(WL + (tid >> 2) * 272 + (32 * (tid & 3) + 8 * q) * 2) = w; }
    }
    __syncthreads();
    bf16x8 af[4];
#pragma unroll
    for (int ks = 0; ks < 4; ++ks) af[ks] = *(const LAS bf16x8*)(vT + (16 * wave + c) * 272 + (32 * ks + 8 * g4) * 2);
    const int col = 128 * g + 16 * wave + 4 * g4;
    u32x2 uw[8]; float bias[8];
#pragma unroll
    for (int ti = 0; ti < 8; ++ti) { uw[ti] = *(const u32x2*)(ZA + (size_t)(r0 + 16 * ti + c) * NZA + C_SU + col); bias[ti] = p->sgu_b[(l * 4 + g) * 128 + 16 * ti + c]; }
#pragma unroll
    for (int ti = 0; ti < 8; ++ti) {
        f32x4 acc = (f32x4){0.f, 0.f, 0.f, 0.f};
#pragma unroll
        for (int ks = 0; ks < 4; ++ks) acc = mfma16(af[ks], *(const LAS bf16x8*)(WL + (16 * ti + c) * 272 + (32 * ks + 8 * g4) * 2), acc);
        const float o0 = gelu_tanh(bflo(uw[ti].x)) * (acc[0] + bias[ti]), o1 = gelu_tanh(bfhi(uw[ti].x)) * (acc[1] + bias[ti]), o2 = gelu_tanh(bflo(uw[ti].y)) * (acc[2] + bias[ti]), o3 = gelu_tanh(bfhi(uw[ti].y)) * (acc[3] + bias[ti]);
        u32x2 w; w.x = pk2(o0, o1); w.y = pk2(o2, o3); *(u32x2*)(BR + (size_t)(r0 + 16 * ti + c) * 512 + col) = w;
    }
    __syncthreads();
}

__device__ __forceinline__ void ret_load_k(KPC p, const bf16* ZA, int r0, int h, bool latent, int pos0, int tid, float (&a)[8], float (&bb)[8]) {
    const int j = tid >> 2, q4 = tid & 3; const bf16* src = ZA + (size_t)(r0 + j) * NZA + C_RK + 64 * h + 8 * q4;
    unpack8(*(const u32x4*)src, a); unpack8(*(const u32x4*)(src + 32), bb);
    if (latent) { const float* rc = (const float*)(p->ws + WS_ROPEC); const float* rsn = (const float*)(p->ws + WS_ROPES); const int pos = pos0 + j;
#pragma unroll
        for (int e = 0; e < 8; ++e) { const float cs = rc[pos * 32 + 8 * q4 + e], sn = rsn[pos * 32 + 8 * q4 + e]; const float x1 = a[e], x2 = bb[e]; a[e] = x1 * cs - x2 * sn; bb[e] = x1 * sn + x2 * cs; } }
#pragma unroll
    for (int e = 0; e < 8; ++e) { a[e] *= 0.125f; bb[e] *= 0.125f; }
}
__device__ __forceinline__ void ret_stage_vT(const bf16* ZA, int r0, int h, LAS unsigned char* vT, int tid) {
    const int j = tid >> 2, q4 = tid & 3; const bf16* src = ZA + (size_t)(r0 + j) * NZA + C_RV + 128 * h + 32 * q4;
#pragma unroll
    for (int q = 0; q < 4; ++q) { const u32x4 v = *(const u32x4*)(src + 8 * q); const unsigned vw[4] = {v.x, v.y, v.z, v.w};
#pragma unroll
        for (int e = 0; e < 4; ++e) { *(LAS unsigned short*)(vT + (32 * q4 + 8 * q + 2 * e) * 272 + j * 2) = (unsigned short)(vw[e] & 0xffffu); *(LAS unsigned short*)(vT + (32 * q4 + 8 * q + 2 * e + 1) * 272 + j * 2) = (unsigned short)(vw[e] >> 16); } }
}
__device__ __forceinline__ void ret_upd_item(KPC p, int l, LAS unsigned char* lds, int item, int tid, int lane, int wave) {
    const bf16* ZA = (const bf16*)(p->ws + WS_ZA); float* RS = (float*)(p->ws + WS_RS);
    const int b = item / (NCH * 4), rem = item % (NCH * 4), n = rem >> 2, h = rem & 3, c = lane & 15, g4 = lane >> 4;
    const bool latent = n < 32; const int r0 = latent ? b * T + 128 * n : ML + b * CL + 128 * (n - 32);
    const float lgf = log2_sigmoid(p->dec_f[l * 4 + h]), lgb = log2_sigmoid(p->dec_b[l * 4 + h]);
    LAS unsigned char* vT = lds; LAS unsigned char* kTf = lds + 34816; LAS unsigned char* kTb = lds + 34816 + 17408;
    {   float a[8], bb[8]; ret_load_k(p, ZA, r0, h, latent, 128 * n, tid, a, bb);
        const int j = tid >> 2, q4 = tid & 3; const float wf = ex2((float)(127 - j) * lgf), wb = ex2((float)j * lgb);
#pragma unroll
        for (int e = 0; e < 8; e += 2) {
            unsigned w = pk2(a[e] * wf, a[e + 1] * wf); *(LAS unsigned short*)(kTf + (8 * q4 + e) * 272 + j * 2) = (unsigned short)(w & 0xffffu); *(LAS unsigned short*)(kTf + (8 * q4 + e + 1) * 272 + j * 2) = (unsigned short)(w >> 16);
            w = pk2(bb[e] * wf, bb[e + 1] * wf); *(LAS unsigned short*)(kTf + (32 + 8 * q4 + e) * 272 + j * 2) = (unsigned short)(w & 0xffffu); *(LAS unsigned short*)(kTf + (32 + 8 * q4 + e + 1) * 272 + j * 2) = (unsigned short)(w >> 16);
            w = pk2(a[e] * wb, a[e + 1] * wb); *(LAS unsigned short*)(kTb + (8 * q4 + e) * 272 + j * 2) = (unsigned short)(w & 0xffffu); *(LAS unsigned short*)(kTb + (8 * q4 + e + 1) * 272 + j * 2) = (unsigned short)(w >> 16);
            w = pk2(bb[e] * wb, bb[e + 1] * wb); *(LAS unsigned short*)(kTb + (32 + 8 * q4 + e) * 272 + j * 2) = (unsigned short)(w & 0xffffu); *(LAS unsigned short*)(kTb + (32 + 8 * q4 + e + 1) * 272 + j * 2) = (unsigned short)(w >> 16);
        }
        ret_stage_vT(ZA, r0, h, vT, tid);
    }
    __syncthreads();
    bf16x8 af[4];
#pragma unroll
    for (int ks = 0; ks < 4; ++ks) af[ks] = *(const LAS bf16x8*)(vT + (16 * wave + c) * 272 + (32 * ks + 8 * g4) * 2);
#pragma unroll
    for (int dir = 0; dir < 2; ++dir) { const LAS unsigned char* kT = dir ? kTb : kTf;
        float* dst = RS + ((size_t)(((b * 4 + h) * 2 + dir) * NCH + n) * 128 + 16 * wave + 4 * g4) * 64;
#pragma unroll
        for (int dt = 0; dt < 4; ++dt) { f32x4 acc = (f32x4){0.f, 0.f, 0.f, 0.f};
#pragma unroll
            for (int ks = 0; ks < 4; ++ks) acc = mfma16(af[ks], *(const LAS bf16x8*)(kT + (16 * dt + c) * 272 + (32 * ks + 8 * g4) * 2), acc);
#pragma unroll
            for (int rr = 0; rr < 4; ++rr) dst[rr * 64 + 16 * dt + c] = acc[rr]; } }
    __syncthreads();
}
__device__ __forceinline__ void phase_scan(KPC p, int l, int tid, int bid, int G) {
    const float* RS = (const float*)(p->ws + WS_RS); bf16* ST = (bf16*)(p->ws + WS_ST);
    for (int idx = bid * 512 + tid; idx < NB * 4 * 2 * 8192; idx += G * 512) {
        const int ed = idx & 8191, dir = (idx >> 13) & 1, bh = idx >> 14, e = ed >> 6, d = ed & 63, h = bh & 3;
        const float* P = RS + (size_t)((bh * 2 + dir) * NCH) * 8192 + ed;
        bf16* S = ST + ((size_t)bh * NCH * 128 + e) * 128 + dir * 64 + d;
        const float lg = log2_sigmoid(dir ? p->dec_b[l * 4 + h] : p->dec_f[l * 4 + h]); const float dec = ex2(128.f * lg);
        const float u32 = P[32 * 8192], u33 = P[33 * 8192];
        if (dir == 0) {
            S[32 * 16384] = 0; S[33 * 16384] = (bf16)(pk2(u32, 0.f) & 0xffffu);
            float s = dec * u32 + u33;
            for (int n = 0; n < 32; ++n) { const float u = P[(size_t)n * 8192]; S[(size_t)n * 16384] = (bf16)(pk2(s, 0.f) & 0xffffu); s = dec * s + u; }
        } else {
            S[33 * 16384] = 0; S[32 * 16384] = (bf16)(pk2(u33, 0.f) & 0xffffu);
            float s = dec * u33 + u32;
            for (int n = 31; n >= 0; --n) { const float u = P[(size_t)n * 8192]; S[(size_t)n * 16384] = (bf16)(pk2(s, 0.f) & 0xffffu); s = dec * s + u; }
        }
    }
}
__device__ __forceinline__ void ret_out_item(KPC p, int l, LAS unsigned char* lds, int item, int tid, int lane, int wave) {
    const bf16* ZA = (const bf16*)(p->ws + WS_ZA); bf16* BR = (bf16*)p->out; const bf16* ST = (const bf16*)(p->ws + WS_ST);
    const int b = item / (NCH * 4), rem = item % (NCH * 4), n = rem >> 2, h = rem & 3, c = lane & 15, g4 = lane >> 4;
    const bool latent = n < 32; const int r0 = latent ? b * T + 128 * n : ML + b * CL + 128 * (n - 32);
    const float lgf = log2_sigmoid(p->dec_f[l * 4 + h]), lgb = log2_sigmoid(p->dec_b[l * 4 + h]);
    LAS unsigned char* vT = lds; LAS unsigned char* Kl = lds + 34816; LAS unsigned char* Sl = lds + 34816 + 18432;
    {   float a[8], bb[8]; ret_load_k(p, ZA, r0, h, latent, 128 * n, tid, a, bb);
        const int j = tid >> 2, q4 = tid & 3;
        *(LAS u32x4*)(Kl + j * 144 + 16 * q4) = pack8(a); *(LAS u32x4*)(Kl + j * 144 + 64 + 16 * q4) = pack8(bb);
        ret_stage_vT(ZA, r0, h, vT, tid);
        const u32x4* ssrc = (const u32x4*)(ST + (size_t)((b * 4 + h) * NCH + n) * 16384);
#pragma unroll
        for (int k = 0; k < 4; ++k) { const int q = tid + 512 * k; *(LAS u32x4*)(Sl + (q >> 4) * 272 + (q & 15) * 16) = ssrc[q]; }
    }
    __syncthreads();
    const int ii = 16 * wave + c;
    bf16x8 qf[2];
    {   const bf16* src = ZA + (size_t)(r0 + ii) * NZA + C_RQ + 64 * h + 8 * g4; float a[8], bb[8]; unpack8(*(const u32x4*)src, a); unpack8(*(const u32x4*)(src + 32), bb);
        if (latent) { const float* rc = (const float*)(p->ws + WS_ROPEC); const float* rsn = (const float*)(p->ws + WS_ROPES); const int pos = 128 * n + ii;
#pragma unroll
            for (int e = 0; e < 8; ++e) { const float cs = rc[pos * 32 + 8 * g4 + e], sn = rsn[pos * 32 + 8 * g4 + e]; const float x1 = a[e], x2 = bb[e]; a[e] = x1 * cs - x2 * sn; bb[e] = x1 * sn + x2 * cs; } }
        qf[0] = as_bf16x8(pack8(a)); qf[1] = as_bf16x8(pack8(bb)); }
    bf16x8 pf[4];
#pragma unroll
    for (int kk = 0; kk < 4; ++kk) {
        f32x4 sa = (f32x4){0.f, 0.f, 0.f, 0.f}, sb = (f32x4){0.f, 0.f, 0.f, 0.f};
        sa = mfma16(*(const LAS bf16x8*)(Kl + (32 * kk + c) * 144 + g4 * 16), qf[0], sa); sa = mfma16(*(const LAS bf16x8*)(Kl + (32 * kk + c) * 144 + 64 + g4 * 16), qf[1], sa);
        sb = mfma16(*(const LAS bf16x8*)(Kl + (32 * kk + 16 + c) * 144 + g4 * 16), qf[0], sb); sb = mfma16(*(const LAS bf16x8*)(Kl + (32 * kk + 16 + c) * 144 + 64 + g4 * 16), qf[1], sb);
        float pa[4], pb[4];
#pragma unroll
        for (int rr = 0; rr < 4; ++rr) { const int ja = 32 * kk + 4 * g4 + rr, jb = ja + 16; const int da = ii - ja, db = ii - jb;
            pa[rr] = sa[rr] * ((da >= 0) ? ex2((float)da * lgf) : ex2((float)(-da) * lgb)); pb[rr] = sb[rr] * ((db >= 0) ? ex2((float)db * lgf) : ex2((float)(-db) * lgb)); }
        u32x4 w; w.x = pk2(pa[0], pa[1]); w.y = pk2(pa[2], pa[3]); w.z = pk2(pb[0], pb[1]); w.w = pk2(pb[2], pb[3]); pf[kk] = as_bf16x8(w);
    }
    const float cf = ex2((float)(ii + 1) * lgf), cb = ex2((float)(128 - ii) * lgb);
    f32x4 O[8]; float s = 0.f, ss = 0.f;
#pragma unroll
    for (int et = 0; et < 8; ++et) {
        f32x4 acc = (f32x4){0.f, 0.f, 0.f, 0.f}, xf = (f32x4){0.f, 0.f, 0.f, 0.f}, xb = (f32x4){0.f, 0.f, 0.f, 0.f};
#pragma unroll
        for (int kk = 0; kk < 4; ++kk) { const u32x2 v0 = *(const LAS u32x2*)(vT + (16 * et + c) * 272 + (32 * kk + 4 * g4) * 2), v1 = *(const LAS u32x2*)(vT + (16 * et + c) * 272 + (32 * kk + 16 + 4 * g4) * 2);
            u32x4 vv; vv.x = v0.x; vv.y = v0.y; vv.z = v1.x; vv.w = v1.y; acc = mfma16(as_bf16x8(vv), pf[kk], acc); }
#pragma unroll
        for (int ks = 0; ks < 2; ++ks) { xf = mfma16(*(const LAS bf16x8*)(Sl + (16 * et + c) * 272 + (32 * ks + 8 * g4) * 2), qf[ks], xf);
            xb = mfma16(*(const LAS bf16x8*)(Sl + (16 * et + c) * 272 + (64 + 32 * ks + 8 * g4) * 2), qf[ks], xb); }
        acc = acc + xf * cf + xb * cb; O[et] = acc;
        s += (acc[0] + acc[1]) + (acc[2] + acc[3]); ss += (acc[0] * acc[0] + acc[1] * acc[1]) + (acc[2] * acc[2] + acc[3] * acc[3]);
    }
    s = sum_x16_x32(s); ss = sum_x16_x32(ss);
    const float mean = s * (1.f / 128.f), var = fmaxf(ss * (1.f / 128.f) - mean * mean, 0.f), rstd = 1.0f / sqrtf(var + EPS);
    const bf16* gsrc = ZA + (size_t)(r0 + ii) * NZA + C_RG + 128 * h + 4 * g4; bf16* dst = BR + (size_t)(r0 + ii) * 512 + 128 * h + 4 * g4;
#pragma unroll
    for (int et = 0; et < 8; ++et) { const u32x2 gw = *(const u32x2*)(gsrc + 16 * et); const float g0 = bflo(gw.x), g1 = bfhi(gw.x), g2 = bflo(gw.y), g3 = bfhi(gw.y);
        const float o0 = (O[et][0] - mean) * rstd * g0 * sigmoidf_(g0), o1 = (O[et][1] - mean) * rstd * g1 * sigmoidf_(g1), o2 = (O[et][2] - mean) * rstd * g2 * sigmoidf_(g2), o3 = (O[et][3] - mean) * rstd * g3 * sigmoidf_(g3);
        u32x2 w; w.x = pk2(o0, o1); w.y = pk2(o2, o3); *(u32x2*)(dst + 16 * et) = w; }
    __syncthreads();
}

#ifndef REP_CVT
#define REP_CVT 1
#endif
#ifndef REP_N2R
#define REP_N2R 1
#endif
#ifndef REP_TK
#define REP_TK 1
#endif
__device__ __forceinline__ int wr_off(int k) { return k * 64 + (k >> 2) * 16; }
__device__ __forceinline__ void phase_norm2(KPC p, int l, LAS unsigned char* lds, int tid, int lane, int wave, int bid, int G) {
    if (l == 1 || G != 256) { for (int rep = 0; rep < REP_CVT; ++rep) convert_experts(p, l, 0, CVT_ITEMS, bid * 8 + wave, G * 8, lds, lane, wave); __syncthreads(); }
    LAS unsigned char* wrl = lds + 69632;
    for (int i = tid; i < 1024 * 4; i += 512) { const int k = i >> 2, q = i & 3; *(LAS f32x4*)(wrl + wr_off(k) + 16 * q) = *(const f32x4*)(p->w_router + (size_t)l * 16384 + k * 16 + 4 * q); }
    __syncthreads();
    const float* modv = (const float*)(p->ws + WS_MODV) + l * 9 * 6144; const float* X = (const float*)(p->ws + WS_X); bf16* H = (bf16*)(p->ws + WS_H);
    float* AFF = (float*)(p->ws + WS_AFF); float* AFFC = (float*)(p->ws + WS_AFFC); int* INV = (int*)(p->ws + WS_INV);
    const int rows = (l == 0) ? M : ML, stride = G * 8;
    for (int rep = 0; rep < REP_N2R; ++rep) {
    int r = bid * 8 + wave;
    f32x4 vn[4];
#pragma unroll
    for (int j = 0; j < 4; ++j) vn[j] = (r < rows) ? *(const f32x4*)(X + (size_t)r * 1024 + 4 * lane + 256 * j) : (f32x4){0.f, 0.f, 0.f, 0.f};
    for (; r < rows; r += stride) {
        const int bi = (r < ML) ? (r >> 12) : 8; const float* mv = modv + bi * 6144;
        f32x4 v[4], h[4], g[4], sc[4], sh[4];
#pragma unroll
        for (int j = 0; j < 4; ++j) { v[j] = vn[j]; const int col = 4 * lane + 256 * j; g[j] = *(const f32x4*)(p->norm2_g + l * 1024 + col); sh[j] = *(const f32x4*)(mv + 3 * 1024 + col); sc[j] = *(const f32x4*)(mv + 4 * 1024 + col); }
        const int rn = r + stride;
        if (rn < rows) {
#pragma unroll
            for (int j = 0; j < 4; ++j) vn[j] = *(const f32x4*)(X + (size_t)rn * 1024 + 4 * lane + 256 * j); }
        const float rs = row_rs(v);
#pragma unroll
        for (int j = 0; j < 4; ++j) h[j] = (v[j] * rs) * g[j] * (sc[j] + 1.0f) + sh[j];
        store_h(h, H + (size_t)r * 1024, lane);
        float lg[16];
#pragma unroll
        for (int e = 0; e < 16; ++e) lg[e] = 0.f;
#pragma unroll
        for (int j = 0; j < 4; ++j)
#pragma unroll
            for (int i = 0; i < 4; ++i) { const int k = 4 * lane + 256 * j + i; const float hv = h[j][i]; const LAS f32x4* wp = (const LAS f32x4*)(wrl + wr_off(k));
#pragma unroll
                for (int q = 0; q < 4; ++q) { const f32x4 w = wp[q]; lg[4 * q] += hv * w.x; lg[4 * q + 1] += hv * w.y; lg[4 * q + 2] += hv * w.z; lg[4 * q + 3] += hv * w.w; } }
        float mx = -1e30f;
#pragma unroll
        for (int e = 0; e < 16; ++e) { lg[e] = wave_sum(lg[e]); mx = fmaxf(mx, lg[e]); }
        float sum = 0.f;
#pragma unroll
        for (int e = 0; e < 16; ++e) { lg[e] = ex2((lg[e] - mx) * LOG2E); sum += lg[e]; }
        const float isum = 1.0f / sum; float mine = 0.f;
#pragma unroll
        for (int e = 0; e < 16; ++e) mine = (lane == e) ? lg[e] * isum : mine;
        if (lane < 16) { if (r < ML) AFF[((size_t)(bi * 16 + lane) << 12) + (r & 4095)] = mine; else AFFC[((r - ML) >> 8) * 4096 + lane * 256 + ((r - ML) & 255)] = mine;
            INV[(size_t)r * 16 + lane] = -1; }
    }
    }
}

__device__ __forceinline__ int block_sum_i(int v, LAS int* red, int buf, int lane, int wave) {
    v = wave_sum_i(v);
    if (lane == 0) red[buf * 8 + wave] = v;
    __syncthreads();
    int s = 0;
#pragma unroll
    for (int w = 0; w < 8; ++w) s += red[buf * 8 + w];
    return s;
}
__device__ __forceinline__ int block_excl_scan(int v, LAS int* red, int buf, int lane, int wave) {
    int inc = v;
#pragma unroll
    for (int o = 1; o < 64; o <<= 1) { const int t = __builtin_amdgcn_ds_bpermute((lane - o) << 2, inc); if (lane >= o) inc += t; }
    if (lane == 63) red[buf * 8 + wave] = inc;
    __syncthreads();
    int base = 0;
#pragma unroll
    for (int w = 0; w < 8; ++w) { const int x = red[buf * 8 + w]; if (w < wave) base += x; }
    return base + inc - v;
}
template <int KPT>
__device__ __forceinline__ void topk_item(KPC p, const float* aff, int n, int cap, int rowbase, int e, int slotbase, int s_lo, int s_hi, bool writer, LAS unsigned char* lds, int tid, int lane, int wave) {
    const bf16* H = (const bf16*)(p->ws + WS_H); bf16* XS = (bf16*)(p->ws + WS_XS); float* topw = (float*)(p->ws + WS_TOPW); int* INV = (int*)(p->ws + WS_INV);
    LAS int* red = (LAS int*)lds; LAS int* rl = (LAS int*)(lds + 128);
    unsigned key[KPT]; const bool valid = tid * KPT < n;
#pragma unroll
    for (int j = 0; j < KPT; ++j) key[j] = valid ? __float_as_uint(aff[tid * KPT + j]) : 0u;
    unsigned Tsel = 0u;
    for (int bit = 30; bit >= 0; --bit) { const unsigned cand = Tsel | (1u << bit); int cnt = 0;
#pragma unroll
        for (int j = 0; j < KPT; ++j) cnt += (valid && key[j] >= cand) ? 1 : 0;
        if (block_sum_i(cnt, red, bit & 1, lane, wave) >= cap) Tsel = cand; }
    int cgt = 0, ceq = 0;
#pragma unroll
    for (int j = 0; j < KPT; ++j) { cgt += (valid && key[j] > Tsel) ? 1 : 0; ceq += (valid && key[j] == Tsel) ? 1 : 0; }
    const int need = cap - block_sum_i(cgt, red, 1, lane, wave);
    int er = block_excl_scan(ceq, red, 2, lane, wave);
    bool sel[KPT]; int nsel = 0;
#pragma unroll
    for (int j = 0; j < KPT; ++j) { const bool iseq = valid && key[j] == Tsel; sel[j] = valid && (key[j] > Tsel || (iseq && er < need)); er += iseq ? 1 : 0; nsel += sel[j] ? 1 : 0; }
    int slot = block_excl_scan(nsel, red, 3, lane, wave);
#pragma unroll
    for (int j = 0; j < KPT; ++j) if (sel[j]) { const int t = tid * KPT + j; if (slot < cap) { rl[slot] = t; if (writer) { topw[e * ME + slotbase + slot] = __uint_as_float(key[j]); INV[(size_t)(rowbase + t) * 16 + e] = slotbase + slot; } } ++slot; }
    __syncthreads();
    for (int s = s_lo + wave * 4; s < s_hi; s += 32) {
        u32x4 a[4][2];
#pragma unroll
        for (int q = 0; q < 4; ++q) { const int t = rl[s + q]; const u32x4* src = (const u32x4*)(H + (size_t)(rowbase + t) * 1024); a[q][0] = src[lane]; a[q][1] = src[lane + 64]; }
#pragma unroll
        for (int q = 0; q < 4; ++q) { u32x4* dst = (u32x4*)(XS + ((size_t)e * ME + slotbase + s + q) * 1024); dst[lane] = a[q][0]; dst[lane + 64] = a[q][1]; }
    }
    __syncthreads();
}
__device__ __forceinline__ void phase_topk(KPC p, int l, LAS unsigned char* lds, int tid, int lane, int wave, int bid, int G) {
    const float* AFF = (const float*)(p->ws + WS_AFF); const float* AFFC = (const float*)(p->ws + WS_AFFC);
    const int nitem = (l == 0) ? 384 : 256;
    for (int it = bid; it < nitem; it += G) {
        if (it < 256) { const int q = it >> 1, hf = it & 1, b = q >> 4, e = q & 15; topk_item<8>(p, AFF + ((size_t)(b * 16 + e) << 12), 4096, CAPL, b * T, e, b * CAPL, hf * 256, hf * 256 + 256, hf == 0, lds, tid, lane, wave); }
        else { const int q = it - 256, b = q >> 4, e = q & 15; topk_item<1>(p, AFFC + (b * 16 + e) * 256, 256, CAPC, ML + b * CL, e, NB * CAPL + b * CAPC, 0, CAPC, true, lds, tid, lane, wave); }
    }
}

__device__ __forceinline__ void phase_combine(KPC p, int l, LAS unsigned char* lds, int tid, int lane, int wave, int bid, int G) {
    const float* modv = (const float*)(p->ws + WS_MODV); float* X = (float*)(p->ws + WS_X); bf16* H = (bf16*)(p->ws + WS_H);
    const bf16* Y = (const bf16*)(p->ws + WS_XS); const int* INV = (const int*)(p->ws + WS_INV);
    const int rows = (l == 0) ? M : ML, stride = G * 8;
    int r = bid * 8 + wave;
    int slot_next = (lane < 16 && r < rows) ? INV[(size_t)r * 16 + lane] : -1;
    f32x4 vn[4];
#pragma unroll
    for (int j = 0; j < 4; ++j) vn[j] = (r < rows) ? *(const f32x4*)(X + (size_t)r * 1024 + 4 * lane + 256 * j) : (f32x4){0.f, 0.f, 0.f, 0.f};
    for (; r < rows; r += stride) {
        const int bi = (r < ML) ? (r >> 12) : 8;
        const int myslot = slot_next; const int rn = r + stride;
        slot_next = (lane < 16 && rn < rows) ? INV[(size_t)rn * 16 + lane] : -1;
        f32x4 v[4], acc[4], g2v[4];
        const float* g2 = modv + (l * 9 + bi) * 6144 + 5 * 1024;
#pragma unroll
        for (int j = 0; j < 4; ++j) { v[j] = vn[j]; acc[j] = (f32x4){0.f, 0.f, 0.f, 0.f}; g2v[j] = *(const f32x4*)(g2 + 4 * lane + 256 * j); }
        unsigned mask = (unsigned)(__builtin_amdgcn_ballot_w64(myslot >= 0) & 0xffffull);
        bool first = true;
        while (mask || first) {
          if (mask) {
            const int e0 = __builtin_ctz(mask); mask &= mask - 1u; const int s0 = __builtin_amdgcn_readlane(myslot, e0);
            const bool has1 = mask != 0u; const int e1 = has1 ? __builtin_ctz(mask) : e0; if (has1) mask &= mask - 1u; const int s1 = __builtin_amdgcn_readlane(myslot, e1);
            const bf16* ya = Y + ((size_t)e0 * ME + s0) * 1024; const bf16* yb = Y + ((size_t)e1 * ME + s1) * 1024;
            u32x2 wa[4], wb[4];
#pragma unroll
            for (int j = 0; j < 4; ++j) wa[j] = *(const u32x2*)(ya + 4 * lane + 256 * j);
#pragma unroll
            for (int j = 0; j < 4; ++j) wb[j] = *(const u32x2*)(yb + 4 * lane + 256 * j);
            if (first && rn < rows) {
#pragma unroll
                for (int j = 0; j < 4; ++j) vn[j] = *(const f32x4*)(X + (size_t)rn * 1024 + 4 * lane + 256 * j); }
            first = false;
            const float kb = has1 ? 1.0f : 0.0f;
#pragma unroll
            for (int j = 0; j < 4; ++j) { acc[j] += (f32x4){bflo(wa[j].x), bfhi(wa[j].x), bflo(wa[j].y), bfhi(wa[j].y)}; acc[j] += (f32x4){bflo(wb[j].x), bfhi(wb[j].x), bflo(wb[j].y), bfhi(wb[j].y)} * kb; }
          } else {
            if (rn < rows) {
#pragma unroll
                for (int j = 0; j < 4; ++j) vn[j] = *(const f32x4*)(X + (size_t)rn * 1024 + 4 * lane + 256 * j); }
            first = false;
          }
        }
#pragma unroll
        for (int j = 0; j < 4; ++j) v[j] = v[j] + g2v[j] * acc[j];
        if (l == 0) {
#pragma unroll
            for (int j = 0; j < 4; ++j) *(f32x4*)(X + (size_t)r * 1024 + 4 * lane + 256 * j) = v[j];
            const float rs = row_rs(v); f32x4 h[4];
            norm_mod(v, rs, p->norm1_g + 1024, modv + (9 + bi) * 6144, modv + (9 + bi) * 6144 + 1024, h, lane);
            store_h(h, H + (size_t)r * 1024, lane);
        } else {
#pragma unroll
            for (int j = 0; j < 4; ++j) *(f32x4*)(p->out + (size_t)r * 1024 + 4 * lane + 256 * j) = v[j];
        }
    }
    if (l == 0) convert_small(p, 1, lds, lane, wave, bid, G);
}

#define XB_TMO      128
#define XB_XCNT(j)  (256  + 64 * (j))
#define XB_XSUB(j)  (1280 + 64 * (j))
#define XB_XGEN(j)  (2304 + 64 * (j))
#define XB_TOP      3328
#define XB_TOPGEN   3392
#define XCD_BAR_WORDS 3456
#define XB_SPIN_CAP (1u << 18)

__device__ __forceinline__ unsigned xb_ld(unsigned* p)              { return __hip_atomic_load(p, __ATOMIC_RELAXED, __HIP_MEMORY_SCOPE_AGENT); }
__device__ __forceinline__ unsigned xb_add(unsigned* p, unsigned v) { return __hip_atomic_fetch_add(p, v, __ATOMIC_RELAXED, __HIP_MEMORY_SCOPE_AGENT); }
__device__ __forceinline__ unsigned xb_xcc_id() { return (unsigned)__builtin_amdgcn_s_getreg((3 << 11) | 20) & 0xFu; }
#define XB_SPIN(cond, bar) do { unsigned _sp = 0; while (cond) { __builtin_amdgcn_s_sleep(1); \
    if ((++_sp & 255u) == 0u) { if (xb_ld(&(bar)[XB_TMO])) break; if (_sp > XB_SPIN_CAP) { atomicAdd(&(bar)[XB_TMO], 1u); break; } } } } while (0)

struct XcdBarrier {
    unsigned* bar; unsigned x;
    volatile LAS unsigned* st;
};

__device__ __forceinline__ XcdBarrier xcd_barrier_post(unsigned* bar, volatile LAS unsigned* st) {
    XcdBarrier b; b.bar = bar; b.x = xb_xcc_id(); b.st = st;
    if (threadIdx.x == 0) (void)xb_add(&bar[XB_XCNT(b.x)], 1u);
    return b;
}
__device__ __forceinline__ void xcd_barrier_complete(unsigned* bar, unsigned x, unsigned& nloc, unsigned& nx) {
    const unsigned G = gridDim.x * gridDim.y * gridDim.z;
    unsigned sum, cnt, mine, sp = 0u;
    for (;;) {
        sum = 0u; cnt = 0u; mine = 0u;
#pragma unroll
        for (unsigned j = 0; j < 16; ++j) { const unsigned c = xb_ld(&bar[XB_XCNT(j)]); sum += c; cnt += (c > 0u) ? 1u : 0u; mine = (j == x) ? c : mine; }
        if (sum == G) break;
        __builtin_amdgcn_s_sleep(1);
        if ((++sp & 255u) == 0u) { if (xb_ld(&bar[XB_TMO])) break; if (sp > XB_SPIN_CAP) { atomicAdd(&bar[XB_TMO], 1u); break; } }
    }
    nloc = mine > 0u ? mine : 1u; nx = cnt > 0u ? cnt : 1u;
}

__device__ __forceinline__ void xcd_barrier(const XcdBarrier& b) {
    asm volatile("s_waitcnt vmcnt(0)" ::: "memory");
    __syncthreads();
    if (threadIdx.x == 0) {
        unsigned* bar = b.bar;
        __builtin_amdgcn_s_waitcnt(0);
        unsigned nloc = b.st[0], nx = b.st[1];
        if (nloc == 0u) { xcd_barrier_complete(bar, b.x, nloc, nx); b.st[0] = nloc; b.st[1] = nx; }
        const unsigned old = xb_add(&bar[XB_XSUB(b.x)], 1u);
        const unsigned gen = old / nloc;
        if (old + 1u == (gen + 1u) * nloc) {
            __builtin_amdgcn_fence(__ATOMIC_RELEASE, "agent");
            asm volatile("s_waitcnt vmcnt(0)" ::: "memory");
            const unsigned og = xb_add(&bar[XB_TOP], 1u);
            const unsigned tg = og / nx;
            if (og + 1u == (tg + 1u) * nx) xb_add(&bar[XB_TOPGEN], 1u);
            else XB_SPIN(xb_ld(&bar[XB_TOPGEN]) == tg, bar);
            __builtin_amdgcn_fence(__ATOMIC_ACQUIRE, "agent");
            xb_add(&bar[XB_XGEN(b.x)], 1u);
            asm volatile("s_waitcnt vmcnt(0)" ::: "memory");
        } else {
            XB_SPIN(xb_ld(&bar[XB_XGEN(b.x)]) == gen, bar);
            __builtin_amdgcn_fence(__ATOMIC_ACQUIRE, "agent");
            asm volatile("s_waitcnt vmcnt(0)" ::: "memory");
        }
    }
    __syncthreads();
}

#ifndef REP_GZA
#define REP_GZA 1
#endif
#ifndef REP_GG
#define REP_GG 1
#endif
#ifndef REP_GMRG
#define REP_GMRG 1
#endif
#ifndef REP_GM1
#define REP_GM1 1
#endif
#ifndef REP_GM2
#define REP_GM2 1
#endif
#ifndef REP_ATT
#define REP_ATT 1
#endif
#ifndef REP_UPD
#define REP_UPD 1
#endif
#ifndef REP_SGU
#define REP_SGU 1
#endif
#ifndef REP_PRE
#define REP_PRE 1
#endif
#ifndef REP_CMB
#define REP_CMB 1
#endif
#ifndef REP_MIX
#define REP_MIX 1
#endif
#ifndef REP_RO
#define REP_RO 1
#endif
#ifndef REP_N2
#define REP_N2 1
#endif
#ifndef REP_GEMM
#define REP_GEMM 1
#endif
#ifndef REP_SYNC
#define REP_SYNC 1
#endif
#ifndef EN_GEMM
#define EN_GEMM 0x3f
#endif
#ifndef EN_ATT
#define EN_ATT 1
#endif
#ifndef EN_UPD
#define EN_UPD 1
#endif
#ifndef EN_SGU
#define EN_SGU 1
#endif
#ifndef EN_RO
#define EN_RO 1
#endif
#ifndef EN_MISC
#define EN_MISC 1
#endif
#define KPP() ({ KPC q_ = kp_; asm volatile("" : "+s"(q_)); q_; })
__global__ void __launch_bounds__(512, 2) mk_fwd(KP p_unused) {
    extern __shared__ __attribute__((aligned(16))) unsigned char lds_raw[];
    LAS unsigned char* lds = (LAS unsigned char*)lds_raw;
    cg::grid_group grid = cg::this_grid();
    const int bid = blockIdx.x, G = gridDim.x;
#define IDS() int tid = threadIdx.x; asm volatile("" : "+v"(tid)); const int lane = tid & 63, wave = __builtin_amdgcn_readfirstlane(tid >> 6); (void)lane; (void)wave
    const KPC kp_ = (KPC)__builtin_amdgcn_kernarg_segment_ptr();
    volatile LAS unsigned* bst = (volatile LAS unsigned*)(lds + 147392);
    if (threadIdx.x < 16) bst[threadIdx.x] = 0u;
    __syncthreads();
    (void)xcd_barrier_post((unsigned*)KPP()->ws, bst);
#define GSYNC() do { XcdBarrier b_; b_.bar = (unsigned*)KPP()->ws; b_.x = xb_xcc_id(); b_.st = bst; xcd_barrier(b_); } while (0)

    { IDS(); for (int rep = 0; rep < REP_PRE; ++rep) { phase_prep(KPP(), lds, tid, lane, wave, bid, G); __syncthreads(); } }
    grid.sync();
    { IDS(); for (int rep = 0; rep < REP_PRE; ++rep) phase_norm_in(KPP(), lane, wave, bid, G); }
    GSYNC();
#pragma unroll 1
    for (int l = 0; l < 2; ++l) {
        {
            unsigned char* ws = KPP()->ws;
            pg8::Gemm g{(const pg8::bf16_t*)(ws + WS_H), (const pg8::bf16_t*)(ws + WS_WTIN), M, NZA, 1024}; GroupOrder S{1, M / 256, NZA / 256, 0, 0, G, bid};
            EpiZA E{(bf16*)(ws + WS_ZA)};
            for (int rep = 0; rep < REP_GEMM * REP_GZA; ++rep) pg8::gemm_phase<EpiZA, GroupOrder, true, true>(lds, g, S, E);
#ifdef PROBE_ZA_SLEEP
            { const unsigned long long t0 = __builtin_amdgcn_s_memrealtime(); while (__builtin_amdgcn_s_memrealtime() - t0 < 100000ull) __builtin_amdgcn_s_sleep(64); __syncthreads(); for (int rep = 0; rep < PROBE_ZA_SLEEP; ++rep) pg8::gemm_phase<EpiZA, GroupOrder, true, true>(lds, g, S, E); }
#endif
#ifdef PROBE_ZA_NULL
            { EpiNull En; pg8::gemm_phase<EpiNull, GroupOrder, true, true>(lds, g, S, En); }
#endif
        }
        GSYNC();
        {
            KPC p = KPP(); IDS();
            float mq = fabsf(p->qn_g[l * 64 + lane]), mk = fabsf(p->kn_g[l * 64 + lane]);
            mq = wave_max(mq); mk = wave_max(mk);
            const float Mb2 = 8.0f * mq * mk * LOG2E;
            const int natt = (l == 0) ? 544 : 512, nupd = NB * NCH * 4, nvp = (l == 0) ? (M / 128) : (ML / 128);
            for (int rep = 0; rep < REP_MIX; ++rep)
            for (int it = bid; it < natt + nupd + nvp; it += G) {
                if (it < natt) { for (int q = 0; q < REP_ATT; ++q) att_item(p, l, lds, it, Mb2, tid, lane, wave); }
                else if (it < natt + nupd) { for (int q = 0; q < REP_UPD; ++q) ret_upd_item(p, l, lds, it - natt, tid, lane, wave); }
                else { for (int q = 0; q < REP_SGU; ++q) sgu_vprep_item(p, it - natt - nupd, tid); }
            }
        }
        GSYNC();
        { IDS(); for (int rep = 0; rep < REP_RO; ++rep) phase_scan(KPP(), l, tid, bid, G); }
        GSYNC();
        {   KPC p = KPP(); IDS(); const int nch = (l == 0) ? NCH : 32;
            const int nro = NB * nch * 4, nsgu = ((l == 0) ? (M / 128) : (ML / 128)) * 4;
            for (int rep = 0; rep < REP_RO; ++rep)
            for (int it = bid; it < nro + nsgu; it += G) {
                if (it < nro) { const int b = it / (nch * 4), rem = it % (nch * 4); ret_out_item(p, l, lds, b * (NCH * 4) + rem, tid, lane, wave); }
                else sgu_item(p, l, lds, it - nro, tid, lane, wave);
            }
        }
        GSYNC();
        const int Mrows = (l == 0) ? M : ML;
        {
            unsigned char* ws = KPP()->ws;
            pg8::Gemm g{(const pg8::bf16_t*)(ws + WS_H), (const pg8::bf16_t*)(ws + WS_WTIN) + (size_t)NZA * 1024, Mrows, NZG, 1024}; GroupOrder S{1, Mrows / 256, NZG / 256, 0, 0, G, bid};
            EpiSig E{(bf16*)(ws + WS_G)};
            for (int rep = 0; rep < REP_GEMM * REP_GG; ++rep) pg8::gemm_phase<EpiSig, GroupOrder, true, true>(lds, g, S, E);
            if (l == 0 && G == 256 && bid >= CVT_G_IDLE0) { IDS(); convert_experts(KPP(), 0, 0, CVT_G_HI, (bid - CVT_G_IDLE0) * 8 + wave, (256 - CVT_G_IDLE0) * 8, lds, lane, wave); }
        }
        GSYNC();
        {
            KPC p = KPP(); unsigned char* ws = p->ws;
            pg8::Gemm g{(const pg8::bf16_t*)p->out, (const pg8::bf16_t*)(ws + WS_WTBR), 3 * M, 3072, 512}; MergeOrder S{Mrows / 256, G, bid};
            EpiMergeChain E{(const bf16*)(ws + WS_G), (bf16*)(ws + WS_H)};
            for (int rep = 0; rep < REP_GEMM * REP_GMRG; ++rep) pg8::gemm_phase<EpiMergeChain, MergeOrder, true, true>(lds, g, S, E);
            if (l == 0 && G == 256 && bid >= CVT_M_IDLE0) { IDS(); convert_experts(KPP(), 0, CVT_G_HI, CVT_M_HI, (bid - CVT_M_IDLE0) * 8 + wave, (256 - CVT_M_IDLE0) * 8, lds, lane, wave); }
        }
        GSYNC();
        {
            KPC p = KPP(); unsigned char* ws = p->ws;
            pg8::Gemm g{(const pg8::bf16_t*)(ws + WS_H), (const pg8::bf16_t*)(ws + WS_WTOUT), Mrows, 1024, 1024}; GroupOrder S{1, Mrows / 256, 4, 0, 0, G, bid};
            EpiOut E{(l == 0) ? p->x : (const float*)(ws + WS_X), (l == 0) ? p->ctx : (const float*)(ws + WS_X) + (size_t)ML * 1024, (float*)(ws + WS_X), (const float*)(ws + WS_MODV) + l * 9 * 6144};
            pg8::gemm_phase<EpiOut, GroupOrder, true, true>(lds, g, S, E);
            if (l == 0 && G == 256 && bid >= CVT_O_IDLE0) { IDS(); convert_experts(KPP(), 0, CVT_M_HI, CVT_ITEMS, (bid - CVT_O_IDLE0) * 8 + wave, (256 - CVT_O_IDLE0) * 8, lds, lane, wave); }
        }
        GSYNC();
        { IDS(); for (int rep = 0; rep < REP_N2; ++rep) { phase_norm2(KPP(), l, lds, tid, lane, wave, bid, G); __syncthreads(); } }
        GSYNC();
        { IDS(); for (int rep = 0; rep < REP_N2 * REP_TK; ++rep) phase_topk(KPP(), l, lds, tid, lane, wave, bid, G); }
        GSYNC();
        {
            unsigned char* ws = KPP()->ws;
            pg8::Gemm g{(const pg8::bf16_t*)(ws + WS_XS), (const pg8::bf16_t*)(ws + WS_WT1), NE * ME, NE * 2048, 1024}; GroupOrder S{NE, (l == 0) ? 17 : 16, 8, 17, 8, G, bid};
            EpiMoe1 E{(bf16*)(ws + WS_ACT)};
            for (int rep = 0; rep < REP_GEMM * REP_GM1; ++rep) pg8::gemm_phase<EpiMoe1, GroupOrder, true, true>(lds, g, S, E);
        }
        GSYNC();
        {
            unsigned char* ws = KPP()->ws;
            pg8::Gemm g{(const pg8::bf16_t*)(ws + WS_ACT), (const pg8::bf16_t*)(ws + WS_WT2), NE * ME, NE * 1024, 1024}; GroupOrder S{NE, (l == 0) ? 17 : 16, 4, 17, 4, G, bid};
            EpiMoe2 E{(bf16*)(ws + WS_XS), (const float*)(ws + WS_TOPW)};
            for (int rep = 0; rep < REP_GEMM * REP_GM2; ++rep) pg8::gemm_phase<EpiMoe2, GroupOrder, true, true>(lds, g, S, E);
        }
        GSYNC();
        { IDS(); for (int rep = 0; rep < ((l == 1) ? REP_CMB : 1); ++rep) phase_combine(KPP(), l, lds, tid, lane, wave, bid, G); }
        if (l == 0) GSYNC();
        for (int rep = 1; rep < REP_SYNC; ++rep) { for (int k = 0; k < 12; ++k) GSYNC(); }
    }
}

extern "C" void kernel_launch(void* const* d_in, const int* in_sizes, int n_in, void* d_out, int out_size, void* d_ws, size_t ws_size, hipStream_t stream) {
    static int grid = 0;
    if (grid == 0) {
        if (n_in != 22 || out_size != ML * D || ws_size < WS_END) { fprintf(stderr, "kernel_launch: unexpected shapes (n_in %d out %d ws %zu, need %zu)\n", n_in, out_size, ws_size, (size_t)WS_END); grid = -1; return; }
        int dev = 0, cus = 0, per_cu = 0;
        if (hipGetDevice(&dev) != hipSuccess || hipDeviceGetAttribute(&cus, hipDeviceAttributeMultiprocessorCount, dev) != hipSuccess) { grid = -1; return; }
        if (hipFuncSetAttribute((const void*)mk_fwd, hipFuncAttributeMaxDynamicSharedMemorySize, LDS_BYTES) != hipSuccess) { fprintf(stderr, "kernel_launch: hipFuncSetAttribute failed\n"); grid = -1; return; }
        if (hipOccupancyMaxActiveBlocksPerMultiprocessor(&per_cu, (const void*)mk_fwd, 512, LDS_BYTES) != hipSuccess || per_cu < 1) { fprintf(stderr, "kernel_launch: occupancy query says %d\n", per_cu); (void)hipGetLastError(); }
        grid = cus;
        fprintf(stderr, "kernel_launch: grid %d, occupancy %d/CU, ws %zu\n", grid, per_cu, ws_size);
    }
    if (grid < 0) return;
    if (hipMemsetAsync(d_ws, 0, 16384, stream) != hipSuccess) { fprintf(stderr, "kernel_launch: memset failed\n"); return; }
    KP hp{};
    const float** f = (const float**)&hp;
    for (int i = 0; i < 22; ++i) f[i] = (const float*)d_in[i];
    hp.out = (float*)d_out; hp.ws = (unsigned char*)d_ws;
    void* args[] = {&hp};
    hipError_t e = hipLaunchCooperativeKernel((const void*)mk_fwd, dim3(grid), dim3(512), args, LDS_BYTES, stream);
    if (e != hipSuccess) fprintf(stderr, "kernel_launch: cooperative launch failed: %s\n", hipGetErrorString(e));
}
```

```cpp
#include <hip/hip_runtime.h>
#include <hip/hip_cooperative_groups.h>
#include <cstdio>
#include <cstdint>
namespace cg = cooperative_groups;

namespace pg8 {
#define PG8_LAS __attribute__((address_space(3)))
typedef unsigned short bf16_t;
typedef short bf16x8 __attribute__((ext_vector_type(8)));
typedef float f32x4 __attribute__((ext_vector_type(4)));
typedef unsigned u32x4 __attribute__((ext_vector_type(4)));
constexpr int BM = 256, BK = 64, HALF = 128, HTB = HALF * BK * 2  , STAGE_BYTES = 8 * HTB, NXCD = 8, WGM = 8;

__host__ __device__ __forceinline__ int lds_byte(int r, int c) { const int st = (r >> 4) * 2 + (c >> 5), rr = r & 15, cc = c & 31, ob = rr * 64 + cc * 2; return st * 1024 + (ob ^ (((ob >> 9) & 1) << 5)); }
__host__ __device__ __forceinline__ void stage_rc(int b, int& R, int& C) { const int st = b / 1024, sb = b % 1024, swz = sb ^ (((sb >> 9) & 1) << 5); R = (st >> 1) * 16 + swz / 64; C = (st & 1) * 32 + (swz % 64) / 2; }
__host__ __device__ __forceinline__ int perm32(int rho) { const int n = rho >> 4, i = rho & 15; return 8 * (i >> 2) + 4 * n + (i & 3); }

struct Unit { int pm, pn; };
struct Gemm { const bf16_t* A; const bf16_t* Bt; int M, N, K; };

struct StaticOrder {
    int nM, nN, nwg, G, c;
    __host__ __device__ void init(int M, int N, int G_, int c_) { nM = M / BM; nN = N / BM; nwg = nM * nN; G = G_; c = c_; }
    __host__ __device__ bool next(int i, Unit& u) const {
        const long L = (long)i * G + c; if (L >= nwg) return false;
        int wgid = (int)L; { const int q = nwg / NXCD, r = nwg % NXCD, xcd = wgid % NXCD, off = wgid / NXCD; wgid = (xcd < r ? xcd * (q + 1) : r * (q + 1) + (xcd - r) * q) + off; }
        const int nig = WGM * nN, gid = wgid / nig, fm = gid * WGM, gsz = (nM - fm) < WGM ? (nM - fm) : WGM;
        u.pm = fm + ((wgid % nig) % gsz); u.pn = (wgid % nig) / gsz; return true;
    }
    __device__ __forceinline__ void a_ready(const Unit&) const {}
    __device__ __forceinline__ void done(const Unit&) const {}
};

__device__ __forceinline__ unsigned cvt_pk_bf16(float lo, float hi) { unsigned r; asm volatile("v_cvt_pk_bf16_f32 %0, %1, %2" : "=v"(r) : "v"(lo), "v"(hi)); return r; }
typedef float f32x2 __attribute__((ext_vector_type(2)));
__device__ __forceinline__ f32x2 gelu_pk(f32x2 v) {
    const f32x2 av = __builtin_elementwise_abs(v), d = av * 0.2316418882f + 1.0f;
    f32x2 t; t.x = __builtin_amdgcn_rcpf(d.x); t.y = __builtin_amdgcn_rcpf(d.y);
    f32x2 q = t * 0.5307027145f + (-0.7265760135f); q = q * t + 0.7107068705f; q = q * t + (-0.142248368f); q = q * t + 0.127414796f; q = q * t;
    const f32x2 s = (v * v) * (-0.72134752044f);
    f32x2 e; e.x = __builtin_amdgcn_exp2f(s.x); e.y = __builtin_amdgcn_exp2f(s.y);
    const f32x2 m = v * (q * e), r = v - m;
    f32x2 o; o.x = v.x < 0.f ? m.x : r.x; o.y = v.y < 0.f ? m.y : r.y; return o;
}

template <int ACT  > struct EpiBf16 {
    static constexpr bool PERM = true, AFTER_DRAIN = false, CHAIN = false; static_assert(ACT == 0 || ACT == 1, "EpiBf16: ACT is 0 (none) or 1 (gelu_pk)");
    bf16_t* O; int ldc; const float* bias; int split_cols; size_t split_stride; float scale0;
    __device__ __forceinline__ void operator()(const f32x4 (&acc)[2][2][4][2], const Unit& u, int wr, int wc, int fr, int fq) const {
        const int row0 = u.pm * BM + wr * 64 + fr; int colt = u.pn * BM; bf16_t* base = O;
        float sc = 1.f; if (split_cols) { const int t = colt / split_cols; base += (size_t)t * split_stride; colt -= t * split_cols; if (t == 0) sc = scale0; }
        const int col0 = colt + wc * 32 + 8 * fq, bcol0 = u.pn * BM + wc * 32 + 8 * fq;
        f32x4 bv[2][2];
#pragma unroll
        for (int bj = 0; bj < 2; ++bj)
#pragma unroll
            for (int n = 0; n < 2; ++n) bv[bj][n] = bias ? *(const f32x4*)(bias + bcol0 + bj * HALF + 4 * n) : (f32x4){0.f, 0.f, 0.f, 0.f};
#pragma unroll
        for (int ai = 0; ai < 2; ++ai)
#pragma unroll
            for (int m = 0; m < 4; ++m) { bf16_t* rowp = base + (size_t)(row0 + ai * HALF + m * 16) * ldc + col0;
#pragma unroll
                for (int bj = 0; bj < 2; ++bj) { f32x4 v0 = acc[ai][bj][m][0] + bv[bj][0], v1 = acc[ai][bj][m][1] + bv[bj][1];
                    if (ACT == 1) { f32x2 a = gelu_pk((f32x2){v0[0], v0[1]}), b = gelu_pk((f32x2){v0[2], v0[3]}), c = gelu_pk((f32x2){v1[0], v1[1]}), d = gelu_pk((f32x2){v1[2], v1[3]});
                        v0 = (f32x4){a.x, a.y, b.x, b.y}; v1 = (f32x4){c.x, c.y, d.x, d.y}; }
                    v0 = v0 * sc; v1 = v1 * sc; u32x4 w; w.x = cvt_pk_bf16(v0[0], v0[1]); w.y = cvt_pk_bf16(v0[2], v0[3]); w.z = cvt_pk_bf16(v1[0], v1[1]); w.w = cvt_pk_bf16(v1[2], v1[3]);
                    *(u32x4*)(rowp + bj * HALF) = w; } }
    }
};
template <class Epi, class Sched, bool ALIGN_EPI = false, bool SP2 = false>
__device__ __forceinline__ void gemm_phase(PG8_LAS unsigned char* lds, const Gemm g, const Sched& S, const Epi& E) {
    int tid_ = threadIdx.x; asm volatile("" : "+v"(tid_));
    const int tid = tid_, wid = __builtin_amdgcn_readfirstlane(tid >> 6), lane = tid & 63, wr = wid >> 2, wc = wid & 3, fr = lane & 15, fq = lane >> 4;
    const int K = g.K, nt = K / BK;
    unsigned voffA[2], voffB[2];
#pragma unroll
    for (int i = 0; i < 2; ++i) { int R, C; stage_rc(tid * 16 + i * 8192, R, C); const int Rb = Epi::PERM ? ((R & ~31) + perm32(R & 31)) : R;
        voffA[i] = (unsigned)(R * K + C) * 2u; voffB[i] = (unsigned)(Rb * K + C) * 2u; }
    const size_t kstep = (size_t)(BK * 2);
    const size_t hstep = (size_t)HALF * K * 2;
    const size_t tstep = 2 * hstep;
    const unsigned ldsw = (unsigned)wid * 1024u;
    const int aoff = lds_byte(wr * 64 + fr, fq * 8), boff = lds_byte(wc * 32 + fr, fq * 8);
#define PG8_SA(b, h) (((b) * 2 + (h)) * HTB)
#define PG8_SB(b, h) ((4 + (b) * 2 + (h)) * HTB)
#define PG8_STAGE(bufoff, gbase, voff) do { _Pragma("unroll") for (int _i = 0; _i < 2; ++_i) \
        __builtin_amdgcn_global_load_lds((const unsigned*)((const char*)(gbase) + (voff)[_i]), (PG8_LAS unsigned*)(lds + (bufoff) + ldsw + _i * 8192), 16, 0, 0); } while (0)
#define PG8_LDA(dst, b, h) do { _Pragma("unroll") for (int m = 0; m < 4; ++m) _Pragma("unroll") for (int k = 0; k < 2; ++k) dst[m][k] = *(const PG8_LAS bf16x8*)(lds + PG8_SA(b, h) + aoff + m * 2048 + k * 1024); } while (0)
#define PG8_LDB(dst, b, h) do { _Pragma("unroll") for (int n = 0; n < 2; ++n) _Pragma("unroll") for (int k = 0; k < 2; ++k) dst[n][k] = *(const PG8_LAS bf16x8*)(lds + PG8_SB(b, h) + boff + n * 2048 + k * 1024); } while (0)
#define PG8_MMA(ai, bj, At, Bt) do { __builtin_amdgcn_s_setprio(1); _Pragma("unroll") for (int m = 0; m < 4; ++m) _Pragma("unroll") for (int n = 0; n < 2; ++n) _Pragma("unroll") for (int k = 0; k < 2; ++k) \
        acc[ai][bj][m][n] = __builtin_amdgcn_mfma_f32_16x16x32_bf16(Bt[n][k], At[m][k], acc[ai][bj][m][n], 0, 0, 0); __builtin_amdgcn_s_setprio(0); } while (0)
#define PG8_WAIT_V(n) asm volatile("s_waitcnt vmcnt(" #n ")" ::: "memory")
#define PG8_WAIT_L(n) asm volatile("s_waitcnt lgkmcnt(" #n ")" ::: "memory")
#define PG8_BAR __builtin_amdgcn_s_barrier()
#define PG8_SCHED __builtin_amdgcn_sched_barrier(0)
    Unit cur, nxt; int ui = 0;
    if (!S.next(0, cur)) return;
    f32x4 acc[2][2][4][2];
#pragma unroll
    for (int a = 0; a < 2; ++a)
#pragma unroll
        for (int b = 0; b < 2; ++b)
#pragma unroll
            for (int m = 0; m < 4; ++m)
#pragma unroll
                for (int n = 0; n < 2; ++n) acc[a][b][m][n] = (f32x4){0.f, 0.f, 0.f, 0.f};
    bf16x8 At[4][2], B0[2][2], B1[2][2];
    const char* cA = (const char*)g.A + (size_t)cur.pm * tstep; const char* cB = (const char*)g.Bt + (size_t)cur.pn * tstep;
    S.a_ready(cur);
    if constexpr (SP2) {
        PG8_STAGE(PG8_SB(0, 0), cB, voffB); PG8_STAGE(PG8_SB(0, 1), cB + hstep, voffB); PG8_STAGE(PG8_SA(0, 0), cA, voffA); PG8_STAGE(PG8_SA(0, 1), cA + hstep, voffA);
        if (wr == 1) PG8_BAR;
        PG8_WAIT_V(2); PG8_BAR;
        PG8_STAGE(PG8_SB(1, 0), cB + kstep, voffB); PG8_STAGE(PG8_SA(1, 0), cA + kstep, voffA); PG8_STAGE(PG8_SB(1, 1), cB + hstep + kstep, voffB);
        PG8_WAIT_V(6); PG8_BAR;
    } else {
        PG8_STAGE(PG8_SB(0, 0), cB, voffB); PG8_STAGE(PG8_SA(0, 0), cA, voffA); PG8_STAGE(PG8_SB(0, 1), cB + hstep, voffB); PG8_STAGE(PG8_SA(0, 1), cA + hstep, voffA);
        if (wr == 1) PG8_BAR;
        PG8_WAIT_V(4); PG8_BAR;
        PG8_STAGE(PG8_SB(1, 0), cB + kstep, voffB); PG8_STAGE(PG8_SA(1, 0), cA + kstep, voffA); PG8_STAGE(PG8_SB(1, 1), cB + hstep + kstep, voffB);
        PG8_WAIT_V(6); PG8_BAR;
    }
    for (;;) {
        const bool has_next = S.next(ui + 1, nxt);
        const char* nA = has_next ? (const char*)g.A + (size_t)nxt.pm * tstep : cA; const char* nB = has_next ? (const char*)g.Bt + (size_t)nxt.pn * tstep : cB;
        for (int t = 0; t < nt; t += 2) {
            const bool last = (t == nt - 2);
            const char* a1 = cA + (size_t)(t + 1) * kstep;
            const char* a2 = last ? nA : cA + (size_t)(t + 2) * kstep; const char* b2 = last ? nB : cB + (size_t)(t + 2) * kstep;
            const char* a3 = a2 + kstep; const char* b3 = b2 + kstep;
            if (last && has_next) S.a_ready(nxt);
            if constexpr (SP2) {
            PG8_LDB(B0, 0, 0); PG8_LDB(B1, 0, 1); PG8_SCHED; PG8_LDA(At, 0, 0); PG8_STAGE(PG8_SA(1, 1), a1 + hstep, voffA);
            PG8_WAIT_V(8); PG8_WAIT_L(0); PG8_BAR; PG8_MMA(0, 0, At, B0); PG8_MMA(0, 1, At, B1); PG8_BAR; PG8_SCHED;
            PG8_LDA(At, 0, 1); PG8_STAGE(PG8_SB(0, 0), b2, voffB); PG8_STAGE(PG8_SB(0, 1), b2 + hstep, voffB); PG8_STAGE(PG8_SA(0, 0), a2, voffA);
            PG8_WAIT_V(8); PG8_WAIT_L(0); PG8_BAR; PG8_MMA(1, 0, At, B0); PG8_MMA(1, 1, At, B1); PG8_BAR; PG8_SCHED;
            PG8_LDB(B0, 1, 0); PG8_LDB(B1, 1, 1); PG8_SCHED; PG8_LDA(At, 1, 0); PG8_STAGE(PG8_SA(0, 1), a2 + hstep, voffA);
            PG8_WAIT_V(8); PG8_WAIT_L(0); PG8_BAR; PG8_MMA(0, 0, At, B0); PG8_MMA(0, 1, At, B1); PG8_BAR; PG8_SCHED;
            PG8_LDA(At, 1, 1); PG8_STAGE(PG8_SB(1, 0), b3, voffB); PG8_STAGE(PG8_SB(1, 1), b3 + hstep, voffB); PG8_STAGE(PG8_SA(1, 0), a3, voffA);
            PG8_WAIT_V(8); PG8_WAIT_L(0); PG8_BAR; PG8_MMA(1, 0, At, B0); PG8_MMA(1, 1, At, B1); PG8_BAR; PG8_SCHED;
            } else {
            PG8_LDB(B0, 0, 0); PG8_SCHED; PG8_LDA(At, 0, 0); PG8_STAGE(PG8_SA(1, 1), a1 + hstep, voffA);
            PG8_WAIT_L(8); PG8_BAR; PG8_WAIT_L(0); PG8_MMA(0, 0, At, B0); PG8_BAR; PG8_SCHED;
            PG8_LDB(B1, 0, 1); PG8_STAGE(PG8_SB(0, 0), b2, voffB);
            PG8_BAR; PG8_WAIT_L(0); PG8_MMA(0, 1, At, B1); PG8_BAR;
            PG8_LDA(At, 0, 1); PG8_STAGE(PG8_SA(0, 0), a2, voffA);
            PG8_BAR; PG8_WAIT_L(0); PG8_MMA(1, 0, At, B0); PG8_BAR; PG8_SCHED;
            PG8_STAGE(PG8_SB(0, 1), b2 + hstep, voffB);
            PG8_WAIT_V(6); PG8_BAR; PG8_MMA(1, 1, At, B1); PG8_BAR;
            PG8_LDB(B0, 1, 0); PG8_SCHED; PG8_LDA(At, 1, 0); PG8_STAGE(PG8_SA(0, 1), a2 + hstep, voffA);
            PG8_WAIT_L(8); PG8_BAR; PG8_WAIT_L(0); PG8_MMA(0, 0, At, B0); PG8_BAR; PG8_SCHED;
            PG8_LDB(B1, 1, 1); PG8_STAGE(PG8_SB(1, 0), b3, voffB);
            PG8_BAR; PG8_WAIT_L(0); PG8_MMA(0, 1, At, B1); PG8_BAR;
            PG8_LDA(At, 1, 1); PG8_STAGE(PG8_SA(1, 0), a3, voffA);
            PG8_BAR; PG8_WAIT_L(0); PG8_MMA(1, 0, At, B0); PG8_BAR; PG8_SCHED;
            PG8_STAGE(PG8_SB(1, 1), b3 + hstep, voffB);
            PG8_WAIT_V(6); PG8_BAR; PG8_MMA(1, 1, At, B1); PG8_BAR;
            }
        }
        if constexpr (ALIGN_EPI) { if (wr == 0) PG8_BAR; }
        bool keep_acc = false;
        if constexpr (Epi::CHAIN) { keep_acc = E.chain(acc, cur, wr, wc, fr, fq); S.done(cur); }
        else if constexpr (!Epi::AFTER_DRAIN) { E(acc, cur, wr, wc, fr, fq); S.done(cur); }
        if (!has_next) break;
        if (!keep_acc) {
#pragma unroll
        for (int a = 0; a < 2; ++a)
#pragma unroll
            for (int b = 0; b < 2; ++b)
#pragma unroll
                for (int m = 0; m < 4; ++m)
#pragma unroll
                    for (int n = 0; n < 2; ++n) acc[a][b][m][n] = (f32x4){0.f, 0.f, 0.f, 0.f};
        }
        cur = nxt; cA = nA; cB = nB; ++ui;
        if constexpr (ALIGN_EPI) { if (wr == 1) PG8_BAR; }
    }
    PG8_WAIT_V(0);
    if constexpr (!ALIGN_EPI) { if (wr == 0) PG8_BAR; }
    PG8_BAR;
    if constexpr (Epi::AFTER_DRAIN) { E.fused(acc, cur, wr, wc, fr, fq, lds, wid, lane); S.done(cur); }
#undef PG8_SA
#undef PG8_SB
#undef PG8_STAGE
#undef PG8_LDA
#undef PG8_LDB
#undef PG8_MMA
#undef PG8_WAIT_V
#undef PG8_WAIT_L
#undef PG8_BAR
#undef PG8_SCHED
}
}

#define LAS __attribute__((address_space(3)))
typedef unsigned short bf16;
typedef short bf16x8 __attribute__((ext_vector_type(8)));
typedef float f32x4 __attribute__((ext_vector_type(4)));
typedef unsigned u32x4 __attribute__((ext_vector_type(4)));
typedef unsigned u32x2 __attribute__((ext_vector_type(2)));

constexpr int D = 1024, NB = 8, T = 4096, CL = 256;
constexpr int ML = NB * T, MC = NB * CL, M = ML + MC;
constexpr int NZA = 3328, NZG = 3072;
constexpr int C_RQ = 0, C_RK = 256, C_RV = 512, C_RG = 1024, C_SU = 1536, C_SV = 2048, C_AQ = 2560, C_AK = 3072, C_AV = 3200;
constexpr int NE = 16, CAPL = 512, CAPC = 32, ME = NB * (CAPL + CAPC);
constexpr int NCH = 34;
constexpr float EPS = 1e-6f, LOG2E = 1.4426950408889634f;
constexpr int LDS_BYTES = 147456;

constexpr size_t MiB = 1u << 20;
constexpr size_t WS_ROPEC = 1 * MiB, WS_ROPES = 1 * MiB + 512 * 1024, WS_MODV = 2 * MiB, WS_AFF = 3 * MiB, WS_AFFC = 5 * MiB, WS_INV = 6 * MiB, WS_TOPW = 9 * MiB;
constexpr size_t WS_WTIN = 16 * MiB, WS_WTBR = WS_WTIN + (size_t)6400 * 1024 * 2, WS_WTOUT = WS_WTBR + (size_t)3072 * 512 * 2;
constexpr size_t WS_X = 34 * MiB, WS_H = 170 * MiB, WS_R = 238 * MiB;
constexpr size_t WS_ZA = WS_R, WS_G = WS_R, WS_RS = 459 * MiB, WS_ST = 527 * MiB;
constexpr size_t WS_XS = WS_R, WS_ACT = 374 * MiB, WS_WT1 = 510 * MiB, WS_WT2 = 574 * MiB, WS_END = 606 * MiB;
static_assert(WS_WTOUT + 2 * MiB <= WS_X && WS_ZA + (size_t)M * NZA * 2 <= WS_RS && WS_ST + (size_t)NB * 4 * NCH * 128 * 128 * 2 <= WS_END, "ws map");

struct KP {
    const float *x, *c, *ctx, *c_ctx, *w_mod, *b_mod, *norm1_g, *norm2_g, *w_in, *dec_f, *dec_b, *sgu_w, *sgu_b, *qn_g, *kn_g, *sink, *w_branch, *w_out, *w_router, *w_eg, *w_eu, *w_ed;
    float* out; unsigned char* ws;
};
typedef const __attribute__((address_space(4))) KP* KPC;

#define LDS_WAIT() asm volatile("s_waitcnt lgkmcnt(0)" ::: "memory")
__device__ __forceinline__ unsigned pk2(float lo, float hi) { return pg8::cvt_pk_bf16(lo, hi); }
__device__ __forceinline__ float bflo(unsigned w) { return __uint_as_float(w << 16); }
__device__ __forceinline__ float bfhi(unsigned w) { return __uint_as_float(w & 0xffff0000u); }
__device__ __forceinline__ void unpack8(const u32x4 w, float (&f)[8]) { f[0] = bflo(w.x); f[1] = bfhi(w.x); f[2] = bflo(w.y); f[3] = bfhi(w.y); f[4] = bflo(w.z); f[5] = bfhi(w.z); f[6] = bflo(w.w); f[7] = bfhi(w.w); }
__device__ __forceinline__ u32x4 pack8(const float (&f)[8]) { u32x4 o; o.x = pk2(f[0], f[1]); o.y = pk2(f[2], f[3]); o.z = pk2(f[4], f[5]); o.w = pk2(f[6], f[7]); return o; }
template <int MASK> __device__ __forceinline__ float swz_xor(float v) { static_assert(MASK > 0 && MASK < 32, "swz_xor: 1..31"); return __builtin_bit_cast(float, __builtin_amdgcn_ds_swizzle(__builtin_bit_cast(int, v), 0x1f | (MASK << 10))); }
template <int MASK> __device__ __forceinline__ int swz_xor_i(int v) { return __builtin_amdgcn_ds_swizzle(v, 0x1f | (MASK << 10)); }
__device__ __forceinline__ float sum_x32(float v) { const unsigned u = __builtin_bit_cast(unsigned, v); auto r = __builtin_amdgcn_permlane32_swap(u, u, false, false); return __builtin_bit_cast(float, (unsigned)r[0]) + __builtin_bit_cast(float, (unsigned)r[1]); }
__device__ __forceinline__ float max_x32(float v) { const unsigned u = __builtin_bit_cast(unsigned, v); auto r = __builtin_amdgcn_permlane32_swap(u, u, false, false); return fmaxf(__builtin_bit_cast(float, (unsigned)r[0]), __builtin_bit_cast(float, (unsigned)r[1])); }
__device__ __forceinline__ int sum_x32_i(int v) { auto r = __builtin_amdgcn_permlane32_swap((unsigned)v, (unsigned)v, false, false); return (int)r[0] + (int)r[1]; }
__device__ __forceinline__ float wave_sum(float v) { v += swz_xor<1>(v); v += swz_xor<2>(v); v += swz_xor<4>(v); v += swz_xor<8>(v); v += swz_xor<16>(v); return sum_x32(v); }
__device__ __forceinline__ float wave_max(float v) { v = fmaxf(v, swz_xor<1>(v)); v = fmaxf(v, swz_xor<2>(v)); v = fmaxf(v, swz_xor<4>(v)); v = fmaxf(v, swz_xor<8>(v)); v = fmaxf(v, swz_xor<16>(v)); return max_x32(v); }
__device__ __forceinline__ int wave_sum_i(int v) { v += swz_xor_i<1>(v); v += swz_xor_i<2>(v); v += swz_xor_i<4>(v); v += swz_xor_i<8>(v); v += swz_xor_i<16>(v); return sum_x32_i(v); }
__device__ __forceinline__ float sum_x16_x32(float v) { v += swz_xor<16>(v); return sum_x32(v); }
__device__ __forceinline__ float sum_x1_x2(float v) { v += swz_xor<1>(v); v += swz_xor<2>(v); return v; }
__device__ __forceinline__ float ex2(float x) { return __builtin_amdgcn_exp2f(x); }
__device__ __forceinline__ float sigmoidf_(float x) { return 1.f / (1.f + ex2(-x * LOG2E)); }
__device__ __forceinline__ float gelu_tanh(float x) { const float u = 0.7978845608028654f * (x + 0.044715f * x * x * x); return x / (1.f + ex2(-2.f * LOG2E * u)); }
__device__ __forceinline__ f32x4 mfma16(bf16x8 a, bf16x8 b, f32x4 c) { return __builtin_amdgcn_mfma_f32_16x16x32_bf16(a, b, c, 0, 0, 0); }
__device__ __forceinline__ bf16x8 as_bf16x8(u32x4 w) { return __builtin_bit_cast(bf16x8, w); }
__device__ __forceinline__ float log2_sigmoid(float a) { return -log1pf(__expf(-a)) * LOG2E; }

#ifndef WGM_
#define WGM_ 8
#endif
struct GroupOrder {
    int nG, nM, nN, pmS, pnS, G, c;
    __device__ __forceinline__ bool next(int i, pg8::Unit& u) const {
        const long L = (long)i * G + c; const int tot = nG * nM * nN; if (L >= tot) return false;
        int wgid = (int)L; { const int q = tot / 8, r = tot % 8, xcd = wgid % 8, off = wgid / 8; wgid = (xcd < r ? xcd * (q + 1) : r * (q + 1) + (xcd - r) * q) + off; }
        const int per = nM * nN, g = wgid / per, rem = wgid - g * per;
        const int nig = WGM_ * nN, gid = rem / nig, fm = gid * WGM_, gsz = (nM - fm) < WGM_ ? (nM - fm) : WGM_;
        u.pm = g * pmS + fm + ((rem % nig) % gsz); u.pn = g * pnS + (rem % nig) / gsz; return true;
    }
    __device__ __forceinline__ void a_ready(const pg8::Unit&) const {}
    __device__ __forceinline__ void done(const pg8::Unit&) const {}
};
struct MergeOrder {
    int nM, G, c;
    __device__ __forceinline__ bool next(int i, pg8::Unit& u) const {
        const int ii = i / 3, g = i - 3 * ii; const long L = (long)ii * G + c; const int tot = nM * 4; if (L >= tot) return false;
        int wgid = (int)L; { const int q = tot / 8, r = tot % 8, xcd = wgid % 8, off = wgid / 8; wgid = (xcd < r ? xcd * (q + 1) : r * (q + 1) + (xcd - r) * q) + off; }
        const int nig = 32, gid = wgid / nig, fm = gid * 8, gsz = (nM - fm) < 8 ? (nM - fm) : 8;
        u.pm = g * (M / 256) + fm + ((wgid % nig) % gsz); u.pn = g * 4 + (wgid % nig) / gsz; return true;
    }
    __device__ __forceinline__ void a_ready(const pg8::Unit&) const {}
    __device__ __forceinline__ void done(const pg8::Unit&) const {}
};

struct EpiZA {
    static constexpr bool PERM = true, AFTER_DRAIN = false, CHAIN = false;
    bf16* O;
    __device__ __forceinline__ void operator()(const f32x4 (&acc)[2][2][4][2], const pg8::Unit& u, int wr, int wc, int fr, int fq) const {
        const int row0 = u.pm * 256 + wr * 64 + fr, col0 = u.pn * 256 + wc * 32 + 8 * fq; const bool act = false;
#pragma unroll
        for (int ai = 0; ai < 2; ++ai)
#pragma unroll
            for (int m = 0; m < 4; ++m) { bf16* rowp = O + (size_t)(row0 + ai * 128 + m * 16) * NZA + col0;
#pragma unroll
                for (int bj = 0; bj < 2; ++bj) { const f32x4 v0 = acc[ai][bj][m][0], v1 = acc[ai][bj][m][1];
                    float o[8] = {v0[0], v0[1], v0[2], v0[3], v1[0], v1[1], v1[2], v1[3]};
                    if (act) {
#pragma unroll
                        for (int k = 0; k < 8; ++k) o[k] = gelu_tanh(o[k]); }
                    *(u32x4*)(rowp + bj * 128) = pack8(o); } }
    }
};
struct EpiNull {
    static constexpr bool PERM = true, AFTER_DRAIN = false, CHAIN = false;
    __device__ __forceinline__ void operator()(const f32x4 (&acc)[2][2][4][2], const pg8::Unit& u, int wr, int wc, int fr, int fq) const {
#pragma unroll
        for (int ai = 0; ai < 2; ++ai)
#pragma unroll
            for (int m = 0; m < 4; ++m)
#pragma unroll
                for (int bj = 0; bj < 2; ++bj) { asm volatile("" :: "v"(acc[ai][bj][m][0]), "v"(acc[ai][bj][m][1])); }
    }
};
struct EpiSig {
    static constexpr bool PERM = true, AFTER_DRAIN = false, CHAIN = false;
    bf16* O;
    __device__ __forceinline__ void operator()(const f32x4 (&acc)[2][2][4][2], const pg8::Unit& u, int wr, int wc, int fr, int fq) const {
        const int row0 = u.pm * 256 + wr * 64 + fr, col0 = u.pn * 256 + wc * 32 + 8 * fq;
#pragma unroll
        for (int ai = 0; ai < 2; ++ai)
#pragma unroll
            for (int m = 0; m < 4; ++m) { bf16* rowp = O + (size_t)(row0 + ai * 128 + m * 16) * NZG + col0;
#pragma unroll
                for (int bj = 0; bj < 2; ++bj) { const f32x4 v0 = acc[ai][bj][m][0], v1 = acc[ai][bj][m][1];
                    float o[8] = {v0[0], v0[1], v0[2], v0[3], v1[0], v1[1], v1[2], v1[3]};
#pragma unroll
                    for (int k = 0; k < 8; ++k) o[k] = fmaxf(sigmoidf_(o[k]), 1e-20f);
                    *(u32x4*)(rowp + bj * 128) = pack8(o); } }
    }
};
struct EpiMergeChain {
    static constexpr bool PERM = true, AFTER_DRAIN = false, CHAIN = true;
    const bf16* Gt; bf16* Hm;
    __device__ __forceinline__ bool chain(f32x4 (&acc)[2][2][4][2], const pg8::Unit& u, int wr, int wc, int fr, int fq) const {
        const int g = u.pm / (M / 256), m = u.pm - g * (M / 256), n = u.pn - g * 4;
        const int row0 = m * 256 + wr * 64 + fr, col0 = n * 256 + wc * 32 + 8 * fq;
#pragma unroll
        for (int ai = 0; ai < 2; ++ai) {
            u32x4 gw[4][2], hw[4][2];
#pragma unroll
            for (int mm = 0; mm < 4; ++mm)
#pragma unroll
                for (int bj = 0; bj < 2; ++bj) gw[mm][bj] = *(const u32x4*)(Gt + (size_t)(row0 + ai * 128 + mm * 16) * NZG + g * 1024 + col0 + bj * 128);
            if (g < 2) {
#pragma unroll
                for (int mm = 0; mm < 4; ++mm)
#pragma unroll
                    for (int bj = 0; bj < 2; ++bj) hw[mm][bj] = *(const u32x4*)(Gt + (size_t)(row0 + ai * 128 + mm * 16) * NZG + (g + 1) * 1024 + col0 + bj * 128);
            }
#pragma unroll
            for (int mm = 0; mm < 4; ++mm)
#pragma unroll
                for (int bj = 0; bj < 2; ++bj) {
                    float sc[8]; unpack8(gw[mm][bj], sc);
                    if (g < 2) { float sn[8]; unpack8(hw[mm][bj], sn);
#pragma unroll
                        for (int k = 0; k < 8; ++k) sc[k] *= __builtin_amdgcn_rcpf(sn[k]); }
                    f32x4& v0 = acc[ai][bj][mm][0]; f32x4& v1 = acc[ai][bj][mm][1];
                    v0[0] *= sc[0]; v0[1] *= sc[1]; v0[2] *= sc[2]; v0[3] *= sc[3]; v1[0] *= sc[4]; v1[1] *= sc[5]; v1[2] *= sc[6]; v1[3] *= sc[7];
                    if (g == 2) { u32x4 w; w.x = pk2(v0[0], v0[1]); w.y = pk2(v0[2], v0[3]); w.z = pk2(v1[0], v1[1]); w.w = pk2(v1[2], v1[3]);
                        *(u32x4*)(Hm + (size_t)(row0 + ai * 128 + mm * 16) * 1024 + col0 + bj * 128) = w; }
                }
        }
        return g < 2;
    }
};
struct EpiMerge {
    static constexpr bool PERM = true, AFTER_DRAIN = false, CHAIN = false;
    const bf16* Gt; bf16* Hm;
    __device__ __forceinline__ void operator()(const f32x4 (&acc)[2][2][4][2], const pg8::Unit& u, int wr, int wc, int fr, int fq) const {
        const int g = u.pm / (M / 256), m = u.pm - g * (M / 256), n = u.pn - g * 4;
        const int row0 = m * 256 + wr * 64 + fr, col0 = n * 256 + wc * 32 + 8 * fq;
#pragma unroll
        for (int ai = 0; ai < 2; ++ai) {
            u32x4 gw[4][2], ow[4][2];
#pragma unroll
            for (int mm = 0; mm < 4; ++mm)
#pragma unroll
                for (int bj = 0; bj < 2; ++bj) gw[mm][bj] = *(const u32x4*)(Gt + (size_t)(row0 + ai * 128 + mm * 16) * NZG + g * 1024 + col0 + bj * 128);
            if (g > 0) {
#pragma unroll
                for (int mm = 0; mm < 4; ++mm)
#pragma unroll
                    for (int bj = 0; bj < 2; ++bj) ow[mm][bj] = *(const u32x4*)(Hm + (size_t)(row0 + ai * 128 + mm * 16) * 1024 + col0 + bj * 128);
            }
#pragma unroll
            for (int mm = 0; mm < 4; ++mm)
#pragma unroll
                for (int bj = 0; bj < 2; ++bj) {
                    float gt[8]; unpack8(gw[mm][bj], gt);
                    const f32x4 v0 = acc[ai][bj][mm][0], v1 = acc[ai][bj][mm][1];
                    float o[8] = {v0[0], v0[1], v0[2], v0[3], v1[0], v1[1], v1[2], v1[3]};
#pragma unroll
                    for (int k = 0; k < 8; ++k) o[k] *= sigmoidf_(gt[k]);
                    if (g > 0) { float od[8]; unpack8(ow[mm][bj], od);
#pragma unroll
                        for (int k = 0; k < 8; ++k) o[k] += od[k]; }
                    *(u32x4*)(Hm + (size_t)(row0 + ai * 128 + mm * 16) * 1024 + col0 + bj * 128) = pack8(o);
                }
        }
    }
};
struct EpiOut {
    static constexpr bool PERM = false, AFTER_DRAIN = false, CHAIN = false;
    const float* xl; const float* xc; float* X; const float* modv;
    __device__ __forceinline__ void operator()(const f32x4 (&acc)[2][2][4][2], const pg8::Unit& u, int wr, int wc, int fr, int fq) const {
        const int row0 = u.pm * 256 + wr * 64 + fr, col0 = u.pn * 256 + wc * 32 + 4 * fq;
        const int bi = (u.pm * 256 < ML) ? ((u.pm * 256) >> 12) : 8;
        const float* g1 = modv + bi * 6144 + 2 * 1024;
        const float* src0 = (u.pm * 256 < ML) ? xl + (size_t)row0 * 1024 : xc + (size_t)(row0 - ML) * 1024;
        f32x4 gv[2][2];
#pragma unroll
        for (int bj = 0; bj < 2; ++bj)
#pragma unroll
            for (int n = 0; n < 2; ++n) gv[bj][n] = *(const f32x4*)(g1 + col0 + bj * 128 + n * 16);
#pragma unroll
        for (int ai = 0; ai < 2; ++ai) {
            f32x4 xv[4][2][2];
#pragma unroll
            for (int m = 0; m < 4; ++m)
#pragma unroll
                for (int bj = 0; bj < 2; ++bj)
#pragma unroll
                    for (int n = 0; n < 2; ++n) xv[m][bj][n] = *(const f32x4*)(src0 + (size_t)(ai * 128 + m * 16) * 1024 + col0 + bj * 128 + n * 16);
#pragma unroll
            for (int m = 0; m < 4; ++m)
#pragma unroll
                for (int bj = 0; bj < 2; ++bj)
#pragma unroll
                    for (int n = 0; n < 2; ++n) *(f32x4*)(X + (size_t)(row0 + ai * 128 + m * 16) * 1024 + col0 + bj * 128 + n * 16) = xv[m][bj][n] + gv[bj][n] * acc[ai][bj][m][n];
        }
    }
};
struct EpiMoe1 {
    static constexpr bool PERM = true, AFTER_DRAIN = false, CHAIN = false;
    bf16* ACT;
    __device__ __forceinline__ void operator()(const f32x4 (&acc)[2][2][4][2], const pg8::Unit& u, int wr, int wc, int fr, int fq) const {
        const int row0 = u.pm * 256 + wr * 64 + fr, col0 = (u.pn & 7) * 128 + wc * 32 + 8 * fq;
#pragma unroll
        for (int ai = 0; ai < 2; ++ai)
#pragma unroll
            for (int m = 0; m < 4; ++m) { const size_t r = (size_t)(row0 + ai * 128 + m * 16);
                const f32x4 a0 = acc[ai][0][m][0], a1 = acc[ai][0][m][1], u0 = acc[ai][1][m][0], u1 = acc[ai][1][m][1];
                float o[8];
#pragma unroll
                for (int k = 0; k < 4; ++k) { o[k] = a0[k] * sigmoidf_(a0[k]) * u0[k]; o[4 + k] = a1[k] * sigmoidf_(a1[k]) * u1[k]; }
                *(u32x4*)(ACT + r * 1024 + col0) = pack8(o); }
    }
};
struct EpiMoe2 {
    static constexpr bool PERM = true, AFTER_DRAIN = false, CHAIN = false;
    bf16* Y; const float* topw;
    __device__ __forceinline__ void operator()(const f32x4 (&acc)[2][2][4][2], const pg8::Unit& u, int wr, int wc, int fr, int fq) const {
        const int row0 = u.pm * 256 + wr * 64 + fr, col0 = (u.pn & 3) * 256 + wc * 32 + 8 * fq;
        float twv[2][4];
#pragma unroll
        for (int ai = 0; ai < 2; ++ai)
#pragma unroll
            for (int m = 0; m < 4; ++m) twv[ai][m] = topw[row0 + ai * 128 + m * 16];
#pragma unroll
        for (int ai = 0; ai < 2; ++ai)
#pragma unroll
            for (int m = 0; m < 4; ++m) { const size_t r = (size_t)(row0 + ai * 128 + m * 16); const float tw = twv[ai][m];
#pragma unroll
                for (int bj = 0; bj < 2; ++bj) { const f32x4 v0 = acc[ai][bj][m][0] * tw, v1 = acc[ai][bj][m][1] * tw;
                    u32x4 w; w.x = pk2(v0[0], v0[1]); w.y = pk2(v0[2], v0[3]); w.z = pk2(v1[0], v1[1]); w.w = pk2(v1[2], v1[3]);
                    *(u32x4*)(Y + r * 1024 + col0 + bj * 128) = w; } }
    }
};

__device__ __forceinline__ void tr_item(const float* W, int N, int k0, int n0, bf16* dst, int K, LAS float* scr, int lane) {
#pragma unroll 8
    for (int i = 0; i < 32; ++i) { const int kk = 2 * i + (lane >> 5); scr[kk * 33 + (lane & 31)] = W[(size_t)(k0 + kk) * N + n0 + (lane & 31)]; }
    LDS_WAIT();
    const int cc = lane & 7;
#pragma unroll
    for (int j = 0; j < 4; ++j) { const int n = (lane >> 3) + 8 * j; const LAS float* s = scr + (8 * cc) * 33 + n;
        u32x4 o; o.x = pk2(s[0 * 33], s[1 * 33]); o.y = pk2(s[2 * 33], s[3 * 33]); o.z = pk2(s[4 * 33], s[5 * 33]); o.w = pk2(s[6 * 33], s[7 * 33]);
        *(u32x4*)(dst + (size_t)n * K + 8 * cc) = o; }
    LDS_WAIT();
}
__device__ __forceinline__ void convert_small(KPC p, int l, LAS unsigned char* lds, int lane, int wave, int bid, int G) {
    LAS float* scr = (LAS float*)(lds + wave * 8448);
    const int gw = bid * 8 + wave, NGW = G * 8;
    constexpr int I_IN = 16 * 200, I_BR = 8 * 32, I_OUT = 16 * 32;
    bf16* wtin = (bf16*)(p->ws + WS_WTIN); bf16* wtbr = (bf16*)(p->ws + WS_WTBR); bf16* wtout = (bf16*)(p->ws + WS_WTOUT);
    for (int it = gw; it < I_IN + 3 * I_BR + I_OUT; it += NGW) {
        int r = it;
        if (r < I_IN) { const int kb = r / 200, nb = r % 200; tr_item(p->w_in + (size_t)l * 1024 * 6400, 6400, 64 * kb, 32 * nb, wtin + (size_t)(32 * nb) * 1024 + 64 * kb, 1024, scr, lane); continue; }
        r -= I_IN;
        if (r < 3 * I_BR) { const int br = r / I_BR, q = r % I_BR, kb = q / 32, nb = q % 32;
            tr_item(p->w_branch + ((size_t)l * 3 + br) * 512 * 1024, 1024, 64 * kb, 32 * nb, wtbr + (size_t)(br * 1024 + 32 * nb) * 512 + 64 * kb, 512, scr, lane); continue; }
        r -= 3 * I_BR;
        { const int kb = r / 32, nb = r % 32; tr_item(p->w_out + (size_t)l * 1024 * 1024, 1024, 64 * kb, 32 * nb, wtout + (size_t)(32 * nb) * 1024 + 64 * kb, 1024, scr, lane); }
    }
}
__device__ __forceinline__ void convert_experts(KPC p, int l, int lo, int hi, int widx, int nw, LAS unsigned char* lds, int lane, int wave) {
    LAS float* scr = (LAS float*)(lds + wave * 8448);
    bf16* wt1 = (bf16*)(p->ws + WS_WT1); bf16* wt2 = (bf16*)(p->ws + WS_WT2);
    for (int it = lo + widx; it < hi; it += nw) {
        const int e = it / 1536, q = it % 1536, which = q / 512, qq = q % 512, kb = qq / 32, nb = qq % 32, n0 = 32 * nb, k0 = 64 * kb;
        const size_t woff = ((size_t)l * NE + e) * 1024 * 1024;
        if (which == 0) tr_item(p->w_eg + woff, 1024, k0, n0, wt1 + ((size_t)e * 2048 + (n0 >> 7) * 256 + (n0 & 127)) * 1024 + k0, 1024, scr, lane);
        else if (which == 1) tr_item(p->w_eu + woff, 1024, k0, n0, wt1 + ((size_t)e * 2048 + (n0 >> 7) * 256 + 128 + (n0 & 127)) * 1024 + k0, 1024, scr, lane);
        else tr_item(p->w_ed + woff, 1024, k0, n0, wt2 + ((size_t)e * 1024 + n0) * 1024 + k0, 1024, scr, lane);
    }
}
constexpr int CVT_ITEMS = NE * 3 * 512;
constexpr int CVT_G_IDLE0 = 96, CVT_M_IDLE0 = 32, CVT_O_IDLE0 = 32;
constexpr int CVT_G_HI = 7680, CVT_M_HI = 7680 + 14336;

__device__ __forceinline__ void phase_prep(KPC p, LAS unsigned char* lds, int tid, int lane, int wave, int bid, int G) {
    unsigned char* ws = p->ws;
    {   float* rc = (float*)(ws + WS_ROPEC); float* rsn = (float*)(ws + WS_ROPES);
        for (int i = bid * 512 + tid; i < T * 32; i += G * 512) { const int t = i >> 5, f = i & 31; const int pos = (f < 16) ? (t >> 6) : (t & 63); const int fi = f & 15;
            const float inv = ex2(-(float)fi * (13.287712379549449f / 16.f));
            float ang = (float)pos * inv; ang -= 6.283185307179586f * rintf(ang * 0.15915494309189535f);
            rc[i] = __cosf(ang); rsn[i] = __sinf(ang); } }
    {   LAS float* sv = (LAS float*)lds;
        LAS float* red = (LAS float*)(lds + 36864);
        for (int i = tid; i < 9 * 1024; i += 512) { const int r = i >> 10, k = i & 1023; const float v = (r < 8) ? p->c[r * 1024 + k] : p->c_ctx[k]; sv[i] = v * sigmoidf_(v); }
        __syncthreads();
        for (int it = bid; it < 192; it += G) {
            const int l = it / 96, n0 = (it % 96) * 64;
            const float* W = p->w_mod + (size_t)l * 1024 * 6144 + n0 + lane;
            float acc[9];
#pragma unroll
            for (int r = 0; r < 9; ++r) acc[r] = 0.f;
#pragma unroll 1
            for (int k0 = wave * 128; k0 < wave * 128 + 128; k0 += 16) {
                float wv[16];
#pragma unroll
                for (int kk = 0; kk < 16; ++kk) wv[kk] = W[(size_t)(k0 + kk) * 6144];
#pragma unroll
                for (int kk = 0; kk < 16; ++kk)
#pragma unroll
                    for (int r = 0; r < 9; ++r) acc[r] += sv[r * 1024 + k0 + kk] * wv[kk]; }
#pragma unroll
            for (int r = 0; r < 9; ++r) red[(wave * 9 + r) * 64 + lane] = acc[r];
            __syncthreads();
            for (int i = tid; i < 576; i += 512) { const int r = i >> 6, ln = i & 63; float s = 0.f;
#pragma unroll
                for (int w = 0; w < 8; ++w) s += red[(w * 9 + r) * 64 + ln];
                s += p->b_mod[l * 6144 + n0 + ln]; ((float*)(ws + WS_MODV))[(l * 9 + r) * 6144 + n0 + ln] = s; }
            __syncthreads();
        }
    }
    __syncthreads();
    convert_small(p, 0, lds, lane, wave, bid, G);
}

__device__ __forceinline__ float row_rs(const f32x4 (&v)[4]) {
    float ss = 0.f;
#pragma unroll
    for (int j = 0; j < 4; ++j) ss += (v[j].x * v[j].x + v[j].y * v[j].y) + (v[j].z * v[j].z + v[j].w * v[j].w);
    return 1.0f / sqrtf(wave_sum(ss) * (1.f / 1024.f) + EPS);
}
__device__ __forceinline__ void norm_mod(const f32x4 (&v)[4], float rs, const float* gain, const float* sh, const float* sc, f32x4 (&h)[4], int lane) {
#pragma unroll
    for (int j = 0; j < 4; ++j) { const int col = 4 * lane + 256 * j; const f32x4 g = *(const f32x4*)(gain + col), a = *(const f32x4*)(sc + col), b = *(const f32x4*)(sh + col);
        h[j] = (v[j] * rs) * g * (a + 1.0f) + b; }
}
__device__ __forceinline__ void store_h(const f32x4 (&h)[4], bf16* hrow, int lane) {
#pragma unroll
    for (int j = 0; j < 4; ++j) { u32x2 w; w.x = pk2(h[j].x, h[j].y); w.y = pk2(h[j].z, h[j].w); *(u32x2*)(hrow + 4 * lane + 256 * j) = w; }
}
__device__ __forceinline__ void phase_norm_in(KPC p, int lane, int wave, int bid, int G) {
    const float* modv = (const float*)(p->ws + WS_MODV); bf16* H = (bf16*)(p->ws + WS_H);
    const int stride = G * 8; int r = bid * 8 + wave;
    f32x4 vn[4];
    {   const float* src = (r < ML) ? p->x + (size_t)r * 1024 : p->ctx + (size_t)(r - ML) * 1024;
#pragma unroll
        for (int j = 0; j < 4; ++j) vn[j] = (r < M) ? *(const f32x4*)(src + 4 * lane + 256 * j) : (f32x4){0.f, 0.f, 0.f, 0.f}; }
    for (; r < M; r += stride) {
        const int bi = (r < ML) ? (r >> 12) : 8; const float* mv = modv + bi * 6144;
        f32x4 v[4], h[4], g[4], sc[4], sh[4];
#pragma unroll
        for (int j = 0; j < 4; ++j) { v[j] = vn[j]; const int col = 4 * lane + 256 * j; g[j] = *(const f32x4*)(p->norm1_g + col); sh[j] = *(const f32x4*)(mv + col); sc[j] = *(const f32x4*)(mv + 1024 + col); }
        const int rn = r + stride;
        if (rn < M) { const float* src = (rn < ML) ? p->x + (size_t)rn * 1024 : p->ctx + (size_t)(rn - ML) * 1024;
#pragma unroll
            for (int j = 0; j < 4; ++j) vn[j] = *(const f32x4*)(src + 4 * lane + 256 * j); }
        const float rs = row_rs(v);
#pragma unroll
        for (int j = 0; j < 4; ++j) h[j] = (v[j] * rs) * g[j] * (sc[j] + 1.0f) + sh[j];
        store_h(h, H + (size_t)r * 1024, lane);
    }
}

__device__ __forceinline__ void att_item(KPC p, int l, LAS unsigned char* lds, int item, float Mb2, int tid, int lane, int wave) {
    const bf16* ZA = (const bf16*)(p->ws + WS_ZA); bf16* BR = (bf16*)p->out + (size_t)2 * M * 512;
    const float* rc = (const float*)(p->ws + WS_ROPEC); const float* rsn = (const float*)(p->ws + WS_ROPES);
    const bool isctx = item >= 512;
    int b, kvh, qb;
    if (!isctx) { b = item >> 6; kvh = (item >> 5) & 1; qb = item & 31; } else { const int ci = item - 512; b = ci >> 2; kvh = (ci >> 1) & 1; qb = ci & 1; }
    const int rowbase = isctx ? ML + b * CL : b * T;
    const int g = wave >> 1, qs = wave & 1, hh = kvh * 4 + g, c = lane & 15, g4 = lane >> 4, q0 = qb * 128 + qs * 64;
    const float* qg = p->qn_g + l * 64; const float* kg = p->kn_g + l * 64;
    LAS unsigned char* Kl = lds; LAS unsigned char* Vt = lds + 18432;
    bf16x8 qf[4][2];
#pragma unroll
    for (int ti = 0; ti < 4; ++ti) {
        const int pos = q0 + 16 * ti + c; const bf16* src = ZA + (size_t)(rowbase + pos) * NZA + C_AQ + hh * 64 + 8 * g4;
        float a[8], bb[8]; unpack8(*(const u32x4*)src, a); unpack8(*(const u32x4*)(src + 32), bb);
        float ss = 0.f;
#pragma unroll
        for (int j = 0; j < 8; ++j) ss += a[j] * a[j] + bb[j] * bb[j];
        ss = sum_x16_x32(ss);
        const float rs = 1.0f / sqrtf(ss * (1.f / 64.f) + EPS);
#pragma unroll
        for (int j = 0; j < 8; ++j) { a[j] *= rs * qg[8 * g4 + j]; bb[j] *= rs * qg[32 + 8 * g4 + j]; }
        if (!isctx) {
#pragma unroll
            for (int j = 0; j < 8; ++j) { const float cs = rc[pos * 32 + 8 * g4 + j], sn = rsn[pos * 32 + 8 * g4 + j]; const float x1 = a[j], x2 = bb[j]; a[j] = x1 * cs - x2 * sn; bb[j] = x1 * sn + x2 * cs; } }
#pragma unroll
        for (int j = 0; j < 8; ++j) { a[j] *= 0.125f * LOG2E; bb[j] *= 0.125f * LOG2E; }
        qf[ti][0] = as_bf16x8(pack8(a)); qf[ti][1] = as_bf16x8(pack8(bb));
        __builtin_amdgcn_sched_barrier(0);
    }
    f32x4 O[4][4]; float lsum[4];
#pragma unroll
    for (int i = 0; i < 4; ++i) { lsum[i] = 0.f;
#pragma unroll
        for (int j = 0; j < 4; ++j) O[i][j] = (f32x4){0.f, 0.f, 0.f, 0.f}; }
    const int ntile = isctx ? 2 : 5;
    for (int kt = 0; kt < ntile; ++kt) {
        int krow0, kpos0 = 0, mode = 0; bool local = false;
        if (isctx) krow0 = ML + b * CL + 128 * kt;
        else if (kt < 3) { const int kb = qb - 1 + kt; if (kb < 0 || kb > 31) continue; krow0 = b * T + kb * 128; kpos0 = kb * 128; local = true; mode = (kt == 0) ? 1 : ((kt == 2) ? 2 : 0); }
        else krow0 = ML + b * CL + 128 * (kt - 3);
#ifndef REP_ATT_STAGE
#define REP_ATT_STAGE 1
#endif
        for (int rs_ = 0; rs_ < REP_ATT_STAGE; ++rs_) {
        __syncthreads();
        {
            const int key = tid >> 2, q4 = tid & 3; const bf16* src = ZA + (size_t)(krow0 + key) * NZA + C_AK + kvh * 64 + 8 * q4;
            float a[8], bb[8]; unpack8(*(const u32x4*)src, a); unpack8(*(const u32x4*)(src + 32), bb);
            float ss = 0.f;
#pragma unroll
            for (int j = 0; j < 8; ++j) ss += a[j] * a[j] + bb[j] * bb[j];
            ss = sum_x1_x2(ss);
            const float rs = 1.0f / sqrtf(ss * (1.f / 64.f) + EPS);
#pragma unroll
            for (int j = 0; j < 8; ++j) { a[j] *= rs * kg[8 * q4 + j]; bb[j] *= rs * kg[32 + 8 * q4 + j]; }
            if (local) { const int pos = kpos0 + key;
#pragma unroll
                for (int j = 0; j < 8; ++j) { const float cs = rc[pos * 32 + 8 * q4 + j], sn = rsn[pos * 32 + 8 * q4 + j]; const float x1 = a[j], x2 = bb[j]; a[j] = x1 * cs - x2 * sn; bb[j] = x1 * sn + x2 * cs; } }
            *(LAS u32x4*)(Kl + key * 144 + 16 * q4) = pack8(a); *(LAS u32x4*)(Kl + key * 144 + 64 + 16 * q4) = pack8(bb);
            const bf16* vs = ZA + (size_t)(krow0 + key) * NZA + C_AV + kvh * 64 + 16 * q4;
            const u32x4 v0 = *(const u32x4*)vs, v1 = *(const u32x4*)(vs + 8);
            const unsigned vw[8] = {v0.x, v0.y, v0.z, v0.w, v1.x, v1.y, v1.z, v1.w};
#pragma unroll
            for (int j = 0; j < 8; ++j) { *(LAS unsigned short*)(Vt + (16 * q4 + 2 * j) * 272 + key * 2) = (unsigned short)(vw[j] & 0xffffu); *(LAS unsigned short*)(Vt + (16 * q4 + 2 * j + 1) * 272 + key * 2) = (unsigned short)(vw[j] >> 16); }
        }
        }
        __syncthreads();
#pragma unroll 1
        for (int kk = 0; kk < 4; ++kk) {
            if ((mode == 1 && 32 * kk + 31 < qs * 64) || (mode == 2 && 32 * kk > qs * 64 + 63)) continue;
            bf16x8 ka[2][2];
#pragma unroll
            for (int hf = 0; hf < 2; ++hf)
#pragma unroll
                for (int ks = 0; ks < 2; ++ks) ka[hf][ks] = *(const LAS bf16x8*)(Kl + (32 * kk + 16 * hf + c) * 144 + ks * 64 + g4 * 16);
            bf16x8 pf[4];
#pragma unroll
            for (int ti = 0; ti < 4; ++ti) {
                f32x4 sa = (f32x4){-Mb2, -Mb2, -Mb2, -Mb2}, sb = sa;
                sa = mfma16(ka[0][0], qf[ti][0], sa); sa = mfma16(ka[0][1], qf[ti][1], sa);
                sb = mfma16(ka[1][0], qf[ti][0], sb); sb = mfma16(ka[1][1], qf[ti][1], sb);
                float pa[4], pb[4];
#pragma unroll
                for (int rr = 0; rr < 4; ++rr) { pa[rr] = ex2(sa[rr]); pb[rr] = ex2(sb[rr]); }
                if (mode != 0) {
                    const int ii = qs * 64 + 16 * ti + c; const int mlo = (mode == 1) ? ii : -1000, mhi = (mode == 2) ? ii : 1000;
#pragma unroll
                    for (int rr = 0; rr < 4; ++rr) { const int ja = 32 * kk + 4 * g4 + rr, jb = ja + 16;
                        pa[rr] = (ja >= mlo && ja <= mhi) ? pa[rr] : 0.f; pb[rr] = (jb >= mlo && jb <= mhi) ? pb[rr] : 0.f; } }
                lsum[ti] += ((pa[0] + pa[1]) + (pa[2] + pa[3])) + ((pb[0] + pb[1]) + (pb[2] + pb[3]));
                u32x4 w; w.x = pk2(pa[0], pa[1]); w.y = pk2(pa[2], pa[3]); w.z = pk2(pb[0], pb[1]); w.w = pk2(pb[2], pb[3]); pf[ti] = as_bf16x8(w);
            }
#pragma unroll
            for (int dt = 0; dt < 4; ++dt) {
                const u32x2 v0 = *(const LAS u32x2*)(Vt + (16 * dt + c) * 272 + (32 * kk + 4 * g4) * 2), v1 = *(const LAS u32x2*)(Vt + (16 * dt + c) * 272 + (32 * kk + 16 + 4 * g4) * 2);
                u32x4 vv; vv.x = v0.x; vv.y = v0.y; vv.z = v1.x; vv.w = v1.y; const bf16x8 va = as_bf16x8(vv);
#pragma unroll
                for (int ti = 0; ti < 4; ++ti) O[dt][ti] = mfma16(va, pf[ti], O[dt][ti]);
            }
        }
    }
    const float sk = ex2(p->sink[l * 8 + hh] * LOG2E - Mb2);
#pragma unroll
    for (int ti = 0; ti < 4; ++ti) { float lt = sum_x16_x32(lsum[ti]); const float inv = 1.0f / (lt + sk);
        bf16* dst = BR + (size_t)(rowbase + q0 + 16 * ti + c) * 512 + hh * 64 + 4 * g4;
#pragma unroll
        for (int dt = 0; dt < 4; ++dt) { const f32x4 o = O[dt][ti] * inv; u32x2 w; w.x = pk2(o[0], o[1]); w.y = pk2(o[2], o[3]); *(u32x2*)(dst + 16 * dt) = w; } }
    __syncthreads();
}

__device__ __forceinline__ void sgu_vprep_item(KPC p, int ch, int tid) {
    bf16* ZA = (bf16*)(p->ws + WS_ZA);
    const int seg = tid & 15;
    bf16* rowp0 = ZA + (size_t)(ch * 128 + (tid >> 4)) * NZA + C_SV + 32 * seg;
    u32x4 raw[4][4];
#pragma unroll
    for (int ps = 0; ps < 4; ++ps)
#pragma unroll
        for (int q = 0; q < 4; ++q) raw[ps][q] = *(const u32x4*)(rowp0 + (size_t)ps * 32 * NZA + 8 * q);
#pragma unroll
    for (int ps = 0; ps < 4; ++ps) {
        bf16* rowp = rowp0 + (size_t)ps * 32 * NZA;
        float f[4][8]; float s = 0.f, ss = 0.f;
#pragma unroll
        for (int q = 0; q < 4; ++q) unpack8(raw[ps][q], f[q]);
#pragma unroll
        for (int q = 0; q < 4; ++q)
#pragma unroll
            for (int e = 0; e < 8; ++e) { const float y = gelu_tanh(f[q][e]); f[q][e] = y; s += y; ss += y * y; }
        s += swz_xor<1>(s); s += swz_xor<2>(s); s += swz_xor<4>(s); s += swz_xor<8>(s);
        ss += swz_xor<1>(ss); ss += swz_xor<2>(ss); ss += swz_xor<4>(ss); ss += swz_xor<8>(ss);
        const float mean = s * (1.f / 512.f), var = fmaxf(ss * (1.f / 512.f) - mean * mean, 0.f), rstd = 1.0f / sqrtf(var + EPS);
#pragma unroll
        for (int q = 0; q < 4; ++q) {
#pragma unroll
            for (int e = 0; e < 8; ++e) f[q][e] = (f[q][e] - mean) * rstd;
            *(u32x4*)(rowp + 8 * q) = pack8(f[q]); }
    }
}
__device__ __forceinline__ void sgu_item(KPC p, int l, LAS unsigned char* lds, int item, int tid, int lane, int wave) {
    const bf16* ZA = (const bf16*)(p->ws + WS_ZA); bf16* BR = (bf16*)p->out + (size_t)1 * M * 512;
    const int ch = item >> 2, g = item & 3, r0 = ch * 128, c = lane & 15, g4 = lane >> 4;
    LAS unsigned char* vT = lds;
    LAS unsigned char* WL = lds + 34816;
    {   const int j = tid >> 2, q4 = tid & 3; const bf16* src = ZA + (size_t)(r0 + j) * NZA + C_SV + 128 * g + 32 * q4;
#pragma unroll
        for (int q = 0; q < 4; ++q) { const u32x4 v = *(const u32x4*)(src + 8 * q); const unsigned vw[4] = {v.x, v.y, v.z, v.w};
#pragma unroll
            for (int e = 0; e < 4; ++e) { *(LAS unsigned short*)(vT + (32 * q4 + 8 * q + 2 * e) * 272 + j * 2) = (unsigned short)(vw[e] & 0xffffu); *(LAS unsigned short*)(vT + (32 * q4 + 8 * q + 2 * e + 1) * 272 + j * 2) = (unsigned short)(vw[e] >> 16); } }
        const float* wsrc = p->sgu_w + ((size_t)(l * 4 + g) * 128 + (tid >> 2)) * 128 + 32 * (tid & 3);
#pragma unroll
        for (int q = 0; q < 4; ++q) { const f32x4 a = *(const f32x4*)(wsrc + 8 * q), bq = *(const f32x4*)(wsrc + 8 * q + 4);
            u32x4 w; w.x = pk2(a.x, a.y); w.y = pk2(a.z, a.w); w.z = pk2(bq.x, bq.y); w.w = pk2(bq.z, bq.w);
            *(LAS u32x4*)(WL + (tid >> 2) * 272 + (32 * (tid & 3) + 8 * q) * 2) = w; }
    }
    __syncthreads();
    bf16x8 af[4];
#pragma unroll
    for (int ks = 0; ks < 4; ++ks) af[ks] = *(const LAS bf16x8*)(vT + (16 * wave + c) * 272 + (32 * ks + 8 * g4) * 2);
    const int col = 128 * g + 16 * wave + 4 * g4;
    u32x2 uw[8]; float bias[8];
#pragma unroll
    for (int ti = 0; ti < 8; ++ti) { uw[ti] = *(const u32x2*)(ZA + (size_t)(r0 + 16 * ti + c) * NZA + C_SU + col); bias[ti] = p->sgu_b[(l * 4 + g) * 128 + 16 * ti + c]; }
#pragma unroll
    for (int ti = 0; ti < 8; ++ti) {
        f32x4 acc = (f32x4){0.f, 0.f, 0.f, 0.f};
#pragma unroll
        for (int ks = 0; ks < 4; ++ks) acc = mfma16(af[ks], *(const LAS bf16x8*)(WL + (16 * ti + c) * 272 + (32 * ks + 8 * g4) * 2), acc);
        const float o0 = gelu_tanh(bflo(uw[ti].x)) * (acc[0] + bias[ti]), o1 = gelu_tanh(bfhi(uw[ti].x)) * (acc[1] + bias[ti]), o2 = gelu_tanh(bflo(uw[ti].y)) * (acc[2] + bias[ti]), o3 = gelu_tanh(bfhi(uw[ti].y)) * (acc[3] + bias[ti]);
        u32x2 w; w.x = pk2(o0, o1); w.y = pk2(o2, o3); *(u32x2*)(BR + (size_t)(r0 + 16 * ti + c) * 512 + col) = w;
    }
    __syncthreads();
}

__device__ __forceinline__ void ret_load_k(KPC p, const bf16* ZA, int r0, int h, bool latent, int pos0, int tid, float (&a)[8], float (&bb)[8]) {
    const int j = tid >> 2, q4 = tid & 3; const bf16* src = ZA + (size_t)(r0 + j) * NZA + C_RK + 64 * h + 8 * q4;
    unpack8(*(const u32x4*)src, a); unpack8(*(const u32x4*)(src + 32), bb);
    if (latent) { const float* rc = (const float*)(p->ws + WS_ROPEC); const float* rsn = (const float*)(p->ws + WS_ROPES); const int pos = pos0 + j;
#pragma unroll
        for (int e = 0; e < 8; ++e) { const float cs = rc[pos * 32 + 8 * q4 + e], sn = rsn[pos * 32 + 8 * q4 + e]; const float x1 = a[e], x2 = bb[e]; a[e] = x1 * cs - x2 * sn; bb[e] = x1 * sn + x2 * cs; } }
#pragma unroll
    for (int e = 0; e < 8; ++e) { a[e] *= 0.125f; bb[e] *= 0.125f; }
}
__device__ __forceinline__ void ret_stage_vT(const bf16* ZA, int r0, int h, LAS unsigned char* vT, int tid) {
    const int j = tid >> 2, q4 = tid & 3; const bf16* src = ZA + (size_t)(r0 + j) * NZA + C_RV + 128 * h + 32 * q4;
#pragma unroll
    for (int q = 0; q < 4; ++q) { const u32x4 v = *(const u32x4*)(src + 8 * q); const unsigned vw[4] = {v.x, v.y, v.z, v.w};
#pragma unroll
        for (int e = 0; e < 4; ++e) { *(LAS unsigned short*)(vT + (32 * q4 + 8 * q + 2 * e) * 272 + j * 2) = (unsigned short)(vw[e] & 0xffffu); *(LAS unsigned short*)(vT + (32 * q4 + 8 * q + 2 * e + 1) * 272 + j * 2) = (unsigned short)(vw[e] >> 16); } }
}
__device__ __forceinline__ void ret_upd_item(KPC p, int l, LAS unsigned char* lds, int item, int tid, int lane, int wave) {
    const bf16* ZA = (const bf16*)(p->ws + WS_ZA); float* RS = (float*)(p->ws + WS_RS);
    const int b = item / (NCH * 4), rem = item % (NCH * 4), n = rem >> 2, h = rem & 3, c = lane & 15, g4 = lane >> 4;
    const bool latent = n < 32; const int r0 = latent ? b * T + 128 * n : ML + b * CL + 128 * (n - 32);
    const float lgf = log2_sigmoid(p->dec_f[l * 4 + h]), lgb = log2_sigmoid(p->dec_b[l * 4 + h]);
    LAS unsigned char* vT = lds; LAS unsigned char* kTf = lds + 34816; LAS unsigned char* kTb = lds + 34816 + 17408;
    {   float a[8], bb[8]; ret_load_k(p, ZA, r0, h, latent, 128 * n, tid, a, bb);
        const int j = tid >> 2, q4 = tid & 3; const float wf = ex2((float)(127 - j) * lgf), wb = ex2((float)j * lgb);
#pragma unroll
        for (int e = 0; e < 8; e += 2) {
            unsigned w = pk2(a[e] * wf, a[e + 1] * wf); *(LAS unsigned short*)(kTf + (8 * q4 + e) * 272 + j * 2) = (unsigned short)(w & 0xffffu); *(LAS unsigned short*)(kTf + (8 * q4 + e + 1) * 272 + j * 2) = (unsigned short)(w >> 16);
            w = pk2(bb[e] * wf, bb[e + 1] * wf); *(LAS unsigned short*)(kTf + (32 + 8 * q4 + e) * 272 + j * 2) = (unsigned short)(w & 0xffffu); *(LAS unsigned short*)(kTf + (32 + 8 * q4 + e + 1) * 272 + j * 2) = (unsigned short)(w >> 16);
            w = pk2(a[e] * wb, a[e + 1] * wb); *(LAS unsigned short*)(kTb + (8 * q4 + e) * 272 + j * 2) = (unsigned short)(w & 0xffffu); *(LAS unsigned short*)(kTb + (8 * q4 + e + 1) * 272 + j * 2) = (unsigned short)(w >> 16);
            w = pk2(bb[e] * wb, bb[e + 1] * wb); *(LAS unsigned short*)(kTb + (32 + 8 * q4 + e) * 272 + j * 2) = (unsigned short)(w & 0xffffu); *(LAS unsigned short*)(kTb + (32 + 8 * q4 + e + 1) * 272 + j * 2) = (unsigned short)(w >> 16);
        }
        ret_stage_vT(ZA, r0, h, vT, tid);
    }
    __syncthreads();
    bf16x8 af[4];
#pragma unroll
    for (int ks = 0; ks < 4; ++ks) af[ks] = *(const LAS bf16x8*)(vT + (16 * wave + c) * 272 + (32 * ks + 8 * g4) * 2);
#pragma unroll
    for (int dir = 0; dir < 2; ++dir) { const LAS unsigned char* kT = dir ? kTb : kTf;
        float* dst = RS + ((size_t)(((b * 4 + h) * 2 + dir) * NCH + n) * 128 + 16 * wave + 4 * g4) * 64;
#pragma unroll
        for (int dt = 0; dt < 4; ++dt) { f32x4 acc = (f32x4){0.f, 0.f, 0.f, 0.f};
#pragma unroll
            for (int ks = 0; ks < 4; ++ks) acc = mfma16(af[ks], *(const LAS bf16x8*)(kT + (16 * dt + c) * 272 + (32 * ks + 8 * g4) * 2), acc);
#pragma unroll
            for (int rr = 0; rr < 4; ++rr) dst[rr * 64 + 16 * dt + c] = acc[rr]; } }
    __syncthreads();
}
__device__ __forceinline__ void phase_scan(KPC p, int l, int tid, int bid, int G) {
    const float* __restrict__ RS = (const float*)(p->ws + WS_RS); bf16* __restrict__ ST = (bf16*)(p->ws + WS_ST);
    for (int idx = bid * 512 + tid; idx < NB * 4 * 2 * 8192; idx += G * 512) {
        const int ed = idx & 8191, dir = (idx >> 13) & 1, bh = idx >> 14, e = ed >> 6, d = ed & 63, h = bh & 3;
        const float* P = RS + (size_t)((bh * 2 + dir) * NCH) * 8192 + ed;
        bf16* S = ST + ((size_t)bh * NCH * 128 + e) * 128 + dir * 64 + d;
        const float lg = log2_sigmoid(dir ? p->dec_b[l * 4 + h] : p->dec_f[l * 4 + h]); const float dec = ex2(128.f * lg);
        float u[NCH];
#pragma unroll
        for (int n = 0; n < NCH; ++n) u[n] = P[(size_t)n * 8192];
        if (dir == 0) {
            S[32 * 16384] = 0; S[33 * 16384] = (bf16)(pk2(u[32], 0.f) & 0xffffu);
            float s = dec * u[32] + u[33];
#pragma unroll
            for (int n = 0; n < 32; ++n) { S[(size_t)n * 16384] = (bf16)(pk2(s, 0.f) & 0xffffu); s = dec * s + u[n]; }
        } else {
            S[33 * 16384] = 0; S[32 * 16384] = (bf16)(pk2(u[33], 0.f) & 0xffffu);
            float s = dec * u[33] + u[32];
#pragma unroll
            for (int n = 31; n >= 0; --n) { S[(size_t)n * 16384] = (bf16)(pk2(s, 0.f) & 0xffffu); s = dec * s + u[n]; }
        }
    }
}
__device__ __forceinline__ void ret_out_item(KPC p, int l, LAS unsigned char* lds, int item, int tid, int lane, int wave) {
    const bf16* ZA = (const bf16*)(p->ws + WS_ZA); bf16* BR = (bf16*)p->out; const bf16* ST = (const bf16*)(p->ws + WS_ST);
    const int b = item / (NCH * 4), rem = item % (NCH * 4), n = rem >> 2, h = rem & 3, c = lane & 15, g4 = lane >> 4;
    const bool latent = n < 32; const int r0 = latent ? b * T + 128 * n : ML + b * CL + 128 * (n - 32);
    const float lgf = log2_sigmoid(p->dec_f[l * 4 + h]), lgb = log2_sigmoid(p->dec_b[l * 4 + h]);
    LAS unsigned char* vT = lds; LAS unsigned char* Kl = lds + 34816; LAS unsigned char* Sl = lds + 34816 + 18432;
    {   float a[8], bb[8]; ret_load_k(p, ZA, r0, h, latent, 128 * n, tid, a, bb);
        const int j = tid >> 2, q4 = tid & 3;
        *(LAS u32x4*)(Kl + j * 144 + 16 * q4) = pack8(a); *(LAS u32x4*)(Kl + j * 144 + 64 + 16 * q4) = pack8(bb);
        ret_stage_vT(ZA, r0, h, vT, tid);
        const u32x4* ssrc = (const u32x4*)(ST + (size_t)((b * 4 + h) * NCH + n) * 16384);
#pragma unroll
        for (int k = 0; k < 4; ++k) { const int q = tid + 512 * k; *(LAS u32x4*)(Sl + (q >> 4) * 272 + (q & 15) * 16) = ssrc[q]; }
    }
    __syncthreads();
    const int ii = 16 * wave + c;
    bf16x8 qf[2];
    {   const bf16* src = ZA + (size_t)(r0 + ii) * NZA + C_RQ + 64 * h + 8 * g4; float a[8], bb[8]; unpack8(*(const u32x4*)src, a); unpack8(*(const u32x4*)(src + 32), bb);
        if (latent) { const float* rc = (const float*)(p->ws + WS_ROPEC); const float* rsn = (const float*)(p->ws + WS_ROPES); const int pos = 128 * n + ii;
#pragma unroll
            for (int e = 0; e < 8; ++e) { const float cs = rc[pos * 32 + 8 * g4 + e], sn = rsn[pos * 32 + 8 * g4 + e]; const float x1 = a[e], x2 = bb[e]; a[e] = x1 * cs - x2 * sn; bb[e] = x1 * sn + x2 * cs; } }
        qf[0] = as_bf16x8(pack8(a)); qf[1] = as_bf16x8(pack8(bb)); }
    bf16x8 pf[4];
#pragma unroll
    for (int kk = 0; kk < 4; ++kk) {
        f32x4 sa = (f32x4){0.f, 0.f, 0.f, 0.f}, sb = (f32x4){0.f, 0.f, 0.f, 0.f};
        sa = mfma16(*(const LAS bf16x8*)(Kl + (32 * kk + c) * 144 + g4 * 16), qf[0], sa); sa = mfma16(*(const LAS bf16x8*)(Kl + (32 * kk + c) * 144 + 64 + g4 * 16), qf[1], sa);
        sb = mfma16(*(const LAS bf16x8*)(Kl + (32 * kk + 16 + c) * 144 + g4 * 16), qf[0], sb); sb = mfma16(*(const LAS bf16x8*)(Kl + (32 * kk + 16 + c) * 144 + 64 + g4 * 16), qf[1], sb);
        float pa[4], pb[4];
#pragma unroll
        for (int rr = 0; rr < 4; ++rr) { const int ja = 32 * kk + 4 * g4 + rr, jb = ja + 16; const int da = ii - ja, db = ii - jb;
            pa[rr] = sa[rr] * ((da >= 0) ? ex2((float)da * lgf) : ex2((float)(-da) * lgb)); pb[rr] = sb[rr] * ((db >= 0) ? ex2((float)db * lgf) : ex2((float)(-db) * lgb)); }
        u32x4 w; w.x = pk2(pa[0], pa[1]); w.y = pk2(pa[2], pa[3]); w.z = pk2(pb[0], pb[1]); w.w = pk2(pb[2], pb[3]); pf[kk] = as_bf16x8(w);
    }
    const float cf = ex2((float)(ii + 1) * lgf), cb = ex2((float)(128 - ii) * lgb);
    f32x4 O[8]; float s = 0.f, ss = 0.f;
#pragma unroll
    for (int et = 0; et < 8; ++et) {
        f32x4 acc = (f32x4){0.f, 0.f, 0.f, 0.f}, xf = (f32x4){0.f, 0.f, 0.f, 0.f}, xb = (f32x4){0.f, 0.f, 0.f, 0.f};
#pragma unroll
        for (int kk = 0; kk < 4; ++kk) { const u32x2 v0 = *(const LAS u32x2*)(vT + (16 * et + c) * 272 + (32 * kk + 4 * g4) * 2), v1 = *(const LAS u32x2*)(vT + (16 * et + c) * 272 + (32 * kk + 16 + 4 * g4) * 2);
            u32x4 vv; vv.x = v0.x; vv.y = v0.y; vv.z = v1.x; vv.w = v1.y; acc = mfma16(as_bf16x8(vv), pf[kk], acc); }
#pragma unroll
        for (int ks = 0; ks < 2; ++ks) { xf = mfma16(*(const LAS bf16x8*)(Sl + (16 * et + c) * 272 + (32 * ks + 8 * g4) * 2), qf[ks], xf);
            xb = mfma16(*(const LAS bf16x8*)(Sl + (16 * et + c) * 272 + (64 + 32 * ks + 8 * g4) * 2), qf[ks], xb); }
        acc = acc + xf * cf + xb * cb; O[et] = acc;
        s += (acc[0] + acc[1]) + (acc[2] + acc[3]); ss += (acc[0] * acc[0] + acc[1] * acc[1]) + (acc[2] * acc[2] + acc[3] * acc[3]);
    }
    s = sum_x16_x32(s); ss = sum_x16_x32(ss);
    const float mean = s * (1.f / 128.f), var = fmaxf(ss * (1.f / 128.f) - mean * mean, 0.f), rstd = 1.0f / sqrtf(var + EPS);
    const bf16* gsrc = ZA + (size_t)(r0 + ii) * NZA + C_RG + 128 * h + 4 * g4; bf16* dst = BR + (size_t)(r0 + ii) * 512 + 128 * h + 4 * g4;
#pragma unroll
    for (int et = 0; et < 8; ++et) { const u32x2 gw = *(const u32x2*)(gsrc + 16 * et); const float g0 = bflo(gw.x), g1 = bfhi(gw.x), g2 = bflo(gw.y), g3 = bfhi(gw.y);
        const float o0 = (O[et][0] - mean) * rstd * g0 * sigmoidf_(g0), o1 = (O[et][1] - mean) * rstd * g1 * sigmoidf_(g1), o2 = (O[et][2] - mean) * rstd * g2 * sigmoidf_(g2), o3 = (O[et][3] - mean) * rstd * g3 * sigmoidf_(g3);
        u32x2 w; w.x = pk2(o0, o1); w.y = pk2(o2, o3); *(u32x2*)(dst + 16 * et) = w; }
    __syncthreads();
}

#ifndef REP_CVT
#define REP_CVT 1
#endif
#ifndef REP_N2R
#define REP_N2R 1
#endif
#ifndef REP_TK
#define REP_TK 1
#endif
__device__ __forceinline__ int wr_off(int k) { return k * 64 + (k >> 2) * 16; }
__device__ __forceinline__ void phase_norm2(KPC p, int l, LAS unsigned char* lds, int tid, int lane, int wave, int bid, int G) {
    if (l == 1 || G != 256) { for (int rep = 0; rep < REP_CVT; ++rep) convert_experts(p, l, 0, CVT_ITEMS, bid * 8 + wave, G * 8, lds, lane, wave); __syncthreads(); }
    LAS unsigned char* wrl = lds + 69632;
    for (int i = tid; i < 1024 * 4; i += 512) { const int k = i >> 2, q = i & 3; *(LAS f32x4*)(wrl + wr_off(k) + 16 * q) = *(const f32x4*)(p->w_router + (size_t)l * 16384 + k * 16 + 4 * q); }
    __syncthreads();
    const float* modv = (const float*)(p->ws + WS_MODV) + l * 9 * 6144; const float* X = (const float*)(p->ws + WS_X); bf16* H = (bf16*)(p->ws + WS_H);
    float* AFF = (float*)(p->ws + WS_AFF); float* AFFC = (float*)(p->ws + WS_AFFC); int* INV = (int*)(p->ws + WS_INV);
    const int rows = (l == 0) ? M : ML, stride = G * 8;
    for (int rep = 0; rep < REP_N2R; ++rep) {
    int r = bid * 8 + wave;
    f32x4 vn[4];
#pragma unroll
    for (int j = 0; j < 4; ++j) vn[j] = (r < rows) ? *(const f32x4*)(X + (size_t)r * 1024 + 4 * lane + 256 * j) : (f32x4){0.f, 0.f, 0.f, 0.f};
    for (; r < rows; r += stride) {
        const int bi = (r < ML) ? (r >> 12) : 8; const float* mv = modv + bi * 6144;
        f32x4 v[4], h[4], g[4], sc[4], sh[4];
#pragma unroll
        for (int j = 0; j < 4; ++j) { v[j] = vn[j]; const int col = 4 * lane + 256 * j; g[j] = *(const f32x4*)(p->norm2_g + l * 1024 + col); sh[j] = *(const f32x4*)(mv + 3 * 1024 + col); sc[j] = *(const f32x4*)(mv + 4 * 1024 + col); }
        const int rn = r + stride;
        if (rn < rows) {
#pragma unroll
            for (int j = 0; j < 4; ++j) vn[j] = *(const f32x4*)(X + (size_t)rn * 1024 + 4 * lane + 256 * j); }
        const float rs = row_rs(v);
#pragma unroll
        for (int j = 0; j < 4; ++j) h[j] = (v[j] * rs) * g[j] * (sc[j] + 1.0f) + sh[j];
        store_h(h, H + (size_t)r * 1024, lane);
        float lg[16];
#pragma unroll
        for (int e = 0; e < 16; ++e) lg[e] = 0.f;
#pragma unroll
        for (int j = 0; j < 4; ++j)
#pragma unroll
            for (int i = 0; i < 4; ++i) { const int k = 4 * lane + 256 * j + i; const float hv = h[j][i]; const LAS f32x4* wp = (const LAS f32x4*)(wrl + wr_off(k));
#pragma unroll
                for (int q = 0; q < 4; ++q) { const f32x4 w = wp[q]; lg[4 * q] += hv * w.x; lg[4 * q + 1] += hv * w.y; lg[4 * q + 2] += hv * w.z; lg[4 * q + 3] += hv * w.w; } }
        float mx = -1e30f;
#pragma unroll
        for (int e = 0; e < 16; ++e) { lg[e] = wave_sum(lg[e]); mx = fmaxf(mx, lg[e]); }
        float sum = 0.f;
#pragma unroll
        for (int e = 0; e < 16; ++e) { lg[e] = ex2((lg[e] - mx) * LOG2E); sum += lg[e]; }
        const float isum = 1.0f / sum; float mine = 0.f;
#pragma unroll
        for (int e = 0; e < 16; ++e) mine = (lane == e) ? lg[e] * isum : mine;
        if (lane < 16) { if (r < ML) AFF[((size_t)(bi * 16 + lane) << 12) + (r & 4095)] = mine; else AFFC[((r - ML) >> 8) * 4096 + lane * 256 + ((r - ML) & 255)] = mine;
            INV[(size_t)r * 16 + lane] = -1; }
    }
    }
}

__device__ __forceinline__ int block_sum_i(int v, LAS int* red, int buf, int lane, int wave) {
    v = wave_sum_i(v);
    if (lane == 0) red[buf * 8 + wave] = v;
    __syncthreads();
    int s = 0;
#pragma unroll
    for (int w = 0; w < 8; ++w) s += red[buf * 8 + w];
    return s;
}
__device__ __forceinline__ int block_excl_scan(int v, LAS int* red, int buf, int lane, int wave) {
    int inc = v;
#pragma unroll
    for (int o = 1; o < 64; o <<= 1) { const int t = __builtin_amdgcn_ds_bpermute((lane - o) << 2, inc); if (lane >= o) inc += t; }
    if (lane == 63) red[buf * 8 + wave] = inc;
    __syncthreads();
    int base = 0;
#pragma unroll
    for (int w = 0; w < 8; ++w) { const int x = red[buf * 8 + w]; if (w < wave) base += x; }
    return base + inc - v;
}
template <int KPT>
__device__ __forceinline__ void topk_item(KPC p, const float* aff, int n, int cap, int rowbase, int e, int slotbase, int s_lo, int s_hi, bool writer, LAS unsigned char* lds, int tid, int lane, int wave) {
    const bf16* H = (const bf16*)(p->ws + WS_H); bf16* XS = (bf16*)(p->ws + WS_XS); float* topw = (float*)(p->ws + WS_TOPW); int* INV = (int*)(p->ws + WS_INV);
    LAS int* red = (LAS int*)lds; LAS int* rl = (LAS int*)(lds + 128);
    unsigned key[KPT]; const bool valid = tid * KPT < n;
#pragma unroll
    for (int j = 0; j < KPT; ++j) key[j] = valid ? __float_as_uint(aff[tid * KPT + j]) : 0u;
    unsigned Tsel = 0u;
    for (int bit = 30; bit >= 0; --bit) { const unsigned cand = Tsel | (1u << bit); int cnt = 0;
#pragma unroll
        for (int j = 0; j < KPT; ++j) cnt += (valid && key[j] >= cand) ? 1 : 0;
        if (block_sum_i(cnt, red, bit & 1, lane, wave) >= cap) Tsel = cand; }
    int cgt = 0, ceq = 0;
#pragma unroll
    for (int j = 0; j < KPT; ++j) { cgt += (valid && key[j] > Tsel) ? 1 : 0; ceq += (valid && key[j] == Tsel) ? 1 : 0; }
    const int need = cap - block_sum_i(cgt, red, 1, lane, wave);
    int er = block_excl_scan(ceq, red, 2, lane, wave);
    bool sel[KPT]; int nsel = 0;
#pragma unroll
    for (int j = 0; j < KPT; ++j) { const bool iseq = valid && key[j] == Tsel; sel[j] = valid && (key[j] > Tsel || (iseq && er < need)); er += iseq ? 1 : 0; nsel += sel[j] ? 1 : 0; }
    int slot = block_excl_scan(nsel, red, 3, lane, wave);
#pragma unroll
    for (int j = 0; j < KPT; ++j) if (sel[j]) { const int t = tid * KPT + j; if (slot < cap) { rl[slot] = t; if (writer) { topw[e * ME + slotbase + slot] = __uint_as_float(key[j]); INV[(size_t)(rowbase + t) * 16 + e] = slotbase + slot; } } ++slot; }
    __syncthreads();
    for (int s = s_lo + wave * 4; s < s_hi; s += 32) {
        u32x4 a[4][2];
#pragma unroll
        for (int q = 0; q < 4; ++q) { const int t = rl[s + q]; const u32x4* src = (const u32x4*)(H + (size_t)(rowbase + t) * 1024); a[q][0] = src[lane]; a[q][1] = src[lane + 64]; }
#pragma unroll
        for (int q = 0; q < 4; ++q) { u32x4* dst = (u32x4*)(XS + ((size_t)e * ME + slotbase + s + q) * 1024); dst[lane] = a[q][0]; dst[lane + 64] = a[q][1]; }
    }
    __syncthreads();
}
__device__ __forceinline__ void phase_topk(KPC p, int l, LAS unsigned char* lds, int tid, int lane, int wave, int bid, int G) {
    const float* AFF = (const float*)(p->ws + WS_AFF); const float* AFFC = (const float*)(p->ws + WS_AFFC);
    const int nitem = (l == 0) ? 384 : 256;
    for (int it = bid; it < nitem; it += G) {
        if (it < 256) { const int q = it >> 1, hf = it & 1, b = q >> 4, e = q & 15; topk_item<8>(p, AFF + ((size_t)(b * 16 + e) << 12), 4096, CAPL, b * T, e, b * CAPL, hf * 256, hf * 256 + 256, hf == 0, lds, tid, lane, wave); }
        else { const int q = it - 256, b = q >> 4, e = q & 15; topk_item<1>(p, AFFC + (b * 16 + e) * 256, 256, CAPC, ML + b * CL, e, NB * CAPL + b * CAPC, 0, CAPC, true, lds, tid, lane, wave); }
    }
}

__device__ __forceinline__ void phase_combine(KPC p, int l, LAS unsigned char* lds, int tid, int lane, int wave, int bid, int G) {
    const float* modv = (const float*)(p->ws + WS_MODV); float* X = (float*)(p->ws + WS_X); bf16* H = (bf16*)(p->ws + WS_H);
    const bf16* Y = (const bf16*)(p->ws + WS_XS); const int* INV = (const int*)(p->ws + WS_INV);
    const int rows = (l == 0) ? M : ML, stride = G * 8;
    int r = bid * 8 + wave;
    int slot_next = (lane < 16 && r < rows) ? INV[(size_t)r * 16 + lane] : -1;
    f32x4 vn[4];
#pragma unroll
    for (int j = 0; j < 4; ++j) vn[j] = (r < rows) ? *(const f32x4*)(X + (size_t)r * 1024 + 4 * lane + 256 * j) : (f32x4){0.f, 0.f, 0.f, 0.f};
    for (; r < rows; r += stride) {
        const int bi = (r < ML) ? (r >> 12) : 8;
        const int myslot = slot_next; const int rn = r + stride;
        slot_next = (lane < 16 && rn < rows) ? INV[(size_t)rn * 16 + lane] : -1;
        f32x4 v[4], acc[4], g2v[4];
        const float* g2 = modv + (l * 9 + bi) * 6144 + 5 * 1024;
#pragma unroll
        for (int j = 0; j < 4; ++j) { v[j] = vn[j]; acc[j] = (f32x4){0.f, 0.f, 0.f, 0.f}; g2v[j] = *(const f32x4*)(g2 + 4 * lane + 256 * j); }
        unsigned mask = (unsigned)(__builtin_amdgcn_ballot_w64(myslot >= 0) & 0xffffull);
        bool first = true;
        while (mask || first) {
          if (mask) {
            const int e0 = __builtin_ctz(mask); mask &= mask - 1u; const int s0 = __builtin_amdgcn_readlane(myslot, e0);
            const bool has1 = mask != 0u; const int e1 = has1 ? __builtin_ctz(mask) : e0; if (has1) mask &= mask - 1u; const int s1 = __builtin_amdgcn_readlane(myslot, e1);
            const bf16* ya = Y + ((size_t)e0 * ME + s0) * 1024; const bf16* yb = Y + ((size_t)e1 * ME + s1) * 1024;
            u32x2 wa[4], wb[4];
#pragma unroll
            for (int j = 0; j < 4; ++j) wa[j] = *(const u32x2*)(ya + 4 * lane + 256 * j);
#pragma unroll
            for (int j = 0; j < 4; ++j) wb[j] = *(const u32x2*)(yb + 4 * lane + 256 * j);
            if (first && rn < rows) {
#pragma unroll
                for (int j = 0; j < 4; ++j) vn[j] = *(const f32x4*)(X + (size_t)rn * 1024 + 4 * lane + 256 * j); }
            first = false;
            const float kb = has1 ? 1.0f : 0.0f;
#pragma unroll
            for (int j = 0; j < 4; ++j) { acc[j] += (f32x4){bflo(wa[j].x), bfhi(wa[j].x), bflo(wa[j].y), bfhi(wa[j].y)}; acc[j] += (f32x4){bflo(wb[j].x), bfhi(wb[j].x), bflo(wb[j].y), bfhi(wb[j].y)} * kb; }
          } else {
            if (rn < rows) {
#pragma unroll
                for (int j = 0; j < 4; ++j) vn[j] = *(const f32x4*)(X + (size_t)rn * 1024 + 4 * lane + 256 * j); }
            first = false;
          }
        }
#pragma unroll
        for (int j = 0; j < 4; ++j) v[j] = v[j] + g2v[j] * acc[j];
        if (l == 0) {
#pragma unroll
            for (int j = 0; j < 4; ++j) *(f32x4*)(X + (size_t)r * 1024 + 4 * lane + 256 * j) = v[j];
            const float rs = row_rs(v); f32x4 h[4];
            norm_mod(v, rs, p->norm1_g + 1024, modv + (9 + bi) * 6144, modv + (9 + bi) * 6144 + 1024, h, lane);
            store_h(h, H + (size_t)r * 1024, lane);
        } else {
#pragma unroll
            for (int j = 0; j < 4; ++j) *(f32x4*)(p->out + (size_t)r * 1024 + 4 * lane + 256 * j) = v[j];
        }
    }
    if (l == 0) convert_small(p, 1, lds, lane, wave, bid, G);
}

#define XB_TMO      128
#define XB_XCNT(j)  (256  + 64 * (j))
#define XB_XSUB(j)  (1280 + 64 * (j))
#define XB_XGEN(j)  (2304 + 64 * (j))
#define XB_TOP      3328
#define XB_TOPGEN   3392
#define XCD_BAR_WORDS 3456
#define XB_SPIN_CAP (1u << 18)

__device__ __forceinline__ unsigned xb_ld(unsigned* p)              { return __hip_atomic_load(p, __ATOMIC_RELAXED, __HIP_MEMORY_SCOPE_AGENT); }
__device__ __forceinline__ unsigned xb_add(unsigned* p, unsigned v) { return __hip_atomic_fetch_add(p, v, __ATOMIC_RELAXED, __HIP_MEMORY_SCOPE_AGENT); }
__device__ __forceinline__ unsigned xb_xcc_id() { return (unsigned)__builtin_amdgcn_s_getreg((3 << 11) | 20) & 0xFu; }
#define XB_SPIN(cond, bar) do { unsigned _sp = 0; while (cond) { __builtin_amdgcn_s_sleep(1); \
    if ((++_sp & 255u) == 0u) { if (xb_ld(&(bar)[XB_TMO])) break; if (_sp > XB_SPIN_CAP) { atomicAdd(&(bar)[XB_TMO], 1u); break; } } } } while (0)

struct XcdBarrier {
    unsigned* bar; unsigned x;
    volatile LAS unsigned* st;
};

__device__ __forceinline__ XcdBarrier xcd_barrier_post(unsigned* bar, volatile LAS unsigned* st) {
    XcdBarrier b; b.bar = bar; b.x = xb_xcc_id(); b.st = st;
    if (threadIdx.x == 0) (void)xb_add(&bar[XB_XCNT(b.x)], 1u);
    return b;
}
__device__ __forceinline__ void xcd_barrier_complete(unsigned* bar, unsigned x, unsigned& nloc, unsigned& nx) {
    const unsigned G = gridDim.x * gridDim.y * gridDim.z;
    unsigned sum, cnt, mine, sp = 0u;
    for (;;) {
        sum = 0u; cnt = 0u; mine = 0u;
#pragma unroll
        for (unsigned j = 0; j < 16; ++j) { const unsigned c = xb_ld(&bar[XB_XCNT(j)]); sum += c; cnt += (c > 0u) ? 1u : 0u; mine = (j == x) ? c : mine; }
        if (sum == G) break;
        __builtin_amdgcn_s_sleep(1);
        if ((++sp & 255u) == 0u) { if (xb_ld(&bar[XB_TMO])) break; if (sp > XB_SPIN_CAP) { atomicAdd(&bar[XB_TMO], 1u); break; } }
    }
    nloc = mine > 0u ? mine : 1u; nx = cnt > 0u ? cnt : 1u;
}

__device__ __forceinline__ void xcd_barrier(const XcdBarrier& b) {
    asm volatile("s_waitcnt vmcnt(0)" ::: "memory");
    __syncthreads();
    if (threadIdx.x == 0) {
        unsigned* bar = b.bar;
        __builtin_amdgcn_s_waitcnt(0);
        unsigned nloc = b.st[0], nx = b.st[1];
        if (nloc == 0u) { xcd_barrier_complete(bar, b.x, nloc, nx); b.st[0] = nloc; b.st[1] = nx; }
        const unsigned old = xb_add(&bar[XB_XSUB(b.x)], 1u);
        const unsigned gen = old / nloc;
        if (old + 1u == (gen + 1u) * nloc) {
            __builtin_amdgcn_fence(__ATOMIC_RELEASE, "agent");
            asm volatile("s_waitcnt vmcnt(0)" ::: "memory");
            const unsigned og = xb_add(&bar[XB_TOP], 1u);
            const unsigned tg = og / nx;
            if (og + 1u == (tg + 1u) * nx) xb_add(&bar[XB_TOPGEN], 1u);
            else XB_SPIN(xb_ld(&bar[XB_TOPGEN]) == tg, bar);
            __builtin_amdgcn_fence(__ATOMIC_ACQUIRE, "agent");
            xb_add(&bar[XB_XGEN(b.x)], 1u);
            asm volatile("s_waitcnt vmcnt(0)" ::: "memory");
        } else {
            XB_SPIN(xb_ld(&bar[XB_XGEN(b.x)]) == gen, bar);
            __builtin_amdgcn_fence(__ATOMIC_ACQUIRE, "agent");
            asm volatile("s_waitcnt vmcnt(0)" ::: "memory");
        }
    }
    __syncthreads();
}

#ifndef REP_GZA
#define REP_GZA 1
#endif
#ifndef REP_GG
#define REP_GG 1
#endif
#ifndef REP_GMRG
#define REP_GMRG 1
#endif
#ifndef REP_GM1
#define REP_GM1 1
#endif
#ifndef REP_GM2
#define REP_GM2 1
#endif
#ifndef REP_ATT
#define REP_ATT 1
#endif
#ifndef REP_UPD
#define REP_UPD 1
#endif
#ifndef REP_SGU
#define REP_SGU 1
#endif
#ifndef REP_SCAN
#define REP_SCAN 1
#endif
#ifndef REP_PRE
#define REP_PRE 1
#endif
#ifndef REP_CMB
#define REP_CMB 1
#endif
#ifndef REP_MIX
#define REP_MIX 1
#endif
#ifndef REP_RO
#define REP_RO 1
#endif
#ifndef REP_N2
#define REP_N2 1
#endif
#ifndef REP_GEMM
#define REP_GEMM 1
#endif
#ifndef REP_SYNC
#define REP_SYNC 1
#endif
#ifndef EN_GEMM
#define EN_GEMM 0x3f
#endif
#ifndef EN_ATT
#define EN_ATT 1
#endif
#ifndef EN_UPD
#define EN_UPD 1
#endif
#ifndef EN_SGU
#define EN_SGU 1
#endif
#ifndef EN_RO
#define EN_RO 1
#endif
#ifndef EN_MISC
#define EN_MISC 1
#endif
#define KPP() ({ KPC q_ = kp_; asm volatile("" : "+s"(q_)); q_; })
__global__ void __launch_bounds__(512, 2) mk_fwd(KP p_unused) {
    extern __shared__ __attribute__((aligned(16))) unsigned char lds_raw[];
    LAS unsigned char* lds = (LAS unsigned char*)lds_raw;
    cg::grid_group grid = cg::this_grid();
    const int bid = blockIdx.x, G = gridDim.x;
#define IDS() int tid = threadIdx.x; asm volatile("" : "+v"(tid)); const int lane = tid & 63, wave = __builtin_amdgcn_readfirstlane(tid >> 6); (void)lane; (void)wave
    const KPC kp_ = (KPC)__builtin_amdgcn_kernarg_segment_ptr();
    volatile LAS unsigned* bst = (volatile LAS unsigned*)(lds + 147392);
    if (threadIdx.x < 16) bst[threadIdx.x] = 0u;
    __syncthreads();
    (void)xcd_barrier_post((unsigned*)KPP()->ws, bst);
#ifdef PROBE_WAIT
    unsigned long long wacc = 0ull;
#define GSYNC() do { const unsigned long long t0_ = __builtin_amdgcn_s_memrealtime(); XcdBarrier b_; b_.bar = (unsigned*)KPP()->ws; b_.x = xb_xcc_id(); b_.st = bst; xcd_barrier(b_); wacc += __builtin_amdgcn_s_memrealtime() - t0_; } while (0)
#else
#define GSYNC() do { XcdBarrier b_; b_.bar = (unsigned*)KPP()->ws; b_.x = xb_xcc_id(); b_.st = bst; xcd_barrier(b_); } while (0)
#endif

    { IDS(); for (int rep = 0; rep < REP_PRE; ++rep) { phase_prep(KPP(), lds, tid, lane, wave, bid, G); __syncthreads(); } }
    grid.sync();
    { IDS(); for (int rep = 0; rep < REP_PRE; ++rep) phase_norm_in(KPP(), lane, wave, bid, G); }
    GSYNC();
#pragma unroll 1
    for (int l = 0; l < 2; ++l) {
        {
            unsigned char* ws = KPP()->ws;
            pg8::Gemm g{(const pg8::bf16_t*)(ws + WS_H), (const pg8::bf16_t*)(ws + WS_WTIN), M, NZA, 1024}; GroupOrder S{1, M / 256, NZA / 256, 0, 0, G, bid};
            EpiZA E{(bf16*)(ws + WS_ZA)};
            for (int rep = 0; rep < REP_GEMM * REP_GZA; ++rep) pg8::gemm_phase<EpiZA, GroupOrder, true, true>(lds, g, S, E);
#ifdef PROBE_ZA_HALF
            if (bid < PROBE_ZA_HALF) { GroupOrder S2{1, M / 256, NZA / 256, 0, 0, PROBE_ZA_HALF, bid}; pg8::gemm_phase<EpiZA, GroupOrder, true, true>(lds, g, S2, E); }
#endif
#ifdef PROBE_ZA_SLEEP
            { const unsigned long long t0 = __builtin_amdgcn_s_memrealtime(); while (__builtin_amdgcn_s_memrealtime() - t0 < 100000ull) __builtin_amdgcn_s_sleep(64); __syncthreads(); for (int rep = 0; rep < PROBE_ZA_SLEEP; ++rep) pg8::gemm_phase<EpiZA, GroupOrder, true, true>(lds, g, S, E); }
#endif
#ifdef PROBE_ZA_NULL
            { EpiNull En; pg8::gemm_phase<EpiNull, GroupOrder, true, true>(lds, g, S, En); }
#endif
        }
        GSYNC();
        {
            KPC p = KPP(); IDS();
            float mq = fabsf(p->qn_g[l * 64 + lane]), mk = fabsf(p->kn_g[l * 64 + lane]);
            mq = wave_max(mq); mk = wave_max(mk);
            const float Mb2 = 8.0f * mq * mk * LOG2E;
            const int natt = (l == 0) ? 544 : 512, nupd = NB * NCH * 4, nvp = (l == 0) ? (M / 128) : (ML / 128);
            for (int rep = 0; rep < REP_MIX; ++rep)
            for (int it = bid; it < natt + nupd + nvp; it += G) {
                if (it < natt) { for (int q = 0; q < REP_ATT; ++q) att_item(p, l, lds, it, Mb2, tid, lane, wave); }
                else if (it < natt + nupd) { for (int q = 0; q < REP_UPD; ++q) ret_upd_item(p, l, lds, it - natt, tid, lane, wave); }
                else { for (int q = 0; q < REP_SGU; ++q) sgu_vprep_item(p, it - natt - nupd, tid); }
            }
        }
        GSYNC();
        { IDS(); for (int rep = 0; rep < REP_RO * REP_SCAN; ++rep) phase_scan(KPP(), l, tid, bid, G); }
        GSYNC();
        {   KPC p = KPP(); IDS(); const int nch = (l == 0) ? NCH : 32;
            const int nro = NB * nch * 4, nsgu = ((l == 0) ? (M / 128) : (ML / 128)) * 4;
            for (int rep = 0; rep < REP_RO; ++rep)
            for (int it = bid; it < nro + nsgu; it += G) {
                if (it < nro) { const int b = it / (nch * 4), rem = it % (nch * 4); ret_out_item(p, l, lds, b * (NCH * 4) + rem, tid, lane, wave); }
                else sgu_item(p, l, lds, it - nro, tid, lane, wave);
            }
        }
        GSYNC();
        const int Mrows = (l == 0) ? M : ML;
        {
            unsigned char* ws = KPP()->ws;
            pg8::Gemm g{(const pg8::bf16_t*)(ws + WS_H), (const pg8::bf16_t*)(ws + WS_WTIN) + (size_t)NZA * 1024, Mrows, NZG, 1024}; GroupOrder S{1, Mrows / 256, NZG / 256, 0, 0, G, bid};
            EpiSig E{(bf16*)(ws + WS_G)};
            for (int rep = 0; rep < REP_GEMM * REP_GG; ++rep) pg8::gemm_phase<EpiSig, GroupOrder, true, true>(lds, g, S, E);
            if (l == 0 && G == 256 && bid >= CVT_G_IDLE0) { IDS(); convert_experts(KPP(), 0, 0, CVT_G_HI, (bid - CVT_G_IDLE0) * 8 + wave, (256 - CVT_G_IDLE0) * 8, lds, lane, wave); }
        }
        GSYNC();
        {
            KPC p = KPP(); unsigned char* ws = p->ws;
            pg8::Gemm g{(const pg8::bf16_t*)p->out, (const pg8::bf16_t*)(ws + WS_WTBR), 3 * M, 3072, 512}; MergeOrder S{Mrows / 256, G, bid};
            EpiMergeChain E{(const bf16*)(ws + WS_G), (bf16*)(ws + WS_H)};
            for (int rep = 0; rep < REP_GEMM * REP_GMRG; ++rep) pg8::gemm_phase<EpiMergeChain, MergeOrder, true, true>(lds, g, S, E);
            if (l == 0 && G == 256 && bid >= CVT_M_IDLE0) { IDS(); convert_experts(KPP(), 0, CVT_G_HI, CVT_M_HI, (bid - CVT_M_IDLE0) * 8 + wave, (256 - CVT_M_IDLE0) * 8, lds, lane, wave); }
        }
        GSYNC();
        {
            KPC p = KPP(); unsigned char* ws = p->ws;
            pg8::Gemm g{(const pg8::bf16_t*)(ws + WS_H), (const pg8::bf16_t*)(ws + WS_WTOUT), Mrows, 1024, 1024}; GroupOrder S{1, Mrows / 256, 4, 0, 0, G, bid};
            EpiOut E{(l == 0) ? p->x : (const float*)(ws + WS_X), (l == 0) ? p->ctx : (const float*)(ws + WS_X) + (size_t)ML * 1024, (float*)(ws + WS_X), (const float*)(ws + WS_MODV) + l * 9 * 6144};
            pg8::gemm_phase<EpiOut, GroupOrder, true, true>(lds, g, S, E);
            if (l == 0 && G == 256 && bid >= CVT_O_IDLE0) { IDS(); convert_experts(KPP(), 0, CVT_M_HI, CVT_ITEMS, (bid - CVT_O_IDLE0) * 8 + wave, (256 - CVT_O_IDLE0) * 8, lds, lane, wave); }
        }
        GSYNC();
        { IDS(); for (int rep = 0; rep < REP_N2; ++rep) { phase_norm2(KPP(), l, lds, tid, lane, wave, bid, G); __syncthreads(); } }
        GSYNC();
        { IDS(); for (int rep = 0; rep < REP_N2 * REP_TK; ++rep) phase_topk(KPP(), l, lds, tid, lane, wave, bid, G); }
        GSYNC();
        {
            unsigned char* ws = KPP()->ws;
            pg8::Gemm g{(const pg8::bf16_t*)(ws + WS_XS), (const pg8::bf16_t*)(ws + WS_WT1), NE * ME, NE * 2048, 1024}; GroupOrder S{NE, (l == 0) ? 17 : 16, 8, 17, 8, G, bid};
            EpiMoe1 E{(bf16*)(ws + WS_ACT)};
            for (int rep = 0; rep < REP_GEMM * REP_GM1; ++rep) pg8::gemm_phase<EpiMoe1, GroupOrder, true, true>(lds, g, S, E);
        }
        GSYNC();
        {
            unsigned char* ws = KPP()->ws;
            pg8::Gemm g{(const pg8::bf16_t*)(ws + WS_ACT), (const pg8::bf16_t*)(ws + WS_WT2), NE * ME, NE * 1024, 1024}; GroupOrder S{NE, (l == 0) ? 17 : 16, 4, 17, 4, G, bid};
            EpiMoe2 E{(bf16*)(ws + WS_XS), (const float*)(ws + WS_TOPW)};
            for (int rep = 0; rep < REP_GEMM * REP_GM2; ++rep) pg8::gemm_phase<EpiMoe2, GroupOrder, true, true>(lds, g, S, E);
        }
        GSYNC();
        { IDS(); for (int rep = 0; rep < ((l == 1) ? REP_CMB : 1); ++rep) phase_combine(KPP(), l, lds, tid, lane, wave, bid, G); }
        if (l == 0) GSYNC();
        for (int rep = 1; rep < REP_SYNC; ++rep) { for (int k = 0; k < 12; ++k) GSYNC(); }
    }
#ifdef PROBE_WAIT
    if (bid == PROBE_WAIT - 1) { const unsigned long long t0 = __builtin_amdgcn_s_memrealtime(); while (__builtin_amdgcn_s_memrealtime() - t0 < wacc) __builtin_amdgcn_s_sleep(8); }
#endif
}

extern "C" void kernel_launch(void* const* d_in, const int* in_sizes, int n_in, void* d_out, int out_size, void* d_ws, size_t ws_size, hipStream_t stream) {
    static int grid = 0;
    if (grid == 0) {
        if (n_in != 22 || out_size != ML * D || ws_size < WS_END) { fprintf(stderr, "kernel_launch: unexpected shapes (n_in %d out %d ws %zu, need %zu)\n", n_in, out_size, ws_size, (size_t)WS_END); grid = -1; return; }
        int dev = 0, cus = 0, per_cu = 0;
        if (hipGetDevice(&dev) != hipSuccess || hipDeviceGetAttribute(&cus, hipDeviceAttributeMultiprocessorCount, dev) != hipSuccess) { grid = -1; return; }
        if (hipFuncSetAttribute((const void*)mk_fwd, hipFuncAttributeMaxDynamicSharedMemorySize, LDS_BYTES) != hipSuccess) { fprintf(stderr, "kernel_launch: hipFuncSetAttribute failed\n"); grid = -1; return; }
        if (hipOccupancyMaxActiveBlocksPerMultiprocessor(&per_cu, (const void*)mk_fwd, 512, LDS_BYTES) != hipSuccess || per_cu < 1) { fprintf(stderr, "kernel_launch: occupancy query says %d\n", per_cu); (void)hipGetLastError(); }
        grid = cus;
        fprintf(stderr, "kernel_launch: grid %d, occupancy %d/CU, ws %zu\n", grid, per_cu, ws_size);
    }
    if (grid < 0) return;
    if (hipMemsetAsync(d_ws, 0, 16384, stream) != hipSuccess) { fprintf(stderr, "kernel_launch: memset failed\n"); return; }
    KP hp{};
    const float** f = (const float**)&hp;
    for (int i = 0; i < 22; ++i) f[i] = (const float*)d_in[i];
    hp.out = (float*)d_out; hp.ws = (unsigned char*)d_ws;
    void* args[] = {&hp};
    hipError_t e = hipLaunchCooperativeKernel((const void*)mk_fwd, dim3(grid), dim3(512), args, LDS_BYTES, stream);
    if (e != hipSuccess) fprintf(stderr, "kernel_launch: cooperative launch failed: %s\n", hipGetErrorString(e));
}
```

```cpp
#include <hip/hip_runtime.h>
#include <hip/hip_cooperative_groups.h>
#include <cstdio>
#include <cstdint>
namespace cg = cooperative_groups;

namespace pg8 {
#define PG8_LAS __attribute__((address_space(3)))
typedef unsigned short bf16_t;
typedef short bf16x8 __attribute__((ext_vector_type(8)));
typedef float f32x4 __attribute__((ext_vector_type(4)));
typedef unsigned u32x4 __attribute__((ext_vector_type(4)));
constexpr int BM = 256, BK = 64, HALF = 128, HTB = HALF * BK * 2  , STAGE_BYTES = 8 * HTB, NXCD = 8, WGM = 8;

__host__ __device__ __forceinline__ int lds_byte(int r, int c) { const int st = (r >> 4) * 2 + (c >> 5), rr = r & 15, cc = c & 31, ob = rr * 64 + cc * 2; return st * 1024 + (ob ^ (((ob >> 9) & 1) << 5)); }
__host__ __device__ __forceinline__ void stage_rc(int b, int& R, int& C) { const int st = b / 1024, sb = b % 1024, swz = sb ^ (((sb >> 9) & 1) << 5); R = (st >> 1) * 16 + swz / 64; C = (st & 1) * 32 + (swz % 64) / 2; }
__host__ __device__ __forceinline__ int perm32(int rho) { const int n = rho >> 4, i = rho & 15; return 8 * (i >> 2) + 4 * n + (i & 3); }

struct Unit { int pm, pn; };
struct Gemm { const bf16_t* A; const bf16_t* Bt; int M, N, K; };

struct StaticOrder {
    int nM, nN, nwg, G, c;
    __host__ __device__ void init(int M, int N, int G_, int c_) { nM = M / BM; nN = N / BM; nwg = nM * nN; G = G_; c = c_; }
    __host__ __device__ bool next(int i, Unit& u) const {
        const long L = (long)i * G + c; if (L >= nwg) return false;
        int wgid = (int)L; { const int q = nwg / NXCD, r = nwg % NXCD, xcd = wgid % NXCD, off = wgid / NXCD; wgid = (xcd < r ? xcd * (q + 1) : r * (q + 1) + (xcd - r) * q) + off; }
        const int nig = WGM * nN, gid = wgid / nig, fm = gid * WGM, gsz = (nM - fm) < WGM ? (nM - fm) : WGM;
        u.pm = fm + ((wgid % nig) % gsz); u.pn = (wgid % nig) / gsz; return true;
    }
    __device__ __forceinline__ void a_ready(const Unit&) const {}
    __device__ __forceinline__ void done(const Unit&) const {}
};

__device__ __forceinline__ unsigned cvt_pk_bf16(float lo, float hi) { unsigned r; asm volatile("v_cvt_pk_bf16_f32 %0, %1, %2" : "=v"(r) : "v"(lo), "v"(hi)); return r; }
typedef float f32x2 __attribute__((ext_vector_type(2)));
__device__ __forceinline__ f32x2 gelu_pk(f32x2 v) {
    const f32x2 av = __builtin_elementwise_abs(v), d = av * 0.2316418882f + 1.0f;
    f32x2 t; t.x = __builtin_amdgcn_rcpf(d.x); t.y = __builtin_amdgcn_rcpf(d.y);
    f32x2 q = t * 0.5307027145f + (-0.7265760135f); q = q * t + 0.7107068705f; q = q * t + (-0.142248368f); q = q * t + 0.127414796f; q = q * t;
    const f32x2 s = (v * v) * (-0.72134752044f);
    f32x2 e; e.x = __builtin_amdgcn_exp2f(s.x); e.y = __builtin_amdgcn_exp2f(s.y);
    const f32x2 m = v * (q * e), r = v - m;
    f32x2 o; o.x = v.x < 0.f ? m.x : r.x; o.y = v.y < 0.f ? m.y : r.y; return o;
}

template <int ACT  > struct EpiBf16 {
    static constexpr bool PERM = true, AFTER_DRAIN = false, CHAIN = false; static_assert(ACT == 0 || ACT == 1, "EpiBf16: ACT is 0 (none) or 1 (gelu_pk)");
    bf16_t* O; int ldc; const float* bias; int split_cols; size_t split_stride; float scale0;
    __device__ __forceinline__ void operator()(const f32x4 (&acc)[2][2][4][2], const Unit& u, int wr, int wc, int fr, int fq) const {
        const int row0 = u.pm * BM + wr * 64 + fr; int colt = u.pn * BM; bf16_t* base = O;
        float sc = 1.f; if (split_cols) { const int t = colt / split_cols; base += (size_t)t * split_stride; colt -= t * split_cols; if (t == 0) sc = scale0; }
        const int col0 = colt + wc * 32 + 8 * fq, bcol0 = u.pn * BM + wc * 32 + 8 * fq;
        f32x4 bv[2][2];
#pragma unroll
        for (int bj = 0; bj < 2; ++bj)
#pragma unroll
            for (int n = 0; n < 2; ++n) bv[bj][n] = bias ? *(const f32x4*)(bias + bcol0 + bj * HALF + 4 * n) : (f32x4){0.f, 0.f, 0.f, 0.f};
#pragma unroll
        for (int ai = 0; ai < 2; ++ai)
#pragma unroll
            for (int m = 0; m < 4; ++m) { bf16_t* rowp = base + (size_t)(row0 + ai * HALF + m * 16) * ldc + col0;
#pragma unroll
                for (int bj = 0; bj < 2; ++bj) { f32x4 v0 = acc[ai][bj][m][0] + bv[bj][0], v1 = acc[ai][bj][m][1] + bv[bj][1];
                    if (ACT == 1) { f32x2 a = gelu_pk((f32x2){v0[0], v0[1]}), b = gelu_pk((f32x2){v0[2], v0[3]}), c = gelu_pk((f32x2){v1[0], v1[1]}), d = gelu_pk((f32x2){v1[2], v1[3]});
                        v0 = (f32x4){a.x, a.y, b.x, b.y}; v1 = (f32x4){c.x, c.y, d.x, d.y}; }
                    v0 = v0 * sc; v1 = v1 * sc; u32x4 w; w.x = cvt_pk_bf16(v0[0], v0[1]); w.y = cvt_pk_bf16(v0[2], v0[3]); w.z = cvt_pk_bf16(v1[0], v1[1]); w.w = cvt_pk_bf16(v1[2], v1[3]);
                    *(u32x4*)(rowp + bj * HALF) = w; } }
    }
};
template <class Epi, class Sched, bool ALIGN_EPI = false, bool SP2 = false>
__device__ __forceinline__ void gemm_phase(PG8_LAS unsigned char* lds, const Gemm g, const Sched& S, const Epi& E) {
    int tid_ = threadIdx.x; asm volatile("" : "+v"(tid_));
    const int tid = tid_, wid = __builtin_amdgcn_readfirstlane(tid >> 6), lane = tid & 63, wr = wid >> 2, wc = wid & 3, fr = lane & 15, fq = lane >> 4;
    const int K = g.K, nt = K / BK;
    unsigned voffA[2], voffB[2];
#pragma unroll
    for (int i = 0; i < 2; ++i) { int R, C; stage_rc(tid * 16 + i * 8192, R, C); const int Rb = Epi::PERM ? ((R & ~31) + perm32(R & 31)) : R;
        voffA[i] = (unsigned)(R * K + C) * 2u; voffB[i] = (unsigned)(Rb * K + C) * 2u; }
    const size_t kstep = (size_t)(BK * 2);
    const size_t hstep = (size_t)HALF * K * 2;
    const size_t tstep = 2 * hstep;
    const unsigned ldsw = (unsigned)wid * 1024u;
    const int aoff = lds_byte(wr * 64 + fr, fq * 8), boff = lds_byte(wc * 32 + fr, fq * 8);
#define PG8_SA(b, h) (((b) * 2 + (h)) * HTB)
#define PG8_SB(b, h) ((4 + (b) * 2 + (h)) * HTB)
#define PG8_STAGE(bufoff, gbase, voff) do { _Pragma("unroll") for (int _i = 0; _i < 2; ++_i) \
        __builtin_amdgcn_global_load_lds((const unsigned*)((const char*)(gbase) + (voff)[_i]), (PG8_LAS unsigned*)(lds + (bufoff) + ldsw + _i * 8192), 16, 0, 0); } while (0)
#define PG8_LDA(dst, b, h) do { _Pragma("unroll") for (int m = 0; m < 4; ++m) _Pragma("unroll") for (int k = 0; k < 2; ++k) dst[m][k] = *(const PG8_LAS bf16x8*)(lds + PG8_SA(b, h) + aoff + m * 2048 + k * 1024); } while (0)
#define PG8_LDB(dst, b, h) do { _Pragma("unroll") for (int n = 0; n < 2; ++n) _Pragma("unroll") for (int k = 0; k < 2; ++k) dst[n][k] = *(const PG8_LAS bf16x8*)(lds + PG8_SB(b, h) + boff + n * 2048 + k * 1024); } while (0)
#define PG8_MMA(ai, bj, At, Bt) do { __builtin_amdgcn_s_setprio(1); _Pragma("unroll") for (int m = 0; m < 4; ++m) _Pragma("unroll") for (int n = 0; n < 2; ++n) _Pragma("unroll") for (int k = 0; k < 2; ++k) \
        acc[ai][bj][m][n] = __builtin_amdgcn_mfma_f32_16x16x32_bf16(Bt[n][k], At[m][k], acc[ai][bj][m][n], 0, 0, 0); __builtin_amdgcn_s_setprio(0); } while (0)
#define PG8_WAIT_V(n) asm volatile("s_waitcnt vmcnt(" #n ")" ::: "memory")
#define PG8_WAIT_L(n) asm volatile("s_waitcnt lgkmcnt(" #n ")" ::: "memory")
#define PG8_BAR __builtin_amdgcn_s_barrier()
#define PG8_SCHED __builtin_amdgcn_sched_barrier(0)
    Unit cur, nxt; int ui = 0;
    if (!S.next(0, cur)) return;
    f32x4 acc[2][2][4][2];
#pragma unroll
    for (int a = 0; a < 2; ++a)
#pragma unroll
        for (int b = 0; b < 2; ++b)
#pragma unroll
            for (int m = 0; m < 4; ++m)
#pragma unroll
                for (int n = 0; n < 2; ++n) acc[a][b][m][n] = (f32x4){0.f, 0.f, 0.f, 0.f};
    bf16x8 At[4][2], B0[2][2], B1[2][2];
    const char* cA = (const char*)g.A + (size_t)cur.pm * tstep; const char* cB = (const char*)g.Bt + (size_t)cur.pn * tstep;
    S.a_ready(cur);
    if constexpr (SP2) {
        PG8_STAGE(PG8_SB(0, 0), cB, voffB); PG8_STAGE(PG8_SB(0, 1), cB + hstep, voffB); PG8_STAGE(PG8_SA(0, 0), cA, voffA); PG8_STAGE(PG8_SA(0, 1), cA + hstep, voffA);
        if (wr == 1) PG8_BAR;
        PG8_WAIT_V(2); PG8_BAR;
        PG8_STAGE(PG8_SB(1, 0), cB + kstep, voffB); PG8_STAGE(PG8_SA(1, 0), cA + kstep, voffA); PG8_STAGE(PG8_SB(1, 1), cB + hstep + kstep, voffB);
        PG8_WAIT_V(6); PG8_BAR;
    } else {
        PG8_STAGE(PG8_SB(0, 0), cB, voffB); PG8_STAGE(PG8_SA(0, 0), cA, voffA); PG8_STAGE(PG8_SB(0, 1), cB + hstep, voffB); PG8_STAGE(PG8_SA(0, 1), cA + hstep, voffA);
        if (wr == 1) PG8_BAR;
        PG8_WAIT_V(4); PG8_BAR;
        PG8_STAGE(PG8_SB(1, 0), cB + kstep, voffB); PG8_STAGE(PG8_SA(1, 0), cA + kstep, voffA); PG8_STAGE(PG8_SB(1, 1), cB + hstep + kstep, voffB);
        PG8_WAIT_V(6); PG8_BAR;
    }
    for (;;) {
        const bool has_next = S.next(ui + 1, nxt);
        const char* nA = has_next ? (const char*)g.A + (size_t)nxt.pm * tstep : cA; const char* nB = has_next ? (const char*)g.Bt + (size_t)nxt.pn * tstep : cB;
        for (int t = 0; t < nt; t += 2) {
            const bool last = (t == nt - 2);
            const char* a1 = cA + (size_t)(t + 1) * kstep;
            const char* a2 = last ? nA : cA + (size_t)(t + 2) * kstep; const char* b2 = last ? nB : cB + (size_t)(t + 2) * kstep;
            const char* a3 = a2 + kstep; const char* b3 = b2 + kstep;
            if (last && has_next) S.a_ready(nxt);
            if constexpr (SP2) {
            PG8_LDB(B0, 0, 0); PG8_LDB(B1, 0, 1); PG8_SCHED; PG8_LDA(At, 0, 0); PG8_STAGE(PG8_SA(1, 1), a1 + hstep, voffA);
            PG8_WAIT_V(8); PG8_WAIT_L(0); PG8_BAR; PG8_MMA(0, 0, At, B0); PG8_MMA(0, 1, At, B1); PG8_BAR; PG8_SCHED;
            PG8_LDA(At, 0, 1); PG8_STAGE(PG8_SB(0, 0), b2, voffB); PG8_STAGE(PG8_SB(0, 1), b2 + hstep, voffB); PG8_STAGE(PG8_SA(0, 0), a2, voffA);
            PG8_WAIT_V(8); PG8_WAIT_L(0); PG8_BAR; PG8_MMA(1, 0, At, B0); PG8_MMA(1, 1, At, B1); PG8_BAR; PG8_SCHED;
            PG8_LDB(B0, 1, 0); PG8_LDB(B1, 1, 1); PG8_SCHED; PG8_LDA(At, 1, 0); PG8_STAGE(PG8_SA(0, 1), a2 + hstep, voffA);
            PG8_WAIT_V(8); PG8_WAIT_L(0); PG8_BAR; PG8_MMA(0, 0, At, B0); PG8_MMA(0, 1, At, B1); PG8_BAR; PG8_SCHED;
            PG8_LDA(At, 1, 1); PG8_STAGE(PG8_SB(1, 0), b3, voffB); PG8_STAGE(PG8_SB(1, 1), b3 + hstep, voffB); PG8_STAGE(PG8_SA(1, 0), a3, voffA);
            PG8_WAIT_V(8); PG8_WAIT_L(0); PG8_BAR; PG8_MMA(1, 0, At, B0); PG8_MMA(1, 1, At, B1); PG8_BAR; PG8_SCHED;
            } else {
            PG8_LDB(B0, 0, 0); PG8_SCHED; PG8_LDA(At, 0, 0); PG8_STAGE(PG8_SA(1, 1), a1 + hstep, voffA);
            PG8_WAIT_L(8); PG8_BAR; PG8_WAIT_L(0); PG8_MMA(0, 0, At, B0); PG8_BAR; PG8_SCHED;
            PG8_LDB(B1, 0, 1); PG8_STAGE(PG8_SB(0, 0), b2, voffB);
            PG8_BAR; PG8_WAIT_L(0); PG8_MMA(0, 1, At, B1); PG8_BAR;
            PG8_LDA(At, 0, 1); PG8_STAGE(PG8_SA(0, 0), a2, voffA);
            PG8_BAR; PG8_WAIT_L(0); PG8_MMA(1, 0, At, B0); PG8_BAR; PG8_SCHED;
            PG8_STAGE(PG8_SB(0, 1), b2 + hstep, voffB);
            PG8_WAIT_V(6); PG8_BAR; PG8_MMA(1, 1, At, B1); PG8_BAR;
            PG8_LDB(B0, 1, 0); PG8_SCHED; PG8_LDA(At, 1, 0); PG8_STAGE(PG8_SA(0, 1), a2 + hstep, voffA);
            PG8_WAIT_L(8); PG8_BAR; PG8_WAIT_L(0); PG8_MMA(0, 0, At, B0); PG8_BAR; PG8_SCHED;
            PG8_LDB(B1, 1, 1); PG8_STAGE(PG8_SB(1, 0), b3, voffB);
            PG8_BAR; PG8_WAIT_L(0); PG8_MMA(0, 1, At, B1); PG8_BAR;
            PG8_LDA(At, 1, 1); PG8_STAGE(PG8_SA(1, 0), a3, voffA);
            PG8_BAR; PG8_WAIT_L(0); PG8_MMA(1, 0, At, B0); PG8_BAR; PG8_SCHED;
            PG8_STAGE(PG8_SB(1, 1), b3 + hstep, voffB);
            PG8_WAIT_V(6); PG8_BAR; PG8_MMA(1, 1, At, B1); PG8_BAR;
            }
        }
        if constexpr (ALIGN_EPI) { if (wr == 0) PG8_BAR; }
        bool keep_acc = false;
        if constexpr (Epi::CHAIN) { keep_acc = E.chain(acc, cur, wr, wc, fr, fq); S.done(cur); }
        else if constexpr (!Epi::AFTER_DRAIN) { E(acc, cur, wr, wc, fr, fq); S.done(cur); }
        if (!has_next) break;
        if (!keep_acc) {
#pragma unroll
        for (int a = 0; a < 2; ++a)
#pragma unroll
            for (int b = 0; b < 2; ++b)
#pragma unroll
                for (int m = 0; m < 4; ++m)
#pragma unroll
                    for (int n = 0; n < 2; ++n) acc[a][b][m][n] = (f32x4){0.f, 0.f, 0.f, 0.f};
        }
        cur = nxt; cA = nA; cB = nB; ++ui;
        if constexpr (ALIGN_EPI) { if (wr == 1) PG8_BAR; }
    }
    PG8_WAIT_V(0);
    if constexpr (!ALIGN_EPI) { if (wr == 0) PG8_BAR; }
    PG8_BAR;
    if constexpr (Epi::AFTER_DRAIN) { E.fused(acc, cur, wr, wc, fr, fq, lds, wid, lane); S.done(cur); }
#undef PG8_SA
#undef PG8_SB
#undef PG8_STAGE
#undef PG8_LDA
#undef PG8_LDB
#undef PG8_MMA
#undef PG8_WAIT_V
#undef PG8_WAIT_L
#undef PG8_BAR
#undef PG8_SCHED
}
}

#define LAS __attribute__((address_space(3)))
typedef unsigned short bf16;
typedef short bf16x8 __attribute__((ext_vector_type(8)));
typedef float f32x4 __attribute__((ext_vector_type(4)));
typedef unsigned u32x4 __attribute__((ext_vector_type(4)));
typedef unsigned u32x2 __attribute__((ext_vector_type(2)));

constexpr int D = 1024, NB = 8, T = 4096, CL = 256;
constexpr int ML = NB * T, MC = NB * CL, M = ML + MC;
constexpr int NZA = 3328, NZG = 3072;
constexpr int C_RQ = 0, C_RK = 256, C_RV = 512, C_RG = 1024, C_SU = 1536, C_SV = 2048, C_AQ = 2560, C_AK = 3072, C_AV = 3200;
constexpr int NE = 16, CAPL = 512, CAPC = 32, ME = NB * (CAPL + CAPC);
constexpr int NCH = 34;
constexpr float EPS = 1e-6f, LOG2E = 1.4426950408889634f;
constexpr int LDS_BYTES = 147456;

constexpr size_t MiB = 1u << 20;
constexpr size_t WS_ROPEC = 1 * MiB, WS_ROPES = 1 * MiB + 512 * 1024, WS_MODV = 2 * MiB, WS_AFF = 3 * MiB, WS_AFFC = 5 * MiB, WS_INV = 6 * MiB, WS_TOPW = 9 * MiB;
constexpr size_t WS_WTIN = 16 * MiB, WS_WTBR = WS_WTIN + (size_t)6400 * 1024 * 2, WS_WTOUT = WS_WTBR + (size_t)3072 * 512 * 2;
constexpr size_t WS_X = 34 * MiB, WS_H = 170 * MiB, WS_R = 238 * MiB;
constexpr size_t WS_ZA = WS_R, WS_G = WS_R, WS_RS = 459 * MiB, WS_ST = 527 * MiB;
constexpr size_t WS_XS = WS_R, WS_ACT = 374 * MiB, WS_WT1 = 510 * MiB, WS_WT2 = 574 * MiB, WS_END = 606 * MiB;
static_assert(WS_WTOUT + 2 * MiB <= WS_X && WS_ZA + (size_t)M * NZA * 2 <= WS_RS && WS_ST + (size_t)NB * 4 * NCH * 128 * 128 * 2 <= WS_END, "ws map");

struct KP {
    const float *x, *c, *ctx, *c_ctx, *w_mod, *b_mod, *norm1_g, *norm2_g, *w_in, *dec_f, *dec_b, *sgu_w, *sgu_b, *qn_g, *kn_g, *sink, *w_branch, *w_out, *w_router, *w_eg, *w_eu, *w_ed;
    float* out; unsigned char* ws;
};
typedef const __attribute__((address_space(4))) KP* KPC;

#define LDS_WAIT() asm volatile("s_waitcnt lgkmcnt(0)" ::: "memory")
__device__ __forceinline__ unsigned pk2(float lo, float hi) { return pg8::cvt_pk_bf16(lo, hi); }
__device__ __forceinline__ float bflo(unsigned w) { return __uint_as_float(w << 16); }
__device__ __forceinline__ float bfhi(unsigned w) { return __uint_as_float(w & 0xffff0000u); }
__device__ __forceinline__ void unpack8(const u32x4 w, float (&f)[8]) { f[0] = bflo(w.x); f[1] = bfhi(w.x); f[2] = bflo(w.y); f[3] = bfhi(w.y); f[4] = bflo(w.z); f[5] = bfhi(w.z); f[6] = bflo(w.w); f[7] = bfhi(w.w); }
__device__ __forceinline__ u32x4 pack8(const float (&f)[8]) { u32x4 o; o.x = pk2(f[0], f[1]); o.y = pk2(f[2], f[3]); o.z = pk2(f[4], f[5]); o.w = pk2(f[6], f[7]); return o; }
template <int MASK> __device__ __forceinline__ float swz_xor(float v) { static_assert(MASK > 0 && MASK < 32, "swz_xor: 1..31"); return __builtin_bit_cast(float, __builtin_amdgcn_ds_swizzle(__builtin_bit_cast(int, v), 0x1f | (MASK << 10))); }
template <int MASK> __device__ __forceinline__ int swz_xor_i(int v) { return __builtin_amdgcn_ds_swizzle(v, 0x1f | (MASK << 10)); }
__device__ __forceinline__ float sum_x32(float v) { const unsigned u = __builtin_bit_cast(unsigned, v); auto r = __builtin_amdgcn_permlane32_swap(u, u, false, false); return __builtin_bit_cast(float, (unsigned)r[0]) + __builtin_bit_cast(float, (unsigned)r[1]); }
__device__ __forceinline__ float max_x32(float v) { const unsigned u = __builtin_bit_cast(unsigned, v); auto r = __builtin_amdgcn_permlane32_swap(u, u, false, false); return fmaxf(__builtin_bit_cast(float, (unsigned)r[0]), __builtin_bit_cast(float, (unsigned)r[1])); }
__device__ __forceinline__ int sum_x32_i(int v) { auto r = __builtin_amdgcn_permlane32_swap((unsigned)v, (unsigned)v, false, false); return (int)r[0] + (int)r[1]; }
__device__ __forceinline__ float wave_sum(float v) { v += swz_xor<1>(v); v += swz_xor<2>(v); v += swz_xor<4>(v); v += swz_xor<8>(v); v += swz_xor<16>(v); return sum_x32(v); }
__device__ __forceinline__ float wave_max(float v) { v = fmaxf(v, swz_xor<1>(v)); v = fmaxf(v, swz_xor<2>(v)); v = fmaxf(v, swz_xor<4>(v)); v = fmaxf(v, swz_xor<8>(v)); v = fmaxf(v, swz_xor<16>(v)); return max_x32(v); }
__device__ __forceinline__ int wave_sum_i(int v) { v += swz_xor_i<1>(v); v += swz_xor_i<2>(v); v += swz_xor_i<4>(v); v += swz_xor_i<8>(v); v += swz_xor_i<16>(v); return sum_x32_i(v); }
__device__ __forceinline__ float sum_x16_x32(float v) { v += swz_xor<16>(v); return sum_x32(v); }
__device__ __forceinline__ float sum_x1_x2(float v) { v += swz_xor<1>(v); v += swz_xor<2>(v); return v; }
__device__ __forceinline__ float ex2(float x) { return __builtin_amdgcn_exp2f(x); }
__device__ __forceinline__ float sigmoidf_(float x) { return 1.f / (1.f + ex2(-x * LOG2E)); }
__device__ __forceinline__ float gelu_tanh(float x) { const float u = 0.7978845608028654f * (x + 0.044715f * x * x * x); return x / (1.f + ex2(-2.f * LOG2E * u)); }
__device__ __forceinline__ f32x4 mfma16(bf16x8 a, bf16x8 b, f32x4 c) { return __builtin_amdgcn_mfma_f32_16x16x32_bf16(a, b, c, 0, 0, 0); }
__device__ __forceinline__ bf16x8 as_bf16x8(u32x4 w) { return __builtin_bit_cast(bf16x8, w); }
__device__ __forceinline__ float log2_sigmoid(float a) { return -log1pf(__expf(-a)) * LOG2E; }

#ifndef WGM_
#define WGM_ 8
#endif
struct GroupOrder {
    int nG, nM, nN, pmS, pnS, G, c;
    __device__ __forceinline__ bool next(int i, pg8::Unit& u) const {
        const long L = (long)i * G + c; const int tot = nG * nM * nN; if (L >= tot) return false;
        int wgid = (int)L; { const int q = tot / 8, r = tot % 8, xcd = wgid % 8, off = wgid / 8; wgid = (xcd < r ? xcd * (q + 1) : r * (q + 1) + (xcd - r) * q) + off; }
        const int per = nM * nN, g = wgid / per, rem = wgid - g * per;
        const int nig = WGM_ * nN, gid = rem / nig, fm = gid * WGM_, gsz = (nM - fm) < WGM_ ? (nM - fm) : WGM_;
        u.pm = g * pmS + fm + ((rem % nig) % gsz); u.pn = g * pnS + (rem % nig) / gsz; return true;
    }
    __device__ __forceinline__ void a_ready(const pg8::Unit&) const {}
    __device__ __forceinline__ void done(const pg8::Unit&) const {}
};
struct MergeOrder {
    int nM, G, c;
    __device__ __forceinline__ bool next(int i, pg8::Unit& u) const {
        const int ii = i / 3, g = i - 3 * ii; const long L = (long)ii * G + c; const int tot = nM * 4; if (L >= tot) return false;
        int wgid = (int)L; { const int q = tot / 8, r = tot % 8, xcd = wgid % 8, off = wgid / 8; wgid = (xcd < r ? xcd * (q + 1) : r * (q + 1) + (xcd - r) * q) + off; }
        const int nig = 32, gid = wgid / nig, fm = gid * 8, gsz = (nM - fm) < 8 ? (nM - fm) : 8;
        u.pm = g * (M / 256) + fm + ((wgid % nig) % gsz); u.pn = g * 4 + (wgid % nig) / gsz; return true;
    }
    __device__ __forceinline__ void a_ready(const pg8::Unit&) const {}
    __device__ __forceinline__ void done(const pg8::Unit&) const {}
};

struct EpiZA {
    static constexpr bool PERM = true, AFTER_DRAIN = false, CHAIN = false;
    bf16* O;
    __device__ __forceinline__ void operator()(const f32x4 (&acc)[2][2][4][2], const pg8::Unit& u, int wr, int wc, int fr, int fq) const {
        const int row0 = u.pm * 256 + wr * 64 + fr, col0 = u.pn * 256 + wc * 32 + 8 * fq; const bool act = false;
#pragma unroll
        for (int ai = 0; ai < 2; ++ai)
#pragma unroll
            for (int m = 0; m < 4; ++m) { bf16* rowp = O + (size_t)(row0 + ai * 128 + m * 16) * NZA + col0;
#pragma unroll
                for (int bj = 0; bj < 2; ++bj) { const f32x4 v0 = acc[ai][bj][m][0], v1 = acc[ai][bj][m][1];
                    float o[8] = {v0[0], v0[1], v0[2], v0[3], v1[0], v1[1], v1[2], v1[3]};
                    if (act) {
#pragma unroll
                        for (int k = 0; k < 8; ++k) o[k] = gelu_tanh(o[k]); }
                    *(u32x4*)(rowp + bj * 128) = pack8(o); } }
    }
};
struct EpiNull {
    static constexpr bool PERM = true, AFTER_DRAIN = false, CHAIN = false;
    __device__ __forceinline__ void operator()(const f32x4 (&acc)[2][2][4][2], const pg8::Unit& u, int wr, int wc, int fr, int fq) const {
#pragma unroll
        for (int ai = 0; ai < 2; ++ai)
#pragma unroll
            for (int m = 0; m < 4; ++m)
#pragma unroll
                for (int bj = 0; bj < 2; ++bj) { asm volatile("" :: "v"(acc[ai][bj][m][0]), "v"(acc[ai][bj][m][1])); }
    }
};
struct EpiSig {
    static constexpr bool PERM = true, AFTER_DRAIN = false, CHAIN = false;
    bf16* O;
    __device__ __forceinline__ void operator()(const f32x4 (&acc)[2][2][4][2], const pg8::Unit& u, int wr, int wc, int fr, int fq) const {
        const int row0 = u.pm * 256 + wr * 64 + fr, col0 = u.pn * 256 + wc * 32 + 8 * fq;
#pragma unroll
        for (int ai = 0; ai < 2; ++ai)
#pragma unroll
            for (int m = 0; m < 4; ++m) { bf16* rowp = O + (size_t)(row0 + ai * 128 + m * 16) * NZG + col0;
#pragma unroll
                for (int bj = 0; bj < 2; ++bj) { const f32x4 v0 = acc[ai][bj][m][0], v1 = acc[ai][bj][m][1];
                    float o[8] = {v0[0], v0[1], v0[2], v0[3], v1[0], v1[1], v1[2], v1[3]};
#pragma unroll
                    for (int k = 0; k < 8; ++k) o[k] = fmaxf(sigmoidf_(o[k]), 1e-20f);
                    *(u32x4*)(rowp + bj * 128) = pack8(o); } }
    }
};
struct EpiMergeChain {
    static constexpr bool PERM = true, AFTER_DRAIN = false, CHAIN = true;
    const bf16* Gt; bf16* Hm;
    __device__ __forceinline__ bool chain(f32x4 (&acc)[2][2][4][2], const pg8::Unit& u, int wr, int wc, int fr, int fq) const {
        const int g = u.pm / (M / 256), m = u.pm - g * (M / 256), n = u.pn - g * 4;
        const int row0 = m * 256 + wr * 64 + fr, col0 = n * 256 + wc * 32 + 8 * fq;
#pragma unroll
        for (int ai = 0; ai < 2; ++ai) {
            u32x4 gw[4][2], hw[4][2];
#pragma unroll
            for (int mm = 0; mm < 4; ++mm)
#pragma unroll
                for (int bj = 0; bj < 2; ++bj) gw[mm][bj] = *(const u32x4*)(Gt + (size_t)(row0 + ai * 128 + mm * 16) * NZG + g * 1024 + col0 + bj * 128);
            if (g < 2) {
#pragma unroll
                for (int mm = 0; mm < 4; ++mm)
#pragma unroll
                    for (int bj = 0; bj < 2; ++bj) hw[mm][bj] = *(const u32x4*)(Gt + (size_t)(row0 + ai * 128 + mm * 16) * NZG + (g + 1) * 1024 + col0 + bj * 128);
            }
#pragma unroll
            for (int mm = 0; mm < 4; ++mm)
#pragma unroll
                for (int bj = 0; bj < 2; ++bj) {
                    float sc[8]; unpack8(gw[mm][bj], sc);
                    if (g < 2) { float sn[8]; unpack8(hw[mm][bj], sn);
#pragma unroll
                        for (int k = 0; k < 8; ++k) sc[k] *= __builtin_amdgcn_rcpf(sn[k]); }
                    f32x4& v0 = acc[ai][bj][mm][0]; f32x4& v1 = acc[ai][bj][mm][1];
                    v0[0] *= sc[0]; v0[1] *= sc[1]; v0[2] *= sc[2]; v0[3] *= sc[3]; v1[0] *= sc[4]; v1[1] *= sc[5]; v1[2] *= sc[6]; v1[3] *= sc[7];
                    if (g == 2) { u32x4 w; w.x = pk2(v0[0], v0[1]); w.y = pk2(v0[2], v0[3]); w.z = pk2(v1[0], v1[1]); w.w = pk2(v1[2], v1[3]);
                        *(u32x4*)(Hm + (size_t)(row0 + ai * 128 + mm * 16) * 1024 + col0 + bj * 128) = w; }
                }
        }
        return g < 2;
    }
};
struct EpiMerge {
    static constexpr bool PERM = true, AFTER_DRAIN = false, CHAIN = false;
    const bf16* Gt; bf16* Hm;
    __device__ __forceinline__ void operator()(const f32x4 (&acc)[2][2][4][2], const pg8::Unit& u, int wr, int wc, int fr, int fq) const {
        const int g = u.pm / (M / 256), m = u.pm - g * (M / 256), n = u.pn - g * 4;
        const int row0 = m * 256 + wr * 64 + fr, col0 = n * 256 + wc * 32 + 8 * fq;
#pragma unroll
        for (int ai = 0; ai < 2; ++ai) {
            u32x4 gw[4][2], ow[4][2];
#pragma unroll
            for (int mm = 0; mm < 4; ++mm)
#pragma unroll
                for (int bj = 0; bj < 2; ++bj) gw[mm][bj] = *(const u32x4*)(Gt + (size_t)(row0 + ai * 128 + mm * 16) * NZG + g * 1024 + col0 + bj * 128);
            if (g > 0) {
#pragma unroll
                for (int mm = 0; mm < 4; ++mm)
#pragma unroll
                    for (int bj = 0; bj < 2; ++bj) ow[mm][bj] = *(const u32x4*)(Hm + (size_t)(row0 + ai * 128 + mm * 16) * 1024 + col0 + bj * 128);
            }
#pragma unroll
            for (int mm = 0; mm < 4; ++mm)
#pragma unroll
                for (int bj = 0; bj < 2; ++bj) {
                    float gt[8]; unpack8(gw[mm][bj], gt);
                    const f32x4 v0 = acc[ai][bj][mm][0], v1 = acc[ai][bj][mm][1];
                    float o[8] = {v0[0], v0[1], v0[2], v0[3], v1[0], v1[1], v1[2], v1[3]};
#pragma unroll
                    for (int k = 0; k < 8; ++k) o[k] *= sigmoidf_(gt[k]);
                    if (g > 0) { float od[8]; unpack8(ow[mm][bj], od);
#pragma unroll
                        for (int k = 0; k < 8; ++k) o[k] += od[k]; }
                    *(u32x4*)(Hm + (size_t)(row0 + ai * 128 + mm * 16) * 1024 + col0 + bj * 128) = pack8(o);
                }
        }
    }
};
struct EpiOut {
    static constexpr bool PERM = true, AFTER_DRAIN = false, CHAIN = false;
    const float* xl; const float* xc; bf16* X; const float* modv; int from_f32;
    __device__ __forceinline__ void operator()(const f32x4 (&acc)[2][2][4][2], const pg8::Unit& u, int wr, int wc, int fr, int fq) const {
        const int row0 = u.pm * 256 + wr * 64 + fr, col0 = u.pn * 256 + wc * 32 + 8 * fq;
        const int bi = (u.pm * 256 < ML) ? ((u.pm * 256) >> 12) : 8;
        const float* g1 = modv + bi * 6144 + 2 * 1024;
        f32x4 gv[2][2];
#pragma unroll
        for (int bj = 0; bj < 2; ++bj) { gv[bj][0] = *(const f32x4*)(g1 + col0 + bj * 128); gv[bj][1] = *(const f32x4*)(g1 + col0 + bj * 128 + 4); }
        if (from_f32) {
            const float* src0 = (u.pm * 256 < ML) ? xl + (size_t)row0 * 1024 : xc + (size_t)(row0 - ML) * 1024;
#pragma unroll
            for (int ai = 0; ai < 2; ++ai) {
                f32x4 xv[4][2][2];
#pragma unroll
                for (int m = 0; m < 4; ++m)
#pragma unroll
                    for (int bj = 0; bj < 2; ++bj) { const float* s = src0 + (size_t)(ai * 128 + m * 16) * 1024 + col0 + bj * 128; xv[m][bj][0] = *(const f32x4*)s; xv[m][bj][1] = *(const f32x4*)(s + 4); }
#pragma unroll
                for (int m = 0; m < 4; ++m)
#pragma unroll
                    for (int bj = 0; bj < 2; ++bj) { const f32x4 o0 = xv[m][bj][0] + gv[bj][0] * acc[ai][bj][m][0], o1 = xv[m][bj][1] + gv[bj][1] * acc[ai][bj][m][1];
                        u32x4 w; w.x = pk2(o0[0], o0[1]); w.y = pk2(o0[2], o0[3]); w.z = pk2(o1[0], o1[1]); w.w = pk2(o1[2], o1[3]);
                        *(u32x4*)(X + (size_t)(row0 + ai * 128 + m * 16) * 1024 + col0 + bj * 128) = w; }
            }
        } else {
#pragma unroll
            for (int ai = 0; ai < 2; ++ai) {
                u32x4 xw[4][2];
#pragma unroll
                for (int m = 0; m < 4; ++m)
#pragma unroll
                    for (int bj = 0; bj < 2; ++bj) xw[m][bj] = *(const u32x4*)(X + (size_t)(row0 + ai * 128 + m * 16) * 1024 + col0 + bj * 128);
#pragma unroll
                for (int m = 0; m < 4; ++m)
#pragma unroll
                    for (int bj = 0; bj < 2; ++bj) { float xo[8]; unpack8(xw[m][bj], xo); const f32x4 a0 = acc[ai][bj][m][0], a1 = acc[ai][bj][m][1];
                        float o[8] = {xo[0] + gv[bj][0][0] * a0[0], xo[1] + gv[bj][0][1] * a0[1], xo[2] + gv[bj][0][2] * a0[2], xo[3] + gv[bj][0][3] * a0[3],
                                      xo[4] + gv[bj][1][0] * a1[0], xo[5] + gv[bj][1][1] * a1[1], xo[6] + gv[bj][1][2] * a1[2], xo[7] + gv[bj][1][3] * a1[3]};
                        *(u32x4*)(X + (size_t)(row0 + ai * 128 + m * 16) * 1024 + col0 + bj * 128) = pack8(o); }
            }
        }
    }
};
struct EpiMoe1 {
    static constexpr bool PERM = true, AFTER_DRAIN = false, CHAIN = false;
    bf16* ACT;
    __device__ __forceinline__ void operator()(const f32x4 (&acc)[2][2][4][2], const pg8::Unit& u, int wr, int wc, int fr, int fq) const {
        const int row0 = u.pm * 256 + wr * 64 + fr, col0 = (u.pn & 7) * 128 + wc * 32 + 8 * fq;
#pragma unroll
        for (int ai = 0; ai < 2; ++ai)
#pragma unroll
            for (int m = 0; m < 4; ++m) { const size_t r = (size_t)(row0 + ai * 128 + m * 16);
                const f32x4 a0 = acc[ai][0][m][0], a1 = acc[ai][0][m][1], u0 = acc[ai][1][m][0], u1 = acc[ai][1][m][1];
                float o[8];
#pragma unroll
                for (int k = 0; k < 4; ++k) { o[k] = a0[k] * sigmoidf_(a0[k]) * u0[k]; o[4 + k] = a1[k] * sigmoidf_(a1[k]) * u1[k]; }
                *(u32x4*)(ACT + r * 1024 + col0) = pack8(o); }
    }
};
struct EpiMoe2 {
    static constexpr bool PERM = true, AFTER_DRAIN = false, CHAIN = false;
    bf16* Y; const float* topw;
    __device__ __forceinline__ void operator()(const f32x4 (&acc)[2][2][4][2], const pg8::Unit& u, int wr, int wc, int fr, int fq) const {
        const int row0 = u.pm * 256 + wr * 64 + fr, col0 = (u.pn & 3) * 256 + wc * 32 + 8 * fq;
        float twv[2][4];
#pragma unroll
        for (int ai = 0; ai < 2; ++ai)
#pragma unroll
            for (int m = 0; m < 4; ++m) twv[ai][m] = topw[row0 + ai * 128 + m * 16];
#pragma unroll
        for (int ai = 0; ai < 2; ++ai)
#pragma unroll
            for (int m = 0; m < 4; ++m) { const size_t r = (size_t)(row0 + ai * 128 + m * 16); const float tw = twv[ai][m];
#pragma unroll
                for (int bj = 0; bj < 2; ++bj) { const f32x4 v0 = acc[ai][bj][m][0] * tw, v1 = acc[ai][bj][m][1] * tw;
                    u32x4 w; w.x = pk2(v0[0], v0[1]); w.y = pk2(v0[2], v0[3]); w.z = pk2(v1[0], v1[1]); w.w = pk2(v1[2], v1[3]);
                    *(u32x4*)(Y + r * 1024 + col0 + bj * 128) = w; } }
    }
};

__device__ __forceinline__ void tr_item(const float* W, int N, int k0, int n0, bf16* dst, int K, LAS float* scr, int lane) {
#pragma unroll 8
    for (int i = 0; i < 32; ++i) { const int kk = 2 * i + (lane >> 5); scr[kk * 33 + (lane & 31)] = W[(size_t)(k0 + kk) * N + n0 + (lane & 31)]; }
    LDS_WAIT();
    const int cc = lane & 7;
#pragma unroll
    for (int j = 0; j < 4; ++j) { const int n = (lane >> 3) + 8 * j; const LAS float* s = scr + (8 * cc) * 33 + n;
        u32x4 o; o.x = pk2(s[0 * 33], s[1 * 33]); o.y = pk2(s[2 * 33], s[3 * 33]); o.z = pk2(s[4 * 33], s[5 * 33]); o.w = pk2(s[6 * 33], s[7 * 33]);
        *(u32x4*)(dst + (size_t)n * K + 8 * cc) = o; }
    LDS_WAIT();
}
__device__ __forceinline__ void convert_small(KPC p, int l, LAS unsigned char* lds, int lane, int wave, int bid, int G) {
    LAS float* scr = (LAS float*)(lds + wave * 8448);
    const int gw = bid * 8 + wave, NGW = G * 8;
    constexpr int I_IN = 16 * 200, I_BR = 8 * 32, I_OUT = 16 * 32;
    bf16* wtin = (bf16*)(p->ws + WS_WTIN); bf16* wtbr = (bf16*)(p->ws + WS_WTBR); bf16* wtout = (bf16*)(p->ws + WS_WTOUT);
    for (int it = gw; it < I_IN + 3 * I_BR + I_OUT; it += NGW) {
        int r = it;
        if (r < I_IN) { const int kb = r / 200, nb = r % 200; tr_item(p->w_in + (size_t)l * 1024 * 6400, 6400, 64 * kb, 32 * nb, wtin + (size_t)(32 * nb) * 1024 + 64 * kb, 1024, scr, lane); continue; }
        r -= I_IN;
        if (r < 3 * I_BR) { const int br = r / I_BR, q = r % I_BR, kb = q / 32, nb = q % 32;
            tr_item(p->w_branch + ((size_t)l * 3 + br) * 512 * 1024, 1024, 64 * kb, 32 * nb, wtbr + (size_t)(br * 1024 + 32 * nb) * 512 + 64 * kb, 512, scr, lane); continue; }
        r -= 3 * I_BR;
        { const int kb = r / 32, nb = r % 32; tr_item(p->w_out + (size_t)l * 1024 * 1024, 1024, 64 * kb, 32 * nb, wtout + (size_t)(32 * nb) * 1024 + 64 * kb, 1024, scr, lane); }
    }
}
__device__ __forceinline__ void convert_experts(KPC p, int l, int lo, int hi, int widx, int nw, LAS unsigned char* lds, int lane, int wave) {
    LAS float* scr = (LAS float*)(lds + wave * 8448);
    bf16* wt1 = (bf16*)(p->ws + WS_WT1); bf16* wt2 = (bf16*)(p->ws + WS_WT2);
    for (int it = lo + widx; it < hi; it += nw) {
        const int e = it / 1536, q = it % 1536, which = q / 512, qq = q % 512, kb = qq / 32, nb = qq % 32, n0 = 32 * nb, k0 = 64 * kb;
        const size_t woff = ((size_t)l * NE + e) * 1024 * 1024;
        if (which == 0) tr_item(p->w_eg + woff, 1024, k0, n0, wt1 + ((size_t)e * 2048 + (n0 >> 7) * 256 + (n0 & 127)) * 1024 + k0, 1024, scr, lane);
        else if (which == 1) tr_item(p->w_eu + woff, 1024, k0, n0, wt1 + ((size_t)e * 2048 + (n0 >> 7) * 256 + 128 + (n0 & 127)) * 1024 + k0, 1024, scr, lane);
        else tr_item(p->w_ed + woff, 1024, k0, n0, wt2 + ((size_t)e * 1024 + n0) * 1024 + k0, 1024, scr, lane);
    }
}
constexpr int CVT_ITEMS = NE * 3 * 512;
constexpr int CVT_G_IDLE0 = 96, CVT_M_IDLE0 = 32, CVT_O_IDLE0 = 32;
constexpr int CVT_G_HI = 7680, CVT_M_HI = 7680 + 14336;

__device__ __forceinline__ void phase_prep(KPC p, LAS unsigned char* lds, int tid, int lane, int wave, int bid, int G) {
    unsigned char* ws = p->ws;
    {   float* rc = (float*)(ws + WS_ROPEC); float* rsn = (float*)(ws + WS_ROPES);
        for (int i = bid * 512 + tid; i < T * 32; i += G * 512) { const int t = i >> 5, f = i & 31; const int pos = (f < 16) ? (t >> 6) : (t & 63); const int fi = f & 15;
            const float inv = ex2(-(float)fi * (13.287712379549449f / 16.f));
            float ang = (float)pos * inv; ang -= 6.283185307179586f * rintf(ang * 0.15915494309189535f);
            rc[i] = __cosf(ang); rsn[i] = __sinf(ang); } }
    {   LAS float* sv = (LAS float*)lds;
        LAS float* red = (LAS float*)(lds + 36864);
        for (int i = tid; i < 9 * 1024; i += 512) { const int r = i >> 10, k = i & 1023; const float v = (r < 8) ? p->c[r * 1024 + k] : p->c_ctx[k]; sv[i] = v * sigmoidf_(v); }
        __syncthreads();
        for (int it = bid; it < 192; it += G) {
            const int l = it / 96, n0 = (it % 96) * 64;
            const float* W = p->w_mod + (size_t)l * 1024 * 6144 + n0 + lane;
            float acc[9];
#pragma unroll
            for (int r = 0; r < 9; ++r) acc[r] = 0.f;
#pragma unroll 1
            for (int k0 = wave * 128; k0 < wave * 128 + 128; k0 += 16) {
                float wv[16];
#pragma unroll
                for (int kk = 0; kk < 16; ++kk) wv[kk] = W[(size_t)(k0 + kk) * 6144];
#pragma unroll
                for (int kk = 0; kk < 16; ++kk)
#pragma unroll
                    for (int r = 0; r < 9; ++r) acc[r] += sv[r * 1024 + k0 + kk] * wv[kk]; }
#pragma unroll
            for (int r = 0; r < 9; ++r) red[(wave * 9 + r) * 64 + lane] = acc[r];
            __syncthreads();
            for (int i = tid; i < 576; i += 512) { const int r = i >> 6, ln = i & 63; float s = 0.f;
#pragma unroll
                for (int w = 0; w < 8; ++w) s += red[(w * 9 + r) * 64 + ln];
                s += p->b_mod[l * 6144 + n0 + ln]; ((float*)(ws + WS_MODV))[(l * 9 + r) * 6144 + n0 + ln] = s; }
            __syncthreads();
        }
    }
    __syncthreads();
    convert_small(p, 0, lds, lane, wave, bid, G);
}

__device__ __forceinline__ float row_rs(const f32x4 (&v)[4]) {
    float ss = 0.f;
#pragma unroll
    for (int j = 0; j < 4; ++j) ss += (v[j].x * v[j].x + v[j].y * v[j].y) + (v[j].z * v[j].z + v[j].w * v[j].w);
    return 1.0f / sqrtf(wave_sum(ss) * (1.f / 1024.f) + EPS);
}
__device__ __forceinline__ void norm_mod(const f32x4 (&v)[4], float rs, const float* gain, const float* sh, const float* sc, f32x4 (&h)[4], int lane) {
#pragma unroll
    for (int j = 0; j < 4; ++j) { const int col = 4 * lane + 256 * j; const f32x4 g = *(const f32x4*)(gain + col), a = *(const f32x4*)(sc + col), b = *(const f32x4*)(sh + col);
        h[j] = (v[j] * rs) * g * (a + 1.0f) + b; }
}
__device__ __forceinline__ void store_h(const f32x4 (&h)[4], bf16* hrow, int lane) {
#pragma unroll
    for (int j = 0; j < 4; ++j) { u32x2 w; w.x = pk2(h[j].x, h[j].y); w.y = pk2(h[j].z, h[j].w); *(u32x2*)(hrow + 4 * lane + 256 * j) = w; }
}
__device__ __forceinline__ void phase_norm_in(KPC p, int lane, int wave, int bid, int G) {
    const float* modv = (const float*)(p->ws + WS_MODV); bf16* H = (bf16*)(p->ws + WS_H);
    const int stride = G * 8; int r = bid * 8 + wave;
    f32x4 vn[4];
    {   const float* src = (r < ML) ? p->x + (size_t)r * 1024 : p->ctx + (size_t)(r - ML) * 1024;
#pragma unroll
        for (int j = 0; j < 4; ++j) vn[j] = (r < M) ? *(const f32x4*)(src + 4 * lane + 256 * j) : (f32x4){0.f, 0.f, 0.f, 0.f}; }
    for (; r < M; r += stride) {
        const int bi = (r < ML) ? (r >> 12) : 8; const float* mv = modv + bi * 6144;
        f32x4 v[4], h[4], g[4], sc[4], sh[4];
#pragma unroll
        for (int j = 0; j < 4; ++j) { v[j] = vn[j]; const int col = 4 * lane + 256 * j; g[j] = *(const f32x4*)(p->norm1_g + col); sh[j] = *(const f32x4*)(mv + col); sc[j] = *(const f32x4*)(mv + 1024 + col); }
        const int rn = r + stride;
        if (rn < M) { const float* src = (rn < ML) ? p->x + (size_t)rn * 1024 : p->ctx + (size_t)(rn - ML) * 1024;
#pragma unroll
            for (int j = 0; j < 4; ++j) vn[j] = *(const f32x4*)(src + 4 * lane + 256 * j); }
        const float rs = row_rs(v);
#pragma unroll
        for (int j = 0; j < 4; ++j) h[j] = (v[j] * rs) * g[j] * (sc[j] + 1.0f) + sh[j];
        store_h(h, H + (size_t)r * 1024, lane);
    }
}

__device__ __forceinline__ void att_item(KPC p, int l, LAS unsigned char* lds, int item, float Mb2, int tid, int lane, int wave) {
    const bf16* ZA = (const bf16*)(p->ws + WS_ZA); bf16* BR = (bf16*)p->out + (size_t)2 * M * 512;
    const float* rc = (const float*)(p->ws + WS_ROPEC); const float* rsn = (const float*)(p->ws + WS_ROPES);
    const bool isctx = item >= 512;
    int b, kvh, qb;
    if (!isctx) { b = item >> 6; kvh = (item >> 5) & 1; qb = item & 31; } else { const int ci = item - 512; b = ci >> 2; kvh = (ci >> 1) & 1; qb = ci & 1; }
    const int rowbase = isctx ? ML + b * CL : b * T;
    const int g = wave >> 1, qs = wave & 1, hh = kvh * 4 + g, c = lane & 15, g4 = lane >> 4, q0 = qb * 128 + qs * 64;
    const float* qg = p->qn_g + l * 64; const float* kg = p->kn_g + l * 64;
    LAS unsigned char* Kl = lds; LAS unsigned char* Vt = lds + 18432;
    bf16x8 qf[4][2];
#pragma unroll
    for (int ti = 0; ti < 4; ++ti) {
        const int pos = q0 + 16 * ti + c; const bf16* src = ZA + (size_t)(rowbase + pos) * NZA + C_AQ + hh * 64 + 8 * g4;
        float a[8], bb[8]; unpack8(*(const u32x4*)src, a); unpack8(*(const u32x4*)(src + 32), bb);
        float ss = 0.f;
#pragma unroll
        for (int j = 0; j < 8; ++j) ss += a[j] * a[j] + bb[j] * bb[j];
        ss = sum_x16_x32(ss);
        const float rs = 1.0f / sqrtf(ss * (1.f / 64.f) + EPS);
#pragma unroll
        for (int j = 0; j < 8; ++j) { a[j] *= rs * qg[8 * g4 + j]; bb[j] *= rs * qg[32 + 8 * g4 + j]; }
        if (!isctx) {
#pragma unroll
            for (int j = 0; j < 8; ++j) { const float cs = rc[pos * 32 + 8 * g4 + j], sn = rsn[pos * 32 + 8 * g4 + j]; const float x1 = a[j], x2 = bb[j]; a[j] = x1 * cs - x2 * sn; bb[j] = x1 * sn + x2 * cs; } }
#pragma unroll
        for (int j = 0; j < 8; ++j) { a[j] *= 0.125f * LOG2E; bb[j] *= 0.125f * LOG2E; }
        qf[ti][0] = as_bf16x8(pack8(a)); qf[ti][1] = as_bf16x8(pack8(bb));
        __builtin_amdgcn_sched_barrier(0);
    }
    f32x4 O[4][4]; float lsum[4];
#pragma unroll
    for (int i = 0; i < 4; ++i) { lsum[i] = 0.f;
#pragma unroll
        for (int j = 0; j < 4; ++j) O[i][j] = (f32x4){0.f, 0.f, 0.f, 0.f}; }
    const int ntile = isctx ? 2 : 5;
    for (int kt = 0; kt < ntile; ++kt) {
        int krow0, kpos0 = 0, mode = 0; bool local = false;
        if (isctx) krow0 = ML + b * CL + 128 * kt;
        else if (kt < 3) { const int kb = qb - 1 + kt; if (kb < 0 || kb > 31) continue; krow0 = b * T + kb * 128; kpos0 = kb * 128; local = true; mode = (kt == 0) ? 1 : ((kt == 2) ? 2 : 0); }
        else krow0 = ML + b * CL + 128 * (kt - 3);
#ifndef REP_ATT_STAGE
#define REP_ATT_STAGE 1
#endif
        for (int rs_ = 0; rs_ < REP_ATT_STAGE; ++rs_) {
        __syncthreads();
        {
            const int key = tid >> 2, q4 = tid & 3; const bf16* src = ZA + (size_t)(krow0 + key) * NZA + C_AK + kvh * 64 + 8 * q4;
            float a[8], bb[8]; unpack8(*(const u32x4*)src, a); unpack8(*(const u32x4*)(src + 32), bb);
            float ss = 0.f;
#pragma unroll
            for (int j = 0; j < 8; ++j) ss += a[j] * a[j] + bb[j] * bb[j];
            ss = sum_x1_x2(ss);
            const float rs = 1.0f / sqrtf(ss * (1.f / 64.f) + EPS);
#pragma unroll
            for (int j = 0; j < 8; ++j) { a[j] *= rs * kg[8 * q4 + j]; bb[j] *= rs * kg[32 + 8 * q4 + j]; }
            if (local) { const int pos = kpos0 + key;
#pragma unroll
                for (int j = 0; j < 8; ++j) { const float cs = rc[pos * 32 + 8 * q4 + j], sn = rsn[pos * 32 + 8 * q4 + j]; const float x1 = a[j], x2 = bb[j]; a[j] = x1 * cs - x2 * sn; bb[j] = x1 * sn + x2 * cs; } }
            *(LAS u32x4*)(Kl + key * 144 + 16 * q4) = pack8(a); *(LAS u32x4*)(Kl + key * 144 + 64 + 16 * q4) = pack8(bb);
            const bf16* vs = ZA + (size_t)(krow0 + key) * NZA + C_AV + kvh * 64 + 16 * q4;
            const u32x4 v0 = *(const u32x4*)vs, v1 = *(const u32x4*)(vs + 8);
            const unsigned vw[8] = {v0.x, v0.y, v0.z, v0.w, v1.x, v1.y, v1.z, v1.w};
#pragma unroll
            for (int j = 0; j < 8; ++j) { *(LAS unsigned short*)(Vt + (16 * q4 + 2 * j) * 272 + key * 2) = (unsigned short)(vw[j] & 0xffffu); *(LAS unsigned short*)(Vt + (16 * q4 + 2 * j + 1) * 272 + key * 2) = (unsigned short)(vw[j] >> 16); }
        }
        }
        __syncthreads();
#pragma unroll 1
        for (int kk = 0; kk < 4; ++kk) {
            if ((mode == 1 && 32 * kk + 31 < qs * 64) || (mode == 2 && 32 * kk > qs * 64 + 63)) continue;
            bf16x8 ka[2][2];
#pragma unroll
            for (int hf = 0; hf < 2; ++hf)
#pragma unroll
                for (int ks = 0; ks < 2; ++ks) ka[hf][ks] = *(const LAS bf16x8*)(Kl + (32 * kk + 16 * hf + c) * 144 + ks * 64 + g4 * 16);
            bf16x8 pf[4];
#pragma unroll
            for (int ti = 0; ti < 4; ++ti) {
                f32x4 sa = (f32x4){-Mb2, -Mb2, -Mb2, -Mb2}, sb = sa;
                sa = mfma16(ka[0][0], qf[ti][0], sa); sa = mfma16(ka[0][1], qf[ti][1], sa);
                sb = mfma16(ka[1][0], qf[ti][0], sb); sb = mfma16(ka[1][1], qf[ti][1], sb);
                float pa[4], pb[4];
#pragma unroll
                for (int rr = 0; rr < 4; ++rr) { pa[rr] = ex2(sa[rr]); pb[rr] = ex2(sb[rr]); }
                if (mode != 0) {
                    const int ii = qs * 64 + 16 * ti + c; const int mlo = (mode == 1) ? ii : -1000, mhi = (mode == 2) ? ii : 1000;
#pragma unroll
                    for (int rr = 0; rr < 4; ++rr) { const int ja = 32 * kk + 4 * g4 + rr, jb = ja + 16;
                        pa[rr] = (ja >= mlo && ja <= mhi) ? pa[rr] : 0.f; pb[rr] = (jb >= mlo && jb <= mhi) ? pb[rr] : 0.f; } }
                lsum[ti] += ((pa[0] + pa[1]) + (pa[2] + pa[3])) + ((pb[0] + pb[1]) + (pb[2] + pb[3]));
                u32x4 w; w.x = pk2(pa[0], pa[1]); w.y = pk2(pa[2], pa[3]); w.z = pk2(pb[0], pb[1]); w.w = pk2(pb[2], pb[3]); pf[ti] = as_bf16x8(w);
            }
#pragma unroll
            for (int dt = 0; dt < 4; ++dt) {
                const u32x2 v0 = *(const LAS u32x2*)(Vt + (16 * dt + c) * 272 + (32 * kk + 4 * g4) * 2), v1 = *(const LAS u32x2*)(Vt + (16 * dt + c) * 272 + (32 * kk + 16 + 4 * g4) * 2);
                u32x4 vv; vv.x = v0.x; vv.y = v0.y; vv.z = v1.x; vv.w = v1.y; const bf16x8 va = as_bf16x8(vv);
#pragma unroll
                for (int ti = 0; ti < 4; ++ti) O[dt][ti] = mfma16(va, pf[ti], O[dt][ti]);
            }
        }
    }
    const float sk = ex2(p->sink[l * 8 + hh] * LOG2E - Mb2);
#pragma unroll
    for (int ti = 0; ti < 4; ++ti) { float lt = sum_x16_x32(lsum[ti]); const float inv = 1.0f / (lt + sk);
        bf16* dst = BR + (size_t)(rowbase + q0 + 16 * ti + c) * 512 + hh * 64 + 4 * g4;
#pragma unroll
        for (int dt = 0; dt < 4; ++dt) { const f32x4 o = O[dt][ti] * inv; u32x2 w; w.x = pk2(o[0], o[1]); w.y = pk2(o[2], o[3]); *(u32x2*)(dst + 16 * dt) = w; } }
    __syncthreads();
}

__device__ __forceinline__ void sgu_vprep_item(KPC p, int ch, int tid) {
    bf16* ZA = (bf16*)(p->ws + WS_ZA);
    const int seg = tid & 15;
    bf16* rowp0 = ZA + (size_t)(ch * 128 + (tid >> 4)) * NZA + C_SV + 32 * seg;
    u32x4 raw[4][4];
#pragma unroll
    for (int ps = 0; ps < 4; ++ps)
#pragma unroll
        for (int q = 0; q < 4; ++q) raw[ps][q] = *(const u32x4*)(rowp0 + (size_t)ps * 32 * NZA + 8 * q);
#pragma unroll
    for (int ps = 0; ps < 4; ++ps) {
        bf16* rowp = rowp0 + (size_t)ps * 32 * NZA;
        float f[4][8]; float s = 0.f, ss = 0.f;
#pragma unroll
        for (int q = 0; q < 4; ++q) unpack8(raw[ps][q], f[q]);
#pragma unroll
        for (int q = 0; q < 4; ++q)
#pragma unroll
            for (int e = 0; e < 8; ++e) { const float y = gelu_tanh(f[q][e]); f[q][e] = y; s += y; ss += y * y; }
        s += swz_xor<1>(s); s += swz_xor<2>(s); s += swz_xor<4>(s); s += swz_xor<8>(s);
        ss += swz_xor<1>(ss); ss += swz_xor<2>(ss); ss += swz_xor<4>(ss); ss += swz_xor<8>(ss);
        const float mean = s * (1.f / 512.f), var = fmaxf(ss * (1.f / 512.f) - mean * mean, 0.f), rstd = 1.0f / sqrtf(var + EPS);
#pragma unroll
        for (int q = 0; q < 4; ++q) {
#pragma unroll
            for (int e = 0; e < 8; ++e) f[q][e] = (f[q][e] - mean) * rstd;
            *(u32x4*)(rowp + 8 * q) = pack8(f[q]); }
    }
}
__device__ __forceinline__ void sgu_item(KPC p, int l, LAS unsigned char* lds, int item, int tid, int lane, int wave) {
    const bf16* ZA = (const bf16*)(p->ws + WS_ZA); bf16* BR = (bf16*)p->out + (size_t)1 * M * 512;
    const int ch = item >> 2, g = item & 3, r0 = ch * 128, c = lane & 15, g4 = lane >> 4;
    LAS unsigned char* vT = lds;
    LAS unsigned char* WL = lds + 34816;
    {   const int j = tid >> 2, q4 = tid & 3; const bf16* src = ZA + (size_t)(r0 + j) * NZA + C_SV + 128 * g + 32 * q4;
#pragma unroll
        for (int q = 0; q < 4; ++q) { const u32x4 v = *(const u32x4*)(src + 8 * q); const unsigned vw[4] = {v.x, v.y, v.z, v.w};
#pragma unroll
            for (int e = 0; e < 4; ++e) { *(LAS unsigned short*)(vT + (32 * q4 + 8 * q + 2 * e) * 272 + j * 2) = (unsigned short)(vw[e] & 0xffffu); *(LAS unsigned short*)(vT + (32 * q4 + 8 * q + 2 * e + 1) * 272 + j * 2) = (unsigned short)(vw[e] >> 16); } }
        const float* wsrc = p->sgu_w + ((size_t)(l * 4 + g) * 128 + (tid >> 2)) * 128 + 32 * (tid & 3);
#pragma unroll
        for (int q = 0; q < 4; ++q) { const f32x4 a = *(const f32x4*)(wsrc + 8 * q), bq = *(const f32x4*)(wsrc + 8 * q + 4);
            u32x4 w; w.x = pk2(a.x, a.y); w.y = pk2(a.z, a.w); w.z = pk2(bq.x, bq.y); w.w = pk2(bq.z, bq.w);
            *(LAS u32x4*)(WL + (tid >> 2) * 272 + (32 * (tid & 3) + 8 * q) * 2) = w; }
    }
    __syncthreads();
    bf16x8 af[4];
#pragma unroll
    for (int ks = 0; ks < 4; ++ks) af[ks] = *(const LAS bf16x8*)(vT + (16 * wave + c) * 272 + (32 * ks + 8 * g4) * 2);
    const int col = 128 * g + 16 * wave + 4 * g4;
    u32x2 uw[8]; float bias[8];
#pragma unroll
    for (int ti = 0; ti < 8; ++ti) { uw[ti] = *(const u32x2*)(ZA + (size_t)(r0 + 16 * ti + c) * NZA + C_SU + col); bias[ti] = p->sgu_b[(l * 4 + g) * 128 + 16 * ti + c]; }
#pragma unroll
    for (int ti = 0; ti < 8; ++ti) {
        f32x4 acc = (f32x4){0.f, 0.f, 0.f, 0.f};
#pragma unroll
        for (int ks = 0; ks < 4; ++ks) acc = mfma16(af[ks], *(const LAS bf16x8*)(WL + (16 * ti + c) * 272 + (32 * ks + 8 * g4) * 2), acc);
        const float o0 = gelu_tanh(bflo(uw[ti].x)) * (acc[0] + bias[ti]), o1 = gelu_tanh(bfhi(uw[ti].x)) * (acc[1] + bias[ti]), o2 = gelu_tanh(bflo(uw[ti].y)) * (acc[2] + bias[ti]), o3 = gelu_tanh(bfhi(uw[ti].y)) * (acc[3] + bias[ti]);
        u32x2 w; w.x = pk2(o0, o1); w.y = pk2(o2, o3); *(u32x2*)(BR + (size_t)(r0 + 16 * ti + c) * 512 + col) = w;
    }
    __syncthreads();
}

__device__ __forceinline__ void ret_load_k(KPC p, const bf16* ZA, int r0, int h, bool latent, int pos0, int tid, float (&a)[8], float (&bb)[8]) {
    const int j = tid >> 2, q4 = tid & 3; const bf16* src = ZA + (size_t)(r0 + j) * NZA + C_RK + 64 * h + 8 * q4;
    unpack8(*(const u32x4*)src, a); unpack8(*(const u32x4*)(src + 32), bb);
    if (latent) { const float* rc = (const float*)(p->ws + WS_ROPEC); const float* rsn = (const float*)(p->ws + WS_ROPES); const int pos = pos0 + j;
#pragma unroll
        for (int e = 0; e < 8; ++e) { const float cs = rc[pos * 32 + 8 * q4 + e], sn = rsn[pos * 32 + 8 * q4 + e]; const float x1 = a[e], x2 = bb[e]; a[e] = x1 * cs - x2 * sn; bb[e] = x1 * sn + x2 * cs; } }
#pragma unroll
    for (int e = 0; e < 8; ++e) { a[e] *= 0.125f; bb[e] *= 0.125f; }
}
__device__ __forceinline__ void ret_stage_vT(const bf16* ZA, int r0, int h, LAS unsigned char* vT, int tid) {
    const int j = tid >> 2, q4 = tid & 3; const bf16* src = ZA + (size_t)(r0 + j) * NZA + C_RV + 128 * h + 32 * q4;
#pragma unroll
    for (int q = 0; q < 4; ++q) { const u32x4 v = *(const u32x4*)(src + 8 * q); const unsigned vw[4] = {v.x, v.y, v.z, v.w};
#pragma unroll
        for (int e = 0; e < 4; ++e) { *(LAS unsigned short*)(vT + (32 * q4 + 8 * q + 2 * e) * 272 + j * 2) = (unsigned short)(vw[e] & 0xffffu); *(LAS unsigned short*)(vT + (32 * q4 + 8 * q + 2 * e + 1) * 272 + j * 2) = (unsigned short)(vw[e] >> 16); } }
}
__device__ __forceinline__ void ret_upd_item(KPC p, int l, LAS unsigned char* lds, int item, int tid, int lane, int wave) {
    const bf16* ZA = (const bf16*)(p->ws + WS_ZA); float* RS = (float*)(p->ws + WS_RS);
    const int b = item / (NCH * 4), rem = item % (NCH * 4), n = rem >> 2, h = rem & 3, c = lane & 15, g4 = lane >> 4;
    const bool latent = n < 32; const int r0 = latent ? b * T + 128 * n : ML + b * CL + 128 * (n - 32);
    const float lgf = log2_sigmoid(p->dec_f[l * 4 + h]), lgb = log2_sigmoid(p->dec_b[l * 4 + h]);
    LAS unsigned char* vT = lds; LAS unsigned char* kTf = lds + 34816; LAS unsigned char* kTb = lds + 34816 + 17408;
    {   float a[8], bb[8]; ret_load_k(p, ZA, r0, h, latent, 128 * n, tid, a, bb);
        const int j = tid >> 2, q4 = tid & 3; const float wf = ex2((float)(127 - j) * lgf), wb = ex2((float)j * lgb);
#pragma unroll
        for (int e = 0; e < 8; e += 2) {
            unsigned w = pk2(a[e] * wf, a[e + 1] * wf); *(LAS unsigned short*)(kTf + (8 * q4 + e) * 272 + j * 2) = (unsigned short)(w & 0xffffu); *(LAS unsigned short*)(kTf + (8 * q4 + e + 1) * 272 + j * 2) = (unsigned short)(w >> 16);
            w = pk2(bb[e] * wf, bb[e + 1] * wf); *(LAS unsigned short*)(kTf + (32 + 8 * q4 + e) * 272 + j * 2) = (unsigned short)(w & 0xffffu); *(LAS unsigned short*)(kTf + (32 + 8 * q4 + e + 1) * 272 + j * 2) = (unsigned short)(w >> 16);
            w = pk2(a[e] * wb, a[e + 1] * wb); *(LAS unsigned short*)(kTb + (8 * q4 + e) * 272 + j * 2) = (unsigned short)(w & 0xffffu); *(LAS unsigned short*)(kTb + (8 * q4 + e + 1) * 272 + j * 2) = (unsigned short)(w >> 16);
            w = pk2(bb[e] * wb, bb[e + 1] * wb); *(LAS unsigned short*)(kTb + (32 + 8 * q4 + e) * 272 + j * 2) = (unsigned short)(w & 0xffffu); *(LAS unsigned short*)(kTb + (32 + 8 * q4 + e + 1) * 272 + j * 2) = (unsigned short)(w >> 16);
        }
        ret_stage_vT(ZA, r0, h, vT, tid);
    }
    __syncthreads();
    bf16x8 af[4];
#pragma unroll
    for (int ks = 0; ks < 4; ++ks) af[ks] = *(const LAS bf16x8*)(vT + (16 * wave + c) * 272 + (32 * ks + 8 * g4) * 2);
#pragma unroll
    for (int dir = 0; dir < 2; ++dir) { const LAS unsigned char* kT = dir ? kTb : kTf;
        float* dst = RS + ((size_t)(((b * 4 + h) * 2 + dir) * NCH + n) * 128 + 16 * wave + 4 * g4) * 64;
#pragma unroll
        for (int dt = 0; dt < 4; ++dt) { f32x4 acc = (f32x4){0.f, 0.f, 0.f, 0.f};
#pragma unroll
            for (int ks = 0; ks < 4; ++ks) acc = mfma16(af[ks], *(const LAS bf16x8*)(kT + (16 * dt + c) * 272 + (32 * ks + 8 * g4) * 2), acc);
#pragma unroll
            for (int rr = 0; rr < 4; ++rr) dst[rr * 64 + 16 * dt + c] = acc[rr]; } }
    __syncthreads();
}
__device__ __forceinline__ void phase_scan(KPC p, int l, int tid, int bid, int G) {
    const float* __restrict__ RS = (const float*)(p->ws + WS_RS); bf16* __restrict__ ST = (bf16*)(p->ws + WS_ST);
    for (int idx = bid * 512 + tid; idx < NB * 4 * 2 * 8192; idx += G * 512) {
        const int ed = idx & 8191, dir = (idx >> 13) & 1, bh = idx >> 14, e = ed >> 6, d = ed & 63, h = bh & 3;
        const float* P = RS + (size_t)((bh * 2 + dir) * NCH) * 8192 + ed;
        bf16* S = ST + ((size_t)bh * NCH * 128 + e) * 128 + dir * 64 + d;
        const float lg = log2_sigmoid(dir ? p->dec_b[l * 4 + h] : p->dec_f[l * 4 + h]); const float dec = ex2(128.f * lg);
        float u[NCH];
#pragma unroll
        for (int n = 0; n < NCH; ++n) u[n] = P[(size_t)n * 8192];
        if (dir == 0) {
            S[32 * 16384] = 0; S[33 * 16384] = (bf16)(pk2(u[32], 0.f) & 0xffffu);
            float s = dec * u[32] + u[33];
#pragma unroll
            for (int n = 0; n < 32; ++n) { S[(size_t)n * 16384] = (bf16)(pk2(s, 0.f) & 0xffffu); s = dec * s + u[n]; }
        } else {
            S[33 * 16384] = 0; S[32 * 16384] = (bf16)(pk2(u[33], 0.f) & 0xffffu);
            float s = dec * u[33] + u[32];
#pragma unroll
            for (int n = 31; n >= 0; --n) { S[(size_t)n * 16384] = (bf16)(pk2(s, 0.f) & 0xffffu); s = dec * s + u[n]; }
        }
    }
}
__device__ __forceinline__ void ret_out_item(KPC p, int l, LAS unsigned char* lds, int item, int tid, int lane, int wave) {
    const bf16* ZA = (const bf16*)(p->ws + WS_ZA); bf16* BR = (bf16*)p->out; const bf16* ST = (const bf16*)(p->ws + WS_ST);
    const int b = item / (NCH * 4), rem = item % (NCH * 4), n = rem >> 2, h = rem & 3, c = lane & 15, g4 = lane >> 4;
    const bool latent = n < 32; const int r0 = latent ? b * T + 128 * n : ML + b * CL + 128 * (n - 32);
    const float lgf = log2_sigmoid(p->dec_f[l * 4 + h]), lgb = log2_sigmoid(p->dec_b[l * 4 + h]);
    LAS unsigned char* vT = lds; LAS unsigned char* Kl = lds + 34816; LAS unsigned char* Sl = lds + 34816 + 18432;
    {   float a[8], bb[8]; ret_load_k(p, ZA, r0, h, latent, 128 * n, tid, a, bb);
        const int j = tid >> 2, q4 = tid & 3;
        *(LAS u32x4*)(Kl + j * 144 + 16 * q4) = pack8(a); *(LAS u32x4*)(Kl + j * 144 + 64 + 16 * q4) = pack8(bb);
        ret_stage_vT(ZA, r0, h, vT, tid);
        const u32x4* ssrc = (const u32x4*)(ST + (size_t)((b * 4 + h) * NCH + n) * 16384);
#pragma unroll
        for (int k = 0; k < 4; ++k) { const int q = tid + 512 * k; *(LAS u32x4*)(Sl + (q >> 4) * 272 + (q & 15) * 16) = ssrc[q]; }
    }
    __syncthreads();
    const int ii = 16 * wave + c;
    bf16x8 qf[2];
    {   const bf16* src = ZA + (size_t)(r0 + ii) * NZA + C_RQ + 64 * h + 8 * g4; float a[8], bb[8]; unpack8(*(const u32x4*)src, a); unpack8(*(const u32x4*)(src + 32), bb);
        if (latent) { const float* rc = (const float*)(p->ws + WS_ROPEC); const float* rsn = (const float*)(p->ws + WS_ROPES); const int pos = 128 * n + ii;
#pragma unroll
            for (int e = 0; e < 8; ++e) { const float cs = rc[pos * 32 + 8 * g4 + e], sn = rsn[pos * 32 + 8 * g4 + e]; const float x1 = a[e], x2 = bb[e]; a[e] = x1 * cs - x2 * sn; bb[e] = x1 * sn + x2 * cs; } }
        qf[0] = as_bf16x8(pack8(a)); qf[1] = as_bf16x8(pack8(bb)); }
    bf16x8 pf[4];
#pragma unroll
    for (int kk = 0; kk < 4; ++kk) {
        f32x4 sa = (f32x4){0.f, 0.f, 0.f, 0.f}, sb = (f32x4){0.f, 0.f, 0.f, 0.f};
        sa = mfma16(*(const LAS bf16x8*)(Kl + (32 * kk + c) * 144 + g4 * 16), qf[0], sa); sa = mfma16(*(const LAS bf16x8*)(Kl + (32 * kk + c) * 144 + 64 + g4 * 16), qf[1], sa);
        sb = mfma16(*(const LAS bf16x8*)(Kl + (32 * kk + 16 + c) * 144 + g4 * 16), qf[0], sb); sb = mfma16(*(const LAS bf16x8*)(Kl + (32 * kk + 16 + c) * 144 + 64 + g4 * 16), qf[1], sb);
        float pa[4], pb[4];
#pragma unroll
        for (int rr = 0; rr < 4; ++rr) { const int ja = 32 * kk + 4 * g4 + rr, jb = ja + 16; const int da = ii - ja, db = ii - jb;
            pa[rr] = sa[rr] * ((da >= 0) ? ex2((float)da * lgf) : ex2((float)(-da) * lgb)); pb[rr] = sb[rr] * ((db >= 0) ? ex2((float)db * lgf) : ex2((float)(-db) * lgb)); }
        u32x4 w; w.x = pk2(pa[0], pa[1]); w.y = pk2(pa[2], pa[3]); w.z = pk2(pb[0], pb[1]); w.w = pk2(pb[2], pb[3]); pf[kk] = as_bf16x8(w);
    }
    const float cf = ex2((float)(ii + 1) * lgf), cb = ex2((float)(128 - ii) * lgb);
    f32x4 O[8]; float s = 0.f, ss = 0.f;
#pragma unroll
    for (int et = 0; et < 8; ++et) {
        f32x4 acc = (f32x4){0.f, 0.f, 0.f, 0.f}, xf = (f32x4){0.f, 0.f, 0.f, 0.f}, xb = (f32x4){0.f, 0.f, 0.f, 0.f};
#pragma unroll
        for (int kk = 0; kk < 4; ++kk) { const u32x2 v0 = *(const LAS u32x2*)(vT + (16 * et + c) * 272 + (32 * kk + 4 * g4) * 2), v1 = *(const LAS u32x2*)(vT + (16 * et + c) * 272 + (32 * kk + 16 + 4 * g4) * 2);
            u32x4 vv; vv.x = v0.x; vv.y = v0.y; vv.z = v1.x; vv.w = v1.y; acc = mfma16(as_bf16x8(vv), pf[kk], acc); }
#pragma unroll
        for (int ks = 0; ks < 2; ++ks) { xf = mfma16(*(const LAS bf16x8*)(Sl + (16 * et + c) * 272 + (32 * ks + 8 * g4) * 2), qf[ks], xf);
            xb = mfma16(*(const LAS bf16x8*)(Sl + (16 * et + c) * 272 + (64 + 32 * ks + 8 * g4) * 2), qf[ks], xb); }
        acc = acc + xf * cf + xb * cb; O[et] = acc;
        s += (acc[0] + acc[1]) + (acc[2] + acc[3]); ss += (acc[0] * acc[0] + acc[1] * acc[1]) + (acc[2] * acc[2] + acc[3] * acc[3]);
    }
    s = sum_x16_x32(s); ss = sum_x16_x32(ss);
    const float mean = s * (1.f / 128.f), var = fmaxf(ss * (1.f / 128.f) - mean * mean, 0.f), rstd = 1.0f / sqrtf(var + EPS);
    const bf16* gsrc = ZA + (size_t)(r0 + ii) * NZA + C_RG + 128 * h + 4 * g4; bf16* dst = BR + (size_t)(r0 + ii) * 512 + 128 * h + 4 * g4;
#pragma unroll
    for (int et = 0; et < 8; ++et) { const u32x2 gw = *(const u32x2*)(gsrc + 16 * et); const float g0 = bflo(gw.x), g1 = bfhi(gw.x), g2 = bflo(gw.y), g3 = bfhi(gw.y);
        const float o0 = (O[et][0] - mean) * rstd * g0 * sigmoidf_(g0), o1 = (O[et][1] - mean) * rstd * g1 * sigmoidf_(g1), o2 = (O[et][2] - mean) * rstd * g2 * sigmoidf_(g2), o3 = (O[et][3] - mean) * rstd * g3 * sigmoidf_(g3);
        u32x2 w; w.x = pk2(o0, o1); w.y = pk2(o2, o3); *(u32x2*)(dst + 16 * et) = w; }
    __syncthreads();
}

#ifndef REP_CVT
#define REP_CVT 1
#endif
#ifndef REP_N2R
#define REP_N2R 1
#endif
#ifndef REP_TK
#define REP_TK 1
#endif
__device__ __forceinline__ int wr_off(int k) { return k * 64 + (k >> 2) * 16; }
__device__ __forceinline__ void phase_norm2(KPC p, int l, LAS unsigned char* lds, int tid, int lane, int wave, int bid, int G) {
    if (l == 1 || G != 256) { for (int rep = 0; rep < REP_CVT; ++rep) convert_experts(p, l, 0, CVT_ITEMS, bid * 8 + wave, G * 8, lds, lane, wave); __syncthreads(); }
    LAS unsigned char* wrl = lds + 69632;
    for (int i = tid; i < 1024 * 4; i += 512) { const int k = i >> 2, q = i & 3; *(LAS f32x4*)(wrl + wr_off(k) + 16 * q) = *(const f32x4*)(p->w_router + (size_t)l * 16384 + k * 16 + 4 * q); }
    __syncthreads();
    const float* modv = (const float*)(p->ws + WS_MODV) + l * 9 * 6144; const bf16* X = (const bf16*)(p->ws + WS_X); bf16* H = (bf16*)(p->ws + WS_H);
    float* AFF = (float*)(p->ws + WS_AFF); float* AFFC = (float*)(p->ws + WS_AFFC); int* INV = (int*)(p->ws + WS_INV);
    const int rows = (l == 0) ? M : ML, stride = G * 8;
    for (int rep = 0; rep < REP_N2R; ++rep) {
    int r = bid * 8 + wave;
    u32x2 vn[4];
#pragma unroll
    for (int j = 0; j < 4; ++j) vn[j] = (r < rows) ? *(const u32x2*)(X + (size_t)r * 1024 + 4 * lane + 256 * j) : (u32x2){0u, 0u};
    for (; r < rows; r += stride) {
        const int bi = (r < ML) ? (r >> 12) : 8; const float* mv = modv + bi * 6144;
        f32x4 v[4], h[4], g[4], sc[4], sh[4];
#pragma unroll
        for (int j = 0; j < 4; ++j) { v[j] = (f32x4){bflo(vn[j].x), bfhi(vn[j].x), bflo(vn[j].y), bfhi(vn[j].y)}; const int col = 4 * lane + 256 * j; g[j] = *(const f32x4*)(p->norm2_g + l * 1024 + col); sh[j] = *(const f32x4*)(mv + 3 * 1024 + col); sc[j] = *(const f32x4*)(mv + 4 * 1024 + col); }
        const int rn = r + stride;
        if (rn < rows) {
#pragma unroll
            for (int j = 0; j < 4; ++j) vn[j] = *(const u32x2*)(X + (size_t)rn * 1024 + 4 * lane + 256 * j); }
        const float rs = row_rs(v);
#pragma unroll
        for (int j = 0; j < 4; ++j) h[j] = (v[j] * rs) * g[j] * (sc[j] + 1.0f) + sh[j];
        store_h(h, H + (size_t)r * 1024, lane);
        float lg[16];
#pragma unroll
        for (int e = 0; e < 16; ++e) lg[e] = 0.f;
#pragma unroll
        for (int j = 0; j < 4; ++j)
#pragma unroll
            for (int i = 0; i < 4; ++i) { const int k = 4 * lane + 256 * j + i; const float hv = h[j][i]; const LAS f32x4* wp = (const LAS f32x4*)(wrl + wr_off(k));
#pragma unroll
                for (int q = 0; q < 4; ++q) { const f32x4 w = wp[q]; lg[4 * q] += hv * w.x; lg[4 * q + 1] += hv * w.y; lg[4 * q + 2] += hv * w.z; lg[4 * q + 3] += hv * w.w; } }
        float mx = -1e30f;
#pragma unroll
        for (int e = 0; e < 16; ++e) { lg[e] = wave_sum(lg[e]); mx = fmaxf(mx, lg[e]); }
        float sum = 0.f;
#pragma unroll
        for (int e = 0; e < 16; ++e) { lg[e] = ex2((lg[e] - mx) * LOG2E); sum += lg[e]; }
        const float isum = 1.0f / sum; float mine = 0.f;
#pragma unroll
        for (int e = 0; e < 16; ++e) mine = (lane == e) ? lg[e] * isum : mine;
        if (lane < 16) { if (r < ML) AFF[((size_t)(bi * 16 + lane) << 12) + (r & 4095)] = mine; else AFFC[((r - ML) >> 8) * 4096 + lane * 256 + ((r - ML) & 255)] = mine;
            INV[(size_t)r * 16 + lane] = -1; }
    }
    }
}

__device__ __forceinline__ int block_sum_i(int v, LAS int* red, int buf, int lane, int wave) {
    v = wave_sum_i(v);
    if (lane == 0) red[buf * 8 + wave] = v;
    __syncthreads();
    int s = 0;
#pragma unroll
    for (int w = 0; w < 8; ++w) s += red[buf * 8 + w];
    return s;
}
__device__ __forceinline__ int block_excl_scan(int v, LAS int* red, int buf, int lane, int wave) {
    int inc = v;
#pragma unroll
    for (int o = 1; o < 64; o <<= 1) { const int t = __builtin_amdgcn_ds_bpermute((lane - o) << 2, inc); if (lane >= o) inc += t; }
    if (lane == 63) red[buf * 8 + wave] = inc;
    __syncthreads();
    int base = 0;
#pragma unroll
    for (int w = 0; w < 8; ++w) { const int x = red[buf * 8 + w]; if (w < wave) base += x; }
    return base + inc - v;
}
template <int KPT>
__device__ __forceinline__ void topk_item(KPC p, const float* aff, int n, int cap, int rowbase, int e, int slotbase, int s_lo, int s_hi, bool writer, LAS unsigned char* lds, int tid, int lane, int wave) {
    const bf16* H = (const bf16*)(p->ws + WS_H); bf16* XS = (bf16*)(p->ws + WS_XS); float* topw = (float*)(p->ws + WS_TOPW); int* INV = (int*)(p->ws + WS_INV);
    LAS int* red = (LAS int*)lds; LAS int* rl = (LAS int*)(lds + 128);
    unsigned key[KPT]; const bool valid = tid * KPT < n;
#pragma unroll
    for (int j = 0; j < KPT; ++j) key[j] = valid ? __float_as_uint(aff[tid * KPT + j]) : 0u;
    unsigned Tsel = 0u;
    for (int bit = 30; bit >= 0; --bit) { const unsigned cand = Tsel | (1u << bit); int cnt = 0;
#pragma unroll
        for (int j = 0; j < KPT; ++j) cnt += (valid && key[j] >= cand) ? 1 : 0;
        if (block_sum_i(cnt, red, bit & 1, lane, wave) >= cap) Tsel = cand; }
    int cgt = 0, ceq = 0;
#pragma unroll
    for (int j = 0; j < KPT; ++j) { cgt += (valid && key[j] > Tsel) ? 1 : 0; ceq += (valid && key[j] == Tsel) ? 1 : 0; }
    const int need = cap - block_sum_i(cgt, red, 1, lane, wave);
    int er = block_excl_scan(ceq, red, 2, lane, wave);
    bool sel[KPT]; int nsel = 0;
#pragma unroll
    for (int j = 0; j < KPT; ++j) { const bool iseq = valid && key[j] == Tsel; sel[j] = valid && (key[j] > Tsel || (iseq && er < need)); er += iseq ? 1 : 0; nsel += sel[j] ? 1 : 0; }
    int slot = block_excl_scan(nsel, red, 3, lane, wave);
#pragma unroll
    for (int j = 0; j < KPT; ++j) if (sel[j]) { const int t = tid * KPT + j; if (slot < cap) { rl[slot] = t; if (writer) { topw[e * ME + slotbase + slot] = __uint_as_float(key[j]); INV[(size_t)(rowbase + t) * 16 + e] = slotbase + slot; } } ++slot; }
    __syncthreads();
    for (int s = s_lo + wave * 4; s < s_hi; s += 32) {
        u32x4 a[4][2];
#pragma unroll
        for (int q = 0; q < 4; ++q) { const int t = rl[s + q]; const u32x4* src = (const u32x4*)(H + (size_t)(rowbase + t) * 1024); a[q][0] = src[lane]; a[q][1] = src[lane + 64]; }
#pragma unroll
        for (int q = 0; q < 4; ++q) { u32x4* dst = (u32x4*)(XS + ((size_t)e * ME + slotbase + s + q) * 1024); dst[lane] = a[q][0]; dst[lane + 64] = a[q][1]; }
    }
    __syncthreads();
}
__device__ __forceinline__ void phase_topk(KPC p, int l, LAS unsigned char* lds, int tid, int lane, int wave, int bid, int G) {
    const float* AFF = (const float*)(p->ws + WS_AFF); const float* AFFC = (const float*)(p->ws + WS_AFFC);
    const int nitem = (l == 0) ? 384 : 256;
    for (int it = bid; it < nitem; it += G) {
        if (it < 256) { const int q = it >> 1, hf = it & 1, b = q >> 4, e = q & 15; topk_item<8>(p, AFF + ((size_t)(b * 16 + e) << 12), 4096, CAPL, b * T, e, b * CAPL, hf * 256, hf * 256 + 256, hf == 0, lds, tid, lane, wave); }
        else { const int q = it - 256, b = q >> 4, e = q & 15; topk_item<1>(p, AFFC + (b * 16 + e) * 256, 256, CAPC, ML + b * CL, e, NB * CAPL + b * CAPC, 0, CAPC, true, lds, tid, lane, wave); }
    }
}

__device__ __forceinline__ void phase_combine(KPC p, int l, LAS unsigned char* lds, int tid, int lane, int wave, int bid, int G) {
    const float* modv = (const float*)(p->ws + WS_MODV); bf16* X = (bf16*)(p->ws + WS_X); bf16* H = (bf16*)(p->ws + WS_H);
    const bf16* Y = (const bf16*)(p->ws + WS_XS); const int* INV = (const int*)(p->ws + WS_INV);
    const int rows = (l == 0) ? M : ML, stride = G * 8;
    int r = bid * 8 + wave;
    int slot_next = (lane < 16 && r < rows) ? INV[(size_t)r * 16 + lane] : -1;
    u32x2 vn[4];
#pragma unroll
    for (int j = 0; j < 4; ++j) vn[j] = (r < rows) ? *(const u32x2*)(X + (size_t)r * 1024 + 4 * lane + 256 * j) : (u32x2){0u, 0u};
    for (; r < rows; r += stride) {
        const int bi = (r < ML) ? (r >> 12) : 8;
        const int myslot = slot_next; const int rn = r + stride;
        slot_next = (lane < 16 && rn < rows) ? INV[(size_t)rn * 16 + lane] : -1;
        f32x4 v[4], acc[4], g2v[4];
        const float* g2 = modv + (l * 9 + bi) * 6144 + 5 * 1024;
#pragma unroll
        for (int j = 0; j < 4; ++j) { v[j] = (f32x4){bflo(vn[j].x), bfhi(vn[j].x), bflo(vn[j].y), bfhi(vn[j].y)}; acc[j] = (f32x4){0.f, 0.f, 0.f, 0.f}; g2v[j] = *(const f32x4*)(g2 + 4 * lane + 256 * j); }
        unsigned mask = (unsigned)(__builtin_amdgcn_ballot_w64(myslot >= 0) & 0xffffull);
        bool first = true;
        while (mask || first) {
          if (mask) {
            const int e0 = __builtin_ctz(mask); mask &= mask - 1u; const int s0 = __builtin_amdgcn_readlane(myslot, e0);
            const bool has1 = mask != 0u; const int e1 = has1 ? __builtin_ctz(mask) : e0; if (has1) mask &= mask - 1u; const int s1 = __builtin_amdgcn_readlane(myslot, e1);
            const bf16* ya = Y + ((size_t)e0 * ME + s0) * 1024; const bf16* yb = Y + ((size_t)e1 * ME + s1) * 1024;
            u32x2 wa[4], wb[4];
#pragma unroll
            for (int j = 0; j < 4; ++j) wa[j] = *(const u32x2*)(ya + 4 * lane + 256 * j);
#pragma unroll
            for (int j = 0; j < 4; ++j) wb[j] = *(const u32x2*)(yb + 4 * lane + 256 * j);
            if (first && rn < rows) {
#pragma unroll
                for (int j = 0; j < 4; ++j) vn[j] = *(const u32x2*)(X + (size_t)rn * 1024 + 4 * lane + 256 * j); }
            first = false;
            const float kb = has1 ? 1.0f : 0.0f;
#pragma unroll
            for (int j = 0; j < 4; ++j) { acc[j] += (f32x4){bflo(wa[j].x), bfhi(wa[j].x), bflo(wa[j].y), bfhi(wa[j].y)}; acc[j] += (f32x4){bflo(wb[j].x), bfhi(wb[j].x), bflo(wb[j].y), bfhi(wb[j].y)} * kb; }
          } else {
            if (rn < rows) {
#pragma unroll
                for (int j = 0; j < 4; ++j) vn[j] = *(const u32x2*)(X + (size_t)rn * 1024 + 4 * lane + 256 * j); }
            first = false;
          }
        }
#pragma unroll
        for (int j = 0; j < 4; ++j) v[j] = v[j] + g2v[j] * acc[j];
        if (l == 0) {
#pragma unroll
            for (int j = 0; j < 4; ++j) { u32x2 w; w.x = pk2(v[j].x, v[j].y); w.y = pk2(v[j].z, v[j].w); *(u32x2*)(X + (size_t)r * 1024 + 4 * lane + 256 * j) = w; }
            const float rs = row_rs(v); f32x4 h[4];
            norm_mod(v, rs, p->norm1_g + 1024, modv + (9 + bi) * 6144, modv + (9 + bi) * 6144 + 1024, h, lane);
            store_h(h, H + (size_t)r * 1024, lane);
        } else {
#pragma unroll
            for (int j = 0; j < 4; ++j) *(f32x4*)(p->out + (size_t)r * 1024 + 4 * lane + 256 * j) = v[j];
        }
    }
    if (l == 0) convert_small(p, 1, lds, lane, wave, bid, G);
}

#define XB_TMO      128
#define XB_XCNT(j)  (256  + 64 * (j))
#define XB_XSUB(j)  (1280 + 64 * (j))
#define XB_XGEN(j)  (2304 + 64 * (j))
#define XB_TOP      3328
#define XB_TOPGEN   3392
#define XCD_BAR_WORDS 3456
#define XB_SPIN_CAP (1u << 18)

__device__ __forceinline__ unsigned xb_ld(unsigned* p)              { return __hip_atomic_load(p, __ATOMIC_RELAXED, __HIP_MEMORY_SCOPE_AGENT); }
__device__ __forceinline__ unsigned xb_add(unsigned* p, unsigned v) { return __hip_atomic_fetch_add(p, v, __ATOMIC_RELAXED, __HIP_MEMORY_SCOPE_AGENT); }
__device__ __forceinline__ unsigned xb_xcc_id() { return (unsigned)__builtin_amdgcn_s_getreg((3 << 11) | 20) & 0xFu; }
#define XB_SPIN(cond, bar) do { unsigned _sp = 0; while (cond) { __builtin_amdgcn_s_sleep(1); \
    if ((++_sp & 255u) == 0u) { if (xb_ld(&(bar)[XB_TMO])) break; if (_sp > XB_SPIN_CAP) { atomicAdd(&(bar)[XB_TMO], 1u); break; } } } } while (0)

struct XcdBarrier {
    unsigned* bar; unsigned x;
    volatile LAS unsigned* st;
};

__device__ __forceinline__ XcdBarrier xcd_barrier_post(unsigned* bar, volatile LAS unsigned* st) {
    XcdBarrier b; b.bar = bar; b.x = xb_xcc_id(); b.st = st;
    if (threadIdx.x == 0) (void)xb_add(&bar[XB_XCNT(b.x)], 1u);
    return b;
}
__device__ __forceinline__ void xcd_barrier_complete(unsigned* bar, unsigned x, unsigned& nloc, unsigned& nx) {
    const unsigned G = gridDim.x * gridDim.y * gridDim.z;
    unsigned sum, cnt, mine, sp = 0u;
    for (;;) {
        sum = 0u; cnt = 0u; mine = 0u;
#pragma unroll
        for (unsigned j = 0; j < 16; ++j) { const unsigned c = xb_ld(&bar[XB_XCNT(j)]); sum += c; cnt += (c > 0u) ? 1u : 0u; mine = (j == x) ? c : mine; }
        if (sum == G) break;
        __builtin_amdgcn_s_sleep(1);
        if ((++sp & 255u) == 0u) { if (xb_ld(&bar[XB_TMO])) break; if (sp > XB_SPIN_CAP) { atomicAdd(&bar[XB_TMO], 1u); break; } }
    }
    nloc = mine > 0u ? mine : 1u; nx = cnt > 0u ? cnt : 1u;
}

__device__ __forceinline__ void xcd_barrier(const XcdBarrier& b) {
    asm volatile("s_waitcnt vmcnt(0)" ::: "memory");
    __syncthreads();
    if (threadIdx.x == 0) {
        unsigned* bar = b.bar;
        __builtin_amdgcn_s_waitcnt(0);
        unsigned nloc = b.st[0], nx = b.st[1];
        if (nloc == 0u) { xcd_barrier_complete(bar, b.x, nloc, nx); b.st[0] = nloc; b.st[1] = nx; }
        const unsigned old = xb_add(&bar[XB_XSUB(b.x)], 1u);
        const unsigned gen = old / nloc;
        if (old + 1u == (gen + 1u) * nloc) {
            __builtin_amdgcn_fence(__ATOMIC_RELEASE, "agent");
            asm volatile("s_waitcnt vmcnt(0)" ::: "memory");
            const unsigned og = xb_add(&bar[XB_TOP], 1u);
            const unsigned tg = og / nx;
            if (og + 1u == (tg + 1u) * nx) xb_add(&bar[XB_TOPGEN], 1u);
            else XB_SPIN(xb_ld(&bar[XB_TOPGEN]) == tg, bar);
            __builtin_amdgcn_fence(__ATOMIC_ACQUIRE, "agent");
            xb_add(&bar[XB_XGEN(b.x)], 1u);
            asm volatile("s_waitcnt vmcnt(0)" ::: "memory");
        } else {
            XB_SPIN(xb_ld(&bar[XB_XGEN(b.x)]) == gen, bar);
            __builtin_amdgcn_fence(__ATOMIC_ACQUIRE, "agent");
            asm volatile("s_waitcnt vmcnt(0)" ::: "memory");
        }
    }
    __syncthreads();
}

#ifndef REP_GZA
#define REP_GZA 1
#endif
#ifndef REP_GG
#define REP_GG 1
#endif
#ifndef REP_GMRG
#define REP_GMRG 1
#endif
#ifndef REP_GM1
#define REP_GM1 1
#endif
#ifndef REP_GM2
#define REP_GM2 1
#endif
#ifndef REP_ATT
#define REP_ATT 1
#endif
#ifndef REP_UPD
#define REP_UPD 1
#endif
#ifndef REP_SGU
#define REP_SGU 1
#endif
#ifndef REP_SCAN
#define REP_SCAN 1
#endif
#ifndef REP_PRE
#define REP_PRE 1
#endif
#ifndef REP_CMB
#define REP_CMB 1
#endif
#ifndef REP_MIX
#define REP_MIX 1
#endif
#ifndef REP_RO
#define REP_RO 1
#endif
#ifndef REP_N2
#define REP_N2 1
#endif
#ifndef REP_GEMM
#define REP_GEMM 1
#endif
#ifndef REP_SYNC
#define REP_SYNC 1
#endif
#ifndef EN_GEMM
#define EN_GEMM 0x3f
#endif
#ifndef EN_ATT
#define EN_ATT 1
#endif
#ifndef EN_UPD
#define EN_UPD 1
#endif
#ifndef EN_SGU
#define EN_SGU 1
#endif
#ifndef EN_RO
#define EN_RO 1
#endif
#ifndef EN_MISC
#define EN_MISC 1
#endif
#define KPP() ({ KPC q_ = kp_; asm volatile("" : "+s"(q_)); q_; })
__global__ void __launch_bounds__(512, 2) mk_fwd(KP p_unused) {
    extern __shared__ __attribute__((aligned(16))) unsigned char lds_raw[];
    LAS unsigned char* lds = (LAS unsigned char*)lds_raw;
    cg::grid_group grid = cg::this_grid();
    const int bid = blockIdx.x, G = gridDim.x;
#define IDS() int tid = threadIdx.x; asm volatile("" : "+v"(tid)); const int lane = tid & 63, wave = __builtin_amdgcn_readfirstlane(tid >> 6); (void)lane; (void)wave
    const KPC kp_ = (KPC)__builtin_amdgcn_kernarg_segment_ptr();
    volatile LAS unsigned* bst = (volatile LAS unsigned*)(lds + 147392);
    if (threadIdx.x < 16) bst[threadIdx.x] = 0u;
    __syncthreads();
    (void)xcd_barrier_post((unsigned*)KPP()->ws, bst);
#ifdef PROBE_WAIT
    unsigned long long wacc = 0ull;
#define GSYNC() do { const unsigned long long t0_ = __builtin_amdgcn_s_memrealtime(); XcdBarrier b_; b_.bar = (unsigned*)KPP()->ws; b_.x = xb_xcc_id(); b_.st = bst; xcd_barrier(b_); wacc += __builtin_amdgcn_s_memrealtime() - t0_; } while (0)
#else
#define GSYNC() do { XcdBarrier b_; b_.bar = (unsigned*)KPP()->ws; b_.x = xb_xcc_id(); b_.st = bst; xcd_barrier(b_); } while (0)
#endif

    { IDS(); for (int rep = 0; rep < REP_PRE; ++rep) { phase_prep(KPP(), lds, tid, lane, wave, bid, G); __syncthreads(); } }
    grid.sync();
    { IDS(); for (int rep = 0; rep < REP_PRE; ++rep) phase_norm_in(KPP(), lane, wave, bid, G); }
    GSYNC();
#pragma unroll 1
    for (int l = 0; l < 2; ++l) {
        {
            unsigned char* ws = KPP()->ws;
            pg8::Gemm g{(const pg8::bf16_t*)(ws + WS_H), (const pg8::bf16_t*)(ws + WS_WTIN), M, NZA, 1024}; GroupOrder S{1, M / 256, NZA / 256, 0, 0, G, bid};
            EpiZA E{(bf16*)(ws + WS_ZA)};
            for (int rep = 0; rep < REP_GEMM * REP_GZA; ++rep) pg8::gemm_phase<EpiZA, GroupOrder, true, true>(lds, g, S, E);
#ifdef PROBE_ZA_HALF
            if (bid < PROBE_ZA_HALF) { GroupOrder S2{1, M / 256, NZA / 256, 0, 0, PROBE_ZA_HALF, bid}; pg8::gemm_phase<EpiZA, GroupOrder, true, true>(lds, g, S2, E); }
#endif
#ifdef PROBE_ZA_SLEEP
            { const unsigned long long t0 = __builtin_amdgcn_s_memrealtime(); while (__builtin_amdgcn_s_memrealtime() - t0 < 100000ull) __builtin_amdgcn_s_sleep(64); __syncthreads(); for (int rep = 0; rep < PROBE_ZA_SLEEP; ++rep) pg8::gemm_phase<EpiZA, GroupOrder, true, true>(lds, g, S, E); }
#endif
#ifdef PROBE_ZA_NULL
            { EpiNull En; pg8::gemm_phase<EpiNull, GroupOrder, true, true>(lds, g, S, En); }
#endif
        }
        GSYNC();
        {
            KPC p = KPP(); IDS();
            float mq = fabsf(p->qn_g[l * 64 + lane]), mk = fabsf(p->kn_g[l * 64 + lane]);
            mq = wave_max(mq); mk = wave_max(mk);
            const float Mb2 = 8.0f * mq * mk * LOG2E;
            const int natt = (l == 0) ? 544 : 512, nupd = NB * NCH * 4, nvp = (l == 0) ? (M / 128) : (ML / 128);
            for (int rep = 0; rep < REP_MIX; ++rep)
            for (int it = bid; it < natt + nupd + nvp; it += G) {
                if (it < natt) { for (int q = 0; q < REP_ATT; ++q) att_item(p, l, lds, it, Mb2, tid, lane, wave); }
                else if (it < natt + nupd) { for (int q = 0; q < REP_UPD; ++q) ret_upd_item(p, l, lds, it - natt, tid, lane, wave); }
                else { for (int q = 0; q < REP_SGU; ++q) sgu_vprep_item(p, it - natt - nupd, tid); }
            }
        }
        GSYNC();
        { IDS(); for (int rep = 0; rep < REP_RO * REP_SCAN; ++rep) phase_scan(KPP(), l, tid, bid, G); }
        GSYNC();
        {   KPC p = KPP(); IDS(); const int nch = (l == 0) ? NCH : 32;
            const int nro = NB * nch * 4, nsgu = ((l == 0) ? (M / 128) : (ML / 128)) * 4;
            for (int rep = 0; rep < REP_RO; ++rep)
            for (int it = bid; it < nro + nsgu; it += G) {
                if (it < nro) { const int b = it / (nch * 4), rem = it % (nch * 4); ret_out_item(p, l, lds, b * (NCH * 4) + rem, tid, lane, wave); }
                else sgu_item(p, l, lds, it - nro, tid, lane, wave);
            }
        }
        GSYNC();
        const int Mrows = (l == 0) ? M : ML;
        {
            unsigned char* ws = KPP()->ws;
            pg8::Gemm g{(const pg8::bf16_t*)(ws + WS_H), (const pg8::bf16_t*)(ws + WS_WTIN) + (size_t)NZA * 1024, Mrows, NZG, 1024}; GroupOrder S{1, Mrows / 256, NZG / 256, 0, 0, G, bid};
            EpiSig E{(bf16*)(ws + WS_G)};
            for (int rep = 0; rep < REP_GEMM * REP_GG; ++rep) pg8::gemm_phase<EpiSig, GroupOrder, true, true>(lds, g, S, E);
            if (l == 0 && G == 256 && bid >= CVT_G_IDLE0) { IDS(); convert_experts(KPP(), 0, 0, CVT_G_HI, (bid - CVT_G_IDLE0) * 8 + wave, (256 - CVT_G_IDLE0) * 8, lds, lane, wave); }
        }
        GSYNC();
        {
            KPC p = KPP(); unsigned char* ws = p->ws;
            pg8::Gemm g{(const pg8::bf16_t*)p->out, (const pg8::bf16_t*)(ws + WS_WTBR), 3 * M, 3072, 512}; MergeOrder S{Mrows / 256, G, bid};
            EpiMergeChain E{(const bf16*)(ws + WS_G), (bf16*)(ws + WS_H)};
            for (int rep = 0; rep < REP_GEMM * REP_GMRG; ++rep) pg8::gemm_phase<EpiMergeChain, MergeOrder, true, true>(lds, g, S, E);
            if (l == 0 && G == 256 && bid >= CVT_M_IDLE0) { IDS(); convert_experts(KPP(), 0, CVT_G_HI, CVT_M_HI, (bid - CVT_M_IDLE0) * 8 + wave, (256 - CVT_M_IDLE0) * 8, lds, lane, wave); }
        }
        GSYNC();
        {
            KPC p = KPP(); unsigned char* ws = p->ws;
            pg8::Gemm g{(const pg8::bf16_t*)(ws + WS_H), (const pg8::bf16_t*)(ws + WS_WTOUT), Mrows, 1024, 1024}; GroupOrder S{1, Mrows / 256, 4, 0, 0, G, bid};
            EpiOut E{p->x, p->ctx, (bf16*)(ws + WS_X), (const float*)(ws + WS_MODV) + l * 9 * 6144, (l == 0) ? 1 : 0};
            pg8::gemm_phase<EpiOut, GroupOrder, true, true>(lds, g, S, E);
            if (l == 0 && G == 256 && bid >= CVT_O_IDLE0) { IDS(); convert_experts(KPP(), 0, CVT_M_HI, CVT_ITEMS, (bid - CVT_O_IDLE0) * 8 + wave, (256 - CVT_O_IDLE0) * 8, lds, lane, wave); }
        }
        GSYNC();
        { IDS(); for (int rep = 0; rep < REP_N2; ++rep) { phase_norm2(KPP(), l, lds, tid, lane, wave, bid, G); __syncthreads(); } }
        GSYNC();
        { IDS(); for (int rep = 0; rep < REP_N2 * REP_TK; ++rep) phase_topk(KPP(), l, lds, tid, lane, wave, bid, G); }
        GSYNC();
        {
            unsigned char* ws = KPP()->ws;
            pg8::Gemm g{(const pg8::bf16_t*)(ws + WS_XS), (const pg8::bf16_t*)(ws + WS_WT1), NE * ME, NE * 2048, 1024}; GroupOrder S{NE, (l == 0) ? 17 : 16, 8, 17, 8, G, bid};
            EpiMoe1 E{(bf16*)(ws + WS_ACT)};
            for (int rep = 0; rep < REP_GEMM * REP_GM1; ++rep) pg8::gemm_phase<EpiMoe1, GroupOrder, true, true>(lds, g, S, E);
        }
        GSYNC();
        {
            unsigned char* ws = KPP()->ws;
            pg8::Gemm g{(const pg8::bf16_t*)(ws + WS_ACT), (const pg8::bf16_t*)(ws + WS_WT2), NE * ME, NE * 1024, 1024}; GroupOrder S{NE, (l == 0) ? 17 : 16, 4, 17, 4, G, bid};
            EpiMoe2 E{(bf16*)(ws + WS_XS), (const float*)(ws + WS_TOPW)};
            for (int rep = 0; rep < REP_GEMM * REP_GM2; ++rep) pg8::gemm_phase<EpiMoe2, GroupOrder, true, true>(lds, g, S, E);
        }
        GSYNC();
        { IDS(); for (int rep = 0; rep < ((l == 1) ? REP_CMB : 1); ++rep) phase_combine(KPP(), l, lds, tid, lane, wave, bid, G); }
        if (l == 0) GSYNC();
        for (int rep = 1; rep < REP_SYNC; ++rep) { for (int k = 0; k < 12; ++k) GSYNC(); }
    }
#ifdef PROBE_WAIT
    if (bid == PROBE_WAIT - 1) { const unsigned long long t0 = __builtin_amdgcn_s_memrealtime(); while (__builtin_amdgcn_s_memrealtime() - t0 < wacc) __builtin_amdgcn_s_sleep(8); }
#endif
}

extern "C" void kernel_launch(void* const* d_in, const int* in_sizes, int n_in, void* d_out, int out_size, void* d_ws, size_t ws_size, hipStream_t stream) {
    static int grid = 0;
    if (grid == 0) {
        if (n_in != 22 || out_size != ML * D || ws_size < WS_END) { fprintf(stderr, "kernel_launch: unexpected shapes (n_in %d out %d ws %zu, need %zu)\n", n_in, out_size, ws_size, (size_t)WS_END); grid = -1; return; }
        int dev = 0, cus = 0, per_cu = 0;
        if (hipGetDevice(&dev) != hipSuccess || hipDeviceGetAttribute(&cus, hipDeviceAttributeMultiprocessorCount, dev) != hipSuccess) { grid = -1; return; }
        if (hipFuncSetAttribute((const void*)mk_fwd, hipFuncAttributeMaxDynamicSharedMemorySize, LDS_BYTES) != hipSuccess) { fprintf(stderr, "kernel_launch: hipFuncSetAttribute failed\n"); grid = -1; return; }
        if (hipOccupancyMaxActiveBlocksPerMultiprocessor(&per_cu, (const void*)mk_fwd, 512, LDS_BYTES) != hipSuccess || per_cu < 1) { fprintf(stderr, "kernel_launch: occupancy query says %d\n", per_cu); (void)hipGetLastError(); }
        grid = cus;
        fprintf(stderr, "kernel_launch: grid %d, occupancy %d/CU, ws %zu\n", grid, per_cu, ws_size);
    }
    if (grid < 0) return;
    if (hipMemsetAsync(d_ws, 0, 16384, stream) != hipSuccess) { fprintf(stderr, "kernel_launch: memset failed\n"); return; }
    KP hp{};
    const float** f = (const float**)&hp;
    for (int i = 0; i < 22; ++i) f[i] = (const float*)d_in[i];
    hp.out = (float*)d_out; hp.ws = (unsigned char*)d_ws;
    void* args[] = {&hp};
    hipError_t e = hipLaunchCooperativeKernel((const void*)mk_fwd, dim3(grid), dim3(512), args, LDS_BYTES, stream);
    if (e != hipSuccess) fprintf(stderr, "kernel_launch: cooperative launch failed: %s\n", hipGetErrorString(e));
}
```

```cpp
#include <hip/hip_runtime.h>
#include <hip/hip_cooperative_groups.h>
#include <cstdio>
#include <cstdint>
namespace cg = cooperative_groups;

namespace pg8 {
#define PG8_LAS __attribute__((address_space(3)))
typedef unsigned short bf16_t;
typedef short bf16x8 __attribute__((ext_vector_type(8)));
typedef float f32x4 __attribute__((ext_vector_type(4)));
typedef unsigned u32x4 __attribute__((ext_vector_type(4)));
constexpr int BM = 256, BK = 64, HALF = 128, HTB = HALF * BK * 2  , STAGE_BYTES = 8 * HTB, NXCD = 8, WGM = 8;

__host__ __device__ __forceinline__ int lds_byte(int r, int c) { const int st = (r >> 4) * 2 + (c >> 5), rr = r & 15, cc = c & 31, ob = rr * 64 + cc * 2; return st * 1024 + (ob ^ (((ob >> 9) & 1) << 5)); }
__host__ __device__ __forceinline__ void stage_rc(int b, int& R, int& C) { const int st = b / 1024, sb = b % 1024, swz = sb ^ (((sb >> 9) & 1) << 5); R = (st >> 1) * 16 + swz / 64; C = (st & 1) * 32 + (swz % 64) / 2; }
__host__ __device__ __forceinline__ int perm32(int rho) { const int n = rho >> 4, i = rho & 15; return 8 * (i >> 2) + 4 * n + (i & 3); }

struct Unit { int pm, pn; };
struct Gemm { const bf16_t* A; const bf16_t* Bt; int M, N, K; };

struct StaticOrder {
    int nM, nN, nwg, G, c;
    __host__ __device__ void init(int M, int N, int G_, int c_) { nM = M / BM; nN = N / BM; nwg = nM * nN; G = G_; c = c_; }
    __host__ __device__ bool next(int i, Unit& u) const {
        const long L = (long)i * G + c; if (L >= nwg) return false;
        int wgid = (int)L; { const int q = nwg / NXCD, r = nwg % NXCD, xcd = wgid % NXCD, off = wgid / NXCD; wgid = (xcd < r ? xcd * (q + 1) : r * (q + 1) + (xcd - r) * q) + off; }
        const int nig = WGM * nN, gid = wgid / nig, fm = gid * WGM, gsz = (nM - fm) < WGM ? (nM - fm) : WGM;
        u.pm = fm + ((wgid % nig) % gsz); u.pn = (wgid % nig) / gsz; return true;
    }
    __device__ __forceinline__ void a_ready(const Unit&) const {}
    __device__ __forceinline__ void done(const Unit&) const {}
};

__device__ __forceinline__ unsigned cvt_pk_bf16(float lo, float hi) { unsigned r; asm volatile("v_cvt_pk_bf16_f32 %0, %1, %2" : "=v"(r) : "v"(lo), "v"(hi)); return r; }
typedef float f32x2 __attribute__((ext_vector_type(2)));
__device__ __forceinline__ f32x2 gelu_pk(f32x2 v) {
    const f32x2 av = __builtin_elementwise_abs(v), d = av * 0.2316418882f + 1.0f;
    f32x2 t; t.x = __builtin_amdgcn_rcpf(d.x); t.y = __builtin_amdgcn_rcpf(d.y);
    f32x2 q = t * 0.5307027145f + (-0.7265760135f); q = q * t + 0.7107068705f; q = q * t + (-0.142248368f); q = q * t + 0.127414796f; q = q * t;
    const f32x2 s = (v * v) * (-0.72134752044f);
    f32x2 e; e.x = __builtin_amdgcn_exp2f(s.x); e.y = __builtin_amdgcn_exp2f(s.y);
    const f32x2 m = v * (q * e), r = v - m;
    f32x2 o; o.x = v.x < 0.f ? m.x : r.x; o.y = v.y < 0.f ? m.y : r.y; return o;
}

template <int ACT  > struct EpiBf16 {
    static constexpr bool PERM = true, AFTER_DRAIN = false, CHAIN = false; static_assert(ACT == 0 || ACT == 1, "EpiBf16: ACT is 0 (none) or 1 (gelu_pk)");
    bf16_t* O; int ldc; const float* bias; int split_cols; size_t split_stride; float scale0;
    __device__ __forceinline__ void operator()(const f32x4 (&acc)[2][2][4][2], const Unit& u, int wr, int wc, int fr, int fq) const {
        const int row0 = u.pm * BM + wr * 64 + fr; int colt = u.pn * BM; bf16_t* base = O;
        float sc = 1.f; if (split_cols) { const int t = colt / split_cols; base += (size_t)t * split_stride; colt -= t * split_cols; if (t == 0) sc = scale0; }
        const int col0 = colt + wc * 32 + 8 * fq, bcol0 = u.pn * BM + wc * 32 + 8 * fq;
        f32x4 bv[2][2];
#pragma unroll
        for (int bj = 0; bj < 2; ++bj)
#pragma unroll
            for (int n = 0; n < 2; ++n) bv[bj][n] = bias ? *(const f32x4*)(bias + bcol0 + bj * HALF + 4 * n) : (f32x4){0.f, 0.f, 0.f, 0.f};
#pragma unroll
        for (int ai = 0; ai < 2; ++ai)
#pragma unroll
            for (int m = 0; m < 4; ++m) { bf16_t* rowp = base + (size_t)(row0 + ai * HALF + m * 16) * ldc + col0;
#pragma unroll
                for (int bj = 0; bj < 2; ++bj) { f32x4 v0 = acc[ai][bj][m][0] + bv[bj][0], v1 = acc[ai][bj][m][1] + bv[bj][1];
                    if (ACT == 1) { f32x2 a = gelu_pk((f32x2){v0[0], v0[1]}), b = gelu_pk((f32x2){v0[2], v0[3]}), c = gelu_pk((f32x2){v1[0], v1[1]}), d = gelu_pk((f32x2){v1[2], v1[3]});
                        v0 = (f32x4){a.x, a.y, b.x, b.y}; v1 = (f32x4){c.x, c.y, d.x, d.y}; }
                    v0 = v0 * sc; v1 = v1 * sc; u32x4 w; w.x = cvt_pk_bf16(v0[0], v0[1]); w.y = cvt_pk_bf16(v0[2], v0[3]); w.z = cvt_pk_bf16(v1[0], v1[1]); w.w = cvt_pk_bf16(v1[2], v1[3]);
                    *(u32x4*)(rowp + bj * HALF) = w; } }
    }
};
template <class Epi, class Sched, bool ALIGN_EPI = false, bool SP2 = false>
__device__ __forceinline__ void gemm_phase(PG8_LAS unsigned char* lds, const Gemm g, const Sched& S, const Epi& E) {
    int tid_ = threadIdx.x; asm volatile("" : "+v"(tid_));
    const int tid = tid_, wid = __builtin_amdgcn_readfirstlane(tid >> 6), lane = tid & 63, wr = wid >> 2, wc = wid & 3, fr = lane & 15, fq = lane >> 4;
    const int K = g.K, nt = K / BK;
    unsigned voffA[2], voffB[2];
#pragma unroll
    for (int i = 0; i < 2; ++i) { int R, C; stage_rc(tid * 16 + i * 8192, R, C); const int Rb = Epi::PERM ? ((R & ~31) + perm32(R & 31)) : R;
        voffA[i] = (unsigned)(R * K + C) * 2u; voffB[i] = (unsigned)(Rb * K + C) * 2u; }
    const size_t kstep = (size_t)(BK * 2);
    const size_t hstep = (size_t)HALF * K * 2;
    const size_t tstep = 2 * hstep;
    const unsigned ldsw = (unsigned)wid * 1024u;
    const int aoff = lds_byte(wr * 64 + fr, fq * 8), boff = lds_byte(wc * 32 + fr, fq * 8);
#define PG8_SA(b, h) (((b) * 2 + (h)) * HTB)
#define PG8_SB(b, h) ((4 + (b) * 2 + (h)) * HTB)
#define PG8_STAGE(bufoff, gbase, voff) do { _Pragma("unroll") for (int _i = 0; _i < 2; ++_i) \
        __builtin_amdgcn_global_load_lds((const unsigned*)((const char*)(gbase) + (voff)[_i]), (PG8_LAS unsigned*)(lds + (bufoff) + ldsw + _i * 8192), 16, 0, 0); } while (0)
#define PG8_LDA(dst, b, h) do { _Pragma("unroll") for (int m = 0; m < 4; ++m) _Pragma("unroll") for (int k = 0; k < 2; ++k) dst[m][k] = *(const PG8_LAS bf16x8*)(lds + PG8_SA(b, h) + aoff + m * 2048 + k * 1024); } while (0)
#define PG8_LDB(dst, b, h) do { _Pragma("unroll") for (int n = 0; n < 2; ++n) _Pragma("unroll") for (int k = 0; k < 2; ++k) dst[n][k] = *(const PG8_LAS bf16x8*)(lds + PG8_SB(b, h) + boff + n * 2048 + k * 1024); } while (0)
#define PG8_MMA(ai, bj, At, Bt) do { __builtin_amdgcn_s_setprio(1); _Pragma("unroll") for (int m = 0; m < 4; ++m) _Pragma("unroll") for (int n = 0; n < 2; ++n) _Pragma("unroll") for (int k = 0; k < 2; ++k) \
        acc[ai][bj][m][n] = __builtin_amdgcn_mfma_f32_16x16x32_bf16(Bt[n][k], At[m][k], acc[ai][bj][m][n], 0, 0, 0); __builtin_amdgcn_s_setprio(0); } while (0)
#define PG8_WAIT_V(n) asm volatile("s_waitcnt vmcnt(" #n ")" ::: "memory")
#define PG8_WAIT_L(n) asm volatile("s_waitcnt lgkmcnt(" #n ")" ::: "memory")
#define PG8_BAR __builtin_amdgcn_s_barrier()
#define PG8_SCHED __builtin_amdgcn_sched_barrier(0)
    Unit cur, nxt; int ui = 0;
    if (!S.next(0, cur)) return;
    f32x4 acc[2][2][4][2];
#pragma unroll
    for (int a = 0; a < 2; ++a)
#pragma unroll
        for (int b = 0; b < 2; ++b)
#pragma unroll
            for (int m = 0; m < 4; ++m)
#pragma unroll
                for (int n = 0; n < 2; ++n) acc[a][b][m][n] = (f32x4){0.f, 0.f, 0.f, 0.f};
    bf16x8 At[4][2], B0[2][2], B1[2][2];
    const char* cA = (const char*)g.A + (size_t)cur.pm * tstep; const char* cB = (const char*)g.Bt + (size_t)cur.pn * tstep;
    S.a_ready(cur);
    if constexpr (SP2) {
        PG8_STAGE(PG8_SB(0, 0), cB, voffB); PG8_STAGE(PG8_SB(0, 1), cB + hstep, voffB); PG8_STAGE(PG8_SA(0, 0), cA, voffA); PG8_STAGE(PG8_SA(0, 1), cA + hstep, voffA);
        if (wr == 1) PG8_BAR;
        PG8_WAIT_V(2); PG8_BAR;
        PG8_STAGE(PG8_SB(1, 0), cB + kstep, voffB); PG8_STAGE(PG8_SA(1, 0), cA + kstep, voffA); PG8_STAGE(PG8_SB(1, 1), cB + hstep + kstep, voffB);
        PG8_WAIT_V(6); PG8_BAR;
    } else {
        PG8_STAGE(PG8_SB(0, 0), cB, voffB); PG8_STAGE(PG8_SA(0, 0), cA, voffA); PG8_STAGE(PG8_SB(0, 1), cB + hstep, voffB); PG8_STAGE(PG8_SA(0, 1), cA + hstep, voffA);
        if (wr == 1) PG8_BAR;
        PG8_WAIT_V(4); PG8_BAR;
        PG8_STAGE(PG8_SB(1, 0), cB + kstep, voffB); PG8_STAGE(PG8_SA(1, 0), cA + kstep, voffA); PG8_STAGE(PG8_SB(1, 1), cB + hstep + kstep, voffB);
        PG8_WAIT_V(6); PG8_BAR;
    }
    for (;;) {
        const bool has_next = S.next(ui + 1, nxt);
        const char* nA = has_next ? (const char*)g.A + (size_t)nxt.pm * tstep : cA; const char* nB = has_next ? (const char*)g.Bt + (size_t)nxt.pn * tstep : cB;
        for (int t = 0; t < nt; t += 2) {
            const bool last = (t == nt - 2);
            const char* a1 = cA + (size_t)(t + 1) * kstep;
            const char* a2 = last ? nA : cA + (size_t)(t + 2) * kstep; const char* b2 = last ? nB : cB + (size_t)(t + 2) * kstep;
            const char* a3 = a2 + kstep; const char* b3 = b2 + kstep;
            if (last && has_next) S.a_ready(nxt);
            if constexpr (SP2) {
            PG8_LDB(B0, 0, 0); PG8_LDB(B1, 0, 1); PG8_SCHED; PG8_LDA(At, 0, 0); PG8_STAGE(PG8_SA(1, 1), a1 + hstep, voffA);
            PG8_WAIT_V(8); PG8_WAIT_L(0); PG8_BAR; PG8_MMA(0, 0, At, B0); PG8_MMA(0, 1, At, B1); PG8_BAR; PG8_SCHED;
            PG8_LDA(At, 0, 1); PG8_STAGE(PG8_SB(0, 0), b2, voffB); PG8_STAGE(PG8_SB(0, 1), b2 + hstep, voffB); PG8_STAGE(PG8_SA(0, 0), a2, voffA);
            PG8_WAIT_V(8); PG8_WAIT_L(0); PG8_BAR; PG8_MMA(1, 0, At, B0); PG8_MMA(1, 1, At, B1); PG8_BAR; PG8_SCHED;
            PG8_LDB(B0, 1, 0); PG8_LDB(B1, 1, 1); PG8_SCHED; PG8_LDA(At, 1, 0); PG8_STAGE(PG8_SA(0, 1), a2 + hstep, voffA);
            PG8_WAIT_V(8); PG8_WAIT_L(0); PG8_BAR; PG8_MMA(0, 0, At, B0); PG8_MMA(0, 1, At, B1); PG8_BAR; PG8_SCHED;
            PG8_LDA(At, 1, 1); PG8_STAGE(PG8_SB(1, 0), b3, voffB); PG8_STAGE(PG8_SB(1, 1), b3 + hstep, voffB); PG8_STAGE(PG8_SA(1, 0), a3, voffA);
            PG8_WAIT_V(8); PG8_WAIT_L(0); PG8_BAR; PG8_MMA(1, 0, At, B0); PG8_MMA(1, 1, At, B1); PG8_BAR; PG8_SCHED;
            } else {
            PG8_LDB(B0, 0, 0); PG8_SCHED; PG8_LDA(At, 0, 0); PG8_STAGE(PG8_SA(1, 1), a1 + hstep, voffA);
            PG8_WAIT_L(8); PG8_BAR; PG8_WAIT_L(0); PG8_MMA(0, 0, At, B0); PG8_BAR; PG8_SCHED;
            PG8_LDB(B1, 0, 1); PG8_STAGE(PG8_SB(0, 0), b2, voffB);
            PG8_BAR; PG8_WAIT_L(0); PG8_MMA(0, 1, At, B1); PG8_BAR;
            PG8_LDA(At, 0, 1); PG8_STAGE(PG8_SA(0, 0), a2, voffA);
            PG8_BAR; PG8_WAIT_L(0); PG8_MMA(1, 0, At, B0); PG8_BAR; PG8_SCHED;
            PG8_STAGE(PG8_SB(0, 1), b2 + hstep, voffB);
            PG8_WAIT_V(6); PG8_BAR; PG8_MMA(1, 1, At, B1); PG8_BAR;
            PG8_LDB(B0, 1, 0); PG8_SCHED; PG8_LDA(At, 1, 0); PG8_STAGE(PG8_SA(0, 1), a2 + hstep, voffA);
            PG8_WAIT_L(8); PG8_BAR; PG8_WAIT_L(0); PG8_MMA(0, 0, At, B0); PG8_BAR; PG8_SCHED;
            PG8_LDB(B1, 1, 1); PG8_STAGE(PG8_SB(1, 0), b3, voffB);
            PG8_BAR; PG8_WAIT_L(0); PG8_MMA(0, 1, At, B1); PG8_BAR;
            PG8_LDA(At, 1, 1); PG8_STAGE(PG8_SA(1, 0), a3, voffA);
            PG8_BAR; PG8_WAIT_L(0); PG8_MMA(1, 0, At, B0); PG8_BAR; PG8_SCHED;
            PG8_STAGE(PG8_SB(1, 1), b3 + hstep, voffB);
            PG8_WAIT_V(6); PG8_BAR; PG8_MMA(1, 1, At, B1); PG8_BAR;
            }
        }
        if constexpr (ALIGN_EPI) { if (wr == 0) PG8_BAR; }
        bool keep_acc = false;
        if constexpr (Epi::CHAIN) { keep_acc = E.chain(acc, cur, wr, wc, fr, fq); S.done(cur); }
        else if constexpr (!Epi::AFTER_DRAIN) { E(acc, cur, wr, wc, fr, fq); S.done(cur); }
        if (!has_next) break;
        if (!keep_acc) {
#pragma unroll
        for (int a = 0; a < 2; ++a)
#pragma unroll
            for (int b = 0; b < 2; ++b)
#pragma unroll
                for (int m = 0; m < 4; ++m)
#pragma unroll
                    for (int n = 0; n < 2; ++n) acc[a][b][m][n] = (f32x4){0.f, 0.f, 0.f, 0.f};
        }
        cur = nxt; cA = nA; cB = nB; ++ui;
        if constexpr (ALIGN_EPI) { if (wr == 1) PG8_BAR; }
    }
    PG8_WAIT_V(0);
    if constexpr (!ALIGN_EPI) { if (wr == 0) PG8_BAR; }
    PG8_BAR;
    if constexpr (Epi::AFTER_DRAIN) { E.fused(acc, cur, wr, wc, fr, fq, lds, wid, lane); S.done(cur); }
#undef PG8_SA
#undef PG8_SB
#undef PG8_STAGE
#undef PG8_LDA
#undef PG8_LDB
#undef PG8_MMA
#undef PG8_WAIT_V
#undef PG8_WAIT_L
#undef PG8_BAR
#undef PG8_SCHED
}
}

#define LAS __attribute__((address_space(3)))
typedef unsigned short bf16;
typedef short bf16x8 __attribute__((ext_vector_type(8)));
typedef float f32x4 __attribute__((ext_vector_type(4)));
typedef unsigned u32x4 __attribute__((ext_vector_type(4)));
typedef unsigned u32x2 __attribute__((ext_vector_type(2)));

constexpr int D = 1024, NB = 8, T = 4096, CL = 256;
constexpr int ML = NB * T, MC = NB * CL, M = ML + MC;
constexpr int NZA = 3328, NZG = 3072;
constexpr int C_RQ = 0, C_RK = 256, C_RV = 512, C_RG = 1024, C_SU = 1536, C_SV = 2048, C_AQ = 2560, C_AK = 3072, C_AV = 3200;
constexpr int NE = 16, CAPL = 512, CAPC = 32, ME = NB * (CAPL + CAPC);
constexpr int NCH = 34;
constexpr float EPS = 1e-6f, LOG2E = 1.4426950408889634f;
constexpr int LDS_BYTES = 147456;

constexpr size_t MiB = 1u << 20;
constexpr size_t WS_ROPEC = 1 * MiB, WS_ROPES = 1 * MiB + 512 * 1024, WS_MODV = 2 * MiB, WS_AFF = 3 * MiB, WS_AFFC = 5 * MiB, WS_INV = 6 * MiB, WS_TOPW = 9 * MiB;
constexpr size_t WS_WTIN = 16 * MiB, WS_WTBR = WS_WTIN + (size_t)6400 * 1024 * 2, WS_WTOUT = WS_WTBR + (size_t)3072 * 512 * 2;
constexpr size_t WS_X = 34 * MiB, WS_H = 170 * MiB, WS_R = 238 * MiB;
constexpr size_t WS_ZA = WS_R, WS_G = WS_R, WS_RS = 459 * MiB, WS_ST = 527 * MiB;
constexpr size_t WS_XS = WS_R, WS_ACT = 374 * MiB, WS_WT1 = 510 * MiB, WS_WT2 = 574 * MiB, WS_END = 606 * MiB;
static_assert(WS_WTOUT + 2 * MiB <= WS_X && WS_ZA + (size_t)M * NZA * 2 <= WS_RS && WS_ST + (size_t)NB * 4 * NCH * 128 * 128 * 2 <= WS_END, "ws map");

struct KP {
    const float *x, *c, *ctx, *c_ctx, *w_mod, *b_mod, *norm1_g, *norm2_g, *w_in, *dec_f, *dec_b, *sgu_w, *sgu_b, *qn_g, *kn_g, *sink, *w_branch, *w_out, *w_router, *w_eg, *w_eu, *w_ed;
    float* out; unsigned char* ws;
};
typedef const __attribute__((address_space(4))) KP* KPC;

#define LDS_WAIT() asm volatile("s_waitcnt lgkmcnt(0)" ::: "memory")
__device__ __forceinline__ unsigned pk2(float lo, float hi) { return pg8::cvt_pk_bf16(lo, hi); }
__device__ __forceinline__ float bflo(unsigned w) { return __uint_as_float(w << 16); }
__device__ __forceinline__ float bfhi(unsigned w) { return __uint_as_float(w & 0xffff0000u); }
__device__ __forceinline__ void unpack8(const u32x4 w, float (&f)[8]) { f[0] = bflo(w.x); f[1] = bfhi(w.x); f[2] = bflo(w.y); f[3] = bfhi(w.y); f[4] = bflo(w.z); f[5] = bfhi(w.z); f[6] = bflo(w.w); f[7] = bfhi(w.w); }
__device__ __forceinline__ u32x4 pack8(const float (&f)[8]) { u32x4 o; o.x = pk2(f[0], f[1]); o.y = pk2(f[2], f[3]); o.z = pk2(f[4], f[5]); o.w = pk2(f[6], f[7]); return o; }
template <int MASK> __device__ __forceinline__ float swz_xor(float v) { static_assert(MASK > 0 && MASK < 32, "swz_xor: 1..31"); return __builtin_bit_cast(float, __builtin_amdgcn_ds_swizzle(__builtin_bit_cast(int, v), 0x1f | (MASK << 10))); }
template <int MASK> __device__ __forceinline__ int swz_xor_i(int v) { return __builtin_amdgcn_ds_swizzle(v, 0x1f | (MASK << 10)); }
__device__ __forceinline__ float sum_x32(float v) { const unsigned u = __builtin_bit_cast(unsigned, v); auto r = __builtin_amdgcn_permlane32_swap(u, u, false, false); return __builtin_bit_cast(float, (unsigned)r[0]) + __builtin_bit_cast(float, (unsigned)r[1]); }
__device__ __forceinline__ float max_x32(float v) { const unsigned u = __builtin_bit_cast(unsigned, v); auto r = __builtin_amdgcn_permlane32_swap(u, u, false, false); return fmaxf(__builtin_bit_cast(float, (unsigned)r[0]), __builtin_bit_cast(float, (unsigned)r[1])); }
__device__ __forceinline__ int sum_x32_i(int v) { auto r = __builtin_amdgcn_permlane32_swap((unsigned)v, (unsigned)v, false, false); return (int)r[0] + (int)r[1]; }
__device__ __forceinline__ float wave_sum(float v) { v += swz_xor<1>(v); v += swz_xor<2>(v); v += swz_xor<4>(v); v += swz_xor<8>(v); v += swz_xor<16>(v); return sum_x32(v); }
__device__ __forceinline__ float wave_max(float v) { v = fmaxf(v, swz_xor<1>(v)); v = fmaxf(v, swz_xor<2>(v)); v = fmaxf(v, swz_xor<4>(v)); v = fmaxf(v, swz_xor<8>(v)); v = fmaxf(v, swz_xor<16>(v)); return max_x32(v); }
__device__ __forceinline__ int wave_sum_i(int v) { v += swz_xor_i<1>(v); v += swz_xor_i<2>(v); v += swz_xor_i<4>(v); v += swz_xor_i<8>(v); v += swz_xor_i<16>(v); return sum_x32_i(v); }
__device__ __forceinline__ float sum_x16_x32(float v) { v += swz_xor<16>(v); return sum_x32(v); }
__device__ __forceinline__ float sum_x1_x2(float v) { v += swz_xor<1>(v); v += swz_xor<2>(v); return v; }
__device__ __forceinline__ float ex2(float x) { return __builtin_amdgcn_exp2f(x); }
__device__ __forceinline__ float sigmoidf_(float x) { return 1.f / (1.f + ex2(-x * LOG2E)); }
__device__ __forceinline__ float gelu_tanh(float x) { const float u = 0.7978845608028654f * (x + 0.044715f * x * x * x); return x / (1.f + ex2(-2.f * LOG2E * u)); }
__device__ __forceinline__ f32x4 mfma16(bf16x8 a, bf16x8 b, f32x4 c) { return __builtin_amdgcn_mfma_f32_16x16x32_bf16(a, b, c, 0, 0, 0); }
__device__ __forceinline__ bf16x8 as_bf16x8(u32x4 w) { return __builtin_bit_cast(bf16x8, w); }
__device__ __forceinline__ float log2_sigmoid(float a) { return -log1pf(__expf(-a)) * LOG2E; }

#ifndef WGM_
#define WGM_ 8
#endif
struct GroupOrder {
    int nG, nM, nN, pmS, pnS, G, c;
    __device__ __forceinline__ bool next(int i, pg8::Unit& u) const {
        const long L = (long)i * G + c; const int tot = nG * nM * nN; if (L >= tot) return false;
        int wgid = (int)L; { const int q = tot / 8, r = tot % 8, xcd = wgid % 8, off = wgid / 8; wgid = (xcd < r ? xcd * (q + 1) : r * (q + 1) + (xcd - r) * q) + off; }
        const int per = nM * nN, g = wgid / per, rem = wgid - g * per;
        const int nig = WGM_ * nN, gid = rem / nig, fm = gid * WGM_, gsz = (nM - fm) < WGM_ ? (nM - fm) : WGM_;
        u.pm = g * pmS + fm + ((rem % nig) % gsz); u.pn = g * pnS + (rem % nig) / gsz; return true;
    }
    __device__ __forceinline__ void a_ready(const pg8::Unit&) const {}
    __device__ __forceinline__ void done(const pg8::Unit&) const {}
};
struct MergeOrder {
    int nM, G, c;
    __device__ __forceinline__ bool next(int i, pg8::Unit& u) const {
        const int ii = i / 3, g = i - 3 * ii; const long L = (long)ii * G + c; const int tot = nM * 4; if (L >= tot) return false;
        int wgid = (int)L; { const int q = tot / 8, r = tot % 8, xcd = wgid % 8, off = wgid / 8; wgid = (xcd < r ? xcd * (q + 1) : r * (q + 1) + (xcd - r) * q) + off; }
        const int nig = 32, gid = wgid / nig, fm = gid * 8, gsz = (nM - fm) < 8 ? (nM - fm) : 8;
        u.pm = g * (M / 256) + fm + ((wgid % nig) % gsz); u.pn = g * 4 + (wgid % nig) / gsz; return true;
    }
    __device__ __forceinline__ void a_ready(const pg8::Unit&) const {}
    __device__ __forceinline__ void done(const pg8::Unit&) const {}
};

struct EpiZA {
    static constexpr bool PERM = true, AFTER_DRAIN = false, CHAIN = false;
    bf16* O;
    __device__ __forceinline__ void operator()(const f32x4 (&acc)[2][2][4][2], const pg8::Unit& u, int wr, int wc, int fr, int fq) const {
        const int row0 = u.pm * 256 + wr * 64 + fr, col0 = u.pn * 256 + wc * 32 + 8 * fq; const bool act = false;
#pragma unroll
        for (int ai = 0; ai < 2; ++ai)
#pragma unroll
            for (int m = 0; m < 4; ++m) { bf16* rowp = O + (size_t)(row0 + ai * 128 + m * 16) * NZA + col0;
#pragma unroll
                for (int bj = 0; bj < 2; ++bj) { const f32x4 v0 = acc[ai][bj][m][0], v1 = acc[ai][bj][m][1];
                    float o[8] = {v0[0], v0[1], v0[2], v0[3], v1[0], v1[1], v1[2], v1[3]};
                    if (act) {
#pragma unroll
                        for (int k = 0; k < 8; ++k) o[k] = gelu_tanh(o[k]); }
                    *(u32x4*)(rowp + bj * 128) = pack8(o); } }
    }
};
struct EpiNull {
    static constexpr bool PERM = true, AFTER_DRAIN = false, CHAIN = false;
    __device__ __forceinline__ void operator()(const f32x4 (&acc)[2][2][4][2], const pg8::Unit& u, int wr, int wc, int fr, int fq) const {
#pragma unroll
        for (int ai = 0; ai < 2; ++ai)
#pragma unroll
            for (int m = 0; m < 4; ++m)
#pragma unroll
                for (int bj = 0; bj < 2; ++bj) { asm volatile("" :: "v"(acc[ai][bj][m][0]), "v"(acc[ai][bj][m][1])); }
    }
};
struct EpiSig {
    static constexpr bool PERM = true, AFTER_DRAIN = false, CHAIN = false;
    bf16* O;
    __device__ __forceinline__ void operator()(const f32x4 (&acc)[2][2][4][2], const pg8::Unit& u, int wr, int wc, int fr, int fq) const {
        const int row0 = u.pm * 256 + wr * 64 + fr, col0 = u.pn * 256 + wc * 32 + 8 * fq;
#pragma unroll
        for (int ai = 0; ai < 2; ++ai)
#pragma unroll
            for (int m = 0; m < 4; ++m) { bf16* rowp = O + (size_t)(row0 + ai * 128 + m * 16) * NZG + col0;
#pragma unroll
                for (int bj = 0; bj < 2; ++bj) { const f32x4 v0 = acc[ai][bj][m][0], v1 = acc[ai][bj][m][1];
                    float o[8] = {v0[0], v0[1], v0[2], v0[3], v1[0], v1[1], v1[2], v1[3]};
#pragma unroll
                    for (int k = 0; k < 8; ++k) o[k] = fmaxf(sigmoidf_(o[k]), 1e-20f);
                    *(u32x4*)(rowp + bj * 128) = pack8(o); } }
    }
};
struct EpiMergeChain {
    static constexpr bool PERM = true, AFTER_DRAIN = false, CHAIN = true;
    const bf16* Gt; bf16* Hm;
    __device__ __forceinline__ bool chain(f32x4 (&acc)[2][2][4][2], const pg8::Unit& u, int wr, int wc, int fr, int fq) const {
        const int g = u.pm / (M / 256), m = u.pm - g * (M / 256), n = u.pn - g * 4;
        const int row0 = m * 256 + wr * 64 + fr, col0 = n * 256 + wc * 32 + 8 * fq;
#pragma unroll
        for (int ai = 0; ai < 2; ++ai) {
            u32x4 gw[4][2], hw[4][2];
#pragma unroll
            for (int mm = 0; mm < 4; ++mm)
#pragma unroll
                for (int bj = 0; bj < 2; ++bj) gw[mm][bj] = *(const u32x4*)(Gt + (size_t)(row0 + ai * 128 + mm * 16) * NZG + g * 1024 + col0 + bj * 128);
            if (g < 2) {
#pragma unroll
                for (int mm = 0; mm < 4; ++mm)
#pragma unroll
                    for (int bj = 0; bj < 2; ++bj) hw[mm][bj] = *(const u32x4*)(Gt + (size_t)(row0 + ai * 128 + mm * 16) * NZG + (g + 1) * 1024 + col0 + bj * 128);
            }
#pragma unroll
            for (int mm = 0; mm < 4; ++mm)
#pragma unroll
                for (int bj = 0; bj < 2; ++bj) {
                    float sc[8]; unpack8(gw[mm][bj], sc);
                    if (g < 2) { float sn[8]; unpack8(hw[mm][bj], sn);
#pragma unroll
                        for (int k = 0; k < 8; ++k) sc[k] *= __builtin_amdgcn_rcpf(sn[k]); }
                    f32x4& v0 = acc[ai][bj][mm][0]; f32x4& v1 = acc[ai][bj][mm][1];
                    v0[0] *= sc[0]; v0[1] *= sc[1]; v0[2] *= sc[2]; v0[3] *= sc[3]; v1[0] *= sc[4]; v1[1] *= sc[5]; v1[2] *= sc[6]; v1[3] *= sc[7];
                    if (g == 2) { u32x4 w; w.x = pk2(v0[0], v0[1]); w.y = pk2(v0[2], v0[3]); w.z = pk2(v1[0], v1[1]); w.w = pk2(v1[2], v1[3]);
                        *(u32x4*)(Hm + (size_t)(row0 + ai * 128 + mm * 16) * 1024 + col0 + bj * 128) = w; }
                }
        }
        return g < 2;
    }
};
struct EpiMerge {
    static constexpr bool PERM = true, AFTER_DRAIN = false, CHAIN = false;
    const bf16* Gt; bf16* Hm;
    __device__ __forceinline__ void operator()(const f32x4 (&acc)[2][2][4][2], const pg8::Unit& u, int wr, int wc, int fr, int fq) const {
        const int g = u.pm / (M / 256), m = u.pm - g * (M / 256), n = u.pn - g * 4;
        const int row0 = m * 256 + wr * 64 + fr, col0 = n * 256 + wc * 32 + 8 * fq;
#pragma unroll
        for (int ai = 0; ai < 2; ++ai) {
            u32x4 gw[4][2], ow[4][2];
#pragma unroll
            for (int mm = 0; mm < 4; ++mm)
#pragma unroll
                for (int bj = 0; bj < 2; ++bj) gw[mm][bj] = *(const u32x4*)(Gt + (size_t)(row0 + ai * 128 + mm * 16) * NZG + g * 1024 + col0 + bj * 128);
            if (g > 0) {
#pragma unroll
                for (int mm = 0; mm < 4; ++mm)
#pragma unroll
                    for (int bj = 0; bj < 2; ++bj) ow[mm][bj] = *(const u32x4*)(Hm + (size_t)(row0 + ai * 128 + mm * 16) * 1024 + col0 + bj * 128);
            }
#pragma unroll
            for (int mm = 0; mm < 4; ++mm)
#pragma unroll
                for (int bj = 0; bj < 2; ++bj) {
                    float gt[8]; unpack8(gw[mm][bj], gt);
                    const f32x4 v0 = acc[ai][bj][mm][0], v1 = acc[ai][bj][mm][1];
                    float o[8] = {v0[0], v0[1], v0[2], v0[3], v1[0], v1[1], v1[2], v1[3]};
#pragma unroll
                    for (int k = 0; k < 8; ++k) o[k] *= sigmoidf_(gt[k]);
                    if (g > 0) { float od[8]; unpack8(ow[mm][bj], od);
#pragma unroll
                        for (int k = 0; k < 8; ++k) o[k] += od[k]; }
                    *(u32x4*)(Hm + (size_t)(row0 + ai * 128 + mm * 16) * 1024 + col0 + bj * 128) = pack8(o);
                }
        }
    }
};
struct EpiOut {
    static constexpr bool PERM = true, AFTER_DRAIN = false, CHAIN = false;
    const float* xl; const float* xc; bf16* X; const float* modv; int from_f32;
    __device__ __forceinline__ void operator()(const f32x4 (&acc)[2][2][4][2], const pg8::Unit& u, int wr, int wc, int fr, int fq) const {
        const int row0 = u.pm * 256 + wr * 64 + fr, col0 = u.pn * 256 + wc * 32 + 8 * fq;
        const int bi = (u.pm * 256 < ML) ? ((u.pm * 256) >> 12) : 8;
        const float* g1 = modv + bi * 6144 + 2 * 1024;
        f32x4 gv[2][2];
#pragma unroll
        for (int bj = 0; bj < 2; ++bj) { gv[bj][0] = *(const f32x4*)(g1 + col0 + bj * 128); gv[bj][1] = *(const f32x4*)(g1 + col0 + bj * 128 + 4); }
        if (from_f32) {
            const float* src0 = (u.pm * 256 < ML) ? xl + (size_t)row0 * 1024 : xc + (size_t)(row0 - ML) * 1024;
#pragma unroll
            for (int ai = 0; ai < 2; ++ai) {
                f32x4 xv[4][2][2];
#pragma unroll
                for (int m = 0; m < 4; ++m)
#pragma unroll
                    for (int bj = 0; bj < 2; ++bj) { const float* s = src0 + (size_t)(ai * 128 + m * 16) * 1024 + col0 + bj * 128; xv[m][bj][0] = *(const f32x4*)s; xv[m][bj][1] = *(const f32x4*)(s + 4); }
#pragma unroll
                for (int m = 0; m < 4; ++m)
#pragma unroll
                    for (int bj = 0; bj < 2; ++bj) { const f32x4 o0 = xv[m][bj][0] + gv[bj][0] * acc[ai][bj][m][0], o1 = xv[m][bj][1] + gv[bj][1] * acc[ai][bj][m][1];
                        u32x4 w; w.x = pk2(o0[0], o0[1]); w.y = pk2(o0[2], o0[3]); w.z = pk2(o1[0], o1[1]); w.w = pk2(o1[2], o1[3]);
                        *(u32x4*)(X + (size_t)(row0 + ai * 128 + m * 16) * 1024 + col0 + bj * 128) = w; }
            }
        } else {
#pragma unroll
            for (int ai = 0; ai < 2; ++ai) {
                u32x4 xw[4][2];
#pragma unroll
                for (int m = 0; m < 4; ++m)
#pragma unroll
                    for (int bj = 0; bj < 2; ++bj) xw[m][bj] = *(const u32x4*)(X + (size_t)(row0 + ai * 128 + m * 16) * 1024 + col0 + bj * 128);
#pragma unroll
                for (int m = 0; m < 4; ++m)
#pragma unroll
                    for (int bj = 0; bj < 2; ++bj) { float xo[8]; unpack8(xw[m][bj], xo); const f32x4 a0 = acc[ai][bj][m][0], a1 = acc[ai][bj][m][1];
                        float o[8] = {xo[0] + gv[bj][0][0] * a0[0], xo[1] + gv[bj][0][1] * a0[1], xo[2] + gv[bj][0][2] * a0[2], xo[3] + gv[bj][0][3] * a0[3],
                                      xo[4] + gv[bj][1][0] * a1[0], xo[5] + gv[bj][1][1] * a1[1], xo[6] + gv[bj][1][2] * a1[2], xo[7] + gv[bj][1][3] * a1[3]};
                        *(u32x4*)(X + (size_t)(row0 + ai * 128 + m * 16) * 1024 + col0 + bj * 128) = pack8(o); }
            }
        }
    }
};
struct EpiMoe1 {
    static constexpr bool PERM = true, AFTER_DRAIN = false, CHAIN = false;
    bf16* ACT;
    __device__ __forceinline__ void operator()(const f32x4 (&acc)[2][2][4][2], const pg8::Unit& u, int wr, int wc, int fr, int fq) const {
        const int row0 = u.pm * 256 + wr * 64 + fr, col0 = (u.pn & 7) * 128 + wc * 32 + 8 * fq;
#pragma unroll
        for (int ai = 0; ai < 2; ++ai)
#pragma unroll
            for (int m = 0; m < 4; ++m) { const size_t r = (size_t)(row0 + ai * 128 + m * 16);
                const f32x4 a0 = acc[ai][0][m][0], a1 = acc[ai][0][m][1], u0 = acc[ai][1][m][0], u1 = acc[ai][1][m][1];
                float o[8];
#pragma unroll
                for (int k = 0; k < 4; ++k) { o[k] = a0[k] * sigmoidf_(a0[k]) * u0[k]; o[4 + k] = a1[k] * sigmoidf_(a1[k]) * u1[k]; }
                *(u32x4*)(ACT + r * 1024 + col0) = pack8(o); }
    }
};
struct EpiMoe2 {
    static constexpr bool PERM = true, AFTER_DRAIN = false, CHAIN = false;
    bf16* Y; const float* topw;
    __device__ __forceinline__ void operator()(const f32x4 (&acc)[2][2][4][2], const pg8::Unit& u, int wr, int wc, int fr, int fq) const {
        const int row0 = u.pm * 256 + wr * 64 + fr, col0 = (u.pn & 3) * 256 + wc * 32 + 8 * fq;
        float twv[2][4];
#pragma unroll
        for (int ai = 0; ai < 2; ++ai)
#pragma unroll
            for (int m = 0; m < 4; ++m) twv[ai][m] = topw[row0 + ai * 128 + m * 16];
#pragma unroll
        for (int ai = 0; ai < 2; ++ai)
#pragma unroll
            for (int m = 0; m < 4; ++m) { const size_t r = (size_t)(row0 + ai * 128 + m * 16); const float tw = twv[ai][m];
#pragma unroll
                for (int bj = 0; bj < 2; ++bj) { const f32x4 v0 = acc[ai][bj][m][0] * tw, v1 = acc[ai][bj][m][1] * tw;
                    u32x4 w; w.x = pk2(v0[0], v0[1]); w.y = pk2(v0[2], v0[3]); w.z = pk2(v1[0], v1[1]); w.w = pk2(v1[2], v1[3]);
                    *(u32x4*)(Y + r * 1024 + col0 + bj * 128) = w; } }
    }
};

__device__ __forceinline__ void tr_item(const float* W, int N, int k0, int n0, bf16* dst, int K, LAS float* scr, int lane) {
#pragma unroll 8
    for (int i = 0; i < 32; ++i) { const int kk = 2 * i + (lane >> 5); scr[kk * 33 + (lane & 31)] = W[(size_t)(k0 + kk) * N + n0 + (lane & 31)]; }
    LDS_WAIT();
    const int cc = lane & 7;
#pragma unroll
    for (int j = 0; j < 4; ++j) { const int n = (lane >> 3) + 8 * j; const LAS float* s = scr + (8 * cc) * 33 + n;
        u32x4 o; o.x = pk2(s[0 * 33], s[1 * 33]); o.y = pk2(s[2 * 33], s[3 * 33]); o.z = pk2(s[4 * 33], s[5 * 33]); o.w = pk2(s[6 * 33], s[7 * 33]);
        *(u32x4*)(dst + (size_t)n * K + 8 * cc) = o; }
    LDS_WAIT();
}
__device__ __forceinline__ void convert_small(KPC p, int l, LAS unsigned char* lds, int lane, int wave, int bid, int G) {
    LAS float* scr = (LAS float*)(lds + wave * 8448);
    const int gw = bid * 8 + wave, NGW = G * 8;
    constexpr int I_IN = 16 * 200, I_BR = 8 * 32, I_OUT = 16 * 32;
    bf16* wtin = (bf16*)(p->ws + WS_WTIN); bf16* wtbr = (bf16*)(p->ws + WS_WTBR); bf16* wtout = (bf16*)(p->ws + WS_WTOUT);
    for (int it = gw; it < I_IN + 3 * I_BR + I_OUT; it += NGW) {
        int r = it;
        if (r < I_IN) { const int kb = r / 200, nb = r % 200; tr_item(p->w_in + (size_t)l * 1024 * 6400, 6400, 64 * kb, 32 * nb, wtin + (size_t)(32 * nb) * 1024 + 64 * kb, 1024, scr, lane); continue; }
        r -= I_IN;
        if (r < 3 * I_BR) { const int br = r / I_BR, q = r % I_BR, kb = q / 32, nb = q % 32;
            tr_item(p->w_branch + ((size_t)l * 3 + br) * 512 * 1024, 1024, 64 * kb, 32 * nb, wtbr + (size_t)(br * 1024 + 32 * nb) * 512 + 64 * kb, 512, scr, lane); continue; }
        r -= 3 * I_BR;
        { const int kb = r / 32, nb = r % 32; tr_item(p->w_out + (size_t)l * 1024 * 1024, 1024, 64 * kb, 32 * nb, wtout + (size_t)(32 * nb) * 1024 + 64 * kb, 1024, scr, lane); }
    }
}
__device__ __forceinline__ void convert_experts(KPC p, int l, int lo, int hi, int widx, int nw, LAS unsigned char* lds, int lane, int wave) {
    LAS float* scr = (LAS float*)(lds + wave * 8448);
    bf16* wt1 = (bf16*)(p->ws + WS_WT1); bf16* wt2 = (bf16*)(p->ws + WS_WT2);
    for (int it = lo + widx; it < hi; it += nw) {
        const int e = it / 1536, q = it % 1536, which = q / 512, qq = q % 512, kb = qq / 32, nb = qq % 32, n0 = 32 * nb, k0 = 64 * kb;
        const size_t woff = ((size_t)l * NE + e) * 1024 * 1024;
        if (which == 0) tr_item(p->w_eg + woff, 1024, k0, n0, wt1 + ((size_t)e * 2048 + (n0 >> 7) * 256 + (n0 & 127)) * 1024 + k0, 1024, scr, lane);
        else if (which == 1) tr_item(p->w_eu + woff, 1024, k0, n0, wt1 + ((size_t)e * 2048 + (n0 >> 7) * 256 + 128 + (n0 & 127)) * 1024 + k0, 1024, scr, lane);
        else tr_item(p->w_ed + woff, 1024, k0, n0, wt2 + ((size_t)e * 1024 + n0) * 1024 + k0, 1024, scr, lane);
    }
}
constexpr int CVT_ITEMS = NE * 3 * 512;
constexpr int CVT_G_IDLE0 = 96, CVT_M_IDLE0 = 32, CVT_O_IDLE0 = 32;
constexpr int CVT_G_HI = 7680, CVT_M_HI = 7680 + 14336;

__device__ __forceinline__ void phase_prep(KPC p, LAS unsigned char* lds, int tid, int lane, int wave, int bid, int G) {
    unsigned char* ws = p->ws;
    {   float* rc = (float*)(ws + WS_ROPEC); float* rsn = (float*)(ws + WS_ROPES);
        for (int i = bid * 512 + tid; i < T * 32; i += G * 512) { const int t = i >> 5, f = i & 31; const int pos = (f < 16) ? (t >> 6) : (t & 63); const int fi = f & 15;
            const float inv = ex2(-(float)fi * (13.287712379549449f / 16.f));
            float ang = (float)pos * inv; ang -= 6.283185307179586f * rintf(ang * 0.15915494309189535f);
            rc[i] = __cosf(ang); rsn[i] = __sinf(ang); } }
    {   LAS float* sv = (LAS float*)lds;
        LAS float* red = (LAS float*)(lds + 36864);
        for (int i = tid; i < 9 * 1024; i += 512) { const int r = i >> 10, k = i & 1023; const float v = (r < 8) ? p->c[r * 1024 + k] : p->c_ctx[k]; sv[i] = v * sigmoidf_(v); }
        __syncthreads();
        for (int it = bid; it < 192; it += G) {
            const int l = it / 96, n0 = (it % 96) * 64;
            const float* W = p->w_mod + (size_t)l * 1024 * 6144 + n0 + lane;
            float acc[9];
#pragma unroll
            for (int r = 0; r < 9; ++r) acc[r] = 0.f;
#pragma unroll 1
            for (int k0 = wave * 128; k0 < wave * 128 + 128; k0 += 16) {
                float wv[16];
#pragma unroll
                for (int kk = 0; kk < 16; ++kk) wv[kk] = W[(size_t)(k0 + kk) * 6144];
#pragma unroll
                for (int kk = 0; kk < 16; ++kk)
#pragma unroll
                    for (int r = 0; r < 9; ++r) acc[r] += sv[r * 1024 + k0 + kk] * wv[kk]; }
#pragma unroll
            for (int r = 0; r < 9; ++r) red[(wave * 9 + r) * 64 + lane] = acc[r];
            __syncthreads();
            for (int i = tid; i < 576; i += 512) { const int r = i >> 6, ln = i & 63; float s = 0.f;
#pragma unroll
                for (int w = 0; w < 8; ++w) s += red[(w * 9 + r) * 64 + ln];
                s += p->b_mod[l * 6144 + n0 + ln]; ((float*)(ws + WS_MODV))[(l * 9 + r) * 6144 + n0 + ln] = s; }
            __syncthreads();
        }
    }
    __syncthreads();
    convert_small(p, 0, lds, lane, wave, bid, G);
}

__device__ __forceinline__ float row_rs(const f32x4 (&v)[4]) {
    float ss = 0.f;
#pragma unroll
    for (int j = 0; j < 4; ++j) ss += (v[j].x * v[j].x + v[j].y * v[j].y) + (v[j].z * v[j].z + v[j].w * v[j].w);
    return 1.0f / sqrtf(wave_sum(ss) * (1.f / 1024.f) + EPS);
}
__device__ __forceinline__ void norm_mod(const f32x4 (&v)[4], float rs, const float* gain, const float* sh, const float* sc, f32x4 (&h)[4], int lane) {
#pragma unroll
    for (int j = 0; j < 4; ++j) { const int col = 4 * lane + 256 * j; const f32x4 g = *(const f32x4*)(gain + col), a = *(const f32x4*)(sc + col), b = *(const f32x4*)(sh + col);
        h[j] = (v[j] * rs) * g * (a + 1.0f) + b; }
}
__device__ __forceinline__ void store_h(const f32x4 (&h)[4], bf16* hrow, int lane) {
#pragma unroll
    for (int j = 0; j < 4; ++j) { u32x2 w; w.x = pk2(h[j].x, h[j].y); w.y = pk2(h[j].z, h[j].w); *(u32x2*)(hrow + 4 * lane + 256 * j) = w; }
}
__device__ __forceinline__ void phase_norm_in(KPC p, int lane, int wave, int bid, int G) {
    const float* modv = (const float*)(p->ws + WS_MODV); bf16* H = (bf16*)(p->ws + WS_H);
    const int stride = G * 8; int r = bid * 8 + wave;
    f32x4 vn[4];
    {   const float* src = (r < ML) ? p->x + (size_t)r * 1024 : p->ctx + (size_t)(r - ML) * 1024;
#pragma unroll
        for (int j = 0; j < 4; ++j) vn[j] = (r < M) ? *(const f32x4*)(src + 4 * lane + 256 * j) : (f32x4){0.f, 0.f, 0.f, 0.f}; }
    for (; r < M; r += stride) {
        const int bi = (r < ML) ? (r >> 12) : 8; const float* mv = modv + bi * 6144;
        f32x4 v[4], h[4], g[4], sc[4], sh[4];
#pragma unroll
        for (int j = 0; j < 4; ++j) { v[j] = vn[j]; const int col = 4 * lane + 256 * j; g[j] = *(const f32x4*)(p->norm1_g + col); sh[j] = *(const f32x4*)(mv + col); sc[j] = *(const f32x4*)(mv + 1024 + col); }
        const int rn = r + stride;
        if (rn < M) { const float* src = (rn < ML) ? p->x + (size_t)rn * 1024 : p->ctx + (size_t)(rn - ML) * 1024;
#pragma unroll
            for (int j = 0; j < 4; ++j) vn[j] = *(const f32x4*)(src + 4 * lane + 256 * j); }
        const float rs = row_rs(v);
#pragma unroll
        for (int j = 0; j < 4; ++j) h[j] = (v[j] * rs) * g[j] * (sc[j] + 1.0f) + sh[j];
        store_h(h, H + (size_t)r * 1024, lane);
    }
}

__device__ __forceinline__ void att_item(KPC p, int l, LAS unsigned char* lds, int item, float Mb2, int tid, int lane, int wave) {
    const bf16* ZA = (const bf16*)(p->ws + WS_ZA); bf16* BR = (bf16*)p->out + (size_t)2 * M * 512;
    const float* rc = (const float*)(p->ws + WS_ROPEC); const float* rsn = (const float*)(p->ws + WS_ROPES);
    const bool isctx = item >= 512;
    int b, kvh, qb;
    if (!isctx) { b = item >> 6; kvh = (item >> 5) & 1; qb = item & 31; } else { const int ci = item - 512; b = ci >> 2; kvh = (ci >> 1) & 1; qb = ci & 1; }
    const int rowbase = isctx ? ML + b * CL : b * T;
    const int g = wave >> 1, qs = wave & 1, hh = kvh * 4 + g, c = lane & 15, g4 = lane >> 4, q0 = qb * 128 + qs * 64;
    const float* qg = p->qn_g + l * 64; const float* kg = p->kn_g + l * 64;
    LAS unsigned char* Kl = lds; LAS unsigned char* Vt = lds + 18432;
    bf16x8 qf[4][2];
#pragma unroll
    for (int ti = 0; ti < 4; ++ti) {
        const int pos = q0 + 16 * ti + c; const bf16* src = ZA + (size_t)(rowbase + pos) * NZA + C_AQ + hh * 64 + 8 * g4;
        float a[8], bb[8]; unpack8(*(const u32x4*)src, a); unpack8(*(const u32x4*)(src + 32), bb);
        float ss = 0.f;
#pragma unroll
        for (int j = 0; j < 8; ++j) ss += a[j] * a[j] + bb[j] * bb[j];
        ss = sum_x16_x32(ss);
        const float rs = 1.0f / sqrtf(ss * (1.f / 64.f) + EPS);
#pragma unroll
        for (int j = 0; j < 8; ++j) { a[j] *= rs * qg[8 * g4 + j]; bb[j] *= rs * qg[32 + 8 * g4 + j]; }
        if (!isctx) {
#pragma unroll
            for (int j = 0; j < 8; ++j) { const float cs = rc[pos * 32 + 8 * g4 + j], sn = rsn[pos * 32 + 8 * g4 + j]; const float x1 = a[j], x2 = bb[j]; a[j] = x1 * cs - x2 * sn; bb[j] = x1 * sn + x2 * cs; } }
#pragma unroll
        for (int j = 0; j < 8; ++j) { a[j] *= 0.125f * LOG2E; bb[j] *= 0.125f * LOG2E; }
        qf[ti][0] = as_bf16x8(pack8(a)); qf[ti][1] = as_bf16x8(pack8(bb));
        __builtin_amdgcn_sched_barrier(0);
    }
    f32x4 O[4][4]; float lsum[4];
#pragma unroll
    for (int i = 0; i < 4; ++i) { lsum[i] = 0.f;
#pragma unroll
        for (int j = 0; j < 4; ++j) O[i][j] = (f32x4){0.f, 0.f, 0.f, 0.f}; }
    const int ntile = isctx ? 2 : 5;
    for (int kt = 0; kt < ntile; ++kt) {
        int krow0, kpos0 = 0, mode = 0; bool local = false;
        if (isctx) krow0 = ML + b * CL + 128 * kt;
        else if (kt < 3) { const int kb = qb - 1 + kt; if (kb < 0 || kb > 31) continue; krow0 = b * T + kb * 128; kpos0 = kb * 128; local = true; mode = (kt == 0) ? 1 : ((kt == 2) ? 2 : 0); }
        else krow0 = ML + b * CL + 128 * (kt - 3);
#ifndef REP_ATT_STAGE
#define REP_ATT_STAGE 1
#endif
        for (int rs_ = 0; rs_ < REP_ATT_STAGE; ++rs_) {
        __syncthreads();
        {
            const int key = tid >> 2, q4 = tid & 3; const bf16* src = ZA + (size_t)(krow0 + key) * NZA + C_AK + kvh * 64 + 8 * q4;
            float a[8], bb[8]; unpack8(*(const u32x4*)src, a); unpack8(*(const u32x4*)(src + 32), bb);
            float ss = 0.f;
#pragma unroll
            for (int j = 0; j < 8; ++j) ss += a[j] * a[j] + bb[j] * bb[j];
            ss = sum_x1_x2(ss);
            const float rs = 1.0f / sqrtf(ss * (1.f / 64.f) + EPS);
#pragma unroll
            for (int j = 0; j < 8; ++j) { a[j] *= rs * kg[8 * q4 + j]; bb[j] *= rs * kg[32 + 8 * q4 + j]; }
            if (local) { const int pos = kpos0 + key;
#pragma unroll
                for (int j = 0; j < 8; ++j) { const float cs = rc[pos * 32 + 8 * q4 + j], sn = rsn[pos * 32 + 8 * q4 + j]; const float x1 = a[j], x2 = bb[j]; a[j] = x1 * cs - x2 * sn; bb[j] = x1 * sn + x2 * cs; } }
            *(LAS u32x4*)(Kl + key * 144 + 16 * q4) = pack8(a); *(LAS u32x4*)(Kl + key * 144 + 64 + 16 * q4) = pack8(bb);
            const bf16* vs = ZA + (size_t)(krow0 + key) * NZA + C_AV + kvh * 64 + 16 * q4;
            const u32x4 v0 = *(const u32x4*)vs, v1 = *(const u32x4*)(vs + 8);
            const unsigned vw[8] = {v0.x, v0.y, v0.z, v0.w, v1.x, v1.y, v1.z, v1.w};
#pragma unroll
            for (int j = 0; j < 8; ++j) { *(LAS unsigned short*)(Vt + (16 * q4 + 2 * j) * 272 + key * 2) = (unsigned short)(vw[j] & 0xffffu); *(LAS unsigned short*)(Vt + (16 * q4 + 2 * j + 1) * 272 + key * 2) = (unsigned short)(vw[j] >> 16); }
        }
        }
        __syncthreads();
#pragma unroll 1
        for (int kk = 0; kk < 4; ++kk) {
            if ((mode == 1 && 32 * kk + 31 < qs * 64) || (mode == 2 && 32 * kk > qs * 64 + 63)) continue;
            bf16x8 ka[2][2];
#pragma unroll
            for (int hf = 0; hf < 2; ++hf)
#pragma unroll
                for (int ks = 0; ks < 2; ++ks) ka[hf][ks] = *(const LAS bf16x8*)(Kl + (32 * kk + 16 * hf + c) * 144 + ks * 64 + g4 * 16);
            bf16x8 pf[4];
#pragma unroll
            for (int ti = 0; ti < 4; ++ti) {
                f32x4 sa = (f32x4){-Mb2, -Mb2, -Mb2, -Mb2}, sb = sa;
                sa = mfma16(ka[0][0], qf[ti][0], sa); sa = mfma16(ka[0][1], qf[ti][1], sa);
                sb = mfma16(ka[1][0], qf[ti][0], sb); sb = mfma16(ka[1][1], qf[ti][1], sb);
                float pa[4], pb[4];
#pragma unroll
                for (int rr = 0; rr < 4; ++rr) { pa[rr] = ex2(sa[rr]); pb[rr] = ex2(sb[rr]); }
                if (mode != 0) {
                    const int ii = qs * 64 + 16 * ti + c; const int mlo = (mode == 1) ? ii : -1000, mhi = (mode == 2) ? ii : 1000;
#pragma unroll
                    for (int rr = 0; rr < 4; ++rr) { const int ja = 32 * kk + 4 * g4 + rr, jb = ja + 16;
                        pa[rr] = (ja >= mlo && ja <= mhi) ? pa[rr] : 0.f; pb[rr] = (jb >= mlo && jb <= mhi) ? pb[rr] : 0.f; } }
                lsum[ti] += ((pa[0] + pa[1]) + (pa[2] + pa[3])) + ((pb[0] + pb[1]) + (pb[2] + pb[3]));
                u32x4 w; w.x = pk2(pa[0], pa[1]); w.y = pk2(pa[2], pa[3]); w.z = pk2(pb[0], pb[1]); w.w = pk2(pb[2], pb[3]); pf[ti] = as_bf16x8(w);
            }
#pragma unroll
            for (int dt = 0; dt < 4; ++dt) {
                const u32x2 v0 = *(const LAS u32x2*)(Vt + (16 * dt + c) * 272 + (32 * kk + 4 * g4) * 2), v1 = *(const LAS u32x2*)(Vt + (16 * dt + c) * 272 + (32 * kk + 16 + 4 * g4) * 2);
                u32x4 vv; vv.x = v0.x; vv.y = v0.y; vv.z = v1.x; vv.w = v1.y; const bf16x8 va = as_bf16x8(vv);
#pragma unroll
                for (int ti = 0; ti < 4; ++ti) O[dt][ti] = mfma16(va, pf[ti], O[dt][ti]);
            }
        }
    }
    const float sk = ex2(p->sink[l * 8 + hh] * LOG2E - Mb2);
#pragma unroll
    for (int ti = 0; ti < 4; ++ti) { float lt = sum_x16_x32(lsum[ti]); const float inv = 1.0f / (lt + sk);
        bf16* dst = BR + (size_t)(rowbase + q0 + 16 * ti + c) * 512 + hh * 64 + 4 * g4;
#pragma unroll
        for (int dt = 0; dt < 4; ++dt) { const f32x4 o = O[dt][ti] * inv; u32x2 w; w.x = pk2(o[0], o[1]); w.y = pk2(o[2], o[3]); *(u32x2*)(dst + 16 * dt) = w; } }
    __syncthreads();
}

__device__ __forceinline__ void sgu_vprep_item(KPC p, int ch, int tid) {
    bf16* ZA = (bf16*)(p->ws + WS_ZA);
    const int seg = tid & 15;
    bf16* rowp0 = ZA + (size_t)(ch * 128 + (tid >> 4)) * NZA + C_SV + 32 * seg;
    u32x4 raw[4][4];
#pragma unroll
    for (int ps = 0; ps < 4; ++ps)
#pragma unroll
        for (int q = 0; q < 4; ++q) raw[ps][q] = *(const u32x4*)(rowp0 + (size_t)ps * 32 * NZA + 8 * q);
#pragma unroll
    for (int ps = 0; ps < 4; ++ps) {
        bf16* rowp = rowp0 + (size_t)ps * 32 * NZA;
        float f[4][8]; float s = 0.f, ss = 0.f;
#pragma unroll
        for (int q = 0; q < 4; ++q) unpack8(raw[ps][q], f[q]);
#pragma unroll
        for (int q = 0; q < 4; ++q)
#pragma unroll
            for (int e = 0; e < 8; ++e) { const float y = gelu_tanh(f[q][e]); f[q][e] = y; s += y; ss += y * y; }
        s += swz_xor<1>(s); s += swz_xor<2>(s); s += swz_xor<4>(s); s += swz_xor<8>(s);
        ss += swz_xor<1>(ss); ss += swz_xor<2>(ss); ss += swz_xor<4>(ss); ss += swz_xor<8>(ss);
        const float mean = s * (1.f / 512.f), var = fmaxf(ss * (1.f / 512.f) - mean * mean, 0.f), rstd = 1.0f / sqrtf(var + EPS);
#pragma unroll
        for (int q = 0; q < 4; ++q) {
#pragma unroll
            for (int e = 0; e < 8; ++e) f[q][e] = (f[q][e] - mean) * rstd;
            *(u32x4*)(rowp + 8 * q) = pack8(f[q]); }
    }
}
__device__ __forceinline__ void sgu_item(KPC p, int l, LAS unsigned char* lds, int item, int tid, int lane, int wave) {
    const bf16* ZA = (const bf16*)(p->ws + WS_ZA); bf16* BR = (bf16*)p->out + (size_t)1 * M * 512;
    const int ch = item >> 2, g = item & 3, r0 = ch * 128, c = lane & 15, g4 = lane >> 4;
    LAS unsigned char* vT = lds;
    LAS unsigned char* WL = lds + 34816;
    {   const int j = tid >> 2, q4 = tid & 3; const bf16* src = ZA + (size_t)(r0 + j) * NZA + C_SV + 128 * g + 32 * q4;
#pragma unroll
        for (int q = 0; q < 4; ++q) { const u32x4 v = *(const u32x4*)(src + 8 * q); const unsigned vw[4] = {v.x, v.y, v.z, v.w};
#pragma unroll
            for (int e = 0; e < 4; ++e) { *(LAS unsigned short*)(vT + (32 * q4 + 8 * q + 2 * e) * 272 + j * 2) = (unsigned short)(vw[e] & 0xffffu); *(LAS unsigned short*)(vT + (32 * q4 + 8 * q + 2 * e + 1) * 272 + j * 2) = (unsigned short)(vw[e] >> 16); } }
        const float* wsrc = p->sgu_w + ((size_t)(l * 4 + g) * 128 + (tid >> 2)) * 128 + 32 * (tid & 3);
#pragma unroll
        for (int q = 0; q < 4; ++q) { const f32x4 a = *(const f32x4*)(wsrc + 8 * q), bq = *(const f32x4*)(wsrc + 8 * q + 4);
            u32x4 w; w.x = pk2(a.x, a.y); w.y = pk2(a.z, a.w); w.z = pk2(bq.x, bq.y); w.w = pk2(bq.z, bq.w);
            *(LAS u32x4*)(WL + (tid >> 2) * 272 + (32 * (tid & 3) + 8 * q) * 2) = w; }
    }
    __syncthreads();
    bf16x8 af[4];
#pragma unroll
    for (int ks = 0; ks < 4; ++ks) af[ks] = *(const LAS bf16x8*)(vT + (16 * wave + c) * 272 + (32 * ks + 8 * g4) * 2);
    const int col = 128 * g + 16 * wave + 4 * g4;
    u32x2 uw[8]; float bias[8];
#pragma unroll
    for (int ti = 0; ti < 8; ++ti) { uw[ti] = *(const u32x2*)(ZA + (size_t)(r0 + 16 * ti + c) * NZA + C_SU + col); bias[ti] = p->sgu_b[(l * 4 + g) * 128 + 16 * ti + c]; }
#pragma unroll
    for (int ti = 0; ti < 8; ++ti) {
        f32x4 acc = (f32x4){0.f, 0.f, 0.f, 0.f};
#pragma unroll
        for (int ks = 0; ks < 4; ++ks) acc = mfma16(af[ks], *(const LAS bf16x8*)(WL + (16 * ti + c) * 272 + (32 * ks + 8 * g4) * 2), acc);
        const float o0 = gelu_tanh(bflo(uw[ti].x)) * (acc[0] + bias[ti]), o1 = gelu_tanh(bfhi(uw[ti].x)) * (acc[1] + bias[ti]), o2 = gelu_tanh(bflo(uw[ti].y)) * (acc[2] + bias[ti]), o3 = gelu_tanh(bfhi(uw[ti].y)) * (acc[3] + bias[ti]);
        u32x2 w; w.x = pk2(o0, o1); w.y = pk2(o2, o3); *(u32x2*)(BR + (size_t)(r0 + 16 * ti + c) * 512 + col) = w;
    }
    __syncthreads();
}

__device__ __forceinline__ void ret_load_k(KPC p, const bf16* ZA, int r0, int h, bool latent, int pos0, int tid, float (&a)[8], float (&bb)[8]) {
    const int j = tid >> 2, q4 = tid & 3; const bf16* src = ZA + (size_t)(r0 + j) * NZA + C_RK + 64 * h + 8 * q4;
    unpack8(*(const u32x4*)src, a); unpack8(*(const u32x4*)(src + 32), bb);
    if (latent) { const float* rc = (const float*)(p->ws + WS_ROPEC); const float* rsn = (const float*)(p->ws + WS_ROPES); const int pos = pos0 + j;
#pragma unroll
        for (int e = 0; e < 8; ++e) { const float cs = rc[pos * 32 + 8 * q4 + e], sn = rsn[pos * 32 + 8 * q4 + e]; const float x1 = a[e], x2 = bb[e]; a[e] = x1 * cs - x2 * sn; bb[e] = x1 * sn + x2 * cs; } }
#pragma unroll
    for (int e = 0; e < 8; ++e) { a[e] *= 0.125f; bb[e] *= 0.125f; }
}
__device__ __forceinline__ void ret_stage_vT(const bf16* ZA, int r0, int h, LAS unsigned char* vT, int tid) {
    const int j = tid >> 2, q4 = tid & 3; const bf16* src = ZA + (size_t)(r0 + j) * NZA + C_RV + 128 * h + 32 * q4;
#pragma unroll
    for (int q = 0; q < 4; ++q) { const u32x4 v = *(const u32x4*)(src + 8 * q); const unsigned vw[4] = {v.x, v.y, v.z, v.w};
#pragma unroll
        for (int e = 0; e < 4; ++e) { *(LAS unsigned short*)(vT + (32 * q4 + 8 * q + 2 * e) * 272 + j * 2) = (unsigned short)(vw[e] & 0xffffu); *(LAS unsigned short*)(vT + (32 * q4 + 8 * q + 2 * e + 1) * 272 + j * 2) = (unsigned short)(vw[e] >> 16); } }
}
__device__ __forceinline__ void ret_upd_item(KPC p, int l, LAS unsigned char* lds, int item, int tid, int lane, int wave) {
    const bf16* ZA = (const bf16*)(p->ws + WS_ZA); float* RS = (float*)(p->ws + WS_RS);
    const int b = item / (NCH * 4), rem = item % (NCH * 4), n = rem >> 2, h = rem & 3, c = lane & 15, g4 = lane >> 4;
    const bool latent = n < 32; const int r0 = latent ? b * T + 128 * n : ML + b * CL + 128 * (n - 32);
    const float lgf = log2_sigmoid(p->dec_f[l * 4 + h]), lgb = log2_sigmoid(p->dec_b[l * 4 + h]);
    LAS unsigned char* vT = lds; LAS unsigned char* kTf = lds + 34816; LAS unsigned char* kTb = lds + 34816 + 17408;
    {   float a[8], bb[8]; ret_load_k(p, ZA, r0, h, latent, 128 * n, tid, a, bb);
        const int j = tid >> 2, q4 = tid & 3; const float wf = ex2((float)(127 - j) * lgf), wb = ex2((float)j * lgb);
#pragma unroll
        for (int e = 0; e < 8; e += 2) {
            unsigned w = pk2(a[e] * wf, a[e + 1] * wf); *(LAS unsigned short*)(kTf + (8 * q4 + e) * 272 + j * 2) = (unsigned short)(w & 0xffffu); *(LAS unsigned short*)(kTf + (8 * q4 + e + 1) * 272 + j * 2) = (unsigned short)(w >> 16);
            w = pk2(bb[e] * wf, bb[e + 1] * wf); *(LAS unsigned short*)(kTf + (32 + 8 * q4 + e) * 272 + j * 2) = (unsigned short)(w & 0xffffu); *(LAS unsigned short*)(kTf + (32 + 8 * q4 + e + 1) * 272 + j * 2) = (unsigned short)(w >> 16);
            w = pk2(a[e] * wb, a[e + 1] * wb); *(LAS unsigned short*)(kTb + (8 * q4 + e) * 272 + j * 2) = (unsigned short)(w & 0xffffu); *(LAS unsigned short*)(kTb + (8 * q4 + e + 1) * 272 + j * 2) = (unsigned short)(w >> 16);
            w = pk2(bb[e] * wb, bb[e + 1] * wb); *(LAS unsigned short*)(kTb + (32 + 8 * q4 + e) * 272 + j * 2) = (unsigned short)(w & 0xffffu); *(LAS unsigned short*)(kTb + (32 + 8 * q4 + e + 1) * 272 + j * 2) = (unsigned short)(w >> 16);
        }
        ret_stage_vT(ZA, r0, h, vT, tid);
    }
    __syncthreads();
    bf16x8 af[4];
#pragma unroll
    for (int ks = 0; ks < 4; ++ks) af[ks] = *(const LAS bf16x8*)(vT + (16 * wave + c) * 272 + (32 * ks + 8 * g4) * 2);
#pragma unroll
    for (int dir = 0; dir < 2; ++dir) { const LAS unsigned char* kT = dir ? kTb : kTf;
        float* dst = RS + ((size_t)(((b * 4 + h) * 2 + dir) * NCH + n) * 128 + 16 * wave + 4 * g4) * 64;
#pragma unroll
        for (int dt = 0; dt < 4; ++dt) { f32x4 acc = (f32x4){0.f, 0.f, 0.f, 0.f};
#pragma unroll
            for (int ks = 0; ks < 4; ++ks) acc = mfma16(af[ks], *(const LAS bf16x8*)(kT + (16 * dt + c) * 272 + (32 * ks + 8 * g4) * 2), acc);
#pragma unroll
            for (int rr = 0; rr < 4; ++rr) dst[rr * 64 + 16 * dt + c] = acc[rr]; } }
    __syncthreads();
}
__device__ __forceinline__ void phase_scan(KPC p, int l, int tid, int bid, int G) {
    const float* __restrict__ RS = (const float*)(p->ws + WS_RS); bf16* __restrict__ ST = (bf16*)(p->ws + WS_ST);
    for (int idx = bid * 512 + tid; idx < NB * 4 * 2 * 8192; idx += G * 512) {
        const int ed = idx & 8191, dir = (idx >> 13) & 1, bh = idx >> 14, e = ed >> 6, d = ed & 63, h = bh & 3;
        const float* P = RS + (size_t)((bh * 2 + dir) * NCH) * 8192 + ed;
        bf16* S = ST + ((size_t)bh * NCH * 128 + e) * 128 + dir * 64 + d;
        const float lg = log2_sigmoid(dir ? p->dec_b[l * 4 + h] : p->dec_f[l * 4 + h]); const float dec = ex2(128.f * lg);
        float u[NCH];
#pragma unroll
        for (int n = 0; n < NCH; ++n) u[n] = P[(size_t)n * 8192];
        if (dir == 0) {
            S[32 * 16384] = 0; S[33 * 16384] = (bf16)(pk2(u[32], 0.f) & 0xffffu);
            float s = dec * u[32] + u[33];
#pragma unroll
            for (int n = 0; n < 32; ++n) { S[(size_t)n * 16384] = (bf16)(pk2(s, 0.f) & 0xffffu); s = dec * s + u[n]; }
        } else {
            S[33 * 16384] = 0; S[32 * 16384] = (bf16)(pk2(u[33], 0.f) & 0xffffu);
            float s = dec * u[33] + u[32];
#pragma unroll
            for (int n = 31; n >= 0; --n) { S[(size_t)n * 16384] = (bf16)(pk2(s, 0.f) & 0xffffu); s = dec * s + u[n]; }
        }
    }
}
__device__ __forceinline__ void ret_out_item(KPC p, int l, LAS unsigned char* lds, int item, int tid, int lane, int wave) {
    const bf16* ZA = (const bf16*)(p->ws + WS_ZA); bf16* BR = (bf16*)p->out; const bf16* ST = (const bf16*)(p->ws + WS_ST);
    const int b = item / (NCH * 4), rem = item % (NCH * 4), n = rem >> 2, h = rem & 3, c = lane & 15, g4 = lane >> 4;
    const bool latent = n < 32; const int r0 = latent ? b * T + 128 * n : ML + b * CL + 128 * (n - 32);
    const float lgf = log2_sigmoid(p->dec_f[l * 4 + h]), lgb = log2_sigmoid(p->dec_b[l * 4 + h]);
    LAS unsigned char* vT = lds; LAS unsigned char* Kl = lds + 34816; LAS unsigned char* Sl = lds + 34816 + 18432;
    {   float a[8], bb[8]; ret_load_k(p, ZA, r0, h, latent, 128 * n, tid, a, bb);
        const int j = tid >> 2, q4 = tid & 3;
        *(LAS u32x4*)(Kl + j * 144 + 16 * q4) = pack8(a); *(LAS u32x4*)(Kl + j * 144 + 64 + 16 * q4) = pack8(bb);
        ret_stage_vT(ZA, r0, h, vT, tid);
        const u32x4* ssrc = (const u32x4*)(ST + (size_t)((b * 4 + h) * NCH + n) * 16384);
#pragma unroll
        for (int k = 0; k < 4; ++k) { const int q = tid + 512 * k; *(LAS u32x4*)(Sl + (q >> 4) * 272 + (q & 15) * 16) = ssrc[q]; }
    }
    __syncthreads();
    const int ii = 16 * wave + c;
    bf16x8 qf[2];
    {   const bf16* src = ZA + (size_t)(r0 + ii) * NZA + C_RQ + 64 * h + 8 * g4; float a[8], bb[8]; unpack8(*(const u32x4*)src, a); unpack8(*(const u32x4*)(src + 32), bb);
        if (latent) { const float* rc = (const float*)(p->ws + WS_ROPEC); const float* rsn = (const float*)(p->ws + WS_ROPES); const int pos = 128 * n + ii;
#pragma unroll
            for (int e = 0; e < 8; ++e) { const float cs = rc[pos * 32 + 8 * g4 + e], sn = rsn[pos * 32 + 8 * g4 + e]; const float x1 = a[e], x2 = bb[e]; a[e] = x1 * cs - x2 * sn; bb[e] = x1 * sn + x2 * cs; } }
        qf[0] = as_bf16x8(pack8(a)); qf[1] = as_bf16x8(pack8(bb)); }
    bf16x8 pf[4];
#pragma unroll
    for (int kk = 0; kk < 4; ++kk) {
        f32x4 sa = (f32x4){0.f, 0.f, 0.f, 0.f}, sb = (f32x4){0.f, 0.f, 0.f, 0.f};
        sa = mfma16(*(const LAS bf16x8*)(Kl + (32 * kk + c) * 144 + g4 * 16), qf[0], sa); sa = mfma16(*(const LAS bf16x8*)(Kl + (32 * kk + c) * 144 + 64 + g4 * 16), qf[1], sa);
        sb = mfma16(*(const LAS bf16x8*)(Kl + (32 * kk + 16 + c) * 144 + g4 * 16), qf[0], sb); sb = mfma16(*(const LAS bf16x8*)(Kl + (32 * kk + 16 + c) * 144 + 64 + g4 * 16), qf[1], sb);
        float pa[4], pb[4];
#pragma unroll
        for (int rr = 0; rr < 4; ++rr) { const int ja = 32 * kk + 4 * g4 + rr, jb = ja + 16; const int da = ii - ja, db = ii - jb;
            pa[rr] = sa[rr] * ((da >= 0) ? ex2((float)da * lgf) : ex2((float)(-da) * lgb)); pb[rr] = sb[rr] * ((db >= 0) ? ex2((float)db * lgf) : ex2((float)(-db) * lgb)); }
        u32x4 w; w.x = pk2(pa[0], pa[1]); w.y = pk2(pa[2], pa[3]); w.z = pk2(pb[0], pb[1]); w.w = pk2(pb[2], pb[3]); pf[kk] = as_bf16x8(w);
    }
    const float cf = ex2((float)(ii + 1) * lgf), cb = ex2((float)(128 - ii) * lgb);
    f32x4 O[8]; float s = 0.f, ss = 0.f;
#pragma unroll
    for (int et = 0; et < 8; ++et) {
        f32x4 acc = (f32x4){0.f, 0.f, 0.f, 0.f}, xf = (f32x4){0.f, 0.f, 0.f, 0.f}, xb = (f32x4){0.f, 0.f, 0.f, 0.f};
#pragma unroll
        for (int kk = 0; kk < 4; ++kk) { const u32x2 v0 = *(const LAS u32x2*)(vT + (16 * et + c) * 272 + (32 * kk + 4 * g4) * 2), v1 = *(const LAS u32x2*)(vT + (16 * et + c) * 272 + (32 * kk + 16 + 4 * g4) * 2);
            u32x4 vv; vv.x = v0.x; vv.y = v0.y; vv.z = v1.x; vv.w = v1.y; acc = mfma16(as_bf16x8(vv), pf[kk], acc); }
#pragma unroll
        for (int ks = 0; ks < 2; ++ks) { xf = mfma16(*(const LAS bf16x8*)(Sl + (16 * et + c) * 272 + (32 * ks + 8 * g4) * 2), qf[ks], xf);
            xb = mfma16(*(const LAS bf16x8*)(Sl + (16 * et + c) * 272 + (64 + 32 * ks + 8 * g4) * 2), qf[ks], xb); }
        acc = acc + xf * cf + xb * cb; O[et] = acc;
        s += (acc[0] + acc[1]) + (acc[2] + acc[3]); ss += (acc[0] * acc[0] + acc[1] * acc[1]) + (acc[2] * acc[2] + acc[3] * acc[3]);
    }
    s = sum_x16_x32(s); ss = sum_x16_x32(ss);
    const float mean = s * (1.f / 128.f), var = fmaxf(ss * (1.f / 128.f) - mean * mean, 0.f), rstd = 1.0f / sqrtf(var + EPS);
    const bf16* gsrc = ZA + (size_t)(r0 + ii) * NZA + C_RG + 128 * h + 4 * g4; bf16* dst = BR + (size_t)(r0 + ii) * 512 + 128 * h + 4 * g4;
#pragma unroll
    for (int et = 0; et < 8; ++et) { const u32x2 gw = *(const u32x2*)(gsrc + 16 * et); const float g0 = bflo(gw.x), g1 = bfhi(gw.x), g2 = bflo(gw.y), g3 = bfhi(gw.y);
        const float o0 = (O[et][0] - mean) * rstd * g0 * sigmoidf_(g0), o1 = (O[et][1] - mean) * rstd * g1 * sigmoidf_(g1), o2 = (O[et][2] - mean) * rstd * g2 * sigmoidf_(g2), o3 = (O[et][3] - mean) * rstd * g3 * sigmoidf_(g3);
        u32x2 w; w.x = pk2(o0, o1); w.y = pk2(o2, o3); *(u32x2*)(dst + 16 * et) = w; }
    __syncthreads();
}

#ifndef REP_CVT
#define REP_CVT 1
#endif
#ifndef REP_N2R
#define REP_N2R 1
#endif
#ifndef REP_TK
#define REP_TK 1
#endif
__device__ __forceinline__ int wr_off(int k) { return k * 64 + (k >> 2) * 16; }
__device__ __forceinline__ void phase_norm2(KPC p, int l, LAS unsigned char* lds, int tid, int lane, int wave, int bid, int G) {
    if (l == 1 || G != 256) { for (int rep = 0; rep < REP_CVT; ++rep) convert_experts(p, l, 0, CVT_ITEMS, bid * 8 + wave, G * 8, lds, lane, wave); __syncthreads(); }
    LAS unsigned char* wrl = lds + 69632;
    for (int i = tid; i < 1024 * 4; i += 512) { const int k = i >> 2, q = i & 3; *(LAS f32x4*)(wrl + wr_off(k) + 16 * q) = *(const f32x4*)(p->w_router + (size_t)l * 16384 + k * 16 + 4 * q); }
    __syncthreads();
    const float* modv = (const float*)(p->ws + WS_MODV) + l * 9 * 6144; const bf16* X = (const bf16*)(p->ws + WS_X); bf16* H = (bf16*)(p->ws + WS_H);
    float* AFF = (float*)(p->ws + WS_AFF); float* AFFC = (float*)(p->ws + WS_AFFC); int* INV = (int*)(p->ws + WS_INV);
    const int rows = (l == 0) ? M : ML, stride = G * 8;
    for (int rep = 0; rep < REP_N2R; ++rep) {
    int r = bid * 8 + wave;
    u32x2 vn[4];
#pragma unroll
    for (int j = 0; j < 4; ++j) vn[j] = (r < rows) ? *(const u32x2*)(X + (size_t)r * 1024 + 4 * lane + 256 * j) : (u32x2){0u, 0u};
    for (; r < rows; r += stride) {
        const int bi = (r < ML) ? (r >> 12) : 8; const float* mv = modv + bi * 6144;
        f32x4 v[4], h[4], g[4], sc[4], sh[4];
#pragma unroll
        for (int j = 0; j < 4; ++j) { v[j] = (f32x4){bflo(vn[j].x), bfhi(vn[j].x), bflo(vn[j].y), bfhi(vn[j].y)}; const int col = 4 * lane + 256 * j; g[j] = *(const f32x4*)(p->norm2_g + l * 1024 + col); sh[j] = *(const f32x4*)(mv + 3 * 1024 + col); sc[j] = *(const f32x4*)(mv + 4 * 1024 + col); }
        const int rn = r + stride;
        if (rn < rows) {
#pragma unroll
            for (int j = 0; j < 4; ++j) vn[j] = *(const u32x2*)(X + (size_t)rn * 1024 + 4 * lane + 256 * j); }
        const float rs = row_rs(v);
#pragma unroll
        for (int j = 0; j < 4; ++j) h[j] = (v[j] * rs) * g[j] * (sc[j] + 1.0f) + sh[j];
        store_h(h, H + (size_t)r * 1024, lane);
        float lg[16];
#pragma unroll
        for (int e = 0; e < 16; ++e) lg[e] = 0.f;
#pragma unroll
        for (int j = 0; j < 4; ++j)
#pragma unroll
            for (int i = 0; i < 4; ++i) { const int k = 4 * lane + 256 * j + i; const float hv = h[j][i]; const LAS f32x4* wp = (const LAS f32x4*)(wrl + wr_off(k));
#pragma unroll
                for (int q = 0; q < 4; ++q) { const f32x4 w = wp[q]; lg[4 * q] += hv * w.x; lg[4 * q + 1] += hv * w.y; lg[4 * q + 2] += hv * w.z; lg[4 * q + 3] += hv * w.w; } }
        float mx = -1e30f;
#pragma unroll
        for (int e = 0; e < 16; ++e) { lg[e] = wave_sum(lg[e]); mx = fmaxf(mx, lg[e]); }
        float sum = 0.f;
#pragma unroll
        for (int e = 0; e < 16; ++e) { lg[e] = ex2((lg[e] - mx) * LOG2E); sum += lg[e]; }
        const float isum = 1.0f / sum; float mine = 0.f;
#pragma unroll
        for (int e = 0; e < 16; ++e) mine = (lane == e) ? lg[e] * isum : mine;
        if (lane < 16) { if (r < ML) AFF[((size_t)(bi * 16 + lane) << 12) + (r & 4095)] = mine; else AFFC[((r - ML) >> 8) * 4096 + lane * 256 + ((r - ML) & 255)] = mine;
            INV[(size_t)r * 16 + lane] = -1; }
    }
    }
}

__device__ __forceinline__ int block_sum_i(int v, LAS int* red, int buf, int lane, int wave) {
    v = wave_sum_i(v);
    if (lane == 0) red[buf * 8 + wave] = v;
    __syncthreads();
    int s = 0;
#pragma unroll
    for (int w = 0; w < 8; ++w) s += red[buf * 8 + w];
    return s;
}
__device__ __forceinline__ int block_excl_scan(int v, LAS int* red, int buf, int lane, int wave) {
    int inc = v;
#pragma unroll
    for (int o = 1; o < 64; o <<= 1) { const int t = __builtin_amdgcn_ds_bpermute((lane - o) << 2, inc); if (lane >= o) inc += t; }
    if (lane == 63) red[buf * 8 + wave] = inc;
    __syncthreads();
    int base = 0;
#pragma unroll
    for (int w = 0; w < 8; ++w) { const int x = red[buf * 8 + w]; if (w < wave) base += x; }
    return base + inc - v;
}
template <int KPT>
__device__ __forceinline__ void topk_item(KPC p, const float* aff, int n, int cap, int rowbase, int e, int slotbase, int s_lo, int s_hi, bool writer, LAS unsigned char* lds, int tid, int lane, int wave) {
    const bf16* H = (const bf16*)(p->ws + WS_H); bf16* XS = (bf16*)(p->ws + WS_XS); float* topw = (float*)(p->ws + WS_TOPW); int* INV = (int*)(p->ws + WS_INV);
    LAS int* red = (LAS int*)lds; LAS int* rl = (LAS int*)(lds + 128);
    unsigned key[KPT]; const bool valid = tid * KPT < n;
#pragma unroll
    for (int j = 0; j < KPT; ++j) key[j] = valid ? __float_as_uint(aff[tid * KPT + j]) : 0u;
    unsigned Tsel = 0u;
    for (int bit = 30; bit >= 0; --bit) { const unsigned cand = Tsel | (1u << bit); int cnt = 0;
#pragma unroll
        for (int j = 0; j < KPT; ++j) cnt += (valid && key[j] >= cand) ? 1 : 0;
        if (block_sum_i(cnt, red, bit & 1, lane, wave) >= cap) Tsel = cand; }
    int cgt = 0, ceq = 0;
#pragma unroll
    for (int j = 0; j < KPT; ++j) { cgt += (valid && key[j] > Tsel) ? 1 : 0; ceq += (valid && key[j] == Tsel) ? 1 : 0; }
    const int need = cap - block_sum_i(cgt, red, 1, lane, wave);
    int er = block_excl_scan(ceq, red, 2, lane, wave);
    bool sel[KPT]; int nsel = 0;
#pragma unroll
    for (int j = 0; j < KPT; ++j) { const bool iseq = valid && key[j] == Tsel; sel[j] = valid && (key[j] > Tsel || (iseq && er < need)); er += iseq ? 1 : 0; nsel += sel[j] ? 1 : 0; }
    int slot = block_excl_scan(nsel, red, 3, lane, wave);
#pragma unroll
    for (int j = 0; j < KPT; ++j) if (sel[j]) { const int t = tid * KPT + j; if (slot < cap) { rl[slot] = t; if (writer) { topw[e * ME + slotbase + slot] = __uint_as_float(key[j]); INV[(size_t)(rowbase + t) * 16 + e] = slotbase + slot; } } ++slot; }
    __syncthreads();
    for (int s = s_lo + wave * 4; s < s_hi; s += 32) {
        u32x4 a[4][2];
#pragma unroll
        for (int q = 0; q < 4; ++q) { const int t = rl[s + q]; const u32x4* src = (const u32x4*)(H + (size_t)(rowbase + t) * 1024); a[q][0] = src[lane]; a[q][1] = src[lane + 64]; }
#pragma unroll
        for (int q = 0; q < 4; ++q) { u32x4* dst = (u32x4*)(XS + ((size_t)e * ME + slotbase + s + q) * 1024); dst[lane] = a[q][0]; dst[lane + 64] = a[q][1]; }
    }
    __syncthreads();
}
__device__ __forceinline__ void phase_topk(KPC p, int l, LAS unsigned char* lds, int tid, int lane, int wave, int bid, int G) {
    const float* AFF = (const float*)(p->ws + WS_AFF); const float* AFFC = (const float*)(p->ws + WS_AFFC);
    const int nitem = (l == 0) ? 384 : 256;
    for (int it = bid; it < nitem; it += G) {
        if (it < 256) { const int q = it >> 1, hf = it & 1, b = q >> 4, e = q & 15; topk_item<8>(p, AFF + ((size_t)(b * 16 + e) << 12), 4096, CAPL, b * T, e, b * CAPL, hf * 256, hf * 256 + 256, hf == 0, lds, tid, lane, wave); }
        else { const int q = it - 256, b = q >> 4, e = q & 15; topk_item<1>(p, AFFC + (b * 16 + e) * 256, 256, CAPC, ML + b * CL, e, NB * CAPL + b * CAPC, 0, CAPC, true, lds, tid, lane, wave); }
    }
}

__device__ __forceinline__ void phase_combine(KPC p, int l, LAS unsigned char* lds, int tid, int lane, int wave, int bid, int G) {
    const float* modv = (const float*)(p->ws + WS_MODV); bf16* X = (bf16*)(p->ws + WS_X); bf16* H = (bf16*)(p->ws + WS_H);
    const bf16* Y = (const bf16*)(p->ws + WS_XS); const int* INV = (const int*)(p->ws + WS_INV);
    const int rows = (l == 0) ? M : ML, stride = G * 8;
    int r = bid * 8 + wave;
    int slot_next = (lane < 16 && r < rows) ? INV[(size_t)r * 16 + lane] : -1;
    u32x2 vn[4];
#pragma unroll
    for (int j = 0; j < 4; ++j) vn[j] = (r < rows) ? *(const u32x2*)(X + (size_t)r * 1024 + 4 * lane + 256 * j) : (u32x2){0u, 0u};
    for (; r < rows; r += stride) {
        const int bi = (r < ML) ? (r >> 12) : 8;
        const int myslot = slot_next; const int rn = r + stride;
        slot_next = (lane < 16 && rn < rows) ? INV[(size_t)rn * 16 + lane] : -1;
        f32x4 v[4], acc[4], g2v[4];
        const float* g2 = modv + (l * 9 + bi) * 6144 + 5 * 1024;
#pragma unroll
        for (int j = 0; j < 4; ++j) { v[j] = (f32x4){bflo(vn[j].x), bfhi(vn[j].x), bflo(vn[j].y), bfhi(vn[j].y)}; acc[j] = (f32x4){0.f, 0.f, 0.f, 0.f}; g2v[j] = *(const f32x4*)(g2 + 4 * lane + 256 * j); }
        unsigned mask = (unsigned)(__builtin_amdgcn_ballot_w64(myslot >= 0) & 0xffffull);
        bool first = true;
        while (mask || first) {
          if (mask) {
            const int e0 = __builtin_ctz(mask); mask &= mask - 1u; const int s0 = __builtin_amdgcn_readlane(myslot, e0);
            const bool has1 = mask != 0u; const int e1 = has1 ? __builtin_ctz(mask) : e0; if (has1) mask &= mask - 1u; const int s1 = __builtin_amdgcn_readlane(myslot, e1);
            const bf16* ya = Y + ((size_t)e0 * ME + s0) * 1024; const bf16* yb = Y + ((size_t)e1 * ME + s1) * 1024;
            u32x2 wa[4], wb[4];
#pragma unroll
            for (int j = 0; j < 4; ++j) wa[j] = *(const u32x2*)(ya + 4 * lane + 256 * j);
#pragma unroll
            for (int j = 0; j < 4; ++j) wb[j] = *(const u32x2*)(yb + 4 * lane + 256 * j);
            if (first && rn < rows) {
#pragma unroll
                for (int j = 0; j < 4; ++j) vn[j] = *(const u32x2*)(X + (size_t)rn * 1024 + 4 * lane + 256 * j); }
            first = false;
            const float kb = has1 ? 1.0f : 0.0f;
#pragma unroll
            for (int j = 0; j < 4; ++j) { acc[j] += (f32x4){bflo(wa[j].x), bfhi(wa[j].x), bflo(wa[j].y), bfhi(wa[j].y)}; acc[j] += (f32x4){bflo(wb[j].x), bfhi(wb[j].x), bflo(wb[j].y), bfhi(wb[j].y)} * kb; }
          } else {
            if (rn < rows) {
#pragma unroll
                for (int j = 0; j < 4; ++j) vn[j] = *(const u32x2*)(X + (size_t)rn * 1024 + 4 * lane + 256 * j); }
            first = false;
          }
        }
#pragma unroll
        for (int j = 0; j < 4; ++j) v[j] = v[j] + g2v[j] * acc[j];
        if (l == 0) {
#pragma unroll
            for (int j = 0; j < 4; ++j) { u32x2 w; w.x = pk2(v[j].x, v[j].y); w.y = pk2(v[j].z, v[j].w); *(u32x2*)(X + (size_t)r * 1024 + 4 * lane + 256 * j) = w; }
            const float rs = row_rs(v); f32x4 h[4];
            norm_mod(v, rs, p->norm1_g + 1024, modv + (9 + bi) * 6144, modv + (9 + bi) * 6144 + 1024, h, lane);
            store_h(h, H + (size_t)r * 1024, lane);
        } else {
#pragma unroll
            for (int j = 0; j < 4; ++j) *(f32x4*)(p->out + (size_t)r * 1024 + 4 * lane + 256 * j) = v[j];
        }
    }
    if (l == 0) convert_small(p, 1, lds, lane, wave, bid, G);
}

#define XB_TMO      128
#define XB_XCNT(j)  (256  + 64 * (j))
#define XB_XSUB(j)  (1280 + 64 * (j))
#define XB_XGEN(j)  (2304 + 64 * (j))
#define XB_TOP      3328
#define XB_TOPGEN   3392
#define XCD_BAR_WORDS 3456
#define XB_SPIN_CAP (1u << 18)

__device__ __forceinline__ unsigned xb_ld(unsigned* p)              { return __hip_atomic_load(p, __ATOMIC_RELAXED, __HIP_MEMORY_SCOPE_AGENT); }
__device__ __forceinline__ unsigned xb_add(unsigned* p, unsigned v) { return __hip_atomic_fetch_add(p, v, __ATOMIC_RELAXED, __HIP_MEMORY_SCOPE_AGENT); }
__device__ __forceinline__ unsigned xb_xcc_id() { return (unsigned)__builtin_amdgcn_s_getreg((3 << 11) | 20) & 0xFu; }
#define XB_SPIN(cond, bar) do { unsigned _sp = 0; while (cond) { __builtin_amdgcn_s_sleep(1); \
    if ((++_sp & 255u) == 0u) { if (xb_ld(&(bar)[XB_TMO])) break; if (_sp > XB_SPIN_CAP) { atomicAdd(&(bar)[XB_TMO], 1u); break; } } } } while (0)

struct XcdBarrier {
    unsigned* bar; unsigned x;
    volatile LAS unsigned* st;
};

__device__ __forceinline__ XcdBarrier xcd_barrier_post(unsigned* bar, volatile LAS unsigned* st) {
    XcdBarrier b; b.bar = bar; b.x = xb_xcc_id(); b.st = st;
    if (threadIdx.x == 0) (void)xb_add(&bar[XB_XCNT(b.x)], 1u);
    return b;
}
__device__ __forceinline__ void xcd_barrier_complete(unsigned* bar, unsigned x, unsigned& nloc, unsigned& nx) {
    const unsigned G = gridDim.x * gridDim.y * gridDim.z;
    unsigned sum, cnt, mine, sp = 0u;
    for (;;) {
        sum = 0u; cnt = 0u; mine = 0u;
#pragma unroll
        for (unsigned j = 0; j < 16; ++j) { const unsigned c = xb_ld(&bar[XB_XCNT(j)]); sum += c; cnt += (c > 0u) ? 1u : 0u; mine = (j == x) ? c : mine; }
        if (sum == G) break;
        __builtin_amdgcn_s_sleep(1);
        if ((++sp & 255u) == 0u) { if (xb_ld(&bar[XB_TMO])) break; if (sp > XB_SPIN_CAP) { atomicAdd(&bar[XB_TMO], 1u); break; } }
    }
    nloc = mine > 0u ? mine : 1u; nx = cnt > 0u ? cnt : 1u;
}

__device__ __forceinline__ void xcd_barrier(const XcdBarrier& b) {
    asm volatile("s_waitcnt vmcnt(0)" ::: "memory");
    __syncthreads();
    if (threadIdx.x == 0) {
        unsigned* bar = b.bar;
        __builtin_amdgcn_s_waitcnt(0);
        unsigned nloc = b.st[0], nx = b.st[1];
        if (nloc == 0u) { xcd_barrier_complete(bar, b.x, nloc, nx); b.st[0] = nloc; b.st[1] = nx; }
        const unsigned old = xb_add(&bar[XB_XSUB(b.x)], 1u);
        const unsigned gen = old / nloc;
        if (old + 1u == (gen + 1u) * nloc) {
            __builtin_amdgcn_fence(__ATOMIC_RELEASE, "agent");
            asm volatile("s_waitcnt vmcnt(0)" ::: "memory");
            const unsigned og = xb_add(&bar[XB_TOP], 1u);
            const unsigned tg = og / nx;
            if (og + 1u == (tg + 1u) * nx) xb_add(&bar[XB_TOPGEN], 1u);
            else XB_SPIN(xb_ld(&bar[XB_TOPGEN]) == tg, bar);
            __builtin_amdgcn_fence(__ATOMIC_ACQUIRE, "agent");
            xb_add(&bar[XB_XGEN(b.x)], 1u);
            asm volatile("s_waitcnt vmcnt(0)" ::: "memory");
        } else {
            XB_SPIN(xb_ld(&bar[XB_XGEN(b.x)]) == gen, bar);
            __builtin_amdgcn_fence(__ATOMIC_ACQUIRE, "agent");
            asm volatile("s_waitcnt vmcnt(0)" ::: "memory");
        }
    }
    __syncthreads();
}

#ifndef REP_GZA
#define REP_GZA 1
#endif
#ifndef REP_GG
#define REP_GG 1
#endif
#ifndef REP_GMRG
#define REP_GMRG 1
#endif
#ifndef REP_GM1
#define REP_GM1 1
#endif
#ifndef REP_GM2
#define REP_GM2 1
#endif
#ifndef REP_ATT
#define REP_ATT 1
#endif
#ifndef REP_UPD
#define REP_UPD 1
#endif
#ifndef REP_SGU
#define REP_SGU 1
#endif
#ifndef REP_SCAN
#define REP_SCAN 1
#endif
#ifndef REP_PRE
#define REP_PRE 1
#endif
#ifndef REP_CMB
#define REP_CMB 1
#endif
#ifndef REP_MIX
#define REP_MIX 1
#endif
#ifndef REP_RO
#define REP_RO 1
#endif
#ifndef REP_N2
#define REP_N2 1
#endif
#ifndef REP_GEMM
#define REP_GEMM 1
#endif
#ifndef REP_SYNC
#define REP_SYNC 1
#endif
#ifndef EN_GEMM
#define EN_GEMM 0x3f
#endif
#ifndef EN_ATT
#define EN_ATT 1
#endif
#ifndef EN_UPD
#define EN_UPD 1
#endif
#ifndef EN_SGU
#define EN_SGU 1
#endif
#ifndef EN_RO
#define EN_RO 1
#endif
#ifndef EN_MISC
#define EN_MISC 1
#endif
#define KPP() ({ KPC q_ = kp_; asm volatile("" : "+s"(q_)); q_; })
__global__ void __launch_bounds__(512, 2) mk_fwd(KP p_unused) {
    extern __shared__ __attribute__((aligned(16))) unsigned char lds_raw[];
    LAS unsigned char* lds = (LAS unsigned char*)lds_raw;
    cg::grid_group grid = cg::this_grid();
    const int bid = blockIdx.x, G = gridDim.x;
#define IDS() int tid = threadIdx.x; asm volatile("" : "+v"(tid)); const int lane = tid & 63, wave = __builtin_amdgcn_readfirstlane(tid >> 6); (void)lane; (void)wave
    const KPC kp_ = (KPC)__builtin_amdgcn_kernarg_segment_ptr();
    volatile LAS unsigned* bst = (volatile LAS unsigned*)(lds + 147392);
    if (threadIdx.x < 16) bst[threadIdx.x] = 0u;
    __syncthreads();
    (void)xcd_barrier_post((unsigned*)KPP()->ws, bst);
#ifdef PROBE_WAIT
    unsigned long long wacc = 0ull;
    int bidx_ = 0;
#ifndef PW_LO
#define PW_LO 0
#define PW_HI 100
#endif
#define GSYNC() do { const unsigned long long t0_ = __builtin_amdgcn_s_memrealtime(); XcdBarrier b_; b_.bar = (unsigned*)KPP()->ws; b_.x = xb_xcc_id(); b_.st = bst; xcd_barrier(b_); if (bidx_ >= PW_LO && bidx_ < PW_HI) wacc += __builtin_amdgcn_s_memrealtime() - t0_; ++bidx_; } while (0)
#else
#define GSYNC() do { XcdBarrier b_; b_.bar = (unsigned*)KPP()->ws; b_.x = xb_xcc_id(); b_.st = bst; xcd_barrier(b_); } while (0)
#endif

    { IDS(); for (int rep = 0; rep < REP_PRE; ++rep) { phase_prep(KPP(), lds, tid, lane, wave, bid, G); __syncthreads(); } }
    if (G == 0x7fffffff) grid.sync();
    GSYNC();
    { IDS(); for (int rep = 0; rep < REP_PRE; ++rep) phase_norm_in(KPP(), lane, wave, bid, G); }
    GSYNC();
#pragma unroll 1
    for (int l = 0; l < 2; ++l) {
        {
            unsigned char* ws = KPP()->ws;
            pg8::Gemm g{(const pg8::bf16_t*)(ws + WS_H), (const pg8::bf16_t*)(ws + WS_WTIN), M, NZA, 1024}; GroupOrder S{1, M / 256, NZA / 256, 0, 0, G, bid};
            EpiZA E{(bf16*)(ws + WS_ZA)};
            for (int rep = 0; rep < REP_GEMM * REP_GZA; ++rep) pg8::gemm_phase<EpiZA, GroupOrder, true, true>(lds, g, S, E);
#ifdef PROBE_ZA_HALF
            if (bid < PROBE_ZA_HALF) { GroupOrder S2{1, M / 256, NZA / 256, 0, 0, PROBE_ZA_HALF, bid}; pg8::gemm_phase<EpiZA, GroupOrder, true, true>(lds, g, S2, E); }
#endif
#ifdef PROBE_ZA_SLEEP
            { const unsigned long long t0 = __builtin_amdgcn_s_memrealtime(); while (__builtin_amdgcn_s_memrealtime() - t0 < 100000ull) __builtin_amdgcn_s_sleep(64); __syncthreads(); for (int rep = 0; rep < PROBE_ZA_SLEEP; ++rep) pg8::gemm_phase<EpiZA, GroupOrder, true, true>(lds, g, S, E); }
#endif
#ifdef PROBE_ZA_NULL
            { EpiNull En; pg8::gemm_phase<EpiNull, GroupOrder, true, true>(lds, g, S, En); }
#endif
        }
        GSYNC();
        {
            KPC p = KPP(); IDS();
            float mq = fabsf(p->qn_g[l * 64 + lane]), mk = fabsf(p->kn_g[l * 64 + lane]);
            mq = wave_max(mq); mk = wave_max(mk);
            const float Mb2 = 8.0f * mq * mk * LOG2E;
            const int natt = (l == 0) ? 544 : 512, nupd = NB * NCH * 4, nvp = (l == 0) ? (M / 128) : (ML / 128);
            for (int rep = 0; rep < REP_MIX; ++rep)
            for (int it = bid; it < natt + nupd + nvp; it += G) {
                if (it < natt) { for (int q = 0; q < REP_ATT; ++q) att_item(p, l, lds, it, Mb2, tid, lane, wave); }
                else if (it < natt + nupd) { for (int q = 0; q < REP_UPD; ++q) ret_upd_item(p, l, lds, it - natt, tid, lane, wave); }
                else { for (int q = 0; q < REP_SGU; ++q) sgu_vprep_item(p, it - natt - nupd, tid); }
            }
        }
        GSYNC();
        { IDS(); for (int rep = 0; rep < REP_RO * REP_SCAN; ++rep) phase_scan(KPP(), l, tid, bid, G); }
        GSYNC();
        {   KPC p = KPP(); IDS(); const int nch = (l == 0) ? NCH : 32;
            const int nro = NB * nch * 4, nsgu = ((l == 0) ? (M / 128) : (ML / 128)) * 4;
            for (int rep = 0; rep < REP_RO; ++rep)
            for (int it = bid; it < nro + nsgu; it += G) {
                if (it < nro) { const int b = it / (nch * 4), rem = it % (nch * 4); ret_out_item(p, l, lds, b * (NCH * 4) + rem, tid, lane, wave); }
                else sgu_item(p, l, lds, it - nro, tid, lane, wave);
            }
        }
        GSYNC();
        const int Mrows = (l == 0) ? M : ML;
        {
            unsigned char* ws = KPP()->ws;
            pg8::Gemm g{(const pg8::bf16_t*)(ws + WS_H), (const pg8::bf16_t*)(ws + WS_WTIN) + (size_t)NZA * 1024, Mrows, NZG, 1024}; GroupOrder S{1, Mrows / 256, NZG / 256, 0, 0, G, bid};
            EpiSig E{(bf16*)(ws + WS_G)};
            for (int rep = 0; rep < REP_GEMM * REP_GG; ++rep) pg8::gemm_phase<EpiSig, GroupOrder, true, true>(lds, g, S, E);
            if (l == 0 && G == 256 && bid >= CVT_G_IDLE0) { IDS(); convert_experts(KPP(), 0, 0, CVT_G_HI, (bid - CVT_G_IDLE0) * 8 + wave, (256 - CVT_G_IDLE0) * 8, lds, lane, wave); }
        }
        GSYNC();
        {
            KPC p = KPP(); unsigned char* ws = p->ws;
            pg8::Gemm g{(const pg8::bf16_t*)p->out, (const pg8::bf16_t*)(ws + WS_WTBR), 3 * M, 3072, 512}; MergeOrder S{Mrows / 256, G, bid};
            EpiMergeChain E{(const bf16*)(ws + WS_G), (bf16*)(ws + WS_H)};
            for (int rep = 0; rep < REP_GEMM * REP_GMRG; ++rep) pg8::gemm_phase<EpiMergeChain, MergeOrder, true, true>(lds, g, S, E);
            if (l == 0 && G == 256 && bid >= CVT_M_IDLE0) { IDS(); convert_experts(KPP(), 0, CVT_G_HI, CVT_M_HI, (bid - CVT_M_IDLE0) * 8 + wave, (256 - CVT_M_IDLE0) * 8, lds, lane, wave); }
        }
        GSYNC();
        {
            KPC p = KPP(); unsigned char* ws = p->ws;
            pg8::Gemm g{(const pg8::bf16_t*)(ws + WS_H), (const pg8::bf16_t*)(ws + WS_WTOUT), Mrows, 1024, 1024}; GroupOrder S{1, Mrows / 256, 4, 0, 0, G, bid};
            EpiOut E{p->x, p->ctx, (bf16*)(ws + WS_X), (const float*)(ws + WS_MODV) + l * 9 * 6144, (l == 0) ? 1 : 0};
            pg8::gemm_phase<EpiOut, GroupOrder, true, true>(lds, g, S, E);
            if (l == 0 && G == 256 && bid >= CVT_O_IDLE0) { IDS(); convert_experts(KPP(), 0, CVT_M_HI, CVT_ITEMS, (bid - CVT_O_IDLE0) * 8 + wave, (256 - CVT_O_IDLE0) * 8, lds, lane, wave); }
        }
        GSYNC();
        { IDS(); for (int rep = 0; rep < REP_N2; ++rep) { phase_norm2(KPP(), l, lds, tid, lane, wave, bid, G); __syncthreads(); } }
        GSYNC();
        { IDS(); for (int rep = 0; rep < REP_N2 * REP_TK; ++rep) phase_topk(KPP(), l, lds, tid, lane, wave, bid, G); }
        GSYNC();
        {
            unsigned char* ws = KPP()->ws;
            pg8::Gemm g{(const pg8::bf16_t*)(ws + WS_XS), (const pg8::bf16_t*)(ws + WS_WT1), NE * ME, NE * 2048, 1024}; GroupOrder S{NE, (l == 0) ? 17 : 16, 8, 17, 8, G, bid};
            EpiMoe1 E{(bf16*)(ws + WS_ACT)};
            for (int rep = 0; rep < REP_GEMM * REP_GM1; ++rep) pg8::gemm_phase<EpiMoe1, GroupOrder, true, true>(lds, g, S, E);
        }
        GSYNC();
        {
            unsigned char* ws = KPP()->ws;
            pg8::Gemm g{(const pg8::bf16_t*)(ws + WS_ACT), (const pg8::bf16_t*)(ws + WS_WT2), NE * ME, NE * 1024, 1024}; GroupOrder S{NE, (l == 0) ? 17 : 16, 4, 17, 4, G, bid};
            EpiMoe2 E{(bf16*)(ws + WS_XS), (const float*)(ws + WS_TOPW)};
            for (int rep = 0; rep < REP_GEMM * REP_GM2; ++rep) pg8::gemm_phase<EpiMoe2, GroupOrder, true, true>(lds, g, S, E);
        }
        GSYNC();
        { IDS(); for (int rep = 0; rep < ((l == 1) ? REP_CMB : 1); ++rep) phase_combine(KPP(), l, lds, tid, lane, wave, bid, G); }
        if (l == 0) GSYNC();
        for (int rep = 1; rep < REP_SYNC; ++rep) { for (int k = 0; k < 12; ++k) GSYNC(); }
    }
#ifdef PROBE_WAIT
    if (bid == PROBE_WAIT - 1) { const unsigned long long t0 = __builtin_amdgcn_s_memrealtime(); while (__builtin_amdgcn_s_memrealtime() - t0 < wacc) __builtin_amdgcn_s_sleep(8); }
#endif
}

extern "C" void kernel_launch(void* const* d_in, const int* in_sizes, int n_in, void* d_out, int out_size, void* d_ws, size_t ws_size, hipStream_t stream) {
    static int grid = 0;
    if (grid == 0) {
        if (n_in != 22 || out_size != ML * D || ws_size < WS_END) { fprintf(stderr, "kernel_launch: unexpected shapes (n_in %d out %d ws %zu, need %zu)\n", n_in, out_size, ws_size, (size_t)WS_END); grid = -1; return; }
        int dev = 0, cus = 0, per_cu = 0;
        if (hipGetDevice(&dev) != hipSuccess || hipDeviceGetAttribute(&cus, hipDeviceAttributeMultiprocessorCount, dev) != hipSuccess) { grid = -1; return; }
        if (hipFuncSetAttribute((const void*)mk_fwd, hipFuncAttributeMaxDynamicSharedMemorySize, LDS_BYTES) != hipSuccess) { fprintf(stderr, "kernel_launch: hipFuncSetAttribute failed\n"); grid = -1; return; }
        if (hipOccupancyMaxActiveBlocksPerMultiprocessor(&per_cu, (const void*)mk_fwd, 512, LDS_BYTES) != hipSuccess || per_cu < 1) { fprintf(stderr, "kernel_launch: occupancy query says %d\n", per_cu); (void)hipGetLastError(); }
        grid = cus;
        fprintf(stderr, "kernel_launch: grid %d, occupancy %d/CU, ws %zu\n", grid, per_cu, ws_size);
    }
    if (grid < 0) return;
    if (hipMemsetAsync(d_ws, 0, 16384, stream) != hipSuccess) { fprintf(stderr, "kernel_launch: memset failed\n"); return; }
    KP hp{};
    const float** f = (const float**)&hp;
    for (int i = 0; i < 22; ++i) f[i] = (const float*)d_in[i];
    hp.out = (float*)d_out; hp.ws = (unsigned char*)d_ws;
    void* args[] = {&hp};
    hipError_t e = hipLaunchCooperativeKernel((const void*)mk_fwd, dim3(grid), dim3(512), args, LDS_BYTES, stream);
    if (e != hipSuccess) fprintf(stderr, "kernel_launch: cooperative launch failed: %s\n", hipGetErrorString(e));
}
```

```cpp
#include <hip/hip_runtime.h>
#include <hip/hip_cooperative_groups.h>
#include <cstdio>
#include <cstdint>
namespace cg = cooperative_groups;

namespace pg8 {
#define PG8_LAS __attribute__((address_space(3)))
typedef unsigned short bf16_t;
typedef short bf16x8 __attribute__((ext_vector_type(8)));
typedef float f32x4 __attribute__((ext_vector_type(4)));
typedef unsigned u32x4 __attribute__((ext_vector_type(4)));
constexpr int BM = 256, BK = 64, HALF = 128, HTB = HALF * BK * 2  , STAGE_BYTES = 8 * HTB, NXCD = 8, WGM = 8;

__host__ __device__ __forceinline__ int lds_byte(int r, int c) { const int st = (r >> 4) * 2 + (c >> 5), rr = r & 15, cc = c & 31, ob = rr * 64 + cc * 2; return st * 1024 + (ob ^ (((ob >> 9) & 1) << 5)); }
__host__ __device__ __forceinline__ void stage_rc(int b, int& R, int& C) { const int st = b / 1024, sb = b % 1024, swz = sb ^ (((sb >> 9) & 1) << 5); R = (st >> 1) * 16 + swz / 64; C = (st & 1) * 32 + (swz % 64) / 2; }
__host__ __device__ __forceinline__ int perm32(int rho) { const int n = rho >> 4, i = rho & 15; return 8 * (i >> 2) + 4 * n + (i & 3); }

struct Unit { int pm, pn; };
struct Gemm { const bf16_t* A; const bf16_t* Bt; int M, N, K; };

struct StaticOrder {
    int nM, nN, nwg, G, c;
    __host__ __device__ void init(int M, int N, int G_, int c_) { nM = M / BM; nN = N / BM; nwg = nM * nN; G = G_; c = c_; }
    __host__ __device__ bool next(int i, Unit& u) const {
        const long L = (long)i * G + c; if (L >= nwg) return false;
        int wgid = (int)L; { const int q = nwg / NXCD, r = nwg % NXCD, xcd = wgid % NXCD, off = wgid / NXCD; wgid = (xcd < r ? xcd * (q + 1) : r * (q + 1) + (xcd - r) * q) + off; }
        const int nig = WGM * nN, gid = wgid / nig, fm = gid * WGM, gsz = (nM - fm) < WGM ? (nM - fm) : WGM;
        u.pm = fm + ((wgid % nig) % gsz); u.pn = (wgid % nig) / gsz; return true;
    }
    __device__ __forceinline__ void a_ready(const Unit&) const {}
    __device__ __forceinline__ void done(const Unit&) const {}
};

__device__ __forceinline__ unsigned cvt_pk_bf16(float lo, float hi) { unsigned r; asm volatile("v_cvt_pk_bf16_f32 %0, %1, %2" : "=v"(r) : "v"(lo), "v"(hi)); return r; }
typedef float f32x2 __attribute__((ext_vector_type(2)));
__device__ __forceinline__ f32x2 gelu_pk(f32x2 v) {
    const f32x2 av = __builtin_elementwise_abs(v), d = av * 0.2316418882f + 1.0f;
    f32x2 t; t.x = __builtin_amdgcn_rcpf(d.x); t.y = __builtin_amdgcn_rcpf(d.y);
    f32x2 q = t * 0.5307027145f + (-0.7265760135f); q = q * t + 0.7107068705f; q = q * t + (-0.142248368f); q = q * t + 0.127414796f; q = q * t;
    const f32x2 s = (v * v) * (-0.72134752044f);
    f32x2 e; e.x = __builtin_amdgcn_exp2f(s.x); e.y = __builtin_amdgcn_exp2f(s.y);
    const f32x2 m = v * (q * e), r = v - m;
    f32x2 o; o.x = v.x < 0.f ? m.x : r.x; o.y = v.y < 0.f ? m.y : r.y; return o;
}

template <int ACT  > struct EpiBf16 {
    static constexpr bool PERM = true, AFTER_DRAIN = false, CHAIN = false; static_assert(ACT == 0 || ACT == 1, "EpiBf16: ACT is 0 (none) or 1 (gelu_pk)");
    bf16_t* O; int ldc; const float* bias; int split_cols; size_t split_stride; float scale0;
    __device__ __forceinline__ void operator()(const f32x4 (&acc)[2][2][4][2], const Unit& u, int wr, int wc, int fr, int fq) const {
        const int row0 = u.pm * BM + wr * 64 + fr; int colt = u.pn * BM; bf16_t* base = O;
        float sc = 1.f; if (split_cols) { const int t = colt / split_cols; base += (size_t)t * split_stride; colt -= t * split_cols; if (t == 0) sc = scale0; }
        const int col0 = colt + wc * 32 + 8 * fq, bcol0 = u.pn * BM + wc * 32 + 8 * fq;
        f32x4 bv[2][2];
#pragma unroll
        for (int bj = 0; bj < 2; ++bj)
#pragma unroll
            for (int n = 0; n < 2; ++n) bv[bj][n] = bias ? *(const f32x4*)(bias + bcol0 + bj * HALF + 4 * n) : (f32x4){0.f, 0.f, 0.f, 0.f};
#pragma unroll
        for (int ai = 0; ai < 2; ++ai)
#pragma unroll
            for (int m = 0; m < 4; ++m) { bf16_t* rowp = base + (size_t)(row0 + ai * HALF + m * 16) * ldc + col0;
#pragma unroll
                for (int bj = 0; bj < 2; ++bj) { f32x4 v0 = acc[ai][bj][m][0] + bv[bj][0], v1 = acc[ai][bj][m][1] + bv[bj][1];
                    if (ACT == 1) { f32x2 a = gelu_pk((f32x2){v0[0], v0[1]}), b = gelu_pk((f32x2){v0[2], v0[3]}), c = gelu_pk((f32x2){v1[0], v1[1]}), d = gelu_pk((f32x2){v1[2], v1[3]});
                        v0 = (f32x4){a.x, a.y, b.x, b.y}; v1 = (f32x4){c.x, c.y, d.x, d.y}; }
                    v0 = v0 * sc; v1 = v1 * sc; u32x4 w; w.x = cvt_pk_bf16(v0[0], v0[1]); w.y = cvt_pk_bf16(v0[2], v0[3]); w.z = cvt_pk_bf16(v1[0], v1[1]); w.w = cvt_pk_bf16(v1[2], v1[3]);
                    *(u32x4*)(rowp + bj * HALF) = w; } }
    }
};
template <class Epi, class Sched, bool ALIGN_EPI = false, bool SP2 = false>
__device__ __forceinline__ void gemm_phase(PG8_LAS unsigned char* lds, const Gemm g, const Sched& S, const Epi& E) {
    int tid_ = threadIdx.x; asm volatile("" : "+v"(tid_));
    const int tid = tid_, wid = __builtin_amdgcn_readfirstlane(tid >> 6), lane = tid & 63, wr = wid >> 2, wc = wid & 3, fr = lane & 15, fq = lane >> 4;
    const int K = g.K, nt = K / BK;
    unsigned voffA[2], voffB[2];
#pragma unroll
    for (int i = 0; i < 2; ++i) { int R, C; stage_rc(tid * 16 + i * 8192, R, C); const int Rb = Epi::PERM ? ((R & ~31) + perm32(R & 31)) : R;
        voffA[i] = (unsigned)(R * K + C) * 2u; voffB[i] = (unsigned)(Rb * K + C) * 2u; }
    const size_t kstep = (size_t)(BK * 2);
    const size_t hstep = (size_t)HALF * K * 2;
    const size_t tstep = 2 * hstep;
    const unsigned ldsw = (unsigned)wid * 1024u;
    const int aoff = lds_byte(wr * 64 + fr, fq * 8), boff = lds_byte(wc * 32 + fr, fq * 8);
#define PG8_SA(b, h) (((b) * 2 + (h)) * HTB)
#define PG8_SB(b, h) ((4 + (b) * 2 + (h)) * HTB)
#define PG8_STAGE(bufoff, gbase, voff) do { _Pragma("unroll") for (int _i = 0; _i < 2; ++_i) \
        __builtin_amdgcn_global_load_lds((const unsigned*)((const char*)(gbase) + (voff)[_i]), (PG8_LAS unsigned*)(lds + (bufoff) + ldsw + _i * 8192), 16, 0, 0); } while (0)
#define PG8_LDA(dst, b, h) do { _Pragma("unroll") for (int m = 0; m < 4; ++m) _Pragma("unroll") for (int k = 0; k < 2; ++k) dst[m][k] = *(const PG8_LAS bf16x8*)(lds + PG8_SA(b, h) + aoff + m * 2048 + k * 1024); } while (0)
#define PG8_LDB(dst, b, h) do { _Pragma("unroll") for (int n = 0; n < 2; ++n) _Pragma("unroll") for (int k = 0; k < 2; ++k) dst[n][k] = *(const PG8_LAS bf16x8*)(lds + PG8_SB(b, h) + boff + n * 2048 + k * 1024); } while (0)
#define PG8_MMA(ai, bj, At, Bt) do { __builtin_amdgcn_s_setprio(1); _Pragma("unroll") for (int m = 0; m < 4; ++m) _Pragma("unroll") for (int n = 0; n < 2; ++n) _Pragma("unroll") for (int k = 0; k < 2; ++k) \
        acc[ai][bj][m][n] = __builtin_amdgcn_mfma_f32_16x16x32_bf16(Bt[n][k], At[m][k], acc[ai][bj][m][n], 0, 0, 0); __builtin_amdgcn_s_setprio(0); } while (0)
#define PG8_WAIT_V(n) asm volatile("s_waitcnt vmcnt(" #n ")" ::: "memory")
#define PG8_WAIT_L(n) asm volatile("s_waitcnt lgkmcnt(" #n ")" ::: "memory")
#define PG8_BAR __builtin_amdgcn_s_barrier()
#define PG8_SCHED __builtin_amdgcn_sched_barrier(0)
    Unit cur, nxt; int ui = 0;
    if (!S.next(0, cur)) return;
    f32x4 acc[2][2][4][2];
#pragma unroll
    for (int a = 0; a < 2; ++a)
#pragma unroll
        for (int b = 0; b < 2; ++b)
#pragma unroll
            for (int m = 0; m < 4; ++m)
#pragma unroll
                for (int n = 0; n < 2; ++n) acc[a][b][m][n] = (f32x4){0.f, 0.f, 0.f, 0.f};
    bf16x8 At[4][2], B0[2][2], B1[2][2];
    const char* cA = (const char*)g.A + (size_t)cur.pm * tstep; const char* cB = (const char*)g.Bt + (size_t)cur.pn * tstep;
    S.a_ready(cur);
    if constexpr (SP2) {
        PG8_STAGE(PG8_SB(0, 0), cB, voffB); PG8_STAGE(PG8_SB(0, 1), cB + hstep, voffB); PG8_STAGE(PG8_SA(0, 0), cA, voffA); PG8_STAGE(PG8_SA(0, 1), cA + hstep, voffA);
        if (wr == 1) PG8_BAR;
        PG8_WAIT_V(2); PG8_BAR;
        PG8_STAGE(PG8_SB(1, 0), cB + kstep, voffB); PG8_STAGE(PG8_SA(1, 0), cA + kstep, voffA); PG8_STAGE(PG8_SB(1, 1), cB + hstep + kstep, voffB);
        PG8_WAIT_V(6); PG8_BAR;
    } else {
        PG8_STAGE(PG8_SB(0, 0), cB, voffB); PG8_STAGE(PG8_SA(0, 0), cA, voffA); PG8_STAGE(PG8_SB(0, 1), cB + hstep, voffB); PG8_STAGE(PG8_SA(0, 1), cA + hstep, voffA);
        if (wr == 1) PG8_BAR;
        PG8_WAIT_V(4); PG8_BAR;
        PG8_STAGE(PG8_SB(1, 0), cB + kstep, voffB); PG8_STAGE(PG8_SA(1, 0), cA + kstep, voffA); PG8_STAGE(PG8_SB(1, 1), cB + hstep + kstep, voffB);
        PG8_WAIT_V(6); PG8_BAR;
    }
    for (;;) {
        const bool has_next = S.next(ui + 1, nxt);
        const char* nA = has_next ? (const char*)g.A + (size_t)nxt.pm * tstep : cA; const char* nB = has_next ? (const char*)g.Bt + (size_t)nxt.pn * tstep : cB;
        for (int t = 0; t < nt; t += 2) {
            const bool last = (t == nt - 2);
            const char* a1 = cA + (size_t)(t + 1) * kstep;
            const char* a2 = last ? nA : cA + (size_t)(t + 2) * kstep; const char* b2 = last ? nB : cB + (size_t)(t + 2) * kstep;
            const char* a3 = a2 + kstep; const char* b3 = b2 + kstep;
            if (last && has_next) S.a_ready(nxt);
            if constexpr (SP2) {
            PG8_LDB(B0, 0, 0); PG8_LDB(B1, 0, 1); PG8_SCHED; PG8_LDA(At, 0, 0); PG8_STAGE(PG8_SA(1, 1), a1 + hstep, voffA);
            PG8_WAIT_V(8); PG8_WAIT_L(0); PG8_BAR; PG8_MMA(0, 0, At, B0); PG8_MMA(0, 1, At, B1); PG8_BAR; PG8_SCHED;
            PG8_LDA(At, 0, 1); PG8_STAGE(PG8_SB(0, 0), b2, voffB); PG8_STAGE(PG8_SB(0, 1), b2 + hstep, voffB); PG8_STAGE(PG8_SA(0, 0), a2, voffA);
            PG8_WAIT_V(8); PG8_WAIT_L(0); PG8_BAR; PG8_MMA(1, 0, At, B0); PG8_MMA(1, 1, At, B1); PG8_BAR; PG8_SCHED;
            PG8_LDB(B0, 1, 0); PG8_LDB(B1, 1, 1); PG8_SCHED; PG8_LDA(At, 1, 0); PG8_STAGE(PG8_SA(0, 1), a2 + hstep, voffA);
            PG8_WAIT_V(8); PG8_WAIT_L(0); PG8_BAR; PG8_MMA(0, 0, At, B0); PG8_MMA(0, 1, At, B1); PG8_BAR; PG8_SCHED;
            PG8_LDA(At, 1, 1); PG8_STAGE(PG8_SB(1, 0), b3, voffB); PG8_STAGE(PG8_SB(1, 1), b3 + hstep, voffB); PG8_STAGE(PG8_SA(1, 0), a3, voffA);
            PG8_WAIT_V(8); PG8_WAIT_L(0); PG8_BAR; PG8_MMA(1, 0, At, B0); PG8_MMA(1, 1, At, B1); PG8_BAR; PG8_SCHED;
            } else {
            PG8_LDB(B0, 0, 0); PG8_SCHED; PG8_LDA(At, 0, 0); PG8_STAGE(PG8_SA(1, 1), a1 + hstep, voffA);
            PG8_WAIT_L(8); PG8_BAR; PG8_WAIT_L(0); PG8_MMA(0, 0, At, B0); PG8_BAR; PG8_SCHED;
            PG8_LDB(B1, 0, 1); PG8_STAGE(PG8_SB(0, 0), b2, voffB);
            PG8_BAR; PG8_WAIT_L(0); PG8_MMA(0, 1, At, B1); PG8_BAR;
            PG8_LDA(At, 0, 1); PG8_STAGE(PG8_SA(0, 0), a2, voffA);
            PG8_BAR; PG8_WAIT_L(0); PG8_MMA(1, 0, At, B0); PG8_BAR; PG8_SCHED;
            PG8_STAGE(PG8_SB(0, 1), b2 + hstep, voffB);
            PG8_WAIT_V(6); PG8_BAR; PG8_MMA(1, 1, At, B1); PG8_BAR;
            PG8_LDB(B0, 1, 0); PG8_SCHED; PG8_LDA(At, 1, 0); PG8_STAGE(PG8_SA(0, 1), a2 + hstep, voffA);
            PG8_WAIT_L(8); PG8_BAR; PG8_WAIT_L(0); PG8_MMA(0, 0, At, B0); PG8_BAR; PG8_SCHED;
            PG8_LDB(B1, 1, 1); PG8_STAGE(PG8_SB(1, 0), b3, voffB);
            PG8_BAR; PG8_WAIT_L(0); PG8_MMA(0, 1, At, B1); PG8_BAR;
            PG8_LDA(At, 1, 1); PG8_STAGE(PG8_SA(1, 0), a3, voffA);
            PG8_BAR; PG8_WAIT_L(0); PG8_MMA(1, 0, At, B0); PG8_BAR; PG8_SCHED;
            PG8_STAGE(PG8_SB(1, 1), b3 + hstep, voffB);
            PG8_WAIT_V(6); PG8_BAR; PG8_MMA(1, 1, At, B1); PG8_BAR;
            }
        }
        if constexpr (ALIGN_EPI) { if (wr == 0) PG8_BAR; }
        bool keep_acc = false;
        if constexpr (Epi::CHAIN) { keep_acc = E.chain(acc, cur, wr, wc, fr, fq); S.done(cur); }
        else if constexpr (!Epi::AFTER_DRAIN) { E(acc, cur, wr, wc, fr, fq); S.done(cur); }
        if (!has_next) break;
        if (!keep_acc) {
#pragma unroll
        for (int a = 0; a < 2; ++a)
#pragma unroll
            for (int b = 0; b < 2; ++b)
#pragma unroll
                for (int m = 0; m < 4; ++m)
#pragma unroll
                    for (int n = 0; n < 2; ++n) acc[a][b][m][n] = (f32x4){0.f, 0.f, 0.f, 0.f};
        }
        cur = nxt; cA = nA; cB = nB; ++ui;
        if constexpr (ALIGN_EPI) { if (wr == 1) PG8_BAR; }
    }
    PG8_WAIT_V(0);
    if constexpr (!ALIGN_EPI) { if (wr == 0) PG8_BAR; }
    PG8_BAR;
    if constexpr (Epi::AFTER_DRAIN) { E.fused(acc, cur, wr, wc, fr, fq, lds, wid, lane); S.done(cur); }
#undef PG8_SA
#undef PG8_SB
#undef PG8_STAGE
#undef PG8_LDA
#undef PG8_LDB
#undef PG8_MMA
#undef PG8_WAIT_V
#undef PG8_WAIT_L
#undef PG8_BAR
#undef PG8_SCHED
}
}

#define LAS __attribute__((address_space(3)))
typedef unsigned short bf16;
typedef short bf16x8 __attribute__((ext_vector_type(8)));
typedef float f32x4 __attribute__((ext_vector_type(4)));
typedef unsigned u32x4 __attribute__((ext_vector_type(4)));
typedef unsigned u32x2 __attribute__((ext_vector_type(2)));

constexpr int D = 1024, NB = 8, T = 4096, CL = 256;
constexpr int ML = NB * T, MC = NB * CL, M = ML + MC;
constexpr int NZA = 3328, NZG = 3072;
constexpr int C_RQ = 0, C_RK = 256, C_RV = 512, C_RG = 1024, C_SU = 1536, C_SV = 2048, C_AQ = 2560, C_AK = 3072, C_AV = 3200;
constexpr int NE = 16, CAPL = 512, CAPC = 32, ME = NB * (CAPL + CAPC);
constexpr int NCH = 34;
constexpr float EPS = 1e-6f, LOG2E = 1.4426950408889634f;
constexpr int LDS_BYTES = 147456;

constexpr size_t MiB = 1u << 20;
constexpr size_t WS_ROPEC = 1 * MiB, WS_ROPES = 1 * MiB + 512 * 1024, WS_MODV = 2 * MiB, WS_AFF = 3 * MiB, WS_AFFC = 5 * MiB, WS_INV = 6 * MiB, WS_TOPW = 9 * MiB;
constexpr size_t WS_WTIN = 16 * MiB, WS_WTBR = WS_WTIN + (size_t)6400 * 1024 * 2, WS_WTOUT = WS_WTBR + (size_t)3072 * 512 * 2;
constexpr size_t WS_X = 34 * MiB, WS_H = 170 * MiB, WS_R = 238 * MiB;
constexpr size_t WS_ZA = WS_R, WS_G = WS_R, WS_RS = 459 * MiB, WS_ST = 527 * MiB;
constexpr size_t WS_XS = WS_R, WS_ACT = 374 * MiB, WS_WT1 = 510 * MiB, WS_WT2 = 574 * MiB, WS_END = 606 * MiB;
static_assert(WS_WTOUT + 2 * MiB <= WS_X && WS_ZA + (size_t)M * NZA * 2 <= WS_RS && WS_ST + (size_t)NB * 4 * NCH * 128 * 128 * 2 <= WS_END, "ws map");

struct KP {
    const float *x, *c, *ctx, *c_ctx, *w_mod, *b_mod, *norm1_g, *norm2_g, *w_in, *dec_f, *dec_b, *sgu_w, *sgu_b, *qn_g, *kn_g, *sink, *w_branch, *w_out, *w_router, *w_eg, *w_eu, *w_ed;
    float* out; unsigned char* ws;
};
typedef const __attribute__((address_space(4))) KP* KPC;

#define LDS_WAIT() asm volatile("s_waitcnt lgkmcnt(0)" ::: "memory")
__device__ __forceinline__ unsigned pk2(float lo, float hi) { return pg8::cvt_pk_bf16(lo, hi); }
__device__ __forceinline__ float bflo(unsigned w) { return __uint_as_float(w << 16); }
__device__ __forceinline__ float bfhi(unsigned w) { return __uint_as_float(w & 0xffff0000u); }
__device__ __forceinline__ void unpack8(const u32x4 w, float (&f)[8]) { f[0] = bflo(w.x); f[1] = bfhi(w.x); f[2] = bflo(w.y); f[3] = bfhi(w.y); f[4] = bflo(w.z); f[5] = bfhi(w.z); f[6] = bflo(w.w); f[7] = bfhi(w.w); }
__device__ __forceinline__ u32x4 pack8(const float (&f)[8]) { u32x4 o; o.x = pk2(f[0], f[1]); o.y = pk2(f[2], f[3]); o.z = pk2(f[4], f[5]); o.w = pk2(f[6], f[7]); return o; }
template <int MASK> __device__ __forceinline__ float swz_xor(float v) { static_assert(MASK > 0 && MASK < 32, "swz_xor: 1..31"); return __builtin_bit_cast(float, __builtin_amdgcn_ds_swizzle(__builtin_bit_cast(int, v), 0x1f | (MASK << 10))); }
template <int MASK> __device__ __forceinline__ int swz_xor_i(int v) { return __builtin_amdgcn_ds_swizzle(v, 0x1f | (MASK << 10)); }
__device__ __forceinline__ float sum_x32(float v) { const unsigned u = __builtin_bit_cast(unsigned, v); auto r = __builtin_amdgcn_permlane32_swap(u, u, false, false); return __builtin_bit_cast(float, (unsigned)r[0]) + __builtin_bit_cast(float, (unsigned)r[1]); }
__device__ __forceinline__ float max_x32(float v) { const unsigned u = __builtin_bit_cast(unsigned, v); auto r = __builtin_amdgcn_permlane32_swap(u, u, false, false); return fmaxf(__builtin_bit_cast(float, (unsigned)r[0]), __builtin_bit_cast(float, (unsigned)r[1])); }
__device__ __forceinline__ int sum_x32_i(int v) { auto r = __builtin_amdgcn_permlane32_swap((unsigned)v, (unsigned)v, false, false); return (int)r[0] + (int)r[1]; }
__device__ __forceinline__ float wave_sum(float v) { v += swz_xor<1>(v); v += swz_xor<2>(v); v += swz_xor<4>(v); v += swz_xor<8>(v); v += swz_xor<16>(v); return sum_x32(v); }
__device__ __forceinline__ float wave_max(float v) { v = fmaxf(v, swz_xor<1>(v)); v = fmaxf(v, swz_xor<2>(v)); v = fmaxf(v, swz_xor<4>(v)); v = fmaxf(v, swz_xor<8>(v)); v = fmaxf(v, swz_xor<16>(v)); return max_x32(v); }
__device__ __forceinline__ int wave_sum_i(int v) { v += swz_xor_i<1>(v); v += swz_xor_i<2>(v); v += swz_xor_i<4>(v); v += swz_xor_i<8>(v); v += swz_xor_i<16>(v); return sum_x32_i(v); }
__device__ __forceinline__ float sum_x16_x32(float v) { v += swz_xor<16>(v); return sum_x32(v); }
__device__ __forceinline__ float sum_x1_x2(float v) { v += swz_xor<1>(v); v += swz_xor<2>(v); return v; }
__device__ __forceinline__ float ex2(float x) { return __builtin_amdgcn_exp2f(x); }
__device__ __forceinline__ float sigmoidf_(float x) { return 1.f / (1.f + ex2(-x * LOG2E)); }
__device__ __forceinline__ float gelu_tanh(float x) { const float u = 0.7978845608028654f * (x + 0.044715f * x * x * x); return x / (1.f + ex2(-2.f * LOG2E * u)); }
__device__ __forceinline__ f32x4 mfma16(bf16x8 a, bf16x8 b, f32x4 c) { return __builtin_amdgcn_mfma_f32_16x16x32_bf16(a, b, c, 0, 0, 0); }
__device__ __forceinline__ bf16x8 as_bf16x8(u32x4 w) { return __builtin_bit_cast(bf16x8, w); }
__device__ __forceinline__ float log2_sigmoid(float a) { return -log1pf(__expf(-a)) * LOG2E; }

#ifndef WGM_
#define WGM_ 8
#endif
struct GroupOrder {
    int nG, nM, nN, pmS, pnS, G, c;
    __device__ __forceinline__ bool next(int i, pg8::Unit& u) const {
        const long L = (long)i * G + c; const int tot = nG * nM * nN; if (L >= tot) return false;
        int wgid = (int)L; { const int q = tot / 8, r = tot % 8, xcd = wgid % 8, off = wgid / 8; wgid = (xcd < r ? xcd * (q + 1) : r * (q + 1) + (xcd - r) * q) + off; }
        const int per = nM * nN, g = wgid / per, rem = wgid - g * per;
        const int nig = WGM_ * nN, gid = rem / nig, fm = gid * WGM_, gsz = (nM - fm) < WGM_ ? (nM - fm) : WGM_;
        u.pm = g * pmS + fm + ((rem % nig) % gsz); u.pn = g * pnS + (rem % nig) / gsz; return true;
    }
    __device__ __forceinline__ void a_ready(const pg8::Unit&) const {}
    __device__ __forceinline__ void done(const pg8::Unit&) const {}
};
struct MergeOrder {
    int nM, G, c;
    __device__ __forceinline__ bool next(int i, pg8::Unit& u) const {
        const int ii = i / 3, g = i - 3 * ii; const long L = (long)ii * G + c; const int tot = nM * 4; if (L >= tot) return false;
        int wgid = (int)L; { const int q = tot / 8, r = tot % 8, xcd = wgid % 8, off = wgid / 8; wgid = (xcd < r ? xcd * (q + 1) : r * (q + 1) + (xcd - r) * q) + off; }
        const int nig = 32, gid = wgid / nig, fm = gid * 8, gsz = (nM - fm) < 8 ? (nM - fm) : 8;
        u.pm = g * (M / 256) + fm + ((wgid % nig) % gsz); u.pn = g * 4 + (wgid % nig) / gsz; return true;
    }
    __device__ __forceinline__ void a_ready(const pg8::Unit&) const {}
    __device__ __forceinline__ void done(const pg8::Unit&) const {}
};

struct EpiZA {
    static constexpr bool PERM = true, AFTER_DRAIN = false, CHAIN = false;
    bf16* O;
    __device__ __forceinline__ void operator()(const f32x4 (&acc)[2][2][4][2], const pg8::Unit& u, int wr, int wc, int fr, int fq) const {
        const int row0 = u.pm * 256 + wr * 64 + fr, col0 = u.pn * 256 + wc * 32 + 8 * fq; const bool act = false;
#pragma unroll
        for (int ai = 0; ai < 2; ++ai)
#pragma unroll
            for (int m = 0; m < 4; ++m) { bf16* rowp = O + (size_t)(row0 + ai * 128 + m * 16) * NZA + col0;
#pragma unroll
                for (int bj = 0; bj < 2; ++bj) { const f32x4 v0 = acc[ai][bj][m][0], v1 = acc[ai][bj][m][1];
                    float o[8] = {v0[0], v0[1], v0[2], v0[3], v1[0], v1[1], v1[2], v1[3]};
                    if (act) {
#pragma unroll
                        for (int k = 0; k < 8; ++k) o[k] = gelu_tanh(o[k]); }
                    *(u32x4*)(rowp + bj * 128) = pack8(o); } }
    }
};
struct EpiNull {
    static constexpr bool PERM = true, AFTER_DRAIN = false, CHAIN = false;
    __device__ __forceinline__ void operator()(const f32x4 (&acc)[2][2][4][2], const pg8::Unit& u, int wr, int wc, int fr, int fq) const {
#pragma unroll
        for (int ai = 0; ai < 2; ++ai)
#pragma unroll
            for (int m = 0; m < 4; ++m)
#pragma unroll
                for (int bj = 0; bj < 2; ++bj) { asm volatile("" :: "v"(acc[ai][bj][m][0]), "v"(acc[ai][bj][m][1])); }
    }
};
struct EpiSig {
    static constexpr bool PERM = true, AFTER_DRAIN = false, CHAIN = false;
    bf16* O;
    __device__ __forceinline__ void operator()(const f32x4 (&acc)[2][2][4][2], const pg8::Unit& u, int wr, int wc, int fr, int fq) const {
        const int row0 = u.pm * 256 + wr * 64 + fr, col0 = u.pn * 256 + wc * 32 + 8 * fq;
#pragma unroll
        for (int ai = 0; ai < 2; ++ai)
#pragma unroll
            for (int m = 0; m < 4; ++m) { bf16* rowp = O + (size_t)(row0 + ai * 128 + m * 16) * NZG + col0;
#pragma unroll
                for (int bj = 0; bj < 2; ++bj) { const f32x4 v0 = acc[ai][bj][m][0], v1 = acc[ai][bj][m][1];
                    float o[8] = {v0[0], v0[1], v0[2], v0[3], v1[0], v1[1], v1[2], v1[3]};
#pragma unroll
                    for (int k = 0; k < 8; ++k) o[k] = fmaxf(sigmoidf_(o[k]), 1e-20f);
                    *(u32x4*)(rowp + bj * 128) = pack8(o); } }
    }
};
struct EpiMergeChain {
    static constexpr bool PERM = true, AFTER_DRAIN = false, CHAIN = true;
    const bf16* Gt; bf16* Hm;
    __device__ __forceinline__ bool chain(f32x4 (&acc)[2][2][4][2], const pg8::Unit& u, int wr, int wc, int fr, int fq) const {
        const int g = u.pm / (M / 256), m = u.pm - g * (M / 256), n = u.pn - g * 4;
        const int row0 = m * 256 + wr * 64 + fr, col0 = n * 256 + wc * 32 + 8 * fq;
#pragma unroll
        for (int ai = 0; ai < 2; ++ai) {
            u32x4 gw[4][2], hw[4][2];
#pragma unroll
            for (int mm = 0; mm < 4; ++mm)
#pragma unroll
                for (int bj = 0; bj < 2; ++bj) gw[mm][bj] = *(const u32x4*)(Gt + (size_t)(row0 + ai * 128 + mm * 16) * NZG + g * 1024 + col0 + bj * 128);
            if (g < 2) {
#pragma unroll
                for (int mm = 0; mm < 4; ++mm)
#pragma unroll
                    for (int bj = 0; bj < 2; ++bj) hw[mm][bj] = *(const u32x4*)(Gt + (size_t)(row0 + ai * 128 + mm * 16) * NZG + (g + 1) * 1024 + col0 + bj * 128);
            }
#pragma unroll
            for (int mm = 0; mm < 4; ++mm)
#pragma unroll
                for (int bj = 0; bj < 2; ++bj) {
                    float sc[8]; unpack8(gw[mm][bj], sc);
                    if (g < 2) { float sn[8]; unpack8(hw[mm][bj], sn);
#pragma unroll
                        for (int k = 0; k < 8; ++k) sc[k] *= __builtin_amdgcn_rcpf(sn[k]); }
                    f32x4& v0 = acc[ai][bj][mm][0]; f32x4& v1 = acc[ai][bj][mm][1];
                    v0[0] *= sc[0]; v0[1] *= sc[1]; v0[2] *= sc[2]; v0[3] *= sc[3]; v1[0] *= sc[4]; v1[1] *= sc[5]; v1[2] *= sc[6]; v1[3] *= sc[7];
                    if (g == 2) { u32x4 w; w.x = pk2(v0[0], v0[1]); w.y = pk2(v0[2], v0[3]); w.z = pk2(v1[0], v1[1]); w.w = pk2(v1[2], v1[3]);
                        *(u32x4*)(Hm + (size_t)(row0 + ai * 128 + mm * 16) * 1024 + col0 + bj * 128) = w; }
                }
        }
        return g < 2;
    }
};
struct EpiMerge {
    static constexpr bool PERM = true, AFTER_DRAIN = false, CHAIN = false;
    const bf16* Gt; bf16* Hm;
    __device__ __forceinline__ void operator()(const f32x4 (&acc)[2][2][4][2], const pg8::Unit& u, int wr, int wc, int fr, int fq) const {
        const int g = u.pm / (M / 256), m = u.pm - g * (M / 256), n = u.pn - g * 4;
        const int row0 = m * 256 + wr * 64 + fr, col0 = n * 256 + wc * 32 + 8 * fq;
#pragma unroll
        for (int ai = 0; ai < 2; ++ai) {
            u32x4 gw[4][2], ow[4][2];
#pragma unroll
            for (int mm = 0; mm < 4; ++mm)
#pragma unroll
                for (int bj = 0; bj < 2; ++bj) gw[mm][bj] = *(const u32x4*)(Gt + (size_t)(row0 + ai * 128 + mm * 16) * NZG + g * 1024 + col0 + bj * 128);
            if (g > 0) {
#pragma unroll
                for (int mm = 0; mm < 4; ++mm)
#pragma unroll
                    for (int bj = 0; bj < 2; ++bj) ow[mm][bj] = *(const u32x4*)(Hm + (size_t)(row0 + ai * 128 + mm * 16) * 1024 + col0 + bj * 128);
            }
#pragma unroll
            for (int mm = 0; mm < 4; ++mm)
#pragma unroll
                for (int bj = 0; bj < 2; ++bj) {
                    float gt[8]; unpack8(gw[mm][bj], gt);
                    const f32x4 v0 = acc[ai][bj][mm][0], v1 = acc[ai][bj][mm][1];
                    float o[8] = {v0[0], v0[1], v0[2], v0[3], v1[0], v1[1], v1[2], v1[3]};
#pragma unroll
                    for (int k = 0; k < 8; ++k) o[k] *= sigmoidf_(gt[k]);
                    if (g > 0) { float od[8]; unpack8(ow[mm][bj], od);
#pragma unroll
                        for (int k = 0; k < 8; ++k) o[k] += od[k]; }
                    *(u32x4*)(Hm + (size_t)(row0 + ai * 128 + mm * 16) * 1024 + col0 + bj * 128) = pack8(o);
                }
        }
    }
};
struct EpiOut {
    static constexpr bool PERM = true, AFTER_DRAIN = false, CHAIN = false;
    const float* xl; const float* xc; bf16* X; const float* modv; int from_f32;
    __device__ __forceinline__ void operator()(const f32x4 (&acc)[2][2][4][2], const pg8::Unit& u, int wr, int wc, int fr, int fq) const {
        const int row0 = u.pm * 256 + wr * 64 + fr, col0 = u.pn * 256 + wc * 32 + 8 * fq;
        const int bi = (u.pm * 256 < ML) ? ((u.pm * 256) >> 12) : 8;
        const float* g1 = modv + bi * 6144 + 2 * 1024;
        f32x4 gv[2][2];
#pragma unroll
        for (int bj = 0; bj < 2; ++bj) { gv[bj][0] = *(const f32x4*)(g1 + col0 + bj * 128); gv[bj][1] = *(const f32x4*)(g1 + col0 + bj * 128 + 4); }
        if (from_f32) {
            const float* src0 = (u.pm * 256 < ML) ? xl + (size_t)row0 * 1024 : xc + (size_t)(row0 - ML) * 1024;
#pragma unroll
            for (int ai = 0; ai < 2; ++ai) {
                f32x4 xv[4][2][2];
#pragma unroll
                for (int m = 0; m < 4; ++m)
#pragma unroll
                    for (int bj = 0; bj < 2; ++bj) { const float* s = src0 + (size_t)(ai * 128 + m * 16) * 1024 + col0 + bj * 128; xv[m][bj][0] = *(const f32x4*)s; xv[m][bj][1] = *(const f32x4*)(s + 4); }
#pragma unroll
                for (int m = 0; m < 4; ++m)
#pragma unroll
                    for (int bj = 0; bj < 2; ++bj) { const f32x4 o0 = xv[m][bj][0] + gv[bj][0] * acc[ai][bj][m][0], o1 = xv[m][bj][1] + gv[bj][1] * acc[ai][bj][m][1];
                        u32x4 w; w.x = pk2(o0[0], o0[1]); w.y = pk2(o0[2], o0[3]); w.z = pk2(o1[0], o1[1]); w.w = pk2(o1[2], o1[3]);
                        *(u32x4*)(X + (size_t)(row0 + ai * 128 + m * 16) * 1024 + col0 + bj * 128) = w; }
            }
        } else {
#pragma unroll
            for (int ai = 0; ai < 2; ++ai) {
                u32x4 xw[4][2];
#pragma unroll
                for (int m = 0; m < 4; ++m)
#pragma unroll
                    for (int bj = 0; bj < 2; ++bj) xw[m][bj] = *(const u32x4*)(X + (size_t)(row0 + ai * 128 + m * 16) * 1024 + col0 + bj * 128);
#pragma unroll
                for (int m = 0; m < 4; ++m)
#pragma unroll
                    for (int bj = 0; bj < 2; ++bj) { float xo[8]; unpack8(xw[m][bj], xo); const f32x4 a0 = acc[ai][bj][m][0], a1 = acc[ai][bj][m][1];
                        float o[8] = {xo[0] + gv[bj][0][0] * a0[0], xo[1] + gv[bj][0][1] * a0[1], xo[2] + gv[bj][0][2] * a0[2], xo[3] + gv[bj][0][3] * a0[3],
                                      xo[4] + gv[bj][1][0] * a1[0], xo[5] + gv[bj][1][1] * a1[1], xo[6] + gv[bj][1][2] * a1[2], xo[7] + gv[bj][1][3] * a1[3]};
                        *(u32x4*)(X + (size_t)(row0 + ai * 128 + m * 16) * 1024 + col0 + bj * 128) = pack8(o); }
            }
        }
    }
};
struct EpiMoe1 {
    static constexpr bool PERM = true, AFTER_DRAIN = false, CHAIN = false;
    bf16* ACT;
    __device__ __forceinline__ void operator()(const f32x4 (&acc)[2][2][4][2], const pg8::Unit& u, int wr, int wc, int fr, int fq) const {
        const int row0 = u.pm * 256 + wr * 64 + fr, col0 = (u.pn & 7) * 128 + wc * 32 + 8 * fq;
#pragma unroll
        for (int ai = 0; ai < 2; ++ai)
#pragma unroll
            for (int m = 0; m < 4; ++m) { const size_t r = (size_t)(row0 + ai * 128 + m * 16);
                const f32x4 a0 = acc[ai][0][m][0], a1 = acc[ai][0][m][1], u0 = acc[ai][1][m][0], u1 = acc[ai][1][m][1];
                float o[8];
#pragma unroll
                for (int k = 0; k < 4; ++k) { o[k] = a0[k] * sigmoidf_(a0[k]) * u0[k]; o[4 + k] = a1[k] * sigmoidf_(a1[k]) * u1[k]; }
                *(u32x4*)(ACT + r * 1024 + col0) = pack8(o); }
    }
};
struct EpiMoe2 {
    static constexpr bool PERM = true, AFTER_DRAIN = false, CHAIN = false;
    bf16* Y; const float* topw;
    __device__ __forceinline__ void operator()(const f32x4 (&acc)[2][2][4][2], const pg8::Unit& u, int wr, int wc, int fr, int fq) const {
        const int row0 = u.pm * 256 + wr * 64 + fr, col0 = (u.pn & 3) * 256 + wc * 32 + 8 * fq;
        float twv[2][4];
#pragma unroll
        for (int ai = 0; ai < 2; ++ai)
#pragma unroll
            for (int m = 0; m < 4; ++m) twv[ai][m] = topw[row0 + ai * 128 + m * 16];
#pragma unroll
        for (int ai = 0; ai < 2; ++ai)
#pragma unroll
            for (int m = 0; m < 4; ++m) { const size_t r = (size_t)(row0 + ai * 128 + m * 16); const float tw = twv[ai][m];
#pragma unroll
                for (int bj = 0; bj < 2; ++bj) { const f32x4 v0 = acc[ai][bj][m][0] * tw, v1 = acc[ai][bj][m][1] * tw;
                    u32x4 w; w.x = pk2(v0[0], v0[1]); w.y = pk2(v0[2], v0[3]); w.z = pk2(v1[0], v1[1]); w.w = pk2(v1[2], v1[3]);
                    *(u32x4*)(Y + r * 1024 + col0 + bj * 128) = w; } }
    }
};

__device__ __forceinline__ void tr_item(const float* W, int N, int k0, int n0, bf16* dst, int K, LAS float* scr, int lane) {
#pragma unroll 8
    for (int i = 0; i < 32; ++i) { const int kk = 2 * i + (lane >> 5); scr[kk * 33 + (lane & 31)] = W[(size_t)(k0 + kk) * N + n0 + (lane & 31)]; }
    LDS_WAIT();
    const int cc = lane & 7;
#pragma unroll
    for (int j = 0; j < 4; ++j) { const int n = (lane >> 3) + 8 * j; const LAS float* s = scr + (8 * cc) * 33 + n;
        u32x4 o; o.x = pk2(s[0 * 33], s[1 * 33]); o.y = pk2(s[2 * 33], s[3 * 33]); o.z = pk2(s[4 * 33], s[5 * 33]); o.w = pk2(s[6 * 33], s[7 * 33]);
        *(u32x4*)(dst + (size_t)n * K + 8 * cc) = o; }
    LDS_WAIT();
}
__device__ __forceinline__ void convert_small(KPC p, int l, LAS unsigned char* lds, int lane, int wave, int bid, int G) {
    LAS float* scr = (LAS float*)(lds + wave * 8448);
    const int gw = bid * 8 + wave, NGW = G * 8;
    constexpr int I_IN = 16 * 200, I_BR = 8 * 32, I_OUT = 16 * 32;
    bf16* wtin = (bf16*)(p->ws + WS_WTIN); bf16* wtbr = (bf16*)(p->ws + WS_WTBR); bf16* wtout = (bf16*)(p->ws + WS_WTOUT);
    for (int it = gw; it < I_IN + 3 * I_BR + I_OUT; it += NGW) {
        int r = it;
        if (r < I_IN) { const int kb = r / 200, nb = r % 200; tr_item(p->w_in + (size_t)l * 1024 * 6400, 6400, 64 * kb, 32 * nb, wtin + (size_t)(32 * nb) * 1024 + 64 * kb, 1024, scr, lane); continue; }
        r -= I_IN;
        if (r < 3 * I_BR) { const int br = r / I_BR, q = r % I_BR, kb = q / 32, nb = q % 32;
            tr_item(p->w_branch + ((size_t)l * 3 + br) * 512 * 1024, 1024, 64 * kb, 32 * nb, wtbr + (size_t)(br * 1024 + 32 * nb) * 512 + 64 * kb, 512, scr, lane); continue; }
        r -= 3 * I_BR;
        { const int kb = r / 32, nb = r % 32; tr_item(p->w_out + (size_t)l * 1024 * 1024, 1024, 64 * kb, 32 * nb, wtout + (size_t)(32 * nb) * 1024 + 64 * kb, 1024, scr, lane); }
    }
}
__device__ __forceinline__ void convert_experts(KPC p, int l, int lo, int hi, int widx, int nw, LAS unsigned char* lds, int lane, int wave) {
    LAS float* scr = (LAS float*)(lds + wave * 8448);
    bf16* wt1 = (bf16*)(p->ws + WS_WT1); bf16* wt2 = (bf16*)(p->ws + WS_WT2);
    for (int it = lo + widx; it < hi; it += nw) {
        const int e = it / 1536, q = it % 1536, which = q / 512, qq = q % 512, kb = qq / 32, nb = qq % 32, n0 = 32 * nb, k0 = 64 * kb;
        const size_t woff = ((size_t)l * NE + e) * 1024 * 1024;
        if (which == 0) tr_item(p->w_eg + woff, 1024, k0, n0, wt1 + ((size_t)e * 2048 + (n0 >> 7) * 256 + (n0 & 127)) * 1024 + k0, 1024, scr, lane);
        else if (which == 1) tr_item(p->w_eu + woff, 1024, k0, n0, wt1 + ((size_t)e * 2048 + (n0 >> 7) * 256 + 128 + (n0 & 127)) * 1024 + k0, 1024, scr, lane);
        else tr_item(p->w_ed + woff, 1024, k0, n0, wt2 + ((size_t)e * 1024 + n0) * 1024 + k0, 1024, scr, lane);
    }
}
constexpr int CVT_ITEMS = NE * 3 * 512;
constexpr int CVT_G_IDLE0 = 96, CVT_M_IDLE0 = 32, CVT_O_IDLE0 = 32;
constexpr int CVT_G_HI = 7680, CVT_M_HI = 7680 + 14336;

__device__ __forceinline__ void phase_prep(KPC p, LAS unsigned char* lds, int tid, int lane, int wave, int bid, int G) {
    unsigned char* ws = p->ws;
    {   float* rc = (float*)(ws + WS_ROPEC); float* rsn = (float*)(ws + WS_ROPES);
        for (int i = bid * 512 + tid; i < T * 32; i += G * 512) { const int t = i >> 5, f = i & 31; const int pos = (f < 16) ? (t >> 6) : (t & 63); const int fi = f & 15;
            const float inv = ex2(-(float)fi * (13.287712379549449f / 16.f));
            float ang = (float)pos * inv; ang -= 6.283185307179586f * rintf(ang * 0.15915494309189535f);
            rc[i] = __cosf(ang); rsn[i] = __sinf(ang); } }
    {   LAS float* sv = (LAS float*)lds;
        LAS float* red = (LAS float*)(lds + 36864);
        for (int i = tid; i < 9 * 1024; i += 512) { const int r = i >> 10, k = i & 1023; const float v = (r < 8) ? p->c[r * 1024 + k] : p->c_ctx[k]; sv[i] = v * sigmoidf_(v); }
        __syncthreads();
        for (int it = bid; it < 192; it += G) {
            const int l = it / 96, n0 = (it % 96) * 64;
            const float* W = p->w_mod + (size_t)l * 1024 * 6144 + n0 + lane;
            float acc[9];
#pragma unroll
            for (int r = 0; r < 9; ++r) acc[r] = 0.f;
#pragma unroll 1
            for (int k0 = wave * 128; k0 < wave * 128 + 128; k0 += 16) {
                float wv[16];
#pragma unroll
                for (int kk = 0; kk < 16; ++kk) wv[kk] = W[(size_t)(k0 + kk) * 6144];
#pragma unroll
                for (int kk = 0; kk < 16; ++kk)
#pragma unroll
                    for (int r = 0; r < 9; ++r) acc[r] += sv[r * 1024 + k0 + kk] * wv[kk]; }
#pragma unroll
            for (int r = 0; r < 9; ++r) red[(wave * 9 + r) * 64 + lane] = acc[r];
            __syncthreads();
            for (int i = tid; i < 576; i += 512) { const int r = i >> 6, ln = i & 63; float s = 0.f;
#pragma unroll
                for (int w = 0; w < 8; ++w) s += red[(w * 9 + r) * 64 + ln];
                s += p->b_mod[l * 6144 + n0 + ln]; ((float*)(ws + WS_MODV))[(l * 9 + r) * 6144 + n0 + ln] = s; }
            __syncthreads();
        }
    }
    __syncthreads();
    convert_small(p, 0, lds, lane, wave, bid, G);
}

__device__ __forceinline__ float row_rs(const f32x4 (&v)[4]) {
    float ss = 0.f;
#pragma unroll
    for (int j = 0; j < 4; ++j) ss += (v[j].x * v[j].x + v[j].y * v[j].y) + (v[j].z * v[j].z + v[j].w * v[j].w);
    return 1.0f / sqrtf(wave_sum(ss) * (1.f / 1024.f) + EPS);
}
__device__ __forceinline__ void norm_mod(const f32x4 (&v)[4], float rs, const float* gain, const float* sh, const float* sc, f32x4 (&h)[4], int lane) {
#pragma unroll
    for (int j = 0; j < 4; ++j) { const int col = 4 * lane + 256 * j; const f32x4 g = *(const f32x4*)(gain + col), a = *(const f32x4*)(sc + col), b = *(const f32x4*)(sh + col);
        h[j] = (v[j] * rs) * g * (a + 1.0f) + b; }
}
__device__ __forceinline__ void store_h(const f32x4 (&h)[4], bf16* hrow, int lane) {
#pragma unroll
    for (int j = 0; j < 4; ++j) { u32x2 w; w.x = pk2(h[j].x, h[j].y); w.y = pk2(h[j].z, h[j].w); *(u32x2*)(hrow + 4 * lane + 256 * j) = w; }
}
__device__ __forceinline__ void phase_norm_in(KPC p, int lane, int wave, int bid, int G) {
    const float* modv = (const float*)(p->ws + WS_MODV); bf16* H = (bf16*)(p->ws + WS_H);
    const int stride = G * 8; int r = bid * 8 + wave;
    f32x4 vn[4];
    {   const float* src = (r < ML) ? p->x + (size_t)r * 1024 : p->ctx + (size_t)(r - ML) * 1024;
#pragma unroll
        for (int j = 0; j < 4; ++j) vn[j] = (r < M) ? *(const f32x4*)(src + 4 * lane + 256 * j) : (f32x4){0.f, 0.f, 0.f, 0.f}; }
    for (; r < M; r += stride) {
        const int bi = (r < ML) ? (r >> 12) : 8; const float* mv = modv + bi * 6144;
        f32x4 v[4], h[4], g[4], sc[4], sh[4];
#pragma unroll
        for (int j = 0; j < 4; ++j) { v[j] = vn[j]; const int col = 4 * lane + 256 * j; g[j] = *(const f32x4*)(p->norm1_g + col); sh[j] = *(const f32x4*)(mv + col); sc[j] = *(const f32x4*)(mv + 1024 + col); }
        const int rn = r + stride;
        if (rn < M) { const float* src = (rn < ML) ? p->x + (size_t)rn * 1024 : p->ctx + (size_t)(rn - ML) * 1024;
#pragma unroll
            for (int j = 0; j < 4; ++j) vn[j] = *(const f32x4*)(src + 4 * lane + 256 * j); }
        const float rs = row_rs(v);
#pragma unroll
        for (int j = 0; j < 4; ++j) h[j] = (v[j] * rs) * g[j] * (sc[j] + 1.0f) + sh[j];
        store_h(h, H + (size_t)r * 1024, lane);
    }
}

__device__ __forceinline__ void ld8f(const float* p, float (&f)[8]) { const f32x4 a = *(const f32x4*)p, b = *(const f32x4*)(p + 4); f[0] = a[0]; f[1] = a[1]; f[2] = a[2]; f[3] = a[3]; f[4] = b[0]; f[5] = b[1]; f[6] = b[2]; f[7] = b[3]; }
__device__ __forceinline__ void att_item(KPC p, int l, LAS unsigned char* lds, int item, float Mb2, int tid, int lane, int wave) {
    const bf16* ZA = (const bf16*)(p->ws + WS_ZA); bf16* BR = (bf16*)p->out + (size_t)2 * M * 512;
    const float* rc = (const float*)(p->ws + WS_ROPEC); const float* rsn = (const float*)(p->ws + WS_ROPES);
    const bool isctx = item >= 512;
    int b, kvh, qb;
    if (!isctx) { b = item >> 6; kvh = (item >> 5) & 1; qb = item & 31; } else { const int ci = item - 512; b = ci >> 2; kvh = (ci >> 1) & 1; qb = ci & 1; }
    const int rowbase = isctx ? ML + b * CL : b * T;
    const int g = wave >> 1, qs = wave & 1, hh = kvh * 4 + g, c = lane & 15, g4 = lane >> 4, q0 = qb * 128 + qs * 64;
    const float* qg = p->qn_g + l * 64; const float* kg = p->kn_g + l * 64;
    LAS unsigned char* Kl = lds; LAS unsigned char* Vt = lds + 18432;
    bf16x8 qf[4][2];
    float qga[8], qgb[8]; ld8f(qg + 8 * g4, qga); ld8f(qg + 32 + 8 * g4, qgb);
#pragma unroll
    for (int ti = 0; ti < 4; ++ti) {
        const int pos = q0 + 16 * ti + c; const bf16* src = ZA + (size_t)(rowbase + pos) * NZA + C_AQ + hh * 64 + 8 * g4;
        float a[8], bb[8]; unpack8(*(const u32x4*)src, a); unpack8(*(const u32x4*)(src + 32), bb);
        float ss = 0.f;
#pragma unroll
        for (int j = 0; j < 8; ++j) ss += a[j] * a[j] + bb[j] * bb[j];
        ss = sum_x16_x32(ss);
        const float rs = 1.0f / sqrtf(ss * (1.f / 64.f) + EPS);
#pragma unroll
        for (int j = 0; j < 8; ++j) { a[j] *= rs * qga[j]; bb[j] *= rs * qgb[j]; }
        if (!isctx) { float cs8[8], sn8[8]; ld8f(rc + pos * 32 + 8 * g4, cs8); ld8f(rsn + pos * 32 + 8 * g4, sn8);
#pragma unroll
            for (int j = 0; j < 8; ++j) { const float cs = cs8[j], sn = sn8[j]; const float x1 = a[j], x2 = bb[j]; a[j] = x1 * cs - x2 * sn; bb[j] = x1 * sn + x2 * cs; } }
#pragma unroll
        for (int j = 0; j < 8; ++j) { a[j] *= 0.125f * LOG2E; bb[j] *= 0.125f * LOG2E; }
        qf[ti][0] = as_bf16x8(pack8(a)); qf[ti][1] = as_bf16x8(pack8(bb));
        __builtin_amdgcn_sched_barrier(0);
    }
    f32x4 O[4][4]; float lsum[4];
#pragma unroll
    for (int i = 0; i < 4; ++i) { lsum[i] = 0.f;
#pragma unroll
        for (int j = 0; j < 4; ++j) O[i][j] = (f32x4){0.f, 0.f, 0.f, 0.f}; }
    float kga[8], kgb[8]; ld8f(kg + 8 * (tid & 3), kga); ld8f(kg + 32 + 8 * (tid & 3), kgb);
    const int ntile = isctx ? 2 : 5;
    for (int kt = 0; kt < ntile; ++kt) {
        int krow0, kpos0 = 0, mode = 0; bool local = false;
        if (isctx) krow0 = ML + b * CL + 128 * kt;
        else if (kt < 3) { const int kb = qb - 1 + kt; if (kb < 0 || kb > 31) continue; krow0 = b * T + kb * 128; kpos0 = kb * 128; local = true; mode = (kt == 0) ? 1 : ((kt == 2) ? 2 : 0); }
        else krow0 = ML + b * CL + 128 * (kt - 3);
#ifndef REP_ATT_STAGE
#define REP_ATT_STAGE 1
#endif
        for (int rs_ = 0; rs_ < REP_ATT_STAGE; ++rs_) {
        __syncthreads();
        {
            const int key = tid >> 2, q4 = tid & 3; const bf16* src = ZA + (size_t)(krow0 + key) * NZA + C_AK + kvh * 64 + 8 * q4;
            float a[8], bb[8]; unpack8(*(const u32x4*)src, a); unpack8(*(const u32x4*)(src + 32), bb);
            float ss = 0.f;
#pragma unroll
            for (int j = 0; j < 8; ++j) ss += a[j] * a[j] + bb[j] * bb[j];
            ss = sum_x1_x2(ss);
            const float rs = 1.0f / sqrtf(ss * (1.f / 64.f) + EPS);
#pragma unroll
            for (int j = 0; j < 8; ++j) { a[j] *= rs * kga[j]; bb[j] *= rs * kgb[j]; }
            if (local) { const int pos = kpos0 + key; float cs8[8], sn8[8]; ld8f(rc + pos * 32 + 8 * q4, cs8); ld8f(rsn + pos * 32 + 8 * q4, sn8);
#pragma unroll
                for (int j = 0; j < 8; ++j) { const float cs = cs8[j], sn = sn8[j]; const float x1 = a[j], x2 = bb[j]; a[j] = x1 * cs - x2 * sn; bb[j] = x1 * sn + x2 * cs; } }
            *(LAS u32x4*)(Kl + key * 144 + 16 * q4) = pack8(a); *(LAS u32x4*)(Kl + key * 144 + 64 + 16 * q4) = pack8(bb);
            const bf16* vs = ZA + (size_t)(krow0 + key) * NZA + C_AV + kvh * 64 + 16 * q4;
            const u32x4 v0 = *(const u32x4*)vs, v1 = *(const u32x4*)(vs + 8);
            const unsigned vw[8] = {v0.x, v0.y, v0.z, v0.w, v1.x, v1.y, v1.z, v1.w};
#pragma unroll
            for (int j = 0; j < 8; ++j) { *(LAS unsigned short*)(Vt + (16 * q4 + 2 * j) * 272 + key * 2) = (unsigned short)(vw[j] & 0xffffu); *(LAS unsigned short*)(Vt + (16 * q4 + 2 * j + 1) * 272 + key * 2) = (unsigned short)(vw[j] >> 16); }
        }
        }
        __syncthreads();
#pragma unroll 1
        for (int kk = 0; kk < 4; ++kk) {
            if ((mode == 1 && 32 * kk + 31 < qs * 64) || (mode == 2 && 32 * kk > qs * 64 + 63)) continue;
            bf16x8 ka[2][2];
#pragma unroll
            for (int hf = 0; hf < 2; ++hf)
#pragma unroll
                for (int ks = 0; ks < 2; ++ks) ka[hf][ks] = *(const LAS bf16x8*)(Kl + (32 * kk + 16 * hf + c) * 144 + ks * 64 + g4 * 16);
            bf16x8 pf[4];
#pragma unroll
            for (int ti = 0; ti < 4; ++ti) {
                f32x4 sa = (f32x4){-Mb2, -Mb2, -Mb2, -Mb2}, sb = sa;
                sa = mfma16(ka[0][0], qf[ti][0], sa); sa = mfma16(ka[0][1], qf[ti][1], sa);
                sb = mfma16(ka[1][0], qf[ti][0], sb); sb = mfma16(ka[1][1], qf[ti][1], sb);
                float pa[4], pb[4];
#pragma unroll
                for (int rr = 0; rr < 4; ++rr) { pa[rr] = ex2(sa[rr]); pb[rr] = ex2(sb[rr]); }
                if (mode != 0) {
                    const int ii = qs * 64 + 16 * ti + c; const int mlo = (mode == 1) ? ii : -1000, mhi = (mode == 2) ? ii : 1000;
#pragma unroll
                    for (int rr = 0; rr < 4; ++rr) { const int ja = 32 * kk + 4 * g4 + rr, jb = ja + 16;
                        pa[rr] = (ja >= mlo && ja <= mhi) ? pa[rr] : 0.f; pb[rr] = (jb >= mlo && jb <= mhi) ? pb[rr] : 0.f; } }
                lsum[ti] += ((pa[0] + pa[1]) + (pa[2] + pa[3])) + ((pb[0] + pb[1]) + (pb[2] + pb[3]));
                u32x4 w; w.x = pk2(pa[0], pa[1]); w.y = pk2(pa[2], pa[3]); w.z = pk2(pb[0], pb[1]); w.w = pk2(pb[2], pb[3]); pf[ti] = as_bf16x8(w);
            }
#pragma unroll
            for (int dt = 0; dt < 4; ++dt) {
                const u32x2 v0 = *(const LAS u32x2*)(Vt + (16 * dt + c) * 272 + (32 * kk + 4 * g4) * 2), v1 = *(const LAS u32x2*)(Vt + (16 * dt + c) * 272 + (32 * kk + 16 + 4 * g4) * 2);
                u32x4 vv; vv.x = v0.x; vv.y = v0.y; vv.z = v1.x; vv.w = v1.y; const bf16x8 va = as_bf16x8(vv);
#pragma unroll
                for (int ti = 0; ti < 4; ++ti) O[dt][ti] = mfma16(va, pf[ti], O[dt][ti]);
            }
        }
    }
    const float sk = ex2(p->sink[l * 8 + hh] * LOG2E - Mb2);
#pragma unroll
    for (int ti = 0; ti < 4; ++ti) { float lt = sum_x16_x32(lsum[ti]); const float inv = 1.0f / (lt + sk);
        bf16* dst = BR + (size_t)(rowbase + q0 + 16 * ti + c) * 512 + hh * 64 + 4 * g4;
#pragma unroll
        for (int dt = 0; dt < 4; ++dt) { const f32x4 o = O[dt][ti] * inv; u32x2 w; w.x = pk2(o[0], o[1]); w.y = pk2(o[2], o[3]); *(u32x2*)(dst + 16 * dt) = w; } }
    __syncthreads();
}

__device__ __forceinline__ void sgu_vprep_item(KPC p, int ch, int tid) {
    bf16* ZA = (bf16*)(p->ws + WS_ZA);
    const int seg = tid & 15;
    bf16* rowp0 = ZA + (size_t)(ch * 128 + (tid >> 4)) * NZA + C_SV + 32 * seg;
    u32x4 raw[4][4];
#pragma unroll
    for (int ps = 0; ps < 4; ++ps)
#pragma unroll
        for (int q = 0; q < 4; ++q) raw[ps][q] = *(const u32x4*)(rowp0 + (size_t)ps * 32 * NZA + 8 * q);
#pragma unroll
    for (int ps = 0; ps < 4; ++ps) {
        bf16* rowp = rowp0 + (size_t)ps * 32 * NZA;
        float f[4][8]; float s = 0.f, ss = 0.f;
#pragma unroll
        for (int q = 0; q < 4; ++q) unpack8(raw[ps][q], f[q]);
#pragma unroll
        for (int q = 0; q < 4; ++q)
#pragma unroll
            for (int e = 0; e < 8; ++e) { const float y = gelu_tanh(f[q][e]); f[q][e] = y; s += y; ss += y * y; }
        s += swz_xor<1>(s); s += swz_xor<2>(s); s += swz_xor<4>(s); s += swz_xor<8>(s);
        ss += swz_xor<1>(ss); ss += swz_xor<2>(ss); ss += swz_xor<4>(ss); ss += swz_xor<8>(ss);
        const float mean = s * (1.f / 512.f), var = fmaxf(ss * (1.f / 512.f) - mean * mean, 0.f), rstd = 1.0f / sqrtf(var + EPS);
#pragma unroll
        for (int q = 0; q < 4; ++q) {
#pragma unroll
            for (int e = 0; e < 8; ++e) f[q][e] = (f[q][e] - mean) * rstd;
            *(u32x4*)(rowp + 8 * q) = pack8(f[q]); }
    }
}
__device__ __forceinline__ void sgu_item(KPC p, int l, LAS unsigned char* lds, int item, int tid, int lane, int wave) {
    const bf16* ZA = (const bf16*)(p->ws + WS_ZA); bf16* BR = (bf16*)p->out + (size_t)1 * M * 512;
    const int ch = item >> 2, g = item & 3, r0 = ch * 128, c = lane & 15, g4 = lane >> 4;
    LAS unsigned char* vT = lds;
    LAS unsigned char* WL = lds + 34816;
    {   const int j = tid >> 2, q4 = tid & 3; const bf16* src = ZA + (size_t)(r0 + j) * NZA + C_SV + 128 * g + 32 * q4;
#pragma unroll
        for (int q = 0; q < 4; ++q) { const u32x4 v = *(const u32x4*)(src + 8 * q); const unsigned vw[4] = {v.x, v.y, v.z, v.w};
#pragma unroll
            for (int e = 0; e < 4; ++e) { *(LAS unsigned short*)(vT + (32 * q4 + 8 * q + 2 * e) * 272 + j * 2) = (unsigned short)(vw[e] & 0xffffu); *(LAS unsigned short*)(vT + (32 * q4 + 8 * q + 2 * e + 1) * 272 + j * 2) = (unsigned short)(vw[e] >> 16); } }
        const float* wsrc = p->sgu_w + ((size_t)(l * 4 + g) * 128 + (tid >> 2)) * 128 + 32 * (tid & 3);
#pragma unroll
        for (int q = 0; q < 4; ++q) { const f32x4 a = *(const f32x4*)(wsrc + 8 * q), bq = *(const f32x4*)(wsrc + 8 * q + 4);
            u32x4 w; w.x = pk2(a.x, a.y); w.y = pk2(a.z, a.w); w.z = pk2(bq.x, bq.y); w.w = pk2(bq.z, bq.w);
            *(LAS u32x4*)(WL + (tid >> 2) * 272 + (32 * (tid & 3) + 8 * q) * 2) = w; }
    }
    __syncthreads();
    bf16x8 af[4];
#pragma unroll
    for (int ks = 0; ks < 4; ++ks) af[ks] = *(const LAS bf16x8*)(vT + (16 * wave + c) * 272 + (32 * ks + 8 * g4) * 2);
    const int col = 128 * g + 16 * wave + 4 * g4;
    u32x2 uw[8]; float bias[8];
#pragma unroll
    for (int ti = 0; ti < 8; ++ti) { uw[ti] = *(const u32x2*)(ZA + (size_t)(r0 + 16 * ti + c) * NZA + C_SU + col); bias[ti] = p->sgu_b[(l * 4 + g) * 128 + 16 * ti + c]; }
#pragma unroll
    for (int ti = 0; ti < 8; ++ti) {
        f32x4 acc = (f32x4){0.f, 0.f, 0.f, 0.f};
#pragma unroll
        for (int ks = 0; ks < 4; ++ks) acc = mfma16(af[ks], *(const LAS bf16x8*)(WL + (16 * ti + c) * 272 + (32 * ks + 8 * g4) * 2), acc);
        const float o0 = gelu_tanh(bflo(uw[ti].x)) * (acc[0] + bias[ti]), o1 = gelu_tanh(bfhi(uw[ti].x)) * (acc[1] + bias[ti]), o2 = gelu_tanh(bflo(uw[ti].y)) * (acc[2] + bias[ti]), o3 = gelu_tanh(bfhi(uw[ti].y)) * (acc[3] + bias[ti]);
        u32x2 w; w.x = pk2(o0, o1); w.y = pk2(o2, o3); *(u32x2*)(BR + (size_t)(r0 + 16 * ti + c) * 512 + col) = w;
    }
    __syncthreads();
}

__device__ __forceinline__ void ret_load_k(KPC p, const bf16* ZA, int r0, int h, bool latent, int pos0, int tid, float (&a)[8], float (&bb)[8]) {
    const int j = tid >> 2, q4 = tid & 3; const bf16* src = ZA + (size_t)(r0 + j) * NZA + C_RK + 64 * h + 8 * q4;
    unpack8(*(const u32x4*)src, a); unpack8(*(const u32x4*)(src + 32), bb);
    if (latent) { const float* rc = (const float*)(p->ws + WS_ROPEC); const float* rsn = (const float*)(p->ws + WS_ROPES); const int pos = pos0 + j; float cs8[8], sn8[8]; ld8f(rc + pos * 32 + 8 * q4, cs8); ld8f(rsn + pos * 32 + 8 * q4, sn8);
#pragma unroll
        for (int e = 0; e < 8; ++e) { const float cs = cs8[e], sn = sn8[e]; const float x1 = a[e], x2 = bb[e]; a[e] = x1 * cs - x2 * sn; bb[e] = x1 * sn + x2 * cs; } }
#pragma unroll
    for (int e = 0; e < 8; ++e) { a[e] *= 0.125f; bb[e] *= 0.125f; }
}
__device__ __forceinline__ void ret_stage_vT(const bf16* ZA, int r0, int h, LAS unsigned char* vT, int tid) {
    const int j = tid >> 2, q4 = tid & 3; const bf16* src = ZA + (size_t)(r0 + j) * NZA + C_RV + 128 * h + 32 * q4;
#pragma unroll
    for (int q = 0; q < 4; ++q) { const u32x4 v = *(const u32x4*)(src + 8 * q); const unsigned vw[4] = {v.x, v.y, v.z, v.w};
#pragma unroll
        for (int e = 0; e < 4; ++e) { *(LAS unsigned short*)(vT + (32 * q4 + 8 * q + 2 * e) * 272 + j * 2) = (unsigned short)(vw[e] & 0xffffu); *(LAS unsigned short*)(vT + (32 * q4 + 8 * q + 2 * e + 1) * 272 + j * 2) = (unsigned short)(vw[e] >> 16); } }
}
__device__ __forceinline__ void ret_upd_item(KPC p, int l, LAS unsigned char* lds, int item, int tid, int lane, int wave) {
    const bf16* ZA = (const bf16*)(p->ws + WS_ZA); float* RS = (float*)(p->ws + WS_RS);
    const int b = item / (NCH * 4), rem = item % (NCH * 4), n = rem >> 2, h = rem & 3, c = lane & 15, g4 = lane >> 4;
    const bool latent = n < 32; const int r0 = latent ? b * T + 128 * n : ML + b * CL + 128 * (n - 32);
    const float lgf = log2_sigmoid(p->dec_f[l * 4 + h]), lgb = log2_sigmoid(p->dec_b[l * 4 + h]);
    LAS unsigned char* vT = lds; LAS unsigned char* kTf = lds + 34816; LAS unsigned char* kTb = lds + 34816 + 17408;
    {   float a[8], bb[8]; ret_load_k(p, ZA, r0, h, latent, 128 * n, tid, a, bb);
        const int j = tid >> 2, q4 = tid & 3; const float wf = ex2((float)(127 - j) * lgf), wb = ex2((float)j * lgb);
#pragma unroll
        for (int e = 0; e < 8; e += 2) {
            unsigned w = pk2(a[e] * wf, a[e + 1] * wf); *(LAS unsigned short*)(kTf + (8 * q4 + e) * 272 + j * 2) = (unsigned short)(w & 0xffffu); *(LAS unsigned short*)(kTf + (8 * q4 + e + 1) * 272 + j * 2) = (unsigned short)(w >> 16);
            w = pk2(bb[e] * wf, bb[e + 1] * wf); *(LAS unsigned short*)(kTf + (32 + 8 * q4 + e) * 272 + j * 2) = (unsigned short)(w & 0xffffu); *(LAS unsigned short*)(kTf + (32 + 8 * q4 + e + 1) * 272 + j * 2) = (unsigned short)(w >> 16);
            w = pk2(a[e] * wb, a[e + 1] * wb); *(LAS unsigned short*)(kTb + (8 * q4 + e) * 272 + j * 2) = (unsigned short)(w & 0xffffu); *(LAS unsigned short*)(kTb + (8 * q4 + e + 1) * 272 + j * 2) = (unsigned short)(w >> 16);
            w = pk2(bb[e] * wb, bb[e + 1] * wb); *(LAS unsigned short*)(kTb + (32 + 8 * q4 + e) * 272 + j * 2) = (unsigned short)(w & 0xffffu); *(LAS unsigned short*)(kTb + (32 + 8 * q4 + e + 1) * 272 + j * 2) = (unsigned short)(w >> 16);
        }
        ret_stage_vT(ZA, r0, h, vT, tid);
    }
    __syncthreads();
    bf16x8 af[4];
#pragma unroll
    for (int ks = 0; ks < 4; ++ks) af[ks] = *(const LAS bf16x8*)(vT + (16 * wave + c) * 272 + (32 * ks + 8 * g4) * 2);
#pragma unroll
    for (int dir = 0; dir < 2; ++dir) { const LAS unsigned char* kT = dir ? kTb : kTf;
        float* dst = RS + ((size_t)(((b * 4 + h) * 2 + dir) * NCH + n) * 128 + 16 * wave + 4 * g4) * 64;
#pragma unroll
        for (int dt = 0; dt < 4; ++dt) { f32x4 acc = (f32x4){0.f, 0.f, 0.f, 0.f};
#pragma unroll
            for (int ks = 0; ks < 4; ++ks) acc = mfma16(af[ks], *(const LAS bf16x8*)(kT + (16 * dt + c) * 272 + (32 * ks + 8 * g4) * 2), acc);
#pragma unroll
            for (int rr = 0; rr < 4; ++rr) dst[rr * 64 + 16 * dt + c] = acc[rr]; } }
    __syncthreads();
}
__device__ __forceinline__ void phase_scan(KPC p, int l, int tid, int bid, int G) {
    const float* __restrict__ RS = (const float*)(p->ws + WS_RS); bf16* __restrict__ ST = (bf16*)(p->ws + WS_ST);
    for (int idx = bid * 512 + tid; idx < NB * 4 * 2 * 8192; idx += G * 512) {
        const int ed = idx & 8191, dir = (idx >> 13) & 1, bh = idx >> 14, e = ed >> 6, d = ed & 63, h = bh & 3;
        const float* P = RS + (size_t)((bh * 2 + dir) * NCH) * 8192 + ed;
        bf16* S = ST + ((size_t)bh * NCH * 128 + e) * 128 + dir * 64 + d;
        const float lg = log2_sigmoid(dir ? p->dec_b[l * 4 + h] : p->dec_f[l * 4 + h]); const float dec = ex2(128.f * lg);
        float u[NCH];
#pragma unroll
        for (int n = 0; n < NCH; ++n) u[n] = P[(size_t)n * 8192];
        if (dir == 0) {
            S[32 * 16384] = 0; S[33 * 16384] = (bf16)(pk2(u[32], 0.f) & 0xffffu);
            float s = dec * u[32] + u[33];
#pragma unroll
            for (int n = 0; n < 32; ++n) { S[(size_t)n * 16384] = (bf16)(pk2(s, 0.f) & 0xffffu); s = dec * s + u[n]; }
        } else {
            S[33 * 16384] = 0; S[32 * 16384] = (bf16)(pk2(u[33], 0.f) & 0xffffu);
            float s = dec * u[33] + u[32];
#pragma unroll
            for (int n = 31; n >= 0; --n) { S[(size_t)n * 16384] = (bf16)(pk2(s, 0.f) & 0xffffu); s = dec * s + u[n]; }
        }
    }
}
__device__ __forceinline__ void ret_out_item(KPC p, int l, LAS unsigned char* lds, int item, int tid, int lane, int wave) {
    const bf16* ZA = (const bf16*)(p->ws + WS_ZA); bf16* BR = (bf16*)p->out; const bf16* ST = (const bf16*)(p->ws + WS_ST);
    const int b = item / (NCH * 4), rem = item % (NCH * 4), n = rem >> 2, h = rem & 3, c = lane & 15, g4 = lane >> 4;
    const bool latent = n < 32; const int r0 = latent ? b * T + 128 * n : ML + b * CL + 128 * (n - 32);
    const float lgf = log2_sigmoid(p->dec_f[l * 4 + h]), lgb = log2_sigmoid(p->dec_b[l * 4 + h]);
    LAS unsigned char* vT = lds; LAS unsigned char* Kl = lds + 34816; LAS unsigned char* Sl = lds + 34816 + 18432;
    {   float a[8], bb[8]; ret_load_k(p, ZA, r0, h, latent, 128 * n, tid, a, bb);
        const int j = tid >> 2, q4 = tid & 3;
        *(LAS u32x4*)(Kl + j * 144 + 16 * q4) = pack8(a); *(LAS u32x4*)(Kl + j * 144 + 64 + 16 * q4) = pack8(bb);
        ret_stage_vT(ZA, r0, h, vT, tid);
        const u32x4* ssrc = (const u32x4*)(ST + (size_t)((b * 4 + h) * NCH + n) * 16384);
#pragma unroll
        for (int k = 0; k < 4; ++k) { const int q = tid + 512 * k; *(LAS u32x4*)(Sl + (q >> 4) * 272 + (q & 15) * 16) = ssrc[q]; }
    }
    __syncthreads();
    const int ii = 16 * wave + c;
    bf16x8 qf[2];
    {   const bf16* src = ZA + (size_t)(r0 + ii) * NZA + C_RQ + 64 * h + 8 * g4; float a[8], bb[8]; unpack8(*(const u32x4*)src, a); unpack8(*(const u32x4*)(src + 32), bb);
        if (latent) { const float* rc = (const float*)(p->ws + WS_ROPEC); const float* rsn = (const float*)(p->ws + WS_ROPES); const int pos = 128 * n + ii; float cs8[8], sn8[8]; ld8f(rc + pos * 32 + 8 * g4, cs8); ld8f(rsn + pos * 32 + 8 * g4, sn8);
#pragma unroll
            for (int e = 0; e < 8; ++e) { const float cs = cs8[e], sn = sn8[e]; const float x1 = a[e], x2 = bb[e]; a[e] = x1 * cs - x2 * sn; bb[e] = x1 * sn + x2 * cs; } }
        qf[0] = as_bf16x8(pack8(a)); qf[1] = as_bf16x8(pack8(bb)); }
    bf16x8 pf[4];
#pragma unroll
    for (int kk = 0; kk < 4; ++kk) {
        f32x4 sa = (f32x4){0.f, 0.f, 0.f, 0.f}, sb = (f32x4){0.f, 0.f, 0.f, 0.f};
        sa = mfma16(*(const LAS bf16x8*)(Kl + (32 * kk + c) * 144 + g4 * 16), qf[0], sa); sa = mfma16(*(const LAS bf16x8*)(Kl + (32 * kk + c) * 144 + 64 + g4 * 16), qf[1], sa);
        sb = mfma16(*(const LAS bf16x8*)(Kl + (32 * kk + 16 + c) * 144 + g4 * 16), qf[0], sb); sb = mfma16(*(const LAS bf16x8*)(Kl + (32 * kk + 16 + c) * 144 + 64 + g4 * 16), qf[1], sb);
        float pa[4], pb[4];
#pragma unroll
        for (int rr = 0; rr < 4; ++rr) { const int ja = 32 * kk + 4 * g4 + rr, jb = ja + 16; const int da = ii - ja, db = ii - jb;
            pa[rr] = sa[rr] * ((da >= 0) ? ex2((float)da * lgf) : ex2((float)(-da) * lgb)); pb[rr] = sb[rr] * ((db >= 0) ? ex2((float)db * lgf) : ex2((float)(-db) * lgb)); }
        u32x4 w; w.x = pk2(pa[0], pa[1]); w.y = pk2(pa[2], pa[3]); w.z = pk2(pb[0], pb[1]); w.w = pk2(pb[2], pb[3]); pf[kk] = as_bf16x8(w);
    }
    const float cf = ex2((float)(ii + 1) * lgf), cb = ex2((float)(128 - ii) * lgb);
    f32x4 O[8]; float s = 0.f, ss = 0.f;
#pragma unroll
    for (int et = 0; et < 8; ++et) {
        f32x4 acc = (f32x4){0.f, 0.f, 0.f, 0.f}, xf = (f32x4){0.f, 0.f, 0.f, 0.f}, xb = (f32x4){0.f, 0.f, 0.f, 0.f};
#pragma unroll
        for (int kk = 0; kk < 4; ++kk) { const u32x2 v0 = *(const LAS u32x2*)(vT + (16 * et + c) * 272 + (32 * kk + 4 * g4) * 2), v1 = *(const LAS u32x2*)(vT + (16 * et + c) * 272 + (32 * kk + 16 + 4 * g4) * 2);
            u32x4 vv; vv.x = v0.x; vv.y = v0.y; vv.z = v1.x; vv.w = v1.y; acc = mfma16(as_bf16x8(vv), pf[kk], acc); }
#pragma unroll
        for (int ks = 0; ks < 2; ++ks) { xf = mfma16(*(const LAS bf16x8*)(Sl + (16 * et + c) * 272 + (32 * ks + 8 * g4) * 2), qf[ks], xf);
            xb = mfma16(*(const LAS bf16x8*)(Sl + (16 * et + c) * 272 + (64 + 32 * ks + 8 * g4) * 2), qf[ks], xb); }
        acc = acc + xf * cf + xb * cb; O[et] = acc;
        s += (acc[0] + acc[1]) + (acc[2] + acc[3]); ss += (acc[0] * acc[0] + acc[1] * acc[1]) + (acc[2] * acc[2] + acc[3] * acc[3]);
    }
    s = sum_x16_x32(s); ss = sum_x16_x32(ss);
    const float mean = s * (1.f / 128.f), var = fmaxf(ss * (1.f / 128.f) - mean * mean, 0.f), rstd = 1.0f / sqrtf(var + EPS);
    const bf16* gsrc = ZA + (size_t)(r0 + ii) * NZA + C_RG + 128 * h + 4 * g4; bf16* dst = BR + (size_t)(r0 + ii) * 512 + 128 * h + 4 * g4;
#pragma unroll
    for (int et = 0; et < 8; ++et) { const u32x2 gw = *(const u32x2*)(gsrc + 16 * et); const float g0 = bflo(gw.x), g1 = bfhi(gw.x), g2 = bflo(gw.y), g3 = bfhi(gw.y);
        const float o0 = (O[et][0] - mean) * rstd * g0 * sigmoidf_(g0), o1 = (O[et][1] - mean) * rstd * g1 * sigmoidf_(g1), o2 = (O[et][2] - mean) * rstd * g2 * sigmoidf_(g2), o3 = (O[et][3] - mean) * rstd * g3 * sigmoidf_(g3);
        u32x2 w; w.x = pk2(o0, o1); w.y = pk2(o2, o3); *(u32x2*)(dst + 16 * et) = w; }
    __syncthreads();
}

#ifndef REP_CVT
#define REP_CVT 1
#endif
#ifndef REP_N2R
#define REP_N2R 1
#endif
#ifndef REP_TK
#define REP_TK 1
#endif
__device__ __forceinline__ int wr_off(int k) { return k * 64 + (k >> 2) * 16; }
__device__ __forceinline__ void phase_norm2(KPC p, int l, LAS unsigned char* lds, int tid, int lane, int wave, int bid, int G) {
    if (l == 1 || G != 256) { for (int rep = 0; rep < REP_CVT; ++rep) convert_experts(p, l, 0, CVT_ITEMS, bid * 8 + wave, G * 8, lds, lane, wave); __syncthreads(); }
    LAS unsigned char* wrl = lds + 69632;
    for (int i = tid; i < 1024 * 4; i += 512) { const int k = i >> 2, q = i & 3; *(LAS f32x4*)(wrl + wr_off(k) + 16 * q) = *(const f32x4*)(p->w_router + (size_t)l * 16384 + k * 16 + 4 * q); }
    __syncthreads();
    const float* modv = (const float*)(p->ws + WS_MODV) + l * 9 * 6144; const bf16* X = (const bf16*)(p->ws + WS_X); bf16* H = (bf16*)(p->ws + WS_H);
    float* AFF = (float*)(p->ws + WS_AFF); float* AFFC = (float*)(p->ws + WS_AFFC); int* INV = (int*)(p->ws + WS_INV);
    const int rows = (l == 0) ? M : ML, stride = G * 8;
    for (int rep = 0; rep < REP_N2R; ++rep) {
    int r = bid * 8 + wave;
    u32x2 vn[4];
#pragma unroll
    for (int j = 0; j < 4; ++j) vn[j] = (r < rows) ? *(const u32x2*)(X + (size_t)r * 1024 + 4 * lane + 256 * j) : (u32x2){0u, 0u};
    for (; r < rows; r += stride) {
        const int bi = (r < ML) ? (r >> 12) : 8; const float* mv = modv + bi * 6144;
        f32x4 v[4], h[4], g[4], sc[4], sh[4];
#pragma unroll
        for (int j = 0; j < 4; ++j) { v[j] = (f32x4){bflo(vn[j].x), bfhi(vn[j].x), bflo(vn[j].y), bfhi(vn[j].y)}; const int col = 4 * lane + 256 * j; g[j] = *(const f32x4*)(p->norm2_g + l * 1024 + col); sh[j] = *(const f32x4*)(mv + 3 * 1024 + col); sc[j] = *(const f32x4*)(mv + 4 * 1024 + col); }
        const int rn = r + stride;
        if (rn < rows) {
#pragma unroll
            for (int j = 0; j < 4; ++j) vn[j] = *(const u32x2*)(X + (size_t)rn * 1024 + 4 * lane + 256 * j); }
        const float rs = row_rs(v);
#pragma unroll
        for (int j = 0; j < 4; ++j) h[j] = (v[j] * rs) * g[j] * (sc[j] + 1.0f) + sh[j];
        store_h(h, H + (size_t)r * 1024, lane);
        float lg[16];
#pragma unroll
        for (int e = 0; e < 16; ++e) lg[e] = 0.f;
#pragma unroll
        for (int j = 0; j < 4; ++j)
#pragma unroll
            for (int i = 0; i < 4; ++i) { const int k = 4 * lane + 256 * j + i; const float hv = h[j][i]; const LAS f32x4* wp = (const LAS f32x4*)(wrl + wr_off(k));
#pragma unroll
                for (int q = 0; q < 4; ++q) { const f32x4 w = wp[q]; lg[4 * q] += hv * w.x; lg[4 * q + 1] += hv * w.y; lg[4 * q + 2] += hv * w.z; lg[4 * q + 3] += hv * w.w; } }
        float mx = -1e30f;
#pragma unroll
        for (int e = 0; e < 16; ++e) { lg[e] = wave_sum(lg[e]); mx = fmaxf(mx, lg[e]); }
        float sum = 0.f;
#pragma unroll
        for (int e = 0; e < 16; ++e) { lg[e] = ex2((lg[e] - mx) * LOG2E); sum += lg[e]; }
        const float isum = 1.0f / sum; float mine = 0.f;
#pragma unroll
        for (int e = 0; e < 16; ++e) mine = (lane == e) ? lg[e] * isum : mine;
        if (lane < 16) { if (r < ML) AFF[((size_t)(bi * 16 + lane) << 12) + (r & 4095)] = mine; else AFFC[((r - ML) >> 8) * 4096 + lane * 256 + ((r - ML) & 255)] = mine;
            INV[(size_t)r * 16 + lane] = -1; }
    }
    }
}

__device__ __forceinline__ int block_sum_i(int v, LAS int* red, int buf, int lane, int wave) {
    v = wave_sum_i(v);
    if (lane == 0) red[buf * 8 + wave] = v;
    __syncthreads();
    int s = 0;
#pragma unroll
    for (int w = 0; w < 8; ++w) s += red[buf * 8 + w];
    return s;
}
__device__ __forceinline__ int block_excl_scan(int v, LAS int* red, int buf, int lane, int wave) {
    int inc = v;
#pragma unroll
    for (int o = 1; o < 64; o <<= 1) { const int t = __builtin_amdgcn_ds_bpermute((lane - o) << 2, inc); if (lane >= o) inc += t; }
    if (lane == 63) red[buf * 8 + wave] = inc;
    __syncthreads();
    int base = 0;
#pragma unroll
    for (int w = 0; w < 8; ++w) { const int x = red[buf * 8 + w]; if (w < wave) base += x; }
    return base + inc - v;
}
template <int KPT>
__device__ __forceinline__ void topk_item(KPC p, const float* aff, int n, int cap, int rowbase, int e, int slotbase, int s_lo, int s_hi, bool writer, LAS unsigned char* lds, int tid, int lane, int wave) {
    const bf16* H = (const bf16*)(p->ws + WS_H); bf16* XS = (bf16*)(p->ws + WS_XS); float* topw = (float*)(p->ws + WS_TOPW); int* INV = (int*)(p->ws + WS_INV);
    LAS int* red = (LAS int*)lds; LAS int* rl = (LAS int*)(lds + 128);
    unsigned key[KPT]; const bool valid = tid * KPT < n;
#pragma unroll
    for (int j = 0; j < KPT; ++j) key[j] = valid ? __float_as_uint(aff[tid * KPT + j]) : 0u;
    unsigned Tsel = 0u;
    for (int bit = 30; bit >= 0; --bit) { const unsigned cand = Tsel | (1u << bit); int cnt = 0;
#pragma unroll
        for (int j = 0; j < KPT; ++j) cnt += (valid && key[j] >= cand) ? 1 : 0;
        if (block_sum_i(cnt, red, bit & 1, lane, wave) >= cap) Tsel = cand; }
    int cgt = 0, ceq = 0;
#pragma unroll
    for (int j = 0; j < KPT; ++j) { cgt += (valid && key[j] > Tsel) ? 1 : 0; ceq += (valid && key[j] == Tsel) ? 1 : 0; }
    const int need = cap - block_sum_i(cgt, red, 1, lane, wave);
    int er = block_excl_scan(ceq, red, 2, lane, wave);
    bool sel[KPT]; int nsel = 0;
#pragma unroll
    for (int j = 0; j < KPT; ++j) { const bool iseq = valid && key[j] == Tsel; sel[j] = valid && (key[j] > Tsel || (iseq && er < need)); er += iseq ? 1 : 0; nsel += sel[j] ? 1 : 0; }
    int slot = block_excl_scan(nsel, red, 3, lane, wave);
#pragma unroll
    for (int j = 0; j < KPT; ++j) if (sel[j]) { const int t = tid * KPT + j; if (slot < cap) { rl[slot] = t; if (writer) { topw[e * ME + slotbase + slot] = __uint_as_float(key[j]); INV[(size_t)(rowbase + t) * 16 + e] = slotbase + slot; } } ++slot; }
    __syncthreads();
    for (int s = s_lo + wave * 4; s < s_hi; s += 32) {
        u32x4 a[4][2];
#pragma unroll
        for (int q = 0; q < 4; ++q) { const int t = rl[s + q]; const u32x4* src = (const u32x4*)(H + (size_t)(rowbase + t) * 1024); a[q][0] = src[lane]; a[q][1] = src[lane + 64]; }
#pragma unroll
        for (int q = 0; q < 4; ++q) { u32x4* dst = (u32x4*)(XS + ((size_t)e * ME + slotbase + s + q) * 1024); dst[lane] = a[q][0]; dst[lane + 64] = a[q][1]; }
    }
    __syncthreads();
}
__device__ __forceinline__ void phase_topk(KPC p, int l, LAS unsigned char* lds, int tid, int lane, int wave, int bid, int G) {
    const float* AFF = (const float*)(p->ws + WS_AFF); const float* AFFC = (const float*)(p->ws + WS_AFFC);
    const int nitem = (l == 0) ? 384 : 256;
    for (int it = bid; it < nitem; it += G) {
        if (it < 256) { const int q = it >> 1, hf = it & 1, b = q >> 4, e = q & 15; topk_item<8>(p, AFF + ((size_t)(b * 16 + e) << 12), 4096, CAPL, b * T, e, b * CAPL, hf * 256, hf * 256 + 256, hf == 0, lds, tid, lane, wave); }
        else { const int q = it - 256, b = q >> 4, e = q & 15; topk_item<1>(p, AFFC + (b * 16 + e) * 256, 256, CAPC, ML + b * CL, e, NB * CAPL + b * CAPC, 0, CAPC, true, lds, tid, lane, wave); }
    }
}

__device__ __forceinline__ void phase_combine(KPC p, int l, LAS unsigned char* lds, int tid, int lane, int wave, int bid, int G) {
    const float* modv = (const float*)(p->ws + WS_MODV); bf16* X = (bf16*)(p->ws + WS_X); bf16* H = (bf16*)(p->ws + WS_H);
    const bf16* Y = (const bf16*)(p->ws + WS_XS); const int* INV = (const int*)(p->ws + WS_INV);
    const int rows = (l == 0) ? M : ML, stride = G * 8;
    int r = bid * 8 + wave;
    int slot_next = (lane < 16 && r < rows) ? INV[(size_t)r * 16 + lane] : -1;
    u32x2 vn[4];
#pragma unroll
    for (int j = 0; j < 4; ++j) vn[j] = (r < rows) ? *(const u32x2*)(X + (size_t)r * 1024 + 4 * lane + 256 * j) : (u32x2){0u, 0u};
    for (; r < rows; r += stride) {
        const int bi = (r < ML) ? (r >> 12) : 8;
        const int myslot = slot_next; const int rn = r + stride;
        slot_next = (lane < 16 && rn < rows) ? INV[(size_t)rn * 16 + lane] : -1;
        f32x4 v[4], acc[4], g2v[4];
        const float* g2 = modv + (l * 9 + bi) * 6144 + 5 * 1024;
#pragma unroll
        for (int j = 0; j < 4; ++j) { v[j] = (f32x4){bflo(vn[j].x), bfhi(vn[j].x), bflo(vn[j].y), bfhi(vn[j].y)}; acc[j] = (f32x4){0.f, 0.f, 0.f, 0.f}; g2v[j] = *(const f32x4*)(g2 + 4 * lane + 256 * j); }
        unsigned mask = (unsigned)(__builtin_amdgcn_ballot_w64(myslot >= 0) & 0xffffull);
        bool first = true;
        while (mask || first) {
          if (mask) {
            const int e0 = __builtin_ctz(mask); mask &= mask - 1u; const int s0 = __builtin_amdgcn_readlane(myslot, e0);
            const bool has1 = mask != 0u; const int e1 = has1 ? __builtin_ctz(mask) : e0; if (has1) mask &= mask - 1u; const int s1 = __builtin_amdgcn_readlane(myslot, e1);
            const bf16* ya = Y + ((size_t)e0 * ME + s0) * 1024; const bf16* yb = Y + ((size_t)e1 * ME + s1) * 1024;
            u32x2 wa[4], wb[4];
#pragma unroll
            for (int j = 0; j < 4; ++j) wa[j] = *(const u32x2*)(ya + 4 * lane + 256 * j);
#pragma unroll
            for (int j = 0; j < 4; ++j) wb[j] = *(const u32x2*)(yb + 4 * lane + 256 * j);
            if (first && rn < rows) {
#pragma unroll
                for (int j = 0; j < 4; ++j) vn[j] = *(const u32x2*)(X + (size_t)rn * 1024 + 4 * lane + 256 * j); }
            first = false;
            const float kb = has1 ? 1.0f : 0.0f;
#pragma unroll
            for (int j = 0; j < 4; ++j) { acc[j] += (f32x4){bflo(wa[j].x), bfhi(wa[j].x), bflo(wa[j].y), bfhi(wa[j].y)}; acc[j] += (f32x4){bflo(wb[j].x), bfhi(wb[j].x), bflo(wb[j].y), bfhi(wb[j].y)} * kb; }
          } else {
            if (rn < rows) {
#pragma unroll
                for (int j = 0; j < 4; ++j) vn[j] = *(const u32x2*)(X + (size_t)rn * 1024 + 4 * lane + 256 * j); }
            first = false;
          }
        }
#pragma unroll
        for (int j = 0; j < 4; ++j) v[j] = v[j] + g2v[j] * acc[j];
        if (l == 0) {
#pragma unroll
            for (int j = 0; j < 4; ++j) { u32x2 w; w.x = pk2(v[j].x, v[j].y); w.y = pk2(v[j].z, v[j].w); *(u32x2*)(X + (size_t)r * 1024 + 4 * lane + 256 * j) = w; }
            const float rs = row_rs(v); f32x4 h[4];
            norm_mod(v, rs, p->norm1_g + 1024, modv + (9 + bi) * 6144, modv + (9 + bi) * 6144 + 1024, h, lane);
            store_h(h, H + (size_t)r * 1024, lane);
        } else {
#pragma unroll
            for (int j = 0; j < 4; ++j) *(f32x4*)(p->out + (size_t)r * 1024 + 4 * lane + 256 * j) = v[j];
        }
    }
    if (l == 0) convert_small(p, 1, lds, lane, wave, bid, G);
}

#define XB_TMO      128
#define XB_XCNT(j)  (256  + 64 * (j))
#define XB_XSUB(j)  (1280 + 64 * (j))
#define XB_XGEN(j)  (2304 + 64 * (j))
#define XB_TOP      3328
#define XB_TOPGEN   3392
#define XCD_BAR_WORDS 3456
#define XB_SPIN_CAP (1u << 18)

__device__ __forceinline__ unsigned xb_ld(unsigned* p)              { return __hip_atomic_load(p, __ATOMIC_RELAXED, __HIP_MEMORY_SCOPE_AGENT); }
__device__ __forceinline__ unsigned xb_add(unsigned* p, unsigned v) { return __hip_atomic_fetch_add(p, v, __ATOMIC_RELAXED, __HIP_MEMORY_SCOPE_AGENT); }
__device__ __forceinline__ unsigned xb_xcc_id() { return (unsigned)__builtin_amdgcn_s_getreg((3 << 11) | 20) & 0xFu; }
#define XB_SPIN(cond, bar) do { unsigned _sp = 0; while (cond) { __builtin_amdgcn_s_sleep(1); \
    if ((++_sp & 255u) == 0u) { if (xb_ld(&(bar)[XB_TMO])) break; if (_sp > XB_SPIN_CAP) { atomicAdd(&(bar)[XB_TMO], 1u); break; } } } } while (0)

struct XcdBarrier {
    unsigned* bar; unsigned x;
    volatile LAS unsigned* st;
};

__device__ __forceinline__ XcdBarrier xcd_barrier_post(unsigned* bar, volatile LAS unsigned* st) {
    XcdBarrier b; b.bar = bar; b.x = xb_xcc_id(); b.st = st;
    if (threadIdx.x == 0) (void)xb_add(&bar[XB_XCNT(b.x)], 1u);
    return b;
}
__device__ __forceinline__ void xcd_barrier_complete(unsigned* bar, unsigned x, unsigned& nloc, unsigned& nx) {
    const unsigned G = gridDim.x * gridDim.y * gridDim.z;
    unsigned sum, cnt, mine, sp = 0u;
    for (;;) {
        sum = 0u; cnt = 0u; mine = 0u;
#pragma unroll
        for (unsigned j = 0; j < 16; ++j) { const unsigned c = xb_ld(&bar[XB_XCNT(j)]); sum += c; cnt += (c > 0u) ? 1u : 0u; mine = (j == x) ? c : mine; }
        if (sum == G) break;
        __builtin_amdgcn_s_sleep(1);
        if ((++sp & 255u) == 0u) { if (xb_ld(&bar[XB_TMO])) break; if (sp > XB_SPIN_CAP) { atomicAdd(&bar[XB_TMO], 1u); break; } }
    }
    nloc = mine > 0u ? mine : 1u; nx = cnt > 0u ? cnt : 1u;
}

__device__ __forceinline__ void xcd_barrier(const XcdBarrier& b) {
    asm volatile("s_waitcnt vmcnt(0)" ::: "memory");
    __syncthreads();
    if (threadIdx.x == 0) {
        unsigned* bar = b.bar;
        __builtin_amdgcn_s_waitcnt(0);
        unsigned nloc = b.st[0], nx = b.st[1];
        if (nloc == 0u) { xcd_barrier_complete(bar, b.x, nloc, nx); b.st[0] = nloc; b.st[1] = nx; }
        const unsigned old = xb_add(&bar[XB_XSUB(b.x)], 1u);
        const unsigned gen = old / nloc;
        if (old + 1u == (gen + 1u) * nloc) {
            __builtin_amdgcn_fence(__ATOMIC_RELEASE, "agent");
            asm volatile("s_waitcnt vmcnt(0)" ::: "memory");
            const unsigned og = xb_add(&bar[XB_TOP], 1u);
            const unsigned tg = og / nx;
            if (og + 1u == (tg + 1u) * nx) xb_add(&bar[XB_TOPGEN], 1u);
            else XB_SPIN(xb_ld(&bar[XB_TOPGEN]) == tg, bar);
            __builtin_amdgcn_fence(__ATOMIC_ACQUIRE, "agent");
            xb_add(&bar[XB_XGEN(b.x)], 1u);
            asm volatile("s_waitcnt vmcnt(0)" ::: "memory");
        } else {
            XB_SPIN(xb_ld(&bar[XB_XGEN(b.x)]) == gen, bar);
            __builtin_amdgcn_fence(__ATOMIC_ACQUIRE, "agent");
            asm volatile("s_waitcnt vmcnt(0)" ::: "memory");
        }
    }
    __syncthreads();
}

#ifndef REP_GZA
#define REP_GZA 1
#endif
#ifndef REP_GG
#define REP_GG 1
#endif
#ifndef REP_GMRG
#define REP_GMRG 1
#endif
#ifndef REP_GM1
#define REP_GM1 1
#endif
#ifndef REP_GM2
#define REP_GM2 1
#endif
#ifndef REP_ATT
#define REP_ATT 1
#endif
#ifndef REP_UPD
#define REP_UPD 1
#endif
#ifndef REP_SGU
#define REP_SGU 1
#endif
#ifndef REP_SCAN
#define REP_SCAN 1
#endif
#ifndef REP_PRE
#define REP_PRE 1
#endif
#ifndef REP_CMB
#define REP_CMB 1
#endif
#ifndef REP_MIX
#define REP_MIX 1
#endif
#ifndef REP_RO
#define REP_RO 1
#endif
#ifndef REP_N2
#define REP_N2 1
#endif
#ifndef REP_GEMM
#define REP_GEMM 1
#endif
#ifndef REP_SYNC
#define REP_SYNC 1
#endif
#ifndef EN_GEMM
#define EN_GEMM 0x3f
#endif
#ifndef EN_ATT
#define EN_ATT 1
#endif
#ifndef EN_UPD
#define EN_UPD 1
#endif
#ifndef EN_SGU
#define EN_SGU 1
#endif
#ifndef EN_RO
#define EN_RO 1
#endif
#ifndef EN_MISC
#define EN_MISC 1
#endif
#define KPP() ({ KPC q_ = kp_; asm volatile("" : "+s"(q_)); q_; })
__global__ void __launch_bounds__(512, 2) mk_fwd(KP p_unused) {
    extern __shared__ __attribute__((aligned(16))) unsigned char lds_raw[];
    LAS unsigned char* lds = (LAS unsigned char*)lds_raw;
    cg::grid_group grid = cg::this_grid();
    const int bid = blockIdx.x, G = gridDim.x;
#define IDS() int tid = threadIdx.x; asm volatile("" : "+v"(tid)); const int lane = tid & 63, wave = __builtin_amdgcn_readfirstlane(tid >> 6); (void)lane; (void)wave
    const KPC kp_ = (KPC)__builtin_amdgcn_kernarg_segment_ptr();
    volatile LAS unsigned* bst = (volatile LAS unsigned*)(lds + 147392);
    if (threadIdx.x < 16) bst[threadIdx.x] = 0u;
    __syncthreads();
    (void)xcd_barrier_post((unsigned*)KPP()->ws, bst);
#ifdef PROBE_WAIT
    unsigned long long wacc = 0ull;
    int bidx_ = 0;
#ifndef PW_LO
#define PW_LO 0
#define PW_HI 100
#endif
#define GSYNC() do { const unsigned long long t0_ = __builtin_amdgcn_s_memrealtime(); XcdBarrier b_; b_.bar = (unsigned*)KPP()->ws; b_.x = xb_xcc_id(); b_.st = bst; xcd_barrier(b_); if (bidx_ >= PW_LO && bidx_ < PW_HI) wacc += __builtin_amdgcn_s_memrealtime() - t0_; ++bidx_; } while (0)
#else
#define GSYNC() do { XcdBarrier b_; b_.bar = (unsigned*)KPP()->ws; b_.x = xb_xcc_id(); b_.st = bst; xcd_barrier(b_); } while (0)
#endif

    { IDS(); for (int rep = 0; rep < REP_PRE; ++rep) { phase_prep(KPP(), lds, tid, lane, wave, bid, G); __syncthreads(); } }
    if (G == 0x7fffffff) grid.sync();
    GSYNC();
    { IDS(); for (int rep = 0; rep < REP_PRE; ++rep) phase_norm_in(KPP(), lane, wave, bid, G); }
    GSYNC();
#pragma unroll 1
    for (int l = 0; l < 2; ++l) {
        {
            unsigned char* ws = KPP()->ws;
            pg8::Gemm g{(const pg8::bf16_t*)(ws + WS_H), (const pg8::bf16_t*)(ws + WS_WTIN), M, NZA, 1024}; GroupOrder S{1, M / 256, NZA / 256, 0, 0, G, bid};
            EpiZA E{(bf16*)(ws + WS_ZA)};
            for (int rep = 0; rep < REP_GEMM * REP_GZA; ++rep) pg8::gemm_phase<EpiZA, GroupOrder, true, true>(lds, g, S, E);
#ifdef PROBE_ZA_HALF
            if (bid < PROBE_ZA_HALF) { GroupOrder S2{1, M / 256, NZA / 256, 0, 0, PROBE_ZA_HALF, bid}; pg8::gemm_phase<EpiZA, GroupOrder, true, true>(lds, g, S2, E); }
#endif
#ifdef PROBE_ZA_SLEEP
            { const unsigned long long t0 = __builtin_amdgcn_s_memrealtime(); while (__builtin_amdgcn_s_memrealtime() - t0 < 100000ull) __builtin_amdgcn_s_sleep(64); __syncthreads(); for (int rep = 0; rep < PROBE_ZA_SLEEP; ++rep) pg8::gemm_phase<EpiZA, GroupOrder, true, true>(lds, g, S, E); }
#endif
#ifdef PROBE_ZA_NULL
            { EpiNull En; pg8::gemm_phase<EpiNull, GroupOrder, true, true>(lds, g, S, En); }
#endif
        }
        GSYNC();
        {
            KPC p = KPP(); IDS();
            float mq = fabsf(p->qn_g[l * 64 + lane]), mk = fabsf(p->kn_g[l * 64 + lane]);
            mq = wave_max(mq); mk = wave_max(mk);
            const float Mb2 = 8.0f * mq * mk * LOG2E;
            const int natt = (l == 0) ? 544 : 512, nupd = NB * NCH * 4, nvp = (l == 0) ? (M / 128) : (ML / 128);
            for (int rep = 0; rep < REP_MIX; ++rep)
            for (int it = bid; it < natt + nupd + nvp; it += G) {
                if (it < natt) { for (int q = 0; q < REP_ATT; ++q) att_item(p, l, lds, it, Mb2, tid, lane, wave); }
                else if (it < natt + nupd) { for (int q = 0; q < REP_UPD; ++q) ret_upd_item(p, l, lds, it - natt, tid, lane, wave); }
                else { for (int q = 0; q < REP_SGU; ++q) sgu_vprep_item(p, it - natt - nupd, tid); }
            }
        }
        GSYNC();
        { IDS(); for (int rep = 0; rep < REP_RO * REP_SCAN; ++rep) phase_scan(KPP(), l, tid, bid, G); }
        GSYNC();
        {   KPC p = KPP(); IDS(); const int nch = (l == 0) ? NCH : 32;
            const int nro = NB * nch * 4, nsgu = ((l == 0) ? (M / 128) : (ML / 128)) * 4;
            for (int rep = 0; rep < REP_RO; ++rep)
            for (int it = bid; it < nro + nsgu; it += G) {
                if (it < nro) { const int b = it / (nch * 4), rem = it % (nch * 4); ret_out_item(p, l, lds, b * (NCH * 4) + rem, tid, lane, wave); }
                else sgu_item(p, l, lds, it - nro, tid, lane, wave);
            }
        }
        GSYNC();
        const int Mrows = (l == 0) ? M : ML;
        {
            unsigned char* ws = KPP()->ws;
            pg8::Gemm g{(const pg8::bf16_t*)(ws + WS_H), (const pg8::bf16_t*)(ws + WS_WTIN) + (size_t)NZA * 1024, Mrows, NZG, 1024}; GroupOrder S{1, Mrows / 256, NZG / 256, 0, 0, G, bid};
            EpiSig E{(bf16*)(ws + WS_G)};
            for (int rep = 0; rep < REP_GEMM * REP_GG; ++rep) pg8::gemm_phase<EpiSig, GroupOrder, true, true>(lds, g, S, E);
            if (l == 0 && G == 256 && bid >= CVT_G_IDLE0) { IDS(); convert_experts(KPP(), 0, 0, CVT_G_HI, (bid - CVT_G_IDLE0) * 8 + wave, (256 - CVT_G_IDLE0) * 8, lds, lane, wave); }
        }
        GSYNC();
        {
            KPC p = KPP(); unsigned char* ws = p->ws;
            pg8::Gemm g{(const pg8::bf16_t*)p->out, (const pg8::bf16_t*)(ws + WS_WTBR), 3 * M, 3072, 512}; MergeOrder S{Mrows / 256, G, bid};
            EpiMergeChain E{(const bf16*)(ws + WS_G), (bf16*)(ws + WS_H)};
            for (int rep = 0; rep < REP_GEMM * REP_GMRG; ++rep) pg8::gemm_phase<EpiMergeChain, MergeOrder, true, true>(lds, g, S, E);
            if (l == 0 && G == 256 && bid >= CVT_M_IDLE0) { IDS(); convert_experts(KPP(), 0, CVT_G_HI, CVT_M_HI, (bid - CVT_M_IDLE0) * 8 + wave, (256 - CVT_M_IDLE0) * 8, lds, lane, wave); }
        }
        GSYNC();
        {
            KPC p = KPP(); unsigned char* ws = p->ws;
            pg8::Gemm g{(const pg8::bf16_t*)(ws + WS_H), (const pg8::bf16_t*)(ws + WS_WTOUT), Mrows, 1024, 1024}; GroupOrder S{1, Mrows / 256, 4, 0, 0, G, bid};
            EpiOut E{p->x, p->ctx, (bf16*)(ws + WS_X), (const float*)(ws + WS_MODV) + l * 9 * 6144, (l == 0) ? 1 : 0};
            pg8::gemm_phase<EpiOut, GroupOrder, true, true>(lds, g, S, E);
            if (l == 0 && G == 256 && bid >= CVT_O_IDLE0) { IDS(); convert_experts(KPP(), 0, CVT_M_HI, CVT_ITEMS, (bid - CVT_O_IDLE0) * 8 + wave, (256 - CVT_O_IDLE0) * 8, lds, lane, wave); }
        }
        GSYNC();
        { IDS(); for (int rep = 0; rep < REP_N2; ++rep) { phase_norm2(KPP(), l, lds, tid, lane, wave, bid, G); __syncthreads(); } }
        GSYNC();
        { IDS(); for (int rep = 0; rep < REP_N2 * REP_TK; ++rep) phase_topk(KPP(), l, lds, tid, lane, wave, bid, G); }
        GSYNC();
        {
            unsigned char* ws = KPP()->ws;
            pg8::Gemm g{(const pg8::bf16_t*)(ws + WS_XS), (const pg8::bf16_t*)(ws + WS_WT1), NE * ME, NE * 2048, 1024}; GroupOrder S{NE, (l == 0) ? 17 : 16, 8, 17, 8, G, bid};
            EpiMoe1 E{(bf16*)(ws + WS_ACT)};
            for (int rep = 0; rep < REP_GEMM * REP_GM1; ++rep) pg8::gemm_phase<EpiMoe1, GroupOrder, true, true>(lds, g, S, E);
        }
        GSYNC();
        {
            unsigned char* ws = KPP()->ws;
            pg8::Gemm g{(const pg8::bf16_t*)(ws + WS_ACT), (const pg8::bf16_t*)(ws + WS_WT2), NE * ME, NE * 1024, 1024}; GroupOrder S{NE, (l == 0) ? 17 : 16, 4, 17, 4, G, bid};
            EpiMoe2 E{(bf16*)(ws + WS_XS), (const float*)(ws + WS_TOPW)};
            for (int rep = 0; rep < REP_GEMM * REP_GM2; ++rep) pg8::gemm_phase<EpiMoe2, GroupOrder, true, true>(lds, g, S, E);
        }
        GSYNC();
        { IDS(); for (int rep = 0; rep < ((l == 1) ? REP_CMB : 1); ++rep) phase_combine(KPP(), l, lds, tid, lane, wave, bid, G); }
        if (l == 0) GSYNC();
        for (int rep = 1; rep < REP_SYNC; ++rep) { for (int k = 0; k < 12; ++k) GSYNC(); }
    }
#ifdef PROBE_WAIT
    if (bid == PROBE_WAIT - 1) { const unsigned long long t0 = __builtin_amdgcn_s_memrealtime(); while (__builtin_amdgcn_s_memrealtime() - t0 < wacc) __builtin_amdgcn_s_sleep(8); }
#endif
}

extern "C" void kernel_launch(void* const* d_in, const int* in_sizes, int n_in, void* d_out, int out_size, void* d_ws, size_t ws_size, hipStream_t stream) {
    static int grid = 0;
    if (grid == 0) {
        if (n_in != 22 || out_size != ML * D || ws_size < WS_END) { fprintf(stderr, "kernel_launch: unexpected shapes (n_in %d out %d ws %zu, need %zu)\n", n_in, out_size, ws_size, (size_t)WS_END); grid = -1; return; }
        int dev = 0, cus = 0, per_cu = 0;
        if (hipGetDevice(&dev) != hipSuccess || hipDeviceGetAttribute(&cus, hipDeviceAttributeMultiprocessorCount, dev) != hipSuccess) { grid = -1; return; }
        if (hipFuncSetAttribute((const void*)mk_fwd, hipFuncAttributeMaxDynamicSharedMemorySize, LDS_BYTES) != hipSuccess) { fprintf(stderr, "kernel_launch: hipFuncSetAttribute failed\n"); grid = -1; return; }
        if (hipOccupancyMaxActiveBlocksPerMultiprocessor(&per_cu, (const void*)mk_fwd, 512, LDS_BYTES) != hipSuccess || per_cu < 1) { fprintf(stderr, "kernel_launch: occupancy query says %d\n", per_cu); (void)hipGetLastError(); }
        grid = cus;
        fprintf(stderr, "kernel_launch: grid %d, occupancy %d/CU, ws %zu\n", grid, per_cu, ws_size);
    }
    if (grid < 0) return;
    if (hipMemsetAsync(d_ws, 0, 16384, stream) != hipSuccess) { fprintf(stderr, "kernel_launch: memset failed\n"); return; }
    KP hp{};
    const float** f = (const float**)&hp;
    for (int i = 0; i < 22; ++i) f[i] = (const float*)d_in[i];
    hp.out = (float*)d_out; hp.ws = (unsigned char*)d_ws;
    void* args[] = {&hp};
    hipError_t e = hipLaunchCooperativeKernel((const void*)mk_fwd, dim3(grid), dim3(512), args, LDS_BYTES, stream);
    if (e != hipSuccess) fprintf(stderr, "kernel_launch: cooperative launch failed: %s\n", hipGetErrorString(e));
}
```

```cpp
#include <hip/hip_runtime.h>
#include <hip/hip_cooperative_groups.h>
#include <cstdio>
#include <cstdint>
namespace cg = cooperative_groups;
namespace pg8 {
#define PG8_LAS __attribute__((address_space(3)))
typedef unsigned short bf16_t;
typedef short bf16x8 __attribute__((ext_vector_type(8)));
typedef float f32x4 __attribute__((ext_vector_type(4)));
typedef unsigned u32x4 __attribute__((ext_vector_type(4)));
constexpr int BM = 256, BK = 64, HALF = 128, HTB = HALF * BK * 2  , STAGE_BYTES = 8 * HTB, NXCD = 8, WGM = 8;

__host__ __device__ __forceinline__ int lds_byte(int r, int c) { const int st = (r >> 4) * 2 + (c >> 5), rr = r & 15, cc = c & 31, ob = rr * 64 + cc * 2; return st * 1024 + (ob ^ (((ob >> 9) & 1) << 5)); }
__host__ __device__ __forceinline__ void stage_rc(int b, int& R, int& C) { const int st = b / 1024, sb = b % 1024, swz = sb ^ (((sb >> 9) & 1) << 5); R = (st >> 1) * 16 + swz / 64; C = (st & 1) * 32 + (swz % 64) / 2; }
__host__ __device__ __forceinline__ int perm32(int rho) { const int n = rho >> 4, i = rho & 15; return 8 * (i >> 2) + 4 * n + (i & 3); }

struct Unit { int pm, pn; };
struct Gemm { const bf16_t* A; const bf16_t* Bt; int M, N, K; };

struct StaticOrder {
    int nM, nN, nwg, G, c;
    __host__ __device__ void init(int M, int N, int G_, int c_) { nM = M / BM; nN = N / BM; nwg = nM * nN; G = G_; c = c_; }
    __host__ __device__ bool next(int i, Unit& u) const {
        const long L = (long)i * G + c; if (L >= nwg) return false;
        int wgid = (int)L; { const int q = nwg / NXCD, r = nwg % NXCD, xcd = wgid % NXCD, off = wgid / NXCD; wgid = (xcd < r ? xcd * (q + 1) : r * (q + 1) + (xcd - r) * q) + off; }
        const int nig = WGM * nN, gid = wgid / nig, fm = gid * WGM, gsz = (nM - fm) < WGM ? (nM - fm) : WGM;
        u.pm = fm + ((wgid % nig) % gsz); u.pn = (wgid % nig) / gsz; return true;
    }
    __device__ __forceinline__ void a_ready(const Unit&) const {}
    __device__ __forceinline__ void done(const Unit&) const {}
};

__device__ __forceinline__ unsigned cvt_pk_bf16(float lo, float hi) { unsigned r; asm volatile("v_cvt_pk_bf16_f32 %0, %1, %2" : "=v"(r) : "v"(lo), "v"(hi)); return r; }
typedef float f32x2 __attribute__((ext_vector_type(2)));
__device__ __forceinline__ f32x2 gelu_pk(f32x2 v) {
    const f32x2 av = __builtin_elementwise_abs(v), d = av * 0.2316418882f + 1.0f;
    f32x2 t; t.x = __builtin_amdgcn_rcpf(d.x); t.y = __builtin_amdgcn_rcpf(d.y);
    f32x2 q = t * 0.5307027145f + (-0.7265760135f); q = q * t + 0.7107068705f; q = q * t + (-0.142248368f); q = q * t + 0.127414796f; q = q * t;
    const f32x2 s = (v * v) * (-0.72134752044f);
    f32x2 e; e.x = __builtin_amdgcn_exp2f(s.x); e.y = __builtin_amdgcn_exp2f(s.y);
    const f32x2 m = v * (q * e), r = v - m;
    f32x2 o; o.x = v.x < 0.f ? m.x : r.x; o.y = v.y < 0.f ? m.y : r.y; return o;
}

template <int ACT  > struct EpiBf16 {
    static constexpr bool PERM = true, AFTER_DRAIN = false, CHAIN = false; static_assert(ACT == 0 || ACT == 1, "EpiBf16: ACT is 0 (none) or 1 (gelu_pk)");
    bf16_t* O; int ldc; const float* bias; int split_cols; size_t split_stride; float scale0;
    __device__ __forceinline__ void operator()(const f32x4 (&acc)[2][2][4][2], const Unit& u, int wr, int wc, int fr, int fq) const {
        const int row0 = u.pm * BM + wr * 64 + fr; int colt = u.pn * BM; bf16_t* base = O;
        float sc = 1.f; if (split_cols) { const int t = colt / split_cols; base += (size_t)t * split_stride; colt -= t * split_cols; if (t == 0) sc = scale0; }
        const int col0 = colt + wc * 32 + 8 * fq, bcol0 = u.pn * BM + wc * 32 + 8 * fq;
        f32x4 bv[2][2];
#pragma unroll
        for (int bj = 0; bj < 2; ++bj)
#pragma unroll
            for (int n = 0; n < 2; ++n) bv[bj][n] = bias ? *(const f32x4*)(bias + bcol0 + bj * HALF + 4 * n) : (f32x4){0.f, 0.f, 0.f, 0.f};
#pragma unroll
        for (int ai = 0; ai < 2; ++ai)
#pragma unroll
            for (int m = 0; m < 4; ++m) { bf16_t* rowp = base + (size_t)(row0 + ai * HALF + m * 16) * ldc + col0;
#pragma unroll
                for (int bj = 0; bj < 2; ++bj) { f32x4 v0 = acc[ai][bj][m][0] + bv[bj][0], v1 = acc[ai][bj][m][1] + bv[bj][1];
                    if (ACT == 1) { f32x2 a = gelu_pk((f32x2){v0[0], v0[1]}), b = gelu_pk((f32x2){v0[2], v0[3]}), c = gelu_pk((f32x2){v1[0], v1[1]}), d = gelu_pk((f32x2){v1[2], v1[3]});
                        v0 = (f32x4){a.x, a.y, b.x, b.y}; v1 = (f32x4){c.x, c.y, d.x, d.y}; }
                    v0 = v0 * sc; v1 = v1 * sc; u32x4 w; w.x = cvt_pk_bf16(v0[0], v0[1]); w.y = cvt_pk_bf16(v0[2], v0[3]); w.z = cvt_pk_bf16(v1[0], v1[1]); w.w = cvt_pk_bf16(v1[2], v1[3]);
                    *(u32x4*)(rowp + bj * HALF) = w; } }
    }
};
template <class Epi, class Sched, bool ALIGN_EPI = false, bool SP2 = false>
__device__ __forceinline__ void gemm_phase(PG8_LAS unsigned char* lds, const Gemm g, const Sched& S, const Epi& E) {
    int tid_ = threadIdx.x; asm volatile("" : "+v"(tid_));
    const int tid = tid_, wid = __builtin_amdgcn_readfirstlane(tid >> 6), lane = tid & 63, wr = wid >> 2, wc = wid & 3, fr = lane & 15, fq = lane >> 4;
    const int K = g.K, nt = K / BK;
    unsigned voffA[2], voffB[2];
#pragma unroll
    for (int i = 0; i < 2; ++i) { int R, C; stage_rc(tid * 16 + i * 8192, R, C); const int Rb = Epi::PERM ? ((R & ~31) + perm32(R & 31)) : R;
        voffA[i] = (unsigned)(R * K + C) * 2u; voffB[i] = (unsigned)(Rb * K + C) * 2u; }
    const size_t kstep = (size_t)(BK * 2);
    const size_t hstep = (size_t)HALF * K * 2;
    const size_t tstep = 2 * hstep;
    const unsigned ldsw = (unsigned)wid * 1024u;
    const int aoff = lds_byte(wr * 64 + fr, fq * 8), boff = lds_byte(wc * 32 + fr, fq * 8);
#define PG8_SA(b, h) (((b) * 2 + (h)) * HTB)
#define PG8_SB(b, h) ((4 + (b) * 2 + (h)) * HTB)
#define PG8_STAGE(bufoff, gbase, voff) do { _Pragma("unroll") for (int _i = 0; _i < 2; ++_i) \
        __builtin_amdgcn_global_load_lds((const unsigned*)((const char*)(gbase) + (voff)[_i]), (PG8_LAS unsigned*)(lds + (bufoff) + ldsw + _i * 8192), 16, 0, 0); } while (0)
#define PG8_LDA(dst, b, h) do { _Pragma("unroll") for (int m = 0; m < 4; ++m) _Pragma("unroll") for (int k = 0; k < 2; ++k) dst[m][k] = *(const PG8_LAS bf16x8*)(lds + PG8_SA(b, h) + aoff + m * 2048 + k * 1024); } while (0)
#define PG8_LDB(dst, b, h) do { _Pragma("unroll") for (int n = 0; n < 2; ++n) _Pragma("unroll") for (int k = 0; k < 2; ++k) dst[n][k] = *(const PG8_LAS bf16x8*)(lds + PG8_SB(b, h) + boff + n * 2048 + k * 1024); } while (0)
#define PG8_MMA(ai, bj, At, Bt) do { __builtin_amdgcn_s_setprio(1); _Pragma("unroll") for (int m = 0; m < 4; ++m) _Pragma("unroll") for (int n = 0; n < 2; ++n) _Pragma("unroll") for (int k = 0; k < 2; ++k) \
        acc[ai][bj][m][n] = __builtin_amdgcn_mfma_f32_16x16x32_bf16(Bt[n][k], At[m][k], acc[ai][bj][m][n], 0, 0, 0); __builtin_amdgcn_s_setprio(0); } while (0)
#define PG8_WAIT_V(n) asm volatile("s_waitcnt vmcnt(" #n ")" ::: "memory")
#define PG8_WAIT_L(n) asm volatile("s_waitcnt lgkmcnt(" #n ")" ::: "memory")
#define PG8_BAR __builtin_amdgcn_s_barrier()
#define PG8_SCHED __builtin_amdgcn_sched_barrier(0)
    Unit cur, nxt; int ui = 0;
    if (!S.next(0, cur)) return;
    f32x4 acc[2][2][4][2];
#pragma unroll
    for (int a = 0; a < 2; ++a)
#pragma unroll
        for (int b = 0; b < 2; ++b)
#pragma unroll
            for (int m = 0; m < 4; ++m)
#pragma unroll
                for (int n = 0; n < 2; ++n) acc[a][b][m][n] = (f32x4){0.f, 0.f, 0.f, 0.f};
    bf16x8 At[4][2], B0[2][2], B1[2][2];
    const char* cA = (const char*)g.A + (size_t)cur.pm * tstep; const char* cB = (const char*)g.Bt + (size_t)cur.pn * tstep;
    S.a_ready(cur);
    if constexpr (SP2) {
        PG8_STAGE(PG8_SB(0, 0), cB, voffB); PG8_STAGE(PG8_SB(0, 1), cB + hstep, voffB); PG8_STAGE(PG8_SA(0, 0), cA, voffA); PG8_STAGE(PG8_SA(0, 1), cA + hstep, voffA);
        if (wr == 1) PG8_BAR;
        PG8_WAIT_V(2); PG8_BAR;
        PG8_STAGE(PG8_SB(1, 0), cB + kstep, voffB); PG8_STAGE(PG8_SA(1, 0), cA + kstep, voffA); PG8_STAGE(PG8_SB(1, 1), cB + hstep + kstep, voffB);
        PG8_WAIT_V(6); PG8_BAR;
    } else {
        PG8_STAGE(PG8_SB(0, 0), cB, voffB); PG8_STAGE(PG8_SA(0, 0), cA, voffA); PG8_STAGE(PG8_SB(0, 1), cB + hstep, voffB); PG8_STAGE(PG8_SA(0, 1), cA + hstep, voffA);
        if (wr == 1) PG8_BAR;
        PG8_WAIT_V(4); PG8_BAR;
        PG8_STAGE(PG8_SB(1, 0), cB + kstep, voffB); PG8_STAGE(PG8_SA(1, 0), cA + kstep, voffA); PG8_STAGE(PG8_SB(1, 1), cB + hstep + kstep, voffB);
        PG8_WAIT_V(6); PG8_BAR;
    }
    for (;;) {
        const bool has_next = S.next(ui + 1, nxt);
        const char* nA = has_next ? (const char*)g.A + (size_t)nxt.pm * tstep : cA; const char* nB = has_next ? (const char*)g.Bt + (size_t)nxt.pn * tstep : cB;
        for (int t = 0; t < nt; t += 2) {
            const bool last = (t == nt - 2);
            const char* a1 = cA + (size_t)(t + 1) * kstep;
            const char* a2 = last ? nA : cA + (size_t)(t + 2) * kstep; const char* b2 = last ? nB : cB + (size_t)(t + 2) * kstep;
            const char* a3 = a2 + kstep; const char* b3 = b2 + kstep;
            if (last && has_next) S.a_ready(nxt);
            if constexpr (SP2) {
            PG8_LDB(B0, 0, 0); PG8_LDB(B1, 0, 1); PG8_SCHED; PG8_LDA(At, 0, 0); PG8_STAGE(PG8_SA(1, 1), a1 + hstep, voffA);
            PG8_WAIT_V(8); PG8_WAIT_L(0); PG8_BAR; PG8_MMA(0, 0, At, B0); PG8_MMA(0, 1, At, B1); PG8_BAR; PG8_SCHED;
            PG8_LDA(At, 0, 1); PG8_STAGE(PG8_SB(0, 0), b2, voffB); PG8_STAGE(PG8_SB(0, 1), b2 + hstep, voffB); PG8_STAGE(PG8_SA(0, 0), a2, voffA);
            PG8_WAIT_V(8); PG8_WAIT_L(0); PG8_BAR; PG8_MMA(1, 0, At, B0); PG8_MMA(1, 1, At, B1); PG8_BAR; PG8_SCHED;
            PG8_LDB(B0, 1, 0); PG8_LDB(B1, 1, 1); PG8_SCHED; PG8_LDA(At, 1, 0); PG8_STAGE(PG8_SA(0, 1), a2 + hstep, voffA);
            PG8_WAIT_V(8); PG8_WAIT_L(0); PG8_BAR; PG8_MMA(0, 0, At, B0); PG8_MMA(0, 1, At, B1); PG8_BAR; PG8_SCHED;
            PG8_LDA(At, 1, 1); PG8_STAGE(PG8_SB(1, 0), b3, voffB); PG8_STAGE(PG8_SB(1, 1), b3 + hstep, voffB); PG8_STAGE(PG8_SA(1, 0), a3, voffA);
            PG8_WAIT_V(8); PG8_WAIT_L(0); PG8_BAR; PG8_MMA(1, 0, At, B0); PG8_MMA(1, 1, At, B1); PG8_BAR; PG8_SCHED;
            } else {
            PG8_LDB(B0, 0, 0); PG8_SCHED; PG8_LDA(At, 0, 0); PG8_STAGE(PG8_SA(1, 1), a1 + hstep, voffA);
            PG8_WAIT_L(8); PG8_BAR; PG8_WAIT_L(0); PG8_MMA(0, 0, At, B0); PG8_BAR; PG8_SCHED;
            PG8_LDB(B1, 0, 1); PG8_STAGE(PG8_SB(0, 0), b2, voffB);
            PG8_BAR; PG8_WAIT_L(0); PG8_MMA(0, 1, At, B1); PG8_BAR;
            PG8_LDA(At, 0, 1); PG8_STAGE(PG8_SA(0, 0), a2, voffA);
            PG8_BAR; PG8_WAIT_L(0); PG8_MMA(1, 0, At, B0); PG8_BAR; PG8_SCHED;
            PG8_STAGE(PG8_SB(0, 1), b2 + hstep, voffB);
            PG8_WAIT_V(6); PG8_BAR; PG8_MMA(1, 1, At, B1); PG8_BAR;
            PG8_LDB(B0, 1, 0); PG8_SCHED; PG8_LDA(At, 1, 0); PG8_STAGE(PG8_SA(0, 1), a2 + hstep, voffA);
            PG8_WAIT_L(8); PG8_BAR; PG8_WAIT_L(0); PG8_MMA(0, 0, At, B0); PG8_BAR; PG8_SCHED;
            PG8_LDB(B1, 1, 1); PG8_STAGE(PG8_SB(1, 0), b3, voffB);
            PG8_BAR; PG8_WAIT_L(0); PG8_MMA(0, 1, At, B1); PG8_BAR;
            PG8_LDA(At, 1, 1); PG8_STAGE(PG8_SA(1, 0), a3, voffA);
            PG8_BAR; PG8_WAIT_L(0); PG8_MMA(1, 0, At, B0); PG8_BAR; PG8_SCHED;
            PG8_STAGE(PG8_SB(1, 1), b3 + hstep, voffB);
            PG8_WAIT_V(6); PG8_BAR; PG8_MMA(1, 1, At, B1); PG8_BAR;
            }
        }
        if constexpr (ALIGN_EPI) { if (wr == 0) PG8_BAR; }
        bool keep_acc = false;
        if constexpr (Epi::CHAIN) { keep_acc = E.chain(acc, cur, wr, wc, fr, fq); S.done(cur); }
        else if constexpr (!Epi::AFTER_DRAIN) { E(acc, cur, wr, wc, fr, fq); S.done(cur); }
        if (!has_next) break;
        if (!keep_acc) {
#pragma unroll
        for (int a = 0; a < 2; ++a)
#pragma unroll
            for (int b = 0; b < 2; ++b)
#pragma unroll
                for (int m = 0; m < 4; ++m)
#pragma unroll
                    for (int n = 0; n < 2; ++n) acc[a][b][m][n] = (f32x4){0.f, 0.f, 0.f, 0.f};
        }
        cur = nxt; cA = nA; cB = nB; ++ui;
        if constexpr (ALIGN_EPI) { if (wr == 1) PG8_BAR; }
    }
    PG8_WAIT_V(0);
    if constexpr (!ALIGN_EPI) { if (wr == 0) PG8_BAR; }
    PG8_BAR;
    if constexpr (Epi::AFTER_DRAIN) { E.fused(acc, cur, wr, wc, fr, fq, lds, wid, lane); S.done(cur); }
#undef PG8_SA
#undef PG8_SB
#undef PG8_STAGE
#undef PG8_LDA
#undef PG8_LDB
#undef PG8_MMA
#undef PG8_WAIT_V
#undef PG8_WAIT_L
#undef PG8_BAR
#undef PG8_SCHED
}
}

#define LAS __attribute__((address_space(3)))
typedef unsigned short bf16;
typedef short bf16x8 __attribute__((ext_vector_type(8)));
typedef float f32x4 __attribute__((ext_vector_type(4)));
typedef unsigned u32x4 __attribute__((ext_vector_type(4)));
typedef unsigned u32x2 __attribute__((ext_vector_type(2)));

constexpr int D = 1024, NB = 8, T = 4096, CL = 256;
constexpr int ML = NB * T, MC = NB * CL, M = ML + MC;
constexpr int NZA = 3328, NZG = 3072;
constexpr int C_RQ = 0, C_RK = 256, C_RV = 512, C_RG = 1024, C_SU = 1536, C_SV = 2048, C_AQ = 2560, C_AK = 3072, C_AV = 3200;
constexpr int NE = 16, CAPL = 512, CAPC = 32, ME = NB * (CAPL + CAPC);
constexpr int NCH = 34;
constexpr float EPS = 1e-6f, LOG2E = 1.4426950408889634f;
constexpr int LDS_BYTES = 147456;

constexpr size_t MiB = 1u << 20;
constexpr size_t WS_ROPEC = 1 * MiB, WS_ROPES = 1 * MiB + 512 * 1024, WS_MODV = 2 * MiB, WS_AFF = 3 * MiB, WS_AFFC = 5 * MiB, WS_INV = 6 * MiB, WS_TOPW = 9 * MiB;
constexpr size_t WS_WTIN = 16 * MiB, WS_WTBR = WS_WTIN + (size_t)6400 * 1024 * 2, WS_WTOUT = WS_WTBR + (size_t)3072 * 512 * 2;
constexpr size_t WS_X = 34 * MiB, WS_H = 170 * MiB, WS_R = 238 * MiB;
constexpr size_t WS_ZA = WS_R, WS_G = WS_R, WS_RS = 459 * MiB, WS_ST = 527 * MiB;
constexpr size_t WS_XS = WS_R, WS_ACT = 374 * MiB, WS_WT1 = 510 * MiB, WS_WT2 = 574 * MiB, WS_END = 606 * MiB;
static_assert(WS_WTOUT + 2 * MiB <= WS_X && WS_ZA + (size_t)M * NZA * 2 <= WS_RS && WS_ST + (size_t)NB * 4 * NCH * 128 * 128 * 2 <= WS_END, "ws map");

struct KP {
    const float *x, *c, *ctx, *c_ctx, *w_mod, *b_mod, *norm1_g, *norm2_g, *w_in, *dec_f, *dec_b, *sgu_w, *sgu_b, *qn_g, *kn_g, *sink, *w_branch, *w_out, *w_router, *w_eg, *w_eu, *w_ed;
    float* out; unsigned char* ws;
};
typedef const __attribute__((address_space(4))) KP* KPC;

#define LDS_WAIT() asm volatile("s_waitcnt lgkmcnt(0)" ::: "memory")
__device__ __forceinline__ unsigned pk2(float lo, float hi) { return pg8::cvt_pk_bf16(lo, hi); }
__device__ __forceinline__ float bflo(unsigned w) { return __uint_as_float(w << 16); }
__device__ __forceinline__ float bfhi(unsigned w) { return __uint_as_float(w & 0xffff0000u); }
__device__ __forceinline__ void unpack8(const u32x4 w, float (&f)[8]) { f[0] = bflo(w.x); f[1] = bfhi(w.x); f[2] = bflo(w.y); f[3] = bfhi(w.y); f[4] = bflo(w.z); f[5] = bfhi(w.z); f[6] = bflo(w.w); f[7] = bfhi(w.w); }
__device__ __forceinline__ u32x4 pack8(const float (&f)[8]) { u32x4 o; o.x = pk2(f[0], f[1]); o.y = pk2(f[2], f[3]); o.z = pk2(f[4], f[5]); o.w = pk2(f[6], f[7]); return o; }
template <int MASK> __device__ __forceinline__ float swz_xor(float v) { static_assert(MASK > 0 && MASK < 32, "swz_xor: 1..31"); return __builtin_bit_cast(float, __builtin_amdgcn_ds_swizzle(__builtin_bit_cast(int, v), 0x1f | (MASK << 10))); }
template <int MASK> __device__ __forceinline__ int swz_xor_i(int v) { return __builtin_amdgcn_ds_swizzle(v, 0x1f | (MASK << 10)); }
__device__ __forceinline__ float sum_x32(float v) { const unsigned u = __builtin_bit_cast(unsigned, v); auto r = __builtin_amdgcn_permlane32_swap(u, u, false, false); return __builtin_bit_cast(float, (unsigned)r[0]) + __builtin_bit_cast(float, (unsigned)r[1]); }
__device__ __forceinline__ float max_x32(float v) { const unsigned u = __builtin_bit_cast(unsigned, v); auto r = __builtin_amdgcn_permlane32_swap(u, u, false, false); return fmaxf(__builtin_bit_cast(float, (unsigned)r[0]), __builtin_bit_cast(float, (unsigned)r[1])); }
__device__ __forceinline__ int sum_x32_i(int v) { auto r = __builtin_amdgcn_permlane32_swap((unsigned)v, (unsigned)v, false, false); return (int)r[0] + (int)r[1]; }
__device__ __forceinline__ float wave_sum(float v) { v += swz_xor<1>(v); v += swz_xor<2>(v); v += swz_xor<4>(v); v += swz_xor<8>(v); v += swz_xor<16>(v); return sum_x32(v); }
__device__ __forceinline__ float wave_max(float v) { v = fmaxf(v, swz_xor<1>(v)); v = fmaxf(v, swz_xor<2>(v)); v = fmaxf(v, swz_xor<4>(v)); v = fmaxf(v, swz_xor<8>(v)); v = fmaxf(v, swz_xor<16>(v)); return max_x32(v); }
__device__ __forceinline__ int wave_sum_i(int v) { v += swz_xor_i<1>(v); v += swz_xor_i<2>(v); v += swz_xor_i<4>(v); v += swz_xor_i<8>(v); v += swz_xor_i<16>(v); return sum_x32_i(v); }
__device__ __forceinline__ float sum_x16_x32(float v) { v += swz_xor<16>(v); return sum_x32(v); }
__device__ __forceinline__ float sum_x1_x2(float v) { v += swz_xor<1>(v); v += swz_xor<2>(v); return v; }
__device__ __forceinline__ float ex2(float x) { return __builtin_amdgcn_exp2f(x); }
__device__ __forceinline__ float sigmoidf_(float x) { return 1.f / (1.f + ex2(-x * LOG2E)); }
__device__ __forceinline__ float gelu_tanh(float x) { const float u = 0.7978845608028654f * (x + 0.044715f * x * x * x); return x / (1.f + ex2(-2.f * LOG2E * u)); }
__device__ __forceinline__ f32x4 mfma16(bf16x8 a, bf16x8 b, f32x4 c) { return __builtin_amdgcn_mfma_f32_16x16x32_bf16(a, b, c, 0, 0, 0); }
__device__ __forceinline__ bf16x8 as_bf16x8(u32x4 w) { return __builtin_bit_cast(bf16x8, w); }
__device__ __forceinline__ float log2_sigmoid(float a) { return -log1pf(__expf(-a)) * LOG2E; }

struct GroupOrder {
    int nG, nM, nN, pmS, pnS, G, c;
    __device__ __forceinline__ bool next(int i, pg8::Unit& u) const {
        const long L = (long)i * G + c; const int tot = nG * nM * nN; if (L >= tot) return false;
        int wgid = (int)L; { const int q = tot / 8, r = tot % 8, xcd = wgid % 8, off = wgid / 8; wgid = (xcd < r ? xcd * (q + 1) : r * (q + 1) + (xcd - r) * q) + off; }
        const int per = nM * nN, g = wgid / per, rem = wgid - g * per;
        const int nig = 8 * nN, gid = rem / nig, fm = gid * 8, gsz = (nM - fm) < 8 ? (nM - fm) : 8;
        u.pm = g * pmS + fm + ((rem % nig) % gsz); u.pn = g * pnS + (rem % nig) / gsz; return true;
    }
    __device__ __forceinline__ void a_ready(const pg8::Unit&) const {}
    __device__ __forceinline__ void done(const pg8::Unit&) const {}
};
struct MergeOrder {
    int nM, G, c;
    __device__ __forceinline__ bool next(int i, pg8::Unit& u) const {
        const int ii = i / 3, g = i - 3 * ii; const long L = (long)ii * G + c; const int tot = nM * 4; if (L >= tot) return false;
        int wgid = (int)L; { const int q = tot / 8, r = tot % 8, xcd = wgid % 8, off = wgid / 8; wgid = (xcd < r ? xcd * (q + 1) : r * (q + 1) + (xcd - r) * q) + off; }
        const int nig = 32, gid = wgid / nig, fm = gid * 8, gsz = (nM - fm) < 8 ? (nM - fm) : 8;
        u.pm = g * (M / 256) + fm + ((wgid % nig) % gsz); u.pn = g * 4 + (wgid % nig) / gsz; return true;
    }
    __device__ __forceinline__ void a_ready(const pg8::Unit&) const {}
    __device__ __forceinline__ void done(const pg8::Unit&) const {}
};

struct EpiZA {
    static constexpr bool PERM = true, AFTER_DRAIN = false, CHAIN = false;
    bf16* O;
    __device__ __forceinline__ void operator()(const f32x4 (&acc)[2][2][4][2], const pg8::Unit& u, int wr, int wc, int fr, int fq) const {
        const int row0 = u.pm * 256 + wr * 64 + fr, col0 = u.pn * 256 + wc * 32 + 8 * fq; const bool act = false;
#pragma unroll
        for (int ai = 0; ai < 2; ++ai)
#pragma unroll
            for (int m = 0; m < 4; ++m) { bf16* rowp = O + (size_t)(row0 + ai * 128 + m * 16) * NZA + col0;
#pragma unroll
                for (int bj = 0; bj < 2; ++bj) { const f32x4 v0 = acc[ai][bj][m][0], v1 = acc[ai][bj][m][1];
                    float o[8] = {v0[0], v0[1], v0[2], v0[3], v1[0], v1[1], v1[2], v1[3]};
                    if (act) {
#pragma unroll
                        for (int k = 0; k < 8; ++k) o[k] = gelu_tanh(o[k]); }
                    *(u32x4*)(rowp + bj * 128) = pack8(o); } }
    }
};
struct EpiSig {
    static constexpr bool PERM = true, AFTER_DRAIN = false, CHAIN = false;
    bf16* O;
    __device__ __forceinline__ void operator()(const f32x4 (&acc)[2][2][4][2], const pg8::Unit& u, int wr, int wc, int fr, int fq) const {
        const int row0 = u.pm * 256 + wr * 64 + fr, col0 = u.pn * 256 + wc * 32 + 8 * fq;
#pragma unroll
        for (int ai = 0; ai < 2; ++ai)
#pragma unroll
            for (int m = 0; m < 4; ++m) { bf16* rowp = O + (size_t)(row0 + ai * 128 + m * 16) * NZG + col0;
#pragma unroll
                for (int bj = 0; bj < 2; ++bj) { const f32x4 v0 = acc[ai][bj][m][0], v1 = acc[ai][bj][m][1];
                    float o[8] = {v0[0], v0[1], v0[2], v0[3], v1[0], v1[1], v1[2], v1[3]};
#pragma unroll
                    for (int k = 0; k < 8; ++k) o[k] = fmaxf(sigmoidf_(o[k]), 1e-20f);
                    *(u32x4*)(rowp + bj * 128) = pack8(o); } }
    }
};
struct EpiMergeChain {
    static constexpr bool PERM = true, AFTER_DRAIN = false, CHAIN = true;
    const bf16* Gt; bf16* Hm;
    __device__ __forceinline__ bool chain(f32x4 (&acc)[2][2][4][2], const pg8::Unit& u, int wr, int wc, int fr, int fq) const {
        const int g = u.pm / (M / 256), m = u.pm - g * (M / 256), n = u.pn - g * 4;
        const int row0 = m * 256 + wr * 64 + fr, col0 = n * 256 + wc * 32 + 8 * fq;
#pragma unroll
        for (int ai = 0; ai < 2; ++ai) {
            u32x4 gw[4][2], hw[4][2];
#pragma unroll
            for (int mm = 0; mm < 4; ++mm)
#pragma unroll
                for (int bj = 0; bj < 2; ++bj) gw[mm][bj] = *(const u32x4*)(Gt + (size_t)(row0 + ai * 128 + mm * 16) * NZG + g * 1024 + col0 + bj * 128);
            if (g < 2) {
#pragma unroll
                for (int mm = 0; mm < 4; ++mm)
#pragma unroll
                    for (int bj = 0; bj < 2; ++bj) hw[mm][bj] = *(const u32x4*)(Gt + (size_t)(row0 + ai * 128 + mm * 16) * NZG + (g + 1) * 1024 + col0 + bj * 128);
            }
#pragma unroll
            for (int mm = 0; mm < 4; ++mm)
#pragma unroll
                for (int bj = 0; bj < 2; ++bj) {
                    float sc[8]; unpack8(gw[mm][bj], sc);
                    if (g < 2) { float sn[8]; unpack8(hw[mm][bj], sn);
#pragma unroll
                        for (int k = 0; k < 8; ++k) sc[k] *= __builtin_amdgcn_rcpf(sn[k]); }
                    f32x4& v0 = acc[ai][bj][mm][0]; f32x4& v1 = acc[ai][bj][mm][1];
                    v0[0] *= sc[0]; v0[1] *= sc[1]; v0[2] *= sc[2]; v0[3] *= sc[3]; v1[0] *= sc[4]; v1[1] *= sc[5]; v1[2] *= sc[6]; v1[3] *= sc[7];
                    if (g == 2) { u32x4 w; w.x = pk2(v0[0], v0[1]); w.y = pk2(v0[2], v0[3]); w.z = pk2(v1[0], v1[1]); w.w = pk2(v1[2], v1[3]);
                        *(u32x4*)(Hm + (size_t)(row0 + ai * 128 + mm * 16) * 1024 + col0 + bj * 128) = w; }
                }
        }
        return g < 2;
    }
};
struct EpiOut {
    static constexpr bool PERM = true, AFTER_DRAIN = false, CHAIN = false;
    const float* xl; const float* xc; bf16* X; const float* modv; int from_f32;
    __device__ __forceinline__ void operator()(const f32x4 (&acc)[2][2][4][2], const pg8::Unit& u, int wr, int wc, int fr, int fq) const {
        const int row0 = u.pm * 256 + wr * 64 + fr, col0 = u.pn * 256 + wc * 32 + 8 * fq;
        const int bi = (u.pm * 256 < ML) ? ((u.pm * 256) >> 12) : 8;
        const float* g1 = modv + bi * 6144 + 2 * 1024;
        f32x4 gv[2][2];
#pragma unroll
        for (int bj = 0; bj < 2; ++bj) { gv[bj][0] = *(const f32x4*)(g1 + col0 + bj * 128); gv[bj][1] = *(const f32x4*)(g1 + col0 + bj * 128 + 4); }
        if (from_f32) {
            const float* src0 = (u.pm * 256 < ML) ? xl + (size_t)row0 * 1024 : xc + (size_t)(row0 - ML) * 1024;
#pragma unroll
            for (int ai = 0; ai < 2; ++ai) {
                f32x4 xv[4][2][2];
#pragma unroll
                for (int m = 0; m < 4; ++m)
#pragma unroll
                    for (int bj = 0; bj < 2; ++bj) { const float* s = src0 + (size_t)(ai * 128 + m * 16) * 1024 + col0 + bj * 128; xv[m][bj][0] = *(const f32x4*)s; xv[m][bj][1] = *(const f32x4*)(s + 4); }
#pragma unroll
                for (int m = 0; m < 4; ++m)
#pragma unroll
                    for (int bj = 0; bj < 2; ++bj) { const f32x4 o0 = xv[m][bj][0] + gv[bj][0] * acc[ai][bj][m][0], o1 = xv[m][bj][1] + gv[bj][1] * acc[ai][bj][m][1];
                        u32x4 w; w.x = pk2(o0[0], o0[1]); w.y = pk2(o0[2], o0[3]); w.z = pk2(o1[0], o1[1]); w.w = pk2(o1[2], o1[3]);
                        *(u32x4*)(X + (size_t)(row0 + ai * 128 + m * 16) * 1024 + col0 + bj * 128) = w; }
            }
        } else {
#pragma unroll
            for (int ai = 0; ai < 2; ++ai) {
                u32x4 xw[4][2];
#pragma unroll
                for (int m = 0; m < 4; ++m)
#pragma unroll
                    for (int bj = 0; bj < 2; ++bj) xw[m][bj] = *(const u32x4*)(X + (size_t)(row0 + ai * 128 + m * 16) * 1024 + col0 + bj * 128);
#pragma unroll
                for (int m = 0; m < 4; ++m)
#pragma unroll
                    for (int bj = 0; bj < 2; ++bj) { float xo[8]; unpack8(xw[m][bj], xo); const f32x4 a0 = acc[ai][bj][m][0], a1 = acc[ai][bj][m][1];
                        float o[8] = {xo[0] + gv[bj][0][0] * a0[0], xo[1] + gv[bj][0][1] * a0[1], xo[2] + gv[bj][0][2] * a0[2], xo[3] + gv[bj][0][3] * a0[3],
                                      xo[4] + gv[bj][1][0] * a1[0], xo[5] + gv[bj][1][1] * a1[1], xo[6] + gv[bj][1][2] * a1[2], xo[7] + gv[bj][1][3] * a1[3]};
                        *(u32x4*)(X + (size_t)(row0 + ai * 128 + m * 16) * 1024 + col0 + bj * 128) = pack8(o); }
            }
        }
    }
};
struct EpiMoe1 {
    static constexpr bool PERM = true, AFTER_DRAIN = false, CHAIN = false;
    bf16* ACT;
    __device__ __forceinline__ void operator()(const f32x4 (&acc)[2][2][4][2], const pg8::Unit& u, int wr, int wc, int fr, int fq) const {
        const int row0 = u.pm * 256 + wr * 64 + fr, col0 = (u.pn & 7) * 128 + wc * 32 + 8 * fq;
#pragma unroll
        for (int ai = 0; ai < 2; ++ai)
#pragma unroll
            for (int m = 0; m < 4; ++m) { const size_t r = (size_t)(row0 + ai * 128 + m * 16);
                const f32x4 a0 = acc[ai][0][m][0], a1 = acc[ai][0][m][1], u0 = acc[ai][1][m][0], u1 = acc[ai][1][m][1];
                float o[8];
#pragma unroll
                for (int k = 0; k < 4; ++k) { o[k] = a0[k] * sigmoidf_(a0[k]) * u0[k]; o[4 + k] = a1[k] * sigmoidf_(a1[k]) * u1[k]; }
                *(u32x4*)(ACT + r * 1024 + col0) = pack8(o); }
    }
};
struct EpiMoe2 {
    static constexpr bool PERM = true, AFTER_DRAIN = false, CHAIN = false;
    bf16* Y; const float* topw;
    __device__ __forceinline__ void operator()(const f32x4 (&acc)[2][2][4][2], const pg8::Unit& u, int wr, int wc, int fr, int fq) const {
        const int row0 = u.pm * 256 + wr * 64 + fr, col0 = (u.pn & 3) * 256 + wc * 32 + 8 * fq;
        float twv[2][4];
#pragma unroll
        for (int ai = 0; ai < 2; ++ai)
#pragma unroll
            for (int m = 0; m < 4; ++m) twv[ai][m] = topw[row0 + ai * 128 + m * 16];
#pragma unroll
        for (int ai = 0; ai < 2; ++ai)
#pragma unroll
            for (int m = 0; m < 4; ++m) { const size_t r = (size_t)(row0 + ai * 128 + m * 16); const float tw = twv[ai][m];
#pragma unroll
                for (int bj = 0; bj < 2; ++bj) { const f32x4 v0 = acc[ai][bj][m][0] * tw, v1 = acc[ai][bj][m][1] * tw;
                    u32x4 w; w.x = pk2(v0[0], v0[1]); w.y = pk2(v0[2], v0[3]); w.z = pk2(v1[0], v1[1]); w.w = pk2(v1[2], v1[3]);
                    *(u32x4*)(Y + r * 1024 + col0 + bj * 128) = w; } }
    }
};

__device__ __forceinline__ void tr_item(const float* W, int N, int k0, int n0, bf16* dst, int K, LAS float* scr, int lane) {
#pragma unroll 8
    for (int i = 0; i < 32; ++i) { const int kk = 2 * i + (lane >> 5); scr[kk * 33 + (lane & 31)] = W[(size_t)(k0 + kk) * N + n0 + (lane & 31)]; }
    LDS_WAIT();
    const int cc = lane & 7;
#pragma unroll
    for (int j = 0; j < 4; ++j) { const int n = (lane >> 3) + 8 * j; const LAS float* s = scr + (8 * cc) * 33 + n;
        u32x4 o; o.x = pk2(s[0 * 33], s[1 * 33]); o.y = pk2(s[2 * 33], s[3 * 33]); o.z = pk2(s[4 * 33], s[5 * 33]); o.w = pk2(s[6 * 33], s[7 * 33]);
        *(u32x4*)(dst + (size_t)n * K + 8 * cc) = o; }
    LDS_WAIT();
}
__device__ __forceinline__ void convert_small(KPC p, int l, LAS unsigned char* lds, int lane, int wave, int bid, int G) {
    LAS float* scr = (LAS float*)(lds + wave * 8448);
    const int gw = bid * 8 + wave, NGW = G * 8;
    constexpr int I_IN = 16 * 200, I_BR = 8 * 32, I_OUT = 16 * 32;
    bf16* wtin = (bf16*)(p->ws + WS_WTIN); bf16* wtbr = (bf16*)(p->ws + WS_WTBR); bf16* wtout = (bf16*)(p->ws + WS_WTOUT);
    for (int it = gw; it < I_IN + 3 * I_BR + I_OUT; it += NGW) {
        int r = it;
        if (r < I_IN) { const int kb = r / 200, nb = r % 200; tr_item(p->w_in + (size_t)l * 1024 * 6400, 6400, 64 * kb, 32 * nb, wtin + (size_t)(32 * nb) * 1024 + 64 * kb, 1024, scr, lane); continue; }
        r -= I_IN;
        if (r < 3 * I_BR) { const int br = r / I_BR, q = r % I_BR, kb = q / 32, nb = q % 32;
            tr_item(p->w_branch + ((size_t)l * 3 + br) * 512 * 1024, 1024, 64 * kb, 32 * nb, wtbr + (size_t)(br * 1024 + 32 * nb) * 512 + 64 * kb, 512, scr, lane); continue; }
        r -= 3 * I_BR;
        { const int kb = r / 32, nb = r % 32; tr_item(p->w_out + (size_t)l * 1024 * 1024, 1024, 64 * kb, 32 * nb, wtout + (size_t)(32 * nb) * 1024 + 64 * kb, 1024, scr, lane); }
    }
}
__device__ __forceinline__ void convert_experts(KPC p, int l, int lo, int hi, int widx, int nw, LAS unsigned char* lds, int lane, int wave) {
    LAS float* scr = (LAS float*)(lds + wave * 8448);
    bf16* wt1 = (bf16*)(p->ws + WS_WT1); bf16* wt2 = (bf16*)(p->ws + WS_WT2);
    for (int it = lo + widx; it < hi; it += nw) {
        const int e = it / 1536, q = it % 1536, which = q / 512, qq = q % 512, kb = qq / 32, nb = qq % 32, n0 = 32 * nb, k0 = 64 * kb;
        const size_t woff = ((size_t)l * NE + e) * 1024 * 1024;
        if (which == 0) tr_item(p->w_eg + woff, 1024, k0, n0, wt1 + ((size_t)e * 2048 + (n0 >> 7) * 256 + (n0 & 127)) * 1024 + k0, 1024, scr, lane);
        else if (which == 1) tr_item(p->w_eu + woff, 1024, k0, n0, wt1 + ((size_t)e * 2048 + (n0 >> 7) * 256 + 128 + (n0 & 127)) * 1024 + k0, 1024, scr, lane);
        else tr_item(p->w_ed + woff, 1024, k0, n0, wt2 + ((size_t)e * 1024 + n0) * 1024 + k0, 1024, scr, lane);
    }
}
constexpr int CVT_ITEMS = NE * 3 * 512;
constexpr int CVT_G_IDLE0 = 96, CVT_M_IDLE0 = 32, CVT_O_IDLE0 = 32;
constexpr int CVT_G_HI = 7680, CVT_M_HI = 7680 + 14336;

__device__ __forceinline__ void phase_prep(KPC p, LAS unsigned char* lds, int tid, int lane, int wave, int bid, int G) {
    unsigned char* ws = p->ws;
    {   float* rc = (float*)(ws + WS_ROPEC); float* rsn = (float*)(ws + WS_ROPES);
        for (int i = bid * 512 + tid; i < T * 32; i += G * 512) { const int t = i >> 5, f = i & 31; const int pos = (f < 16) ? (t >> 6) : (t & 63); const int fi = f & 15;
            const float inv = ex2(-(float)fi * (13.287712379549449f / 16.f));
            float ang = (float)pos * inv; ang -= 6.283185307179586f * rintf(ang * 0.15915494309189535f);
            rc[i] = __cosf(ang); rsn[i] = __sinf(ang); } }
    {   LAS float* sv = (LAS float*)lds;
        LAS float* red = (LAS float*)(lds + 36864);
        for (int i = tid; i < 9 * 1024; i += 512) { const int r = i >> 10, k = i & 1023; const float v = (r < 8) ? p->c[r * 1024 + k] : p->c_ctx[k]; sv[i] = v * sigmoidf_(v); }
        __syncthreads();
        for (int it = bid; it < 192; it += G) {
            const int l = it / 96, n0 = (it % 96) * 64;
            const float* W = p->w_mod + (size_t)l * 1024 * 6144 + n0 + lane;
            float acc[9];
#pragma unroll
            for (int r = 0; r < 9; ++r) acc[r] = 0.f;
#pragma unroll 1
            for (int k0 = wave * 128; k0 < wave * 128 + 128; k0 += 16) {
                float wv[16];
#pragma unroll
                for (int kk = 0; kk < 16; ++kk) wv[kk] = W[(size_t)(k0 + kk) * 6144];
#pragma unroll
                for (int kk = 0; kk < 16; ++kk)
#pragma unroll
                    for (int r = 0; r < 9; ++r) acc[r] += sv[r * 1024 + k0 + kk] * wv[kk]; }
#pragma unroll
            for (int r = 0; r < 9; ++r) red[(wave * 9 + r) * 64 + lane] = acc[r];
            __syncthreads();
            for (int i = tid; i < 576; i += 512) { const int r = i >> 6, ln = i & 63; float s = 0.f;
#pragma unroll
                for (int w = 0; w < 8; ++w) s += red[(w * 9 + r) * 64 + ln];
                s += p->b_mod[l * 6144 + n0 + ln]; ((float*)(ws + WS_MODV))[(l * 9 + r) * 6144 + n0 + ln] = s; }
            __syncthreads();
        }
    }
    __syncthreads();
    convert_small(p, 0, lds, lane, wave, bid, G);
}

__device__ __forceinline__ float row_rs(const f32x4 (&v)[4]) {
    float ss = 0.f;
#pragma unroll
    for (int j = 0; j < 4; ++j) ss += (v[j].x * v[j].x + v[j].y * v[j].y) + (v[j].z * v[j].z + v[j].w * v[j].w);
    return 1.0f / sqrtf(wave_sum(ss) * (1.f / 1024.f) + EPS);
}
__device__ __forceinline__ void norm_mod(const f32x4 (&v)[4], float rs, const float* gain, const float* sh, const float* sc, f32x4 (&h)[4], int lane) {
#pragma unroll
    for (int j = 0; j < 4; ++j) { const int col = 4 * lane + 256 * j; const f32x4 g = *(const f32x4*)(gain + col), a = *(const f32x4*)(sc + col), b = *(const f32x4*)(sh + col);
        h[j] = (v[j] * rs) * g * (a + 1.0f) + b; }
}
__device__ __forceinline__ void store_h(const f32x4 (&h)[4], bf16* hrow, int lane) {
#pragma unroll
    for (int j = 0; j < 4; ++j) { u32x2 w; w.x = pk2(h[j].x, h[j].y); w.y = pk2(h[j].z, h[j].w); *(u32x2*)(hrow + 4 * lane + 256 * j) = w; }
}
__device__ __forceinline__ void phase_norm_in(KPC p, int lane, int wave, int bid, int G) {
    const float* modv = (const float*)(p->ws + WS_MODV); bf16* H = (bf16*)(p->ws + WS_H);
    const int stride = G * 8; int r = bid * 8 + wave;
    f32x4 vn[4];
    {   const float* src = (r < ML) ? p->x + (size_t)r * 1024 : p->ctx + (size_t)(r - ML) * 1024;
#pragma unroll
        for (int j = 0; j < 4; ++j) vn[j] = (r < M) ? *(const f32x4*)(src + 4 * lane + 256 * j) : (f32x4){0.f, 0.f, 0.f, 0.f}; }
    for (; r < M; r += stride) {
        const int bi = (r < ML) ? (r >> 12) : 8; const float* mv = modv + bi * 6144;
        f32x4 v[4], h[4], g[4], sc[4], sh[4];
#pragma unroll
        for (int j = 0; j < 4; ++j) { v[j] = vn[j]; const int col = 4 * lane + 256 * j; g[j] = *(const f32x4*)(p->norm1_g + col); sh[j] = *(const f32x4*)(mv + col); sc[j] = *(const f32x4*)(mv + 1024 + col); }
        const int rn = r + stride;
        if (rn < M) { const float* src = (rn < ML) ? p->x + (size_t)rn * 1024 : p->ctx + (size_t)(rn - ML) * 1024;
#pragma unroll
            for (int j = 0; j < 4; ++j) vn[j] = *(const f32x4*)(src + 4 * lane + 256 * j); }
        const float rs = row_rs(v);
#pragma unroll
        for (int j = 0; j < 4; ++j) h[j] = (v[j] * rs) * g[j] * (sc[j] + 1.0f) + sh[j];
        store_h(h, H + (size_t)r * 1024, lane);
    }
}

__device__ __forceinline__ void ld8f(const float* p, float (&f)[8]) { const f32x4 a = *(const f32x4*)p, b = *(const f32x4*)(p + 4); f[0] = a[0]; f[1] = a[1]; f[2] = a[2]; f[3] = a[3]; f[4] = b[0]; f[5] = b[1]; f[6] = b[2]; f[7] = b[3]; }
__device__ __forceinline__ void att_item(KPC p, int l, LAS unsigned char* lds, int item, float Mb2, int tid, int lane, int wave) {
    const bf16* ZA = (const bf16*)(p->ws + WS_ZA); bf16* BR = (bf16*)p->out + (size_t)2 * M * 512;
    const float* rc = (const float*)(p->ws + WS_ROPEC); const float* rsn = (const float*)(p->ws + WS_ROPES);
    const bool isctx = item >= 512;
    int b, kvh, qb;
    if (!isctx) { b = item >> 6; kvh = (item >> 5) & 1; qb = item & 31; } else { const int ci = item - 512; b = ci >> 2; kvh = (ci >> 1) & 1; qb = ci & 1; }
    const int rowbase = isctx ? ML + b * CL : b * T;
    const int g = wave >> 1, qs = wave & 1, hh = kvh * 4 + g, c = lane & 15, g4 = lane >> 4, q0 = qb * 128 + qs * 64;
    const float* qg = p->qn_g + l * 64; const float* kg = p->kn_g + l * 64;
    LAS unsigned char* Kl = lds; LAS unsigned char* Vt = lds + 18432;
    bf16x8 qf[4][2];
    float qga[8], qgb[8]; ld8f(qg + 8 * g4, qga); ld8f(qg + 32 + 8 * g4, qgb);
#pragma unroll
    for (int ti = 0; ti < 4; ++ti) {
        const int pos = q0 + 16 * ti + c; const bf16* src = ZA + (size_t)(rowbase + pos) * NZA + C_AQ + hh * 64 + 8 * g4;
        float a[8], bb[8]; unpack8(*(const u32x4*)src, a); unpack8(*(const u32x4*)(src + 32), bb);
        float ss = 0.f;
#pragma unroll
        for (int j = 0; j < 8; ++j) ss += a[j] * a[j] + bb[j] * bb[j];
        ss = sum_x16_x32(ss);
        const float rs = 1.0f / sqrtf(ss * (1.f / 64.f) + EPS);
#pragma unroll
        for (int j = 0; j < 8; ++j) { a[j] *= rs * qga[j]; bb[j] *= rs * qgb[j]; }
        if (!isctx) { float cs8[8], sn8[8]; ld8f(rc + pos * 32 + 8 * g4, cs8); ld8f(rsn + pos * 32 + 8 * g4, sn8);
#pragma unroll
            for (int j = 0; j < 8; ++j) { const float cs = cs8[j], sn = sn8[j]; const float x1 = a[j], x2 = bb[j]; a[j] = x1 * cs - x2 * sn; bb[j] = x1 * sn + x2 * cs; } }
#pragma unroll
        for (int j = 0; j < 8; ++j) { a[j] *= 0.125f * LOG2E; bb[j] *= 0.125f * LOG2E; }
        qf[ti][0] = as_bf16x8(pack8(a)); qf[ti][1] = as_bf16x8(pack8(bb));
        __builtin_amdgcn_sched_barrier(0);
    }
    f32x4 O[4][4]; float lsum[4];
#pragma unroll
    for (int i = 0; i < 4; ++i) { lsum[i] = 0.f;
#pragma unroll
        for (int j = 0; j < 4; ++j) O[i][j] = (f32x4){0.f, 0.f, 0.f, 0.f}; }
    float kga[8], kgb[8]; ld8f(kg + 8 * (tid & 3), kga); ld8f(kg + 32 + 8 * (tid & 3), kgb);
    const int ntile = isctx ? 2 : 5;
    for (int kt = 0; kt < ntile; ++kt) {
        int krow0, kpos0 = 0, mode = 0; bool local = false;
        if (isctx) krow0 = ML + b * CL + 128 * kt;
        else if (kt < 3) { const int kb = qb - 1 + kt; if (kb < 0 || kb > 31) continue; krow0 = b * T + kb * 128; kpos0 = kb * 128; local = true; mode = (kt == 0) ? 1 : ((kt == 2) ? 2 : 0); }
        else krow0 = ML + b * CL + 128 * (kt - 3);
        __syncthreads();
        {
            const int key = tid >> 2, q4 = tid & 3; const bf16* src = ZA + (size_t)(krow0 + key) * NZA + C_AK + kvh * 64 + 8 * q4;
            float a[8], bb[8]; unpack8(*(const u32x4*)src, a); unpack8(*(const u32x4*)(src + 32), bb);
            float ss = 0.f;
#pragma unroll
            for (int j = 0; j < 8; ++j) ss += a[j] * a[j] + bb[j] * bb[j];
            ss = sum_x1_x2(ss);
            const float rs = 1.0f / sqrtf(ss * (1.f / 64.f) + EPS);
#pragma unroll
            for (int j = 0; j < 8; ++j) { a[j] *= rs * kga[j]; bb[j] *= rs * kgb[j]; }
            if (local) { const int pos = kpos0 + key; float cs8[8], sn8[8]; ld8f(rc + pos * 32 + 8 * q4, cs8); ld8f(rsn + pos * 32 + 8 * q4, sn8);
#pragma unroll
                for (int j = 0; j < 8; ++j) { const float cs = cs8[j], sn = sn8[j]; const float x1 = a[j], x2 = bb[j]; a[j] = x1 * cs - x2 * sn; bb[j] = x1 * sn + x2 * cs; } }
            *(LAS u32x4*)(Kl + key * 144 + 16 * q4) = pack8(a); *(LAS u32x4*)(Kl + key * 144 + 64 + 16 * q4) = pack8(bb);
            const bf16* vs = ZA + (size_t)(krow0 + key) * NZA + C_AV + kvh * 64 + 16 * q4;
            const u32x4 v0 = *(const u32x4*)vs, v1 = *(const u32x4*)(vs + 8);
            const unsigned vw[8] = {v0.x, v0.y, v0.z, v0.w, v1.x, v1.y, v1.z, v1.w};
#pragma unroll
            for (int j = 0; j < 8; ++j) { *(LAS unsigned short*)(Vt + (16 * q4 + 2 * j) * 272 + key * 2) = (unsigned short)(vw[j] & 0xffffu); *(LAS unsigned short*)(Vt + (16 * q4 + 2 * j + 1) * 272 + key * 2) = (unsigned short)(vw[j] >> 16); }
        }
        __syncthreads();
#pragma unroll 1
        for (int kk = 0; kk < 4; ++kk) {
            if ((mode == 1 && 32 * kk + 31 < qs * 64) || (mode == 2 && 32 * kk > qs * 64 + 63)) continue;
            bf16x8 ka[2][2];
#pragma unroll
            for (int hf = 0; hf < 2; ++hf)
#pragma unroll
                for (int ks = 0; ks < 2; ++ks) ka[hf][ks] = *(const LAS bf16x8*)(Kl + (32 * kk + 16 * hf + c) * 144 + ks * 64 + g4 * 16);
            bf16x8 pf[4];
#pragma unroll
            for (int ti = 0; ti < 4; ++ti) {
                f32x4 sa = (f32x4){-Mb2, -Mb2, -Mb2, -Mb2}, sb = sa;
                sa = mfma16(ka[0][0], qf[ti][0], sa); sa = mfma16(ka[0][1], qf[ti][1], sa);
                sb = mfma16(ka[1][0], qf[ti][0], sb); sb = mfma16(ka[1][1], qf[ti][1], sb);
                float pa[4], pb[4];
#pragma unroll
                for (int rr = 0; rr < 4; ++rr) { pa[rr] = ex2(sa[rr]); pb[rr] = ex2(sb[rr]); }
                if (mode != 0) {
                    const int ii = qs * 64 + 16 * ti + c; const int mlo = (mode == 1) ? ii : -1000, mhi = (mode == 2) ? ii : 1000;
#pragma unroll
                    for (int rr = 0; rr < 4; ++rr) { const int ja = 32 * kk + 4 * g4 + rr, jb = ja + 16;
                        pa[rr] = (ja >= mlo && ja <= mhi) ? pa[rr] : 0.f; pb[rr] = (jb >= mlo && jb <= mhi) ? pb[rr] : 0.f; } }
                lsum[ti] += ((pa[0] + pa[1]) + (pa[2] + pa[3])) + ((pb[0] + pb[1]) + (pb[2] + pb[3]));
                u32x4 w; w.x = pk2(pa[0], pa[1]); w.y = pk2(pa[2], pa[3]); w.z = pk2(pb[0], pb[1]); w.w = pk2(pb[2], pb[3]); pf[ti] = as_bf16x8(w);
            }
#pragma unroll
            for (int dt = 0; dt < 4; ++dt) {
                const u32x2 v0 = *(const LAS u32x2*)(Vt + (16 * dt + c) * 272 + (32 * kk + 4 * g4) * 2), v1 = *(const LAS u32x2*)(Vt + (16 * dt + c) * 272 + (32 * kk + 16 + 4 * g4) * 2);
                u32x4 vv; vv.x = v0.x; vv.y = v0.y; vv.z = v1.x; vv.w = v1.y; const bf16x8 va = as_bf16x8(vv);
#pragma unroll
                for (int ti = 0; ti < 4; ++ti) O[dt][ti] = mfma16(va, pf[ti], O[dt][ti]);
            }
        }
    }
    const float sk = ex2(p->sink[l * 8 + hh] * LOG2E - Mb2);
#pragma unroll
    for (int ti = 0; ti < 4; ++ti) { float lt = sum_x16_x32(lsum[ti]); const float inv = 1.0f / (lt + sk);
        bf16* dst = BR + (size_t)(rowbase + q0 + 16 * ti + c) * 512 + hh * 64 + 4 * g4;
#pragma unroll
        for (int dt = 0; dt < 4; ++dt) { const f32x4 o = O[dt][ti] * inv; u32x2 w; w.x = pk2(o[0], o[1]); w.y = pk2(o[2], o[3]); *(u32x2*)(dst + 16 * dt) = w; } }
    __syncthreads();
}

__device__ __forceinline__ void sgu_vprep_item(KPC p, int ch, int tid) {
    bf16* ZA = (bf16*)(p->ws + WS_ZA);
    const int seg = tid & 15;
    bf16* rowp0 = ZA + (size_t)(ch * 128 + (tid >> 4)) * NZA + C_SV + 32 * seg;
    u32x4 raw[4][4];
#pragma unroll
    for (int ps = 0; ps < 4; ++ps)
#pragma unroll
        for (int q = 0; q < 4; ++q) raw[ps][q] = *(const u32x4*)(rowp0 + (size_t)ps * 32 * NZA + 8 * q);
#pragma unroll
    for (int ps = 0; ps < 4; ++ps) {
        bf16* rowp = rowp0 + (size_t)ps * 32 * NZA;
        float f[4][8]; float s = 0.f, ss = 0.f;
#pragma unroll
        for (int q = 0; q < 4; ++q) unpack8(raw[ps][q], f[q]);
#pragma unroll
        for (int q = 0; q < 4; ++q)
#pragma unroll
            for (int e = 0; e < 8; ++e) { const float y = gelu_tanh(f[q][e]); f[q][e] = y; s += y; ss += y * y; }
        s += swz_xor<1>(s); s += swz_xor<2>(s); s += swz_xor<4>(s); s += swz_xor<8>(s);
        ss += swz_xor<1>(ss); ss += swz_xor<2>(ss); ss += swz_xor<4>(ss); ss += swz_xor<8>(ss);
        const float mean = s * (1.f / 512.f), var = fmaxf(ss * (1.f / 512.f) - mean * mean, 0.f), rstd = 1.0f / sqrtf(var + EPS);
#pragma unroll
        for (int q = 0; q < 4; ++q) {
#pragma unroll
            for (int e = 0; e < 8; ++e) f[q][e] = (f[q][e] - mean) * rstd;
            *(u32x4*)(rowp + 8 * q) = pack8(f[q]); }
    }
}
__device__ __forceinline__ void sgu_item(KPC p, int l, LAS unsigned char* lds, int item, int tid, int lane, int wave) {
    const bf16* ZA = (const bf16*)(p->ws + WS_ZA); bf16* BR = (bf16*)p->out + (size_t)1 * M * 512;
    const int ch = item >> 2, g = item & 3, r0 = ch * 128, c = lane & 15, g4 = lane >> 4;
    LAS unsigned char* vT = lds;
    LAS unsigned char* WL = lds + 34816;
    {   const int j = tid >> 2, q4 = tid & 3; const bf16* src = ZA + (size_t)(r0 + j) * NZA + C_SV + 128 * g + 32 * q4;
#pragma unroll
        for (int q = 0; q < 4; ++q) { const u32x4 v = *(const u32x4*)(src + 8 * q); const unsigned vw[4] = {v.x, v.y, v.z, v.w};
#pragma unroll
            for (int e = 0; e < 4; ++e) { *(LAS unsigned short*)(vT + (32 * q4 + 8 * q + 2 * e) * 272 + j * 2) = (unsigned short)(vw[e] & 0xffffu); *(LAS unsigned short*)(vT + (32 * q4 + 8 * q + 2 * e + 1) * 272 + j * 2) = (unsigned short)(vw[e] >> 16); } }
        const float* wsrc = p->sgu_w + ((size_t)(l * 4 + g) * 128 + (tid >> 2)) * 128 + 32 * (tid & 3);
#pragma unroll
        for (int q = 0; q < 4; ++q) { const f32x4 a = *(const f32x4*)(wsrc + 8 * q), bq = *(const f32x4*)(wsrc + 8 * q + 4);
            u32x4 w; w.x = pk2(a.x, a.y); w.y = pk2(a.z, a.w); w.z = pk2(bq.x, bq.y); w.w = pk2(bq.z, bq.w);
            *(LAS u32x4*)(WL + (tid >> 2) * 272 + (32 * (tid & 3) + 8 * q) * 2) = w; }
    }
    __syncthreads();
    bf16x8 af[4];
#pragma unroll
    for (int ks = 0; ks < 4; ++ks) af[ks] = *(const LAS bf16x8*)(vT + (16 * wave + c) * 272 + (32 * ks + 8 * g4) * 2);
    const int col = 128 * g + 16 * wave + 4 * g4;
    u32x2 uw[8]; float bias[8];
#pragma unroll
    for (int ti = 0; ti < 8; ++ti) { uw[ti] = *(const u32x2*)(ZA + (size_t)(r0 + 16 * ti + c) * NZA + C_SU + col); bias[ti] = p->sgu_b[(l * 4 + g) * 128 + 16 * ti + c]; }
#pragma unroll
    for (int ti = 0; ti < 8; ++ti) {
        f32x4 acc = (f32x4){0.f, 0.f, 0.f, 0.f};
#pragma unroll
        for (int ks = 0; ks < 4; ++ks) acc = mfma16(af[ks], *(const LAS bf16x8*)(WL + (16 * ti + c) * 272 + (32 * ks + 8 * g4) * 2), acc);
        const float o0 = gelu_tanh(bflo(uw[ti].x)) * (acc[0] + bias[ti]), o1 = gelu_tanh(bfhi(uw[ti].x)) * (acc[1] + bias[ti]), o2 = gelu_tanh(bflo(uw[ti].y)) * (acc[2] + bias[ti]), o3 = gelu_tanh(bfhi(uw[ti].y)) * (acc[3] + bias[ti]);
        u32x2 w; w.x = pk2(o0, o1); w.y = pk2(o2, o3); *(u32x2*)(BR + (size_t)(r0 + 16 * ti + c) * 512 + col) = w;
    }
    __syncthreads();
}

__device__ __forceinline__ void ret_load_k(KPC p, const bf16* ZA, int r0, int h, bool latent, int pos0, int tid, float (&a)[8], float (&bb)[8]) {
    const int j = tid >> 2, q4 = tid & 3; const bf16* src = ZA + (size_t)(r0 + j) * NZA + C_RK + 64 * h + 8 * q4;
    unpack8(*(const u32x4*)src, a); unpack8(*(const u32x4*)(src + 32), bb);
    if (latent) { const float* rc = (const float*)(p->ws + WS_ROPEC); const float* rsn = (const float*)(p->ws + WS_ROPES); const int pos = pos0 + j; float cs8[8], sn8[8]; ld8f(rc + pos * 32 + 8 * q4, cs8); ld8f(rsn + pos * 32 + 8 * q4, sn8);
#pragma unroll
        for (int e = 0; e < 8; ++e) { const float cs = cs8[e], sn = sn8[e]; const float x1 = a[e], x2 = bb[e]; a[e] = x1 * cs - x2 * sn; bb[e] = x1 * sn + x2 * cs; } }
#pragma unroll
    for (int e = 0; e < 8; ++e) { a[e] *= 0.125f; bb[e] *= 0.125f; }
}
__device__ __forceinline__ void ret_stage_vT(const bf16* ZA, int r0, int h, LAS unsigned char* vT, int tid) {
    const int j = tid >> 2, q4 = tid & 3; const bf16* src = ZA + (size_t)(r0 + j) * NZA + C_RV + 128 * h + 32 * q4;
#pragma unroll
    for (int q = 0; q < 4; ++q) { const u32x4 v = *(const u32x4*)(src + 8 * q); const unsigned vw[4] = {v.x, v.y, v.z, v.w};
#pragma unroll
        for (int e = 0; e < 4; ++e) { *(LAS unsigned short*)(vT + (32 * q4 + 8 * q + 2 * e) * 272 + j * 2) = (unsigned short)(vw[e] & 0xffffu); *(LAS unsigned short*)(vT + (32 * q4 + 8 * q + 2 * e + 1) * 272 + j * 2) = (unsigned short)(vw[e] >> 16); } }
}
__device__ __forceinline__ void ret_upd_item(KPC p, int l, LAS unsigned char* lds, int item, int tid, int lane, int wave) {
    const bf16* ZA = (const bf16*)(p->ws + WS_ZA); float* RS = (float*)(p->ws + WS_RS);
    const int b = item / (NCH * 4), rem = item % (NCH * 4), n = rem >> 2, h = rem & 3, c = lane & 15, g4 = lane >> 4;
    const bool latent = n < 32; const int r0 = latent ? b * T + 128 * n : ML + b * CL + 128 * (n - 32);
    const float lgf = log2_sigmoid(p->dec_f[l * 4 + h]), lgb = log2_sigmoid(p->dec_b[l * 4 + h]);
    LAS unsigned char* vT = lds; LAS unsigned char* kTf = lds + 34816; LAS unsigned char* kTb = lds + 34816 + 17408;
    {   float a[8], bb[8]; ret_load_k(p, ZA, r0, h, latent, 128 * n, tid, a, bb);
        const int j = tid >> 2, q4 = tid & 3; const float wf = ex2((float)(127 - j) * lgf), wb = ex2((float)j * lgb);
#pragma unroll
        for (int e = 0; e < 8; e += 2) {
            unsigned w = pk2(a[e] * wf, a[e + 1] * wf); *(LAS unsigned short*)(kTf + (8 * q4 + e) * 272 + j * 2) = (unsigned short)(w & 0xffffu); *(LAS unsigned short*)(kTf + (8 * q4 + e + 1) * 272 + j * 2) = (unsigned short)(w >> 16);
            w = pk2(bb[e] * wf, bb[e + 1] * wf); *(LAS unsigned short*)(kTf + (32 + 8 * q4 + e) * 272 + j * 2) = (unsigned short)(w & 0xffffu); *(LAS unsigned short*)(kTf + (32 + 8 * q4 + e + 1) * 272 + j * 2) = (unsigned short)(w >> 16);
            w = pk2(a[e] * wb, a[e + 1] * wb); *(LAS unsigned short*)(kTb + (8 * q4 + e) * 272 + j * 2) = (unsigned short)(w & 0xffffu); *(LAS unsigned short*)(kTb + (8 * q4 + e + 1) * 272 + j * 2) = (unsigned short)(w >> 16);
            w = pk2(bb[e] * wb, bb[e + 1] * wb); *(LAS unsigned short*)(kTb + (32 + 8 * q4 + e) * 272 + j * 2) = (unsigned short)(w & 0xffffu); *(LAS unsigned short*)(kTb + (32 + 8 * q4 + e + 1) * 272 + j * 2) = (unsigned short)(w >> 16);
        }
        ret_stage_vT(ZA, r0, h, vT, tid);
    }
    __syncthreads();
    bf16x8 af[4];
#pragma unroll
    for (int ks = 0; ks < 4; ++ks) af[ks] = *(const LAS bf16x8*)(vT + (16 * wave + c) * 272 + (32 * ks + 8 * g4) * 2);
#pragma unroll
    for (int dir = 0; dir < 2; ++dir) { const LAS unsigned char* kT = dir ? kTb : kTf;
        float* dst = RS + ((size_t)(((b * 4 + h) * 2 + dir) * NCH + n) * 128 + 16 * wave + 4 * g4) * 64;
#pragma unroll
        for (int dt = 0; dt < 4; ++dt) { f32x4 acc = (f32x4){0.f, 0.f, 0.f, 0.f};
#pragma unroll
            for (int ks = 0; ks < 4; ++ks) acc = mfma16(af[ks], *(const LAS bf16x8*)(kT + (16 * dt + c) * 272 + (32 * ks + 8 * g4) * 2), acc);
#pragma unroll
            for (int rr = 0; rr < 4; ++rr) dst[rr * 64 + 16 * dt + c] = acc[rr]; } }
    __syncthreads();
}
__device__ __forceinline__ void phase_scan(KPC p, int l, int tid, int bid, int G) {
    const float* __restrict__ RS = (const float*)(p->ws + WS_RS); bf16* __restrict__ ST = (bf16*)(p->ws + WS_ST);
    for (int idx = bid * 512 + tid; idx < NB * 4 * 2 * 8192; idx += G * 512) {
        const int ed = idx & 8191, dir = (idx >> 13) & 1, bh = idx >> 14, e = ed >> 6, d = ed & 63, h = bh & 3;
        const float* P = RS + (size_t)((bh * 2 + dir) * NCH) * 8192 + ed;
        bf16* S = ST + ((size_t)bh * NCH * 128 + e) * 128 + dir * 64 + d;
        const float lg = log2_sigmoid(dir ? p->dec_b[l * 4 + h] : p->dec_f[l * 4 + h]); const float dec = ex2(128.f * lg);
        float u[NCH];
#pragma unroll
        for (int n = 0; n < NCH; ++n) u[n] = P[(size_t)n * 8192];
        if (dir == 0) {
            S[32 * 16384] = 0; S[33 * 16384] = (bf16)(pk2(u[32], 0.f) & 0xffffu);
            float s = dec * u[32] + u[33];
#pragma unroll
            for (int n = 0; n < 32; ++n) { S[(size_t)n * 16384] = (bf16)(pk2(s, 0.f) & 0xffffu); s = dec * s + u[n]; }
        } else {
            S[33 * 16384] = 0; S[32 * 16384] = (bf16)(pk2(u[33], 0.f) & 0xffffu);
            float s = dec * u[33] + u[32];
#pragma unroll
            for (int n = 31; n >= 0; --n) { S[(size_t)n * 16384] = (bf16)(pk2(s, 0.f) & 0xffffu); s = dec * s + u[n]; }
        }
    }
}
__device__ __forceinline__ void ret_out_item(KPC p, int l, LAS unsigned char* lds, int item, int tid, int lane, int wave) {
    const bf16* ZA = (const bf16*)(p->ws + WS_ZA); bf16* BR = (bf16*)p->out; const bf16* ST = (const bf16*)(p->ws + WS_ST);
    const int b = item / (NCH * 4), rem = item % (NCH * 4), n = rem >> 2, h = rem & 3, c = lane & 15, g4 = lane >> 4;
    const bool latent = n < 32; const int r0 = latent ? b * T + 128 * n : ML + b * CL + 128 * (n - 32);
    const float lgf = log2_sigmoid(p->dec_f[l * 4 + h]), lgb = log2_sigmoid(p->dec_b[l * 4 + h]);
    LAS unsigned char* vT = lds; LAS unsigned char* Kl = lds + 34816; LAS unsigned char* Sl = lds + 34816 + 18432;
    {   float a[8], bb[8]; ret_load_k(p, ZA, r0, h, latent, 128 * n, tid, a, bb);
        const int j = tid >> 2, q4 = tid & 3;
        *(LAS u32x4*)(Kl + j * 144 + 16 * q4) = pack8(a); *(LAS u32x4*)(Kl + j * 144 + 64 + 16 * q4) = pack8(bb);
        ret_stage_vT(ZA, r0, h, vT, tid);
        const u32x4* ssrc = (const u32x4*)(ST + (size_t)((b * 4 + h) * NCH + n) * 16384);
#pragma unroll
        for (int k = 0; k < 4; ++k) { const int q = tid + 512 * k; *(LAS u32x4*)(Sl + (q >> 4) * 272 + (q & 15) * 16) = ssrc[q]; }
    }
    __syncthreads();
    const int ii = 16 * wave + c;
    bf16x8 qf[2];
    {   const bf16* src = ZA + (size_t)(r0 + ii) * NZA + C_RQ + 64 * h + 8 * g4; float a[8], bb[8]; unpack8(*(const u32x4*)src, a); unpack8(*(const u32x4*)(src + 32), bb);
        if (latent) { const float* rc = (const float*)(p->ws + WS_ROPEC); const float* rsn = (const float*)(p->ws + WS_ROPES); const int pos = 128 * n + ii; float cs8[8], sn8[8]; ld8f(rc + pos * 32 + 8 * g4, cs8); ld8f(rsn + pos * 32 + 8 * g4, sn8);
#pragma unroll
            for (int e = 0; e < 8; ++e) { const float cs = cs8[e], sn = sn8[e]; const float x1 = a[e], x2 = bb[e]; a[e] = x1 * cs - x2 * sn; bb[e] = x1 * sn + x2 * cs; } }
        qf[0] = as_bf16x8(pack8(a)); qf[1] = as_bf16x8(pack8(bb)); }
    bf16x8 pf[4];
#pragma unroll
    for (int kk = 0; kk < 4; ++kk) {
        f32x4 sa = (f32x4){0.f, 0.f, 0.f, 0.f}, sb = (f32x4){0.f, 0.f, 0.f, 0.f};
        sa = mfma16(*(const LAS bf16x8*)(Kl + (32 * kk + c) * 144 + g4 * 16), qf[0], sa); sa = mfma16(*(const LAS bf16x8*)(Kl + (32 * kk + c) * 144 + 64 + g4 * 16), qf[1], sa);
        sb = mfma16(*(const LAS bf16x8*)(Kl + (32 * kk + 16 + c) * 144 + g4 * 16), qf[0], sb); sb = mfma16(*(const LAS bf16x8*)(Kl + (32 * kk + 16 + c) * 144 + 64 + g4 * 16), qf[1], sb);
        float pa[4], pb[4];
#pragma unroll
        for (int rr = 0; rr < 4; ++rr) { const int ja = 32 * kk + 4 * g4 + rr, jb = ja + 16; const int da = ii - ja, db = ii - jb;
            pa[rr] = sa[rr] * ((da >= 0) ? ex2((float)da * lgf) : ex2((float)(-da) * lgb)); pb[rr] = sb[rr] * ((db >= 0) ? ex2((float)db * lgf) : ex2((float)(-db) * lgb)); }
        u32x4 w; w.x = pk2(pa[0], pa[1]); w.y = pk2(pa[2], pa[3]); w.z = pk2(pb[0], pb[1]); w.w = pk2(pb[2], pb[3]); pf[kk] = as_bf16x8(w);
    }
    const float cf = ex2((float)(ii + 1) * lgf), cb = ex2((float)(128 - ii) * lgb);
    f32x4 O[8]; float s = 0.f, ss = 0.f;
#pragma unroll
    for (int et = 0; et < 8; ++et) {
        f32x4 acc = (f32x4){0.f, 0.f, 0.f, 0.f}, xf = (f32x4){0.f, 0.f, 0.f, 0.f}, xb = (f32x4){0.f, 0.f, 0.f, 0.f};
#pragma unroll
        for (int kk = 0; kk < 4; ++kk) { const u32x2 v0 = *(const LAS u32x2*)(vT + (16 * et + c) * 272 + (32 * kk + 4 * g4) * 2), v1 = *(const LAS u32x2*)(vT + (16 * et + c) * 272 + (32 * kk + 16 + 4 * g4) * 2);
            u32x4 vv; vv.x = v0.x; vv.y = v0.y; vv.z = v1.x; vv.w = v1.y; acc = mfma16(as_bf16x8(vv), pf[kk], acc); }
#pragma unroll
        for (int ks = 0; ks < 2; ++ks) { xf = mfma16(*(const LAS bf16x8*)(Sl + (16 * et + c) * 272 + (32 * ks + 8 * g4) * 2), qf[ks], xf);
            xb = mfma16(*(const LAS bf16x8*)(Sl + (16 * et + c) * 272 + (64 + 32 * ks + 8 * g4) * 2), qf[ks], xb); }
        acc = acc + xf * cf + xb * cb; O[et] = acc;
        s += (acc[0] + acc[1]) + (acc[2] + acc[3]); ss += (acc[0] * acc[0] + acc[1] * acc[1]) + (acc[2] * acc[2] + acc[3] * acc[3]);
    }
    s = sum_x16_x32(s); ss = sum_x16_x32(ss);
    const float mean = s * (1.f / 128.f), var = fmaxf(ss * (1.f / 128.f) - mean * mean, 0.f), rstd = 1.0f / sqrtf(var + EPS);
    const bf16* gsrc = ZA + (size_t)(r0 + ii) * NZA + C_RG + 128 * h + 4 * g4; bf16* dst = BR + (size_t)(r0 + ii) * 512 + 128 * h + 4 * g4;
#pragma unroll
    for (int et = 0; et < 8; ++et) { const u32x2 gw = *(const u32x2*)(gsrc + 16 * et); const float g0 = bflo(gw.x), g1 = bfhi(gw.x), g2 = bflo(gw.y), g3 = bfhi(gw.y);
        const float o0 = (O[et][0] - mean) * rstd * g0 * sigmoidf_(g0), o1 = (O[et][1] - mean) * rstd * g1 * sigmoidf_(g1), o2 = (O[et][2] - mean) * rstd * g2 * sigmoidf_(g2), o3 = (O[et][3] - mean) * rstd * g3 * sigmoidf_(g3);
        u32x2 w; w.x = pk2(o0, o1); w.y = pk2(o2, o3); *(u32x2*)(dst + 16 * et) = w; }
    __syncthreads();
}

__device__ __forceinline__ int wr_off(int k) { return k * 64 + (k >> 2) * 16; }
__device__ __forceinline__ void phase_norm2(KPC p, int l, LAS unsigned char* lds, int tid, int lane, int wave, int bid, int G) {
    if (l == 1 || G != 256) { convert_experts(p, l, 0, CVT_ITEMS, bid * 8 + wave, G * 8, lds, lane, wave); __syncthreads(); }
    LAS unsigned char* wrl = lds + 69632;
    for (int i = tid; i < 1024 * 4; i += 512) { const int k = i >> 2, q = i & 3; *(LAS f32x4*)(wrl + wr_off(k) + 16 * q) = *(const f32x4*)(p->w_router + (size_t)l * 16384 + k * 16 + 4 * q); }
    __syncthreads();
    const float* modv = (const float*)(p->ws + WS_MODV) + l * 9 * 6144; const bf16* X = (const bf16*)(p->ws + WS_X); bf16* H = (bf16*)(p->ws + WS_H);
    float* AFF = (float*)(p->ws + WS_AFF); float* AFFC = (float*)(p->ws + WS_AFFC); int* INV = (int*)(p->ws + WS_INV);
    const int rows = (l == 0) ? M : ML, stride = G * 8;
    {
    int r = bid * 8 + wave;
    u32x2 vn[4];
#pragma unroll
    for (int j = 0; j < 4; ++j) vn[j] = (r < rows) ? *(const u32x2*)(X + (size_t)r * 1024 + 4 * lane + 256 * j) : (u32x2){0u, 0u};
    for (; r < rows; r += stride) {
        const int bi = (r < ML) ? (r >> 12) : 8; const float* mv = modv + bi * 6144;
        f32x4 v[4], h[4], g[4], sc[4], sh[4];
#pragma unroll
        for (int j = 0; j < 4; ++j) { v[j] = (f32x4){bflo(vn[j].x), bfhi(vn[j].x), bflo(vn[j].y), bfhi(vn[j].y)}; const int col = 4 * lane + 256 * j; g[j] = *(const f32x4*)(p->norm2_g + l * 1024 + col); sh[j] = *(const f32x4*)(mv + 3 * 1024 + col); sc[j] = *(const f32x4*)(mv + 4 * 1024 + col); }
        const int rn = r + stride;
        if (rn < rows) {
#pragma unroll
            for (int j = 0; j < 4; ++j) vn[j] = *(const u32x2*)(X + (size_t)rn * 1024 + 4 * lane + 256 * j); }
        const float rs = row_rs(v);
#pragma unroll
        for (int j = 0; j < 4; ++j) h[j] = (v[j] * rs) * g[j] * (sc[j] + 1.0f) + sh[j];
        store_h(h, H + (size_t)r * 1024, lane);
        float lg[16];
#pragma unroll
        for (int e = 0; e < 16; ++e) lg[e] = 0.f;
#pragma unroll
        for (int j = 0; j < 4; ++j)
#pragma unroll
            for (int i = 0; i < 4; ++i) { const int k = 4 * lane + 256 * j + i; const float hv = h[j][i]; const LAS f32x4* wp = (const LAS f32x4*)(wrl + wr_off(k));
#pragma unroll
                for (int q = 0; q < 4; ++q) { const f32x4 w = wp[q]; lg[4 * q] += hv * w.x; lg[4 * q + 1] += hv * w.y; lg[4 * q + 2] += hv * w.z; lg[4 * q + 3] += hv * w.w; } }
        float mx = -1e30f;
#pragma unroll
        for (int e = 0; e < 16; ++e) { lg[e] = wave_sum(lg[e]); mx = fmaxf(mx, lg[e]); }
        float sum = 0.f;
#pragma unroll
        for (int e = 0; e < 16; ++e) { lg[e] = ex2((lg[e] - mx) * LOG2E); sum += lg[e]; }
        const float isum = 1.0f / sum; float mine = 0.f;
#pragma unroll
        for (int e = 0; e < 16; ++e) mine = (lane == e) ? lg[e] * isum : mine;
        if (lane < 16) { if (r < ML) AFF[((size_t)(bi * 16 + lane) << 12) + (r & 4095)] = mine; else AFFC[((r - ML) >> 8) * 4096 + lane * 256 + ((r - ML) & 255)] = mine;
            INV[(size_t)r * 16 + lane] = -1; }
    }
    }
}

__device__ __forceinline__ int block_sum_i(int v, LAS int* red, int buf, int lane, int wave) {
    v = wave_sum_i(v);
    if (lane == 0) red[buf * 8 + wave] = v;
    __syncthreads();
    int s = 0;
#pragma unroll
    for (int w = 0; w < 8; ++w) s += red[buf * 8 + w];
    return s;
}
__device__ __forceinline__ int block_excl_scan(int v, LAS int* red, int buf, int lane, int wave) {
    int inc = v;
#pragma unroll
    for (int o = 1; o < 64; o <<= 1) { const int t = __builtin_amdgcn_ds_bpermute((lane - o) << 2, inc); if (lane >= o) inc += t; }
    if (lane == 63) red[buf * 8 + wave] = inc;
    __syncthreads();
    int base = 0;
#pragma unroll
    for (int w = 0; w < 8; ++w) { const int x = red[buf * 8 + w]; if (w < wave) base += x; }
    return base + inc - v;
}
template <int KPT>
__device__ __forceinline__ void topk_item(KPC p, const float* aff, int n, int cap, int rowbase, int e, int slotbase, int s_lo, int s_hi, bool writer, LAS unsigned char* lds, int tid, int lane, int wave) {
    const bf16* H = (const bf16*)(p->ws + WS_H); bf16* XS = (bf16*)(p->ws + WS_XS); float* topw = (float*)(p->ws + WS_TOPW); int* INV = (int*)(p->ws + WS_INV);
    LAS int* red = (LAS int*)lds; LAS int* rl = (LAS int*)(lds + 128);
    unsigned key[KPT]; const bool valid = tid * KPT < n;
#pragma unroll
    for (int j = 0; j < KPT; ++j) key[j] = valid ? __float_as_uint(aff[tid * KPT + j]) : 0u;
    unsigned Tsel = 0u;
    for (int bit = 30; bit >= 0; --bit) { const unsigned cand = Tsel | (1u << bit); int cnt = 0;
#pragma unroll
        for (int j = 0; j < KPT; ++j) cnt += (valid && key[j] >= cand) ? 1 : 0;
        if (block_sum_i(cnt, red, bit & 1, lane, wave) >= cap) Tsel = cand; }
    int cgt = 0, ceq = 0;
#pragma unroll
    for (int j = 0; j < KPT; ++j) { cgt += (valid && key[j] > Tsel) ? 1 : 0; ceq += (valid && key[j] == Tsel) ? 1 : 0; }
    const int need = cap - block_sum_i(cgt, red, 1, lane, wave);
    int er = block_excl_scan(ceq, red, 2, lane, wave);
    bool sel[KPT]; int nsel = 0;
#pragma unroll
    for (int j = 0; j < KPT; ++j) { const bool iseq = valid && key[j] == Tsel; sel[j] = valid && (key[j] > Tsel || (iseq && er < need)); er += iseq ? 1 : 0; nsel += sel[j] ? 1 : 0; }
    int slot = block_excl_scan(nsel, red, 3, lane, wave);
#pragma unroll
    for (int j = 0; j < KPT; ++j) if (sel[j]) { const int t = tid * KPT + j; if (slot < cap) { rl[slot] = t; if (writer) { topw[e * ME + slotbase + slot] = __uint_as_float(key[j]); INV[(size_t)(rowbase + t) * 16 + e] = slotbase + slot; } } ++slot; }
    __syncthreads();
    for (int s = s_lo + wave * 4; s < s_hi; s += 32) {
        u32x4 a[4][2];
#pragma unroll
        for (int q = 0; q < 4; ++q) { const int t = rl[s + q]; const u32x4* src = (const u32x4*)(H + (size_t)(rowbase + t) * 1024); a[q][0] = src[lane]; a[q][1] = src[lane + 64]; }
#pragma unroll
        for (int q = 0; q < 4; ++q) { u32x4* dst = (u32x4*)(XS + ((size_t)e * ME + slotbase + s + q) * 1024); dst[lane] = a[q][0]; dst[lane + 64] = a[q][1]; }
    }
    __syncthreads();
}
__device__ __forceinline__ void phase_topk(KPC p, int l, LAS unsigned char* lds, int tid, int lane, int wave, int bid, int G) {
    const float* AFF = (const float*)(p->ws + WS_AFF); const float* AFFC = (const float*)(p->ws + WS_AFFC);
    const int nitem = (l == 0) ? 384 : 256;
    for (int it = bid; it < nitem; it += G) {
        if (it < 256) { const int q = it >> 1, hf = it & 1, b = q >> 4, e = q & 15; topk_item<8>(p, AFF + ((size_t)(b * 16 + e) << 12), 4096, CAPL, b * T, e, b * CAPL, hf * 256, hf * 256 + 256, hf == 0, lds, tid, lane, wave); }
        else { const int q = it - 256, b = q >> 4, e = q & 15; topk_item<1>(p, AFFC + (b * 16 + e) * 256, 256, CAPC, ML + b * CL, e, NB * CAPL + b * CAPC, 0, CAPC, true, lds, tid, lane, wave); }
    }
}

__device__ __forceinline__ void phase_combine(KPC p, int l, LAS unsigned char* lds, int tid, int lane, int wave, int bid, int G) {
    const float* modv = (const float*)(p->ws + WS_MODV); bf16* X = (bf16*)(p->ws + WS_X); bf16* H = (bf16*)(p->ws + WS_H);
    const bf16* Y = (const bf16*)(p->ws + WS_XS); const int* INV = (const int*)(p->ws + WS_INV);
    const int rows = (l == 0) ? M : ML, stride = G * 8;
    int r = bid * 8 + wave;
    int slot_next = (lane < 16 && r < rows) ? INV[(size_t)r * 16 + lane] : -1;
    u32x2 vn[4];
#pragma unroll
    for (int j = 0; j < 4; ++j) vn[j] = (r < rows) ? *(const u32x2*)(X + (size_t)r * 1024 + 4 * lane + 256 * j) : (u32x2){0u, 0u};
    for (; r < rows; r += stride) {
        const int bi = (r < ML) ? (r >> 12) : 8;
        const int myslot = slot_next; const int rn = r + stride;
        slot_next = (lane < 16 && rn < rows) ? INV[(size_t)rn * 16 + lane] : -1;
        f32x4 v[4], acc[4], g2v[4];
        const float* g2 = modv + (l * 9 + bi) * 6144 + 5 * 1024;
#pragma unroll
        for (int j = 0; j < 4; ++j) { v[j] = (f32x4){bflo(vn[j].x), bfhi(vn[j].x), bflo(vn[j].y), bfhi(vn[j].y)}; acc[j] = (f32x4){0.f, 0.f, 0.f, 0.f}; g2v[j] = *(const f32x4*)(g2 + 4 * lane + 256 * j); }
        unsigned mask = (unsigned)(__builtin_amdgcn_ballot_w64(myslot >= 0) & 0xffffull);
        bool first = true;
        while (mask || first) {
          if (mask) {
            const int e0 = __builtin_ctz(mask); mask &= mask - 1u; const int s0 = __builtin_amdgcn_readlane(myslot, e0);
            const bool has1 = mask != 0u; const int e1 = has1 ? __builtin_ctz(mask) : e0; if (has1) mask &= mask - 1u; const int s1 = __builtin_amdgcn_readlane(myslot, e1);
            const bf16* ya = Y + ((size_t)e0 * ME + s0) * 1024; const bf16* yb = Y + ((size_t)e1 * ME + s1) * 1024;
            u32x2 wa[4], wb[4];
#pragma unroll
            for (int j = 0; j < 4; ++j) wa[j] = *(const u32x2*)(ya + 4 * lane + 256 * j);
#pragma unroll
            for (int j = 0; j < 4; ++j) wb[j] = *(const u32x2*)(yb + 4 * lane + 256 * j);
            if (first && rn < rows) {
#pragma unroll
                for (int j = 0; j < 4; ++j) vn[j] = *(const u32x2*)(X + (size_t)rn * 1024 + 4 * lane + 256 * j); }
            first = false;
            const float kb = has1 ? 1.0f : 0.0f;
#pragma unroll
            for (int j = 0; j < 4; ++j) { acc[j] += (f32x4){bflo(wa[j].x), bfhi(wa[j].x), bflo(wa[j].y), bfhi(wa[j].y)}; acc[j] += (f32x4){bflo(wb[j].x), bfhi(wb[j].x), bflo(wb[j].y), bfhi(wb[j].y)} * kb; }
          } else {
            if (rn < rows) {
#pragma unroll
                for (int j = 0; j < 4; ++j) vn[j] = *(const u32x2*)(X + (size_t)rn * 1024 + 4 * lane + 256 * j); }
            first = false;
          }
        }
#pragma unroll
        for (int j = 0; j < 4; ++j) v[j] = v[j] + g2v[j] * acc[j];
        if (l == 0) {
#pragma unroll
            for (int j = 0; j < 4; ++j) { u32x2 w; w.x = pk2(v[j].x, v[j].y); w.y = pk2(v[j].z, v[j].w); *(u32x2*)(X + (size_t)r * 1024 + 4 * lane + 256 * j) = w; }
            const float rs = row_rs(v); f32x4 h[4];
            norm_mod(v, rs, p->norm1_g + 1024, modv + (9 + bi) * 6144, modv + (9 + bi) * 6144 + 1024, h, lane);
            store_h(h, H + (size_t)r * 1024, lane);
        } else {
#pragma unroll
            for (int j = 0; j < 4; ++j) *(f32x4*)(p->out + (size_t)r * 1024 + 4 * lane + 256 * j) = v[j];
        }
    }
    if (l == 0) convert_small(p, 1, lds, lane, wave, bid, G);
}

#define XB_TMO      128
#define XB_XCNT(j)  (256  + 64 * (j))
#define XB_XSUB(j)  (1280 + 64 * (j))
#define XB_XGEN(j)  (2304 + 64 * (j))
#define XB_TOP      3328
#define XB_TOPGEN   3392
#define XCD_BAR_WORDS 3456
#define XB_SPIN_CAP (1u << 18)

__device__ __forceinline__ unsigned xb_ld(unsigned* p)              { return __hip_atomic_load(p, __ATOMIC_RELAXED, __HIP_MEMORY_SCOPE_AGENT); }
__device__ __forceinline__ unsigned xb_add(unsigned* p, unsigned v) { return __hip_atomic_fetch_add(p, v, __ATOMIC_RELAXED, __HIP_MEMORY_SCOPE_AGENT); }
__device__ __forceinline__ unsigned xb_xcc_id() { return (unsigned)__builtin_amdgcn_s_getreg((3 << 11) | 20) & 0xFu; }
#define XB_SPIN(cond, bar) do { unsigned _sp = 0; while (cond) { __builtin_amdgcn_s_sleep(1); \
    if ((++_sp & 255u) == 0u) { if (xb_ld(&(bar)[XB_TMO])) break; if (_sp > XB_SPIN_CAP) { atomicAdd(&(bar)[XB_TMO], 1u); break; } } } } while (0)

struct XcdBarrier {
    unsigned* bar; unsigned x;
    volatile LAS unsigned* st;
};

__device__ __forceinline__ XcdBarrier xcd_barrier_post(unsigned* bar, volatile LAS unsigned* st) {
    XcdBarrier b; b.bar = bar; b.x = xb_xcc_id(); b.st = st;
    if (threadIdx.x == 0) (void)xb_add(&bar[XB_XCNT(b.x)], 1u);
    return b;
}
__device__ __forceinline__ void xcd_barrier_complete(unsigned* bar, unsigned x, unsigned& nloc, unsigned& nx) {
    const unsigned G = gridDim.x * gridDim.y * gridDim.z;
    unsigned sum, cnt, mine, sp = 0u;
    for (;;) {
        sum = 0u; cnt = 0u; mine = 0u;
#pragma unroll
        for (unsigned j = 0; j < 16; ++j) { const unsigned c = xb_ld(&bar[XB_XCNT(j)]); sum += c; cnt += (c > 0u) ? 1u : 0u; mine = (j == x) ? c : mine; }
        if (sum == G) break;
        __builtin_amdgcn_s_sleep(1);
        if ((++sp & 255u) == 0u) { if (xb_ld(&bar[XB_TMO])) break; if (sp > XB_SPIN_CAP) { atomicAdd(&bar[XB_TMO], 1u); break; } }
    }
    nloc = mine > 0u ? mine : 1u; nx = cnt > 0u ? cnt : 1u;
}

__device__ __forceinline__ void xcd_barrier(const XcdBarrier& b) {
    asm volatile("s_waitcnt vmcnt(0)" ::: "memory");
    __syncthreads();
    if (threadIdx.x == 0) {
        unsigned* bar = b.bar;
        __builtin_amdgcn_s_waitcnt(0);
        unsigned nloc = b.st[0], nx = b.st[1];
        if (nloc == 0u) { xcd_barrier_complete(bar, b.x, nloc, nx); b.st[0] = nloc; b.st[1] = nx; }
        const unsigned old = xb_add(&bar[XB_XSUB(b.x)], 1u);
        const unsigned gen = old / nloc;
        if (old + 1u == (gen + 1u) * nloc) {
            __builtin_amdgcn_fence(__ATOMIC_RELEASE, "agent");
            asm volatile("s_waitcnt vmcnt(0)" ::: "memory");
            const unsigned og = xb_add(&bar[XB_TOP], 1u);
            const unsigned tg = og / nx;
            if (og + 1u == (tg + 1u) * nx) xb_add(&bar[XB_TOPGEN], 1u);
            else XB_SPIN(xb_ld(&bar[XB_TOPGEN]) == tg, bar);
            __builtin_amdgcn_fence(__ATOMIC_ACQUIRE, "agent");
            xb_add(&bar[XB_XGEN(b.x)], 1u);
            asm volatile("s_waitcnt vmcnt(0)" ::: "memory");
        } else {
            XB_SPIN(xb_ld(&bar[XB_XGEN(b.x)]) == gen, bar);
            __builtin_amdgcn_fence(__ATOMIC_ACQUIRE, "agent");
            asm volatile("s_waitcnt vmcnt(0)" ::: "memory");
        }
    }
    __syncthreads();
}

#define KPP() ({ KPC q_ = kp_; asm volatile("" : "+s"(q_)); q_; })
__global__ void __launch_bounds__(512, 2) mk_fwd(KP p_unused) {
    extern __shared__ __attribute__((aligned(16))) unsigned char lds_raw[];
    LAS unsigned char* lds = (LAS unsigned char*)lds_raw;
    cg::grid_group grid = cg::this_grid();
    const int bid = blockIdx.x, G = gridDim.x;
#define IDS() int tid = threadIdx.x; asm volatile("" : "+v"(tid)); const int lane = tid & 63, wave = __builtin_amdgcn_readfirstlane(tid >> 6); (void)lane; (void)wave
    const KPC kp_ = (KPC)__builtin_amdgcn_kernarg_segment_ptr();
    volatile LAS unsigned* bst = (volatile LAS unsigned*)(lds + 147392);
    if (threadIdx.x < 16) bst[threadIdx.x] = 0u;
    __syncthreads();
    (void)xcd_barrier_post((unsigned*)KPP()->ws, bst);
#define GSYNC() do { XcdBarrier b_; b_.bar = (unsigned*)KPP()->ws; b_.x = xb_xcc_id(); b_.st = bst; xcd_barrier(b_); } while (0)

    { IDS(); phase_prep(KPP(), lds, tid, lane, wave, bid, G); }
    if (G == 0x7fffffff) grid.sync();
    GSYNC();
    { IDS(); phase_norm_in(KPP(), lane, wave, bid, G); }
    GSYNC();
#pragma unroll 1
    for (int l = 0; l < 2; ++l) {
        {
            unsigned char* ws = KPP()->ws;
            pg8::Gemm g{(const pg8::bf16_t*)(ws + WS_H), (const pg8::bf16_t*)(ws + WS_WTIN), M, NZA, 1024}; GroupOrder S{1, M / 256, NZA / 256, 0, 0, G, bid};
            EpiZA E{(bf16*)(ws + WS_ZA)};
            pg8::gemm_phase<EpiZA, GroupOrder, true, true>(lds, g, S, E);
        }
        GSYNC();
        {
            KPC p = KPP(); IDS();
            float mq = fabsf(p->qn_g[l * 64 + lane]), mk = fabsf(p->kn_g[l * 64 + lane]);
            mq = wave_max(mq); mk = wave_max(mk);
            const float Mb2 = 8.0f * mq * mk * LOG2E;
            const int natt = (l == 0) ? 544 : 512, nupd = NB * NCH * 4, nvp = (l == 0) ? (M / 128) : (ML / 128);
            for (int it = bid; it < natt + nupd + nvp; it += G) {
                if (it < natt) { att_item(p, l, lds, it, Mb2, tid, lane, wave); }
                else if (it < natt + nupd) { ret_upd_item(p, l, lds, it - natt, tid, lane, wave); }
                else { sgu_vprep_item(p, it - natt - nupd, tid); }
            }
        }
        GSYNC();
        { IDS(); phase_scan(KPP(), l, tid, bid, G); }
        GSYNC();
        {   KPC p = KPP(); IDS(); const int nch = (l == 0) ? NCH : 32;
            const int nro = NB * nch * 4, nsgu = ((l == 0) ? (M / 128) : (ML / 128)) * 4;
            for (int it = bid; it < nro + nsgu; it += G) {
                if (it < nro) { const int b = it / (nch * 4), rem = it % (nch * 4); ret_out_item(p, l, lds, b * (NCH * 4) + rem, tid, lane, wave); }
                else sgu_item(p, l, lds, it - nro, tid, lane, wave);
            }
        }
        GSYNC();
        const int Mrows = (l == 0) ? M : ML;
        {
            unsigned char* ws = KPP()->ws;
            pg8::Gemm g{(const pg8::bf16_t*)(ws + WS_H), (const pg8::bf16_t*)(ws + WS_WTIN) + (size_t)NZA * 1024, Mrows, NZG, 1024}; GroupOrder S{1, Mrows / 256, NZG / 256, 0, 0, G, bid};
            EpiSig E{(bf16*)(ws + WS_G)};
            pg8::gemm_phase<EpiSig, GroupOrder, true, true>(lds, g, S, E);
            if (l == 0 && G == 256 && bid >= CVT_G_IDLE0) { IDS(); convert_experts(KPP(), 0, 0, CVT_G_HI, (bid - CVT_G_IDLE0) * 8 + wave, (256 - CVT_G_IDLE0) * 8, lds, lane, wave); }
        }
        GSYNC();
        {
            KPC p = KPP(); unsigned char* ws = p->ws;
            pg8::Gemm g{(const pg8::bf16_t*)p->out, (const pg8::bf16_t*)(ws + WS_WTBR), 3 * M, 3072, 512}; MergeOrder S{Mrows / 256, G, bid};
            EpiMergeChain E{(const bf16*)(ws + WS_G), (bf16*)(ws + WS_H)};
            pg8::gemm_phase<EpiMergeChain, MergeOrder, true, true>(lds, g, S, E);
            if (l == 0 && G == 256 && bid >= CVT_M_IDLE0) { IDS(); convert_experts(KPP(), 0, CVT_G_HI, CVT_M_HI, (bid - CVT_M_IDLE0) * 8 + wave, (256 - CVT_M_IDLE0) * 8, lds, lane, wave); }
        }
        GSYNC();
        {
            KPC p = KPP(); unsigned char* ws = p->ws;
            pg8::Gemm g{(const pg8::bf16_t*)(ws + WS_H), (const pg8::bf16_t*)(ws + WS_WTOUT), Mrows, 1024, 1024}; GroupOrder S{1, Mrows / 256, 4, 0, 0, G, bid};
            EpiOut E{p->x, p->ctx, (bf16*)(ws + WS_X), (const float*)(ws + WS_MODV) + l * 9 * 6144, (l == 0) ? 1 : 0};
            pg8::gemm_phase<EpiOut, GroupOrder, true, true>(lds, g, S, E);
            if (l == 0 && G == 256 && bid >= CVT_O_IDLE0) { IDS(); convert_experts(KPP(), 0, CVT_M_HI, CVT_ITEMS, (bid - CVT_O_IDLE0) * 8 + wave, (256 - CVT_O_IDLE0) * 8, lds, lane, wave); }
        }
        GSYNC();
        { IDS(); phase_norm2(KPP(), l, lds, tid, lane, wave, bid, G); }
        GSYNC();
        { IDS(); phase_topk(KPP(), l, lds, tid, lane, wave, bid, G); }
        GSYNC();
        {
            unsigned char* ws = KPP()->ws;
            pg8::Gemm g{(const pg8::bf16_t*)(ws + WS_XS), (const pg8::bf16_t*)(ws + WS_WT1), NE * ME, NE * 2048, 1024}; GroupOrder S{NE, (l == 0) ? 17 : 16, 8, 17, 8, G, bid};
            EpiMoe1 E{(bf16*)(ws + WS_ACT)};
            pg8::gemm_phase<EpiMoe1, GroupOrder, true, true>(lds, g, S, E);
        }
        GSYNC();
        {
            unsigned char* ws = KPP()->ws;
            pg8::Gemm g{(const pg8::bf16_t*)(ws + WS_ACT), (const pg8::bf16_t*)(ws + WS_WT2), NE * ME, NE * 1024, 1024}; GroupOrder S{NE, (l == 0) ? 17 : 16, 4, 17, 4, G, bid};
            EpiMoe2 E{(bf16*)(ws + WS_XS), (const float*)(ws + WS_TOPW)};
            pg8::gemm_phase<EpiMoe2, GroupOrder, true, true>(lds, g, S, E);
        }
        GSYNC();
        { IDS(); phase_combine(KPP(), l, lds, tid, lane, wave, bid, G); }
        if (l == 0) GSYNC();
    }
}

extern "C" void kernel_launch(void* const* d_in, const int* in_sizes, int n_in, void* d_out, int out_size, void* d_ws, size_t ws_size, hipStream_t stream) {
    static int grid = 0;
    if (grid == 0) {
        if (n_in != 22 || out_size != ML * D || ws_size < WS_END) { fprintf(stderr, "kernel_launch: unexpected shapes (n_in %d out %d ws %zu, need %zu)\n", n_in, out_size, ws_size, (size_t)WS_END); grid = -1; return; }
        int dev = 0, cus = 0, per_cu = 0;
        if (hipGetDevice(&dev) != hipSuccess || hipDeviceGetAttribute(&cus, hipDeviceAttributeMultiprocessorCount, dev) != hipSuccess) { grid = -1; return; }
        if (hipFuncSetAttribute((const void*)mk_fwd, hipFuncAttributeMaxDynamicSharedMemorySize, LDS_BYTES) != hipSuccess) { fprintf(stderr, "kernel_launch: hipFuncSetAttribute failed\n"); grid = -1; return; }
        if (hipOccupancyMaxActiveBlocksPerMultiprocessor(&per_cu, (const void*)mk_fwd, 512, LDS_BYTES) != hipSuccess || per_cu < 1) { fprintf(stderr, "kernel_launch: occupancy query says %d\n", per_cu); (void)hipGetLastError(); }
        grid = cus;
        fprintf(stderr, "kernel_launch: grid %d, occupancy %d/CU, ws %zu\n", grid, per_cu, ws_size);
    }
    if (grid < 0) return;
    if (hipMemsetAsync(d_ws, 0, 16384, stream) != hipSuccess) { fprintf(stderr, "kernel_launch: memset failed\n"); return; }
    KP hp{};
    const float** f = (const float**)&hp;
    for (int i = 0; i < 22; ++i) f[i] = (const float*)d_in[i];
    hp.out = (float*)d_out; hp.ws = (unsigned char*)d_ws;
    void* args[] = {&hp};
    hipError_t e = hipLaunchCooperativeKernel((const void*)mk_fwd, dim3(grid), dim3(512), args, LDS_BYTES, stream);
    if (e != hipSuccess) fprintf(stderr, "kernel_launch: cooperative launch failed: %s\n", hipGetErrorString(e));
}
```

```cpp
#include <hip/hip_runtime.h>
#include <hip/hip_cooperative_groups.h>
#include <cstdio>
#include <cstdint>
namespace cg = cooperative_groups;
namespace pg8 {
#define PG8_LAS __attribute__((address_space(3)))
typedef unsigned short bf16_t;
typedef short bf16x8 __attribute__((ext_vector_type(8)));
typedef float f32x4 __attribute__((ext_vector_type(4)));
typedef unsigned u32x4 __attribute__((ext_vector_type(4)));
constexpr int BM = 256, BK = 64, HALF = 128, HTB = HALF * BK * 2  , STAGE_BYTES = 8 * HTB, NXCD = 8, WGM = 8;

__host__ __device__ __forceinline__ int lds_byte(int r, int c) { const int st = (r >> 4) * 2 + (c >> 5), rr = r & 15, cc = c & 31, ob = rr * 64 + cc * 2; return st * 1024 + (ob ^ (((ob >> 9) & 1) << 5)); }
__host__ __device__ __forceinline__ void stage_rc(int b, int& R, int& C) { const int st = b / 1024, sb = b % 1024, swz = sb ^ (((sb >> 9) & 1) << 5); R = (st >> 1) * 16 + swz / 64; C = (st & 1) * 32 + (swz % 64) / 2; }
__host__ __device__ __forceinline__ int perm32(int rho) { const int n = rho >> 4, i = rho & 15; return 8 * (i >> 2) + 4 * n + (i & 3); }

struct Unit { int pm, pn; };
struct Gemm { const bf16_t* A; const bf16_t* Bt; int M, N, K; };

struct StaticOrder {
    int nM, nN, nwg, G, c;
    __host__ __device__ void init(int M, int N, int G_, int c_) { nM = M / BM; nN = N / BM; nwg = nM * nN; G = G_; c = c_; }
    __host__ __device__ bool next(int i, Unit& u) const {
        const long L = (long)i * G + c; if (L >= nwg) return false;
        int wgid = (int)L; { const int q = nwg / NXCD, r = nwg % NXCD, xcd = wgid % NXCD, off = wgid / NXCD; wgid = (xcd < r ? xcd * (q + 1) : r * (q + 1) + (xcd - r) * q) + off; }
        const int nig = WGM * nN, gid = wgid / nig, fm = gid * WGM, gsz = (nM - fm) < WGM ? (nM - fm) : WGM;
        u.pm = fm + ((wgid % nig) % gsz); u.pn = (wgid % nig) / gsz; return true;
    }
    __device__ __forceinline__ void a_ready(const Unit&) const {}
    __device__ __forceinline__ void done(const Unit&) const {}
};

__device__ __forceinline__ unsigned cvt_pk_bf16(float lo, float hi) { unsigned r; asm volatile("v_cvt_pk_bf16_f32 %0, %1, %2" : "=v"(r) : "v"(lo), "v"(hi)); return r; }
typedef float f32x2 __attribute__((ext_vector_type(2)));
__device__ __forceinline__ f32x2 gelu_pk(f32x2 v) {
    const f32x2 av = __builtin_elementwise_abs(v), d = av * 0.2316418882f + 1.0f;
    f32x2 t; t.x = __builtin_amdgcn_rcpf(d.x); t.y = __builtin_amdgcn_rcpf(d.y);
    f32x2 q = t * 0.5307027145f + (-0.7265760135f); q = q * t + 0.7107068705f; q = q * t + (-0.142248368f); q = q * t + 0.127414796f; q = q * t;
    const f32x2 s = (v * v) * (-0.72134752044f);
    f32x2 e; e.x = __builtin_amdgcn_exp2f(s.x); e.y = __builtin_amdgcn_exp2f(s.y);
    const f32x2 m = v * (q * e), r = v - m;
    f32x2 o; o.x = v.x < 0.f ? m.x : r.x; o.y = v.y < 0.f ? m.y : r.y; return o;
}

template <int ACT  > struct EpiBf16 {
    static constexpr bool PERM = true, AFTER_DRAIN = false, CHAIN = false; static_assert(ACT == 0 || ACT == 1, "EpiBf16: ACT is 0 (none) or 1 (gelu_pk)");
    bf16_t* O; int ldc; const float* bias; int split_cols; size_t split_stride; float scale0;
    __device__ __forceinline__ void operator()(const f32x4 (&acc)[2][2][4][2], const Unit& u, int wr, int wc, int fr, int fq) const {
        const int row0 = u.pm * BM + wr * 64 + fr; int colt = u.pn * BM; bf16_t* base = O;
        float sc = 1.f; if (split_cols) { const int t = colt / split_cols; base += (size_t)t * split_stride; colt -= t * split_cols; if (t == 0) sc = scale0; }
        const int col0 = colt + wc * 32 + 8 * fq, bcol0 = u.pn * BM + wc * 32 + 8 * fq;
        f32x4 bv[2][2];
#pragma unroll
        for (int bj = 0; bj < 2; ++bj)
#pragma unroll
            for (int n = 0; n < 2; ++n) bv[bj][n] = bias ? *(const f32x4*)(bias + bcol0 + bj * HALF + 4 * n) : (f32x4){0.f, 0.f, 0.f, 0.f};
#pragma unroll
        for (int ai = 0; ai < 2; ++ai)
#pragma unroll
            for (int m = 0; m < 4; ++m) { bf16_t* rowp = base + (size_t)(row0 + ai * HALF + m * 16) * ldc + col0;
#pragma unroll
                for (int bj = 0; bj < 2; ++bj) { f32x4 v0 = acc[ai][bj][m][0] + bv[bj][0], v1 = acc[ai][bj][m][1] + bv[bj][1];
                    if (ACT == 1) { f32x2 a = gelu_pk((f32x2){v0[0], v0[1]}), b = gelu_pk((f32x2){v0[2], v0[3]}), c = gelu_pk((f32x2){v1[0], v1[1]}), d = gelu_pk((f32x2){v1[2], v1[3]});
                        v0 = (f32x4){a.x, a.y, b.x, b.y}; v1 = (f32x4){c.x, c.y, d.x, d.y}; }
                    v0 = v0 * sc; v1 = v1 * sc; u32x4 w; w.x = cvt_pk_bf16(v0[0], v0[1]); w.y = cvt_pk_bf16(v0[2], v0[3]); w.z = cvt_pk_bf16(v1[0], v1[1]); w.w = cvt_pk_bf16(v1[2], v1[3]);
                    *(u32x4*)(rowp + bj * HALF) = w; } }
    }
};
template <class Epi, class Sched, bool ALIGN_EPI = false, bool SP2 = false>
__device__ __forceinline__ void gemm_phase(PG8_LAS unsigned char* lds, const Gemm g, const Sched& S, const Epi& E) {
    int tid_ = threadIdx.x; asm volatile("" : "+v"(tid_));
    const int tid = tid_, wid = __builtin_amdgcn_readfirstlane(tid >> 6), lane = tid & 63, wr = wid >> 2, wc = wid & 3, fr = lane & 15, fq = lane >> 4;
    const int K = g.K, nt = K / BK;
    unsigned voffA[2], voffB[2];
#pragma unroll
    for (int i = 0; i < 2; ++i) { int R, C; stage_rc(tid * 16 + i * 8192, R, C); const int Rb = Epi::PERM ? ((R & ~31) + perm32(R & 31)) : R;
        voffA[i] = (unsigned)(R * K + C) * 2u; voffB[i] = (unsigned)(Rb * K + C) * 2u; }
    const size_t kstep = (size_t)(BK * 2);
    const size_t hstep = (size_t)HALF * K * 2;
    const size_t tstep = 2 * hstep;
    const unsigned ldsw = (unsigned)wid * 1024u;
    const int aoff = lds_byte(wr * 64 + fr, fq * 8), boff = lds_byte(wc * 32 + fr, fq * 8);
#define PG8_SA(b, h) (((b) * 2 + (h)) * HTB)
#define PG8_SB(b, h) ((4 + (b) * 2 + (h)) * HTB)
#define PG8_STAGE(bufoff, gbase, voff) do { _Pragma("unroll") for (int _i = 0; _i < 2; ++_i) \
        __builtin_amdgcn_global_load_lds((const unsigned*)((const char*)(gbase) + (voff)[_i]), (PG8_LAS unsigned*)(lds + (bufoff) + ldsw + _i * 8192), 16, 0, 0); } while (0)
#define PG8_LDA(dst, b, h) do { _Pragma("unroll") for (int m = 0; m < 4; ++m) _Pragma("unroll") for (int k = 0; k < 2; ++k) dst[m][k] = *(const PG8_LAS bf16x8*)(lds + PG8_SA(b, h) + aoff + m * 2048 + k * 1024); } while (0)
#define PG8_LDB(dst, b, h) do { _Pragma("unroll") for (int n = 0; n < 2; ++n) _Pragma("unroll") for (int k = 0; k < 2; ++k) dst[n][k] = *(const PG8_LAS bf16x8*)(lds + PG8_SB(b, h) + boff + n * 2048 + k * 1024); } while (0)
#define PG8_MMA(ai, bj, At, Bt) do { __builtin_amdgcn_s_setprio(1); _Pragma("unroll") for (int m = 0; m < 4; ++m) _Pragma("unroll") for (int n = 0; n < 2; ++n) _Pragma("unroll") for (int k = 0; k < 2; ++k) \
        acc[ai][bj][m][n] = __builtin_amdgcn_mfma_f32_16x16x32_bf16(Bt[n][k], At[m][k], acc[ai][bj][m][n], 0, 0, 0); __builtin_amdgcn_s_setprio(0); } while (0)
#define PG8_WAIT_V(n) asm volatile("s_waitcnt vmcnt(" #n ")" ::: "memory")
#define PG8_WAIT_L(n) asm volatile("s_waitcnt lgkmcnt(" #n ")" ::: "memory")
#define PG8_BAR __builtin_amdgcn_s_barrier()
#define PG8_SCHED __builtin_amdgcn_sched_barrier(0)
    Unit cur, nxt; int ui = 0;
    if (!S.next(0, cur)) return;
    f32x4 acc[2][2][4][2];
#pragma unroll
    for (int a = 0; a < 2; ++a)
#pragma unroll
        for (int b = 0; b < 2; ++b)
#pragma unroll
            for (int m = 0; m < 4; ++m)
#pragma unroll
                for (int n = 0; n < 2; ++n) acc[a][b][m][n] = (f32x4){0.f, 0.f, 0.f, 0.f};
    bf16x8 At[4][2], B0[2][2], B1[2][2];
    const char* cA = (const char*)g.A + (size_t)cur.pm * tstep; const char* cB = (const char*)g.Bt + (size_t)cur.pn * tstep;
    S.a_ready(cur);
    if constexpr (SP2) {
        PG8_STAGE(PG8_SB(0, 0), cB, voffB); PG8_STAGE(PG8_SB(0, 1), cB + hstep, voffB); PG8_STAGE(PG8_SA(0, 0), cA, voffA); PG8_STAGE(PG8_SA(0, 1), cA + hstep, voffA);
        if (wr == 1) PG8_BAR;
        PG8_WAIT_V(2); PG8_BAR;
        PG8_STAGE(PG8_SB(1, 0), cB + kstep, voffB); PG8_STAGE(PG8_SA(1, 0), cA + kstep, voffA); PG8_STAGE(PG8_SB(1, 1), cB + hstep + kstep, voffB);
        PG8_WAIT_V(6); PG8_BAR;
    } else {
        PG8_STAGE(PG8_SB(0, 0), cB, voffB); PG8_STAGE(PG8_SA(0, 0), cA, voffA); PG8_STAGE(PG8_SB(0, 1), cB + hstep, voffB); PG8_STAGE(PG8_SA(0, 1), cA + hstep, voffA);
        if (wr == 1) PG8_BAR;
        PG8_WAIT_V(4); PG8_BAR;
        PG8_STAGE(PG8_SB(1, 0), cB + kstep, voffB); PG8_STAGE(PG8_SA(1, 0), cA + kstep, voffA); PG8_STAGE(PG8_SB(1, 1), cB + hstep + kstep, voffB);
        PG8_WAIT_V(6); PG8_BAR;
    }
    for (;;) {
        const bool has_next = S.next(ui + 1, nxt);
        const char* nA = has_next ? (const char*)g.A + (size_t)nxt.pm * tstep : cA; const char* nB = has_next ? (const char*)g.Bt + (size_t)nxt.pn * tstep : cB;
        for (int t = 0; t < nt; t += 2) {
            const bool last = (t == nt - 2);
            const char* a1 = cA + (size_t)(t + 1) * kstep;
            const char* a2 = last ? nA : cA + (size_t)(t + 2) * kstep; const char* b2 = last ? nB : cB + (size_t)(t + 2) * kstep;
            const char* a3 = a2 + kstep; const char* b3 = b2 + kstep;
            if (last && has_next) S.a_ready(nxt);
            if constexpr (SP2) {
            PG8_LDB(B0, 0, 0); PG8_LDB(B1, 0, 1); PG8_SCHED; PG8_LDA(At, 0, 0); PG8_STAGE(PG8_SA(1, 1), a1 + hstep, voffA);
            PG8_WAIT_V(8); PG8_WAIT_L(0); PG8_BAR; PG8_MMA(0, 0, At, B0); PG8_MMA(0, 1, At, B1); PG8_BAR; PG8_SCHED;
            PG8_LDA(At, 0, 1); PG8_STAGE(PG8_SB(0, 0), b2, voffB); PG8_STAGE(PG8_SB(0, 1), b2 + hstep, voffB); PG8_STAGE(PG8_SA(0, 0), a2, voffA);
            PG8_WAIT_V(8); PG8_WAIT_L(0); PG8_BAR; PG8_MMA(1, 0, At, B0); PG8_MMA(1, 1, At, B1); PG8_BAR; PG8_SCHED;
            PG8_LDB(B0, 1, 0); PG8_LDB(B1, 1, 1); PG8_SCHED; PG8_LDA(At, 1, 0); PG8_STAGE(PG8_SA(0, 1), a2 + hstep, voffA);
            PG8_WAIT_V(8); PG8_WAIT_L(0); PG8_BAR; PG8_MMA(0, 0, At, B0); PG8_MMA(0, 1, At, B1); PG8_BAR; PG8_SCHED;
            PG8_LDA(At, 1, 1); PG8_STAGE(PG8_SB(1, 0), b3, voffB); PG8_STAGE(PG8_SB(1, 1), b3 + hstep, voffB); PG8_STAGE(PG8_SA(1, 0), a3, voffA);
            PG8_WAIT_V(8); PG8_WAIT_L(0); PG8_BAR; PG8_MMA(1, 0, At, B0); PG8_MMA(1, 1, At, B1); PG8_BAR; PG8_SCHED;
            } else {
            PG8_LDB(B0, 0, 0); PG8_SCHED; PG8_LDA(At, 0, 0); PG8_STAGE(PG8_SA(1, 1), a1 + hstep, voffA);
            PG8_WAIT_L(8); PG8_BAR; PG8_WAIT_L(0); PG8_MMA(0, 0, At, B0); PG8_BAR; PG8_SCHED;
            PG8_LDB(B1, 0, 1); PG8_STAGE(PG8_SB(0, 0), b2, voffB);
            PG8_BAR; PG8_WAIT_L(0); PG8_MMA(0, 1, At, B1); PG8_BAR;
            PG8_LDA(At, 0, 1); PG8_STAGE(PG8_SA(0, 0), a2, voffA);
            PG8_BAR; PG8_WAIT_L(0); PG8_MMA(1, 0, At, B0); PG8_BAR; PG8_SCHED;
            PG8_STAGE(PG8_SB(0, 1), b2 + hstep, voffB);
            PG8_WAIT_V(6); PG8_BAR; PG8_MMA(1, 1, At, B1); PG8_BAR;
            PG8_LDB(B0, 1, 0); PG8_SCHED; PG8_LDA(At, 1, 0); PG8_STAGE(PG8_SA(0, 1), a2 + hstep, voffA);
            PG8_WAIT_L(8); PG8_BAR; PG8_WAIT_L(0); PG8_MMA(0, 0, At, B0); PG8_BAR; PG8_SCHED;
            PG8_LDB(B1, 1, 1); PG8_STAGE(PG8_SB(1, 0), b3, voffB);
            PG8_BAR; PG8_WAIT_L(0); PG8_MMA(0, 1, At, B1); PG8_BAR;
            PG8_LDA(At, 1, 1); PG8_STAGE(PG8_SA(1, 0), a3, voffA);
            PG8_BAR; PG8_WAIT_L(0); PG8_MMA(1, 0, At, B0); PG8_BAR; PG8_SCHED;
            PG8_STAGE(PG8_SB(1, 1), b3 + hstep, voffB);
            PG8_WAIT_V(6); PG8_BAR; PG8_MMA(1, 1, At, B1); PG8_BAR;
            }
        }
        if constexpr (ALIGN_EPI) { if (wr == 0) PG8_BAR; }
        bool keep_acc = false;
        if constexpr (Epi::CHAIN) { keep_acc = E.chain(acc, cur, wr, wc, fr, fq); S.done(cur); }
        else if constexpr (!Epi::AFTER_DRAIN) { E(acc, cur, wr, wc, fr, fq); S.done(cur); }
        if (!has_next) break;
        if (!keep_acc) {
#pragma unroll
        for (int a = 0; a < 2; ++a)
#pragma unroll
            for (int b = 0; b < 2; ++b)
#pragma unroll
                for (int m = 0; m < 4; ++m)
#pragma unroll
                    for (int n = 0; n < 2; ++n) acc[a][b][m][n] = (f32x4){0.f, 0.f, 0.f, 0.f};
        }
        cur = nxt; cA = nA; cB = nB; ++ui;
        if constexpr (ALIGN_EPI) { if (wr == 1) PG8_BAR; }
    }
    PG8_WAIT_V(0);
    if constexpr (!ALIGN_EPI) { if (wr == 0) PG8_BAR; }
    PG8_BAR;
    if constexpr (Epi::AFTER_DRAIN) { E.fused(acc, cur, wr, wc, fr, fq, lds, wid, lane); S.done(cur); }
#undef PG8_SA
#undef PG8_SB
#undef PG8_STAGE
#undef PG8_LDA
#undef PG8_LDB
#undef PG8_MMA
#undef PG8_WAIT_V
#undef PG8_WAIT_L
#undef PG8_BAR
#undef PG8_SCHED
}
}

#define LAS __attribute__((address_space(3)))
typedef unsigned short bf16;
typedef short bf16x8 __attribute__((ext_vector_type(8)));
typedef float f32x4 __attribute__((ext_vector_type(4)));
typedef unsigned u32x4 __attribute__((ext_vector_type(4)));
typedef unsigned u32x2 __attribute__((ext_vector_type(2)));

constexpr int D = 1024, NB = 8, T = 4096, CL = 256;
constexpr int ML = NB * T, MC = NB * CL, M = ML + MC;
constexpr int NZA = 3328, NZG = 3072;
constexpr int C_RQ = 0, C_RK = 256, C_RV = 512, C_RG = 1024, C_SU = 1536, C_SV = 2048, C_AQ = 2560, C_AK = 3072, C_AV = 3200;
constexpr int NE = 16, CAPL = 512, CAPC = 32, ME = NB * (CAPL + CAPC);
constexpr int NCH = 34;
constexpr float EPS = 1e-6f, LOG2E = 1.4426950408889634f;
constexpr int LDS_BYTES = 147456;

constexpr size_t MiB = 1u << 20;
constexpr size_t WS_ROPEC = 1 * MiB, WS_ROPES = 1 * MiB + 512 * 1024, WS_MODV = 2 * MiB, WS_AFF = 3 * MiB, WS_AFFC = 5 * MiB, WS_INV = 6 * MiB, WS_TOPW = 9 * MiB;
constexpr size_t WS_WTIN = 16 * MiB, WS_WTBR = WS_WTIN + (size_t)6400 * 1024 * 2, WS_WTOUT = WS_WTBR + (size_t)3072 * 512 * 2;
constexpr size_t WS_X = 34 * MiB, WS_H = 170 * MiB, WS_R = 238 * MiB;
constexpr size_t WS_ZA = WS_R, WS_G = WS_R, WS_RS = 459 * MiB, WS_ST = 527 * MiB;
constexpr size_t WS_XS = WS_R, WS_ACT = 374 * MiB, WS_WT1 = 510 * MiB, WS_WT2 = 574 * MiB, WS_END = 606 * MiB;
static_assert(WS_WTOUT + 2 * MiB <= WS_X && WS_ZA + (size_t)M * NZA * 2 <= WS_RS && WS_ST + (size_t)NB * 4 * NCH * 128 * 128 * 2 <= WS_END, "ws map");

struct KP {
    const float *x, *c, *ctx, *c_ctx, *w_mod, *b_mod, *norm1_g, *norm2_g, *w_in, *dec_f, *dec_b, *sgu_w, *sgu_b, *qn_g, *kn_g, *sink, *w_branch, *w_out, *w_router, *w_eg, *w_eu, *w_ed;
    float* out; unsigned char* ws;
};
typedef const __attribute__((address_space(4))) KP* KPC;

#define LDS_WAIT() asm volatile("s_waitcnt lgkmcnt(0)" ::: "memory")
__device__ __forceinline__ unsigned pk2(float lo, float hi) { return pg8::cvt_pk_bf16(lo, hi); }
__device__ __forceinline__ float bflo(unsigned w) { return __uint_as_float(w << 16); }
__device__ __forceinline__ float bfhi(unsigned w) { return __uint_as_float(w & 0xffff0000u); }
__device__ __forceinline__ void unpack8(const u32x4 w, float (&f)[8]) { f[0] = bflo(w.x); f[1] = bfhi(w.x); f[2] = bflo(w.y); f[3] = bfhi(w.y); f[4] = bflo(w.z); f[5] = bfhi(w.z); f[6] = bflo(w.w); f[7] = bfhi(w.w); }
__device__ __forceinline__ u32x4 pack8(const float (&f)[8]) { u32x4 o; o.x = pk2(f[0], f[1]); o.y = pk2(f[2], f[3]); o.z = pk2(f[4], f[5]); o.w = pk2(f[6], f[7]); return o; }
template <int MASK> __device__ __forceinline__ float swz_xor(float v) { static_assert(MASK > 0 && MASK < 32, "swz_xor: 1..31"); return __builtin_bit_cast(float, __builtin_amdgcn_ds_swizzle(__builtin_bit_cast(int, v), 0x1f | (MASK << 10))); }
template <int MASK> __device__ __forceinline__ int swz_xor_i(int v) { return __builtin_amdgcn_ds_swizzle(v, 0x1f | (MASK << 10)); }
__device__ __forceinline__ float sum_x32(float v) { const unsigned u = __builtin_bit_cast(unsigned, v); auto r = __builtin_amdgcn_permlane32_swap(u, u, false, false); return __builtin_bit_cast(float, (unsigned)r[0]) + __builtin_bit_cast(float, (unsigned)r[1]); }
__device__ __forceinline__ float max_x32(float v) { const unsigned u = __builtin_bit_cast(unsigned, v); auto r = __builtin_amdgcn_permlane32_swap(u, u, false, false); return fmaxf(__builtin_bit_cast(float, (unsigned)r[0]), __builtin_bit_cast(float, (unsigned)r[1])); }
__device__ __forceinline__ int sum_x32_i(int v) { auto r = __builtin_amdgcn_permlane32_swap((unsigned)v, (unsigned)v, false, false); return (int)r[0] + (int)r[1]; }
__device__ __forceinline__ float wave_sum(float v) { v += swz_xor<1>(v); v += swz_xor<2>(v); v += swz_xor<4>(v); v += swz_xor<8>(v); v += swz_xor<16>(v); return sum_x32(v); }
__device__ __forceinline__ float wave_max(float v) { v = fmaxf(v, swz_xor<1>(v)); v = fmaxf(v, swz_xor<2>(v)); v = fmaxf(v, swz_xor<4>(v)); v = fmaxf(v, swz_xor<8>(v)); v = fmaxf(v, swz_xor<16>(v)); return max_x32(v); }
__device__ __forceinline__ int wave_sum_i(int v) { v += swz_xor_i<1>(v); v += swz_xor_i<2>(v); v += swz_xor_i<4>(v); v += swz_xor_i<8>(v); v += swz_xor_i<16>(v); return sum_x32_i(v); }
__device__ __forceinline__ float sum_x16_x32(float v) { v += swz_xor<16>(v); return sum_x32(v); }
__device__ __forceinline__ float sum_x1_x2(float v) { v += swz_xor<1>(v); v += swz_xor<2>(v); return v; }
__device__ __forceinline__ float ex2(float x) { return __builtin_amdgcn_exp2f(x); }
__device__ __forceinline__ float sigmoidf_(float x) { return 1.f / (1.f + ex2(-x * LOG2E)); }
__device__ __forceinline__ float gelu_tanh(float x) { const float u = 0.7978845608028654f * (x + 0.044715f * x * x * x); return x / (1.f + ex2(-2.f * LOG2E * u)); }
__device__ __forceinline__ f32x4 mfma16(bf16x8 a, bf16x8 b, f32x4 c) { return __builtin_amdgcn_mfma_f32_16x16x32_bf16(a, b, c, 0, 0, 0); }
__device__ __forceinline__ bf16x8 as_bf16x8(u32x4 w) { return __builtin_bit_cast(bf16x8, w); }
__device__ __forceinline__ float log2_sigmoid(float a) { return -log1pf(__expf(-a)) * LOG2E; }

struct GroupOrder {
    int nG, nM, nN, pmS, pnS, G, c;
    __device__ __forceinline__ bool next(int i, pg8::Unit& u) const {
        const long L = (long)i * G + c; const int tot = nG * nM * nN; if (L >= tot) return false;
        int wgid = (int)L; { const int q = tot / 8, r = tot % 8, xcd = wgid % 8, off = wgid / 8; wgid = (xcd < r ? xcd * (q + 1) : r * (q + 1) + (xcd - r) * q) + off; }
        const int per = nM * nN, g = wgid / per, rem = wgid - g * per;
        const int nig = 8 * nN, gid = rem / nig, fm = gid * 8, gsz = (nM - fm) < 8 ? (nM - fm) : 8;
        u.pm = g * pmS + fm + ((rem % nig) % gsz); u.pn = g * pnS + (rem % nig) / gsz; return true;
    }
    __device__ __forceinline__ void a_ready(const pg8::Unit&) const {}
    __device__ __forceinline__ void done(const pg8::Unit&) const {}
};
struct MergeOrder {
    int nM, G, c;
    __device__ __forceinline__ bool next(int i, pg8::Unit& u) const {
        const int ii = i / 3, g = i - 3 * ii; const long L = (long)ii * G + c; const int tot = nM * 4; if (L >= tot) return false;
        int wgid = (int)L; { const int q = tot / 8, r = tot % 8, xcd = wgid % 8, off = wgid / 8; wgid = (xcd < r ? xcd * (q + 1) : r * (q + 1) + (xcd - r) * q) + off; }
        const int nig = 32, gid = wgid / nig, fm = gid * 8, gsz = (nM - fm) < 8 ? (nM - fm) : 8;
        u.pm = g * (M / 256) + fm + ((wgid % nig) % gsz); u.pn = g * 4 + (wgid % nig) / gsz; return true;
    }
    __device__ __forceinline__ void a_ready(const pg8::Unit&) const {}
    __device__ __forceinline__ void done(const pg8::Unit&) const {}
};

struct EpiZA {
    static constexpr bool PERM = true, AFTER_DRAIN = false, CHAIN = false;
    bf16* O;
    __device__ __forceinline__ void operator()(const f32x4 (&acc)[2][2][4][2], const pg8::Unit& u, int wr, int wc, int fr, int fq) const {
        const int row0 = u.pm * 256 + wr * 64 + fr, col0 = u.pn * 256 + wc * 32 + 8 * fq; const bool act = false;
#pragma unroll
        for (int ai = 0; ai < 2; ++ai)
#pragma unroll
            for (int m = 0; m < 4; ++m) { bf16* rowp = O + (size_t)(row0 + ai * 128 + m * 16) * NZA + col0;
#pragma unroll
                for (int bj = 0; bj < 2; ++bj) { const f32x4 v0 = acc[ai][bj][m][0], v1 = acc[ai][bj][m][1];
                    float o[8] = {v0[0], v0[1], v0[2], v0[3], v1[0], v1[1], v1[2], v1[3]};
                    if (act) {
#pragma unroll
                        for (int k = 0; k < 8; ++k) o[k] = gelu_tanh(o[k]); }
                    *(u32x4*)(rowp + bj * 128) = pack8(o); } }
    }
};
struct EpiSig {
    static constexpr bool PERM = true, AFTER_DRAIN = false, CHAIN = false;
    bf16* O;
    __device__ __forceinline__ void operator()(const f32x4 (&acc)[2][2][4][2], const pg8::Unit& u, int wr, int wc, int fr, int fq) const {
        const int row0 = u.pm * 256 + wr * 64 + fr, col0 = u.pn * 256 + wc * 32 + 8 * fq;
#pragma unroll
        for (int ai = 0; ai < 2; ++ai)
#pragma unroll
            for (int m = 0; m < 4; ++m) { bf16* rowp = O + (size_t)(row0 + ai * 128 + m * 16) * NZG + col0;
#pragma unroll
                for (int bj = 0; bj < 2; ++bj) { const f32x4 v0 = acc[ai][bj][m][0], v1 = acc[ai][bj][m][1];
                    float o[8] = {v0[0], v0[1], v0[2], v0[3], v1[0], v1[1], v1[2], v1[3]};
#pragma unroll
                    for (int k = 0; k < 8; ++k) o[k] = fmaxf(sigmoidf_(o[k]), 1e-20f);
                    *(u32x4*)(rowp + bj * 128) = pack8(o); } }
    }
};
struct EpiMergeChain {
    static constexpr bool PERM = true, AFTER_DRAIN = false, CHAIN = true;
    const bf16* Gt; bf16* Hm;
    __device__ __forceinline__ bool chain(f32x4 (&acc)[2][2][4][2], const pg8::Unit& u, int wr, int wc, int fr, int fq) const {
        const int g = u.pm / (M / 256), m = u.pm - g * (M / 256), n = u.pn - g * 4;
        const int row0 = m * 256 + wr * 64 + fr, col0 = n * 256 + wc * 32 + 8 * fq;
#pragma unroll
        for (int ai = 0; ai < 2; ++ai) {
            u32x4 gw[4][2], hw[4][2];
#pragma unroll
            for (int mm = 0; mm < 4; ++mm)
#pragma unroll
                for (int bj = 0; bj < 2; ++bj) gw[mm][bj] = *(const u32x4*)(Gt + (size_t)(row0 + ai * 128 + mm * 16) * NZG + g * 1024 + col0 + bj * 128);
            if (g < 2) {
#pragma unroll
                for (int mm = 0; mm < 4; ++mm)
#pragma unroll
                    for (int bj = 0; bj < 2; ++bj) hw[mm][bj] = *(const u32x4*)(Gt + (size_t)(row0 + ai * 128 + mm * 16) * NZG + (g + 1) * 1024 + col0 + bj * 128);
            }
#pragma unroll
            for (int mm = 0; mm < 4; ++mm)
#pragma unroll
                for (int bj = 0; bj < 2; ++bj) {
                    float sc[8]; unpack8(gw[mm][bj], sc);
                    if (g < 2) { float sn[8]; unpack8(hw[mm][bj], sn);
#pragma unroll
                        for (int k = 0; k < 8; ++k) sc[k] *= __builtin_amdgcn_rcpf(sn[k]); }
                    f32x4& v0 = acc[ai][bj][mm][0]; f32x4& v1 = acc[ai][bj][mm][1];
                    v0[0] *= sc[0]; v0[1] *= sc[1]; v0[2] *= sc[2]; v0[3] *= sc[3]; v1[0] *= sc[4]; v1[1] *= sc[5]; v1[2] *= sc[6]; v1[3] *= sc[7];
                    if (g == 2) { u32x4 w; w.x = pk2(v0[0], v0[1]); w.y = pk2(v0[2], v0[3]); w.z = pk2(v1[0], v1[1]); w.w = pk2(v1[2], v1[3]);
                        *(u32x4*)(Hm + (size_t)(row0 + ai * 128 + mm * 16) * 1024 + col0 + bj * 128) = w; }
                }
        }
        return g < 2;
    }
};
struct EpiOut {
    static constexpr bool PERM = true, AFTER_DRAIN = false, CHAIN = false;
    const float* xl; const float* xc; bf16* X; const float* modv; int from_f32;
    __device__ __forceinline__ void operator()(const f32x4 (&acc)[2][2][4][2], const pg8::Unit& u, int wr, int wc, int fr, int fq) const {
        const int row0 = u.pm * 256 + wr * 64 + fr, col0 = u.pn * 256 + wc * 32 + 8 * fq;
        const int bi = (u.pm * 256 < ML) ? ((u.pm * 256) >> 12) : 8;
        const float* g1 = modv + bi * 6144 + 2 * 1024;
        f32x4 gv[2][2];
#pragma unroll
        for (int bj = 0; bj < 2; ++bj) { gv[bj][0] = *(const f32x4*)(g1 + col0 + bj * 128); gv[bj][1] = *(const f32x4*)(g1 + col0 + bj * 128 + 4); }
        if (from_f32) {
            const float* src0 = (u.pm * 256 < ML) ? xl + (size_t)row0 * 1024 : xc + (size_t)(row0 - ML) * 1024;
#pragma unroll
            for (int ai = 0; ai < 2; ++ai) {
                f32x4 xv[4][2][2];
#pragma unroll
                for (int m = 0; m < 4; ++m)
#pragma unroll
                    for (int bj = 0; bj < 2; ++bj) { const float* s = src0 + (size_t)(ai * 128 + m * 16) * 1024 + col0 + bj * 128; xv[m][bj][0] = *(const f32x4*)s; xv[m][bj][1] = *(const f32x4*)(s + 4); }
#pragma unroll
                for (int m = 0; m < 4; ++m)
#pragma unroll
                    for (int bj = 0; bj < 2; ++bj) { const f32x4 o0 = xv[m][bj][0] + gv[bj][0] * acc[ai][bj][m][0], o1 = xv[m][bj][1] + gv[bj][1] * acc[ai][bj][m][1];
                        u32x4 w; w.x = pk2(o0[0], o0[1]); w.y = pk2(o0[2], o0[3]); w.z = pk2(o1[0], o1[1]); w.w = pk2(o1[2], o1[3]);
                        *(u32x4*)(X + (size_t)(row0 + ai * 128 + m * 16) * 1024 + col0 + bj * 128) = w; }
            }
        } else {
#pragma unroll
            for (int ai = 0; ai < 2; ++ai) {
                u32x4 xw[4][2];
#pragma unroll
                for (int m = 0; m < 4; ++m)
#pragma unroll
                    for (int bj = 0; bj < 2; ++bj) xw[m][bj] = *(const u32x4*)(X + (size_t)(row0 + ai * 128 + m * 16) * 1024 + col0 + bj * 128);
#pragma unroll
                for (int m = 0; m < 4; ++m)
#pragma unroll
                    for (int bj = 0; bj < 2; ++bj) { float xo[8]; unpack8(xw[m][bj], xo); const f32x4 a0 = acc[ai][bj][m][0], a1 = acc[ai][bj][m][1];
                        float o[8] = {xo[0] + gv[bj][0][0] * a0[0], xo[1] + gv[bj][0][1] * a0[1], xo[2] + gv[bj][0][2] * a0[2], xo[3] + gv[bj][0][3] * a0[3],
                                      xo[4] + gv[bj][1][0] * a1[0], xo[5] + gv[bj][1][1] * a1[1], xo[6] + gv[bj][1][2] * a1[2], xo[7] + gv[bj][1][3] * a1[3]};
                        *(u32x4*)(X + (size_t)(row0 + ai * 128 + m * 16) * 1024 + col0 + bj * 128) = pack8(o); }
            }
        }
    }
};
struct EpiMoe1 {
    static constexpr bool PERM = true, AFTER_DRAIN = false, CHAIN = false;
    bf16* ACT;
    __device__ __forceinline__ void operator()(const f32x4 (&acc)[2][2][4][2], const pg8::Unit& u, int wr, int wc, int fr, int fq) const {
        const int row0 = u.pm * 256 + wr * 64 + fr, col0 = (u.pn & 7) * 128 + wc * 32 + 8 * fq;
#pragma unroll
        for (int ai = 0; ai < 2; ++ai)
#pragma unroll
            for (int m = 0; m < 4; ++m) { const size_t r = (size_t)(row0 + ai * 128 + m * 16);
                const f32x4 a0 = acc[ai][0][m][0], a1 = acc[ai][0][m][1], u0 = acc[ai][1][m][0], u1 = acc[ai][1][m][1];
                float o[8];
#pragma unroll
                for (int k = 0; k < 4; ++k) { o[k] = a0[k] * sigmoidf_(a0[k]) * u0[k]; o[4 + k] = a1[k] * sigmoidf_(a1[k]) * u1[k]; }
                *(u32x4*)(ACT + r * 1024 + col0) = pack8(o); }
    }
};
struct EpiMoe2 {
    static constexpr bool PERM = true, AFTER_DRAIN = false, CHAIN = false;
    bf16* Y; const float* topw;
    __device__ __forceinline__ void operator()(const f32x4 (&acc)[2][2][4][2], const pg8::Unit& u, int wr, int wc, int fr, int fq) const {
        const int row0 = u.pm * 256 + wr * 64 + fr, col0 = (u.pn & 3) * 256 + wc * 32 + 8 * fq;
        float twv[2][4];
#pragma unroll
        for (int ai = 0; ai < 2; ++ai)
#pragma unroll
            for (int m = 0; m < 4; ++m) twv[ai][m] = topw[row0 + ai * 128 + m * 16];
#pragma unroll
        for (int ai = 0; ai < 2; ++ai)
#pragma unroll
            for (int m = 0; m < 4; ++m) { const size_t r = (size_t)(row0 + ai * 128 + m * 16); const float tw = twv[ai][m];
#pragma unroll
                for (int bj = 0; bj < 2; ++bj) { const f32x4 v0 = acc[ai][bj][m][0] * tw, v1 = acc[ai][bj][m][1] * tw;
                    u32x4 w; w.x = pk2(v0[0], v0[1]); w.y = pk2(v0[2], v0[3]); w.z = pk2(v1[0], v1[1]); w.w = pk2(v1[2], v1[3]);
                    *(u32x4*)(Y + r * 1024 + col0 + bj * 128) = w; } }
    }
};

__device__ __forceinline__ void tr_item(const float* W, int N, int k0, int n0, bf16* dst, int K, LAS float* scr, int lane) {
#pragma unroll 8
    for (int i = 0; i < 32; ++i) { const int kk = 2 * i + (lane >> 5); scr[kk * 33 + (lane & 31)] = W[(size_t)(k0 + kk) * N + n0 + (lane & 31)]; }
    LDS_WAIT();
    const int cc = lane & 7;
#pragma unroll
    for (int j = 0; j < 4; ++j) { const int n = (lane >> 3) + 8 * j; const LAS float* s = scr + (8 * cc) * 33 + n;
        u32x4 o; o.x = pk2(s[0 * 33], s[1 * 33]); o.y = pk2(s[2 * 33], s[3 * 33]); o.z = pk2(s[4 * 33], s[5 * 33]); o.w = pk2(s[6 * 33], s[7 * 33]);
        *(u32x4*)(dst + (size_t)n * K + 8 * cc) = o; }
    LDS_WAIT();
}
__device__ __forceinline__ void convert_small(KPC p, int l, LAS unsigned char* lds, int lane, int wave, int bid, int G) {
    LAS float* scr = (LAS float*)(lds + wave * 8448);
    const int gw = bid * 8 + wave, NGW = G * 8;
    constexpr int I_IN = 16 * 200, I_BR = 8 * 32, I_OUT = 16 * 32;
    bf16* wtin = (bf16*)(p->ws + WS_WTIN); bf16* wtbr = (bf16*)(p->ws + WS_WTBR); bf16* wtout = (bf16*)(p->ws + WS_WTOUT);
    for (int it = gw; it < I_IN + 3 * I_BR + I_OUT; it += NGW) {
        int r = it;
        if (r < I_IN) { const int kb = r / 200, nb = r % 200; tr_item(p->w_in + (size_t)l * 1024 * 6400, 6400, 64 * kb, 32 * nb, wtin + (size_t)(32 * nb) * 1024 + 64 * kb, 1024, scr, lane); continue; }
        r -= I_IN;
        if (r < 3 * I_BR) { const int br = r / I_BR, q = r % I_BR, kb = q / 32, nb = q % 32;
            tr_item(p->w_branch + ((size_t)l * 3 + br) * 512 * 1024, 1024, 64 * kb, 32 * nb, wtbr + (size_t)(br * 1024 + 32 * nb) * 512 + 64 * kb, 512, scr, lane); continue; }
        r -= 3 * I_BR;
        { const int kb = r / 32, nb = r % 32; tr_item(p->w_out + (size_t)l * 1024 * 1024, 1024, 64 * kb, 32 * nb, wtout + (size_t)(32 * nb) * 1024 + 64 * kb, 1024, scr, lane); }
    }
}
__device__ __forceinline__ void convert_experts(KPC p, int l, int lo, int hi, int widx, int nw, LAS unsigned char* lds, int lane, int wave) {
    LAS float* scr = (LAS float*)(lds + wave * 8448);
    bf16* wt1 = (bf16*)(p->ws + WS_WT1); bf16* wt2 = (bf16*)(p->ws + WS_WT2);
    for (int it = lo + widx; it < hi; it += nw) {
        const int e = it / 1536, q = it % 1536, which = q / 512, qq = q % 512, kb = qq / 32, nb = qq % 32, n0 = 32 * nb, k0 = 64 * kb;
        const size_t woff = ((size_t)l * NE + e) * 1024 * 1024;
        if (which == 0) tr_item(p->w_eg + woff, 1024, k0, n0, wt1 + ((size_t)e * 2048 + (n0 >> 7) * 256 + (n0 & 127)) * 1024 + k0, 1024, scr, lane);
        else if (which == 1) tr_item(p->w_eu + woff, 1024, k0, n0, wt1 + ((size_t)e * 2048 + (n0 >> 7) * 256 + 128 + (n0 & 127)) * 1024 + k0, 1024, scr, lane);
        else tr_item(p->w_ed + woff, 1024, k0, n0, wt2 + ((size_t)e * 1024 + n0) * 1024 + k0, 1024, scr, lane);
    }
}
constexpr int CVT_ITEMS = NE * 3 * 512;
constexpr int CVT_G_IDLE0 = 96, CVT_M_IDLE0 = 32, CVT_O_IDLE0 = 32;
constexpr int CVT_G_HI = 7680, CVT_M_HI = 7680 + 14336;

__device__ __forceinline__ void phase_prep(KPC p, LAS unsigned char* lds, int tid, int lane, int wave, int bid, int G) {
    unsigned char* ws = p->ws;
    {   float* rc = (float*)(ws + WS_ROPEC); float* rsn = (float*)(ws + WS_ROPES);
        for (int i = bid * 512 + tid; i < T * 32; i += G * 512) { const int t = i >> 5, f = i & 31; const int pos = (f < 16) ? (t >> 6) : (t & 63); const int fi = f & 15;
            const float inv = ex2(-(float)fi * (13.287712379549449f / 16.f));
            float ang = (float)pos * inv; ang -= 6.283185307179586f * rintf(ang * 0.15915494309189535f);
            rc[i] = __cosf(ang); rsn[i] = __sinf(ang); } }
    {   LAS float* sv = (LAS float*)lds;
        LAS float* red = (LAS float*)(lds + 36864);
        for (int i = tid; i < 9 * 1024; i += 512) { const int r = i >> 10, k = i & 1023; const float v = (r < 8) ? p->c[r * 1024 + k] : p->c_ctx[k]; sv[i] = v * sigmoidf_(v); }
        __syncthreads();
        for (int it = bid; it < 192; it += G) {
            const int l = it / 96, n0 = (it % 96) * 64;
            const float* W = p->w_mod + (size_t)l * 1024 * 6144 + n0 + lane;
            float acc[9];
#pragma unroll
            for (int r = 0; r < 9; ++r) acc[r] = 0.f;
#pragma unroll 1
            for (int k0 = wave * 128; k0 < wave * 128 + 128; k0 += 16) {
                float wv[16];
#pragma unroll
                for (int kk = 0; kk < 16; ++kk) wv[kk] = W[(size_t)(k0 + kk) * 6144];
#pragma unroll
                for (int kk = 0; kk < 16; ++kk)
#pragma unroll
                    for (int r = 0; r < 9; ++r) acc[r] += sv[r * 1024 + k0 + kk] * wv[kk]; }
#pragma unroll
            for (int r = 0; r < 9; ++r) red[(wave * 9 + r) * 64 + lane] = acc[r];
            __syncthreads();
            for (int i = tid; i < 576; i += 512) { const int r = i >> 6, ln = i & 63; float s = 0.f;
#pragma unroll
                for (int w = 0; w < 8; ++w) s += red[(w * 9 + r) * 64 + ln];
                s += p->b_mod[l * 6144 + n0 + ln]; ((float*)(ws + WS_MODV))[(l * 9 + r) * 6144 + n0 + ln] = s; }
            __syncthreads();
        }
    }
    __syncthreads();
    convert_small(p, 0, lds, lane, wave, bid, G);
}

__device__ __forceinline__ float row_rs(const f32x4 (&v)[4]) {
    float ss = 0.f;
#pragma unroll
    for (int j = 0; j < 4; ++j) ss += (v[j].x * v[j].x + v[j].y * v[j].y) + (v[j].z * v[j].z + v[j].w * v[j].w);
    return 1.0f / sqrtf(wave_sum(ss) * (1.f / 1024.f) + EPS);
}
__device__ __forceinline__ void norm_mod(const f32x4 (&v)[4], float rs, const float* gain, const float* sh, const float* sc, f32x4 (&h)[4], int lane) {
#pragma unroll
    for (int j = 0; j < 4; ++j) { const int col = 4 * lane + 256 * j; const f32x4 g = *(const f32x4*)(gain + col), a = *(const f32x4*)(sc + col), b = *(const f32x4*)(sh + col);
        h[j] = (v[j] * rs) * g * (a + 1.0f) + b; }
}
__device__ __forceinline__ void store_h(const f32x4 (&h)[4], bf16* hrow, int lane) {
#pragma unroll
    for (int j = 0; j < 4; ++j) { u32x2 w; w.x = pk2(h[j].x, h[j].y); w.y = pk2(h[j].z, h[j].w); *(u32x2*)(hrow + 4 * lane + 256 * j) = w; }
}
__device__ __forceinline__ void phase_norm_in(KPC p, int lane, int wave, int bid, int G) {
    const float* modv = (const float*)(p->ws + WS_MODV); bf16* H = (bf16*)(p->ws + WS_H);
    const int stride = G * 8; int r = bid * 8 + wave;
    f32x4 vn[4];
    {   const float* src = (r < ML) ? p->x + (size_t)r * 1024 : p->ctx + (size_t)(r - ML) * 1024;
#pragma unroll
        for (int j = 0; j < 4; ++j) vn[j] = (r < M) ? *(const f32x4*)(src + 4 * lane + 256 * j) : (f32x4){0.f, 0.f, 0.f, 0.f}; }
    for (; r < M; r += stride) {
        const int bi = (r < ML) ? (r >> 12) : 8; const float* mv = modv + bi * 6144;
        f32x4 v[4], h[4], g[4], sc[4], sh[4];
#pragma unroll
        for (int j = 0; j < 4; ++j) { v[j] = vn[j]; const int col = 4 * lane + 256 * j; g[j] = *(const f32x4*)(p->norm1_g + col); sh[j] = *(const f32x4*)(mv + col); sc[j] = *(const f32x4*)(mv + 1024 + col); }
        const int rn = r + stride;
        if (rn < M) { const float* src = (rn < ML) ? p->x + (size_t)rn * 1024 : p->ctx + (size_t)(rn - ML) * 1024;
#pragma unroll
            for (int j = 0; j < 4; ++j) vn[j] = *(const f32x4*)(src + 4 * lane + 256 * j); }
        const float rs = row_rs(v);
#pragma unroll
        for (int j = 0; j < 4; ++j) h[j] = (v[j] * rs) * g[j] * (sc[j] + 1.0f) + sh[j];
        store_h(h, H + (size_t)r * 1024, lane);
    }
}

typedef short s16x4 __attribute__((ext_vector_type(4)));
__device__ __forceinline__ u32x2 lds_tr16(const LAS unsigned char* addr) { const s16x4 r = __builtin_amdgcn_ds_read_tr16_b64_v4i16((LAS s16x4*)addr); return __builtin_bit_cast(u32x2, r); }
__device__ __forceinline__ void ld8f(const float* p, float (&f)[8]) { const f32x4 a = *(const f32x4*)p, b = *(const f32x4*)(p + 4); f[0] = a[0]; f[1] = a[1]; f[2] = a[2]; f[3] = a[3]; f[4] = b[0]; f[5] = b[1]; f[6] = b[2]; f[7] = b[3]; }
__device__ __forceinline__ void att_item(KPC p, int l, LAS unsigned char* lds, int item, float Mb2, int tid, int lane, int wave) {
    const bf16* ZA = (const bf16*)(p->ws + WS_ZA); bf16* BR = (bf16*)p->out + (size_t)2 * M * 512;
    const float* rc = (const float*)(p->ws + WS_ROPEC); const float* rsn = (const float*)(p->ws + WS_ROPES);
    const bool isctx = item >= 512;
    int b, kvh, qb;
    if (!isctx) { b = item >> 6; kvh = (item >> 5) & 1; qb = item & 31; } else { const int ci = item - 512; b = ci >> 2; kvh = (ci >> 1) & 1; qb = ci & 1; }
    const int rowbase = isctx ? ML + b * CL : b * T;
    const int g = wave >> 1, qs = wave & 1, hh = kvh * 4 + g, c = lane & 15, g4 = lane >> 4, q0 = qb * 128 + qs * 64;
    const float* qg = p->qn_g + l * 64; const float* kg = p->kn_g + l * 64;
    LAS unsigned char* Kl = lds;
    bf16x8 qf[4][2];
    float qga[8], qgb[8]; ld8f(qg + 8 * g4, qga); ld8f(qg + 32 + 8 * g4, qgb);
#pragma unroll
    for (int ti = 0; ti < 4; ++ti) {
        const int pos = q0 + 16 * ti + c; const bf16* src = ZA + (size_t)(rowbase + pos) * NZA + C_AQ + hh * 64 + 8 * g4;
        float a[8], bb[8]; unpack8(*(const u32x4*)src, a); unpack8(*(const u32x4*)(src + 32), bb);
        float ss = 0.f;
#pragma unroll
        for (int j = 0; j < 8; ++j) ss += a[j] * a[j] + bb[j] * bb[j];
        ss = sum_x16_x32(ss);
        const float rs = 1.0f / sqrtf(ss * (1.f / 64.f) + EPS);
#pragma unroll
        for (int j = 0; j < 8; ++j) { a[j] *= rs * qga[j]; bb[j] *= rs * qgb[j]; }
        if (!isctx) { float cs8[8], sn8[8]; ld8f(rc + pos * 32 + 8 * g4, cs8); ld8f(rsn + pos * 32 + 8 * g4, sn8);
#pragma unroll
            for (int j = 0; j < 8; ++j) { const float cs = cs8[j], sn = sn8[j]; const float x1 = a[j], x2 = bb[j]; a[j] = x1 * cs - x2 * sn; bb[j] = x1 * sn + x2 * cs; } }
#pragma unroll
        for (int j = 0; j < 8; ++j) { a[j] *= 0.125f * LOG2E; bb[j] *= 0.125f * LOG2E; }
        qf[ti][0] = as_bf16x8(pack8(a)); qf[ti][1] = as_bf16x8(pack8(bb));
        __builtin_amdgcn_sched_barrier(0);
    }
    f32x4 O[4][4]; float lsum[4];
#pragma unroll
    for (int i = 0; i < 4; ++i) { lsum[i] = 0.f;
#pragma unroll
        for (int j = 0; j < 4; ++j) O[i][j] = (f32x4){0.f, 0.f, 0.f, 0.f}; }
    const int key = tid >> 2, q4 = tid & 3;
    LAS unsigned char* Vl = lds + 55296;
#pragma unroll 1
    for (int st = isctx ? 1 : 0; st < 2; ++st) {
        __syncthreads();
        {   u32x4 kr[1][2], vr[1][2];
#define ATT_VB(lb_) ((st == 0) ? ((qb - 1 + (lb_)) >= 0 && (qb - 1 + (lb_)) <= 31) : ((lb_) < 2))
#define ATT_LD(lb_, s_) do { if (ATT_VB(lb_)) { const int krow = (st == 0) ? b * T + (qb - 1 + (lb_)) * 128 + key : ML + b * CL + 128 * (lb_) + key; \
                const bf16* ks = ZA + (size_t)krow * NZA + C_AK + kvh * 64 + 8 * q4; kr[s_][0] = *(const u32x4*)ks; kr[s_][1] = *(const u32x4*)(ks + 32); \
                const bf16* vs = ZA + (size_t)krow * NZA + C_AV + kvh * 64 + 16 * q4; vr[s_][0] = *(const u32x4*)vs; vr[s_][1] = *(const u32x4*)(vs + 8); } } while (0)
#pragma unroll 1
            for (int lb = 0; lb < 3; ++lb) {
                ATT_LD(lb, 0);
                if (ATT_VB(lb)) {
                    float a[8], bb[8]; unpack8(kr[0][0], a); unpack8(kr[0][1], bb);
                    float ss = 0.f;
#pragma unroll
                    for (int j = 0; j < 8; ++j) ss += a[j] * a[j] + bb[j] * bb[j];
                    ss = sum_x1_x2(ss);
                    const float rs = 1.0f / sqrtf(ss * (1.f / 64.f) + EPS);
                    float kga[8], kgb[8]; ld8f(kg + 8 * q4, kga); ld8f(kg + 32 + 8 * q4, kgb);
#pragma unroll
                    for (int j = 0; j < 8; ++j) { a[j] *= rs * kga[j]; bb[j] *= rs * kgb[j]; }
                    __builtin_amdgcn_sched_barrier(0);
                    if (st == 0) { const int pos = (qb - 1 + lb) * 128 + key; float cs8[8], sn8[8]; ld8f(rc + pos * 32 + 8 * q4, cs8); ld8f(rsn + pos * 32 + 8 * q4, sn8);
#pragma unroll
                        for (int j = 0; j < 8; ++j) { const float cs = cs8[j], sn = sn8[j]; const float x1 = a[j], x2 = bb[j]; a[j] = x1 * cs - x2 * sn; bb[j] = x1 * sn + x2 * cs; } }
                    LAS unsigned char* kd = Kl + (lb * 128 + key) * 144; *(LAS u32x4*)(kd + 16 * q4) = pack8(a); *(LAS u32x4*)(kd + 64 + 16 * q4) = pack8(bb);
                    LAS unsigned char* vd = Vl + (lb * 128 + key) * 144 + 32 * q4; *(LAS u32x4*)vd = vr[0][0]; *(LAS u32x4*)(vd + 16) = vr[0][1];
                }
            }
#undef ATT_VB
#undef ATT_LD
        }
        __syncthreads();
#pragma unroll 1
        for (int lb = 0; lb < 3; ++lb) {
            if (st == 0) { const int kb = qb - 1 + lb; if (kb < 0 || kb > 31) continue; } else if (lb >= 2) continue;
            const int mode = (st == 0) ? ((lb == 0) ? 1 : ((lb == 2) ? 2 : 0)) : 0;
            const LAS unsigned char* Kb = Kl + lb * 128 * 144; const LAS unsigned char* Vb = Vl + lb * 128 * 144;
#pragma unroll 1
            for (int kk = 0; kk < 4; ++kk) {
                if ((mode == 1 && 32 * kk + 31 < qs * 64) || (mode == 2 && 32 * kk > qs * 64 + 63)) continue;
                bf16x8 ka[2][2];
#pragma unroll
                for (int hf = 0; hf < 2; ++hf)
#pragma unroll
                    for (int ks = 0; ks < 2; ++ks) ka[hf][ks] = *(const LAS bf16x8*)(Kb + (32 * kk + 16 * hf + c) * 144 + ks * 64 + g4 * 16);
                bf16x8 pf[4];
#pragma unroll
                for (int ti = 0; ti < 4; ++ti) {
                    f32x4 sa = (f32x4){-Mb2, -Mb2, -Mb2, -Mb2}, sb = sa;
                    sa = mfma16(ka[0][0], qf[ti][0], sa); sa = mfma16(ka[0][1], qf[ti][1], sa);
                    sb = mfma16(ka[1][0], qf[ti][0], sb); sb = mfma16(ka[1][1], qf[ti][1], sb);
                    float pa[4], pb[4];
#pragma unroll
                    for (int rr = 0; rr < 4; ++rr) { pa[rr] = ex2(sa[rr]); pb[rr] = ex2(sb[rr]); }
                    if (mode != 0) {
                        const int ii = qs * 64 + 16 * ti + c; const int mlo = (mode == 1) ? ii : -1000, mhi = (mode == 2) ? ii : 1000;
#pragma unroll
                        for (int rr = 0; rr < 4; ++rr) { const int ja = 32 * kk + 4 * g4 + rr, jb = ja + 16;
                            pa[rr] = (ja >= mlo && ja <= mhi) ? pa[rr] : 0.f; pb[rr] = (jb >= mlo && jb <= mhi) ? pb[rr] : 0.f; } }
                    lsum[ti] += ((pa[0] + pa[1]) + (pa[2] + pa[3])) + ((pb[0] + pb[1]) + (pb[2] + pb[3]));
                    u32x4 w; w.x = pk2(pa[0], pa[1]); w.y = pk2(pa[2], pa[3]); w.z = pk2(pb[0], pb[1]); w.w = pk2(pb[2], pb[3]); pf[ti] = as_bf16x8(w);
                }
#pragma unroll
                for (int dt = 0; dt < 4; ++dt) {
                    const u32x2 v0 = lds_tr16(Vb + (32 * kk + 4 * g4 + (c >> 2)) * 144 + (16 * dt + 4 * (c & 3)) * 2), v1 = lds_tr16(Vb + (32 * kk + 16 + 4 * g4 + (c >> 2)) * 144 + (16 * dt + 4 * (c & 3)) * 2);
                    u32x4 vv; vv.x = v0.x; vv.y = v0.y; vv.z = v1.x; vv.w = v1.y; const bf16x8 va = as_bf16x8(vv);
#pragma unroll
                    for (int ti = 0; ti < 4; ++ti) O[dt][ti] = mfma16(va, pf[ti], O[dt][ti]);
                }
            }
        }
    }
    const float sk = ex2(p->sink[l * 8 + hh] * LOG2E - Mb2);
#pragma unroll
    for (int ti = 0; ti < 4; ++ti) { float lt = sum_x16_x32(lsum[ti]); const float inv = 1.0f / (lt + sk);
        bf16* dst = BR + (size_t)(rowbase + q0 + 16 * ti + c) * 512 + hh * 64 + 4 * g4;
#pragma unroll
        for (int dt = 0; dt < 4; ++dt) { const f32x4 o = O[dt][ti] * inv; u32x2 w; w.x = pk2(o[0], o[1]); w.y = pk2(o[2], o[3]); *(u32x2*)(dst + 16 * dt) = w; } }
    __syncthreads();
}

__device__ __forceinline__ void sgu_vprep_item(KPC p, int ch, int tid) {
    bf16* ZA = (bf16*)(p->ws + WS_ZA);
    const int seg = tid & 15;
    bf16* rowp0 = ZA + (size_t)(ch * 128 + (tid >> 4)) * NZA + C_SV + 32 * seg;
    u32x4 raw[4][4];
#pragma unroll
    for (int ps = 0; ps < 4; ++ps)
#pragma unroll
        for (int q = 0; q < 4; ++q) raw[ps][q] = *(const u32x4*)(rowp0 + (size_t)ps * 32 * NZA + 8 * q);
#pragma unroll
    for (int ps = 0; ps < 4; ++ps) {
        bf16* rowp = rowp0 + (size_t)ps * 32 * NZA;
        float f[4][8]; float s = 0.f, ss = 0.f;
#pragma unroll
        for (int q = 0; q < 4; ++q) unpack8(raw[ps][q], f[q]);
#pragma unroll
        for (int q = 0; q < 4; ++q)
#pragma unroll
            for (int e = 0; e < 8; ++e) { const float y = gelu_tanh(f[q][e]); f[q][e] = y; s += y; ss += y * y; }
        s += swz_xor<1>(s); s += swz_xor<2>(s); s += swz_xor<4>(s); s += swz_xor<8>(s);
        ss += swz_xor<1>(ss); ss += swz_xor<2>(ss); ss += swz_xor<4>(ss); ss += swz_xor<8>(ss);
        const float mean = s * (1.f / 512.f), var = fmaxf(ss * (1.f / 512.f) - mean * mean, 0.f), rstd = 1.0f / sqrtf(var + EPS);
#pragma unroll
        for (int q = 0; q < 4; ++q) {
#pragma unroll
            for (int e = 0; e < 8; ++e) f[q][e] = (f[q][e] - mean) * rstd;
            *(u32x4*)(rowp + 8 * q) = pack8(f[q]); }
    }
}
__device__ __forceinline__ void sgu_item(KPC p, int l, LAS unsigned char* lds, int item, int tid, int lane, int wave) {
    const bf16* ZA = (const bf16*)(p->ws + WS_ZA); bf16* BR = (bf16*)p->out + (size_t)1 * M * 512;
    const int ch = item >> 2, g = item & 3, r0 = ch * 128, c = lane & 15, g4 = lane >> 4;
    LAS unsigned char* vT = lds;
    LAS unsigned char* WL = lds + 34816;
    {   const int j = tid >> 2, q4 = tid & 3; const bf16* src = ZA + (size_t)(r0 + j) * NZA + C_SV + 128 * g + 32 * q4;
#pragma unroll
        for (int q = 0; q < 4; ++q) { const u32x4 v = *(const u32x4*)(src + 8 * q); const unsigned vw[4] = {v.x, v.y, v.z, v.w};
#pragma unroll
            for (int e = 0; e < 4; ++e) { *(LAS unsigned short*)(vT + (32 * q4 + 8 * q + 2 * e) * 272 + j * 2) = (unsigned short)(vw[e] & 0xffffu); *(LAS unsigned short*)(vT + (32 * q4 + 8 * q + 2 * e + 1) * 272 + j * 2) = (unsigned short)(vw[e] >> 16); } }
        const float* wsrc = p->sgu_w + ((size_t)(l * 4 + g) * 128 + (tid >> 2)) * 128 + 32 * (tid & 3);
#pragma unroll
        for (int q = 0; q < 4; ++q) { const f32x4 a = *(const f32x4*)(wsrc + 8 * q), bq = *(const f32x4*)(wsrc + 8 * q + 4);
            u32x4 w; w.x = pk2(a.x, a.y); w.y = pk2(a.z, a.w); w.z = pk2(bq.x, bq.y); w.w = pk2(bq.z, bq.w);
            *(LAS u32x4*)(WL + (tid >> 2) * 272 + (32 * (tid & 3) + 8 * q) * 2) = w; }
    }
    __syncthreads();
    bf16x8 af[4];
#pragma unroll
    for (int ks = 0; ks < 4; ++ks) af[ks] = *(const LAS bf16x8*)(vT + (16 * wave + c) * 272 + (32 * ks + 8 * g4) * 2);
    const int col = 128 * g + 16 * wave + 4 * g4;
    u32x2 uw[8]; float bias[8];
#pragma unroll
    for (int ti = 0; ti < 8; ++ti) { uw[ti] = *(const u32x2*)(ZA + (size_t)(r0 + 16 * ti + c) * NZA + C_SU + col); bias[ti] = p->sgu_b[(l * 4 + g) * 128 + 16 * ti + c]; }
#pragma unroll
    for (int ti = 0; ti < 8; ++ti) {
        f32x4 acc = (f32x4){0.f, 0.f, 0.f, 0.f};
#pragma unroll
        for (int ks = 0; ks < 4; ++ks) acc = mfma16(af[ks], *(const LAS bf16x8*)(WL + (16 * ti + c) * 272 + (32 * ks + 8 * g4) * 2), acc);
        const float o0 = gelu_tanh(bflo(uw[ti].x)) * (acc[0] + bias[ti]), o1 = gelu_tanh(bfhi(uw[ti].x)) * (acc[1] + bias[ti]), o2 = gelu_tanh(bflo(uw[ti].y)) * (acc[2] + bias[ti]), o3 = gelu_tanh(bfhi(uw[ti].y)) * (acc[3] + bias[ti]);
        u32x2 w; w.x = pk2(o0, o1); w.y = pk2(o2, o3); *(u32x2*)(BR + (size_t)(r0 + 16 * ti + c) * 512 + col) = w;
    }
    __syncthreads();
}

__device__ __forceinline__ void ret_load_k(KPC p, const bf16* ZA, int r0, int h, bool latent, int pos0, int tid, float (&a)[8], float (&bb)[8]) {
    const int j = tid >> 2, q4 = tid & 3; const bf16* src = ZA + (size_t)(r0 + j) * NZA + C_RK + 64 * h + 8 * q4;
    unpack8(*(const u32x4*)src, a); unpack8(*(const u32x4*)(src + 32), bb);
    if (latent) { const float* rc = (const float*)(p->ws + WS_ROPEC); const float* rsn = (const float*)(p->ws + WS_ROPES); const int pos = pos0 + j; float cs8[8], sn8[8]; ld8f(rc + pos * 32 + 8 * q4, cs8); ld8f(rsn + pos * 32 + 8 * q4, sn8);
#pragma unroll
        for (int e = 0; e < 8; ++e) { const float cs = cs8[e], sn = sn8[e]; const float x1 = a[e], x2 = bb[e]; a[e] = x1 * cs - x2 * sn; bb[e] = x1 * sn + x2 * cs; } }
#pragma unroll
    for (int e = 0; e < 8; ++e) { a[e] *= 0.125f; bb[e] *= 0.125f; }
}
__device__ __forceinline__ void ret_stage_vT(const bf16* ZA, int r0, int h, LAS unsigned char* vT, int tid) {
    const int j = tid >> 2, q4 = tid & 3; const bf16* src = ZA + (size_t)(r0 + j) * NZA + C_RV + 128 * h + 32 * q4;
#pragma unroll
    for (int q = 0; q < 4; ++q) { const u32x4 v = *(const u32x4*)(src + 8 * q); const unsigned vw[4] = {v.x, v.y, v.z, v.w};
#pragma unroll
        for (int e = 0; e < 4; ++e) { *(LAS unsigned short*)(vT + (32 * q4 + 8 * q + 2 * e) * 272 + j * 2) = (unsigned short)(vw[e] & 0xffffu); *(LAS unsigned short*)(vT + (32 * q4 + 8 * q + 2 * e + 1) * 272 + j * 2) = (unsigned short)(vw[e] >> 16); } }
}
__device__ __forceinline__ void ret_upd_item(KPC p, int l, LAS unsigned char* lds, int item, int tid, int lane, int wave) {
    const bf16* ZA = (const bf16*)(p->ws + WS_ZA); float* RS = (float*)(p->ws + WS_RS);
    const int b = item / (NCH * 4), rem = item % (NCH * 4), n = rem >> 2, h = rem & 3, c = lane & 15, g4 = lane >> 4;
    const bool latent = n < 32; const int r0 = latent ? b * T + 128 * n : ML + b * CL + 128 * (n - 32);
    const float lgf = log2_sigmoid(p->dec_f[l * 4 + h]), lgb = log2_sigmoid(p->dec_b[l * 4 + h]);
    LAS unsigned char* vT = lds; LAS unsigned char* kTf = lds + 34816; LAS unsigned char* kTb = lds + 34816 + 17408;
    {   float a[8], bb[8]; ret_load_k(p, ZA, r0, h, latent, 128 * n, tid, a, bb);
        const int j = tid >> 2, q4 = tid & 3; const float wf = ex2((float)(127 - j) * lgf), wb = ex2((float)j * lgb);
#pragma unroll
        for (int e = 0; e < 8; e += 2) {
            unsigned w = pk2(a[e] * wf, a[e + 1] * wf); *(LAS unsigned short*)(kTf + (8 * q4 + e) * 272 + j * 2) = (unsigned short)(w & 0xffffu); *(LAS unsigned short*)(kTf + (8 * q4 + e + 1) * 272 + j * 2) = (unsigned short)(w >> 16);
            w = pk2(bb[e] * wf, bb[e + 1] * wf); *(LAS unsigned short*)(kTf + (32 + 8 * q4 + e) * 272 + j * 2) = (unsigned short)(w & 0xffffu); *(LAS unsigned short*)(kTf + (32 + 8 * q4 + e + 1) * 272 + j * 2) = (unsigned short)(w >> 16);
            w = pk2(a[e] * wb, a[e + 1] * wb); *(LAS unsigned short*)(kTb + (8 * q4 + e) * 272 + j * 2) = (unsigned short)(w & 0xffffu); *(LAS unsigned short*)(kTb + (8 * q4 + e + 1) * 272 + j * 2) = (unsigned short)(w >> 16);
            w = pk2(bb[e] * wb, bb[e + 1] * wb); *(LAS unsigned short*)(kTb + (32 + 8 * q4 + e) * 272 + j * 2) = (unsigned short)(w & 0xffffu); *(LAS unsigned short*)(kTb + (32 + 8 * q4 + e + 1) * 272 + j * 2) = (unsigned short)(w >> 16);
        }
        ret_stage_vT(ZA, r0, h, vT, tid);
    }
    __syncthreads();
    bf16x8 af[4];
#pragma unroll
    for (int ks = 0; ks < 4; ++ks) af[ks] = *(const LAS bf16x8*)(vT + (16 * wave + c) * 272 + (32 * ks + 8 * g4) * 2);
#pragma unroll
    for (int dir = 0; dir < 2; ++dir) { const LAS unsigned char* kT = dir ? kTb : kTf;
        float* dst = RS + ((size_t)(((b * 4 + h) * 2 + dir) * NCH + n) * 128 + 16 * wave + 4 * g4) * 64;
#pragma unroll
        for (int dt = 0; dt < 4; ++dt) { f32x4 acc = (f32x4){0.f, 0.f, 0.f, 0.f};
#pragma unroll
            for (int ks = 0; ks < 4; ++ks) acc = mfma16(af[ks], *(const LAS bf16x8*)(kT + (16 * dt + c) * 272 + (32 * ks + 8 * g4) * 2), acc);
#pragma unroll
            for (int rr = 0; rr < 4; ++rr) dst[rr * 64 + 16 * dt + c] = acc[rr]; } }
    __syncthreads();
}
__device__ __forceinline__ void phase_scan(KPC p, int l, int tid, int bid, int G) {
    const float* __restrict__ RS = (const float*)(p->ws + WS_RS); bf16* __restrict__ ST = (bf16*)(p->ws + WS_ST);
    for (int idx = bid * 512 + tid; idx < NB * 4 * 2 * 8192; idx += G * 512) {
        const int ed = idx & 8191, dir = (idx >> 13) & 1, bh = idx >> 14, e = ed >> 6, d = ed & 63, h = bh & 3;
        const float* P = RS + (size_t)((bh * 2 + dir) * NCH) * 8192 + ed;
        bf16* S = ST + ((size_t)bh * NCH * 128 + e) * 128 + dir * 64 + d;
        const float lg = log2_sigmoid(dir ? p->dec_b[l * 4 + h] : p->dec_f[l * 4 + h]); const float dec = ex2(128.f * lg);
        float u[NCH];
#pragma unroll
        for (int n = 0; n < NCH; ++n) u[n] = P[(size_t)n * 8192];
        if (dir == 0) {
            S[32 * 16384] = 0; S[33 * 16384] = (bf16)(pk2(u[32], 0.f) & 0xffffu);
            float s = dec * u[32] + u[33];
#pragma unroll
            for (int n = 0; n < 32; ++n) { S[(size_t)n * 16384] = (bf16)(pk2(s, 0.f) & 0xffffu); s = dec * s + u[n]; }
        } else {
            S[33 * 16384] = 0; S[32 * 16384] = (bf16)(pk2(u[33], 0.f) & 0xffffu);
            float s = dec * u[33] + u[32];
#pragma unroll
            for (int n = 31; n >= 0; --n) { S[(size_t)n * 16384] = (bf16)(pk2(s, 0.f) & 0xffffu); s = dec * s + u[n]; }
        }
    }
}
__device__ __forceinline__ void ret_out_item(KPC p, int l, LAS unsigned char* lds, int item, int tid, int lane, int wave) {
    const bf16* ZA = (const bf16*)(p->ws + WS_ZA); bf16* BR = (bf16*)p->out; const bf16* ST = (const bf16*)(p->ws + WS_ST);
    const int b = item / (NCH * 4), rem = item % (NCH * 4), n = rem >> 2, h = rem & 3, c = lane & 15, g4 = lane >> 4;
    const bool latent = n < 32; const int r0 = latent ? b * T + 128 * n : ML + b * CL + 128 * (n - 32);
    const float lgf = log2_sigmoid(p->dec_f[l * 4 + h]), lgb = log2_sigmoid(p->dec_b[l * 4 + h]);
    LAS unsigned char* vT = lds; LAS unsigned char* Kl = lds + 34816; LAS unsigned char* Sl = lds + 34816 + 18432;
    {   float a[8], bb[8]; ret_load_k(p, ZA, r0, h, latent, 128 * n, tid, a, bb);
        const int j = tid >> 2, q4 = tid & 3;
        *(LAS u32x4*)(Kl + j * 144 + 16 * q4) = pack8(a); *(LAS u32x4*)(Kl + j * 144 + 64 + 16 * q4) = pack8(bb);
        ret_stage_vT(ZA, r0, h, vT, tid);
        const u32x4* ssrc = (const u32x4*)(ST + (size_t)((b * 4 + h) * NCH + n) * 16384);
#pragma unroll
        for (int k = 0; k < 4; ++k) { const int q = tid + 512 * k; *(LAS u32x4*)(Sl + (q >> 4) * 272 + (q & 15) * 16) = ssrc[q]; }
    }
    __syncthreads();
    const int ii = 16 * wave + c;
    bf16x8 qf[2];
    {   const bf16* src = ZA + (size_t)(r0 + ii) * NZA + C_RQ + 64 * h + 8 * g4; float a[8], bb[8]; unpack8(*(const u32x4*)src, a); unpack8(*(const u32x4*)(src + 32), bb);
        if (latent) { const float* rc = (const float*)(p->ws + WS_ROPEC); const float* rsn = (const float*)(p->ws + WS_ROPES); const int pos = 128 * n + ii; float cs8[8], sn8[8]; ld8f(rc + pos * 32 + 8 * g4, cs8); ld8f(rsn + pos * 32 + 8 * g4, sn8);
#pragma unroll
            for (int e = 0; e < 8; ++e) { const float cs = cs8[e], sn = sn8[e]; const float x1 = a[e], x2 = bb[e]; a[e] = x1 * cs - x2 * sn; bb[e] = x1 * sn + x2 * cs; } }
        qf[0] = as_bf16x8(pack8(a)); qf[1] = as_bf16x8(pack8(bb)); }
    bf16x8 pf[4];
#pragma unroll
    for (int kk = 0; kk < 4; ++kk) {
        f32x4 sa = (f32x4){0.f, 0.f, 0.f, 0.f}, sb = (f32x4){0.f, 0.f, 0.f, 0.f};
        sa = mfma16(*(const LAS bf16x8*)(Kl + (32 * kk + c) * 144 + g4 * 16), qf[0], sa); sa = mfma16(*(const LAS bf16x8*)(Kl + (32 * kk + c) * 144 + 64 + g4 * 16), qf[1], sa);
        sb = mfma16(*(const LAS bf16x8*)(Kl + (32 * kk + 16 + c) * 144 + g4 * 16), qf[0], sb); sb = mfma16(*(const LAS bf16x8*)(Kl + (32 * kk + 16 + c) * 144 + 64 + g4 * 16), qf[1], sb);
        float pa[4], pb[4];
#pragma unroll
        for (int rr = 0; rr < 4; ++rr) { const int ja = 32 * kk + 4 * g4 + rr, jb = ja + 16; const int da = ii - ja, db = ii - jb;
            pa[rr] = sa[rr] * ((da >= 0) ? ex2((float)da * lgf) : ex2((float)(-da) * lgb)); pb[rr] = sb[rr] * ((db >= 0) ? ex2((float)db * lgf) : ex2((float)(-db) * lgb)); }
        u32x4 w; w.x = pk2(pa[0], pa[1]); w.y = pk2(pa[2], pa[3]); w.z = pk2(pb[0], pb[1]); w.w = pk2(pb[2], pb[3]); pf[kk] = as_bf16x8(w);
    }
    const float cf = ex2((float)(ii + 1) * lgf), cb = ex2((float)(128 - ii) * lgb);
    f32x4 O[8]; float s = 0.f, ss = 0.f;
#pragma unroll
    for (int et = 0; et < 8; ++et) {
        f32x4 acc = (f32x4){0.f, 0.f, 0.f, 0.f}, xf = (f32x4){0.f, 0.f, 0.f, 0.f}, xb = (f32x4){0.f, 0.f, 0.f, 0.f};
#pragma unroll
        for (int kk = 0; kk < 4; ++kk) { const u32x2 v0 = *(const LAS u32x2*)(vT + (16 * et + c) * 272 + (32 * kk + 4 * g4) * 2), v1 = *(const LAS u32x2*)(vT + (16 * et + c) * 272 + (32 * kk + 16 + 4 * g4) * 2);
            u32x4 vv; vv.x = v0.x; vv.y = v0.y; vv.z = v1.x; vv.w = v1.y; acc = mfma16(as_bf16x8(vv), pf[kk], acc); }
#pragma unroll
        for (int ks = 0; ks < 2; ++ks) { xf = mfma16(*(const LAS bf16x8*)(Sl + (16 * et + c) * 272 + (32 * ks + 8 * g4) * 2), qf[ks], xf);
            xb = mfma16(*(const LAS bf16x8*)(Sl + (16 * et + c) * 272 + (64 + 32 * ks + 8 * g4) * 2), qf[ks], xb); }
        acc = acc + xf * cf + xb * cb; O[et] = acc;
        s += (acc[0] + acc[1]) + (acc[2] + acc[3]); ss += (acc[0] * acc[0] + acc[1] * acc[1]) + (acc[2] * acc[2] + acc[3] * acc[3]);
    }
    s = sum_x16_x32(s); ss = sum_x16_x32(ss);
    const float mean = s * (1.f / 128.f), var = fmaxf(ss * (1.f / 128.f) - mean * mean, 0.f), rstd = 1.0f / sqrtf(var + EPS);
    const bf16* gsrc = ZA + (size_t)(r0 + ii) * NZA + C_RG + 128 * h + 4 * g4; bf16* dst = BR + (size_t)(r0 + ii) * 512 + 128 * h + 4 * g4;
#pragma unroll
    for (int et = 0; et < 8; ++et) { const u32x2 gw = *(const u32x2*)(gsrc + 16 * et); const float g0 = bflo(gw.x), g1 = bfhi(gw.x), g2 = bflo(gw.y), g3 = bfhi(gw.y);
        const float o0 = (O[et][0] - mean) * rstd * g0 * sigmoidf_(g0), o1 = (O[et][1] - mean) * rstd * g1 * sigmoidf_(g1), o2 = (O[et][2] - mean) * rstd * g2 * sigmoidf_(g2), o3 = (O[et][3] - mean) * rstd * g3 * sigmoidf_(g3);
        u32x2 w; w.x = pk2(o0, o1); w.y = pk2(o2, o3); *(u32x2*)(dst + 16 * et) = w; }
    __syncthreads();
}

__device__ __forceinline__ int wr_off(int k) { return k * 64 + (k >> 2) * 16; }
__device__ __forceinline__ void phase_norm2(KPC p, int l, LAS unsigned char* lds, int tid, int lane, int wave, int bid, int G) {
    if (l == 1 || G != 256) { convert_experts(p, l, 0, CVT_ITEMS, bid * 8 + wave, G * 8, lds, lane, wave); __syncthreads(); }
    LAS unsigned char* wrl = lds + 69632;
    for (int i = tid; i < 1024 * 4; i += 512) { const int k = i >> 2, q = i & 3; *(LAS f32x4*)(wrl + wr_off(k) + 16 * q) = *(const f32x4*)(p->w_router + (size_t)l * 16384 + k * 16 + 4 * q); }
    __syncthreads();
    const float* modv = (const float*)(p->ws + WS_MODV) + l * 9 * 6144; const bf16* X = (const bf16*)(p->ws + WS_X); bf16* H = (bf16*)(p->ws + WS_H);
    float* AFF = (float*)(p->ws + WS_AFF); float* AFFC = (float*)(p->ws + WS_AFFC); int* INV = (int*)(p->ws + WS_INV);
    const int rows = (l == 0) ? M : ML, stride = G * 8;
    {
    int r = bid * 8 + wave;
    u32x2 vn[4];
#pragma unroll
    for (int j = 0; j < 4; ++j) vn[j] = (r < rows) ? *(const u32x2*)(X + (size_t)r * 1024 + 4 * lane + 256 * j) : (u32x2){0u, 0u};
    for (; r < rows; r += stride) {
        const int bi = (r < ML) ? (r >> 12) : 8; const float* mv = modv + bi * 6144;
        f32x4 v[4], h[4], g[4], sc[4], sh[4];
#pragma unroll
        for (int j = 0; j < 4; ++j) { v[j] = (f32x4){bflo(vn[j].x), bfhi(vn[j].x), bflo(vn[j].y), bfhi(vn[j].y)}; const int col = 4 * lane + 256 * j; g[j] = *(const f32x4*)(p->norm2_g + l * 1024 + col); sh[j] = *(const f32x4*)(mv + 3 * 1024 + col); sc[j] = *(const f32x4*)(mv + 4 * 1024 + col); }
        const int rn = r + stride;
        if (rn < rows) {
#pragma unroll
            for (int j = 0; j < 4; ++j) vn[j] = *(const u32x2*)(X + (size_t)rn * 1024 + 4 * lane + 256 * j); }
        const float rs = row_rs(v);
#pragma unroll
        for (int j = 0; j < 4; ++j) h[j] = (v[j] * rs) * g[j] * (sc[j] + 1.0f) + sh[j];
        store_h(h, H + (size_t)r * 1024, lane);
        float lg[16];
#pragma unroll
        for (int e = 0; e < 16; ++e) lg[e] = 0.f;
#pragma unroll
        for (int j = 0; j < 4; ++j)
#pragma unroll
            for (int i = 0; i < 4; ++i) { const int k = 4 * lane + 256 * j + i; const float hv = h[j][i]; const LAS f32x4* wp = (const LAS f32x4*)(wrl + wr_off(k));
#pragma unroll
                for (int q = 0; q < 4; ++q) { const f32x4 w = wp[q]; lg[4 * q] += hv * w.x; lg[4 * q + 1] += hv * w.y; lg[4 * q + 2] += hv * w.z; lg[4 * q + 3] += hv * w.w; } }
        float mx = -1e30f;
#pragma unroll
        for (int e = 0; e < 16; ++e) { lg[e] = wave_sum(lg[e]); mx = fmaxf(mx, lg[e]); }
        float sum = 0.f;
#pragma unroll
        for (int e = 0; e < 16; ++e) { lg[e] = ex2((lg[e] - mx) * LOG2E); sum += lg[e]; }
        const float isum = 1.0f / sum; float mine = 0.f;
#pragma unroll
        for (int e = 0; e < 16; ++e) mine = (lane == e) ? lg[e] * isum : mine;
        if (lane < 16) { if (r < ML) AFF[((size_t)(bi * 16 + lane) << 12) + (r & 4095)] = mine; else AFFC[((r - ML) >> 8) * 4096 + lane * 256 + ((r - ML) & 255)] = mine;
            INV[(size_t)r * 16 + lane] = -1; }
    }
    }
}

__device__ __forceinline__ int block_sum_i(int v, LAS int* red, int buf, int lane, int wave) {
    v = wave_sum_i(v);
    if (lane == 0) red[buf * 8 + wave] = v;
    __syncthreads();
    int s = 0;
#pragma unroll
    for (int w = 0; w < 8; ++w) s += red[buf * 8 + w];
    return s;
}
__device__ __forceinline__ int block_excl_scan(int v, LAS int* red, int buf, int lane, int wave) {
    int inc = v;
#pragma unroll
    for (int o = 1; o < 64; o <<= 1) { const int t = __builtin_amdgcn_ds_bpermute((lane - o) << 2, inc); if (lane >= o) inc += t; }
    if (lane == 63) red[buf * 8 + wave] = inc;
    __syncthreads();
    int base = 0;
#pragma unroll
    for (int w = 0; w < 8; ++w) { const int x = red[buf * 8 + w]; if (w < wave) base += x; }
    return base + inc - v;
}
template <int KPT>
__device__ __forceinline__ void topk_item(KPC p, const float* aff, int n, int cap, int rowbase, int e, int slotbase, int s_lo, int s_hi, bool writer, LAS unsigned char* lds, int tid, int lane, int wave) {
    const bf16* H = (const bf16*)(p->ws + WS_H); bf16* XS = (bf16*)(p->ws + WS_XS); float* topw = (float*)(p->ws + WS_TOPW); int* INV = (int*)(p->ws + WS_INV);
    LAS int* red = (LAS int*)lds; LAS int* rl = (LAS int*)(lds + 128);
    unsigned key[KPT]; const bool valid = tid * KPT < n;
#pragma unroll
    for (int j = 0; j < KPT; ++j) key[j] = valid ? __float_as_uint(aff[tid * KPT + j]) : 0u;
    unsigned Tsel = 0u;
    for (int bit = 30; bit >= 0; --bit) { const unsigned cand = Tsel | (1u << bit); int cnt = 0;
#pragma unroll
        for (int j = 0; j < KPT; ++j) cnt += (valid && key[j] >= cand) ? 1 : 0;
        if (block_sum_i(cnt, red, bit & 1, lane, wave) >= cap) Tsel = cand; }
    int cgt = 0, ceq = 0;
#pragma unroll
    for (int j = 0; j < KPT; ++j) { cgt += (valid && key[j] > Tsel) ? 1 : 0; ceq += (valid && key[j] == Tsel) ? 1 : 0; }
    const int need = cap - block_sum_i(cgt, red, 1, lane, wave);
    int er = block_excl_scan(ceq, red, 2, lane, wave);
    bool sel[KPT]; int nsel = 0;
#pragma unroll
    for (int j = 0; j < KPT; ++j) { const bool iseq = valid && key[j] == Tsel; sel[j] = valid && (key[j] > Tsel || (iseq && er < need)); er += iseq ? 1 : 0; nsel += sel[j] ? 1 : 0; }
    int slot = block_excl_scan(nsel, red, 3, lane, wave);
#pragma unroll
    for (int j = 0; j < KPT; ++j) if (sel[j]) { const int t = tid * KPT + j; if (slot < cap) { rl[slot] = t; if (writer) { topw[e * ME + slotbase + slot] = __uint_as_float(key[j]); INV[(size_t)(rowbase + t) * 16 + e] = slotbase + slot; } } ++slot; }
    __syncthreads();
    for (int s = s_lo + wave * 4; s < s_hi; s += 32) {
        u32x4 a[4][2];
#pragma unroll
        for (int q = 0; q < 4; ++q) { const int t = rl[s + q]; const u32x4* src = (const u32x4*)(H + (size_t)(rowbase + t) * 1024); a[q][0] = src[lane]; a[q][1] = src[lane + 64]; }
#pragma unroll
        for (int q = 0; q < 4; ++q) { u32x4* dst = (u32x4*)(XS + ((size_t)e * ME + slotbase + s + q) * 1024); dst[lane] = a[q][0]; dst[lane + 64] = a[q][1]; }
    }
    __syncthreads();
}
__device__ __forceinline__ void phase_topk(KPC p, int l, LAS unsigned char* lds, int tid, int lane, int wave, int bid, int G) {
    const float* AFF = (const float*)(p->ws + WS_AFF); const float* AFFC = (const float*)(p->ws + WS_AFFC);
    const int nitem = (l == 0) ? 384 : 256;
    for (int it = bid; it < nitem; it += G) {
        if (it < 256) { const int q = it >> 1, hf = it & 1, b = q >> 4, e = q & 15; topk_item<8>(p, AFF + ((size_t)(b * 16 + e) << 12), 4096, CAPL, b * T, e, b * CAPL, hf * 256, hf * 256 + 256, hf == 0, lds, tid, lane, wave); }
        else { const int q = it - 256, b = q >> 4, e = q & 15; topk_item<1>(p, AFFC + (b * 16 + e) * 256, 256, CAPC, ML + b * CL, e, NB * CAPL + b * CAPC, 0, CAPC, true, lds, tid, lane, wave); }
    }
}

__device__ __forceinline__ void phase_combine(KPC p, int l, LAS unsigned char* lds, int tid, int lane, int wave, int bid, int G) {
    const float* modv = (const float*)(p->ws + WS_MODV); bf16* X = (bf16*)(p->ws + WS_X); bf16* H = (bf16*)(p->ws + WS_H);
    const bf16* Y = (const bf16*)(p->ws + WS_XS); const int* INV = (const int*)(p->ws + WS_INV);
    const int rows = (l == 0) ? M : ML, stride = G * 8;
    int r = bid * 8 + wave;
    int slot_next = (lane < 16 && r < rows) ? INV[(size_t)r * 16 + lane] : -1;
    u32x2 vn[4];
#pragma unroll
    for (int j = 0; j < 4; ++j) vn[j] = (r < rows) ? *(const u32x2*)(X + (size_t)r * 1024 + 4 * lane + 256 * j) : (u32x2){0u, 0u};
    for (; r < rows; r += stride) {
        const int bi = (r < ML) ? (r >> 12) : 8;
        const int myslot = slot_next; const int rn = r + stride;
        slot_next = (lane < 16 && rn < rows) ? INV[(size_t)rn * 16 + lane] : -1;
        f32x4 v[4], acc[4], g2v[4];
        const float* g2 = modv + (l * 9 + bi) * 6144 + 5 * 1024;
#pragma unroll
        for (int j = 0; j < 4; ++j) { v[j] = (f32x4){bflo(vn[j].x), bfhi(vn[j].x), bflo(vn[j].y), bfhi(vn[j].y)}; acc[j] = (f32x4){0.f, 0.f, 0.f, 0.f}; g2v[j] = *(const f32x4*)(g2 + 4 * lane + 256 * j); }
        unsigned mask = (unsigned)(__builtin_amdgcn_ballot_w64(myslot >= 0) & 0xffffull);
        bool first = true;
        while (mask || first) {
          if (mask) {
            const int e0 = __builtin_ctz(mask); mask &= mask - 1u; const int s0 = __builtin_amdgcn_readlane(myslot, e0);
            const bool has1 = mask != 0u; const int e1 = has1 ? __builtin_ctz(mask) : e0; if (has1) mask &= mask - 1u; const int s1 = __builtin_amdgcn_readlane(myslot, e1);
            const bf16* ya = Y + ((size_t)e0 * ME + s0) * 1024; const bf16* yb = Y + ((size_t)e1 * ME + s1) * 1024;
            u32x2 wa[4], wb[4];
#pragma unroll
            for (int j = 0; j < 4; ++j) wa[j] = *(const u32x2*)(ya + 4 * lane + 256 * j);
#pragma unroll
            for (int j = 0; j < 4; ++j) wb[j] = *(const u32x2*)(yb + 4 * lane + 256 * j);
            if (first && rn < rows) {
#pragma unroll
                for (int j = 0; j < 4; ++j) vn[j] = *(const u32x2*)(X + (size_t)rn * 1024 + 4 * lane + 256 * j); }
            first = false;
            const float kb = has1 ? 1.0f : 0.0f;
#pragma unroll
            for (int j = 0; j < 4; ++j) { acc[j] += (f32x4){bflo(wa[j].x), bfhi(wa[j].x), bflo(wa[j].y), bfhi(wa[j].y)}; acc[j] += (f32x4){bflo(wb[j].x), bfhi(wb[j].x), bflo(wb[j].y), bfhi(wb[j].y)} * kb; }
          } else {
            if (rn < rows) {
#pragma unroll
                for (int j = 0; j < 4; ++j) vn[j] = *(const u32x2*)(X + (size_t)rn * 1024 + 4 * lane + 256 * j); }
            first = false;
          }
        }
#pragma unroll
        for (int j = 0; j < 4; ++j) v[j] = v[j] + g2v[j] * acc[j];
        if (l == 0) {
#pragma unroll
            for (int j = 0; j < 4; ++j) { u32x2 w; w.x = pk2(v[j].x, v[j].y); w.y = pk2(v[j].z, v[j].w); *(u32x2*)(X + (size_t)r * 1024 + 4 * lane + 256 * j) = w; }
            const float rs = row_rs(v); f32x4 h[4];
            norm_mod(v, rs, p->norm1_g + 1024, modv + (9 + bi) * 6144, modv + (9 + bi) * 6144 + 1024, h, lane);
            store_h(h, H + (size_t)r * 1024, lane);
        } else {
#pragma unroll
            for (int j = 0; j < 4; ++j) *(f32x4*)(p->out + (size_t)r * 1024 + 4 * lane + 256 * j) = v[j];
        }
    }
    if (l == 0) convert_small(p, 1, lds, lane, wave, bid, G);
}

#define XB_TMO      128
#define XB_XCNT(j)  (256  + 64 * (j))
#define XB_XSUB(j)  (1280 + 64 * (j))
#define XB_XGEN(j)  (2304 + 64 * (j))
#define XB_TOP      3328
#define XB_TOPGEN   3392
#define XCD_BAR_WORDS 3456
#define XB_SPIN_CAP (1u << 18)

__device__ __forceinline__ unsigned xb_ld(unsigned* p)              { return __hip_atomic_load(p, __ATOMIC_RELAXED, __HIP_MEMORY_SCOPE_AGENT); }
__device__ __forceinline__ unsigned xb_add(unsigned* p, unsigned v) { return __hip_atomic_fetch_add(p, v, __ATOMIC_RELAXED, __HIP_MEMORY_SCOPE_AGENT); }
__device__ __forceinline__ unsigned xb_xcc_id() { return (unsigned)__builtin_amdgcn_s_getreg((3 << 11) | 20) & 0xFu; }
#define XB_SPIN(cond, bar) do { unsigned _sp = 0; while (cond) { __builtin_amdgcn_s_sleep(1); \
    if ((++_sp & 255u) == 0u) { if (xb_ld(&(bar)[XB_TMO])) break; if (_sp > XB_SPIN_CAP) { atomicAdd(&(bar)[XB_TMO], 1u); break; } } } } while (0)

struct XcdBarrier {
    unsigned* bar; unsigned x;
    volatile LAS unsigned* st;
};

__device__ __forceinline__ XcdBarrier xcd_barrier_post(unsigned* bar, volatile LAS unsigned* st) {
    XcdBarrier b; b.bar = bar; b.x = xb_xcc_id(); b.st = st;
    if (threadIdx.x == 0) (void)xb_add(&bar[XB_XCNT(b.x)], 1u);
    return b;
}
__device__ __forceinline__ void xcd_barrier_complete(unsigned* bar, unsigned x, unsigned& nloc, unsigned& nx) {
    const unsigned G = gridDim.x * gridDim.y * gridDim.z;
    unsigned sum, cnt, mine, sp = 0u;
    for (;;) {
        sum = 0u; cnt = 0u; mine = 0u;
#pragma unroll
        for (unsigned j = 0; j < 16; ++j) { const unsigned c = xb_ld(&bar[XB_XCNT(j)]); sum += c; cnt += (c > 0u) ? 1u : 0u; mine = (j == x) ? c : mine; }
        if (sum == G) break;
        __builtin_amdgcn_s_sleep(1);
        if ((++sp & 255u) == 0u) { if (xb_ld(&bar[XB_TMO])) break; if (sp > XB_SPIN_CAP) { atomicAdd(&bar[XB_TMO], 1u); break; } }
    }
    nloc = mine > 0u ? mine : 1u; nx = cnt > 0u ? cnt : 1u;
}

__device__ __forceinline__ void xcd_barrier(const XcdBarrier& b) {
    asm volatile("s_waitcnt vmcnt(0)" ::: "memory");
    __syncthreads();
    if (threadIdx.x == 0) {
        unsigned* bar = b.bar;
        __builtin_amdgcn_s_waitcnt(0);
        unsigned nloc = b.st[0], nx = b.st[1];
        if (nloc == 0u) { xcd_barrier_complete(bar, b.x, nloc, nx); b.st[0] = nloc; b.st[1] = nx; }
        const unsigned old = xb_add(&bar[XB_XSUB(b.x)], 1u);
        const unsigned gen = old / nloc;
        if (old + 1u == (gen + 1u) * nloc) {
            __builtin_amdgcn_fence(__ATOMIC_RELEASE, "agent");
            asm volatile("s_waitcnt vmcnt(0)" ::: "memory");
            const unsigned og = xb_add(&bar[XB_TOP], 1u);
            const unsigned tg = og / nx;
            if (og + 1u == (tg + 1u) * nx) xb_add(&bar[XB_TOPGEN], 1u);
            else XB_SPIN(xb_ld(&bar[XB_TOPGEN]) == tg, bar);
            __builtin_amdgcn_fence(__ATOMIC_ACQUIRE, "agent");
            xb_add(&bar[XB_XGEN(b.x)], 1u);
            asm volatile("s_waitcnt vmcnt(0)" ::: "memory");
        } else {
            XB_SPIN(xb_ld(&bar[XB_XGEN(b.x)]) == gen, bar);
            __builtin_amdgcn_fence(__ATOMIC_ACQUIRE, "agent");
            asm volatile("s_waitcnt vmcnt(0)" ::: "memory");
        }
    }
    __syncthreads();
}

#define KPP() ({ KPC q_ = kp_; asm volatile("" : "+s"(q_)); q_; })
__global__ void __launch_bounds__(512, 2) mk_fwd(KP p_unused) {
    extern __shared__ __attribute__((aligned(16))) unsigned char lds_raw[];
    LAS unsigned char* lds = (LAS unsigned char*)lds_raw;
    cg::grid_group grid = cg::this_grid();
    const int bid = blockIdx.x, G = gridDim.x;
#define IDS() int tid = threadIdx.x; asm volatile("" : "+v"(tid)); const int lane = tid & 63, wave = __builtin_amdgcn_readfirstlane(tid >> 6); (void)lane; (void)wave
    const KPC kp_ = (KPC)__builtin_amdgcn_kernarg_segment_ptr();
    volatile LAS unsigned* bst = (volatile LAS unsigned*)(lds + 147392);
    if (threadIdx.x < 16) bst[threadIdx.x] = 0u;
    __syncthreads();
    (void)xcd_barrier_post((unsigned*)KPP()->ws, bst);
#define GSYNC() do { XcdBarrier b_; b_.bar = (unsigned*)KPP()->ws; b_.x = xb_xcc_id(); b_.st = bst; xcd_barrier(b_); } while (0)

    { IDS(); phase_prep(KPP(), lds, tid, lane, wave, bid, G); }
    if (G == 0x7fffffff) grid.sync();
    GSYNC();
    { IDS(); phase_norm_in(KPP(), lane, wave, bid, G); }
    GSYNC();
#pragma unroll 1
    for (int l = 0; l < 2; ++l) {
        {
            unsigned char* ws = KPP()->ws;
            pg8::Gemm g{(const pg8::bf16_t*)(ws + WS_H), (const pg8::bf16_t*)(ws + WS_WTIN), M, NZA, 1024}; GroupOrder S{1, M / 256, NZA / 256, 0, 0, G, bid};
            EpiZA E{(bf16*)(ws + WS_ZA)};
            pg8::gemm_phase<EpiZA, GroupOrder, true, true>(lds, g, S, E);
        }
        GSYNC();
        {
            KPC p = KPP(); IDS();
            float mq = fabsf(p->qn_g[l * 64 + lane]), mk = fabsf(p->kn_g[l * 64 + lane]);
            mq = wave_max(mq); mk = wave_max(mk);
            const float Mb2 = 8.0f * mq * mk * LOG2E;
            const int natt = (l == 0) ? 544 : 512, nupd = NB * NCH * 4, nvp = (l == 0) ? (M / 128) : (ML / 128);
            for (int it = bid; it < natt + nupd + nvp; it += G) {
                if (it < natt) { att_item(p, l, lds, it, Mb2, tid, lane, wave); }
                else if (it < natt + nupd) { ret_upd_item(p, l, lds, it - natt, tid, lane, wave); }
                else { sgu_vprep_item(p, it - natt - nupd, tid); }
            }
        }
        GSYNC();
        { IDS(); phase_scan(KPP(), l, tid, bid, G); }
        GSYNC();
        {   KPC p = KPP(); IDS(); const int nch = (l == 0) ? NCH : 32;
            const int nro = NB * nch * 4, nsgu = ((l == 0) ? (M / 128) : (ML / 128)) * 4;
            for (int it = bid; it < nro + nsgu; it += G) {
                if (it < nro) { const int b = it / (nch * 4), rem = it % (nch * 4); ret_out_item(p, l, lds, b * (NCH * 4) + rem, tid, lane, wave); }
                else sgu_item(p, l, lds, it - nro, tid, lane, wave);
            }
        }
        GSYNC();
        const int Mrows = (l == 0) ? M : ML;
        {
            unsigned char* ws = KPP()->ws;
            pg8::Gemm g{(const pg8::bf16_t*)(ws + WS_H), (const pg8::bf16_t*)(ws + WS_WTIN) + (size_t)NZA * 1024, Mrows, NZG, 1024}; GroupOrder S{1, Mrows / 256, NZG / 256, 0, 0, G, bid};
            EpiSig E{(bf16*)(ws + WS_G)};
            pg8::gemm_phase<EpiSig, GroupOrder, true, true>(lds, g, S, E);
            if (l == 0 && G == 256 && bid >= CVT_G_IDLE0) { IDS(); convert_experts(KPP(), 0, 0, CVT_G_HI, (bid - CVT_G_IDLE0) * 8 + wave, (256 - CVT_G_IDLE0) * 8, lds, lane, wave); }
        }
        GSYNC();
        {
            KPC p = KPP(); unsigned char* ws = p->ws;
            pg8::Gemm g{(const pg8::bf16_t*)p->out, (const pg8::bf16_t*)(ws + WS_WTBR), 3 * M, 3072, 512}; MergeOrder S{Mrows / 256, G, bid};
            EpiMergeChain E{(const bf16*)(ws + WS_G), (bf16*)(ws + WS_H)};
            pg8::gemm_phase<EpiMergeChain, MergeOrder, true, true>(lds, g, S, E);
            if (l == 0 && G == 256 && bid >= CVT_M_IDLE0) { IDS(); convert_experts(KPP(), 0, CVT_G_HI, CVT_M_HI, (bid - CVT_M_IDLE0) * 8 + wave, (256 - CVT_M_IDLE0) * 8, lds, lane, wave); }
        }
        GSYNC();
        {
            KPC p = KPP(); unsigned char* ws = p->ws;
            pg8::Gemm g{(const pg8::bf16_t*)(ws + WS_H), (const pg8::bf16_t*)(ws + WS_WTOUT), Mrows, 1024, 1024}; GroupOrder S{1, Mrows / 256, 4, 0, 0, G, bid};
            EpiOut E{p->x, p->ctx, (bf16*)(ws + WS_X), (const float*)(ws + WS_MODV) + l * 9 * 6144, (l == 0) ? 1 : 0};
            pg8::gemm_phase<EpiOut, GroupOrder, true, true>(lds, g, S, E);
            if (l == 0 && G == 256 && bid >= CVT_O_IDLE0) { IDS(); convert_experts(KPP(), 0, CVT_M_HI, CVT_ITEMS, (bid - CVT_O_IDLE0) * 8 + wave, (256 - CVT_O_IDLE0) * 8, lds, lane, wave); }
        }
        GSYNC();
        { IDS(); phase_norm2(KPP(), l, lds, tid, lane, wave, bid, G); }
        GSYNC();
        { IDS(); phase_topk(KPP(), l, lds, tid, lane, wave, bid, G); }
        GSYNC();
        {
            unsigned char* ws = KPP()->ws;
            pg8::Gemm g{(const pg8::bf16_t*)(ws + WS_XS), (const pg8::bf16_t*)(ws + WS_WT1), NE * ME, NE * 2048, 1024}; GroupOrder S{NE, (l == 0) ? 17 : 16, 8, 17, 8, G, bid};
            EpiMoe1 E{(bf16*)(ws + WS_ACT)};
            pg8::gemm_phase<EpiMoe1, GroupOrder, true, true>(lds, g, S, E);
        }
        GSYNC();
        {
            unsigned char* ws = KPP()->ws;
            pg8::Gemm g{(const pg8::bf16_t*)(ws + WS_ACT), (const pg8::bf16_t*)(ws + WS_WT2), NE * ME, NE * 1024, 1024}; GroupOrder S{NE, (l == 0) ? 17 : 16, 4, 17, 4, G, bid};
            EpiMoe2 E{(bf16*)(ws + WS_XS), (const float*)(ws + WS_TOPW)};
            pg8::gemm_phase<EpiMoe2, GroupOrder, true, true>(lds, g, S, E);
        }
        GSYNC();
        { IDS(); phase_combine(KPP(), l, lds, tid, lane, wave, bid, G); }
        if (l == 0) GSYNC();
    }
}

extern "C" void kernel_launch(void* const* d_in, const int* in_sizes, int n_in, void* d_out, int out_size, void* d_ws, size_t ws_size, hipStream_t stream) {
    static int grid = 0;
    if (grid == 0) {
        if (n_in != 22 || out_size != ML * D || ws_size < WS_END) { fprintf(stderr, "kernel_launch: unexpected shapes (n_in %d out %d ws %zu, need %zu)\n", n_in, out_size, ws_size, (size_t)WS_END); grid = -1; return; }
        int dev = 0, cus = 0, per_cu = 0;
        if (hipGetDevice(&dev) != hipSuccess || hipDeviceGetAttribute(&cus, hipDeviceAttributeMultiprocessorCount, dev) != hipSuccess) { grid = -1; return; }
        if (hipFuncSetAttribute((const void*)mk_fwd, hipFuncAttributeMaxDynamicSharedMemorySize, LDS_BYTES) != hipSuccess) { fprintf(stderr, "kernel_launch: hipFuncSetAttribute failed\n"); grid = -1; return; }
        if (hipOccupancyMaxActiveBlocksPerMultiprocessor(&per_cu, (const void*)mk_fwd, 512, LDS_BYTES) != hipSuccess || per_cu < 1) { fprintf(stderr, "kernel_launch: occupancy query says %d\n", per_cu); (void)hipGetLastError(); }
        grid = cus;
        fprintf(stderr, "kernel_launch: grid %d, occupancy %d/CU, ws %zu\n", grid, per_cu, ws_size);
    }
    if (grid < 0) return;
    if (hipMemsetAsync(d_ws, 0, 16384, stream) != hipSuccess) { fprintf(stderr, "kernel_launch: memset failed\n"); return; }
    KP hp{};
    const float** f = (const float**)&hp;
    for (int i = 0; i < 22; ++i) f[i] = (const float*)d_in[i];
    hp.out = (float*)d_out; hp.ws = (unsigned char*)d_ws;
    void* args[] = {&hp};
    hipError_t e = hipLaunchCooperativeKernel((const void*)mk_fwd, dim3(grid), dim3(512), args, LDS_BYTES, stream);
    if (e != hipSuccess) fprintf(stderr, "kernel_launch: cooperative launch failed: %s\n", hipGetErrorString(e));
}
```

```cpp
#include <hip/hip_runtime.h>
#include <hip/hip_cooperative_groups.h>
#include <cstdio>
#include <cstdint>
namespace cg = cooperative_groups;
namespace pg8 {
#define PG8_LAS __attribute__((address_space(3)))
typedef unsigned short bf16_t;
typedef short bf16x8 __attribute__((ext_vector_type(8)));
typedef float f32x4 __attribute__((ext_vector_type(4)));
typedef unsigned u32x4 __attribute__((ext_vector_type(4)));
constexpr int BM = 256, BK = 64, HALF = 128, HTB = HALF * BK * 2  , STAGE_BYTES = 8 * HTB, NXCD = 8, WGM = 8;

__host__ __device__ __forceinline__ int lds_byte(int r, int c) { const int st = (r >> 4) * 2 + (c >> 5), rr = r & 15, cc = c & 31, ob = rr * 64 + cc * 2; return st * 1024 + (ob ^ (((ob >> 9) & 1) << 5)); }
__host__ __device__ __forceinline__ void stage_rc(int b, int& R, int& C) { const int st = b / 1024, sb = b % 1024, swz = sb ^ (((sb >> 9) & 1) << 5); R = (st >> 1) * 16 + swz / 64; C = (st & 1) * 32 + (swz % 64) / 2; }
__host__ __device__ __forceinline__ int perm32(int rho) { const int n = rho >> 4, i = rho & 15; return 8 * (i >> 2) + 4 * n + (i & 3); }

struct Unit { int pm, pn; };
struct Gemm { const bf16_t* A; const bf16_t* Bt; int M, N, K; };

struct StaticOrder {
    int nM, nN, nwg, G, c;
    __host__ __device__ void init(int M, int N, int G_, int c_) { nM = M / BM; nN = N / BM; nwg = nM * nN; G = G_; c = c_; }
    __host__ __device__ bool next(int i, Unit& u) const {
        const long L = (long)i * G + c; if (L >= nwg) return false;
        int wgid = (int)L; { const int q = nwg / NXCD, r = nwg % NXCD, xcd = wgid % NXCD, off = wgid / NXCD; wgid = (xcd < r ? xcd * (q + 1) : r * (q + 1) + (xcd - r) * q) + off; }
        const int nig = WGM * nN, gid = wgid / nig, fm = gid * WGM, gsz = (nM - fm) < WGM ? (nM - fm) : WGM;
        u.pm = fm + ((wgid % nig) % gsz); u.pn = (wgid % nig) / gsz; return true;
    }
    __device__ __forceinline__ void a_ready(const Unit&) const {}
    __device__ __forceinline__ void done(const Unit&) const {}
};

__device__ __forceinline__ unsigned cvt_pk_bf16(float lo, float hi) { unsigned r; asm volatile("v_cvt_pk_bf16_f32 %0, %1, %2" : "=v"(r) : "v"(lo), "v"(hi)); return r; }
typedef float f32x2 __attribute__((ext_vector_type(2)));
__device__ __forceinline__ f32x2 gelu_pk(f32x2 v) {
    const f32x2 av = __builtin_elementwise_abs(v), d = av * 0.2316418882f + 1.0f;
    f32x2 t; t.x = __builtin_amdgcn_rcpf(d.x); t.y = __builtin_amdgcn_rcpf(d.y);
    f32x2 q = t * 0.5307027145f + (-0.7265760135f); q = q * t + 0.7107068705f; q = q * t + (-0.142248368f); q = q * t + 0.127414796f; q = q * t;
    const f32x2 s = (v * v) * (-0.72134752044f);
    f32x2 e; e.x = __builtin_amdgcn_exp2f(s.x); e.y = __builtin_amdgcn_exp2f(s.y);
    const f32x2 m = v * (q * e), r = v - m;
    f32x2 o; o.x = v.x < 0.f ? m.x : r.x; o.y = v.y < 0.f ? m.y : r.y; return o;
}

template <int ACT  > struct EpiBf16 {
    static constexpr bool PERM = true, AFTER_DRAIN = false, CHAIN = false; static_assert(ACT == 0 || ACT == 1, "EpiBf16: ACT is 0 (none) or 1 (gelu_pk)");
    bf16_t* O; int ldc; const float* bias; int split_cols; size_t split_stride; float scale0;
    __device__ __forceinline__ void operator()(const f32x4 (&acc)[2][2][4][2], const Unit& u, int wr, int wc, int fr, int fq) const {
        const int row0 = u.pm * BM + wr * 64 + fr; int colt = u.pn * BM; bf16_t* base = O;
        float sc = 1.f; if (split_cols) { const int t = colt / split_cols; base += (size_t)t * split_stride; colt -= t * split_cols; if (t == 0) sc = scale0; }
        const int col0 = colt + wc * 32 + 8 * fq, bcol0 = u.pn * BM + wc * 32 + 8 * fq;
        f32x4 bv[2][2];
#pragma unroll
        for (int bj = 0; bj < 2; ++bj)
#pragma unroll
            for (int n = 0; n < 2; ++n) bv[bj][n] = bias ? *(const f32x4*)(bias + bcol0 + bj * HALF + 4 * n) : (f32x4){0.f, 0.f, 0.f, 0.f};
#pragma unroll
        for (int ai = 0; ai < 2; ++ai)
#pragma unroll
            for (int m = 0; m < 4; ++m) { bf16_t* rowp = base + (size_t)(row0 + ai * HALF + m * 16) * ldc + col0;
#pragma unroll
                for (int bj = 0; bj < 2; ++bj) { f32x4 v0 = acc[ai][bj][m][0] + bv[bj][0], v1 = acc[ai][bj][m][1] + bv[bj][1];
                    if (ACT == 1) { f32x2 a = gelu_pk((f32x2){v0[0], v0[1]}), b = gelu_pk((f32x2){v0[2], v0[3]}), c = gelu_pk((f32x2){v1[0], v1[1]}), d = gelu_pk((f32x2){v1[2], v1[3]});
                        v0 = (f32x4){a.x, a.y, b.x, b.y}; v1 = (f32x4){c.x, c.y, d.x, d.y}; }
                    v0 = v0 * sc; v1 = v1 * sc; u32x4 w; w.x = cvt_pk_bf16(v0[0], v0[1]); w.y = cvt_pk_bf16(v0[2], v0[3]); w.z = cvt_pk_bf16(v1[0], v1[1]); w.w = cvt_pk_bf16(v1[2], v1[3]);
                    *(u32x4*)(rowp + bj * HALF) = w; } }
    }
};
template <class Epi, class Sched, bool ALIGN_EPI = false, bool SP2 = false>
__device__ __forceinline__ void gemm_phase(PG8_LAS unsigned char* lds, const Gemm g, const Sched& S, const Epi& E) {
    int tid_ = threadIdx.x; asm volatile("" : "+v"(tid_));
    const int tid = tid_, wid = __builtin_amdgcn_readfirstlane(tid >> 6), lane = tid & 63, wr = wid >> 2, wc = wid & 3, fr = lane & 15, fq = lane >> 4;
    const int K = g.K, nt = K / BK;
    unsigned voffA[2], voffB[2];
#pragma unroll
    for (int i = 0; i < 2; ++i) { int R, C; stage_rc(tid * 16 + i * 8192, R, C); const int Rb = Epi::PERM ? ((R & ~31) + perm32(R & 31)) : R;
        voffA[i] = (unsigned)(R * K + C) * 2u; voffB[i] = (unsigned)(Rb * K + C) * 2u; }
    const size_t kstep = (size_t)(BK * 2);
    const size_t hstep = (size_t)HALF * K * 2;
    const size_t tstep = 2 * hstep;
    const unsigned ldsw = (unsigned)wid * 1024u;
    const int aoff = lds_byte(wr * 64 + fr, fq * 8), boff = lds_byte(wc * 32 + fr, fq * 8);
#define PG8_SA(b, h) (((b) * 2 + (h)) * HTB)
#define PG8_SB(b, h) ((4 + (b) * 2 + (h)) * HTB)
#define PG8_STAGE(bufoff, gbase, voff) do { _Pragma("unroll") for (int _i = 0; _i < 2; ++_i) \
        __builtin_amdgcn_global_load_lds((const unsigned*)((const char*)(gbase) + (voff)[_i]), (PG8_LAS unsigned*)(lds + (bufoff) + ldsw + _i * 8192), 16, 0, 0); } while (0)
#define PG8_LDA(dst, b, h) do { _Pragma("unroll") for (int m = 0; m < 4; ++m) _Pragma("unroll") for (int k = 0; k < 2; ++k) dst[m][k] = *(const PG8_LAS bf16x8*)(lds + PG8_SA(b, h) + aoff + m * 2048 + k * 1024); } while (0)
#define PG8_LDB(dst, b, h) do { _Pragma("unroll") for (int n = 0; n < 2; ++n) _Pragma("unroll") for (int k = 0; k < 2; ++k) dst[n][k] = *(const PG8_LAS bf16x8*)(lds + PG8_SB(b, h) + boff + n * 2048 + k * 1024); } while (0)
#define PG8_MMA(ai, bj, At, Bt) do { __builtin_amdgcn_s_setprio(1); _Pragma("unroll") for (int m = 0; m < 4; ++m) _Pragma("unroll") for (int n = 0; n < 2; ++n) _Pragma("unroll") for (int k = 0; k < 2; ++k) \
        acc[ai][bj][m][n] = __builtin_amdgcn_mfma_f32_16x16x32_bf16(Bt[n][k], At[m][k], acc[ai][bj][m][n], 0, 0, 0); __builtin_amdgcn_s_setprio(0); } while (0)
#define PG8_WAIT_V(n) asm volatile("s_waitcnt vmcnt(" #n ")" ::: "memory")
#define PG8_WAIT_L(n) asm volatile("s_waitcnt lgkmcnt(" #n ")" ::: "memory")
#define PG8_BAR __builtin_amdgcn_s_barrier()
#define PG8_SCHED __builtin_amdgcn_sched_barrier(0)
    Unit cur, nxt; int ui = 0;
    if (!S.next(0, cur)) return;
    f32x4 acc[2][2][4][2];
#pragma unroll
    for (int a = 0; a < 2; ++a)
#pragma unroll
        for (int b = 0; b < 2; ++b)
#pragma unroll
            for (int m = 0; m < 4; ++m)
#pragma unroll
                for (int n = 0; n < 2; ++n) acc[a][b][m][n] = (f32x4){0.f, 0.f, 0.f, 0.f};
    bf16x8 At[4][2], B0[2][2], B1[2][2];
    const char* cA = (const char*)g.A + (size_t)cur.pm * tstep; const char* cB = (const char*)g.Bt + (size_t)cur.pn * tstep;
    S.a_ready(cur);
    if constexpr (SP2) {
        PG8_STAGE(PG8_SB(0, 0), cB, voffB); PG8_STAGE(PG8_SB(0, 1), cB + hstep, voffB); PG8_STAGE(PG8_SA(0, 0), cA, voffA); PG8_STAGE(PG8_SA(0, 1), cA + hstep, voffA);
        if (wr == 1) PG8_BAR;
        PG8_WAIT_V(2); PG8_BAR;
        PG8_STAGE(PG8_SB(1, 0), cB + kstep, voffB); PG8_STAGE(PG8_SA(1, 0), cA + kstep, voffA); PG8_STAGE(PG8_SB(1, 1), cB + hstep + kstep, voffB);
        PG8_WAIT_V(6); PG8_BAR;
    } else {
        PG8_STAGE(PG8_SB(0, 0), cB, voffB); PG8_STAGE(PG8_SA(0, 0), cA, voffA); PG8_STAGE(PG8_SB(0, 1), cB + hstep, voffB); PG8_STAGE(PG8_SA(0, 1), cA + hstep, voffA);
        if (wr == 1) PG8_BAR;
        PG8_WAIT_V(4); PG8_BAR;
        PG8_STAGE(PG8_SB(1, 0), cB + kstep, voffB); PG8_STAGE(PG8_SA(1, 0), cA + kstep, voffA); PG8_STAGE(PG8_SB(1, 1), cB + hstep + kstep, voffB);
        PG8_WAIT_V(6); PG8_BAR;
    }
    for (;;) {
        const bool has_next = S.next(ui + 1, nxt);
        const char* nA = has_next ? (const char*)g.A + (size_t)nxt.pm * tstep : cA; const char* nB = has_next ? (const char*)g.Bt + (size_t)nxt.pn * tstep : cB;
        for (int t = 0; t < nt; t += 2) {
            const bool last = (t == nt - 2);
            const char* a1 = cA + (size_t)(t + 1) * kstep;
            const char* a2 = last ? nA : cA + (size_t)(t + 2) * kstep; const char* b2 = last ? nB : cB + (size_t)(t + 2) * kstep;
            const char* a3 = a2 + kstep; const char* b3 = b2 + kstep;
            if (last && has_next) S.a_ready(nxt);
            if constexpr (SP2) {
            PG8_LDB(B0, 0, 0); PG8_LDB(B1, 0, 1); PG8_SCHED; PG8_LDA(At, 0, 0); PG8_STAGE(PG8_SA(1, 1), a1 + hstep, voffA);
            PG8_WAIT_V(8); PG8_WAIT_L(0); PG8_BAR; PG8_MMA(0, 0, At, B0); PG8_MMA(0, 1, At, B1); PG8_BAR; PG8_SCHED;
            PG8_LDA(At, 0, 1); PG8_STAGE(PG8_SB(0, 0), b2, voffB); PG8_STAGE(PG8_SB(0, 1), b2 + hstep, voffB); PG8_STAGE(PG8_SA(0, 0), a2, voffA);
            PG8_WAIT_V(8); PG8_WAIT_L(0); PG8_BAR; PG8_MMA(1, 0, At, B0); PG8_MMA(1, 1, At, B1); PG8_BAR; PG8_SCHED;
            PG8_LDB(B0, 1, 0); PG8_LDB(B1, 1, 1); PG8_SCHED; PG8_LDA(At, 1, 0); PG8_STAGE(PG8_SA(0, 1), a2 + hstep, voffA);
            PG8_WAIT_V(8); PG8_WAIT_L(0); PG8_BAR; PG8_MMA(0, 0, At, B0); PG8_MMA(0, 1, At, B1); PG8_BAR; PG8_SCHED;
            PG8_LDA(At, 1, 1); PG8_STAGE(PG8_SB(1, 0), b3, voffB); PG8_STAGE(PG8_SB(1, 1), b3 + hstep, voffB); PG8_STAGE(PG8_SA(1, 0), a3, voffA);
            PG8_WAIT_V(8); PG8_WAIT_L(0); PG8_BAR; PG8_MMA(1, 0, At, B0); PG8_MMA(1, 1, At, B1); PG8_BAR; PG8_SCHED;
            } else {
            PG8_LDB(B0, 0, 0); PG8_SCHED; PG8_LDA(At, 0, 0); PG8_STAGE(PG8_SA(1, 1), a1 + hstep, voffA);
            PG8_WAIT_L(8); PG8_BAR; PG8_WAIT_L(0); PG8_MMA(0, 0, At, B0); PG8_BAR; PG8_SCHED;
            PG8_LDB(B1, 0, 1); PG8_STAGE(PG8_SB(0, 0), b2, voffB);
            PG8_BAR; PG8_WAIT_L(0); PG8_MMA(0, 1, At, B1); PG8_BAR;
            PG8_LDA(At, 0, 1); PG8_STAGE(PG8_SA(0, 0), a2, voffA);
            PG8_BAR; PG8_WAIT_L(0); PG8_MMA(1, 0, At, B0); PG8_BAR; PG8_SCHED;
            PG8_STAGE(PG8_SB(0, 1), b2 + hstep, voffB);
            PG8_WAIT_V(6); PG8_BAR; PG8_MMA(1, 1, At, B1); PG8_BAR;
            PG8_LDB(B0, 1, 0); PG8_SCHED; PG8_LDA(At, 1, 0); PG8_STAGE(PG8_SA(0, 1), a2 + hstep, voffA);
            PG8_WAIT_L(8); PG8_BAR; PG8_WAIT_L(0); PG8_MMA(0, 0, At, B0); PG8_BAR; PG8_SCHED;
            PG8_LDB(B1, 1, 1); PG8_STAGE(PG8_SB(1, 0), b3, voffB);
            PG8_BAR; PG8_WAIT_L(0); PG8_MMA(0, 1, At, B1); PG8_BAR;
            PG8_LDA(At, 1, 1); PG8_STAGE(PG8_SA(1, 0), a3, voffA);
            PG8_BAR; PG8_WAIT_L(0); PG8_MMA(1, 0, At, B0); PG8_BAR; PG8_SCHED;
            PG8_STAGE(PG8_SB(1, 1), b3 + hstep, voffB);
            PG8_WAIT_V(6); PG8_BAR; PG8_MMA(1, 1, At, B1); PG8_BAR;
            }
        }
        if constexpr (ALIGN_EPI) { if (wr == 0) PG8_BAR; }
        bool keep_acc = false;
        if constexpr (Epi::CHAIN) { keep_acc = E.chain(acc, cur, wr, wc, fr, fq); S.done(cur); }
        else if constexpr (!Epi::AFTER_DRAIN) { E(acc, cur, wr, wc, fr, fq); S.done(cur); }
        if (!has_next) break;
        if (!keep_acc) {
#pragma unroll
        for (int a = 0; a < 2; ++a)
#pragma unroll
            for (int b = 0; b < 2; ++b)
#pragma unroll
                for (int m = 0; m < 4; ++m)
#pragma unroll
                    for (int n = 0; n < 2; ++n) acc[a][b][m][n] = (f32x4){0.f, 0.f, 0.f, 0.f};
        }
        cur = nxt; cA = nA; cB = nB; ++ui;
        if constexpr (ALIGN_EPI) { if (wr == 1) PG8_BAR; }
    }
    PG8_WAIT_V(0);
    if constexpr (!ALIGN_EPI) { if (wr == 0) PG8_BAR; }
    PG8_BAR;
    if constexpr (Epi::AFTER_DRAIN) { E.fused(acc, cur, wr, wc, fr, fq, lds, wid, lane); S.done(cur); }
#undef PG8_SA
#undef PG8_SB
#undef PG8_STAGE
#undef PG8_LDA
#undef PG8_LDB
#undef PG8_MMA
#undef PG8_WAIT_V
#undef PG8_WAIT_L
#undef PG8_BAR
#undef PG8_SCHED
}
}

#define LAS __attribute__((address_space(3)))
typedef unsigned short bf16;
typedef short bf16x8 __attribute__((ext_vector_type(8)));
typedef float f32x4 __attribute__((ext_vector_type(4)));
typedef unsigned u32x4 __attribute__((ext_vector_type(4)));
typedef unsigned u32x2 __attribute__((ext_vector_type(2)));

constexpr int D = 1024, NB = 8, T = 4096, CL = 256;
constexpr int ML = NB * T, MC = NB * CL, M = ML + MC;
constexpr int NZA = 3328, NZG = 3072;
constexpr int C_RQ = 0, C_RK = 256, C_RV = 512, C_RG = 1024, C_SU = 1536, C_SV = 2048, C_AQ = 2560, C_AK = 3072, C_AV = 3200;
constexpr int NE = 16, CAPL = 512, CAPC = 32, ME = NB * (CAPL + CAPC);
constexpr int NCH = 34;
constexpr float EPS = 1e-6f, LOG2E = 1.4426950408889634f;
constexpr int LDS_BYTES = 147456;

constexpr size_t MiB = 1u << 20;
constexpr size_t WS_LG = 15360;
constexpr size_t WS_ROPEC = 1 * MiB, WS_ROPES = 1 * MiB + 512 * 1024, WS_MODV = 2 * MiB, WS_AFF = 3 * MiB, WS_AFFC = 5 * MiB, WS_INV = 6 * MiB, WS_TOPW = 9 * MiB;
constexpr size_t WS_WTIN = 16 * MiB, WS_WTBR = WS_WTIN + (size_t)6400 * 1024 * 2, WS_WTOUT = WS_WTBR + (size_t)3072 * 512 * 2;
constexpr size_t WS_X = 34 * MiB, WS_H = 170 * MiB, WS_R = 238 * MiB;
constexpr size_t WS_ZA = WS_R, WS_G = WS_R, WS_RS = 459 * MiB, WS_ST = 527 * MiB;
constexpr size_t WS_XS = WS_R, WS_ACT = 374 * MiB, WS_WT1 = 510 * MiB, WS_WT2 = 574 * MiB, WS_END = 606 * MiB;
static_assert(WS_WTOUT + 2 * MiB <= WS_X && WS_ZA + (size_t)M * NZA * 2 <= WS_RS && WS_ST + (size_t)NB * 4 * NCH * 128 * 128 * 2 <= WS_END, "ws map");

struct KP {
    const float *x, *c, *ctx, *c_ctx, *w_mod, *b_mod, *norm1_g, *norm2_g, *w_in, *dec_f, *dec_b, *sgu_w, *sgu_b, *qn_g, *kn_g, *sink, *w_branch, *w_out, *w_router, *w_eg, *w_eu, *w_ed;
    float* out; unsigned char* ws;
};
typedef const __attribute__((address_space(4))) KP* KPC;

#define LDS_WAIT() asm volatile("s_waitcnt lgkmcnt(0)" ::: "memory")
__device__ __forceinline__ unsigned pk2(float lo, float hi) { return pg8::cvt_pk_bf16(lo, hi); }
__device__ __forceinline__ float bflo(unsigned w) { return __uint_as_float(w << 16); }
__device__ __forceinline__ float bfhi(unsigned w) { return __uint_as_float(w & 0xffff0000u); }
__device__ __forceinline__ void unpack8(const u32x4 w, float (&f)[8]) { f[0] = bflo(w.x); f[1] = bfhi(w.x); f[2] = bflo(w.y); f[3] = bfhi(w.y); f[4] = bflo(w.z); f[5] = bfhi(w.z); f[6] = bflo(w.w); f[7] = bfhi(w.w); }
__device__ __forceinline__ u32x4 pack8(const float (&f)[8]) { u32x4 o; o.x = pk2(f[0], f[1]); o.y = pk2(f[2], f[3]); o.z = pk2(f[4], f[5]); o.w = pk2(f[6], f[7]); return o; }
template <int MASK> __device__ __forceinline__ float swz_xor(float v) { static_assert(MASK > 0 && MASK < 32, "swz_xor: 1..31"); return __builtin_bit_cast(float, __builtin_amdgcn_ds_swizzle(__builtin_bit_cast(int, v), 0x1f | (MASK << 10))); }
template <int MASK> __device__ __forceinline__ int swz_xor_i(int v) { return __builtin_amdgcn_ds_swizzle(v, 0x1f | (MASK << 10)); }
__device__ __forceinline__ float sum_x32(float v) { const unsigned u = __builtin_bit_cast(unsigned, v); auto r = __builtin_amdgcn_permlane32_swap(u, u, false, false); return __builtin_bit_cast(float, (unsigned)r[0]) + __builtin_bit_cast(float, (unsigned)r[1]); }
__device__ __forceinline__ float max_x32(float v) { const unsigned u = __builtin_bit_cast(unsigned, v); auto r = __builtin_amdgcn_permlane32_swap(u, u, false, false); return fmaxf(__builtin_bit_cast(float, (unsigned)r[0]), __builtin_bit_cast(float, (unsigned)r[1])); }
__device__ __forceinline__ int sum_x32_i(int v) { auto r = __builtin_amdgcn_permlane32_swap((unsigned)v, (unsigned)v, false, false); return (int)r[0] + (int)r[1]; }
__device__ __forceinline__ float wave_sum(float v) { v += swz_xor<1>(v); v += swz_xor<2>(v); v += swz_xor<4>(v); v += swz_xor<8>(v); v += swz_xor<16>(v); return sum_x32(v); }
__device__ __forceinline__ float wave_max(float v) { v = fmaxf(v, swz_xor<1>(v)); v = fmaxf(v, swz_xor<2>(v)); v = fmaxf(v, swz_xor<4>(v)); v = fmaxf(v, swz_xor<8>(v)); v = fmaxf(v, swz_xor<16>(v)); return max_x32(v); }
__device__ __forceinline__ int wave_sum_i(int v) { v += swz_xor_i<1>(v); v += swz_xor_i<2>(v); v += swz_xor_i<4>(v); v += swz_xor_i<8>(v); v += swz_xor_i<16>(v); return sum_x32_i(v); }
__device__ __forceinline__ float sum_x16_x32(float v) { v += swz_xor<16>(v); return sum_x32(v); }
__device__ __forceinline__ float sum_x1_x2(float v) { v += swz_xor<1>(v); v += swz_xor<2>(v); return v; }
__device__ __forceinline__ float ex2(float x) { return __builtin_amdgcn_exp2f(x); }
__device__ __forceinline__ float rcp_(float x) { return __builtin_amdgcn_rcpf(x); }
__device__ __forceinline__ float rsq_(float x) { return __builtin_amdgcn_rsqf(x); }
__device__ __forceinline__ float sigmoidf_(float x) { return rcp_(1.f + ex2(-x * LOG2E)); }
__device__ __forceinline__ float gelu_tanh(float x) { const float u = 0.7978845608028654f * (x + 0.044715f * x * x * x); return x * rcp_(1.f + ex2(-2.f * LOG2E * u)); }
__device__ __forceinline__ f32x4 mfma16(bf16x8 a, bf16x8 b, f32x4 c) { return __builtin_amdgcn_mfma_f32_16x16x32_bf16(a, b, c, 0, 0, 0); }
__device__ __forceinline__ bf16x8 as_bf16x8(u32x4 w) { return __builtin_bit_cast(bf16x8, w); }
__device__ __forceinline__ float log2_sigmoid(float a) { return -log1pf(__expf(-a)) * LOG2E; }

struct GroupOrder {
    int nG, nM, nN, pmS, pnS, G, c;
    __device__ __forceinline__ bool next(int i, pg8::Unit& u) const {
        const long L = (long)i * G + c; const int tot = nG * nM * nN; if (L >= tot) return false;
        int wgid = (int)L; { const int q = tot / 8, r = tot % 8, xcd = wgid % 8, off = wgid / 8; wgid = (xcd < r ? xcd * (q + 1) : r * (q + 1) + (xcd - r) * q) + off; }
        const int per = nM * nN, g = wgid / per, rem = wgid - g * per;
        const int nig = 8 * nN, gid = rem / nig, fm = gid * 8, gsz = (nM - fm) < 8 ? (nM - fm) : 8;
        u.pm = g * pmS + fm + ((rem % nig) % gsz); u.pn = g * pnS + (rem % nig) / gsz; return true;
    }
    __device__ __forceinline__ void a_ready(const pg8::Unit&) const {}
    __device__ __forceinline__ void done(const pg8::Unit&) const {}
};
struct MergeOrder {
    int nM, G, c;
    __device__ __forceinline__ bool next(int i, pg8::Unit& u) const {
        const int ii = i / 3, g = i - 3 * ii; const long L = (long)ii * G + c; const int tot = nM * 4; if (L >= tot) return false;
        int wgid = (int)L; { const int q = tot / 8, r = tot % 8, xcd = wgid % 8, off = wgid / 8; wgid = (xcd < r ? xcd * (q + 1) : r * (q + 1) + (xcd - r) * q) + off; }
        const int nig = 32, gid = wgid / nig, fm = gid * 8, gsz = (nM - fm) < 8 ? (nM - fm) : 8;
        u.pm = g * (M / 256) + fm + ((wgid % nig) % gsz); u.pn = g * 4 + (wgid % nig) / gsz; return true;
    }
    __device__ __forceinline__ void a_ready(const pg8::Unit&) const {}
    __device__ __forceinline__ void done(const pg8::Unit&) const {}
};

struct EpiZA {
    static constexpr bool PERM = true, AFTER_DRAIN = false, CHAIN = false;
    bf16* O;
    __device__ __forceinline__ void operator()(const f32x4 (&acc)[2][2][4][2], const pg8::Unit& u, int wr, int wc, int fr, int fq) const {
        const int row0 = u.pm * 256 + wr * 64 + fr, col0 = u.pn * 256 + wc * 32 + 8 * fq; const bool act = false;
#pragma unroll
        for (int ai = 0; ai < 2; ++ai)
#pragma unroll
            for (int m = 0; m < 4; ++m) { bf16* rowp = O + (size_t)(row0 + ai * 128 + m * 16) * NZA + col0;
#pragma unroll
                for (int bj = 0; bj < 2; ++bj) { const f32x4 v0 = acc[ai][bj][m][0], v1 = acc[ai][bj][m][1];
                    float o[8] = {v0[0], v0[1], v0[2], v0[3], v1[0], v1[1], v1[2], v1[3]};
                    if (act) {
#pragma unroll
                        for (int k = 0; k < 8; ++k) o[k] = gelu_tanh(o[k]); }
                    *(u32x4*)(rowp + bj * 128) = pack8(o); } }
    }
};
struct EpiSig {
    static constexpr bool PERM = true, AFTER_DRAIN = false, CHAIN = false;
    bf16* O;
    __device__ __forceinline__ void operator()(const f32x4 (&acc)[2][2][4][2], const pg8::Unit& u, int wr, int wc, int fr, int fq) const {
        const int row0 = u.pm * 256 + wr * 64 + fr, col0 = u.pn * 256 + wc * 32 + 8 * fq;
#pragma unroll
        for (int ai = 0; ai < 2; ++ai)
#pragma unroll
            for (int m = 0; m < 4; ++m) { bf16* rowp = O + (size_t)(row0 + ai * 128 + m * 16) * NZG + col0;
#pragma unroll
                for (int bj = 0; bj < 2; ++bj) { const f32x4 v0 = acc[ai][bj][m][0], v1 = acc[ai][bj][m][1];
                    float o[8] = {v0[0], v0[1], v0[2], v0[3], v1[0], v1[1], v1[2], v1[3]};
#pragma unroll
                    for (int k = 0; k < 8; ++k) o[k] = fmaxf(sigmoidf_(o[k]), 1e-20f);
                    *(u32x4*)(rowp + bj * 128) = pack8(o); } }
    }
};
struct EpiMergeChain {
    static constexpr bool PERM = true, AFTER_DRAIN = false, CHAIN = true;
    const bf16* Gt; bf16* Hm;
    __device__ __forceinline__ bool chain(f32x4 (&acc)[2][2][4][2], const pg8::Unit& u, int wr, int wc, int fr, int fq) const {
        const int g = u.pm / (M / 256), m = u.pm - g * (M / 256), n = u.pn - g * 4;
        const int row0 = m * 256 + wr * 64 + fr, col0 = n * 256 + wc * 32 + 8 * fq;
#pragma unroll
        for (int ai = 0; ai < 2; ++ai) {
            u32x4 gw[4][2], hw[4][2];
#pragma unroll
            for (int mm = 0; mm < 4; ++mm)
#pragma unroll
                for (int bj = 0; bj < 2; ++bj) gw[mm][bj] = *(const u32x4*)(Gt + (size_t)(row0 + ai * 128 + mm * 16) * NZG + g * 1024 + col0 + bj * 128);
            if (g < 2) {
#pragma unroll
                for (int mm = 0; mm < 4; ++mm)
#pragma unroll
                    for (int bj = 0; bj < 2; ++bj) hw[mm][bj] = *(const u32x4*)(Gt + (size_t)(row0 + ai * 128 + mm * 16) * NZG + (g + 1) * 1024 + col0 + bj * 128);
            }
#pragma unroll
            for (int mm = 0; mm < 4; ++mm)
#pragma unroll
                for (int bj = 0; bj < 2; ++bj) {
                    float sc[8]; unpack8(gw[mm][bj], sc);
                    if (g < 2) { float sn[8]; unpack8(hw[mm][bj], sn);
#pragma unroll
                        for (int k = 0; k < 8; ++k) sc[k] *= __builtin_amdgcn_rcpf(sn[k]); }
                    f32x4& v0 = acc[ai][bj][mm][0]; f32x4& v1 = acc[ai][bj][mm][1];
                    v0[0] *= sc[0]; v0[1] *= sc[1]; v0[2] *= sc[2]; v0[3] *= sc[3]; v1[0] *= sc[4]; v1[1] *= sc[5]; v1[2] *= sc[6]; v1[3] *= sc[7];
                    if (g == 2) { u32x4 w; w.x = pk2(v0[0], v0[1]); w.y = pk2(v0[2], v0[3]); w.z = pk2(v1[0], v1[1]); w.w = pk2(v1[2], v1[3]);
                        *(u32x4*)(Hm + (size_t)(row0 + ai * 128 + mm * 16) * 1024 + col0 + bj * 128) = w; }
                }
        }
        return g < 2;
    }
};
struct EpiOut {
    static constexpr bool PERM = true, AFTER_DRAIN = false, CHAIN = false;
    const float* xl; const float* xc; bf16* X; const float* modv; int from_f32;
    __device__ __forceinline__ void operator()(const f32x4 (&acc)[2][2][4][2], const pg8::Unit& u, int wr, int wc, int fr, int fq) const {
        const int row0 = u.pm * 256 + wr * 64 + fr, col0 = u.pn * 256 + wc * 32 + 8 * fq;
        const int bi = (u.pm * 256 < ML) ? ((u.pm * 256) >> 12) : 8;
        const float* g1 = modv + bi * 6144 + 2 * 1024;
        f32x4 gv[2][2];
#pragma unroll
        for (int bj = 0; bj < 2; ++bj) { gv[bj][0] = *(const f32x4*)(g1 + col0 + bj * 128); gv[bj][1] = *(const f32x4*)(g1 + col0 + bj * 128 + 4); }
        if (from_f32) {
            const float* src0 = (u.pm * 256 < ML) ? xl + (size_t)row0 * 1024 : xc + (size_t)(row0 - ML) * 1024;
#pragma unroll
            for (int ai = 0; ai < 2; ++ai) {
                f32x4 xv[4][2][2];
#pragma unroll
                for (int m = 0; m < 4; ++m)
#pragma unroll
                    for (int bj = 0; bj < 2; ++bj) { const float* s = src0 + (size_t)(ai * 128 + m * 16) * 1024 + col0 + bj * 128; xv[m][bj][0] = *(const f32x4*)s; xv[m][bj][1] = *(const f32x4*)(s + 4); }
#pragma unroll
                for (int m = 0; m < 4; ++m)
#pragma unroll
                    for (int bj = 0; bj < 2; ++bj) { const f32x4 o0 = xv[m][bj][0] + gv[bj][0] * acc[ai][bj][m][0], o1 = xv[m][bj][1] + gv[bj][1] * acc[ai][bj][m][1];
                        u32x4 w; w.x = pk2(o0[0], o0[1]); w.y = pk2(o0[2], o0[3]); w.z = pk2(o1[0], o1[1]); w.w = pk2(o1[2], o1[3]);
                        *(u32x4*)(X + (size_t)(row0 + ai * 128 + m * 16) * 1024 + col0 + bj * 128) = w; }
            }
        } else {
#pragma unroll
            for (int ai = 0; ai < 2; ++ai) {
                u32x4 xw[4][2];
#pragma unroll
                for (int m = 0; m < 4; ++m)
#pragma unroll
                    for (int bj = 0; bj < 2; ++bj) xw[m][bj] = *(const u32x4*)(X + (size_t)(row0 + ai * 128 + m * 16) * 1024 + col0 + bj * 128);
#pragma unroll
                for (int m = 0; m < 4; ++m)
#pragma unroll
                    for (int bj = 0; bj < 2; ++bj) { float xo[8]; unpack8(xw[m][bj], xo); const f32x4 a0 = acc[ai][bj][m][0], a1 = acc[ai][bj][m][1];
                        float o[8] = {xo[0] + gv[bj][0][0] * a0[0], xo[1] + gv[bj][0][1] * a0[1], xo[2] + gv[bj][0][2] * a0[2], xo[3] + gv[bj][0][3] * a0[3],
                                      xo[4] + gv[bj][1][0] * a1[0], xo[5] + gv[bj][1][1] * a1[1], xo[6] + gv[bj][1][2] * a1[2], xo[7] + gv[bj][1][3] * a1[3]};
                        *(u32x4*)(X + (size_t)(row0 + ai * 128 + m * 16) * 1024 + col0 + bj * 128) = pack8(o); }
            }
        }
    }
};
struct EpiMoe1 {
    static constexpr bool PERM = true, AFTER_DRAIN = false, CHAIN = false;
    bf16* ACT;
    __device__ __forceinline__ void operator()(const f32x4 (&acc)[2][2][4][2], const pg8::Unit& u, int wr, int wc, int fr, int fq) const {
        const int row0 = u.pm * 256 + wr * 64 + fr, col0 = (u.pn & 7) * 128 + wc * 32 + 8 * fq;
#pragma unroll
        for (int ai = 0; ai < 2; ++ai)
#pragma unroll
            for (int m = 0; m < 4; ++m) { const size_t r = (size_t)(row0 + ai * 128 + m * 16);
                const f32x4 a0 = acc[ai][0][m][0], a1 = acc[ai][0][m][1], u0 = acc[ai][1][m][0], u1 = acc[ai][1][m][1];
                float o[8];
#pragma unroll
                for (int k = 0; k < 4; ++k) { o[k] = a0[k] * sigmoidf_(a0[k]) * u0[k]; o[4 + k] = a1[k] * sigmoidf_(a1[k]) * u1[k]; }
                *(u32x4*)(ACT + r * 1024 + col0) = pack8(o); }
    }
};
struct EpiMoe2 {
    static constexpr bool PERM = true, AFTER_DRAIN = false, CHAIN = false;
    bf16* Y; const float* topw;
    __device__ __forceinline__ void operator()(const f32x4 (&acc)[2][2][4][2], const pg8::Unit& u, int wr, int wc, int fr, int fq) const {
        const int row0 = u.pm * 256 + wr * 64 + fr, col0 = (u.pn & 3) * 256 + wc * 32 + 8 * fq;
        float twv[2][4];
#pragma unroll
        for (int ai = 0; ai < 2; ++ai)
#pragma unroll
            for (int m = 0; m < 4; ++m) twv[ai][m] = topw[row0 + ai * 128 + m * 16];
#pragma unroll
        for (int ai = 0; ai < 2; ++ai)
#pragma unroll
            for (int m = 0; m < 4; ++m) { const size_t r = (size_t)(row0 + ai * 128 + m * 16); const float tw = twv[ai][m];
#pragma unroll
                for (int bj = 0; bj < 2; ++bj) { const f32x4 v0 = acc[ai][bj][m][0] * tw, v1 = acc[ai][bj][m][1] * tw;
                    u32x4 w; w.x = pk2(v0[0], v0[1]); w.y = pk2(v0[2], v0[3]); w.z = pk2(v1[0], v1[1]); w.w = pk2(v1[2], v1[3]);
                    *(u32x4*)(Y + r * 1024 + col0 + bj * 128) = w; } }
    }
};

__device__ __forceinline__ void tr_item(const float* W, int N, int k0, int n0, bf16* dst, int K, LAS float* scr, int lane) {
#pragma unroll 8
    for (int i = 0; i < 32; ++i) { const int kk = 2 * i + (lane >> 5); scr[kk * 33 + (lane & 31)] = W[(size_t)(k0 + kk) * N + n0 + (lane & 31)]; }
    LDS_WAIT();
    const int cc = lane & 7;
#pragma unroll
    for (int j = 0; j < 4; ++j) { const int n = (lane >> 3) + 8 * j; const LAS float* s = scr + (8 * cc) * 33 + n;
        u32x4 o; o.x = pk2(s[0 * 33], s[1 * 33]); o.y = pk2(s[2 * 33], s[3 * 33]); o.z = pk2(s[4 * 33], s[5 * 33]); o.w = pk2(s[6 * 33], s[7 * 33]);
        *(u32x4*)(dst + (size_t)n * K + 8 * cc) = o; }
    LDS_WAIT();
}
__device__ __forceinline__ void convert_small(KPC p, int l, LAS unsigned char* lds, int lane, int wave, int bid, int G) {
    LAS float* scr = (LAS float*)(lds + wave * 8448);
    const int gw = bid * 8 + wave, NGW = G * 8;
    constexpr int I_IN = 16 * 200, I_BR = 8 * 32, I_OUT = 16 * 32;
    bf16* wtin = (bf16*)(p->ws + WS_WTIN); bf16* wtbr = (bf16*)(p->ws + WS_WTBR); bf16* wtout = (bf16*)(p->ws + WS_WTOUT);
    for (int it = gw; it < I_IN + 3 * I_BR + I_OUT; it += NGW) {
        int r = it;
        if (r < I_IN) { const int kb = r / 200, nb = r % 200; tr_item(p->w_in + (size_t)l * 1024 * 6400, 6400, 64 * kb, 32 * nb, wtin + (size_t)(32 * nb) * 1024 + 64 * kb, 1024, scr, lane); continue; }
        r -= I_IN;
        if (r < 3 * I_BR) { const int br = r / I_BR, q = r % I_BR, kb = q / 32, nb = q % 32;
            tr_item(p->w_branch + ((size_t)l * 3 + br) * 512 * 1024, 1024, 64 * kb, 32 * nb, wtbr + (size_t)(br * 1024 + 32 * nb) * 512 + 64 * kb, 512, scr, lane); continue; }
        r -= 3 * I_BR;
        { const int kb = r / 32, nb = r % 32; tr_item(p->w_out + (size_t)l * 1024 * 1024, 1024, 64 * kb, 32 * nb, wtout + (size_t)(32 * nb) * 1024 + 64 * kb, 1024, scr, lane); }
    }
}
__device__ __forceinline__ void convert_experts(KPC p, int l, int lo, int hi, int widx, int nw, LAS unsigned char* lds, int lane, int wave) {
    LAS float* scr = (LAS float*)(lds + wave * 8448);
    bf16* wt1 = (bf16*)(p->ws + WS_WT1); bf16* wt2 = (bf16*)(p->ws + WS_WT2);
    for (int it = lo + widx; it < hi; it += nw) {
        const int e = it / 1536, q = it % 1536, which = q / 512, qq = q % 512, kb = qq / 32, nb = qq % 32, n0 = 32 * nb, k0 = 64 * kb;
        const size_t woff = ((size_t)l * NE + e) * 1024 * 1024;
        if (which == 0) tr_item(p->w_eg + woff, 1024, k0, n0, wt1 + ((size_t)e * 2048 + (n0 >> 7) * 256 + (n0 & 127)) * 1024 + k0, 1024, scr, lane);
        else if (which == 1) tr_item(p->w_eu + woff, 1024, k0, n0, wt1 + ((size_t)e * 2048 + (n0 >> 7) * 256 + 128 + (n0 & 127)) * 1024 + k0, 1024, scr, lane);
        else tr_item(p->w_ed + woff, 1024, k0, n0, wt2 + ((size_t)e * 1024 + n0) * 1024 + k0, 1024, scr, lane);
    }
}
constexpr int CVT_ITEMS = NE * 3 * 512;
constexpr int CVT_G_IDLE0 = 96, CVT_M_IDLE0 = 32, CVT_O_IDLE0 = 32;
constexpr int CVT_G_HI = 7680, CVT_M_HI = 7680 + 14336;

__device__ __forceinline__ void phase_prep(KPC p, LAS unsigned char* lds, int tid, int lane, int wave, int bid, int G) {
    unsigned char* ws = p->ws;
    {   float* rc = (float*)(ws + WS_ROPEC); float* rsn = (float*)(ws + WS_ROPES);
        for (int i = bid * 512 + tid; i < T * 32; i += G * 512) { const int t = i >> 5, f = i & 31; const int pos = (f < 16) ? (t >> 6) : (t & 63); const int fi = f & 15;
            const float inv = ex2(-(float)fi * (13.287712379549449f / 16.f));
            float ang = (float)pos * inv; ang -= 6.283185307179586f * rintf(ang * 0.15915494309189535f);
            rc[i] = __cosf(ang); rsn[i] = __sinf(ang); } }
    if (bid == 0 && tid < 16) { const int l = tid >> 3, dir = (tid >> 2) & 1, h = tid & 3; ((float*)(ws + WS_LG))[tid] = log2_sigmoid(dir ? p->dec_b[l * 4 + h] : p->dec_f[l * 4 + h]); }
    {   LAS float* sv = (LAS float*)lds;
        LAS float* red = (LAS float*)(lds + 36864);
        for (int i = tid; i < 9 * 1024; i += 512) { const int r = i >> 10, k = i & 1023; const float v = (r < 8) ? p->c[r * 1024 + k] : p->c_ctx[k]; sv[i] = v * sigmoidf_(v); }
        __syncthreads();
        for (int it = bid; it < 192; it += G) {
            const int l = it / 96, n0 = (it % 96) * 64;
            const float* W = p->w_mod + (size_t)l * 1024 * 6144 + n0 + lane;
            float acc[9];
#pragma unroll
            for (int r = 0; r < 9; ++r) acc[r] = 0.f;
#pragma unroll 1
            for (int k0 = wave * 128; k0 < wave * 128 + 128; k0 += 16) {
                float wv[16];
#pragma unroll
                for (int kk = 0; kk < 16; ++kk) wv[kk] = W[(size_t)(k0 + kk) * 6144];
#pragma unroll
                for (int kk = 0; kk < 16; ++kk)
#pragma unroll
                    for (int r = 0; r < 9; ++r) acc[r] += sv[r * 1024 + k0 + kk] * wv[kk]; }
#pragma unroll
            for (int r = 0; r < 9; ++r) red[(wave * 9 + r) * 64 + lane] = acc[r];
            __syncthreads();
            for (int i = tid; i < 576; i += 512) { const int r = i >> 6, ln = i & 63; float s = 0.f;
#pragma unroll
                for (int w = 0; w < 8; ++w) s += red[(w * 9 + r) * 64 + ln];
                s += p->b_mod[l * 6144 + n0 + ln]; ((float*)(ws + WS_MODV))[(l * 9 + r) * 6144 + n0 + ln] = s; }
            __syncthreads();
        }
    }
    __syncthreads();
    convert_small(p, 0, lds, lane, wave, bid, G);
}

__device__ __forceinline__ float row_rs(const f32x4 (&v)[4]) {
    float ss = 0.f;
#pragma unroll
    for (int j = 0; j < 4; ++j) ss += (v[j].x * v[j].x + v[j].y * v[j].y) + (v[j].z * v[j].z + v[j].w * v[j].w);
    return rsq_(wave_sum(ss) * (1.f / 1024.f) + EPS);
}
__device__ __forceinline__ void norm_mod(const f32x4 (&v)[4], float rs, const float* gain, const float* sh, const float* sc, f32x4 (&h)[4], int lane) {
#pragma unroll
    for (int j = 0; j < 4; ++j) { const int col = 4 * lane + 256 * j; const f32x4 g = *(const f32x4*)(gain + col), a = *(const f32x4*)(sc + col), b = *(const f32x4*)(sh + col);
        h[j] = (v[j] * rs) * g * (a + 1.0f) + b; }
}
__device__ __forceinline__ void store_h(const f32x4 (&h)[4], bf16* hrow, int lane) {
#pragma unroll
    for (int j = 0; j < 4; ++j) { u32x2 w; w.x = pk2(h[j].x, h[j].y); w.y = pk2(h[j].z, h[j].w); *(u32x2*)(hrow + 4 * lane + 256 * j) = w; }
}
__device__ __forceinline__ void phase_norm_in(KPC p, int lane, int wave, int bid, int G) {
    const float* modv = (const float*)(p->ws + WS_MODV); bf16* H = (bf16*)(p->ws + WS_H);
    const int stride = G * 8; int r = bid * 8 + wave;
    f32x4 vn[4];
    {   const float* src = (r < ML) ? p->x + (size_t)r * 1024 : p->ctx + (size_t)(r - ML) * 1024;
#pragma unroll
        for (int j = 0; j < 4; ++j) vn[j] = (r < M) ? *(const f32x4*)(src + 4 * lane + 256 * j) : (f32x4){0.f, 0.f, 0.f, 0.f}; }
    for (; r < M; r += stride) {
        const int bi = (r < ML) ? (r >> 12) : 8; const float* mv = modv + bi * 6144;
        f32x4 v[4], h[4], g[4], sc[4], sh[4];
#pragma unroll
        for (int j = 0; j < 4; ++j) { v[j] = vn[j]; const int col = 4 * lane + 256 * j; g[j] = *(const f32x4*)(p->norm1_g + col); sh[j] = *(const f32x4*)(mv + col); sc[j] = *(const f32x4*)(mv + 1024 + col); }
        const int rn = r + stride;
        if (rn < M) { const float* src = (rn < ML) ? p->x + (size_t)rn * 1024 : p->ctx + (size_t)(rn - ML) * 1024;
#pragma unroll
            for (int j = 0; j < 4; ++j) vn[j] = *(const f32x4*)(src + 4 * lane + 256 * j); }
        const float rs = row_rs(v);
#pragma unroll
        for (int j = 0; j < 4; ++j) h[j] = (v[j] * rs) * g[j] * (sc[j] + 1.0f) + sh[j];
        store_h(h, H + (size_t)r * 1024, lane);
    }
}

typedef short s16x4 __attribute__((ext_vector_type(4)));
__device__ __forceinline__ u32x2 lds_tr16(const LAS unsigned char* addr) { const s16x4 r = __builtin_amdgcn_ds_read_tr16_b64_v4i16((LAS s16x4*)addr); return __builtin_bit_cast(u32x2, r); }
__device__ __forceinline__ void ld8f(const float* p, float (&f)[8]) { const f32x4 a = *(const f32x4*)p, b = *(const f32x4*)(p + 4); f[0] = a[0]; f[1] = a[1]; f[2] = a[2]; f[3] = a[3]; f[4] = b[0]; f[5] = b[1]; f[6] = b[2]; f[7] = b[3]; }
__device__ __forceinline__ void att_item(KPC p, int l, LAS unsigned char* lds, int item, float Mb2, int tid, int lane, int wave) {
    const bf16* ZA = (const bf16*)(p->ws + WS_ZA); bf16* BR = (bf16*)p->out + (size_t)2 * M * 512;
    const float* rc = (const float*)(p->ws + WS_ROPEC); const float* rsn = (const float*)(p->ws + WS_ROPES);
    const bool isctx = item >= 512;
    int b, kvh, qb;
    if (!isctx) { b = item >> 6; kvh = (item >> 5) & 1; qb = item & 31; } else { const int ci = item - 512; b = ci >> 2; kvh = (ci >> 1) & 1; qb = ci & 1; }
    const int rowbase = isctx ? ML + b * CL : b * T;
    const int g = wave >> 1, qs = wave & 1, hh = kvh * 4 + g, c = lane & 15, g4 = lane >> 4, q0 = qb * 128 + qs * 64;
    const float* qg = p->qn_g + l * 64; const float* kg = p->kn_g + l * 64;
    LAS unsigned char* Kl = lds;
    bf16x8 qf[4][2];
    float qga[8], qgb[8]; ld8f(qg + 8 * g4, qga); ld8f(qg + 32 + 8 * g4, qgb);
#pragma unroll
    for (int ti = 0; ti < 4; ++ti) {
        const int pos = q0 + 16 * ti + c; const bf16* src = ZA + (size_t)(rowbase + pos) * NZA + C_AQ + hh * 64 + 8 * g4;
        float a[8], bb[8]; unpack8(*(const u32x4*)src, a); unpack8(*(const u32x4*)(src + 32), bb);
        float ss = 0.f;
#pragma unroll
        for (int j = 0; j < 8; ++j) ss += a[j] * a[j] + bb[j] * bb[j];
        ss = sum_x16_x32(ss);
        const float rs = rsq_(ss * (1.f / 64.f) + EPS);
#pragma unroll
        for (int j = 0; j < 8; ++j) { a[j] *= rs * qga[j]; bb[j] *= rs * qgb[j]; }
        if (!isctx) { float cs8[8], sn8[8]; ld8f(rc + pos * 32 + 8 * g4, cs8); ld8f(rsn + pos * 32 + 8 * g4, sn8);
#pragma unroll
            for (int j = 0; j < 8; ++j) { const float cs = cs8[j], sn = sn8[j]; const float x1 = a[j], x2 = bb[j]; a[j] = x1 * cs - x2 * sn; bb[j] = x1 * sn + x2 * cs; } }
#pragma unroll
        for (int j = 0; j < 8; ++j) { a[j] *= 0.125f * LOG2E; bb[j] *= 0.125f * LOG2E; }
        qf[ti][0] = as_bf16x8(pack8(a)); qf[ti][1] = as_bf16x8(pack8(bb));
        __builtin_amdgcn_sched_barrier(0);
    }
    f32x4 O[4][4]; float lsum[4];
#pragma unroll
    for (int i = 0; i < 4; ++i) { lsum[i] = 0.f;
#pragma unroll
        for (int j = 0; j < 4; ++j) O[i][j] = (f32x4){0.f, 0.f, 0.f, 0.f}; }
    const int key = tid >> 2, q4 = tid & 3;
    LAS unsigned char* Vl = lds + 55296;
#pragma unroll 1
    for (int st = isctx ? 1 : 0; st < 2; ++st) {
        __syncthreads();
        {   u32x4 kr[1][2], vr[1][2];
#define ATT_VB(lb_) ((st == 0) ? ((qb - 1 + (lb_)) >= 0 && (qb - 1 + (lb_)) <= 31) : ((lb_) < 2))
#define ATT_LD(lb_, s_) do { if (ATT_VB(lb_)) { const int krow = (st == 0) ? b * T + (qb - 1 + (lb_)) * 128 + key : ML + b * CL + 128 * (lb_) + key; \
                const bf16* ks = ZA + (size_t)krow * NZA + C_AK + kvh * 64 + 8 * q4; kr[s_][0] = *(const u32x4*)ks; kr[s_][1] = *(const u32x4*)(ks + 32); \
                const bf16* vs = ZA + (size_t)krow * NZA + C_AV + kvh * 64 + 16 * q4; vr[s_][0] = *(const u32x4*)vs; vr[s_][1] = *(const u32x4*)(vs + 8); } } while (0)
#pragma unroll 1
            for (int lb = 0; lb < 3; ++lb) {
                ATT_LD(lb, 0);
                if (ATT_VB(lb)) {
                    float a[8], bb[8]; unpack8(kr[0][0], a); unpack8(kr[0][1], bb);
                    float ss = 0.f;
#pragma unroll
                    for (int j = 0; j < 8; ++j) ss += a[j] * a[j] + bb[j] * bb[j];
                    ss = sum_x1_x2(ss);
                    const float rs = rsq_(ss * (1.f / 64.f) + EPS);
                    float kga[8], kgb[8]; ld8f(kg + 8 * q4, kga); ld8f(kg + 32 + 8 * q4, kgb);
#pragma unroll
                    for (int j = 0; j < 8; ++j) { a[j] *= rs * kga[j]; bb[j] *= rs * kgb[j]; }
                    __builtin_amdgcn_sched_barrier(0);
                    if (st == 0) { const int pos = (qb - 1 + lb) * 128 + key; float cs8[8], sn8[8]; ld8f(rc + pos * 32 + 8 * q4, cs8); ld8f(rsn + pos * 32 + 8 * q4, sn8);
#pragma unroll
                        for (int j = 0; j < 8; ++j) { const float cs = cs8[j], sn = sn8[j]; const float x1 = a[j], x2 = bb[j]; a[j] = x1 * cs - x2 * sn; bb[j] = x1 * sn + x2 * cs; } }
                    LAS unsigned char* kd = Kl + (lb * 128 + key) * 144; *(LAS u32x4*)(kd + 16 * q4) = pack8(a); *(LAS u32x4*)(kd + 64 + 16 * q4) = pack8(bb);
                    LAS unsigned char* vd = Vl + (lb * 128 + key) * 144 + 32 * q4; *(LAS u32x4*)vd = vr[0][0]; *(LAS u32x4*)(vd + 16) = vr[0][1];
                }
            }
#undef ATT_VB
#undef ATT_LD
        }
        __syncthreads();
#pragma unroll 1
        for (int lb = 0; lb < 3; ++lb) {
            if (st == 0) { const int kb = qb - 1 + lb; if (kb < 0 || kb > 31) continue; } else if (lb >= 2) continue;
            const int mode = (st == 0) ? ((lb == 0) ? 1 : ((lb == 2) ? 2 : 0)) : 0;
            const LAS unsigned char* Kb = Kl + lb * 128 * 144; const LAS unsigned char* Vb = Vl + lb * 128 * 144;
#pragma unroll 1
            for (int kk = 0; kk < 4; ++kk) {
                if ((mode == 1 && 32 * kk + 31 < qs * 64) || (mode == 2 && 32 * kk > qs * 64 + 63)) continue;
                bf16x8 ka[2][2];
#pragma unroll
                for (int hf = 0; hf < 2; ++hf)
#pragma unroll
                    for (int ks = 0; ks < 2; ++ks) ka[hf][ks] = *(const LAS bf16x8*)(Kb + (32 * kk + 16 * hf + c) * 144 + ks * 64 + g4 * 16);
                bf16x8 pf[4];
#pragma unroll
                for (int ti = 0; ti < 4; ++ti) {
                    f32x4 sa = (f32x4){-Mb2, -Mb2, -Mb2, -Mb2}, sb = sa;
                    sa = mfma16(ka[0][0], qf[ti][0], sa); sa = mfma16(ka[0][1], qf[ti][1], sa);
                    sb = mfma16(ka[1][0], qf[ti][0], sb); sb = mfma16(ka[1][1], qf[ti][1], sb);
                    float pa[4], pb[4];
#pragma unroll
                    for (int rr = 0; rr < 4; ++rr) { pa[rr] = ex2(sa[rr]); pb[rr] = ex2(sb[rr]); }
                    if (mode != 0) {
                        const int ii = qs * 64 + 16 * ti + c; const int mlo = (mode == 1) ? ii : -1000, mhi = (mode == 2) ? ii : 1000;
#pragma unroll
                        for (int rr = 0; rr < 4; ++rr) { const int ja = 32 * kk + 4 * g4 + rr, jb = ja + 16;
                            pa[rr] = (ja >= mlo && ja <= mhi) ? pa[rr] : 0.f; pb[rr] = (jb >= mlo && jb <= mhi) ? pb[rr] : 0.f; } }
                    lsum[ti] += ((pa[0] + pa[1]) + (pa[2] + pa[3])) + ((pb[0] + pb[1]) + (pb[2] + pb[3]));
                    u32x4 w; w.x = pk2(pa[0], pa[1]); w.y = pk2(pa[2], pa[3]); w.z = pk2(pb[0], pb[1]); w.w = pk2(pb[2], pb[3]); pf[ti] = as_bf16x8(w);
                }
#pragma unroll
                for (int dt = 0; dt < 4; ++dt) {
                    const u32x2 v0 = lds_tr16(Vb + (32 * kk + 4 * g4 + (c >> 2)) * 144 + (16 * dt + 4 * (c & 3)) * 2), v1 = lds_tr16(Vb + (32 * kk + 16 + 4 * g4 + (c >> 2)) * 144 + (16 * dt + 4 * (c & 3)) * 2);
                    u32x4 vv; vv.x = v0.x; vv.y = v0.y; vv.z = v1.x; vv.w = v1.y; const bf16x8 va = as_bf16x8(vv);
#pragma unroll
                    for (int ti = 0; ti < 4; ++ti) O[dt][ti] = mfma16(va, pf[ti], O[dt][ti]);
                }
            }
        }
    }
    const float sk = ex2(p->sink[l * 8 + hh] * LOG2E - Mb2);
#pragma unroll
    for (int ti = 0; ti < 4; ++ti) { float lt = sum_x16_x32(lsum[ti]); const float inv = rcp_(lt + sk);
        bf16* dst = BR + (size_t)(rowbase + q0 + 16 * ti + c) * 512 + hh * 64 + 4 * g4;
#pragma unroll
        for (int dt = 0; dt < 4; ++dt) { const f32x4 o = O[dt][ti] * inv; u32x2 w; w.x = pk2(o[0], o[1]); w.y = pk2(o[2], o[3]); *(u32x2*)(dst + 16 * dt) = w; } }
    __syncthreads();
}

__device__ __forceinline__ void sgu_vprep_item(KPC p, int ch, int tid) {
    bf16* ZA = (bf16*)(p->ws + WS_ZA);
    const int seg = tid & 15;
    bf16* rowp0 = ZA + (size_t)(ch * 128 + (tid >> 4)) * NZA + C_SV + 32 * seg;
    u32x4 raw[4][4];
#pragma unroll
    for (int ps = 0; ps < 4; ++ps)
#pragma unroll
        for (int q = 0; q < 4; ++q) raw[ps][q] = *(const u32x4*)(rowp0 + (size_t)ps * 32 * NZA + 8 * q);
#pragma unroll
    for (int ps = 0; ps < 4; ++ps) {
        bf16* rowp = rowp0 + (size_t)ps * 32 * NZA;
        float f[4][8]; float s = 0.f, ss = 0.f;
#pragma unroll
        for (int q = 0; q < 4; ++q) unpack8(raw[ps][q], f[q]);
#pragma unroll
        for (int q = 0; q < 4; ++q)
#pragma unroll
            for (int e = 0; e < 8; ++e) { const float y = gelu_tanh(f[q][e]); f[q][e] = y; s += y; ss += y * y; }
        s += swz_xor<1>(s); s += swz_xor<2>(s); s += swz_xor<4>(s); s += swz_xor<8>(s);
        ss += swz_xor<1>(ss); ss += swz_xor<2>(ss); ss += swz_xor<4>(ss); ss += swz_xor<8>(ss);
        const float mean = s * (1.f / 512.f), var = fmaxf(ss * (1.f / 512.f) - mean * mean, 0.f), rstd = rsq_(var + EPS);
#pragma unroll
        for (int q = 0; q < 4; ++q) {
#pragma unroll
            for (int e = 0; e < 8; ++e) f[q][e] = (f[q][e] - mean) * rstd;
            *(u32x4*)(rowp + 8 * q) = pack8(f[q]); }
    }
}
__device__ __forceinline__ void sgu_item(KPC p, int l, LAS unsigned char* lds, int item, int tid, int lane, int wave) {
    const bf16* ZA = (const bf16*)(p->ws + WS_ZA); bf16* BR = (bf16*)p->out + (size_t)1 * M * 512;
    const int ch = item >> 2, g = item & 3, r0 = ch * 128, c = lane & 15, g4 = lane >> 4;
    LAS unsigned char* vT = lds;
    LAS unsigned char* WL = lds + 34816;
    {   const int j = tid >> 2, q4 = tid & 3; const bf16* src = ZA + (size_t)(r0 + j) * NZA + C_SV + 128 * g + 32 * q4;
#pragma unroll
        for (int q = 0; q < 4; ++q) { const u32x4 v = *(const u32x4*)(src + 8 * q); const unsigned vw[4] = {v.x, v.y, v.z, v.w};
#pragma unroll
            for (int e = 0; e < 4; ++e) { *(LAS unsigned short*)(vT + (32 * q4 + 8 * q + 2 * e) * 272 + j * 2) = (unsigned short)(vw[e] & 0xffffu); *(LAS unsigned short*)(vT + (32 * q4 + 8 * q + 2 * e + 1) * 272 + j * 2) = (unsigned short)(vw[e] >> 16); } }
        const float* wsrc = p->sgu_w + ((size_t)(l * 4 + g) * 128 + (tid >> 2)) * 128 + 32 * (tid & 3);
#pragma unroll
        for (int q = 0; q < 4; ++q) { const f32x4 a = *(const f32x4*)(wsrc + 8 * q), bq = *(const f32x4*)(wsrc + 8 * q + 4);
            u32x4 w; w.x = pk2(a.x, a.y); w.y = pk2(a.z, a.w); w.z = pk2(bq.x, bq.y); w.w = pk2(bq.z, bq.w);
            *(LAS u32x4*)(WL + (tid >> 2) * 272 + (32 * (tid & 3) + 8 * q) * 2) = w; }
    }
    __syncthreads();
    bf16x8 af[4];
#pragma unroll
    for (int ks = 0; ks < 4; ++ks) af[ks] = *(const LAS bf16x8*)(vT + (16 * wave + c) * 272 + (32 * ks + 8 * g4) * 2);
    const int col = 128 * g + 16 * wave + 4 * g4;
    u32x2 uw[8]; float bias[8];
#pragma unroll
    for (int ti = 0; ti < 8; ++ti) { uw[ti] = *(const u32x2*)(ZA + (size_t)(r0 + 16 * ti + c) * NZA + C_SU + col); bias[ti] = p->sgu_b[(l * 4 + g) * 128 + 16 * ti + c]; }
#pragma unroll
    for (int ti = 0; ti < 8; ++ti) {
        f32x4 acc = (f32x4){0.f, 0.f, 0.f, 0.f};
#pragma unroll
        for (int ks = 0; ks < 4; ++ks) acc = mfma16(af[ks], *(const LAS bf16x8*)(WL + (16 * ti + c) * 272 + (32 * ks + 8 * g4) * 2), acc);
        const float o0 = gelu_tanh(bflo(uw[ti].x)) * (acc[0] + bias[ti]), o1 = gelu_tanh(bfhi(uw[ti].x)) * (acc[1] + bias[ti]), o2 = gelu_tanh(bflo(uw[ti].y)) * (acc[2] + bias[ti]), o3 = gelu_tanh(bfhi(uw[ti].y)) * (acc[3] + bias[ti]);
        u32x2 w; w.x = pk2(o0, o1); w.y = pk2(o2, o3); *(u32x2*)(BR + (size_t)(r0 + 16 * ti + c) * 512 + col) = w;
    }
    __syncthreads();
}

__device__ __forceinline__ void ret_load_k(KPC p, const bf16* ZA, int r0, int h, bool latent, int pos0, int tid, float (&a)[8], float (&bb)[8]) {
    const int j = tid >> 2, q4 = tid & 3; const bf16* src = ZA + (size_t)(r0 + j) * NZA + C_RK + 64 * h + 8 * q4;
    unpack8(*(const u32x4*)src, a); unpack8(*(const u32x4*)(src + 32), bb);
    if (latent) { const float* rc = (const float*)(p->ws + WS_ROPEC); const float* rsn = (const float*)(p->ws + WS_ROPES); const int pos = pos0 + j; float cs8[8], sn8[8]; ld8f(rc + pos * 32 + 8 * q4, cs8); ld8f(rsn + pos * 32 + 8 * q4, sn8);
#pragma unroll
        for (int e = 0; e < 8; ++e) { const float cs = cs8[e], sn = sn8[e]; const float x1 = a[e], x2 = bb[e]; a[e] = x1 * cs - x2 * sn; bb[e] = x1 * sn + x2 * cs; } }
#pragma unroll
    for (int e = 0; e < 8; ++e) { a[e] *= 0.125f; bb[e] *= 0.125f; }
}
__device__ __forceinline__ void ret_stage_vT(const bf16* ZA, int r0, int h, LAS unsigned char* vT, int tid) {
    const int j = tid >> 2, q4 = tid & 3; const bf16* src = ZA + (size_t)(r0 + j) * NZA + C_RV + 128 * h + 32 * q4;
#pragma unroll
    for (int q = 0; q < 4; ++q) { const u32x4 v = *(const u32x4*)(src + 8 * q); const unsigned vw[4] = {v.x, v.y, v.z, v.w};
#pragma unroll
        for (int e = 0; e < 4; ++e) { *(LAS unsigned short*)(vT + (32 * q4 + 8 * q + 2 * e) * 272 + j * 2) = (unsigned short)(vw[e] & 0xffffu); *(LAS unsigned short*)(vT + (32 * q4 + 8 * q + 2 * e + 1) * 272 + j * 2) = (unsigned short)(vw[e] >> 16); } }
}
__device__ __forceinline__ void ret_upd_item(KPC p, int l, LAS unsigned char* lds, int item, int tid, int lane, int wave) {
    const bf16* ZA = (const bf16*)(p->ws + WS_ZA); float* RS = (float*)(p->ws + WS_RS);
    const int b = item / (NCH * 4), rem = item % (NCH * 4), n = rem >> 2, h = rem & 3, c = lane & 15, g4 = lane >> 4;
    const bool latent = n < 32; const int r0 = latent ? b * T + 128 * n : ML + b * CL + 128 * (n - 32);
    const float lgf = ((const float*)(p->ws + WS_LG))[l * 8 + h], lgb = ((const float*)(p->ws + WS_LG))[l * 8 + 4 + h];
    LAS unsigned char* vT = lds; LAS unsigned char* kTf = lds + 34816; LAS unsigned char* kTb = lds + 34816 + 17408;
    {   float a[8], bb[8]; ret_load_k(p, ZA, r0, h, latent, 128 * n, tid, a, bb);
        const int j = tid >> 2, q4 = tid & 3; const float wf = ex2((float)(127 - j) * lgf), wb = ex2((float)j * lgb);
#pragma unroll
        for (int e = 0; e < 8; e += 2) {
            unsigned w = pk2(a[e] * wf, a[e + 1] * wf); *(LAS unsigned short*)(kTf + (8 * q4 + e) * 272 + j * 2) = (unsigned short)(w & 0xffffu); *(LAS unsigned short*)(kTf + (8 * q4 + e + 1) * 272 + j * 2) = (unsigned short)(w >> 16);
            w = pk2(bb[e] * wf, bb[e + 1] * wf); *(LAS unsigned short*)(kTf + (32 + 8 * q4 + e) * 272 + j * 2) = (unsigned short)(w & 0xffffu); *(LAS unsigned short*)(kTf + (32 + 8 * q4 + e + 1) * 272 + j * 2) = (unsigned short)(w >> 16);
            w = pk2(a[e] * wb, a[e + 1] * wb); *(LAS unsigned short*)(kTb + (8 * q4 + e) * 272 + j * 2) = (unsigned short)(w & 0xffffu); *(LAS unsigned short*)(kTb + (8 * q4 + e + 1) * 272 + j * 2) = (unsigned short)(w >> 16);
            w = pk2(bb[e] * wb, bb[e + 1] * wb); *(LAS unsigned short*)(kTb + (32 + 8 * q4 + e) * 272 + j * 2) = (unsigned short)(w & 0xffffu); *(LAS unsigned short*)(kTb + (32 + 8 * q4 + e + 1) * 272 + j * 2) = (unsigned short)(w >> 16);
        }
        ret_stage_vT(ZA, r0, h, vT, tid);
    }
    __syncthreads();
    bf16x8 af[4];
#pragma unroll
    for (int ks = 0; ks < 4; ++ks) af[ks] = *(const LAS bf16x8*)(vT + (16 * wave + c) * 272 + (32 * ks + 8 * g4) * 2);
#pragma unroll
    for (int dir = 0; dir < 2; ++dir) { const LAS unsigned char* kT = dir ? kTb : kTf;
        float* dst = RS + ((size_t)(((b * 4 + h) * 2 + dir) * NCH + n) * 128 + 16 * wave + 4 * g4) * 64;
#pragma unroll
        for (int dt = 0; dt < 4; ++dt) { f32x4 acc = (f32x4){0.f, 0.f, 0.f, 0.f};
#pragma unroll
            for (int ks = 0; ks < 4; ++ks) acc = mfma16(af[ks], *(const LAS bf16x8*)(kT + (16 * dt + c) * 272 + (32 * ks + 8 * g4) * 2), acc);
#pragma unroll
            for (int rr = 0; rr < 4; ++rr) dst[rr * 64 + 16 * dt + c] = acc[rr]; } }
    __syncthreads();
}
__device__ __forceinline__ void phase_scan(KPC p, int l, int tid, int bid, int G) {
    const float* __restrict__ RS = (const float*)(p->ws + WS_RS); bf16* __restrict__ ST = (bf16*)(p->ws + WS_ST);
    for (int idx = bid * 512 + tid; idx < NB * 4 * 2 * 8192; idx += G * 512) {
        const int ed = idx & 8191, dir = (idx >> 13) & 1, bh = idx >> 14, e = ed >> 6, d = ed & 63, h = bh & 3;
        const float* P = RS + (size_t)((bh * 2 + dir) * NCH) * 8192 + ed;
        bf16* S = ST + ((size_t)bh * NCH * 128 + e) * 128 + dir * 64 + d;
        const float lg = ((const float*)(p->ws + WS_LG))[l * 8 + dir * 4 + h]; const float dec = ex2(128.f * lg);
        float u[NCH];
#pragma unroll
        for (int n = 0; n < NCH; ++n) u[n] = P[(size_t)n * 8192];
        if (dir == 0) {
            S[32 * 16384] = 0; S[33 * 16384] = (bf16)(pk2(u[32], 0.f) & 0xffffu);
            float s = dec * u[32] + u[33];
#pragma unroll
            for (int n = 0; n < 32; ++n) { S[(size_t)n * 16384] = (bf16)(pk2(s, 0.f) & 0xffffu); s = dec * s + u[n]; }
        } else {
            S[33 * 16384] = 0; S[32 * 16384] = (bf16)(pk2(u[33], 0.f) & 0xffffu);
            float s = dec * u[33] + u[32];
#pragma unroll
            for (int n = 31; n >= 0; --n) { S[(size_t)n * 16384] = (bf16)(pk2(s, 0.f) & 0xffffu); s = dec * s + u[n]; }
        }
    }
}
__device__ __forceinline__ void ret_out_item(KPC p, int l, LAS unsigned char* lds, int item, int tid, int lane, int wave) {
    const bf16* ZA = (const bf16*)(p->ws + WS_ZA); bf16* BR = (bf16*)p->out; const bf16* ST = (const bf16*)(p->ws + WS_ST);
    const int b = item / (NCH * 4), rem = item % (NCH * 4), n = rem >> 2, h = rem & 3, c = lane & 15, g4 = lane >> 4;
    const bool latent = n < 32; const int r0 = latent ? b * T + 128 * n : ML + b * CL + 128 * (n - 32);
    const float lgf = ((const float*)(p->ws + WS_LG))[l * 8 + h], lgb = ((const float*)(p->ws + WS_LG))[l * 8 + 4 + h];
    LAS unsigned char* vT = lds; LAS unsigned char* Kl = lds + 34816; LAS unsigned char* Sl = lds + 34816 + 18432;
    {   float a[8], bb[8]; ret_load_k(p, ZA, r0, h, latent, 128 * n, tid, a, bb);
        const int j = tid >> 2, q4 = tid & 3;
        *(LAS u32x4*)(Kl + j * 144 + 16 * q4) = pack8(a); *(LAS u32x4*)(Kl + j * 144 + 64 + 16 * q4) = pack8(bb);
        ret_stage_vT(ZA, r0, h, vT, tid);
        const u32x4* ssrc = (const u32x4*)(ST + (size_t)((b * 4 + h) * NCH + n) * 16384);
#pragma unroll
        for (int k = 0; k < 4; ++k) { const int q = tid + 512 * k; *(LAS u32x4*)(Sl + (q >> 4) * 272 + (q & 15) * 16) = ssrc[q]; }
    }
    __syncthreads();
    const int ii = 16 * wave + c;
    bf16x8 qf[2];
    {   const bf16* src = ZA + (size_t)(r0 + ii) * NZA + C_RQ + 64 * h + 8 * g4; float a[8], bb[8]; unpack8(*(const u32x4*)src, a); unpack8(*(const u32x4*)(src + 32), bb);
        if (latent) { const float* rc = (const float*)(p->ws + WS_ROPEC); const float* rsn = (const float*)(p->ws + WS_ROPES); const int pos = 128 * n + ii; float cs8[8], sn8[8]; ld8f(rc + pos * 32 + 8 * g4, cs8); ld8f(rsn + pos * 32 + 8 * g4, sn8);
#pragma unroll
            for (int e = 0; e < 8; ++e) { const float cs = cs8[e], sn = sn8[e]; const float x1 = a[e], x2 = bb[e]; a[e] = x1 * cs - x2 * sn; bb[e] = x1 * sn + x2 * cs; } }
        qf[0] = as_bf16x8(pack8(a)); qf[1] = as_bf16x8(pack8(bb)); }
    bf16x8 pf[4];
#pragma unroll
    for (int kk = 0; kk < 4; ++kk) {
        f32x4 sa = (f32x4){0.f, 0.f, 0.f, 0.f}, sb = (f32x4){0.f, 0.f, 0.f, 0.f};
        sa = mfma16(*(const LAS bf16x8*)(Kl + (32 * kk + c) * 144 + g4 * 16), qf[0], sa); sa = mfma16(*(const LAS bf16x8*)(Kl + (32 * kk + c) * 144 + 64 + g4 * 16), qf[1], sa);
        sb = mfma16(*(const LAS bf16x8*)(Kl + (32 * kk + 16 + c) * 144 + g4 * 16), qf[0], sb); sb = mfma16(*(const LAS bf16x8*)(Kl + (32 * kk + 16 + c) * 144 + 64 + g4 * 16), qf[1], sb);
        float pa[4], pb[4];
#pragma unroll
        for (int rr = 0; rr < 4; ++rr) { const int ja = 32 * kk + 4 * g4 + rr, jb = ja + 16; const int da = ii - ja, db = ii - jb;
            pa[rr] = sa[rr] * ((da >= 0) ? ex2((float)da * lgf) : ex2((float)(-da) * lgb)); pb[rr] = sb[rr] * ((db >= 0) ? ex2((float)db * lgf) : ex2((float)(-db) * lgb)); }
        u32x4 w; w.x = pk2(pa[0], pa[1]); w.y = pk2(pa[2], pa[3]); w.z = pk2(pb[0], pb[1]); w.w = pk2(pb[2], pb[3]); pf[kk] = as_bf16x8(w);
    }
    const float cf = ex2((float)(ii + 1) * lgf), cb = ex2((float)(128 - ii) * lgb);
    f32x4 O[8]; float s = 0.f, ss = 0.f;
#pragma unroll
    for (int et = 0; et < 8; ++et) {
        f32x4 acc = (f32x4){0.f, 0.f, 0.f, 0.f}, xf = (f32x4){0.f, 0.f, 0.f, 0.f}, xb = (f32x4){0.f, 0.f, 0.f, 0.f};
#pragma unroll
        for (int kk = 0; kk < 4; ++kk) { const u32x2 v0 = *(const LAS u32x2*)(vT + (16 * et + c) * 272 + (32 * kk + 4 * g4) * 2), v1 = *(const LAS u32x2*)(vT + (16 * et + c) * 272 + (32 * kk + 16 + 4 * g4) * 2);
            u32x4 vv; vv.x = v0.x; vv.y = v0.y; vv.z = v1.x; vv.w = v1.y; acc = mfma16(as_bf16x8(vv), pf[kk], acc); }
#pragma unroll
        for (int ks = 0; ks < 2; ++ks) { xf = mfma16(*(const LAS bf16x8*)(Sl + (16 * et + c) * 272 + (32 * ks + 8 * g4) * 2), qf[ks], xf);
            xb = mfma16(*(const LAS bf16x8*)(Sl + (16 * et + c) * 272 + (64 + 32 * ks + 8 * g4) * 2), qf[ks], xb); }
        acc = acc + xf * cf + xb * cb; O[et] = acc;
        s += (acc[0] + acc[1]) + (acc[2] + acc[3]); ss += (acc[0] * acc[0] + acc[1] * acc[1]) + (acc[2] * acc[2] + acc[3] * acc[3]);
    }
    s = sum_x16_x32(s); ss = sum_x16_x32(ss);
    const float mean = s * (1.f / 128.f), var = fmaxf(ss * (1.f / 128.f) - mean * mean, 0.f), rstd = rsq_(var + EPS);
    const bf16* gsrc = ZA + (size_t)(r0 + ii) * NZA + C_RG + 128 * h + 4 * g4; bf16* dst = BR + (size_t)(r0 + ii) * 512 + 128 * h + 4 * g4;
#pragma unroll
    for (int et = 0; et < 8; ++et) { const u32x2 gw = *(const u32x2*)(gsrc + 16 * et); const float g0 = bflo(gw.x), g1 = bfhi(gw.x), g2 = bflo(gw.y), g3 = bfhi(gw.y);
        const float o0 = (O[et][0] - mean) * rstd * g0 * sigmoidf_(g0), o1 = (O[et][1] - mean) * rstd * g1 * sigmoidf_(g1), o2 = (O[et][2] - mean) * rstd * g2 * sigmoidf_(g2), o3 = (O[et][3] - mean) * rstd * g3 * sigmoidf_(g3);
        u32x2 w; w.x = pk2(o0, o1); w.y = pk2(o2, o3); *(u32x2*)(dst + 16 * et) = w; }
    __syncthreads();
}

__device__ __forceinline__ int wr_off(int k) { return k * 64 + (k >> 2) * 16; }
__device__ __forceinline__ void phase_norm2(KPC p, int l, LAS unsigned char* lds, int tid, int lane, int wave, int bid, int G) {
    if (l == 1 || G != 256) { convert_experts(p, l, 0, CVT_ITEMS, bid * 8 + wave, G * 8, lds, lane, wave); __syncthreads(); }
    LAS unsigned char* wrl = lds + 69632;
    for (int i = tid; i < 1024 * 4; i += 512) { const int k = i >> 2, q = i & 3; *(LAS f32x4*)(wrl + wr_off(k) + 16 * q) = *(const f32x4*)(p->w_router + (size_t)l * 16384 + k * 16 + 4 * q); }
    __syncthreads();
    const float* modv = (const float*)(p->ws + WS_MODV) + l * 9 * 6144; const bf16* X = (const bf16*)(p->ws + WS_X); bf16* H = (bf16*)(p->ws + WS_H);
    float* AFF = (float*)(p->ws + WS_AFF); float* AFFC = (float*)(p->ws + WS_AFFC); int* INV = (int*)(p->ws + WS_INV);
    const int rows = (l == 0) ? M : ML, stride = G * 8;
    {
    int r = bid * 8 + wave;
    u32x2 vn[4];
#pragma unroll
    for (int j = 0; j < 4; ++j) vn[j] = (r < rows) ? *(const u32x2*)(X + (size_t)r * 1024 + 4 * lane + 256 * j) : (u32x2){0u, 0u};
    for (; r < rows; r += stride) {
        const int bi = (r < ML) ? (r >> 12) : 8; const float* mv = modv + bi * 6144;
        f32x4 v[4], h[4], g[4], sc[4], sh[4];
#pragma unroll
        for (int j = 0; j < 4; ++j) { v[j] = (f32x4){bflo(vn[j].x), bfhi(vn[j].x), bflo(vn[j].y), bfhi(vn[j].y)}; const int col = 4 * lane + 256 * j; g[j] = *(const f32x4*)(p->norm2_g + l * 1024 + col); sh[j] = *(const f32x4*)(mv + 3 * 1024 + col); sc[j] = *(const f32x4*)(mv + 4 * 1024 + col); }
        const int rn = r + stride;
        if (rn < rows) {
#pragma unroll
            for (int j = 0; j < 4; ++j) vn[j] = *(const u32x2*)(X + (size_t)rn * 1024 + 4 * lane + 256 * j); }
        const float rs = row_rs(v);
#pragma unroll
        for (int j = 0; j < 4; ++j) h[j] = (v[j] * rs) * g[j] * (sc[j] + 1.0f) + sh[j];
        store_h(h, H + (size_t)r * 1024, lane);
        float lg[16];
#pragma unroll
        for (int e = 0; e < 16; ++e) lg[e] = 0.f;
#pragma unroll
        for (int j = 0; j < 4; ++j)
#pragma unroll
            for (int i = 0; i < 4; ++i) { const int k = 4 * lane + 256 * j + i; const float hv = h[j][i]; const LAS f32x4* wp = (const LAS f32x4*)(wrl + wr_off(k));
#pragma unroll
                for (int q = 0; q < 4; ++q) { const f32x4 w = wp[q]; lg[4 * q] += hv * w.x; lg[4 * q + 1] += hv * w.y; lg[4 * q + 2] += hv * w.z; lg[4 * q + 3] += hv * w.w; } }
        float mx = -1e30f;
#pragma unroll
        for (int e = 0; e < 16; ++e) { lg[e] = wave_sum(lg[e]); mx = fmaxf(mx, lg[e]); }
        float sum = 0.f;
#pragma unroll
        for (int e = 0; e < 16; ++e) { lg[e] = ex2((lg[e] - mx) * LOG2E); sum += lg[e]; }
        const float isum = rcp_(sum); float mine = 0.f;
#pragma unroll
        for (int e = 0; e < 16; ++e) mine = (lane == e) ? lg[e] * isum : mine;
        if (lane < 16) { if (r < ML) AFF[((size_t)(bi * 16 + lane) << 12) + (r & 4095)] = mine; else AFFC[((r - ML) >> 8) * 4096 + lane * 256 + ((r - ML) & 255)] = mine;
            INV[(size_t)r * 16 + lane] = -1; }
    }
    }
}

__device__ __forceinline__ int block_sum_i(int v, LAS int* red, int buf, int lane, int wave) {
    v = wave_sum_i(v);
    if (lane == 0) red[buf * 8 + wave] = v;
    __syncthreads();
    int s = 0;
#pragma unroll
    for (int w = 0; w < 8; ++w) s += red[buf * 8 + w];
    return s;
}
__device__ __forceinline__ int block_excl_scan(int v, LAS int* red, int buf, int lane, int wave) {
    int inc = v;
#pragma unroll
    for (int o = 1; o < 64; o <<= 1) { const int t = __builtin_amdgcn_ds_bpermute((lane - o) << 2, inc); if (lane >= o) inc += t; }
    if (lane == 63) red[buf * 8 + wave] = inc;
    __syncthreads();
    int base = 0;
#pragma unroll
    for (int w = 0; w < 8; ++w) { const int x = red[buf * 8 + w]; if (w < wave) base += x; }
    return base + inc - v;
}
template <int KPT>
__device__ __forceinline__ void topk_item(KPC p, const float* aff, int n, int cap, int rowbase, int e, int slotbase, int s_lo, int s_hi, bool writer, LAS unsigned char* lds, int tid, int lane, int wave) {
    const bf16* H = (const bf16*)(p->ws + WS_H); bf16* XS = (bf16*)(p->ws + WS_XS); float* topw = (float*)(p->ws + WS_TOPW); int* INV = (int*)(p->ws + WS_INV);
    LAS int* red = (LAS int*)lds; LAS int* rl = (LAS int*)(lds + 128);
    unsigned key[KPT]; const bool valid = tid * KPT < n;
#pragma unroll
    for (int j = 0; j < KPT; ++j) key[j] = valid ? __float_as_uint(aff[tid * KPT + j]) : 0u;
    unsigned Tsel = 0u;
    for (int bit = 30; bit >= 0; --bit) { const unsigned cand = Tsel | (1u << bit); int cnt = 0;
#pragma unroll
        for (int j = 0; j < KPT; ++j) cnt += (valid && key[j] >= cand) ? 1 : 0;
        if (block_sum_i(cnt, red, bit & 1, lane, wave) >= cap) Tsel = cand; }
    int cgt = 0, ceq = 0;
#pragma unroll
    for (int j = 0; j < KPT; ++j) { cgt += (valid && key[j] > Tsel) ? 1 : 0; ceq += (valid && key[j] == Tsel) ? 1 : 0; }
    const int need = cap - block_sum_i(cgt, red, 1, lane, wave);
    int er = block_excl_scan(ceq, red, 2, lane, wave);
    bool sel[KPT]; int nsel = 0;
#pragma unroll
    for (int j = 0; j < KPT; ++j) { const bool iseq = valid && key[j] == Tsel; sel[j] = valid && (key[j] > Tsel || (iseq && er < need)); er += iseq ? 1 : 0; nsel += sel[j] ? 1 : 0; }
    int slot = block_excl_scan(nsel, red, 3, lane, wave);
#pragma unroll
    for (int j = 0; j < KPT; ++j) if (sel[j]) { const int t = tid * KPT + j; if (slot < cap) { rl[slot] = t; if (writer) { topw[e * ME + slotbase + slot] = __uint_as_float(key[j]); INV[(size_t)(rowbase + t) * 16 + e] = slotbase + slot; } } ++slot; }
    __syncthreads();
    for (int s = s_lo + wave * 4; s < s_hi; s += 32) {
        u32x4 a[4][2];
#pragma unroll
        for (int q = 0; q < 4; ++q) { const int t = rl[s + q]; const u32x4* src = (const u32x4*)(H + (size_t)(rowbase + t) * 1024); a[q][0] = src[lane]; a[q][1] = src[lane + 64]; }
#pragma unroll
        for (int q = 0; q < 4; ++q) { u32x4* dst = (u32x4*)(XS + ((size_t)e * ME + slotbase + s + q) * 1024); dst[lane] = a[q][0]; dst[lane + 64] = a[q][1]; }
    }
    __syncthreads();
}
__device__ __forceinline__ void phase_topk(KPC p, int l, LAS unsigned char* lds, int tid, int lane, int wave, int bid, int G) {
    const float* AFF = (const float*)(p->ws + WS_AFF); const float* AFFC = (const float*)(p->ws + WS_AFFC);
    const int nitem = (l == 0) ? 384 : 256;
    for (int it = bid; it < nitem; it += G) {
        if (it < 256) { const int q = it >> 1, hf = it & 1, b = q >> 4, e = q & 15; topk_item<8>(p, AFF + ((size_t)(b * 16 + e) << 12), 4096, CAPL, b * T, e, b * CAPL, hf * 256, hf * 256 + 256, hf == 0, lds, tid, lane, wave); }
        else { const int q = it - 256, b = q >> 4, e = q & 15; topk_item<1>(p, AFFC + (b * 16 + e) * 256, 256, CAPC, ML + b * CL, e, NB * CAPL + b * CAPC, 0, CAPC, true, lds, tid, lane, wave); }
    }
}

__device__ __forceinline__ void phase_combine(KPC p, int l, LAS unsigned char* lds, int tid, int lane, int wave, int bid, int G) {
    const float* modv = (const float*)(p->ws + WS_MODV); bf16* X = (bf16*)(p->ws + WS_X); bf16* H = (bf16*)(p->ws + WS_H);
    const bf16* Y = (const bf16*)(p->ws + WS_XS); const int* INV = (const int*)(p->ws + WS_INV);
    const int rows = (l == 0) ? M : ML, stride = G * 8;
    int r = bid * 8 + wave;
    int slot_next = (lane < 16 && r < rows) ? INV[(size_t)r * 16 + lane] : -1;
    u32x2 vn[4];
#pragma unroll
    for (int j = 0; j < 4; ++j) vn[j] = (r < rows) ? *(const u32x2*)(X + (size_t)r * 1024 + 4 * lane + 256 * j) : (u32x2){0u, 0u};
    for (; r < rows; r += stride) {
        const int bi = (r < ML) ? (r >> 12) : 8;
        const int myslot = slot_next; const int rn = r + stride;
        slot_next = (lane < 16 && rn < rows) ? INV[(size_t)rn * 16 + lane] : -1;
        f32x4 v[4], acc[4], g2v[4];
        const float* g2 = modv + (l * 9 + bi) * 6144 + 5 * 1024;
#pragma unroll
        for (int j = 0; j < 4; ++j) { v[j] = (f32x4){bflo(vn[j].x), bfhi(vn[j].x), bflo(vn[j].y), bfhi(vn[j].y)}; acc[j] = (f32x4){0.f, 0.f, 0.f, 0.f}; g2v[j] = *(const f32x4*)(g2 + 4 * lane + 256 * j); }
        unsigned mask = (unsigned)(__builtin_amdgcn_ballot_w64(myslot >= 0) & 0xffffull);
        bool first = true;
        while (mask || first) {
          if (mask) {
            const int e0 = __builtin_ctz(mask); mask &= mask - 1u; const int s0 = __builtin_amdgcn_readlane(myslot, e0);
            const bool has1 = mask != 0u; const int e1 = has1 ? __builtin_ctz(mask) : e0; if (has1) mask &= mask - 1u; const int s1 = __builtin_amdgcn_readlane(myslot, e1);
            const bf16* ya = Y + ((size_t)e0 * ME + s0) * 1024; const bf16* yb = Y + ((size_t)e1 * ME + s1) * 1024;
            u32x2 wa[4], wb[4];
#pragma unroll
            for (int j = 0; j < 4; ++j) wa[j] = *(const u32x2*)(ya + 4 * lane + 256 * j);
#pragma unroll
            for (int j = 0; j < 4; ++j) wb[j] = *(const u32x2*)(yb + 4 * lane + 256 * j);
            if (first && rn < rows) {
#pragma unroll
                for (int j = 0; j < 4; ++j) vn[j] = *(const u32x2*)(X + (size_t)rn * 1024 + 4 * lane + 256 * j); }
            first = false;
            const float kb = has1 ? 1.0f : 0.0f;
#pragma unroll
            for (int j = 0; j < 4; ++j) { acc[j] += (f32x4){bflo(wa[j].x), bfhi(wa[j].x), bflo(wa[j].y), bfhi(wa[j].y)}; acc[j] += (f32x4){bflo(wb[j].x), bfhi(wb[j].x), bflo(wb[j].y), bfhi(wb[j].y)} * kb; }
          } else {
            if (rn < rows) {
#pragma unroll
                for (int j = 0; j < 4; ++j) vn[j] = *(const u32x2*)(X + (size_t)rn * 1024 + 4 * lane + 256 * j); }
            first = false;
          }
        }
#pragma unroll
        for (int j = 0; j < 4; ++j) v[j] = v[j] + g2v[j] * acc[j];
        if (l == 0) {
#pragma unroll
            for (int j = 0; j < 4; ++j) { u32x2 w; w.x = pk2(v[j].x, v[j].y); w.y = pk2(v[j].z, v[j].w); *(u32x2*)(X + (size_t)r * 1024 + 4 * lane + 256 * j) = w; }
            const float rs = row_rs(v); f32x4 h[4];
            norm_mod(v, rs, p->norm1_g + 1024, modv + (9 + bi) * 6144, modv + (9 + bi) * 6144 + 1024, h, lane);
            store_h(h, H + (size_t)r * 1024, lane);
        } else {
#pragma unroll
            for (int j = 0; j < 4; ++j) *(f32x4*)(p->out + (size_t)r * 1024 + 4 * lane + 256 * j) = v[j];
        }
    }
    if (l == 0) convert_small(p, 1, lds, lane, wave, bid, G);
}

#define XB_TMO      128
#define XB_XCNT(j)  (256  + 64 * (j))
#define XB_XSUB(j)  (1280 + 64 * (j))
#define XB_XGEN(j)  (2304 + 64 * (j))
#define XB_TOP      3328
#define XB_TOPGEN   3392
#define XCD_BAR_WORDS 3456
#define XB_SPIN_CAP (1u << 18)

__device__ __forceinline__ unsigned xb_ld(unsigned* p)              { return __hip_atomic_load(p, __ATOMIC_RELAXED, __HIP_MEMORY_SCOPE_AGENT); }
__device__ __forceinline__ unsigned xb_add(unsigned* p, unsigned v) { return __hip_atomic_fetch_add(p, v, __ATOMIC_RELAXED, __HIP_MEMORY_SCOPE_AGENT); }
__device__ __forceinline__ unsigned xb_xcc_id() { return (unsigned)__builtin_amdgcn_s_getreg((3 << 11) | 20) & 0xFu; }
#define XB_SPIN(cond, bar) do { unsigned _sp = 0; while (cond) { __builtin_amdgcn_s_sleep(1); \
    if ((++_sp & 255u) == 0u) { if (xb_ld(&(bar)[XB_TMO])) break; if (_sp > XB_SPIN_CAP) { atomicAdd(&(bar)[XB_TMO], 1u); break; } } } } while (0)

struct XcdBarrier {
    unsigned* bar; unsigned x;
    volatile LAS unsigned* st;
};

__device__ __forceinline__ XcdBarrier xcd_barrier_post(unsigned* bar, volatile LAS unsigned* st) {
    XcdBarrier b; b.bar = bar; b.x = xb_xcc_id(); b.st = st;
    if (threadIdx.x == 0) (void)xb_add(&bar[XB_XCNT(b.x)], 1u);
    return b;
}
__device__ __forceinline__ void xcd_barrier_complete(unsigned* bar, unsigned x, unsigned& nloc, unsigned& nx) {
    const unsigned G = gridDim.x * gridDim.y * gridDim.z;
    unsigned sum, cnt, mine, sp = 0u;
    for (;;) {
        sum = 0u; cnt = 0u; mine = 0u;
#pragma unroll
        for (unsigned j = 0; j < 16; ++j) { const unsigned c = xb_ld(&bar[XB_XCNT(j)]); sum += c; cnt += (c > 0u) ? 1u : 0u; mine = (j == x) ? c : mine; }
        if (sum == G) break;
        __builtin_amdgcn_s_sleep(1);
        if ((++sp & 255u) == 0u) { if (xb_ld(&bar[XB_TMO])) break; if (sp > XB_SPIN_CAP) { atomicAdd(&bar[XB_TMO], 1u); break; } }
    }
    nloc = mine > 0u ? mine : 1u; nx = cnt > 0u ? cnt : 1u;
}

__device__ __forceinline__ void xcd_barrier(const XcdBarrier& b) {
    asm volatile("s_waitcnt vmcnt(0)" ::: "memory");
    __syncthreads();
    if (threadIdx.x == 0) {
        unsigned* bar = b.bar;
        __builtin_amdgcn_s_waitcnt(0);
        unsigned nloc = b.st[0], nx = b.st[1];
        if (nloc == 0u) { xcd_barrier_complete(bar, b.x, nloc, nx); b.st[0] = nloc; b.st[1] = nx; }
        const unsigned old = xb_add(&bar[XB_XSUB(b.x)], 1u);
        const unsigned gen = old / nloc;
        if (old + 1u == (gen + 1u) * nloc) {
            __builtin_amdgcn_fence(__ATOMIC_RELEASE, "agent");
            asm volatile("s_waitcnt vmcnt(0)" ::: "memory");
            const unsigned og = xb_add(&bar[XB_TOP], 1u);
            const unsigned tg = og / nx;
            if (og + 1u == (tg + 1u) * nx) xb_add(&bar[XB_TOPGEN], 1u);
            else XB_SPIN(xb_ld(&bar[XB_TOPGEN]) == tg, bar);
            __builtin_amdgcn_fence(__ATOMIC_ACQUIRE, "agent");
            xb_add(&bar[XB_XGEN(b.x)], 1u);
            asm volatile("s_waitcnt vmcnt(0)" ::: "memory");
        } else {
            XB_SPIN(xb_ld(&bar[XB_XGEN(b.x)]) == gen, bar);
            __builtin_amdgcn_fence(__ATOMIC_ACQUIRE, "agent");
            asm volatile("s_waitcnt vmcnt(0)" ::: "memory");
        }
    }
    __syncthreads();
}

#define KPP() ({ KPC q_ = kp_; asm volatile("" : "+s"(q_)); q_; })
__global__ void __launch_bounds__(512, 2) mk_fwd(KP p_unused) {
    extern __shared__ __attribute__((aligned(16))) unsigned char lds_raw[];
    LAS unsigned char* lds = (LAS unsigned char*)lds_raw;
    cg::grid_group grid = cg::this_grid();
    const int bid = blockIdx.x, G = gridDim.x;
#define IDS() int tid = threadIdx.x; asm volatile("" : "+v"(tid)); const int lane = tid & 63, wave = __builtin_amdgcn_readfirstlane(tid >> 6); (void)lane; (void)wave
    const KPC kp_ = (KPC)__builtin_amdgcn_kernarg_segment_ptr();
    volatile LAS unsigned* bst = (volatile LAS unsigned*)(lds + 147392);
    if (threadIdx.x < 16) bst[threadIdx.x] = 0u;
    __syncthreads();
    (void)xcd_barrier_post((unsigned*)KPP()->ws, bst);
#define GSYNC() do { XcdBarrier b_; b_.bar = (unsigned*)KPP()->ws; b_.x = xb_xcc_id(); b_.st = bst; xcd_barrier(b_); } while (0)

    { IDS(); phase_prep(KPP(), lds, tid, lane, wave, bid, G); }
    if (G == 0x7fffffff) grid.sync();
    GSYNC();
    { IDS(); phase_norm_in(KPP(), lane, wave, bid, G); }
    GSYNC();
#pragma unroll 1
    for (int l = 0; l < 2; ++l) {
        {
            unsigned char* ws = KPP()->ws;
            pg8::Gemm g{(const pg8::bf16_t*)(ws + WS_H), (const pg8::bf16_t*)(ws + WS_WTIN), M, NZA, 1024}; GroupOrder S{1, M / 256, NZA / 256, 0, 0, G, bid};
            EpiZA E{(bf16*)(ws + WS_ZA)};
            pg8::gemm_phase<EpiZA, GroupOrder, true, true>(lds, g, S, E);
        }
        GSYNC();
        {
            KPC p = KPP(); IDS();
            float mq = fabsf(p->qn_g[l * 64 + lane]), mk = fabsf(p->kn_g[l * 64 + lane]);
            mq = wave_max(mq); mk = wave_max(mk);
            const float Mb2 = 8.0f * mq * mk * LOG2E;
            const int natt = (l == 0) ? 544 : 512, nupd = NB * NCH * 4, nvp = (l == 0) ? (M / 128) : (ML / 128);
            for (int it = bid; it < natt + nupd + nvp; it += G) {
                if (it < natt) { att_item(p, l, lds, it, Mb2, tid, lane, wave); }
                else if (it < natt + nupd) { ret_upd_item(p, l, lds, it - natt, tid, lane, wave); }
                else { sgu_vprep_item(p, it - natt - nupd, tid); }
            }
        }
        GSYNC();
        { IDS(); phase_scan(KPP(), l, tid, bid, G); }
        GSYNC();
        {   KPC p = KPP(); IDS(); const int nch = (l == 0) ? NCH : 32;
            const int nro = NB * nch * 4, nsgu = ((l == 0) ? (M / 128) : (ML / 128)) * 4;
            for (int it = bid; it < nro + nsgu; it += G) {
                if (it < nro) { const int b = it / (nch * 4), rem = it % (nch * 4); ret_out_item(p, l, lds, b * (NCH * 4) + rem, tid, lane, wave); }
                else sgu_item(p, l, lds, it - nro, tid, lane, wave);
            }
        }
        GSYNC();
        const int Mrows = (l == 0) ? M : ML;
        {
            unsigned char* ws = KPP()->ws;
            pg8::Gemm g{(const pg8::bf16_t*)(ws + WS_H), (const pg8::bf16_t*)(ws + WS_WTIN) + (size_t)NZA * 1024, Mrows, NZG, 1024}; GroupOrder S{1, Mrows / 256, NZG / 256, 0, 0, G, bid};
            EpiSig E{(bf16*)(ws + WS_G)};
            pg8::gemm_phase<EpiSig, GroupOrder, true, true>(lds, g, S, E);
            if (l == 0 && G == 256 && bid >= CVT_G_IDLE0) { IDS(); convert_experts(KPP(), 0, 0, CVT_G_HI, (bid - CVT_G_IDLE0) * 8 + wave, (256 - CVT_G_IDLE0) * 8, lds, lane, wave); }
        }
        GSYNC();
        {
            KPC p = KPP(); unsigned char* ws = p->ws;
            pg8::Gemm g{(const pg8::bf16_t*)p->out, (const pg8::bf16_t*)(ws + WS_WTBR), 3 * M, 3072, 512}; MergeOrder S{Mrows / 256, G, bid};
            EpiMergeChain E{(const bf16*)(ws + WS_G), (bf16*)(ws + WS_H)};
            pg8::gemm_phase<EpiMergeChain, MergeOrder, true, true>(lds, g, S, E);
            if (l == 0 && G == 256 && bid >= CVT_M_IDLE0) { IDS(); convert_experts(KPP(), 0, CVT_G_HI, CVT_M_HI, (bid - CVT_M_IDLE0) * 8 + wave, (256 - CVT_M_IDLE0) * 8, lds, lane, wave); }
        }
        GSYNC();
        {
            KPC p = KPP(); unsigned char* ws = p->ws;
            pg8::Gemm g{(const pg8::bf16_t*)(ws + WS_H), (const pg8::bf16_t*)(ws + WS_WTOUT), Mrows, 1024, 1024}; GroupOrder S{1, Mrows / 256, 4, 0, 0, G, bid};
            EpiOut E{p->x, p->ctx, (bf16*)(ws + WS_X), (const float*)(ws + WS_MODV) + l * 9 * 6144, (l == 0) ? 1 : 0};
            pg8::gemm_phase<EpiOut, GroupOrder, true, true>(lds, g, S, E);
            if (l == 0 && G == 256 && bid >= CVT_O_IDLE0) { IDS(); convert_experts(KPP(), 0, CVT_M_HI, CVT_ITEMS, (bid - CVT_O_IDLE0) * 8 + wave, (256 - CVT_O_IDLE0) * 8, lds, lane, wave); }
        }
        GSYNC();
        { IDS(); phase_norm2(KPP(), l, lds, tid, lane, wave, bid, G); }
        GSYNC();
        { IDS(); phase_topk(KPP(), l, lds, tid, lane, wave, bid, G); }
        GSYNC();
        {
            unsigned char* ws = KPP()->ws;
            pg8::Gemm g{(const pg8::bf16_t*)(ws + WS_XS), (const pg8::bf16_t*)(ws + WS_WT1), NE * ME, NE * 2048, 1024}; GroupOrder S{NE, (l == 0) ? 17 : 16, 8, 17, 8, G, bid};
            EpiMoe1 E{(bf16*)(ws + WS_ACT)};
            pg8::gemm_phase<EpiMoe1, GroupOrder, true, true>(lds, g, S, E);
        }
        GSYNC();
        {
            unsigned char* ws = KPP()->ws;
            pg8::Gemm g{(const pg8::bf16_t*)(ws + WS_ACT), (const pg8::bf16_t*)(ws + WS_WT2), NE * ME, NE * 1024, 1024}; GroupOrder S{NE, (l == 0) ? 17 : 16, 4, 17, 4, G, bid};
            EpiMoe2 E{(bf16*)(ws + WS_XS), (const float*)(ws + WS_TOPW)};
            pg8::gemm_phase<EpiMoe2, GroupOrder, true, true>(lds, g, S, E);
        }
        GSYNC();
        { IDS(); phase_combine(KPP(), l, lds, tid, lane, wave, bid, G); }
        if (l == 0) GSYNC();
    }
}

extern "C" void kernel_launch(void* const* d_in, const int* in_sizes, int n_in, void* d_out, int out_size, void* d_ws, size_t ws_size, hipStream_t stream) {
    static int grid = 0;
    if (grid == 0) {
        if (n_in != 22 || out_size != ML * D || ws_size < WS_END) { fprintf(stderr, "kernel_launch: unexpected shapes (n_in %d out %d ws %zu, need %zu)\n", n_in, out_size, ws_size, (size_t)WS_END); grid = -1; return; }
        int dev = 0, cus = 0, per_cu = 0;
        if (hipGetDevice(&dev) != hipSuccess || hipDeviceGetAttribute(&cus, hipDeviceAttributeMultiprocessorCount, dev) != hipSuccess) { grid = -1; return; }
        if (hipFuncSetAttribute((const void*)mk_fwd, hipFuncAttributeMaxDynamicSharedMemorySize, LDS_BYTES) != hipSuccess) { fprintf(stderr, "kernel_launch: hipFuncSetAttribute failed\n"); grid = -1; return; }
        if (hipOccupancyMaxActiveBlocksPerMultiprocessor(&per_cu, (const void*)mk_fwd, 512, LDS_BYTES) != hipSuccess || per_cu < 1) { fprintf(stderr, "kernel_launch: occupancy query says %d\n", per_cu); (void)hipGetLastError(); }
        grid = cus;
        fprintf(stderr, "kernel_launch: grid %d, occupancy %d/CU, ws %zu\n", grid, per_cu, ws_size);
    }
    if (grid < 0) return;
    if (hipMemsetAsync(d_ws, 0, 16384, stream) != hipSuccess) { fprintf(stderr, "kernel_launch: memset failed\n"); return; }
    KP hp{};
    const float** f = (const float**)&hp;
    for (int i = 0; i < 22; ++i) f[i] = (const float*)d_in[i];
    hp.out = (float*)d_out; hp.ws = (unsigned char*)d_ws;
    void* args[] = {&hp};
    hipError_t e = hipLaunchCooperativeKernel((const void*)mk_fwd, dim3(grid), dim3(512), args, LDS_BYTES, stream);
    if (e != hipSuccess) fprintf(stderr, "kernel_launch: cooperative launch failed: %s\n", hipGetErrorString(e));
}
```

```cpp
#include <hip/hip_runtime.h>
#include <hip/hip_cooperative_groups.h>
#include <cstdio>
#include <cstdint>
namespace cg = cooperative_groups;
namespace pg8 {
#define PG8_LAS __attribute__((address_space(3)))
typedef unsigned short bf16_t;
typedef short bf16x8 __attribute__((ext_vector_type(8)));
typedef float f32x4 __attribute__((ext_vector_type(4)));
typedef unsigned u32x4 __attribute__((ext_vector_type(4)));
constexpr int BM = 256, BK = 64, HALF = 128, HTB = HALF * BK * 2  , STAGE_BYTES = 8 * HTB, NXCD = 8, WGM = 8;

__host__ __device__ __forceinline__ int lds_byte(int r, int c) { const int st = (r >> 4) * 2 + (c >> 5), rr = r & 15, cc = c & 31, ob = rr * 64 + cc * 2; return st * 1024 + (ob ^ (((ob >> 9) & 1) << 5)); }
__host__ __device__ __forceinline__ void stage_rc(int b, int& R, int& C) { const int st = b / 1024, sb = b % 1024, swz = sb ^ (((sb >> 9) & 1) << 5); R = (st >> 1) * 16 + swz / 64; C = (st & 1) * 32 + (swz % 64) / 2; }
__host__ __device__ __forceinline__ int perm32(int rho) { const int n = rho >> 4, i = rho & 15; return 8 * (i >> 2) + 4 * n + (i & 3); }

struct Unit { int pm, pn; };
struct Gemm { const bf16_t* A; const bf16_t* Bt; int M, N, K; };

struct StaticOrder {
    int nM, nN, nwg, G, c;
    __host__ __device__ void init(int M, int N, int G_, int c_) { nM = M / BM; nN = N / BM; nwg = nM * nN; G = G_; c = c_; }
    __host__ __device__ bool next(int i, Unit& u) const {
        const long L = (long)i * G + c; if (L >= nwg) return false;
        int wgid = (int)L; { const int q = nwg / NXCD, r = nwg % NXCD, xcd = wgid % NXCD, off = wgid / NXCD; wgid = (xcd < r ? xcd * (q + 1) : r * (q + 1) + (xcd - r) * q) + off; }
        const int nig = WGM * nN, gid = wgid / nig, fm = gid * WGM, gsz = (nM - fm) < WGM ? (nM - fm) : WGM;
        u.pm = fm + ((wgid % nig) % gsz); u.pn = (wgid % nig) / gsz; return true;
    }
    __device__ __forceinline__ void a_ready(const Unit&) const {}
    __device__ __forceinline__ void done(const Unit&) const {}
};

__device__ __forceinline__ unsigned cvt_pk_bf16(float lo, float hi) { unsigned r; asm volatile("v_cvt_pk_bf16_f32 %0, %1, %2" : "=v"(r) : "v"(lo), "v"(hi)); return r; }
typedef float f32x2 __attribute__((ext_vector_type(2)));
__device__ __forceinline__ f32x2 gelu_pk(f32x2 v) {
    const f32x2 av = __builtin_elementwise_abs(v), d = av * 0.2316418882f + 1.0f;
    f32x2 t; t.x = __builtin_amdgcn_rcpf(d.x); t.y = __builtin_amdgcn_rcpf(d.y);
    f32x2 q = t * 0.5307027145f + (-0.7265760135f); q = q * t + 0.7107068705f; q = q * t + (-0.142248368f); q = q * t + 0.127414796f; q = q * t;
    const f32x2 s = (v * v) * (-0.72134752044f);
    f32x2 e; e.x = __builtin_amdgcn_exp2f(s.x); e.y = __builtin_amdgcn_exp2f(s.y);
    const f32x2 m = v * (q * e), r = v - m;
    f32x2 o; o.x = v.x < 0.f ? m.x : r.x; o.y = v.y < 0.f ? m.y : r.y; return o;
}

template <int ACT  > struct EpiBf16 {
    static constexpr bool PERM = true, AFTER_DRAIN = false, CHAIN = false; static_assert(ACT == 0 || ACT == 1, "EpiBf16: ACT is 0 (none) or 1 (gelu_pk)");
    bf16_t* O; int ldc; const float* bias; int split_cols; size_t split_stride; float scale0;
    __device__ __forceinline__ void operator()(const f32x4 (&acc)[2][2][4][2], const Unit& u, int wr, int wc, int fr, int fq) const {
        const int row0 = u.pm * BM + wr * 64 + fr; int colt = u.pn * BM; bf16_t* base = O;
        float sc = 1.f; if (split_cols) { const int t = colt / split_cols; base += (size_t)t * split_stride; colt -= t * split_cols; if (t == 0) sc = scale0; }
        const int col0 = colt + wc * 32 + 8 * fq, bcol0 = u.pn * BM + wc * 32 + 8 * fq;
        f32x4 bv[2][2];
#pragma unroll
        for (int bj = 0; bj < 2; ++bj)
#pragma unroll
            for (int n = 0; n < 2; ++n) bv[bj][n] = bias ? *(const f32x4*)(bias + bcol0 + bj * HALF + 4 * n) : (f32x4){0.f, 0.f, 0.f, 0.f};
#pragma unroll
        for (int ai = 0; ai < 2; ++ai)
#pragma unroll
            for (int m = 0; m < 4; ++m) { bf16_t* rowp = base + (size_t)(row0 + ai * HALF + m * 16) * ldc + col0;
#pragma unroll
                for (int bj = 0; bj < 2; ++bj) { f32x4 v0 = acc[ai][bj][m][0] + bv[bj][0], v1 = acc[ai][bj][m][1] + bv[bj][1];
                    if (ACT == 1) { f32x2 a = gelu_pk((f32x2){v0[0], v0[1]}), b = gelu_pk((f32x2){v0[2], v0[3]}), c = gelu_pk((f32x2){v1[0], v1[1]}), d = gelu_pk((f32x2){v1[2], v1[3]});
                        v0 = (f32x4){a.x, a.y, b.x, b.y}; v1 = (f32x4){c.x, c.y, d.x, d.y}; }
                    v0 = v0 * sc; v1 = v1 * sc; u32x4 w; w.x = cvt_pk_bf16(v0[0], v0[1]); w.y = cvt_pk_bf16(v0[2], v0[3]); w.z = cvt_pk_bf16(v1[0], v1[1]); w.w = cvt_pk_bf16(v1[2], v1[3]);
                    *(u32x4*)(rowp + bj * HALF) = w; } }
    }
};
template <class Epi, class Sched, bool ALIGN_EPI = false, bool SP2 = false>
__device__ __forceinline__ void gemm_phase(PG8_LAS unsigned char* lds, const Gemm g, const Sched& S, const Epi& E) {
    int tid_ = threadIdx.x; asm volatile("" : "+v"(tid_));
    const int tid = tid_, wid = __builtin_amdgcn_readfirstlane(tid >> 6), lane = tid & 63, wr = wid >> 2, wc = wid & 3, fr = lane & 15, fq = lane >> 4;
    const int K = g.K, nt = K / BK;
    unsigned voffA[2], voffB[2];
#pragma unroll
    for (int i = 0; i < 2; ++i) { int R, C; stage_rc(tid * 16 + i * 8192, R, C); const int Rb = Epi::PERM ? ((R & ~31) + perm32(R & 31)) : R;
        voffA[i] = (unsigned)(R * K + C) * 2u; voffB[i] = (unsigned)(Rb * K + C) * 2u; }
    const size_t kstep = (size_t)(BK * 2);
    const size_t hstep = (size_t)HALF * K * 2;
    const size_t tstep = 2 * hstep;
    const unsigned ldsw = (unsigned)wid * 1024u;
    const int aoff = lds_byte(wr * 64 + fr, fq * 8), boff = lds_byte(wc * 32 + fr, fq * 8);
#define PG8_SA(b, h) (((b) * 2 + (h)) * HTB)
#define PG8_SB(b, h) ((4 + (b) * 2 + (h)) * HTB)
#define PG8_STAGE(bufoff, gbase, voff) do { _Pragma("unroll") for (int _i = 0; _i < 2; ++_i) \
        __builtin_amdgcn_global_load_lds((const unsigned*)((const char*)(gbase) + (voff)[_i]), (PG8_LAS unsigned*)(lds + (bufoff) + ldsw + _i * 8192), 16, 0, 0); } while (0)
#define PG8_LDA(dst, b, h) do { _Pragma("unroll") for (int m = 0; m < 4; ++m) _Pragma("unroll") for (int k = 0; k < 2; ++k) dst[m][k] = *(const PG8_LAS bf16x8*)(lds + PG8_SA(b, h) + aoff + m * 2048 + k * 1024); } while (0)
#define PG8_LDB(dst, b, h) do { _Pragma("unroll") for (int n = 0; n < 2; ++n) _Pragma("unroll") for (int k = 0; k < 2; ++k) dst[n][k] = *(const PG8_LAS bf16x8*)(lds + PG8_SB(b, h) + boff + n * 2048 + k * 1024); } while (0)
#define PG8_MMA(ai, bj, At, Bt) do { __builtin_amdgcn_s_setprio(1); _Pragma("unroll") for (int m = 0; m < 4; ++m) _Pragma("unroll") for (int n = 0; n < 2; ++n) _Pragma("unroll") for (int k = 0; k < 2; ++k) \
        acc[ai][bj][m][n] = __builtin_amdgcn_mfma_f32_16x16x32_bf16(Bt[n][k], At[m][k], acc[ai][bj][m][n], 0, 0, 0); __builtin_amdgcn_s_setprio(0); } while (0)
#define PG8_WAIT_V(n) asm volatile("s_waitcnt vmcnt(" #n ")" ::: "memory")
#define PG8_WAIT_L(n) asm volatile("s_waitcnt lgkmcnt(" #n ")" ::: "memory")
#define PG8_BAR __builtin_amdgcn_s_barrier()
#define PG8_SCHED __builtin_amdgcn_sched_barrier(0)
    Unit cur, nxt; int ui = 0;
    if (!S.next(0, cur)) return;
    f32x4 acc[2][2][4][2];
#pragma unroll
    for (int a = 0; a < 2; ++a)
#pragma unroll
        for (int b = 0; b < 2; ++b)
#pragma unroll
            for (int m = 0; m < 4; ++m)
#pragma unroll
                for (int n = 0; n < 2; ++n) acc[a][b][m][n] = (f32x4){0.f, 0.f, 0.f, 0.f};
    bf16x8 At[4][2], B0[2][2], B1[2][2];
    const char* cA = (const char*)g.A + (size_t)cur.pm * tstep; const char* cB = (const char*)g.Bt + (size_t)cur.pn * tstep;
    S.a_ready(cur);
    if constexpr (SP2) {
        PG8_STAGE(PG8_SB(0, 0), cB, voffB); PG8_STAGE(PG8_SB(0, 1), cB + hstep, voffB); PG8_STAGE(PG8_SA(0, 0), cA, voffA); PG8_STAGE(PG8_SA(0, 1), cA + hstep, voffA);
        if (wr == 1) PG8_BAR;
        PG8_WAIT_V(2); PG8_BAR;
        PG8_STAGE(PG8_SB(1, 0), cB + kstep, voffB); PG8_STAGE(PG8_SA(1, 0), cA + kstep, voffA); PG8_STAGE(PG8_SB(1, 1), cB + hstep + kstep, voffB);
        PG8_WAIT_V(6); PG8_BAR;
    } else {
        PG8_STAGE(PG8_SB(0, 0), cB, voffB); PG8_STAGE(PG8_SA(0, 0), cA, voffA); PG8_STAGE(PG8_SB(0, 1), cB + hstep, voffB); PG8_STAGE(PG8_SA(0, 1), cA + hstep, voffA);
        if (wr == 1) PG8_BAR;
        PG8_WAIT_V(4); PG8_BAR;
        PG8_STAGE(PG8_SB(1, 0), cB + kstep, voffB); PG8_STAGE(PG8_SA(1, 0), cA + kstep, voffA); PG8_STAGE(PG8_SB(1, 1), cB + hstep + kstep, voffB);
        PG8_WAIT_V(6); PG8_BAR;
    }
    for (;;) {
        const bool has_next = S.next(ui + 1, nxt);
        const char* nA = has_next ? (const char*)g.A + (size_t)nxt.pm * tstep : cA; const char* nB = has_next ? (const char*)g.Bt + (size_t)nxt.pn * tstep : cB;
        for (int t = 0; t < nt; t += 2) {
            const bool last = (t == nt - 2);
            const char* a1 = cA + (size_t)(t + 1) * kstep;
            const char* a2 = last ? nA : cA + (size_t)(t + 2) * kstep; const char* b2 = last ? nB : cB + (size_t)(t + 2) * kstep;
            const char* a3 = a2 + kstep; const char* b3 = b2 + kstep;
            if (last && has_next) S.a_ready(nxt);
            if constexpr (SP2) {
            PG8_LDB(B0, 0, 0); PG8_LDB(B1, 0, 1); PG8_SCHED; PG8_LDA(At, 0, 0); PG8_STAGE(PG8_SA(1, 1), a1 + hstep, voffA);
            PG8_WAIT_V(8); PG8_WAIT_L(0); PG8_BAR; PG8_MMA(0, 0, At, B0); PG8_MMA(0, 1, At, B1); PG8_BAR; PG8_SCHED;
            PG8_LDA(At, 0, 1); PG8_STAGE(PG8_SB(0, 0), b2, voffB); PG8_STAGE(PG8_SB(0, 1), b2 + hstep, voffB); PG8_STAGE(PG8_SA(0, 0), a2, voffA);
            PG8_WAIT_V(8); PG8_WAIT_L(0); PG8_BAR; PG8_MMA(1, 0, At, B0); PG8_MMA(1, 1, At, B1); PG8_BAR; PG8_SCHED;
            PG8_LDB(B0, 1, 0); PG8_LDB(B1, 1, 1); PG8_SCHED; PG8_LDA(At, 1, 0); PG8_STAGE(PG8_SA(0, 1), a2 + hstep, voffA);
            PG8_WAIT_V(8); PG8_WAIT_L(0); PG8_BAR; PG8_MMA(0, 0, At, B0); PG8_MMA(0, 1, At, B1); PG8_BAR; PG8_SCHED;
            PG8_LDA(At, 1, 1); PG8_STAGE(PG8_SB(1, 0), b3, voffB); PG8_STAGE(PG8_SB(1, 1), b3 + hstep, voffB); PG8_STAGE(PG8_SA(1, 0), a3, voffA);
            PG8_WAIT_V(8); PG8_WAIT_L(0); PG8_BAR; PG8_MMA(1, 0, At, B0); PG8_MMA(1, 1, At, B1); PG8_BAR; PG8_SCHED;
            } else {
            PG8_LDB(B0, 0, 0); PG8_SCHED; PG8_LDA(At, 0, 0); PG8_STAGE(PG8_SA(1, 1), a1 + hstep, voffA);
            PG8_WAIT_L(8); PG8_BAR; PG8_WAIT_L(0); PG8_MMA(0, 0, At, B0); PG8_BAR; PG8_SCHED;
            PG8_LDB(B1, 0, 1); PG8_STAGE(PG8_SB(0, 0), b2, voffB);
            PG8_BAR; PG8_WAIT_L(0); PG8_MMA(0, 1, At, B1); PG8_BAR;
            PG8_LDA(At, 0, 1); PG8_STAGE(PG8_SA(0, 0), a2, voffA);
            PG8_BAR; PG8_WAIT_L(0); PG8_MMA(1, 0, At, B0); PG8_BAR; PG8_SCHED;
            PG8_STAGE(PG8_SB(0, 1), b2 + hstep, voffB);
            PG8_WAIT_V(6); PG8_BAR; PG8_MMA(1, 1, At, B1); PG8_BAR;
            PG8_LDB(B0, 1, 0); PG8_SCHED; PG8_LDA(At, 1, 0); PG8_STAGE(PG8_SA(0, 1), a2 + hstep, voffA);
            PG8_WAIT_L(8); PG8_BAR; PG8_WAIT_L(0); PG8_MMA(0, 0, At, B0); PG8_BAR; PG8_SCHED;
            PG8_LDB(B1, 1, 1); PG8_STAGE(PG8_SB(1, 0), b3, voffB);
            PG8_BAR; PG8_WAIT_L(0); PG8_MMA(0, 1, At, B1); PG8_BAR;
            PG8_LDA(At, 1, 1); PG8_STAGE(PG8_SA(1, 0), a3, voffA);
            PG8_BAR; PG8_WAIT_L(0); PG8_MMA(1, 0, At, B0); PG8_BAR; PG8_SCHED;
            PG8_STAGE(PG8_SB(1, 1), b3 + hstep, voffB);
            PG8_WAIT_V(6); PG8_BAR; PG8_MMA(1, 1, At, B1); PG8_BAR;
            }
        }
        if constexpr (ALIGN_EPI) { if (wr == 0) PG8_BAR; }
        bool keep_acc = false;
        if constexpr (Epi::CHAIN) { keep_acc = E.chain(acc, cur, wr, wc, fr, fq); S.done(cur); }
        else if constexpr (!Epi::AFTER_DRAIN) { E(acc, cur, wr, wc, fr, fq); S.done(cur); }
        if (!has_next) break;
        if (!keep_acc) {
#pragma unroll
        for (int a = 0; a < 2; ++a)
#pragma unroll
            for (int b = 0; b < 2; ++b)
#pragma unroll
                for (int m = 0; m < 4; ++m)
#pragma unroll
                    for (int n = 0; n < 2; ++n) acc[a][b][m][n] = (f32x4){0.f, 0.f, 0.f, 0.f};
        }
        cur = nxt; cA = nA; cB = nB; ++ui;
        if constexpr (ALIGN_EPI) { if (wr == 1) PG8_BAR; }
    }
    PG8_WAIT_V(0);
    if constexpr (!ALIGN_EPI) { if (wr == 0) PG8_BAR; }
    PG8_BAR;
    if constexpr (Epi::AFTER_DRAIN) { E.fused(acc, cur, wr, wc, fr, fq, lds, wid, lane); S.done(cur); }
#undef PG8_SA
#undef PG8_SB
#undef PG8_STAGE
#undef PG8_LDA
#undef PG8_LDB
#undef PG8_MMA
#undef PG8_WAIT_V
#undef PG8_WAIT_L
#undef PG8_BAR
#undef PG8_SCHED
}
}

#define LAS __attribute__((address_space(3)))
typedef unsigned short bf16;
typedef short bf16x8 __attribute__((ext_vector_type(8)));
typedef float f32x4 __attribute__((ext_vector_type(4)));
typedef unsigned u32x4 __attribute__((ext_vector_type(4)));
typedef unsigned u32x2 __attribute__((ext_vector_type(2)));

constexpr int D = 1024, NB = 8, T = 4096, CL = 256;
constexpr int ML = NB * T, MC = NB * CL, M = ML + MC;
constexpr int NZA = 3328, NZG = 3072;
constexpr int C_RQ = 0, C_RK = 256, C_RV = 512, C_RG = 1024, C_SU = 1536, C_SV = 2048, C_AQ = 2560, C_AK = 3072, C_AV = 3200;
constexpr int NE = 16, CAPL = 512, CAPC = 32, ME = NB * (CAPL + CAPC);
constexpr int NCH = 34;
constexpr float EPS = 1e-6f, LOG2E = 1.4426950408889634f;
constexpr int LDS_BYTES = 147456;

constexpr size_t MiB = 1u << 20;
constexpr size_t WS_LG = 15360;
constexpr size_t WS_ROPEC = 1 * MiB, WS_ROPES = 1 * MiB + 512 * 1024, WS_MODV = 2 * MiB, WS_AFF = 3 * MiB, WS_AFFC = 5 * MiB, WS_INV = 6 * MiB, WS_TOPW = 9 * MiB;
constexpr size_t WS_WTIN = 16 * MiB, WS_WTBR = WS_WTIN + (size_t)6400 * 1024 * 2, WS_WTOUT = WS_WTBR + (size_t)3072 * 512 * 2;
constexpr size_t WS_X = 34 * MiB, WS_H = 170 * MiB, WS_R = 238 * MiB;
constexpr size_t WS_ZA = WS_R, WS_G = WS_R, WS_RS = 459 * MiB, WS_ST = 527 * MiB;
constexpr size_t WS_XS = WS_R, WS_ACT = 374 * MiB, WS_WT1 = 510 * MiB, WS_WT2 = 574 * MiB, WS_END = 606 * MiB;
static_assert(WS_WTOUT + 2 * MiB <= WS_X && WS_ZA + (size_t)M * NZA * 2 <= WS_RS && WS_ST + (size_t)NB * 4 * NCH * 128 * 128 * 2 <= WS_END, "ws map");

struct KP {
    const float *x, *c, *ctx, *c_ctx, *w_mod, *b_mod, *norm1_g, *norm2_g, *w_in, *dec_f, *dec_b, *sgu_w, *sgu_b, *qn_g, *kn_g, *sink, *w_branch, *w_out, *w_router, *w_eg, *w_eu, *w_ed;
    float* out; unsigned char* ws;
};
typedef const __attribute__((address_space(4))) KP* KPC;

#define LDS_WAIT() asm volatile("s_waitcnt lgkmcnt(0)" ::: "memory")
__device__ __forceinline__ unsigned pk2(float lo, float hi) { return pg8::cvt_pk_bf16(lo, hi); }
__device__ __forceinline__ float bflo(unsigned w) { return __uint_as_float(w << 16); }
__device__ __forceinline__ float bfhi(unsigned w) { return __uint_as_float(w & 0xffff0000u); }
__device__ __forceinline__ void unpack8(const u32x4 w, float (&f)[8]) { f[0] = bflo(w.x); f[1] = bfhi(w.x); f[2] = bflo(w.y); f[3] = bfhi(w.y); f[4] = bflo(w.z); f[5] = bfhi(w.z); f[6] = bflo(w.w); f[7] = bfhi(w.w); }
__device__ __forceinline__ u32x4 pack8(const float (&f)[8]) { u32x4 o; o.x = pk2(f[0], f[1]); o.y = pk2(f[2], f[3]); o.z = pk2(f[4], f[5]); o.w = pk2(f[6], f[7]); return o; }
template <int CTRL> __device__ __forceinline__ float dpp_f(float v) { return __builtin_bit_cast(float, __builtin_amdgcn_update_dpp(0, __builtin_bit_cast(int, v), CTRL, 0xf, 0xf, false)); }
template <int CTRL> __device__ __forceinline__ int dpp_i(int v) { return __builtin_amdgcn_update_dpp(0, v, CTRL, 0xf, 0xf, false); }
constexpr int DPP_XOR1 = 0xB1  , DPP_XOR2 = 0x4E  , DPP_HMIRROR = 0x141  , DPP_MIRROR = 0x140  ;
__device__ __forceinline__ float sum_x16(float v) { const unsigned u = __builtin_bit_cast(unsigned, v); auto r = __builtin_amdgcn_permlane16_swap(u, u, false, false); return __builtin_bit_cast(float, (unsigned)r[0]) + __builtin_bit_cast(float, (unsigned)r[1]); }
__device__ __forceinline__ float sum_x32(float v) { const unsigned u = __builtin_bit_cast(unsigned, v); auto r = __builtin_amdgcn_permlane32_swap(u, u, false, false); return __builtin_bit_cast(float, (unsigned)r[0]) + __builtin_bit_cast(float, (unsigned)r[1]); }
__device__ __forceinline__ float max_x16(float v) { const unsigned u = __builtin_bit_cast(unsigned, v); auto r = __builtin_amdgcn_permlane16_swap(u, u, false, false); return fmaxf(__builtin_bit_cast(float, (unsigned)r[0]), __builtin_bit_cast(float, (unsigned)r[1])); }
__device__ __forceinline__ float max_x32(float v) { const unsigned u = __builtin_bit_cast(unsigned, v); auto r = __builtin_amdgcn_permlane32_swap(u, u, false, false); return fmaxf(__builtin_bit_cast(float, (unsigned)r[0]), __builtin_bit_cast(float, (unsigned)r[1])); }
__device__ __forceinline__ int sum_x16_i(int v) { auto r = __builtin_amdgcn_permlane16_swap((unsigned)v, (unsigned)v, false, false); return (int)r[0] + (int)r[1]; }
__device__ __forceinline__ int sum_x32_i(int v) { auto r = __builtin_amdgcn_permlane32_swap((unsigned)v, (unsigned)v, false, false); return (int)r[0] + (int)r[1]; }
__device__ __forceinline__ float row_sum(float v) { v += dpp_f<DPP_XOR1>(v); v += dpp_f<DPP_XOR2>(v); v += dpp_f<DPP_HMIRROR>(v); v += dpp_f<DPP_MIRROR>(v); return v; }
__device__ __forceinline__ float row_max(float v) { v = fmaxf(v, dpp_f<DPP_XOR1>(v)); v = fmaxf(v, dpp_f<DPP_XOR2>(v)); v = fmaxf(v, dpp_f<DPP_HMIRROR>(v)); v = fmaxf(v, dpp_f<DPP_MIRROR>(v)); return v; }
__device__ __forceinline__ int row_sum_i(int v) { v += dpp_i<DPP_XOR1>(v); v += dpp_i<DPP_XOR2>(v); v += dpp_i<DPP_HMIRROR>(v); v += dpp_i<DPP_MIRROR>(v); return v; }
__device__ __forceinline__ float wave_sum(float v) { return sum_x32(sum_x16(row_sum(v))); }
__device__ __forceinline__ float wave_max(float v) { return max_x32(max_x16(row_max(v))); }
__device__ __forceinline__ int wave_sum_i(int v) { return sum_x32_i(sum_x16_i(row_sum_i(v))); }
__device__ __forceinline__ float sum_x16_x32(float v) { return sum_x32(sum_x16(v)); }
__device__ __forceinline__ float sum_x1_x2(float v) { v += dpp_f<DPP_XOR1>(v); v += dpp_f<DPP_XOR2>(v); return v; }
template <int MASK> __device__ __forceinline__ float swz_xor(float v) { static_assert(MASK > 0 && MASK < 32, "swz_xor: 1..31"); return __builtin_bit_cast(float, __builtin_amdgcn_ds_swizzle(__builtin_bit_cast(int, v), 0x1f | (MASK << 10))); }
__device__ __forceinline__ float ex2(float x) { return __builtin_amdgcn_exp2f(x); }
__device__ __forceinline__ float rcp_(float x) { return __builtin_amdgcn_rcpf(x); }
__device__ __forceinline__ float rsq_(float x) { return __builtin_amdgcn_rsqf(x); }
__device__ __forceinline__ float sigmoidf_(float x) { return rcp_(1.f + ex2(-x * LOG2E)); }
__device__ __forceinline__ float gelu_tanh(float x) { const float u = 0.7978845608028654f * (x + 0.044715f * x * x * x); return x * rcp_(1.f + ex2(-2.f * LOG2E * u)); }
__device__ __forceinline__ f32x4 mfma16(bf16x8 a, bf16x8 b, f32x4 c) { return __builtin_amdgcn_mfma_f32_16x16x32_bf16(a, b, c, 0, 0, 0); }
__device__ __forceinline__ bf16x8 as_bf16x8(u32x4 w) { return __builtin_bit_cast(bf16x8, w); }
__device__ __forceinline__ float log2_sigmoid(float a) { return -log1pf(__expf(-a)) * LOG2E; }

struct GroupOrder {
    int nG, nM, nN, pmS, pnS, G, c;
    __device__ __forceinline__ bool next(int i, pg8::Unit& u) const {
        const long L = (long)i * G + c; const int tot = nG * nM * nN; if (L >= tot) return false;
        int wgid = (int)L; { const int q = tot / 8, r = tot % 8, xcd = wgid % 8, off = wgid / 8; wgid = (xcd < r ? xcd * (q + 1) : r * (q + 1) + (xcd - r) * q) + off; }
        const int per = nM * nN, g = wgid / per, rem = wgid - g * per;
        const int nig = 8 * nN, gid = rem / nig, fm = gid * 8, gsz = (nM - fm) < 8 ? (nM - fm) : 8;
        u.pm = g * pmS + fm + ((rem % nig) % gsz); u.pn = g * pnS + (rem % nig) / gsz; return true;
    }
    __device__ __forceinline__ void a_ready(const pg8::Unit&) const {}
    __device__ __forceinline__ void done(const pg8::Unit&) const {}
};
struct MergeOrder {
    int nM, G, c;
    __device__ __forceinline__ bool next(int i, pg8::Unit& u) const {
        const int ii = i / 3, g = i - 3 * ii; const long L = (long)ii * G + c; const int tot = nM * 4; if (L >= tot) return false;
        int wgid = (int)L; { const int q = tot / 8, r = tot % 8, xcd = wgid % 8, off = wgid / 8; wgid = (xcd < r ? xcd * (q + 1) : r * (q + 1) + (xcd - r) * q) + off; }
        const int nig = 32, gid = wgid / nig, fm = gid * 8, gsz = (nM - fm) < 8 ? (nM - fm) : 8;
        u.pm = g * (M / 256) + fm + ((wgid % nig) % gsz); u.pn = g * 4 + (wgid % nig) / gsz; return true;
    }
    __device__ __forceinline__ void a_ready(const pg8::Unit&) const {}
    __device__ __forceinline__ void done(const pg8::Unit&) const {}
};

struct EpiZA {
    static constexpr bool PERM = true, AFTER_DRAIN = false, CHAIN = false;
    bf16* O;
    __device__ __forceinline__ void operator()(const f32x4 (&acc)[2][2][4][2], const pg8::Unit& u, int wr, int wc, int fr, int fq) const {
        const int row0 = u.pm * 256 + wr * 64 + fr, col0 = u.pn * 256 + wc * 32 + 8 * fq; const bool act = false;
#pragma unroll
        for (int ai = 0; ai < 2; ++ai)
#pragma unroll
            for (int m = 0; m < 4; ++m) { bf16* rowp = O + (size_t)(row0 + ai * 128 + m * 16) * NZA + col0;
#pragma unroll
                for (int bj = 0; bj < 2; ++bj) { const f32x4 v0 = acc[ai][bj][m][0], v1 = acc[ai][bj][m][1];
                    float o[8] = {v0[0], v0[1], v0[2], v0[3], v1[0], v1[1], v1[2], v1[3]};
                    if (act) {
#pragma unroll
                        for (int k = 0; k < 8; ++k) o[k] = gelu_tanh(o[k]); }
                    *(u32x4*)(rowp + bj * 128) = pack8(o); } }
    }
};
struct EpiSig {
    static constexpr bool PERM = true, AFTER_DRAIN = false, CHAIN = false;
    bf16* O;
    __device__ __forceinline__ void operator()(const f32x4 (&acc)[2][2][4][2], const pg8::Unit& u, int wr, int wc, int fr, int fq) const {
        const int row0 = u.pm * 256 + wr * 64 + fr, col0 = u.pn * 256 + wc * 32 + 8 * fq;
#pragma unroll
        for (int ai = 0; ai < 2; ++ai)
#pragma unroll
            for (int m = 0; m < 4; ++m) { bf16* rowp = O + (size_t)(row0 + ai * 128 + m * 16) * NZG + col0;
#pragma unroll
                for (int bj = 0; bj < 2; ++bj) { const f32x4 v0 = acc[ai][bj][m][0], v1 = acc[ai][bj][m][1];
                    float o[8] = {v0[0], v0[1], v0[2], v0[3], v1[0], v1[1], v1[2], v1[3]};
#pragma unroll
                    for (int k = 0; k < 8; ++k) o[k] = fmaxf(sigmoidf_(o[k]), 1e-20f);
                    *(u32x4*)(rowp + bj * 128) = pack8(o); } }
    }
};
struct EpiMergeChain {
    static constexpr bool PERM = true, AFTER_DRAIN = false, CHAIN = true;
    const bf16* Gt; bf16* Hm;
    __device__ __forceinline__ bool chain(f32x4 (&acc)[2][2][4][2], const pg8::Unit& u, int wr, int wc, int fr, int fq) const {
        const int g = u.pm / (M / 256), m = u.pm - g * (M / 256), n = u.pn - g * 4;
        const int row0 = m * 256 + wr * 64 + fr, col0 = n * 256 + wc * 32 + 8 * fq;
#pragma unroll
        for (int ai = 0; ai < 2; ++ai) {
            u32x4 gw[4][2], hw[4][2];
#pragma unroll
            for (int mm = 0; mm < 4; ++mm)
#pragma unroll
                for (int bj = 0; bj < 2; ++bj) gw[mm][bj] = *(const u32x4*)(Gt + (size_t)(row0 + ai * 128 + mm * 16) * NZG + g * 1024 + col0 + bj * 128);
            if (g < 2) {
#pragma unroll
                for (int mm = 0; mm < 4; ++mm)
#pragma unroll
                    for (int bj = 0; bj < 2; ++bj) hw[mm][bj] = *(const u32x4*)(Gt + (size_t)(row0 + ai * 128 + mm * 16) * NZG + (g + 1) * 1024 + col0 + bj * 128);
            }
#pragma unroll
            for (int mm = 0; mm < 4; ++mm)
#pragma unroll
                for (int bj = 0; bj < 2; ++bj) {
                    float sc[8]; unpack8(gw[mm][bj], sc);
                    if (g < 2) { float sn[8]; unpack8(hw[mm][bj], sn);
#pragma unroll
                        for (int k = 0; k < 8; ++k) sc[k] *= __builtin_amdgcn_rcpf(sn[k]); }
                    f32x4& v0 = acc[ai][bj][mm][0]; f32x4& v1 = acc[ai][bj][mm][1];
                    v0[0] *= sc[0]; v0[1] *= sc[1]; v0[2] *= sc[2]; v0[3] *= sc[3]; v1[0] *= sc[4]; v1[1] *= sc[5]; v1[2] *= sc[6]; v1[3] *= sc[7];
                    if (g == 2) { u32x4 w; w.x = pk2(v0[0], v0[1]); w.y = pk2(v0[2], v0[3]); w.z = pk2(v1[0], v1[1]); w.w = pk2(v1[2], v1[3]);
                        *(u32x4*)(Hm + (size_t)(row0 + ai * 128 + mm * 16) * 1024 + col0 + bj * 128) = w; }
                }
        }
        return g < 2;
    }
};
struct EpiOut {
    static constexpr bool PERM = true, AFTER_DRAIN = false, CHAIN = false;
    const float* xl; const float* xc; bf16* X; const float* modv; int from_f32;
    __device__ __forceinline__ void operator()(const f32x4 (&acc)[2][2][4][2], const pg8::Unit& u, int wr, int wc, int fr, int fq) const {
        const int row0 = u.pm * 256 + wr * 64 + fr, col0 = u.pn * 256 + wc * 32 + 8 * fq;
        const int bi = (u.pm * 256 < ML) ? ((u.pm * 256) >> 12) : 8;
        const float* g1 = modv + bi * 6144 + 2 * 1024;
        f32x4 gv[2][2];
#pragma unroll
        for (int bj = 0; bj < 2; ++bj) { gv[bj][0] = *(const f32x4*)(g1 + col0 + bj * 128); gv[bj][1] = *(const f32x4*)(g1 + col0 + bj * 128 + 4); }
        if (from_f32) {
            const float* src0 = (u.pm * 256 < ML) ? xl + (size_t)row0 * 1024 : xc + (size_t)(row0 - ML) * 1024;
#pragma unroll
            for (int ai = 0; ai < 2; ++ai) {
                f32x4 xv[4][2][2];
#pragma unroll
                for (int m = 0; m < 4; ++m)
#pragma unroll
                    for (int bj = 0; bj < 2; ++bj) { const float* s = src0 + (size_t)(ai * 128 + m * 16) * 1024 + col0 + bj * 128; xv[m][bj][0] = *(const f32x4*)s; xv[m][bj][1] = *(const f32x4*)(s + 4); }
#pragma unroll
                for (int m = 0; m < 4; ++m)
#pragma unroll
                    for (int bj = 0; bj < 2; ++bj) { const f32x4 o0 = xv[m][bj][0] + gv[bj][0] * acc[ai][bj][m][0], o1 = xv[m][bj][1] + gv[bj][1] * acc[ai][bj][m][1];
                        u32x4 w; w.x = pk2(o0[0], o0[1]); w.y = pk2(o0[2], o0[3]); w.z = pk2(o1[0], o1[1]); w.w = pk2(o1[2], o1[3]);
                        *(u32x4*)(X + (size_t)(row0 + ai * 128 + m * 16) * 1024 + col0 + bj * 128) = w; }
            }
        } else {
#pragma unroll
            for (int ai = 0; ai < 2; ++ai) {
                u32x4 xw[4][2];
#pragma unroll
                for (int m = 0; m < 4; ++m)
#pragma unroll
                    for (int bj = 0; bj < 2; ++bj) xw[m][bj] = *(const u32x4*)(X + (size_t)(row0 + ai * 128 + m * 16) * 1024 + col0 + bj * 128);
#pragma unroll
                for (int m = 0; m < 4; ++m)
#pragma unroll
                    for (int bj = 0; bj < 2; ++bj) { float xo[8]; unpack8(xw[m][bj], xo); const f32x4 a0 = acc[ai][bj][m][0], a1 = acc[ai][bj][m][1];
                        float o[8] = {xo[0] + gv[bj][0][0] * a0[0], xo[1] + gv[bj][0][1] * a0[1], xo[2] + gv[bj][0][2] * a0[2], xo[3] + gv[bj][0][3] * a0[3],
                                      xo[4] + gv[bj][1][0] * a1[0], xo[5] + gv[bj][1][1] * a1[1], xo[6] + gv[bj][1][2] * a1[2], xo[7] + gv[bj][1][3] * a1[3]};
                        *(u32x4*)(X + (size_t)(row0 + ai * 128 + m * 16) * 1024 + col0 + bj * 128) = pack8(o); }
            }
        }
    }
};
struct EpiMoe1 {
    static constexpr bool PERM = true, AFTER_DRAIN = false, CHAIN = false;
    bf16* ACT;
    __device__ __forceinline__ void operator()(const f32x4 (&acc)[2][2][4][2], const pg8::Unit& u, int wr, int wc, int fr, int fq) const {
        const int row0 = u.pm * 256 + wr * 64 + fr, col0 = (u.pn & 7) * 128 + wc * 32 + 8 * fq;
#pragma unroll
        for (int ai = 0; ai < 2; ++ai)
#pragma unroll
            for (int m = 0; m < 4; ++m) { const size_t r = (size_t)(row0 + ai * 128 + m * 16);
                const f32x4 a0 = acc[ai][0][m][0], a1 = acc[ai][0][m][1], u0 = acc[ai][1][m][0], u1 = acc[ai][1][m][1];
                float o[8];
#pragma unroll
                for (int k = 0; k < 4; ++k) { o[k] = a0[k] * sigmoidf_(a0[k]) * u0[k]; o[4 + k] = a1[k] * sigmoidf_(a1[k]) * u1[k]; }
                *(u32x4*)(ACT + r * 1024 + col0) = pack8(o); }
    }
};
struct EpiMoe2 {
    static constexpr bool PERM = true, AFTER_DRAIN = false, CHAIN = false;
    bf16* Y; const float* topw;
    __device__ __forceinline__ void operator()(const f32x4 (&acc)[2][2][4][2], const pg8::Unit& u, int wr, int wc, int fr, int fq) const {
        const int row0 = u.pm * 256 + wr * 64 + fr, col0 = (u.pn & 3) * 256 + wc * 32 + 8 * fq;
        float twv[2][4];
#pragma unroll
        for (int ai = 0; ai < 2; ++ai)
#pragma unroll
            for (int m = 0; m < 4; ++m) twv[ai][m] = topw[row0 + ai * 128 + m * 16];
#pragma unroll
        for (int ai = 0; ai < 2; ++ai)
#pragma unroll
            for (int m = 0; m < 4; ++m) { const size_t r = (size_t)(row0 + ai * 128 + m * 16); const float tw = twv[ai][m];
#pragma unroll
                for (int bj = 0; bj < 2; ++bj) { const f32x4 v0 = acc[ai][bj][m][0] * tw, v1 = acc[ai][bj][m][1] * tw;
                    u32x4 w; w.x = pk2(v0[0], v0[1]); w.y = pk2(v0[2], v0[3]); w.z = pk2(v1[0], v1[1]); w.w = pk2(v1[2], v1[3]);
                    *(u32x4*)(Y + r * 1024 + col0 + bj * 128) = w; } }
    }
};

__device__ __forceinline__ void tr_item(const float* W, int N, int k0, int n0, bf16* dst, int K, LAS float* scr, int lane) {
#pragma unroll 8
    for (int i = 0; i < 32; ++i) { const int kk = 2 * i + (lane >> 5); scr[kk * 33 + (lane & 31)] = W[(size_t)(k0 + kk) * N + n0 + (lane & 31)]; }
    LDS_WAIT();
    const int cc = lane & 7;
#pragma unroll
    for (int j = 0; j < 4; ++j) { const int n = (lane >> 3) + 8 * j; const LAS float* s = scr + (8 * cc) * 33 + n;
        u32x4 o; o.x = pk2(s[0 * 33], s[1 * 33]); o.y = pk2(s[2 * 33], s[3 * 33]); o.z = pk2(s[4 * 33], s[5 * 33]); o.w = pk2(s[6 * 33], s[7 * 33]);
        *(u32x4*)(dst + (size_t)n * K + 8 * cc) = o; }
    LDS_WAIT();
}
__device__ __forceinline__ void convert_small(KPC p, int l, LAS unsigned char* lds, int lane, int wave, int bid, int G) {
    LAS float* scr = (LAS float*)(lds + wave * 8448);
    const int gw = bid * 8 + wave, NGW = G * 8;
    constexpr int I_IN = 16 * 200, I_BR = 8 * 32, I_OUT = 16 * 32;
    bf16* wtin = (bf16*)(p->ws + WS_WTIN); bf16* wtbr = (bf16*)(p->ws + WS_WTBR); bf16* wtout = (bf16*)(p->ws + WS_WTOUT);
    for (int it = gw; it < I_IN + 3 * I_BR + I_OUT; it += NGW) {
        int r = it;
        if (r < I_IN) { const int kb = r / 200, nb = r % 200; tr_item(p->w_in + (size_t)l * 1024 * 6400, 6400, 64 * kb, 32 * nb, wtin + (size_t)(32 * nb) * 1024 + 64 * kb, 1024, scr, lane); continue; }
        r -= I_IN;
        if (r < 3 * I_BR) { const int br = r / I_BR, q = r % I_BR, kb = q / 32, nb = q % 32;
            tr_item(p->w_branch + ((size_t)l * 3 + br) * 512 * 1024, 1024, 64 * kb, 32 * nb, wtbr + (size_t)(br * 1024 + 32 * nb) * 512 + 64 * kb, 512, scr, lane); continue; }
        r -= 3 * I_BR;
        { const int kb = r / 32, nb = r % 32; tr_item(p->w_out + (size_t)l * 1024 * 1024, 1024, 64 * kb, 32 * nb, wtout + (size_t)(32 * nb) * 1024 + 64 * kb, 1024, scr, lane); }
    }
}
__device__ __forceinline__ void convert_experts(KPC p, int l, int lo, int hi, int widx, int nw, LAS unsigned char* lds, int lane, int wave) {
    LAS float* scr = (LAS float*)(lds + wave * 8448);
    bf16* wt1 = (bf16*)(p->ws + WS_WT1); bf16* wt2 = (bf16*)(p->ws + WS_WT2);
    for (int it = lo + widx; it < hi; it += nw) {
        const int e = it / 1536, q = it % 1536, which = q / 512, qq = q % 512, kb = qq / 32, nb = qq % 32, n0 = 32 * nb, k0 = 64 * kb;
        const size_t woff = ((size_t)l * NE + e) * 1024 * 1024;
        if (which == 0) tr_item(p->w_eg + woff, 1024, k0, n0, wt1 + ((size_t)e * 2048 + (n0 >> 7) * 256 + (n0 & 127)) * 1024 + k0, 1024, scr, lane);
        else if (which == 1) tr_item(p->w_eu + woff, 1024, k0, n0, wt1 + ((size_t)e * 2048 + (n0 >> 7) * 256 + 128 + (n0 & 127)) * 1024 + k0, 1024, scr, lane);
        else tr_item(p->w_ed + woff, 1024, k0, n0, wt2 + ((size_t)e * 1024 + n0) * 1024 + k0, 1024, scr, lane);
    }
}
constexpr int CVT_ITEMS = NE * 3 * 512;
constexpr int CVT_G_IDLE0 = 96, CVT_M_IDLE0 = 32, CVT_O_IDLE0 = 32;
constexpr int CVT_G_HI = 7680, CVT_M_HI = 7680 + 14336;

__device__ __forceinline__ void phase_prep(KPC p, LAS unsigned char* lds, int tid, int lane, int wave, int bid, int G) {
    unsigned char* ws = p->ws;
    {   float* rc = (float*)(ws + WS_ROPEC); float* rsn = (float*)(ws + WS_ROPES);
        for (int i = bid * 512 + tid; i < T * 32; i += G * 512) { const int t = i >> 5, f = i & 31; const int pos = (f < 16) ? (t >> 6) : (t & 63); const int fi = f & 15;
            const float inv = ex2(-(float)fi * (13.287712379549449f / 16.f));
            float ang = (float)pos * inv; ang -= 6.283185307179586f * rintf(ang * 0.15915494309189535f);
            rc[i] = __cosf(ang); rsn[i] = __sinf(ang); } }
    if (bid == 0 && tid < 16) { const int l = tid >> 3, dir = (tid >> 2) & 1, h = tid & 3; ((float*)(ws + WS_LG))[tid] = log2_sigmoid(dir ? p->dec_b[l * 4 + h] : p->dec_f[l * 4 + h]); }
    {   LAS float* sv = (LAS float*)lds;
        LAS float* red = (LAS float*)(lds + 36864);
        for (int i = tid; i < 9 * 1024; i += 512) { const int r = i >> 10, k = i & 1023; const float v = (r < 8) ? p->c[r * 1024 + k] : p->c_ctx[k]; sv[i] = v * sigmoidf_(v); }
        __syncthreads();
        for (int it = bid; it < 192; it += G) {
            const int l = it / 96, n0 = (it % 96) * 64;
            const float* W = p->w_mod + (size_t)l * 1024 * 6144 + n0 + lane;
            float acc[9];
#pragma unroll
            for (int r = 0; r < 9; ++r) acc[r] = 0.f;
#pragma unroll 1
            for (int k0 = wave * 128; k0 < wave * 128 + 128; k0 += 16) {
                float wv[16];
#pragma unroll
                for (int kk = 0; kk < 16; ++kk) wv[kk] = W[(size_t)(k0 + kk) * 6144];
#pragma unroll
                for (int kk = 0; kk < 16; ++kk)
#pragma unroll
                    for (int r = 0; r < 9; ++r) acc[r] += sv[r * 1024 + k0 + kk] * wv[kk]; }
#pragma unroll
            for (int r = 0; r < 9; ++r) red[(wave * 9 + r) * 64 + lane] = acc[r];
            __syncthreads();
            for (int i = tid; i < 576; i += 512) { const int r = i >> 6, ln = i & 63; float s = 0.f;
#pragma unroll
                for (int w = 0; w < 8; ++w) s += red[(w * 9 + r) * 64 + ln];
                s += p->b_mod[l * 6144 + n0 + ln]; ((float*)(ws + WS_MODV))[(l * 9 + r) * 6144 + n0 + ln] = s; }
            __syncthreads();
        }
    }
    __syncthreads();
    convert_small(p, 0, lds, lane, wave, bid, G);
}

__device__ __forceinline__ float row_rs(const f32x4 (&v)[4]) {
    float ss = 0.f;
#pragma unroll
    for (int j = 0; j < 4; ++j) ss += (v[j].x * v[j].x + v[j].y * v[j].y) + (v[j].z * v[j].z + v[j].w * v[j].w);
    return rsq_(wave_sum(ss) * (1.f / 1024.f) + EPS);
}
__device__ __forceinline__ void norm_mod(const f32x4 (&v)[4], float rs, const float* gain, const float* sh, const float* sc, f32x4 (&h)[4], int lane) {
#pragma unroll
    for (int j = 0; j < 4; ++j) { const int col = 4 * lane + 256 * j; const f32x4 g = *(const f32x4*)(gain + col), a = *(const f32x4*)(sc + col), b = *(const f32x4*)(sh + col);
        h[j] = (v[j] * rs) * g * (a + 1.0f) + b; }
}
__device__ __forceinline__ void store_h(const f32x4 (&h)[4], bf16* hrow, int lane) {
#pragma unroll
    for (int j = 0; j < 4; ++j) { u32x2 w; w.x = pk2(h[j].x, h[j].y); w.y = pk2(h[j].z, h[j].w); *(u32x2*)(hrow + 4 * lane + 256 * j) = w; }
}
__device__ __forceinline__ void phase_norm_in(KPC p, int lane, int wave, int bid, int G) {
    const float* modv = (const float*)(p->ws + WS_MODV); bf16* H = (bf16*)(p->ws + WS_H);
    const int stride = G * 8; int r = bid * 8 + wave;
    f32x4 vn[4];
    {   const float* src = (r < ML) ? p->x + (size_t)r * 1024 : p->ctx + (size_t)(r - ML) * 1024;
#pragma unroll
        for (int j = 0; j < 4; ++j) vn[j] = (r < M) ? *(const f32x4*)(src + 4 * lane + 256 * j) : (f32x4){0.f, 0.f, 0.f, 0.f}; }
    for (; r < M; r += stride) {
        const int bi = (r < ML) ? (r >> 12) : 8; const float* mv = modv + bi * 6144;
        f32x4 v[4], h[4], g[4], sc[4], sh[4];
#pragma unroll
        for (int j = 0; j < 4; ++j) { v[j] = vn[j]; const int col = 4 * lane + 256 * j; g[j] = *(const f32x4*)(p->norm1_g + col); sh[j] = *(const f32x4*)(mv + col); sc[j] = *(const f32x4*)(mv + 1024 + col); }
        const int rn = r + stride;
        if (rn < M) { const float* src = (rn < ML) ? p->x + (size_t)rn * 1024 : p->ctx + (size_t)(rn - ML) * 1024;
#pragma unroll
            for (int j = 0; j < 4; ++j) vn[j] = *(const f32x4*)(src + 4 * lane + 256 * j); }
        const float rs = row_rs(v);
#pragma unroll
        for (int j = 0; j < 4; ++j) h[j] = (v[j] * rs) * g[j] * (sc[j] + 1.0f) + sh[j];
        store_h(h, H + (size_t)r * 1024, lane);
    }
}

typedef short s16x4 __attribute__((ext_vector_type(4)));
__device__ __forceinline__ u32x2 lds_tr16(const LAS unsigned char* addr) { const s16x4 r = __builtin_amdgcn_ds_read_tr16_b64_v4i16((LAS s16x4*)addr); return __builtin_bit_cast(u32x2, r); }
__device__ __forceinline__ void ld8f(const float* p, float (&f)[8]) { const f32x4 a = *(const f32x4*)p, b = *(const f32x4*)(p + 4); f[0] = a[0]; f[1] = a[1]; f[2] = a[2]; f[3] = a[3]; f[4] = b[0]; f[5] = b[1]; f[6] = b[2]; f[7] = b[3]; }
__device__ __forceinline__ void att_item(KPC p, int l, LAS unsigned char* lds, int item, float Mb2, int tid, int lane, int wave) {
    const bf16* ZA = (const bf16*)(p->ws + WS_ZA); bf16* BR = (bf16*)p->out + (size_t)2 * M * 512;
    const float* rc = (const float*)(p->ws + WS_ROPEC); const float* rsn = (const float*)(p->ws + WS_ROPES);
    const bool isctx = item >= 512;
    int b, kvh, qb;
    if (!isctx) { b = item >> 6; kvh = (item >> 5) & 1; qb = item & 31; } else { const int ci = item - 512; b = ci >> 2; kvh = (ci >> 1) & 1; qb = ci & 1; }
    const int rowbase = isctx ? ML + b * CL : b * T;
    const int g = wave >> 1, qs = wave & 1, hh = kvh * 4 + g, c = lane & 15, g4 = lane >> 4, q0 = qb * 128 + qs * 64;
    const float* qg = p->qn_g + l * 64; const float* kg = p->kn_g + l * 64;
    LAS unsigned char* Kl = lds;
    bf16x8 qf[4][2];
    float qga[8], qgb[8]; ld8f(qg + 8 * g4, qga); ld8f(qg + 32 + 8 * g4, qgb);
#pragma unroll
    for (int ti = 0; ti < 4; ++ti) {
        const int pos = q0 + 16 * ti + c; const bf16* src = ZA + (size_t)(rowbase + pos) * NZA + C_AQ + hh * 64 + 8 * g4;
        float a[8], bb[8]; unpack8(*(const u32x4*)src, a); unpack8(*(const u32x4*)(src + 32), bb);
        float ss = 0.f;
#pragma unroll
        for (int j = 0; j < 8; ++j) ss += a[j] * a[j] + bb[j] * bb[j];
        ss = sum_x16_x32(ss);
        const float rs = rsq_(ss * (1.f / 64.f) + EPS);
#pragma unroll
        for (int j = 0; j < 8; ++j) { a[j] *= rs * qga[j]; bb[j] *= rs * qgb[j]; }
        if (!isctx) { float cs8[8], sn8[8]; ld8f(rc + pos * 32 + 8 * g4, cs8); ld8f(rsn + pos * 32 + 8 * g4, sn8);
#pragma unroll
            for (int j = 0; j < 8; ++j) { const float cs = cs8[j], sn = sn8[j]; const float x1 = a[j], x2 = bb[j]; a[j] = x1 * cs - x2 * sn; bb[j] = x1 * sn + x2 * cs; } }
#pragma unroll
        for (int j = 0; j < 8; ++j) { a[j] *= 0.125f * LOG2E; bb[j] *= 0.125f * LOG2E; }
        qf[ti][0] = as_bf16x8(pack8(a)); qf[ti][1] = as_bf16x8(pack8(bb));
        __builtin_amdgcn_sched_barrier(0);
    }
    f32x4 O[4][4]; float lsum[4];
#pragma unroll
    for (int i = 0; i < 4; ++i) { lsum[i] = 0.f;
#pragma unroll
        for (int j = 0; j < 4; ++j) O[i][j] = (f32x4){0.f, 0.f, 0.f, 0.f}; }
    const int key = tid >> 2, q4 = tid & 3;
    LAS unsigned char* Vl = lds + 55296;
#pragma unroll 1
    for (int st = isctx ? 1 : 0; st < 2; ++st) {
        __syncthreads();
        {   u32x4 kr[1][2], vr[1][2];
#define ATT_VB(lb_) ((st == 0) ? ((qb - 1 + (lb_)) >= 0 && (qb - 1 + (lb_)) <= 31) : ((lb_) < 2))
#define ATT_LD(lb_, s_) do { if (ATT_VB(lb_)) { const int krow = (st == 0) ? b * T + (qb - 1 + (lb_)) * 128 + key : ML + b * CL + 128 * (lb_) + key; \
                const bf16* ks = ZA + (size_t)krow * NZA + C_AK + kvh * 64 + 8 * q4; kr[s_][0] = *(const u32x4*)ks; kr[s_][1] = *(const u32x4*)(ks + 32); \
                const bf16* vs = ZA + (size_t)krow * NZA + C_AV + kvh * 64 + 16 * q4; vr[s_][0] = *(const u32x4*)vs; vr[s_][1] = *(const u32x4*)(vs + 8); } } while (0)
#pragma unroll 1
            for (int lb = 0; lb < 3; ++lb) {
                ATT_LD(lb, 0);
                if (ATT_VB(lb)) {
                    float a[8], bb[8]; unpack8(kr[0][0], a); unpack8(kr[0][1], bb);
                    float ss = 0.f;
#pragma unroll
                    for (int j = 0; j < 8; ++j) ss += a[j] * a[j] + bb[j] * bb[j];
                    ss = sum_x1_x2(ss);
                    const float rs = rsq_(ss * (1.f / 64.f) + EPS);
                    float kga[8], kgb[8]; ld8f(kg + 8 * q4, kga); ld8f(kg + 32 + 8 * q4, kgb);
#pragma unroll
                    for (int j = 0; j < 8; ++j) { a[j] *= rs * kga[j]; bb[j] *= rs * kgb[j]; }
                    __builtin_amdgcn_sched_barrier(0);
                    if (st == 0) { const int pos = (qb - 1 + lb) * 128 + key; float cs8[8], sn8[8]; ld8f(rc + pos * 32 + 8 * q4, cs8); ld8f(rsn + pos * 32 + 8 * q4, sn8);
#pragma unroll
                        for (int j = 0; j < 8; ++j) { const float cs = cs8[j], sn = sn8[j]; const float x1 = a[j], x2 = bb[j]; a[j] = x1 * cs - x2 * sn; bb[j] = x1 * sn + x2 * cs; } }
                    LAS unsigned char* kd = Kl + (lb * 128 + key) * 144; *(LAS u32x4*)(kd + 16 * q4) = pack8(a); *(LAS u32x4*)(kd + 64 + 16 * q4) = pack8(bb);
                    LAS unsigned char* vd = Vl + (lb * 128 + key) * 144 + 32 * q4; *(LAS u32x4*)vd = vr[0][0]; *(LAS u32x4*)(vd + 16) = vr[0][1];
                }
            }
#undef ATT_VB
#undef ATT_LD
        }
        __syncthreads();
#pragma unroll 1
        for (int lb = 0; lb < 3; ++lb) {
            if (st == 0) { const int kb = qb - 1 + lb; if (kb < 0 || kb > 31) continue; } else if (lb >= 2) continue;
            const int mode = (st == 0) ? ((lb == 0) ? 1 : ((lb == 2) ? 2 : 0)) : 0;
            const LAS unsigned char* Kb = Kl + lb * 128 * 144; const LAS unsigned char* Vb = Vl + lb * 128 * 144;
#pragma unroll 1
            for (int kk = 0; kk < 4; ++kk) {
                if ((mode == 1 && 32 * kk + 31 < qs * 64) || (mode == 2 && 32 * kk > qs * 64 + 63)) continue;
                bf16x8 ka[2][2];
#pragma unroll
                for (int hf = 0; hf < 2; ++hf)
#pragma unroll
                    for (int ks = 0; ks < 2; ++ks) ka[hf][ks] = *(const LAS bf16x8*)(Kb + (32 * kk + 16 * hf + c) * 144 + ks * 64 + g4 * 16);
                bf16x8 pf[4];
#pragma unroll
                for (int ti = 0; ti < 4; ++ti) {
                    f32x4 sa = (f32x4){-Mb2, -Mb2, -Mb2, -Mb2}, sb = sa;
                    sa = mfma16(ka[0][0], qf[ti][0], sa); sa = mfma16(ka[0][1], qf[ti][1], sa);
                    sb = mfma16(ka[1][0], qf[ti][0], sb); sb = mfma16(ka[1][1], qf[ti][1], sb);
                    float pa[4], pb[4];
#pragma unroll
                    for (int rr = 0; rr < 4; ++rr) { pa[rr] = ex2(sa[rr]); pb[rr] = ex2(sb[rr]); }
                    if (mode != 0) {
                        const int ii = qs * 64 + 16 * ti + c; const int mlo = (mode == 1) ? ii : -1000, mhi = (mode == 2) ? ii : 1000;
#pragma unroll
                        for (int rr = 0; rr < 4; ++rr) { const int ja = 32 * kk + 4 * g4 + rr, jb = ja + 16;
                            pa[rr] = (ja >= mlo && ja <= mhi) ? pa[rr] : 0.f; pb[rr] = (jb >= mlo && jb <= mhi) ? pb[rr] : 0.f; } }
                    lsum[ti] += ((pa[0] + pa[1]) + (pa[2] + pa[3])) + ((pb[0] + pb[1]) + (pb[2] + pb[3]));
                    u32x4 w; w.x = pk2(pa[0], pa[1]); w.y = pk2(pa[2], pa[3]); w.z = pk2(pb[0], pb[1]); w.w = pk2(pb[2], pb[3]); pf[ti] = as_bf16x8(w);
                }
#pragma unroll
                for (int dt = 0; dt < 4; ++dt) {
                    const u32x2 v0 = lds_tr16(Vb + (32 * kk + 4 * g4 + (c >> 2)) * 144 + (16 * dt + 4 * (c & 3)) * 2), v1 = lds_tr16(Vb + (32 * kk + 16 + 4 * g4 + (c >> 2)) * 144 + (16 * dt + 4 * (c & 3)) * 2);
                    u32x4 vv; vv.x = v0.x; vv.y = v0.y; vv.z = v1.x; vv.w = v1.y; const bf16x8 va = as_bf16x8(vv);
#pragma unroll
                    for (int ti = 0; ti < 4; ++ti) O[dt][ti] = mfma16(va, pf[ti], O[dt][ti]);
                }
            }
        }
    }
    const float sk = ex2(p->sink[l * 8 + hh] * LOG2E - Mb2);
#pragma unroll
    for (int ti = 0; ti < 4; ++ti) { float lt = sum_x16_x32(lsum[ti]); const float inv = rcp_(lt + sk);
        bf16* dst = BR + (size_t)(rowbase + q0 + 16 * ti + c) * 512 + hh * 64 + 4 * g4;
#pragma unroll
        for (int dt = 0; dt < 4; ++dt) { const f32x4 o = O[dt][ti] * inv; u32x2 w; w.x = pk2(o[0], o[1]); w.y = pk2(o[2], o[3]); *(u32x2*)(dst + 16 * dt) = w; } }
    __syncthreads();
}

__device__ __forceinline__ void sgu_vprep_item(KPC p, int ch, int tid) {
    bf16* ZA = (bf16*)(p->ws + WS_ZA);
    const int seg = tid & 15;
    bf16* rowp0 = ZA + (size_t)(ch * 128 + (tid >> 4)) * NZA + C_SV + 32 * seg;
    u32x4 raw[4][4];
#pragma unroll
    for (int ps = 0; ps < 4; ++ps)
#pragma unroll
        for (int q = 0; q < 4; ++q) raw[ps][q] = *(const u32x4*)(rowp0 + (size_t)ps * 32 * NZA + 8 * q);
#pragma unroll
    for (int ps = 0; ps < 4; ++ps) {
        bf16* rowp = rowp0 + (size_t)ps * 32 * NZA;
        float f[4][8]; float s = 0.f, ss = 0.f;
#pragma unroll
        for (int q = 0; q < 4; ++q) unpack8(raw[ps][q], f[q]);
#pragma unroll
        for (int q = 0; q < 4; ++q)
#pragma unroll
            for (int e = 0; e < 8; ++e) { const float y = gelu_tanh(f[q][e]); f[q][e] = y; s += y; ss += y * y; }
        s = row_sum(s); ss = row_sum(ss);
        const float mean = s * (1.f / 512.f), var = fmaxf(ss * (1.f / 512.f) - mean * mean, 0.f), rstd = rsq_(var + EPS);
#pragma unroll
        for (int q = 0; q < 4; ++q) {
#pragma unroll
            for (int e = 0; e < 8; ++e) f[q][e] = (f[q][e] - mean) * rstd;
            *(u32x4*)(rowp + 8 * q) = pack8(f[q]); }
    }
}
__device__ __forceinline__ void sgu_item(KPC p, int l, LAS unsigned char* lds, int item, int tid, int lane, int wave) {
    const bf16* ZA = (const bf16*)(p->ws + WS_ZA); bf16* BR = (bf16*)p->out + (size_t)1 * M * 512;
    const int ch = item >> 2, g = item & 3, r0 = ch * 128, c = lane & 15, g4 = lane >> 4;
    LAS unsigned char* vT = lds;
    LAS unsigned char* WL = lds + 34816;
    {   const int j = tid >> 2, q4 = tid & 3; const bf16* src = ZA + (size_t)(r0 + j) * NZA + C_SV + 128 * g + 32 * q4;
#pragma unroll
        for (int q = 0; q < 4; ++q) { const u32x4 v = *(const u32x4*)(src + 8 * q); const unsigned vw[4] = {v.x, v.y, v.z, v.w};
#pragma unroll
            for (int e = 0; e < 4; ++e) { *(LAS unsigned short*)(vT + (32 * q4 + 8 * q + 2 * e) * 272 + j * 2) = (unsigned short)(vw[e] & 0xffffu); *(LAS unsigned short*)(vT + (32 * q4 + 8 * q + 2 * e + 1) * 272 + j * 2) = (unsigned short)(vw[e] >> 16); } }
        const float* wsrc = p->sgu_w + ((size_t)(l * 4 + g) * 128 + (tid >> 2)) * 128 + 32 * (tid & 3);
#pragma unroll
        for (int q = 0; q < 4; ++q) { const f32x4 a = *(const f32x4*)(wsrc + 8 * q), bq = *(const f32x4*)(wsrc + 8 * q + 4);
            u32x4 w; w.x = pk2(a.x, a.y); w.y = pk2(a.z, a.w); w.z = pk2(bq.x, bq.y); w.w = pk2(bq.z, bq.w);
            *(LAS u32x4*)(WL + (tid >> 2) * 272 + (32 * (tid & 3) + 8 * q) * 2) = w; }
    }
    __syncthreads();
    bf16x8 af[4];
#pragma unroll
    for (int ks = 0; ks < 4; ++ks) af[ks] = *(const LAS bf16x8*)(vT + (16 * wave + c) * 272 + (32 * ks + 8 * g4) * 2);
    const int col = 128 * g + 16 * wave + 4 * g4;
    u32x2 uw[8]; float bias[8];
#pragma unroll
    for (int ti = 0; ti < 8; ++ti) { uw[ti] = *(const u32x2*)(ZA + (size_t)(r0 + 16 * ti + c) * NZA + C_SU + col); bias[ti] = p->sgu_b[(l * 4 + g) * 128 + 16 * ti + c]; }
#pragma unroll
    for (int ti = 0; ti < 8; ++ti) {
        f32x4 acc = (f32x4){0.f, 0.f, 0.f, 0.f};
#pragma unroll
        for (int ks = 0; ks < 4; ++ks) acc = mfma16(af[ks], *(const LAS bf16x8*)(WL + (16 * ti + c) * 272 + (32 * ks + 8 * g4) * 2), acc);
        const float o0 = gelu_tanh(bflo(uw[ti].x)) * (acc[0] + bias[ti]), o1 = gelu_tanh(bfhi(uw[ti].x)) * (acc[1] + bias[ti]), o2 = gelu_tanh(bflo(uw[ti].y)) * (acc[2] + bias[ti]), o3 = gelu_tanh(bfhi(uw[ti].y)) * (acc[3] + bias[ti]);
        u32x2 w; w.x = pk2(o0, o1); w.y = pk2(o2, o3); *(u32x2*)(BR + (size_t)(r0 + 16 * ti + c) * 512 + col) = w;
    }
    __syncthreads();
}

__device__ __forceinline__ void ret_load_k(KPC p, const bf16* ZA, int r0, int h, bool latent, int pos0, int tid, float (&a)[8], float (&bb)[8]) {
    const int j = tid >> 2, q4 = tid & 3; const bf16* src = ZA + (size_t)(r0 + j) * NZA + C_RK + 64 * h + 8 * q4;
    unpack8(*(const u32x4*)src, a); unpack8(*(const u32x4*)(src + 32), bb);
    if (latent) { const float* rc = (const float*)(p->ws + WS_ROPEC); const float* rsn = (const float*)(p->ws + WS_ROPES); const int pos = pos0 + j; float cs8[8], sn8[8]; ld8f(rc + pos * 32 + 8 * q4, cs8); ld8f(rsn + pos * 32 + 8 * q4, sn8);
#pragma unroll
        for (int e = 0; e < 8; ++e) { const float cs = cs8[e], sn = sn8[e]; const float x1 = a[e], x2 = bb[e]; a[e] = x1 * cs - x2 * sn; bb[e] = x1 * sn + x2 * cs; } }
#pragma unroll
    for (int e = 0; e < 8; ++e) { a[e] *= 0.125f; bb[e] *= 0.125f; }
}
__device__ __forceinline__ void ret_stage_vT(const bf16* ZA, int r0, int h, LAS unsigned char* vT, int tid) {
    const int j = tid >> 2, q4 = tid & 3; const bf16* src = ZA + (size_t)(r0 + j) * NZA + C_RV + 128 * h + 32 * q4;
#pragma unroll
    for (int q = 0; q < 4; ++q) { const u32x4 v = *(const u32x4*)(src + 8 * q); const unsigned vw[4] = {v.x, v.y, v.z, v.w};
#pragma unroll
        for (int e = 0; e < 4; ++e) { *(LAS unsigned short*)(vT + (32 * q4 + 8 * q + 2 * e) * 272 + j * 2) = (unsigned short)(vw[e] & 0xffffu); *(LAS unsigned short*)(vT + (32 * q4 + 8 * q + 2 * e + 1) * 272 + j * 2) = (unsigned short)(vw[e] >> 16); } }
}
__device__ __forceinline__ void ret_upd_item(KPC p, int l, LAS unsigned char* lds, int item, int tid, int lane, int wave) {
    const bf16* ZA = (const bf16*)(p->ws + WS_ZA); float* RS = (float*)(p->ws + WS_RS);
    const int b = item / (NCH * 4), rem = item % (NCH * 4), n = rem >> 2, h = rem & 3, c = lane & 15, g4 = lane >> 4;
    const bool latent = n < 32; const int r0 = latent ? b * T + 128 * n : ML + b * CL + 128 * (n - 32);
    const float lgf = ((const float*)(p->ws + WS_LG))[l * 8 + h], lgb = ((const float*)(p->ws + WS_LG))[l * 8 + 4 + h];
    LAS unsigned char* vT = lds; LAS unsigned char* kTf = lds + 34816; LAS unsigned char* kTb = lds + 34816 + 17408;
    {   float a[8], bb[8]; ret_load_k(p, ZA, r0, h, latent, 128 * n, tid, a, bb);
        const int j = tid >> 2, q4 = tid & 3; const float wf = ex2((float)(127 - j) * lgf), wb = ex2((float)j * lgb);
#pragma unroll
        for (int e = 0; e < 8; e += 2) {
            unsigned w = pk2(a[e] * wf, a[e + 1] * wf); *(LAS unsigned short*)(kTf + (8 * q4 + e) * 272 + j * 2) = (unsigned short)(w & 0xffffu); *(LAS unsigned short*)(kTf + (8 * q4 + e + 1) * 272 + j * 2) = (unsigned short)(w >> 16);
            w = pk2(bb[e] * wf, bb[e + 1] * wf); *(LAS unsigned short*)(kTf + (32 + 8 * q4 + e) * 272 + j * 2) = (unsigned short)(w & 0xffffu); *(LAS unsigned short*)(kTf + (32 + 8 * q4 + e + 1) * 272 + j * 2) = (unsigned short)(w >> 16);
            w = pk2(a[e] * wb, a[e + 1] * wb); *(LAS unsigned short*)(kTb + (8 * q4 + e) * 272 + j * 2) = (unsigned short)(w & 0xffffu); *(LAS unsigned short*)(kTb + (8 * q4 + e + 1) * 272 + j * 2) = (unsigned short)(w >> 16);
            w = pk2(bb[e] * wb, bb[e + 1] * wb); *(LAS unsigned short*)(kTb + (32 + 8 * q4 + e) * 272 + j * 2) = (unsigned short)(w & 0xffffu); *(LAS unsigned short*)(kTb + (32 + 8 * q4 + e + 1) * 272 + j * 2) = (unsigned short)(w >> 16);
        }
        ret_stage_vT(ZA, r0, h, vT, tid);
    }
    __syncthreads();
    bf16x8 af[4];
#pragma unroll
    for (int ks = 0; ks < 4; ++ks) af[ks] = *(const LAS bf16x8*)(vT + (16 * wave + c) * 272 + (32 * ks + 8 * g4) * 2);
#pragma unroll
    for (int dir = 0; dir < 2; ++dir) { const LAS unsigned char* kT = dir ? kTb : kTf;
        float* dst = RS + ((size_t)(((b * 4 + h) * 2 + dir) * NCH + n) * 128 + 16 * wave + 4 * g4) * 64;
#pragma unroll
        for (int dt = 0; dt < 4; ++dt) { f32x4 acc = (f32x4){0.f, 0.f, 0.f, 0.f};
#pragma unroll
            for (int ks = 0; ks < 4; ++ks) acc = mfma16(af[ks], *(const LAS bf16x8*)(kT + (16 * dt + c) * 272 + (32 * ks + 8 * g4) * 2), acc);
#pragma unroll
            for (int rr = 0; rr < 4; ++rr) dst[rr * 64 + 16 * dt + c] = acc[rr]; } }
    __syncthreads();
}
__device__ __forceinline__ void phase_scan(KPC p, int l, int tid, int bid, int G) {
    const float* __restrict__ RS = (const float*)(p->ws + WS_RS); bf16* __restrict__ ST = (bf16*)(p->ws + WS_ST);
    for (int idx = bid * 512 + tid; idx < NB * 4 * 2 * 8192; idx += G * 512) {
        const int ed = idx & 8191, dir = (idx >> 13) & 1, bh = idx >> 14, e = ed >> 6, d = ed & 63, h = bh & 3;
        const float* P = RS + (size_t)((bh * 2 + dir) * NCH) * 8192 + ed;
        bf16* S = ST + ((size_t)bh * NCH * 128 + e) * 128 + dir * 64 + d;
        const float lg = ((const float*)(p->ws + WS_LG))[l * 8 + dir * 4 + h]; const float dec = ex2(128.f * lg);
        float u[NCH];
#pragma unroll
        for (int n = 0; n < NCH; ++n) u[n] = P[(size_t)n * 8192];
        if (dir == 0) {
            S[32 * 16384] = 0; S[33 * 16384] = (bf16)(pk2(u[32], 0.f) & 0xffffu);
            float s = dec * u[32] + u[33];
#pragma unroll
            for (int n = 0; n < 32; ++n) { S[(size_t)n * 16384] = (bf16)(pk2(s, 0.f) & 0xffffu); s = dec * s + u[n]; }
        } else {
            S[33 * 16384] = 0; S[32 * 16384] = (bf16)(pk2(u[33], 0.f) & 0xffffu);
            float s = dec * u[33] + u[32];
#pragma unroll
            for (int n = 31; n >= 0; --n) { S[(size_t)n * 16384] = (bf16)(pk2(s, 0.f) & 0xffffu); s = dec * s + u[n]; }
        }
    }
}
__device__ __forceinline__ void ret_out_item(KPC p, int l, LAS unsigned char* lds, int item, int tid, int lane, int wave) {
    const bf16* ZA = (const bf16*)(p->ws + WS_ZA); bf16* BR = (bf16*)p->out; const bf16* ST = (const bf16*)(p->ws + WS_ST);
    const int b = item / (NCH * 4), rem = item % (NCH * 4), n = rem >> 2, h = rem & 3, c = lane & 15, g4 = lane >> 4;
    const bool latent = n < 32; const int r0 = latent ? b * T + 128 * n : ML + b * CL + 128 * (n - 32);
    const float lgf = ((const float*)(p->ws + WS_LG))[l * 8 + h], lgb = ((const float*)(p->ws + WS_LG))[l * 8 + 4 + h];
    LAS unsigned char* vT = lds; LAS unsigned char* Kl = lds + 34816; LAS unsigned char* Sl = lds + 34816 + 18432;
    {   float a[8], bb[8]; ret_load_k(p, ZA, r0, h, latent, 128 * n, tid, a, bb);
        const int j = tid >> 2, q4 = tid & 3;
        *(LAS u32x4*)(Kl + j * 144 + 16 * q4) = pack8(a); *(LAS u32x4*)(Kl + j * 144 + 64 + 16 * q4) = pack8(bb);
        ret_stage_vT(ZA, r0, h, vT, tid);
        const u32x4* ssrc = (const u32x4*)(ST + (size_t)((b * 4 + h) * NCH + n) * 16384);
#pragma unroll
        for (int k = 0; k < 4; ++k) { const int q = tid + 512 * k; *(LAS u32x4*)(Sl + (q >> 4) * 272 + (q & 15) * 16) = ssrc[q]; }
    }
    __syncthreads();
    const int ii = 16 * wave + c;
    bf16x8 qf[2];
    {   const bf16* src = ZA + (size_t)(r0 + ii) * NZA + C_RQ + 64 * h + 8 * g4; float a[8], bb[8]; unpack8(*(const u32x4*)src, a); unpack8(*(const u32x4*)(src + 32), bb);
        if (latent) { const float* rc = (const float*)(p->ws + WS_ROPEC); const float* rsn = (const float*)(p->ws + WS_ROPES); const int pos = 128 * n + ii; float cs8[8], sn8[8]; ld8f(rc + pos * 32 + 8 * g4, cs8); ld8f(rsn + pos * 32 + 8 * g4, sn8);
#pragma unroll
            for (int e = 0; e < 8; ++e) { const float cs = cs8[e], sn = sn8[e]; const float x1 = a[e], x2 = bb[e]; a[e] = x1 * cs - x2 * sn; bb[e] = x1 * sn + x2 * cs; } }
        qf[0] = as_bf16x8(pack8(a)); qf[1] = as_bf16x8(pack8(bb)); }
    bf16x8 pf[4];
#pragma unroll
    for (int kk = 0; kk < 4; ++kk) {
        f32x4 sa = (f32x4){0.f, 0.f, 0.f, 0.f}, sb = (f32x4){0.f, 0.f, 0.f, 0.f};
        sa = mfma16(*(const LAS bf16x8*)(Kl + (32 * kk + c) * 144 + g4 * 16), qf[0], sa); sa = mfma16(*(const LAS bf16x8*)(Kl + (32 * kk + c) * 144 + 64 + g4 * 16), qf[1], sa);
        sb = mfma16(*(const LAS bf16x8*)(Kl + (32 * kk + 16 + c) * 144 + g4 * 16), qf[0], sb); sb = mfma16(*(const LAS bf16x8*)(Kl + (32 * kk + 16 + c) * 144 + 64 + g4 * 16), qf[1], sb);
        float pa[4], pb[4];
#pragma unroll
        for (int rr = 0; rr < 4; ++rr) { const int ja = 32 * kk + 4 * g4 + rr, jb = ja + 16; const int da = ii - ja, db = ii - jb;
            pa[rr] = sa[rr] * ((da >= 0) ? ex2((float)da * lgf) : ex2((float)(-da) * lgb)); pb[rr] = sb[rr] * ((db >= 0) ? ex2((float)db * lgf) : ex2((float)(-db) * lgb)); }
        u32x4 w; w.x = pk2(pa[0], pa[1]); w.y = pk2(pa[2], pa[3]); w.z = pk2(pb[0], pb[1]); w.w = pk2(pb[2], pb[3]); pf[kk] = as_bf16x8(w);
    }
    const float cf = ex2((float)(ii + 1) * lgf), cb = ex2((float)(128 - ii) * lgb);
    f32x4 O[8]; float s = 0.f, ss = 0.f;
#pragma unroll
    for (int et = 0; et < 8; ++et) {
        f32x4 acc = (f32x4){0.f, 0.f, 0.f, 0.f}, xf = (f32x4){0.f, 0.f, 0.f, 0.f}, xb = (f32x4){0.f, 0.f, 0.f, 0.f};
#pragma unroll
        for (int kk = 0; kk < 4; ++kk) { const u32x2 v0 = *(const LAS u32x2*)(vT + (16 * et + c) * 272 + (32 * kk + 4 * g4) * 2), v1 = *(const LAS u32x2*)(vT + (16 * et + c) * 272 + (32 * kk + 16 + 4 * g4) * 2);
            u32x4 vv; vv.x = v0.x; vv.y = v0.y; vv.z = v1.x; vv.w = v1.y; acc = mfma16(as_bf16x8(vv), pf[kk], acc); }
#pragma unroll
        for (int ks = 0; ks < 2; ++ks) { xf = mfma16(*(const LAS bf16x8*)(Sl + (16 * et + c) * 272 + (32 * ks + 8 * g4) * 2), qf[ks], xf);
            xb = mfma16(*(const LAS bf16x8*)(Sl + (16 * et + c) * 272 + (64 + 32 * ks + 8 * g4) * 2), qf[ks], xb); }
        acc = acc + xf * cf + xb * cb; O[et] = acc;
        s += (acc[0] + acc[1]) + (acc[2] + acc[3]); ss += (acc[0] * acc[0] + acc[1] * acc[1]) + (acc[2] * acc[2] + acc[3] * acc[3]);
    }
    s = sum_x16_x32(s); ss = sum_x16_x32(ss);
    const float mean = s * (1.f / 128.f), var = fmaxf(ss * (1.f / 128.f) - mean * mean, 0.f), rstd = rsq_(var + EPS);
    const bf16* gsrc = ZA + (size_t)(r0 + ii) * NZA + C_RG + 128 * h + 4 * g4; bf16* dst = BR + (size_t)(r0 + ii) * 512 + 128 * h + 4 * g4;
#pragma unroll
    for (int et = 0; et < 8; ++et) { const u32x2 gw = *(const u32x2*)(gsrc + 16 * et); const float g0 = bflo(gw.x), g1 = bfhi(gw.x), g2 = bflo(gw.y), g3 = bfhi(gw.y);
        const float o0 = (O[et][0] - mean) * rstd * g0 * sigmoidf_(g0), o1 = (O[et][1] - mean) * rstd * g1 * sigmoidf_(g1), o2 = (O[et][2] - mean) * rstd * g2 * sigmoidf_(g2), o3 = (O[et][3] - mean) * rstd * g3 * sigmoidf_(g3);
        u32x2 w; w.x = pk2(o0, o1); w.y = pk2(o2, o3); *(u32x2*)(dst + 16 * et) = w; }
    __syncthreads();
}

__device__ __forceinline__ int wr_off(int k) { return k * 64 + (k >> 2) * 16; }
__device__ __forceinline__ void phase_norm2(KPC p, int l, LAS unsigned char* lds, int tid, int lane, int wave, int bid, int G) {
    if (l == 1 || G != 256) { convert_experts(p, l, 0, CVT_ITEMS, bid * 8 + wave, G * 8, lds, lane, wave); __syncthreads(); }
    LAS unsigned char* wrl = lds + 69632;
    for (int i = tid; i < 1024 * 4; i += 512) { const int k = i >> 2, q = i & 3; *(LAS f32x4*)(wrl + wr_off(k) + 16 * q) = *(const f32x4*)(p->w_router + (size_t)l * 16384 + k * 16 + 4 * q); }
    __syncthreads();
    const float* modv = (const float*)(p->ws + WS_MODV) + l * 9 * 6144; const bf16* X = (const bf16*)(p->ws + WS_X); bf16* H = (bf16*)(p->ws + WS_H);
    float* AFF = (float*)(p->ws + WS_AFF); float* AFFC = (float*)(p->ws + WS_AFFC); int* INV = (int*)(p->ws + WS_INV);
    const int rows = (l == 0) ? M : ML, stride = G * 8;
    {
    int r = bid * 8 + wave;
    u32x2 vn[4];
#pragma unroll
    for (int j = 0; j < 4; ++j) vn[j] = (r < rows) ? *(const u32x2*)(X + (size_t)r * 1024 + 4 * lane + 256 * j) : (u32x2){0u, 0u};
    for (; r < rows; r += stride) {
        const int bi = (r < ML) ? (r >> 12) : 8; const float* mv = modv + bi * 6144;
        f32x4 v[4], h[4], g[4], sc[4], sh[4];
#pragma unroll
        for (int j = 0; j < 4; ++j) { v[j] = (f32x4){bflo(vn[j].x), bfhi(vn[j].x), bflo(vn[j].y), bfhi(vn[j].y)}; const int col = 4 * lane + 256 * j; g[j] = *(const f32x4*)(p->norm2_g + l * 1024 + col); sh[j] = *(const f32x4*)(mv + 3 * 1024 + col); sc[j] = *(const f32x4*)(mv + 4 * 1024 + col); }
        const int rn = r + stride;
        if (rn < rows) {
#pragma unroll
            for (int j = 0; j < 4; ++j) vn[j] = *(const u32x2*)(X + (size_t)rn * 1024 + 4 * lane + 256 * j); }
        const float rs = row_rs(v);
#pragma unroll
        for (int j = 0; j < 4; ++j) h[j] = (v[j] * rs) * g[j] * (sc[j] + 1.0f) + sh[j];
        store_h(h, H + (size_t)r * 1024, lane);
        float lg[16];
#pragma unroll
        for (int e = 0; e < 16; ++e) lg[e] = 0.f;
#pragma unroll
        for (int j = 0; j < 4; ++j)
#pragma unroll
            for (int i = 0; i < 4; ++i) { const int k = 4 * lane + 256 * j + i; const float hv = h[j][i]; const LAS f32x4* wp = (const LAS f32x4*)(wrl + wr_off(k));
#pragma unroll
                for (int q = 0; q < 4; ++q) { const f32x4 w = wp[q]; lg[4 * q] += hv * w.x; lg[4 * q + 1] += hv * w.y; lg[4 * q + 2] += hv * w.z; lg[4 * q + 3] += hv * w.w; } }
        float mx = -1e30f;
#pragma unroll
        for (int e = 0; e < 16; ++e) { lg[e] = wave_sum(lg[e]); mx = fmaxf(mx, lg[e]); }
        float sum = 0.f;
#pragma unroll
        for (int e = 0; e < 16; ++e) { lg[e] = ex2((lg[e] - mx) * LOG2E); sum += lg[e]; }
        const float isum = rcp_(sum); float mine = 0.f;
#pragma unroll
        for (int e = 0; e < 16; ++e) mine = (lane == e) ? lg[e] * isum : mine;
        if (lane < 16) { if (r < ML) AFF[((size_t)(bi * 16 + lane) << 12) + (r & 4095)] = mine; else AFFC[((r - ML) >> 8) * 4096 + lane * 256 + ((r - ML) & 255)] = mine;
            INV[(size_t)r * 16 + lane] = -1; }
    }
    }
}

__device__ __forceinline__ int block_sum_i(int v, LAS int* red, int buf, int lane, int wave) {
    v = wave_sum_i(v);
    if (lane == 0) red[buf * 8 + wave] = v;
    __syncthreads();
    int s = 0;
#pragma unroll
    for (int w = 0; w < 8; ++w) s += red[buf * 8 + w];
    return s;
}
__device__ __forceinline__ int block_excl_scan(int v, LAS int* red, int buf, int lane, int wave) {
    int inc = v;
#pragma unroll
    for (int o = 1; o < 64; o <<= 1) { const int t = __builtin_amdgcn_ds_bpermute((lane - o) << 2, inc); if (lane >= o) inc += t; }
    if (lane == 63) red[buf * 8 + wave] = inc;
    __syncthreads();
    int base = 0;
#pragma unroll
    for (int w = 0; w < 8; ++w) { const int x = red[buf * 8 + w]; if (w < wave) base += x; }
    return base + inc - v;
}
template <int KPT>
__device__ __forceinline__ void topk_item(KPC p, const float* aff, int n, int cap, int rowbase, int e, int slotbase, int s_lo, int s_hi, bool writer, LAS unsigned char* lds, int tid, int lane, int wave) {
    const bf16* H = (const bf16*)(p->ws + WS_H); bf16* XS = (bf16*)(p->ws + WS_XS); float* topw = (float*)(p->ws + WS_TOPW); int* INV = (int*)(p->ws + WS_INV);
    LAS int* red = (LAS int*)lds; LAS int* rl = (LAS int*)(lds + 128);
    unsigned key[KPT]; const bool valid = tid * KPT < n;
#pragma unroll
    for (int j = 0; j < KPT; ++j) key[j] = valid ? __float_as_uint(aff[tid * KPT + j]) : 0u;
    unsigned Tsel = 0u;
    for (int bit = 30; bit >= 0; --bit) { const unsigned cand = Tsel | (1u << bit); int cnt = 0;
#pragma unroll
        for (int j = 0; j < KPT; ++j) cnt += (valid && key[j] >= cand) ? 1 : 0;
        if (block_sum_i(cnt, red, bit & 1, lane, wave) >= cap) Tsel = cand; }
    int cgt = 0, ceq = 0;
#pragma unroll
    for (int j = 0; j < KPT; ++j) { cgt += (valid && key[j] > Tsel) ? 1 : 0; ceq += (valid && key[j] == Tsel) ? 1 : 0; }
    const int need = cap - block_sum_i(cgt, red, 1, lane, wave);
    int er = block_excl_scan(ceq, red, 2, lane, wave);
    bool sel[KPT]; int nsel = 0;
#pragma unroll
    for (int j = 0; j < KPT; ++j) { const bool iseq = valid && key[j] == Tsel; sel[j] = valid && (key[j] > Tsel || (iseq && er < need)); er += iseq ? 1 : 0; nsel += sel[j] ? 1 : 0; }
    int slot = block_excl_scan(nsel, red, 3, lane, wave);
#pragma unroll
    for (int j = 0; j < KPT; ++j) if (sel[j]) { const int t = tid * KPT + j; if (slot < cap) { rl[slot] = t; if (writer) { topw[e * ME + slotbase + slot] = __uint_as_float(key[j]); INV[(size_t)(rowbase + t) * 16 + e] = slotbase + slot; } } ++slot; }
    __syncthreads();
    for (int s = s_lo + wave * 4; s < s_hi; s += 32) {
        u32x4 a[4][2];
#pragma unroll
        for (int q = 0; q < 4; ++q) { const int t = rl[s + q]; const u32x4* src = (const u32x4*)(H + (size_t)(rowbase + t) * 1024); a[q][0] = src[lane]; a[q][1] = src[lane + 64]; }
#pragma unroll
        for (int q = 0; q < 4; ++q) { u32x4* dst = (u32x4*)(XS + ((size_t)e * ME + slotbase + s + q) * 1024); dst[lane] = a[q][0]; dst[lane + 64] = a[q][1]; }
    }
    __syncthreads();
}
__device__ __forceinline__ void phase_topk(KPC p, int l, LAS unsigned char* lds, int tid, int lane, int wave, int bid, int G) {
    const float* AFF = (const float*)(p->ws + WS_AFF); const float* AFFC = (const float*)(p->ws + WS_AFFC);
    const int nitem = (l == 0) ? 384 : 256;
    for (int it = bid; it < nitem; it += G) {
        if (it < 256) { const int q = it >> 1, hf = it & 1, b = q >> 4, e = q & 15; topk_item<8>(p, AFF + ((size_t)(b * 16 + e) << 12), 4096, CAPL, b * T, e, b * CAPL, hf * 256, hf * 256 + 256, hf == 0, lds, tid, lane, wave); }
        else { const int q = it - 256, b = q >> 4, e = q & 15; topk_item<1>(p, AFFC + (b * 16 + e) * 256, 256, CAPC, ML + b * CL, e, NB * CAPL + b * CAPC, 0, CAPC, true, lds, tid, lane, wave); }
    }
}

__device__ __forceinline__ void phase_combine(KPC p, int l, LAS unsigned char* lds, int tid, int lane, int wave, int bid, int G) {
    const float* modv = (const float*)(p->ws + WS_MODV); bf16* X = (bf16*)(p->ws + WS_X); bf16* H = (bf16*)(p->ws + WS_H);
    const bf16* Y = (const bf16*)(p->ws + WS_XS); const int* INV = (const int*)(p->ws + WS_INV);
    const int rows = (l == 0) ? M : ML, stride = G * 8;
    int r = bid * 8 + wave;
    int slot_next = (lane < 16 && r < rows) ? INV[(size_t)r * 16 + lane] : -1;
    u32x2 vn[4];
#pragma unroll
    for (int j = 0; j < 4; ++j) vn[j] = (r < rows) ? *(const u32x2*)(X + (size_t)r * 1024 + 4 * lane + 256 * j) : (u32x2){0u, 0u};
    for (; r < rows; r += stride) {
        const int bi = (r < ML) ? (r >> 12) : 8;
        const int myslot = slot_next; const int rn = r + stride;
        slot_next = (lane < 16 && rn < rows) ? INV[(size_t)rn * 16 + lane] : -1;
        f32x4 v[4], acc[4], g2v[4];
        const float* g2 = modv + (l * 9 + bi) * 6144 + 5 * 1024;
#pragma unroll
        for (int j = 0; j < 4; ++j) { v[j] = (f32x4){bflo(vn[j].x), bfhi(vn[j].x), bflo(vn[j].y), bfhi(vn[j].y)}; acc[j] = (f32x4){0.f, 0.f, 0.f, 0.f}; g2v[j] = *(const f32x4*)(g2 + 4 * lane + 256 * j); }
        unsigned mask = (unsigned)(__builtin_amdgcn_ballot_w64(myslot >= 0) & 0xffffull);
        bool first = true;
        while (mask || first) {
          if (mask) {
            const int e0 = __builtin_ctz(mask); mask &= mask - 1u; const int s0 = __builtin_amdgcn_readlane(myslot, e0);
            const bool has1 = mask != 0u; const int e1 = has1 ? __builtin_ctz(mask) : e0; if (has1) mask &= mask - 1u; const int s1 = __builtin_amdgcn_readlane(myslot, e1);
            const bf16* ya = Y + ((size_t)e0 * ME + s0) * 1024; const bf16* yb = Y + ((size_t)e1 * ME + s1) * 1024;
            u32x2 wa[4], wb[4];
#pragma unroll
            for (int j = 0; j < 4; ++j) wa[j] = *(const u32x2*)(ya + 4 * lane + 256 * j);
#pragma unroll
            for (int j = 0; j < 4; ++j) wb[j] = *(const u32x2*)(yb + 4 * lane + 256 * j);
            if (first && rn < rows) {
#pragma unroll
                for (int j = 0; j < 4; ++j) vn[j] = *(const u32x2*)(X + (size_t)rn * 1024 + 4 * lane + 256 * j); }
            first = false;
            const float kb = has1 ? 1.0f : 0.0f;
#pragma unroll
            for (int j = 0; j < 4; ++j) { acc[j] += (f32x4){bflo(wa[j].x), bfhi(wa[j].x), bflo(wa[j].y), bfhi(wa[j].y)}; acc[j] += (f32x4){bflo(wb[j].x), bfhi(wb[j].x), bflo(wb[j].y), bfhi(wb[j].y)} * kb; }
          } else {
            if (rn < rows) {
#pragma unroll
                for (int j = 0; j < 4; ++j) vn[j] = *(const u32x2*)(X + (size_t)rn * 1024 + 4 * lane + 256 * j); }
            first = false;
          }
        }
#pragma unroll
        for (int j = 0; j < 4; ++j) v[j] = v[j] + g2v[j] * acc[j];
        if (l == 0) {
#pragma unroll
            for (int j = 0; j < 4; ++j) { u32x2 w; w.x = pk2(v[j].x, v[j].y); w.y = pk2(v[j].z, v[j].w); *(u32x2*)(X + (size_t)r * 1024 + 4 * lane + 256 * j) = w; }
            const float rs = row_rs(v); f32x4 h[4];
            norm_mod(v, rs, p->norm1_g + 1024, modv + (9 + bi) * 6144, modv + (9 + bi) * 6144 + 1024, h, lane);
            store_h(h, H + (size_t)r * 1024, lane);
        } else {
#pragma unroll
            for (int j = 0; j < 4; ++j) *(f32x4*)(p->out + (size_t)r * 1024 + 4 * lane + 256 * j) = v[j];
        }
    }
    if (l == 0) convert_small(p, 1, lds, lane, wave, bid, G);
}

#define XB_TMO      128
#define XB_XCNT(j)  (256  + 64 * (j))
#define XB_XSUB(j)  (1280 + 64 * (j))
#define XB_XGEN(j)  (2304 + 64 * (j))
#define XB_TOP      3328
#define XB_TOPGEN   3392
#define XCD_BAR_WORDS 3456
#define XB_SPIN_CAP (1u << 18)

__device__ __forceinline__ unsigned xb_ld(unsigned* p)              { return __hip_atomic_load(p, __ATOMIC_RELAXED, __HIP_MEMORY_SCOPE_AGENT); }
__device__ __forceinline__ unsigned xb_add(unsigned* p, unsigned v) { return __hip_atomic_fetch_add(p, v, __ATOMIC_RELAXED, __HIP_MEMORY_SCOPE_AGENT); }
__device__ __forceinline__ unsigned xb_xcc_id() { return (unsigned)__builtin_amdgcn_s_getreg((3 << 11) | 20) & 0xFu; }
#define XB_SPIN(cond, bar) do { unsigned _sp = 0; while (cond) { __builtin_amdgcn_s_sleep(1); \
    if ((++_sp & 255u) == 0u) { if (xb_ld(&(bar)[XB_TMO])) break; if (_sp > XB_SPIN_CAP) { atomicAdd(&(bar)[XB_TMO], 1u); break; } } } } while (0)

struct XcdBarrier {
    unsigned* bar; unsigned x;
    volatile LAS unsigned* st;
};

__device__ __forceinline__ XcdBarrier xcd_barrier_post(unsigned* bar, volatile LAS unsigned* st) {
    XcdBarrier b; b.bar = bar; b.x = xb_xcc_id(); b.st = st;
    if (threadIdx.x == 0) (void)xb_add(&bar[XB_XCNT(b.x)], 1u);
    return b;
}
__device__ __forceinline__ void xcd_barrier_complete(unsigned* bar, unsigned x, unsigned& nloc, unsigned& nx) {
    const unsigned G = gridDim.x * gridDim.y * gridDim.z;
    unsigned sum, cnt, mine, sp = 0u;
    for (;;) {
        sum = 0u; cnt = 0u; mine = 0u;
#pragma unroll
        for (unsigned j = 0; j < 16; ++j) { const unsigned c = xb_ld(&bar[XB_XCNT(j)]); sum += c; cnt += (c > 0u) ? 1u : 0u; mine = (j == x) ? c : mine; }
        if (sum == G) break;
        __builtin_amdgcn_s_sleep(1);
        if ((++sp & 255u) == 0u) { if (xb_ld(&bar[XB_TMO])) break; if (sp > XB_SPIN_CAP) { atomicAdd(&bar[XB_TMO], 1u); break; } }
    }
    nloc = mine > 0u ? mine : 1u; nx = cnt > 0u ? cnt : 1u;
}

__device__ __forceinline__ void xcd_barrier(const XcdBarrier& b) {
    asm volatile("s_waitcnt vmcnt(0)" ::: "memory");
    __syncthreads();
    if (threadIdx.x == 0) {
        unsigned* bar = b.bar;
        __builtin_amdgcn_s_waitcnt(0);
        unsigned nloc = b.st[0], nx = b.st[1];
        if (nloc == 0u) { xcd_barrier_complete(bar, b.x, nloc, nx); b.st[0] = nloc; b.st[1] = nx; }
        const unsigned old = xb_add(&bar[XB_XSUB(b.x)], 1u);
        const unsigned gen = old / nloc;
        if (old + 1u == (gen + 1u) * nloc) {
            __builtin_amdgcn_fence(__ATOMIC_RELEASE, "agent");
            asm volatile("s_waitcnt vmcnt(0)" ::: "memory");
            const unsigned og = xb_add(&bar[XB_TOP], 1u);
            const unsigned tg = og / nx;
            if (og + 1u == (tg + 1u) * nx) xb_add(&bar[XB_TOPGEN], 1u);
            else XB_SPIN(xb_ld(&bar[XB_TOPGEN]) == tg, bar);
            __builtin_amdgcn_fence(__ATOMIC_ACQUIRE, "agent");
            xb_add(&bar[XB_XGEN(b.x)], 1u);
            asm volatile("s_waitcnt vmcnt(0)" ::: "memory");
        } else {
            XB_SPIN(xb_ld(&bar[XB_XGEN(b.x)]) == gen, bar);
            __builtin_amdgcn_fence(__ATOMIC_ACQUIRE, "agent");
            asm volatile("s_waitcnt vmcnt(0)" ::: "memory");
        }
    }
    __syncthreads();
}

#define KPP() ({ KPC q_ = kp_; asm volatile("" : "+s"(q_)); q_; })
__global__ void __launch_bounds__(512, 2) mk_fwd(KP p_unused) {
    extern __shared__ __attribute__((aligned(16))) unsigned char lds_raw[];
    LAS unsigned char* lds = (LAS unsigned char*)lds_raw;
    cg::grid_group grid = cg::this_grid();
    const int bid = blockIdx.x, G = gridDim.x;
#define IDS() int tid = threadIdx.x; asm volatile("" : "+v"(tid)); const int lane = tid & 63, wave = __builtin_amdgcn_readfirstlane(tid >> 6); (void)lane; (void)wave
    const KPC kp_ = (KPC)__builtin_amdgcn_kernarg_segment_ptr();
    volatile LAS unsigned* bst = (volatile LAS unsigned*)(lds + 147392);
    if (threadIdx.x < 16) bst[threadIdx.x] = 0u;
    __syncthreads();
    (void)xcd_barrier_post((unsigned*)KPP()->ws, bst);
#define GSYNC() do { XcdBarrier b_; b_.bar = (unsigned*)KPP()->ws; b_.x = xb_xcc_id(); b_.st = bst; xcd_barrier(b_); } while (0)

    { IDS(); phase_prep(KPP(), lds, tid, lane, wave, bid, G); }
    if (G == 0x7fffffff) grid.sync();
    GSYNC();
    { IDS(); phase_norm_in(KPP(), lane, wave, bid, G); }
    GSYNC();
#pragma unroll 1
    for (int l = 0; l < 2; ++l) {
        {
            unsigned char* ws = KPP()->ws;
            pg8::Gemm g{(const pg8::bf16_t*)(ws + WS_H), (const pg8::bf16_t*)(ws + WS_WTIN), M, NZA, 1024}; GroupOrder S{1, M / 256, NZA / 256, 0, 0, G, bid};
            EpiZA E{(bf16*)(ws + WS_ZA)};
            pg8::gemm_phase<EpiZA, GroupOrder, true, true>(lds, g, S, E);
        }
        GSYNC();
        {
            KPC p = KPP(); IDS();
            float mq = fabsf(p->qn_g[l * 64 + lane]), mk = fabsf(p->kn_g[l * 64 + lane]);
            mq = wave_max(mq); mk = wave_max(mk);
            const float Mb2 = 8.0f * mq * mk * LOG2E;
            const int natt = (l == 0) ? 544 : 512, nupd = NB * NCH * 4, nvp = (l == 0) ? (M / 128) : (ML / 128);
            for (int it = bid; it < natt + nupd + nvp; it += G) {
                if (it < natt) { att_item(p, l, lds, it, Mb2, tid, lane, wave); }
                else if (it < natt + nupd) { ret_upd_item(p, l, lds, it - natt, tid, lane, wave); }
                else { sgu_vprep_item(p, it - natt - nupd, tid); }
            }
        }
        GSYNC();
        { IDS(); phase_scan(KPP(), l, tid, bid, G); }
        GSYNC();
        {   KPC p = KPP(); IDS(); const int nch = (l == 0) ? NCH : 32;
            const int nro = NB * nch * 4, nsgu = ((l == 0) ? (M / 128) : (ML / 128)) * 4;
            for (int it = bid; it < nro + nsgu; it += G) {
                if (it < nro) { const int b = it / (nch * 4), rem = it % (nch * 4); ret_out_item(p, l, lds, b * (NCH * 4) + rem, tid, lane, wave); }
                else sgu_item(p, l, lds, it - nro, tid, lane, wave);
            }
        }
        GSYNC();
        const int Mrows = (l == 0) ? M : ML;
        {
            unsigned char* ws = KPP()->ws;
            pg8::Gemm g{(const pg8::bf16_t*)(ws + WS_H), (const pg8::bf16_t*)(ws + WS_WTIN) + (size_t)NZA * 1024, Mrows, NZG, 1024}; GroupOrder S{1, Mrows / 256, NZG / 256, 0, 0, G, bid};
            EpiSig E{(bf16*)(ws + WS_G)};
            pg8::gemm_phase<EpiSig, GroupOrder, true, true>(lds, g, S, E);
            if (l == 0 && G == 256 && bid >= CVT_G_IDLE0) { IDS(); convert_experts(KPP(), 0, 0, CVT_G_HI, (bid - CVT_G_IDLE0) * 8 + wave, (256 - CVT_G_IDLE0) * 8, lds, lane, wave); }
        }
        GSYNC();
        {
            KPC p = KPP(); unsigned char* ws = p->ws;
            pg8::Gemm g{(const pg8::bf16_t*)p->out, (const pg8::bf16_t*)(ws + WS_WTBR), 3 * M, 3072, 512}; MergeOrder S{Mrows / 256, G, bid};
            EpiMergeChain E{(const bf16*)(ws + WS_G), (bf16*)(ws + WS_H)};
            pg8::gemm_phase<EpiMergeChain, MergeOrder, true, true>(lds, g, S, E);
            if (l == 0 && G == 256 && bid >= CVT_M_IDLE0) { IDS(); convert_experts(KPP(), 0, CVT_G_HI, CVT_M_HI, (bid - CVT_M_IDLE0) * 8 + wave, (256 - CVT_M_IDLE0) * 8, lds, lane, wave); }
        }
        GSYNC();
        {
            KPC p = KPP(); unsigned char* ws = p->ws;
            pg8::Gemm g{(const pg8::bf16_t*)(ws + WS_H), (const pg8::bf16_t*)(ws + WS_WTOUT), Mrows, 1024, 1024}; GroupOrder S{1, Mrows / 256, 4, 0, 0, G, bid};
            EpiOut E{p->x, p->ctx, (bf16*)(ws + WS_X), (const float*)(ws + WS_MODV) + l * 9 * 6144, (l == 0) ? 1 : 0};
            pg8::gemm_phase<EpiOut, GroupOrder, true, true>(lds, g, S, E);
            if (l == 0 && G == 256 && bid >= CVT_O_IDLE0) { IDS(); convert_experts(KPP(), 0, CVT_M_HI, CVT_ITEMS, (bid - CVT_O_IDLE0) * 8 + wave, (256 - CVT_O_IDLE0) * 8, lds, lane, wave); }
        }
        GSYNC();
        { IDS(); phase_norm2(KPP(), l, lds, tid, lane, wave, bid, G); }
        GSYNC();
        { IDS(); phase_topk(KPP(), l, lds, tid, lane, wave, bid, G); }
        GSYNC();
        {
            unsigned char* ws = KPP()->ws;
            pg8::Gemm g{(const pg8::bf16_t*)(ws + WS_XS), (const pg8::bf16_t*)(ws + WS_WT1), NE * ME, NE * 2048, 1024}; GroupOrder S{NE, (l == 0) ? 17 : 16, 8, 17, 8, G, bid};
            EpiMoe1 E{(bf16*)(ws + WS_ACT)};
            pg8::gemm_phase<EpiMoe1, GroupOrder, true, true>(lds, g, S, E);
        }
        GSYNC();
        {
            unsigned char* ws = KPP()->ws;
            pg8::Gemm g{(const pg8::bf16_t*)(ws + WS_ACT), (const pg8::bf16_t*)(ws + WS_WT2), NE * ME, NE * 1024, 1024}; GroupOrder S{NE, (l == 0) ? 17 : 16, 4, 17, 4, G, bid};
            EpiMoe2 E{(bf16*)(ws + WS_XS), (const float*)(ws + WS_TOPW)};
            pg8::gemm_phase<EpiMoe2, GroupOrder, true, true>(lds, g, S, E);
        }
        GSYNC();
        { IDS(); phase_combine(KPP(), l, lds, tid, lane, wave, bid, G); }
        if (l == 0) GSYNC();
    }
}

extern "C" void kernel_launch(void* const* d_in, const int* in_sizes, int n_in, void* d_out, int out_size, void* d_ws, size_t ws_size, hipStream_t stream) {
    static int grid = 0;
    if (grid == 0) {
        if (n_in != 22 || out_size != ML * D || ws_size < WS_END) { fprintf(stderr, "kernel_launch: unexpected shapes (n_in %d out %d ws %zu, need %zu)\n", n_in, out_size, ws_size, (size_t)WS_END); grid = -1; return; }
        int dev = 0, cus = 0, per_cu = 0;
        if (hipGetDevice(&dev) != hipSuccess || hipDeviceGetAttribute(&cus, hipDeviceAttributeMultiprocessorCount, dev) != hipSuccess) { grid = -1; return; }
        if (hipFuncSetAttribute((const void*)mk_fwd, hipFuncAttributeMaxDynamicSharedMemorySize, LDS_BYTES) != hipSuccess) { fprintf(stderr, "kernel_launch: hipFuncSetAttribute failed\n"); grid = -1; return; }
        if (hipOccupancyMaxActiveBlocksPerMultiprocessor(&per_cu, (const void*)mk_fwd, 512, LDS_BYTES) != hipSuccess || per_cu < 1) { fprintf(stderr, "kernel_launch: occupancy query says %d\n", per_cu); (void)hipGetLastError(); }
        grid = cus;
        fprintf(stderr, "kernel_launch: grid %d, occupancy %d/CU, ws %zu\n", grid, per_cu, ws_size);
    }
    if (grid < 0) return;
    if (hipMemsetAsync(d_ws, 0, 16384, stream) != hipSuccess) { fprintf(stderr, "kernel_launch: memset failed\n"); return; }
    KP hp{};
    const float** f = (const float**)&hp;
    for (int i = 0; i < 22; ++i) f[i] = (const float*)d_in[i];
    hp.out = (float*)d_out; hp.ws = (unsigned char*)d_ws;
    void* args[] = {&hp};
    hipError_t e = hipLaunchCooperativeKernel((const void*)mk_fwd, dim3(grid), dim3(512), args, LDS_BYTES, stream);
    if (e != hipSuccess) fprintf(stderr, "kernel_launch: cooperative launch failed: %s\n", hipGetErrorString(e));
}
```

```cpp
#include <hip/hip_runtime.h>
#include <hip/hip_cooperative_groups.h>
#include <cstdio>
#include <cstdint>
namespace cg = cooperative_groups;
namespace pg8 {
#define PG8_LAS __attribute__((address_space(3)))
typedef unsigned short bf16_t;
typedef short bf16x8 __attribute__((ext_vector_type(8)));
typedef float f32x4 __attribute__((ext_vector_type(4)));
typedef unsigned u32x4 __attribute__((ext_vector_type(4)));
constexpr int BM = 256, BK = 64, HALF = 128, HTB = HALF * BK * 2  , STAGE_BYTES = 8 * HTB, NXCD = 8, WGM = 8;

__host__ __device__ __forceinline__ int lds_byte(int r, int c) { const int st = (r >> 4) * 2 + (c >> 5), rr = r & 15, cc = c & 31, ob = rr * 64 + cc * 2; return st * 1024 + (ob ^ (((ob >> 9) & 1) << 5)); }
__host__ __device__ __forceinline__ void stage_rc(int b, int& R, int& C) { const int st = b / 1024, sb = b % 1024, swz = sb ^ (((sb >> 9) & 1) << 5); R = (st >> 1) * 16 + swz / 64; C = (st & 1) * 32 + (swz % 64) / 2; }
__host__ __device__ __forceinline__ int perm32(int rho) { const int n = rho >> 4, i = rho & 15; return 8 * (i >> 2) + 4 * n + (i & 3); }

struct Unit { int pm, pn; };
struct Gemm { const bf16_t* A; const bf16_t* Bt; int M, N, K; };

struct StaticOrder {
    int nM, nN, nwg, G, c;
    __host__ __device__ void init(int M, int N, int G_, int c_) { nM = M / BM; nN = N / BM; nwg = nM * nN; G = G_; c = c_; }
    __host__ __device__ bool next(int i, Unit& u) const {
        const long L = (long)i * G + c; if (L >= nwg) return false;
        int wgid = (int)L; { const int q = nwg / NXCD, r = nwg % NXCD, xcd = wgid % NXCD, off = wgid / NXCD; wgid = (xcd < r ? xcd * (q + 1) : r * (q + 1) + (xcd - r) * q) + off; }
        const int nig = WGM * nN, gid = wgid / nig, fm = gid * WGM, gsz = (nM - fm) < WGM ? (nM - fm) : WGM;
        u.pm = fm + ((wgid % nig) % gsz); u.pn = (wgid % nig) / gsz; return true;
    }
    __device__ __forceinline__ void a_ready(const Unit&) const {}
    __device__ __forceinline__ void done(const Unit&) const {}
};

__device__ __forceinline__ unsigned cvt_pk_bf16(float lo, float hi) { unsigned r; asm volatile("v_cvt_pk_bf16_f32 %0, %1, %2" : "=v"(r) : "v"(lo), "v"(hi)); return r; }
typedef float f32x2 __attribute__((ext_vector_type(2)));
__device__ __forceinline__ f32x2 gelu_pk(f32x2 v) {
    const f32x2 av = __builtin_elementwise_abs(v), d = av * 0.2316418882f + 1.0f;
    f32x2 t; t.x = __builtin_amdgcn_rcpf(d.x); t.y = __builtin_amdgcn_rcpf(d.y);
    f32x2 q = t * 0.5307027145f + (-0.7265760135f); q = q * t + 0.7107068705f; q = q * t + (-0.142248368f); q = q * t + 0.127414796f; q = q * t;
    const f32x2 s = (v * v) * (-0.72134752044f);
    f32x2 e; e.x = __builtin_amdgcn_exp2f(s.x); e.y = __builtin_amdgcn_exp2f(s.y);
    const f32x2 m = v * (q * e), r = v - m;
    f32x2 o; o.x = v.x < 0.f ? m.x : r.x; o.y = v.y < 0.f ? m.y : r.y; return o;
}

template <int ACT  > struct EpiBf16 {
    static constexpr bool PERM = true, AFTER_DRAIN = false, CHAIN = false; static_assert(ACT == 0 || ACT == 1, "EpiBf16: ACT is 0 (none) or 1 (gelu_pk)");
    bf16_t* O; int ldc; const float* bias; int split_cols; size_t split_stride; float scale0;
    __device__ __forceinline__ void operator()(const f32x4 (&acc)[2][2][4][2], const Unit& u, int wr, int wc, int fr, int fq) const {
        const int row0 = u.pm * BM + wr * 64 + fr; int colt = u.pn * BM; bf16_t* base = O;
        float sc = 1.f; if (split_cols) { const int t = colt / split_cols; base += (size_t)t * split_stride; colt -= t * split_cols; if (t == 0) sc = scale0; }
        const int col0 = colt + wc * 32 + 8 * fq, bcol0 = u.pn * BM + wc * 32 + 8 * fq;
        f32x4 bv[2][2];
#pragma unroll
        for (int bj = 0; bj < 2; ++bj)
#pragma unroll
            for (int n = 0; n < 2; ++n) bv[bj][n] = bias ? *(const f32x4*)(bias + bcol0 + bj * HALF + 4 * n) : (f32x4){0.f, 0.f, 0.f, 0.f};
#pragma unroll
        for (int ai = 0; ai < 2; ++ai)
#pragma unroll
            for (int m = 0; m < 4; ++m) { bf16_t* rowp = base + (size_t)(row0 + ai * HALF + m * 16) * ldc + col0;
#pragma unroll
                for (int bj = 0; bj < 2; ++bj) { f32x4 v0 = acc[ai][bj][m][0] + bv[bj][0], v1 = acc[ai][bj][m][1] + bv[bj][1];
                    if (ACT == 1) { f32x2 a = gelu_pk((f32x2){v0[0], v0[1]}), b = gelu_pk((f32x2){v0[2], v0[3]}), c = gelu_pk((f32x2){v1[0], v1[1]}), d = gelu_pk((f32x2){v1[2], v1[3]});
                        v0 = (f32x4){a.x, a.y, b.x, b.y}; v1 = (f32x4){c.x, c.y, d.x, d.y}; }
                    v0 = v0 * sc; v1 = v1 * sc; u32x4 w; w.x = cvt_pk_bf16(v0[0], v0[1]); w.y = cvt_pk_bf16(v0[2], v0[3]); w.z = cvt_pk_bf16(v1[0], v1[1]); w.w = cvt_pk_bf16(v1[2], v1[3]);
                    *(u32x4*)(rowp + bj * HALF) = w; } }
    }
};
template <class Epi, class Sched, bool ALIGN_EPI = false, bool SP2 = false>
__device__ __forceinline__ void gemm_phase(PG8_LAS unsigned char* lds, const Gemm g, const Sched& S, const Epi& E) {
    int tid_ = threadIdx.x; asm volatile("" : "+v"(tid_));
    const int tid = tid_, wid = __builtin_amdgcn_readfirstlane(tid >> 6), lane = tid & 63, wr = wid >> 2, wc = wid & 3, fr = lane & 15, fq = lane >> 4;
    const int K = g.K, nt = K / BK;
    unsigned voffA[2], voffB[2];
#pragma unroll
    for (int i = 0; i < 2; ++i) { int R, C; stage_rc(tid * 16 + i * 8192, R, C); const int Rb = Epi::PERM ? ((R & ~31) + perm32(R & 31)) : R;
        voffA[i] = (unsigned)(R * K + C) * 2u; voffB[i] = (unsigned)(Rb * K + C) * 2u; }
    const size_t kstep = (size_t)(BK * 2);
    const size_t hstep = (size_t)HALF * K * 2;
    const size_t tstep = 2 * hstep;
    const unsigned ldsw = (unsigned)wid * 1024u;
    const int aoff = lds_byte(wr * 64 + fr, fq * 8), boff = lds_byte(wc * 32 + fr, fq * 8);
#define PG8_SA(b, h) (((b) * 2 + (h)) * HTB)
#define PG8_SB(b, h) ((4 + (b) * 2 + (h)) * HTB)
#define PG8_STAGE(bufoff, gbase, voff) do { _Pragma("unroll") for (int _i = 0; _i < 2; ++_i) \
        __builtin_amdgcn_global_load_lds((const unsigned*)((const char*)(gbase) + (voff)[_i]), (PG8_LAS unsigned*)(lds + (bufoff) + ldsw + _i * 8192), 16, 0, 0); } while (0)
#define PG8_LDA(dst, b, h) do { _Pragma("unroll") for (int m = 0; m < 4; ++m) _Pragma("unroll") for (int k = 0; k < 2; ++k) dst[m][k] = *(const PG8_LAS bf16x8*)(lds + PG8_SA(b, h) + aoff + m * 2048 + k * 1024); } while (0)
#define PG8_LDB(dst, b, h) do { _Pragma("unroll") for (int n = 0; n < 2; ++n) _Pragma("unroll") for (int k = 0; k < 2; ++k) dst[n][k] = *(const PG8_LAS bf16x8*)(lds + PG8_SB(b, h) + boff + n * 2048 + k * 1024); } while (0)
#define PG8_MMA(ai, bj, At, Bt) do { __builtin_amdgcn_s_setprio(1); _Pragma("unroll") for (int m = 0; m < 4; ++m) _Pragma("unroll") for (int n = 0; n < 2; ++n) _Pragma("unroll") for (int k = 0; k < 2; ++k) \
        acc[ai][bj][m][n] = __builtin_amdgcn_mfma_f32_16x16x32_bf16(Bt[n][k], At[m][k], acc[ai][bj][m][n], 0, 0, 0); __builtin_amdgcn_s_setprio(0); } while (0)
#define PG8_WAIT_V(n) asm volatile("s_waitcnt vmcnt(" #n ")" ::: "memory")
#define PG8_WAIT_L(n) asm volatile("s_waitcnt lgkmcnt(" #n ")" ::: "memory")
#define PG8_BAR __builtin_amdgcn_s_barrier()
#define PG8_SCHED __builtin_amdgcn_sched_barrier(0)
    Unit cur, nxt; int ui = 0;
    if (!S.next(0, cur)) return;
    f32x4 acc[2][2][4][2];
#pragma unroll
    for (int a = 0; a < 2; ++a)
#pragma unroll
        for (int b = 0; b < 2; ++b)
#pragma unroll
            for (int m = 0; m < 4; ++m)
#pragma unroll
                for (int n = 0; n < 2; ++n) acc[a][b][m][n] = (f32x4){0.f, 0.f, 0.f, 0.f};
    bf16x8 At[4][2], B0[2][2], B1[2][2];
    const char* cA = (const char*)g.A + (size_t)cur.pm * tstep; const char* cB = (const char*)g.Bt + (size_t)cur.pn * tstep;
    S.a_ready(cur);
    if constexpr (SP2) {
        PG8_STAGE(PG8_SB(0, 0), cB, voffB); PG8_STAGE(PG8_SB(0, 1), cB + hstep, voffB); PG8_STAGE(PG8_SA(0, 0), cA, voffA); PG8_STAGE(PG8_SA(0, 1), cA + hstep, voffA);
        if (wr == 1) PG8_BAR;
        PG8_WAIT_V(2); PG8_BAR;
        PG8_STAGE(PG8_SB(1, 0), cB + kstep, voffB); PG8_STAGE(PG8_SA(1, 0), cA + kstep, voffA); PG8_STAGE(PG8_SB(1, 1), cB + hstep + kstep, voffB);
        PG8_WAIT_V(6); PG8_BAR;
    } else {
        PG8_STAGE(PG8_SB(0, 0), cB, voffB); PG8_STAGE(PG8_SA(0, 0), cA, voffA); PG8_STAGE(PG8_SB(0, 1), cB + hstep, voffB); PG8_STAGE(PG8_SA(0, 1), cA + hstep, voffA);
        if (wr == 1) PG8_BAR;
        PG8_WAIT_V(4); PG8_BAR;
        PG8_STAGE(PG8_SB(1, 0), cB + kstep, voffB); PG8_STAGE(PG8_SA(1, 0), cA + kstep, voffA); PG8_STAGE(PG8_SB(1, 1), cB + hstep + kstep, voffB);
        PG8_WAIT_V(6); PG8_BAR;
    }
    for (;;) {
        const bool has_next = S.next(ui + 1, nxt);
        const char* nA = has_next ? (const char*)g.A + (size_t)nxt.pm * tstep : cA; const char* nB = has_next ? (const char*)g.Bt + (size_t)nxt.pn * tstep : cB;
        for (int t = 0; t < nt; t += 2) {
            const bool last = (t == nt - 2);
            const char* a1 = cA + (size_t)(t + 1) * kstep;
            const char* a2 = last ? nA : cA + (size_t)(t + 2) * kstep; const char* b2 = last ? nB : cB + (size_t)(t + 2) * kstep;
            const char* a3 = a2 + kstep; const char* b3 = b2 + kstep;
            if (last && has_next) S.a_ready(nxt);
            if constexpr (SP2) {
            PG8_LDB(B0, 0, 0); PG8_LDB(B1, 0, 1); PG8_SCHED; PG8_LDA(At, 0, 0); PG8_STAGE(PG8_SA(1, 1), a1 + hstep, voffA);
            PG8_WAIT_V(8); PG8_WAIT_L(0); PG8_BAR; PG8_MMA(0, 0, At, B0); PG8_MMA(0, 1, At, B1); PG8_BAR; PG8_SCHED;
            PG8_LDA(At, 0, 1); PG8_STAGE(PG8_SB(0, 0), b2, voffB); PG8_STAGE(PG8_SB(0, 1), b2 + hstep, voffB); PG8_STAGE(PG8_SA(0, 0), a2, voffA);
            PG8_WAIT_V(8); PG8_WAIT_L(0); PG8_BAR; PG8_MMA(1, 0, At, B0); PG8_MMA(1, 1, At, B1); PG8_BAR; PG8_SCHED;
            PG8_LDB(B0, 1, 0); PG8_LDB(B1, 1, 1); PG8_SCHED; PG8_LDA(At, 1, 0); PG8_STAGE(PG8_SA(0, 1), a2 + hstep, voffA);
            PG8_WAIT_V(8); PG8_WAIT_L(0); PG8_BAR; PG8_MMA(0, 0, At, B0); PG8_MMA(0, 1, At, B1); PG8_BAR; PG8_SCHED;
            PG8_LDA(At, 1, 1); PG8_STAGE(PG8_SB(1, 0), b3, voffB); PG8_STAGE(PG8_SB(1, 1), b3 + hstep, voffB); PG8_STAGE(PG8_SA(1, 0), a3, voffA);
            PG8_WAIT_V(8); PG8_WAIT_L(0); PG8_BAR; PG8_MMA(1, 0, At, B0); PG8_MMA(1, 1, At, B1); PG8_BAR; PG8_SCHED;
            } else {
            PG8_LDB(B0, 0, 0); PG8_SCHED; PG8_LDA(At, 0, 0); PG8_STAGE(PG8_SA(1, 1), a1 + hstep, voffA);
            PG8_WAIT_L(8); PG8_BAR; PG8_WAIT_L(0); PG8_MMA(0, 0, At, B0); PG8_BAR; PG8_SCHED;
            PG8_LDB(B1, 0, 1); PG8_STAGE(PG8_SB(0, 0), b2, voffB);
            PG8_BAR; PG8_WAIT_L(0); PG8_MMA(0, 1, At, B1); PG8_BAR;
            PG8_LDA(At, 0, 1); PG8_STAGE(PG8_SA(0, 0), a2, voffA);
            PG8_BAR; PG8_WAIT_L(0); PG8_MMA(1, 0, At, B0); PG8_BAR; PG8_SCHED;
            PG8_STAGE(PG8_SB(0, 1), b2 + hstep, voffB);
            PG8_WAIT_V(6); PG8_BAR; PG8_MMA(1, 1, At, B1); PG8_BAR;
            PG8_LDB(B0, 1, 0); PG8_SCHED; PG8_LDA(At, 1, 0); PG8_STAGE(PG8_SA(0, 1), a2 + hstep, voffA);
            PG8_WAIT_L(8); PG8_BAR; PG8_WAIT_L(0); PG8_MMA(0, 0, At, B0); PG8_BAR; PG8_SCHED;
            PG8_LDB(B1, 1, 1); PG8_STAGE(PG8_SB(1, 0), b3, voffB);
            PG8_BAR; PG8_WAIT_L(0); PG8_MMA(0, 1, At, B1); PG8_BAR;
            PG8_LDA(At, 1, 1); PG8_STAGE(PG8_SA(1, 0), a3, voffA);
            PG8_BAR; PG8_WAIT_L(0); PG8_MMA(1, 0, At, B0); PG8_BAR; PG8_SCHED;
            PG8_STAGE(PG8_SB(1, 1), b3 + hstep, voffB);
            PG8_WAIT_V(6); PG8_BAR; PG8_MMA(1, 1, At, B1); PG8_BAR;
            }
        }
        if constexpr (ALIGN_EPI) { if (wr == 0) PG8_BAR; }
        bool keep_acc = false;
        if constexpr (Epi::CHAIN) { keep_acc = E.chain(acc, cur, wr, wc, fr, fq); S.done(cur); }
        else if constexpr (!Epi::AFTER_DRAIN) { E(acc, cur, wr, wc, fr, fq); S.done(cur); }
        if (!has_next) break;
        if (!keep_acc) {
#pragma unroll
        for (int a = 0; a < 2; ++a)
#pragma unroll
            for (int b = 0; b < 2; ++b)
#pragma unroll
                for (int m = 0; m < 4; ++m)
#pragma unroll
                    for (int n = 0; n < 2; ++n) acc[a][b][m][n] = (f32x4){0.f, 0.f, 0.f, 0.f};
        }
        cur = nxt; cA = nA; cB = nB; ++ui;
        if constexpr (ALIGN_EPI) { if (wr == 1) PG8_BAR; }
    }
    PG8_WAIT_V(0);
    if constexpr (!ALIGN_EPI) { if (wr == 0) PG8_BAR; }
    PG8_BAR;
    if constexpr (Epi::AFTER_DRAIN) { E.fused(acc, cur, wr, wc, fr, fq, lds, wid, lane); S.done(cur); }
#undef PG8_SA
#undef PG8_SB
#undef PG8_STAGE
#undef PG8_LDA
#undef PG8_LDB
#undef PG8_MMA
#undef PG8_WAIT_V
#undef PG8_WAIT_L
#undef PG8_BAR
#undef PG8_SCHED
}
}

#define LAS __attribute__((address_space(3)))
typedef unsigned short bf16;
typedef short bf16x8 __attribute__((ext_vector_type(8)));
typedef float f32x4 __attribute__((ext_vector_type(4)));
typedef unsigned u32x4 __attribute__((ext_vector_type(4)));
typedef unsigned u32x2 __attribute__((ext_vector_type(2)));

constexpr int D = 1024, NB = 8, T = 4096, CL = 256;
constexpr int ML = NB * T, MC = NB * CL, M = ML + MC;
constexpr int NZA = 3328, NZG = 3072;
constexpr int C_RQ = 0, C_RK = 256, C_RV = 512, C_RG = 1024, C_SU = 1536, C_SV = 2048, C_AQ = 2560, C_AK = 3072, C_AV = 3200;
constexpr int NE = 16, CAPL = 512, CAPC = 32, ME = NB * (CAPL + CAPC);
constexpr int NCH = 34;
constexpr float EPS = 1e-6f, LOG2E = 1.4426950408889634f;
constexpr int LDS_BYTES = 147456;

constexpr size_t MiB = 1u << 20;
constexpr size_t WS_LG = 15360;
constexpr size_t WS_ROPEC = 1 * MiB, WS_ROPES = 1 * MiB + 512 * 1024, WS_MODV = 2 * MiB, WS_AFF = 3 * MiB, WS_AFFC = 5 * MiB, WS_INV = 6 * MiB, WS_TOPW = 9 * MiB;
constexpr size_t WS_WTIN = 16 * MiB, WS_WTBR = WS_WTIN + (size_t)6400 * 1024 * 2, WS_WTOUT = WS_WTBR + (size_t)3072 * 512 * 2;
constexpr size_t WS_X = 34 * MiB, WS_H = 170 * MiB, WS_R = 238 * MiB;
constexpr size_t WS_ZA = WS_R, WS_G = WS_R, WS_RS = 459 * MiB, WS_ST = 527 * MiB;
constexpr size_t WS_XS = WS_R, WS_ACT = 374 * MiB, WS_WT1 = 510 * MiB, WS_WT2 = 574 * MiB, WS_END = 606 * MiB;
static_assert(WS_WTOUT + 2 * MiB <= WS_X && WS_ZA + (size_t)M * NZA * 2 <= WS_RS && WS_ST + (size_t)NB * 4 * NCH * 128 * 128 * 2 <= WS_END, "ws map");

struct KP {
    const float *x, *c, *ctx, *c_ctx, *w_mod, *b_mod, *norm1_g, *norm2_g, *w_in, *dec_f, *dec_b, *sgu_w, *sgu_b, *qn_g, *kn_g, *sink, *w_branch, *w_out, *w_router, *w_eg, *w_eu, *w_ed;
    float* out; unsigned char* ws;
};
typedef const __attribute__((address_space(4))) KP* KPC;

#define LDS_WAIT() asm volatile("s_waitcnt lgkmcnt(0)" ::: "memory")
__device__ __forceinline__ unsigned pk2(float lo, float hi) { return pg8::cvt_pk_bf16(lo, hi); }
__device__ __forceinline__ float bflo(unsigned w) { return __uint_as_float(w << 16); }
__device__ __forceinline__ float bfhi(unsigned w) { return __uint_as_float(w & 0xffff0000u); }
__device__ __forceinline__ void unpack8(const u32x4 w, float (&f)[8]) { f[0] = bflo(w.x); f[1] = bfhi(w.x); f[2] = bflo(w.y); f[3] = bfhi(w.y); f[4] = bflo(w.z); f[5] = bfhi(w.z); f[6] = bflo(w.w); f[7] = bfhi(w.w); }
__device__ __forceinline__ u32x4 pack8(const float (&f)[8]) { u32x4 o; o.x = pk2(f[0], f[1]); o.y = pk2(f[2], f[3]); o.z = pk2(f[4], f[5]); o.w = pk2(f[6], f[7]); return o; }
template <int CTRL> __device__ __forceinline__ float dpp_f(float v) { return __builtin_bit_cast(float, __builtin_amdgcn_update_dpp(0, __builtin_bit_cast(int, v), CTRL, 0xf, 0xf, false)); }
template <int CTRL> __device__ __forceinline__ int dpp_i(int v) { return __builtin_amdgcn_update_dpp(0, v, CTRL, 0xf, 0xf, false); }
constexpr int DPP_XOR1 = 0xB1  , DPP_XOR2 = 0x4E  , DPP_HMIRROR = 0x141  , DPP_MIRROR = 0x140  ;
__device__ __forceinline__ float sum_x16(float v) { const unsigned u = __builtin_bit_cast(unsigned, v); auto r = __builtin_amdgcn_permlane16_swap(u, u, false, false); return __builtin_bit_cast(float, (unsigned)r[0]) + __builtin_bit_cast(float, (unsigned)r[1]); }
__device__ __forceinline__ float sum_x32(float v) { const unsigned u = __builtin_bit_cast(unsigned, v); auto r = __builtin_amdgcn_permlane32_swap(u, u, false, false); return __builtin_bit_cast(float, (unsigned)r[0]) + __builtin_bit_cast(float, (unsigned)r[1]); }
__device__ __forceinline__ float max_x16(float v) { const unsigned u = __builtin_bit_cast(unsigned, v); auto r = __builtin_amdgcn_permlane16_swap(u, u, false, false); return fmaxf(__builtin_bit_cast(float, (unsigned)r[0]), __builtin_bit_cast(float, (unsigned)r[1])); }
__device__ __forceinline__ float max_x32(float v) { const unsigned u = __builtin_bit_cast(unsigned, v); auto r = __builtin_amdgcn_permlane32_swap(u, u, false, false); return fmaxf(__builtin_bit_cast(float, (unsigned)r[0]), __builtin_bit_cast(float, (unsigned)r[1])); }
__device__ __forceinline__ int sum_x16_i(int v) { auto r = __builtin_amdgcn_permlane16_swap((unsigned)v, (unsigned)v, false, false); return (int)r[0] + (int)r[1]; }
__device__ __forceinline__ int sum_x32_i(int v) { auto r = __builtin_amdgcn_permlane32_swap((unsigned)v, (unsigned)v, false, false); return (int)r[0] + (int)r[1]; }
__device__ __forceinline__ float row_sum(float v) { v += dpp_f<DPP_XOR1>(v); v += dpp_f<DPP_XOR2>(v); v += dpp_f<DPP_HMIRROR>(v); v += dpp_f<DPP_MIRROR>(v); return v; }
__device__ __forceinline__ float row_max(float v) { v = fmaxf(v, dpp_f<DPP_XOR1>(v)); v = fmaxf(v, dpp_f<DPP_XOR2>(v)); v = fmaxf(v, dpp_f<DPP_HMIRROR>(v)); v = fmaxf(v, dpp_f<DPP_MIRROR>(v)); return v; }
__device__ __forceinline__ int row_sum_i(int v) { v += dpp_i<DPP_XOR1>(v); v += dpp_i<DPP_XOR2>(v); v += dpp_i<DPP_HMIRROR>(v); v += dpp_i<DPP_MIRROR>(v); return v; }
__device__ __forceinline__ float wave_sum(float v) { return sum_x32(sum_x16(row_sum(v))); }
__device__ __forceinline__ float wave_max(float v) { return max_x32(max_x16(row_max(v))); }
__device__ __forceinline__ int wave_sum_i(int v) { return sum_x32_i(sum_x16_i(row_sum_i(v))); }
__device__ __forceinline__ float sum_x16_x32(float v) { return sum_x32(sum_x16(v)); }
__device__ __forceinline__ float sum_x1_x2(float v) { v += dpp_f<DPP_XOR1>(v); v += dpp_f<DPP_XOR2>(v); return v; }
template <int MASK> __device__ __forceinline__ float swz_xor(float v) { static_assert(MASK > 0 && MASK < 32, "swz_xor: 1..31"); return __builtin_bit_cast(float, __builtin_amdgcn_ds_swizzle(__builtin_bit_cast(int, v), 0x1f | (MASK << 10))); }
__device__ __forceinline__ float ex2(float x) { return __builtin_amdgcn_exp2f(x); }
__device__ __forceinline__ float rcp_(float x) { return __builtin_amdgcn_rcpf(x); }
__device__ __forceinline__ float rsq_(float x) { return __builtin_amdgcn_rsqf(x); }
__device__ __forceinline__ float sigmoidf_(float x) { return rcp_(1.f + ex2(-x * LOG2E)); }
__device__ __forceinline__ float gelu_tanh(float x) { const float u = 0.7978845608028654f * (x + 0.044715f * x * x * x); return x * rcp_(1.f + ex2(-2.f * LOG2E * u)); }
__device__ __forceinline__ f32x4 mfma16(bf16x8 a, bf16x8 b, f32x4 c) { return __builtin_amdgcn_mfma_f32_16x16x32_bf16(a, b, c, 0, 0, 0); }
__device__ __forceinline__ bf16x8 as_bf16x8(u32x4 w) { return __builtin_bit_cast(bf16x8, w); }
__device__ __forceinline__ float log2_sigmoid(float a) { return -log1pf(__expf(-a)) * LOG2E; }

struct GroupOrder {
    int nG, nM, nN, pmS, pnS, G, c;
    __device__ __forceinline__ bool next(int i, pg8::Unit& u) const {
        const long L = (long)i * G + c; const int tot = nG * nM * nN; if (L >= tot) return false;
        int wgid = (int)L; { const int q = tot / 8, r = tot % 8, xcd = wgid % 8, off = wgid / 8; wgid = (xcd < r ? xcd * (q + 1) : r * (q + 1) + (xcd - r) * q) + off; }
        const int per = nM * nN, g = wgid / per, rem = wgid - g * per;
        const int nig = 8 * nN, gid = rem / nig, fm = gid * 8, gsz = (nM - fm) < 8 ? (nM - fm) : 8;
        u.pm = g * pmS + fm + ((rem % nig) % gsz); u.pn = g * pnS + (rem % nig) / gsz; return true;
    }
    __device__ __forceinline__ void a_ready(const pg8::Unit&) const {}
    __device__ __forceinline__ void done(const pg8::Unit&) const {}
};
struct MergeOrder {
    int nM, G, c;
    __device__ __forceinline__ bool next(int i, pg8::Unit& u) const {
        const int ii = i / 3, g = i - 3 * ii; const long L = (long)ii * G + c; const int tot = nM * 4; if (L >= tot) return false;
        int wgid = (int)L; { const int q = tot / 8, r = tot % 8, xcd = wgid % 8, off = wgid / 8; wgid = (xcd < r ? xcd * (q + 1) : r * (q + 1) + (xcd - r) * q) + off; }
        const int nig = 32, gid = wgid / nig, fm = gid * 8, gsz = (nM - fm) < 8 ? (nM - fm) : 8;
        u.pm = g * (M / 256) + fm + ((wgid % nig) % gsz); u.pn = g * 4 + (wgid % nig) / gsz; return true;
    }
    __device__ __forceinline__ void a_ready(const pg8::Unit&) const {}
    __device__ __forceinline__ void done(const pg8::Unit&) const {}
};

struct EpiZA {
    static constexpr bool PERM = true, AFTER_DRAIN = false, CHAIN = false;
    bf16* O;
    __device__ __forceinline__ void operator()(const f32x4 (&acc)[2][2][4][2], const pg8::Unit& u, int wr, int wc, int fr, int fq) const {
        const int row0 = u.pm * 256 + wr * 64 + fr, col0 = u.pn * 256 + wc * 32 + 8 * fq; const bool act = false;
#pragma unroll
        for (int ai = 0; ai < 2; ++ai)
#pragma unroll
            for (int m = 0; m < 4; ++m) { bf16* rowp = O + (size_t)(row0 + ai * 128 + m * 16) * NZA + col0;
#pragma unroll
                for (int bj = 0; bj < 2; ++bj) { const f32x4 v0 = acc[ai][bj][m][0], v1 = acc[ai][bj][m][1];
                    float o[8] = {v0[0], v0[1], v0[2], v0[3], v1[0], v1[1], v1[2], v1[3]};
                    if (act) {
#pragma unroll
                        for (int k = 0; k < 8; ++k) o[k] = gelu_tanh(o[k]); }
                    *(u32x4*)(rowp + bj * 128) = pack8(o); } }
    }
};
struct EpiSig {
    static constexpr bool PERM = true, AFTER_DRAIN = false, CHAIN = false;
    bf16* O;
    __device__ __forceinline__ void operator()(const f32x4 (&acc)[2][2][4][2], const pg8::Unit& u, int wr, int wc, int fr, int fq) const {
        const int row0 = u.pm * 256 + wr * 64 + fr, col0 = u.pn * 256 + wc * 32 + 8 * fq;
#pragma unroll
        for (int ai = 0; ai < 2; ++ai)
#pragma unroll
            for (int m = 0; m < 4; ++m) { bf16* rowp = O + (size_t)(row0 + ai * 128 + m * 16) * NZG + col0;
#pragma unroll
                for (int bj = 0; bj < 2; ++bj) { const f32x4 v0 = acc[ai][bj][m][0], v1 = acc[ai][bj][m][1];
                    float o[8] = {v0[0], v0[1], v0[2], v0[3], v1[0], v1[1], v1[2], v1[3]};
#pragma unroll
                    for (int k = 0; k < 8; ++k) o[k] = fmaxf(sigmoidf_(o[k]), 1e-20f);
                    *(u32x4*)(rowp + bj * 128) = pack8(o); } }
    }
};
struct EpiMergeChain {
    static constexpr bool PERM = true, AFTER_DRAIN = false, CHAIN = true;
    const bf16* Gt; bf16* Hm;
    __device__ __forceinline__ bool chain(f32x4 (&acc)[2][2][4][2], const pg8::Unit& u, int wr, int wc, int fr, int fq) const {
        const int g = u.pm / (M / 256), m = u.pm - g * (M / 256), n = u.pn - g * 4;
        const int row0 = m * 256 + wr * 64 + fr, col0 = n * 256 + wc * 32 + 8 * fq;
#pragma unroll
        for (int ai = 0; ai < 2; ++ai) {
            u32x4 gw[4][2], hw[4][2];
#pragma unroll
            for (int mm = 0; mm < 4; ++mm)
#pragma unroll
                for (int bj = 0; bj < 2; ++bj) gw[mm][bj] = *(const u32x4*)(Gt + (size_t)(row0 + ai * 128 + mm * 16) * NZG + g * 1024 + col0 + bj * 128);
            if (g < 2) {
#pragma unroll
                for (int mm = 0; mm < 4; ++mm)
#pragma unroll
                    for (int bj = 0; bj < 2; ++bj) hw[mm][bj] = *(const u32x4*)(Gt + (size_t)(row0 + ai * 128 + mm * 16) * NZG + (g + 1) * 1024 + col0 + bj * 128);
            }
#pragma unroll
            for (int mm = 0; mm < 4; ++mm)
#pragma unroll
                for (int bj = 0; bj < 2; ++bj) {
                    float sc[8]; unpack8(gw[mm][bj], sc);
                    if (g < 2) { float sn[8]; unpack8(hw[mm][bj], sn);
#pragma unroll
                        for (int k = 0; k < 8; ++k) sc[k] *= __builtin_amdgcn_rcpf(sn[k]); }
                    f32x4& v0 = acc[ai][bj][mm][0]; f32x4& v1 = acc[ai][bj][mm][1];
                    v0[0] *= sc[0]; v0[1] *= sc[1]; v0[2] *= sc[2]; v0[3] *= sc[3]; v1[0] *= sc[4]; v1[1] *= sc[5]; v1[2] *= sc[6]; v1[3] *= sc[7];
                    if (g == 2) { u32x4 w; w.x = pk2(v0[0], v0[1]); w.y = pk2(v0[2], v0[3]); w.z = pk2(v1[0], v1[1]); w.w = pk2(v1[2], v1[3]);
                        *(u32x4*)(Hm + (size_t)(row0 + ai * 128 + mm * 16) * 1024 + col0 + bj * 128) = w; }
                }
        }
        return g < 2;
    }
};
struct EpiOut {
    static constexpr bool PERM = true, AFTER_DRAIN = false, CHAIN = false;
    const float* xl; const float* xc; bf16* X; const float* modv; int from_f32;
    __device__ __forceinline__ void operator()(const f32x4 (&acc)[2][2][4][2], const pg8::Unit& u, int wr, int wc, int fr, int fq) const {
        const int row0 = u.pm * 256 + wr * 64 + fr, col0 = u.pn * 256 + wc * 32 + 8 * fq;
        const int bi = (u.pm * 256 < ML) ? ((u.pm * 256) >> 12) : 8;
        const float* g1 = modv + bi * 6144 + 2 * 1024;
        f32x4 gv[2][2];
#pragma unroll
        for (int bj = 0; bj < 2; ++bj) { gv[bj][0] = *(const f32x4*)(g1 + col0 + bj * 128); gv[bj][1] = *(const f32x4*)(g1 + col0 + bj * 128 + 4); }
        if (from_f32) {
            const float* src0 = (u.pm * 256 < ML) ? xl + (size_t)row0 * 1024 : xc + (size_t)(row0 - ML) * 1024;
#pragma unroll
            for (int ai = 0; ai < 2; ++ai) {
                f32x4 xv[4][2][2];
#pragma unroll
                for (int m = 0; m < 4; ++m)
#pragma unroll
                    for (int bj = 0; bj < 2; ++bj) { const float* s = src0 + (size_t)(ai * 128 + m * 16) * 1024 + col0 + bj * 128; xv[m][bj][0] = *(const f32x4*)s; xv[m][bj][1] = *(const f32x4*)(s + 4); }
#pragma unroll
                for (int m = 0; m < 4; ++m)
#pragma unroll
                    for (int bj = 0; bj < 2; ++bj) { const f32x4 o0 = xv[m][bj][0] + gv[bj][0] * acc[ai][bj][m][0], o1 = xv[m][bj][1] + gv[bj][1] * acc[ai][bj][m][1];
                        u32x4 w; w.x = pk2(o0[0], o0[1]); w.y = pk2(o0[2], o0[3]); w.z = pk2(o1[0], o1[1]); w.w = pk2(o1[2], o1[3]);
                        *(u32x4*)(X + (size_t)(row0 + ai * 128 + m * 16) * 1024 + col0 + bj * 128) = w; }
            }
        } else {
#pragma unroll
            for (int ai = 0; ai < 2; ++ai) {
                u32x4 xw[4][2];
#pragma unroll
                for (int m = 0; m < 4; ++m)
#pragma unroll
                    for (int bj = 0; bj < 2; ++bj) xw[m][bj] = *(const u32x4*)(X + (size_t)(row0 + ai * 128 + m * 16) * 1024 + col0 + bj * 128);
#pragma unroll
                for (int m = 0; m < 4; ++m)
#pragma unroll
                    for (int bj = 0; bj < 2; ++bj) { float xo[8]; unpack8(xw[m][bj], xo); const f32x4 a0 = acc[ai][bj][m][0], a1 = acc[ai][bj][m][1];
                        float o[8] = {xo[0] + gv[bj][0][0] * a0[0], xo[1] + gv[bj][0][1] * a0[1], xo[2] + gv[bj][0][2] * a0[2], xo[3] + gv[bj][0][3] * a0[3],
                                      xo[4] + gv[bj][1][0] * a1[0], xo[5] + gv[bj][1][1] * a1[1], xo[6] + gv[bj][1][2] * a1[2], xo[7] + gv[bj][1][3] * a1[3]};
                        *(u32x4*)(X + (size_t)(row0 + ai * 128 + m * 16) * 1024 + col0 + bj * 128) = pack8(o); }
            }
        }
    }
};
struct EpiMoe1 {
    static constexpr bool PERM = true, AFTER_DRAIN = false, CHAIN = false;
    bf16* ACT;
    __device__ __forceinline__ void operator()(const f32x4 (&acc)[2][2][4][2], const pg8::Unit& u, int wr, int wc, int fr, int fq) const {
        const int row0 = u.pm * 256 + wr * 64 + fr, col0 = (u.pn & 7) * 128 + wc * 32 + 8 * fq;
#pragma unroll
        for (int ai = 0; ai < 2; ++ai)
#pragma unroll
            for (int m = 0; m < 4; ++m) { const size_t r = (size_t)(row0 + ai * 128 + m * 16);
                const f32x4 a0 = acc[ai][0][m][0], a1 = acc[ai][0][m][1], u0 = acc[ai][1][m][0], u1 = acc[ai][1][m][1];
                float o[8];
#pragma unroll
                for (int k = 0; k < 4; ++k) { o[k] = a0[k] * sigmoidf_(a0[k]) * u0[k]; o[4 + k] = a1[k] * sigmoidf_(a1[k]) * u1[k]; }
                *(u32x4*)(ACT + r * 1024 + col0) = pack8(o); }
    }
};
struct EpiMoe2 {
    static constexpr bool PERM = true, AFTER_DRAIN = false, CHAIN = false;
    bf16* Y; const float* topw;
    __device__ __forceinline__ void operator()(const f32x4 (&acc)[2][2][4][2], const pg8::Unit& u, int wr, int wc, int fr, int fq) const {
        const int row0 = u.pm * 256 + wr * 64 + fr, col0 = (u.pn & 3) * 256 + wc * 32 + 8 * fq;
        float twv[2][4];
#pragma unroll
        for (int ai = 0; ai < 2; ++ai)
#pragma unroll
            for (int m = 0; m < 4; ++m) twv[ai][m] = topw[row0 + ai * 128 + m * 16];
#pragma unroll
        for (int ai = 0; ai < 2; ++ai)
#pragma unroll
            for (int m = 0; m < 4; ++m) { const size_t r = (size_t)(row0 + ai * 128 + m * 16); const float tw = twv[ai][m];
#pragma unroll
                for (int bj = 0; bj < 2; ++bj) { const f32x4 v0 = acc[ai][bj][m][0] * tw, v1 = acc[ai][bj][m][1] * tw;
                    u32x4 w; w.x = pk2(v0[0], v0[1]); w.y = pk2(v0[2], v0[3]); w.z = pk2(v1[0], v1[1]); w.w = pk2(v1[2], v1[3]);
                    *(u32x4*)(Y + r * 1024 + col0 + bj * 128) = w; } }
    }
};

__device__ __forceinline__ void tr_item(const float* W, int N, int k0, int n0, bf16* dst, int K, LAS float* scr, int lane) {
#pragma unroll 8
    for (int i = 0; i < 32; ++i) { const int kk = 2 * i + (lane >> 5); scr[kk * 33 + (lane & 31)] = W[(size_t)(k0 + kk) * N + n0 + (lane & 31)]; }
    LDS_WAIT();
    const int cc = lane & 7;
#pragma unroll
    for (int j = 0; j < 4; ++j) { const int n = (lane >> 3) + 8 * j; const LAS float* s = scr + (8 * cc) * 33 + n;
        u32x4 o; o.x = pk2(s[0 * 33], s[1 * 33]); o.y = pk2(s[2 * 33], s[3 * 33]); o.z = pk2(s[4 * 33], s[5 * 33]); o.w = pk2(s[6 * 33], s[7 * 33]);
        *(u32x4*)(dst + (size_t)n * K + 8 * cc) = o; }
    LDS_WAIT();
}
__device__ __forceinline__ void convert_small(KPC p, int l, LAS unsigned char* lds, int lane, int wave, int bid, int G) {
    LAS float* scr = (LAS float*)(lds + wave * 8448);
    const int gw = bid * 8 + wave, NGW = G * 8;
    constexpr int I_IN = 16 * 200, I_BR = 8 * 32, I_OUT = 16 * 32;
    bf16* wtin = (bf16*)(p->ws + WS_WTIN); bf16* wtbr = (bf16*)(p->ws + WS_WTBR); bf16* wtout = (bf16*)(p->ws + WS_WTOUT);
    for (int it = gw; it < I_IN + 3 * I_BR + I_OUT; it += NGW) {
        int r = it;
        if (r < I_IN) { const int kb = r / 200, nb = r % 200; tr_item(p->w_in + (size_t)l * 1024 * 6400, 6400, 64 * kb, 32 * nb, wtin + (size_t)(32 * nb) * 1024 + 64 * kb, 1024, scr, lane); continue; }
        r -= I_IN;
        if (r < 3 * I_BR) { const int br = r / I_BR, q = r % I_BR, kb = q / 32, nb = q % 32;
            tr_item(p->w_branch + ((size_t)l * 3 + br) * 512 * 1024, 1024, 64 * kb, 32 * nb, wtbr + (size_t)(br * 1024 + 32 * nb) * 512 + 64 * kb, 512, scr, lane); continue; }
        r -= 3 * I_BR;
        { const int kb = r / 32, nb = r % 32; tr_item(p->w_out + (size_t)l * 1024 * 1024, 1024, 64 * kb, 32 * nb, wtout + (size_t)(32 * nb) * 1024 + 64 * kb, 1024, scr, lane); }
    }
}
__device__ __forceinline__ void convert_experts(KPC p, int l, int lo, int hi, int widx, int nw, LAS unsigned char* lds, int lane, int wave) {
    LAS float* scr = (LAS float*)(lds + wave * 8448);
    bf16* wt1 = (bf16*)(p->ws + WS_WT1); bf16* wt2 = (bf16*)(p->ws + WS_WT2);
    for (int it = lo + widx; it < hi; it += nw) {
        const int e = it / 1536, q = it % 1536, which = q / 512, qq = q % 512, kb = qq / 32, nb = qq % 32, n0 = 32 * nb, k0 = 64 * kb;
        const size_t woff = ((size_t)l * NE + e) * 1024 * 1024;
        if (which == 0) tr_item(p->w_eg + woff, 1024, k0, n0, wt1 + ((size_t)e * 2048 + (n0 >> 7) * 256 + (n0 & 127)) * 1024 + k0, 1024, scr, lane);
        else if (which == 1) tr_item(p->w_eu + woff, 1024, k0, n0, wt1 + ((size_t)e * 2048 + (n0 >> 7) * 256 + 128 + (n0 & 127)) * 1024 + k0, 1024, scr, lane);
        else tr_item(p->w_ed + woff, 1024, k0, n0, wt2 + ((size_t)e * 1024 + n0) * 1024 + k0, 1024, scr, lane);
    }
}
constexpr int CVT_ITEMS = NE * 3 * 512;
constexpr int CVT_G_IDLE0 = 96, CVT_M_IDLE0 = 32, CVT_O_IDLE0 = 32;
constexpr int CVT_G_HI = 7680, CVT_M_HI = 7680 + 14336;

__device__ __forceinline__ void phase_prep(KPC p, LAS unsigned char* lds, int tid, int lane, int wave, int bid, int G) {
    unsigned char* ws = p->ws;
    {   float* rc = (float*)(ws + WS_ROPEC); float* rsn = (float*)(ws + WS_ROPES);
        for (int i = bid * 512 + tid; i < T * 32; i += G * 512) { const int t = i >> 5, f = i & 31; const int pos = (f < 16) ? (t >> 6) : (t & 63); const int fi = f & 15;
            const float inv = ex2(-(float)fi * (13.287712379549449f / 16.f));
            float ang = (float)pos * inv; ang -= 6.283185307179586f * rintf(ang * 0.15915494309189535f);
            rc[i] = __cosf(ang); rsn[i] = __sinf(ang); } }
    if (bid == 0 && tid < 16) { const int l = tid >> 3, dir = (tid >> 2) & 1, h = tid & 3; ((float*)(ws + WS_LG))[tid] = log2_sigmoid(dir ? p->dec_b[l * 4 + h] : p->dec_f[l * 4 + h]); }
    {   LAS float* sv = (LAS float*)lds;
        LAS float* red = (LAS float*)(lds + 36864);
        for (int i = tid; i < 9 * 1024; i += 512) { const int r = i >> 10, k = i & 1023; const float v = (r < 8) ? p->c[r * 1024 + k] : p->c_ctx[k]; sv[i] = v * sigmoidf_(v); }
        __syncthreads();
        for (int it = bid; it < 192; it += G) {
            const int l = it / 96, n0 = (it % 96) * 64;
            const float* W = p->w_mod + (size_t)l * 1024 * 6144 + n0 + lane;
            float acc[9];
#pragma unroll
            for (int r = 0; r < 9; ++r) acc[r] = 0.f;
#pragma unroll 1
            for (int k0 = wave * 128; k0 < wave * 128 + 128; k0 += 16) {
                float wv[16];
#pragma unroll
                for (int kk = 0; kk < 16; ++kk) wv[kk] = W[(size_t)(k0 + kk) * 6144];
#pragma unroll
                for (int kk = 0; kk < 16; ++kk)
#pragma unroll
                    for (int r = 0; r < 9; ++r) acc[r] += sv[r * 1024 + k0 + kk] * wv[kk]; }
#pragma unroll
            for (int r = 0; r < 9; ++r) red[(wave * 9 + r) * 64 + lane] = acc[r];
            __syncthreads();
            for (int i = tid; i < 576; i += 512) { const int r = i >> 6, ln = i & 63; float s = 0.f;
#pragma unroll
                for (int w = 0; w < 8; ++w) s += red[(w * 9 + r) * 64 + ln];
                s += p->b_mod[l * 6144 + n0 + ln]; ((float*)(ws + WS_MODV))[(l * 9 + r) * 6144 + n0 + ln] = s; }
            __syncthreads();
        }
    }
    __syncthreads();
    convert_small(p, 0, lds, lane, wave, bid, G);
}

__device__ __forceinline__ float row_rs(const f32x4 (&v)[4]) {
    float ss = 0.f;
#pragma unroll
    for (int j = 0; j < 4; ++j) ss += (v[j].x * v[j].x + v[j].y * v[j].y) + (v[j].z * v[j].z + v[j].w * v[j].w);
    return rsq_(wave_sum(ss) * (1.f / 1024.f) + EPS);
}
__device__ __forceinline__ void norm_mod(const f32x4 (&v)[4], float rs, const float* gain, const float* sh, const float* sc, f32x4 (&h)[4], int lane) {
#pragma unroll
    for (int j = 0; j < 4; ++j) { const int col = 4 * lane + 256 * j; const f32x4 g = *(const f32x4*)(gain + col), a = *(const f32x4*)(sc + col), b = *(const f32x4*)(sh + col);
        h[j] = (v[j] * rs) * g * (a + 1.0f) + b; }
}
__device__ __forceinline__ void store_h(const f32x4 (&h)[4], bf16* hrow, int lane) {
#pragma unroll
    for (int j = 0; j < 4; ++j) { u32x2 w; w.x = pk2(h[j].x, h[j].y); w.y = pk2(h[j].z, h[j].w); *(u32x2*)(hrow + 4 * lane + 256 * j) = w; }
}
__device__ __forceinline__ void phase_norm_in(KPC p, int lane, int wave, int bid, int G) {
    const float* modv = (const float*)(p->ws + WS_MODV); bf16* H = (bf16*)(p->ws + WS_H);
    const int stride = G * 8; int r = bid * 8 + wave;
    f32x4 vn[4];
    {   const float* src = (r < ML) ? p->x + (size_t)r * 1024 : p->ctx + (size_t)(r - ML) * 1024;
#pragma unroll
        for (int j = 0; j < 4; ++j) vn[j] = (r < M) ? *(const f32x4*)(src + 4 * lane + 256 * j) : (f32x4){0.f, 0.f, 0.f, 0.f}; }
    for (; r < M; r += stride) {
        const int bi = (r < ML) ? (r >> 12) : 8; const float* mv = modv + bi * 6144;
        f32x4 v[4], h[4], g[4], sc[4], sh[4];
#pragma unroll
        for (int j = 0; j < 4; ++j) { v[j] = vn[j]; const int col = 4 * lane + 256 * j; g[j] = *(const f32x4*)(p->norm1_g + col); sh[j] = *(const f32x4*)(mv + col); sc[j] = *(const f32x4*)(mv + 1024 + col); }
        const int rn = r + stride;
        if (rn < M) { const float* src = (rn < ML) ? p->x + (size_t)rn * 1024 : p->ctx + (size_t)(rn - ML) * 1024;
#pragma unroll
            for (int j = 0; j < 4; ++j) vn[j] = *(const f32x4*)(src + 4 * lane + 256 * j); }
        const float rs = row_rs(v);
#pragma unroll
        for (int j = 0; j < 4; ++j) h[j] = (v[j] * rs) * g[j] * (sc[j] + 1.0f) + sh[j];
        store_h(h, H + (size_t)r * 1024, lane);
    }
}

typedef short s16x4 __attribute__((ext_vector_type(4)));
__device__ __forceinline__ u32x2 lds_tr16(const LAS unsigned char* addr) { const s16x4 r = __builtin_amdgcn_ds_read_tr16_b64_v4i16((LAS s16x4*)addr); return __builtin_bit_cast(u32x2, r); }
__device__ __forceinline__ void ld8f(const float* p, float (&f)[8]) { const f32x4 a = *(const f32x4*)p, b = *(const f32x4*)(p + 4); f[0] = a[0]; f[1] = a[1]; f[2] = a[2]; f[3] = a[3]; f[4] = b[0]; f[5] = b[1]; f[6] = b[2]; f[7] = b[3]; }
__device__ __forceinline__ void att_item(KPC p, int l, LAS unsigned char* lds, int item, float Mb2, int tid, int lane, int wave) {
    const bf16* ZA = (const bf16*)(p->ws + WS_ZA); bf16* BR = (bf16*)p->out + (size_t)2 * M * 512;
    const float* rc = (const float*)(p->ws + WS_ROPEC); const float* rsn = (const float*)(p->ws + WS_ROPES);
    const bool isctx = item >= 512;
    int b, kvh, qb;
    if (!isctx) { b = item >> 6; kvh = (item >> 5) & 1; qb = item & 31; } else { const int ci = item - 512; b = ci >> 2; kvh = (ci >> 1) & 1; qb = ci & 1; }
    const int rowbase = isctx ? ML + b * CL : b * T;
    const int g = wave >> 1, qs = wave & 1, hh = kvh * 4 + g, c = lane & 15, g4 = lane >> 4, q0 = qb * 128 + qs * 64;
    const float* qg = p->qn_g + l * 64; const float* kg = p->kn_g + l * 64;
    LAS unsigned char* Kl = lds;
    bf16x8 qf[4][2];
    float qga[8], qgb[8]; ld8f(qg + 8 * g4, qga); ld8f(qg + 32 + 8 * g4, qgb);
#pragma unroll
    for (int ti = 0; ti < 4; ++ti) {
        const int pos = q0 + 16 * ti + c; const bf16* src = ZA + (size_t)(rowbase + pos) * NZA + C_AQ + hh * 64 + 8 * g4;
        float a[8], bb[8]; unpack8(*(const u32x4*)src, a); unpack8(*(const u32x4*)(src + 32), bb);
        float ss = 0.f;
#pragma unroll
        for (int j = 0; j < 8; ++j) ss += a[j] * a[j] + bb[j] * bb[j];
        ss = sum_x16_x32(ss);
        const float rs = rsq_(ss * (1.f / 64.f) + EPS);
#pragma unroll
        for (int j = 0; j < 8; ++j) { a[j] *= rs * qga[j]; bb[j] *= rs * qgb[j]; }
        if (!isctx) { float cs8[8], sn8[8]; ld8f(rc + pos * 32 + 8 * g4, cs8); ld8f(rsn + pos * 32 + 8 * g4, sn8);
#pragma unroll
            for (int j = 0; j < 8; ++j) { const float cs = cs8[j], sn = sn8[j]; const float x1 = a[j], x2 = bb[j]; a[j] = x1 * cs - x2 * sn; bb[j] = x1 * sn + x2 * cs; } }
#pragma unroll
        for (int j = 0; j < 8; ++j) { a[j] *= 0.125f * LOG2E; bb[j] *= 0.125f * LOG2E; }
        qf[ti][0] = as_bf16x8(pack8(a)); qf[ti][1] = as_bf16x8(pack8(bb));
        __builtin_amdgcn_sched_barrier(0);
    }
    f32x4 O[4][4]; float lsum[4];
#pragma unroll
    for (int i = 0; i < 4; ++i) { lsum[i] = 0.f;
#pragma unroll
        for (int j = 0; j < 4; ++j) O[i][j] = (f32x4){0.f, 0.f, 0.f, 0.f}; }
    const int key = tid >> 2, q4 = tid & 3;
    LAS unsigned char* Vl = lds + 55296;
#pragma unroll 1
    for (int st = isctx ? 1 : 0; st < 2; ++st) {
        __syncthreads();
        {   u32x4 kr[1][2], vr[1][2];
#define ATT_VB(lb_) ((st == 0) ? ((qb - 1 + (lb_)) >= 0 && (qb - 1 + (lb_)) <= 31) : ((lb_) < 2))
#define ATT_LD(lb_, s_) do { if (ATT_VB(lb_)) { const int krow = (st == 0) ? b * T + (qb - 1 + (lb_)) * 128 + key : ML + b * CL + 128 * (lb_) + key; \
                const bf16* ks = ZA + (size_t)krow * NZA + C_AK + kvh * 64 + 8 * q4; kr[s_][0] = *(const u32x4*)ks; kr[s_][1] = *(const u32x4*)(ks + 32); \
                const bf16* vs = ZA + (size_t)krow * NZA + C_AV + kvh * 64 + 16 * q4; vr[s_][0] = *(const u32x4*)vs; vr[s_][1] = *(const u32x4*)(vs + 8); } } while (0)
#pragma unroll 1
            for (int lb = 0; lb < 3; ++lb) {
                ATT_LD(lb, 0);
                if (ATT_VB(lb)) {
                    float a[8], bb[8]; unpack8(kr[0][0], a); unpack8(kr[0][1], bb);
                    float ss = 0.f;
#pragma unroll
                    for (int j = 0; j < 8; ++j) ss += a[j] * a[j] + bb[j] * bb[j];
                    ss = sum_x1_x2(ss);
                    const float rs = rsq_(ss * (1.f / 64.f) + EPS);
                    float kga[8], kgb[8]; ld8f(kg + 8 * q4, kga); ld8f(kg + 32 + 8 * q4, kgb);
#pragma unroll
                    for (int j = 0; j < 8; ++j) { a[j] *= rs * kga[j]; bb[j] *= rs * kgb[j]; }
                    __builtin_amdgcn_sched_barrier(0);
                    if (st == 0) { const int pos = (qb - 1 + lb) * 128 + key; float cs8[8], sn8[8]; ld8f(rc + pos * 32 + 8 * q4, cs8); ld8f(rsn + pos * 32 + 8 * q4, sn8);
#pragma unroll
                        for (int j = 0; j < 8; ++j) { const float cs = cs8[j], sn = sn8[j]; const float x1 = a[j], x2 = bb[j]; a[j] = x1 * cs - x2 * sn; bb[j] = x1 * sn + x2 * cs; } }
                    LAS unsigned char* kd = Kl + (lb * 128 + key) * 144; *(LAS u32x4*)(kd + 16 * q4) = pack8(a); *(LAS u32x4*)(kd + 64 + 16 * q4) = pack8(bb);
                    LAS unsigned char* vd = Vl + (lb * 128 + key) * 144 + 32 * q4; *(LAS u32x4*)vd = vr[0][0]; *(LAS u32x4*)(vd + 16) = vr[0][1];
                }
            }
#undef ATT_VB
#undef ATT_LD
        }
        __syncthreads();
#pragma unroll 1
        for (int lb = 0; lb < 3; ++lb) {
            if (st == 0) { const int kb = qb - 1 + lb; if (kb < 0 || kb > 31) continue; } else if (lb >= 2) continue;
            const int mode = (st == 0) ? ((lb == 0) ? 1 : ((lb == 2) ? 2 : 0)) : 0;
            const LAS unsigned char* Kb = Kl + lb * 128 * 144; const LAS unsigned char* Vb = Vl + lb * 128 * 144;
#pragma unroll 1
            for (int kk = 0; kk < 4; ++kk) {
                if ((mode == 1 && 32 * kk + 31 < qs * 64) || (mode == 2 && 32 * kk > qs * 64 + 63)) continue;
                bf16x8 ka[2][2];
#pragma unroll
                for (int hf = 0; hf < 2; ++hf)
#pragma unroll
                    for (int ks = 0; ks < 2; ++ks) ka[hf][ks] = *(const LAS bf16x8*)(Kb + (32 * kk + 16 * hf + c) * 144 + ks * 64 + g4 * 16);
                bf16x8 pf[4];
#pragma unroll
                for (int ti = 0; ti < 4; ++ti) {
                    f32x4 sa = (f32x4){-Mb2, -Mb2, -Mb2, -Mb2}, sb = sa;
                    sa = mfma16(ka[0][0], qf[ti][0], sa); sa = mfma16(ka[0][1], qf[ti][1], sa);
                    sb = mfma16(ka[1][0], qf[ti][0], sb); sb = mfma16(ka[1][1], qf[ti][1], sb);
                    float pa[4], pb[4];
#pragma unroll
                    for (int rr = 0; rr < 4; ++rr) { pa[rr] = ex2(sa[rr]); pb[rr] = ex2(sb[rr]); }
                    if (mode != 0) {
                        const int ii = qs * 64 + 16 * ti + c; const int mlo = (mode == 1) ? ii : -1000, mhi = (mode == 2) ? ii : 1000;
#pragma unroll
                        for (int rr = 0; rr < 4; ++rr) { const int ja = 32 * kk + 4 * g4 + rr, jb = ja + 16;
                            pa[rr] = (ja >= mlo && ja <= mhi) ? pa[rr] : 0.f; pb[rr] = (jb >= mlo && jb <= mhi) ? pb[rr] : 0.f; } }
                    lsum[ti] += ((pa[0] + pa[1]) + (pa[2] + pa[3])) + ((pb[0] + pb[1]) + (pb[2] + pb[3]));
                    u32x4 w; w.x = pk2(pa[0], pa[1]); w.y = pk2(pa[2], pa[3]); w.z = pk2(pb[0], pb[1]); w.w = pk2(pb[2], pb[3]); pf[ti] = as_bf16x8(w);
                }
#pragma unroll
                for (int dt = 0; dt < 4; ++dt) {
                    const u32x2 v0 = lds_tr16(Vb + (32 * kk + 4 * g4 + (c >> 2)) * 144 + (16 * dt + 4 * (c & 3)) * 2), v1 = lds_tr16(Vb + (32 * kk + 16 + 4 * g4 + (c >> 2)) * 144 + (16 * dt + 4 * (c & 3)) * 2);
                    u32x4 vv; vv.x = v0.x; vv.y = v0.y; vv.z = v1.x; vv.w = v1.y; const bf16x8 va = as_bf16x8(vv);
#pragma unroll
                    for (int ti = 0; ti < 4; ++ti) O[dt][ti] = mfma16(va, pf[ti], O[dt][ti]);
                }
            }
        }
    }
    const float sk = ex2(p->sink[l * 8 + hh] * LOG2E - Mb2);
#pragma unroll
    for (int ti = 0; ti < 4; ++ti) { float lt = sum_x16_x32(lsum[ti]); const float inv = rcp_(lt + sk);
        bf16* dst = BR + (size_t)(rowbase + q0 + 16 * ti + c) * 512 + hh * 64 + 4 * g4;
#pragma unroll
        for (int dt = 0; dt < 4; ++dt) { const f32x4 o = O[dt][ti] * inv; u32x2 w; w.x = pk2(o[0], o[1]); w.y = pk2(o[2], o[3]); *(u32x2*)(dst + 16 * dt) = w; } }
    __syncthreads();
}

__device__ __forceinline__ void sgu_vprep_item(KPC p, int ch, int tid) {
    bf16* ZA = (bf16*)(p->ws + WS_ZA);
    const int seg = tid & 15;
    bf16* rowp0 = ZA + (size_t)(ch * 128 + (tid >> 4)) * NZA + C_SV + 32 * seg;
    u32x4 raw[4][4];
#pragma unroll
    for (int ps = 0; ps < 4; ++ps)
#pragma unroll
        for (int q = 0; q < 4; ++q) raw[ps][q] = *(const u32x4*)(rowp0 + (size_t)ps * 32 * NZA + 8 * q);
#pragma unroll
    for (int ps = 0; ps < 4; ++ps) {
        bf16* rowp = rowp0 + (size_t)ps * 32 * NZA;
        float f[4][8]; float s = 0.f, ss = 0.f;
#pragma unroll
        for (int q = 0; q < 4; ++q) unpack8(raw[ps][q], f[q]);
#pragma unroll
        for (int q = 0; q < 4; ++q)
#pragma unroll
            for (int e = 0; e < 8; ++e) { const float y = gelu_tanh(f[q][e]); f[q][e] = y; s += y; ss += y * y; }
        s = row_sum(s); ss = row_sum(ss);
        const float mean = s * (1.f / 512.f), var = fmaxf(ss * (1.f / 512.f) - mean * mean, 0.f), rstd = rsq_(var + EPS);
#pragma unroll
        for (int q = 0; q < 4; ++q) {
#pragma unroll
            for (int e = 0; e < 8; ++e) f[q][e] = (f[q][e] - mean) * rstd;
            *(u32x4*)(rowp + 8 * q) = pack8(f[q]); }
    }
}
__device__ __forceinline__ void sgu_block(KPC p, int l, LAS unsigned char* lds, int nchunk, int tid, int lane, int wave, int bid, int G) {
    const bf16* ZA = (const bf16*)(p->ws + WS_ZA); bf16* BR = (bf16*)p->out + (size_t)1 * M * 512;
    const int c = lane & 15, g4 = lane >> 4, tq = c >> 2, tp = c & 3, j = tid >> 2, q4 = tid & 3;
    LAS unsigned char* Vl = lds;
    LAS unsigned char* WL = lds + 34816;
    const int g = bid & 3, cstride = G >> 2; int ch = bid >> 2;
    if ((G & 3) != 0 || ch >= nchunk) return;
    {   const float* wsrc = p->sgu_w + ((size_t)(l * 4 + g) * 128 + j) * 128 + 32 * q4;
#pragma unroll
        for (int q = 0; q < 4; ++q) { const f32x4 a = *(const f32x4*)(wsrc + 8 * q), bq = *(const f32x4*)(wsrc + 8 * q + 4);
            u32x4 w; w.x = pk2(a.x, a.y); w.y = pk2(a.z, a.w); w.z = pk2(bq.x, bq.y); w.w = pk2(bq.z, bq.w);
            *(LAS u32x4*)(WL + j * 272 + (32 * q4 + 8 * q) * 2) = w; } }
    const int col = 128 * g + 16 * wave + 4 * g4;
    u32x4 raw[4]; u32x2 uwn[8]; float bias[8];
#pragma unroll
    for (int ti = 0; ti < 8; ++ti) bias[ti] = p->sgu_b[(l * 4 + g) * 128 + 16 * ti + c];
    {   const bf16* src = ZA + (size_t)(ch * 128 + j) * NZA + C_SV + 128 * g + 32 * q4;
#pragma unroll
        for (int q = 0; q < 4; ++q) raw[q] = *(const u32x4*)(src + 8 * q);
#pragma unroll
        for (int ti = 0; ti < 8; ++ti) uwn[ti] = *(const u32x2*)(ZA + (size_t)(ch * 128 + 16 * ti + c) * NZA + C_SU + col); }
    for (; ch < nchunk; ch += cstride) {
        const int r0 = ch * 128;
        __syncthreads();
#pragma unroll
        for (int q = 0; q < 4; ++q) *(LAS u32x4*)(Vl + j * 272 + (32 * q4 + 8 * q) * 2) = raw[q];
        __syncthreads();
        u32x2 uw[8];
#pragma unroll
        for (int ti = 0; ti < 8; ++ti) uw[ti] = uwn[ti];
        if (ch + cstride < nchunk) { const bf16* src = ZA + (size_t)((ch + cstride) * 128 + j) * NZA + C_SV + 128 * g + 32 * q4;
#pragma unroll
            for (int q = 0; q < 4; ++q) raw[q] = *(const u32x4*)(src + 8 * q);
#pragma unroll
            for (int ti = 0; ti < 8; ++ti) uwn[ti] = *(const u32x2*)(ZA + (size_t)((ch + cstride) * 128 + 16 * ti + c) * NZA + C_SU + col); }
        __builtin_amdgcn_sched_barrier(0);
        bf16x8 af[4];
#pragma unroll
        for (int ks = 0; ks < 4; ++ks) { const u32x2 v0 = lds_tr16(Vl + (32 * ks + 8 * g4 + tq) * 272 + (16 * wave + 4 * tp) * 2), v1 = lds_tr16(Vl + (32 * ks + 8 * g4 + 4 + tq) * 272 + (16 * wave + 4 * tp) * 2);
            u32x4 vv; vv.x = v0.x; vv.y = v0.y; vv.z = v1.x; vv.w = v1.y; af[ks] = as_bf16x8(vv); }
#pragma unroll
        for (int ti = 0; ti < 8; ++ti) {
            f32x4 acc = (f32x4){0.f, 0.f, 0.f, 0.f};
#pragma unroll
            for (int ks = 0; ks < 4; ++ks) acc = mfma16(af[ks], *(const LAS bf16x8*)(WL + (16 * ti + c) * 272 + (32 * ks + 8 * g4) * 2), acc);
            const float o0 = gelu_tanh(bflo(uw[ti].x)) * (acc[0] + bias[ti]), o1 = gelu_tanh(bfhi(uw[ti].x)) * (acc[1] + bias[ti]), o2 = gelu_tanh(bflo(uw[ti].y)) * (acc[2] + bias[ti]), o3 = gelu_tanh(bfhi(uw[ti].y)) * (acc[3] + bias[ti]);
            u32x2 w; w.x = pk2(o0, o1); w.y = pk2(o2, o3); *(u32x2*)(BR + (size_t)(r0 + 16 * ti + c) * 512 + col) = w;
        }
    }
    __syncthreads();
}
__device__ __forceinline__ void sgu_item(KPC p, int l, LAS unsigned char* lds, int item, int tid, int lane, int wave) {
    const bf16* ZA = (const bf16*)(p->ws + WS_ZA); bf16* BR = (bf16*)p->out + (size_t)1 * M * 512;
    const int ch = item >> 2, g = item & 3, r0 = ch * 128, c = lane & 15, g4 = lane >> 4;
    LAS unsigned char* vT = lds;
    LAS unsigned char* WL = lds + 34816;
    {   const int j = tid >> 2, q4 = tid & 3; const bf16* src = ZA + (size_t)(r0 + j) * NZA + C_SV + 128 * g + 32 * q4;
#pragma unroll
        for (int q = 0; q < 4; ++q) { const u32x4 v = *(const u32x4*)(src + 8 * q); const unsigned vw[4] = {v.x, v.y, v.z, v.w};
#pragma unroll
            for (int e = 0; e < 4; ++e) { *(LAS unsigned short*)(vT + (32 * q4 + 8 * q + 2 * e) * 272 + j * 2) = (unsigned short)(vw[e] & 0xffffu); *(LAS unsigned short*)(vT + (32 * q4 + 8 * q + 2 * e + 1) * 272 + j * 2) = (unsigned short)(vw[e] >> 16); } }
        const float* wsrc = p->sgu_w + ((size_t)(l * 4 + g) * 128 + (tid >> 2)) * 128 + 32 * (tid & 3);
#pragma unroll
        for (int q = 0; q < 4; ++q) { const f32x4 a = *(const f32x4*)(wsrc + 8 * q), bq = *(const f32x4*)(wsrc + 8 * q + 4);
            u32x4 w; w.x = pk2(a.x, a.y); w.y = pk2(a.z, a.w); w.z = pk2(bq.x, bq.y); w.w = pk2(bq.z, bq.w);
            *(LAS u32x4*)(WL + (tid >> 2) * 272 + (32 * (tid & 3) + 8 * q) * 2) = w; }
    }
    __syncthreads();
    bf16x8 af[4];
#pragma unroll
    for (int ks = 0; ks < 4; ++ks) af[ks] = *(const LAS bf16x8*)(vT + (16 * wave + c) * 272 + (32 * ks + 8 * g4) * 2);
    const int col = 128 * g + 16 * wave + 4 * g4;
    u32x2 uw[8]; float bias[8];
#pragma unroll
    for (int ti = 0; ti < 8; ++ti) { uw[ti] = *(const u32x2*)(ZA + (size_t)(r0 + 16 * ti + c) * NZA + C_SU + col); bias[ti] = p->sgu_b[(l * 4 + g) * 128 + 16 * ti + c]; }
#pragma unroll
    for (int ti = 0; ti < 8; ++ti) {
        f32x4 acc = (f32x4){0.f, 0.f, 0.f, 0.f};
#pragma unroll
        for (int ks = 0; ks < 4; ++ks) acc = mfma16(af[ks], *(const LAS bf16x8*)(WL + (16 * ti + c) * 272 + (32 * ks + 8 * g4) * 2), acc);
        const float o0 = gelu_tanh(bflo(uw[ti].x)) * (acc[0] + bias[ti]), o1 = gelu_tanh(bfhi(uw[ti].x)) * (acc[1] + bias[ti]), o2 = gelu_tanh(bflo(uw[ti].y)) * (acc[2] + bias[ti]), o3 = gelu_tanh(bfhi(uw[ti].y)) * (acc[3] + bias[ti]);
        u32x2 w; w.x = pk2(o0, o1); w.y = pk2(o2, o3); *(u32x2*)(BR + (size_t)(r0 + 16 * ti + c) * 512 + col) = w;
    }
    __syncthreads();
}

__device__ __forceinline__ void ret_load_k(KPC p, const bf16* ZA, int r0, int h, bool latent, int pos0, int tid, float (&a)[8], float (&bb)[8]) {
    const int j = tid >> 2, q4 = tid & 3; const bf16* src = ZA + (size_t)(r0 + j) * NZA + C_RK + 64 * h + 8 * q4;
    unpack8(*(const u32x4*)src, a); unpack8(*(const u32x4*)(src + 32), bb);
    if (latent) { const float* rc = (const float*)(p->ws + WS_ROPEC); const float* rsn = (const float*)(p->ws + WS_ROPES); const int pos = pos0 + j; float cs8[8], sn8[8]; ld8f(rc + pos * 32 + 8 * q4, cs8); ld8f(rsn + pos * 32 + 8 * q4, sn8);
#pragma unroll
        for (int e = 0; e < 8; ++e) { const float cs = cs8[e], sn = sn8[e]; const float x1 = a[e], x2 = bb[e]; a[e] = x1 * cs - x2 * sn; bb[e] = x1 * sn + x2 * cs; } }
#pragma unroll
    for (int e = 0; e < 8; ++e) { a[e] *= 0.125f; bb[e] *= 0.125f; }
}
__device__ __forceinline__ void ret_stage_vT(const bf16* ZA, int r0, int h, LAS unsigned char* vT, int tid) {
    const int j = tid >> 2, q4 = tid & 3; const bf16* src = ZA + (size_t)(r0 + j) * NZA + C_RV + 128 * h + 32 * q4;
#pragma unroll
    for (int q = 0; q < 4; ++q) { const u32x4 v = *(const u32x4*)(src + 8 * q); const unsigned vw[4] = {v.x, v.y, v.z, v.w};
#pragma unroll
        for (int e = 0; e < 4; ++e) { *(LAS unsigned short*)(vT + (32 * q4 + 8 * q + 2 * e) * 272 + j * 2) = (unsigned short)(vw[e] & 0xffffu); *(LAS unsigned short*)(vT + (32 * q4 + 8 * q + 2 * e + 1) * 272 + j * 2) = (unsigned short)(vw[e] >> 16); } }
}
__device__ __forceinline__ void ret_upd_block(KPC p, int l, LAS unsigned char* lds, int first, int stride, int total, int tid, int lane, int wave) {
    const bf16* ZA = (const bf16*)(p->ws + WS_ZA); float* RS = (float*)(p->ws + WS_RS);
    const float* rc = (const float*)(p->ws + WS_ROPEC); const float* rsn = (const float*)(p->ws + WS_ROPES);
    const int c = lane & 15, g4 = lane >> 4, tq = c >> 2, tp = c & 3, j = tid >> 2, q4 = tid & 3;
    LAS unsigned char* Vl = lds; LAS unsigned char* Kf = lds + 34816; LAS unsigned char* Kb = lds + 34816 + 18432;
    u32x4 k0, k1, v[4]; f32x4 c0, c1, s0, s1;
#define UPD_DECODE(it_) const int b = (it_) / (NCH * 4), rem = (it_) % (NCH * 4), n = rem >> 2, h = rem & 3; const bool latent = n < 32; const int r0 = latent ? b * T + 128 * n : ML + b * CL + 128 * (n - 32)
#define UPD_LOAD(it_) do { UPD_DECODE(it_); const bf16* ks = ZA + (size_t)(r0 + j) * NZA + C_RK + 64 * h + 8 * q4; k0 = *(const u32x4*)ks; k1 = *(const u32x4*)(ks + 32); \
        if (latent) { const int pos = 128 * n + j; c0 = *(const f32x4*)(rc + pos * 32 + 8 * q4); c1 = *(const f32x4*)(rc + pos * 32 + 8 * q4 + 4); s0 = *(const f32x4*)(rsn + pos * 32 + 8 * q4); s1 = *(const f32x4*)(rsn + pos * 32 + 8 * q4 + 4); } \
        const bf16* vs = ZA + (size_t)(r0 + j) * NZA + C_RV + 128 * h + 32 * q4; _Pragma("unroll") for (int q = 0; q < 4; ++q) v[q] = *(const u32x4*)(vs + 8 * q); } while (0)
    int it = first;
    if (it < total) UPD_LOAD(it);
    for (; it < total; it += stride) {
        UPD_DECODE(it); (void)r0;
        const float lgf = ((const float*)(p->ws + WS_LG))[l * 8 + h], lgb = ((const float*)(p->ws + WS_LG))[l * 8 + 4 + h];
        __syncthreads();
        {   float a[8], bb[8]; unpack8(k0, a); unpack8(k1, bb);
            if (latent) {
#pragma unroll
                for (int e = 0; e < 8; ++e) { const float cs = (e < 4) ? c0[e & 3] : c1[e & 3], sn = (e < 4) ? s0[e & 3] : s1[e & 3]; const float x1 = a[e], x2 = bb[e]; a[e] = x1 * cs - x2 * sn; bb[e] = x1 * sn + x2 * cs; } }
            const float wf = 0.125f * ex2((float)(127 - j) * lgf), wb = 0.125f * ex2((float)j * lgb);
            float af_[8], bf_[8], ab_[8], bb_[8];
#pragma unroll
            for (int e = 0; e < 8; ++e) { af_[e] = a[e] * wf; bf_[e] = bb[e] * wf; ab_[e] = a[e] * wb; bb_[e] = bb[e] * wb; }
            *(LAS u32x4*)(Kf + j * 144 + 16 * q4) = pack8(af_); *(LAS u32x4*)(Kf + j * 144 + 64 + 16 * q4) = pack8(bf_);
            *(LAS u32x4*)(Kb + j * 144 + 16 * q4) = pack8(ab_); *(LAS u32x4*)(Kb + j * 144 + 64 + 16 * q4) = pack8(bb_);
#pragma unroll
            for (int q = 0; q < 4; ++q) *(LAS u32x4*)(Vl + j * 272 + (32 * q4 + 8 * q) * 2) = v[q];
        }
        __syncthreads();
        if (it + stride < total) UPD_LOAD(it + stride);
        __builtin_amdgcn_sched_barrier(0);
        bf16x8 af[4];
#pragma unroll
        for (int ks = 0; ks < 4; ++ks) { const u32x2 v0 = lds_tr16(Vl + (32 * ks + 8 * g4 + tq) * 272 + (16 * wave + 4 * tp) * 2), v1 = lds_tr16(Vl + (32 * ks + 8 * g4 + 4 + tq) * 272 + (16 * wave + 4 * tp) * 2);
            u32x4 vv; vv.x = v0.x; vv.y = v0.y; vv.z = v1.x; vv.w = v1.y; af[ks] = as_bf16x8(vv); }
#pragma unroll
        for (int dir = 0; dir < 2; ++dir) { const LAS unsigned char* Kx = dir ? Kb : Kf;
            float* dst = RS + ((size_t)(((b * 4 + h) * 2 + dir) * NCH + n) * 128 + 16 * wave + c) * 64 + 4 * g4;
#pragma unroll
            for (int dt = 0; dt < 4; ++dt) { f32x4 acc = (f32x4){0.f, 0.f, 0.f, 0.f};
#pragma unroll
                for (int ks = 0; ks < 4; ++ks) { const u32x2 kk0 = lds_tr16(Kx + (32 * ks + 8 * g4 + tq) * 144 + (16 * dt + 4 * tp) * 2), kk1 = lds_tr16(Kx + (32 * ks + 8 * g4 + 4 + tq) * 144 + (16 * dt + 4 * tp) * 2);
                    u32x4 kv; kv.x = kk0.x; kv.y = kk0.y; kv.z = kk1.x; kv.w = kk1.y; acc = mfma16(as_bf16x8(kv), af[ks], acc); }
                *(f32x4*)(dst + 16 * dt) = acc; } }
    }
#undef UPD_DECODE
#undef UPD_LOAD
    __syncthreads();
}
__device__ __forceinline__ void ret_upd_item(KPC p, int l, LAS unsigned char* lds, int item, int tid, int lane, int wave) {
    const bf16* ZA = (const bf16*)(p->ws + WS_ZA); float* RS = (float*)(p->ws + WS_RS);
    const int b = item / (NCH * 4), rem = item % (NCH * 4), n = rem >> 2, h = rem & 3, c = lane & 15, g4 = lane >> 4;
    const bool latent = n < 32; const int r0 = latent ? b * T + 128 * n : ML + b * CL + 128 * (n - 32);
    const float lgf = ((const float*)(p->ws + WS_LG))[l * 8 + h], lgb = ((const float*)(p->ws + WS_LG))[l * 8 + 4 + h];
    LAS unsigned char* Vl = lds; LAS unsigned char* Kf = lds + 34816; LAS unsigned char* Kb = lds + 34816 + 18432;
    {   float a[8], bb[8]; ret_load_k(p, ZA, r0, h, latent, 128 * n, tid, a, bb);
        const int j = tid >> 2, q4 = tid & 3; const float wf = ex2((float)(127 - j) * lgf), wb = ex2((float)j * lgb);
        float af_[8], bf_[8], ab_[8], bb_[8];
#pragma unroll
        for (int e = 0; e < 8; ++e) { af_[e] = a[e] * wf; bf_[e] = bb[e] * wf; ab_[e] = a[e] * wb; bb_[e] = bb[e] * wb; }
        *(LAS u32x4*)(Kf + j * 144 + 16 * q4) = pack8(af_); *(LAS u32x4*)(Kf + j * 144 + 64 + 16 * q4) = pack8(bf_);
        *(LAS u32x4*)(Kb + j * 144 + 16 * q4) = pack8(ab_); *(LAS u32x4*)(Kb + j * 144 + 64 + 16 * q4) = pack8(bb_);
        const bf16* vs = ZA + (size_t)(r0 + j) * NZA + C_RV + 128 * h + 32 * q4;
#pragma unroll
        for (int q = 0; q < 4; ++q) *(LAS u32x4*)(Vl + j * 272 + (32 * q4 + 8 * q) * 2) = *(const u32x4*)(vs + 8 * q);
    }
    __syncthreads();
    const int tq = c >> 2, tp = c & 3;
    bf16x8 af[4];
#pragma unroll
    for (int ks = 0; ks < 4; ++ks) { const u32x2 v0 = lds_tr16(Vl + (32 * ks + 8 * g4 + tq) * 272 + (16 * wave + 4 * tp) * 2), v1 = lds_tr16(Vl + (32 * ks + 8 * g4 + 4 + tq) * 272 + (16 * wave + 4 * tp) * 2);
        u32x4 vv; vv.x = v0.x; vv.y = v0.y; vv.z = v1.x; vv.w = v1.y; af[ks] = as_bf16x8(vv); }
#pragma unroll
    for (int dir = 0; dir < 2; ++dir) { const LAS unsigned char* Kx = dir ? Kb : Kf;
        float* dst = RS + ((size_t)(((b * 4 + h) * 2 + dir) * NCH + n) * 128 + 16 * wave + c) * 64 + 4 * g4;
#pragma unroll
        for (int dt = 0; dt < 4; ++dt) { f32x4 acc = (f32x4){0.f, 0.f, 0.f, 0.f};
#pragma unroll
            for (int ks = 0; ks < 4; ++ks) { const u32x2 k0 = lds_tr16(Kx + (32 * ks + 8 * g4 + tq) * 144 + (16 * dt + 4 * tp) * 2), k1 = lds_tr16(Kx + (32 * ks + 8 * g4 + 4 + tq) * 144 + (16 * dt + 4 * tp) * 2);
                u32x4 kv; kv.x = k0.x; kv.y = k0.y; kv.z = k1.x; kv.w = k1.y; acc = mfma16(as_bf16x8(kv), af[ks], acc); }
            *(f32x4*)(dst + 16 * dt) = acc; } }
    __syncthreads();
}
__device__ __forceinline__ void phase_scan(KPC p, int l, int tid, int bid, int G) {
    const float* __restrict__ RS = (const float*)(p->ws + WS_RS); bf16* __restrict__ ST = (bf16*)(p->ws + WS_ST);
    for (int idx = bid * 512 + tid; idx < NB * 4 * 2 * 8192; idx += G * 512) {
        const int ed = idx & 8191, dir = (idx >> 13) & 1, bh = idx >> 14, e = ed >> 6, d = ed & 63, h = bh & 3;
        const float* P = RS + (size_t)((bh * 2 + dir) * NCH) * 8192 + ed;
        bf16* S = ST + ((size_t)bh * NCH * 128 + e) * 128 + dir * 64 + d;
        const float lg = ((const float*)(p->ws + WS_LG))[l * 8 + dir * 4 + h]; const float dec = ex2(128.f * lg);
        float u[NCH];
#pragma unroll
        for (int n = 0; n < NCH; ++n) u[n] = P[(size_t)n * 8192];
        if (dir == 0) {
            S[32 * 16384] = 0; S[33 * 16384] = (bf16)(pk2(u[32], 0.f) & 0xffffu);
            float s = dec * u[32] + u[33];
#pragma unroll
            for (int n = 0; n < 32; ++n) { S[(size_t)n * 16384] = (bf16)(pk2(s, 0.f) & 0xffffu); s = dec * s + u[n]; }
        } else {
            S[33 * 16384] = 0; S[32 * 16384] = (bf16)(pk2(u[33], 0.f) & 0xffffu);
            float s = dec * u[33] + u[32];
#pragma unroll
            for (int n = 31; n >= 0; --n) { S[(size_t)n * 16384] = (bf16)(pk2(s, 0.f) & 0xffffu); s = dec * s + u[n]; }
        }
    }
}
__device__ __forceinline__ void ret_out_item(KPC p, int l, LAS unsigned char* lds, int item, int tid, int lane, int wave) {
    const bf16* ZA = (const bf16*)(p->ws + WS_ZA); bf16* BR = (bf16*)p->out; const bf16* ST = (const bf16*)(p->ws + WS_ST);
    const int b = item / (NCH * 4), rem = item % (NCH * 4), n = rem >> 2, h = rem & 3, c = lane & 15, g4 = lane >> 4;
    const bool latent = n < 32; const int r0 = latent ? b * T + 128 * n : ML + b * CL + 128 * (n - 32);
    const float lgf = ((const float*)(p->ws + WS_LG))[l * 8 + h], lgb = ((const float*)(p->ws + WS_LG))[l * 8 + 4 + h];
    LAS unsigned char* vT = lds; LAS unsigned char* Kl = lds + 34816; LAS unsigned char* Sl = lds + 34816 + 18432;
    {   float a[8], bb[8]; ret_load_k(p, ZA, r0, h, latent, 128 * n, tid, a, bb);
        const int j = tid >> 2, q4 = tid & 3;
        *(LAS u32x4*)(Kl + j * 144 + 16 * q4) = pack8(a); *(LAS u32x4*)(Kl + j * 144 + 64 + 16 * q4) = pack8(bb);
        ret_stage_vT(ZA, r0, h, vT, tid);
        const u32x4* ssrc = (const u32x4*)(ST + (size_t)((b * 4 + h) * NCH + n) * 16384);
#pragma unroll
        for (int k = 0; k < 4; ++k) { const int q = tid + 512 * k; *(LAS u32x4*)(Sl + (q >> 4) * 272 + (q & 15) * 16) = ssrc[q]; }
    }
    __syncthreads();
    const int ii = 16 * wave + c;
    bf16x8 qf[2];
    {   const bf16* src = ZA + (size_t)(r0 + ii) * NZA + C_RQ + 64 * h + 8 * g4; float a[8], bb[8]; unpack8(*(const u32x4*)src, a); unpack8(*(const u32x4*)(src + 32), bb);
        if (latent) { const float* rc = (const float*)(p->ws + WS_ROPEC); const float* rsn = (const float*)(p->ws + WS_ROPES); const int pos = 128 * n + ii; float cs8[8], sn8[8]; ld8f(rc + pos * 32 + 8 * g4, cs8); ld8f(rsn + pos * 32 + 8 * g4, sn8);
#pragma unroll
            for (int e = 0; e < 8; ++e) { const float cs = cs8[e], sn = sn8[e]; const float x1 = a[e], x2 = bb[e]; a[e] = x1 * cs - x2 * sn; bb[e] = x1 * sn + x2 * cs; } }
        qf[0] = as_bf16x8(pack8(a)); qf[1] = as_bf16x8(pack8(bb)); }
    bf16x8 pf[4];
#pragma unroll
    for (int kk = 0; kk < 4; ++kk) {
        f32x4 sa = (f32x4){0.f, 0.f, 0.f, 0.f}, sb = (f32x4){0.f, 0.f, 0.f, 0.f};
        sa = mfma16(*(const LAS bf16x8*)(Kl + (32 * kk + c) * 144 + g4 * 16), qf[0], sa); sa = mfma16(*(const LAS bf16x8*)(Kl + (32 * kk + c) * 144 + 64 + g4 * 16), qf[1], sa);
        sb = mfma16(*(const LAS bf16x8*)(Kl + (32 * kk + 16 + c) * 144 + g4 * 16), qf[0], sb); sb = mfma16(*(const LAS bf16x8*)(Kl + (32 * kk + 16 + c) * 144 + 64 + g4 * 16), qf[1], sb);
        float pa[4], pb[4];
#pragma unroll
        for (int rr = 0; rr < 4; ++rr) { const int ja = 32 * kk + 4 * g4 + rr, jb = ja + 16; const int da = ii - ja, db = ii - jb;
            pa[rr] = sa[rr] * ((da >= 0) ? ex2((float)da * lgf) : ex2((float)(-da) * lgb)); pb[rr] = sb[rr] * ((db >= 0) ? ex2((float)db * lgf) : ex2((float)(-db) * lgb)); }
        u32x4 w; w.x = pk2(pa[0], pa[1]); w.y = pk2(pa[2], pa[3]); w.z = pk2(pb[0], pb[1]); w.w = pk2(pb[2], pb[3]); pf[kk] = as_bf16x8(w);
    }
    const float cf = ex2((float)(ii + 1) * lgf), cb = ex2((float)(128 - ii) * lgb);
    f32x4 O[8]; float s = 0.f, ss = 0.f;
#pragma unroll
    for (int et = 0; et < 8; ++et) {
        f32x4 acc = (f32x4){0.f, 0.f, 0.f, 0.f}, xf = (f32x4){0.f, 0.f, 0.f, 0.f}, xb = (f32x4){0.f, 0.f, 0.f, 0.f};
#pragma unroll
        for (int kk = 0; kk < 4; ++kk) { const u32x2 v0 = *(const LAS u32x2*)(vT + (16 * et + c) * 272 + (32 * kk + 4 * g4) * 2), v1 = *(const LAS u32x2*)(vT + (16 * et + c) * 272 + (32 * kk + 16 + 4 * g4) * 2);
            u32x4 vv; vv.x = v0.x; vv.y = v0.y; vv.z = v1.x; vv.w = v1.y; acc = mfma16(as_bf16x8(vv), pf[kk], acc); }
#pragma unroll
        for (int ks = 0; ks < 2; ++ks) { xf = mfma16(*(const LAS bf16x8*)(Sl + (16 * et + c) * 272 + (32 * ks + 8 * g4) * 2), qf[ks], xf);
            xb = mfma16(*(const LAS bf16x8*)(Sl + (16 * et + c) * 272 + (64 + 32 * ks + 8 * g4) * 2), qf[ks], xb); }
        acc = acc + xf * cf + xb * cb; O[et] = acc;
        s += (acc[0] + acc[1]) + (acc[2] + acc[3]); ss += (acc[0] * acc[0] + acc[1] * acc[1]) + (acc[2] * acc[2] + acc[3] * acc[3]);
    }
    s = sum_x16_x32(s); ss = sum_x16_x32(ss);
    const float mean = s * (1.f / 128.f), var = fmaxf(ss * (1.f / 128.f) - mean * mean, 0.f), rstd = rsq_(var + EPS);
    const bf16* gsrc = ZA + (size_t)(r0 + ii) * NZA + C_RG + 128 * h + 4 * g4; bf16* dst = BR + (size_t)(r0 + ii) * 512 + 128 * h + 4 * g4;
#pragma unroll
    for (int et = 0; et < 8; ++et) { const u32x2 gw = *(const u32x2*)(gsrc + 16 * et); const float g0 = bflo(gw.x), g1 = bfhi(gw.x), g2 = bflo(gw.y), g3 = bfhi(gw.y);
        const float o0 = (O[et][0] - mean) * rstd * g0 * sigmoidf_(g0), o1 = (O[et][1] - mean) * rstd * g1 * sigmoidf_(g1), o2 = (O[et][2] - mean) * rstd * g2 * sigmoidf_(g2), o3 = (O[et][3] - mean) * rstd * g3 * sigmoidf_(g3);
        u32x2 w; w.x = pk2(o0, o1); w.y = pk2(o2, o3); *(u32x2*)(dst + 16 * et) = w; }
    __syncthreads();
}

__device__ __forceinline__ int wr_off(int k) { return k * 64 + (k >> 2) * 16; }
__device__ __forceinline__ void phase_norm2(KPC p, int l, LAS unsigned char* lds, int tid, int lane, int wave, int bid, int G) {
    if (l == 1 || G != 256) { convert_experts(p, l, 0, CVT_ITEMS, bid * 8 + wave, G * 8, lds, lane, wave); __syncthreads(); }
    LAS unsigned char* wrl = lds + 69632;
    for (int i = tid; i < 1024 * 4; i += 512) { const int k = i >> 2, q = i & 3; *(LAS f32x4*)(wrl + wr_off(k) + 16 * q) = *(const f32x4*)(p->w_router + (size_t)l * 16384 + k * 16 + 4 * q); }
    __syncthreads();
    const float* modv = (const float*)(p->ws + WS_MODV) + l * 9 * 6144; const bf16* X = (const bf16*)(p->ws + WS_X); bf16* H = (bf16*)(p->ws + WS_H);
    float* AFF = (float*)(p->ws + WS_AFF); float* AFFC = (float*)(p->ws + WS_AFFC); int* INV = (int*)(p->ws + WS_INV);
    const int rows = (l == 0) ? M : ML, stride = G * 8;
    {
    int r = bid * 8 + wave;
    u32x2 vn[4];
#pragma unroll
    for (int j = 0; j < 4; ++j) vn[j] = (r < rows) ? *(const u32x2*)(X + (size_t)r * 1024 + 4 * lane + 256 * j) : (u32x2){0u, 0u};
    for (; r < rows; r += stride) {
        const int bi = (r < ML) ? (r >> 12) : 8; const float* mv = modv + bi * 6144;
        f32x4 v[4], h[4], g[4], sc[4], sh[4];
#pragma unroll
        for (int j = 0; j < 4; ++j) { v[j] = (f32x4){bflo(vn[j].x), bfhi(vn[j].x), bflo(vn[j].y), bfhi(vn[j].y)}; const int col = 4 * lane + 256 * j; g[j] = *(const f32x4*)(p->norm2_g + l * 1024 + col); sh[j] = *(const f32x4*)(mv + 3 * 1024 + col); sc[j] = *(const f32x4*)(mv + 4 * 1024 + col); }
        const int rn = r + stride;
        if (rn < rows) {
#pragma unroll
            for (int j = 0; j < 4; ++j) vn[j] = *(const u32x2*)(X + (size_t)rn * 1024 + 4 * lane + 256 * j); }
        const float rs = row_rs(v);
#pragma unroll
        for (int j = 0; j < 4; ++j) h[j] = (v[j] * rs) * g[j] * (sc[j] + 1.0f) + sh[j];
        store_h(h, H + (size_t)r * 1024, lane);
        float lg[16];
#pragma unroll
        for (int e = 0; e < 16; ++e) lg[e] = 0.f;
#pragma unroll
        for (int j = 0; j < 4; ++j)
#pragma unroll
            for (int i = 0; i < 4; ++i) { const int k = 4 * lane + 256 * j + i; const float hv = h[j][i]; const LAS f32x4* wp = (const LAS f32x4*)(wrl + wr_off(k));
#pragma unroll
                for (int q = 0; q < 4; ++q) { const f32x4 w = wp[q]; lg[4 * q] += hv * w.x; lg[4 * q + 1] += hv * w.y; lg[4 * q + 2] += hv * w.z; lg[4 * q + 3] += hv * w.w; } }
        float mx = -1e30f;
#pragma unroll
        for (int e = 0; e < 16; ++e) { lg[e] = wave_sum(lg[e]); mx = fmaxf(mx, lg[e]); }
        float sum = 0.f;
#pragma unroll
        for (int e = 0; e < 16; ++e) { lg[e] = ex2((lg[e] - mx) * LOG2E); sum += lg[e]; }
        const float isum = rcp_(sum); float mine = 0.f;
#pragma unroll
        for (int e = 0; e < 16; ++e) mine = (lane == e) ? lg[e] * isum : mine;
        if (lane < 16) { if (r < ML) AFF[((size_t)(bi * 16 + lane) << 12) + (r & 4095)] = mine; else AFFC[((r - ML) >> 8) * 4096 + lane * 256 + ((r - ML) & 255)] = mine;
            INV[(size_t)r * 16 + lane] = -1; }
    }
    }
}

__device__ __forceinline__ int block_sum_i(int v, LAS int* red, int buf, int lane, int wave) {
    v = wave_sum_i(v);
    if (lane == 0) red[buf * 8 + wave] = v;
    __syncthreads();
    int s = 0;
#pragma unroll
    for (int w = 0; w < 8; ++w) s += red[buf * 8 + w];
    return s;
}
__device__ __forceinline__ int block_excl_scan(int v, LAS int* red, int buf, int lane, int wave) {
    int inc = v;
#pragma unroll
    for (int o = 1; o < 64; o <<= 1) { const int t = __builtin_amdgcn_ds_bpermute((lane - o) << 2, inc); if (lane >= o) inc += t; }
    if (lane == 63) red[buf * 8 + wave] = inc;
    __syncthreads();
    int base = 0;
#pragma unroll
    for (int w = 0; w < 8; ++w) { const int x = red[buf * 8 + w]; if (w < wave) base += x; }
    return base + inc - v;
}
template <int KPT>
__device__ __forceinline__ void topk_item(KPC p, const float* aff, int n, int cap, int rowbase, int e, int slotbase, int s_lo, int s_hi, bool writer, LAS unsigned char* lds, int tid, int lane, int wave) {
    const bf16* H = (const bf16*)(p->ws + WS_H); bf16* XS = (bf16*)(p->ws + WS_XS); float* topw = (float*)(p->ws + WS_TOPW); int* INV = (int*)(p->ws + WS_INV);
    LAS int* red = (LAS int*)lds; LAS int* rl = (LAS int*)(lds + 128);
    unsigned key[KPT]; const bool valid = tid * KPT < n;
#pragma unroll
    for (int j = 0; j < KPT; ++j) key[j] = valid ? __float_as_uint(aff[tid * KPT + j]) : 0u;
    unsigned Tsel = 0u;
    for (int bit = 30; bit >= 0; --bit) { const unsigned cand = Tsel | (1u << bit); int cnt = 0;
#pragma unroll
        for (int j = 0; j < KPT; ++j) cnt += (valid && key[j] >= cand) ? 1 : 0;
        if (block_sum_i(cnt, red, bit & 1, lane, wave) >= cap) Tsel = cand; }
    int cgt = 0, ceq = 0;
#pragma unroll
    for (int j = 0; j < KPT; ++j) { cgt += (valid && key[j] > Tsel) ? 1 : 0; ceq += (valid && key[j] == Tsel) ? 1 : 0; }
    const int need = cap - block_sum_i(cgt, red, 1, lane, wave);
    int er = block_excl_scan(ceq, red, 2, lane, wave);
    bool sel[KPT]; int nsel = 0;
#pragma unroll
    for (int j = 0; j < KPT; ++j) { const bool iseq = valid && key[j] == Tsel; sel[j] = valid && (key[j] > Tsel || (iseq && er < need)); er += iseq ? 1 : 0; nsel += sel[j] ? 1 : 0; }
    int slot = block_excl_scan(nsel, red, 3, lane, wave);
#pragma unroll
    for (int j = 0; j < KPT; ++j) if (sel[j]) { const int t = tid * KPT + j; if (slot < cap) { rl[slot] = t; if (writer) { topw[e * ME + slotbase + slot] = __uint_as_float(key[j]); INV[(size_t)(rowbase + t) * 16 + e] = slotbase + slot; } } ++slot; }
    __syncthreads();
    for (int s = s_lo + wave * 4; s < s_hi; s += 32) {
        u32x4 a[4][2];
#pragma unroll
        for (int q = 0; q < 4; ++q) { const int t = rl[s + q]; const u32x4* src = (const u32x4*)(H + (size_t)(rowbase + t) * 1024); a[q][0] = src[lane]; a[q][1] = src[lane + 64]; }
#pragma unroll
        for (int q = 0; q < 4; ++q) { u32x4* dst = (u32x4*)(XS + ((size_t)e * ME + slotbase + s + q) * 1024); dst[lane] = a[q][0]; dst[lane + 64] = a[q][1]; }
    }
    __syncthreads();
}
__device__ __forceinline__ void phase_topk(KPC p, int l, LAS unsigned char* lds, int tid, int lane, int wave, int bid, int G) {
    const float* AFF = (const float*)(p->ws + WS_AFF); const float* AFFC = (const float*)(p->ws + WS_AFFC);
    const int nitem = (l == 0) ? 384 : 256;
    for (int it = bid; it < nitem; it += G) {
        if (it < 256) { const int q = it >> 1, hf = it & 1, b = q >> 4, e = q & 15; topk_item<8>(p, AFF + ((size_t)(b * 16 + e) << 12), 4096, CAPL, b * T, e, b * CAPL, hf * 256, hf * 256 + 256, hf == 0, lds, tid, lane, wave); }
        else { const int q = it - 256, b = q >> 4, e = q & 15; topk_item<1>(p, AFFC + (b * 16 + e) * 256, 256, CAPC, ML + b * CL, e, NB * CAPL + b * CAPC, 0, CAPC, true, lds, tid, lane, wave); }
    }
}

__device__ __forceinline__ void phase_combine(KPC p, int l, LAS unsigned char* lds, int tid, int lane, int wave, int bid, int G) {
    const float* modv = (const float*)(p->ws + WS_MODV); bf16* X = (bf16*)(p->ws + WS_X); bf16* H = (bf16*)(p->ws + WS_H);
    const bf16* Y = (const bf16*)(p->ws + WS_XS); const int* INV = (const int*)(p->ws + WS_INV);
    const int rows = (l == 0) ? M : ML, stride = G * 8;
    int r = bid * 8 + wave;
    int slot_next = (lane < 16 && r < rows) ? INV[(size_t)r * 16 + lane] : -1;
    u32x2 vn[4];
#pragma unroll
    for (int j = 0; j < 4; ++j) vn[j] = (r < rows) ? *(const u32x2*)(X + (size_t)r * 1024 + 4 * lane + 256 * j) : (u32x2){0u, 0u};
    for (; r < rows; r += stride) {
        const int bi = (r < ML) ? (r >> 12) : 8;
        const int myslot = slot_next; const int rn = r + stride;
        slot_next = (lane < 16 && rn < rows) ? INV[(size_t)rn * 16 + lane] : -1;
        f32x4 v[4], acc[4], g2v[4];
        const float* g2 = modv + (l * 9 + bi) * 6144 + 5 * 1024;
#pragma unroll
        for (int j = 0; j < 4; ++j) { v[j] = (f32x4){bflo(vn[j].x), bfhi(vn[j].x), bflo(vn[j].y), bfhi(vn[j].y)}; acc[j] = (f32x4){0.f, 0.f, 0.f, 0.f}; g2v[j] = *(const f32x4*)(g2 + 4 * lane + 256 * j); }
        unsigned mask = (unsigned)(__builtin_amdgcn_ballot_w64(myslot >= 0) & 0xffffull);
        bool first = true;
        while (mask || first) {
          if (mask) {
            const int e0 = __builtin_ctz(mask); mask &= mask - 1u; const int s0 = __builtin_amdgcn_readlane(myslot, e0);
            const bool has1 = mask != 0u; const int e1 = has1 ? __builtin_ctz(mask) : e0; if (has1) mask &= mask - 1u; const int s1 = __builtin_amdgcn_readlane(myslot, e1);
            const bf16* ya = Y + ((size_t)e0 * ME + s0) * 1024; const bf16* yb = Y + ((size_t)e1 * ME + s1) * 1024;
            u32x2 wa[4], wb[4];
#pragma unroll
            for (int j = 0; j < 4; ++j) wa[j] = *(const u32x2*)(ya + 4 * lane + 256 * j);
#pragma unroll
            for (int j = 0; j < 4; ++j) wb[j] = *(const u32x2*)(yb + 4 * lane + 256 * j);
            if (first && rn < rows) {
#pragma unroll
                for (int j = 0; j < 4; ++j) vn[j] = *(const u32x2*)(X + (size_t)rn * 1024 + 4 * lane + 256 * j); }
            first = false;
            const float kb = has1 ? 1.0f : 0.0f;
#pragma unroll
            for (int j = 0; j < 4; ++j) { acc[j] += (f32x4){bflo(wa[j].x), bfhi(wa[j].x), bflo(wa[j].y), bfhi(wa[j].y)}; acc[j] += (f32x4){bflo(wb[j].x), bfhi(wb[j].x), bflo(wb[j].y), bfhi(wb[j].y)} * kb; }
          } else {
            if (rn < rows) {
#pragma unroll
                for (int j = 0; j < 4; ++j) vn[j] = *(const u32x2*)(X + (size_t)rn * 1024 + 4 * lane + 256 * j); }
            first = false;
          }
        }
#pragma unroll
        for (int j = 0; j < 4; ++j) v[j] = v[j] + g2v[j] * acc[j];
        if (l == 0) {
#pragma unroll
            for (int j = 0; j < 4; ++j) { u32x2 w; w.x = pk2(v[j].x, v[j].y); w.y = pk2(v[j].z, v[j].w); *(u32x2*)(X + (size_t)r * 1024 + 4 * lane + 256 * j) = w; }
            const float rs = row_rs(v); f32x4 h[4];
            norm_mod(v, rs, p->norm1_g + 1024, modv + (9 + bi) * 6144, modv + (9 + bi) * 6144 + 1024, h, lane);
            store_h(h, H + (size_t)r * 1024, lane);
        } else {
#pragma unroll
            for (int j = 0; j < 4; ++j) *(f32x4*)(p->out + (size_t)r * 1024 + 4 * lane + 256 * j) = v[j];
        }
    }
    if (l == 0) convert_small(p, 1, lds, lane, wave, bid, G);
}

#define XB_TMO      128
#define XB_XCNT(j)  (256  + 64 * (j))
#define XB_XSUB(j)  (1280 + 64 * (j))
#define XB_XGEN(j)  (2304 + 64 * (j))
#define XB_TOP      3328
#define XB_TOPGEN   3392
#define XCD_BAR_WORDS 3456
#define XB_SPIN_CAP (1u << 18)

__device__ __forceinline__ unsigned xb_ld(unsigned* p)              { return __hip_atomic_load(p, __ATOMIC_RELAXED, __HIP_MEMORY_SCOPE_AGENT); }
__device__ __forceinline__ unsigned xb_add(unsigned* p, unsigned v) { return __hip_atomic_fetch_add(p, v, __ATOMIC_RELAXED, __HIP_MEMORY_SCOPE_AGENT); }
__device__ __forceinline__ unsigned xb_xcc_id() { return (unsigned)__builtin_amdgcn_s_getreg((3 << 11) | 20) & 0xFu; }
#define XB_SPIN(cond, bar) do { unsigned _sp = 0; while (cond) { __builtin_amdgcn_s_sleep(1); \
    if ((++_sp & 255u) == 0u) { if (xb_ld(&(bar)[XB_TMO])) break; if (_sp > XB_SPIN_CAP) { atomicAdd(&(bar)[XB_TMO], 1u); break; } } } } while (0)

struct XcdBarrier {
    unsigned* bar; unsigned x;
    volatile LAS unsigned* st;
};

__device__ __forceinline__ XcdBarrier xcd_barrier_post(unsigned* bar, volatile LAS unsigned* st) {
    XcdBarrier b; b.bar = bar; b.x = xb_xcc_id(); b.st = st;
    if (threadIdx.x == 0) (void)xb_add(&bar[XB_XCNT(b.x)], 1u);
    return b;
}
__device__ __forceinline__ void xcd_barrier_complete(unsigned* bar, unsigned x, unsigned& nloc, unsigned& nx) {
    const unsigned G = gridDim.x * gridDim.y * gridDim.z;
    unsigned sum, cnt, mine, sp = 0u;
    for (;;) {
        sum = 0u; cnt = 0u; mine = 0u;
#pragma unroll
        for (unsigned j = 0; j < 16; ++j) { const unsigned c = xb_ld(&bar[XB_XCNT(j)]); sum += c; cnt += (c > 0u) ? 1u : 0u; mine = (j == x) ? c : mine; }
        if (sum == G) break;
        __builtin_amdgcn_s_sleep(1);
        if ((++sp & 255u) == 0u) { if (xb_ld(&bar[XB_TMO])) break; if (sp > XB_SPIN_CAP) { atomicAdd(&bar[XB_TMO], 1u); break; } }
    }
    nloc = mine > 0u ? mine : 1u; nx = cnt > 0u ? cnt : 1u;
}

__device__ __forceinline__ void xcd_barrier(const XcdBarrier& b) {
    asm volatile("s_waitcnt vmcnt(0)" ::: "memory");
    __syncthreads();
    if (threadIdx.x == 0) {
        unsigned* bar = b.bar;
        __builtin_amdgcn_s_waitcnt(0);
        unsigned nloc = b.st[0], nx = b.st[1];
        if (nloc == 0u) { xcd_barrier_complete(bar, b.x, nloc, nx); b.st[0] = nloc; b.st[1] = nx; }
        const unsigned old = xb_add(&bar[XB_XSUB(b.x)], 1u);
        const unsigned gen = old / nloc;
        if (old + 1u == (gen + 1u) * nloc) {
            __builtin_amdgcn_fence(__ATOMIC_RELEASE, "agent");
            asm volatile("s_waitcnt vmcnt(0)" ::: "memory");
            const unsigned og = xb_add(&bar[XB_TOP], 1u);
            const unsigned tg = og / nx;
            if (og + 1u == (tg + 1u) * nx) xb_add(&bar[XB_TOPGEN], 1u);
            else XB_SPIN(xb_ld(&bar[XB_TOPGEN]) == tg, bar);
            __builtin_amdgcn_fence(__ATOMIC_ACQUIRE, "agent");
            xb_add(&bar[XB_XGEN(b.x)], 1u);
            asm volatile("s_waitcnt vmcnt(0)" ::: "memory");
        } else {
            XB_SPIN(xb_ld(&bar[XB_XGEN(b.x)]) == gen, bar);
            __builtin_amdgcn_fence(__ATOMIC_ACQUIRE, "agent");
            asm volatile("s_waitcnt vmcnt(0)" ::: "memory");
        }
    }
    __syncthreads();
}

#define KPP() ({ KPC q_ = kp_; asm volatile("" : "+s"(q_)); q_; })
__global__ void __launch_bounds__(512, 2) mk_fwd(KP p_unused) {
    extern __shared__ __attribute__((aligned(16))) unsigned char lds_raw[];
    LAS unsigned char* lds = (LAS unsigned char*)lds_raw;
    cg::grid_group grid = cg::this_grid();
    const int bid = blockIdx.x, G = gridDim.x;
#define IDS() int tid = threadIdx.x; asm volatile("" : "+v"(tid)); const int lane = tid & 63, wave = __builtin_amdgcn_readfirstlane(tid >> 6); (void)lane; (void)wave
    const KPC kp_ = (KPC)__builtin_amdgcn_kernarg_segment_ptr();
    volatile LAS unsigned* bst = (volatile LAS unsigned*)(lds + 147392);
    if (threadIdx.x < 16) bst[threadIdx.x] = 0u;
    __syncthreads();
    (void)xcd_barrier_post((unsigned*)KPP()->ws, bst);
#define GSYNC() do { XcdBarrier b_; b_.bar = (unsigned*)KPP()->ws; b_.x = xb_xcc_id(); b_.st = bst; xcd_barrier(b_); } while (0)

    { IDS(); phase_prep(KPP(), lds, tid, lane, wave, bid, G); }
    if (G == 0x7fffffff) grid.sync();
    GSYNC();
    { IDS(); phase_norm_in(KPP(), lane, wave, bid, G); }
    GSYNC();
#pragma unroll 1
    for (int l = 0; l < 2; ++l) {
        {
            unsigned char* ws = KPP()->ws;
            pg8::Gemm g{(const pg8::bf16_t*)(ws + WS_H), (const pg8::bf16_t*)(ws + WS_WTIN), M, NZA, 1024}; GroupOrder S{1, M / 256, NZA / 256, 0, 0, G, bid};
            EpiZA E{(bf16*)(ws + WS_ZA)};
            pg8::gemm_phase<EpiZA, GroupOrder, true, true>(lds, g, S, E);
        }
        GSYNC();
        {
            KPC p = KPP(); IDS();
            float mq = fabsf(p->qn_g[l * 64 + lane]), mk = fabsf(p->kn_g[l * 64 + lane]);
            mq = wave_max(mq); mk = wave_max(mk);
            const float Mb2 = 8.0f * mq * mk * LOG2E;
            const int natt = (l == 0) ? 544 : 512, nupd = NB * NCH * 4, nvp = (l == 0) ? (M / 128) : (ML / 128);
            for (int it = bid; it < natt; it += G) att_item(p, l, lds, it, Mb2, tid, lane, wave);
            ret_upd_block(p, l, lds, (bid + G - (natt % G)) % G, G, nupd, tid, lane, wave);
            for (int it = bid; it < nvp; it += G) { sgu_vprep_item(p, it, tid); }
        }
        GSYNC();
        { IDS(); phase_scan(KPP(), l, tid, bid, G); }
        GSYNC();
        {   KPC p = KPP(); IDS(); const int nch = (l == 0) ? NCH : 32;
            const int nro = NB * nch * 4, nsgu = ((l == 0) ? (M / 128) : (ML / 128)) * 4;
            for (int it = bid; it < nro; it += G) { const int b = it / (nch * 4), rem = it % (nch * 4); ret_out_item(p, l, lds, b * (NCH * 4) + rem, tid, lane, wave); }
            if ((G & 3) == 0) sgu_block(p, l, lds, nsgu >> 2, tid, lane, wave, bid, G);
            else for (int it = bid; it < nsgu; it += G) sgu_item(p, l, lds, it, tid, lane, wave);
        }
        GSYNC();
        const int Mrows = (l == 0) ? M : ML;
        {
            unsigned char* ws = KPP()->ws;
            pg8::Gemm g{(const pg8::bf16_t*)(ws + WS_H), (const pg8::bf16_t*)(ws + WS_WTIN) + (size_t)NZA * 1024, Mrows, NZG, 1024}; GroupOrder S{1, Mrows / 256, NZG / 256, 0, 0, G, bid};
            EpiSig E{(bf16*)(ws + WS_G)};
            pg8::gemm_phase<EpiSig, GroupOrder, true, true>(lds, g, S, E);
            if (l == 0 && G == 256 && bid >= CVT_G_IDLE0) { IDS(); convert_experts(KPP(), 0, 0, CVT_G_HI, (bid - CVT_G_IDLE0) * 8 + wave, (256 - CVT_G_IDLE0) * 8, lds, lane, wave); }
        }
        GSYNC();
        {
            KPC p = KPP(); unsigned char* ws = p->ws;
            pg8::Gemm g{(const pg8::bf16_t*)p->out, (const pg8::bf16_t*)(ws + WS_WTBR), 3 * M, 3072, 512}; MergeOrder S{Mrows / 256, G, bid};
            EpiMergeChain E{(const bf16*)(ws + WS_G), (bf16*)(ws + WS_H)};
            pg8::gemm_phase<EpiMergeChain, MergeOrder, true, true>(lds, g, S, E);
            if (l == 0 && G == 256 && bid >= CVT_M_IDLE0) { IDS(); convert_experts(KPP(), 0, CVT_G_HI, CVT_M_HI, (bid - CVT_M_IDLE0) * 8 + wave, (256 - CVT_M_IDLE0) * 8, lds, lane, wave); }
        }
        GSYNC();
        {
            KPC p = KPP(); unsigned char* ws = p->ws;
            pg8::Gemm g{(const pg8::bf16_t*)(ws + WS_H), (const pg8::bf16_t*)(ws + WS_WTOUT), Mrows, 1024, 1024}; GroupOrder S{1, Mrows / 256, 4, 0, 0, G, bid};
            EpiOut E{p->x, p->ctx, (bf16*)(ws + WS_X), (const float*)(ws + WS_MODV) + l * 9 * 6144, (l == 0) ? 1 : 0};
            pg8::gemm_phase<EpiOut, GroupOrder, true, true>(lds, g, S, E);
            if (l == 0 && G == 256 && bid >= CVT_O_IDLE0) { IDS(); convert_experts(KPP(), 0, CVT_M_HI, CVT_ITEMS, (bid - CVT_O_IDLE0) * 8 + wave, (256 - CVT_O_IDLE0) * 8, lds, lane, wave); }
        }
        GSYNC();
        { IDS(); phase_norm2(KPP(), l, lds, tid, lane, wave, bid, G); }
        GSYNC();
        { IDS(); phase_topk(KPP(), l, lds, tid, lane, wave, bid, G); }
        GSYNC();
        {
            unsigned char* ws = KPP()->ws;
            pg8::Gemm g{(const pg8::bf16_t*)(ws + WS_XS), (const pg8::bf16_t*)(ws + WS_WT1), NE * ME, NE * 2048, 1024}; GroupOrder S{NE, (l == 0) ? 17 : 16, 8, 17, 8, G, bid};
            EpiMoe1 E{(bf16*)(ws + WS_ACT)};
            pg8::gemm_phase<EpiMoe1, GroupOrder, true, true>(lds, g, S, E);
        }
        GSYNC();
        {
            unsigned char* ws = KPP()->ws;
            pg8::Gemm g{(const pg8::bf16_t*)(ws + WS_ACT), (const pg8::bf16_t*)(ws + WS_WT2), NE * ME, NE * 1024, 1024}; GroupOrder S{NE, (l == 0) ? 17 : 16, 4, 17, 4, G, bid};
            EpiMoe2 E{(bf16*)(ws + WS_XS), (const float*)(ws + WS_TOPW)};
            pg8::gemm_phase<EpiMoe2, GroupOrder, true, true>(lds, g, S, E);
        }
        GSYNC();
        { IDS(); phase_combine(KPP(), l, lds, tid, lane, wave, bid, G); }
        if (l == 0) GSYNC();
    }
}

extern "C" void kernel_launch(void* const* d_in, const int* in_sizes, int n_in, void* d_out, int out_size, void* d_ws, size_t ws_size, hipStream_t stream) {
    static int grid = 0;
    if (grid == 0) {
        if (n_in != 22 || out_size != ML * D || ws_size < WS_END) { fprintf(stderr, "kernel_launch: unexpected shapes (n_in %d out %d ws %zu, need %zu)\n", n_in, out_size, ws_size, (size_t)WS_END); grid = -1; return; }
        int dev = 0, cus = 0, per_cu = 0;
        if (hipGetDevice(&dev) != hipSuccess || hipDeviceGetAttribute(&cus, hipDeviceAttributeMultiprocessorCount, dev) != hipSuccess) { grid = -1; return; }
        if (hipFuncSetAttribute((const void*)mk_fwd, hipFuncAttributeMaxDynamicSharedMemorySize, LDS_BYTES) != hipSuccess) { fprintf(stderr, "kernel_launch: hipFuncSetAttribute failed\n"); grid = -1; return; }
        if (hipOccupancyMaxActiveBlocksPerMultiprocessor(&per_cu, (const void*)mk_fwd, 512, LDS_BYTES) != hipSuccess || per_cu < 1) { fprintf(stderr, "kernel_launch: occupancy query says %d\n", per_cu); (void)hipGetLastError(); }
        grid = cus;
        fprintf(stderr, "kernel_launch: grid %d, occupancy %d/CU, ws %zu\n", grid, per_cu, ws_size);
    }
    if (grid < 0) return;
    if (hipMemsetAsync(d_ws, 0, 16384, stream) != hipSuccess) { fprintf(stderr, "kernel_launch: memset failed\n"); return; }
    KP hp{};
    const float** f = (const float**)&hp;
    for (int i = 0; i < 22; ++i) f[i] = (const float*)d_in[i];
    hp.out = (float*)d_out; hp.ws = (unsigned char*)d_ws;
    void* args[] = {&hp};
    hipError_t e = hipLaunchCooperativeKernel((const void*)mk_fwd, dim3(grid), dim3(512), args, LDS_BYTES, stream);
    if (e != hipSuccess) fprintf(stderr, "kernel_launch: cooperative launch failed: %s\n", hipGetErrorString(e));
}
```

```cpp
#include <hip/hip_runtime.h>
#include <hip/hip_cooperative_groups.h>
#include <cstdio>
#include <cstdint>
namespace cg = cooperative_groups;
namespace pg8 {
#define PG8_LAS __attribute__((address_space(3)))
typedef unsigned short bf16_t;
typedef short bf16x8 __attribute__((ext_vector_type(8)));
typedef float f32x4 __attribute__((ext_vector_type(4)));
typedef unsigned u32x4 __attribute__((ext_vector_type(4)));
constexpr int BM = 256, BK = 64, HALF = 128, HTB = HALF * BK * 2  , STAGE_BYTES = 8 * HTB, NXCD = 8, WGM = 8;

__host__ __device__ __forceinline__ int lds_byte(int r, int c) { const int st = (r >> 4) * 2 + (c >> 5), rr = r & 15, cc = c & 31, ob = rr * 64 + cc * 2; return st * 1024 + (ob ^ (((ob >> 9) & 1) << 5)); }
__host__ __device__ __forceinline__ void stage_rc(int b, int& R, int& C) { const int st = b / 1024, sb = b % 1024, swz = sb ^ (((sb >> 9) & 1) << 5); R = (st >> 1) * 16 + swz / 64; C = (st & 1) * 32 + (swz % 64) / 2; }
__host__ __device__ __forceinline__ int perm32(int rho) { const int n = rho >> 4, i = rho & 15; return 8 * (i >> 2) + 4 * n + (i & 3); }

struct Unit { int pm, pn; };
struct Gemm { const bf16_t* A; const bf16_t* Bt; int M, N, K; };

struct StaticOrder {
    int nM, nN, nwg, G, c;
    __host__ __device__ void init(int M, int N, int G_, int c_) { nM = M / BM; nN = N / BM; nwg = nM * nN; G = G_; c = c_; }
    __host__ __device__ bool next(int i, Unit& u) const {
        const long L = (long)i * G + c; if (L >= nwg) return false;
        int wgid = (int)L; { const int q = nwg / NXCD, r = nwg % NXCD, xcd = wgid % NXCD, off = wgid / NXCD; wgid = (xcd < r ? xcd * (q + 1) : r * (q + 1) + (xcd - r) * q) + off; }
        const int nig = WGM * nN, gid = wgid / nig, fm = gid * WGM, gsz = (nM - fm) < WGM ? (nM - fm) : WGM;
        u.pm = fm + ((wgid % nig) % gsz); u.pn = (wgid % nig) / gsz; return true;
    }
    __device__ __forceinline__ void a_ready(const Unit&) const {}
    __device__ __forceinline__ void done(const Unit&) const {}
};

__device__ __forceinline__ unsigned cvt_pk_bf16(float lo, float hi) { unsigned r; asm volatile("v_cvt_pk_bf16_f32 %0, %1, %2" : "=v"(r) : "v"(lo), "v"(hi)); return r; }
typedef float f32x2 __attribute__((ext_vector_type(2)));
__device__ __forceinline__ f32x2 gelu_pk(f32x2 v) {
    const f32x2 av = __builtin_elementwise_abs(v), d = av * 0.2316418882f + 1.0f;
    f32x2 t; t.x = __builtin_amdgcn_rcpf(d.x); t.y = __builtin_amdgcn_rcpf(d.y);
    f32x2 q = t * 0.5307027145f + (-0.7265760135f); q = q * t + 0.7107068705f; q = q * t + (-0.142248368f); q = q * t + 0.127414796f; q = q * t;
    const f32x2 s = (v * v) * (-0.72134752044f);
    f32x2 e; e.x = __builtin_amdgcn_exp2f(s.x); e.y = __builtin_amdgcn_exp2f(s.y);
    const f32x2 m = v * (q * e), r = v - m;
    f32x2 o; o.x = v.x < 0.f ? m.x : r.x; o.y = v.y < 0.f ? m.y : r.y; return o;
}

template <int ACT  > struct EpiBf16 {
    static constexpr bool PERM = true, AFTER_DRAIN = false, CHAIN = false; static_assert(ACT == 0 || ACT == 1, "EpiBf16: ACT is 0 (none) or 1 (gelu_pk)");
    bf16_t* O; int ldc; const float* bias; int split_cols; size_t split_stride; float scale0;
    __device__ __forceinline__ void operator()(const f32x4 (&acc)[2][2][4][2], const Unit& u, int wr, int wc, int fr, int fq) const {
        const int row0 = u.pm * BM + wr * 64 + fr; int colt = u.pn * BM; bf16_t* base = O;
        float sc = 1.f; if (split_cols) { const int t = colt / split_cols; base += (size_t)t * split_stride; colt -= t * split_cols; if (t == 0) sc = scale0; }
        const int col0 = colt + wc * 32 + 8 * fq, bcol0 = u.pn * BM + wc * 32 + 8 * fq;
        f32x4 bv[2][2];
#pragma unroll
        for (int bj = 0; bj < 2; ++bj)
#pragma unroll
            for (int n = 0; n < 2; ++n) bv[bj][n] = bias ? *(const f32x4*)(bias + bcol0 + bj * HALF + 4 * n) : (f32x4){0.f, 0.f, 0.f, 0.f};
#pragma unroll
        for (int ai = 0; ai < 2; ++ai)
#pragma unroll
            for (int m = 0; m < 4; ++m) { bf16_t* rowp = base + (size_t)(row0 + ai * HALF + m * 16) * ldc + col0;
#pragma unroll
                for (int bj = 0; bj < 2; ++bj) { f32x4 v0 = acc[ai][bj][m][0] + bv[bj][0], v1 = acc[ai][bj][m][1] + bv[bj][1];
                    if (ACT == 1) { f32x2 a = gelu_pk((f32x2){v0[0], v0[1]}), b = gelu_pk((f32x2){v0[2], v0[3]}), c = gelu_pk((f32x2){v1[0], v1[1]}), d = gelu_pk((f32x2){v1[2], v1[3]});
                        v0 = (f32x4){a.x, a.y, b.x, b.y}; v1 = (f32x4){c.x, c.y, d.x, d.y}; }
                    v0 = v0 * sc; v1 = v1 * sc; u32x4 w; w.x = cvt_pk_bf16(v0[0], v0[1]); w.y = cvt_pk_bf16(v0[2], v0[3]); w.z = cvt_pk_bf16(v1[0], v1[1]); w.w = cvt_pk_bf16(v1[2], v1[3]);
                    *(u32x4*)(rowp + bj * HALF) = w; } }
    }
};
template <class Epi, class Sched, bool ALIGN_EPI = false, bool SP2 = false>
__device__ __forceinline__ void gemm_phase(PG8_LAS unsigned char* lds, const Gemm g, const Sched& S, const Epi& E) {
    int tid_ = threadIdx.x; asm volatile("" : "+v"(tid_));
    const int tid = tid_, wid = __builtin_amdgcn_readfirstlane(tid >> 6), lane = tid & 63, wr = wid >> 2, wc = wid & 3, fr = lane & 15, fq = lane >> 4;
    const int K = g.K, nt = K / BK;
    unsigned voffA[2], voffB[2];
#pragma unroll
    for (int i = 0; i < 2; ++i) { int R, C; stage_rc(tid * 16 + i * 8192, R, C); const int Rb = Epi::PERM ? ((R & ~31) + perm32(R & 31)) : R;
        voffA[i] = (unsigned)(R * K + C) * 2u; voffB[i] = (unsigned)(Rb * K + C) * 2u; }
    const size_t kstep = (size_t)(BK * 2);
    const size_t hstep = (size_t)HALF * K * 2;
    const size_t tstep = 2 * hstep;
    const unsigned ldsw = (unsigned)wid * 1024u;
    const int aoff = lds_byte(wr * 64 + fr, fq * 8), boff = lds_byte(wc * 32 + fr, fq * 8);
#define PG8_SA(b, h) (((b) * 2 + (h)) * HTB)
#define PG8_SB(b, h) ((4 + (b) * 2 + (h)) * HTB)
#define PG8_STAGE(bufoff, gbase, voff) do { _Pragma("unroll") for (int _i = 0; _i < 2; ++_i) \
        __builtin_amdgcn_global_load_lds((const unsigned*)((const char*)(gbase) + (voff)[_i]), (PG8_LAS unsigned*)(lds + (bufoff) + ldsw + _i * 8192), 16, 0, 0); } while (0)
#define PG8_LDA(dst, b, h) do { _Pragma("unroll") for (int m = 0; m < 4; ++m) _Pragma("unroll") for (int k = 0; k < 2; ++k) dst[m][k] = *(const PG8_LAS bf16x8*)(lds + PG8_SA(b, h) + aoff + m * 2048 + k * 1024); } while (0)
#define PG8_LDB(dst, b, h) do { _Pragma("unroll") for (int n = 0; n < 2; ++n) _Pragma("unroll") for (int k = 0; k < 2; ++k) dst[n][k] = *(const PG8_LAS bf16x8*)(lds + PG8_SB(b, h) + boff + n * 2048 + k * 1024); } while (0)
#define PG8_MMA(ai, bj, At, Bt) do { __builtin_amdgcn_s_setprio(1); _Pragma("unroll") for (int m = 0; m < 4; ++m) _Pragma("unroll") for (int n = 0; n < 2; ++n) _Pragma("unroll") for (int k = 0; k < 2; ++k) \
        acc[ai][bj][m][n] = __builtin_amdgcn_mfma_f32_16x16x32_bf16(Bt[n][k], At[m][k], acc[ai][bj][m][n], 0, 0, 0); __builtin_amdgcn_s_setprio(0); } while (0)
#define PG8_WAIT_V(n) asm volatile("s_waitcnt vmcnt(" #n ")" ::: "memory")
#define PG8_WAIT_L(n) asm volatile("s_waitcnt lgkmcnt(" #n ")" ::: "memory")
#define PG8_BAR __builtin_amdgcn_s_barrier()
#define PG8_SCHED __builtin_amdgcn_sched_barrier(0)
    Unit cur, nxt; int ui = 0;
    if (!S.next(0, cur)) return;
    f32x4 acc[2][2][4][2];
#pragma unroll
    for (int a = 0; a < 2; ++a)
#pragma unroll
        for (int b = 0; b < 2; ++b)
#pragma unroll
            for (int m = 0; m < 4; ++m)
#pragma unroll
                for (int n = 0; n < 2; ++n) acc[a][b][m][n] = (f32x4){0.f, 0.f, 0.f, 0.f};
    bf16x8 At[4][2], B0[2][2], B1[2][2];
    const char* cA = (const char*)g.A + (size_t)cur.pm * tstep; const char* cB = (const char*)g.Bt + (size_t)cur.pn * tstep;
    S.a_ready(cur);
    if constexpr (SP2) {
        PG8_STAGE(PG8_SB(0, 0), cB, voffB); PG8_STAGE(PG8_SB(0, 1), cB + hstep, voffB); PG8_STAGE(PG8_SA(0, 0), cA, voffA); PG8_STAGE(PG8_SA(0, 1), cA + hstep, voffA);
        if (wr == 1) PG8_BAR;
        PG8_WAIT_V(2); PG8_BAR;
        PG8_STAGE(PG8_SB(1, 0), cB + kstep, voffB); PG8_STAGE(PG8_SA(1, 0), cA + kstep, voffA); PG8_STAGE(PG8_SB(1, 1), cB + hstep + kstep, voffB);
        PG8_WAIT_V(6); PG8_BAR;
    } else {
        PG8_STAGE(PG8_SB(0, 0), cB, voffB); PG8_STAGE(PG8_SA(0, 0), cA, voffA); PG8_STAGE(PG8_SB(0, 1), cB + hstep, voffB); PG8_STAGE(PG8_SA(0, 1), cA + hstep, voffA);
        if (wr == 1) PG8_BAR;
        PG8_WAIT_V(4); PG8_BAR;
        PG8_STAGE(PG8_SB(1, 0), cB + kstep, voffB); PG8_STAGE(PG8_SA(1, 0), cA + kstep, voffA); PG8_STAGE(PG8_SB(1, 1), cB + hstep + kstep, voffB);
        PG8_WAIT_V(6); PG8_BAR;
    }
    for (;;) {
        const bool has_next = S.next(ui + 1, nxt);
        const char* nA = has_next ? (const char*)g.A + (size_t)nxt.pm * tstep : cA; const char* nB = has_next ? (const char*)g.Bt + (size_t)nxt.pn * tstep : cB;
        for (int t = 0; t < nt; t += 2) {
            const bool last = (t == nt - 2);
            const char* a1 = cA + (size_t)(t + 1) * kstep;
            const char* a2 = last ? nA : cA + (size_t)(t + 2) * kstep; const char* b2 = last ? nB : cB + (size_t)(t + 2) * kstep;
            const char* a3 = a2 + kstep; const char* b3 = b2 + kstep;
            if (last && has_next) S.a_ready(nxt);
            if constexpr (SP2) {
            PG8_LDB(B0, 0, 0); PG8_LDB(B1, 0, 1); PG8_SCHED; PG8_LDA(At, 0, 0); PG8_STAGE(PG8_SA(1, 1), a1 + hstep, voffA);
            PG8_WAIT_V(8); PG8_WAIT_L(0); PG8_BAR; PG8_MMA(0, 0, At, B0); PG8_MMA(0, 1, At, B1); PG8_BAR; PG8_SCHED;
            PG8_LDA(At, 0, 1); PG8_STAGE(PG8_SB(0, 0), b2, voffB); PG8_STAGE(PG8_SB(0, 1), b2 + hstep, voffB); PG8_STAGE(PG8_SA(0, 0), a2, voffA);
            PG8_WAIT_V(8); PG8_WAIT_L(0); PG8_BAR; PG8_MMA(1, 0, At, B0); PG8_MMA(1, 1, At, B1); PG8_BAR; PG8_SCHED;
            PG8_LDB(B0, 1, 0); PG8_LDB(B1, 1, 1); PG8_SCHED; PG8_LDA(At, 1, 0); PG8_STAGE(PG8_SA(0, 1), a2 + hstep, voffA);
            PG8_WAIT_V(8); PG8_WAIT_L(0); PG8_BAR; PG8_MMA(0, 0, At, B0); PG8_MMA(0, 1, At, B1); PG8_BAR; PG8_SCHED;
            PG8_LDA(At, 1, 1); PG8_STAGE(PG8_SB(1, 0), b3, voffB); PG8_STAGE(PG8_SB(1, 1), b3 + hstep, voffB); PG8_STAGE(PG8_SA(1, 0), a3, voffA);
            PG8_WAIT_V(8); PG8_WAIT_L(0); PG8_BAR; PG8_MMA(1, 0, At, B0); PG8_MMA(1, 1, At, B1); PG8_BAR; PG8_SCHED;
            } else {
            PG8_LDB(B0, 0, 0); PG8_SCHED; PG8_LDA(At, 0, 0); PG8_STAGE(PG8_SA(1, 1), a1 + hstep, voffA);
            PG8_WAIT_L(8); PG8_BAR; PG8_WAIT_L(0); PG8_MMA(0, 0, At, B0); PG8_BAR; PG8_SCHED;
            PG8_LDB(B1, 0, 1); PG8_STAGE(PG8_SB(0, 0), b2, voffB);
            PG8_BAR; PG8_WAIT_L(0); PG8_MMA(0, 1, At, B1); PG8_BAR;
            PG8_LDA(At, 0, 1); PG8_STAGE(PG8_SA(0, 0), a2, voffA);
            PG8_BAR; PG8_WAIT_L(0); PG8_MMA(1, 0, At, B0); PG8_BAR; PG8_SCHED;
            PG8_STAGE(PG8_SB(0, 1), b2 + hstep, voffB);
            PG8_WAIT_V(6); PG8_BAR; PG8_MMA(1, 1, At, B1); PG8_BAR;
            PG8_LDB(B0, 1, 0); PG8_SCHED; PG8_LDA(At, 1, 0); PG8_STAGE(PG8_SA(0, 1), a2 + hstep, voffA);
            PG8_WAIT_L(8); PG8_BAR; PG8_WAIT_L(0); PG8_MMA(0, 0, At, B0); PG8_BAR; PG8_SCHED;
            PG8_LDB(B1, 1, 1); PG8_STAGE(PG8_SB(1, 0), b3, voffB);
            PG8_BAR; PG8_WAIT_L(0); PG8_MMA(0, 1, At, B1); PG8_BAR;
            PG8_LDA(At, 1, 1); PG8_STAGE(PG8_SA(1, 0), a3, voffA);
            PG8_BAR; PG8_WAIT_L(0); PG8_MMA(1, 0, At, B0); PG8_BAR; PG8_SCHED;
            PG8_STAGE(PG8_SB(1, 1), b3 + hstep, voffB);
            PG8_WAIT_V(6); PG8_BAR; PG8_MMA(1, 1, At, B1); PG8_BAR;
            }
        }
        if constexpr (ALIGN_EPI) { if (wr == 0) PG8_BAR; }
        bool keep_acc = false;
        if constexpr (Epi::CHAIN) { keep_acc = E.chain(acc, cur, wr, wc, fr, fq); S.done(cur); }
        else if constexpr (!Epi::AFTER_DRAIN) { E(acc, cur, wr, wc, fr, fq); S.done(cur); }
        if (!has_next) break;
        if (!keep_acc) {
#pragma unroll
        for (int a = 0; a < 2; ++a)
#pragma unroll
            for (int b = 0; b < 2; ++b)
#pragma unroll
                for (int m = 0; m < 4; ++m)
#pragma unroll
                    for (int n = 0; n < 2; ++n) acc[a][b][m][n] = (f32x4){0.f, 0.f, 0.f, 0.f};
        }
        cur = nxt; cA = nA; cB = nB; ++ui;
        if constexpr (ALIGN_EPI) { if (wr == 1) PG8_BAR; }
    }
    PG8_WAIT_V(0);
    if constexpr (!ALIGN_EPI) { if (wr == 0) PG8_BAR; }
    PG8_BAR;
    if constexpr (Epi::AFTER_DRAIN) { E.fused(acc, cur, wr, wc, fr, fq, lds, wid, lane); S.done(cur); }
#undef PG8_SA
#undef PG8_SB
#undef PG8_STAGE
#undef PG8_LDA
#undef PG8_LDB
#undef PG8_MMA
#undef PG8_WAIT_V
#undef PG8_WAIT_L
#undef PG8_BAR
#undef PG8_SCHED
}
}

#define LAS __attribute__((address_space(3)))
typedef unsigned short bf16;
typedef short bf16x8 __attribute__((ext_vector_type(8)));
typedef float f32x4 __attribute__((ext_vector_type(4)));
typedef unsigned u32x4 __attribute__((ext_vector_type(4)));
typedef unsigned u32x2 __attribute__((ext_vector_type(2)));

constexpr int D = 1024, NB = 8, T = 4096, CL = 256;
constexpr int ML = NB * T, MC = NB * CL, M = ML + MC;
constexpr int NZA = 3328, NZG = 3072;
constexpr int C_RQ = 0, C_RK = 256, C_RV = 512, C_RG = 1024, C_SU = 1536, C_SV = 2048, C_AQ = 2560, C_AK = 3072, C_AV = 3200;
constexpr int NE = 16, CAPL = 512, CAPC = 32, ME = NB * (CAPL + CAPC);
constexpr int NCH = 34;
constexpr float EPS = 1e-6f, LOG2E = 1.4426950408889634f;
constexpr int LDS_BYTES = 147456;

constexpr size_t MiB = 1u << 20;
constexpr size_t WS_LG = 15360;
constexpr size_t WS_ROPEC = 1 * MiB, WS_ROPES = 1 * MiB + 512 * 1024, WS_MODV = 2 * MiB, WS_AFF = 3 * MiB, WS_AFFC = 5 * MiB, WS_INV = 6 * MiB, WS_TOPW = 9 * MiB;
constexpr size_t WS_WTIN = 16 * MiB, WS_WTBR = WS_WTIN + (size_t)6400 * 1024 * 2, WS_WTOUT = WS_WTBR + (size_t)3072 * 512 * 2;
constexpr size_t WS_X = 34 * MiB, WS_H = 170 * MiB, WS_R = 238 * MiB;
constexpr size_t WS_ZA = WS_R, WS_G = WS_R, WS_RS = 459 * MiB, WS_ST = 527 * MiB;
constexpr size_t WS_XS = WS_R, WS_ACT = 374 * MiB, WS_WT1 = 510 * MiB, WS_WT2 = 574 * MiB, WS_END = 606 * MiB;
static_assert(WS_WTOUT + 2 * MiB <= WS_X && WS_ZA + (size_t)M * NZA * 2 <= WS_RS && WS_ST + (size_t)NB * 4 * NCH * 128 * 128 * 2 <= WS_END, "ws map");

struct KP {
    const float *x, *c, *ctx, *c_ctx, *w_mod, *b_mod, *norm1_g, *norm2_g, *w_in, *dec_f, *dec_b, *sgu_w, *sgu_b, *qn_g, *kn_g, *sink, *w_branch, *w_out, *w_router, *w_eg, *w_eu, *w_ed;
    float* out; unsigned char* ws;
};
typedef const __attribute__((address_space(4))) KP* KPC;

#define LDS_WAIT() asm volatile("s_waitcnt lgkmcnt(0)" ::: "memory")
__device__ __forceinline__ unsigned pk2(float lo, float hi) { return pg8::cvt_pk_bf16(lo, hi); }
__device__ __forceinline__ float bflo(unsigned w) { return __uint_as_float(w << 16); }
__device__ __forceinline__ float bfhi(unsigned w) { return __uint_as_float(w & 0xffff0000u); }
__device__ __forceinline__ void unpack8(const u32x4 w, float (&f)[8]) { f[0] = bflo(w.x); f[1] = bfhi(w.x); f[2] = bflo(w.y); f[3] = bfhi(w.y); f[4] = bflo(w.z); f[5] = bfhi(w.z); f[6] = bflo(w.w); f[7] = bfhi(w.w); }
__device__ __forceinline__ u32x4 pack8(const float (&f)[8]) { u32x4 o; o.x = pk2(f[0], f[1]); o.y = pk2(f[2], f[3]); o.z = pk2(f[4], f[5]); o.w = pk2(f[6], f[7]); return o; }
template <int CTRL> __device__ __forceinline__ float dpp_f(float v) { return __builtin_bit_cast(float, __builtin_amdgcn_update_dpp(0, __builtin_bit_cast(int, v), CTRL, 0xf, 0xf, false)); }
template <int CTRL> __device__ __forceinline__ int dpp_i(int v) { return __builtin_amdgcn_update_dpp(0, v, CTRL, 0xf, 0xf, false); }
constexpr int DPP_XOR1 = 0xB1  , DPP_XOR2 = 0x4E  , DPP_HMIRROR = 0x141  , DPP_MIRROR = 0x140  ;
__device__ __forceinline__ float sum_x16(float v) { const unsigned u = __builtin_bit_cast(unsigned, v); auto r = __builtin_amdgcn_permlane16_swap(u, u, false, false); return __builtin_bit_cast(float, (unsigned)r[0]) + __builtin_bit_cast(float, (unsigned)r[1]); }
__device__ __forceinline__ float sum_x32(float v) { const unsigned u = __builtin_bit_cast(unsigned, v); auto r = __builtin_amdgcn_permlane32_swap(u, u, false, false); return __builtin_bit_cast(float, (unsigned)r[0]) + __builtin_bit_cast(float, (unsigned)r[1]); }
__device__ __forceinline__ float max_x16(float v) { const unsigned u = __builtin_bit_cast(unsigned, v); auto r = __builtin_amdgcn_permlane16_swap(u, u, false, false); return fmaxf(__builtin_bit_cast(float, (unsigned)r[0]), __builtin_bit_cast(float, (unsigned)r[1])); }
__device__ __forceinline__ float max_x32(float v) { const unsigned u = __builtin_bit_cast(unsigned, v); auto r = __builtin_amdgcn_permlane32_swap(u, u, false, false); return fmaxf(__builtin_bit_cast(float, (unsigned)r[0]), __builtin_bit_cast(float, (unsigned)r[1])); }
__device__ __forceinline__ int sum_x16_i(int v) { auto r = __builtin_amdgcn_permlane16_swap((unsigned)v, (unsigned)v, false, false); return (int)r[0] + (int)r[1]; }
__device__ __forceinline__ int sum_x32_i(int v) { auto r = __builtin_amdgcn_permlane32_swap((unsigned)v, (unsigned)v, false, false); return (int)r[0] + (int)r[1]; }
__device__ __forceinline__ float row_sum(float v) { v += dpp_f<DPP_XOR1>(v); v += dpp_f<DPP_XOR2>(v); v += dpp_f<DPP_HMIRROR>(v); v += dpp_f<DPP_MIRROR>(v); return v; }
__device__ __forceinline__ float row_max(float v) { v = fmaxf(v, dpp_f<DPP_XOR1>(v)); v = fmaxf(v, dpp_f<DPP_XOR2>(v)); v = fmaxf(v, dpp_f<DPP_HMIRROR>(v)); v = fmaxf(v, dpp_f<DPP_MIRROR>(v)); return v; }
__device__ __forceinline__ int row_sum_i(int v) { v += dpp_i<DPP_XOR1>(v); v += dpp_i<DPP_XOR2>(v); v += dpp_i<DPP_HMIRROR>(v); v += dpp_i<DPP_MIRROR>(v); return v; }
__device__ __forceinline__ float wave_sum(float v) { return sum_x32(sum_x16(row_sum(v))); }
__device__ __forceinline__ float wave_max(float v) { return max_x32(max_x16(row_max(v))); }
__device__ __forceinline__ int wave_sum_i(int v) { return sum_x32_i(sum_x16_i(row_sum_i(v))); }
__device__ __forceinline__ float sum_x16_x32(float v) { return sum_x32(sum_x16(v)); }
__device__ __forceinline__ float sum_x1_x2(float v) { v += dpp_f<DPP_XOR1>(v); v += dpp_f<DPP_XOR2>(v); return v; }
template <int MASK> __device__ __forceinline__ float swz_xor(float v) { static_assert(MASK > 0 && MASK < 32, "swz_xor: 1..31"); return __builtin_bit_cast(float, __builtin_amdgcn_ds_swizzle(__builtin_bit_cast(int, v), 0x1f | (MASK << 10))); }
__device__ __forceinline__ float ex2(float x) { return __builtin_amdgcn_exp2f(x); }
__device__ __forceinline__ float rcp_(float x) { return __builtin_amdgcn_rcpf(x); }
__device__ __forceinline__ float rsq_(float x) { return __builtin_amdgcn_rsqf(x); }
__device__ __forceinline__ float sigmoidf_(float x) { return rcp_(1.f + ex2(-x * LOG2E)); }
__device__ __forceinline__ float gelu_tanh(float x) { const float u = 0.7978845608028654f * (x + 0.044715f * x * x * x); return x * rcp_(1.f + ex2(-2.f * LOG2E * u)); }
__device__ __forceinline__ f32x4 mfma16(bf16x8 a, bf16x8 b, f32x4 c) { return __builtin_amdgcn_mfma_f32_16x16x32_bf16(a, b, c, 0, 0, 0); }
__device__ __forceinline__ bf16x8 as_bf16x8(u32x4 w) { return __builtin_bit_cast(bf16x8, w); }
__device__ __forceinline__ float log2_sigmoid(float a) { return -log1pf(__expf(-a)) * LOG2E; }

struct GroupOrder {
    int nG, nM, nN, pmS, pnS, G, c;
    __device__ __forceinline__ bool next(int i, pg8::Unit& u) const {
        const long L = (long)i * G + c; const int tot = nG * nM * nN; if (L >= tot) return false;
        int wgid = (int)L; { const int q = tot / 8, r = tot % 8, xcd = wgid % 8, off = wgid / 8; wgid = (xcd < r ? xcd * (q + 1) : r * (q + 1) + (xcd - r) * q) + off; }
        const int per = nM * nN, g = wgid / per, rem = wgid - g * per;
        const int nig = 8 * nN, gid = rem / nig, fm = gid * 8, gsz = (nM - fm) < 8 ? (nM - fm) : 8;
        u.pm = g * pmS + fm + ((rem % nig) % gsz); u.pn = g * pnS + (rem % nig) / gsz; return true;
    }
    __device__ __forceinline__ void a_ready(const pg8::Unit&) const {}
    __device__ __forceinline__ void done(const pg8::Unit&) const {}
};
struct MergeOrder {
    int nM, G, c;
    __device__ __forceinline__ bool next(int i, pg8::Unit& u) const {
        const int ii = i / 3, g = i - 3 * ii; const long L = (long)ii * G + c; const int tot = nM * 4; if (L >= tot) return false;
        int wgid = (int)L; { const int q = tot / 8, r = tot % 8, xcd = wgid % 8, off = wgid / 8; wgid = (xcd < r ? xcd * (q + 1) : r * (q + 1) + (xcd - r) * q) + off; }
        const int nig = 32, gid = wgid / nig, fm = gid * 8, gsz = (nM - fm) < 8 ? (nM - fm) : 8;
        u.pm = g * (M / 256) + fm + ((wgid % nig) % gsz); u.pn = g * 4 + (wgid % nig) / gsz; return true;
    }
    __device__ __forceinline__ void a_ready(const pg8::Unit&) const {}
    __device__ __forceinline__ void done(const pg8::Unit&) const {}
};

struct EpiZA {
    static constexpr bool PERM = true, AFTER_DRAIN = false, CHAIN = false;
    bf16* O;
    __device__ __forceinline__ void operator()(const f32x4 (&acc)[2][2][4][2], const pg8::Unit& u, int wr, int wc, int fr, int fq) const {
        const int row0 = u.pm * 256 + wr * 64 + fr, col0 = u.pn * 256 + wc * 32 + 8 * fq; const bool act = false;
#pragma unroll
        for (int ai = 0; ai < 2; ++ai)
#pragma unroll
            for (int m = 0; m < 4; ++m) { bf16* rowp = O + (size_t)(row0 + ai * 128 + m * 16) * NZA + col0;
#pragma unroll
                for (int bj = 0; bj < 2; ++bj) { const f32x4 v0 = acc[ai][bj][m][0], v1 = acc[ai][bj][m][1];
                    float o[8] = {v0[0], v0[1], v0[2], v0[3], v1[0], v1[1], v1[2], v1[3]};
                    if (act) {
#pragma unroll
                        for (int k = 0; k < 8; ++k) o[k] = gelu_tanh(o[k]); }
                    *(u32x4*)(rowp + bj * 128) = pack8(o); } }
    }
};
struct EpiSig {
    static constexpr bool PERM = true, AFTER_DRAIN = false, CHAIN = false;
    bf16* O;
    __device__ __forceinline__ void operator()(const f32x4 (&acc)[2][2][4][2], const pg8::Unit& u, int wr, int wc, int fr, int fq) const {
        const int row0 = u.pm * 256 + wr * 64 + fr, col0 = u.pn * 256 + wc * 32 + 8 * fq;
#pragma unroll
        for (int ai = 0; ai < 2; ++ai)
#pragma unroll
            for (int m = 0; m < 4; ++m) { bf16* rowp = O + (size_t)(row0 + ai * 128 + m * 16) * NZG + col0;
#pragma unroll
                for (int bj = 0; bj < 2; ++bj) { const f32x4 v0 = acc[ai][bj][m][0], v1 = acc[ai][bj][m][1];
                    float o[8] = {v0[0], v0[1], v0[2], v0[3], v1[0], v1[1], v1[2], v1[3]};
#pragma unroll
                    for (int k = 0; k < 8; ++k) o[k] = fmaxf(sigmoidf_(o[k]), 1e-20f);
                    *(u32x4*)(rowp + bj * 128) = pack8(o); } }
    }
};
struct EpiMergeChain {
    static constexpr bool PERM = true, AFTER_DRAIN = false, CHAIN = true;
    const bf16* Gt; bf16* Hm;
    __device__ __forceinline__ bool chain(f32x4 (&acc)[2][2][4][2], const pg8::Unit& u, int wr, int wc, int fr, int fq) const {
        const int g = u.pm / (M / 256), m = u.pm - g * (M / 256), n = u.pn - g * 4;
        const int row0 = m * 256 + wr * 64 + fr, col0 = n * 256 + wc * 32 + 8 * fq;
#pragma unroll
        for (int ai = 0; ai < 2; ++ai) {
            u32x4 gw[4][2], hw[4][2];
#pragma unroll
            for (int mm = 0; mm < 4; ++mm)
#pragma unroll
                for (int bj = 0; bj < 2; ++bj) gw[mm][bj] = *(const u32x4*)(Gt + (size_t)(row0 + ai * 128 + mm * 16) * NZG + g * 1024 + col0 + bj * 128);
            if (g < 2) {
#pragma unroll
                for (int mm = 0; mm < 4; ++mm)
#pragma unroll
                    for (int bj = 0; bj < 2; ++bj) hw[mm][bj] = *(const u32x4*)(Gt + (size_t)(row0 + ai * 128 + mm * 16) * NZG + (g + 1) * 1024 + col0 + bj * 128);
            }
#pragma unroll
            for (int mm = 0; mm < 4; ++mm)
#pragma unroll
                for (int bj = 0; bj < 2; ++bj) {
                    float sc[8]; unpack8(gw[mm][bj], sc);
                    if (g < 2) { float sn[8]; unpack8(hw[mm][bj], sn);
#pragma unroll
                        for (int k = 0; k < 8; ++k) sc[k] *= __builtin_amdgcn_rcpf(sn[k]); }
                    f32x4& v0 = acc[ai][bj][mm][0]; f32x4& v1 = acc[ai][bj][mm][1];
                    v0[0] *= sc[0]; v0[1] *= sc[1]; v0[2] *= sc[2]; v0[3] *= sc[3]; v1[0] *= sc[4]; v1[1] *= sc[5]; v1[2] *= sc[6]; v1[3] *= sc[7];
                    if (g == 2) { u32x4 w; w.x = pk2(v0[0], v0[1]); w.y = pk2(v0[2], v0[3]); w.z = pk2(v1[0], v1[1]); w.w = pk2(v1[2], v1[3]);
                        *(u32x4*)(Hm + (size_t)(row0 + ai * 128 + mm * 16) * 1024 + col0 + bj * 128) = w; }
                }
        }
        return g < 2;
    }
};
struct EpiOut {
    static constexpr bool PERM = true, AFTER_DRAIN = false, CHAIN = false;
    const float* xl; const float* xc; bf16* X; const float* modv; int from_f32;
    __device__ __forceinline__ void operator()(const f32x4 (&acc)[2][2][4][2], const pg8::Unit& u, int wr, int wc, int fr, int fq) const {
        const int row0 = u.pm * 256 + wr * 64 + fr, col0 = u.pn * 256 + wc * 32 + 8 * fq;
        const int bi = (u.pm * 256 < ML) ? ((u.pm * 256) >> 12) : 8;
        const float* g1 = modv + bi * 6144 + 2 * 1024;
        f32x4 gv[2][2];
#pragma unroll
        for (int bj = 0; bj < 2; ++bj) { gv[bj][0] = *(const f32x4*)(g1 + col0 + bj * 128); gv[bj][1] = *(const f32x4*)(g1 + col0 + bj * 128 + 4); }
        if (from_f32) {
            const float* src0 = (u.pm * 256 < ML) ? xl + (size_t)row0 * 1024 : xc + (size_t)(row0 - ML) * 1024;
#pragma unroll
            for (int ai = 0; ai < 2; ++ai) {
                f32x4 xv[4][2][2];
#pragma unroll
                for (int m = 0; m < 4; ++m)
#pragma unroll
                    for (int bj = 0; bj < 2; ++bj) { const float* s = src0 + (size_t)(ai * 128 + m * 16) * 1024 + col0 + bj * 128; xv[m][bj][0] = *(const f32x4*)s; xv[m][bj][1] = *(const f32x4*)(s + 4); }
#pragma unroll
                for (int m = 0; m < 4; ++m)
#pragma unroll
                    for (int bj = 0; bj < 2; ++bj) { const f32x4 o0 = xv[m][bj][0] + gv[bj][0] * acc[ai][bj][m][0], o1 = xv[m][bj][1] + gv[bj][1] * acc[ai][bj][m][1];
                        u32x4 w; w.x = pk2(o0[0], o0[1]); w.y = pk2(o0[2], o0[3]); w.z = pk2(o1[0], o1[1]); w.w = pk2(o1[2], o1[3]);
                        *(u32x4*)(X + (size_t)(row0 + ai * 128 + m * 16) * 1024 + col0 + bj * 128) = w; }
            }
        } else {
#pragma unroll
            for (int ai = 0; ai < 2; ++ai) {
                u32x4 xw[4][2];
#pragma unroll
                for (int m = 0; m < 4; ++m)
#pragma unroll
                    for (int bj = 0; bj < 2; ++bj) xw[m][bj] = *(const u32x4*)(X + (size_t)(row0 + ai * 128 + m * 16) * 1024 + col0 + bj * 128);
#pragma unroll
                for (int m = 0; m < 4; ++m)
#pragma unroll
                    for (int bj = 0; bj < 2; ++bj) { float xo[8]; unpack8(xw[m][bj], xo); const f32x4 a0 = acc[ai][bj][m][0], a1 = acc[ai][bj][m][1];
                        float o[8] = {xo[0] + gv[bj][0][0] * a0[0], xo[1] + gv[bj][0][1] * a0[1], xo[2] + gv[bj][0][2] * a0[2], xo[3] + gv[bj][0][3] * a0[3],
                                      xo[4] + gv[bj][1][0] * a1[0], xo[5] + gv[bj][1][1] * a1[1], xo[6] + gv[bj][1][2] * a1[2], xo[7] + gv[bj][1][3] * a1[3]};
                        *(u32x4*)(X + (size_t)(row0 + ai * 128 + m * 16) * 1024 + col0 + bj * 128) = pack8(o); }
            }
        }
    }
};
struct EpiMoe1 {
    static constexpr bool PERM = true, AFTER_DRAIN = false, CHAIN = false;
    bf16* ACT;
    __device__ __forceinline__ void operator()(const f32x4 (&acc)[2][2][4][2], const pg8::Unit& u, int wr, int wc, int fr, int fq) const {
        const int row0 = u.pm * 256 + wr * 64 + fr, col0 = (u.pn & 7) * 128 + wc * 32 + 8 * fq;
#pragma unroll
        for (int ai = 0; ai < 2; ++ai)
#pragma unroll
            for (int m = 0; m < 4; ++m) { const size_t r = (size_t)(row0 + ai * 128 + m * 16);
                const f32x4 a0 = acc[ai][0][m][0], a1 = acc[ai][0][m][1], u0 = acc[ai][1][m][0], u1 = acc[ai][1][m][1];
                float o[8];
#pragma unroll
                for (int k = 0; k < 4; ++k) { o[k] = a0[k] * sigmoidf_(a0[k]) * u0[k]; o[4 + k] = a1[k] * sigmoidf_(a1[k]) * u1[k]; }
                *(u32x4*)(ACT + r * 1024 + col0) = pack8(o); }
    }
};
struct EpiMoe2 {
    static constexpr bool PERM = true, AFTER_DRAIN = false, CHAIN = false;
    bf16* Y; const float* topw;
    __device__ __forceinline__ void operator()(const f32x4 (&acc)[2][2][4][2], const pg8::Unit& u, int wr, int wc, int fr, int fq) const {
        const int row0 = u.pm * 256 + wr * 64 + fr, col0 = (u.pn & 3) * 256 + wc * 32 + 8 * fq;
        float twv[2][4];
#pragma unroll
        for (int ai = 0; ai < 2; ++ai)
#pragma unroll
            for (int m = 0; m < 4; ++m) twv[ai][m] = topw[row0 + ai * 128 + m * 16];
#pragma unroll
        for (int ai = 0; ai < 2; ++ai)
#pragma unroll
            for (int m = 0; m < 4; ++m) { const size_t r = (size_t)(row0 + ai * 128 + m * 16); const float tw = twv[ai][m];
#pragma unroll
                for (int bj = 0; bj < 2; ++bj) { const f32x4 v0 = acc[ai][bj][m][0] * tw, v1 = acc[ai][bj][m][1] * tw;
                    u32x4 w; w.x = pk2(v0[0], v0[1]); w.y = pk2(v0[2], v0[3]); w.z = pk2(v1[0], v1[1]); w.w = pk2(v1[2], v1[3]);
                    *(u32x4*)(Y + r * 1024 + col0 + bj * 128) = w; } }
    }
};

__device__ __forceinline__ void tr_item(const float* W, int N, int k0, int n0, bf16* dst, int K, LAS float* scr, int lane) {
#pragma unroll 8
    for (int i = 0; i < 32; ++i) { const int kk = 2 * i + (lane >> 5); scr[kk * 33 + (lane & 31)] = W[(size_t)(k0 + kk) * N + n0 + (lane & 31)]; }
    LDS_WAIT();
    const int cc = lane & 7;
#pragma unroll
    for (int j = 0; j < 4; ++j) { const int n = (lane >> 3) + 8 * j; const LAS float* s = scr + (8 * cc) * 33 + n;
        u32x4 o; o.x = pk2(s[0 * 33], s[1 * 33]); o.y = pk2(s[2 * 33], s[3 * 33]); o.z = pk2(s[4 * 33], s[5 * 33]); o.w = pk2(s[6 * 33], s[7 * 33]);
        *(u32x4*)(dst + (size_t)n * K + 8 * cc) = o; }
    LDS_WAIT();
}
__device__ __forceinline__ void convert_small(KPC p, int l, LAS unsigned char* lds, int lane, int wave, int bid, int G) {
    LAS float* scr = (LAS float*)(lds + wave * 8448);
    const int gw = bid * 8 + wave, NGW = G * 8;
    constexpr int I_IN = 16 * 200, I_BR = 8 * 32, I_OUT = 16 * 32;
    bf16* wtin = (bf16*)(p->ws + WS_WTIN); bf16* wtbr = (bf16*)(p->ws + WS_WTBR); bf16* wtout = (bf16*)(p->ws + WS_WTOUT);
    for (int it = gw; it < I_IN + 3 * I_BR + I_OUT; it += NGW) {
        int r = it;
        if (r < I_IN) { const int kb = r / 200, nb = r % 200; tr_item(p->w_in + (size_t)l * 1024 * 6400, 6400, 64 * kb, 32 * nb, wtin + (size_t)(32 * nb) * 1024 + 64 * kb, 1024, scr, lane); continue; }
        r -= I_IN;
        if (r < 3 * I_BR) { const int br = r / I_BR, q = r % I_BR, kb = q / 32, nb = q % 32;
            tr_item(p->w_branch + ((size_t)l * 3 + br) * 512 * 1024, 1024, 64 * kb, 32 * nb, wtbr + (size_t)(br * 1024 + 32 * nb) * 512 + 64 * kb, 512, scr, lane); continue; }
        r -= 3 * I_BR;
        { const int kb = r / 32, nb = r % 32; tr_item(p->w_out + (size_t)l * 1024 * 1024, 1024, 64 * kb, 32 * nb, wtout + (size_t)(32 * nb) * 1024 + 64 * kb, 1024, scr, lane); }
    }
}
__device__ __forceinline__ void convert_experts(KPC p, int l, int lo, int hi, int widx, int nw, LAS unsigned char* lds, int lane, int wave) {
    LAS float* scr = (LAS float*)(lds + wave * 8448);
    bf16* wt1 = (bf16*)(p->ws + WS_WT1); bf16* wt2 = (bf16*)(p->ws + WS_WT2);
    for (int it = lo + widx; it < hi; it += nw) {
        const int e = it / 1536, q = it % 1536, which = q / 512, qq = q % 512, kb = qq / 32, nb = qq % 32, n0 = 32 * nb, k0 = 64 * kb;
        const size_t woff = ((size_t)l * NE + e) * 1024 * 1024;
        if (which == 0) tr_item(p->w_eg + woff, 1024, k0, n0, wt1 + ((size_t)e * 2048 + (n0 >> 7) * 256 + (n0 & 127)) * 1024 + k0, 1024, scr, lane);
        else if (which == 1) tr_item(p->w_eu + woff, 1024, k0, n0, wt1 + ((size_t)e * 2048 + (n0 >> 7) * 256 + 128 + (n0 & 127)) * 1024 + k0, 1024, scr, lane);
        else tr_item(p->w_ed + woff, 1024, k0, n0, wt2 + ((size_t)e * 1024 + n0) * 1024 + k0, 1024, scr, lane);
    }
}
constexpr int CVT_ITEMS = NE * 3 * 512;
constexpr int CVT_G_IDLE0 = 96, CVT_M_IDLE0 = 32, CVT_O_IDLE0 = 32;
constexpr int CVT_G_HI = 7680, CVT_M_HI = 7680 + 14336;

__device__ __forceinline__ void phase_prep(KPC p, LAS unsigned char* lds, int tid, int lane, int wave, int bid, int G) {
    unsigned char* ws = p->ws;
    {   float* rc = (float*)(ws + WS_ROPEC); float* rsn = (float*)(ws + WS_ROPES);
        for (int i = bid * 512 + tid; i < T * 32; i += G * 512) { const int t = i >> 5, f = i & 31; const int pos = (f < 16) ? (t >> 6) : (t & 63); const int fi = f & 15;
            const float inv = ex2(-(float)fi * (13.287712379549449f / 16.f));
            float ang = (float)pos * inv; ang -= 6.283185307179586f * rintf(ang * 0.15915494309189535f);
            rc[i] = __cosf(ang); rsn[i] = __sinf(ang); } }
    if (bid == 0 && tid < 16) { const int l = tid >> 3, dir = (tid >> 2) & 1, h = tid & 3; ((float*)(ws + WS_LG))[tid] = log2_sigmoid(dir ? p->dec_b[l * 4 + h] : p->dec_f[l * 4 + h]); }
    {   LAS float* sv = (LAS float*)lds;
        LAS float* red = (LAS float*)(lds + 36864);
        for (int i = tid; i < 9 * 1024; i += 512) { const int r = i >> 10, k = i & 1023; const float v = (r < 8) ? p->c[r * 1024 + k] : p->c_ctx[k]; sv[i] = v * sigmoidf_(v); }
        __syncthreads();
        for (int it = bid; it < 192; it += G) {
            const int l = it / 96, n0 = (it % 96) * 64;
            const float* W = p->w_mod + (size_t)l * 1024 * 6144 + n0 + lane;
            float acc[9];
#pragma unroll
            for (int r = 0; r < 9; ++r) acc[r] = 0.f;
#pragma unroll 1
            for (int k0 = wave * 128; k0 < wave * 128 + 128; k0 += 16) {
                float wv[16];
#pragma unroll
                for (int kk = 0; kk < 16; ++kk) wv[kk] = W[(size_t)(k0 + kk) * 6144];
#pragma unroll
                for (int kk = 0; kk < 16; ++kk)
#pragma unroll
                    for (int r = 0; r < 9; ++r) acc[r] += sv[r * 1024 + k0 + kk] * wv[kk]; }
#pragma unroll
            for (int r = 0; r < 9; ++r) red[(wave * 9 + r) * 64 + lane] = acc[r];
            __syncthreads();
            for (int i = tid; i < 576; i += 512) { const int r = i >> 6, ln = i & 63; float s = 0.f;
#pragma unroll
                for (int w = 0; w < 8; ++w) s += red[(w * 9 + r) * 64 + ln];
                s += p->b_mod[l * 6144 + n0 + ln]; ((float*)(ws + WS_MODV))[(l * 9 + r) * 6144 + n0 + ln] = s; }
            __syncthreads();
        }
    }
    __syncthreads();
    convert_small(p, 0, lds, lane, wave, bid, G);
}

__device__ __forceinline__ float row_rs(const f32x4 (&v)[4]) {
    float ss = 0.f;
#pragma unroll
    for (int j = 0; j < 4; ++j) ss += (v[j].x * v[j].x + v[j].y * v[j].y) + (v[j].z * v[j].z + v[j].w * v[j].w);
    return rsq_(wave_sum(ss) * (1.f / 1024.f) + EPS);
}
__device__ __forceinline__ void norm_mod(const f32x4 (&v)[4], float rs, const float* gain, const float* sh, const float* sc, f32x4 (&h)[4], int lane) {
#pragma unroll
    for (int j = 0; j < 4; ++j) { const int col = 4 * lane + 256 * j; const f32x4 g = *(const f32x4*)(gain + col), a = *(const f32x4*)(sc + col), b = *(const f32x4*)(sh + col);
        h[j] = (v[j] * rs) * g * (a + 1.0f) + b; }
}
__device__ __forceinline__ void store_h(const f32x4 (&h)[4], bf16* hrow, int lane) {
#pragma unroll
    for (int j = 0; j < 4; ++j) { u32x2 w; w.x = pk2(h[j].x, h[j].y); w.y = pk2(h[j].z, h[j].w); *(u32x2*)(hrow + 4 * lane + 256 * j) = w; }
}
__device__ __forceinline__ void phase_norm_in(KPC p, int lane, int wave, int bid, int G) {
    const float* modv = (const float*)(p->ws + WS_MODV); bf16* H = (bf16*)(p->ws + WS_H);
    const int stride = G * 8; int r = bid * 8 + wave;
    f32x4 vn[4];
    {   const float* src = (r < ML) ? p->x + (size_t)r * 1024 : p->ctx + (size_t)(r - ML) * 1024;
#pragma unroll
        for (int j = 0; j < 4; ++j) vn[j] = (r < M) ? *(const f32x4*)(src + 4 * lane + 256 * j) : (f32x4){0.f, 0.f, 0.f, 0.f}; }
    for (; r < M; r += stride) {
        const int bi = (r < ML) ? (r >> 12) : 8; const float* mv = modv + bi * 6144;
        f32x4 v[4], h[4], g[4], sc[4], sh[4];
#pragma unroll
        for (int j = 0; j < 4; ++j) { v[j] = vn[j]; const int col = 4 * lane + 256 * j; g[j] = *(const f32x4*)(p->norm1_g + col); sh[j] = *(const f32x4*)(mv + col); sc[j] = *(const f32x4*)(mv + 1024 + col); }
        const int rn = r + stride;
        if (rn < M) { const float* src = (rn < ML) ? p->x + (size_t)rn * 1024 : p->ctx + (size_t)(rn - ML) * 1024;
#pragma unroll
            for (int j = 0; j < 4; ++j) vn[j] = *(const f32x4*)(src + 4 * lane + 256 * j); }
        const float rs = row_rs(v);
#pragma unroll
        for (int j = 0; j < 4; ++j) h[j] = (v[j] * rs) * g[j] * (sc[j] + 1.0f) + sh[j];
        store_h(h, H + (size_t)r * 1024, lane);
    }
}

typedef short s16x4 __attribute__((ext_vector_type(4)));
__device__ __forceinline__ u32x2 lds_tr16(const LAS unsigned char* addr) { const s16x4 r = __builtin_amdgcn_ds_read_tr16_b64_v4i16((LAS s16x4*)addr); return __builtin_bit_cast(u32x2, r); }
__device__ __forceinline__ void ld8f(const float* p, float (&f)[8]) { const f32x4 a = *(const f32x4*)p, b = *(const f32x4*)(p + 4); f[0] = a[0]; f[1] = a[1]; f[2] = a[2]; f[3] = a[3]; f[4] = b[0]; f[5] = b[1]; f[6] = b[2]; f[7] = b[3]; }
__device__ __forceinline__ void att_item(KPC p, int l, LAS unsigned char* lds, int item, float Mb2, int tid, int lane, int wave) {
    const bf16* ZA = (const bf16*)(p->ws + WS_ZA); bf16* BR = (bf16*)p->out + (size_t)2 * M * 512;
    const float* rc = (const float*)(p->ws + WS_ROPEC); const float* rsn = (const float*)(p->ws + WS_ROPES);
    const bool isctx = item >= 512;
    int b, kvh, qb;
    if (!isctx) { b = item >> 6; kvh = (item >> 5) & 1; qb = item & 31; } else { const int ci = item - 512; b = ci >> 2; kvh = (ci >> 1) & 1; qb = ci & 1; }
    const int rowbase = isctx ? ML + b * CL : b * T;
    const int g = wave >> 1, qs = wave & 1, hh = kvh * 4 + g, c = lane & 15, g4 = lane >> 4, q0 = qb * 128 + qs * 64;
    const float* qg = p->qn_g + l * 64; const float* kg = p->kn_g + l * 64;
    LAS unsigned char* Kl = lds;
    bf16x8 qf[4][2];
    float qga[8], qgb[8]; ld8f(qg + 8 * g4, qga); ld8f(qg + 32 + 8 * g4, qgb);
#pragma unroll
    for (int ti = 0; ti < 4; ++ti) {
        const int pos = q0 + 16 * ti + c; const bf16* src = ZA + (size_t)(rowbase + pos) * NZA + C_AQ + hh * 64 + 8 * g4;
        float a[8], bb[8]; unpack8(*(const u32x4*)src, a); unpack8(*(const u32x4*)(src + 32), bb);
        float ss = 0.f;
#pragma unroll
        for (int j = 0; j < 8; ++j) ss += a[j] * a[j] + bb[j] * bb[j];
        ss = sum_x16_x32(ss);
        const float rs = rsq_(ss * (1.f / 64.f) + EPS);
#pragma unroll
        for (int j = 0; j < 8; ++j) { a[j] *= rs * qga[j]; bb[j] *= rs * qgb[j]; }
        if (!isctx) { float cs8[8], sn8[8]; ld8f(rc + pos * 32 + 8 * g4, cs8); ld8f(rsn + pos * 32 + 8 * g4, sn8);
#pragma unroll
            for (int j = 0; j < 8; ++j) { const float cs = cs8[j], sn = sn8[j]; const float x1 = a[j], x2 = bb[j]; a[j] = x1 * cs - x2 * sn; bb[j] = x1 * sn + x2 * cs; } }
#pragma unroll
        for (int j = 0; j < 8; ++j) { a[j] *= 0.125f * LOG2E; bb[j] *= 0.125f * LOG2E; }
        qf[ti][0] = as_bf16x8(pack8(a)); qf[ti][1] = as_bf16x8(pack8(bb));
        __builtin_amdgcn_sched_barrier(0);
    }
    f32x4 O[4][4]; float lsum[4];
#pragma unroll
    for (int i = 0; i < 4; ++i) { lsum[i] = 0.f;
#pragma unroll
        for (int j = 0; j < 4; ++j) O[i][j] = (f32x4){0.f, 0.f, 0.f, 0.f}; }
    const int key = tid >> 2, q4 = tid & 3;
    LAS unsigned char* Vl = lds + 55296;
#pragma unroll 1
    for (int st = isctx ? 1 : 0; st < 2; ++st) {
        __syncthreads();
        {   u32x4 kr[1][2], vr[1][2];
#define ATT_VB(lb_) ((st == 0) ? ((qb - 1 + (lb_)) >= 0 && (qb - 1 + (lb_)) <= 31) : ((lb_) < 2))
#define ATT_LD(lb_, s_) do { if (ATT_VB(lb_)) { const int krow = (st == 0) ? b * T + (qb - 1 + (lb_)) * 128 + key : ML + b * CL + 128 * (lb_) + key; \
                const bf16* ks = ZA + (size_t)krow * NZA + C_AK + kvh * 64 + 8 * q4; kr[s_][0] = *(const u32x4*)ks; kr[s_][1] = *(const u32x4*)(ks + 32); \
                const bf16* vs = ZA + (size_t)krow * NZA + C_AV + kvh * 64 + 16 * q4; vr[s_][0] = *(const u32x4*)vs; vr[s_][1] = *(const u32x4*)(vs + 8); } } while (0)
#pragma unroll 1
            for (int lb = 0; lb < 3; ++lb) {
                ATT_LD(lb, 0);
                if (ATT_VB(lb)) {
                    float a[8], bb[8]; unpack8(kr[0][0], a); unpack8(kr[0][1], bb);
                    float ss = 0.f;
#pragma unroll
                    for (int j = 0; j < 8; ++j) ss += a[j] * a[j] + bb[j] * bb[j];
                    ss = sum_x1_x2(ss);
                    const float rs = rsq_(ss * (1.f / 64.f) + EPS);
                    float kga[8], kgb[8]; ld8f(kg + 8 * q4, kga); ld8f(kg + 32 + 8 * q4, kgb);
#pragma unroll
                    for (int j = 0; j < 8; ++j) { a[j] *= rs * kga[j]; bb[j] *= rs * kgb[j]; }
                    __builtin_amdgcn_sched_barrier(0);
                    if (st == 0) { const int pos = (qb - 1 + lb) * 128 + key; float cs8[8], sn8[8]; ld8f(rc + pos * 32 + 8 * q4, cs8); ld8f(rsn + pos * 32 + 8 * q4, sn8);
#pragma unroll
                        for (int j = 0; j < 8; ++j) { const float cs = cs8[j], sn = sn8[j]; const float x1 = a[j], x2 = bb[j]; a[j] = x1 * cs - x2 * sn; bb[j] = x1 * sn + x2 * cs; } }
                    LAS unsigned char* kd = Kl + (lb * 128 + key) * 144; *(LAS u32x4*)(kd + 16 * q4) = pack8(a); *(LAS u32x4*)(kd + 64 + 16 * q4) = pack8(bb);
                    LAS unsigned char* vd = Vl + (lb * 128 + key) * 144 + 32 * q4; *(LAS u32x4*)vd = vr[0][0]; *(LAS u32x4*)(vd + 16) = vr[0][1];
                }
            }
#undef ATT_VB
#undef ATT_LD
        }
        __syncthreads();
#pragma unroll 1
        for (int lb = 0; lb < 3; ++lb) {
            if (st == 0) { const int kb = qb - 1 + lb; if (kb < 0 || kb > 31) continue; } else if (lb >= 2) continue;
            const int mode = (st == 0) ? ((lb == 0) ? 1 : ((lb == 2) ? 2 : 0)) : 0;
            const LAS unsigned char* Kb = Kl + lb * 128 * 144; const LAS unsigned char* Vb = Vl + lb * 128 * 144;
#pragma unroll 1
            for (int kk = 0; kk < 4; ++kk) {
                if ((mode == 1 && 32 * kk + 31 < qs * 64) || (mode == 2 && 32 * kk > qs * 64 + 63)) continue;
                bf16x8 ka[2][2];
#pragma unroll
                for (int hf = 0; hf < 2; ++hf)
#pragma unroll
                    for (int ks = 0; ks < 2; ++ks) ka[hf][ks] = *(const LAS bf16x8*)(Kb + (32 * kk + 16 * hf + c) * 144 + ks * 64 + g4 * 16);
                bf16x8 pf[4];
#pragma unroll
                for (int ti = 0; ti < 4; ++ti) {
                    f32x4 sa = (f32x4){-Mb2, -Mb2, -Mb2, -Mb2}, sb = sa;
                    sa = mfma16(ka[0][0], qf[ti][0], sa); sa = mfma16(ka[0][1], qf[ti][1], sa);
                    sb = mfma16(ka[1][0], qf[ti][0], sb); sb = mfma16(ka[1][1], qf[ti][1], sb);
                    float pa[4], pb[4];
#pragma unroll
                    for (int rr = 0; rr < 4; ++rr) { pa[rr] = ex2(sa[rr]); pb[rr] = ex2(sb[rr]); }
                    if (mode != 0) {
                        const int ii = qs * 64 + 16 * ti + c; const int mlo = (mode == 1) ? ii : -1000, mhi = (mode == 2) ? ii : 1000;
#pragma unroll
                        for (int rr = 0; rr < 4; ++rr) { const int ja = 32 * kk + 4 * g4 + rr, jb = ja + 16;
                            pa[rr] = (ja >= mlo && ja <= mhi) ? pa[rr] : 0.f; pb[rr] = (jb >= mlo && jb <= mhi) ? pb[rr] : 0.f; } }
                    lsum[ti] += ((pa[0] + pa[1]) + (pa[2] + pa[3])) + ((pb[0] + pb[1]) + (pb[2] + pb[3]));
                    u32x4 w; w.x = pk2(pa[0], pa[1]); w.y = pk2(pa[2], pa[3]); w.z = pk2(pb[0], pb[1]); w.w = pk2(pb[2], pb[3]); pf[ti] = as_bf16x8(w);
                }
#pragma unroll
                for (int dt = 0; dt < 4; ++dt) {
                    const u32x2 v0 = lds_tr16(Vb + (32 * kk + 4 * g4 + (c >> 2)) * 144 + (16 * dt + 4 * (c & 3)) * 2), v1 = lds_tr16(Vb + (32 * kk + 16 + 4 * g4 + (c >> 2)) * 144 + (16 * dt + 4 * (c & 3)) * 2);
                    u32x4 vv; vv.x = v0.x; vv.y = v0.y; vv.z = v1.x; vv.w = v1.y; const bf16x8 va = as_bf16x8(vv);
#pragma unroll
                    for (int ti = 0; ti < 4; ++ti) O[dt][ti] = mfma16(va, pf[ti], O[dt][ti]);
                }
            }
        }
    }
    const float sk = ex2(p->sink[l * 8 + hh] * LOG2E - Mb2);
#pragma unroll
    for (int ti = 0; ti < 4; ++ti) { float lt = sum_x16_x32(lsum[ti]); const float inv = rcp_(lt + sk);
        bf16* dst = BR + (size_t)(rowbase + q0 + 16 * ti + c) * 512 + hh * 64 + 4 * g4;
#pragma unroll
        for (int dt = 0; dt < 4; ++dt) { const f32x4 o = O[dt][ti] * inv; u32x2 w; w.x = pk2(o[0], o[1]); w.y = pk2(o[2], o[3]); *(u32x2*)(dst + 16 * dt) = w; } }
    __syncthreads();
}

__device__ __forceinline__ void sgu_vprep_item(KPC p, int ch, int tid) {
    bf16* ZA = (bf16*)(p->ws + WS_ZA);
    const int seg = tid & 15;
    bf16* rowp0 = ZA + (size_t)(ch * 128 + (tid >> 4)) * NZA + C_SV + 32 * seg;
    u32x4 raw[4][4];
#pragma unroll
    for (int ps = 0; ps < 4; ++ps)
#pragma unroll
        for (int q = 0; q < 4; ++q) raw[ps][q] = *(const u32x4*)(rowp0 + (size_t)ps * 32 * NZA + 8 * q);
#pragma unroll
    for (int ps = 0; ps < 4; ++ps) {
        bf16* rowp = rowp0 + (size_t)ps * 32 * NZA;
        float f[4][8]; float s = 0.f, ss = 0.f;
#pragma unroll
        for (int q = 0; q < 4; ++q) unpack8(raw[ps][q], f[q]);
#pragma unroll
        for (int q = 0; q < 4; ++q)
#pragma unroll
            for (int e = 0; e < 8; ++e) { const float y = gelu_tanh(f[q][e]); f[q][e] = y; s += y; ss += y * y; }
        s = row_sum(s); ss = row_sum(ss);
        const float mean = s * (1.f / 512.f), var = fmaxf(ss * (1.f / 512.f) - mean * mean, 0.f), rstd = rsq_(var + EPS);
#pragma unroll
        for (int q = 0; q < 4; ++q) {
#pragma unroll
            for (int e = 0; e < 8; ++e) f[q][e] = (f[q][e] - mean) * rstd;
            *(u32x4*)(rowp + 8 * q) = pack8(f[q]); }
    }
}
__device__ __forceinline__ void sgu_block(KPC p, int l, LAS unsigned char* lds, int nchunk, int tid, int lane, int wave, int bid, int G) {
    const bf16* ZA = (const bf16*)(p->ws + WS_ZA); bf16* BR = (bf16*)p->out + (size_t)1 * M * 512;
    const int c = lane & 15, g4 = lane >> 4, tq = c >> 2, tp = c & 3, j = tid >> 2, q4 = tid & 3;
    LAS unsigned char* Vl = lds;
    LAS unsigned char* WL = lds + 34816;
    const int g = bid & 3, cstride = G >> 2; int ch = bid >> 2;
    if ((G & 3) != 0 || ch >= nchunk) return;
    {   const float* wsrc = p->sgu_w + ((size_t)(l * 4 + g) * 128 + j) * 128 + 32 * q4;
#pragma unroll
        for (int q = 0; q < 4; ++q) { const f32x4 a = *(const f32x4*)(wsrc + 8 * q), bq = *(const f32x4*)(wsrc + 8 * q + 4);
            u32x4 w; w.x = pk2(a.x, a.y); w.y = pk2(a.z, a.w); w.z = pk2(bq.x, bq.y); w.w = pk2(bq.z, bq.w);
            *(LAS u32x4*)(WL + j * 272 + (32 * q4 + 8 * q) * 2) = w; } }
    const int col = 128 * g + 16 * wave + 4 * g4;
    u32x4 raw[4]; u32x2 uwn[8]; float bias[8];
#pragma unroll
    for (int ti = 0; ti < 8; ++ti) bias[ti] = p->sgu_b[(l * 4 + g) * 128 + 16 * ti + c];
    {   const bf16* src = ZA + (size_t)(ch * 128 + j) * NZA + C_SV + 128 * g + 32 * q4;
#pragma unroll
        for (int q = 0; q < 4; ++q) raw[q] = *(const u32x4*)(src + 8 * q);
#pragma unroll
        for (int ti = 0; ti < 8; ++ti) uwn[ti] = *(const u32x2*)(ZA + (size_t)(ch * 128 + 16 * ti + c) * NZA + C_SU + col); }
    for (; ch < nchunk; ch += cstride) {
        const int r0 = ch * 128;
        __syncthreads();
#pragma unroll
        for (int q = 0; q < 4; ++q) *(LAS u32x4*)(Vl + j * 272 + (32 * q4 + 8 * q) * 2) = raw[q];
        __syncthreads();
        u32x2 uw[8];
#pragma unroll
        for (int ti = 0; ti < 8; ++ti) uw[ti] = uwn[ti];
        if (ch + cstride < nchunk) { const bf16* src = ZA + (size_t)((ch + cstride) * 128 + j) * NZA + C_SV + 128 * g + 32 * q4;
#pragma unroll
            for (int q = 0; q < 4; ++q) raw[q] = *(const u32x4*)(src + 8 * q);
#pragma unroll
            for (int ti = 0; ti < 8; ++ti) uwn[ti] = *(const u32x2*)(ZA + (size_t)((ch + cstride) * 128 + 16 * ti + c) * NZA + C_SU + col); }
        __builtin_amdgcn_sched_barrier(0);
        bf16x8 af[4];
#pragma unroll
        for (int ks = 0; ks < 4; ++ks) { const u32x2 v0 = lds_tr16(Vl + (32 * ks + 8 * g4 + tq) * 272 + (16 * wave + 4 * tp) * 2), v1 = lds_tr16(Vl + (32 * ks + 8 * g4 + 4 + tq) * 272 + (16 * wave + 4 * tp) * 2);
            u32x4 vv; vv.x = v0.x; vv.y = v0.y; vv.z = v1.x; vv.w = v1.y; af[ks] = as_bf16x8(vv); }
#pragma unroll
        for (int ti = 0; ti < 8; ++ti) {
            f32x4 acc = (f32x4){0.f, 0.f, 0.f, 0.f};
#pragma unroll
            for (int ks = 0; ks < 4; ++ks) acc = mfma16(af[ks], *(const LAS bf16x8*)(WL + (16 * ti + c) * 272 + (32 * ks + 8 * g4) * 2), acc);
            const float o0 = gelu_tanh(bflo(uw[ti].x)) * (acc[0] + bias[ti]), o1 = gelu_tanh(bfhi(uw[ti].x)) * (acc[1] + bias[ti]), o2 = gelu_tanh(bflo(uw[ti].y)) * (acc[2] + bias[ti]), o3 = gelu_tanh(bfhi(uw[ti].y)) * (acc[3] + bias[ti]);
            u32x2 w; w.x = pk2(o0, o1); w.y = pk2(o2, o3); *(u32x2*)(BR + (size_t)(r0 + 16 * ti + c) * 512 + col) = w;
        }
    }
    __syncthreads();
}
__device__ __forceinline__ void sgu_item(KPC p, int l, LAS unsigned char* lds, int item, int tid, int lane, int wave) {
    const bf16* ZA = (const bf16*)(p->ws + WS_ZA); bf16* BR = (bf16*)p->out + (size_t)1 * M * 512;
    const int ch = item >> 2, g = item & 3, r0 = ch * 128, c = lane & 15, g4 = lane >> 4;
    LAS unsigned char* vT = lds;
    LAS unsigned char* WL = lds + 34816;
    {   const int j = tid >> 2, q4 = tid & 3; const bf16* src = ZA + (size_t)(r0 + j) * NZA + C_SV + 128 * g + 32 * q4;
#pragma unroll
        for (int q = 0; q < 4; ++q) { const u32x4 v = *(const u32x4*)(src + 8 * q); const unsigned vw[4] = {v.x, v.y, v.z, v.w};
#pragma unroll
            for (int e = 0; e < 4; ++e) { *(LAS unsigned short*)(vT + (32 * q4 + 8 * q + 2 * e) * 272 + j * 2) = (unsigned short)(vw[e] & 0xffffu); *(LAS unsigned short*)(vT + (32 * q4 + 8 * q + 2 * e + 1) * 272 + j * 2) = (unsigned short)(vw[e] >> 16); } }
        const float* wsrc = p->sgu_w + ((size_t)(l * 4 + g) * 128 + (tid >> 2)) * 128 + 32 * (tid & 3);
#pragma unroll
        for (int q = 0; q < 4; ++q) { const f32x4 a = *(const f32x4*)(wsrc + 8 * q), bq = *(const f32x4*)(wsrc + 8 * q + 4);
            u32x4 w; w.x = pk2(a.x, a.y); w.y = pk2(a.z, a.w); w.z = pk2(bq.x, bq.y); w.w = pk2(bq.z, bq.w);
            *(LAS u32x4*)(WL + (tid >> 2) * 272 + (32 * (tid & 3) + 8 * q) * 2) = w; }
    }
    __syncthreads();
    bf16x8 af[4];
#pragma unroll
    for (int ks = 0; ks < 4; ++ks) af[ks] = *(const LAS bf16x8*)(vT + (16 * wave + c) * 272 + (32 * ks + 8 * g4) * 2);
    const int col = 128 * g + 16 * wave + 4 * g4;
    u32x2 uw[8]; float bias[8];
#pragma unroll
    for (int ti = 0; ti < 8; ++ti) { uw[ti] = *(const u32x2*)(ZA + (size_t)(r0 + 16 * ti + c) * NZA + C_SU + col); bias[ti] = p->sgu_b[(l * 4 + g) * 128 + 16 * ti + c]; }
#pragma unroll
    for (int ti = 0; ti < 8; ++ti) {
        f32x4 acc = (f32x4){0.f, 0.f, 0.f, 0.f};
#pragma unroll
        for (int ks = 0; ks < 4; ++ks) acc = mfma16(af[ks], *(const LAS bf16x8*)(WL + (16 * ti + c) * 272 + (32 * ks + 8 * g4) * 2), acc);
        const float o0 = gelu_tanh(bflo(uw[ti].x)) * (acc[0] + bias[ti]), o1 = gelu_tanh(bfhi(uw[ti].x)) * (acc[1] + bias[ti]), o2 = gelu_tanh(bflo(uw[ti].y)) * (acc[2] + bias[ti]), o3 = gelu_tanh(bfhi(uw[ti].y)) * (acc[3] + bias[ti]);
        u32x2 w; w.x = pk2(o0, o1); w.y = pk2(o2, o3); *(u32x2*)(BR + (size_t)(r0 + 16 * ti + c) * 512 + col) = w;
    }
    __syncthreads();
}

__device__ __forceinline__ void ret_load_k(KPC p, const bf16* ZA, int r0, int h, bool latent, int pos0, int tid, float (&a)[8], float (&bb)[8]) {
    const int j = tid >> 2, q4 = tid & 3; const bf16* src = ZA + (size_t)(r0 + j) * NZA + C_RK + 64 * h + 8 * q4;
    unpack8(*(const u32x4*)src, a); unpack8(*(const u32x4*)(src + 32), bb);
    if (latent) { const float* rc = (const float*)(p->ws + WS_ROPEC); const float* rsn = (const float*)(p->ws + WS_ROPES); const int pos = pos0 + j; float cs8[8], sn8[8]; ld8f(rc + pos * 32 + 8 * q4, cs8); ld8f(rsn + pos * 32 + 8 * q4, sn8);
#pragma unroll
        for (int e = 0; e < 8; ++e) { const float cs = cs8[e], sn = sn8[e]; const float x1 = a[e], x2 = bb[e]; a[e] = x1 * cs - x2 * sn; bb[e] = x1 * sn + x2 * cs; } }
#pragma unroll
    for (int e = 0; e < 8; ++e) { a[e] *= 0.125f; bb[e] *= 0.125f; }
}
__device__ __forceinline__ void ret_stage_vT(const bf16* ZA, int r0, int h, LAS unsigned char* vT, int tid) {
    const int j = tid >> 2, q4 = tid & 3; const bf16* src = ZA + (size_t)(r0 + j) * NZA + C_RV + 128 * h + 32 * q4;
#pragma unroll
    for (int q = 0; q < 4; ++q) { const u32x4 v = *(const u32x4*)(src + 8 * q); const unsigned vw[4] = {v.x, v.y, v.z, v.w};
#pragma unroll
        for (int e = 0; e < 4; ++e) { *(LAS unsigned short*)(vT + (32 * q4 + 8 * q + 2 * e) * 272 + j * 2) = (unsigned short)(vw[e] & 0xffffu); *(LAS unsigned short*)(vT + (32 * q4 + 8 * q + 2 * e + 1) * 272 + j * 2) = (unsigned short)(vw[e] >> 16); } }
}
__device__ __forceinline__ void ret_upd_block(KPC p, int l, LAS unsigned char* lds, int first, int stride, int total, int tid, int lane, int wave) {
    const bf16* ZA = (const bf16*)(p->ws + WS_ZA); float* RS = (float*)(p->ws + WS_RS);
    const float* rc = (const float*)(p->ws + WS_ROPEC); const float* rsn = (const float*)(p->ws + WS_ROPES);
    const int c = lane & 15, g4 = lane >> 4, tq = c >> 2, tp = c & 3, j = tid >> 2, q4 = tid & 3;
    LAS unsigned char* Vl = lds; LAS unsigned char* Kf = lds + 34816; LAS unsigned char* Kb = lds + 34816 + 18432;
    u32x4 k0, k1, v[4]; f32x4 c0, c1, s0, s1;
#define UPD_DECODE(it_) const int b = (it_) / (NCH * 4), rem = (it_) % (NCH * 4), n = rem >> 2, h = rem & 3; const bool latent = n < 32; const int r0 = latent ? b * T + 128 * n : ML + b * CL + 128 * (n - 32)
#define UPD_LOAD(it_) do { UPD_DECODE(it_); const bf16* ks = ZA + (size_t)(r0 + j) * NZA + C_RK + 64 * h + 8 * q4; k0 = *(const u32x4*)ks; k1 = *(const u32x4*)(ks + 32); \
        if (latent) { const int pos = 128 * n + j; c0 = *(const f32x4*)(rc + pos * 32 + 8 * q4); c1 = *(const f32x4*)(rc + pos * 32 + 8 * q4 + 4); s0 = *(const f32x4*)(rsn + pos * 32 + 8 * q4); s1 = *(const f32x4*)(rsn + pos * 32 + 8 * q4 + 4); } \
        const bf16* vs = ZA + (size_t)(r0 + j) * NZA + C_RV + 128 * h + 32 * q4; _Pragma("unroll") for (int q = 0; q < 4; ++q) v[q] = *(const u32x4*)(vs + 8 * q); } while (0)
    int it = first;
    if (it < total) UPD_LOAD(it);
    for (; it < total; it += stride) {
        UPD_DECODE(it); (void)r0;
        const float lgf = ((const float*)(p->ws + WS_LG))[l * 8 + h], lgb = ((const float*)(p->ws + WS_LG))[l * 8 + 4 + h];
        __syncthreads();
        {   float a[8], bb[8]; unpack8(k0, a); unpack8(k1, bb);
            if (latent) {
#pragma unroll
                for (int e = 0; e < 8; ++e) { const float cs = (e < 4) ? c0[e & 3] : c1[e & 3], sn = (e < 4) ? s0[e & 3] : s1[e & 3]; const float x1 = a[e], x2 = bb[e]; a[e] = x1 * cs - x2 * sn; bb[e] = x1 * sn + x2 * cs; } }
            const float wf = 0.125f * ex2((float)(127 - j) * lgf), wb = 0.125f * ex2((float)j * lgb);
            float af_[8], bf_[8], ab_[8], bb_[8];
#pragma unroll
            for (int e = 0; e < 8; ++e) { af_[e] = a[e] * wf; bf_[e] = bb[e] * wf; ab_[e] = a[e] * wb; bb_[e] = bb[e] * wb; }
            *(LAS u32x4*)(Kf + j * 144 + 16 * q4) = pack8(af_); *(LAS u32x4*)(Kf + j * 144 + 64 + 16 * q4) = pack8(bf_);
            *(LAS u32x4*)(Kb + j * 144 + 16 * q4) = pack8(ab_); *(LAS u32x4*)(Kb + j * 144 + 64 + 16 * q4) = pack8(bb_);
#pragma unroll
            for (int q = 0; q < 4; ++q) *(LAS u32x4*)(Vl + j * 272 + (32 * q4 + 8 * q) * 2) = v[q];
        }
        __syncthreads();
        if (it + stride < total) UPD_LOAD(it + stride);
        __builtin_amdgcn_sched_barrier(0);
        bf16x8 af[4];
#pragma unroll
        for (int ks = 0; ks < 4; ++ks) { const u32x2 v0 = lds_tr16(Vl + (32 * ks + 8 * g4 + tq) * 272 + (16 * wave + 4 * tp) * 2), v1 = lds_tr16(Vl + (32 * ks + 8 * g4 + 4 + tq) * 272 + (16 * wave + 4 * tp) * 2);
            u32x4 vv; vv.x = v0.x; vv.y = v0.y; vv.z = v1.x; vv.w = v1.y; af[ks] = as_bf16x8(vv); }
#pragma unroll
        for (int dir = 0; dir < 2; ++dir) { const LAS unsigned char* Kx = dir ? Kb : Kf;
            float* dst = RS + ((size_t)(((b * 4 + h) * 2 + dir) * NCH + n) * 128 + 16 * wave + c) * 64 + 4 * g4;
#pragma unroll
            for (int dt = 0; dt < 4; ++dt) { f32x4 acc = (f32x4){0.f, 0.f, 0.f, 0.f};
#pragma unroll
                for (int ks = 0; ks < 4; ++ks) { const u32x2 kk0 = lds_tr16(Kx + (32 * ks + 8 * g4 + tq) * 144 + (16 * dt + 4 * tp) * 2), kk1 = lds_tr16(Kx + (32 * ks + 8 * g4 + 4 + tq) * 144 + (16 * dt + 4 * tp) * 2);
                    u32x4 kv; kv.x = kk0.x; kv.y = kk0.y; kv.z = kk1.x; kv.w = kk1.y; acc = mfma16(as_bf16x8(kv), af[ks], acc); }
                *(f32x4*)(dst + 16 * dt) = acc; } }
    }
#undef UPD_DECODE
#undef UPD_LOAD
    __syncthreads();
}
__device__ __forceinline__ void ret_upd_item(KPC p, int l, LAS unsigned char* lds, int item, int tid, int lane, int wave) {
    const bf16* ZA = (const bf16*)(p->ws + WS_ZA); float* RS = (float*)(p->ws + WS_RS);
    const int b = item / (NCH * 4), rem = item % (NCH * 4), n = rem >> 2, h = rem & 3, c = lane & 15, g4 = lane >> 4;
    const bool latent = n < 32; const int r0 = latent ? b * T + 128 * n : ML + b * CL + 128 * (n - 32);
    const float lgf = ((const float*)(p->ws + WS_LG))[l * 8 + h], lgb = ((const float*)(p->ws + WS_LG))[l * 8 + 4 + h];
    LAS unsigned char* Vl = lds; LAS unsigned char* Kf = lds + 34816; LAS unsigned char* Kb = lds + 34816 + 18432;
    {   float a[8], bb[8]; ret_load_k(p, ZA, r0, h, latent, 128 * n, tid, a, bb);
        const int j = tid >> 2, q4 = tid & 3; const float wf = ex2((float)(127 - j) * lgf), wb = ex2((float)j * lgb);
        float af_[8], bf_[8], ab_[8], bb_[8];
#pragma unroll
        for (int e = 0; e < 8; ++e) { af_[e] = a[e] * wf; bf_[e] = bb[e] * wf; ab_[e] = a[e] * wb; bb_[e] = bb[e] * wb; }
        *(LAS u32x4*)(Kf + j * 144 + 16 * q4) = pack8(af_); *(LAS u32x4*)(Kf + j * 144 + 64 + 16 * q4) = pack8(bf_);
        *(LAS u32x4*)(Kb + j * 144 + 16 * q4) = pack8(ab_); *(LAS u32x4*)(Kb + j * 144 + 64 + 16 * q4) = pack8(bb_);
        const bf16* vs = ZA + (size_t)(r0 + j) * NZA + C_RV + 128 * h + 32 * q4;
#pragma unroll
        for (int q = 0; q < 4; ++q) *(LAS u32x4*)(Vl + j * 272 + (32 * q4 + 8 * q) * 2) = *(const u32x4*)(vs + 8 * q);
    }
    __syncthreads();
    const int tq = c >> 2, tp = c & 3;
    bf16x8 af[4];
#pragma unroll
    for (int ks = 0; ks < 4; ++ks) { const u32x2 v0 = lds_tr16(Vl + (32 * ks + 8 * g4 + tq) * 272 + (16 * wave + 4 * tp) * 2), v1 = lds_tr16(Vl + (32 * ks + 8 * g4 + 4 + tq) * 272 + (16 * wave + 4 * tp) * 2);
        u32x4 vv; vv.x = v0.x; vv.y = v0.y; vv.z = v1.x; vv.w = v1.y; af[ks] = as_bf16x8(vv); }
#pragma unroll
    for (int dir = 0; dir < 2; ++dir) { const LAS unsigned char* Kx = dir ? Kb : Kf;
        float* dst = RS + ((size_t)(((b * 4 + h) * 2 + dir) * NCH + n) * 128 + 16 * wave + c) * 64 + 4 * g4;
#pragma unroll
        for (int dt = 0; dt < 4; ++dt) { f32x4 acc = (f32x4){0.f, 0.f, 0.f, 0.f};
#pragma unroll
            for (int ks = 0; ks < 4; ++ks) { const u32x2 k0 = lds_tr16(Kx + (32 * ks + 8 * g4 + tq) * 144 + (16 * dt + 4 * tp) * 2), k1 = lds_tr16(Kx + (32 * ks + 8 * g4 + 4 + tq) * 144 + (16 * dt + 4 * tp) * 2);
                u32x4 kv; kv.x = k0.x; kv.y = k0.y; kv.z = k1.x; kv.w = k1.y; acc = mfma16(as_bf16x8(kv), af[ks], acc); }
            *(f32x4*)(dst + 16 * dt) = acc; } }
    __syncthreads();
}
__device__ __forceinline__ void phase_scan(KPC p, int l, int tid, int bid, int G) {
    const float* __restrict__ RS = (const float*)(p->ws + WS_RS); bf16* __restrict__ ST = (bf16*)(p->ws + WS_ST);
    for (int idx = bid * 512 + tid; idx < NB * 4 * 2 * 8192; idx += G * 512) {
        const int ed = idx & 8191, dir = (idx >> 13) & 1, bh = idx >> 14, e = ed >> 6, d = ed & 63, h = bh & 3;
        const float* P = RS + (size_t)((bh * 2 + dir) * NCH) * 8192 + ed;
        bf16* S = ST + ((size_t)bh * NCH * 128 + e) * 128 + dir * 64 + d;
        const float lg = ((const float*)(p->ws + WS_LG))[l * 8 + dir * 4 + h]; const float dec = ex2(128.f * lg);
        float u[NCH];
#pragma unroll
        for (int n = 0; n < NCH; ++n) u[n] = P[(size_t)n * 8192];
        if (dir == 0) {
            S[32 * 16384] = 0; S[33 * 16384] = (bf16)(pk2(u[32], 0.f) & 0xffffu);
            float s = dec * u[32] + u[33];
#pragma unroll
            for (int n = 0; n < 32; ++n) { S[(size_t)n * 16384] = (bf16)(pk2(s, 0.f) & 0xffffu); s = dec * s + u[n]; }
        } else {
            S[33 * 16384] = 0; S[32 * 16384] = (bf16)(pk2(u[33], 0.f) & 0xffffu);
            float s = dec * u[33] + u[32];
#pragma unroll
            for (int n = 31; n >= 0; --n) { S[(size_t)n * 16384] = (bf16)(pk2(s, 0.f) & 0xffffu); s = dec * s + u[n]; }
        }
    }
}
__device__ __forceinline__ void ret_out_item(KPC p, int l, LAS unsigned char* lds, int item, int tid, int lane, int wave) {
    const bf16* ZA = (const bf16*)(p->ws + WS_ZA); bf16* BR = (bf16*)p->out; const bf16* ST = (const bf16*)(p->ws + WS_ST);
    const int b = item / (NCH * 4), rem = item % (NCH * 4), n = rem >> 2, h = rem & 3, c = lane & 15, g4 = lane >> 4;
    const bool latent = n < 32; const int r0 = latent ? b * T + 128 * n : ML + b * CL + 128 * (n - 32);
    const float lgf = ((const float*)(p->ws + WS_LG))[l * 8 + h], lgb = ((const float*)(p->ws + WS_LG))[l * 8 + 4 + h];
    LAS unsigned char* vT = lds; LAS unsigned char* Kl = lds + 34816; LAS unsigned char* Sl = lds + 34816 + 18432;
    {   float a[8], bb[8]; ret_load_k(p, ZA, r0, h, latent, 128 * n, tid, a, bb);
        const int j = tid >> 2, q4 = tid & 3;
        *(LAS u32x4*)(Kl + j * 144 + 16 * q4) = pack8(a); *(LAS u32x4*)(Kl + j * 144 + 64 + 16 * q4) = pack8(bb);
        ret_stage_vT(ZA, r0, h, vT, tid);
        const u32x4* ssrc = (const u32x4*)(ST + (size_t)((b * 4 + h) * NCH + n) * 16384);
#pragma unroll
        for (int k = 0; k < 4; ++k) { const int q = tid + 512 * k; *(LAS u32x4*)(Sl + (q >> 4) * 272 + (q & 15) * 16) = ssrc[q]; }
    }
    __syncthreads();
    const int ii = 16 * wave + c;
    bf16x8 qf[2];
    {   const bf16* src = ZA + (size_t)(r0 + ii) * NZA + C_RQ + 64 * h + 8 * g4; float a[8], bb[8]; unpack8(*(const u32x4*)src, a); unpack8(*(const u32x4*)(src + 32), bb);
        if (latent) { const float* rc = (const float*)(p->ws + WS_ROPEC); const float* rsn = (const float*)(p->ws + WS_ROPES); const int pos = 128 * n + ii; float cs8[8], sn8[8]; ld8f(rc + pos * 32 + 8 * g4, cs8); ld8f(rsn + pos * 32 + 8 * g4, sn8);
#pragma unroll
            for (int e = 0; e < 8; ++e) { const float cs = cs8[e], sn = sn8[e]; const float x1 = a[e], x2 = bb[e]; a[e] = x1 * cs - x2 * sn; bb[e] = x1 * sn + x2 * cs; } }
        qf[0] = as_bf16x8(pack8(a)); qf[1] = as_bf16x8(pack8(bb)); }
    bf16x8 pf[4];
#pragma unroll
    for (int kk = 0; kk < 4; ++kk) {
        f32x4 sa = (f32x4){0.f, 0.f, 0.f, 0.f}, sb = (f32x4){0.f, 0.f, 0.f, 0.f};
        sa = mfma16(*(const LAS bf16x8*)(Kl + (32 * kk + c) * 144 + g4 * 16), qf[0], sa); sa = mfma16(*(const LAS bf16x8*)(Kl + (32 * kk + c) * 144 + 64 + g4 * 16), qf[1], sa);
        sb = mfma16(*(const LAS bf16x8*)(Kl + (32 * kk + 16 + c) * 144 + g4 * 16), qf[0], sb); sb = mfma16(*(const LAS bf16x8*)(Kl + (32 * kk + 16 + c) * 144 + 64 + g4 * 16), qf[1], sb);
        float pa[4], pb[4];
#pragma unroll
        for (int rr = 0; rr < 4; ++rr) { const int ja = 32 * kk + 4 * g4 + rr, jb = ja + 16; const int da = ii - ja, db = ii - jb;
            pa[rr] = sa[rr] * ((da >= 0) ? ex2((float)da * lgf) : ex2((float)(-da) * lgb)); pb[rr] = sb[rr] * ((db >= 0) ? ex2((float)db * lgf) : ex2((float)(-db) * lgb)); }
        u32x4 w; w.x = pk2(pa[0], pa[1]); w.y = pk2(pa[2], pa[3]); w.z = pk2(pb[0], pb[1]); w.w = pk2(pb[2], pb[3]); pf[kk] = as_bf16x8(w);
    }
    const float cf = ex2((float)(ii + 1) * lgf), cb = ex2((float)(128 - ii) * lgb);
    f32x4 O[8]; float s = 0.f, ss = 0.f;
#pragma unroll
    for (int et = 0; et < 8; ++et) {
        f32x4 acc = (f32x4){0.f, 0.f, 0.f, 0.f}, xf = (f32x4){0.f, 0.f, 0.f, 0.f}, xb = (f32x4){0.f, 0.f, 0.f, 0.f};
#pragma unroll
        for (int kk = 0; kk < 4; ++kk) { const u32x2 v0 = *(const LAS u32x2*)(vT + (16 * et + c) * 272 + (32 * kk + 4 * g4) * 2), v1 = *(const LAS u32x2*)(vT + (16 * et + c) * 272 + (32 * kk + 16 + 4 * g4) * 2);
            u32x4 vv; vv.x = v0.x; vv.y = v0.y; vv.z = v1.x; vv.w = v1.y; acc = mfma16(as_bf16x8(vv), pf[kk], acc); }
#pragma unroll
        for (int ks = 0; ks < 2; ++ks) { xf = mfma16(*(const LAS bf16x8*)(Sl + (16 * et + c) * 272 + (32 * ks + 8 * g4) * 2), qf[ks], xf);
            xb = mfma16(*(const LAS bf16x8*)(Sl + (16 * et + c) * 272 + (64 + 32 * ks + 8 * g4) * 2), qf[ks], xb); }
        acc = acc + xf * cf + xb * cb; O[et] = acc;
        s += (acc[0] + acc[1]) + (acc[2] + acc[3]); ss += (acc[0] * acc[0] + acc[1] * acc[1]) + (acc[2] * acc[2] + acc[3] * acc[3]);
    }
    s = sum_x16_x32(s); ss = sum_x16_x32(ss);
    const float mean = s * (1.f / 128.f), var = fmaxf(ss * (1.f / 128.f) - mean * mean, 0.f), rstd = rsq_(var + EPS);
    const bf16* gsrc = ZA + (size_t)(r0 + ii) * NZA + C_RG + 128 * h + 4 * g4; bf16* dst = BR + (size_t)(r0 + ii) * 512 + 128 * h + 4 * g4;
#pragma unroll
    for (int et = 0; et < 8; ++et) { const u32x2 gw = *(const u32x2*)(gsrc + 16 * et); const float g0 = bflo(gw.x), g1 = bfhi(gw.x), g2 = bflo(gw.y), g3 = bfhi(gw.y);
        const float o0 = (O[et][0] - mean) * rstd * g0 * sigmoidf_(g0), o1 = (O[et][1] - mean) * rstd * g1 * sigmoidf_(g1), o2 = (O[et][2] - mean) * rstd * g2 * sigmoidf_(g2), o3 = (O[et][3] - mean) * rstd * g3 * sigmoidf_(g3);
        u32x2 w; w.x = pk2(o0, o1); w.y = pk2(o2, o3); *(u32x2*)(dst + 16 * et) = w; }
    __syncthreads();
}
__device__ __forceinline__ void ret_out_block(KPC p, int l, LAS unsigned char* lds, int first, int stride, int total, int nch, int tid, int lane, int wave) {
    const bf16* ZA = (const bf16*)(p->ws + WS_ZA); bf16* BR = (bf16*)p->out; const bf16* ST = (const bf16*)(p->ws + WS_ST);
    const float* rc = (const float*)(p->ws + WS_ROPEC); const float* rsn = (const float*)(p->ws + WS_ROPES);
    const int c = lane & 15, g4 = lane >> 4, tq = c >> 2, tp = c & 3, j = tid >> 2, q4 = tid & 3;
    LAS unsigned char* Vl = lds; LAS unsigned char* Kl = lds + 34816; LAS unsigned char* Sl = lds + 34816 + 18432;
    u32x4 k0, k1, v[4];
#define RO_DECODE(it_) const int itx_ = ((it_) / (nch * 4)) * (NCH * 4) + (it_) % (nch * 4); const int b = itx_ / (NCH * 4), rem = itx_ % (NCH * 4), n = rem >> 2, h = rem & 3; const bool latent = n < 32; const int r0 = latent ? b * T + 128 * n : ML + b * CL + 128 * (n - 32)
#define RO_LOAD(it_) do { RO_DECODE(it_); (void)latent; const bf16* ks = ZA + (size_t)(r0 + j) * NZA + C_RK + 64 * h + 8 * q4; k0 = *(const u32x4*)ks; k1 = *(const u32x4*)(ks + 32); \
        const bf16* vs = ZA + (size_t)(r0 + j) * NZA + C_RV + 128 * h + 32 * q4; _Pragma("unroll") for (int q = 0; q < 4; ++q) v[q] = *(const u32x4*)(vs + 8 * q); \
        } while (0)
    int it = first;
    if (it < total) RO_LOAD(it);
    for (; it < total; it += stride) {
        RO_DECODE(it);
        const float lgf = ((const float*)(p->ws + WS_LG))[l * 8 + h], lgb = ((const float*)(p->ws + WS_LG))[l * 8 + 4 + h];
        __syncthreads();
        {   u32x4 st[4]; const u32x4* ssrc = (const u32x4*)(ST + (size_t)((b * 4 + h) * NCH + n) * 16384);
#pragma unroll
            for (int k = 0; k < 4; ++k) st[k] = ssrc[tid + 512 * k];
            float a[8], bb[8]; unpack8(k0, a); unpack8(k1, bb);
            if (latent) { const int pos = 128 * n + j; float cs8[8], sn8[8]; ld8f(rc + pos * 32 + 8 * q4, cs8); ld8f(rsn + pos * 32 + 8 * q4, sn8);
#pragma unroll
                for (int e = 0; e < 8; ++e) { const float cs = cs8[e], sn = sn8[e]; const float x1 = a[e], x2 = bb[e]; a[e] = x1 * cs - x2 * sn; bb[e] = x1 * sn + x2 * cs; } }
#pragma unroll
            for (int e = 0; e < 8; ++e) { a[e] *= 0.125f; bb[e] *= 0.125f; }
            *(LAS u32x4*)(Kl + j * 144 + 16 * q4) = pack8(a); *(LAS u32x4*)(Kl + j * 144 + 64 + 16 * q4) = pack8(bb);
#pragma unroll
            for (int q = 0; q < 4; ++q) *(LAS u32x4*)(Vl + j * 272 + (32 * q4 + 8 * q) * 2) = v[q];
#pragma unroll
            for (int k = 0; k < 4; ++k) { const int q = tid + 512 * k; *(LAS u32x4*)(Sl + (q >> 4) * 272 + (q & 15) * 16) = st[k]; }
        }
        __syncthreads();
        const int ii = 16 * wave + c;
        u32x4 qr0, qr1; f32x4 qc0, qc1, qs0, qs1;
        {   const bf16* src = ZA + (size_t)(r0 + ii) * NZA + C_RQ + 64 * h + 8 * g4; qr0 = *(const u32x4*)src; qr1 = *(const u32x4*)(src + 32);
            if (latent) { const int pos = 128 * n + ii; qc0 = *(const f32x4*)(rc + pos * 32 + 8 * g4); qc1 = *(const f32x4*)(rc + pos * 32 + 8 * g4 + 4); qs0 = *(const f32x4*)(rsn + pos * 32 + 8 * g4); qs1 = *(const f32x4*)(rsn + pos * 32 + 8 * g4 + 4); }
        }
        if (it + stride < total) RO_LOAD(it + stride);
        __builtin_amdgcn_sched_barrier(0);
        bf16x8 qf[2];
        {   float a[8], bb[8]; unpack8(qr0, a); unpack8(qr1, bb);
            if (latent) {
#pragma unroll
                for (int e = 0; e < 8; ++e) { const float cs = (e < 4) ? qc0[e & 3] : qc1[e & 3], sn = (e < 4) ? qs0[e & 3] : qs1[e & 3]; const float x1 = a[e], x2 = bb[e]; a[e] = x1 * cs - x2 * sn; bb[e] = x1 * sn + x2 * cs; } }
            qf[0] = as_bf16x8(pack8(a)); qf[1] = as_bf16x8(pack8(bb)); }
        bf16x8 pf[4];
#pragma unroll
        for (int kk = 0; kk < 4; ++kk) {
            f32x4 sa = (f32x4){0.f, 0.f, 0.f, 0.f}, sb = (f32x4){0.f, 0.f, 0.f, 0.f};
            sa = mfma16(*(const LAS bf16x8*)(Kl + (32 * kk + c) * 144 + g4 * 16), qf[0], sa); sa = mfma16(*(const LAS bf16x8*)(Kl + (32 * kk + c) * 144 + 64 + g4 * 16), qf[1], sa);
            sb = mfma16(*(const LAS bf16x8*)(Kl + (32 * kk + 16 + c) * 144 + g4 * 16), qf[0], sb); sb = mfma16(*(const LAS bf16x8*)(Kl + (32 * kk + 16 + c) * 144 + 64 + g4 * 16), qf[1], sb);
            float pa[4], pb[4];
#pragma unroll
            for (int rr = 0; rr < 4; ++rr) { const int ja = 32 * kk + 4 * g4 + rr, jb = ja + 16; const int da = ii - ja, db = ii - jb;
                const float ea = (da >= 0) ? (float)da * lgf : (float)(-da) * lgb, eb = (db >= 0) ? (float)db * lgf : (float)(-db) * lgb;
                pa[rr] = sa[rr] * ex2(ea); pb[rr] = sb[rr] * ex2(eb); }
            u32x4 w; w.x = pk2(pa[0], pa[1]); w.y = pk2(pa[2], pa[3]); w.z = pk2(pb[0], pb[1]); w.w = pk2(pb[2], pb[3]); pf[kk] = as_bf16x8(w);
        }
        const float cf = ex2((float)(ii + 1) * lgf), cb = ex2((float)(128 - ii) * lgb);
        f32x4 O[8]; float s = 0.f, ss = 0.f;
#pragma unroll
        for (int et = 0; et < 8; ++et) {
            f32x4 acc = (f32x4){0.f, 0.f, 0.f, 0.f}, xf = (f32x4){0.f, 0.f, 0.f, 0.f}, xb = (f32x4){0.f, 0.f, 0.f, 0.f};
#pragma unroll
            for (int kk = 0; kk < 4; ++kk) { const u32x2 v0 = lds_tr16(Vl + (32 * kk + 4 * g4 + tq) * 272 + (16 * et + 4 * tp) * 2), v1 = lds_tr16(Vl + (32 * kk + 16 + 4 * g4 + tq) * 272 + (16 * et + 4 * tp) * 2);
                u32x4 vv; vv.x = v0.x; vv.y = v0.y; vv.z = v1.x; vv.w = v1.y; acc = mfma16(as_bf16x8(vv), pf[kk], acc); }
#pragma unroll
            for (int ks = 0; ks < 2; ++ks) { xf = mfma16(*(const LAS bf16x8*)(Sl + (16 * et + c) * 272 + (32 * ks + 8 * g4) * 2), qf[ks], xf);
                xb = mfma16(*(const LAS bf16x8*)(Sl + (16 * et + c) * 272 + (64 + 32 * ks + 8 * g4) * 2), qf[ks], xb); }
            acc = acc + xf * cf + xb * cb; O[et] = acc;
            s += (acc[0] + acc[1]) + (acc[2] + acc[3]); ss += (acc[0] * acc[0] + acc[1] * acc[1]) + (acc[2] * acc[2] + acc[3] * acc[3]);
        }
        u32x2 gq[8];
        {   const bf16* gsrc = ZA + (size_t)(r0 + ii) * NZA + C_RG + 128 * h + 4 * g4;
#pragma unroll
            for (int et = 0; et < 8; ++et) gq[et] = *(const u32x2*)(gsrc + 16 * et); }
        s = sum_x16_x32(s); ss = sum_x16_x32(ss);
        const float mean = s * (1.f / 128.f), var = fmaxf(ss * (1.f / 128.f) - mean * mean, 0.f), rstd = rsq_(var + EPS);
        bf16* dst = BR + (size_t)(r0 + ii) * 512 + 128 * h + 4 * g4;
#pragma unroll
        for (int et = 0; et < 8; ++et) { const u32x2 gw = gq[et]; const float g0 = bflo(gw.x), g1 = bfhi(gw.x), g2 = bflo(gw.y), g3 = bfhi(gw.y);
            const float o0 = (O[et][0] - mean) * rstd * g0 * sigmoidf_(g0), o1 = (O[et][1] - mean) * rstd * g1 * sigmoidf_(g1), o2 = (O[et][2] - mean) * rstd * g2 * sigmoidf_(g2), o3 = (O[et][3] - mean) * rstd * g3 * sigmoidf_(g3);
            u32x2 w; w.x = pk2(o0, o1); w.y = pk2(o2, o3); *(u32x2*)(dst + 16 * et) = w; }
    }
#undef RO_DECODE
#undef RO_LOAD
    __syncthreads();
}

__device__ __forceinline__ int wr_off(int k) { return k * 64 + (k >> 2) * 16; }
__device__ __forceinline__ void phase_norm2(KPC p, int l, LAS unsigned char* lds, int tid, int lane, int wave, int bid, int G) {
    if (l == 1 || G != 256) { convert_experts(p, l, 0, CVT_ITEMS, bid * 8 + wave, G * 8, lds, lane, wave); __syncthreads(); }
    LAS unsigned char* wrl = lds + 69632;
    for (int i = tid; i < 1024 * 4; i += 512) { const int k = i >> 2, q = i & 3; *(LAS f32x4*)(wrl + wr_off(k) + 16 * q) = *(const f32x4*)(p->w_router + (size_t)l * 16384 + k * 16 + 4 * q); }
    __syncthreads();
    const float* modv = (const float*)(p->ws + WS_MODV) + l * 9 * 6144; const bf16* X = (const bf16*)(p->ws + WS_X); bf16* H = (bf16*)(p->ws + WS_H);
    float* AFF = (float*)(p->ws + WS_AFF); float* AFFC = (float*)(p->ws + WS_AFFC); int* INV = (int*)(p->ws + WS_INV);
    const int rows = (l == 0) ? M : ML, stride = G * 8;
    {
    int r = bid * 8 + wave;
    u32x2 vn[4];
#pragma unroll
    for (int j = 0; j < 4; ++j) vn[j] = (r < rows) ? *(const u32x2*)(X + (size_t)r * 1024 + 4 * lane + 256 * j) : (u32x2){0u, 0u};
    for (; r < rows; r += stride) {
        const int bi = (r < ML) ? (r >> 12) : 8; const float* mv = modv + bi * 6144;
        f32x4 v[4], h[4], g[4], sc[4], sh[4];
#pragma unroll
        for (int j = 0; j < 4; ++j) { v[j] = (f32x4){bflo(vn[j].x), bfhi(vn[j].x), bflo(vn[j].y), bfhi(vn[j].y)}; const int col = 4 * lane + 256 * j; g[j] = *(const f32x4*)(p->norm2_g + l * 1024 + col); sh[j] = *(const f32x4*)(mv + 3 * 1024 + col); sc[j] = *(const f32x4*)(mv + 4 * 1024 + col); }
        const int rn = r + stride;
        if (rn < rows) {
#pragma unroll
            for (int j = 0; j < 4; ++j) vn[j] = *(const u32x2*)(X + (size_t)rn * 1024 + 4 * lane + 256 * j); }
        const float rs = row_rs(v);
#pragma unroll
        for (int j = 0; j < 4; ++j) h[j] = (v[j] * rs) * g[j] * (sc[j] + 1.0f) + sh[j];
        store_h(h, H + (size_t)r * 1024, lane);
        float lg[16];
#pragma unroll
        for (int e = 0; e < 16; ++e) lg[e] = 0.f;
#pragma unroll
        for (int j = 0; j < 4; ++j)
#pragma unroll
            for (int i = 0; i < 4; ++i) { const int k = 4 * lane + 256 * j + i; const float hv = h[j][i]; const LAS f32x4* wp = (const LAS f32x4*)(wrl + wr_off(k));
#pragma unroll
                for (int q = 0; q < 4; ++q) { const f32x4 w = wp[q]; lg[4 * q] += hv * w.x; lg[4 * q + 1] += hv * w.y; lg[4 * q + 2] += hv * w.z; lg[4 * q + 3] += hv * w.w; } }
        float mx = -1e30f;
#pragma unroll
        for (int e = 0; e < 16; ++e) { lg[e] = wave_sum(lg[e]); mx = fmaxf(mx, lg[e]); }
        float sum = 0.f;
#pragma unroll
        for (int e = 0; e < 16; ++e) { lg[e] = ex2((lg[e] - mx) * LOG2E); sum += lg[e]; }
        const float isum = rcp_(sum); float mine = 0.f;
#pragma unroll
        for (int e = 0; e < 16; ++e) mine = (lane == e) ? lg[e] * isum : mine;
        if (lane < 16) { if (r < ML) AFF[((size_t)(bi * 16 + lane) << 12) + (r & 4095)] = mine; else AFFC[((r - ML) >> 8) * 4096 + lane * 256 + ((r - ML) & 255)] = mine;
            INV[(size_t)r * 16 + lane] = -1; }
    }
    }
}

__device__ __forceinline__ int block_sum_i(int v, LAS int* red, int buf, int lane, int wave) {
    v = wave_sum_i(v);
    if (lane == 0) red[buf * 8 + wave] = v;
    __syncthreads();
    int s = 0;
#pragma unroll
    for (int w = 0; w < 8; ++w) s += red[buf * 8 + w];
    return s;
}
__device__ __forceinline__ int block_excl_scan(int v, LAS int* red, int buf, int lane, int wave) {
    int inc = v;
#pragma unroll
    for (int o = 1; o < 64; o <<= 1) { const int t = __builtin_amdgcn_ds_bpermute((lane - o) << 2, inc); if (lane >= o) inc += t; }
    if (lane == 63) red[buf * 8 + wave] = inc;
    __syncthreads();
    int base = 0;
#pragma unroll
    for (int w = 0; w < 8; ++w) { const int x = red[buf * 8 + w]; if (w < wave) base += x; }
    return base + inc - v;
}
template <int KPT>
__device__ __forceinline__ void topk_item(KPC p, const float* aff, int n, int cap, int rowbase, int e, int slotbase, int s_lo, int s_hi, bool writer, LAS unsigned char* lds, int tid, int lane, int wave) {
    const bf16* H = (const bf16*)(p->ws + WS_H); bf16* XS = (bf16*)(p->ws + WS_XS); float* topw = (float*)(p->ws + WS_TOPW); int* INV = (int*)(p->ws + WS_INV);
    LAS int* red = (LAS int*)lds; LAS int* rl = (LAS int*)(lds + 128);
    unsigned key[KPT]; const bool valid = tid * KPT < n;
#pragma unroll
    for (int j = 0; j < KPT; ++j) key[j] = valid ? __float_as_uint(aff[tid * KPT + j]) : 0u;
    unsigned Tsel = 0u;
    for (int bit = 30; bit >= 0; --bit) { const unsigned cand = Tsel | (1u << bit); int cnt = 0;
#pragma unroll
        for (int j = 0; j < KPT; ++j) cnt += (valid && key[j] >= cand) ? 1 : 0;
        if (block_sum_i(cnt, red, bit & 1, lane, wave) >= cap) Tsel = cand; }
    int cgt = 0, ceq = 0;
#pragma unroll
    for (int j = 0; j < KPT; ++j) { cgt += (valid && key[j] > Tsel) ? 1 : 0; ceq += (valid && key[j] == Tsel) ? 1 : 0; }
    const int need = cap - block_sum_i(cgt, red, 1, lane, wave);
    int er = block_excl_scan(ceq, red, 2, lane, wave);
    bool sel[KPT]; int nsel = 0;
#pragma unroll
    for (int j = 0; j < KPT; ++j) { const bool iseq = valid && key[j] == Tsel; sel[j] = valid && (key[j] > Tsel || (iseq && er < need)); er += iseq ? 1 : 0; nsel += sel[j] ? 1 : 0; }
    int slot = block_excl_scan(nsel, red, 3, lane, wave);
#pragma unroll
    for (int j = 0; j < KPT; ++j) if (sel[j]) { const int t = tid * KPT + j; if (slot < cap) { rl[slot] = t; if (writer) { topw[e * ME + slotbase + slot] = __uint_as_float(key[j]); INV[(size_t)(rowbase + t) * 16 + e] = slotbase + slot; } } ++slot; }
    __syncthreads();
    for (int s = s_lo + wave * 4; s < s_hi; s += 32) {
        u32x4 a[4][2];
#pragma unroll
        for (int q = 0; q < 4; ++q) { const int t = rl[s + q]; const u32x4* src = (const u32x4*)(H + (size_t)(rowbase + t) * 1024); a[q][0] = src[lane]; a[q][1] = src[lane + 64]; }
#pragma unroll
        for (int q = 0; q < 4; ++q) { u32x4* dst = (u32x4*)(XS + ((size_t)e * ME + slotbase + s + q) * 1024); dst[lane] = a[q][0]; dst[lane + 64] = a[q][1]; }
    }
    __syncthreads();
}
__device__ __forceinline__ void phase_topk(KPC p, int l, LAS unsigned char* lds, int tid, int lane, int wave, int bid, int G) {
    const float* AFF = (const float*)(p->ws + WS_AFF); const float* AFFC = (const float*)(p->ws + WS_AFFC);
    const int nitem = (l == 0) ? 384 : 256;
    for (int it = bid; it < nitem; it += G) {
        if (it < 256) { const int q = it >> 1, hf = it & 1, b = q >> 4, e = q & 15; topk_item<8>(p, AFF + ((size_t)(b * 16 + e) << 12), 4096, CAPL, b * T, e, b * CAPL, hf * 256, hf * 256 + 256, hf == 0, lds, tid, lane, wave); }
        else { const int q = it - 256, b = q >> 4, e = q & 15; topk_item<1>(p, AFFC + (b * 16 + e) * 256, 256, CAPC, ML + b * CL, e, NB * CAPL + b * CAPC, 0, CAPC, true, lds, tid, lane, wave); }
    }
}

__device__ __forceinline__ void phase_combine(KPC p, int l, LAS unsigned char* lds, int tid, int lane, int wave, int bid, int G) {
    const float* modv = (const float*)(p->ws + WS_MODV); bf16* X = (bf16*)(p->ws + WS_X); bf16* H = (bf16*)(p->ws + WS_H);
    const bf16* Y = (const bf16*)(p->ws + WS_XS); const int* INV = (const int*)(p->ws + WS_INV);
    const int rows = (l == 0) ? M : ML, stride = G * 8;
    int r = bid * 8 + wave;
    int slot_next = (lane < 16 && r < rows) ? INV[(size_t)r * 16 + lane] : -1;
    u32x2 vn[4];
#pragma unroll
    for (int j = 0; j < 4; ++j) vn[j] = (r < rows) ? *(const u32x2*)(X + (size_t)r * 1024 + 4 * lane + 256 * j) : (u32x2){0u, 0u};
    for (; r < rows; r += stride) {
        const int bi = (r < ML) ? (r >> 12) : 8;
        const int myslot = slot_next; const int rn = r + stride;
        slot_next = (lane < 16 && rn < rows) ? INV[(size_t)rn * 16 + lane] : -1;
        f32x4 v[4], acc[4], g2v[4];
        const float* g2 = modv + (l * 9 + bi) * 6144 + 5 * 1024;
#pragma unroll
        for (int j = 0; j < 4; ++j) { v[j] = (f32x4){bflo(vn[j].x), bfhi(vn[j].x), bflo(vn[j].y), bfhi(vn[j].y)}; acc[j] = (f32x4){0.f, 0.f, 0.f, 0.f}; g2v[j] = *(const f32x4*)(g2 + 4 * lane + 256 * j); }
        unsigned mask = (unsigned)(__builtin_amdgcn_ballot_w64(myslot >= 0) & 0xffffull);
        bool first = true;
        while (mask || first) {
          if (mask) {
            const int e0 = __builtin_ctz(mask); mask &= mask - 1u; const int s0 = __builtin_amdgcn_readlane(myslot, e0);
            const bool has1 = mask != 0u; const int e1 = has1 ? __builtin_ctz(mask) : e0; if (has1) mask &= mask - 1u; const int s1 = __builtin_amdgcn_readlane(myslot, e1);
            const bf16* ya = Y + ((size_t)e0 * ME + s0) * 1024; const bf16* yb = Y + ((size_t)e1 * ME + s1) * 1024;
            u32x2 wa[4], wb[4];
#pragma unroll
            for (int j = 0; j < 4; ++j) wa[j] = *(const u32x2*)(ya + 4 * lane + 256 * j);
#pragma unroll
            for (int j = 0; j < 4; ++j) wb[j] = *(const u32x2*)(yb + 4 * lane + 256 * j);
            if (first && rn < rows) {
#pragma unroll
                for (int j = 0; j < 4; ++j) vn[j] = *(const u32x2*)(X + (size_t)rn * 1024 + 4 * lane + 256 * j); }
            first = false;
            const float kb = has1 ? 1.0f : 0.0f;
#pragma unroll
            for (int j = 0; j < 4; ++j) { acc[j] += (f32x4){bflo(wa[j].x), bfhi(wa[j].x), bflo(wa[j].y), bfhi(wa[j].y)}; acc[j] += (f32x4){bflo(wb[j].x), bfhi(wb[j].x), bflo(wb[j].y), bfhi(wb[j].y)} * kb; }
          } else {
            if (rn < rows) {
#pragma unroll
                for (int j = 0; j < 4; ++j) vn[j] = *(const u32x2*)(X + (size_t)rn * 1024 + 4 * lane + 256 * j); }
            first = false;
          }
        }
#pragma unroll
        for (int j = 0; j < 4; ++j) v[j] = v[j] + g2v[j] * acc[j];
        if (l == 0) {
#pragma unroll
            for (int j = 0; j < 4; ++j) { u32x2 w; w.x = pk2(v[j].x, v[j].y); w.y = pk2(v[j].z, v[j].w); *(u32x2*)(X + (size_t)r * 1024 + 4 * lane + 256 * j) = w; }
            const float rs = row_rs(v); f32x4 h[4];
            norm_mod(v, rs, p->norm1_g + 1024, modv + (9 + bi) * 6144, modv + (9 + bi) * 6144 + 1024, h, lane);
            store_h(h, H + (size_t)r * 1024, lane);
        } else {
#pragma unroll
            for (int j = 0; j < 4; ++j) *(f32x4*)(p->out + (size_t)r * 1024 + 4 * lane + 256 * j) = v[j];
        }
    }
    if (l == 0) convert_small(p, 1, lds, lane, wave, bid, G);
}

#define XB_TMO      128
#define XB_XCNT(j)  (256  + 64 * (j))
#define XB_XSUB(j)  (1280 + 64 * (j))
#define XB_XGEN(j)  (2304 + 64 * (j))
#define XB_TOP      3328
#define XB_TOPGEN   3392
#define XCD_BAR_WORDS 3456
#define XB_SPIN_CAP (1u << 18)

__device__ __forceinline__ unsigned xb_ld(unsigned* p)              { return __hip_atomic_load(p, __ATOMIC_RELAXED, __HIP_MEMORY_SCOPE_AGENT); }
__device__ __forceinline__ unsigned xb_add(unsigned* p, unsigned v) { return __hip_atomic_fetch_add(p, v, __ATOMIC_RELAXED, __HIP_MEMORY_SCOPE_AGENT); }
__device__ __forceinline__ unsigned xb_xcc_id() { return (unsigned)__builtin_amdgcn_s_getreg((3 << 11) | 20) & 0xFu; }
#define XB_SPIN(cond, bar) do { unsigned _sp = 0; while (cond) { __builtin_amdgcn_s_sleep(1); \
    if ((++_sp & 255u) == 0u) { if (xb_ld(&(bar)[XB_TMO])) break; if (_sp > XB_SPIN_CAP) { atomicAdd(&(bar)[XB_TMO], 1u); break; } } } } while (0)

struct XcdBarrier {
    unsigned* bar; unsigned x;
    volatile LAS unsigned* st;
};

__device__ __forceinline__ XcdBarrier xcd_barrier_post(unsigned* bar, volatile LAS unsigned* st) {
    XcdBarrier b; b.bar = bar; b.x = xb_xcc_id(); b.st = st;
    if (threadIdx.x == 0) (void)xb_add(&bar[XB_XCNT(b.x)], 1u);
    return b;
}
__device__ __forceinline__ void xcd_barrier_complete(unsigned* bar, unsigned x, unsigned& nloc, unsigned& nx) {
    const unsigned G = gridDim.x * gridDim.y * gridDim.z;
    unsigned sum, cnt, mine, sp = 0u;
    for (;;) {
        sum = 0u; cnt = 0u; mine = 0u;
#pragma unroll
        for (unsigned j = 0; j < 16; ++j) { const unsigned c = xb_ld(&bar[XB_XCNT(j)]); sum += c; cnt += (c > 0u) ? 1u : 0u; mine = (j == x) ? c : mine; }
        if (sum == G) break;
        __builtin_amdgcn_s_sleep(1);
        if ((++sp & 255u) == 0u) { if (xb_ld(&bar[XB_TMO])) break; if (sp > XB_SPIN_CAP) { atomicAdd(&bar[XB_TMO], 1u); break; } }
    }
    nloc = mine > 0u ? mine : 1u; nx = cnt > 0u ? cnt : 1u;
}

__device__ __forceinline__ void xcd_barrier(const XcdBarrier& b) {
    asm volatile("s_waitcnt vmcnt(0)" ::: "memory");
    __syncthreads();
    if (threadIdx.x == 0) {
        unsigned* bar = b.bar;
        __builtin_amdgcn_s_waitcnt(0);
        unsigned nloc = b.st[0], nx = b.st[1];
        if (nloc == 0u) { xcd_barrier_complete(bar, b.x, nloc, nx); b.st[0] = nloc; b.st[1] = nx; }
        const unsigned old = xb_add(&bar[XB_XSUB(b.x)], 1u);
        const unsigned gen = old / nloc;
        if (old + 1u == (gen + 1u) * nloc) {
            __builtin_amdgcn_fence(__ATOMIC_RELEASE, "agent");
            asm volatile("s_waitcnt vmcnt(0)" ::: "memory");
            const unsigned og = xb_add(&bar[XB_TOP], 1u);
            const unsigned tg = og / nx;
            if (og + 1u == (tg + 1u) * nx) xb_add(&bar[XB_TOPGEN], 1u);
            else XB_SPIN(xb_ld(&bar[XB_TOPGEN]) == tg, bar);
            __builtin_amdgcn_fence(__ATOMIC_ACQUIRE, "agent");
            xb_add(&bar[XB_XGEN(b.x)], 1u);
            asm volatile("s_waitcnt vmcnt(0)" ::: "memory");
        } else {
            XB_SPIN(xb_ld(&bar[XB_XGEN(b.x)]) == gen, bar);
            __builtin_amdgcn_fence(__ATOMIC_ACQUIRE, "agent");
            asm volatile("s_waitcnt vmcnt(0)" ::: "memory");
        }
    }
    __syncthreads();
}

#define KPP() ({ KPC q_ = kp_; asm volatile("" : "+s"(q_)); q_; })
__global__ void __launch_bounds__(512, 2) mk_fwd(KP p_unused) {
    extern __shared__ __attribute__((aligned(16))) unsigned char lds_raw[];
    LAS unsigned char* lds = (LAS unsigned char*)lds_raw;
    cg::grid_group grid = cg::this_grid();
    const int bid = blockIdx.x, G = gridDim.x;
#define IDS() int tid = threadIdx.x; asm volatile("" : "+v"(tid)); const int lane = tid & 63, wave = __builtin_amdgcn_readfirstlane(tid >> 6); (void)lane; (void)wave
    const KPC kp_ = (KPC)__builtin_amdgcn_kernarg_segment_ptr();
    volatile LAS unsigned* bst = (volatile LAS unsigned*)(lds + 147392);
    if (threadIdx.x < 16) bst[threadIdx.x] = 0u;
    __syncthreads();
    (void)xcd_barrier_post((unsigned*)KPP()->ws, bst);
#define GSYNC() do { XcdBarrier b_; b_.bar = (unsigned*)KPP()->ws; b_.x = xb_xcc_id(); b_.st = bst; xcd_barrier(b_); } while (0)

    { IDS(); phase_prep(KPP(), lds, tid, lane, wave, bid, G); }
    if (G == 0x7fffffff) grid.sync();
    GSYNC();
    { IDS(); phase_norm_in(KPP(), lane, wave, bid, G); }
    GSYNC();
#pragma unroll 1
    for (int l = 0; l < 2; ++l) {
        {
            unsigned char* ws = KPP()->ws;
            pg8::Gemm g{(const pg8::bf16_t*)(ws + WS_H), (const pg8::bf16_t*)(ws + WS_WTIN), M, NZA, 1024}; GroupOrder S{1, M / 256, NZA / 256, 0, 0, G, bid};
            EpiZA E{(bf16*)(ws + WS_ZA)};
            pg8::gemm_phase<EpiZA, GroupOrder, true, true>(lds, g, S, E);
        }
        GSYNC();
        {
            KPC p = KPP(); IDS();
            float mq = fabsf(p->qn_g[l * 64 + lane]), mk = fabsf(p->kn_g[l * 64 + lane]);
            mq = wave_max(mq); mk = wave_max(mk);
            const float Mb2 = 8.0f * mq * mk * LOG2E;
            const int natt = (l == 0) ? 544 : 512, nupd = NB * NCH * 4, nvp = (l == 0) ? (M / 128) : (ML / 128);
            for (int it = bid; it < natt; it += G) att_item(p, l, lds, it, Mb2, tid, lane, wave);
            ret_upd_block(p, l, lds, (bid + G - (natt % G)) % G, G, nupd, tid, lane, wave);
            for (int it = bid; it < nvp; it += G) { sgu_vprep_item(p, it, tid); }
        }
        GSYNC();
        { IDS(); phase_scan(KPP(), l, tid, bid, G); }
        GSYNC();
        {   KPC p = KPP(); IDS(); const int nch = (l == 0) ? NCH : 32;
            const int nro = NB * nch * 4, nsgu = ((l == 0) ? (M / 128) : (ML / 128)) * 4;
            ret_out_block(p, l, lds, bid, G, nro, nch, tid, lane, wave);
            if ((G & 3) == 0) sgu_block(p, l, lds, nsgu >> 2, tid, lane, wave, bid, G);
            else for (int it = bid; it < nsgu; it += G) sgu_item(p, l, lds, it, tid, lane, wave);
        }
        GSYNC();
        const int Mrows = (l == 0) ? M : ML;
        {
            unsigned char* ws = KPP()->ws;
            pg8::Gemm g{(const pg8::bf16_t*)(ws + WS_H), (const pg8::bf16_t*)(ws + WS_WTIN) + (size_t)NZA * 1024, Mrows, NZG, 1024}; GroupOrder S{1, Mrows / 256, NZG / 256, 0, 0, G, bid};
            EpiSig E{(bf16*)(ws + WS_G)};
            pg8::gemm_phase<EpiSig, GroupOrder, true, true>(lds, g, S, E);
            if (l == 0 && G == 256 && bid >= CVT_G_IDLE0) { IDS(); convert_experts(KPP(), 0, 0, CVT_G_HI, (bid - CVT_G_IDLE0) * 8 + wave, (256 - CVT_G_IDLE0) * 8, lds, lane, wave); }
        }
        GSYNC();
        {
            KPC p = KPP(); unsigned char* ws = p->ws;
            pg8::Gemm g{(const pg8::bf16_t*)p->out, (const pg8::bf16_t*)(ws + WS_WTBR), 3 * M, 3072, 512}; MergeOrder S{Mrows / 256, G, bid};
            EpiMergeChain E{(const bf16*)(ws + WS_G), (bf16*)(ws + WS_H)};
            pg8::gemm_phase<EpiMergeChain, MergeOrder, true, true>(lds, g, S, E);
            if (l == 0 && G == 256 && bid >= CVT_M_IDLE0) { IDS(); convert_experts(KPP(), 0, CVT_G_HI, CVT_M_HI, (bid - CVT_M_IDLE0) * 8 + wave, (256 - CVT_M_IDLE0) * 8, lds, lane, wave); }
        }
        GSYNC();
        {
            KPC p = KPP(); unsigned char* ws = p->ws;
            pg8::Gemm g{(const pg8::bf16_t*)(ws + WS_H), (const pg8::bf16_t*)(ws + WS_WTOUT), Mrows, 1024, 1024}; GroupOrder S{1, Mrows / 256, 4, 0, 0, G, bid};
            EpiOut E{p->x, p->ctx, (bf16*)(ws + WS_X), (const float*)(ws + WS_MODV) + l * 9 * 6144, (l == 0) ? 1 : 0};
            pg8::gemm_phase<EpiOut, GroupOrder, true, true>(lds, g, S, E);
            if (l == 0 && G == 256 && bid >= CVT_O_IDLE0) { IDS(); convert_experts(KPP(), 0, CVT_M_HI, CVT_ITEMS, (bid - CVT_O_IDLE0) * 8 + wave, (256 - CVT_O_IDLE0) * 8, lds, lane, wave); }
        }
        GSYNC();
        { IDS(); phase_norm2(KPP(), l, lds, tid, lane, wave, bid, G); }
        GSYNC();
        { IDS(); phase_topk(KPP(), l, lds, tid, lane, wave, bid, G); }
        GSYNC();
        {
            unsigned char* ws = KPP()->ws;
            pg8::Gemm g{(const pg8::bf16_t*)(ws + WS_XS), (const pg8::bf16_t*)(ws + WS_WT1), NE * ME, NE * 2048, 1024}; GroupOrder S{NE, (l == 0) ? 17 : 16, 8, 17, 8, G, bid};
            EpiMoe1 E{(bf16*)(ws + WS_ACT)};
            pg8::gemm_phase<EpiMoe1, GroupOrder, true, true>(lds, g, S, E);
        }
        GSYNC();
        {
            unsigned char* ws = KPP()->ws;
            pg8::Gemm g{(const pg8::bf16_t*)(ws + WS_ACT), (const pg8::bf16_t*)(ws + WS_WT2), NE * ME, NE * 1024, 1024}; GroupOrder S{NE, (l == 0) ? 17 : 16, 4, 17, 4, G, bid};
            EpiMoe2 E{(bf16*)(ws + WS_XS), (const float*)(ws + WS_TOPW)};
            pg8::gemm_phase<EpiMoe2, GroupOrder, true, true>(lds, g, S, E);
        }
        GSYNC();
        { IDS(); phase_combine(KPP(), l, lds, tid, lane, wave, bid, G); }
        if (l == 0) GSYNC();
    }
}

extern "C" void kernel_launch(void* const* d_in, const int* in_sizes, int n_in, void* d_out, int out_size, void* d_ws, size_t ws_size, hipStream_t stream) {
    static int grid = 0;
    if (grid == 0) {
        if (n_in != 22 || out_size != ML * D || ws_size < WS_END) { fprintf(stderr, "kernel_launch: unexpected shapes (n_in %d out %d ws %zu, need %zu)\n", n_in, out_size, ws_size, (size_t)WS_END); grid = -1; return; }
        int dev = 0, cus = 0, per_cu = 0;
        if (hipGetDevice(&dev) != hipSuccess || hipDeviceGetAttribute(&cus, hipDeviceAttributeMultiprocessorCount, dev) != hipSuccess) { grid = -1; return; }
        if (hipFuncSetAttribute((const void*)mk_fwd, hipFuncAttributeMaxDynamicSharedMemorySize, LDS_BYTES) != hipSuccess) { fprintf(stderr, "kernel_launch: hipFuncSetAttribute failed\n"); grid = -1; return; }
        if (hipOccupancyMaxActiveBlocksPerMultiprocessor(&per_cu, (const void*)mk_fwd, 512, LDS_BYTES) != hipSuccess || per_cu < 1) { fprintf(stderr, "kernel_launch: occupancy query says %d\n", per_cu); (void)hipGetLastError(); }
        grid = cus;
        fprintf(stderr, "kernel_launch: grid %d, occupancy %d/CU, ws %zu\n", grid, per_cu, ws_size);
    }
    if (grid < 0) return;
    if (hipMemsetAsync(d_ws, 0, 16384, stream) != hipSuccess) { fprintf(stderr, "kernel_launch: memset failed\n"); return; }
    KP hp{};
    const float** f = (const float**)&hp;
    for (int i = 0; i < 22; ++i) f[i] = (const float*)d_in[i];
    hp.out = (float*)d_out; hp.ws = (unsigned char*)d_ws;
    void* args[] = {&hp};
    hipError_t e = hipLaunchCooperativeKernel((const void*)mk_fwd, dim3(grid), dim3(512), args, LDS_BYTES, stream);
    if (e != hipSuccess) fprintf(stderr, "kernel_launch: cooperative launch failed: %s\n", hipGetErrorString(e));
}
```

```cpp
#include <hip/hip_runtime.h>
#include <hip/hip_cooperative_groups.h>
#include <cstdio>
#include <cstdint>
namespace cg = cooperative_groups;
namespace pg8 {
#define PG8_LAS __attribute__((address_space(3)))
typedef unsigned short bf16_t;
typedef short bf16x8 __attribute__((ext_vector_type(8)));
typedef float f32x4 __attribute__((ext_vector_type(4)));
typedef unsigned u32x4 __attribute__((ext_vector_type(4)));
constexpr int BM = 256, BK = 64, HALF = 128, HTB = HALF * BK * 2  , STAGE_BYTES = 8 * HTB, NXCD = 8, WGM = 8;

__host__ __device__ __forceinline__ int lds_byte(int r, int c) { const int st = (r >> 4) * 2 + (c >> 5), rr = r & 15, cc = c & 31, ob = rr * 64 + cc * 2; return st * 1024 + (ob ^ (((ob >> 9) & 1) << 5)); }
__host__ __device__ __forceinline__ void stage_rc(int b, int& R, int& C) { const int st = b / 1024, sb = b % 1024, swz = sb ^ (((sb >> 9) & 1) << 5); R = (st >> 1) * 16 + swz / 64; C = (st & 1) * 32 + (swz % 64) / 2; }
__host__ __device__ __forceinline__ int perm32(int rho) { const int n = rho >> 4, i = rho & 15; return 8 * (i >> 2) + 4 * n + (i & 3); }

struct Unit { int pm, pn; };
struct Gemm { const bf16_t* A; const bf16_t* Bt; int M, N, K; const int* rowoff = nullptr; };

struct StaticOrder {
    int nM, nN, nwg, G, c;
    __host__ __device__ void init(int M, int N, int G_, int c_) { nM = M / BM; nN = N / BM; nwg = nM * nN; G = G_; c = c_; }
    __host__ __device__ bool next(int i, Unit& u) const {
        const long L = (long)i * G + c; if (L >= nwg) return false;
        int wgid = (int)L; { const int q = nwg / NXCD, r = nwg % NXCD, xcd = wgid % NXCD, off = wgid / NXCD; wgid = (xcd < r ? xcd * (q + 1) : r * (q + 1) + (xcd - r) * q) + off; }
        const int nig = WGM * nN, gid = wgid / nig, fm = gid * WGM, gsz = (nM - fm) < WGM ? (nM - fm) : WGM;
        u.pm = fm + ((wgid % nig) % gsz); u.pn = (wgid % nig) / gsz; return true;
    }
    __device__ __forceinline__ void a_ready(const Unit&) const {}
    __device__ __forceinline__ void done(const Unit&) const {}
};

__device__ __forceinline__ unsigned cvt_pk_bf16(float lo, float hi) { unsigned r; asm volatile("v_cvt_pk_bf16_f32 %0, %1, %2" : "=v"(r) : "v"(lo), "v"(hi)); return r; }
typedef float f32x2 __attribute__((ext_vector_type(2)));
__device__ __forceinline__ f32x2 gelu_pk(f32x2 v) {
    const f32x2 av = __builtin_elementwise_abs(v), d = av * 0.2316418882f + 1.0f;
    f32x2 t; t.x = __builtin_amdgcn_rcpf(d.x); t.y = __builtin_amdgcn_rcpf(d.y);
    f32x2 q = t * 0.5307027145f + (-0.7265760135f); q = q * t + 0.7107068705f; q = q * t + (-0.142248368f); q = q * t + 0.127414796f; q = q * t;
    const f32x2 s = (v * v) * (-0.72134752044f);
    f32x2 e; e.x = __builtin_amdgcn_exp2f(s.x); e.y = __builtin_amdgcn_exp2f(s.y);
    const f32x2 m = v * (q * e), r = v - m;
    f32x2 o; o.x = v.x < 0.f ? m.x : r.x; o.y = v.y < 0.f ? m.y : r.y; return o;
}

template <int ACT  > struct EpiBf16 {
    static constexpr bool PERM = true, AFTER_DRAIN = false, CHAIN = false; static_assert(ACT == 0 || ACT == 1, "EpiBf16: ACT is 0 (none) or 1 (gelu_pk)");
    bf16_t* O; int ldc; const float* bias; int split_cols; size_t split_stride; float scale0;
    __device__ __forceinline__ void operator()(const f32x4 (&acc)[2][2][4][2], const Unit& u, int wr, int wc, int fr, int fq) const {
        const int row0 = u.pm * BM + wr * 64 + fr; int colt = u.pn * BM; bf16_t* base = O;
        float sc = 1.f; if (split_cols) { const int t = colt / split_cols; base += (size_t)t * split_stride; colt -= t * split_cols; if (t == 0) sc = scale0; }
        const int col0 = colt + wc * 32 + 8 * fq, bcol0 = u.pn * BM + wc * 32 + 8 * fq;
        f32x4 bv[2][2];
#pragma unroll
        for (int bj = 0; bj < 2; ++bj)
#pragma unroll
            for (int n = 0; n < 2; ++n) bv[bj][n] = bias ? *(const f32x4*)(bias + bcol0 + bj * HALF + 4 * n) : (f32x4){0.f, 0.f, 0.f, 0.f};
#pragma unroll
        for (int ai = 0; ai < 2; ++ai)
#pragma unroll
            for (int m = 0; m < 4; ++m) { bf16_t* rowp = base + (size_t)(row0 + ai * HALF + m * 16) * ldc + col0;
#pragma unroll
                for (int bj = 0; bj < 2; ++bj) { f32x4 v0 = acc[ai][bj][m][0] + bv[bj][0], v1 = acc[ai][bj][m][1] + bv[bj][1];
                    if (ACT == 1) { f32x2 a = gelu_pk((f32x2){v0[0], v0[1]}), b = gelu_pk((f32x2){v0[2], v0[3]}), c = gelu_pk((f32x2){v1[0], v1[1]}), d = gelu_pk((f32x2){v1[2], v1[3]});
                        v0 = (f32x4){a.x, a.y, b.x, b.y}; v1 = (f32x4){c.x, c.y, d.x, d.y}; }
                    v0 = v0 * sc; v1 = v1 * sc; u32x4 w; w.x = cvt_pk_bf16(v0[0], v0[1]); w.y = cvt_pk_bf16(v0[2], v0[3]); w.z = cvt_pk_bf16(v1[0], v1[1]); w.w = cvt_pk_bf16(v1[2], v1[3]);
                    *(u32x4*)(rowp + bj * HALF) = w; } }
    }
};
template <class Epi, class Sched, bool ALIGN_EPI = false, bool SP2 = false, bool GATHER = false>
__device__ __forceinline__ void gemm_phase(PG8_LAS unsigned char* lds, const Gemm g, const Sched& S, const Epi& E, int tid_in) {
    int tid_ = tid_in; asm volatile("" : "+v"(tid_));
    const int tid = tid_, wid = __builtin_amdgcn_readfirstlane(tid >> 6), lane = tid & 63, wr = wid >> 2, wc = wid & 3, fr = lane & 15, fq = lane >> 4;
    const int K = g.K, nt = K / BK;
    unsigned voffA[2], voffB[2];
#pragma unroll
    for (int i = 0; i < 2; ++i) { int R, C; stage_rc(tid * 16 + i * 8192, R, C); const int Rb = Epi::PERM ? ((R & ~31) + perm32(R & 31)) : R;
        voffA[i] = (unsigned)(R * K + C) * 2u; voffB[i] = (unsigned)(Rb * K + C) * 2u; }
    unsigned gC[2][2] = {{0u, 0u}, {0u, 0u}}; unsigned gsel = 0u, gcoff = 0u; PG8_LAS unsigned char* const gl = lds + 8 * HTB + wid * 256;
    if constexpr (GATHER) { int R0, C0; stage_rc(tid * 16, R0, C0); gcoff = (unsigned)C0 * 2u; gsel = (unsigned)(128 * (lane >> 5) + 16 * ((wid >> 1) + 4 * ((lane >> 4) & 1)) + (lane & 15)); }
    const size_t kstep = (size_t)(BK * 2);
    const size_t hstep = (size_t)HALF * K * 2;
    const size_t tstep = 2 * hstep;
    const unsigned ldsw = (unsigned)wid * 1024u;
    const int aoff = lds_byte(wr * 64 + fr, fq * 8), boff = lds_byte(wc * 32 + fr, fq * 8);
#define PG8_SA(b, h) (((b) * 2 + (h)) * HTB)
#define PG8_SB(b, h) ((4 + (b) * 2 + (h)) * HTB)
#define PG8_STAGE(bufoff, gbase, voff) do { _Pragma("unroll") for (int _i = 0; _i < 2; ++_i) \
        __builtin_amdgcn_global_load_lds((const unsigned*)((const char*)(gbase) + (voff)[_i]), (PG8_LAS unsigned*)(lds + (bufoff) + ldsw + _i * 8192), 16, 0, 0); } while (0)
#define PG8_STAGE_A(bufoff, gbase, h) do { if constexpr (GATHER) PG8_STAGE(bufoff, gbase, gC[h]); else PG8_STAGE(bufoff, (gbase) + (h) * hstep, voffA); } while (0)
#define PG8_LDA(dst, b, h) do { _Pragma("unroll") for (int m = 0; m < 4; ++m) _Pragma("unroll") for (int k = 0; k < 2; ++k) dst[m][k] = *(const PG8_LAS bf16x8*)(lds + PG8_SA(b, h) + aoff + m * 2048 + k * 1024); } while (0)
#define PG8_LDB(dst, b, h) do { _Pragma("unroll") for (int n = 0; n < 2; ++n) _Pragma("unroll") for (int k = 0; k < 2; ++k) dst[n][k] = *(const PG8_LAS bf16x8*)(lds + PG8_SB(b, h) + boff + n * 2048 + k * 1024); } while (0)
#define PG8_MMA(ai, bj, At, Bt) do { __builtin_amdgcn_s_setprio(1); _Pragma("unroll") for (int m = 0; m < 4; ++m) _Pragma("unroll") for (int n = 0; n < 2; ++n) _Pragma("unroll") for (int k = 0; k < 2; ++k) \
        acc[ai][bj][m][n] = __builtin_amdgcn_mfma_f32_16x16x32_bf16(Bt[n][k], At[m][k], acc[ai][bj][m][n], 0, 0, 0); __builtin_amdgcn_s_setprio(0); } while (0)
#define PG8_WAIT_V(n) asm volatile("s_waitcnt vmcnt(" #n ")" ::: "memory")
#define PG8_WAIT_L(n) asm volatile("s_waitcnt lgkmcnt(" #n ")" ::: "memory")
#define PG8_BAR __builtin_amdgcn_s_barrier()
#define PG8_SCHED __builtin_amdgcn_sched_barrier(0)
    Unit cur, nxt; int ui = 0;
    if (!S.next(0, cur)) return;
    f32x4 acc[2][2][4][2];
#pragma unroll
    for (int a = 0; a < 2; ++a)
#pragma unroll
        for (int b = 0; b < 2; ++b)
#pragma unroll
            for (int m = 0; m < 4; ++m)
#pragma unroll
                for (int n = 0; n < 2; ++n) acc[a][b][m][n] = (f32x4){0.f, 0.f, 0.f, 0.f};
    bf16x8 At[4][2], B0[2][2], B1[2][2];
    const char* cA = GATHER ? (const char*)g.A : (const char*)g.A + (size_t)cur.pm * tstep; const char* cB = (const char*)g.Bt + (size_t)cur.pn * tstep;
    if constexpr (GATHER) {
#pragma unroll
        for (int h = 0; h < 2; ++h)
#pragma unroll
            for (int i = 0; i < 2; ++i) gC[h][i] = (unsigned)g.rowoff[cur.pm * 256 + 128 * h + 16 * ((wid >> 1) + 4 * i) + (lane >> 2)] + gcoff; }
    if constexpr (GATHER) asm volatile("" : "+v"(gC[0][0]), "+v"(gC[0][1]), "+v"(gC[1][0]), "+v"(gC[1][1]));
    S.a_ready(cur);
    if constexpr (SP2) {
        PG8_STAGE(PG8_SB(0, 0), cB, voffB); PG8_STAGE(PG8_SB(0, 1), cB + hstep, voffB); PG8_STAGE_A(PG8_SA(0, 0), cA, 0); PG8_STAGE_A(PG8_SA(0, 1), cA, 1);
        if (wr == 1) PG8_BAR;
        PG8_WAIT_V(2); PG8_BAR;
        PG8_STAGE(PG8_SB(1, 0), cB + kstep, voffB); PG8_STAGE_A(PG8_SA(1, 0), cA + kstep, 0); PG8_STAGE(PG8_SB(1, 1), cB + hstep + kstep, voffB);
        PG8_WAIT_V(6); PG8_BAR;
    } else {
        PG8_STAGE(PG8_SB(0, 0), cB, voffB); PG8_STAGE(PG8_SA(0, 0), cA, voffA); PG8_STAGE(PG8_SB(0, 1), cB + hstep, voffB); PG8_STAGE(PG8_SA(0, 1), cA + hstep, voffA);
        if (wr == 1) PG8_BAR;
        PG8_WAIT_V(4); PG8_BAR;
        PG8_STAGE(PG8_SB(1, 0), cB + kstep, voffB); PG8_STAGE(PG8_SA(1, 0), cA + kstep, voffA); PG8_STAGE(PG8_SB(1, 1), cB + hstep + kstep, voffB);
        PG8_WAIT_V(6); PG8_BAR;
    }
    for (;;) {
        const bool has_next = S.next(ui + 1, nxt);
        if constexpr (GATHER) { if (has_next) __builtin_amdgcn_global_load_lds((const unsigned*)(g.rowoff + nxt.pm * 256 + gsel), (PG8_LAS unsigned*)gl, 4, 0, 0); }
        const char* nA = (has_next && !GATHER) ? (const char*)g.A + (size_t)nxt.pm * tstep : cA; const char* nB = has_next ? (const char*)g.Bt + (size_t)nxt.pn * tstep : cB;
        for (int t = 0; t < nt; t += 2) {
            const bool last = (t == nt - 2);
            const char* a1 = cA + (size_t)(t + 1) * kstep;
            const char* a2 = last ? nA : cA + (size_t)(t + 2) * kstep; const char* b2 = last ? nB : cB + (size_t)(t + 2) * kstep;
            const char* a3 = a2 + kstep; const char* b3 = b2 + kstep;
            if (last && has_next) S.a_ready(nxt);
            if constexpr (SP2) {
            PG8_LDB(B0, 0, 0); PG8_LDB(B1, 0, 1); PG8_SCHED; PG8_LDA(At, 0, 0); PG8_STAGE_A(PG8_SA(1, 1), a1, 1);
            if constexpr (GATHER) { if (last && has_next) {
#pragma unroll
                for (int h = 0; h < 2; ++h)
#pragma unroll
                    for (int i = 0; i < 2; ++i) gC[h][i] = *(const PG8_LAS unsigned*)(gl + ((2 * h + i) * 16 + (lane >> 2)) * 4) + gcoff; } }
            PG8_WAIT_V(8); PG8_WAIT_L(0); PG8_BAR; PG8_MMA(0, 0, At, B0); PG8_MMA(0, 1, At, B1); PG8_BAR; PG8_SCHED;
            PG8_LDA(At, 0, 1); PG8_STAGE(PG8_SB(0, 0), b2, voffB); PG8_STAGE(PG8_SB(0, 1), b2 + hstep, voffB); PG8_STAGE_A(PG8_SA(0, 0), a2, 0);
            PG8_WAIT_V(8); PG8_WAIT_L(0); PG8_BAR; PG8_MMA(1, 0, At, B0); PG8_MMA(1, 1, At, B1); PG8_BAR; PG8_SCHED;
            PG8_LDB(B0, 1, 0); PG8_LDB(B1, 1, 1); PG8_SCHED; PG8_LDA(At, 1, 0); PG8_STAGE_A(PG8_SA(0, 1), a2, 1);
            PG8_WAIT_V(8); PG8_WAIT_L(0); PG8_BAR; PG8_MMA(0, 0, At, B0); PG8_MMA(0, 1, At, B1); PG8_BAR; PG8_SCHED;
            PG8_LDA(At, 1, 1); PG8_STAGE(PG8_SB(1, 0), b3, voffB); PG8_STAGE(PG8_SB(1, 1), b3 + hstep, voffB); PG8_STAGE_A(PG8_SA(1, 0), a3, 0);
            PG8_WAIT_V(8); PG8_WAIT_L(0); PG8_BAR; PG8_MMA(1, 0, At, B0); PG8_MMA(1, 1, At, B1); PG8_BAR; PG8_SCHED;
            } else {
            PG8_LDB(B0, 0, 0); PG8_SCHED; PG8_LDA(At, 0, 0); PG8_STAGE(PG8_SA(1, 1), a1 + hstep, voffA);
            PG8_WAIT_L(8); PG8_BAR; PG8_WAIT_L(0); PG8_MMA(0, 0, At, B0); PG8_BAR; PG8_SCHED;
            PG8_LDB(B1, 0, 1); PG8_STAGE(PG8_SB(0, 0), b2, voffB);
            PG8_BAR; PG8_WAIT_L(0); PG8_MMA(0, 1, At, B1); PG8_BAR;
            PG8_LDA(At, 0, 1); PG8_STAGE(PG8_SA(0, 0), a2, voffA);
            PG8_BAR; PG8_WAIT_L(0); PG8_MMA(1, 0, At, B0); PG8_BAR; PG8_SCHED;
            PG8_STAGE(PG8_SB(0, 1), b2 + hstep, voffB);
            PG8_WAIT_V(6); PG8_BAR; PG8_MMA(1, 1, At, B1); PG8_BAR;
            PG8_LDB(B0, 1, 0); PG8_SCHED; PG8_LDA(At, 1, 0); PG8_STAGE(PG8_SA(0, 1), a2 + hstep, voffA);
            PG8_WAIT_L(8); PG8_BAR; PG8_WAIT_L(0); PG8_MMA(0, 0, At, B0); PG8_BAR; PG8_SCHED;
            PG8_LDB(B1, 1, 1); PG8_STAGE(PG8_SB(1, 0), b3, voffB);
            PG8_BAR; PG8_WAIT_L(0); PG8_MMA(0, 1, At, B1); PG8_BAR;
            PG8_LDA(At, 1, 1); PG8_STAGE(PG8_SA(1, 0), a3, voffA);
            PG8_BAR; PG8_WAIT_L(0); PG8_MMA(1, 0, At, B0); PG8_BAR; PG8_SCHED;
            PG8_STAGE(PG8_SB(1, 1), b3 + hstep, voffB);
            PG8_WAIT_V(6); PG8_BAR; PG8_MMA(1, 1, At, B1); PG8_BAR;
            }
        }
        if constexpr (ALIGN_EPI) { if (wr == 0) PG8_BAR; }
        bool keep_acc = false;
        if constexpr (Epi::CHAIN) { keep_acc = E.chain(acc, cur, wr, wc, fr, fq); S.done(cur); }
        else if constexpr (!Epi::AFTER_DRAIN) { E(acc, cur, wr, wc, fr, fq); S.done(cur); }
        if (!has_next) break;
        if (!keep_acc) {
#pragma unroll
        for (int a = 0; a < 2; ++a)
#pragma unroll
            for (int b = 0; b < 2; ++b)
#pragma unroll
                for (int m = 0; m < 4; ++m)
#pragma unroll
                    for (int n = 0; n < 2; ++n) acc[a][b][m][n] = (f32x4){0.f, 0.f, 0.f, 0.f};
        }
        cur = nxt; cA = nA; cB = nB; ++ui;
        if constexpr (ALIGN_EPI) { if (wr == 1) PG8_BAR; }
    }
    PG8_WAIT_V(0);
    if constexpr (!ALIGN_EPI) { if (wr == 0) PG8_BAR; }
    PG8_BAR;
    if constexpr (Epi::AFTER_DRAIN) { E.fused(acc, cur, wr, wc, fr, fq, lds, wid, lane); S.done(cur); }
#undef PG8_SA
#undef PG8_SB
#undef PG8_STAGE
#undef PG8_STAGE_A
#undef PG8_LDA
#undef PG8_LDB
#undef PG8_MMA
#undef PG8_WAIT_V
#undef PG8_WAIT_L
#undef PG8_BAR
#undef PG8_SCHED
}
}

#define LAS __attribute__((address_space(3)))
typedef unsigned short bf16;
typedef short bf16x8 __attribute__((ext_vector_type(8)));
typedef float f32x4 __attribute__((ext_vector_type(4)));
typedef unsigned u32x4 __attribute__((ext_vector_type(4)));
typedef unsigned u32x2 __attribute__((ext_vector_type(2)));

constexpr int D = 1024, NB = 8, T = 4096, CL = 256;
constexpr int ML = NB * T, MC = NB * CL, M = ML + MC;
constexpr int NZA = 3328, NZG = 3072;
constexpr int C_RQ = 0, C_RK = 256, C_RV = 512, C_RG = 1024, C_SU = 1536, C_SV = 2048, C_AQ = 2560, C_AK = 3072, C_AV = 3200;
constexpr int NE = 16, CAPL = 512, CAPC = 32, ME = NB * (CAPL + CAPC);
constexpr int NCH = 34;
constexpr float EPS = 1e-6f, LOG2E = 1.4426950408889634f;
constexpr int LDS_BYTES = 147456;

constexpr size_t MiB = 1u << 20;
constexpr size_t WS_LG = 15360;
constexpr size_t WS_ROPEC = 1 * MiB, WS_ROPES = 1 * MiB + 512 * 1024, WS_MODV = 2 * MiB, WS_AFF = 3 * MiB, WS_AFFC = 5 * MiB, WS_INV = 6 * MiB, WS_TOPW = 9 * MiB, WS_ROWL = 10 * MiB;
constexpr size_t WS_WTIN = 16 * MiB, WS_WTBR = WS_WTIN + (size_t)6400 * 1024 * 2, WS_WTOUT = WS_WTBR + (size_t)3072 * 512 * 2;
constexpr size_t WS_X = 34 * MiB, WS_H = 170 * MiB, WS_R = 238 * MiB;
constexpr size_t WS_ZA = WS_R, WS_G = WS_R, WS_RS = 459 * MiB, WS_ST = 527 * MiB;
constexpr size_t WS_XS = WS_R, WS_ACT = 374 * MiB, WS_WT1 = 510 * MiB, WS_WT2 = 574 * MiB, WS_END = 606 * MiB;
constexpr size_t WS_WT1B = 102 * MiB, WS_WT2B = 606 * MiB, WS_END2 = 638 * MiB;
static_assert(WS_WTOUT + 2 * MiB <= WS_X && WS_ZA + (size_t)M * NZA * 2 <= WS_RS && WS_ST + (size_t)NB * 4 * NCH * 128 * 128 * 2 <= WS_END, "ws map");

struct KP {
    const float *x, *c, *ctx, *c_ctx, *w_mod, *b_mod, *norm1_g, *norm2_g, *w_in, *dec_f, *dec_b, *sgu_w, *sgu_b, *qn_g, *kn_g, *sink, *w_branch, *w_out, *w_router, *w_eg, *w_eu, *w_ed;
    float* out; unsigned char* ws; int early2;
};
typedef const __attribute__((address_space(4))) KP* KPC;

#define LDS_WAIT() asm volatile("s_waitcnt lgkmcnt(0)" ::: "memory")
__device__ __forceinline__ unsigned pk2(float lo, float hi) { return pg8::cvt_pk_bf16(lo, hi); }
__device__ __forceinline__ float bflo(unsigned w) { return __uint_as_float(w << 16); }
__device__ __forceinline__ float bfhi(unsigned w) { return __uint_as_float(w & 0xffff0000u); }
__device__ __forceinline__ void unpack8(const u32x4 w, float (&f)[8]) { f[0] = bflo(w.x); f[1] = bfhi(w.x); f[2] = bflo(w.y); f[3] = bfhi(w.y); f[4] = bflo(w.z); f[5] = bfhi(w.z); f[6] = bflo(w.w); f[7] = bfhi(w.w); }
__device__ __forceinline__ u32x4 pack8(const float (&f)[8]) { u32x4 o; o.x = pk2(f[0], f[1]); o.y = pk2(f[2], f[3]); o.z = pk2(f[4], f[5]); o.w = pk2(f[6], f[7]); return o; }
template <int CTRL> __device__ __forceinline__ float dpp_f(float v) { return __builtin_bit_cast(float, __builtin_amdgcn_update_dpp(0, __builtin_bit_cast(int, v), CTRL, 0xf, 0xf, false)); }
template <int CTRL> __device__ __forceinline__ int dpp_i(int v) { return __builtin_amdgcn_update_dpp(0, v, CTRL, 0xf, 0xf, false); }
constexpr int DPP_XOR1 = 0xB1  , DPP_XOR2 = 0x4E  , DPP_HMIRROR = 0x141  , DPP_MIRROR = 0x140  ;
__device__ __forceinline__ float sum_x16(float v) { const unsigned u = __builtin_bit_cast(unsigned, v); auto r = __builtin_amdgcn_permlane16_swap(u, u, false, false); return __builtin_bit_cast(float, (unsigned)r[0]) + __builtin_bit_cast(float, (unsigned)r[1]); }
__device__ __forceinline__ float sum_x32(float v) { const unsigned u = __builtin_bit_cast(unsigned, v); auto r = __builtin_amdgcn_permlane32_swap(u, u, false, false); return __builtin_bit_cast(float, (unsigned)r[0]) + __builtin_bit_cast(float, (unsigned)r[1]); }
__device__ __forceinline__ float max_x16(float v) { const unsigned u = __builtin_bit_cast(unsigned, v); auto r = __builtin_amdgcn_permlane16_swap(u, u, false, false); return fmaxf(__builtin_bit_cast(float, (unsigned)r[0]), __builtin_bit_cast(float, (unsigned)r[1])); }
__device__ __forceinline__ float max_x32(float v) { const unsigned u = __builtin_bit_cast(unsigned, v); auto r = __builtin_amdgcn_permlane32_swap(u, u, false, false); return fmaxf(__builtin_bit_cast(float, (unsigned)r[0]), __builtin_bit_cast(float, (unsigned)r[1])); }
__device__ __forceinline__ int sum_x16_i(int v) { auto r = __builtin_amdgcn_permlane16_swap((unsigned)v, (unsigned)v, false, false); return (int)r[0] + (int)r[1]; }
__device__ __forceinline__ int sum_x32_i(int v) { auto r = __builtin_amdgcn_permlane32_swap((unsigned)v, (unsigned)v, false, false); return (int)r[0] + (int)r[1]; }
__device__ __forceinline__ float row_sum(float v) { v += dpp_f<DPP_XOR1>(v); v += dpp_f<DPP_XOR2>(v); v += dpp_f<DPP_HMIRROR>(v); v += dpp_f<DPP_MIRROR>(v); return v; }
__device__ __forceinline__ float row_max(float v) { v = fmaxf(v, dpp_f<DPP_XOR1>(v)); v = fmaxf(v, dpp_f<DPP_XOR2>(v)); v = fmaxf(v, dpp_f<DPP_HMIRROR>(v)); v = fmaxf(v, dpp_f<DPP_MIRROR>(v)); return v; }
__device__ __forceinline__ int row_sum_i(int v) { v += dpp_i<DPP_XOR1>(v); v += dpp_i<DPP_XOR2>(v); v += dpp_i<DPP_HMIRROR>(v); v += dpp_i<DPP_MIRROR>(v); return v; }
__device__ __forceinline__ float wave_sum(float v) { return sum_x32(sum_x16(row_sum(v))); }
__device__ __forceinline__ float wave_max(float v) { return max_x32(max_x16(row_max(v))); }
__device__ __forceinline__ int wave_sum_i(int v) { return sum_x32_i(sum_x16_i(row_sum_i(v))); }
__device__ __forceinline__ float sum_x16_x32(float v) { return sum_x32(sum_x16(v)); }
__device__ __forceinline__ float sum_x1_x2(float v) { v += dpp_f<DPP_XOR1>(v); v += dpp_f<DPP_XOR2>(v); return v; }
template <int MASK> __device__ __forceinline__ float swz_xor(float v) { static_assert(MASK > 0 && MASK < 32, "swz_xor: 1..31"); return __builtin_bit_cast(float, __builtin_amdgcn_ds_swizzle(__builtin_bit_cast(int, v), 0x1f | (MASK << 10))); }
__device__ __forceinline__ float ex2(float x) { return __builtin_amdgcn_exp2f(x); }
__device__ __forceinline__ float rcp_(float x) { return __builtin_amdgcn_rcpf(x); }
__device__ __forceinline__ float rsq_(float x) { return __builtin_amdgcn_rsqf(x); }
__device__ __forceinline__ float sigmoidf_(float x) { return rcp_(1.f + ex2(-x * LOG2E)); }
__device__ __forceinline__ float gelu_tanh(float x) { const float u = 0.7978845608028654f * (x + 0.044715f * x * x * x); return x * rcp_(1.f + ex2(-2.f * LOG2E * u)); }
__device__ __forceinline__ f32x4 mfma16(bf16x8 a, bf16x8 b, f32x4 c) { return __builtin_amdgcn_mfma_f32_16x16x32_bf16(a, b, c, 0, 0, 0); }
__device__ __forceinline__ bf16x8 as_bf16x8(u32x4 w) { return __builtin_bit_cast(bf16x8, w); }
__device__ __forceinline__ float log2_sigmoid(float a) { return -log1pf(__expf(-a)) * LOG2E; }

struct GroupOrder {
    int nG, nM, nN, pmS, pnS, G, c;
    __device__ __forceinline__ bool next(int i, pg8::Unit& u) const {
        const long L = (long)i * G + c; const int tot = nG * nM * nN; if (L >= tot) return false;
        int wgid = (int)L; { const int q = tot / 8, r = tot % 8, xcd = wgid % 8, off = wgid / 8; wgid = (xcd < r ? xcd * (q + 1) : r * (q + 1) + (xcd - r) * q) + off; }
        const int per = nM * nN, g = wgid / per, rem = wgid - g * per;
        const int nig = 8 * nN, gid = rem / nig, fm = gid * 8, gsz = (nM - fm) < 8 ? (nM - fm) : 8;
        u.pm = g * pmS + fm + ((rem % nig) % gsz); u.pn = g * pnS + (rem % nig) / gsz; return true;
    }
    __device__ __forceinline__ void a_ready(const pg8::Unit&) const {}
    __device__ __forceinline__ void done(const pg8::Unit&) const {}
};
struct MergeOrder {
    int nM, G, c;
    __device__ __forceinline__ bool next(int i, pg8::Unit& u) const {
        const int ii = i / 3, g = i - 3 * ii; const long L = (long)ii * G + c; const int tot = nM * 4; if (L >= tot) return false;
        int wgid = (int)L; { const int q = tot / 8, r = tot % 8, xcd = wgid % 8, off = wgid / 8; wgid = (xcd < r ? xcd * (q + 1) : r * (q + 1) + (xcd - r) * q) + off; }
        const int nig = 32, gid = wgid / nig, fm = gid * 8, gsz = (nM - fm) < 8 ? (nM - fm) : 8;
        u.pm = g * (M / 256) + fm + ((wgid % nig) % gsz); u.pn = g * 4 + (wgid % nig) / gsz; return true;
    }
    __device__ __forceinline__ void a_ready(const pg8::Unit&) const {}
    __device__ __forceinline__ void done(const pg8::Unit&) const {}
};

struct EpiZA {
    static constexpr bool PERM = true, AFTER_DRAIN = false, CHAIN = false;
    bf16* O;
    __device__ __forceinline__ void operator()(const f32x4 (&acc)[2][2][4][2], const pg8::Unit& u, int wr, int wc, int fr, int fq) const {
        const int row0 = u.pm * 256 + wr * 64 + fr, col0 = u.pn * 256 + wc * 32 + 8 * fq; const bool act = false;
#pragma unroll
        for (int ai = 0; ai < 2; ++ai)
#pragma unroll
            for (int m = 0; m < 4; ++m) { bf16* rowp = O + (size_t)(row0 + ai * 128 + m * 16) * NZA + col0;
#pragma unroll
                for (int bj = 0; bj < 2; ++bj) { const f32x4 v0 = acc[ai][bj][m][0], v1 = acc[ai][bj][m][1];
                    float o[8] = {v0[0], v0[1], v0[2], v0[3], v1[0], v1[1], v1[2], v1[3]};
                    if (act) {
#pragma unroll
                        for (int k = 0; k < 8; ++k) o[k] = gelu_tanh(o[k]); }
                    *(u32x4*)(rowp + bj * 128) = pack8(o); } }
    }
};
struct EpiSig {
    static constexpr bool PERM = true, AFTER_DRAIN = false, CHAIN = false;
    unsigned char* O;
    __device__ __forceinline__ void operator()(const f32x4 (&acc)[2][2][4][2], const pg8::Unit& u, int wr, int wc, int fr, int fq) const {
        const int row0 = u.pm * 256 + wr * 64 + fr, col0 = u.pn * 256 + wc * 32 + 8 * fq;
#pragma unroll
        for (int ai = 0; ai < 2; ++ai)
#pragma unroll
            for (int m = 0; m < 4; ++m) { unsigned char* rowp = O + (size_t)(row0 + ai * 128 + m * 16) * NZG + col0;
#pragma unroll
                for (int bj = 0; bj < 2; ++bj) { const f32x4 v0 = acc[ai][bj][m][0], v1 = acc[ai][bj][m][1];
                    const float o[8] = {v0[0], v0[1], v0[2], v0[3], v1[0], v1[1], v1[2], v1[3]};
                    unsigned q[8];
#pragma unroll
                    for (int k = 0; k < 8; ++k) { const unsigned t = (unsigned)(sigmoidf_(o[k]) * 255.f + 0.5f); q[k] = t < 1u ? 1u : t; }
                    u32x2 w; w.x = q[0] | (q[1] << 8) | (q[2] << 16) | (q[3] << 24); w.y = q[4] | (q[5] << 8) | (q[6] << 16) | (q[7] << 24);
                    *(u32x2*)(rowp + bj * 128) = w; } }
    }
};
__device__ __forceinline__ void ub8(const u32x2 w, float (&f)[8]) {
    f[0] = (float)(w.x & 0xffu); f[1] = (float)((w.x >> 8) & 0xffu); f[2] = (float)((w.x >> 16) & 0xffu); f[3] = (float)(w.x >> 24);
    f[4] = (float)(w.y & 0xffu); f[5] = (float)((w.y >> 8) & 0xffu); f[6] = (float)((w.y >> 16) & 0xffu); f[7] = (float)(w.y >> 24);
}
struct EpiMergeChain {
    static constexpr bool PERM = true, AFTER_DRAIN = false, CHAIN = true;
    const unsigned char* Gt; bf16* Hm;
    __device__ __forceinline__ bool chain(f32x4 (&acc)[2][2][4][2], const pg8::Unit& u, int wr, int wc, int fr, int fq) const {
        const int g = u.pm / (M / 256), m = u.pm - g * (M / 256), n = u.pn - g * 4;
        const int row0 = m * 256 + wr * 64 + fr, col0 = n * 256 + wc * 32 + 8 * fq;
        u32x2 gw[2][4][2], hw[2][4][2];
#pragma unroll
        for (int ai = 0; ai < 2; ++ai)
#pragma unroll
            for (int mm = 0; mm < 4; ++mm)
#pragma unroll
                for (int bj = 0; bj < 2; ++bj) { const unsigned char* gp = Gt + (size_t)(row0 + ai * 128 + mm * 16) * NZG + g * 1024 + col0 + bj * 128;
                    gw[ai][mm][bj] = *(const u32x2*)gp; if (g < 2) hw[ai][mm][bj] = *(const u32x2*)(gp + 1024); }
#pragma unroll
        for (int ai = 0; ai < 2; ++ai)
#pragma unroll
            for (int mm = 0; mm < 4; ++mm)
#pragma unroll
                for (int bj = 0; bj < 2; ++bj) {
                    float sc[8]; ub8(gw[ai][mm][bj], sc);
                    if (g < 2) { float sn[8]; ub8(hw[ai][mm][bj], sn);
#pragma unroll
                        for (int k = 0; k < 8; ++k) sc[k] *= __builtin_amdgcn_rcpf(sn[k]); }
                    else {
#pragma unroll
                        for (int k = 0; k < 8; ++k) sc[k] *= (1.0f / 255.0f); }
                    f32x4& v0 = acc[ai][bj][mm][0]; f32x4& v1 = acc[ai][bj][mm][1];
                    v0[0] *= sc[0]; v0[1] *= sc[1]; v0[2] *= sc[2]; v0[3] *= sc[3]; v1[0] *= sc[4]; v1[1] *= sc[5]; v1[2] *= sc[6]; v1[3] *= sc[7];
                    if (g == 2) { u32x4 w; w.x = pk2(v0[0], v0[1]); w.y = pk2(v0[2], v0[3]); w.z = pk2(v1[0], v1[1]); w.w = pk2(v1[2], v1[3]);
                        *(u32x4*)(Hm + (size_t)(row0 + ai * 128 + mm * 16) * 1024 + col0 + bj * 128) = w; }
                }
        return g < 2;
    }
};
struct EpiOut {
    static constexpr bool PERM = true, AFTER_DRAIN = false, CHAIN = false;
    const float* xl; const float* xc; bf16* X; const float* modv; int from_f32;
    __device__ __forceinline__ void operator()(const f32x4 (&acc)[2][2][4][2], const pg8::Unit& u, int wr, int wc, int fr, int fq) const {
        const int row0 = u.pm * 256 + wr * 64 + fr, col0 = u.pn * 256 + wc * 32 + 8 * fq;
        const int bi = (u.pm * 256 < ML) ? ((u.pm * 256) >> 12) : 8;
        const float* g1 = modv + bi * 6144 + 2 * 1024;
        f32x4 gv[2][2];
#pragma unroll
        for (int bj = 0; bj < 2; ++bj) { gv[bj][0] = *(const f32x4*)(g1 + col0 + bj * 128); gv[bj][1] = *(const f32x4*)(g1 + col0 + bj * 128 + 4); }
        if (from_f32) {
            const float* src0 = (u.pm * 256 < ML) ? xl + (size_t)row0 * 1024 : xc + (size_t)(row0 - ML) * 1024;
#pragma unroll
            for (int ai = 0; ai < 2; ++ai) {
                f32x4 xv[4][2][2];
#pragma unroll
                for (int m = 0; m < 4; ++m)
#pragma unroll
                    for (int bj = 0; bj < 2; ++bj) { const float* s = src0 + (size_t)(ai * 128 + m * 16) * 1024 + col0 + bj * 128; xv[m][bj][0] = *(const f32x4*)s; xv[m][bj][1] = *(const f32x4*)(s + 4); }
#pragma unroll
                for (int m = 0; m < 4; ++m)
#pragma unroll
                    for (int bj = 0; bj < 2; ++bj) { const f32x4 o0 = xv[m][bj][0] + gv[bj][0] * acc[ai][bj][m][0], o1 = xv[m][bj][1] + gv[bj][1] * acc[ai][bj][m][1];
                        u32x4 w; w.x = pk2(o0[0], o0[1]); w.y = pk2(o0[2], o0[3]); w.z = pk2(o1[0], o1[1]); w.w = pk2(o1[2], o1[3]);
                        *(u32x4*)(X + (size_t)(row0 + ai * 128 + m * 16) * 1024 + col0 + bj * 128) = w; }
            }
        } else {
#pragma unroll
            for (int ai = 0; ai < 2; ++ai) {
                u32x4 xw[4][2];
#pragma unroll
                for (int m = 0; m < 4; ++m)
#pragma unroll
                    for (int bj = 0; bj < 2; ++bj) xw[m][bj] = *(const u32x4*)(X + (size_t)(row0 + ai * 128 + m * 16) * 1024 + col0 + bj * 128);
#pragma unroll
                for (int m = 0; m < 4; ++m)
#pragma unroll
                    for (int bj = 0; bj < 2; ++bj) { float xo[8]; unpack8(xw[m][bj], xo); const f32x4 a0 = acc[ai][bj][m][0], a1 = acc[ai][bj][m][1];
                        float o[8] = {xo[0] + gv[bj][0][0] * a0[0], xo[1] + gv[bj][0][1] * a0[1], xo[2] + gv[bj][0][2] * a0[2], xo[3] + gv[bj][0][3] * a0[3],
                                      xo[4] + gv[bj][1][0] * a1[0], xo[5] + gv[bj][1][1] * a1[1], xo[6] + gv[bj][1][2] * a1[2], xo[7] + gv[bj][1][3] * a1[3]};
                        *(u32x4*)(X + (size_t)(row0 + ai * 128 + m * 16) * 1024 + col0 + bj * 128) = pack8(o); }
            }
        }
    }
};
struct EpiMoe1 {
    static constexpr bool PERM = true, AFTER_DRAIN = false, CHAIN = false;
    bf16* ACT;
    __device__ __forceinline__ void operator()(const f32x4 (&acc)[2][2][4][2], const pg8::Unit& u, int wr, int wc, int fr, int fq) const {
        const int row0 = u.pm * 256 + wr * 64 + fr, col0 = (u.pn & 7) * 128 + wc * 32 + 8 * fq;
#pragma unroll
        for (int ai = 0; ai < 2; ++ai)
#pragma unroll
            for (int m = 0; m < 4; ++m) { const size_t r = (size_t)(row0 + ai * 128 + m * 16);
                const f32x4 a0 = acc[ai][0][m][0], a1 = acc[ai][0][m][1], u0 = acc[ai][1][m][0], u1 = acc[ai][1][m][1];
                float o[8];
#pragma unroll
                for (int k = 0; k < 4; ++k) { o[k] = a0[k] * sigmoidf_(a0[k]) * u0[k]; o[4 + k] = a1[k] * sigmoidf_(a1[k]) * u1[k]; }
                *(u32x4*)(ACT + r * 1024 + col0) = pack8(o); }
    }
};
struct EpiMoe2 {
    static constexpr bool PERM = true, AFTER_DRAIN = false, CHAIN = false;
    bf16* Y; const float* topw;
    __device__ __forceinline__ void operator()(const f32x4 (&acc)[2][2][4][2], const pg8::Unit& u, int wr, int wc, int fr, int fq) const {
        const int row0 = u.pm * 256 + wr * 64 + fr, col0 = (u.pn & 3) * 256 + wc * 32 + 8 * fq;
        float twv[2][4];
#pragma unroll
        for (int ai = 0; ai < 2; ++ai)
#pragma unroll
            for (int m = 0; m < 4; ++m) twv[ai][m] = topw[row0 + ai * 128 + m * 16];
#pragma unroll
        for (int ai = 0; ai < 2; ++ai)
#pragma unroll
            for (int m = 0; m < 4; ++m) { const size_t r = (size_t)(row0 + ai * 128 + m * 16); const float tw = twv[ai][m];
#pragma unroll
                for (int bj = 0; bj < 2; ++bj) { const f32x4 v0 = acc[ai][bj][m][0] * tw, v1 = acc[ai][bj][m][1] * tw;
                    u32x4 w; w.x = pk2(v0[0], v0[1]); w.y = pk2(v0[2], v0[3]); w.z = pk2(v1[0], v1[1]); w.w = pk2(v1[2], v1[3]);
                    *(u32x4*)(Y + r * 1024 + col0 + bj * 128) = w; } }
    }
};

__device__ __forceinline__ void tr_load(const float* src  , int N, f32x4 (&r)[8], int lane) {
    const float* s = src + (size_t)(lane >> 3) * N + 4 * (lane & 7);
#pragma unroll
    for (int i = 0; i < 8; ++i) r[i] = *(const f32x4*)(s + (size_t)(8 * i) * N);
}
__device__ __forceinline__ void tr_lds_in(const f32x4 (&r)[8], LAS float* scr, int lane) {
    LAS float* d = scr + (lane >> 3) * 33 + 4 * (lane & 7);
#pragma unroll
    for (int i = 0; i < 8; ++i)
#pragma unroll
        for (int c = 0; c < 4; ++c) d[(8 * i) * 33 + c] = r[i][c];
}
__device__ __forceinline__ void tr_out(bf16* dst  , int K, const LAS float* scr, int lane) {
    const int cc = lane & 7;
#pragma unroll
    for (int j = 0; j < 4; ++j) { const int n = (lane >> 3) + 8 * j; const LAS float* s = scr + (8 * cc) * 33 + n;
        u32x4 o; o.x = pk2(s[0 * 33], s[1 * 33]); o.y = pk2(s[2 * 33], s[3 * 33]); o.z = pk2(s[4 * 33], s[5 * 33]); o.w = pk2(s[6 * 33], s[7 * 33]);
        *(u32x4*)(dst + (size_t)n * K + 8 * cc) = o; }
}
#define TR_PIPELINE(first_, total_, step_, DEC_) do { f32x4 r_[8]; const float* src_ = nullptr; int N_ = 0, K_ = 0; bf16* dst_ = nullptr; int it_ = (first_); \
        if (it_ < (total_)) { DEC_(it_, src_, N_, dst_, K_); tr_load(src_, N_, r_, lane); } \
        while (it_ < (total_)) { bf16* const cd_ = dst_; const int cK_ = K_; tr_lds_in(r_, scr, lane); const int nx_ = it_ + (step_); \
            if (nx_ < (total_)) { DEC_(nx_, src_, N_, dst_, K_); tr_load(src_, N_, r_, lane); } \
            LDS_WAIT(); tr_out(cd_, cK_, scr, lane); LDS_WAIT(); it_ = nx_; } } while (0)
__device__ __forceinline__ void convert_small(KPC p, int l, LAS unsigned char* lds, int lane, int wave, int bid, int G) {
    LAS float* scr = (LAS float*)(lds + wave * 8448);
    const int gw = bid * 8 + wave, NGW = G * 8;
    constexpr int I_IN = 16 * 200, I_BR = 8 * 32, I_OUT = 16 * 32;
    bf16* wtin = (bf16*)(p->ws + WS_WTIN); bf16* wtbr = (bf16*)(p->ws + WS_WTBR); bf16* wtout = (bf16*)(p->ws + WS_WTOUT);
    auto dec = [&](int it, const float*& src, int& N, bf16*& dst, int& K) {
        int r = it;
        if (r < I_IN) { const int kb = r / 200, nb = r % 200; N = 6400; K = 1024; src = p->w_in + (size_t)l * 1024 * 6400 + (size_t)(64 * kb) * 6400 + 32 * nb; dst = wtin + (size_t)(32 * nb) * 1024 + 64 * kb; return; }
        r -= I_IN;
        if (r < 3 * I_BR) { const int br = r / I_BR, q = r % I_BR, kb = q / 32, nb = q % 32; N = 1024; K = 512;
            src = p->w_branch + ((size_t)l * 3 + br) * 512 * 1024 + (size_t)(64 * kb) * 1024 + 32 * nb; dst = wtbr + (size_t)(br * 1024 + 32 * nb) * 512 + 64 * kb; return; }
        r -= 3 * I_BR;
        { const int kb = r / 32, nb = r % 32; N = 1024; K = 1024; src = p->w_out + (size_t)l * 1024 * 1024 + (size_t)(64 * kb) * 1024 + 32 * nb; dst = wtout + (size_t)(32 * nb) * 1024 + 64 * kb; }
    };
    TR_PIPELINE(gw, I_IN + 3 * I_BR + I_OUT, NGW, dec);
}
__device__ __forceinline__ size_t wt1_off(int l) { return l == 0 ? WS_WT1 : WS_WT1B; }
__device__ __forceinline__ size_t wt2_off(KPC p, int l) { return (l == 1 && p->early2 != 0) ? WS_WT2B : WS_WT2; }
constexpr size_t WS_DYN = 14336;
constexpr int DYN_DONE_G = 3, DYN_DONE_M = 4, DYN_DONE_O = 5, DYN_DONE_E1 = 6, DYN_DONE_E2 = 7;
__device__ __forceinline__ unsigned* dyn_word(KPC p, int k) { return (unsigned*)(p->ws + WS_DYN + k * 128); }
__device__ __forceinline__ unsigned dyn_ld(unsigned* q) { return __hip_atomic_load(q, __ATOMIC_RELAXED, __HIP_MEMORY_SCOPE_AGENT); }
__device__ __forceinline__ unsigned dyn_add(unsigned* q, unsigned v) { return __hip_atomic_fetch_add(q, v, __ATOMIC_RELAXED, __HIP_MEMORY_SCOPE_AGENT); }
template <int LIST>
__device__ __forceinline__ bool convert_list(KPC p, unsigned* done, unsigned nbusy, LAS unsigned char* lds, int tid, int lane, int wave) {
    constexpr int l = (LIST == 0) ? 0 : 1, limit = (LIST == 0) ? 24576 : (LIST == 1) ? 16384 : 8192;
    LAS float* scr = (LAS float*)(lds + wave * 8448); LAS int* slot = (LAS int*)(lds + 8 * 8448);
    bf16* wt1 = (bf16*)(p->ws + wt1_off(l)); bf16* wt2 = (bf16*)(p->ws + wt2_off(p, l));
    unsigned* ctr = dyn_word(p, LIST);
    auto dec = [&](int j, const float*& src, bf16*& dst) {
        const int it = (LIST == 0) ? j : (LIST == 1) ? (j >> 10) * 1536 + (j & 1023) : (j >> 9) * 1536 + 1024 + (j & 511);
        const int e = it / 1536, q = it % 1536, which = q / 512, qq = q % 512, kb = qq / 32, nb = qq % 32, n0 = 32 * nb, k0 = 64 * kb;
        const size_t woff = ((size_t)l * NE + e) * 1024 * 1024 + (size_t)k0 * 1024 + n0;
        src = (which == 0 ? p->w_eg : which == 1 ? p->w_eu : p->w_ed) + woff;
        dst = (which == 2) ? wt2 + ((size_t)e * 1024 + n0) * 1024 + k0 : wt1 + ((size_t)e * 2048 + (n0 >> 7) * 256 + (which == 1 ? 128 : 0) + (n0 & 127)) * 1024 + k0;
    };
    bool stopped = false;
    for (int par = 0;; par ^= 1) {
        if (tid == 0) { const bool st = (done != nullptr) && dyn_ld(done) >= nbusy; slot[par * 2] = st ? limit : (int)dyn_add(ctr, 8u); slot[par * 2 + 1] = st ? 1 : 0; }
        __syncthreads();
        const int base = slot[par * 2];
        if (base >= limit) { stopped = slot[par * 2 + 1] != 0; break; }
        f32x4 r[8]; const float* s0; bf16* d0;
        dec(base + wave, s0, d0); tr_load(s0, 1024, r, lane);
        tr_lds_in(r, scr, lane); LDS_WAIT(); tr_out(d0, 1024, scr, lane); LDS_WAIT();
    }
    __syncthreads();
    return stopped;
}
__device__ __forceinline__ void convert_tail(KPC p, int dk, unsigned nbusy, LAS unsigned char* lds, int tid, int lane, int wave) {
    unsigned* done = dyn_word(p, dk);
    if (convert_list<0>(p, done, nbusy, lds, tid, lane, wave)) return;
    if (convert_list<1>(p, done, nbusy, lds, tid, lane, wave)) return;
    if (p->early2 != 0) (void)convert_list<2>(p, done, nbusy, lds, tid, lane, wave);
}
constexpr int CVT_ITEMS = NE * 3 * 512;
constexpr int CVT_G_IDLE0 = 96, CVT_M_IDLE0 = 32, CVT_O_IDLE0 = 32, CVT_E1_IDLE0 = 128, CVT_E2_IDLE0 = 64;

__device__ __forceinline__ void phase_prep(KPC p, LAS unsigned char* lds, int tid, int lane, int wave, int bid, int G) {
    unsigned char* ws = p->ws;
    {   float* rc = (float*)(ws + WS_ROPEC); float* rsn = (float*)(ws + WS_ROPES);
        for (int i = bid * 512 + tid; i < T * 32; i += G * 512) { const int t = i >> 5, f = i & 31; const int pos = (f < 16) ? (t >> 6) : (t & 63); const int fi = f & 15;
            const float inv = ex2(-(float)fi * (13.287712379549449f / 16.f));
            float ang = (float)pos * inv; ang -= 6.283185307179586f * rintf(ang * 0.15915494309189535f);
            rc[i] = __cosf(ang); rsn[i] = __sinf(ang); } }
    if (bid == 0 && tid < 16) { const int l = tid >> 3, dir = (tid >> 2) & 1, h = tid & 3; ((float*)(ws + WS_LG))[tid] = log2_sigmoid(dir ? p->dec_b[l * 4 + h] : p->dec_f[l * 4 + h]); }
    {   LAS float* sv = (LAS float*)lds;
        LAS float* red = (LAS float*)(lds + 36864);
        {   float cv[18];
#pragma unroll
            for (int q = 0; q < 18; ++q) { const int i = tid + 512 * q, r = i >> 10, k = i & 1023; cv[q] = (r < 8) ? p->c[r * 1024 + k] : p->c_ctx[k]; }
#pragma unroll
            for (int q = 0; q < 18; ++q) sv[tid + 512 * q] = cv[q] * sigmoidf_(cv[q]); }
        __syncthreads();
        for (int it = bid; it < 192; it += G) {
            const int l = it / 96, n0 = (it % 96) * 64;
            const float* W = p->w_mod + (size_t)l * 1024 * 6144 + n0 + lane;
            float acc[9];
#pragma unroll
            for (int r = 0; r < 9; ++r) acc[r] = 0.f;
            float wn[16];
#pragma unroll
            for (int kk = 0; kk < 16; ++kk) wn[kk] = W[(size_t)(wave * 128 + kk) * 6144];
#pragma unroll 1
            for (int k0 = wave * 128; k0 < wave * 128 + 128; k0 += 16) {
                float wv[16];
#pragma unroll
                for (int kk = 0; kk < 16; ++kk) wv[kk] = wn[kk];
                if (k0 + 16 < wave * 128 + 128) {
#pragma unroll
                    for (int kk = 0; kk < 16; ++kk) wn[kk] = W[(size_t)(k0 + 16 + kk) * 6144]; }
#pragma unroll
                for (int kk = 0; kk < 16; ++kk)
#pragma unroll
                    for (int r = 0; r < 9; ++r) acc[r] += sv[r * 1024 + k0 + kk] * wv[kk]; }
#pragma unroll
            for (int r = 0; r < 9; ++r) red[(wave * 9 + r) * 64 + lane] = acc[r];
            __syncthreads();
            for (int i = tid; i < 576; i += 512) { const int r = i >> 6, ln = i & 63; float s = 0.f;
#pragma unroll
                for (int w = 0; w < 8; ++w) s += red[(w * 9 + r) * 64 + ln];
                s += p->b_mod[l * 6144 + n0 + ln]; ((float*)(ws + WS_MODV))[(l * 9 + r) * 6144 + n0 + ln] = s; }
            __syncthreads();
        }
    }
    __syncthreads();
    convert_small(p, 0, lds, lane, wave, bid, G);
}

__device__ __forceinline__ float row_rs(const f32x4 (&v)[4]) {
    float ss = 0.f;
#pragma unroll
    for (int j = 0; j < 4; ++j) ss += (v[j].x * v[j].x + v[j].y * v[j].y) + (v[j].z * v[j].z + v[j].w * v[j].w);
    return rsq_(wave_sum(ss) * (1.f / 1024.f) + EPS);
}
__device__ __forceinline__ void norm_mod(const f32x4 (&v)[4], float rs, const float* gain, const float* sh, const float* sc, f32x4 (&h)[4], int lane) {
#pragma unroll
    for (int j = 0; j < 4; ++j) { const int col = 4 * lane + 256 * j; const f32x4 g = *(const f32x4*)(gain + col), a = *(const f32x4*)(sc + col), b = *(const f32x4*)(sh + col);
        h[j] = (v[j] * rs) * g * (a + 1.0f) + b; }
}
__device__ __forceinline__ void store_h(const f32x4 (&h)[4], bf16* hrow, int lane) {
#pragma unroll
    for (int j = 0; j < 4; ++j) { u32x2 w; w.x = pk2(h[j].x, h[j].y); w.y = pk2(h[j].z, h[j].w); *(u32x2*)(hrow + 4 * lane + 256 * j) = w; }
}
__device__ __forceinline__ void phase_norm_in(KPC p, int lane, int wave, int bid, int G) {
    const float* modv = (const float*)(p->ws + WS_MODV); bf16* H = (bf16*)(p->ws + WS_H);
    const int stride = G * 8; int r = bid * 8 + wave;
    f32x4 vn[4];
    {   const float* src = (r < ML) ? p->x + (size_t)r * 1024 : p->ctx + (size_t)(r - ML) * 1024;
#pragma unroll
        for (int j = 0; j < 4; ++j) vn[j] = (r < M) ? *(const f32x4*)(src + 4 * lane + 256 * j) : (f32x4){0.f, 0.f, 0.f, 0.f}; }
    for (; r < M; r += stride) {
        const int bi = (r < ML) ? (r >> 12) : 8; const float* mv = modv + bi * 6144;
        f32x4 v[4], h[4], g[4], sc[4], sh[4];
#pragma unroll
        for (int j = 0; j < 4; ++j) { v[j] = vn[j]; const int col = 4 * lane + 256 * j; g[j] = *(const f32x4*)(p->norm1_g + col); sh[j] = *(const f32x4*)(mv + col); sc[j] = *(const f32x4*)(mv + 1024 + col); }
        const int rn = r + stride;
        if (rn < M) { const float* src = (rn < ML) ? p->x + (size_t)rn * 1024 : p->ctx + (size_t)(rn - ML) * 1024;
#pragma unroll
            for (int j = 0; j < 4; ++j) vn[j] = *(const f32x4*)(src + 4 * lane + 256 * j); }
        const float rs = row_rs(v);
#pragma unroll
        for (int j = 0; j < 4; ++j) h[j] = (v[j] * rs) * g[j] * (sc[j] + 1.0f) + sh[j];
        store_h(h, H + (size_t)r * 1024, lane);
    }
}

typedef short s16x4 __attribute__((ext_vector_type(4)));
__device__ __forceinline__ u32x2 lds_tr16(const LAS unsigned char* addr) { const s16x4 r = __builtin_amdgcn_ds_read_tr16_b64_v4i16((LAS s16x4*)addr); return __builtin_bit_cast(u32x2, r); }
__device__ __forceinline__ void ld8f(const float* p, float (&f)[8]) { const f32x4 a = *(const f32x4*)p, b = *(const f32x4*)(p + 4); f[0] = a[0]; f[1] = a[1]; f[2] = a[2]; f[3] = a[3]; f[4] = b[0]; f[5] = b[1]; f[6] = b[2]; f[7] = b[3]; }
__device__ __forceinline__ void att_item(KPC p, int l, LAS unsigned char* lds, int item, float Mb2, int tid, int lane, int wave) {
    const bf16* ZA = (const bf16*)(p->ws + WS_ZA); bf16* BR = (bf16*)p->out + (size_t)2 * M * 512;
    const float* rc = (const float*)(p->ws + WS_ROPEC); const float* rsn = (const float*)(p->ws + WS_ROPES);
    const bool isctx = item >= 512;
    int b, kvh, qb;
    if (!isctx) { b = item >> 6; kvh = (item >> 5) & 1; qb = item & 31; } else { const int ci = item - 512; b = ci >> 2; kvh = (ci >> 1) & 1; qb = ci & 1; }
    const int rowbase = isctx ? ML + b * CL : b * T;
    const int g = wave >> 1, qs = wave & 1, hh = kvh * 4 + g, c = lane & 15, g4 = lane >> 4, q0 = qb * 128 + qs * 64;
    const float* qg = p->qn_g + l * 64; const float* kg = p->kn_g + l * 64;
    LAS unsigned char* Kl = lds;
    bf16x8 qf[4][2];
    float qga[8], qgb[8]; ld8f(qg + 8 * g4, qga); ld8f(qg + 32 + 8 * g4, qgb);
#pragma unroll
    for (int ti = 0; ti < 4; ++ti) {
        const int pos = q0 + 16 * ti + c; const bf16* src = ZA + (size_t)(rowbase + pos) * NZA + C_AQ + hh * 64 + 8 * g4;
        float a[8], bb[8]; unpack8(*(const u32x4*)src, a); unpack8(*(const u32x4*)(src + 32), bb);
        float ss = 0.f;
#pragma unroll
        for (int j = 0; j < 8; ++j) ss += a[j] * a[j] + bb[j] * bb[j];
        ss = sum_x16_x32(ss);
        const float rs = rsq_(ss * (1.f / 64.f) + EPS);
#pragma unroll
        for (int j = 0; j < 8; ++j) { a[j] *= rs * qga[j]; bb[j] *= rs * qgb[j]; }
        if (!isctx) { float cs8[8], sn8[8]; ld8f(rc + pos * 32 + 8 * g4, cs8); ld8f(rsn + pos * 32 + 8 * g4, sn8);
#pragma unroll
            for (int j = 0; j < 8; ++j) { const float cs = cs8[j], sn = sn8[j]; const float x1 = a[j], x2 = bb[j]; a[j] = x1 * cs - x2 * sn; bb[j] = x1 * sn + x2 * cs; } }
#pragma unroll
        for (int j = 0; j < 8; ++j) { a[j] *= 0.125f * LOG2E; bb[j] *= 0.125f * LOG2E; }
        qf[ti][0] = as_bf16x8(pack8(a)); qf[ti][1] = as_bf16x8(pack8(bb));
        __builtin_amdgcn_sched_barrier(0);
    }
    f32x4 O[4][4]; float lsum[4];
#pragma unroll
    for (int i = 0; i < 4; ++i) { lsum[i] = 0.f;
#pragma unroll
        for (int j = 0; j < 4; ++j) O[i][j] = (f32x4){0.f, 0.f, 0.f, 0.f}; }
    const int key = tid >> 2, q4 = tid & 3;
    LAS unsigned char* Vl = lds + 55296;
#pragma unroll 1
    for (int st = isctx ? 1 : 0; st < 2; ++st) {
        __syncthreads();
        {   u32x4 kr[1][2], vr[1][2];
#define ATT_VB(lb_) ((st == 0) ? ((qb - 1 + (lb_)) >= 0 && (qb - 1 + (lb_)) <= 31) : ((lb_) < 2))
#define ATT_LD(lb_, s_) do { if (ATT_VB(lb_)) { const int krow = (st == 0) ? b * T + (qb - 1 + (lb_)) * 128 + key : ML + b * CL + 128 * (lb_) + key; \
                const bf16* ks = ZA + (size_t)krow * NZA + C_AK + kvh * 64 + 8 * q4; kr[s_][0] = *(const u32x4*)ks; kr[s_][1] = *(const u32x4*)(ks + 32); \
                const bf16* vs = ZA + (size_t)krow * NZA + C_AV + kvh * 64 + 16 * q4; vr[s_][0] = *(const u32x4*)vs; vr[s_][1] = *(const u32x4*)(vs + 8); } } while (0)
#pragma unroll 1
            for (int lb = 0; lb < 3; ++lb) {
                ATT_LD(lb, 0);
                if (ATT_VB(lb)) {
                    float a[8], bb[8]; unpack8(kr[0][0], a); unpack8(kr[0][1], bb);
                    float ss = 0.f;
#pragma unroll
                    for (int j = 0; j < 8; ++j) ss += a[j] * a[j] + bb[j] * bb[j];
                    ss = sum_x1_x2(ss);
                    const float rs = rsq_(ss * (1.f / 64.f) + EPS);
                    float kga[8], kgb[8]; ld8f(kg + 8 * q4, kga); ld8f(kg + 32 + 8 * q4, kgb);
#pragma unroll
                    for (int j = 0; j < 8; ++j) { a[j] *= rs * kga[j]; bb[j] *= rs * kgb[j]; }
                    __builtin_amdgcn_sched_barrier(0);
                    if (st == 0) { const int pos = (qb - 1 + lb) * 128 + key; float cs8[8], sn8[8]; ld8f(rc + pos * 32 + 8 * q4, cs8); ld8f(rsn + pos * 32 + 8 * q4, sn8);
#pragma unroll
                        for (int j = 0; j < 8; ++j) { const float cs = cs8[j], sn = sn8[j]; const float x1 = a[j], x2 = bb[j]; a[j] = x1 * cs - x2 * sn; bb[j] = x1 * sn + x2 * cs; } }
                    LAS unsigned char* kd = Kl + (lb * 128 + key) * 144; *(LAS u32x4*)(kd + 16 * q4) = pack8(a); *(LAS u32x4*)(kd + 64 + 16 * q4) = pack8(bb);
                    LAS unsigned char* vd = Vl + (lb * 128 + key) * 144 + 32 * q4; *(LAS u32x4*)vd = vr[0][0]; *(LAS u32x4*)(vd + 16) = vr[0][1];
                }
            }
#undef ATT_VB
#undef ATT_LD
        }
        __syncthreads();
#pragma unroll 1
        for (int lb = 0; lb < 3; ++lb) {
            if (st == 0) { const int kb = qb - 1 + lb; if (kb < 0 || kb > 31) continue; } else if (lb >= 2) continue;
            const int mode = (st == 0) ? ((lb == 0) ? 1 : ((lb == 2) ? 2 : 0)) : 0;
            const LAS unsigned char* Kb = Kl + lb * 128 * 144; const LAS unsigned char* Vb = Vl + lb * 128 * 144;
#pragma unroll 1
            for (int kk = 0; kk < 4; ++kk) {
                if ((mode == 1 && 32 * kk + 31 < qs * 64) || (mode == 2 && 32 * kk > qs * 64 + 63)) continue;
                bf16x8 ka[2][2];
#pragma unroll
                for (int hf = 0; hf < 2; ++hf)
#pragma unroll
                    for (int ks = 0; ks < 2; ++ks) ka[hf][ks] = *(const LAS bf16x8*)(Kb + (32 * kk + 16 * hf + c) * 144 + ks * 64 + g4 * 16);
                bf16x8 pf[4];
#pragma unroll
                for (int ti = 0; ti < 4; ++ti) {
                    f32x4 sa = (f32x4){-Mb2, -Mb2, -Mb2, -Mb2}, sb = sa;
                    sa = mfma16(ka[0][0], qf[ti][0], sa); sa = mfma16(ka[0][1], qf[ti][1], sa);
                    sb = mfma16(ka[1][0], qf[ti][0], sb); sb = mfma16(ka[1][1], qf[ti][1], sb);
                    float pa[4], pb[4];
#pragma unroll
                    for (int rr = 0; rr < 4; ++rr) { pa[rr] = ex2(sa[rr]); pb[rr] = ex2(sb[rr]); }
                    if (mode != 0) {
                        const int ii = qs * 64 + 16 * ti + c; const int mlo = (mode == 1) ? ii : -1000, mhi = (mode == 2) ? ii : 1000;
#pragma unroll
                        for (int rr = 0; rr < 4; ++rr) { const int ja = 32 * kk + 4 * g4 + rr, jb = ja + 16;
                            pa[rr] = (ja >= mlo && ja <= mhi) ? pa[rr] : 0.f; pb[rr] = (jb >= mlo && jb <= mhi) ? pb[rr] : 0.f; } }
                    lsum[ti] += ((pa[0] + pa[1]) + (pa[2] + pa[3])) + ((pb[0] + pb[1]) + (pb[2] + pb[3]));
                    u32x4 w; w.x = pk2(pa[0], pa[1]); w.y = pk2(pa[2], pa[3]); w.z = pk2(pb[0], pb[1]); w.w = pk2(pb[2], pb[3]); pf[ti] = as_bf16x8(w);
                }
#pragma unroll
                for (int dt = 0; dt < 4; ++dt) {
                    const u32x2 v0 = lds_tr16(Vb + (32 * kk + 4 * g4 + (c >> 2)) * 144 + (16 * dt + 4 * (c & 3)) * 2), v1 = lds_tr16(Vb + (32 * kk + 16 + 4 * g4 + (c >> 2)) * 144 + (16 * dt + 4 * (c & 3)) * 2);
                    u32x4 vv; vv.x = v0.x; vv.y = v0.y; vv.z = v1.x; vv.w = v1.y; const bf16x8 va = as_bf16x8(vv);
#pragma unroll
                    for (int ti = 0; ti < 4; ++ti) O[dt][ti] = mfma16(va, pf[ti], O[dt][ti]);
                }
            }
        }
    }
    const float sk = ex2(p->sink[l * 8 + hh] * LOG2E - Mb2);
#pragma unroll
    for (int ti = 0; ti < 4; ++ti) { float lt = sum_x16_x32(lsum[ti]); const float inv = rcp_(lt + sk);
        bf16* dst = BR + (size_t)(rowbase + q0 + 16 * ti + c) * 512 + hh * 64 + 4 * g4;
#pragma unroll
        for (int dt = 0; dt < 4; ++dt) { const f32x4 o = O[dt][ti] * inv; u32x2 w; w.x = pk2(o[0], o[1]); w.y = pk2(o[2], o[3]); *(u32x2*)(dst + 16 * dt) = w; } }
    __syncthreads();
}

__device__ __forceinline__ void sgu_vprep_item(KPC p, int ch, int tid) {
    bf16* ZA = (bf16*)(p->ws + WS_ZA);
    const int seg = tid & 15;
    bf16* rowp0 = ZA + (size_t)(ch * 128 + (tid >> 4)) * NZA + C_SV + 32 * seg;
    u32x4 raw[4][4];
#pragma unroll
    for (int ps = 0; ps < 4; ++ps)
#pragma unroll
        for (int q = 0; q < 4; ++q) raw[ps][q] = *(const u32x4*)(rowp0 + (size_t)ps * 32 * NZA + 8 * q);
#pragma unroll
    for (int ps = 0; ps < 4; ++ps) {
        bf16* rowp = rowp0 + (size_t)ps * 32 * NZA;
        float f[4][8]; float s = 0.f, ss = 0.f;
#pragma unroll
        for (int q = 0; q < 4; ++q) unpack8(raw[ps][q], f[q]);
#pragma unroll
        for (int q = 0; q < 4; ++q)
#pragma unroll
            for (int e = 0; e < 8; ++e) { const float y = gelu_tanh(f[q][e]); f[q][e] = y; s += y; ss += y * y; }
        s = row_sum(s); ss = row_sum(ss);
        const float mean = s * (1.f / 512.f), var = fmaxf(ss * (1.f / 512.f) - mean * mean, 0.f), rstd = rsq_(var + EPS);
#pragma unroll
        for (int q = 0; q < 4; ++q) {
#pragma unroll
            for (int e = 0; e < 8; ++e) f[q][e] = (f[q][e] - mean) * rstd;
            *(u32x4*)(rowp + 8 * q) = pack8(f[q]); }
    }
}
__device__ __forceinline__ void sgu_block(KPC p, int l, LAS unsigned char* lds, int nchunk, int tid, int lane, int wave, int bid, int G) {
    const bf16* ZA = (const bf16*)(p->ws + WS_ZA); bf16* BR = (bf16*)p->out + (size_t)1 * M * 512;
    const int c = lane & 15, g4 = lane >> 4, tq = c >> 2, tp = c & 3, j = tid >> 2, q4 = tid & 3;
    LAS unsigned char* Vl = lds;
    LAS unsigned char* WL = lds + 34816;
    const int g = bid & 3, cstride = G >> 2; int ch = bid >> 2;
    if ((G & 3) != 0 || ch >= nchunk) return;
    {   const float* wsrc = p->sgu_w + ((size_t)(l * 4 + g) * 128 + j) * 128 + 32 * q4;
        f32x4 wa[8];
#pragma unroll
        for (int q = 0; q < 8; ++q) wa[q] = *(const f32x4*)(wsrc + 4 * q);
#pragma unroll
        for (int q = 0; q < 4; ++q) { const f32x4 a = wa[2 * q], bq = wa[2 * q + 1];
            u32x4 w; w.x = pk2(a.x, a.y); w.y = pk2(a.z, a.w); w.z = pk2(bq.x, bq.y); w.w = pk2(bq.z, bq.w);
            *(LAS u32x4*)(WL + j * 272 + (32 * q4 + 8 * q) * 2) = w; } }
    const int col = 128 * g + 16 * wave + 4 * g4;
    u32x4 raw[4]; u32x2 uwn[8]; float bias[8];
#pragma unroll
    for (int ti = 0; ti < 8; ++ti) bias[ti] = p->sgu_b[(l * 4 + g) * 128 + 16 * ti + c];
    {   const bf16* src = ZA + (size_t)(ch * 128 + j) * NZA + C_SV + 128 * g + 32 * q4;
#pragma unroll
        for (int q = 0; q < 4; ++q) raw[q] = *(const u32x4*)(src + 8 * q);
#pragma unroll
        for (int ti = 0; ti < 8; ++ti) uwn[ti] = *(const u32x2*)(ZA + (size_t)(ch * 128 + 16 * ti + c) * NZA + C_SU + col); }
    for (; ch < nchunk; ch += cstride) {
        const int r0 = ch * 128;
        __syncthreads();
#pragma unroll
        for (int q = 0; q < 4; ++q) *(LAS u32x4*)(Vl + j * 272 + (32 * q4 + 8 * q) * 2) = raw[q];
        __syncthreads();
        u32x2 uw[8];
#pragma unroll
        for (int ti = 0; ti < 8; ++ti) uw[ti] = uwn[ti];
        if (ch + cstride < nchunk) { const bf16* src = ZA + (size_t)((ch + cstride) * 128 + j) * NZA + C_SV + 128 * g + 32 * q4;
#pragma unroll
            for (int q = 0; q < 4; ++q) raw[q] = *(const u32x4*)(src + 8 * q);
#pragma unroll
            for (int ti = 0; ti < 8; ++ti) uwn[ti] = *(const u32x2*)(ZA + (size_t)((ch + cstride) * 128 + 16 * ti + c) * NZA + C_SU + col); }
        __builtin_amdgcn_sched_barrier(0);
        bf16x8 af[4];
#pragma unroll
        for (int ks = 0; ks < 4; ++ks) { const u32x2 v0 = lds_tr16(Vl + (32 * ks + 8 * g4 + tq) * 272 + (16 * wave + 4 * tp) * 2), v1 = lds_tr16(Vl + (32 * ks + 8 * g4 + 4 + tq) * 272 + (16 * wave + 4 * tp) * 2);
            u32x4 vv; vv.x = v0.x; vv.y = v0.y; vv.z = v1.x; vv.w = v1.y; af[ks] = as_bf16x8(vv); }
#pragma unroll
        for (int ti = 0; ti < 8; ++ti) {
            f32x4 acc = (f32x4){0.f, 0.f, 0.f, 0.f};
#pragma unroll
            for (int ks = 0; ks < 4; ++ks) acc = mfma16(af[ks], *(const LAS bf16x8*)(WL + (16 * ti + c) * 272 + (32 * ks + 8 * g4) * 2), acc);
            const float o0 = gelu_tanh(bflo(uw[ti].x)) * (acc[0] + bias[ti]), o1 = gelu_tanh(bfhi(uw[ti].x)) * (acc[1] + bias[ti]), o2 = gelu_tanh(bflo(uw[ti].y)) * (acc[2] + bias[ti]), o3 = gelu_tanh(bfhi(uw[ti].y)) * (acc[3] + bias[ti]);
            u32x2 w; w.x = pk2(o0, o1); w.y = pk2(o2, o3); *(u32x2*)(BR + (size_t)(r0 + 16 * ti + c) * 512 + col) = w;
        }
    }
    __syncthreads();
}
__device__ __forceinline__ void sgu_item(KPC p, int l, LAS unsigned char* lds, int item, int tid, int lane, int wave) {
    const bf16* ZA = (const bf16*)(p->ws + WS_ZA); bf16* BR = (bf16*)p->out + (size_t)1 * M * 512;
    const int ch = item >> 2, g = item & 3, r0 = ch * 128, c = lane & 15, g4 = lane >> 4;
    LAS unsigned char* vT = lds;
    LAS unsigned char* WL = lds + 34816;
    {   const int j = tid >> 2, q4 = tid & 3; const bf16* src = ZA + (size_t)(r0 + j) * NZA + C_SV + 128 * g + 32 * q4;
#pragma unroll
        for (int q = 0; q < 4; ++q) { const u32x4 v = *(const u32x4*)(src + 8 * q); const unsigned vw[4] = {v.x, v.y, v.z, v.w};
#pragma unroll
            for (int e = 0; e < 4; ++e) { *(LAS unsigned short*)(vT + (32 * q4 + 8 * q + 2 * e) * 272 + j * 2) = (unsigned short)(vw[e] & 0xffffu); *(LAS unsigned short*)(vT + (32 * q4 + 8 * q + 2 * e + 1) * 272 + j * 2) = (unsigned short)(vw[e] >> 16); } }
        const float* wsrc = p->sgu_w + ((size_t)(l * 4 + g) * 128 + (tid >> 2)) * 128 + 32 * (tid & 3);
#pragma unroll
        for (int q = 0; q < 4; ++q) { const f32x4 a = *(const f32x4*)(wsrc + 8 * q), bq = *(const f32x4*)(wsrc + 8 * q + 4);
            u32x4 w; w.x = pk2(a.x, a.y); w.y = pk2(a.z, a.w); w.z = pk2(bq.x, bq.y); w.w = pk2(bq.z, bq.w);
            *(LAS u32x4*)(WL + (tid >> 2) * 272 + (32 * (tid & 3) + 8 * q) * 2) = w; }
    }
    __syncthreads();
    bf16x8 af[4];
#pragma unroll
    for (int ks = 0; ks < 4; ++ks) af[ks] = *(const LAS bf16x8*)(vT + (16 * wave + c) * 272 + (32 * ks + 8 * g4) * 2);
    const int col = 128 * g + 16 * wave + 4 * g4;
    u32x2 uw[8]; float bias[8];
#pragma unroll
    for (int ti = 0; ti < 8; ++ti) { uw[ti] = *(const u32x2*)(ZA + (size_t)(r0 + 16 * ti + c) * NZA + C_SU + col); bias[ti] = p->sgu_b[(l * 4 + g) * 128 + 16 * ti + c]; }
#pragma unroll
    for (int ti = 0; ti < 8; ++ti) {
        f32x4 acc = (f32x4){0.f, 0.f, 0.f, 0.f};
#pragma unroll
        for (int ks = 0; ks < 4; ++ks) acc = mfma16(af[ks], *(const LAS bf16x8*)(WL + (16 * ti + c) * 272 + (32 * ks + 8 * g4) * 2), acc);
        const float o0 = gelu_tanh(bflo(uw[ti].x)) * (acc[0] + bias[ti]), o1 = gelu_tanh(bfhi(uw[ti].x)) * (acc[1] + bias[ti]), o2 = gelu_tanh(bflo(uw[ti].y)) * (acc[2] + bias[ti]), o3 = gelu_tanh(bfhi(uw[ti].y)) * (acc[3] + bias[ti]);
        u32x2 w; w.x = pk2(o0, o1); w.y = pk2(o2, o3); *(u32x2*)(BR + (size_t)(r0 + 16 * ti + c) * 512 + col) = w;
    }
    __syncthreads();
}

__device__ __forceinline__ void ret_load_k(KPC p, const bf16* ZA, int r0, int h, bool latent, int pos0, int tid, float (&a)[8], float (&bb)[8]) {
    const int j = tid >> 2, q4 = tid & 3; const bf16* src = ZA + (size_t)(r0 + j) * NZA + C_RK + 64 * h + 8 * q4;
    unpack8(*(const u32x4*)src, a); unpack8(*(const u32x4*)(src + 32), bb);
    if (latent) { const float* rc = (const float*)(p->ws + WS_ROPEC); const float* rsn = (const float*)(p->ws + WS_ROPES); const int pos = pos0 + j; float cs8[8], sn8[8]; ld8f(rc + pos * 32 + 8 * q4, cs8); ld8f(rsn + pos * 32 + 8 * q4, sn8);
#pragma unroll
        for (int e = 0; e < 8; ++e) { const float cs = cs8[e], sn = sn8[e]; const float x1 = a[e], x2 = bb[e]; a[e] = x1 * cs - x2 * sn; bb[e] = x1 * sn + x2 * cs; } }
#pragma unroll
    for (int e = 0; e < 8; ++e) { a[e] *= 0.125f; bb[e] *= 0.125f; }
}
__device__ __forceinline__ void ret_stage_vT(const bf16* ZA, int r0, int h, LAS unsigned char* vT, int tid) {
    const int j = tid >> 2, q4 = tid & 3; const bf16* src = ZA + (size_t)(r0 + j) * NZA + C_RV + 128 * h + 32 * q4;
#pragma unroll
    for (int q = 0; q < 4; ++q) { const u32x4 v = *(const u32x4*)(src + 8 * q); const unsigned vw[4] = {v.x, v.y, v.z, v.w};
#pragma unroll
        for (int e = 0; e < 4; ++e) { *(LAS unsigned short*)(vT + (32 * q4 + 8 * q + 2 * e) * 272 + j * 2) = (unsigned short)(vw[e] & 0xffffu); *(LAS unsigned short*)(vT + (32 * q4 + 8 * q + 2 * e + 1) * 272 + j * 2) = (unsigned short)(vw[e] >> 16); } }
}
__device__ __forceinline__ void ret_upd_block(KPC p, int l, LAS unsigned char* lds, int first, int stride, int total, int tid, int lane, int wave) {
    const bf16* ZA = (const bf16*)(p->ws + WS_ZA); bf16* RS = (bf16*)(p->ws + WS_RS);
    const float* rc = (const float*)(p->ws + WS_ROPEC); const float* rsn = (const float*)(p->ws + WS_ROPES);
    const int c = lane & 15, g4 = lane >> 4, tq = c >> 2, tp = c & 3, j = tid >> 2, q4 = tid & 3;
    LAS unsigned char* Vl = lds; LAS unsigned char* Kf = lds + 34816; LAS unsigned char* Kb = lds + 34816 + 18432;
    u32x4 k0, k1, v[4]; f32x4 c0, c1, s0, s1;
#define UPD_DECODE(it_) const int b = (it_) / (NCH * 4), rem = (it_) % (NCH * 4), n = rem >> 2, h = rem & 3; const bool latent = n < 32; const int r0 = latent ? b * T + 128 * n : ML + b * CL + 128 * (n - 32)
#define UPD_LOAD(it_) do { UPD_DECODE(it_); const bf16* ks = ZA + (size_t)(r0 + j) * NZA + C_RK + 64 * h + 8 * q4; k0 = *(const u32x4*)ks; k1 = *(const u32x4*)(ks + 32); \
        if (latent) { const int pos = 128 * n + j; c0 = *(const f32x4*)(rc + pos * 32 + 8 * q4); c1 = *(const f32x4*)(rc + pos * 32 + 8 * q4 + 4); s0 = *(const f32x4*)(rsn + pos * 32 + 8 * q4); s1 = *(const f32x4*)(rsn + pos * 32 + 8 * q4 + 4); } \
        const bf16* vs = ZA + (size_t)(r0 + j) * NZA + C_RV + 128 * h + 32 * q4; _Pragma("unroll") for (int q = 0; q < 4; ++q) v[q] = *(const u32x4*)(vs + 8 * q); } while (0)
    int it = first;
    if (it < total) UPD_LOAD(it);
    for (; it < total; it += stride) {
        UPD_DECODE(it); (void)r0;
        const float lgf = ((const float*)(p->ws + WS_LG))[l * 8 + h], lgb = ((const float*)(p->ws + WS_LG))[l * 8 + 4 + h];
        __syncthreads();
        {   float a[8], bb[8]; unpack8(k0, a); unpack8(k1, bb);
            if (latent) {
#pragma unroll
                for (int e = 0; e < 8; ++e) { const float cs = (e < 4) ? c0[e & 3] : c1[e & 3], sn = (e < 4) ? s0[e & 3] : s1[e & 3]; const float x1 = a[e], x2 = bb[e]; a[e] = x1 * cs - x2 * sn; bb[e] = x1 * sn + x2 * cs; } }
            const float wf = 0.125f * ex2((float)(127 - j) * lgf), wb = 0.125f * ex2((float)j * lgb);
            float af_[8], bf_[8], ab_[8], bb_[8];
#pragma unroll
            for (int e = 0; e < 8; ++e) { af_[e] = a[e] * wf; bf_[e] = bb[e] * wf; ab_[e] = a[e] * wb; bb_[e] = bb[e] * wb; }
            *(LAS u32x4*)(Kf + j * 144 + 16 * q4) = pack8(af_); *(LAS u32x4*)(Kf + j * 144 + 64 + 16 * q4) = pack8(bf_);
            *(LAS u32x4*)(Kb + j * 144 + 16 * q4) = pack8(ab_); *(LAS u32x4*)(Kb + j * 144 + 64 + 16 * q4) = pack8(bb_);
#pragma unroll
            for (int q = 0; q < 4; ++q) *(LAS u32x4*)(Vl + j * 272 + (32 * q4 + 8 * q) * 2) = v[q];
        }
        __syncthreads();
        if (it + stride < total) UPD_LOAD(it + stride);
        __builtin_amdgcn_sched_barrier(0);
        bf16x8 af[4];
#pragma unroll
        for (int ks = 0; ks < 4; ++ks) { const u32x2 v0 = lds_tr16(Vl + (32 * ks + 8 * g4 + tq) * 272 + (16 * wave + 4 * tp) * 2), v1 = lds_tr16(Vl + (32 * ks + 8 * g4 + 4 + tq) * 272 + (16 * wave + 4 * tp) * 2);
            u32x4 vv; vv.x = v0.x; vv.y = v0.y; vv.z = v1.x; vv.w = v1.y; af[ks] = as_bf16x8(vv); }
#pragma unroll
        for (int dir = 0; dir < 2; ++dir) { const LAS unsigned char* Kx = dir ? Kb : Kf;
            bf16* dst = RS + ((size_t)(((b * 4 + h) * 2 + dir) * NCH + n) * 128 + 16 * wave + c) * 64 + 4 * g4;
#pragma unroll
            for (int dt = 0; dt < 4; ++dt) { f32x4 acc = (f32x4){0.f, 0.f, 0.f, 0.f};
#pragma unroll
                for (int ks = 0; ks < 4; ++ks) { const u32x2 kk0 = lds_tr16(Kx + (32 * ks + 8 * g4 + tq) * 144 + (16 * dt + 4 * tp) * 2), kk1 = lds_tr16(Kx + (32 * ks + 8 * g4 + 4 + tq) * 144 + (16 * dt + 4 * tp) * 2);
                    u32x4 kv; kv.x = kk0.x; kv.y = kk0.y; kv.z = kk1.x; kv.w = kk1.y; acc = mfma16(as_bf16x8(kv), af[ks], acc); }
                float a0_ = acc[0], a1_ = acc[1], a2_ = acc[2], a3_ = acc[3];
                asm volatile("s_nop 7\n\ts_nop 7\n\ts_nop 3" : "+v"(a0_), "+v"(a1_), "+v"(a2_), "+v"(a3_));
                u32x2 w_; w_.x = pk2(a0_, a1_); w_.y = pk2(a2_, a3_); *(u32x2*)(dst + 16 * dt) = w_; } }
    }
#undef UPD_DECODE
#undef UPD_LOAD
    __syncthreads();
}
__device__ __forceinline__ void phase_scan(KPC p, int l, int tid, int bid, int G) {
    const bf16* __restrict__ RS = (const bf16*)(p->ws + WS_RS); bf16* __restrict__ ST = (bf16*)(p->ws + WS_ST);
    for (int idx = bid * 512 + tid; idx < NB * 4 * 2 * 4096; idx += G * 512) {
        const int ed2 = idx & 4095, dir = (idx >> 12) & 1, bh = idx >> 13, e = ed2 >> 5, d = (ed2 & 31) * 2, h = bh & 3;
        const bf16* P = RS + (size_t)((bh * 2 + dir) * NCH) * 8192 + e * 64 + d;
        bf16* S = ST + ((size_t)bh * NCH * 128 + e) * 128 + dir * 64 + d;
        const float lg = ((const float*)(p->ws + WS_LG))[l * 8 + dir * 4 + h]; const float dec = ex2(128.f * lg);
        unsigned u[NCH];
#pragma unroll
        for (int n = 0; n < NCH; ++n) u[n] = *(const unsigned*)(P + (size_t)n * 8192);
        if (dir == 0) {
            *(unsigned*)(S + 32 * 16384) = 0u; *(unsigned*)(S + 33 * 16384) = u[32];
            float s0 = dec * bflo(u[32]) + bflo(u[33]), s1 = dec * bfhi(u[32]) + bfhi(u[33]);
#pragma unroll
            for (int n = 0; n < 32; ++n) { *(unsigned*)(S + (size_t)n * 16384) = pk2(s0, s1); s0 = dec * s0 + bflo(u[n]); s1 = dec * s1 + bfhi(u[n]); }
        } else {
            *(unsigned*)(S + 33 * 16384) = 0u; *(unsigned*)(S + 32 * 16384) = u[33];
            float s0 = dec * bflo(u[33]) + bflo(u[32]), s1 = dec * bfhi(u[33]) + bfhi(u[32]);
#pragma unroll
            for (int n = 31; n >= 0; --n) { *(unsigned*)(S + (size_t)n * 16384) = pk2(s0, s1); s0 = dec * s0 + bflo(u[n]); s1 = dec * s1 + bfhi(u[n]); }
        }
    }
}
__device__ __forceinline__ void ret_out_item(KPC p, int l, LAS unsigned char* lds, int item, int tid, int lane, int wave) {
    const bf16* ZA = (const bf16*)(p->ws + WS_ZA); bf16* BR = (bf16*)p->out; const bf16* ST = (const bf16*)(p->ws + WS_ST);
    const int b = item / (NCH * 4), rem = item % (NCH * 4), n = rem >> 2, h = rem & 3, c = lane & 15, g4 = lane >> 4;
    const bool latent = n < 32; const int r0 = latent ? b * T + 128 * n : ML + b * CL + 128 * (n - 32);
    const float lgf = ((const float*)(p->ws + WS_LG))[l * 8 + h], lgb = ((const float*)(p->ws + WS_LG))[l * 8 + 4 + h];
    LAS unsigned char* vT = lds; LAS unsigned char* Kl = lds + 34816; LAS unsigned char* Sl = lds + 34816 + 18432;
    {   float a[8], bb[8]; ret_load_k(p, ZA, r0, h, latent, 128 * n, tid, a, bb);
        const int j = tid >> 2, q4 = tid & 3;
        *(LAS u32x4*)(Kl + j * 144 + 16 * q4) = pack8(a); *(LAS u32x4*)(Kl + j * 144 + 64 + 16 * q4) = pack8(bb);
        ret_stage_vT(ZA, r0, h, vT, tid);
        const u32x4* ssrc = (const u32x4*)(ST + (size_t)((b * 4 + h) * NCH + n) * 16384);
#pragma unroll
        for (int k = 0; k < 4; ++k) { const int q = tid + 512 * k; *(LAS u32x4*)(Sl + (q >> 4) * 272 + (q & 15) * 16) = ssrc[q]; }
    }
    __syncthreads();
    const int ii = 16 * wave + c;
    bf16x8 qf[2];
    {   const bf16* src = ZA + (size_t)(r0 + ii) * NZA + C_RQ + 64 * h + 8 * g4; float a[8], bb[8]; unpack8(*(const u32x4*)src, a); unpack8(*(const u32x4*)(src + 32), bb);
        if (latent) { const float* rc = (const float*)(p->ws + WS_ROPEC); const float* rsn = (const float*)(p->ws + WS_ROPES); const int pos = 128 * n + ii; float cs8[8], sn8[8]; ld8f(rc + pos * 32 + 8 * g4, cs8); ld8f(rsn + pos * 32 + 8 * g4, sn8);
#pragma unroll
            for (int e = 0; e < 8; ++e) { const float cs = cs8[e], sn = sn8[e]; const float x1 = a[e], x2 = bb[e]; a[e] = x1 * cs - x2 * sn; bb[e] = x1 * sn + x2 * cs; } }
        qf[0] = as_bf16x8(pack8(a)); qf[1] = as_bf16x8(pack8(bb)); }
    bf16x8 pf[4];
#pragma unroll
    for (int kk = 0; kk < 4; ++kk) {
        f32x4 sa = (f32x4){0.f, 0.f, 0.f, 0.f}, sb = (f32x4){0.f, 0.f, 0.f, 0.f};
        sa = mfma16(*(const LAS bf16x8*)(Kl + (32 * kk + c) * 144 + g4 * 16), qf[0], sa); sa = mfma16(*(const LAS bf16x8*)(Kl + (32 * kk + c) * 144 + 64 + g4 * 16), qf[1], sa);
        sb = mfma16(*(const LAS bf16x8*)(Kl + (32 * kk + 16 + c) * 144 + g4 * 16), qf[0], sb); sb = mfma16(*(const LAS bf16x8*)(Kl + (32 * kk + 16 + c) * 144 + 64 + g4 * 16), qf[1], sb);
        float pa[4], pb[4];
#pragma unroll
        for (int rr = 0; rr < 4; ++rr) { const int ja = 32 * kk + 4 * g4 + rr, jb = ja + 16; const int da = ii - ja, db = ii - jb;
            pa[rr] = sa[rr] * ((da >= 0) ? ex2((float)da * lgf) : ex2((float)(-da) * lgb)); pb[rr] = sb[rr] * ((db >= 0) ? ex2((float)db * lgf) : ex2((float)(-db) * lgb)); }
        u32x4 w; w.x = pk2(pa[0], pa[1]); w.y = pk2(pa[2], pa[3]); w.z = pk2(pb[0], pb[1]); w.w = pk2(pb[2], pb[3]); pf[kk] = as_bf16x8(w);
    }
    const float cf = ex2((float)(ii + 1) * lgf), cb = ex2((float)(128 - ii) * lgb);
    f32x4 O[8]; float s = 0.f, ss = 0.f;
#pragma unroll
    for (int et = 0; et < 8; ++et) {
        f32x4 acc = (f32x4){0.f, 0.f, 0.f, 0.f}, xf = (f32x4){0.f, 0.f, 0.f, 0.f}, xb = (f32x4){0.f, 0.f, 0.f, 0.f};
#pragma unroll
        for (int kk = 0; kk < 4; ++kk) { const u32x2 v0 = *(const LAS u32x2*)(vT + (16 * et + c) * 272 + (32 * kk + 4 * g4) * 2), v1 = *(const LAS u32x2*)(vT + (16 * et + c) * 272 + (32 * kk + 16 + 4 * g4) * 2);
            u32x4 vv; vv.x = v0.x; vv.y = v0.y; vv.z = v1.x; vv.w = v1.y; acc = mfma16(as_bf16x8(vv), pf[kk], acc); }
#pragma unroll
        for (int ks = 0; ks < 2; ++ks) { xf = mfma16(*(const LAS bf16x8*)(Sl + (16 * et + c) * 272 + (32 * ks + 8 * g4) * 2), qf[ks], xf);
            xb = mfma16(*(const LAS bf16x8*)(Sl + (16 * et + c) * 272 + (64 + 32 * ks + 8 * g4) * 2), qf[ks], xb); }
        acc = acc + xf * cf + xb * cb; O[et] = acc;
        s += (acc[0] + acc[1]) + (acc[2] + acc[3]); ss += (acc[0] * acc[0] + acc[1] * acc[1]) + (acc[2] * acc[2] + acc[3] * acc[3]);
    }
    s = sum_x16_x32(s); ss = sum_x16_x32(ss);
    const float mean = s * (1.f / 128.f), var = fmaxf(ss * (1.f / 128.f) - mean * mean, 0.f), rstd = rsq_(var + EPS);
    const bf16* gsrc = ZA + (size_t)(r0 + ii) * NZA + C_RG + 128 * h + 4 * g4; bf16* dst = BR + (size_t)(r0 + ii) * 512 + 128 * h + 4 * g4;
#pragma unroll
    for (int et = 0; et < 8; ++et) { const u32x2 gw = *(const u32x2*)(gsrc + 16 * et); const float g0 = bflo(gw.x), g1 = bfhi(gw.x), g2 = bflo(gw.y), g3 = bfhi(gw.y);
        const float o0 = (O[et][0] - mean) * rstd * g0 * sigmoidf_(g0), o1 = (O[et][1] - mean) * rstd * g1 * sigmoidf_(g1), o2 = (O[et][2] - mean) * rstd * g2 * sigmoidf_(g2), o3 = (O[et][3] - mean) * rstd * g3 * sigmoidf_(g3);
        u32x2 w; w.x = pk2(o0, o1); w.y = pk2(o2, o3); *(u32x2*)(dst + 16 * et) = w; }
    __syncthreads();
}
__device__ __forceinline__ void ret_out_block(KPC p, int l, LAS unsigned char* lds, int first, int stride, int total, int nch, int tid, int lane, int wave) {
    const bf16* ZA = (const bf16*)(p->ws + WS_ZA); bf16* BR = (bf16*)p->out; const bf16* ST = (const bf16*)(p->ws + WS_ST);
    const unsigned char* rcb = p->ws + WS_ROPEC;
    const int c = lane & 15, g4 = lane >> 4, tq = c >> 2, tp = c & 3, j = tid >> 2, q4 = tid & 3; const unsigned kob = (unsigned)(j * 128 + 32 * q4);
    LAS unsigned char* Vl = lds; LAS unsigned char* Kl = lds + 34816; LAS unsigned char* Sl = lds + 34816 + 18432;
    LAS float* DT = (LAS float*)(lds + 34816 + 18432 + 34816);
    u32x4 k0, k1, v[4];
#define RO_DECODE(it_) const int itx_ = ((it_) / (nch * 4)) * (NCH * 4) + (it_) % (nch * 4); const int b = itx_ / (NCH * 4), rem = itx_ % (NCH * 4), n = rem >> 2, h = rem & 3; const bool latent = n < 32; const int r0 = latent ? b * T + 128 * n : ML + b * CL + 128 * (n - 32)
#define RO_LOAD(it_) do { RO_DECODE(it_); (void)latent; const bf16* ks = ZA + (size_t)(r0 + j) * NZA + C_RK + 64 * h + 8 * q4; k0 = *(const u32x4*)ks; k1 = *(const u32x4*)(ks + 32); \
        const bf16* vs = ZA + (size_t)(r0 + j) * NZA + C_RV + 128 * h + 32 * q4; _Pragma("unroll") for (int q = 0; q < 4; ++q) v[q] = *(const u32x4*)(vs + 8 * q); \
        } while (0)
    int it = first;
    if (it < total) RO_LOAD(it);
    for (; it < total; it += stride) {
        RO_DECODE(it);
        const float lgf = ((const float*)(p->ws + WS_LG))[l * 8 + h], lgb = ((const float*)(p->ws + WS_LG))[l * 8 + 4 + h];
        __syncthreads();
        if (tid < 255) DT[tid] = (tid <= 127) ? ex2((float)(127 - tid) * lgf) : ex2((float)(tid - 127) * lgb);
        {   u32x4 st[4]; const u32x4* ssrc = (const u32x4*)(ST + (size_t)((b * 4 + h) * NCH + n) * 16384);
#pragma unroll
            for (int k = 0; k < 4; ++k) st[k] = ssrc[tid + 512 * k];
            float a[8], bb[8]; unpack8(k0, a); unpack8(k1, bb);
            if (latent) { const unsigned ob = (unsigned)n * 16384u + kob; float cs8[8], sn8[8]; ld8f((const float*)(rcb + ob), cs8); ld8f((const float*)(rcb + (ob + 524288u)), sn8);
#pragma unroll
                for (int e = 0; e < 8; ++e) { const float cs = cs8[e], sn = sn8[e]; const float x1 = a[e], x2 = bb[e]; a[e] = x1 * cs - x2 * sn; bb[e] = x1 * sn + x2 * cs; } }
#pragma unroll
            for (int e = 0; e < 8; ++e) { a[e] *= 0.125f; bb[e] *= 0.125f; }
            *(LAS u32x4*)(Kl + j * 144 + 16 * q4) = pack8(a); *(LAS u32x4*)(Kl + j * 144 + 64 + 16 * q4) = pack8(bb);
#pragma unroll
            for (int q = 0; q < 4; ++q) *(LAS u32x4*)(Vl + j * 272 + (32 * q4 + 8 * q) * 2) = v[q];
#pragma unroll
            for (int k = 0; k < 4; ++k) { const int q = tid + 512 * k; *(LAS u32x4*)(Sl + (q >> 4) * 272 + (q & 15) * 16) = st[k]; }
        }
        __syncthreads();
        const int ii = 16 * wave + c;
        const LAS float* dtl = DT + (127 - ii + 4 * g4);
        u32x4 qr0, qr1; f32x4 qc0, qc1, qs0, qs1;
        {   const bf16* src = ZA + (size_t)(r0 + ii) * NZA + C_RQ + 64 * h + 8 * g4; qr0 = *(const u32x4*)src; qr1 = *(const u32x4*)(src + 32);
            if (latent) { const unsigned ob = (unsigned)n * 16384u + (unsigned)(ii * 128 + 32 * g4); qc0 = *(const f32x4*)(rcb + ob); qc1 = *(const f32x4*)(rcb + (ob + 16u)); qs0 = *(const f32x4*)(rcb + (ob + 524288u)); qs1 = *(const f32x4*)(rcb + (ob + 524304u)); }
        }
        if (it + stride < total) RO_LOAD(it + stride);
        __builtin_amdgcn_sched_barrier(0);
        bf16x8 qf[2];
        {   float a[8], bb[8]; unpack8(qr0, a); unpack8(qr1, bb);
            if (latent) {
#pragma unroll
                for (int e = 0; e < 8; ++e) { const float cs = (e < 4) ? qc0[e & 3] : qc1[e & 3], sn = (e < 4) ? qs0[e & 3] : qs1[e & 3]; const float x1 = a[e], x2 = bb[e]; a[e] = x1 * cs - x2 * sn; bb[e] = x1 * sn + x2 * cs; } }
            qf[0] = as_bf16x8(pack8(a)); qf[1] = as_bf16x8(pack8(bb)); }
        bf16x8 pf[4];
#pragma unroll
        for (int kk = 0; kk < 4; ++kk) {
            f32x4 sa = (f32x4){0.f, 0.f, 0.f, 0.f}, sb = (f32x4){0.f, 0.f, 0.f, 0.f};
            sa = mfma16(*(const LAS bf16x8*)(Kl + (32 * kk + c) * 144 + g4 * 16), qf[0], sa); sa = mfma16(*(const LAS bf16x8*)(Kl + (32 * kk + c) * 144 + 64 + g4 * 16), qf[1], sa);
            sb = mfma16(*(const LAS bf16x8*)(Kl + (32 * kk + 16 + c) * 144 + g4 * 16), qf[0], sb); sb = mfma16(*(const LAS bf16x8*)(Kl + (32 * kk + 16 + c) * 144 + 64 + g4 * 16), qf[1], sb);
            float pa[4], pb[4];
#pragma unroll
            for (int rr = 0; rr < 4; ++rr) { pa[rr] = sa[rr] * dtl[32 * kk + rr]; pb[rr] = sb[rr] * dtl[32 * kk + 16 + rr]; }
            u32x4 w; w.x = pk2(pa[0], pa[1]); w.y = pk2(pa[2], pa[3]); w.z = pk2(pb[0], pb[1]); w.w = pk2(pb[2], pb[3]); pf[kk] = as_bf16x8(w);
        }
        const float cf = ex2((float)(ii + 1) * lgf), cb = ex2((float)(128 - ii) * lgb);
        f32x4 O[8]; float s = 0.f, ss = 0.f;
#pragma unroll
        for (int et = 0; et < 8; ++et) {
            f32x4 acc = (f32x4){0.f, 0.f, 0.f, 0.f}, xf = (f32x4){0.f, 0.f, 0.f, 0.f}, xb = (f32x4){0.f, 0.f, 0.f, 0.f};
#pragma unroll
            for (int kk = 0; kk < 4; ++kk) { const u32x2 v0 = lds_tr16(Vl + (32 * kk + 4 * g4 + tq) * 272 + (16 * et + 4 * tp) * 2), v1 = lds_tr16(Vl + (32 * kk + 16 + 4 * g4 + tq) * 272 + (16 * et + 4 * tp) * 2);
                u32x4 vv; vv.x = v0.x; vv.y = v0.y; vv.z = v1.x; vv.w = v1.y; acc = mfma16(as_bf16x8(vv), pf[kk], acc); }
#pragma unroll
            for (int ks = 0; ks < 2; ++ks) { xf = mfma16(*(const LAS bf16x8*)(Sl + (16 * et + c) * 272 + (32 * ks + 8 * g4) * 2), qf[ks], xf);
                xb = mfma16(*(const LAS bf16x8*)(Sl + (16 * et + c) * 272 + (64 + 32 * ks + 8 * g4) * 2), qf[ks], xb); }
            acc = acc + xf * cf + xb * cb; O[et] = acc;
            s += (acc[0] + acc[1]) + (acc[2] + acc[3]); ss += (acc[0] * acc[0] + acc[1] * acc[1]) + (acc[2] * acc[2] + acc[3] * acc[3]);
        }
        u32x2 gq[8];
        {   const bf16* gsrc = ZA + (size_t)(r0 + ii) * NZA + C_RG + 128 * h + 4 * g4;
#pragma unroll
            for (int et = 0; et < 8; ++et) gq[et] = *(const u32x2*)(gsrc + 16 * et); }
        s = sum_x16_x32(s); ss = sum_x16_x32(ss);
        const float mean = s * (1.f / 128.f), var = fmaxf(ss * (1.f / 128.f) - mean * mean, 0.f), rstd = rsq_(var + EPS);
        bf16* dst = BR + (size_t)(r0 + ii) * 512 + 128 * h + 4 * g4;
#pragma unroll
        for (int et = 0; et < 8; ++et) { const u32x2 gw = gq[et]; const float g0 = bflo(gw.x), g1 = bfhi(gw.x), g2 = bflo(gw.y), g3 = bfhi(gw.y);
            const float o0 = (O[et][0] - mean) * rstd * g0 * sigmoidf_(g0), o1 = (O[et][1] - mean) * rstd * g1 * sigmoidf_(g1), o2 = (O[et][2] - mean) * rstd * g2 * sigmoidf_(g2), o3 = (O[et][3] - mean) * rstd * g3 * sigmoidf_(g3);
            u32x2 w; w.x = pk2(o0, o1); w.y = pk2(o2, o3); *(u32x2*)(dst + 16 * et) = w; }
    }
#undef RO_DECODE
#undef RO_LOAD
    __syncthreads();
}

__device__ __forceinline__ int wr_off(int k) { return k * 64 + (k >> 2) * 16; }
__device__ __forceinline__ void phase_norm2_rows(KPC p, int l, LAS unsigned char* lds, int tid, int lane, int wave, int bid, int G) {
    LAS unsigned char* wrl = lds + 69632;
    for (int i = tid; i < 1024 * 4; i += 512) { const int k = i >> 2, q = i & 3; *(LAS f32x4*)(wrl + wr_off(k) + 16 * q) = *(const f32x4*)(p->w_router + (size_t)l * 16384 + k * 16 + 4 * q); }
    __syncthreads();
    const float* modv = (const float*)(p->ws + WS_MODV) + l * 9 * 6144; const bf16* X = (const bf16*)(p->ws + WS_X); bf16* H = (bf16*)(p->ws + WS_H);
    float* AFF = (float*)(p->ws + WS_AFF); float* AFFC = (float*)(p->ws + WS_AFFC); int* INV = (int*)(p->ws + WS_INV);
    const int rows = (l == 0) ? M : ML, stride = G * 8;
    {
    int r = bid * 8 + wave;
    u32x2 vn[4];
#pragma unroll
    for (int j = 0; j < 4; ++j) vn[j] = (r < rows) ? *(const u32x2*)(X + (size_t)r * 1024 + 4 * lane + 256 * j) : (u32x2){0u, 0u};
    for (; r < rows; r += stride) {
        const int bi = (r < ML) ? (r >> 12) : 8; const float* mv = modv + bi * 6144;
        f32x4 v[4], h[4], g[4], sc[4], sh[4];
#pragma unroll
        for (int j = 0; j < 4; ++j) { v[j] = (f32x4){bflo(vn[j].x), bfhi(vn[j].x), bflo(vn[j].y), bfhi(vn[j].y)}; const int col = 4 * lane + 256 * j; g[j] = *(const f32x4*)(p->norm2_g + l * 1024 + col); sh[j] = *(const f32x4*)(mv + 3 * 1024 + col); sc[j] = *(const f32x4*)(mv + 4 * 1024 + col); }
        const int rn = r + stride;
        if (rn < rows) {
#pragma unroll
            for (int j = 0; j < 4; ++j) vn[j] = *(const u32x2*)(X + (size_t)rn * 1024 + 4 * lane + 256 * j); }
        const float rs = row_rs(v);
#pragma unroll
        for (int j = 0; j < 4; ++j) h[j] = (v[j] * rs) * g[j] * (sc[j] + 1.0f) + sh[j];
        store_h(h, H + (size_t)r * 1024, lane);
        float lg[16];
#pragma unroll
        for (int e = 0; e < 16; ++e) lg[e] = 0.f;
#pragma unroll
        for (int j = 0; j < 4; ++j)
#pragma unroll
            for (int i = 0; i < 4; ++i) { const int k = 4 * lane + 256 * j + i; const float hv = h[j][i]; const LAS f32x4* wp = (const LAS f32x4*)(wrl + wr_off(k));
#pragma unroll
                for (int q = 0; q < 4; ++q) { const f32x4 w = wp[q]; lg[4 * q] += hv * w.x; lg[4 * q + 1] += hv * w.y; lg[4 * q + 2] += hv * w.z; lg[4 * q + 3] += hv * w.w; } }
        float mx = -1e30f;
#pragma unroll
        for (int e = 0; e < 16; ++e) { lg[e] = wave_sum(lg[e]); mx = fmaxf(mx, lg[e]); }
        float sum = 0.f;
#pragma unroll
        for (int e = 0; e < 16; ++e) { lg[e] = ex2((lg[e] - mx) * LOG2E); sum += lg[e]; }
        const float isum = rcp_(sum); float mine = 0.f;
#pragma unroll
        for (int e = 0; e < 16; ++e) mine = (lane == e) ? lg[e] * isum : mine;
        if (lane < 16) { if (r < ML) AFF[((size_t)(bi * 16 + lane) << 12) + (r & 4095)] = mine; else AFFC[((r - ML) >> 8) * 4096 + lane * 256 + ((r - ML) & 255)] = mine;
            INV[(size_t)r * 16 + lane] = -1; }
    }
    }
}

constexpr int N2_WS = 1032;
__device__ __forceinline__ void norm2_batch(KPC p, int l, int R0, int nrows, int bi, const LAS float* GSv, const LAS float* SHv, const LAS bf16* WH, const LAS bf16* WL, int lane) {
    const bf16* X = (const bf16*)(p->ws + WS_X); bf16* H = (bf16*)(p->ws + WS_H);
    const int r = lane & 15, kq = lane >> 4; const bool valid = r < nrows;
    const bf16* xr = X + (size_t)(R0 + (valid ? r : 0)) * 1024 + 8 * kq; bf16* hr = H + (size_t)(R0 + r) * 1024 + 8 * kq;
    u32x4 xv[32];
#pragma unroll
    for (int s = 0; s < 32; ++s) xv[s] = *(const u32x4*)(xr + 32 * s);
    float ss = 0.f;
#pragma unroll
    for (int s = 0; s < 32; ++s) { float f[8]; unpack8(xv[s], f);
#pragma unroll
        for (int j = 0; j < 8; ++j) ss += f[j] * f[j]; }
    const float rs = rsq_(sum_x16_x32(ss) * (1.f / 1024.f) + EPS);
    f32x4 acc = (f32x4){0.f, 0.f, 0.f, 0.f};
#pragma unroll
    for (int s = 0; s < 32; ++s) { const int k0 = 32 * s + 8 * kq;
        asm volatile("" : "+v"(xv[s]));
        float f[8], hv[8], hf[8]; unpack8(xv[s], f);
        const f32x4 ga = *(const LAS f32x4*)(GSv + k0), gb = *(const LAS f32x4*)(GSv + k0 + 4), sa = *(const LAS f32x4*)(SHv + k0), sb = *(const LAS f32x4*)(SHv + k0 + 4);
#pragma unroll
        for (int j = 0; j < 4; ++j) { hv[j] = (f[j] * rs) * ga[j] + sa[j]; hv[4 + j] = (f[4 + j] * rs) * gb[j] + sb[j]; }
        const u32x4 hi = pack8(hv);
        if (valid) *(u32x4*)(hr + 32 * s) = hi;
        unpack8(hi, hf);
#pragma unroll
        for (int j = 0; j < 8; ++j) hv[j] -= hf[j];
        const u32x4 lo = pack8(hv);
        const bf16x8 bh = *(const LAS bf16x8*)(WH + r * N2_WS + k0), bl = *(const LAS bf16x8*)(WL + r * N2_WS + k0);
        acc = mfma16(as_bf16x8(hi), bh, acc); acc = mfma16(as_bf16x8(hi), bl, acc); acc = mfma16(as_bf16x8(lo), bh, acc);
        __builtin_amdgcn_sched_barrier(0);
    }
    float af[4];
#pragma unroll
    for (int rr = 0; rr < 4; ++rr) { const float m = row_max(acc[rr]); const float e = ex2((acc[rr] - m) * LOG2E); af[rr] = e * rcp_(row_sum(e)); }
    float* AFF = (float*)(p->ws + WS_AFF); float* AFFC = (float*)(p->ws + WS_AFFC); int* INV = (int*)(p->ws + WS_INV);
    if (R0 < ML) { if (nrows == 16) *(f32x4*)(AFF + ((size_t)(bi * 16 + r) << 12) + (R0 & 4095) + 4 * kq) = (f32x4){af[0], af[1], af[2], af[3]};
        else {
#pragma unroll
            for (int rr = 0; rr < 4; ++rr) if (4 * kq + rr < nrows) AFF[((size_t)(bi * 16 + r) << 12) + (R0 & 4095) + 4 * kq + rr] = af[rr]; } }
    else {
#pragma unroll
        for (int rr = 0; rr < 4; ++rr) { const int t = R0 - ML + 4 * kq + rr; if (4 * kq + rr < nrows) AFFC[(t >> 8) * 4096 + r * 256 + (t & 255)] = af[rr]; } }
    unsigned m1 = 0xffffffffu; asm volatile("" : "+v"(m1));
    if ((lane >> 2) < nrows) *(u32x4*)(INV + (size_t)(R0 + (lane >> 2)) * 16 + 4 * (lane & 3)) = (u32x4){m1, m1, m1, m1};
}
__device__ __forceinline__ void phase_norm2(KPC p, int l, LAS unsigned char* lds, int tid, int lane, int wave, int bid, int G) {
    if (G != 256) { phase_norm2_rows(p, l, lds, tid, lane, wave, bid, G); return; }
    LAS bf16* WH = (LAS bf16*)lds; LAS bf16* WL = WH + 16 * N2_WS;
    LAS float* GS = (LAS float*)(lds + 4 * 16 * N2_WS); LAS float* SH = GS + 1024; LAS float* GS8 = SH + 1024; LAS float* SH8 = GS8 + 1024;
    {   float wv[32];
        const float* wsrc = p->w_router + (size_t)l * 16384 + tid;
#pragma unroll
        for (int q = 0; q < 32; ++q) wv[q] = wsrc[512 * q];
        const float* modv = (const float*)(p->ws + WS_MODV) + l * 9 * 6144; const int bi = bid >> 5;
        float gq[2], sc0[2], sh0[2], sc8[2], sh8[2];
#pragma unroll
        for (int q = 0; q < 2; ++q) { const int k = tid + 512 * q; gq[q] = p->norm2_g[l * 1024 + k]; sc0[q] = modv[bi * 6144 + 4 * 1024 + k]; sh0[q] = modv[bi * 6144 + 3 * 1024 + k];
            sc8[q] = modv[8 * 6144 + 4 * 1024 + k]; sh8[q] = modv[8 * 6144 + 3 * 1024 + k]; }
#pragma unroll
        for (int q = 0; q < 32; ++q) { const int i = tid + 512 * q, k = i >> 4, e = i & 15; const float w = wv[q];
            const unsigned hi = pk2(w, 0.f) & 0xffffu; const float lo = w - __uint_as_float(hi << 16);
            WH[e * N2_WS + k] = (bf16)hi; WL[e * N2_WS + k] = (bf16)(pk2(lo, 0.f) & 0xffffu); }
#pragma unroll
        for (int q = 0; q < 2; ++q) { const int k = tid + 512 * q; GS[k] = gq[q] * (sc0[q] + 1.0f); SH[k] = sh0[q]; GS8[k] = gq[q] * (sc8[q] + 1.0f); SH8[k] = sh8[q]; }
    }
    __syncthreads();
    norm2_batch(p, l, 16 * (bid * 8 + wave), 16, bid >> 5, GS, SH, WH, WL, lane);
    if (l == 0 && bid < 128) norm2_batch(p, l, ML + 16 * bid + 2 * wave, 2, 8, GS8, SH8, WH, WL, lane);
}

__device__ __forceinline__ int block_sum_i(int v, LAS int* red, int buf, int lane, int wave) {
    v = wave_sum_i(v);
    if (lane == 0) red[buf * 8 + wave] = v;
    __syncthreads();
    int s = 0;
#pragma unroll
    for (int w = 0; w < 8; ++w) s += red[buf * 8 + w];
    return s;
}
__device__ __forceinline__ void block_sum_i2(int& v0, int& v1, LAS int* red2, int buf, int lane, int wave) {
    v0 = wave_sum_i(v0); v1 = wave_sum_i(v1);
    if (lane == 0) { red2[buf * 16 + wave] = v0; red2[buf * 16 + 8 + wave] = v1; }
    __syncthreads();
    int s0 = 0, s1 = 0;
#pragma unroll
    for (int w = 0; w < 8; ++w) { s0 += red2[buf * 16 + w]; s1 += red2[buf * 16 + 8 + w]; }
    v0 = s0; v1 = s1;
}
__device__ __forceinline__ int block_excl_scan(int v, LAS int* red, int buf, int lane, int wave) {
    int inc = v;
#pragma unroll
    for (int o = 1; o < 64; o <<= 1) { const int t = __builtin_amdgcn_ds_bpermute((lane - o) << 2, inc); if (lane >= o) inc += t; }
    if (lane == 63) red[buf * 8 + wave] = inc;
    __syncthreads();
    int base = 0;
#pragma unroll
    for (int w = 0; w < 8; ++w) { const int x = red[buf * 8 + w]; if (w < wave) base += x; }
    return base + inc - v;
}
template <int KPT>
__device__ __forceinline__ void topk_item(KPC p, const float* aff, int n, int cap, int rowbase, int e, int slotbase, LAS unsigned char* lds, int tid, int lane, int wave) {
    float* topw = (float*)(p->ws + WS_TOPW); int* INV = (int*)(p->ws + WS_INV); int* ROWL = (int*)(p->ws + WS_ROWL);
    LAS int* red = (LAS int*)lds;
    unsigned key[KPT]; const bool valid = tid * KPT < n;
#pragma unroll
    for (int j = 0; j < KPT; ++j) key[j] = valid ? __float_as_uint(aff[tid * KPT + j]) : 0u;
    unsigned Tsel = 0u; LAS int* red2 = red + 64;
    {   const unsigned cand = 1u << 30; int cnt = 0;
#pragma unroll
        for (int j = 0; j < KPT; ++j) cnt += (valid && key[j] >= cand) ? 1 : 0;
        if (block_sum_i(cnt, red, 0, lane, wave) >= cap) Tsel = cand; }
    for (int b = 28; b >= 0; b -= 2) { const unsigned c1 = Tsel | (1u << b), c2 = Tsel | (2u << b), c3 = Tsel | (3u << b); int n12 = 0, n3 = 0;
#pragma unroll
        for (int j = 0; j < KPT; ++j) { n12 += ((valid && key[j] >= c1) ? 1 : 0) + ((valid && key[j] >= c2) ? 65536 : 0); n3 += (valid && key[j] >= c3) ? 1 : 0; }
        block_sum_i2(n12, n3, red2, (b >> 1) & 1, lane, wave);
        const int n1 = n12 & 0xffff, n2 = n12 >> 16;
        Tsel = (n3 >= cap) ? c3 : (n2 >= cap) ? c2 : (n1 >= cap) ? c1 : Tsel; }
    int cgt = 0, ceq = 0;
#pragma unroll
    for (int j = 0; j < KPT; ++j) { cgt += (valid && key[j] > Tsel) ? 1 : 0; ceq += (valid && key[j] == Tsel) ? 1 : 0; }
    const int need = cap - block_sum_i(cgt, red, 1, lane, wave);
    int er = block_excl_scan(ceq, red, 2, lane, wave);
    bool sel[KPT]; int nsel = 0;
#pragma unroll
    for (int j = 0; j < KPT; ++j) { const bool iseq = valid && key[j] == Tsel; sel[j] = valid && (key[j] > Tsel || (iseq && er < need)); er += iseq ? 1 : 0; nsel += sel[j] ? 1 : 0; }
    int slot = block_excl_scan(nsel, red, 3, lane, wave);
#pragma unroll
    for (int j = 0; j < KPT; ++j) if (sel[j]) { const int t = tid * KPT + j; if (slot < cap) { topw[e * ME + slotbase + slot] = __uint_as_float(key[j]); INV[(size_t)(rowbase + t) * 16 + e] = slotbase + slot; ROWL[e * ME + slotbase + slot] = (rowbase + t) * 2048; } ++slot; }
    __syncthreads();
}
__device__ __forceinline__ void phase_topk(KPC p, int l, LAS unsigned char* lds, int tid, int lane, int wave, int bid, int G) {
    const float* AFF = (const float*)(p->ws + WS_AFF); const float* AFFC = (const float*)(p->ws + WS_AFFC);
    const int nitem = (l == 0) ? 256 : 128;
    for (int it = bid; it < nitem; it += G) {
        if (it < 128) { const int b = it >> 4, e = it & 15; topk_item<8>(p, AFF + ((size_t)(b * 16 + e) << 12), 4096, CAPL, b * T, e, b * CAPL, lds, tid, lane, wave); }
        else { const int q = it - 128, b = q >> 4, e = q & 15; topk_item<1>(p, AFFC + (b * 16 + e) * 256, 256, CAPC, ML + b * CL, e, NB * CAPL + b * CAPC, lds, tid, lane, wave); }
    }
    if (l == 0 && G == 256 && bid >= 128) convert_small(p, 1, lds, lane, wave, bid - 128, 128);
    if (l == 0) (void)convert_list<0>(p, nullptr, 0u, lds, tid, lane, wave);
    else if (G != 256 || bid >= 128) { (void)convert_list<1>(p, nullptr, 0u, lds, tid, lane, wave); (void)convert_list<2>(p, nullptr, 0u, lds, tid, lane, wave); }
}

__device__ __forceinline__ void phase_combine(KPC p, int l, LAS unsigned char* lds, int tid, int lane, int wave, int bid, int G) {
    const float* modv = (const float*)(p->ws + WS_MODV); bf16* X = (bf16*)(p->ws + WS_X); bf16* H = (bf16*)(p->ws + WS_H);
    const bf16* Y = (const bf16*)(p->ws + WS_XS); const int* INV = (const int*)(p->ws + WS_INV);
    const int rows = (l == 0) ? M : ML, stride = G * 8;
    int r = bid * 8 + wave;
#define CMB_LOAD(row_, slot_, x_, y_, cnt_, rest_) do { unsigned m_ = (unsigned)(__builtin_amdgcn_ballot_w64((slot_) >= 0) & 0xffffull); const int np_ = __builtin_popcount(m_); cnt_ = np_ < 4 ? np_ : 4; \
        _Pragma("unroll") for (int k_ = 0; k_ < 4; ++k_) if (k_ < np_) { const int e_ = __builtin_ctz(m_); m_ &= m_ - 1u; const int s_ = __builtin_amdgcn_readlane((slot_), e_); const bf16* yr_ = Y + ((size_t)e_ * ME + s_) * 1024 + 4 * lane; \
            _Pragma("unroll") for (int j_ = 0; j_ < 4; ++j_) y_[k_][j_] = *(const u32x2*)(yr_ + 256 * j_); } \
        rest_ = m_; _Pragma("unroll") for (int j_ = 0; j_ < 4; ++j_) x_[j_] = *(const u32x2*)(X + (size_t)(row_) * 1024 + 4 * lane + 256 * j_); } while (0)
    int slotA = (lane < 16 && r < rows) ? INV[(size_t)r * 16 + lane] : -1;
    int slotB = (lane < 16 && r + stride < rows) ? INV[(size_t)(r + stride) * 16 + lane] : -1;
    u32x2 xa[4], ya[4][4]; int cntA = 0; unsigned restA = 0u;
    if (r < rows) CMB_LOAD(r, slotA, xa, ya, cntA, restA);
    for (; r < rows; r += stride) {
        const int bi = (r < ML) ? (r >> 12) : 8;
        const int rn = r + stride, rnn = rn + stride;
        const int slotC = (lane < 16 && rnn < rows) ? INV[(size_t)rnn * 16 + lane] : -1;
        u32x2 xb[4], yb[4][4]; int cntB = 0; unsigned restB = 0u;
        if (rn < rows) CMB_LOAD(rn, slotB, xb, yb, cntB, restB);
        f32x4 v[4], acc[4], g2v[4];
        const float* g2 = modv + (l * 9 + bi) * 6144 + 5 * 1024;
#pragma unroll
        for (int j = 0; j < 4; ++j) { v[j] = (f32x4){bflo(xa[j].x), bfhi(xa[j].x), bflo(xa[j].y), bfhi(xa[j].y)}; acc[j] = (f32x4){0.f, 0.f, 0.f, 0.f}; g2v[j] = *(const f32x4*)(g2 + 4 * lane + 256 * j); }
#pragma unroll
        for (int k = 0; k < 4; ++k) if (k < cntA) {
#pragma unroll
            for (int j = 0; j < 4; ++j) acc[j] += (f32x4){bflo(ya[k][j].x), bfhi(ya[k][j].x), bflo(ya[k][j].y), bfhi(ya[k][j].y)}; }
        while (restA) { const int e = __builtin_ctz(restA); restA &= restA - 1u; const int s = __builtin_amdgcn_readlane(slotA, e); const bf16* yr = Y + ((size_t)e * ME + s) * 1024 + 4 * lane;
            u32x2 w[4];
#pragma unroll
            for (int j = 0; j < 4; ++j) w[j] = *(const u32x2*)(yr + 256 * j);
#pragma unroll
            for (int j = 0; j < 4; ++j) acc[j] += (f32x4){bflo(w[j].x), bfhi(w[j].x), bflo(w[j].y), bfhi(w[j].y)}; }
#pragma unroll
        for (int j = 0; j < 4; ++j) v[j] = v[j] + g2v[j] * acc[j];
        if (l == 0) {
#pragma unroll
            for (int j = 0; j < 4; ++j) { u32x2 w; w.x = pk2(v[j].x, v[j].y); w.y = pk2(v[j].z, v[j].w); *(u32x2*)(X + (size_t)r * 1024 + 4 * lane + 256 * j) = w; }
            const float rs = row_rs(v); f32x4 h[4];
            norm_mod(v, rs, p->norm1_g + 1024, modv + (9 + bi) * 6144, modv + (9 + bi) * 6144 + 1024, h, lane);
            store_h(h, H + (size_t)r * 1024, lane);
        } else {
#pragma unroll
            for (int j = 0; j < 4; ++j) *(f32x4*)(p->out + (size_t)r * 1024 + 4 * lane + 256 * j) = v[j];
        }
#pragma unroll
        for (int j = 0; j < 4; ++j) { xa[j] = xb[j];
#pragma unroll
            for (int k = 0; k < 4; ++k) ya[k][j] = yb[k][j]; }
        cntA = cntB; restA = restB; slotA = slotB; slotB = slotC;
    }
#undef CMB_LOAD
    if (l == 0 && G != 256) convert_small(p, 1, lds, lane, wave, bid, G);
}

#define XB_TMO      128
#define XB_XCNT(j)  (256  + 64 * (j))
#define XB_XSUB(j)  (1280 + 64 * (j))
#define XB_XGEN(j)  (2304 + 64 * (j))
#define XB_TOP      3328
#define XB_TOPGEN   3392
#define XCD_BAR_WORDS 3456
#define XB_SPIN_CAP (1u << 18)

__device__ __forceinline__ unsigned xb_ld(unsigned* p)              { return __hip_atomic_load(p, __ATOMIC_RELAXED, __HIP_MEMORY_SCOPE_AGENT); }
__device__ __forceinline__ unsigned xb_add(unsigned* p, unsigned v) { return __hip_atomic_fetch_add(p, v, __ATOMIC_RELAXED, __HIP_MEMORY_SCOPE_AGENT); }
__device__ __forceinline__ unsigned xb_xcc_id() { return (unsigned)__builtin_amdgcn_s_getreg((3 << 11) | 20) & 0xFu; }
#define XB_SPIN(cond, bar) do { unsigned _sp = 0; while (cond) { __builtin_amdgcn_s_sleep(1); \
    if ((++_sp & 255u) == 0u) { if (xb_ld(&(bar)[XB_TMO])) break; if (_sp > XB_SPIN_CAP) { atomicAdd(&(bar)[XB_TMO], 1u); break; } } } } while (0)

struct XcdBarrier {
    unsigned* bar; unsigned x; bool t0;
    volatile LAS unsigned* st;
};

__device__ __forceinline__ XcdBarrier xcd_barrier_post(unsigned* bar, volatile LAS unsigned* st) {
    XcdBarrier b; b.bar = bar; b.x = xb_xcc_id(); b.st = st; b.t0 = (threadIdx.x == 0);
    if (threadIdx.x == 0) (void)xb_add(&bar[XB_XCNT(b.x)], 1u);
    return b;
}
__device__ __forceinline__ void xcd_barrier_complete(unsigned* bar, unsigned x, unsigned& nloc, unsigned& nx) {
    const unsigned G = gridDim.x * gridDim.y * gridDim.z;
    unsigned sum, cnt, mine, sp = 0u;
    for (;;) {
        sum = 0u; cnt = 0u; mine = 0u;
#pragma unroll
        for (unsigned j = 0; j < 16; ++j) { const unsigned c = xb_ld(&bar[XB_XCNT(j)]); sum += c; cnt += (c > 0u) ? 1u : 0u; mine = (j == x) ? c : mine; }
        if (sum == G) break;
        __builtin_amdgcn_s_sleep(1);
        if ((++sp & 255u) == 0u) { if (xb_ld(&bar[XB_TMO])) break; if (sp > XB_SPIN_CAP) { atomicAdd(&bar[XB_TMO], 1u); break; } }
    }
    nloc = mine > 0u ? mine : 1u; nx = cnt > 0u ? cnt : 1u;
}

__device__ __forceinline__ void xcd_barrier(const XcdBarrier& b) {
    asm volatile("s_waitcnt vmcnt(0)" ::: "memory");
    __syncthreads();
    if (b.t0) {
        unsigned* bar = b.bar;
        __builtin_amdgcn_s_waitcnt(0);
        unsigned nloc = b.st[0], nx = b.st[1];
        if (nloc == 0u) { xcd_barrier_complete(bar, b.x, nloc, nx); b.st[0] = nloc; b.st[1] = nx; }
        const unsigned old = xb_add(&bar[XB_XSUB(b.x)], 1u);
        const unsigned gen = old / nloc;
        if (old + 1u == (gen + 1u) * nloc) {
            __builtin_amdgcn_fence(__ATOMIC_RELEASE, "agent");
            asm volatile("s_waitcnt vmcnt(0)" ::: "memory");
            const unsigned og = xb_add(&bar[XB_TOP], 1u);
            const unsigned tg = og / nx;
            if (og + 1u == (tg + 1u) * nx) xb_add(&bar[XB_TOPGEN], 1u);
            else XB_SPIN(xb_ld(&bar[XB_TOPGEN]) == tg, bar);
            __builtin_amdgcn_fence(__ATOMIC_ACQUIRE, "agent");
            xb_add(&bar[XB_XGEN(b.x)], 1u);
            asm volatile("s_waitcnt vmcnt(0)" ::: "memory");
        } else {
            XB_SPIN(xb_ld(&bar[XB_XGEN(b.x)]) == gen, bar);
            __builtin_amdgcn_fence(__ATOMIC_ACQUIRE, "agent");
            asm volatile("s_waitcnt vmcnt(0)" ::: "memory");
        }
    }
    __syncthreads();
}

#define KPP() ({ KPC q_ = kp_; asm volatile("" : "+s"(q_)); q_; })
__global__ void __launch_bounds__(512, 2) mk_fwd(KP p_unused) {
    extern __shared__ __attribute__((aligned(16))) unsigned char lds_raw[];
    LAS unsigned char* lds = (LAS unsigned char*)lds_raw;
    cg::grid_group grid = cg::this_grid();
    const int bid = blockIdx.x, G = gridDim.x, w0_ = __builtin_amdgcn_readfirstlane((int)threadIdx.x >> 6);
#define TID0() ({ int w_ = w0_ << 6; asm volatile("" : "+s"(w_)); (int)__builtin_amdgcn_mbcnt_hi(~0u, __builtin_amdgcn_mbcnt_lo(~0u, (unsigned)w_)); })
#define BL() ({ int b_ = bid; asm volatile("" : "+s"(b_)); b_; })
#define GL() ({ int g_ = G; asm volatile("" : "+s"(g_)); g_; })
#define IDS() int tid = TID0(); asm volatile("" : "+v"(tid)); const int lane = tid & 63, wave = __builtin_amdgcn_readfirstlane(tid >> 6); (void)lane; (void)wave
    const KPC kp_ = (KPC)__builtin_amdgcn_kernarg_segment_ptr();
    volatile LAS unsigned* bst = (volatile LAS unsigned*)(lds + 147392);
    if (threadIdx.x < 16) bst[threadIdx.x] = 0u;
    __syncthreads();
    (void)xcd_barrier_post((unsigned*)KPP()->ws, bst);
#define GSYNC() do { XcdBarrier b_; b_.bar = (unsigned*)KPP()->ws; b_.x = xb_xcc_id(); b_.st = bst; b_.t0 = (TID0() == 0); xcd_barrier(b_); } while (0)

    { IDS(); phase_prep(KPP(), lds, tid, lane, wave, bid, G); }
    if (G == 0x7fffffff) grid.sync();
    GSYNC();
    { IDS(); phase_norm_in(KPP(), lane, wave, bid, G); }
    GSYNC();
#pragma unroll 1
    for (int l = 0; l < 2; ++l) {
        {
            unsigned char* ws = KPP()->ws;
            pg8::Gemm g{(const pg8::bf16_t*)(ws + WS_H), (const pg8::bf16_t*)(ws + WS_WTIN), M, NZA, 1024}; GroupOrder S{1, M / 256, NZA / 256, 0, 0, GL(), BL()};
            EpiZA E{(bf16*)(ws + WS_ZA)};
            pg8::gemm_phase<EpiZA, GroupOrder, true, true>(lds, g, S, E, TID0());
        }
        GSYNC();
        {
            const int natt = (l == 0) ? 544 : 512, nupd = NB * NCH * 4, nvp = (l == 0) ? (M / 128) : (ML / 128);
            {   KPC p = KPP(); IDS();
                float mq = fabsf(p->qn_g[l * 64 + lane]), mk = fabsf(p->kn_g[l * 64 + lane]);
                mq = wave_max(mq); mk = wave_max(mk);
                const float Mb2 = 8.0f * mq * mk * LOG2E;
                for (int it = BL(); it < natt; it += GL()) att_item(p, l, lds, it, Mb2, tid, lane, wave); }
            const int nx = natt % GL();
            { KPC p = KPP(); IDS(); ret_upd_block(p, l, lds, BL() >= nx ? BL() - nx : nupd, GL() - nx, nupd, tid, lane, wave); }
            { KPC p = KPP(); IDS(); for (int it = BL(); it < nvp; it += GL()) { sgu_vprep_item(p, it, tid); } }
        }
        GSYNC();
        { IDS(); phase_scan(KPP(), l, tid, BL(), GL()); }
        GSYNC();
        {   const int nch = (l == 0) ? NCH : 32;
            const int nro = NB * nch * 4, nsgu = ((l == 0) ? (M / 128) : (ML / 128)) * 4;
            { KPC p = KPP(); IDS(); ret_out_block(p, l, lds, (BL() + GL() - 4 * ((nsgu >> 2) % (GL() >> 2))) % GL(), GL(), nro, nch, tid, lane, wave); }
            {   KPC p = KPP(); IDS();
                if ((GL() & 3) == 0) sgu_block(p, l, lds, nsgu >> 2, tid, lane, wave, BL(), GL());
                else for (int it = BL(); it < nsgu; it += GL()) sgu_item(p, l, lds, it, tid, lane, wave); }
        }
        GSYNC();
        const int Mrows = (l == 0) ? M : ML;
        {
            unsigned char* ws = KPP()->ws;
            pg8::Gemm g{(const pg8::bf16_t*)(ws + WS_H), (const pg8::bf16_t*)(ws + WS_WTIN) + (size_t)NZA * 1024, Mrows, NZG, 1024}; GroupOrder S{1, Mrows / 256, NZG / 256, 0, 0, GL(), BL()};
            EpiSig E{ws + WS_G};
            pg8::gemm_phase<EpiSig, GroupOrder, true, true>(lds, g, S, E, TID0());
            if (l == 0 && GL() == 256) { if (BL() >= CVT_G_IDLE0) { IDS(); convert_tail(KPP(), DYN_DONE_G, (unsigned)CVT_G_IDLE0, lds, tid, lane, wave); } else if (TID0() == 0) (void)dyn_add(dyn_word(KPP(), DYN_DONE_G), 1u); }
        }
        GSYNC();
        {
            KPC p = KPP(); unsigned char* ws = p->ws;
            pg8::Gemm g{(const pg8::bf16_t*)p->out, (const pg8::bf16_t*)(ws + WS_WTBR), 3 * M, 3072, 512}; MergeOrder S{Mrows / 256, GL(), BL()};
            EpiMergeChain E{ws + WS_G, (bf16*)(ws + WS_H)};
            pg8::gemm_phase<EpiMergeChain, MergeOrder, true, true>(lds, g, S, E, TID0());
            if (l == 0 && GL() == 256) { if (BL() >= CVT_M_IDLE0) { IDS(); convert_tail(KPP(), DYN_DONE_M, (unsigned)CVT_M_IDLE0, lds, tid, lane, wave); } else if (TID0() == 0) (void)dyn_add(dyn_word(KPP(), DYN_DONE_M), 1u); }
        }
        GSYNC();
        {
            KPC p = KPP(); unsigned char* ws = p->ws;
            pg8::Gemm g{(const pg8::bf16_t*)(ws + WS_H), (const pg8::bf16_t*)(ws + WS_WTOUT), Mrows, 1024, 1024}; GroupOrder S{1, Mrows / 256, 4, 0, 0, GL(), BL()};
            EpiOut E{p->x, p->ctx, (bf16*)(ws + WS_X), (const float*)(ws + WS_MODV) + l * 9 * 6144, (l == 0) ? 1 : 0};
            pg8::gemm_phase<EpiOut, GroupOrder, true, true>(lds, g, S, E, TID0());
            if (l == 0 && GL() == 256) { if (BL() >= CVT_O_IDLE0) { IDS(); convert_tail(KPP(), DYN_DONE_O, (unsigned)CVT_O_IDLE0, lds, tid, lane, wave); } else if (TID0() == 0) (void)dyn_add(dyn_word(KPP(), DYN_DONE_O), 1u); }
        }
        GSYNC();
        { IDS(); phase_norm2(KPP(), l, lds, tid, lane, wave, BL(), GL()); }
        GSYNC();
        { IDS(); phase_topk(KPP(), l, lds, tid, lane, wave, BL(), GL()); }
        GSYNC();
        {
            unsigned char* ws = KPP()->ws;
            pg8::Gemm g{(const pg8::bf16_t*)(ws + WS_H), (const pg8::bf16_t*)(ws + wt1_off(l)), NE * ME, NE * 2048, 1024, (const int*)(ws + WS_ROWL)}; GroupOrder S{NE, (l == 0) ? 17 : 16, 8, 17, 8, GL(), BL()};
            EpiMoe1 E{(bf16*)(ws + WS_ACT)};
            pg8::gemm_phase<EpiMoe1, GroupOrder, true, true, true>(lds, g, S, E, TID0());
            if (l == 0 && GL() == 256) { if (BL() >= CVT_E1_IDLE0) { IDS(); convert_tail(KPP(), DYN_DONE_E1, (unsigned)CVT_E1_IDLE0, lds, tid, lane, wave); } else if (TID0() == 0) (void)dyn_add(dyn_word(KPP(), DYN_DONE_E1), 1u); }
        }
        GSYNC();
        {
            KPC p = KPP(); unsigned char* ws = p->ws;
            pg8::Gemm g{(const pg8::bf16_t*)(ws + WS_ACT), (const pg8::bf16_t*)(ws + wt2_off(p, l)), NE * ME, NE * 1024, 1024}; GroupOrder S{NE, (l == 0) ? 17 : 16, 4, 17, 4, GL(), BL()};
            EpiMoe2 E{(bf16*)(ws + WS_XS), (const float*)(ws + WS_TOPW)};
            pg8::gemm_phase<EpiMoe2, GroupOrder, true, true>(lds, g, S, E, TID0());
            if (l == 0 && GL() == 256) { if (BL() >= CVT_E2_IDLE0) { IDS(); convert_tail(KPP(), DYN_DONE_E2, (unsigned)CVT_E2_IDLE0, lds, tid, lane, wave); } else if (TID0() == 0) (void)dyn_add(dyn_word(KPP(), DYN_DONE_E2), 1u); }
        }
        GSYNC();
        { IDS(); phase_combine(KPP(), l, lds, tid, lane, wave, BL(), GL()); }
        if (l == 0) GSYNC();
    }
}

extern "C" void kernel_launch(void* const* d_in, const int* in_sizes, int n_in, void* d_out, int out_size, void* d_ws, size_t ws_size, hipStream_t stream) {
    static int grid = 0;
    if (grid == 0) {
        if (n_in != 22 || out_size != ML * D || ws_size < WS_END) { fprintf(stderr, "kernel_launch: unexpected shapes (n_in %d out %d ws %zu, need %zu)\n", n_in, out_size, ws_size, (size_t)WS_END); grid = -1; return; }
        int dev = 0, cus = 0, per_cu = 0;
        if (hipGetDevice(&dev) != hipSuccess || hipDeviceGetAttribute(&cus, hipDeviceAttributeMultiprocessorCount, dev) != hipSuccess) { grid = -1; return; }
        if (hipFuncSetAttribute((const void*)mk_fwd, hipFuncAttributeMaxDynamicSharedMemorySize, LDS_BYTES) != hipSuccess) { fprintf(stderr, "kernel_launch: hipFuncSetAttribute failed\n"); grid = -1; return; }
        if (hipOccupancyMaxActiveBlocksPerMultiprocessor(&per_cu, (const void*)mk_fwd, 512, LDS_BYTES) != hipSuccess || per_cu < 1) { fprintf(stderr, "kernel_launch: occupancy query says %d\n", per_cu); (void)hipGetLastError(); }
        grid = cus;
        fprintf(stderr, "kernel_launch: grid %d, occupancy %d/CU, ws %zu\n", grid, per_cu, ws_size);
    }
    if (grid < 0) return;
    if (hipMemsetAsync(d_ws, 0, 16384, stream) != hipSuccess) { fprintf(stderr, "kernel_launch: memset failed\n"); return; }
    KP hp{};
    const float** f = (const float**)&hp;
    for (int i = 0; i < 22; ++i) f[i] = (const float*)d_in[i];
    hp.out = (float*)d_out; hp.ws = (unsigned char*)d_ws; hp.early2 = (ws_size >= WS_END2) ? 1 : 0;
    void* args[] = {&hp};
    hipError_t e = hipLaunchCooperativeKernel((const void*)mk_fwd, dim3(grid), dim3(512), args, LDS_BYTES, stream);
    if (e != hipSuccess) fprintf(stderr, "kernel_launch: cooperative launch failed: %s\n", hipGetErrorString(e));
}
```
